# Optimizing an MI355X kernel written in HIP

```python
import math
import jax
import jax.numpy as jnp
from jax import lax
import numpy as np

D_MODEL = 1024
BATCH = 2
SEQ = 16384
DEPTH = 2

F32 = jnp.float32
CTX_LEN = 256
GRID_W = 64
HEAD_DIM = 64
GROUP_WIDTH = D_MODEL // 4
BLOCK = 128
NORM_EPS = 1e-6
ROPE_BASE = 10000.0
SWA_HEADS = GROUP_WIDTH // HEAD_DIM
SWA_KV_HEADS = SWA_HEADS // 2
WINDOW = 128
RET_HEADS = GROUP_WIDTH // HEAD_DIM
RET_CHUNK = 128
DIFF_HEADS = GROUP_WIDTH // HEAD_DIM
DIFF_DIM = HEAD_DIM // 2
LRU_WIDTH = GROUP_WIDTH
LRU_BLOCKS = 4
LRU_BLOCK = LRU_WIDTH // LRU_BLOCKS
CONV_WIDTH = 4
LRU_C = 8.0
D_FF = 2816
N_EXPERTS = 8
TOP_K = 2
D_FF_EXPERT = 3584

PROJ_WIDTHS = (
    SWA_HEADS * HEAD_DIM, SWA_KV_HEADS * HEAD_DIM, SWA_KV_HEADS * HEAD_DIM,
    RET_HEADS * HEAD_DIM, RET_HEADS * HEAD_DIM, RET_HEADS * HEAD_DIM, RET_HEADS * HEAD_DIM,
    DIFF_HEADS * 2 * DIFF_DIM, DIFF_HEADS * 2 * DIFF_DIM, DIFF_HEADS * HEAD_DIM,
    LRU_WIDTH, LRU_WIDTH)
D_IN = sum(PROJ_WIDTHS)

kernel_name = 'hybrid_parallel_heads_dit_block'


def rms_norm(x, g):
    xf = x.astype(F32)
    y = xf * lax.rsqrt(jnp.mean(xf * xf, axis=-1, keepdims=True) + NORM_EPS)
    return (y * g.astype(F32)).astype(x.dtype)


def head_norm(y, gain):
    yf = y.astype(F32)
    yn = yf * lax.rsqrt(jnp.mean(yf * yf, axis=-1, keepdims=True) + NORM_EPS)
    return yn * gain.astype(F32).reshape(y.shape[-2], y.shape[-1])


def modulate(h, shift, scale):
    return h * (1.0 + scale) + shift


def axial_rope(rows, dim):
    row = jnp.repeat(jnp.arange(rows, dtype=F32), GRID_W)
    col = jnp.tile(jnp.arange(GRID_W, dtype=F32), rows)
    n_freq = dim // 4
    inv = ROPE_BASE ** (-jnp.arange(n_freq, dtype=F32) / n_freq)
    ang = jnp.concatenate([row[:, None] * inv, col[:, None] * inv], axis=-1)
    return jnp.cos(ang), jnp.sin(ang)


def line_rope(n, dim):
    n_freq = dim // 2
    inv = ROPE_BASE ** (-jnp.arange(n_freq, dtype=F32) / n_freq)
    ang = jnp.arange(n, dtype=F32)[:, None] * inv
    return jnp.cos(ang), jnp.sin(ang)


def apply_rope(x, cos, sin):
    shape = (1, cos.shape[0]) + (1,) * (x.ndim - 3) + (cos.shape[-1],)
    cos = cos.reshape(shape)
    sin = sin.reshape(shape)
    x1, x2 = jnp.split(x, 2, axis=-1)
    return jnp.concatenate([x1 * cos - x2 * sin, x2 * cos + x1 * sin], axis=-1)


def _flip(t):
    return jnp.flip(t, axis=1)


def _ident(t):
    return t


def split_proj(p):
    cuts = np.cumsum(PROJ_WIDTHS)[:-1].tolist()
    return jnp.split(p, cuts, axis=-1)


def _heads(t, h):
    return t.reshape(t.shape[:2] + (h, -1))


def _diff_heads(t):
    return t.reshape(t.shape[:2] + (DIFF_HEADS, 2, DIFF_DIM))


def swa_mixer(q, k, v, qc, kc, vc, sink, rope, need_ctx):
    B, N = q.shape[:2]
    M = kc.shape[1]
    G, R, d = SWA_KV_HEADS, SWA_HEADS // SWA_KV_HEADS, HEAD_DIM
    nb = N // BLOCK
    scale = d ** -0.5
    q = apply_rope(q.astype(F32), *rope) * scale
    k = apply_rope(k.astype(F32), *rope)
    v = v.astype(F32)
    kc = kc.astype(F32)
    vc = vc.astype(F32)
    sink = sink.astype(F32).reshape(G, R, 1, 1)
    pad = ((0, 0), (BLOCK, BLOCK), (0, 0), (0, 0))
    kp = jnp.pad(k, pad).reshape(B, nb + 2, BLOCK, G, d)
    vp = jnp.pad(v, pad).reshape(B, nb + 2, BLOCK, G, d)
    kw = jnp.concatenate([kp[:, :-2], kp[:, 1:-1], kp[:, 2:]], axis=2)
    vw = jnp.concatenate([vp[:, :-2], vp[:, 1:-1], vp[:, 2:]], axis=2)
    qpos = (jnp.arange(nb) * BLOCK)[:, None, None] + jnp.arange(BLOCK)[None, :, None]
    kpos = (jnp.arange(nb) * BLOCK - BLOCK)[:, None, None] + jnp.arange(3 * BLOCK)[None, None, :]
    valid = (jnp.abs(qpos - kpos) <= WINDOW) & (kpos >= 0) & (kpos < N)
    qb = q.reshape(B, nb, BLOCK, G, R, d)
    s_win = jnp.einsum('bnqgrd,bnkgd->bngrqk', qb, kw)
    s_win = jnp.where(valid[None, :, None, None], s_win, -jnp.inf)
    s_ctx = jnp.einsum('bnqgrd,bmgd->bngrqm', qb, kc)
    s_sink = jnp.broadcast_to(sink, s_win.shape[:-1] + (1,))
    p = jax.nn.softmax(jnp.concatenate([s_win, s_ctx, s_sink], axis=-1), axis=-1)
    nw = 3 * BLOCK
    o = (jnp.einsum('bngrqk,bnkgd->bnqgrd', p[..., :nw], vw)
         + jnp.einsum('bngrqm,bmgd->bnqgrd', p[..., nw:nw + M], vc))
    o = o.reshape(B, N, G * R * d)
    oc = None
    if need_ctx:
        qcg = (qc.astype(F32) * scale).reshape(B, M, G, R, d)
        s = jnp.einsum('bmgrd,bngd->bgrmn', qcg, kc)
        s = jnp.concatenate([s, jnp.broadcast_to(sink, s.shape[:-1] + (1,))], axis=-1)
        pc = jax.nn.softmax(s, axis=-1)
        oc = jnp.einsum('bgrmn,bngd->bmgrd', pc[..., :M], vc).reshape(B, M, G * R * d)
    return o, oc


def _ret_summaries(k, v, lg):
    B, L, H, d = k.shape
    C = RET_CHUNK
    kc = k.reshape(B, L // C, C, H, d)
    vc = v.reshape(B, L // C, C, H, v.shape[-1])
    idx = jnp.arange(C)
    zeta = jnp.exp(lg[:, None] * (C - 1 - idx)[None, :])
    return jnp.einsum('bcmhd,hm,bcmhe->bchde', kc, zeta, vc)


def _ret_scan(U, lg, s0):
    decay = jnp.exp(lg * RET_CHUNK)[None, :, None, None]

    def step(S, u):
        return decay * S + u, S

    s_fin, s_prev = lax.scan(step, s0, jnp.moveaxis(U, 1, 0))
    return s_fin, jnp.moveaxis(s_prev, 0, 1)


def _ret_output(q, k, v, s_prev, lg):
    B, L, H, d = q.shape
    C = RET_CHUNK
    nc = L // C
    e = v.shape[-1]
    qc = q.reshape(B, nc, C, H, d)
    kc = k.reshape(B, nc, C, H, d)
    vc = v.reshape(B, nc, C, H, e)
    idx = jnp.arange(C)
    diff = idx[:, None] - idx[None, :]
    dmask = jnp.where(diff >= 0, jnp.exp(lg[:, None, None] * jnp.maximum(diff, 0)), 0.0)
    s = jnp.einsum('bcnhd,bcmhd->bchnm', qc, kc) * dmask
    inner = jnp.einsum('bchnm,bcmhe->bcnhe', s, vc)
    xi = jnp.exp(lg[:, None] * (idx + 1)[None, :])
    cross = jnp.einsum('bcnhd,bchde->bcnhe', qc, s_prev) * xi.T[None, None, :, :, None]
    return (inner + cross).reshape(B, L, H, e)


def retention_mixer(q, k, v, g, qc, kc, vc, gc, decay_logit, gn, rope, need_ctx):
    B, N, H, d = q.shape
    scale = d ** -0.5
    q = apply_rope(q.astype(F32), *rope)
    k = apply_rope(k.astype(F32), *rope) * scale
    v = v.astype(F32)
    qc = qc.astype(F32)
    kc = kc.astype(F32) * scale
    vc = vc.astype(F32)
    log_gamma = -jax.nn.softplus(-decay_logit.astype(F32))
    y = 0.0
    yc = 0.0
    for direction in range(2):
        lg = log_gamma[direction]
        fl = _flip if direction == 1 else _ident
        s0 = jnp.zeros((B, H, d, v.shape[-1]), F32)
        sc_fin, sc_prev = _ret_scan(_ret_summaries(fl(kc), fl(vc), lg), lg, s0)
        _, s_prev = _ret_scan(_ret_summaries(fl(k), fl(v), lg), lg, sc_fin)
        y = y + fl(_ret_output(fl(q), fl(k), fl(v), s_prev, lg))
        if need_ctx:
            yc = yc + fl(_ret_output(fl(qc), fl(kc), fl(vc), sc_prev, lg))
    o = head_norm(y, gn).reshape(B, N, H * d) * jax.nn.silu(g.astype(F32))
    oc = None
    if need_ctx:
        oc = head_norm(yc, gn).reshape(B, kc.shape[1], H * d) * jax.nn.silu(gc.astype(F32))
    return o, oc


def _diff_attend(qb, k, v, lam):
    s = jnp.einsum('bqhmd,bkhmd->bhmqk', qb, k)
    p = jax.nn.softmax(s, axis=-1)
    w = p[:, :, 0] - lam * p[:, :, 1]
    return jnp.einsum('bhqk,bkhe->bqhe', w, v)


def diff_mixer(q, k, v, qc, kc, vc, lam_vecs, gn, lam_init, rope, need_ctx):
    B, N, H = q.shape[:3]
    M = kc.shape[1]
    scale = DIFF_DIM ** -0.5
    q = apply_rope(q.astype(F32), *rope) * scale
    k = apply_rope(k.astype(F32), *rope)
    v = v.astype(F32)
    kc = kc.astype(F32)
    vc = vc.astype(F32)
    lv = lam_vecs.astype(F32)
    lam = jnp.exp(jnp.sum(lv[0] * lv[1])) - jnp.exp(jnp.sum(lv[2] * lv[3])) + lam_init
    k_all = jnp.concatenate([k, kc], axis=1)
    v_all = jnp.concatenate([v, vc], axis=1)
    nb = N // BLOCK
    qblocks = jnp.moveaxis(q.reshape(B, nb, BLOCK, H, 2, DIFF_DIM), 1, 0)
    o = lax.map(lambda qb: _diff_attend(qb, k_all, v_all, lam), qblocks)
    o = jnp.moveaxis(o, 0, 1).reshape(B, N, H, v.shape[-1])
    o = (head_norm(o, gn) * (1.0 - lam_init)).reshape(B, N, -1)
    oc = None
    if need_ctx:
        occ = _diff_attend(qc.astype(F32) * scale, kc, vc, lam)
        oc = (head_norm(occ, gn) * (1.0 - lam_init)).reshape(B, M, -1)
    return o, oc


def dwconv(x, w, b):
    y = lax.conv_general_dilated(x, w[:, None, :].astype(x.dtype), (1,), [(1, 2)],
                                 dimension_numbers=('NWC', 'WIO', 'NWC'),
                                 feature_group_count=x.shape[-1])
    return y + b


def _lin_combine(left, right):
    a_l, b_l = left
    a_r, b_r = right
    return a_l * a_r, a_r * b_l + b_r


def rglru_scan(u, wa, ba, wx, bx, lam, h0):
    B, L, W = u.shape
    ub = u.reshape(B, L, LRU_BLOCKS, LRU_BLOCK)
    r = jax.nn.sigmoid(jnp.einsum('blhi,hij->blhj', ub, wa.astype(F32)).reshape(B, L, W) + ba.astype(F32))
    i = jax.nn.sigmoid(jnp.einsum('blhi,hij->blhj', ub, wx.astype(F32)).reshape(B, L, W) + bx.astype(F32))
    log_a = -LRU_C * r * jax.nn.softplus(-lam.astype(F32))
    a = jnp.exp(log_a)
    b = jnp.sqrt(-jnp.expm1(2.0 * log_a)) * (i * u)
    b = b.at[:, 0].add(a[:, 0] * h0)
    _, h = lax.associative_scan(_lin_combine, (a, b), axis=1)
    return h


def rglru_mixer(xb, yb, xbc, ybc, conv_w, conv_b, wa, ba, wx, bx, lam, need_ctx):
    u = dwconv(xb, conv_w, conv_b).astype(F32)
    uc = dwconv(xbc, conv_w, conv_b).astype(F32)
    B = u.shape[0]
    h = 0.0
    hc = 0.0
    for direction in range(2):
        fl = _flip if direction == 1 else _ident
        prm = (wa[direction], ba[direction], wx[direction], bx[direction], lam[direction])
        hc_seq = rglru_scan(fl(uc), *prm, jnp.zeros((B, LRU_WIDTH), F32))
        h = h + fl(rglru_scan(fl(u), *prm, hc_seq[:, -1]))
        if need_ctx:
            hc = hc + fl(hc_seq)
    o = h * jax.nn.gelu(yb.astype(F32))
    oc = hc * jax.nn.gelu(ybc.astype(F32)) if need_ctx else None
    return o, oc


def hybrid_mixer(p, pc, sink, ret_logit, ret_g, diff_lam, diff_g, lam_init,
                 conv_w, conv_b, lru_wa, lru_ba, lru_wx, lru_bx, lru_lambda,
                 rope_attn, rope_diff, rope_ret, need_ctx):
    (aq, ak, av, rq, rk, rv, rg, dq, dk, dv, lx, ly) = split_proj(p)
    (aqc, akc, avc, rqc, rkc, rvc, rgc, dqc, dkc, dvc, lxc, lyc) = split_proj(pc)
    oa, oac = swa_mixer(_heads(aq, SWA_HEADS), _heads(ak, SWA_KV_HEADS), _heads(av, SWA_KV_HEADS),
                        _heads(aqc, SWA_HEADS), _heads(akc, SWA_KV_HEADS), _heads(avc, SWA_KV_HEADS),
                        sink, rope_attn, need_ctx)
    ob, obc = retention_mixer(_heads(rq, RET_HEADS), _heads(rk, RET_HEADS), _heads(rv, RET_HEADS), rg,
                              _heads(rqc, RET_HEADS), _heads(rkc, RET_HEADS), _heads(rvc, RET_HEADS), rgc,
                              ret_logit, ret_g, rope_ret, need_ctx)
    od, odc = diff_mixer(_diff_heads(dq), _diff_heads(dk), _heads(dv, DIFF_HEADS),
                         _diff_heads(dqc), _diff_heads(dkc), _heads(dvc, DIFF_HEADS),
                         diff_lam, diff_g, lam_init, rope_diff, need_ctx)
    ol, olc = rglru_mixer(lx, ly, lxc, lyc, conv_w, conv_b, lru_wa, lru_ba, lru_wx, lru_bx,
                          lru_lambda, need_ctx)
    o = jnp.concatenate([oa, ob, od, ol], axis=-1).astype(p.dtype)
    o_ctx = jnp.concatenate([oac, obc, odc, olc], axis=-1).astype(pc.dtype) if need_ctx else None
    return o, o_ctx


def swiglu(h, w1, w3, w2):
    return (jax.nn.silu(h @ w1) * (h @ w3)) @ w2


def moe_swiglu(h, router, w1, w3, w2):
    logits = jnp.einsum('bld,de->ble', h, router).astype(F32)
    top_val, top_idx = lax.top_k(logits, TOP_K)
    top_w = jax.nn.softmax(top_val, axis=-1)
    gate = jnp.sum(jax.nn.one_hot(top_idx, N_EXPERTS, dtype=F32) * top_w[..., None], axis=-2)
    out = jnp.zeros(h.shape, F32)
    for e in range(N_EXPERTS):
        out = out + gate[..., e:e + 1] * swiglu(h, w1[e], w3[e], w2[e])
    return out.astype(h.dtype)


def setup_inputs(seed: int = 0) -> dict:
    key = jax.random.key(seed)
    keys = jax.random.split(key, 32)
    counter = [0]

    def nrm(shape, std):
        k = keys[counter[0]]
        counter[0] += 1
        return jax.random.normal(k, shape, F32) * std

    D = D_MODEL
    n_dense = (DEPTH + 1) // 2
    n_moe = DEPTH // 2
    gam = 1.0 - 2.0 ** (-5.0 - jnp.arange(RET_HEADS, dtype=F32))
    ret_base = jnp.log(gam) - jnp.log1p(-gam)
    a_c = jax.random.uniform(keys[31], (DEPTH, 2, LRU_WIDTH), F32, 0.9, 0.999)
    a = a_c ** (1.0 / LRU_C)
    return {
        'x': nrm((BATCH, SEQ, D), 1.0),
        'c': nrm((BATCH, D), 1.0),
        'ctx': nrm((BATCH, CTX_LEN, D), 1.0),
        'c_ctx': nrm((D,), 1.0),
        'w_ada': nrm((DEPTH, D, 6 * D), 0.5 * D ** -0.5),
        'b_ada': nrm((DEPTH, 6 * D), 0.02),
        'g_norm1': 1.0 + nrm((DEPTH, D), 0.05),
        'g_norm2': 1.0 + nrm((DEPTH, D), 0.05),
        'w_in': nrm((DEPTH, D, D_IN), D ** -0.5),
        'w_out': nrm((DEPTH, D, D), D ** -0.5),
        'attn_sink': nrm((DEPTH, SWA_HEADS), 0.5),
        'ret_decay_logit': ret_base + nrm((DEPTH, 2, RET_HEADS), 0.1),
        'ret_gn': 1.0 + nrm((DEPTH, RET_HEADS * HEAD_DIM), 0.05),
        'diff_lambda': nrm((DEPTH, 4, DIFF_DIM), 0.1),
        'diff_gn': 1.0 + nrm((DEPTH, DIFF_HEADS * HEAD_DIM), 0.05),
        'conv_w': nrm((DEPTH, CONV_WIDTH, LRU_WIDTH), CONV_WIDTH ** -0.5),
        'conv_b': nrm((DEPTH, LRU_WIDTH), 0.02),
        'lru_wa': nrm((DEPTH, 2, LRU_BLOCKS, LRU_BLOCK, LRU_BLOCK), LRU_BLOCK ** -0.5),
        'lru_ba': nrm((DEPTH, 2, LRU_WIDTH), 0.02),
        'lru_wx': nrm((DEPTH, 2, LRU_BLOCKS, LRU_BLOCK, LRU_BLOCK), LRU_BLOCK ** -0.5),
        'lru_bx': nrm((DEPTH, 2, LRU_WIDTH), 0.02),
        'lru_lambda': jnp.log(a) - jnp.log1p(-a),
        'ffn_w1': nrm((n_dense, D, D_FF), D ** -0.5),
        'ffn_w3': nrm((n_dense, D, D_FF), D ** -0.5),
        'ffn_w2': nrm((n_dense, D_FF, D), D_FF ** -0.5),
        'moe_router': nrm((n_moe, D, N_EXPERTS), D ** -0.5),
        'moe_w1': nrm((n_moe, N_EXPERTS, D, D_FF_EXPERT), D ** -0.5),
        'moe_w3': nrm((n_moe, N_EXPERTS, D, D_FF_EXPERT), D ** -0.5),
        'moe_w2': nrm((n_moe, N_EXPERTS, D_FF_EXPERT, D), D_FF_EXPERT ** -0.5),
        'final_norm': 1.0 + nrm((D,), 0.05),
    }


def reference(x, c, ctx, c_ctx, w_ada, b_ada, g_norm1, g_norm2, w_in, w_out,
              attn_sink, ret_decay_logit, ret_gn, diff_lambda, diff_gn,
              conv_w, conv_b, lru_wa, lru_ba, lru_wx, lru_bx, lru_lambda,
              ffn_w1, ffn_w3, ffn_w2, moe_router, moe_w1, moe_w3, moe_w2, final_norm):
    n_lat = x.shape[1]
    rows = n_lat // GRID_W
    rope_attn = axial_rope(rows, HEAD_DIM)
    rope_diff = axial_rope(rows, DIFF_DIM)
    rope_ret = line_rope(n_lat, HEAD_DIM)
    xc = ctx
    for layer in range(DEPTH):
        need_ctx = layer < DEPTH - 1
        lam_init = 0.8 - 0.6 * math.exp(-0.3 * layer)
        mod = (jax.nn.silu(c) @ w_ada[layer] + b_ada[layer])[:, None, :]
        mod_c = jax.nn.silu(c_ctx) @ w_ada[layer] + b_ada[layer]
        sh1, sc1, gt1, sh2, sc2, gt2 = jnp.split(mod, 6, axis=-1)
        sh1c, sc1c, gt1c, sh2c, sc2c, gt2c = jnp.split(mod_c, 6, axis=-1)
        h = modulate(rms_norm(x, g_norm1[layer]), sh1, sc1)
        hc = modulate(rms_norm(xc, g_norm1[layer]), sh1c, sc1c)
        o, o_ctx = hybrid_mixer(h @ w_in[layer], hc @ w_in[layer],
                                attn_sink[layer], ret_decay_logit[layer], ret_gn[layer],
                                diff_lambda[layer], diff_gn[layer], lam_init,
                                conv_w[layer], conv_b[layer], lru_wa[layer], lru_ba[layer],
                                lru_wx[layer], lru_bx[layer], lru_lambda[layer],
                                rope_attn, rope_diff, rope_ret, need_ctx)
        x = x + gt1 * (o @ w_out[layer])
        j = layer // 2
        if layer % 2 == 0:
            ffn = lambda t: swiglu(t, ffn_w1[j], ffn_w3[j], ffn_w2[j])
        else:
            ffn = lambda t: moe_swiglu(t, moe_router[j], moe_w1[j], moe_w3[j], moe_w2[j])
        x = x + gt2 * ffn(modulate(rms_norm(x, g_norm2[layer]), sh2, sc2))
        if need_ctx:
            xc = xc + gt1c * (o_ctx @ w_out[layer])
            xc = xc + gt2c * ffn(modulate(rms_norm(xc, g_norm2[layer]), sh2c, sc2c))
    return rms_norm(x, final_norm)
```

```cpp
#include <hip/hip_runtime.h>
#include <cstdio>
#include <cstdint>

typedef unsigned short bf16_t;
typedef short bf16x8 __attribute__((ext_vector_type(8)));
typedef float f32x4 __attribute__((ext_vector_type(4)));

constexpr int NB = 2, NSEQ = 16384, NCTX = 256, DM = 1024;
constexpr int NLAT = NB * NSEQ;
constexpr int NCR = NB * NCTX;
constexpr int NROW = NLAT + NCR;
constexpr int DIN = 2816, DFF = 2816, DFE = 3584, NE = 8;
constexpr int NCI = 130;
constexpr int C_AQ = 0, C_AK = 256, C_AV = 384, C_RQ = 512, C_RK = 768, C_RV = 1024, C_RG = 1280, C_DQ = 1536, C_DK = 1792, C_DV = 2048, C_LX = 2304, C_LY = 2560;
constexpr int GRP_ROWS = 34816;

constexpr size_t al256(size_t x) { return (x + 255) & ~(size_t)255; }
constexpr size_t OFF_CTRL = 0;
constexpr size_t OFF_MOD = 65536;
constexpr size_t OFF_ROPE_RET = al256(OFF_MOD + 2 * 3 * 6144 * 4);
constexpr size_t OFF_ROPE_AX = al256(OFF_ROPE_RET + 2 * 16384 * 32 * 4);
constexpr size_t OFF_XC = al256(OFF_ROPE_AX + (2 * 256 * 16 + 2 * 64 * 16 + 2 * 256 * 8 + 2 * 64 * 8) * 4);
constexpr size_t OFF_ROUTE = al256(OFF_XC + (size_t)NCR * DM * 4);
constexpr size_t OFF_TOK = al256(OFF_ROUTE + (size_t)NLAT * 16);
constexpr size_t OFF_WGT = al256(OFF_TOK + (size_t)2 * GRP_ROWS * 4);
constexpr size_t OFF_LRU = al256(OFF_WGT + (size_t)2 * GRP_ROWS * 4);
constexpr size_t OFF_WM13 = al256(OFF_LRU + (size_t)3 * 2 * 2 * NCI * 256 * 4);
constexpr size_t OFF_WM2 = al256(OFF_WM13 + (size_t)NE * 2 * DFE * DM * 2);
constexpr size_t OFF_R = al256(OFF_WM2 + (size_t)NE * DM * DFE * 2);
constexpr size_t OFF_P = OFF_R;
constexpr size_t OFF_ACT = al256(OFF_P + (size_t)NROW * DIN * 2);
constexpr size_t OFF_RET = al256(OFF_ACT + (size_t)NROW * DM * 2);
constexpr size_t OFF_WIN = al256(OFF_RET + (size_t)2 * 2 * NCI * 4 * 4096 * 4);
constexpr size_t OFF_WOUT = al256(OFF_WIN + (size_t)2 * DIN * DM * 2);
constexpr size_t OFF_WF13 = al256(OFF_WOUT + (size_t)2 * DM * DM * 2);
constexpr size_t OFF_WF2 = al256(OFF_WF13 + (size_t)2 * DFF * DM * 2);
constexpr size_t OFF_R_END1 = al256(OFF_WF2 + (size_t)DM * DFF * 2);
constexpr size_t OFF_ASORT = OFF_R;
constexpr size_t OFF_UMOE = al256(OFF_ASORT + (size_t)2 * GRP_ROWS * DM * 2);
constexpr size_t OFF_R_END2 = al256(OFF_UMOE + (size_t)GRP_ROWS * DFE * 2);
constexpr size_t WS_NEED = OFF_R_END1 > OFF_R_END2 ? OFF_R_END1 : OFF_R_END2;
static_assert(OFF_ACT >= OFF_UMOE, "H2 must not overlap A_sorted");
constexpr int CW_CNT = 4096;
constexpr int CW_CUR = 4160;

struct Params {
    const float *x, *c, *ctx, *c_ctx, *w_ada, *b_ada, *g1, *g2, *w_in, *w_out, *sink, *ret_logit, *ret_gn, *diff_lam, *diff_gn,
        *conv_w, *conv_b, *lru_wa, *lru_ba, *lru_wx, *lru_bx, *lru_lam, *ffn_w1, *ffn_w3, *ffn_w2, *moe_router, *moe_w1, *moe_w3, *moe_w2, *final_norm;
    float* out; char* ws;
};

__device__ __forceinline__ float bf2f(bf16_t h) { return __uint_as_float(((unsigned)h) << 16); }
__device__ __forceinline__ bf16_t f2bf(float f) { unsigned u = __float_as_uint(f); u += 0x7fffu + ((u >> 16) & 1u); return (bf16_t)(u >> 16); }
__device__ __forceinline__ unsigned pack2(float lo, float hi) { return (unsigned)f2bf(lo) | ((unsigned)f2bf(hi) << 16); }
__device__ __forceinline__ float wave_sum(float v) {
#pragma unroll
    for (int o = 32; o >= 1; o >>= 1) v += __shfl_xor(v, o);
    return v;
}
__device__ __forceinline__ float sigmoidf_(float x) { return 1.0f / (1.0f + __expf(-x)); }
__device__ __forceinline__ float siluf_(float x) { return x / (1.0f + __expf(-x)); }
__device__ __forceinline__ float softplusf_(float x) { return x > 20.f ? x : log1pf(expf(x)); }
__device__ __forceinline__ float gelu_tanh(float x) { const float u = 0.7978845608028654f * (x + 0.044715f * x * x * x); return 0.5f * x * (1.0f + tanhf(u)); }
__device__ __forceinline__ int row_base(int b, int ci) { return ci < 2 ? NLAT + b * NCTX + ci * 128 : b * NSEQ + (ci - 2) * 128; }
__device__ __forceinline__ int mod_class(int row) { return row < NSEQ ? 0 : (row < NLAT ? 1 : 2); }

__device__ void convert_tile(const float* src, int K, int N, bf16_t* dst, int tile, int mode, float* lds) {
    const int tpn = N / 64, tk = tile / tpn, tn = tile % tpn, t = threadIdx.x;
    {   const int kk = t >> 3, nc = (t & 7) * 8;
        const float4 a = *(const float4*)(src + (size_t)(tk * 64 + kk) * N + tn * 64 + nc);
        const float4 b = *(const float4*)(src + (size_t)(tk * 64 + kk) * N + tn * 64 + nc + 4);
        float* d = lds + kk * 65 + nc; d[0] = a.x; d[1] = a.y; d[2] = a.z; d[3] = a.w; d[4] = b.x; d[5] = b.y; d[6] = b.z; d[7] = b.w; }
    __syncthreads();
    {   const int n = t >> 3, kc = (t & 7) * 8, ng = tn * 64 + n;
        const int nrow = mode == 0 ? ng : ((ng >> 7) * 256 + (mode == 2 ? 128 : 0) + (ng & 127));
        uint4 w; w.x = pack2(lds[(kc + 0) * 65 + n], lds[(kc + 1) * 65 + n]); w.y = pack2(lds[(kc + 2) * 65 + n], lds[(kc + 3) * 65 + n]);
        w.z = pack2(lds[(kc + 4) * 65 + n], lds[(kc + 5) * 65 + n]); w.w = pack2(lds[(kc + 6) * 65 + n], lds[(kc + 7) * 65 + n]);
        *(uint4*)(dst + (size_t)nrow * K + tk * 64 + kc) = w; }
    __syncthreads();
}

__device__ void ph_prologue(const Params& p, int bid, int nb, float* lds) {
    char* ws = p.ws; const int t = threadIdx.x;
    {
        const int T_IN = 16 * 44, T_OUT = 16 * 16, T_F13 = 16 * 44, T_F2 = 44 * 16, T_M13 = 16 * 56, T_M2 = 56 * 16;
        const int total = 2 * T_IN + 2 * T_OUT + 2 * T_F13 + T_F2 + 16 * T_M13 + 8 * T_M2;
        for (int u = bid; u < total; u += nb) {
            int r = u;
            if (r < 2 * T_IN) { const int l = r / T_IN; convert_tile(p.w_in + (size_t)l * DM * DIN, DM, DIN, (bf16_t*)(ws + OFF_WIN) + (size_t)l * DIN * DM, r % T_IN, 0, lds); continue; } r -= 2 * T_IN;
            if (r < 2 * T_OUT) { const int l = r / T_OUT; convert_tile(p.w_out + (size_t)l * DM * DM, DM, DM, (bf16_t*)(ws + OFF_WOUT) + (size_t)l * DM * DM, r % T_OUT, 0, lds); continue; } r -= 2 * T_OUT;
            if (r < T_F13) { convert_tile(p.ffn_w1, DM, DFF, (bf16_t*)(ws + OFF_WF13), r, 1, lds); continue; } r -= T_F13;
            if (r < T_F13) { convert_tile(p.ffn_w3, DM, DFF, (bf16_t*)(ws + OFF_WF13), r, 2, lds); continue; } r -= T_F13;
            if (r < T_F2) { convert_tile(p.ffn_w2, DFF, DM, (bf16_t*)(ws + OFF_WF2), r, 0, lds); continue; } r -= T_F2;
            if (r < 8 * T_M13) { const int e = r / T_M13; convert_tile(p.moe_w1 + (size_t)e * DM * DFE, DM, DFE, (bf16_t*)(ws + OFF_WM13) + (size_t)e * 2 * DFE * DM, r % T_M13, 1, lds); continue; } r -= 8 * T_M13;
            if (r < 8 * T_M13) { const int e = r / T_M13; convert_tile(p.moe_w3 + (size_t)e * DM * DFE, DM, DFE, (bf16_t*)(ws + OFF_WM13) + (size_t)e * 2 * DFE * DM, r % T_M13, 2, lds); continue; } r -= 8 * T_M13;
            { const int e = r / T_M2; convert_tile(p.moe_w2 + (size_t)e * DFE * DM, DFE, DM, (bf16_t*)(ws + OFF_WM2) + (size_t)e * DM * DFE, r % T_M2, 0, lds); }
        }
    }
    {
        float* sv = lds;
        float* red = lds + 3072;
        for (int i = t; i < 3072; i += 512) { const int v = i >> 10, k = i & 1023; const float cv = v < 2 ? p.c[v * DM + k] : p.c_ctx[k]; sv[i] = siluf_(cv); }
        __syncthreads();
        float* mod = (float*)(ws + OFF_MOD);
        for (int u = bid; u < 2 * 96; u += nb) {
            const int l = u / 96, j0 = (u % 96) * 64, j = t & 63, kg = t >> 6;
            float a0 = 0.f, a1 = 0.f, a2 = 0.f;
            const float* w = p.w_ada + (size_t)l * DM * 6144 + j0 + j;
            for (int k = kg * 128; k < kg * 128 + 128; ++k) { const float wv = w[(size_t)k * 6144]; a0 += sv[k] * wv; a1 += sv[1024 + k] * wv; a2 += sv[2048 + k] * wv; }
            red[(kg * 3 + 0) * 64 + j] = a0; red[(kg * 3 + 1) * 64 + j] = a1; red[(kg * 3 + 2) * 64 + j] = a2;
            __syncthreads();
            if (t < 192) { const int v = t >> 6; float s = 0.f;
                for (int g = 0; g < 8; ++g) s += red[(g * 3 + v) * 64 + j];
                mod[((size_t)l * 3 + v) * 6144 + j0 + j] = s + p.b_ada[l * 6144 + j0 + j]; }
            __syncthreads();
        }
    }
    {
        float* rr = (float*)(ws + OFF_ROPE_RET);
        const int gt = bid * 512 + t, gs = nb * 512;
        for (int i = gt; i < 16384 * 32; i += gs) { const int n = i >> 5, j = i & 31;
            const float inv = (float)pow(10000.0, -(double)j / 32.0); const float ang = (float)n * inv;
            rr[i] = (float)cos((double)ang); rr[16384 * 32 + i] = (float)sin((double)ang); }
        float* ax = (float*)(ws + OFF_ROPE_AX);
        for (int i = gt; i < 256 * 16; i += gs) { const int n = i >> 4, j = i & 15; const float inv = (float)pow(10000.0, -(double)j / 16.0); const float ang = (float)n * inv;
            ax[i] = (float)cos((double)ang); ax[4096 + i] = (float)sin((double)ang);
            if (n < 64) { ax[8192 + i] = (float)cos((double)ang); ax[9216 + i] = (float)sin((double)ang); } }
        for (int i = gt; i < 256 * 8; i += gs) { const int n = i >> 3, j = i & 7; const float inv = (float)pow(10000.0, -(double)j / 8.0); const float ang = (float)n * inv;
            ax[10240 + i] = (float)cos((double)ang); ax[12288 + i] = (float)sin((double)ang);
            if (n < 64) { ax[14336 + i] = (float)cos((double)ang); ax[14848 + i] = (float)sin((double)ang); } }
        float* xc = (float*)(ws + OFF_XC);
        for (int i = gt; i < NCR * DM / 4; i += gs) ((float4*)xc)[i] = ((const float4*)p.ctx)[i];
        int* tok = (int*)(ws + OFF_TOK);
        for (int i = gt; i < 2 * GRP_ROWS; i += gs) tok[i] = -1;
    }
}

template <bool ROUTE>
__device__ void ph_norm(const Params& p, int l, int which  , int nrows, int bid, int nb) {
    char* ws = p.ws; const int lane = threadIdx.x & 63, wv = threadIdx.x >> 6;
    const float* mod = (const float*)(ws + OFF_MOD) + (size_t)l * 3 * 6144;
    const float* g = (which == 0 ? p.g1 : p.g2) + l * DM;
    bf16_t* H = (bf16_t*)(ws + OFF_ACT);
    const float* xl = (which == 0 && l == 0) ? p.x : p.out;
    const float* xc = (const float*)(ws + OFF_XC);
    for (int r = bid * 8 + wv; r < nrows; r += nb * 8) {
        const float* xr = r < NLAT ? xl + (size_t)r * DM : xc + (size_t)(r - NLAT) * DM;
        const float* mv = mod + (size_t)mod_class(r) * 6144 + (which == 0 ? 0 : 3072);
        float4 v[4]; float ss = 0.f;
#pragma unroll
        for (int i = 0; i < 4; ++i) { v[i] = *(const float4*)(xr + i * 256 + lane * 4); ss += v[i].x * v[i].x + v[i].y * v[i].y + v[i].z * v[i].z + v[i].w * v[i].w; }
        ss = wave_sum(ss);
        const float rn = rsqrtf(ss * (1.0f / 1024.0f) + 1e-6f);
        float lg[8];
        if (ROUTE) {
#pragma unroll
            for (int e = 0; e < 8; ++e) lg[e] = 0.f;
        }
#pragma unroll
        for (int i = 0; i < 4; ++i) {
            const int c = i * 256 + lane * 4;
            const float4 gg = *(const float4*)(g + c), sh = *(const float4*)(mv + c), sc = *(const float4*)(mv + 1024 + c);
            float h0 = v[i].x * rn * gg.x * (1.f + sc.x) + sh.x, h1 = v[i].y * rn * gg.y * (1.f + sc.y) + sh.y;
            float h2 = v[i].z * rn * gg.z * (1.f + sc.z) + sh.z, h3 = v[i].w * rn * gg.w * (1.f + sc.w) + sh.w;
            uint2 w; w.x = pack2(h0, h1); w.y = pack2(h2, h3);
            *(uint2*)(H + (size_t)r * DM + c) = w;
            if (ROUTE) {
                const float* rt = p.moe_router + (size_t)c * 8;
#pragma unroll
                for (int e = 0; e < 8; ++e) lg[e] += h0 * rt[e] + h1 * rt[8 + e] + h2 * rt[16 + e] + h3 * rt[24 + e];
            }
        }
        if (ROUTE) {
#pragma unroll
            for (int e = 0; e < 8; ++e) lg[e] = wave_sum(lg[e]);
            if (lane == 0 && r < NLAT) {
                int e0 = 0; float v0 = lg[0];
#pragma unroll
                for (int e = 1; e < 8; ++e) if (lg[e] > v0) { v0 = lg[e]; e0 = e; }
                int e1 = -1; float v1 = -3.0e38f;
#pragma unroll
                for (int e = 0; e < 8; ++e) if (e != e0 && lg[e] > v1) { v1 = lg[e]; e1 = e; }
                const float ex = __expf(v1 - v0), w0 = 1.0f / (1.0f + ex), w1 = ex / (1.0f + ex);
                int4 rec; rec.x = e0; rec.y = e1; rec.z = __float_as_int(w0); rec.w = __float_as_int(w1);
                *(int4*)(ws + OFF_ROUTE + (size_t)r * 16) = rec;
                unsigned* cw = (unsigned*)ws;
                atomicAdd(cw + CW_CNT + e0, 1u); atomicAdd(cw + CW_CNT + 8 + e1, 1u);
            }
        }
    }
}

template <bool DUAL, class MT, class BSel, class Epi>
__device__ void gemm_direct(const bf16_t* A, int ntiles, int K, MT mtiles_fn, BSel bsel, Epi epi, int bid, int nb) {
    const int lane = threadIdx.x & 63, wv = threadIdx.x >> 6, wr = wv >> 2, wc = wv & 3, fr = lane & 15, fq = lane >> 4;
    const int mtiles = mtiles_fn();
    for (int u = bid; u < mtiles * ntiles; u += nb) {
        const int tm = u / ntiles, tn = u % ntiles;
        const bf16_t* Bt = bsel(tm);
        const int r0 = tm * 128 + wr * 64, c0 = tn * 256 + wc * 64;
        const int br0 = DUAL ? ((c0 >> 7) * 256 + (c0 & 127)) : c0;
        f32x4 acc[4][4], acc2[DUAL ? 4 : 1][DUAL ? 4 : 1];
#pragma unroll
        for (int i = 0; i < 4; ++i)
#pragma unroll
            for (int j = 0; j < 4; ++j) { acc[i][j] = (f32x4){0.f, 0.f, 0.f, 0.f}; if (DUAL) acc2[i][j] = (f32x4){0.f, 0.f, 0.f, 0.f}; }
        const bf16_t* ap = A + (size_t)(r0 + fr) * K + fq * 8;
        const bf16_t* bp = Bt + (size_t)(br0 + fr) * K + fq * 8;
        for (int k = 0; k < K; k += 32) {
            bf16x8 a[4], b[4], b2[DUAL ? 4 : 1];
#pragma unroll
            for (int i = 0; i < 4; ++i) a[i] = *(const bf16x8*)(ap + (size_t)i * 16 * K + k);
#pragma unroll
            for (int j = 0; j < 4; ++j) { b[j] = *(const bf16x8*)(bp + (size_t)j * 16 * K + k); if (DUAL) b2[j] = *(const bf16x8*)(bp + (size_t)(128 + j * 16) * K + k); }
#pragma unroll
            for (int i = 0; i < 4; ++i)
#pragma unroll
                for (int j = 0; j < 4; ++j) {
                    acc[i][j] = __builtin_amdgcn_mfma_f32_16x16x32_bf16(a[i], b[j], acc[i][j], 0, 0, 0);
                    if (DUAL) acc2[i][j] = __builtin_amdgcn_mfma_f32_16x16x32_bf16(a[i], b2[j], acc2[i][j], 0, 0, 0);
                }
        }
#pragma unroll
        for (int i = 0; i < 4; ++i)
#pragma unroll
            for (int j = 0; j < 4; ++j)
#pragma unroll
                for (int q = 0; q < 4; ++q) epi(r0 + i * 16 + fq * 4 + q, c0 + j * 16 + fr, acc[i][j][q], DUAL ? acc2[i][j][q] : 0.f);
    }
}

__device__ void ph_rope(const Params& p, int bid, int nb) {
    char* ws = p.ws; const int lane = threadIdx.x & 63, wv = threadIdx.x >> 6;
    bf16_t* P = (bf16_t*)(ws + OFF_P);
    const float* rr = (const float*)(ws + OFF_ROPE_RET); const float* ax = (const float*)(ws + OFF_ROPE_AX);
    for (int r = bid * 8 + wv; r < NROW; r += nb * 8) {
        const bool lat = r < NLAT; const int n = r & (NSEQ - 1), gr = n >> 6, gc = n & 63;
        bf16_t* pr = P + (size_t)r * DIN;
        for (int it = 0; it < 11; ++it) {
            const int pi = it * 64 + lane;
            int c1, c2; float cs = 1.f, sn = 0.f, scale = 1.f;
            if (pi < 192) {
                const int hd = pi >> 5, j = pi & 31; c1 = (pi < 128 ? C_AQ : C_AK - 256) + hd * 64 + j; c2 = c1 + 32;
                if (pi < 128) scale = 0.125f;
                if (lat) { if (j < 16) { cs = ax[gr * 16 + j]; sn = ax[4096 + gr * 16 + j]; } else { cs = ax[8192 + gc * 16 + j - 16]; sn = ax[9216 + gc * 16 + j - 16]; } }
            } else if (pi < 448) {
                const int q = pi - 192, hd = q >> 5, j = q & 31; c1 = C_RQ + hd * 64 + j; c2 = c1 + 32;
                if (q >= 128) scale = 0.125f;
                if (lat) { cs = rr[n * 32 + j]; sn = rr[16384 * 32 + n * 32 + j]; }
            } else {
                const int q = pi - 448, blk = q >> 4, j = q & 15; c1 = C_DQ + blk * 32 + j; c2 = c1 + 16;
                if (q < 128) scale = 0.17677669529663687f;
                if (lat) { if (j < 8) { cs = ax[10240 + gr * 8 + j]; sn = ax[12288 + gr * 8 + j]; } else { cs = ax[14336 + gc * 8 + j - 8]; sn = ax[14848 + gc * 8 + j - 8]; } }
            }
            const float x1 = bf2f(pr[c1]), x2 = bf2f(pr[c2]);
            pr[c1] = f2bf((x1 * cs - x2 * sn) * scale); pr[c2] = f2bf((x2 * cs + x1 * sn) * scale);
        }
    }
}

__device__ __forceinline__ float ret_lg(const Params& p, int l, int dir, int h) { return -softplusf_(-p.ret_logit[(l * 2 + dir) * 4 + h]); }
__device__ void ph_ret_summ(const Params& p, int l, int bid, int nb, float* lds) {
    char* ws = p.ws; const int t = threadIdx.x;
    const bf16_t* P = (const bf16_t*)(ws + OFF_P); float* RET = (float*)(ws + OFF_RET);
    float* ks = lds; float* vs = lds + 128 * 64; float* zf = vs + 128 * 64; float* zb = zf + 128;
    for (int u = bid; u < 2 * NCI * 4; u += nb) {
        const int h = u & 3, ci = (u >> 2) % NCI, b = u / (4 * NCI), rb = row_base(b, ci);
        const float lgf = ret_lg(p, l, 0, h), lgb = ret_lg(p, l, 1, h);
        __syncthreads();
        for (int i = t; i < 128 * 64; i += 512) { const int m = i >> 6, d = i & 63; ks[i] = bf2f(P[(size_t)(rb + m) * DIN + C_RK + h * 64 + d]); vs[i] = bf2f(P[(size_t)(rb + m) * DIN + C_RV + h * 64 + d]); }
        if (t < 128) { zf[t] = expf(lgf * (float)(127 - t)); zb[t] = expf(lgb * (float)t); }
        __syncthreads();
        const int d = t >> 3, e0 = (t & 7) * 8;
        float af[8], ab[8];
#pragma unroll
        for (int j = 0; j < 8; ++j) { af[j] = 0.f; ab[j] = 0.f; }
        for (int m = 0; m < 128; ++m) { const float kv = ks[m * 64 + d], kf = kv * zf[m], kb = kv * zb[m];
#pragma unroll
            for (int j = 0; j < 8; ++j) { const float vv = vs[m * 64 + e0 + j]; af[j] += kf * vv; ab[j] += kb * vv; } }
        float* of = RET + ((((size_t)0 * 2 + b) * NCI + ci) * 4 + h) * 4096 + d * 64 + e0;
        float* ob = RET + ((((size_t)1 * 2 + b) * NCI + ci) * 4 + h) * 4096 + d * 64 + e0;
#pragma unroll
        for (int j = 0; j < 8; ++j) { of[j] = af[j]; ob[j] = ab[j]; }
    }
}

template <int MODE>
__device__ void ph_lru_chunk(const Params& p, int l, int bid, int nb, float* lds, int ci_lo) {
    char* ws = p.ws; const int t = threadIdx.x;
    const bf16_t* P = (const bf16_t*)(ws + OFF_P);
    float* LA = (float*)(ws + OFF_LRU); float* LB = LA + 2 * 2 * NCI * 256; float* LC = LB + 2 * 2 * NCI * 256;
    bf16_t* O = (bf16_t*)(ws + OFF_ACT);
    float* us = lds;
    float* as_ = lds + 8192;
    float* bs_ = lds + 16384;
    float* hs = lds + 24576;
    const int nci = NCI - ci_lo;
    for (int u = bid; u < 2 * nci * 4; u += nb) {
        const int hb = u & 3, ci = ci_lo + (u >> 2) % nci, b = u / (4 * nci), rb = row_base(b, ci);
        const int seg_lo = ci < 2 ? NLAT + b * NCTX : b * NSEQ, seg_hi = ci < 2 ? seg_lo + NCTX : seg_lo + NSEQ;
        __syncthreads();
        for (int i = t; i < 128 * 64; i += 512) { const int tt = i >> 6, j = i & 63, ch = hb * 64 + j; float acc = p.conv_b[l * 256 + ch];
#pragma unroll
            for (int k = 0; k < 4; ++k) { const int rr = rb + tt - 1 + k; if (rr >= seg_lo && rr < seg_hi) acc += p.conv_w[(l * 4 + k) * 256 + ch] * bf2f(P[(size_t)rr * DIN + C_LX + ch]); }
            us[i] = acc; }
        __syncthreads();
        for (int dir = 0; dir < 2; ++dir) {
            const int j = t & 63, tg = t >> 6, ch = hb * 64 + j;
            const float* wa = p.lru_wa + (((size_t)(l * 2 + dir) * 4 + hb) * 64) * 64 + j;
            const float* wx = p.lru_wx + (((size_t)(l * 2 + dir) * 4 + hb) * 64) * 64 + j;
            const float ba = p.lru_ba[(l * 2 + dir) * 256 + ch], bx = p.lru_bx[(l * 2 + dir) * 256 + ch];
            const float spl = softplusf_(-p.lru_lam[(l * 2 + dir) * 256 + ch]);
            float ra[16], rx[16];
#pragma unroll
            for (int k = 0; k < 16; ++k) { ra[k] = ba; rx[k] = bx; }
            for (int i = 0; i < 64; ++i) { const float wav = wa[i * 64], wxv = wx[i * 64];
#pragma unroll
                for (int k = 0; k < 16; ++k) { const float uv = us[(tg * 16 + k) * 64 + i]; ra[k] += uv * wav; rx[k] += uv * wxv; } }
#pragma unroll
            for (int k = 0; k < 16; ++k) { const int tt = tg * 16 + k; const float r = sigmoidf_(ra[k]), ig = sigmoidf_(rx[k]);
                const float la = -8.0f * r * spl, a = expf(la), bb = sqrtf(-expm1f(2.0f * la)) * (ig * us[tt * 64 + j]);
                as_[tt * 64 + j] = a; bs_[tt * 64 + j] = bb; }
            __syncthreads();
            if (t < 64) {
                const size_t cidx = (((size_t)dir * 2 + b) * NCI + ci) * 256 + hb * 64 + t;
                float h = MODE == 3 ? LC[cidx] : 0.f, ap = 1.f;
                if (dir == 0) { for (int tt = 0; tt < 128; ++tt) { const float a = as_[tt * 64 + t]; h = a * h + bs_[tt * 64 + t]; ap *= a; if (MODE == 3) hs[tt * 64 + t] = h; } }
                else { for (int tt = 127; tt >= 0; --tt) { const float a = as_[tt * 64 + t]; h = a * h + bs_[tt * 64 + t]; ap *= a; if (MODE == 3) hs[tt * 64 + t] += h; } }
                if (MODE == 1) { LA[cidx] = ap; LB[cidx] = h; }
            }
            __syncthreads();
        }
        if (MODE == 3) {
            for (int i = t; i < 128 * 64; i += 512) { const int tt = i >> 6, j = i & 63, ch = hb * 64 + j;
                const float y = bf2f(P[(size_t)(rb + tt) * DIN + C_LY + ch]);
                O[(size_t)(rb + tt) * DM + 768 + ch] = f2bf(hs[i] * gelu_tanh(y)); }
        }
    }
}

__device__ __forceinline__ int scan_ci(int dir, int s) { return dir == 0 ? s : (s == 0 ? 1 : (s == 1 ? 0 : NCI + 1 - s)); }
__device__ void ph_scan2(const Params& p, int l, int bid, int nb) {
    char* ws = p.ws; const int gt = bid * 512 + threadIdx.x, gs = nb * 512;
    float* RET = (float*)(ws + OFF_RET);
    for (int i = gt; i < 2 * 2 * 4 * 4096; i += gs) {
        const int de = i & 4095, h = (i >> 12) & 3, b = (i >> 14) & 1, dir = i >> 15;
        const float decay = expf(ret_lg(p, l, dir, h) * 128.0f); float S = 0.f;
        for (int s = 0; s < NCI; ++s) { const int ci = scan_ci(dir, s); float* q = RET + ((((size_t)dir * 2 + b) * NCI + ci) * 4 + h) * 4096 + de; const float U = *q; *q = S; S = decay * S + U; }
    }
    float* LA = (float*)(ws + OFF_LRU); float* LB = LA + 2 * 2 * NCI * 256; float* LC = LB + 2 * 2 * NCI * 256;
    for (int i = gt; i < 2 * 2 * 256; i += gs) {
        const int ch = i & 255, b = (i >> 8) & 1, dir = i >> 9; float h = 0.f;
        for (int s = 0; s < NCI; ++s) { const int ci = scan_ci(dir, s); const size_t idx = (((size_t)dir * 2 + b) * NCI + ci) * 256 + ch; LC[idx] = h; h = LA[idx] * h + LB[idx]; }
    }
}

__device__ void ph_ret_out(const Params& p, int l, int bid, int nb, float* lds, int ci_lo) {
    char* ws = p.ws; const int t = threadIdx.x;
    const bf16_t* P = (const bf16_t*)(ws + OFF_P); const float* RET = (const float*)(ws + OFF_RET); bf16_t* O = (bf16_t*)(ws + OFF_ACT);
    float* qs = lds;
    float* ks = qs + 128 * 65;
    float* vs = ks + 128 * 65;
    float* sf = vs + 128 * 64;
    float* sb = sf + 4096;
    float* pf = sb + 4096;
    float* pb = pf + 132;
    const int nci = NCI - ci_lo;
    for (int u = bid; u < 2 * nci * 4; u += nb) {
        const int h = u & 3, ci = ci_lo + (u >> 2) % nci, b = u / (4 * nci), rb = row_base(b, ci);
        const float lgf = ret_lg(p, l, 0, h), lgb = ret_lg(p, l, 1, h);
        __syncthreads();
        for (int i = t; i < 128 * 64; i += 512) { const int m = i >> 6, d = i & 63; const bf16_t* pr = P + (size_t)(rb + m) * DIN + h * 64 + d;
            qs[m * 65 + d] = bf2f(pr[C_RQ]); ks[m * 65 + d] = bf2f(pr[C_RK]); vs[i] = bf2f(pr[C_RV]); }
        for (int i = t; i < 4096; i += 512) { sf[i] = RET[((((size_t)0 * 2 + b) * NCI + ci) * 4 + h) * 4096 + i]; sb[i] = RET[((((size_t)1 * 2 + b) * NCI + ci) * 4 + h) * 4096 + i]; }
        if (t < 129) { pf[t] = expf(lgf * (float)t); pb[t] = expf(lgb * (float)t); }
        __syncthreads();
        const int n = t >> 2, e0 = (t & 3) * 16;
        float y[16];
#pragma unroll
        for (int j = 0; j < 16; ++j) y[j] = 0.f;
        for (int m = 0; m < 128; ++m) {
            float s = 0.f;
#pragma unroll 16
            for (int d = 0; d < 64; ++d) s += qs[n * 65 + d] * ks[m * 65 + d];
            float w = 0.f; if (m <= n) w += pf[n - m]; if (m >= n) w += pb[m - n];
            s *= w;
#pragma unroll
            for (int j = 0; j < 16; ++j) y[j] += s * vs[m * 64 + e0 + j];
        }
        const float xf = pf[n + 1], xb = pb[128 - n];
        for (int d = 0; d < 64; ++d) { const float qv = qs[n * 65 + d], qf = qv * xf, qb = qv * xb;
#pragma unroll
            for (int j = 0; j < 16; ++j) y[j] += qf * sf[d * 64 + e0 + j] + qb * sb[d * 64 + e0 + j]; }
        float ss = 0.f;
#pragma unroll
        for (int j = 0; j < 16; ++j) ss += y[j] * y[j];
        ss += __shfl_xor(ss, 1); ss += __shfl_xor(ss, 2);
        const float rn = rsqrtf(ss * (1.0f / 64.0f) + 1e-6f);
#pragma unroll
        for (int j = 0; j < 16; ++j) { const int c = h * 64 + e0 + j; const float g = bf2f(P[(size_t)(rb + n) * DIN + C_RG + c]);
            O[(size_t)(rb + n) * DM + 256 + c] = f2bf(y[j] * rn * p.ret_gn[l * 256 + c] * siluf_(g)); }
    }
}

__device__ __forceinline__ void load_row64(const bf16_t* src, float* dst) {
#pragma unroll
    for (int i = 0; i < 8; ++i) { const uint4 w = *(const uint4*)(src + i * 8);
        dst[i * 8 + 0] = __uint_as_float(w.x << 16); dst[i * 8 + 1] = __uint_as_float(w.x & 0xffff0000u); dst[i * 8 + 2] = __uint_as_float(w.y << 16); dst[i * 8 + 3] = __uint_as_float(w.y & 0xffff0000u);
        dst[i * 8 + 4] = __uint_as_float(w.z << 16); dst[i * 8 + 5] = __uint_as_float(w.z & 0xffff0000u); dst[i * 8 + 6] = __uint_as_float(w.w << 16); dst[i * 8 + 7] = __uint_as_float(w.w & 0xffff0000u); }
}
__device__ void ph_swa(const Params& p, int l, bool need_ctx, int bid, int nb) {
    char* ws = p.ws; const int t = threadIdx.x, qi = t & 127, h = t >> 7, g = h >> 1;
    const bf16_t* P = (const bf16_t*)(ws + OFF_P); bf16_t* O = (bf16_t*)(ws + OFF_ACT);
    const int nun = 2 * 128 + (need_ctx ? 4 : 0);
    for (int u = bid; u < nun; u += nb) {
        const bool isctx = u >= 256; int b, qpos, row, k_lo, k_hi;
        if (!isctx) { b = u >> 7; const int qb = u & 127; qpos = qb * 128 + qi; row = b * NSEQ + qpos; k_lo = qb * 128 - 128 < 0 ? 0 : qb * 128 - 128; k_hi = qb * 128 + 256 > NSEQ ? NSEQ : qb * 128 + 256; }
        else { const int v = u - 256; b = v >> 1; qpos = (v & 1) * 128 + qi; row = NLAT + b * NCTX + qpos; k_lo = 0; k_hi = 0; }
        float q[64], o[64];
        load_row64(P + (size_t)row * DIN + C_AQ + h * 64, q);
#pragma unroll
        for (int d = 0; d < 64; ++d) o[d] = 0.f;
        float m = p.sink[l * 4 + h], lsum = 1.0f;
        const int ntot = (k_hi - k_lo) + NCTX;
        for (int kk = 0; kk < ntot; ++kk) {
            const bool win = kk < (k_hi - k_lo); const int kpos = k_lo + kk;
            const int krow = win ? b * NSEQ + kpos : NLAT + b * NCTX + (kk - (k_hi - k_lo));
            const bool valid = win ? (abs(qpos - kpos) <= 128) : true;
            float kv[64]; load_row64(P + (size_t)krow * DIN + C_AK + g * 64, kv);
            float s = 0.f;
#pragma unroll
            for (int d = 0; d < 64; ++d) s += q[d] * kv[d];
            load_row64(P + (size_t)krow * DIN + C_AV + g * 64, kv);
            if (valid) {
                if (s > m) { const float cr = __expf(m - s); lsum *= cr;
#pragma unroll
                    for (int d = 0; d < 64; ++d) o[d] *= cr;
                    m = s; }
                const float pe = __expf(s - m); lsum += pe;
#pragma unroll
                for (int d = 0; d < 64; ++d) o[d] += pe * kv[d];
            }
        }
        const float inv = 1.0f / lsum;
        bf16_t* op = O + (size_t)row * DM + h * 64;
#pragma unroll
        for (int d = 0; d < 64; d += 2) *(unsigned*)(op + d) = pack2(o[d] * inv, o[d + 1] * inv);
    }
}

__device__ __forceinline__ void load_row32(const bf16_t* src, float* dst) {
#pragma unroll
    for (int i = 0; i < 4; ++i) { const uint4 w = *(const uint4*)(src + i * 8);
        dst[i * 8 + 0] = __uint_as_float(w.x << 16); dst[i * 8 + 1] = __uint_as_float(w.x & 0xffff0000u); dst[i * 8 + 2] = __uint_as_float(w.y << 16); dst[i * 8 + 3] = __uint_as_float(w.y & 0xffff0000u);
        dst[i * 8 + 4] = __uint_as_float(w.z << 16); dst[i * 8 + 5] = __uint_as_float(w.z & 0xffff0000u); dst[i * 8 + 6] = __uint_as_float(w.w << 16); dst[i * 8 + 7] = __uint_as_float(w.w & 0xffff0000u); }
}
__device__ __forceinline__ float diff_lambda_val(const Params& p, int l, float lam_init) {
    const float* lv = p.diff_lam + l * 128; float s1 = 0.f, s2 = 0.f;
    for (int i = 0; i < 32; ++i) { s1 += lv[i] * lv[32 + i]; s2 += lv[64 + i] * lv[96 + i]; }
    return expf(s1) - expf(s2) + lam_init;
}
__device__ void ph_diff(const Params& p, int l, bool need_ctx, float lam_init, int bid, int nb) {
    char* ws = p.ws; const int t = threadIdx.x, mp = t & 1, qi = (t >> 1) & 63, h = t >> 7;
    const bf16_t* P = (const bf16_t*)(ws + OFF_P); bf16_t* O = (bf16_t*)(ws + OFF_ACT);
    const float lam = diff_lambda_val(p, l, lam_init);
    const int nun = 512 + (need_ctx ? 8 : 0);
    for (int u = bid; u < nun; u += nb) {
        const bool isctx = u >= 512; int b, row, nlat;
        if (!isctx) { b = u >> 8; row = b * NSEQ + (u & 255) * 64 + qi; nlat = NSEQ; }
        else { const int v = u - 512; b = v >> 2; row = NLAT + b * NCTX + (v & 3) * 64 + qi; nlat = 0; }
        float q[32], o[64];
        load_row32(P + (size_t)row * DIN + C_DQ + h * 64 + mp * 32, q);
#pragma unroll
        for (int d = 0; d < 64; ++d) o[d] = 0.f;
        float m = -1.0e30f, lsum = 0.f;
        const int ntot = nlat + NCTX;
        for (int kk = 0; kk < ntot; ++kk) {
            const int krow = kk < nlat ? b * NSEQ + kk : NLAT + b * NCTX + (kk - nlat);
            float kv[32]; load_row32(P + (size_t)krow * DIN + C_DK + h * 64 + mp * 32, kv);
            float s = 0.f;
#pragma unroll
            for (int d = 0; d < 32; ++d) s += q[d] * kv[d];
            float vv[64]; load_row64(P + (size_t)krow * DIN + C_DV + h * 64, vv);
            if (s > m) { const float cr = __expf(m - s); lsum *= cr;
#pragma unroll
                for (int d = 0; d < 64; ++d) o[d] *= cr;
                m = s; }
            const float pe = __expf(s - m); lsum += pe;
#pragma unroll
            for (int d = 0; d < 64; ++d) o[d] += pe * vv[d];
        }
        const float inv = 1.0f / lsum; float ss = 0.f;
#pragma unroll
        for (int d = 0; d < 64; ++d) { const float mine = o[d] * inv, other = __shfl_xor(mine, 1); o[d] = mine - lam * other; ss += o[d] * o[d]; }
        const float rn = rsqrtf(ss * (1.0f / 64.0f) + 1e-6f) * (1.0f - lam_init);
        if (mp == 0) { bf16_t* op = O + (size_t)row * DM + 512 + h * 64;
#pragma unroll
            for (int d = 0; d < 64; d += 2) *(unsigned*)(op + d) = pack2(o[d] * rn * p.diff_gn[l * 256 + h * 64 + d], o[d + 1] * rn * p.diff_gn[l * 256 + h * 64 + d + 1]); }
    }
}

__device__ __forceinline__ void moe_offsets(const Params& p, int* offs  ) {
    if (threadIdx.x < 2) { const unsigned* cw = (const unsigned*)p.ws + CW_CNT + threadIdx.x * 8; int o = 0;
        for (int e = 0; e < 8; ++e) { offs[threadIdx.x * 9 + e] = o; o += ((int)cw[e] + 255) & ~255; }
        offs[threadIdx.x * 9 + 8] = o; }
    __syncthreads();
}
__device__ void ph_moe_scatter(const Params& p, int bid, int nb, float* lds) {
    char* ws = p.ws; int* offs = (int*)lds; moe_offsets(p, offs);
    const int lane = threadIdx.x & 63, wv = threadIdx.x >> 6;
    const bf16_t* H = (const bf16_t*)(ws + OFF_ACT); bf16_t* AS = (bf16_t*)(ws + OFF_ASORT);
    int* tok = (int*)(ws + OFF_TOK); float* wgt = (float*)(ws + OFF_WGT); unsigned* cw = (unsigned*)ws;
    for (int r = bid * 8 + wv; r < NLAT; r += nb * 8) {
        const int4 rec = *(const int4*)(ws + OFF_ROUTE + (size_t)r * 16);
        for (int g = 0; g < 2; ++g) {
            const int e = g == 0 ? rec.x : rec.y; int pos = 0;
            if (lane == 0) { pos = offs[g * 9 + e] + (int)atomicAdd(cw + CW_CUR + g * 8 + e, 1u); tok[g * GRP_ROWS + pos] = r; wgt[g * GRP_ROWS + pos] = __int_as_float(g == 0 ? rec.z : rec.w); }
            pos = __shfl(pos, 0);
            const uint4* src = (const uint4*)(H + (size_t)r * DM); uint4* dst = (uint4*)(AS + ((size_t)g * GRP_ROWS + pos) * DM);
            dst[lane] = src[lane]; dst[64 + lane] = src[64 + lane];
        }
    }
}

__device__ void ph_final(const Params& p, int bid, int nb) {
    const int lane = threadIdx.x & 63, wv = threadIdx.x >> 6;
    for (int r = bid * 8 + wv; r < NLAT; r += nb * 8) {
        float* xr = p.out + (size_t)r * DM; float4 v[4]; float ss = 0.f;
#pragma unroll
        for (int i = 0; i < 4; ++i) { v[i] = *(const float4*)(xr + i * 256 + lane * 4); ss += v[i].x * v[i].x + v[i].y * v[i].y + v[i].z * v[i].z + v[i].w * v[i].w; }
        ss = wave_sum(ss); const float rn = rsqrtf(ss * (1.0f / 1024.0f) + 1e-6f);
#pragma unroll
        for (int i = 0; i < 4; ++i) { const float4 g = *(const float4*)(p.final_norm + i * 256 + lane * 4);
            float4 o; o.x = v[i].x * rn * g.x; o.y = v[i].y * rn * g.y; o.z = v[i].z * rn * g.z; o.w = v[i].w * rn * g.w; *(float4*)(xr + i * 256 + lane * 4) = o; }
    }
}

__device__ void ph_gemm_in(const Params& p, int l, int bid, int nb) {
    char* ws = p.ws; bf16_t* Pm = (bf16_t*)(ws + OFF_P); const bf16_t* W = (const bf16_t*)(ws + OFF_WIN) + (size_t)l * DIN * DM;
    gemm_direct<false>((const bf16_t*)(ws + OFF_ACT), DIN / 256, DM, [] { return NROW / 128; }, [=](int) { return W; },
        [=](int r, int c, float v, float) { Pm[(size_t)r * DIN + c] = f2bf(v); }, bid, nb);
}
__device__ void ph_gemm_out(const Params& p, int l, bool need_ctx, int bid, int nb) {
    char* ws = p.ws; const bf16_t* W = (const bf16_t*)(ws + OFF_WOUT) + (size_t)l * DM * DM;
    const float* mod = (const float*)(ws + OFF_MOD) + (size_t)l * 3 * 6144; const float* xin = l == 0 ? p.x : p.out; float* xo = p.out; float* xc = (float*)(ws + OFF_XC);
    const int mt = (need_ctx ? NROW : NLAT) / 128;
    gemm_direct<false>((const bf16_t*)(ws + OFF_ACT), DM / 256, DM, [=] { return mt; }, [=](int) { return W; },
        [=](int r, int c, float v, float) { const float gt = mod[(size_t)mod_class(r) * 6144 + 2048 + c];
            if (r < NLAT) xo[(size_t)r * DM + c] = xin[(size_t)r * DM + c] + gt * v; else { float* q = xc + (size_t)(r - NLAT) * DM + c; *q = *q + gt * v; } }, bid, nb);
}
__device__ void ph_ffn1(const Params& p, bool need_ctx, int bid, int nb) {
    char* ws = p.ws; bf16_t* U = (bf16_t*)(ws + OFF_P); const bf16_t* W = (const bf16_t*)(ws + OFF_WF13);
    const int mt = (need_ctx ? NROW : NLAT) / 128;
    gemm_direct<true>((const bf16_t*)(ws + OFF_ACT), DFF / 256, DM, [=] { return mt; }, [=](int) { return W; },
        [=](int r, int c, float v, float v2) { U[(size_t)r * DFF + c] = f2bf(siluf_(v) * v2); }, bid, nb);
}
__device__ void ph_ffn2(const Params& p, int l, bool need_ctx, int bid, int nb) {
    char* ws = p.ws; const bf16_t* W = (const bf16_t*)(ws + OFF_WF2);
    const float* mod = (const float*)(ws + OFF_MOD) + (size_t)l * 3 * 6144; float* xo = p.out; float* xc = (float*)(ws + OFF_XC);
    const int mt = (need_ctx ? NROW : NLAT) / 128;
    gemm_direct<false>((const bf16_t*)(ws + OFF_P), DM / 256, DFF, [=] { return mt; }, [=](int) { return W; },
        [=](int r, int c, float v, float) { const float gt = mod[(size_t)mod_class(r) * 6144 + 5120 + c];
            float* q = r < NLAT ? xo + (size_t)r * DM + c : xc + (size_t)(r - NLAT) * DM + c; *q = *q + gt * v; }, bid, nb);
}
__device__ __forceinline__ int moe_expert_of_row(const int* offs, int row) { int e = 0;
#pragma unroll
    for (int i = 1; i < 8; ++i) if (row >= offs[i]) e = i;
    return e; }
__device__ void ph_moe1(const Params& p, int g, int bid, int nb, float* lds) {
    char* ws = p.ws; int* offs = (int*)lds; __syncthreads(); moe_offsets(p, offs);
    bf16_t* U = (bf16_t*)(ws + OFF_UMOE); const bf16_t* W = (const bf16_t*)(ws + OFF_WM13); const int* og = offs + g * 9;
    gemm_direct<true>((const bf16_t*)(ws + OFF_ASORT) + (size_t)g * GRP_ROWS * DM, DFE / 256, DM, [=] { return og[8] / 128; },
        [=](int tm) { return W + (size_t)moe_expert_of_row(og, tm * 128) * 2 * DFE * DM; },
        [=](int r, int c, float v, float v2) { U[(size_t)r * DFE + c] = f2bf(siluf_(v) * v2); }, bid, nb);
}
__device__ void ph_moe2(const Params& p, int l, int g, int bid, int nb, float* lds) {
    char* ws = p.ws; int* offs = (int*)lds; __syncthreads(); moe_offsets(p, offs);
    const bf16_t* W = (const bf16_t*)(ws + OFF_WM2); const int* og = offs + g * 9;
    const int* tok = (const int*)(ws + OFF_TOK) + g * GRP_ROWS; const float* wgt = (const float*)(ws + OFF_WGT) + g * GRP_ROWS;
    const float* mod = (const float*)(ws + OFF_MOD) + (size_t)l * 3 * 6144; float* xo = p.out;
    gemm_direct<false>((const bf16_t*)(ws + OFF_UMOE), DM / 256, DFE, [=] { return og[8] / 128; },
        [=](int tm) { return W + (size_t)moe_expert_of_row(og, tm * 128) * DM * DFE; },
        [=](int r, int c, float v, float) { const int tk = tok[r]; if (tk >= 0) { const float gt = mod[(size_t)mod_class(tk) * 6144 + 5120 + c]; float* q = xo + (size_t)tk * DM + c; *q = *q + gt * wgt[r] * v; } }, bid, nb);
}

enum { PH_PRO = 0, PH_NORM1, PH_GEMM_IN, PH_ROPE, PH_SCAN1, PH_SCAN2, PH_MIX, PH_GEMM_OUT, PH_NORM2, PH_FFN1, PH_FFN2, PH_MOE_SCAT, PH_MOE1, PH_MOE2, PH_FINAL };

template <int PH>
__global__ void __launch_bounds__(512, 2) k_phase(Params p, int l, int g) {
    extern __shared__ __attribute__((aligned(16))) float lds[];
    const int bid = blockIdx.x, nb = gridDim.x;
    const bool need_ctx = l == 0;
    const float lam_init = l == 0 ? 0.2f : 0.35550906759509393f;
    if (PH == PH_PRO) ph_prologue(p, bid, nb, lds);
    if (PH == PH_NORM1) ph_norm<false>(p, l, 0, NROW, bid, nb);
    if (PH == PH_GEMM_IN) ph_gemm_in(p, l, bid, nb);
    if (PH == PH_ROPE) ph_rope(p, bid, nb);
    if (PH == PH_SCAN1) { ph_ret_summ(p, l, bid, nb, lds); ph_lru_chunk<1>(p, l, bid, nb, lds, 0); }
    if (PH == PH_SCAN2) ph_scan2(p, l, bid, nb);
    if (PH == PH_MIX) {
        ph_diff(p, l, need_ctx, lam_init, bid, nb);
        ph_swa(p, l, need_ctx, bid, nb);
        ph_ret_out(p, l, bid, nb, lds, need_ctx ? 0 : 2);
        ph_lru_chunk<3>(p, l, bid, nb, lds, need_ctx ? 0 : 2);
    }
    if (PH == PH_GEMM_OUT) ph_gemm_out(p, l, need_ctx, bid, nb);
    if (PH == PH_NORM2) { if (l == 0) ph_norm<false>(p, l, 1, NROW, bid, nb); else ph_norm<true>(p, l, 1, NLAT, bid, nb); }
    if (PH == PH_FFN1) ph_ffn1(p, need_ctx, bid, nb);
    if (PH == PH_FFN2) ph_ffn2(p, l, need_ctx, bid, nb);
    if (PH == PH_MOE_SCAT) ph_moe_scatter(p, bid, nb, lds);
    if (PH == PH_MOE1) ph_moe1(p, g, bid, nb, lds);
    if (PH == PH_MOE2) ph_moe2(p, l, g, bid, nb, lds);
    if (PH == PH_FINAL) ph_final(p, bid, nb);
}

constexpr int LDS_BYTES = 132 * 1024;
template <int PH> static void launch(const Params& p, int l, int g, hipStream_t s) {
    static bool attr = false;
    if (!attr) { (void)hipFuncSetAttribute((const void*)k_phase<PH>, hipFuncAttributeMaxDynamicSharedMemorySize, LDS_BYTES); attr = true; }
    hipLaunchKernelGGL(k_phase<PH>, dim3(256), dim3(512), LDS_BYTES, s, p, l, g);
}

extern "C" void kernel_launch(void* const* d_in, const int* in_sizes, int n_in, void* d_out, int out_size, void* d_ws, size_t ws_size, hipStream_t stream) {
    if (n_in < 30 || ws_size < WS_NEED) { fprintf(stderr, "kernel_launch: bad args n_in=%d ws=%zu need=%zu\n", n_in, ws_size, (size_t)WS_NEED); return; }
    Params p{};
    const float** f = (const float**)&p;
    for (int i = 0; i < 30; ++i) f[i] = (const float*)d_in[i];
    p.out = (float*)d_out; p.ws = (char*)d_ws;
    (void)hipMemsetAsync(d_ws, 0, 65536, stream);
    launch<PH_PRO>(p, 0, 0, stream);
    for (int l = 0; l < 2; ++l) {
        launch<PH_NORM1>(p, l, 0, stream);
        launch<PH_GEMM_IN>(p, l, 0, stream);
        launch<PH_ROPE>(p, l, 0, stream);
        launch<PH_SCAN1>(p, l, 0, stream);
        launch<PH_SCAN2>(p, l, 0, stream);
        launch<PH_MIX>(p, l, 0, stream);
        launch<PH_GEMM_OUT>(p, l, 0, stream);
        launch<PH_NORM2>(p, l, 0, stream);
        if (l == 0) { launch<PH_FFN1>(p, l, 0, stream); launch<PH_FFN2>(p, l, 0, stream); }
        else {
            launch<PH_MOE_SCAT>(p, l, 0, stream);
            for (int g = 0; g < 2; ++g) { launch<PH_MOE1>(p, l, g, stream); launch<PH_MOE2>(p, l, g, stream); }
        }
    }
    launch<PH_FINAL>(p, 0, 0, stream);
}
```

```cpp
#include <hip/hip_runtime.h>
#include <cstdio>
#include <cstdint>

typedef unsigned short bf16_t;
typedef short bf16x8 __attribute__((ext_vector_type(8)));
typedef float f32x4 __attribute__((ext_vector_type(4)));

constexpr int NB = 2, NSEQ = 16384, NCTX = 256, DM = 1024;
constexpr int NLAT = NB * NSEQ;
constexpr int NCR = NB * NCTX;
constexpr int NROW = NLAT + NCR;
constexpr int DIN = 2816, DFF = 2816, DFE = 3584, NE = 8;
constexpr int NCI = 130;
constexpr int C_AQ = 0, C_AK = 256, C_AV = 384, C_RQ = 512, C_RK = 768, C_RV = 1024, C_RG = 1280, C_DQ = 1536, C_DK = 1792, C_DV = 2048, C_LX = 2304, C_LY = 2560;
constexpr int GRP_ROWS = 34816;

constexpr size_t al256(size_t x) { return (x + 255) & ~(size_t)255; }
constexpr size_t OFF_CTRL = 0;
constexpr size_t OFF_MOD = 65536;
constexpr size_t OFF_ROPE_RET = al256(OFF_MOD + 2 * 3 * 6144 * 4);
constexpr size_t OFF_ROPE_AX = al256(OFF_ROPE_RET + 2 * 16384 * 32 * 4);
constexpr size_t OFF_XC = al256(OFF_ROPE_AX + (2 * 256 * 16 + 2 * 64 * 16 + 2 * 256 * 8 + 2 * 64 * 8) * 4);
constexpr size_t OFF_ROUTE = al256(OFF_XC + (size_t)NCR * DM * 4);
constexpr size_t OFF_TOK = al256(OFF_ROUTE + (size_t)NLAT * 16);
constexpr size_t OFF_WGT = al256(OFF_TOK + (size_t)2 * GRP_ROWS * 4);
constexpr size_t OFF_LRU = al256(OFF_WGT + (size_t)2 * GRP_ROWS * 4);
constexpr size_t OFF_WM13 = al256(OFF_LRU + (size_t)3 * 2 * 2 * NCI * 256 * 4);
constexpr size_t OFF_WM2 = al256(OFF_WM13 + (size_t)NE * 2 * DFE * DM * 2);
constexpr size_t OFF_R = al256(OFF_WM2 + (size_t)NE * DM * DFE * 2);
constexpr size_t OFF_P = OFF_R;
constexpr size_t OFF_ACT = al256(OFF_P + (size_t)NROW * DIN * 2);
constexpr size_t OFF_RET = al256(OFF_ACT + (size_t)NROW * DM * 2);
constexpr size_t OFF_WIN = al256(OFF_RET + (size_t)2 * 2 * NCI * 4 * 4096 * 4);
constexpr size_t OFF_WOUT = al256(OFF_WIN + (size_t)2 * DIN * DM * 2);
constexpr size_t OFF_WF13 = al256(OFF_WOUT + (size_t)2 * DM * DM * 2);
constexpr size_t OFF_WF2 = al256(OFF_WF13 + (size_t)2 * DFF * DM * 2);
constexpr size_t OFF_R_END1 = al256(OFF_WF2 + (size_t)DM * DFF * 2);
constexpr size_t OFF_ASORT = OFF_R;
constexpr size_t OFF_UMOE = al256(OFF_ASORT + (size_t)2 * GRP_ROWS * DM * 2);
constexpr size_t OFF_R_END2 = al256(OFF_UMOE + (size_t)GRP_ROWS * DFE * 2);
constexpr size_t WS_NEED = OFF_R_END1 > OFF_R_END2 ? OFF_R_END1 : OFF_R_END2;
static_assert(OFF_ACT >= OFF_UMOE, "H2 must not overlap A_sorted");
constexpr int CW_CNT = 4096;
constexpr int CW_CUR = 4160;

struct Params {
    const float *x, *c, *ctx, *c_ctx, *w_ada, *b_ada, *g1, *g2, *w_in, *w_out, *sink, *ret_logit, *ret_gn, *diff_lam, *diff_gn,
        *conv_w, *conv_b, *lru_wa, *lru_ba, *lru_wx, *lru_bx, *lru_lam, *ffn_w1, *ffn_w3, *ffn_w2, *moe_router, *moe_w1, *moe_w3, *moe_w2, *final_norm;
    float* out; char* ws;
};

__device__ __forceinline__ float bf2f(bf16_t h) { return __uint_as_float(((unsigned)h) << 16); }
__device__ __forceinline__ bf16_t f2bf(float f) { unsigned u = __float_as_uint(f); u += 0x7fffu + ((u >> 16) & 1u); return (bf16_t)(u >> 16); }
__device__ __forceinline__ unsigned pack2(float lo, float hi) { return (unsigned)f2bf(lo) | ((unsigned)f2bf(hi) << 16); }
__device__ __forceinline__ float wave_sum(float v) {
#pragma unroll
    for (int o = 32; o >= 1; o >>= 1) v += __shfl_xor(v, o);
    return v;
}
__device__ __forceinline__ float sigmoidf_(float x) { return 1.0f / (1.0f + __expf(-x)); }
__device__ __forceinline__ float siluf_(float x) { return x / (1.0f + __expf(-x)); }
__device__ __forceinline__ float softplusf_(float x) { return x > 20.f ? x : log1pf(expf(x)); }
__device__ __forceinline__ float gelu_tanh(float x) { const float u = 0.7978845608028654f * (x + 0.044715f * x * x * x); return 0.5f * x * (1.0f + tanhf(u)); }
__device__ __forceinline__ int row_base(int b, int ci) { return ci < 2 ? NLAT + b * NCTX + ci * 128 : b * NSEQ + (ci - 2) * 128; }
__device__ __forceinline__ int mod_class(int row) { return row < NSEQ ? 0 : (row < NLAT ? 1 : 2); }

__device__ __forceinline__ void convert_tile(const float* src, int K, int N, bf16_t* dst, int tile, int mode, float* lds) {
    const int tpn = N / 64, tk = tile / tpn, tn = tile % tpn, t = threadIdx.x;
    {   const int kk = t >> 3, nc = (t & 7) * 8;
        const float4 a = *(const float4*)(src + (size_t)(tk * 64 + kk) * N + tn * 64 + nc);
        const float4 b = *(const float4*)(src + (size_t)(tk * 64 + kk) * N + tn * 64 + nc + 4);
        float* d = lds + kk * 65 + nc; d[0] = a.x; d[1] = a.y; d[2] = a.z; d[3] = a.w; d[4] = b.x; d[5] = b.y; d[6] = b.z; d[7] = b.w; }
    __syncthreads();
    {   const int n = t >> 3, kc = (t & 7) * 8, ng = tn * 64 + n;
        const int nrow = mode == 0 ? ng : ((ng >> 7) * 256 + (mode == 2 ? 128 : 0) + (ng & 127));
        uint4 w; w.x = pack2(lds[(kc + 0) * 65 + n], lds[(kc + 1) * 65 + n]); w.y = pack2(lds[(kc + 2) * 65 + n], lds[(kc + 3) * 65 + n]);
        w.z = pack2(lds[(kc + 4) * 65 + n], lds[(kc + 5) * 65 + n]); w.w = pack2(lds[(kc + 6) * 65 + n], lds[(kc + 7) * 65 + n]);
        *(uint4*)(dst + (size_t)nrow * K + tk * 64 + kc) = w; }
    __syncthreads();
}

__device__ __forceinline__ void ph_prologue(const Params& p, int bid, int nb, float* lds) {
    char* ws = p.ws; const int t = threadIdx.x;
    {
        const int T_IN = 16 * 44, T_OUT = 16 * 16, T_F13 = 16 * 44, T_F2 = 44 * 16, T_M13 = 16 * 56, T_M2 = 56 * 16;
        const int total = 2 * T_IN + 2 * T_OUT + 2 * T_F13 + T_F2 + 16 * T_M13 + 8 * T_M2;
        for (int u = bid; u < total; u += nb) {
            int r = u;
            if (r < 2 * T_IN) { const int l = r / T_IN; convert_tile(p.w_in + (size_t)l * DM * DIN, DM, DIN, (bf16_t*)(ws + OFF_WIN) + (size_t)l * DIN * DM, r % T_IN, 0, lds); continue; } r -= 2 * T_IN;
            if (r < 2 * T_OUT) { const int l = r / T_OUT; convert_tile(p.w_out + (size_t)l * DM * DM, DM, DM, (bf16_t*)(ws + OFF_WOUT) + (size_t)l * DM * DM, r % T_OUT, 0, lds); continue; } r -= 2 * T_OUT;
            if (r < T_F13) { convert_tile(p.ffn_w1, DM, DFF, (bf16_t*)(ws + OFF_WF13), r, 1, lds); continue; } r -= T_F13;
            if (r < T_F13) { convert_tile(p.ffn_w3, DM, DFF, (bf16_t*)(ws + OFF_WF13), r, 2, lds); continue; } r -= T_F13;
            if (r < T_F2) { convert_tile(p.ffn_w2, DFF, DM, (bf16_t*)(ws + OFF_WF2), r, 0, lds); continue; } r -= T_F2;
            if (r < 8 * T_M13) { const int e = r / T_M13; convert_tile(p.moe_w1 + (size_t)e * DM * DFE, DM, DFE, (bf16_t*)(ws + OFF_WM13) + (size_t)e * 2 * DFE * DM, r % T_M13, 1, lds); continue; } r -= 8 * T_M13;
            if (r < 8 * T_M13) { const int e = r / T_M13; convert_tile(p.moe_w3 + (size_t)e * DM * DFE, DM, DFE, (bf16_t*)(ws + OFF_WM13) + (size_t)e * 2 * DFE * DM, r % T_M13, 2, lds); continue; } r -= 8 * T_M13;
            { const int e = r / T_M2; convert_tile(p.moe_w2 + (size_t)e * DFE * DM, DFE, DM, (bf16_t*)(ws + OFF_WM2) + (size_t)e * DM * DFE, r % T_M2, 0, lds); }
        }
    }
    {
        float* sv = lds;
        float* red = lds + 3072;
        for (int i = t; i < 3072; i += 512) { const int v = i >> 10, k = i & 1023; const float cv = v < 2 ? p.c[v * DM + k] : p.c_ctx[k]; sv[i] = siluf_(cv); }
        __syncthreads();
        float* mod = (float*)(ws + OFF_MOD);
        for (int u = bid; u < 2 * 96; u += nb) {
            const int l = u / 96, j0 = (u % 96) * 64, j = t & 63, kg = t >> 6;
            float a0 = 0.f, a1 = 0.f, a2 = 0.f;
            const float* w = p.w_ada + (size_t)l * DM * 6144 + j0 + j;
            for (int k = kg * 128; k < kg * 128 + 128; ++k) { const float wv = w[(size_t)k * 6144]; a0 += sv[k] * wv; a1 += sv[1024 + k] * wv; a2 += sv[2048 + k] * wv; }
            red[(kg * 3 + 0) * 64 + j] = a0; red[(kg * 3 + 1) * 64 + j] = a1; red[(kg * 3 + 2) * 64 + j] = a2;
            __syncthreads();
            if (t < 192) { const int v = t >> 6; float s = 0.f;
                for (int g = 0; g < 8; ++g) s += red[(g * 3 + v) * 64 + j];
                mod[((size_t)l * 3 + v) * 6144 + j0 + j] = s + p.b_ada[l * 6144 + j0 + j]; }
            __syncthreads();
        }
    }
    {
        float* rr = (float*)(ws + OFF_ROPE_RET);
        const int gt = bid * 512 + t, gs = nb * 512;
        for (int i = gt; i < 16384 * 32; i += gs) { const int n = i >> 5, j = i & 31;
            const float inv = (float)pow(10000.0, -(double)j / 32.0); const float ang = (float)n * inv;
            rr[i] = (float)cos((double)ang); rr[16384 * 32 + i] = (float)sin((double)ang); }
        float* ax = (float*)(ws + OFF_ROPE_AX);
        for (int i = gt; i < 256 * 16; i += gs) { const int n = i >> 4, j = i & 15; const float inv = (float)pow(10000.0, -(double)j / 16.0); const float ang = (float)n * inv;
            ax[i] = (float)cos((double)ang); ax[4096 + i] = (float)sin((double)ang);
            if (n < 64) { ax[8192 + i] = (float)cos((double)ang); ax[9216 + i] = (float)sin((double)ang); } }
        for (int i = gt; i < 256 * 8; i += gs) { const int n = i >> 3, j = i & 7; const float inv = (float)pow(10000.0, -(double)j / 8.0); const float ang = (float)n * inv;
            ax[10240 + i] = (float)cos((double)ang); ax[12288 + i] = (float)sin((double)ang);
            if (n < 64) { ax[14336 + i] = (float)cos((double)ang); ax[14848 + i] = (float)sin((double)ang); } }
        float* xc = (float*)(ws + OFF_XC);
        for (int i = gt; i < NCR * DM / 4; i += gs) ((float4*)xc)[i] = ((const float4*)p.ctx)[i];
        int* tok = (int*)(ws + OFF_TOK);
        for (int i = gt; i < 2 * GRP_ROWS; i += gs) tok[i] = -1;
    }
}

template <bool ROUTE>
__device__ __forceinline__ void ph_norm(const Params& p, int l, int which  , int nrows, int bid, int nb) {
    char* ws = p.ws; const int lane = threadIdx.x & 63, wv = threadIdx.x >> 6;
    const float* mod = (const float*)(ws + OFF_MOD) + (size_t)l * 3 * 6144;
    const float* g = (which == 0 ? p.g1 : p.g2) + l * DM;
    bf16_t* H = (bf16_t*)(ws + OFF_ACT);
    const float* xl = (which == 0 && l == 0) ? p.x : p.out;
    const float* xc = (const float*)(ws + OFF_XC);
    for (int r = bid * 8 + wv; r < nrows; r += nb * 8) {
        const float* xr = r < NLAT ? xl + (size_t)r * DM : xc + (size_t)(r - NLAT) * DM;
        const float* mv = mod + (size_t)mod_class(r) * 6144 + (which == 0 ? 0 : 3072);
        float4 v[4]; float ss = 0.f;
#pragma unroll
        for (int i = 0; i < 4; ++i) { v[i] = *(const float4*)(xr + i * 256 + lane * 4); ss += v[i].x * v[i].x + v[i].y * v[i].y + v[i].z * v[i].z + v[i].w * v[i].w; }
        ss = wave_sum(ss);
        const float rn = rsqrtf(ss * (1.0f / 1024.0f) + 1e-6f);
        float lg[8];
        if (ROUTE) {
#pragma unroll
            for (int e = 0; e < 8; ++e) lg[e] = 0.f;
        }
#pragma unroll
        for (int i = 0; i < 4; ++i) {
            const int c = i * 256 + lane * 4;
            const float4 gg = *(const float4*)(g + c), sh = *(const float4*)(mv + c), sc = *(const float4*)(mv + 1024 + c);
            float h0 = v[i].x * rn * gg.x * (1.f + sc.x) + sh.x, h1 = v[i].y * rn * gg.y * (1.f + sc.y) + sh.y;
            float h2 = v[i].z * rn * gg.z * (1.f + sc.z) + sh.z, h3 = v[i].w * rn * gg.w * (1.f + sc.w) + sh.w;
            uint2 w; w.x = pack2(h0, h1); w.y = pack2(h2, h3);
            *(uint2*)(H + (size_t)r * DM + c) = w;
            if (ROUTE) {
                const float* rt = p.moe_router + (size_t)c * 8;
#pragma unroll
                for (int e = 0; e < 8; ++e) lg[e] += h0 * rt[e] + h1 * rt[8 + e] + h2 * rt[16 + e] + h3 * rt[24 + e];
            }
        }
        if (ROUTE) {
#pragma unroll
            for (int e = 0; e < 8; ++e) lg[e] = wave_sum(lg[e]);
            if (lane == 0 && r < NLAT) {
                int e0 = 0; float v0 = lg[0];
#pragma unroll
                for (int e = 1; e < 8; ++e) if (lg[e] > v0) { v0 = lg[e]; e0 = e; }
                int e1 = -1; float v1 = -3.0e38f;
#pragma unroll
                for (int e = 0; e < 8; ++e) if (e != e0 && lg[e] > v1) { v1 = lg[e]; e1 = e; }
                const float ex = __expf(v1 - v0), w0 = 1.0f / (1.0f + ex), w1 = ex / (1.0f + ex);
                int4 rec; rec.x = e0; rec.y = e1; rec.z = __float_as_int(w0); rec.w = __float_as_int(w1);
                *(int4*)(ws + OFF_ROUTE + (size_t)r * 16) = rec;
                unsigned* cw = (unsigned*)ws;
                atomicAdd(cw + CW_CNT + e0, 1u); atomicAdd(cw + CW_CNT + 8 + e1, 1u);
            }
        }
    }
}

template <bool DUAL, class MT, class BSel, class Epi>
__device__ __forceinline__ void gemm_direct(const bf16_t* A, int ntiles, int K, MT mtiles_fn, BSel bsel, Epi epi, int bid, int nb) {
    constexpr int NJ = DUAL ? 2 : 4;
    const int lane = threadIdx.x & 63, wv = threadIdx.x >> 6, wr = wv >> 2, wc = wv & 3, fr = lane & 15, fq = lane >> 4;
    const int mtiles = mtiles_fn();
    for (int u = bid; u < mtiles * ntiles; u += nb) {
        const int tm = u / ntiles, tn = u % ntiles;
        const bf16_t* Bt = bsel(tm);
        const int r0 = tm * 128 + wr * 64, c0 = tn * (64 * NJ) + wc * (16 * NJ);
        const int br0 = DUAL ? ((c0 >> 7) * 256 + (c0 & 127)) : c0;
        f32x4 acc[4][NJ], acc2[4][NJ];
#pragma unroll
        for (int i = 0; i < 4; ++i)
#pragma unroll
            for (int j = 0; j < NJ; ++j) { acc[i][j] = (f32x4){0.f, 0.f, 0.f, 0.f}; acc2[i][j] = (f32x4){0.f, 0.f, 0.f, 0.f}; }
        const bf16_t* ap = A + (size_t)(r0 + fr) * K + fq * 8;
        const bf16_t* bp = Bt + (size_t)(br0 + fr) * K + fq * 8;
        for (int k = 0; k < K; k += 32) {
            bf16x8 a[4], b[NJ], b2[NJ];
#pragma unroll
            for (int i = 0; i < 4; ++i) a[i] = *(const bf16x8*)(ap + (size_t)i * 16 * K + k);
#pragma unroll
            for (int j = 0; j < NJ; ++j) { b[j] = *(const bf16x8*)(bp + (size_t)j * 16 * K + k); if (DUAL) b2[j] = *(const bf16x8*)(bp + (size_t)(128 + j * 16) * K + k); }
#pragma unroll
            for (int i = 0; i < 4; ++i)
#pragma unroll
                for (int j = 0; j < NJ; ++j) {
                    acc[i][j] = __builtin_amdgcn_mfma_f32_16x16x32_bf16(a[i], b[j], acc[i][j], 0, 0, 0);
                    if (DUAL) acc2[i][j] = __builtin_amdgcn_mfma_f32_16x16x32_bf16(a[i], b2[j], acc2[i][j], 0, 0, 0);
                }
        }
#pragma unroll
        for (int i = 0; i < 4; ++i)
#pragma unroll
            for (int j = 0; j < NJ; ++j)
#pragma unroll
                for (int q = 0; q < 4; ++q) epi(r0 + i * 16 + fq * 4 + q, c0 + j * 16 + fr, acc[i][j][q], DUAL ? acc2[i][j][q] : 0.f);
    }
}

__device__ __forceinline__ void ph_rope(const Params& p, int bid, int nb) {
    char* ws = p.ws; const int lane = threadIdx.x & 63, wv = threadIdx.x >> 6;
    bf16_t* P = (bf16_t*)(ws + OFF_P);
    const float* rr = (const float*)(ws + OFF_ROPE_RET); const float* ax = (const float*)(ws + OFF_ROPE_AX);
    for (int r = bid * 8 + wv; r < NROW; r += nb * 8) {
        const bool lat = r < NLAT; const int n = r & (NSEQ - 1), gr = n >> 6, gc = n & 63;
        bf16_t* pr = P + (size_t)r * DIN;
        for (int it = 0; it < 11; ++it) {
            const int pi = it * 64 + lane;
            int c1, c2; float cs = 1.f, sn = 0.f, scale = 1.f;
            if (pi < 192) {
                const int hd = pi >> 5, j = pi & 31; c1 = (pi < 128 ? C_AQ : C_AK - 256) + hd * 64 + j; c2 = c1 + 32;
                if (pi < 128) scale = 0.125f;
                if (lat) { if (j < 16) { cs = ax[gr * 16 + j]; sn = ax[4096 + gr * 16 + j]; } else { cs = ax[8192 + gc * 16 + j - 16]; sn = ax[9216 + gc * 16 + j - 16]; } }
            } else if (pi < 448) {
                const int q = pi - 192, hd = q >> 5, j = q & 31; c1 = C_RQ + hd * 64 + j; c2 = c1 + 32;
                if (q >= 128) scale = 0.125f;
                if (lat) { cs = rr[n * 32 + j]; sn = rr[16384 * 32 + n * 32 + j]; }
            } else {
                const int q = pi - 448, blk = q >> 4, j = q & 15; c1 = C_DQ + blk * 32 + j; c2 = c1 + 16;
                if (q < 128) scale = 0.17677669529663687f;
                if (lat) { if (j < 8) { cs = ax[10240 + gr * 8 + j]; sn = ax[12288 + gr * 8 + j]; } else { cs = ax[14336 + gc * 8 + j - 8]; sn = ax[14848 + gc * 8 + j - 8]; } }
            }
            const float x1 = bf2f(pr[c1]), x2 = bf2f(pr[c2]);
            pr[c1] = f2bf((x1 * cs - x2 * sn) * scale); pr[c2] = f2bf((x2 * cs + x1 * sn) * scale);
        }
    }
}

__device__ __forceinline__ float ret_lg(const Params& p, int l, int dir, int h) { return -softplusf_(-p.ret_logit[(l * 2 + dir) * 4 + h]); }
__device__ __forceinline__ void ph_ret_summ(const Params& p, int l, int bid, int nb, float* lds) {
    char* ws = p.ws; const int t = threadIdx.x;
    const bf16_t* P = (const bf16_t*)(ws + OFF_P); float* RET = (float*)(ws + OFF_RET);
    float* ks = lds; float* vs = lds + 128 * 64; float* zf = vs + 128 * 64; float* zb = zf + 128;
    for (int u = bid; u < 2 * NCI * 4; u += nb) {
        const int h = u & 3, ci = (u >> 2) % NCI, b = u / (4 * NCI), rb = row_base(b, ci);
        const float lgf = ret_lg(p, l, 0, h), lgb = ret_lg(p, l, 1, h);
        __syncthreads();
        for (int i = t; i < 128 * 64; i += 512) { const int m = i >> 6, d = i & 63; ks[i] = bf2f(P[(size_t)(rb + m) * DIN + C_RK + h * 64 + d]); vs[i] = bf2f(P[(size_t)(rb + m) * DIN + C_RV + h * 64 + d]); }
        if (t < 128) { zf[t] = expf(lgf * (float)(127 - t)); zb[t] = expf(lgb * (float)t); }
        __syncthreads();
        const int d = t >> 3, e0 = (t & 7) * 8;
        float af[8], ab[8];
#pragma unroll
        for (int j = 0; j < 8; ++j) { af[j] = 0.f; ab[j] = 0.f; }
        for (int m = 0; m < 128; ++m) { const float kv = ks[m * 64 + d], kf = kv * zf[m], kb = kv * zb[m];
#pragma unroll
            for (int j = 0; j < 8; ++j) { const float vv = vs[m * 64 + e0 + j]; af[j] += kf * vv; ab[j] += kb * vv; } }
        float* of = RET + ((((size_t)0 * 2 + b) * NCI + ci) * 4 + h) * 4096 + d * 64 + e0;
        float* ob = RET + ((((size_t)1 * 2 + b) * NCI + ci) * 4 + h) * 4096 + d * 64 + e0;
#pragma unroll
        for (int j = 0; j < 8; ++j) { of[j] = af[j]; ob[j] = ab[j]; }
    }
}

template <int MODE>
__device__ __forceinline__ void ph_lru_chunk(const Params& p, int l, int bid, int nb, float* lds, int ci_lo) {
    char* ws = p.ws; const int t = threadIdx.x;
    const bf16_t* P = (const bf16_t*)(ws + OFF_P);
    float* LA = (float*)(ws + OFF_LRU); float* LB = LA + 2 * 2 * NCI * 256; float* LC = LB + 2 * 2 * NCI * 256;
    bf16_t* O = (bf16_t*)(ws + OFF_ACT);
    float* us = lds;
    float* as_ = lds + 8192;
    float* bs_ = lds + 16384;
    float* hs = lds + 24576;
    const int nci = NCI - ci_lo;
    for (int u = bid; u < 2 * nci * 4; u += nb) {
        const int hb = u & 3, ci = ci_lo + (u >> 2) % nci, b = u / (4 * nci), rb = row_base(b, ci);
        const int seg_lo = ci < 2 ? NLAT + b * NCTX : b * NSEQ, seg_hi = ci < 2 ? seg_lo + NCTX : seg_lo + NSEQ;
        __syncthreads();
        for (int i = t; i < 128 * 64; i += 512) { const int tt = i >> 6, j = i & 63, ch = hb * 64 + j; float acc = p.conv_b[l * 256 + ch];
#pragma unroll
            for (int k = 0; k < 4; ++k) { const int rr = rb + tt - 1 + k; if (rr >= seg_lo && rr < seg_hi) acc += p.conv_w[(l * 4 + k) * 256 + ch] * bf2f(P[(size_t)rr * DIN + C_LX + ch]); }
            us[i] = acc; }
        __syncthreads();
        for (int dir = 0; dir < 2; ++dir) {
            const int j = t & 63, tg = t >> 6, ch = hb * 64 + j;
            const float* wa = p.lru_wa + (((size_t)(l * 2 + dir) * 4 + hb) * 64) * 64 + j;
            const float* wx = p.lru_wx + (((size_t)(l * 2 + dir) * 4 + hb) * 64) * 64 + j;
            const float ba = p.lru_ba[(l * 2 + dir) * 256 + ch], bx = p.lru_bx[(l * 2 + dir) * 256 + ch];
            const float spl = softplusf_(-p.lru_lam[(l * 2 + dir) * 256 + ch]);
            float ra[16], rx[16];
#pragma unroll
            for (int k = 0; k < 16; ++k) { ra[k] = ba; rx[k] = bx; }
            for (int i = 0; i < 64; ++i) { const float wav = wa[i * 64], wxv = wx[i * 64];
#pragma unroll
                for (int k = 0; k < 16; ++k) { const float uv = us[(tg * 16 + k) * 64 + i]; ra[k] += uv * wav; rx[k] += uv * wxv; } }
#pragma unroll
            for (int k = 0; k < 16; ++k) { const int tt = tg * 16 + k; const float r = sigmoidf_(ra[k]), ig = sigmoidf_(rx[k]);
                const float la = -8.0f * r * spl, a = expf(la), bb = sqrtf(-expm1f(2.0f * la)) * (ig * us[tt * 64 + j]);
                as_[tt * 64 + j] = a; bs_[tt * 64 + j] = bb; }
            __syncthreads();
            if (t < 64) {
                const size_t cidx = (((size_t)dir * 2 + b) * NCI + ci) * 256 + hb * 64 + t;
                float h = MODE == 3 ? LC[cidx] : 0.f, ap = 1.f;
                if (dir == 0) { for (int tt = 0; tt < 128; ++tt) { const float a = as_[tt * 64 + t]; h = a * h + bs_[tt * 64 + t]; ap *= a; if (MODE == 3) hs[tt * 64 + t] = h; } }
                else { for (int tt = 127; tt >= 0; --tt) { const float a = as_[tt * 64 + t]; h = a * h + bs_[tt * 64 + t]; ap *= a; if (MODE == 3) hs[tt * 64 + t] += h; } }
                if (MODE == 1) { LA[cidx] = ap; LB[cidx] = h; }
            }
            __syncthreads();
        }
        if (MODE == 3) {
            for (int i = t; i < 128 * 64; i += 512) { const int tt = i >> 6, j = i & 63, ch = hb * 64 + j;
                const float y = bf2f(P[(size_t)(rb + tt) * DIN + C_LY + ch]);
                O[(size_t)(rb + tt) * DM + 768 + ch] = f2bf(hs[i] * gelu_tanh(y)); }
        }
    }
}

__device__ __forceinline__ int scan_ci(int dir, int s) { return dir == 0 ? s : (s == 0 ? 1 : (s == 1 ? 0 : NCI + 1 - s)); }
__device__ __forceinline__ void ph_scan2(const Params& p, int l, int bid, int nb) {
    char* ws = p.ws; const int gt = bid * 512 + threadIdx.x, gs = nb * 512;
    float* RET = (float*)(ws + OFF_RET);
    for (int i = gt; i < 2 * 2 * 4 * 4096; i += gs) {
        const int de = i & 4095, h = (i >> 12) & 3, b = (i >> 14) & 1, dir = i >> 15;
        const float decay = expf(ret_lg(p, l, dir, h) * 128.0f); float S = 0.f;
        for (int s = 0; s < NCI; ++s) { const int ci = scan_ci(dir, s); float* q = RET + ((((size_t)dir * 2 + b) * NCI + ci) * 4 + h) * 4096 + de; const float U = *q; *q = S; S = decay * S + U; }
    }
    float* LA = (float*)(ws + OFF_LRU); float* LB = LA + 2 * 2 * NCI * 256; float* LC = LB + 2 * 2 * NCI * 256;
    for (int i = gt; i < 2 * 2 * 256; i += gs) {
        const int ch = i & 255, b = (i >> 8) & 1, dir = i >> 9; float h = 0.f;
        for (int s = 0; s < NCI; ++s) { const int ci = scan_ci(dir, s); const size_t idx = (((size_t)dir * 2 + b) * NCI + ci) * 256 + ch; LC[idx] = h; h = LA[idx] * h + LB[idx]; }
    }
}

__device__ __forceinline__ void ph_ret_out(const Params& p, int l, int bid, int nb, float* lds, int ci_lo) {
    char* ws = p.ws; const int t = threadIdx.x;
    const bf16_t* P = (const bf16_t*)(ws + OFF_P); const float* RET = (const float*)(ws + OFF_RET); bf16_t* O = (bf16_t*)(ws + OFF_ACT);
    float* qs = lds;
    float* ks = qs + 128 * 65;
    float* vs = ks + 128 * 65;
    float* sf = vs + 128 * 64;
    float* sb = sf + 4096;
    float* pf = sb + 4096;
    float* pb = pf + 132;
    const int nci = NCI - ci_lo;
    for (int u = bid; u < 2 * nci * 4; u += nb) {
        const int h = u & 3, ci = ci_lo + (u >> 2) % nci, b = u / (4 * nci), rb = row_base(b, ci);
        const float lgf = ret_lg(p, l, 0, h), lgb = ret_lg(p, l, 1, h);
        __syncthreads();
        for (int i = t; i < 128 * 64; i += 512) { const int m = i >> 6, d = i & 63; const bf16_t* pr = P + (size_t)(rb + m) * DIN + h * 64 + d;
            qs[m * 65 + d] = bf2f(pr[C_RQ]); ks[m * 65 + d] = bf2f(pr[C_RK]); vs[i] = bf2f(pr[C_RV]); }
        for (int i = t; i < 4096; i += 512) { sf[i] = RET[((((size_t)0 * 2 + b) * NCI + ci) * 4 + h) * 4096 + i]; sb[i] = RET[((((size_t)1 * 2 + b) * NCI + ci) * 4 + h) * 4096 + i]; }
        if (t < 129) { pf[t] = expf(lgf * (float)t); pb[t] = expf(lgb * (float)t); }
        __syncthreads();
        const int n = t >> 2, e0 = (t & 3) * 16;
        float y[16];
#pragma unroll
        for (int j = 0; j < 16; ++j) y[j] = 0.f;
        for (int m = 0; m < 128; ++m) {
            float s = 0.f;
#pragma unroll 16
            for (int d = 0; d < 64; ++d) s += qs[n * 65 + d] * ks[m * 65 + d];
            float w = 0.f; if (m <= n) w += pf[n - m]; if (m >= n) w += pb[m - n];
            s *= w;
#pragma unroll
            for (int j = 0; j < 16; ++j) y[j] += s * vs[m * 64 + e0 + j];
        }
        const float xf = pf[n + 1], xb = pb[128 - n];
        for (int d = 0; d < 64; ++d) { const float qv = qs[n * 65 + d], qf = qv * xf, qb = qv * xb;
#pragma unroll
            for (int j = 0; j < 16; ++j) y[j] += qf * sf[d * 64 + e0 + j] + qb * sb[d * 64 + e0 + j]; }
        float ss = 0.f;
#pragma unroll
        for (int j = 0; j < 16; ++j) ss += y[j] * y[j];
        ss += __shfl_xor(ss, 1); ss += __shfl_xor(ss, 2);
        const float rn = rsqrtf(ss * (1.0f / 64.0f) + 1e-6f);
#pragma unroll
        for (int j = 0; j < 16; ++j) { const int c = h * 64 + e0 + j; const float g = bf2f(P[(size_t)(rb + n) * DIN + C_RG + c]);
            O[(size_t)(rb + n) * DM + 256 + c] = f2bf(y[j] * rn * p.ret_gn[l * 256 + c] * siluf_(g)); }
    }
}

__device__ __forceinline__ void load_row64(const bf16_t* src, float* dst) {
#pragma unroll
    for (int i = 0; i < 8; ++i) { const uint4 w = *(const uint4*)(src + i * 8);
        dst[i * 8 + 0] = __uint_as_float(w.x << 16); dst[i * 8 + 1] = __uint_as_float(w.x & 0xffff0000u); dst[i * 8 + 2] = __uint_as_float(w.y << 16); dst[i * 8 + 3] = __uint_as_float(w.y & 0xffff0000u);
        dst[i * 8 + 4] = __uint_as_float(w.z << 16); dst[i * 8 + 5] = __uint_as_float(w.z & 0xffff0000u); dst[i * 8 + 6] = __uint_as_float(w.w << 16); dst[i * 8 + 7] = __uint_as_float(w.w & 0xffff0000u); }
}
__device__ __forceinline__ void load_row32(const bf16_t* src, float* dst) {
#pragma unroll
    for (int i = 0; i < 4; ++i) { const uint4 w = *(const uint4*)(src + i * 8);
        dst[i * 8 + 0] = __uint_as_float(w.x << 16); dst[i * 8 + 1] = __uint_as_float(w.x & 0xffff0000u); dst[i * 8 + 2] = __uint_as_float(w.y << 16); dst[i * 8 + 3] = __uint_as_float(w.y & 0xffff0000u);
        dst[i * 8 + 4] = __uint_as_float(w.z << 16); dst[i * 8 + 5] = __uint_as_float(w.z & 0xffff0000u); dst[i * 8 + 6] = __uint_as_float(w.w << 16); dst[i * 8 + 7] = __uint_as_float(w.w & 0xffff0000u); }
}
#define BFLO(w) __uint_as_float((w) << 16)
#define BFHI(w) __uint_as_float((w) & 0xffff0000u)
template <int N8> __device__ __forceinline__ float dot_row(const bf16_t* src, const float* q) {
    float s = 0.f;
#pragma unroll
    for (int i = 0; i < N8; ++i) { const uint4 w = *(const uint4*)(src + i * 8);
        s += q[i * 8 + 0] * BFLO(w.x) + q[i * 8 + 1] * BFHI(w.x) + q[i * 8 + 2] * BFLO(w.y) + q[i * 8 + 3] * BFHI(w.y) + q[i * 8 + 4] * BFLO(w.z) + q[i * 8 + 5] * BFHI(w.z) + q[i * 8 + 6] * BFLO(w.w) + q[i * 8 + 7] * BFHI(w.w); }
    return s;
}
template <int N8> __device__ __forceinline__ void axpy_row(const bf16_t* src, float pe, float* o) {
#pragma unroll
    for (int i = 0; i < N8; ++i) { const uint4 w = *(const uint4*)(src + i * 8);
        o[i * 8 + 0] += pe * BFLO(w.x); o[i * 8 + 1] += pe * BFHI(w.x); o[i * 8 + 2] += pe * BFLO(w.y); o[i * 8 + 3] += pe * BFHI(w.y);
        o[i * 8 + 4] += pe * BFLO(w.z); o[i * 8 + 5] += pe * BFHI(w.z); o[i * 8 + 6] += pe * BFLO(w.w); o[i * 8 + 7] += pe * BFHI(w.w); }
}
__device__ __forceinline__ void ph_swa(const Params& p, int l, bool need_ctx, int bid, int nb) {
    char* ws = p.ws; const int t = threadIdx.x, hf = t & 1, qi = (t >> 1) & 63, h = t >> 7, g = h >> 1;
    const bf16_t* P = (const bf16_t*)(ws + OFF_P); bf16_t* O = (bf16_t*)(ws + OFF_ACT);
    const int nun = 2 * 256 + (need_ctx ? 8 : 0);
    for (int u = bid; u < nun; u += nb) {
        const bool isctx = u >= 512; int b, qpos, row, k_lo, k_hi;
        if (!isctx) { b = u >> 8; const int q0 = (u & 255) * 64; qpos = q0 + qi; row = b * NSEQ + qpos; const int blk = (q0 >> 7) * 128; k_lo = blk - 128 < 0 ? 0 : blk - 128; k_hi = blk + 256 > NSEQ ? NSEQ : blk + 256; }
        else { const int v = u - 512; b = v >> 2; qpos = (v & 3) * 64 + qi; row = NLAT + b * NCTX + qpos; k_lo = 0; k_hi = 0; }
        float q[32], o[32];
        load_row32(P + (size_t)row * DIN + C_AQ + h * 64 + hf * 32, q);
#pragma unroll
        for (int d = 0; d < 32; ++d) o[d] = 0.f;
        float m = p.sink[l * 4 + h], lsum = 1.0f;
        const int nwin = k_hi - k_lo, ntot = nwin + NCTX;
#pragma unroll 1
        for (int kk = 0; kk < ntot; ++kk) {
            const bool win = kk < nwin; const int kpos = k_lo + kk;
            const int krow = win ? b * NSEQ + kpos : NLAT + b * NCTX + (kk - nwin);
            const bool valid = win ? (abs(qpos - kpos) <= 128) : true;
            float s = dot_row<4>(P + (size_t)krow * DIN + C_AK + g * 64 + hf * 32, q);
            s += __shfl_xor(s, 1);
            if (valid) {
                if (s > m) { const float cr = __expf(m - s); lsum *= cr;
#pragma unroll
                    for (int d = 0; d < 32; ++d) o[d] *= cr;
                    m = s; }
                const float pe = __expf(s - m); lsum += pe;
                axpy_row<4>(P + (size_t)krow * DIN + C_AV + g * 64 + hf * 32, pe, o);
            }
        }
        const float inv = 1.0f / lsum;
        bf16_t* op = O + (size_t)row * DM + h * 64 + hf * 32;
#pragma unroll
        for (int d = 0; d < 32; d += 2) *(unsigned*)(op + d) = pack2(o[d] * inv, o[d + 1] * inv);
    }
}

__device__ __forceinline__ float diff_lambda_val(const Params& p, int l, float lam_init) {
    const float* lv = p.diff_lam + l * 128; float s1 = 0.f, s2 = 0.f;
    for (int i = 0; i < 32; ++i) { s1 += lv[i] * lv[32 + i]; s2 += lv[64 + i] * lv[96 + i]; }
    return expf(s1) - expf(s2) + lam_init;
}
__device__ __forceinline__ void ph_diff(const Params& p, int l, bool need_ctx, float lam_init, int bid, int nb) {
    char* ws = p.ws; const int t = threadIdx.x, mp = t & 1, qi = (t >> 1) & 63, h = t >> 7;
    const bf16_t* P = (const bf16_t*)(ws + OFF_P); bf16_t* O = (bf16_t*)(ws + OFF_ACT);
    const float lam = diff_lambda_val(p, l, lam_init);
    const int nun = 512 + (need_ctx ? 8 : 0);
    for (int u = bid; u < nun; u += nb) {
        const bool isctx = u >= 512; int b, row, nlat;
        if (!isctx) { b = u >> 8; row = b * NSEQ + (u & 255) * 64 + qi; nlat = NSEQ; }
        else { const int v = u - 512; b = v >> 2; row = NLAT + b * NCTX + (v & 3) * 64 + qi; nlat = 0; }
        float q[32], o[64];
        load_row32(P + (size_t)row * DIN + C_DQ + h * 64 + mp * 32, q);
#pragma unroll
        for (int d = 0; d < 64; ++d) o[d] = 0.f;
        float m = -1.0e30f, lsum = 0.f;
        const int ntot = nlat + NCTX;
#pragma unroll 1
        for (int kk = 0; kk < ntot; ++kk) {
            const int krow = kk < nlat ? b * NSEQ + kk : NLAT + b * NCTX + (kk - nlat);
            const float s = dot_row<4>(P + (size_t)krow * DIN + C_DK + h * 64 + mp * 32, q);
            if (s > m) { const float cr = __expf(m - s); lsum *= cr;
#pragma unroll
                for (int d = 0; d < 64; ++d) o[d] *= cr;
                m = s; }
            const float pe = __expf(s - m); lsum += pe;
            axpy_row<8>(P + (size_t)krow * DIN + C_DV + h * 64, pe, o);
        }
        const float inv = 1.0f / lsum; float ss = 0.f;
#pragma unroll
        for (int d = 0; d < 64; ++d) { const float mine = o[d] * inv, other = __shfl_xor(mine, 1); o[d] = mine - lam * other; ss += o[d] * o[d]; }
        const float rn = rsqrtf(ss * (1.0f / 64.0f) + 1e-6f) * (1.0f - lam_init);
        if (mp == 0) { bf16_t* op = O + (size_t)row * DM + 512 + h * 64;
#pragma unroll
            for (int d = 0; d < 64; d += 2) *(unsigned*)(op + d) = pack2(o[d] * rn * p.diff_gn[l * 256 + h * 64 + d], o[d + 1] * rn * p.diff_gn[l * 256 + h * 64 + d + 1]); }
    }
}

__device__ __forceinline__ void moe_offsets(const Params& p, int* offs  ) {
    if (threadIdx.x < 2) { const unsigned* cw = (const unsigned*)p.ws + CW_CNT + threadIdx.x * 8; int o = 0;
        for (int e = 0; e < 8; ++e) { offs[threadIdx.x * 9 + e] = o; o += ((int)__hip_atomic_load(cw + e, __ATOMIC_RELAXED, __HIP_MEMORY_SCOPE_AGENT) + 255) & ~255; }
        offs[threadIdx.x * 9 + 8] = o; }
    __syncthreads();
}
__device__ __forceinline__ void ph_moe_scatter(const Params& p, int bid, int nb, float* lds) {
    char* ws = p.ws; int* offs = (int*)lds; moe_offsets(p, offs);
    const int lane = threadIdx.x & 63, wv = threadIdx.x >> 6;
    const bf16_t* H = (const bf16_t*)(ws + OFF_ACT); bf16_t* AS = (bf16_t*)(ws + OFF_ASORT);
    int* tok = (int*)(ws + OFF_TOK); float* wgt = (float*)(ws + OFF_WGT); unsigned* cw = (unsigned*)ws;
    for (int r = bid * 8 + wv; r < NLAT; r += nb * 8) {
        const int4 rec = *(const int4*)(ws + OFF_ROUTE + (size_t)r * 16);
        for (int g = 0; g < 2; ++g) {
            const int e = g == 0 ? rec.x : rec.y; int pos = 0;
            if (lane == 0) { pos = offs[g * 9 + e] + (int)atomicAdd(cw + CW_CUR + g * 8 + e, 1u); tok[g * GRP_ROWS + pos] = r; wgt[g * GRP_ROWS + pos] = __int_as_float(g == 0 ? rec.z : rec.w); }
            pos = __shfl(pos, 0);
            const uint4* src = (const uint4*)(H + (size_t)r * DM); uint4* dst = (uint4*)(AS + ((size_t)g * GRP_ROWS + pos) * DM);
            dst[lane] = src[lane]; dst[64 + lane] = src[64 + lane];
        }
    }
}

__device__ __forceinline__ void ph_final(const Params& p, int bid, int nb) {
    const int lane = threadIdx.x & 63, wv = threadIdx.x >> 6;
    for (int r = bid * 8 + wv; r < NLAT; r += nb * 8) {
        float* xr = p.out + (size_t)r * DM; float4 v[4]; float ss = 0.f;
#pragma unroll
        for (int i = 0; i < 4; ++i) { v[i] = *(const float4*)(xr + i * 256 + lane * 4); ss += v[i].x * v[i].x + v[i].y * v[i].y + v[i].z * v[i].z + v[i].w * v[i].w; }
        ss = wave_sum(ss); const float rn = rsqrtf(ss * (1.0f / 1024.0f) + 1e-6f);
#pragma unroll
        for (int i = 0; i < 4; ++i) { const float4 g = *(const float4*)(p.final_norm + i * 256 + lane * 4);
            float4 o; o.x = v[i].x * rn * g.x; o.y = v[i].y * rn * g.y; o.z = v[i].z * rn * g.z; o.w = v[i].w * rn * g.w; *(float4*)(xr + i * 256 + lane * 4) = o; }
    }
}

__device__ __forceinline__ void ph_gemm_in(const Params& p, int l, int bid, int nb) {
    char* ws = p.ws; bf16_t* Pm = (bf16_t*)(ws + OFF_P); const bf16_t* W = (const bf16_t*)(ws + OFF_WIN) + (size_t)l * DIN * DM;
    gemm_direct<false>((const bf16_t*)(ws + OFF_ACT), DIN / 256, DM, [] { return NROW / 128; }, [=](int) { return W; },
        [=](int r, int c, float v, float) { Pm[(size_t)r * DIN + c] = f2bf(v); }, bid, nb);
}
__device__ __forceinline__ void ph_gemm_out(const Params& p, int l, bool need_ctx, int bid, int nb) {
    char* ws = p.ws; const bf16_t* W = (const bf16_t*)(ws + OFF_WOUT) + (size_t)l * DM * DM;
    const float* mod = (const float*)(ws + OFF_MOD) + (size_t)l * 3 * 6144; const float* xin = l == 0 ? p.x : p.out; float* xo = p.out; float* xc = (float*)(ws + OFF_XC);
    const int mt = (need_ctx ? NROW : NLAT) / 128;
    gemm_direct<false>((const bf16_t*)(ws + OFF_ACT), DM / 256, DM, [=] { return mt; }, [=](int) { return W; },
        [=](int r, int c, float v, float) { const float gt = mod[(size_t)mod_class(r) * 6144 + 2048 + c];
            if (r < NLAT) xo[(size_t)r * DM + c] = xin[(size_t)r * DM + c] + gt * v; else { float* q = xc + (size_t)(r - NLAT) * DM + c; *q = *q + gt * v; } }, bid, nb);
}
__device__ __forceinline__ void ph_ffn1(const Params& p, bool need_ctx, int bid, int nb) {
    char* ws = p.ws; bf16_t* U = (bf16_t*)(ws + OFF_P); const bf16_t* W = (const bf16_t*)(ws + OFF_WF13);
    const int mt = (need_ctx ? NROW : NLAT) / 128;
    gemm_direct<true>((const bf16_t*)(ws + OFF_ACT), DFF / 128, DM, [=] { return mt; }, [=](int) { return W; },
        [=](int r, int c, float v, float v2) { U[(size_t)r * DFF + c] = f2bf(siluf_(v) * v2); }, bid, nb);
}
__device__ __forceinline__ void ph_ffn2(const Params& p, int l, bool need_ctx, int bid, int nb) {
    char* ws = p.ws; const bf16_t* W = (const bf16_t*)(ws + OFF_WF2);
    const float* mod = (const float*)(ws + OFF_MOD) + (size_t)l * 3 * 6144; float* xo = p.out; float* xc = (float*)(ws + OFF_XC);
    const int mt = (need_ctx ? NROW : NLAT) / 128;
    gemm_direct<false>((const bf16_t*)(ws + OFF_P), DM / 256, DFF, [=] { return mt; }, [=](int) { return W; },
        [=](int r, int c, float v, float) { const float gt = mod[(size_t)mod_class(r) * 6144 + 5120 + c];
            float* q = r < NLAT ? xo + (size_t)r * DM + c : xc + (size_t)(r - NLAT) * DM + c; *q = *q + gt * v; }, bid, nb);
}
__device__ __forceinline__ int moe_expert_of_row(const int* offs, int row) { int e = 0;
#pragma unroll
    for (int i = 1; i < 8; ++i) if (row >= offs[i]) e = i;
    return e; }
__device__ __forceinline__ void ph_moe1(const Params& p, int g, int bid, int nb, float* lds) {
    char* ws = p.ws; int* offs = (int*)lds; __syncthreads(); moe_offsets(p, offs);
    bf16_t* U = (bf16_t*)(ws + OFF_UMOE); const bf16_t* W = (const bf16_t*)(ws + OFF_WM13); const int* og = offs + g * 9;
    gemm_direct<true>((const bf16_t*)(ws + OFF_ASORT) + (size_t)g * GRP_ROWS * DM, DFE / 128, DM, [=] { return og[8] / 128; },
        [=](int tm) { return W + (size_t)moe_expert_of_row(og, tm * 128) * 2 * DFE * DM; },
        [=](int r, int c, float v, float v2) { U[(size_t)r * DFE + c] = f2bf(siluf_(v) * v2); }, bid, nb);
}
__device__ __forceinline__ void ph_moe2(const Params& p, int l, int g, int bid, int nb, float* lds) {
    char* ws = p.ws; int* offs = (int*)lds; __syncthreads(); moe_offsets(p, offs);
    const bf16_t* W = (const bf16_t*)(ws + OFF_WM2); const int* og = offs + g * 9;
    const int* tok = (const int*)(ws + OFF_TOK) + g * GRP_ROWS; const float* wgt = (const float*)(ws + OFF_WGT) + g * GRP_ROWS;
    const float* mod = (const float*)(ws + OFF_MOD) + (size_t)l * 3 * 6144; float* xo = p.out;
    gemm_direct<false>((const bf16_t*)(ws + OFF_UMOE), DM / 256, DFE, [=] { return og[8] / 128; },
        [=](int tm) { return W + (size_t)moe_expert_of_row(og, tm * 128) * DM * DFE; },
        [=](int r, int c, float v, float) { const int tk = tok[r]; if (tk >= 0) { const float gt = mod[(size_t)mod_class(tk) * 6144 + 5120 + c]; float* q = xo + (size_t)tk * DM + c; *q = *q + gt * wgt[r] * v; } }, bid, nb);
}

#define XB_TMO      128
#define XB_XCNT(j)  (256  + 64 * (j))
#define XB_XSUB(j)  (1280 + 64 * (j))
#define XB_XGEN(j)  (2304 + 64 * (j))
#define XB_TOP      3328
#define XB_TOPGEN   3392
#define XCD_BAR_WORDS 3456
#define XB_SPIN_CAP (1u << 22)
#define LAS __attribute__((address_space(3)))

__device__ __forceinline__ unsigned xb_ld(unsigned* p)              { return __hip_atomic_load(p, __ATOMIC_RELAXED, __HIP_MEMORY_SCOPE_AGENT); }
__device__ __forceinline__ unsigned xb_add(unsigned* p, unsigned v) { return __hip_atomic_fetch_add(p, v, __ATOMIC_RELAXED, __HIP_MEMORY_SCOPE_AGENT); }
__device__ __forceinline__ unsigned xb_xcc_id() { return (unsigned)__builtin_amdgcn_s_getreg((3 << 11) | 20) & 0xFu; }
#define XB_SPIN(cond, bar) do { unsigned _sp = 0; while (cond) { __builtin_amdgcn_s_sleep(1); \
    if ((++_sp & 255u) == 0u) { if (xb_ld(&(bar)[XB_TMO])) break; if (_sp > XB_SPIN_CAP) { atomicAdd(&(bar)[XB_TMO], 1u); break; } } } } while (0)

struct XcdBarrier {
    unsigned* bar; unsigned x;
    volatile LAS unsigned* st;
};

__device__ __forceinline__ XcdBarrier xcd_barrier_post(unsigned* bar, volatile LAS unsigned* st) {
    XcdBarrier b; b.bar = bar; b.x = xb_xcc_id(); b.st = st;
    if (threadIdx.x == 0) (void)xb_add(&bar[XB_XCNT(b.x)], 1u);
    return b;
}
__device__ __forceinline__ void xcd_barrier_complete(unsigned* bar, unsigned x, unsigned& nloc, unsigned& nx) {
    const unsigned G = gridDim.x * gridDim.y * gridDim.z;
    unsigned sum, cnt, mine, sp = 0u;
    for (;;) {
        sum = 0u; cnt = 0u; mine = 0u;
#pragma unroll
        for (unsigned j = 0; j < 16; ++j) { const unsigned c = xb_ld(&bar[XB_XCNT(j)]); sum += c; cnt += (c > 0u) ? 1u : 0u; mine = (j == x) ? c : mine; }
        if (sum == G) break;
        __builtin_amdgcn_s_sleep(1);
        if ((++sp & 255u) == 0u) { if (xb_ld(&bar[XB_TMO])) break; if (sp > XB_SPIN_CAP) { atomicAdd(&bar[XB_TMO], 1u); break; } }
    }
    nloc = mine > 0u ? mine : 1u; nx = cnt > 0u ? cnt : 1u;
}

__device__ __forceinline__ void xcd_barrier(const XcdBarrier& b) {
    asm volatile("s_waitcnt vmcnt(0)" ::: "memory");
    __syncthreads();
    if (threadIdx.x == 0) {
        unsigned* bar = b.bar;
        __builtin_amdgcn_s_waitcnt(0);
        unsigned nloc = b.st[0], nx = b.st[1];
        if (nloc == 0u) { xcd_barrier_complete(bar, b.x, nloc, nx); b.st[0] = nloc; b.st[1] = nx; }
        const unsigned old = xb_add(&bar[XB_XSUB(b.x)], 1u);
        const unsigned gen = old / nloc;
        if (old + 1u == (gen + 1u) * nloc) {
            __builtin_amdgcn_fence(__ATOMIC_RELEASE, "agent");
            asm volatile("s_waitcnt vmcnt(0)" ::: "memory");
            const unsigned og = xb_add(&bar[XB_TOP], 1u);
            const unsigned tg = og / nx;
            if (og + 1u == (tg + 1u) * nx) xb_add(&bar[XB_TOPGEN], 1u);
            else XB_SPIN(xb_ld(&bar[XB_TOPGEN]) == tg, bar);
            __builtin_amdgcn_fence(__ATOMIC_ACQUIRE, "agent");
            xb_add(&bar[XB_XGEN(b.x)], 1u);
            asm volatile("s_waitcnt vmcnt(0)" ::: "memory");
        } else {
            XB_SPIN(xb_ld(&bar[XB_XGEN(b.x)]) == gen, bar);
            __builtin_amdgcn_fence(__ATOMIC_ACQUIRE, "agent");
            asm volatile("s_waitcnt vmcnt(0)" ::: "memory");
        }
    }
    __syncthreads();
}


constexpr int LDS_FLOATS = 33792;
constexpr int LDS_BYTES = LDS_FLOATS * 4 + 16;

typedef const __attribute__((address_space(4))) unsigned long long* kargp_t;
__device__ __forceinline__ Params load_params() {
    kargp_t q = (kargp_t)__builtin_amdgcn_kernarg_segment_ptr(); asm volatile("" : "+s"(q));
    Params p; unsigned long long* d = (unsigned long long*)&p;
#pragma unroll
    for (int i = 0; i < (int)(sizeof(Params) / 8); ++i) d[i] = q[i];
    return p;
}
#define LOADP(name) const Params name = load_params()

template <int l>
__device__ __forceinline__ void run_layer(const XcdBarrier& bar, int bid, int nb, float* lds) {
    constexpr bool need_ctx = l == 0;
    constexpr float lam_init = l == 0 ? 0.2f : 0.35550906759509393f;
    { LOADP(p); ph_norm<false>(p, l, 0, NROW, bid, nb); } xcd_barrier(bar);
    { LOADP(p); ph_gemm_in(p, l, bid, nb); } xcd_barrier(bar);
    { LOADP(p); ph_rope(p, bid, nb); } xcd_barrier(bar);
    { LOADP(p); ph_ret_summ(p, l, bid, nb, lds); } { LOADP(p); ph_lru_chunk<1>(p, l, bid, nb, lds, 0); } xcd_barrier(bar);
    { LOADP(p); ph_scan2(p, l, bid, nb); } xcd_barrier(bar);
    { LOADP(p); ph_diff(p, l, need_ctx, lam_init, bid, nb); }
    { LOADP(p); ph_swa(p, l, need_ctx, bid, nb); }
    { LOADP(p); ph_ret_out(p, l, bid, nb, lds, need_ctx ? 0 : 2); }
    { LOADP(p); ph_lru_chunk<3>(p, l, bid, nb, lds, need_ctx ? 0 : 2); } xcd_barrier(bar);
    { LOADP(p); ph_gemm_out(p, l, need_ctx, bid, nb); } xcd_barrier(bar);
    if (l == 0) {
        { LOADP(p); ph_norm<false>(p, l, 1, NROW, bid, nb); } xcd_barrier(bar);
        { LOADP(p); ph_ffn1(p, need_ctx, bid, nb); } xcd_barrier(bar);
        { LOADP(p); ph_ffn2(p, l, need_ctx, bid, nb); } xcd_barrier(bar);
    } else {
        { LOADP(p); ph_norm<true>(p, l, 1, NLAT, bid, nb); } xcd_barrier(bar);
        { LOADP(p); ph_moe_scatter(p, bid, nb, lds); } xcd_barrier(bar);
        { LOADP(p); ph_moe1(p, 0, bid, nb, lds); } xcd_barrier(bar);
        { LOADP(p); ph_moe2(p, l, 0, bid, nb, lds); } xcd_barrier(bar);
        { LOADP(p); ph_moe1(p, 1, bid, nb, lds); } xcd_barrier(bar);
        { LOADP(p); ph_moe2(p, l, 1, bid, nb, lds); } xcd_barrier(bar);
    }
}

__global__ void __launch_bounds__(512, 2) fwd(Params p_in) {
    extern __shared__ __attribute__((aligned(16))) float lds[];
    volatile LAS unsigned* st = (volatile LAS unsigned*)(lds + LDS_FLOATS);
    if (threadIdx.x == 0) { st[0] = 0u; st[1] = 0u; st[2] = 0u; st[3] = 0u; }
    __syncthreads();
    XcdBarrier bar;
    { LOADP(p); bar = xcd_barrier_post((unsigned*)p.ws, st); }
    const int bid = blockIdx.x, nb = gridDim.x;
    { LOADP(p); ph_prologue(p, bid, nb, lds); } xcd_barrier(bar);
    run_layer<0>(bar, bid, nb, lds);
    run_layer<1>(bar, bid, nb, lds);
    { LOADP(p); ph_final(p, bid, nb); }
}

extern "C" void kernel_launch(void* const* d_in, const int* in_sizes, int n_in, void* d_out, int out_size, void* d_ws, size_t ws_size, hipStream_t stream) {
    static int grid = 0;
    if (grid == 0) {
        if (n_in < 30 || ws_size < WS_NEED) { fprintf(stderr, "kernel_launch: bad args n_in=%d ws=%zu need=%zu\n", n_in, ws_size, (size_t)WS_NEED); grid = -1; return; }
        int dev = 0, cus = 0, per_cu = 0;
        if (hipGetDevice(&dev) != hipSuccess || hipDeviceGetAttribute(&cus, hipDeviceAttributeMultiprocessorCount, dev) != hipSuccess) { grid = -1; return; }
        if (hipFuncSetAttribute((const void*)fwd, hipFuncAttributeMaxDynamicSharedMemorySize, LDS_BYTES) != hipSuccess) { fprintf(stderr, "kernel_launch: hipFuncSetAttribute failed\n"); grid = -1; return; }
        if (hipOccupancyMaxActiveBlocksPerMultiprocessor(&per_cu, (const void*)fwd, 512, LDS_BYTES) != hipSuccess || per_cu < 1) { fprintf(stderr, "kernel_launch: occupancy query says %d\n", per_cu); per_cu = 1; }
        (void)hipGetLastError();
        grid = cus;
    }
    if (grid < 0) return;
    Params p{};
    const float** f = (const float**)&p;
    for (int i = 0; i < 30; ++i) f[i] = (const float*)d_in[i];
    p.out = (float*)d_out; p.ws = (char*)d_ws;
    (void)hipMemsetAsync(d_ws, 0, 65536, stream);
    hipLaunchKernelGGL(fwd, dim3(grid), dim3(512), LDS_BYTES, stream, p);
}
```

```cpp
#include <hip/hip_runtime.h>
#include <cstdio>
#include <cstdint>

typedef unsigned short bf16_t;
typedef short bf16x8 __attribute__((ext_vector_type(8)));
typedef float f32x4 __attribute__((ext_vector_type(4)));

constexpr int NB = 2, NSEQ = 16384, NCTX = 256, DM = 1024;
constexpr int NLAT = NB * NSEQ;
constexpr int NCR = NB * NCTX;
constexpr int NROW = NLAT + NCR;
constexpr int DIN = 2816, DFF = 2816, DFE = 3584, NE = 8;
constexpr int NCI = 130;
constexpr int C_AQ = 0, C_AK = 256, C_AV = 384, C_RQ = 512, C_RK = 768, C_RV = 1024, C_RG = 1280, C_DQ = 1536, C_DK = 1792, C_DV = 2048, C_LX = 2304, C_LY = 2560;
constexpr int GRP_ROWS = 34816;

constexpr size_t al256(size_t x) { return (x + 255) & ~(size_t)255; }
constexpr size_t OFF_CTRL = 0;
constexpr size_t OFF_MOD = 65536;
constexpr size_t OFF_ROPE_RET = al256(OFF_MOD + 2 * 3 * 6144 * 4);
constexpr size_t OFF_ROPE_AX = al256(OFF_ROPE_RET + 2 * 16384 * 32 * 4);
constexpr size_t OFF_XC = al256(OFF_ROPE_AX + (2 * 256 * 16 + 2 * 64 * 16 + 2 * 256 * 8 + 2 * 64 * 8) * 4);
constexpr size_t OFF_ROUTE = al256(OFF_XC + (size_t)NCR * DM * 4);
constexpr size_t OFF_TOK = al256(OFF_ROUTE + (size_t)NLAT * 16);
constexpr size_t OFF_WGT = al256(OFF_TOK + (size_t)2 * GRP_ROWS * 4);
constexpr size_t OFF_LRU = al256(OFF_WGT + (size_t)2 * GRP_ROWS * 4);
constexpr size_t OFF_WM13 = al256(OFF_LRU + (size_t)3 * 2 * 2 * NCI * 256 * 4);
constexpr size_t OFF_WM2 = al256(OFF_WM13 + (size_t)NE * 2 * DFE * DM * 2);
constexpr size_t OFF_R = al256(OFF_WM2 + (size_t)NE * DM * DFE * 2);
constexpr size_t OFF_P = OFF_R;
constexpr size_t OFF_ACT = al256(OFF_P + (size_t)NROW * DIN * 2);
constexpr size_t OFF_RET = al256(OFF_ACT + (size_t)NROW * DM * 2);
constexpr size_t OFF_WIN = al256(OFF_RET + (size_t)2 * 2 * NCI * 4 * 4096 * 4);
constexpr size_t OFF_WOUT = al256(OFF_WIN + (size_t)2 * DIN * DM * 2);
constexpr size_t OFF_WF13 = al256(OFF_WOUT + (size_t)2 * DM * DM * 2);
constexpr size_t OFF_WF2 = al256(OFF_WF13 + (size_t)2 * DFF * DM * 2);
constexpr size_t OFF_R_END1 = al256(OFF_WF2 + (size_t)DM * DFF * 2);
constexpr size_t OFF_ASORT = OFF_R;
constexpr size_t OFF_UMOE = al256(OFF_ASORT + (size_t)2 * GRP_ROWS * DM * 2);
constexpr size_t OFF_R_END2 = al256(OFF_UMOE + (size_t)GRP_ROWS * DFE * 2);
constexpr size_t WS_NEED = OFF_R_END1 > OFF_R_END2 ? OFF_R_END1 : OFF_R_END2;
static_assert(OFF_ACT >= OFF_UMOE, "H2 must not overlap A_sorted");
constexpr int CW_CNT = 4096;
constexpr int CW_CUR = 4160;

struct Params {
    const float *x, *c, *ctx, *c_ctx, *w_ada, *b_ada, *g1, *g2, *w_in, *w_out, *sink, *ret_logit, *ret_gn, *diff_lam, *diff_gn,
        *conv_w, *conv_b, *lru_wa, *lru_ba, *lru_wx, *lru_bx, *lru_lam, *ffn_w1, *ffn_w3, *ffn_w2, *moe_router, *moe_w1, *moe_w3, *moe_w2, *final_norm;
    float* out; char* ws;
};

__device__ __forceinline__ float bf2f(bf16_t h) { return __uint_as_float(((unsigned)h) << 16); }
__device__ __forceinline__ bf16_t f2bf(float f) { unsigned u = __float_as_uint(f); u += 0x7fffu + ((u >> 16) & 1u); return (bf16_t)(u >> 16); }
__device__ __forceinline__ unsigned pack2(float lo, float hi) { return (unsigned)f2bf(lo) | ((unsigned)f2bf(hi) << 16); }
__device__ __forceinline__ float wave_sum(float v) {
#pragma unroll
    for (int o = 32; o >= 1; o >>= 1) v += __shfl_xor(v, o);
    return v;
}
__device__ __forceinline__ float sigmoidf_(float x) { return 1.0f / (1.0f + __expf(-x)); }
__device__ __forceinline__ float siluf_(float x) { return x / (1.0f + __expf(-x)); }
__device__ __forceinline__ float softplusf_(float x) { return x > 20.f ? x : log1pf(expf(x)); }
__device__ __forceinline__ float gelu_tanh(float x) { const float u = 0.7978845608028654f * (x + 0.044715f * x * x * x); return 0.5f * x * (1.0f + tanhf(u)); }
__device__ __forceinline__ int row_base(int b, int ci) { return ci < 2 ? NLAT + b * NCTX + ci * 128 : b * NSEQ + (ci - 2) * 128; }
__device__ __forceinline__ int mod_class(int row) { return row < NSEQ ? 0 : (row < NLAT ? 1 : 2); }

__device__ __forceinline__ void convert_tile(const float* src, int K, int N, bf16_t* dst, int tile, int mode, float* lds) {
    const int tpn = N / 64, tk = tile / tpn, tn = tile % tpn, t = threadIdx.x;
    {   const int kk = t >> 3, nc = (t & 7) * 8;
        const float4 a = *(const float4*)(src + (size_t)(tk * 64 + kk) * N + tn * 64 + nc);
        const float4 b = *(const float4*)(src + (size_t)(tk * 64 + kk) * N + tn * 64 + nc + 4);
        float* d = lds + kk * 65 + nc; d[0] = a.x; d[1] = a.y; d[2] = a.z; d[3] = a.w; d[4] = b.x; d[5] = b.y; d[6] = b.z; d[7] = b.w; }
    __syncthreads();
    {   const int n = t >> 3, kc = (t & 7) * 8, ng = tn * 64 + n;
        const int nrow = mode == 0 ? ng : ((ng >> 7) * 256 + (mode == 2 ? 128 : 0) + (ng & 127));
        uint4 w; w.x = pack2(lds[(kc + 0) * 65 + n], lds[(kc + 1) * 65 + n]); w.y = pack2(lds[(kc + 2) * 65 + n], lds[(kc + 3) * 65 + n]);
        w.z = pack2(lds[(kc + 4) * 65 + n], lds[(kc + 5) * 65 + n]); w.w = pack2(lds[(kc + 6) * 65 + n], lds[(kc + 7) * 65 + n]);
        *(uint4*)(dst + (size_t)nrow * K + tk * 64 + kc) = w; }
    __syncthreads();
}

__device__ __forceinline__ void ph_prologue(const Params& p, int bid, int nb, float* lds) {
    char* ws = p.ws; const int t = threadIdx.x;
    {
        struct Job { const float* src; bf16_t* dst; int K, N, mode, base; };
        Job* jobs = (Job*)(lds + 64 * 65 + 3);
        const int T_IN = 16 * 44, T_OUT = 16 * 16, T_F13 = 16 * 44, T_F2 = 44 * 16, T_M13 = 16 * 56, T_M2 = 56 * 16;
        const int total = 2 * T_IN + 2 * T_OUT + 2 * T_F13 + T_F2 + 16 * T_M13 + 8 * T_M2;
        if (t < 32) {
            Job jb; jb.src = nullptr; jb.dst = nullptr; jb.K = DM; jb.N = DM; jb.mode = 0; jb.base = total;
            if (t < 2) { jb.src = p.w_in + (size_t)t * DM * DIN; jb.dst = (bf16_t*)(ws + OFF_WIN) + (size_t)t * DIN * DM; jb.N = DIN; jb.base = t * T_IN; }
            else if (t < 4) { jb.src = p.w_out + (size_t)(t - 2) * DM * DM; jb.dst = (bf16_t*)(ws + OFF_WOUT) + (size_t)(t - 2) * DM * DM; jb.base = 2 * T_IN + (t - 2) * T_OUT; }
            else if (t < 6) { jb.src = t == 4 ? p.ffn_w1 : p.ffn_w3; jb.dst = (bf16_t*)(ws + OFF_WF13); jb.N = DFF; jb.mode = t - 3; jb.base = 2 * T_IN + 2 * T_OUT + (t - 4) * T_F13; }
            else if (t == 6) { jb.src = p.ffn_w2; jb.dst = (bf16_t*)(ws + OFF_WF2); jb.K = DFF; jb.base = 2 * T_IN + 2 * T_OUT + 2 * T_F13; }
            else if (t < 23) { const int q = t - 7, e = q & 7, w3 = q >> 3; jb.src = (w3 ? p.moe_w3 : p.moe_w1) + (size_t)e * DM * DFE; jb.dst = (bf16_t*)(ws + OFF_WM13) + (size_t)e * 2 * DFE * DM; jb.N = DFE; jb.mode = 1 + w3;
                jb.base = 2 * T_IN + 2 * T_OUT + 2 * T_F13 + T_F2 + q * T_M13; }
            else if (t < 31) { const int e = t - 23; jb.src = p.moe_w2 + (size_t)e * DFE * DM; jb.dst = (bf16_t*)(ws + OFF_WM2) + (size_t)e * DM * DFE; jb.K = DFE;
                jb.base = 2 * T_IN + 2 * T_OUT + 2 * T_F13 + T_F2 + 16 * T_M13 + e * T_M2; }
            jobs[t] = jb;
        }
        __syncthreads();
        int j = 0;
        for (int u = bid; u < total; u += nb) {
            while (u >= jobs[j + 1].base) ++j;
            const Job jb = jobs[j];
            convert_tile(jb.src, jb.K, jb.N, jb.dst, u - jb.base, jb.mode, lds);
        }
        __syncthreads();
    }
    {
        float* sv = lds;
        float* red = lds + 3072;
        for (int i = t; i < 3072; i += 512) { const int v = i >> 10, k = i & 1023; const float cv = v < 2 ? p.c[v * DM + k] : p.c_ctx[k]; sv[i] = siluf_(cv); }
        __syncthreads();
        float* mod = (float*)(ws + OFF_MOD);
        for (int u = bid; u < 2 * 96; u += nb) {
            const int l = u / 96, j0 = (u % 96) * 64, j = t & 63, kg = t >> 6;
            float a0 = 0.f, a1 = 0.f, a2 = 0.f;
            const float* w = p.w_ada + (size_t)l * DM * 6144 + j0 + j;
            for (int k = kg * 128; k < kg * 128 + 128; ++k) { const float wv = w[(size_t)k * 6144]; a0 += sv[k] * wv; a1 += sv[1024 + k] * wv; a2 += sv[2048 + k] * wv; }
            red[(kg * 3 + 0) * 64 + j] = a0; red[(kg * 3 + 1) * 64 + j] = a1; red[(kg * 3 + 2) * 64 + j] = a2;
            __syncthreads();
            if (t < 192) { const int v = t >> 6; float s = 0.f;
                for (int g = 0; g < 8; ++g) s += red[(g * 3 + v) * 64 + j];
                mod[((size_t)l * 3 + v) * 6144 + j0 + j] = s + p.b_ada[l * 6144 + j0 + j]; }
            __syncthreads();
        }
    }
    {
        float* rr = (float*)(ws + OFF_ROPE_RET);
        const int gt = bid * 512 + t, gs = nb * 512;
        for (int i = gt; i < 16384 * 32; i += gs) { const int n = i >> 5, j = i & 31;
            const float inv = (float)pow(10000.0, -(double)j / 32.0); const float ang = (float)n * inv;
            rr[i] = (float)cos((double)ang); rr[16384 * 32 + i] = (float)sin((double)ang); }
        float* ax = (float*)(ws + OFF_ROPE_AX);
        for (int i = gt; i < 256 * 16; i += gs) { const int n = i >> 4, j = i & 15; const float inv = (float)pow(10000.0, -(double)j / 16.0); const float ang = (float)n * inv;
            ax[i] = (float)cos((double)ang); ax[4096 + i] = (float)sin((double)ang);
            if (n < 64) { ax[8192 + i] = (float)cos((double)ang); ax[9216 + i] = (float)sin((double)ang); } }
        for (int i = gt; i < 256 * 8; i += gs) { const int n = i >> 3, j = i & 7; const float inv = (float)pow(10000.0, -(double)j / 8.0); const float ang = (float)n * inv;
            ax[10240 + i] = (float)cos((double)ang); ax[12288 + i] = (float)sin((double)ang);
            if (n < 64) { ax[14336 + i] = (float)cos((double)ang); ax[14848 + i] = (float)sin((double)ang); } }
        float* xc = (float*)(ws + OFF_XC);
        for (int i = gt; i < NCR * DM / 4; i += gs) ((float4*)xc)[i] = ((const float4*)p.ctx)[i];
        int* tok = (int*)(ws + OFF_TOK);
        for (int i = gt; i < 2 * GRP_ROWS; i += gs) tok[i] = -1;
    }
}

template <bool ROUTE>
__device__ __forceinline__ void ph_norm(const Params& p, int l, int which  , int nrows, int bid, int nb) {
    char* ws = p.ws; const int lane = threadIdx.x & 63, wv = threadIdx.x >> 6;
    const float* mod = (const float*)(ws + OFF_MOD) + (size_t)l * 3 * 6144;
    const float* g = (which == 0 ? p.g1 : p.g2) + l * DM;
    bf16_t* H = (bf16_t*)(ws + OFF_ACT);
    const float* xl = (which == 0 && l == 0) ? p.x : p.out;
    const float* xc = (const float*)(ws + OFF_XC);
    for (int r = bid * 8 + wv; r < nrows; r += nb * 8) {
        const float* xr = r < NLAT ? xl + (size_t)r * DM : xc + (size_t)(r - NLAT) * DM;
        const float* mv = mod + (size_t)mod_class(r) * 6144 + (which == 0 ? 0 : 3072);
        float4 v[4]; float ss = 0.f;
#pragma unroll
        for (int i = 0; i < 4; ++i) { v[i] = *(const float4*)(xr + i * 256 + lane * 4); ss += v[i].x * v[i].x + v[i].y * v[i].y + v[i].z * v[i].z + v[i].w * v[i].w; }
        ss = wave_sum(ss);
        const float rn = rsqrtf(ss * (1.0f / 1024.0f) + 1e-6f);
        float lg[8];
        if (ROUTE) {
#pragma unroll
            for (int e = 0; e < 8; ++e) lg[e] = 0.f;
        }
#pragma unroll
        for (int i = 0; i < 4; ++i) {
            const int c = i * 256 + lane * 4;
            const float4 gg = *(const float4*)(g + c), sh = *(const float4*)(mv + c), sc = *(const float4*)(mv + 1024 + c);
            float h0 = v[i].x * rn * gg.x * (1.f + sc.x) + sh.x, h1 = v[i].y * rn * gg.y * (1.f + sc.y) + sh.y;
            float h2 = v[i].z * rn * gg.z * (1.f + sc.z) + sh.z, h3 = v[i].w * rn * gg.w * (1.f + sc.w) + sh.w;
            uint2 w; w.x = pack2(h0, h1); w.y = pack2(h2, h3);
            *(uint2*)(H + (size_t)r * DM + c) = w;
            if (ROUTE) {
                const float* rt = p.moe_router + (size_t)c * 8;
#pragma unroll
                for (int e = 0; e < 8; ++e) lg[e] += h0 * rt[e] + h1 * rt[8 + e] + h2 * rt[16 + e] + h3 * rt[24 + e];
            }
        }
        if (ROUTE) {
#pragma unroll
            for (int e = 0; e < 8; ++e) lg[e] = wave_sum(lg[e]);
            if (lane == 0 && r < NLAT) {
                int e0 = 0; float v0 = lg[0];
#pragma unroll
                for (int e = 1; e < 8; ++e) if (lg[e] > v0) { v0 = lg[e]; e0 = e; }
                int e1 = -1; float v1 = -3.0e38f;
#pragma unroll
                for (int e = 0; e < 8; ++e) if (e != e0 && lg[e] > v1) { v1 = lg[e]; e1 = e; }
                const float ex = __expf(v1 - v0), w0 = 1.0f / (1.0f + ex), w1 = ex / (1.0f + ex);
                int4 rec; rec.x = e0; rec.y = e1; rec.z = __float_as_int(w0); rec.w = __float_as_int(w1);
                *(int4*)(ws + OFF_ROUTE + (size_t)r * 16) = rec;
                unsigned* cw = (unsigned*)ws;
                atomicAdd(cw + CW_CNT + e0, 1u); atomicAdd(cw + CW_CNT + 8 + e1, 1u);
            }
        }
    }
}

namespace pg8 {
#define PG8_LAS __attribute__((address_space(3)))
typedef unsigned short bf16_t;
typedef short bf16x8 __attribute__((ext_vector_type(8)));
typedef float f32x4 __attribute__((ext_vector_type(4)));
typedef unsigned u32x4 __attribute__((ext_vector_type(4)));
constexpr int BM = 256, BK = 64, HALF = 128, HTB = HALF * BK * 2  , STAGE_BYTES = 8 * HTB, NXCD = 8, WGM = 8;

__host__ __device__ __forceinline__ int lds_byte(int r, int c) { const int st = (r >> 4) * 2 + (c >> 5), rr = r & 15, cc = c & 31, ob = rr * 64 + cc * 2; return st * 1024 + (ob ^ (((ob >> 9) & 1) << 5)); }
__host__ __device__ __forceinline__ void stage_rc(int b, int& R, int& C) { const int st = b / 1024, sb = b % 1024, swz = sb ^ (((sb >> 9) & 1) << 5); R = (st >> 1) * 16 + swz / 64; C = (st & 1) * 32 + (swz % 64) / 2; }
__host__ __device__ __forceinline__ int perm32(int rho) { const int n = rho >> 4, i = rho & 15; return 8 * (i >> 2) + 4 * n + (i & 3); }

struct Unit { int pm, pn; };
struct Gemm { const bf16_t* A; const bf16_t* Bt; int M, N, K; };

struct StaticOrder {
    int nM, nN, nwg, G, c;
    __host__ __device__ void init(int M, int N, int G_, int c_) { nM = M / BM; nN = N / BM; nwg = nM * nN; G = G_; c = c_; }
    __host__ __device__ bool next(int i, Unit& u) const {
        const long L = (long)i * G + c; if (L >= nwg) return false;
        int wgid = (int)L; { const int q = nwg / NXCD, r = nwg % NXCD, xcd = wgid % NXCD, off = wgid / NXCD; wgid = (xcd < r ? xcd * (q + 1) : r * (q + 1) + (xcd - r) * q) + off; }
        const int nig = WGM * nN, gid = wgid / nig, fm = gid * WGM, gsz = (nM - fm) < WGM ? (nM - fm) : WGM;
        u.pm = fm + ((wgid % nig) % gsz); u.pn = (wgid % nig) / gsz; return true;
    }
    __device__ __forceinline__ void a_ready(const Unit&) const {}
    __device__ __forceinline__ void done(const Unit&) const {}
};
__device__ __forceinline__ unsigned cvt_pk_bf16(float lo, float hi) { unsigned r; asm volatile("v_cvt_pk_bf16_f32 %0, %1, %2" : "=v"(r) : "v"(lo), "v"(hi)); return r; }
typedef float f32x2 __attribute__((ext_vector_type(2)));
template <class Epi, class Sched, bool ALIGN_EPI = false, bool SP2 = false>
__device__ __forceinline__ void gemm_phase(PG8_LAS unsigned char* lds, const Gemm g, const Sched& S, const Epi& E) {
    int tid_ = threadIdx.x; asm volatile("" : "+v"(tid_));
    const int tid = tid_, wid = __builtin_amdgcn_readfirstlane(tid >> 6), lane = tid & 63, wr = wid >> 2, wc = wid & 3, fr = lane & 15, fq = lane >> 4;
    const int K = g.K, nt = K / BK;
    unsigned voffA[2], voffB[2];
#pragma unroll
    for (int i = 0; i < 2; ++i) { int R, C; stage_rc(tid * 16 + i * 8192, R, C); const int Rb = Epi::PERM ? ((R & ~31) + perm32(R & 31)) : R;
        voffA[i] = (unsigned)(R * K + C) * 2u; voffB[i] = (unsigned)(Rb * K + C) * 2u; }
    const size_t kstep = (size_t)(BK * 2);
    const size_t hstep = (size_t)HALF * K * 2;
    const size_t tstep = 2 * hstep;
    const unsigned ldsw = (unsigned)wid * 1024u;
    const int aoff = lds_byte(wr * 64 + fr, fq * 8), boff = lds_byte(wc * 32 + fr, fq * 8);
#define PG8_SA(b, h) (((b) * 2 + (h)) * HTB)
#define PG8_SB(b, h) ((4 + (b) * 2 + (h)) * HTB)
#define PG8_STAGE(bufoff, gbase, voff) do { _Pragma("unroll") for (int _i = 0; _i < 2; ++_i) \
        __builtin_amdgcn_global_load_lds((const unsigned*)((const char*)(gbase) + (voff)[_i]), (PG8_LAS unsigned*)(lds + (bufoff) + ldsw + _i * 8192), 16, 0, 0); } while (0)
#define PG8_LDA(dst, b, h) do { _Pragma("unroll") for (int m = 0; m < 4; ++m) _Pragma("unroll") for (int k = 0; k < 2; ++k) dst[m][k] = *(const PG8_LAS bf16x8*)(lds + PG8_SA(b, h) + aoff + m * 2048 + k * 1024); } while (0)
#define PG8_LDB(dst, b, h) do { _Pragma("unroll") for (int n = 0; n < 2; ++n) _Pragma("unroll") for (int k = 0; k < 2; ++k) dst[n][k] = *(const PG8_LAS bf16x8*)(lds + PG8_SB(b, h) + boff + n * 2048 + k * 1024); } while (0)
#define PG8_MMA(ai, bj, At, Bt) do { __builtin_amdgcn_s_setprio(1); _Pragma("unroll") for (int m = 0; m < 4; ++m) _Pragma("unroll") for (int n = 0; n < 2; ++n) _Pragma("unroll") for (int k = 0; k < 2; ++k) \
        acc[ai][bj][m][n] = __builtin_amdgcn_mfma_f32_16x16x32_bf16(Bt[n][k], At[m][k], acc[ai][bj][m][n], 0, 0, 0); __builtin_amdgcn_s_setprio(0); } while (0)
#define PG8_WAIT_V(n) asm volatile("s_waitcnt vmcnt(" #n ")" ::: "memory")
#define PG8_WAIT_L(n) asm volatile("s_waitcnt lgkmcnt(" #n ")" ::: "memory")
#define PG8_BAR __builtin_amdgcn_s_barrier()
#define PG8_SCHED __builtin_amdgcn_sched_barrier(0)
    Unit cur, nxt; int ui = 0;
    if (!S.next(0, cur)) return;
    f32x4 acc[2][2][4][2];
#pragma unroll
    for (int a = 0; a < 2; ++a)
#pragma unroll
        for (int b = 0; b < 2; ++b)
#pragma unroll
            for (int m = 0; m < 4; ++m)
#pragma unroll
                for (int n = 0; n < 2; ++n) acc[a][b][m][n] = (f32x4){0.f, 0.f, 0.f, 0.f};
    bf16x8 At[4][2], B0[2][2], B1[2][2];
    const char* cA = (const char*)g.A + (size_t)cur.pm * tstep; const char* cB = (const char*)g.Bt + (size_t)cur.pn * tstep;
    S.a_ready(cur);
    if constexpr (SP2) {
        PG8_STAGE(PG8_SB(0, 0), cB, voffB); PG8_STAGE(PG8_SB(0, 1), cB + hstep, voffB); PG8_STAGE(PG8_SA(0, 0), cA, voffA); PG8_STAGE(PG8_SA(0, 1), cA + hstep, voffA);
        if (wr == 1) PG8_BAR;
        PG8_WAIT_V(2); PG8_BAR;
        PG8_STAGE(PG8_SB(1, 0), cB + kstep, voffB); PG8_STAGE(PG8_SA(1, 0), cA + kstep, voffA); PG8_STAGE(PG8_SB(1, 1), cB + hstep + kstep, voffB);
        PG8_WAIT_V(6); PG8_BAR;
    } else {
        PG8_STAGE(PG8_SB(0, 0), cB, voffB); PG8_STAGE(PG8_SA(0, 0), cA, voffA); PG8_STAGE(PG8_SB(0, 1), cB + hstep, voffB); PG8_STAGE(PG8_SA(0, 1), cA + hstep, voffA);
        if (wr == 1) PG8_BAR;
        PG8_WAIT_V(4); PG8_BAR;
        PG8_STAGE(PG8_SB(1, 0), cB + kstep, voffB); PG8_STAGE(PG8_SA(1, 0), cA + kstep, voffA); PG8_STAGE(PG8_SB(1, 1), cB + hstep + kstep, voffB);
        PG8_WAIT_V(6); PG8_BAR;
    }
    for (;;) {
        const bool has_next = S.next(ui + 1, nxt);
        const char* nA = has_next ? (const char*)g.A + (size_t)nxt.pm * tstep : cA; const char* nB = has_next ? (const char*)g.Bt + (size_t)nxt.pn * tstep : cB;
        for (int t = 0; t < nt; t += 2) {
            const bool last = (t == nt - 2);
            const char* a1 = cA + (size_t)(t + 1) * kstep;
            const char* a2 = last ? nA : cA + (size_t)(t + 2) * kstep; const char* b2 = last ? nB : cB + (size_t)(t + 2) * kstep;
            const char* a3 = a2 + kstep; const char* b3 = b2 + kstep;
            if (last && has_next) S.a_ready(nxt);
            if constexpr (SP2) {
            PG8_LDB(B0, 0, 0); PG8_LDB(B1, 0, 1); PG8_SCHED; PG8_LDA(At, 0, 0); PG8_STAGE(PG8_SA(1, 1), a1 + hstep, voffA);
            PG8_WAIT_V(8); PG8_WAIT_L(0); PG8_BAR; PG8_MMA(0, 0, At, B0); PG8_MMA(0, 1, At, B1); PG8_BAR; PG8_SCHED;
            PG8_LDA(At, 0, 1); PG8_STAGE(PG8_SB(0, 0), b2, voffB); PG8_STAGE(PG8_SB(0, 1), b2 + hstep, voffB); PG8_STAGE(PG8_SA(0, 0), a2, voffA);
            PG8_WAIT_V(8); PG8_WAIT_L(0); PG8_BAR; PG8_MMA(1, 0, At, B0); PG8_MMA(1, 1, At, B1); PG8_BAR; PG8_SCHED;
            PG8_LDB(B0, 1, 0); PG8_LDB(B1, 1, 1); PG8_SCHED; PG8_LDA(At, 1, 0); PG8_STAGE(PG8_SA(0, 1), a2 + hstep, voffA);
            PG8_WAIT_V(8); PG8_WAIT_L(0); PG8_BAR; PG8_MMA(0, 0, At, B0); PG8_MMA(0, 1, At, B1); PG8_BAR; PG8_SCHED;
            PG8_LDA(At, 1, 1); PG8_STAGE(PG8_SB(1, 0), b3, voffB); PG8_STAGE(PG8_SB(1, 1), b3 + hstep, voffB); PG8_STAGE(PG8_SA(1, 0), a3, voffA);
            PG8_WAIT_V(8); PG8_WAIT_L(0); PG8_BAR; PG8_MMA(1, 0, At, B0); PG8_MMA(1, 1, At, B1); PG8_BAR; PG8_SCHED;
            } else {
            PG8_LDB(B0, 0, 0); PG8_SCHED; PG8_LDA(At, 0, 0); PG8_STAGE(PG8_SA(1, 1), a1 + hstep, voffA);
            PG8_WAIT_L(8); PG8_BAR; PG8_WAIT_L(0); PG8_MMA(0, 0, At, B0); PG8_BAR; PG8_SCHED;
            PG8_LDB(B1, 0, 1); PG8_STAGE(PG8_SB(0, 0), b2, voffB);
            PG8_BAR; PG8_WAIT_L(0); PG8_MMA(0, 1, At, B1); PG8_BAR;
            PG8_LDA(At, 0, 1); PG8_STAGE(PG8_SA(0, 0), a2, voffA);
            PG8_BAR; PG8_WAIT_L(0); PG8_MMA(1, 0, At, B0); PG8_BAR; PG8_SCHED;
            PG8_STAGE(PG8_SB(0, 1), b2 + hstep, voffB);
            PG8_WAIT_V(6); PG8_BAR; PG8_MMA(1, 1, At, B1); PG8_BAR;
            PG8_LDB(B0, 1, 0); PG8_SCHED; PG8_LDA(At, 1, 0); PG8_STAGE(PG8_SA(0, 1), a2 + hstep, voffA);
            PG8_WAIT_L(8); PG8_BAR; PG8_WAIT_L(0); PG8_MMA(0, 0, At, B0); PG8_BAR; PG8_SCHED;
            PG8_LDB(B1, 1, 1); PG8_STAGE(PG8_SB(1, 0), b3, voffB);
            PG8_BAR; PG8_WAIT_L(0); PG8_MMA(0, 1, At, B1); PG8_BAR;
            PG8_LDA(At, 1, 1); PG8_STAGE(PG8_SA(1, 0), a3, voffA);
            PG8_BAR; PG8_WAIT_L(0); PG8_MMA(1, 0, At, B0); PG8_BAR; PG8_SCHED;
            PG8_STAGE(PG8_SB(1, 1), b3 + hstep, voffB);
            PG8_WAIT_V(6); PG8_BAR; PG8_MMA(1, 1, At, B1); PG8_BAR;
            }
        }
        if constexpr (ALIGN_EPI) { if (wr == 0) PG8_BAR; }
        if constexpr (!Epi::AFTER_DRAIN) { E(acc, cur, wr, wc, fr, fq); S.done(cur); }
        if (!has_next) break;
#pragma unroll
        for (int a = 0; a < 2; ++a)
#pragma unroll
            for (int b = 0; b < 2; ++b)
#pragma unroll
                for (int m = 0; m < 4; ++m)
#pragma unroll
                    for (int n = 0; n < 2; ++n) acc[a][b][m][n] = (f32x4){0.f, 0.f, 0.f, 0.f};
        cur = nxt; cA = nA; cB = nB; ++ui;
        if constexpr (ALIGN_EPI) { if (wr == 1) PG8_BAR; }
    }
    PG8_WAIT_V(0);
    if constexpr (!ALIGN_EPI) { if (wr == 0) PG8_BAR; }
    PG8_BAR;
    if constexpr (Epi::AFTER_DRAIN) { E.fused(acc, cur, wr, wc, fr, fq, lds, wid, lane); S.done(cur); }
#undef PG8_SA
#undef PG8_SB
#undef PG8_STAGE
#undef PG8_LDA
#undef PG8_LDB
#undef PG8_MMA
#undef PG8_WAIT_V
#undef PG8_WAIT_L
#undef PG8_BAR
#undef PG8_SCHED
}
}

__device__ __forceinline__ void ph_rope(const Params& p, int bid, int nb) {
    char* ws = p.ws; const int lane = threadIdx.x & 63, wv = threadIdx.x >> 6;
    bf16_t* P = (bf16_t*)(ws + OFF_P);
    const float* rr = (const float*)(ws + OFF_ROPE_RET); const float* ax = (const float*)(ws + OFF_ROPE_AX);
    for (int r = bid * 8 + wv; r < NROW; r += nb * 8) {
        const bool lat = r < NLAT; const int n = r & (NSEQ - 1), gr = n >> 6, gc = n & 63;
        bf16_t* pr = P + (size_t)r * DIN;
        for (int it = 0; it < 11; ++it) {
            const int pi = it * 64 + lane;
            int c1, c2; float cs = 1.f, sn = 0.f, scale = 1.f;
            if (pi < 192) {
                const int hd = pi >> 5, j = pi & 31; c1 = (pi < 128 ? C_AQ : C_AK - 256) + hd * 64 + j; c2 = c1 + 32;
                if (pi < 128) scale = 0.125f;
                if (lat) { if (j < 16) { cs = ax[gr * 16 + j]; sn = ax[4096 + gr * 16 + j]; } else { cs = ax[8192 + gc * 16 + j - 16]; sn = ax[9216 + gc * 16 + j - 16]; } }
            } else if (pi < 448) {
                const int q = pi - 192, hd = q >> 5, j = q & 31; c1 = C_RQ + hd * 64 + j; c2 = c1 + 32;
                if (q >= 128) scale = 0.125f;
                if (lat) { cs = rr[n * 32 + j]; sn = rr[16384 * 32 + n * 32 + j]; }
            } else {
                const int q = pi - 448, blk = q >> 4, j = q & 15; c1 = C_DQ + blk * 32 + j; c2 = c1 + 16;
                if (q < 128) scale = 0.17677669529663687f;
                if (lat) { if (j < 8) { cs = ax[10240 + gr * 8 + j]; sn = ax[12288 + gr * 8 + j]; } else { cs = ax[14336 + gc * 8 + j - 8]; sn = ax[14848 + gc * 8 + j - 8]; } }
            }
            const float x1 = bf2f(pr[c1]), x2 = bf2f(pr[c2]);
            pr[c1] = f2bf((x1 * cs - x2 * sn) * scale); pr[c2] = f2bf((x2 * cs + x1 * sn) * scale);
        }
    }
}

__device__ __forceinline__ float ret_lg(const Params& p, int l, int dir, int h) { return -softplusf_(-p.ret_logit[(l * 2 + dir) * 4 + h]); }
__device__ __forceinline__ void ph_ret_summ(const Params& p, int l, int bid, int nb, float* lds) {
    char* ws = p.ws; const int t = threadIdx.x;
    const bf16_t* P = (const bf16_t*)(ws + OFF_P); float* RET = (float*)(ws + OFF_RET);
    float* ks = lds; float* vs = lds + 128 * 64; float* zf = vs + 128 * 64; float* zb = zf + 128;
    for (int u = bid; u < 2 * NCI * 4; u += nb) {
        const int h = u & 3, ci = (u >> 2) % NCI, b = u / (4 * NCI), rb = row_base(b, ci);
        const float lgf = ret_lg(p, l, 0, h), lgb = ret_lg(p, l, 1, h);
        __syncthreads();
        for (int i = t; i < 128 * 64; i += 512) { const int m = i >> 6, d = i & 63; ks[i] = bf2f(P[(size_t)(rb + m) * DIN + C_RK + h * 64 + d]); vs[i] = bf2f(P[(size_t)(rb + m) * DIN + C_RV + h * 64 + d]); }
        if (t < 128) { zf[t] = expf(lgf * (float)(127 - t)); zb[t] = expf(lgb * (float)t); }
        __syncthreads();
        const int d = t >> 3, e0 = (t & 7) * 8;
        float af[8], ab[8];
#pragma unroll
        for (int j = 0; j < 8; ++j) { af[j] = 0.f; ab[j] = 0.f; }
        for (int m = 0; m < 128; ++m) { const float kv = ks[m * 64 + d], kf = kv * zf[m], kb = kv * zb[m];
#pragma unroll
            for (int j = 0; j < 8; ++j) { const float vv = vs[m * 64 + e0 + j]; af[j] += kf * vv; ab[j] += kb * vv; } }
        float* of = RET + ((((size_t)0 * 2 + b) * NCI + ci) * 4 + h) * 4096 + d * 64 + e0;
        float* ob = RET + ((((size_t)1 * 2 + b) * NCI + ci) * 4 + h) * 4096 + d * 64 + e0;
#pragma unroll
        for (int j = 0; j < 8; ++j) { of[j] = af[j]; ob[j] = ab[j]; }
    }
}

template <int MODE>
__device__ __forceinline__ void ph_lru_chunk(const Params& p, int l, int bid, int nb, float* lds, int ci_lo) {
    char* ws = p.ws; const int t = threadIdx.x;
    const bf16_t* P = (const bf16_t*)(ws + OFF_P);
    float* LA = (float*)(ws + OFF_LRU); float* LB = LA + 2 * 2 * NCI * 256; float* LC = LB + 2 * 2 * NCI * 256;
    bf16_t* O = (bf16_t*)(ws + OFF_ACT);
    float* us = lds;
    float* as_ = lds + 8192;
    float* bs_ = lds + 16384;
    float* hs = lds + 24576;
    const int nci = NCI - ci_lo;
    for (int u = bid; u < 2 * nci * 4; u += nb) {
        const int hb = u & 3, ci = ci_lo + (u >> 2) % nci, b = u / (4 * nci), rb = row_base(b, ci);
        const int seg_lo = ci < 2 ? NLAT + b * NCTX : b * NSEQ, seg_hi = ci < 2 ? seg_lo + NCTX : seg_lo + NSEQ;
        __syncthreads();
        for (int i = t; i < 128 * 64; i += 512) { const int tt = i >> 6, j = i & 63, ch = hb * 64 + j; float acc = p.conv_b[l * 256 + ch];
#pragma unroll
            for (int k = 0; k < 4; ++k) { const int rr = rb + tt - 1 + k; if (rr >= seg_lo && rr < seg_hi) acc += p.conv_w[(l * 4 + k) * 256 + ch] * bf2f(P[(size_t)rr * DIN + C_LX + ch]); }
            us[i] = acc; }
        __syncthreads();
        for (int dir = 0; dir < 2; ++dir) {
            const int j = t & 63, tg = t >> 6, ch = hb * 64 + j;
            const float* wa = p.lru_wa + (((size_t)(l * 2 + dir) * 4 + hb) * 64) * 64 + j;
            const float* wx = p.lru_wx + (((size_t)(l * 2 + dir) * 4 + hb) * 64) * 64 + j;
            const float ba = p.lru_ba[(l * 2 + dir) * 256 + ch], bx = p.lru_bx[(l * 2 + dir) * 256 + ch];
            const float spl = softplusf_(-p.lru_lam[(l * 2 + dir) * 256 + ch]);
            float ra[16], rx[16];
#pragma unroll
            for (int k = 0; k < 16; ++k) { ra[k] = ba; rx[k] = bx; }
            for (int i = 0; i < 64; ++i) { const float wav = wa[i * 64], wxv = wx[i * 64];
#pragma unroll
                for (int k = 0; k < 16; ++k) { const float uv = us[(tg * 16 + k) * 64 + i]; ra[k] += uv * wav; rx[k] += uv * wxv; } }
#pragma unroll
            for (int k = 0; k < 16; ++k) { const int tt = tg * 16 + k; const float r = sigmoidf_(ra[k]), ig = sigmoidf_(rx[k]);
                const float la = -8.0f * r * spl, a = expf(la), bb = sqrtf(-expm1f(2.0f * la)) * (ig * us[tt * 64 + j]);
                as_[tt * 64 + j] = a; bs_[tt * 64 + j] = bb; }
            __syncthreads();
            if (t < 64) {
                const size_t cidx = (((size_t)dir * 2 + b) * NCI + ci) * 256 + hb * 64 + t;
                float h = MODE == 3 ? LC[cidx] : 0.f, ap = 1.f;
                if (dir == 0) { for (int tt = 0; tt < 128; ++tt) { const float a = as_[tt * 64 + t]; h = a * h + bs_[tt * 64 + t]; ap *= a; if (MODE == 3) hs[tt * 64 + t] = h; } }
                else { for (int tt = 127; tt >= 0; --tt) { const float a = as_[tt * 64 + t]; h = a * h + bs_[tt * 64 + t]; ap *= a; if (MODE == 3) hs[tt * 64 + t] += h; } }
                if (MODE == 1) { LA[cidx] = ap; LB[cidx] = h; }
            }
            __syncthreads();
        }
        if (MODE == 3) {
            for (int i = t; i < 128 * 64; i += 512) { const int tt = i >> 6, j = i & 63, ch = hb * 64 + j;
                const float y = bf2f(P[(size_t)(rb + tt) * DIN + C_LY + ch]);
                O[(size_t)(rb + tt) * DM + 768 + ch] = f2bf(hs[i] * gelu_tanh(y)); }
        }
    }
}

__device__ __forceinline__ int scan_ci(int dir, int s) { return dir == 0 ? s : (s == 0 ? 1 : (s == 1 ? 0 : NCI + 1 - s)); }
__device__ __forceinline__ void ph_scan2(const Params& p, int l, int bid, int nb) {
    char* ws = p.ws; const int gt = bid * 512 + threadIdx.x, gs = nb * 512;
    float* RET = (float*)(ws + OFF_RET);
    for (int i = gt; i < 2 * 2 * 4 * 4096; i += gs) {
        const int de = i & 4095, h = (i >> 12) & 3, b = (i >> 14) & 1, dir = i >> 15;
        const float decay = expf(ret_lg(p, l, dir, h) * 128.0f); float S = 0.f;
        for (int s = 0; s < NCI; ++s) { const int ci = scan_ci(dir, s); float* q = RET + ((((size_t)dir * 2 + b) * NCI + ci) * 4 + h) * 4096 + de; const float U = *q; *q = S; S = decay * S + U; }
    }
    float* LA = (float*)(ws + OFF_LRU); float* LB = LA + 2 * 2 * NCI * 256; float* LC = LB + 2 * 2 * NCI * 256;
    for (int i = gt; i < 2 * 2 * 256; i += gs) {
        const int ch = i & 255, b = (i >> 8) & 1, dir = i >> 9; float h = 0.f;
        for (int s = 0; s < NCI; ++s) { const int ci = scan_ci(dir, s); const size_t idx = (((size_t)dir * 2 + b) * NCI + ci) * 256 + ch; LC[idx] = h; h = LA[idx] * h + LB[idx]; }
    }
}

__device__ __forceinline__ void ph_ret_out(const Params& p, int l, int bid, int nb, float* lds, int ci_lo) {
    char* ws = p.ws; const int t = threadIdx.x;
    const bf16_t* P = (const bf16_t*)(ws + OFF_P); const float* RET = (const float*)(ws + OFF_RET); bf16_t* O = (bf16_t*)(ws + OFF_ACT);
    float* qs = lds;
    float* ks = qs + 128 * 65;
    float* vs = ks + 128 * 65;
    float* sf = vs + 128 * 64;
    float* sb = sf + 4096;
    float* pf = sb + 4096;
    float* pb = pf + 132;
    const int nci = NCI - ci_lo;
    for (int u = bid; u < 2 * nci * 4; u += nb) {
        const int h = u & 3, ci = ci_lo + (u >> 2) % nci, b = u / (4 * nci), rb = row_base(b, ci);
        const float lgf = ret_lg(p, l, 0, h), lgb = ret_lg(p, l, 1, h);
        __syncthreads();
        for (int i = t; i < 128 * 64; i += 512) { const int m = i >> 6, d = i & 63; const bf16_t* pr = P + (size_t)(rb + m) * DIN + h * 64 + d;
            qs[m * 65 + d] = bf2f(pr[C_RQ]); ks[m * 65 + d] = bf2f(pr[C_RK]); vs[i] = bf2f(pr[C_RV]); }
        for (int i = t; i < 4096; i += 512) { sf[i] = RET[((((size_t)0 * 2 + b) * NCI + ci) * 4 + h) * 4096 + i]; sb[i] = RET[((((size_t)1 * 2 + b) * NCI + ci) * 4 + h) * 4096 + i]; }
        if (t < 129) { pf[t] = expf(lgf * (float)t); pb[t] = expf(lgb * (float)t); }
        __syncthreads();
        const int n = t >> 2, e0 = (t & 3) * 16;
        float y[16];
#pragma unroll
        for (int j = 0; j < 16; ++j) y[j] = 0.f;
        for (int m = 0; m < 128; ++m) {
            float s = 0.f;
#pragma unroll 16
            for (int d = 0; d < 64; ++d) s += qs[n * 65 + d] * ks[m * 65 + d];
            float w = 0.f; if (m <= n) w += pf[n - m]; if (m >= n) w += pb[m - n];
            s *= w;
#pragma unroll
            for (int j = 0; j < 16; ++j) y[j] += s * vs[m * 64 + e0 + j];
        }
        const float xf = pf[n + 1], xb = pb[128 - n];
        for (int d = 0; d < 64; ++d) { const float qv = qs[n * 65 + d], qf = qv * xf, qb = qv * xb;
#pragma unroll
            for (int j = 0; j < 16; ++j) y[j] += qf * sf[d * 64 + e0 + j] + qb * sb[d * 64 + e0 + j]; }
        float ss = 0.f;
#pragma unroll
        for (int j = 0; j < 16; ++j) ss += y[j] * y[j];
        ss += __shfl_xor(ss, 1); ss += __shfl_xor(ss, 2);
        const float rn = rsqrtf(ss * (1.0f / 64.0f) + 1e-6f);
#pragma unroll
        for (int j = 0; j < 16; ++j) { const int c = h * 64 + e0 + j; const float g = bf2f(P[(size_t)(rb + n) * DIN + C_RG + c]);
            O[(size_t)(rb + n) * DM + 256 + c] = f2bf(y[j] * rn * p.ret_gn[l * 256 + c] * siluf_(g)); }
    }
}

__device__ __forceinline__ void load_row64(const bf16_t* src, float* dst) {
#pragma unroll
    for (int i = 0; i < 8; ++i) { const uint4 w = *(const uint4*)(src + i * 8);
        dst[i * 8 + 0] = __uint_as_float(w.x << 16); dst[i * 8 + 1] = __uint_as_float(w.x & 0xffff0000u); dst[i * 8 + 2] = __uint_as_float(w.y << 16); dst[i * 8 + 3] = __uint_as_float(w.y & 0xffff0000u);
        dst[i * 8 + 4] = __uint_as_float(w.z << 16); dst[i * 8 + 5] = __uint_as_float(w.z & 0xffff0000u); dst[i * 8 + 6] = __uint_as_float(w.w << 16); dst[i * 8 + 7] = __uint_as_float(w.w & 0xffff0000u); }
}
__device__ __forceinline__ void load_row32(const bf16_t* src, float* dst) {
#pragma unroll
    for (int i = 0; i < 4; ++i) { const uint4 w = *(const uint4*)(src + i * 8);
        dst[i * 8 + 0] = __uint_as_float(w.x << 16); dst[i * 8 + 1] = __uint_as_float(w.x & 0xffff0000u); dst[i * 8 + 2] = __uint_as_float(w.y << 16); dst[i * 8 + 3] = __uint_as_float(w.y & 0xffff0000u);
        dst[i * 8 + 4] = __uint_as_float(w.z << 16); dst[i * 8 + 5] = __uint_as_float(w.z & 0xffff0000u); dst[i * 8 + 6] = __uint_as_float(w.w << 16); dst[i * 8 + 7] = __uint_as_float(w.w & 0xffff0000u); }
}
#define BFLO(w) __uint_as_float((w) << 16)
#define BFHI(w) __uint_as_float((w) & 0xffff0000u)
template <int N8> __device__ __forceinline__ float dot_row(const bf16_t* src, const float* q) {
    float s = 0.f;
#pragma unroll
    for (int i = 0; i < N8; ++i) { const uint4 w = *(const uint4*)(src + i * 8);
        s += q[i * 8 + 0] * BFLO(w.x) + q[i * 8 + 1] * BFHI(w.x) + q[i * 8 + 2] * BFLO(w.y) + q[i * 8 + 3] * BFHI(w.y) + q[i * 8 + 4] * BFLO(w.z) + q[i * 8 + 5] * BFHI(w.z) + q[i * 8 + 6] * BFLO(w.w) + q[i * 8 + 7] * BFHI(w.w); }
    return s;
}
template <int N8> __device__ __forceinline__ void axpy_row(const bf16_t* src, float pe, float* o) {
#pragma unroll
    for (int i = 0; i < N8; ++i) { const uint4 w = *(const uint4*)(src + i * 8);
        o[i * 8 + 0] += pe * BFLO(w.x); o[i * 8 + 1] += pe * BFHI(w.x); o[i * 8 + 2] += pe * BFLO(w.y); o[i * 8 + 3] += pe * BFHI(w.y);
        o[i * 8 + 4] += pe * BFLO(w.z); o[i * 8 + 5] += pe * BFHI(w.z); o[i * 8 + 6] += pe * BFLO(w.w); o[i * 8 + 7] += pe * BFHI(w.w); }
}
__device__ __forceinline__ void ph_swa(const Params& p, int l, bool need_ctx, int bid, int nb) {
    char* ws = p.ws; const int t = threadIdx.x, hf = t & 1, qi = (t >> 1) & 63, h = t >> 7, g = h >> 1;
    const bf16_t* P = (const bf16_t*)(ws + OFF_P); bf16_t* O = (bf16_t*)(ws + OFF_ACT);
    const int nun = 2 * 256 + (need_ctx ? 8 : 0);
    for (int u = bid; u < nun; u += nb) {
        const bool isctx = u >= 512; int b, qpos, row, k_lo, k_hi;
        if (!isctx) { b = u >> 8; const int q0 = (u & 255) * 64; qpos = q0 + qi; row = b * NSEQ + qpos; const int blk = (q0 >> 7) * 128; k_lo = blk - 128 < 0 ? 0 : blk - 128; k_hi = blk + 256 > NSEQ ? NSEQ : blk + 256; }
        else { const int v = u - 512; b = v >> 2; qpos = (v & 3) * 64 + qi; row = NLAT + b * NCTX + qpos; k_lo = 0; k_hi = 0; }
        float q[32], o[32];
        load_row32(P + (size_t)row * DIN + C_AQ + h * 64 + hf * 32, q);
#pragma unroll
        for (int d = 0; d < 32; ++d) o[d] = 0.f;
        float m = p.sink[l * 4 + h], lsum = 1.0f;
        const int nwin = k_hi - k_lo, ntot = nwin + NCTX;
#pragma unroll 1
        for (int kk = 0; kk < ntot; ++kk) {
            const bool win = kk < nwin; const int kpos = k_lo + kk;
            const int krow = win ? b * NSEQ + kpos : NLAT + b * NCTX + (kk - nwin);
            const bool valid = win ? (abs(qpos - kpos) <= 128) : true;
            float s = dot_row<4>(P + (size_t)krow * DIN + C_AK + g * 64 + hf * 32, q);
            s += __shfl_xor(s, 1);
            if (valid) {
                if (s > m) { const float cr = __expf(m - s); lsum *= cr;
#pragma unroll
                    for (int d = 0; d < 32; ++d) o[d] *= cr;
                    m = s; }
                const float pe = __expf(s - m); lsum += pe;
                axpy_row<4>(P + (size_t)krow * DIN + C_AV + g * 64 + hf * 32, pe, o);
            }
        }
        const float inv = 1.0f / lsum;
        bf16_t* op = O + (size_t)row * DM + h * 64 + hf * 32;
#pragma unroll
        for (int d = 0; d < 32; d += 2) *(unsigned*)(op + d) = pack2(o[d] * inv, o[d + 1] * inv);
    }
}

__device__ __forceinline__ float diff_lambda_val(const Params& p, int l, float lam_init) {
    const float* lv = p.diff_lam + l * 128; float s1 = 0.f, s2 = 0.f;
    for (int i = 0; i < 32; ++i) { s1 += lv[i] * lv[32 + i]; s2 += lv[64 + i] * lv[96 + i]; }
    return expf(s1) - expf(s2) + lam_init;
}
__device__ __forceinline__ void ph_diff(const Params& p, int l, bool need_ctx, float lam_init, int bid, int nb) {
    char* ws = p.ws; const int t = threadIdx.x, mp = t & 1, qi = (t >> 1) & 63, h = t >> 7;
    const bf16_t* P = (const bf16_t*)(ws + OFF_P); bf16_t* O = (bf16_t*)(ws + OFF_ACT);
    const float lam = diff_lambda_val(p, l, lam_init);
    const int nun = 512 + (need_ctx ? 8 : 0);
    for (int u = bid; u < nun; u += nb) {
        const bool isctx = u >= 512; int b, row, nlat;
        if (!isctx) { b = u >> 8; row = b * NSEQ + (u & 255) * 64 + qi; nlat = NSEQ; }
        else { const int v = u - 512; b = v >> 2; row = NLAT + b * NCTX + (v & 3) * 64 + qi; nlat = 0; }
        float q[32], o[64];
        load_row32(P + (size_t)row * DIN + C_DQ + h * 64 + mp * 32, q);
#pragma unroll
        for (int d = 0; d < 64; ++d) o[d] = 0.f;
        float m = -1.0e30f, lsum = 0.f;
        const int ntot = nlat + NCTX;
#pragma unroll 1
        for (int kk = 0; kk < ntot; ++kk) {
            const int krow = kk < nlat ? b * NSEQ + kk : NLAT + b * NCTX + (kk - nlat);
            const float s = dot_row<4>(P + (size_t)krow * DIN + C_DK + h * 64 + mp * 32, q);
            if (s > m) { const float cr = __expf(m - s); lsum *= cr;
#pragma unroll
                for (int d = 0; d < 64; ++d) o[d] *= cr;
                m = s; }
            const float pe = __expf(s - m); lsum += pe;
            axpy_row<8>(P + (size_t)krow * DIN + C_DV + h * 64, pe, o);
        }
        const float inv = 1.0f / lsum; float ss = 0.f;
#pragma unroll
        for (int d = 0; d < 64; ++d) { const float mine = o[d] * inv, other = __shfl_xor(mine, 1); o[d] = mine - lam * other; ss += o[d] * o[d]; }
        const float rn = rsqrtf(ss * (1.0f / 64.0f) + 1e-6f) * (1.0f - lam_init);
        if (mp == 0) { bf16_t* op = O + (size_t)row * DM + 512 + h * 64;
#pragma unroll
            for (int d = 0; d < 64; d += 2) *(unsigned*)(op + d) = pack2(o[d] * rn * p.diff_gn[l * 256 + h * 64 + d], o[d + 1] * rn * p.diff_gn[l * 256 + h * 64 + d + 1]); }
    }
}

__device__ __forceinline__ void moe_offsets(const Params& p, int* offs  ) {
    if (threadIdx.x < 2) { const unsigned* cw = (const unsigned*)p.ws + CW_CNT + threadIdx.x * 8; int o = 0;
        for (int e = 0; e < 8; ++e) { offs[threadIdx.x * 9 + e] = o; o += ((int)__hip_atomic_load(cw + e, __ATOMIC_RELAXED, __HIP_MEMORY_SCOPE_AGENT) + 255) & ~255; }
        offs[threadIdx.x * 9 + 8] = o; }
    __syncthreads();
}
__device__ __forceinline__ void ph_moe_scatter(const Params& p, int bid, int nb, float* lds) {
    char* ws = p.ws; int* offs = (int*)lds; moe_offsets(p, offs);
    const int lane = threadIdx.x & 63, wv = threadIdx.x >> 6;
    const bf16_t* H = (const bf16_t*)(ws + OFF_ACT); bf16_t* AS = (bf16_t*)(ws + OFF_ASORT);
    int* tok = (int*)(ws + OFF_TOK); float* wgt = (float*)(ws + OFF_WGT); unsigned* cw = (unsigned*)ws;
    for (int r = bid * 8 + wv; r < NLAT; r += nb * 8) {
        const int4 rec = *(const int4*)(ws + OFF_ROUTE + (size_t)r * 16);
        for (int g = 0; g < 2; ++g) {
            const int e = g == 0 ? rec.x : rec.y; int pos = 0;
            if (lane == 0) { pos = offs[g * 9 + e] + (int)atomicAdd(cw + CW_CUR + g * 8 + e, 1u); tok[g * GRP_ROWS + pos] = r; wgt[g * GRP_ROWS + pos] = __int_as_float(g == 0 ? rec.z : rec.w); }
            pos = __shfl(pos, 0);
            const uint4* src = (const uint4*)(H + (size_t)r * DM); uint4* dst = (uint4*)(AS + ((size_t)g * GRP_ROWS + pos) * DM);
            dst[lane] = src[lane]; dst[64 + lane] = src[64 + lane];
        }
    }
}

__device__ __forceinline__ void ph_final(const Params& p, int bid, int nb) {
    const int lane = threadIdx.x & 63, wv = threadIdx.x >> 6;
    for (int r = bid * 8 + wv; r < NLAT; r += nb * 8) {
        float* xr = p.out + (size_t)r * DM; float4 v[4]; float ss = 0.f;
#pragma unroll
        for (int i = 0; i < 4; ++i) { v[i] = *(const float4*)(xr + i * 256 + lane * 4); ss += v[i].x * v[i].x + v[i].y * v[i].y + v[i].z * v[i].z + v[i].w * v[i].w; }
        ss = wave_sum(ss); const float rn = rsqrtf(ss * (1.0f / 1024.0f) + 1e-6f);
#pragma unroll
        for (int i = 0; i < 4; ++i) { const float4 g = *(const float4*)(p.final_norm + i * 256 + lane * 4);
            float4 o; o.x = v[i].x * rn * g.x; o.y = v[i].y * rn * g.y; o.z = v[i].z * rn * g.z; o.w = v[i].w * rn * g.w; *(float4*)(xr + i * 256 + lane * 4) = o; }
    }
}

typedef unsigned u32x4 __attribute__((ext_vector_type(4)));
__device__ __forceinline__ float fast_silu(float v) { return v * __builtin_amdgcn_rcpf(1.0f + __expf(-v)); }
struct EpiStoreBf16 {
    static constexpr bool PERM = true, AFTER_DRAIN = false; bf16_t* O; int ldc;
    __device__ __forceinline__ void operator()(const f32x4 (&acc)[2][2][4][2], const pg8::Unit& u, int wr, int wc, int fr, int fq) const {
        bf16_t* base = O + (size_t)(u.pm * 256 + wr * 64 + fr) * ldc + u.pn * 256 + wc * 32 + 8 * fq;
#pragma unroll
        for (int ai = 0; ai < 2; ++ai)
#pragma unroll
            for (int m = 0; m < 4; ++m) { bf16_t* rowp = base + (size_t)(ai * 128 + m * 16) * ldc;
#pragma unroll
                for (int bj = 0; bj < 2; ++bj) { const f32x4 v0 = acc[ai][bj][m][0], v1 = acc[ai][bj][m][1]; u32x4 w;
                    w.x = pg8::cvt_pk_bf16(v0[0], v0[1]); w.y = pg8::cvt_pk_bf16(v0[2], v0[3]); w.z = pg8::cvt_pk_bf16(v1[0], v1[1]); w.w = pg8::cvt_pk_bf16(v1[2], v1[3]);
                    *(u32x4*)(rowp + bj * 128) = w; } }
    }
};
struct EpiSwiglu {
    static constexpr bool PERM = true, AFTER_DRAIN = false; bf16_t* U; int ldu, npe;
    __device__ __forceinline__ void operator()(const f32x4 (&acc)[2][2][4][2], const pg8::Unit& u, int wr, int wc, int fr, int fq) const {
        bf16_t* base = U + (size_t)(u.pm * 256 + wr * 64 + fr) * ldu + (u.pn % npe) * 128 + wc * 32 + 8 * fq;
#pragma unroll
        for (int ai = 0; ai < 2; ++ai)
#pragma unroll
            for (int m = 0; m < 4; ++m) { float o[8];
#pragma unroll
                for (int n = 0; n < 2; ++n)
#pragma unroll
                    for (int i = 0; i < 4; ++i) o[n * 4 + i] = fast_silu(acc[ai][0][m][n][i]) * acc[ai][1][m][n][i];
                u32x4 w; w.x = pg8::cvt_pk_bf16(o[0], o[1]); w.y = pg8::cvt_pk_bf16(o[2], o[3]); w.z = pg8::cvt_pk_bf16(o[4], o[5]); w.w = pg8::cvt_pk_bf16(o[6], o[7]);
                *(u32x4*)(base + (size_t)(ai * 128 + m * 16) * ldu) = w; }
    }
};
struct EpiResidual {
    static constexpr bool PERM = false, AFTER_DRAIN = false; const float* xin; float* xout; float* xc; const float* gate;
    __device__ __forceinline__ void operator()(const f32x4 (&acc)[2][2][4][2], const pg8::Unit& u, int wr, int wc, int fr, int fq) const {
        const int cls = u.pm < 64 ? 0 : (u.pm < 128 ? 1 : 2), col0 = u.pn * 256 + wc * 32 + 4 * fq;
        const float* gv = gate + (size_t)cls * 6144 + col0;
        const float* bi = u.pm < 128 ? xin + (size_t)u.pm * 256 * DM : xc + (size_t)(u.pm - 128) * 256 * DM;
        float* bo = u.pm < 128 ? xout + (size_t)u.pm * 256 * DM : xc + (size_t)(u.pm - 128) * 256 * DM;
        f32x4 g4[2][2];
#pragma unroll
        for (int bj = 0; bj < 2; ++bj)
#pragma unroll
            for (int n = 0; n < 2; ++n) g4[bj][n] = *(const f32x4*)(gv + bj * 128 + n * 16);
#pragma unroll
        for (int ai = 0; ai < 2; ++ai)
#pragma unroll
            for (int m = 0; m < 4; ++m) { const size_t off = (size_t)(ai * 128 + wr * 64 + m * 16 + fr) * DM + col0;
#pragma unroll
                for (int bj = 0; bj < 2; ++bj)
#pragma unroll
                    for (int n = 0; n < 2; ++n) { const f32x4 xi = *(const f32x4*)(bi + off + bj * 128 + n * 16); *(f32x4*)(bo + off + bj * 128 + n * 16) = xi + g4[bj][n] * acc[ai][bj][m][n]; } }
    }
};
struct EpiMoeScatter {
    static constexpr bool PERM = false, AFTER_DRAIN = false; float* x; const float* gate; const int* tok; const float* wgt; int npe;
    __device__ __forceinline__ void operator()(const f32x4 (&acc)[2][2][4][2], const pg8::Unit& u, int wr, int wc, int fr, int fq) const {
        const int col0 = (u.pn % npe) * 256 + wc * 32 + 4 * fq;
#pragma unroll
        for (int ai = 0; ai < 2; ++ai)
#pragma unroll
            for (int m = 0; m < 4; ++m) { const int r = u.pm * 256 + ai * 128 + wr * 64 + m * 16 + fr; const int tk = tok[r];
                if (tk >= 0) { const float wv = wgt[r]; const float* gv = gate + (size_t)mod_class(tk) * 6144 + col0; float* xr = x + (size_t)tk * DM + col0;
#pragma unroll
                    for (int bj = 0; bj < 2; ++bj)
#pragma unroll
                        for (int n = 0; n < 2; ++n) { const f32x4 g4 = *(const f32x4*)(gv + bj * 128 + n * 16); f32x4* q = (f32x4*)(xr + bj * 128 + n * 16); *q = *q + g4 * wv * acc[ai][bj][m][n]; } } }
    }
};
struct MoeOrder : pg8::StaticOrder {
    int o1, o2, o3, o4, o5, o6, o7, npe;
    __device__ __forceinline__ bool next(int i, pg8::Unit& u) const {
        if (!pg8::StaticOrder::next(i, u)) return false;
        const int r = u.pm * 256; const int e = (r >= o1) + (r >= o2) + (r >= o3) + (r >= o4) + (r >= o5) + (r >= o6) + (r >= o7);
        u.pn += e * npe; return true;
    }
};
#define GEMM_LDS ((PG8_LAS unsigned char*)lds)
__device__ __forceinline__ void ph_gemm_in(const Params& p, int l, int bid, int nb, float* lds) {
    char* ws = p.ws; pg8::Gemm g{(const bf16_t*)(ws + OFF_ACT), (const bf16_t*)(ws + OFF_WIN) + (size_t)l * DIN * DM, NROW, DIN, DM};
    pg8::StaticOrder S; S.init(NROW, DIN, nb, bid);
    EpiStoreBf16 E{(bf16_t*)(ws + OFF_P), DIN};
    pg8::gemm_phase<EpiStoreBf16, pg8::StaticOrder, true, true>(GEMM_LDS, g, S, E);
}
__device__ __forceinline__ void ph_gemm_out(const Params& p, int l, bool need_ctx, int bid, int nb, float* lds) {
    char* ws = p.ws; const int M = need_ctx ? NROW : NLAT;
    pg8::Gemm g{(const bf16_t*)(ws + OFF_ACT), (const bf16_t*)(ws + OFF_WOUT) + (size_t)l * DM * DM, M, DM, DM};
    pg8::StaticOrder S; S.init(M, DM, nb, bid);
    EpiResidual E{l == 0 ? p.x : p.out, p.out, (float*)(ws + OFF_XC), (const float*)(ws + OFF_MOD) + (size_t)l * 3 * 6144 + 2048};
    pg8::gemm_phase<EpiResidual, pg8::StaticOrder, true, true>(GEMM_LDS, g, S, E);
}
__device__ __forceinline__ void ph_ffn1(const Params& p, bool need_ctx, int bid, int nb, float* lds) {
    char* ws = p.ws; const int M = need_ctx ? NROW : NLAT;
    pg8::Gemm g{(const bf16_t*)(ws + OFF_ACT), (const bf16_t*)(ws + OFF_WF13), M, 2 * DFF, DM};
    pg8::StaticOrder S; S.init(M, 2 * DFF, nb, bid);
    EpiSwiglu E{(bf16_t*)(ws + OFF_P), DFF, 2 * DFF / 256};
    pg8::gemm_phase<EpiSwiglu, pg8::StaticOrder, true, true>(GEMM_LDS, g, S, E);
}
__device__ __forceinline__ void ph_ffn2(const Params& p, int l, bool need_ctx, int bid, int nb, float* lds) {
    char* ws = p.ws; const int M = need_ctx ? NROW : NLAT;
    pg8::Gemm g{(const bf16_t*)(ws + OFF_P), (const bf16_t*)(ws + OFF_WF2), M, DM, DFF};
    pg8::StaticOrder S; S.init(M, DM, nb, bid);
    EpiResidual E{p.out, p.out, (float*)(ws + OFF_XC), (const float*)(ws + OFF_MOD) + (size_t)l * 3 * 6144 + 5120};
    pg8::gemm_phase<EpiResidual, pg8::StaticOrder, true, true>(GEMM_LDS, g, S, E);
}
__device__ __forceinline__ MoeOrder moe_order(const int* og, int npe, int nb, int bid) {
    MoeOrder S; S.init(og[8], npe * 256, nb, bid); S.o1 = og[1]; S.o2 = og[2]; S.o3 = og[3]; S.o4 = og[4]; S.o5 = og[5]; S.o6 = og[6]; S.o7 = og[7]; S.npe = npe; return S;
}
__device__ __forceinline__ void ph_moe1(const Params& p, int g, int bid, int nb, float* lds) {
    char* ws = p.ws; int* offs = (int*)(lds + 32768); __syncthreads(); moe_offsets(p, offs);
    const MoeOrder S = moe_order(offs + g * 9, 2 * DFE / 256, nb, bid);
    pg8::Gemm gm{(const bf16_t*)(ws + OFF_ASORT) + (size_t)g * GRP_ROWS * DM, (const bf16_t*)(ws + OFF_WM13), 0, 0, DM};
    EpiSwiglu E{(bf16_t*)(ws + OFF_UMOE), DFE, 2 * DFE / 256};
    pg8::gemm_phase<EpiSwiglu, MoeOrder, true, true>(GEMM_LDS, gm, S, E);
}
__device__ __forceinline__ void ph_moe2(const Params& p, int l, int g, int bid, int nb, float* lds) {
    char* ws = p.ws; int* offs = (int*)(lds + 32768); __syncthreads(); moe_offsets(p, offs);
    const MoeOrder S = moe_order(offs + g * 9, DM / 256, nb, bid);
    pg8::Gemm gm{(const bf16_t*)(ws + OFF_UMOE), (const bf16_t*)(ws + OFF_WM2), 0, 0, DFE};
    EpiMoeScatter E{p.out, (const float*)(ws + OFF_MOD) + (size_t)l * 3 * 6144 + 5120, (const int*)(ws + OFF_TOK) + g * GRP_ROWS, (const float*)(ws + OFF_WGT) + g * GRP_ROWS, DM / 256};
    pg8::gemm_phase<EpiMoeScatter, MoeOrder, true, true>(GEMM_LDS, gm, S, E);
}

#define XB_TMO      128
#define XB_XCNT(j)  (256  + 64 * (j))
#define XB_XSUB(j)  (1280 + 64 * (j))
#define XB_XGEN(j)  (2304 + 64 * (j))
#define XB_TOP      3328
#define XB_TOPGEN   3392
#define XCD_BAR_WORDS 3456
#define XB_SPIN_CAP (1u << 22)
#define LAS __attribute__((address_space(3)))

__device__ __forceinline__ unsigned xb_ld(unsigned* p)              { return __hip_atomic_load(p, __ATOMIC_RELAXED, __HIP_MEMORY_SCOPE_AGENT); }
__device__ __forceinline__ unsigned xb_add(unsigned* p, unsigned v) { return __hip_atomic_fetch_add(p, v, __ATOMIC_RELAXED, __HIP_MEMORY_SCOPE_AGENT); }
__device__ __forceinline__ unsigned xb_xcc_id() { return (unsigned)__builtin_amdgcn_s_getreg((3 << 11) | 20) & 0xFu; }
#define XB_SPIN(cond, bar) do { unsigned _sp = 0; while (cond) { __builtin_amdgcn_s_sleep(1); \
    if ((++_sp & 255u) == 0u) { if (xb_ld(&(bar)[XB_TMO])) break; if (_sp > XB_SPIN_CAP) { atomicAdd(&(bar)[XB_TMO], 1u); break; } } } } while (0)

struct XcdBarrier {
    unsigned* bar; unsigned x;
    volatile LAS unsigned* st;
};

__device__ __forceinline__ XcdBarrier xcd_barrier_post(unsigned* bar, volatile LAS unsigned* st) {
    XcdBarrier b; b.bar = bar; b.x = xb_xcc_id(); b.st = st;
    if (threadIdx.x == 0) (void)xb_add(&bar[XB_XCNT(b.x)], 1u);
    return b;
}
__device__ __forceinline__ void xcd_barrier_complete(unsigned* bar, unsigned x, unsigned& nloc, unsigned& nx) {
    const unsigned G = gridDim.x * gridDim.y * gridDim.z;
    unsigned sum, cnt, mine, sp = 0u;
    for (;;) {
        sum = 0u; cnt = 0u; mine = 0u;
#pragma unroll
        for (unsigned j = 0; j < 16; ++j) { const unsigned c = xb_ld(&bar[XB_XCNT(j)]); sum += c; cnt += (c > 0u) ? 1u : 0u; mine = (j == x) ? c : mine; }
        if (sum == G) break;
        __builtin_amdgcn_s_sleep(1);
        if ((++sp & 255u) == 0u) { if (xb_ld(&bar[XB_TMO])) break; if (sp > XB_SPIN_CAP) { atomicAdd(&bar[XB_TMO], 1u); break; } }
    }
    nloc = mine > 0u ? mine : 1u; nx = cnt > 0u ? cnt : 1u;
}

__device__ __forceinline__ void xcd_barrier(const XcdBarrier& b) {
    asm volatile("s_waitcnt vmcnt(0)" ::: "memory");
    __syncthreads();
    if (threadIdx.x == 0) {
        unsigned* bar = b.bar;
        __builtin_amdgcn_s_waitcnt(0);
        unsigned nloc = b.st[0], nx = b.st[1];
        if (nloc == 0u) { xcd_barrier_complete(bar, b.x, nloc, nx); b.st[0] = nloc; b.st[1] = nx; }
        const unsigned old = xb_add(&bar[XB_XSUB(b.x)], 1u);
        const unsigned gen = old / nloc;
        if (old + 1u == (gen + 1u) * nloc) {
            __builtin_amdgcn_fence(__ATOMIC_RELEASE, "agent");
            asm volatile("s_waitcnt vmcnt(0)" ::: "memory");
            const unsigned og = xb_add(&bar[XB_TOP], 1u);
            const unsigned tg = og / nx;
            if (og + 1u == (tg + 1u) * nx) xb_add(&bar[XB_TOPGEN], 1u);
            else XB_SPIN(xb_ld(&bar[XB_TOPGEN]) == tg, bar);
            __builtin_amdgcn_fence(__ATOMIC_ACQUIRE, "agent");
            xb_add(&bar[XB_XGEN(b.x)], 1u);
            asm volatile("s_waitcnt vmcnt(0)" ::: "memory");
        } else {
            XB_SPIN(xb_ld(&bar[XB_XGEN(b.x)]) == gen, bar);
            __builtin_amdgcn_fence(__ATOMIC_ACQUIRE, "agent");
            asm volatile("s_waitcnt vmcnt(0)" ::: "memory");
        }
    }
    __syncthreads();
}


constexpr int LDS_FLOATS = 33792;
constexpr int LDS_BYTES = LDS_FLOATS * 4 + 16 + 256;

typedef const __attribute__((address_space(4))) unsigned long long* kargp_t;
typedef __attribute__((address_space(1))) const float* gcf_t;
__device__ __forceinline__ Params load_params(const float* lds) {
    const LAS unsigned* tbl = (const LAS unsigned*)(lds + LDS_FLOATS + 4);
    Params p; const float** f = (const float**)&p;
#pragma unroll
    for (int i = 0; i < (int)(sizeof(Params) / 8); ++i) {
        const unsigned lo = __builtin_amdgcn_readfirstlane(tbl[2 * i]), hi = __builtin_amdgcn_readfirstlane(tbl[2 * i + 1]);
        f[i] = (const float*)(gcf_t)(((unsigned long long)hi << 32) | lo); }
    return p;
}
#define LOADP(name) const Params name = load_params(lds)

template <int l>
__device__ __forceinline__ void run_layer(const XcdBarrier& bar, int bid, int nb, float* lds) {
    constexpr bool need_ctx = l == 0;
    constexpr float lam_init = l == 0 ? 0.2f : 0.35550906759509393f;
    { LOADP(p); ph_norm<false>(p, l, 0, NROW, bid, nb); } xcd_barrier(bar);
    { LOADP(p); ph_gemm_in(p, l, bid, nb, lds); } xcd_barrier(bar);
    { LOADP(p); ph_rope(p, bid, nb); } xcd_barrier(bar);
    { LOADP(p); ph_ret_summ(p, l, bid, nb, lds); } { LOADP(p); ph_lru_chunk<1>(p, l, bid, nb, lds, 0); } xcd_barrier(bar);
    { LOADP(p); ph_scan2(p, l, bid, nb); } xcd_barrier(bar);
    { LOADP(p); ph_diff(p, l, need_ctx, lam_init, bid, nb); }
    { LOADP(p); ph_swa(p, l, need_ctx, bid, nb); }
    { LOADP(p); ph_ret_out(p, l, bid, nb, lds, need_ctx ? 0 : 2); }
    { LOADP(p); ph_lru_chunk<3>(p, l, bid, nb, lds, need_ctx ? 0 : 2); } xcd_barrier(bar);
    { LOADP(p); ph_gemm_out(p, l, need_ctx, bid, nb, lds); } xcd_barrier(bar);
    if (l == 0) {
        { LOADP(p); ph_norm<false>(p, l, 1, NROW, bid, nb); } xcd_barrier(bar);
        { LOADP(p); ph_ffn1(p, need_ctx, bid, nb, lds); } xcd_barrier(bar);
        { LOADP(p); ph_ffn2(p, l, need_ctx, bid, nb, lds); } xcd_barrier(bar);
    } else {
        { LOADP(p); ph_norm<true>(p, l, 1, NLAT, bid, nb); } xcd_barrier(bar);
        { LOADP(p); ph_moe_scatter(p, bid, nb, lds); } xcd_barrier(bar);
        { LOADP(p); ph_moe1(p, 0, bid, nb, lds); } xcd_barrier(bar);
        { LOADP(p); ph_moe2(p, l, 0, bid, nb, lds); } xcd_barrier(bar);
        { LOADP(p); ph_moe1(p, 1, bid, nb, lds); } xcd_barrier(bar);
        { LOADP(p); ph_moe2(p, l, 1, bid, nb, lds); } xcd_barrier(bar);
    }
}

__global__ void __launch_bounds__(512, 2) fwd(Params p_in) {
    extern __shared__ __attribute__((aligned(16))) float lds[];
    volatile LAS unsigned* st = (volatile LAS unsigned*)(lds + LDS_FLOATS);
    if (threadIdx.x == 0) { st[0] = 0u; st[1] = 0u; st[2] = 0u; st[3] = 0u; }
    if (threadIdx.x < (int)(sizeof(Params) / 8)) { const kargp_t q = (kargp_t)__builtin_amdgcn_kernarg_segment_ptr(); ((LAS unsigned long long*)(lds + LDS_FLOATS + 4))[threadIdx.x] = q[threadIdx.x]; }
    __syncthreads();
    XcdBarrier bar;
    { LOADP(p); bar = xcd_barrier_post((unsigned*)p.ws, st); }
    const int bid = blockIdx.x, nb = gridDim.x;
    { LOADP(p); ph_prologue(p, bid, nb, lds); } xcd_barrier(bar);
    run_layer<0>(bar, bid, nb, lds);
    run_layer<1>(bar, bid, nb, lds);
    { LOADP(p); ph_final(p, bid, nb); }
}

extern "C" void kernel_launch(void* const* d_in, const int* in_sizes, int n_in, void* d_out, int out_size, void* d_ws, size_t ws_size, hipStream_t stream) {
    static int grid = 0;
    if (grid == 0) {
        if (n_in < 30 || ws_size < WS_NEED) { fprintf(stderr, "kernel_launch: bad args n_in=%d ws=%zu need=%zu\n", n_in, ws_size, (size_t)WS_NEED); grid = -1; return; }
        int dev = 0, cus = 0, per_cu = 0;
        if (hipGetDevice(&dev) != hipSuccess || hipDeviceGetAttribute(&cus, hipDeviceAttributeMultiprocessorCount, dev) != hipSuccess) { grid = -1; return; }
        if (hipFuncSetAttribute((const void*)fwd, hipFuncAttributeMaxDynamicSharedMemorySize, LDS_BYTES) != hipSuccess) { fprintf(stderr, "kernel_launch: hipFuncSetAttribute failed\n"); grid = -1; return; }
        if (hipOccupancyMaxActiveBlocksPerMultiprocessor(&per_cu, (const void*)fwd, 512, LDS_BYTES) != hipSuccess || per_cu < 1) { fprintf(stderr, "kernel_launch: occupancy query says %d\n", per_cu); per_cu = 1; }
        (void)hipGetLastError();
        grid = cus;
    }
    if (grid < 0) return;
    Params p{};
    const float** f = (const float**)&p;
    for (int i = 0; i < 30; ++i) f[i] = (const float*)d_in[i];
    p.out = (float*)d_out; p.ws = (char*)d_ws;
    (void)hipMemsetAsync(d_ws, 0, 65536, stream);
    hipLaunchKernelGGL(fwd, dim3(grid), dim3(512), LDS_BYTES, stream, p);
}
```

```cpp
#include <hip/hip_runtime.h>
#include <cstdio>
#include <cstdint>

typedef unsigned short bf16_t;
typedef short bf16x8 __attribute__((ext_vector_type(8)));
typedef float f32x4 __attribute__((ext_vector_type(4)));
typedef unsigned u32x4 __attribute__((ext_vector_type(4)));
#define LAS __attribute__((address_space(3)))

constexpr int NB = 2, NSEQ = 16384, NCTX = 256, DM = 1024;
constexpr int NLAT = NB * NSEQ;
constexpr int NCR = NB * NCTX;
constexpr int NROW = NLAT + NCR;
constexpr int DIN = 2816, DFF = 2816, DFE = 3584, NE = 8;
constexpr int NCI = 130;
constexpr int C_AQ = 0, C_AK = 256, C_AV = 384, C_RQ = 512, C_RK = 768, C_RV = 1024, C_RG = 1280, C_DQ = 1536, C_DK = 1792, C_DV = 2048, C_LX = 2304, C_LY = 2560;
constexpr int GRP_ROWS = 34816;

constexpr size_t al256(size_t x) { return (x + 255) & ~(size_t)255; }
constexpr size_t OFF_CTRL = 0;
constexpr size_t OFF_MOD = 65536;
constexpr size_t OFF_ROPE_RET = al256(OFF_MOD + 2 * 3 * 6144 * 4);
constexpr size_t OFF_ROPE_AX = al256(OFF_ROPE_RET + 2 * 16384 * 32 * 4);
constexpr size_t OFF_XC = al256(OFF_ROPE_AX + (2 * 256 * 16 + 2 * 64 * 16 + 2 * 256 * 8 + 2 * 64 * 8) * 4);
constexpr size_t OFF_ROUTE = al256(OFF_XC + (size_t)NCR * DM * 4);
constexpr size_t OFF_TOK = al256(OFF_ROUTE + (size_t)NLAT * 16);
constexpr size_t OFF_WGT = al256(OFF_TOK + (size_t)2 * GRP_ROWS * 4);
constexpr size_t OFF_LRU = al256(OFF_WGT + (size_t)2 * GRP_ROWS * 4);
constexpr size_t OFF_WM13 = al256(OFF_LRU + (size_t)3 * 2 * 2 * NCI * 256 * 4);
constexpr size_t OFF_WM2 = al256(OFF_WM13 + (size_t)NE * 2 * DFE * DM * 2);
constexpr size_t OFF_R = al256(OFF_WM2 + (size_t)NE * DM * DFE * 2);
constexpr size_t OFF_P = OFF_R;
constexpr size_t OFF_ACT = al256(OFF_P + (size_t)NROW * DIN * 2);
constexpr size_t OFF_RET = al256(OFF_ACT + (size_t)NROW * DM * 2);
constexpr size_t OFF_WIN = al256(OFF_RET + (size_t)2 * 2 * NCI * 4 * 4096 * 4);
constexpr size_t OFF_WOUT = al256(OFF_WIN + (size_t)2 * DIN * DM * 2);
constexpr size_t OFF_WF13 = al256(OFF_WOUT + (size_t)2 * DM * DM * 2);
constexpr size_t OFF_WF2 = al256(OFF_WF13 + (size_t)2 * DFF * DM * 2);
constexpr size_t OFF_R_END1 = al256(OFF_WF2 + (size_t)DM * DFF * 2);
constexpr size_t OFF_ASORT = OFF_R;
constexpr size_t OFF_UMOE = al256(OFF_ASORT + (size_t)2 * GRP_ROWS * DM * 2);
constexpr size_t OFF_R_END2 = al256(OFF_UMOE + (size_t)GRP_ROWS * DFE * 2);
constexpr size_t WS_NEED = OFF_R_END1 > OFF_R_END2 ? OFF_R_END1 : OFF_R_END2;
static_assert(OFF_ACT >= OFF_UMOE, "H2 must not overlap A_sorted");
constexpr int CW_CNT = 4096;
constexpr int CW_CUR = 4160;

struct Params {
    const float *x, *c, *ctx, *c_ctx, *w_ada, *b_ada, *g1, *g2, *w_in, *w_out, *sink, *ret_logit, *ret_gn, *diff_lam, *diff_gn,
        *conv_w, *conv_b, *lru_wa, *lru_ba, *lru_wx, *lru_bx, *lru_lam, *ffn_w1, *ffn_w3, *ffn_w2, *moe_router, *moe_w1, *moe_w3, *moe_w2, *final_norm;
    float* out; char* ws;
};

__device__ __forceinline__ int ltid_() { int t = threadIdx.x; asm volatile("" : "+v"(t)); return t; }
#define TIDX ltid_()
__device__ __forceinline__ float bf2f(bf16_t h) { return __uint_as_float(((unsigned)h) << 16); }
__device__ __forceinline__ bf16_t f2bf(float f) { unsigned u = __float_as_uint(f); u += 0x7fffu + ((u >> 16) & 1u); return (bf16_t)(u >> 16); }
__device__ __forceinline__ unsigned pack2(float lo, float hi) { return (unsigned)f2bf(lo) | ((unsigned)f2bf(hi) << 16); }
__device__ __forceinline__ float wave_sum(float v) {
#pragma unroll
    for (int o = 32; o >= 1; o >>= 1) v += __shfl_xor(v, o);
    return v;
}
__device__ __forceinline__ float sigmoidf_(float x) { return 1.0f / (1.0f + __expf(-x)); }
__device__ __forceinline__ float siluf_(float x) { return x / (1.0f + __expf(-x)); }
__device__ __forceinline__ float softplusf_(float x) { return x > 20.f ? x : log1pf(expf(x)); }
__device__ __forceinline__ float gelu_tanh(float x) { const float u = 0.7978845608028654f * (x + 0.044715f * x * x * x); return 0.5f * x * (1.0f + tanhf(u)); }
__device__ __forceinline__ int row_base(int b, int ci) { return ci < 2 ? NLAT + b * NCTX + ci * 128 : b * NSEQ + (ci - 2) * 128; }
__device__ __forceinline__ int mod_class(int row) { return row < NSEQ ? 0 : (row < NLAT ? 1 : 2); }

__device__ __forceinline__ void convert_tile(const float* src, int K, int N, bf16_t* dst, int tile, int mode, float* lds) {
    const int tpn = N / 64, tk = tile / tpn, tn = tile % tpn, t = TIDX;
    {   const int kk = t >> 3, nc = (t & 7) * 8;
        const float4 a = *(const float4*)(src + (size_t)(tk * 64 + kk) * N + tn * 64 + nc);
        const float4 b = *(const float4*)(src + (size_t)(tk * 64 + kk) * N + tn * 64 + nc + 4);
        float* d = lds + kk * 65 + nc; d[0] = a.x; d[1] = a.y; d[2] = a.z; d[3] = a.w; d[4] = b.x; d[5] = b.y; d[6] = b.z; d[7] = b.w; }
    __syncthreads();
    {   const int n = t >> 3, kc = (t & 7) * 8, ng = tn * 64 + n;
        const int nrow = mode == 0 ? ng : ((ng >> 7) * 256 + (mode == 2 ? 128 : 0) + (ng & 127));
        uint4 w; w.x = pack2(lds[(kc + 0) * 65 + n], lds[(kc + 1) * 65 + n]); w.y = pack2(lds[(kc + 2) * 65 + n], lds[(kc + 3) * 65 + n]);
        w.z = pack2(lds[(kc + 4) * 65 + n], lds[(kc + 5) * 65 + n]); w.w = pack2(lds[(kc + 6) * 65 + n], lds[(kc + 7) * 65 + n]);
        *(uint4*)(dst + (size_t)nrow * K + tk * 64 + kc) = w; }
    __syncthreads();
}

__device__ __forceinline__ void ph_prologue(const Params& p, int bid, int nb, float* lds) {
    char* ws = p.ws; const int t = TIDX;
    {
        struct Job { const float* src; bf16_t* dst; int K, N, mode, base; };
        Job* jobs = (Job*)(lds + 64 * 65 + 3);
        const int T_IN = 16 * 44, T_OUT = 16 * 16, T_F13 = 16 * 44, T_F2 = 44 * 16, T_M13 = 16 * 56, T_M2 = 56 * 16;
        const int total = 2 * T_IN + 2 * T_OUT + 2 * T_F13 + T_F2 + 16 * T_M13 + 8 * T_M2;
        if (t < 32) {
            Job jb; jb.src = nullptr; jb.dst = nullptr; jb.K = DM; jb.N = DM; jb.mode = 0; jb.base = total;
            if (t < 2) { jb.src = p.w_in + (size_t)t * DM * DIN; jb.dst = (bf16_t*)(ws + OFF_WIN) + (size_t)t * DIN * DM; jb.N = DIN; jb.base = t * T_IN; }
            else if (t < 4) { jb.src = p.w_out + (size_t)(t - 2) * DM * DM; jb.dst = (bf16_t*)(ws + OFF_WOUT) + (size_t)(t - 2) * DM * DM; jb.base = 2 * T_IN + (t - 2) * T_OUT; }
            else if (t < 6) { jb.src = t == 4 ? p.ffn_w1 : p.ffn_w3; jb.dst = (bf16_t*)(ws + OFF_WF13); jb.N = DFF; jb.mode = t - 3; jb.base = 2 * T_IN + 2 * T_OUT + (t - 4) * T_F13; }
            else if (t == 6) { jb.src = p.ffn_w2; jb.dst = (bf16_t*)(ws + OFF_WF2); jb.K = DFF; jb.base = 2 * T_IN + 2 * T_OUT + 2 * T_F13; }
            else if (t < 23) { const int q = t - 7, e = q & 7, w3 = q >> 3; jb.src = (w3 ? p.moe_w3 : p.moe_w1) + (size_t)e * DM * DFE; jb.dst = (bf16_t*)(ws + OFF_WM13) + (size_t)e * 2 * DFE * DM; jb.N = DFE; jb.mode = 1 + w3;
                jb.base = 2 * T_IN + 2 * T_OUT + 2 * T_F13 + T_F2 + q * T_M13; }
            else if (t < 31) { const int e = t - 23; jb.src = p.moe_w2 + (size_t)e * DFE * DM; jb.dst = (bf16_t*)(ws + OFF_WM2) + (size_t)e * DM * DFE; jb.K = DFE;
                jb.base = 2 * T_IN + 2 * T_OUT + 2 * T_F13 + T_F2 + 16 * T_M13 + e * T_M2; }
            jobs[t] = jb;
        }
        __syncthreads();
        int j = 0;
        for (int u = bid; u < total; u += nb) {
            while (u >= jobs[j + 1].base) ++j;
            const Job jb = jobs[j];
            convert_tile(jb.src, jb.K, jb.N, jb.dst, u - jb.base, jb.mode, lds);
        }
        __syncthreads();
    }
    {
        float* sv = lds;
        float* red = lds + 3072;
        for (int i = t; i < 3072; i += 512) { const int v = i >> 10, k = i & 1023; const float cv = v < 2 ? p.c[v * DM + k] : p.c_ctx[k]; sv[i] = siluf_(cv); }
        __syncthreads();
        float* mod = (float*)(ws + OFF_MOD);
        for (int u = bid; u < 2 * 96; u += nb) {
            const int l = u / 96, j0 = (u % 96) * 64, j = t & 63, kg = t >> 6;
            float a0 = 0.f, a1 = 0.f, a2 = 0.f;
            const float* w = p.w_ada + (size_t)l * DM * 6144 + j0 + j;
            for (int k = kg * 128; k < kg * 128 + 128; ++k) { const float wv = w[(size_t)k * 6144]; a0 += sv[k] * wv; a1 += sv[1024 + k] * wv; a2 += sv[2048 + k] * wv; }
            red[(kg * 3 + 0) * 64 + j] = a0; red[(kg * 3 + 1) * 64 + j] = a1; red[(kg * 3 + 2) * 64 + j] = a2;
            __syncthreads();
            if (t < 192) { const int v = t >> 6; float s = 0.f;
                for (int g = 0; g < 8; ++g) s += red[(g * 3 + v) * 64 + j];
                mod[((size_t)l * 3 + v) * 6144 + j0 + j] = s + p.b_ada[l * 6144 + j0 + j]; }
            __syncthreads();
        }
    }
    {
        float* rr = (float*)(ws + OFF_ROPE_RET);
        const int gt = bid * 512 + t, gs = nb * 512;
        for (int i = gt; i < 16384 * 32; i += gs) { const int n = i >> 5, j = i & 31;
            const float inv = (float)pow(10000.0, -(double)j / 32.0); const float ang = (float)n * inv;
            rr[i] = (float)cos((double)ang); rr[16384 * 32 + i] = (float)sin((double)ang); }
        float* ax = (float*)(ws + OFF_ROPE_AX);
        for (int i = gt; i < 256 * 16; i += gs) { const int n = i >> 4, j = i & 15; const float inv = (float)pow(10000.0, -(double)j / 16.0); const float ang = (float)n * inv;
            ax[i] = (float)cos((double)ang); ax[4096 + i] = (float)sin((double)ang);
            if (n < 64) { ax[8192 + i] = (float)cos((double)ang); ax[9216 + i] = (float)sin((double)ang); } }
        for (int i = gt; i < 256 * 8; i += gs) { const int n = i >> 3, j = i & 7; const float inv = (float)pow(10000.0, -(double)j / 8.0); const float ang = (float)n * inv;
            ax[10240 + i] = (float)cos((double)ang); ax[12288 + i] = (float)sin((double)ang);
            if (n < 64) { ax[14336 + i] = (float)cos((double)ang); ax[14848 + i] = (float)sin((double)ang); } }
        float* xc = (float*)(ws + OFF_XC);
        for (int i = gt; i < NCR * DM / 4; i += gs) ((float4*)xc)[i] = ((const float4*)p.ctx)[i];
        int* tok = (int*)(ws + OFF_TOK);
        for (int i = gt; i < 2 * GRP_ROWS; i += gs) tok[i] = -1;
    }
}

template <bool ROUTE>
__device__ __forceinline__ void ph_norm(const Params& p, int l, int which  , int nrows, int bid, int nb) {
    char* ws = p.ws; const int lane = TIDX & 63, wv = TIDX >> 6;
    const float* mod = (const float*)(ws + OFF_MOD) + (size_t)l * 3 * 6144;
    const float* g = (which == 0 ? p.g1 : p.g2) + l * DM;
    bf16_t* H = (bf16_t*)(ws + OFF_ACT);
    const float* xl = (which == 0 && l == 0) ? p.x : p.out;
    const float* xc = (const float*)(ws + OFF_XC);
    for (int r = bid * 8 + wv; r < nrows; r += nb * 8) {
        const float* xr = r < NLAT ? xl + (size_t)r * DM : xc + (size_t)(r - NLAT) * DM;
        const float* mv = mod + (size_t)mod_class(r) * 6144 + (which == 0 ? 0 : 3072);
        float4 v[4]; float ss = 0.f;
#pragma unroll
        for (int i = 0; i < 4; ++i) { v[i] = *(const float4*)(xr + i * 256 + lane * 4); ss += v[i].x * v[i].x + v[i].y * v[i].y + v[i].z * v[i].z + v[i].w * v[i].w; }
        ss = wave_sum(ss);
        const float rn = rsqrtf(ss * (1.0f / 1024.0f) + 1e-6f);
        float lg[8];
        if (ROUTE) {
#pragma unroll
            for (int e = 0; e < 8; ++e) lg[e] = 0.f;
        }
#pragma unroll
        for (int i = 0; i < 4; ++i) {
            const int c = i * 256 + lane * 4;
            const float4 gg = *(const float4*)(g + c), sh = *(const float4*)(mv + c), sc = *(const float4*)(mv + 1024 + c);
            float h0 = v[i].x * rn * gg.x * (1.f + sc.x) + sh.x, h1 = v[i].y * rn * gg.y * (1.f + sc.y) + sh.y;
            float h2 = v[i].z * rn * gg.z * (1.f + sc.z) + sh.z, h3 = v[i].w * rn * gg.w * (1.f + sc.w) + sh.w;
            uint2 w; w.x = pack2(h0, h1); w.y = pack2(h2, h3);
            *(uint2*)(H + (size_t)r * DM + c) = w;
            if (ROUTE) {
                const float* rt = p.moe_router + (size_t)c * 8;
#pragma unroll
                for (int e = 0; e < 8; ++e) lg[e] += h0 * rt[e] + h1 * rt[8 + e] + h2 * rt[16 + e] + h3 * rt[24 + e];
            }
        }
        if (ROUTE) {
#pragma unroll
            for (int e = 0; e < 8; ++e) lg[e] = wave_sum(lg[e]);
            if (lane == 0 && r < NLAT) {
                int e0 = 0; float v0 = lg[0];
#pragma unroll
                for (int e = 1; e < 8; ++e) if (lg[e] > v0) { v0 = lg[e]; e0 = e; }
                int e1 = -1; float v1 = -3.0e38f;
#pragma unroll
                for (int e = 0; e < 8; ++e) if (e != e0 && lg[e] > v1) { v1 = lg[e]; e1 = e; }
                const float ex = __expf(v1 - v0), w0 = 1.0f / (1.0f + ex), w1 = ex / (1.0f + ex);
                int4 rec; rec.x = e0; rec.y = e1; rec.z = __float_as_int(w0); rec.w = __float_as_int(w1);
                *(int4*)(ws + OFF_ROUTE + (size_t)r * 16) = rec;
                unsigned* cw = (unsigned*)ws;
                atomicAdd(cw + CW_CNT + e0, 1u); atomicAdd(cw + CW_CNT + 8 + e1, 1u);
            }
        }
    }
}

namespace pg8 {
#define PG8_LAS __attribute__((address_space(3)))
typedef unsigned short bf16_t;
typedef short bf16x8 __attribute__((ext_vector_type(8)));
typedef float f32x4 __attribute__((ext_vector_type(4)));
typedef unsigned u32x4 __attribute__((ext_vector_type(4)));
constexpr int BM = 256, BK = 64, HALF = 128, HTB = HALF * BK * 2  , STAGE_BYTES = 8 * HTB, NXCD = 8, WGM = 8;

__host__ __device__ __forceinline__ int lds_byte(int r, int c) { const int st = (r >> 4) * 2 + (c >> 5), rr = r & 15, cc = c & 31, ob = rr * 64 + cc * 2; return st * 1024 + (ob ^ (((ob >> 9) & 1) << 5)); }
__host__ __device__ __forceinline__ void stage_rc(int b, int& R, int& C) { const int st = b / 1024, sb = b % 1024, swz = sb ^ (((sb >> 9) & 1) << 5); R = (st >> 1) * 16 + swz / 64; C = (st & 1) * 32 + (swz % 64) / 2; }
__host__ __device__ __forceinline__ int perm32(int rho) { const int n = rho >> 4, i = rho & 15; return 8 * (i >> 2) + 4 * n + (i & 3); }

struct Unit { int pm, pn; };
struct Gemm { const bf16_t* A; const bf16_t* Bt; int M, N, K; };

struct StaticOrder {
    int nM, nN, nwg, G, c;
    __host__ __device__ void init(int M, int N, int G_, int c_) { nM = M / BM; nN = N / BM; nwg = nM * nN; G = G_; c = c_; }
    __host__ __device__ bool next(int i, Unit& u) const {
        const long L = (long)i * G + c; if (L >= nwg) return false;
        int wgid = (int)L; { const int q = nwg / NXCD, r = nwg % NXCD, xcd = wgid % NXCD, off = wgid / NXCD; wgid = (xcd < r ? xcd * (q + 1) : r * (q + 1) + (xcd - r) * q) + off; }
        const int nig = WGM * nN, gid = wgid / nig, fm = gid * WGM, gsz = (nM - fm) < WGM ? (nM - fm) : WGM;
        u.pm = fm + ((wgid % nig) % gsz); u.pn = (wgid % nig) / gsz; return true;
    }
    __device__ __forceinline__ void a_ready(const Unit&) const {}
    __device__ __forceinline__ void done(const Unit&) const {}
};
__device__ __forceinline__ unsigned cvt_pk_bf16(float lo, float hi) { unsigned r; asm volatile("v_cvt_pk_bf16_f32 %0, %1, %2" : "=v"(r) : "v"(lo), "v"(hi)); return r; }
typedef float f32x2 __attribute__((ext_vector_type(2)));
template <class Epi, class Sched, bool ALIGN_EPI = false, bool SP2 = false>
__device__ __forceinline__ void gemm_phase(PG8_LAS unsigned char* lds, const Gemm g, const Sched& S, const Epi& E) {
    int tid_ = threadIdx.x; asm volatile("" : "+v"(tid_));
    const int tid = tid_, wid = __builtin_amdgcn_readfirstlane(tid >> 6), lane = tid & 63, wr = wid >> 2, wc = wid & 3, fr = lane & 15, fq = lane >> 4;
    const int K = g.K, nt = K / BK;
    unsigned voffA[2], voffB[2];
#pragma unroll
    for (int i = 0; i < 2; ++i) { int R, C; stage_rc(tid * 16 + i * 8192, R, C); const int Rb = Epi::PERM ? ((R & ~31) + perm32(R & 31)) : R;
        voffA[i] = (unsigned)(R * K + C) * 2u; voffB[i] = (unsigned)(Rb * K + C) * 2u; }
    const size_t kstep = (size_t)(BK * 2);
    const size_t hstep = (size_t)HALF * K * 2;
    const size_t tstep = 2 * hstep;
    const unsigned ldsw = (unsigned)wid * 1024u;
    const int aoff = lds_byte(wr * 64 + fr, fq * 8), boff = lds_byte(wc * 32 + fr, fq * 8);
#define PG8_SA(b, h) (((b) * 2 + (h)) * HTB)
#define PG8_SB(b, h) ((4 + (b) * 2 + (h)) * HTB)
#define PG8_STAGE(bufoff, gbase, voff) do { _Pragma("unroll") for (int _i = 0; _i < 2; ++_i) \
        __builtin_amdgcn_global_load_lds((const unsigned*)((const char*)(gbase) + (voff)[_i]), (PG8_LAS unsigned*)(lds + (bufoff) + ldsw + _i * 8192), 16, 0, 0); } while (0)
#define PG8_LDA(dst, b, h) do { _Pragma("unroll") for (int m = 0; m < 4; ++m) _Pragma("unroll") for (int k = 0; k < 2; ++k) dst[m][k] = *(const PG8_LAS bf16x8*)(lds + PG8_SA(b, h) + aoff + m * 2048 + k * 1024); } while (0)
#define PG8_LDB(dst, b, h) do { _Pragma("unroll") for (int n = 0; n < 2; ++n) _Pragma("unroll") for (int k = 0; k < 2; ++k) dst[n][k] = *(const PG8_LAS bf16x8*)(lds + PG8_SB(b, h) + boff + n * 2048 + k * 1024); } while (0)
#define PG8_MMA(ai, bj, At, Bt) do { __builtin_amdgcn_s_setprio(1); _Pragma("unroll") for (int m = 0; m < 4; ++m) _Pragma("unroll") for (int n = 0; n < 2; ++n) _Pragma("unroll") for (int k = 0; k < 2; ++k) \
        acc[ai][bj][m][n] = __builtin_amdgcn_mfma_f32_16x16x32_bf16(Bt[n][k], At[m][k], acc[ai][bj][m][n], 0, 0, 0); __builtin_amdgcn_s_setprio(0); } while (0)
#define PG8_WAIT_V(n) asm volatile("s_waitcnt vmcnt(" #n ")" ::: "memory")
#define PG8_WAIT_L(n) asm volatile("s_waitcnt lgkmcnt(" #n ")" ::: "memory")
#define PG8_BAR __builtin_amdgcn_s_barrier()
#define PG8_SCHED __builtin_amdgcn_sched_barrier(0)
    Unit cur, nxt; int ui = 0;
    if (!S.next(0, cur)) return;
    f32x4 acc[2][2][4][2];
#pragma unroll
    for (int a = 0; a < 2; ++a)
#pragma unroll
        for (int b = 0; b < 2; ++b)
#pragma unroll
            for (int m = 0; m < 4; ++m)
#pragma unroll
                for (int n = 0; n < 2; ++n) acc[a][b][m][n] = (f32x4){0.f, 0.f, 0.f, 0.f};
    bf16x8 At[4][2], B0[2][2], B1[2][2];
    const char* cA = (const char*)g.A + (size_t)cur.pm * tstep; const char* cB = (const char*)g.Bt + (size_t)cur.pn * tstep;
    S.a_ready(cur);
    if constexpr (SP2) {
        PG8_STAGE(PG8_SB(0, 0), cB, voffB); PG8_STAGE(PG8_SB(0, 1), cB + hstep, voffB); PG8_STAGE(PG8_SA(0, 0), cA, voffA); PG8_STAGE(PG8_SA(0, 1), cA + hstep, voffA);
        if (wr == 1) PG8_BAR;
        PG8_WAIT_V(2); PG8_BAR;
        PG8_STAGE(PG8_SB(1, 0), cB + kstep, voffB); PG8_STAGE(PG8_SA(1, 0), cA + kstep, voffA); PG8_STAGE(PG8_SB(1, 1), cB + hstep + kstep, voffB);
        PG8_WAIT_V(6); PG8_BAR;
    } else {
        PG8_STAGE(PG8_SB(0, 0), cB, voffB); PG8_STAGE(PG8_SA(0, 0), cA, voffA); PG8_STAGE(PG8_SB(0, 1), cB + hstep, voffB); PG8_STAGE(PG8_SA(0, 1), cA + hstep, voffA);
        if (wr == 1) PG8_BAR;
        PG8_WAIT_V(4); PG8_BAR;
        PG8_STAGE(PG8_SB(1, 0), cB + kstep, voffB); PG8_STAGE(PG8_SA(1, 0), cA + kstep, voffA); PG8_STAGE(PG8_SB(1, 1), cB + hstep + kstep, voffB);
        PG8_WAIT_V(6); PG8_BAR;
    }
    for (;;) {
        const bool has_next = S.next(ui + 1, nxt);
        const char* nA = has_next ? (const char*)g.A + (size_t)nxt.pm * tstep : cA; const char* nB = has_next ? (const char*)g.Bt + (size_t)nxt.pn * tstep : cB;
        for (int t = 0; t < nt; t += 2) {
            const bool last = (t == nt - 2);
            const char* a1 = cA + (size_t)(t + 1) * kstep;
            const char* a2 = last ? nA : cA + (size_t)(t + 2) * kstep; const char* b2 = last ? nB : cB + (size_t)(t + 2) * kstep;
            const char* a3 = a2 + kstep; const char* b3 = b2 + kstep;
            if (last && has_next) S.a_ready(nxt);
            if constexpr (SP2) {
            PG8_LDB(B0, 0, 0); PG8_LDB(B1, 0, 1); PG8_SCHED; PG8_LDA(At, 0, 0); PG8_STAGE(PG8_SA(1, 1), a1 + hstep, voffA);
            PG8_WAIT_V(8); PG8_WAIT_L(0); PG8_BAR; PG8_MMA(0, 0, At, B0); PG8_MMA(0, 1, At, B1); PG8_BAR; PG8_SCHED;
            PG8_LDA(At, 0, 1); PG8_STAGE(PG8_SB(0, 0), b2, voffB); PG8_STAGE(PG8_SB(0, 1), b2 + hstep, voffB); PG8_STAGE(PG8_SA(0, 0), a2, voffA);
            PG8_WAIT_V(8); PG8_WAIT_L(0); PG8_BAR; PG8_MMA(1, 0, At, B0); PG8_MMA(1, 1, At, B1); PG8_BAR; PG8_SCHED;
            PG8_LDB(B0, 1, 0); PG8_LDB(B1, 1, 1); PG8_SCHED; PG8_LDA(At, 1, 0); PG8_STAGE(PG8_SA(0, 1), a2 + hstep, voffA);
            PG8_WAIT_V(8); PG8_WAIT_L(0); PG8_BAR; PG8_MMA(0, 0, At, B0); PG8_MMA(0, 1, At, B1); PG8_BAR; PG8_SCHED;
            PG8_LDA(At, 1, 1); PG8_STAGE(PG8_SB(1, 0), b3, voffB); PG8_STAGE(PG8_SB(1, 1), b3 + hstep, voffB); PG8_STAGE(PG8_SA(1, 0), a3, voffA);
            PG8_WAIT_V(8); PG8_WAIT_L(0); PG8_BAR; PG8_MMA(1, 0, At, B0); PG8_MMA(1, 1, At, B1); PG8_BAR; PG8_SCHED;
            } else {
            PG8_LDB(B0, 0, 0); PG8_SCHED; PG8_LDA(At, 0, 0); PG8_STAGE(PG8_SA(1, 1), a1 + hstep, voffA);
            PG8_WAIT_L(8); PG8_BAR; PG8_WAIT_L(0); PG8_MMA(0, 0, At, B0); PG8_BAR; PG8_SCHED;
            PG8_LDB(B1, 0, 1); PG8_STAGE(PG8_SB(0, 0), b2, voffB);
            PG8_BAR; PG8_WAIT_L(0); PG8_MMA(0, 1, At, B1); PG8_BAR;
            PG8_LDA(At, 0, 1); PG8_STAGE(PG8_SA(0, 0), a2, voffA);
            PG8_BAR; PG8_WAIT_L(0); PG8_MMA(1, 0, At, B0); PG8_BAR; PG8_SCHED;
            PG8_STAGE(PG8_SB(0, 1), b2 + hstep, voffB);
            PG8_WAIT_V(6); PG8_BAR; PG8_MMA(1, 1, At, B1); PG8_BAR;
            PG8_LDB(B0, 1, 0); PG8_SCHED; PG8_LDA(At, 1, 0); PG8_STAGE(PG8_SA(0, 1), a2 + hstep, voffA);
            PG8_WAIT_L(8); PG8_BAR; PG8_WAIT_L(0); PG8_MMA(0, 0, At, B0); PG8_BAR; PG8_SCHED;
            PG8_LDB(B1, 1, 1); PG8_STAGE(PG8_SB(1, 0), b3, voffB);
            PG8_BAR; PG8_WAIT_L(0); PG8_MMA(0, 1, At, B1); PG8_BAR;
            PG8_LDA(At, 1, 1); PG8_STAGE(PG8_SA(1, 0), a3, voffA);
            PG8_BAR; PG8_WAIT_L(0); PG8_MMA(1, 0, At, B0); PG8_BAR; PG8_SCHED;
            PG8_STAGE(PG8_SB(1, 1), b3 + hstep, voffB);
            PG8_WAIT_V(6); PG8_BAR; PG8_MMA(1, 1, At, B1); PG8_BAR;
            }
        }
        if constexpr (ALIGN_EPI) { if (wr == 0) PG8_BAR; }
        if constexpr (!Epi::AFTER_DRAIN) { E(acc, cur, wr, wc, fr, fq); S.done(cur); }
        if (!has_next) break;
#pragma unroll
        for (int a = 0; a < 2; ++a)
#pragma unroll
            for (int b = 0; b < 2; ++b)
#pragma unroll
                for (int m = 0; m < 4; ++m)
#pragma unroll
                    for (int n = 0; n < 2; ++n) acc[a][b][m][n] = (f32x4){0.f, 0.f, 0.f, 0.f};
        cur = nxt; cA = nA; cB = nB; ++ui;
        if constexpr (ALIGN_EPI) { if (wr == 1) PG8_BAR; }
    }
    PG8_WAIT_V(0);
    if constexpr (!ALIGN_EPI) { if (wr == 0) PG8_BAR; }
    PG8_BAR;
    if constexpr (Epi::AFTER_DRAIN) { E.fused(acc, cur, wr, wc, fr, fq, lds, wid, lane); S.done(cur); }
#undef PG8_SA
#undef PG8_SB
#undef PG8_STAGE
#undef PG8_LDA
#undef PG8_LDB
#undef PG8_MMA
#undef PG8_WAIT_V
#undef PG8_WAIT_L
#undef PG8_BAR
#undef PG8_SCHED
}
}

__device__ __forceinline__ void ph_rope(const Params& p, int bid, int nb) {
    char* ws = p.ws; const int lane = TIDX & 63, wv = TIDX >> 6;
    bf16_t* P = (bf16_t*)(ws + OFF_P);
    const float* rr = (const float*)(ws + OFF_ROPE_RET); const float* ax = (const float*)(ws + OFF_ROPE_AX);
    for (int r = bid * 8 + wv; r < NROW; r += nb * 8) {
        const bool lat = r < NLAT; const int n = r & (NSEQ - 1), gr = n >> 6, gc = n & 63;
        bf16_t* pr = P + (size_t)r * DIN;
        for (int it = 0; it < 11; ++it) {
            const int pi = it * 64 + lane;
            int c1, c2; float cs = 1.f, sn = 0.f, scale = 1.f;
            if (pi < 192) {
                const int hd = pi >> 5, j = pi & 31; c1 = (pi < 128 ? C_AQ : C_AK - 256) + hd * 64 + j; c2 = c1 + 32;
                if (pi < 128) scale = 0.125f;
                if (lat) { if (j < 16) { cs = ax[gr * 16 + j]; sn = ax[4096 + gr * 16 + j]; } else { cs = ax[8192 + gc * 16 + j - 16]; sn = ax[9216 + gc * 16 + j - 16]; } }
            } else if (pi < 448) {
                const int q = pi - 192, hd = q >> 5, j = q & 31; c1 = C_RQ + hd * 64 + j; c2 = c1 + 32;
                if (q >= 128) scale = 0.125f;
                if (lat) { cs = rr[n * 32 + j]; sn = rr[16384 * 32 + n * 32 + j]; }
            } else {
                const int q = pi - 448, blk = q >> 4, j = q & 15; c1 = C_DQ + blk * 32 + j; c2 = c1 + 16;
                if (q < 128) scale = 0.17677669529663687f * 1.4426950408889634f;
                if (lat) { if (j < 8) { cs = ax[10240 + gr * 8 + j]; sn = ax[12288 + gr * 8 + j]; } else { cs = ax[14336 + gc * 8 + j - 8]; sn = ax[14848 + gc * 8 + j - 8]; } }
            }
            const float x1 = bf2f(pr[c1]), x2 = bf2f(pr[c2]);
            pr[c1] = f2bf((x1 * cs - x2 * sn) * scale); pr[c2] = f2bf((x2 * cs + x1 * sn) * scale);
        }
    }
}

__device__ __forceinline__ float ret_lg(const Params& p, int l, int dir, int h) { return -softplusf_(-p.ret_logit[(l * 2 + dir) * 4 + h]); }
__device__ __forceinline__ void ph_ret_summ(const Params& p, int l, int bid, int nb, float* lds) {
    char* ws = p.ws; const int t = TIDX;
    const bf16_t* P = (const bf16_t*)(ws + OFF_P); float* RET = (float*)(ws + OFF_RET);
    float* ks = lds; float* vs = lds + 128 * 64; float* zf = vs + 128 * 64; float* zb = zf + 128;
    for (int u = bid; u < 2 * NCI * 4; u += nb) {
        const int h = u & 3, ci = (u >> 2) % NCI, b = u / (4 * NCI), rb = row_base(b, ci);
        const float lgf = ret_lg(p, l, 0, h), lgb = ret_lg(p, l, 1, h);
        __syncthreads();
        for (int i = t; i < 128 * 64; i += 512) { const int m = i >> 6, d = i & 63; ks[i] = bf2f(P[(size_t)(rb + m) * DIN + C_RK + h * 64 + d]); vs[i] = bf2f(P[(size_t)(rb + m) * DIN + C_RV + h * 64 + d]); }
        if (t < 128) { zf[t] = expf(lgf * (float)(127 - t)); zb[t] = expf(lgb * (float)t); }
        __syncthreads();
        const int d = t >> 3, e0 = (t & 7) * 8;
        float af[8], ab[8];
#pragma unroll
        for (int j = 0; j < 8; ++j) { af[j] = 0.f; ab[j] = 0.f; }
        for (int m = 0; m < 128; ++m) { const float kv = ks[m * 64 + d], kf = kv * zf[m], kb = kv * zb[m];
#pragma unroll
            for (int j = 0; j < 8; ++j) { const float vv = vs[m * 64 + e0 + j]; af[j] += kf * vv; ab[j] += kb * vv; } }
        float* of = RET + ((((size_t)0 * 2 + b) * NCI + ci) * 4 + h) * 4096 + d * 64 + e0;
        float* ob = RET + ((((size_t)1 * 2 + b) * NCI + ci) * 4 + h) * 4096 + d * 64 + e0;
#pragma unroll
        for (int j = 0; j < 8; ++j) { of[j] = af[j]; ob[j] = ab[j]; }
    }
}

template <int MODE>
__device__ __forceinline__ void ph_lru_chunk(const Params& p, int l, int bid, int nb, float* lds, int ci_lo) {
    char* ws = p.ws; const int t = TIDX;
    const bf16_t* P = (const bf16_t*)(ws + OFF_P);
    float* LA = (float*)(ws + OFF_LRU); float* LB = LA + 2 * 2 * NCI * 256; float* LC = LB + 2 * 2 * NCI * 256;
    bf16_t* O = (bf16_t*)(ws + OFF_ACT);
    float* us = lds;
    float* as_ = lds + 8192;
    float* bs_ = lds + 16384;
    float* hs = lds + 24576;
    const int nci = NCI - ci_lo;
    for (int u = bid; u < 2 * nci * 4; u += nb) {
        const int hb = u & 3, ci = ci_lo + (u >> 2) % nci, b = u / (4 * nci), rb = row_base(b, ci);
        const int seg_lo = ci < 2 ? NLAT + b * NCTX : b * NSEQ, seg_hi = ci < 2 ? seg_lo + NCTX : seg_lo + NSEQ;
        __syncthreads();
        for (int i = t; i < 128 * 64; i += 512) { const int tt = i >> 6, j = i & 63, ch = hb * 64 + j; float acc = p.conv_b[l * 256 + ch];
#pragma unroll
            for (int k = 0; k < 4; ++k) { const int rr = rb + tt - 1 + k; if (rr >= seg_lo && rr < seg_hi) acc += p.conv_w[(l * 4 + k) * 256 + ch] * bf2f(P[(size_t)rr * DIN + C_LX + ch]); }
            us[i] = acc; }
        __syncthreads();
        for (int dir = 0; dir < 2; ++dir) {
            const int j = t & 63, tg = t >> 6, ch = hb * 64 + j;
            const float* wa = p.lru_wa + (((size_t)(l * 2 + dir) * 4 + hb) * 64) * 64 + j;
            const float* wx = p.lru_wx + (((size_t)(l * 2 + dir) * 4 + hb) * 64) * 64 + j;
            const float ba = p.lru_ba[(l * 2 + dir) * 256 + ch], bx = p.lru_bx[(l * 2 + dir) * 256 + ch];
            const float spl = softplusf_(-p.lru_lam[(l * 2 + dir) * 256 + ch]);
            float ra[16], rx[16];
#pragma unroll
            for (int k = 0; k < 16; ++k) { ra[k] = ba; rx[k] = bx; }
            for (int i = 0; i < 64; ++i) { const float wav = wa[i * 64], wxv = wx[i * 64];
#pragma unroll
                for (int k = 0; k < 16; ++k) { const float uv = us[(tg * 16 + k) * 64 + i]; ra[k] += uv * wav; rx[k] += uv * wxv; } }
#pragma unroll
            for (int k = 0; k < 16; ++k) { const int tt = tg * 16 + k; const float r = sigmoidf_(ra[k]), ig = sigmoidf_(rx[k]);
                const float la = -8.0f * r * spl, a = expf(la), bb = sqrtf(-expm1f(2.0f * la)) * (ig * us[tt * 64 + j]);
                as_[tt * 64 + j] = a; bs_[tt * 64 + j] = bb; }
            __syncthreads();
            if (t < 64) {
                const size_t cidx = (((size_t)dir * 2 + b) * NCI + ci) * 256 + hb * 64 + t;
                float h = MODE == 3 ? LC[cidx] : 0.f, ap = 1.f;
                if (dir == 0) { for (int tt = 0; tt < 128; ++tt) { const float a = as_[tt * 64 + t]; h = a * h + bs_[tt * 64 + t]; ap *= a; if (MODE == 3) hs[tt * 64 + t] = h; } }
                else { for (int tt = 127; tt >= 0; --tt) { const float a = as_[tt * 64 + t]; h = a * h + bs_[tt * 64 + t]; ap *= a; if (MODE == 3) hs[tt * 64 + t] += h; } }
                if (MODE == 1) { LA[cidx] = ap; LB[cidx] = h; }
            }
            __syncthreads();
        }
        if (MODE == 3) {
            for (int i = t; i < 128 * 64; i += 512) { const int tt = i >> 6, j = i & 63, ch = hb * 64 + j;
                const float y = bf2f(P[(size_t)(rb + tt) * DIN + C_LY + ch]);
                O[(size_t)(rb + tt) * DM + 768 + ch] = f2bf(hs[i] * gelu_tanh(y)); }
        }
    }
}

__device__ __forceinline__ int scan_ci(int dir, int s) { return dir == 0 ? s : (s == 0 ? 1 : (s == 1 ? 0 : NCI + 1 - s)); }
__device__ __forceinline__ void ph_scan2(const Params& p, int l, int bid, int nb) {
    char* ws = p.ws; const int gt = bid * 512 + TIDX, gs = nb * 512;
    float* RET = (float*)(ws + OFF_RET);
    for (int i = gt; i < 2 * 2 * 4 * 4096; i += gs) {
        const int de = i & 4095, h = (i >> 12) & 3, b = (i >> 14) & 1, dir = i >> 15;
        const float decay = expf(ret_lg(p, l, dir, h) * 128.0f); float S = 0.f;
        for (int s = 0; s < NCI; ++s) { const int ci = scan_ci(dir, s); float* q = RET + ((((size_t)dir * 2 + b) * NCI + ci) * 4 + h) * 4096 + de; const float U = *q; *q = S; S = decay * S + U; }
    }
    float* LA = (float*)(ws + OFF_LRU); float* LB = LA + 2 * 2 * NCI * 256; float* LC = LB + 2 * 2 * NCI * 256;
    for (int i = gt; i < 2 * 2 * 256; i += gs) {
        const int ch = i & 255, b = (i >> 8) & 1, dir = i >> 9; float h = 0.f;
        for (int s = 0; s < NCI; ++s) { const int ci = scan_ci(dir, s); const size_t idx = (((size_t)dir * 2 + b) * NCI + ci) * 256 + ch; LC[idx] = h; h = LA[idx] * h + LB[idx]; }
    }
}

__device__ __forceinline__ void ph_ret_out(const Params& p, int l, int bid, int nb, float* lds, int ci_lo) {
    char* ws = p.ws; const int t = TIDX;
    const bf16_t* P = (const bf16_t*)(ws + OFF_P); const float* RET = (const float*)(ws + OFF_RET); bf16_t* O = (bf16_t*)(ws + OFF_ACT);
    float* qs = lds;
    float* ks = qs + 128 * 65;
    float* vs = ks + 128 * 65;
    float* sf = vs + 128 * 64;
    float* sb = sf + 4096;
    float* pf = sb + 4096;
    float* pb = pf + 132;
    const int nci = NCI - ci_lo;
    for (int u = bid; u < 2 * nci * 4; u += nb) {
        const int h = u & 3, ci = ci_lo + (u >> 2) % nci, b = u / (4 * nci), rb = row_base(b, ci);
        const float lgf = ret_lg(p, l, 0, h), lgb = ret_lg(p, l, 1, h);
        __syncthreads();
        for (int i = t; i < 128 * 64; i += 512) { const int m = i >> 6, d = i & 63; const bf16_t* pr = P + (size_t)(rb + m) * DIN + h * 64 + d;
            qs[m * 65 + d] = bf2f(pr[C_RQ]); ks[m * 65 + d] = bf2f(pr[C_RK]); vs[i] = bf2f(pr[C_RV]); }
        for (int i = t; i < 4096; i += 512) { sf[i] = RET[((((size_t)0 * 2 + b) * NCI + ci) * 4 + h) * 4096 + i]; sb[i] = RET[((((size_t)1 * 2 + b) * NCI + ci) * 4 + h) * 4096 + i]; }
        if (t < 129) { pf[t] = expf(lgf * (float)t); pb[t] = expf(lgb * (float)t); }
        __syncthreads();
        const int n = t >> 2, e0 = (t & 3) * 16;
        float y[16];
#pragma unroll
        for (int j = 0; j < 16; ++j) y[j] = 0.f;
        for (int m = 0; m < 128; ++m) {
            float s = 0.f;
#pragma unroll 16
            for (int d = 0; d < 64; ++d) s += qs[n * 65 + d] * ks[m * 65 + d];
            float w = 0.f; if (m <= n) w += pf[n - m]; if (m >= n) w += pb[m - n];
            s *= w;
#pragma unroll
            for (int j = 0; j < 16; ++j) y[j] += s * vs[m * 64 + e0 + j];
        }
        const float xf = pf[n + 1], xb = pb[128 - n];
        for (int d = 0; d < 64; ++d) { const float qv = qs[n * 65 + d], qf = qv * xf, qb = qv * xb;
#pragma unroll
            for (int j = 0; j < 16; ++j) y[j] += qf * sf[d * 64 + e0 + j] + qb * sb[d * 64 + e0 + j]; }
        float ss = 0.f;
#pragma unroll
        for (int j = 0; j < 16; ++j) ss += y[j] * y[j];
        ss += __shfl_xor(ss, 1); ss += __shfl_xor(ss, 2);
        const float rn = rsqrtf(ss * (1.0f / 64.0f) + 1e-6f);
#pragma unroll
        for (int j = 0; j < 16; ++j) { const int c = h * 64 + e0 + j; const float g = bf2f(P[(size_t)(rb + n) * DIN + C_RG + c]);
            O[(size_t)(rb + n) * DM + 256 + c] = f2bf(y[j] * rn * p.ret_gn[l * 256 + c] * siluf_(g)); }
    }
}

__device__ __forceinline__ void load_row64(const bf16_t* src, float* dst) {
#pragma unroll
    for (int i = 0; i < 8; ++i) { const uint4 w = *(const uint4*)(src + i * 8);
        dst[i * 8 + 0] = __uint_as_float(w.x << 16); dst[i * 8 + 1] = __uint_as_float(w.x & 0xffff0000u); dst[i * 8 + 2] = __uint_as_float(w.y << 16); dst[i * 8 + 3] = __uint_as_float(w.y & 0xffff0000u);
        dst[i * 8 + 4] = __uint_as_float(w.z << 16); dst[i * 8 + 5] = __uint_as_float(w.z & 0xffff0000u); dst[i * 8 + 6] = __uint_as_float(w.w << 16); dst[i * 8 + 7] = __uint_as_float(w.w & 0xffff0000u); }
}
__device__ __forceinline__ void load_row32(const bf16_t* src, float* dst) {
#pragma unroll
    for (int i = 0; i < 4; ++i) { const uint4 w = *(const uint4*)(src + i * 8);
        dst[i * 8 + 0] = __uint_as_float(w.x << 16); dst[i * 8 + 1] = __uint_as_float(w.x & 0xffff0000u); dst[i * 8 + 2] = __uint_as_float(w.y << 16); dst[i * 8 + 3] = __uint_as_float(w.y & 0xffff0000u);
        dst[i * 8 + 4] = __uint_as_float(w.z << 16); dst[i * 8 + 5] = __uint_as_float(w.z & 0xffff0000u); dst[i * 8 + 6] = __uint_as_float(w.w << 16); dst[i * 8 + 7] = __uint_as_float(w.w & 0xffff0000u); }
}
#define BFLO(w) __uint_as_float((w) << 16)
#define BFHI(w) __uint_as_float((w) & 0xffff0000u)
template <int N8> __device__ __forceinline__ float dot_row(const bf16_t* src, const float* q) {
    float s = 0.f;
#pragma unroll
    for (int i = 0; i < N8; ++i) { const uint4 w = *(const uint4*)(src + i * 8);
        s += q[i * 8 + 0] * BFLO(w.x) + q[i * 8 + 1] * BFHI(w.x) + q[i * 8 + 2] * BFLO(w.y) + q[i * 8 + 3] * BFHI(w.y) + q[i * 8 + 4] * BFLO(w.z) + q[i * 8 + 5] * BFHI(w.z) + q[i * 8 + 6] * BFLO(w.w) + q[i * 8 + 7] * BFHI(w.w); }
    return s;
}
template <int N8> __device__ __forceinline__ void axpy_row(const bf16_t* src, float pe, float* o) {
#pragma unroll
    for (int i = 0; i < N8; ++i) { const uint4 w = *(const uint4*)(src + i * 8);
        o[i * 8 + 0] += pe * BFLO(w.x); o[i * 8 + 1] += pe * BFHI(w.x); o[i * 8 + 2] += pe * BFLO(w.y); o[i * 8 + 3] += pe * BFHI(w.y);
        o[i * 8 + 4] += pe * BFLO(w.z); o[i * 8 + 5] += pe * BFHI(w.z); o[i * 8 + 6] += pe * BFLO(w.w); o[i * 8 + 7] += pe * BFHI(w.w); }
}
__device__ __forceinline__ void ph_swa(const Params& p, int l, bool need_ctx, int bid, int nb) {
    char* ws = p.ws; const int t = TIDX, hf = t & 1, qi = (t >> 1) & 63, h = t >> 7, g = h >> 1;
    const bf16_t* P = (const bf16_t*)(ws + OFF_P); bf16_t* O = (bf16_t*)(ws + OFF_ACT);
    const int nun = 2 * 256 + (need_ctx ? 8 : 0);
    for (int u = bid; u < nun; u += nb) {
        const bool isctx = u >= 512; int b, qpos, row, k_lo, k_hi;
        if (!isctx) { b = u >> 8; const int q0 = (u & 255) * 64; qpos = q0 + qi; row = b * NSEQ + qpos; const int blk = (q0 >> 7) * 128; k_lo = blk - 128 < 0 ? 0 : blk - 128; k_hi = blk + 256 > NSEQ ? NSEQ : blk + 256; }
        else { const int v = u - 512; b = v >> 2; qpos = (v & 3) * 64 + qi; row = NLAT + b * NCTX + qpos; k_lo = 0; k_hi = 0; }
        float q[32], o[32];
        load_row32(P + (size_t)row * DIN + C_AQ + h * 64 + hf * 32, q);
#pragma unroll
        for (int d = 0; d < 32; ++d) o[d] = 0.f;
        float m = p.sink[l * 4 + h], lsum = 1.0f;
        const int nwin = k_hi - k_lo, ntot = nwin + NCTX;
#pragma unroll 1
        for (int kk = 0; kk < ntot; ++kk) {
            const bool win = kk < nwin; const int kpos = k_lo + kk;
            const int krow = win ? b * NSEQ + kpos : NLAT + b * NCTX + (kk - nwin);
            const bool valid = win ? (abs(qpos - kpos) <= 128) : true;
            float s = dot_row<4>(P + (size_t)krow * DIN + C_AK + g * 64 + hf * 32, q);
            s += __shfl_xor(s, 1);
            if (valid) {
                if (s > m) { const float cr = __expf(m - s); lsum *= cr;
#pragma unroll
                    for (int d = 0; d < 32; ++d) o[d] *= cr;
                    m = s; }
                const float pe = __expf(s - m); lsum += pe;
                axpy_row<4>(P + (size_t)krow * DIN + C_AV + g * 64 + hf * 32, pe, o);
            }
        }
        const float inv = 1.0f / lsum;
        bf16_t* op = O + (size_t)row * DM + h * 64 + hf * 32;
#pragma unroll
        for (int d = 0; d < 32; d += 2) *(unsigned*)(op + d) = pack2(o[d] * inv, o[d + 1] * inv);
    }
}

__device__ __forceinline__ float diff_lambda_val(const Params& p, int l, float lam_init) {
    const float* lv = p.diff_lam + l * 128; float s1 = 0.f, s2 = 0.f;
    for (int i = 0; i < 32; ++i) { s1 += lv[i] * lv[32 + i]; s2 += lv[64 + i] * lv[96 + i]; }
    return expf(s1) - expf(s2) + lam_init;
}
typedef float f32x16 __attribute__((ext_vector_type(16)));
typedef short s16x4 __attribute__((ext_vector_type(4)));
typedef short v4i16_t __attribute__((ext_vector_type(4)));
typedef float f32x2_t __attribute__((ext_vector_type(2)));
typedef __bf16 bf16x2_t __attribute__((ext_vector_type(2)));
__device__ __forceinline__ unsigned cvtpk_s(float lo, float hi) { f32x2_t v = {lo, hi}; bf16x2_t bb = __builtin_convertvector(v, bf16x2_t); return __builtin_bit_cast(unsigned, bb); }
__device__ __forceinline__ int crow(int r, int hi) { return (r & 3) + 8 * (r >> 2) + 4 * hi; }
__device__ __forceinline__ float xhalf_max(float m) { auto rr = __builtin_amdgcn_permlane32_swap(__float_as_uint(m), __float_as_uint(m), false, false); return fmaxf(__uint_as_float(rr[0]), __uint_as_float(rr[1])); }
__device__ __forceinline__ float xhalf_sum(float m) { auto rr = __builtin_amdgcn_permlane32_swap(__float_as_uint(m), __float_as_uint(m), false, false); return __uint_as_float(rr[0]) + __uint_as_float(rr[1]); }
__device__ __forceinline__ s16x4 vtr(const LAS char* p) { return __builtin_bit_cast(s16x4, __builtin_amdgcn_ds_read_tr16_b64_v4i16((LAS v4i16_t*)p)); }

constexpr int DF_K = 0, DF_V = 16384, DF_WS = 32768, DF_ST = 34816;
__device__ __forceinline__ void ph_diff(const Params& p, int l, bool need_ctx, float lam_init, int bid, int nb, float* lds) {
    char* ws = p.ws; const int tid = TIDX, lane = tid & 63, r32 = lane & 31, hi = lane >> 5, wid = __builtin_amdgcn_readfirstlane(tid >> 6);
    const bf16_t* P = (const bf16_t*)(ws + OFF_P); bf16_t* O = (bf16_t*)(ws + OFF_ACT);
    LAS char* sm = (LAS char*)lds;
    LAS float* wsf = (LAS float*)(sm + DF_WS) + wid * 64;
    const float lam = diff_lambda_val(p, l, lam_init);
    const int nun = 512 + (need_ctx ? 8 : 0);
    for (int u = bid; u < nun; u += nb) {
        int b, h, qrow0, t_lo;
        if (u < 512) { b = u >> 8; h = (u >> 6) & 3; qrow0 = b * NSEQ + (u & 63) * 256; t_lo = 0; }
        else { const int v = u - 512; b = v >> 2; h = v & 3; qrow0 = NLAT + b * NCTX; t_lo = 256; }
        const int t_hi = 260;
        const bf16_t* kcol = P + C_DK + h * 64 + wid * 8;
        const bf16_t* vcol = P + C_DV + h * 64 + (wid >> 2) * 32 + (lane & 3) * 8;
        const int krow_in = lane, vrow_in = 16 * (wid & 3) + (lane >> 2);
#define TILE_ROW0(t) ((t) < 256 ? b * NSEQ + (t) * 64 : NLAT + b * NCTX + ((t) - 256) * 64)
        bf16x8 qr[4];
        { const bf16_t* qp = P + (size_t)(qrow0 + wid * 32 + r32) * DIN + C_DQ + h * 64 + hi * 8;
#pragma unroll
          for (int d0 = 0; d0 < 4; ++d0) qr[d0] = *(const bf16x8*)(qp + d0 * 16); }
        f32x16 o[2][2]; float mhat[2], lsum[2];
#pragma unroll
        for (int m = 0; m < 2; ++m) { mhat[m] = 0.f; lsum[m] = 0.f;
#pragma unroll
            for (int r = 0; r < 16; ++r) { o[m][0][r] = 0.f; o[m][1][r] = 0.f; } }
        u32x4 kst, vst;
        { const int r0 = TILE_ROW0(t_lo); kst = *(const u32x4*)(kcol + (size_t)(r0 + krow_in) * DIN); vst = *(const u32x4*)(vcol + (size_t)(r0 + vrow_in) * DIN); }
        __syncthreads();
        *(LAS u32x4*)(sm + DF_K + tid * 16) = kst; *(LAS u32x4*)(sm + DF_V + tid * 16) = vst;
        __syncthreads();
        bool first = true;
        for (int t = t_lo; t < t_hi; ++t) {
            const int cur = (t - t_lo) & 1;
            if (t + 1 < t_hi) { const int r0 = TILE_ROW0(t + 1); kst = *(const u32x4*)(kcol + (size_t)(r0 + krow_in) * DIN); vst = *(const u32x4*)(vcol + (size_t)(r0 + vrow_in) * DIN); }
            const LAS char* kb = sm + DF_K + cur * 8192 + hi * 1024 + r32 * 16;
            const LAS char* vb = sm + DF_V + cur * 8192 + ((lane >> 4) & 1) * 32 + (lane & 3) * 8 + (4 * hi + ((lane & 15) >> 2)) * 64;
            bf16x8 kf[8];
#pragma unroll
            for (int j = 0; j < 4; ++j) { kf[2 * j] = *(const LAS bf16x8*)(kb + j * 2048); kf[2 * j + 1] = *(const LAS bf16x8*)(kb + j * 2048 + 512); }
            bf16x8 vf[8];
#pragma unroll
            for (int i = 0; i < 8; ++i) { const s16x4 lo = vtr(vb + (i >> 2) * 4096 + (i & 3) * 1024), hh = vtr(vb + (i >> 2) * 4096 + (i & 3) * 1024 + 512);
                vf[i] = (bf16x8){lo[0], lo[1], lo[2], lo[3], hh[0], hh[1], hh[2], hh[3]}; }
#pragma unroll
            for (int m = 0; m < 2; ++m) {
                float nm = -mhat[m]; asm volatile("" : "+v"(nm));
                f32x16 negm;
#pragma unroll
                for (int r = 0; r < 16; ++r) negm[r] = nm;
                f32x16 c0 = __builtin_amdgcn_mfma_f32_32x32x16_bf16(kf[4 * m + 0], qr[2 * m], negm, 0, 0, 0);
                f32x16 c1 = __builtin_amdgcn_mfma_f32_32x32x16_bf16(kf[4 * m + 1], qr[2 * m], negm, 0, 0, 0);
                c0 = __builtin_amdgcn_mfma_f32_32x32x16_bf16(kf[4 * m + 2], qr[2 * m + 1], c0, 0, 0, 0);
                c1 = __builtin_amdgcn_mfma_f32_32x32x16_bf16(kf[4 * m + 3], qr[2 * m + 1], c1, 0, 0, 0);
                float rm = fmaxf(c0[0], c1[0]);
#pragma unroll
                for (int r = 1; r < 16; ++r) rm = fmaxf(rm, fmaxf(c0[r], c1[r]));
                rm = xhalf_max(rm);
                if (first || __any(rm > 8.0f)) {
                    const float dl = first ? rm : fmaxf(rm, 0.f);
                    mhat[m] += dl;
#pragma unroll
                    for (int r = 0; r < 16; ++r) { c0[r] -= dl; c1[r] -= dl; }
                    if (!first) {
                        const float f = __builtin_amdgcn_exp2f(-dl); lsum[m] *= f;
                        if (hi == 0) wsf[r32] = f;
#pragma unroll
                        for (int r = 0; r < 16; ++r) { const float fr_ = wsf[crow(r, hi)]; o[m][0][r] *= fr_; o[m][1][r] *= fr_; }
                    }
                }
                float sacc = 0.f;
#pragma unroll
                for (int r = 0; r < 16; ++r) { c0[r] = __builtin_amdgcn_exp2f(c0[r]); c1[r] = __builtin_amdgcn_exp2f(c1[r]); sacc += c0[r] + c1[r]; }
                lsum[m] += sacc;
                u32x4 pw[4];
#pragma unroll
                for (int k = 0; k < 2; ++k) {
                    pw[k] = (u32x4){cvtpk_s(c0[8 * k + 0], c0[8 * k + 1]), cvtpk_s(c0[8 * k + 2], c0[8 * k + 3]), cvtpk_s(c0[8 * k + 4], c0[8 * k + 5]), cvtpk_s(c0[8 * k + 6], c0[8 * k + 7])};
                    pw[2 + k] = (u32x4){cvtpk_s(c1[8 * k + 0], c1[8 * k + 1]), cvtpk_s(c1[8 * k + 2], c1[8 * k + 3]), cvtpk_s(c1[8 * k + 4], c1[8 * k + 5]), cvtpk_s(c1[8 * k + 6], c1[8 * k + 7])}; }
#pragma unroll
                for (int k = 0; k < 4; ++k) {
                    o[m][0] = __builtin_amdgcn_mfma_f32_32x32x16_bf16(__builtin_bit_cast(bf16x8, pw[k]), vf[k], o[m][0], 0, 0, 0);
                    o[m][1] = __builtin_amdgcn_mfma_f32_32x32x16_bf16(__builtin_bit_cast(bf16x8, pw[k]), vf[4 + k], o[m][1], 0, 0, 0); }
            }
            first = false;
            if (t + 1 < t_hi) { *(LAS u32x4*)(sm + DF_K + (cur ^ 1) * 8192 + tid * 16) = kst; *(LAS u32x4*)(sm + DF_V + (cur ^ 1) * 8192 + tid * 16) = vst; }
            __syncthreads();
        }
#undef TILE_ROW0
        const float inv0 = 1.0f / xhalf_sum(lsum[0]), inv1 = lam / xhalf_sum(lsum[1]);
        int lane_e = TIDX & 63; asm volatile("" : "+v"(lane_e));
        { const int r32e = lane_e & 31, hie = lane_e >> 5;
        LAS float* wse = (LAS float*)(sm + DF_WS) + wid * 64; LAS float* stge = (LAS float*)(sm + DF_ST) + wid * 2048;
        if (hie == 0) { wse[r32e] = inv0; wse[32 + r32e] = inv1; }
#pragma unroll
        for (int r = 0; r < 16; ++r) { const int q = crow(r, hie); const float i0 = wse[q], i1 = wse[32 + q];
            stge[q * 64 + r32e] = o[0][0][r] * i0 - o[1][0][r] * i1; stge[q * 64 + 32 + r32e] = o[0][1][r] * i0 - o[1][1][r] * i1; } }
        const int lane = lane_e; LAS float* stg = (LAS float*)(sm + DF_ST) + wid * 2048;
        const float* gn = p.diff_gn + l * 256 + h * 64 + (lane & 7) * 8;
        const f32x4 g0 = *(const f32x4*)gn, g1 = *(const f32x4*)(gn + 4);
#pragma unroll
        for (int i = 0; i < 4; ++i) { const int row = i * 8 + (lane >> 3), ch = lane & 7;
            const f32x4 v0 = *(const LAS f32x4*)(stg + row * 64 + ch * 8), v1 = *(const LAS f32x4*)(stg + row * 64 + ch * 8 + 4);
            float ss = v0[0] * v0[0] + v0[1] * v0[1] + v0[2] * v0[2] + v0[3] * v0[3] + v1[0] * v1[0] + v1[1] * v1[1] + v1[2] * v1[2] + v1[3] * v1[3];
            ss += __shfl_xor(ss, 1); ss += __shfl_xor(ss, 2); ss += __shfl_xor(ss, 4);
            const float rn = rsqrtf(ss * (1.0f / 64.0f) + 1e-6f) * (1.0f - lam_init);
            u32x4 w; w.x = cvtpk_s(v0[0] * rn * g0[0], v0[1] * rn * g0[1]); w.y = cvtpk_s(v0[2] * rn * g0[2], v0[3] * rn * g0[3]);
            w.z = cvtpk_s(v1[0] * rn * g1[0], v1[1] * rn * g1[1]); w.w = cvtpk_s(v1[2] * rn * g1[2], v1[3] * rn * g1[3]);
            *(u32x4*)(O + (size_t)(qrow0 + wid * 32 + row) * DM + 512 + h * 64 + ch * 8) = w; }
    }
}

__device__ __forceinline__ void moe_offsets(const Params& p, int* offs  ) {
    if (TIDX < 2) { const unsigned* cw = (const unsigned*)p.ws + CW_CNT + TIDX * 8; int o = 0;
        for (int e = 0; e < 8; ++e) { offs[TIDX * 9 + e] = o; o += ((int)__hip_atomic_load(cw + e, __ATOMIC_RELAXED, __HIP_MEMORY_SCOPE_AGENT) + 255) & ~255; }
        offs[TIDX * 9 + 8] = o; }
    __syncthreads();
}
__device__ __forceinline__ void ph_moe_scatter(const Params& p, int bid, int nb, float* lds) {
    char* ws = p.ws; int* offs = (int*)lds; moe_offsets(p, offs);
    const int lane = TIDX & 63, wv = TIDX >> 6;
    const bf16_t* H = (const bf16_t*)(ws + OFF_ACT); bf16_t* AS = (bf16_t*)(ws + OFF_ASORT);
    int* tok = (int*)(ws + OFF_TOK); float* wgt = (float*)(ws + OFF_WGT); unsigned* cw = (unsigned*)ws;
    for (int r = bid * 8 + wv; r < NLAT; r += nb * 8) {
        const int4 rec = *(const int4*)(ws + OFF_ROUTE + (size_t)r * 16);
        for (int g = 0; g < 2; ++g) {
            const int e = g == 0 ? rec.x : rec.y; int pos = 0;
            if (lane == 0) { pos = offs[g * 9 + e] + (int)atomicAdd(cw + CW_CUR + g * 8 + e, 1u); tok[g * GRP_ROWS + pos] = r; wgt[g * GRP_ROWS + pos] = __int_as_float(g == 0 ? rec.z : rec.w); }
            pos = __shfl(pos, 0);
            const uint4* src = (const uint4*)(H + (size_t)r * DM); uint4* dst = (uint4*)(AS + ((size_t)g * GRP_ROWS + pos) * DM);
            dst[lane] = src[lane]; dst[64 + lane] = src[64 + lane];
        }
    }
}

__device__ __forceinline__ void ph_final(const Params& p, int bid, int nb) {
    const int lane = TIDX & 63, wv = TIDX >> 6;
    for (int r = bid * 8 + wv; r < NLAT; r += nb * 8) {
        float* xr = p.out + (size_t)r * DM; float4 v[4]; float ss = 0.f;
#pragma unroll
        for (int i = 0; i < 4; ++i) { v[i] = *(const float4*)(xr + i * 256 + lane * 4); ss += v[i].x * v[i].x + v[i].y * v[i].y + v[i].z * v[i].z + v[i].w * v[i].w; }
        ss = wave_sum(ss); const float rn = rsqrtf(ss * (1.0f / 1024.0f) + 1e-6f);
#pragma unroll
        for (int i = 0; i < 4; ++i) { const float4 g = *(const float4*)(p.final_norm + i * 256 + lane * 4);
            float4 o; o.x = v[i].x * rn * g.x; o.y = v[i].y * rn * g.y; o.z = v[i].z * rn * g.z; o.w = v[i].w * rn * g.w; *(float4*)(xr + i * 256 + lane * 4) = o; }
    }
}

__device__ __forceinline__ float fast_silu(float v) { return v * __builtin_amdgcn_rcpf(1.0f + __expf(-v)); }
struct EpiStoreBf16 {
    static constexpr bool PERM = true, AFTER_DRAIN = false; bf16_t* O; int ldc;
    __device__ __forceinline__ void operator()(const f32x4 (&acc)[2][2][4][2], const pg8::Unit& u, int wr, int wc, int fr, int fq) const {
        bf16_t* base = O + (size_t)(u.pm * 256 + wr * 64 + fr) * ldc + u.pn * 256 + wc * 32 + 8 * fq;
#pragma unroll
        for (int ai = 0; ai < 2; ++ai)
#pragma unroll
            for (int m = 0; m < 4; ++m) { bf16_t* rowp = base + (size_t)(ai * 128 + m * 16) * ldc;
#pragma unroll
                for (int bj = 0; bj < 2; ++bj) { const f32x4 v0 = acc[ai][bj][m][0], v1 = acc[ai][bj][m][1]; u32x4 w;
                    w.x = pg8::cvt_pk_bf16(v0[0], v0[1]); w.y = pg8::cvt_pk_bf16(v0[2], v0[3]); w.z = pg8::cvt_pk_bf16(v1[0], v1[1]); w.w = pg8::cvt_pk_bf16(v1[2], v1[3]);
                    *(u32x4*)(rowp + bj * 128) = w; } }
    }
};
struct EpiSwiglu {
    static constexpr bool PERM = true, AFTER_DRAIN = false; bf16_t* U; int ldu, npe;
    __device__ __forceinline__ void operator()(const f32x4 (&acc)[2][2][4][2], const pg8::Unit& u, int wr, int wc, int fr, int fq) const {
        bf16_t* base = U + (size_t)(u.pm * 256 + wr * 64 + fr) * ldu + (u.pn % npe) * 128 + wc * 32 + 8 * fq;
#pragma unroll
        for (int ai = 0; ai < 2; ++ai)
#pragma unroll
            for (int m = 0; m < 4; ++m) { float o[8];
#pragma unroll
                for (int n = 0; n < 2; ++n)
#pragma unroll
                    for (int i = 0; i < 4; ++i) o[n * 4 + i] = fast_silu(acc[ai][0][m][n][i]) * acc[ai][1][m][n][i];
                u32x4 w; w.x = pg8::cvt_pk_bf16(o[0], o[1]); w.y = pg8::cvt_pk_bf16(o[2], o[3]); w.z = pg8::cvt_pk_bf16(o[4], o[5]); w.w = pg8::cvt_pk_bf16(o[6], o[7]);
                *(u32x4*)(base + (size_t)(ai * 128 + m * 16) * ldu) = w; }
    }
};
struct EpiResidual {
    static constexpr bool PERM = false, AFTER_DRAIN = false; const float* xin; float* xout; float* xc; const float* gate;
    __device__ __forceinline__ void operator()(const f32x4 (&acc)[2][2][4][2], const pg8::Unit& u, int wr, int wc, int fr, int fq) const {
        const int cls = u.pm < 64 ? 0 : (u.pm < 128 ? 1 : 2), col0 = u.pn * 256 + wc * 32 + 4 * fq;
        const float* gv = gate + (size_t)cls * 6144 + col0;
        const float* bi = u.pm < 128 ? xin + (size_t)u.pm * 256 * DM : xc + (size_t)(u.pm - 128) * 256 * DM;
        float* bo = u.pm < 128 ? xout + (size_t)u.pm * 256 * DM : xc + (size_t)(u.pm - 128) * 256 * DM;
        f32x4 g4[2][2];
#pragma unroll
        for (int bj = 0; bj < 2; ++bj)
#pragma unroll
            for (int n = 0; n < 2; ++n) g4[bj][n] = *(const f32x4*)(gv + bj * 128 + n * 16);
#pragma unroll
        for (int ai = 0; ai < 2; ++ai)
#pragma unroll
            for (int m = 0; m < 4; ++m) { const size_t off = (size_t)(ai * 128 + wr * 64 + m * 16 + fr) * DM + col0;
#pragma unroll
                for (int bj = 0; bj < 2; ++bj)
#pragma unroll
                    for (int n = 0; n < 2; ++n) { const f32x4 xi = *(const f32x4*)(bi + off + bj * 128 + n * 16); *(f32x4*)(bo + off + bj * 128 + n * 16) = xi + g4[bj][n] * acc[ai][bj][m][n]; } }
    }
};
struct EpiMoeScatter {
    static constexpr bool PERM = false, AFTER_DRAIN = false; float* x; const float* gate; const int* tok; const float* wgt; int npe;
    __device__ __forceinline__ void operator()(const f32x4 (&acc)[2][2][4][2], const pg8::Unit& u, int wr, int wc, int fr, int fq) const {
        const int col0 = (u.pn % npe) * 256 + wc * 32 + 4 * fq;
#pragma unroll
        for (int ai = 0; ai < 2; ++ai)
#pragma unroll
            for (int m = 0; m < 4; ++m) { const int r = u.pm * 256 + ai * 128 + wr * 64 + m * 16 + fr; const int tk = tok[r];
                if (tk >= 0) { const float wv = wgt[r]; const float* gv = gate + (size_t)mod_class(tk) * 6144 + col0; float* xr = x + (size_t)tk * DM + col0;
#pragma unroll
                    for (int bj = 0; bj < 2; ++bj)
#pragma unroll
                        for (int n = 0; n < 2; ++n) { const f32x4 g4 = *(const f32x4*)(gv + bj * 128 + n * 16); f32x4* q = (f32x4*)(xr + bj * 128 + n * 16); *q = *q + g4 * wv * acc[ai][bj][m][n]; } } }
    }
};
struct MoeOrder : pg8::StaticOrder {
    int o1, o2, o3, o4, o5, o6, o7, npe;
    __device__ __forceinline__ bool next(int i, pg8::Unit& u) const {
        if (!pg8::StaticOrder::next(i, u)) return false;
        const int r = u.pm * 256; const int e = (r >= o1) + (r >= o2) + (r >= o3) + (r >= o4) + (r >= o5) + (r >= o6) + (r >= o7);
        u.pn += e * npe; return true;
    }
};
#define GEMM_LDS ((PG8_LAS unsigned char*)lds)
__device__ __forceinline__ void ph_gemm_in(const Params& p, int l, int bid, int nb, float* lds) {
    char* ws = p.ws; pg8::Gemm g{(const bf16_t*)(ws + OFF_ACT), (const bf16_t*)(ws + OFF_WIN) + (size_t)l * DIN * DM, NROW, DIN, DM};
    pg8::StaticOrder S; S.init(NROW, DIN, nb, bid);
    EpiStoreBf16 E{(bf16_t*)(ws + OFF_P), DIN};
    pg8::gemm_phase<EpiStoreBf16, pg8::StaticOrder, true, true>(GEMM_LDS, g, S, E);
}
__device__ __forceinline__ void ph_gemm_out(const Params& p, int l, bool need_ctx, int bid, int nb, float* lds) {
    char* ws = p.ws; const int M = need_ctx ? NROW : NLAT;
    pg8::Gemm g{(const bf16_t*)(ws + OFF_ACT), (const bf16_t*)(ws + OFF_WOUT) + (size_t)l * DM * DM, M, DM, DM};
    pg8::StaticOrder S; S.init(M, DM, nb, bid);
    EpiResidual E{l == 0 ? p.x : p.out, p.out, (float*)(ws + OFF_XC), (const float*)(ws + OFF_MOD) + (size_t)l * 3 * 6144 + 2048};
    pg8::gemm_phase<EpiResidual, pg8::StaticOrder, true, true>(GEMM_LDS, g, S, E);
}
__device__ __forceinline__ void ph_ffn1(const Params& p, bool need_ctx, int bid, int nb, float* lds) {
    char* ws = p.ws; const int M = need_ctx ? NROW : NLAT;
    pg8::Gemm g{(const bf16_t*)(ws + OFF_ACT), (const bf16_t*)(ws + OFF_WF13), M, 2 * DFF, DM};
    pg8::StaticOrder S; S.init(M, 2 * DFF, nb, bid);
    EpiSwiglu E{(bf16_t*)(ws + OFF_P), DFF, 2 * DFF / 256};
    pg8::gemm_phase<EpiSwiglu, pg8::StaticOrder, true, true>(GEMM_LDS, g, S, E);
}
__device__ __forceinline__ void ph_ffn2(const Params& p, int l, bool need_ctx, int bid, int nb, float* lds) {
    char* ws = p.ws; const int M = need_ctx ? NROW : NLAT;
    pg8::Gemm g{(const bf16_t*)(ws + OFF_P), (const bf16_t*)(ws + OFF_WF2), M, DM, DFF};
    pg8::StaticOrder S; S.init(M, DM, nb, bid);
    EpiResidual E{p.out, p.out, (float*)(ws + OFF_XC), (const float*)(ws + OFF_MOD) + (size_t)l * 3 * 6144 + 5120};
    pg8::gemm_phase<EpiResidual, pg8::StaticOrder, true, true>(GEMM_LDS, g, S, E);
}
__device__ __forceinline__ MoeOrder moe_order(const int* og, int npe, int nb, int bid) {
    MoeOrder S; S.init(og[8], npe * 256, nb, bid); S.o1 = og[1]; S.o2 = og[2]; S.o3 = og[3]; S.o4 = og[4]; S.o5 = og[5]; S.o6 = og[6]; S.o7 = og[7]; S.npe = npe; return S;
}
__device__ __forceinline__ void ph_moe1(const Params& p, int g, int bid, int nb, float* lds) {
    char* ws = p.ws; int* offs = (int*)(lds + 32768); __syncthreads(); moe_offsets(p, offs);
    const MoeOrder S = moe_order(offs + g * 9, 2 * DFE / 256, nb, bid);
    pg8::Gemm gm{(const bf16_t*)(ws + OFF_ASORT) + (size_t)g * GRP_ROWS * DM, (const bf16_t*)(ws + OFF_WM13), 0, 0, DM};
    EpiSwiglu E{(bf16_t*)(ws + OFF_UMOE), DFE, 2 * DFE / 256};
    pg8::gemm_phase<EpiSwiglu, MoeOrder, true, true>(GEMM_LDS, gm, S, E);
}
__device__ __forceinline__ void ph_moe2(const Params& p, int l, int g, int bid, int nb, float* lds) {
    char* ws = p.ws; int* offs = (int*)(lds + 32768); __syncthreads(); moe_offsets(p, offs);
    const MoeOrder S = moe_order(offs + g * 9, DM / 256, nb, bid);
    pg8::Gemm gm{(const bf16_t*)(ws + OFF_UMOE), (const bf16_t*)(ws + OFF_WM2), 0, 0, DFE};
    EpiMoeScatter E{p.out, (const float*)(ws + OFF_MOD) + (size_t)l * 3 * 6144 + 5120, (const int*)(ws + OFF_TOK) + g * GRP_ROWS, (const float*)(ws + OFF_WGT) + g * GRP_ROWS, DM / 256};
    pg8::gemm_phase<EpiMoeScatter, MoeOrder, true, true>(GEMM_LDS, gm, S, E);
}

#define XB_TMO      128
#define XB_XCNT(j)  (256  + 64 * (j))
#define XB_XSUB(j)  (1280 + 64 * (j))
#define XB_XGEN(j)  (2304 + 64 * (j))
#define XB_TOP      3328
#define XB_TOPGEN   3392
#define XCD_BAR_WORDS 3456
#define XB_SPIN_CAP (1u << 22)

__device__ __forceinline__ unsigned xb_ld(unsigned* p)              { return __hip_atomic_load(p, __ATOMIC_RELAXED, __HIP_MEMORY_SCOPE_AGENT); }
__device__ __forceinline__ unsigned xb_add(unsigned* p, unsigned v) { return __hip_atomic_fetch_add(p, v, __ATOMIC_RELAXED, __HIP_MEMORY_SCOPE_AGENT); }
__device__ __forceinline__ unsigned xb_xcc_id() { return (unsigned)__builtin_amdgcn_s_getreg((3 << 11) | 20) & 0xFu; }
#define XB_SPIN(cond, bar) do { unsigned _sp = 0; while (cond) { __builtin_amdgcn_s_sleep(1); \
    if ((++_sp & 255u) == 0u) { if (xb_ld(&(bar)[XB_TMO])) break; if (_sp > XB_SPIN_CAP) { atomicAdd(&(bar)[XB_TMO], 1u); break; } } } } while (0)

struct XcdBarrier {
    unsigned* bar; unsigned x;
    volatile LAS unsigned* st;
};

__device__ __forceinline__ XcdBarrier xcd_barrier_post(unsigned* bar, volatile LAS unsigned* st) {
    XcdBarrier b; b.bar = bar; b.x = xb_xcc_id(); b.st = st;
    if (threadIdx.x == 0) (void)xb_add(&bar[XB_XCNT(b.x)], 1u);
    return b;
}
__device__ __forceinline__ void xcd_barrier_complete(unsigned* bar, unsigned x, unsigned& nloc, unsigned& nx) {
    const unsigned G = gridDim.x * gridDim.y * gridDim.z;
    unsigned sum, cnt, mine, sp = 0u;
    for (;;) {
        sum = 0u; cnt = 0u; mine = 0u;
#pragma unroll
        for (unsigned j = 0; j < 16; ++j) { const unsigned c = xb_ld(&bar[XB_XCNT(j)]); sum += c; cnt += (c > 0u) ? 1u : 0u; mine = (j == x) ? c : mine; }
        if (sum == G) break;
        __builtin_amdgcn_s_sleep(1);
        if ((++sp & 255u) == 0u) { if (xb_ld(&bar[XB_TMO])) break; if (sp > XB_SPIN_CAP) { atomicAdd(&bar[XB_TMO], 1u); break; } }
    }
    nloc = mine > 0u ? mine : 1u; nx = cnt > 0u ? cnt : 1u;
}

__device__ __forceinline__ void xcd_barrier(const XcdBarrier& b) {
    asm volatile("s_waitcnt vmcnt(0)" ::: "memory");
    __syncthreads();
    if (threadIdx.x == 0) {
        unsigned* bar = b.bar;
        __builtin_amdgcn_s_waitcnt(0);
        unsigned nloc = b.st[0], nx = b.st[1];
        if (nloc == 0u) { xcd_barrier_complete(bar, b.x, nloc, nx); b.st[0] = nloc; b.st[1] = nx; }
        const unsigned old = xb_add(&bar[XB_XSUB(b.x)], 1u);
        const unsigned gen = old / nloc;
        if (old + 1u == (gen + 1u) * nloc) {
            __builtin_amdgcn_fence(__ATOMIC_RELEASE, "agent");
            asm volatile("s_waitcnt vmcnt(0)" ::: "memory");
            const unsigned og = xb_add(&bar[XB_TOP], 1u);
            const unsigned tg = og / nx;
            if (og + 1u == (tg + 1u) * nx) xb_add(&bar[XB_TOPGEN], 1u);
            else XB_SPIN(xb_ld(&bar[XB_TOPGEN]) == tg, bar);
            __builtin_amdgcn_fence(__ATOMIC_ACQUIRE, "agent");
            xb_add(&bar[XB_XGEN(b.x)], 1u);
            asm volatile("s_waitcnt vmcnt(0)" ::: "memory");
        } else {
            XB_SPIN(xb_ld(&bar[XB_XGEN(b.x)]) == gen, bar);
            __builtin_amdgcn_fence(__ATOMIC_ACQUIRE, "agent");
            asm volatile("s_waitcnt vmcnt(0)" ::: "memory");
        }
    }
    __syncthreads();
}


constexpr int LDS_FLOATS = 33792;
constexpr int LDS_BYTES = LDS_FLOATS * 4 + 16 + 256;

typedef const __attribute__((address_space(4))) unsigned long long* kargp_t;
typedef __attribute__((address_space(1))) const float* gcf_t;
__device__ __forceinline__ Params load_params(const float* lds) {
    const LAS unsigned* tbl = (const LAS unsigned*)(lds + LDS_FLOATS + 4);
    Params p; const float** f = (const float**)&p;
#pragma unroll
    for (int i = 0; i < (int)(sizeof(Params) / 8); ++i) {
        const unsigned lo = __builtin_amdgcn_readfirstlane(tbl[2 * i]), hi = __builtin_amdgcn_readfirstlane(tbl[2 * i + 1]);
        f[i] = (const float*)(gcf_t)(((unsigned long long)hi << 32) | lo); }
    return p;
}
#define LOADP(name) const Params name = load_params(lds)

template <int l>
__device__ __forceinline__ void run_layer(const XcdBarrier& bar, int bid, int nb, float* lds) {
    constexpr bool need_ctx = l == 0;
    constexpr float lam_init = l == 0 ? 0.2f : 0.35550906759509393f;
    { LOADP(p); ph_norm<false>(p, l, 0, NROW, bid, nb); } xcd_barrier(bar);
    { LOADP(p); ph_gemm_in(p, l, bid, nb, lds); } xcd_barrier(bar);
    { LOADP(p); ph_rope(p, bid, nb); } xcd_barrier(bar);
    { LOADP(p); ph_ret_summ(p, l, bid, nb, lds); } { LOADP(p); ph_lru_chunk<1>(p, l, bid, nb, lds, 0); } xcd_barrier(bar);
    { LOADP(p); ph_scan2(p, l, bid, nb); } xcd_barrier(bar);
    { LOADP(p); ph_diff(p, l, need_ctx, lam_init, bid, nb, lds); }
    { LOADP(p); ph_swa(p, l, need_ctx, bid, nb); }
    { LOADP(p); ph_ret_out(p, l, bid, nb, lds, need_ctx ? 0 : 2); }
    { LOADP(p); ph_lru_chunk<3>(p, l, bid, nb, lds, need_ctx ? 0 : 2); } xcd_barrier(bar);
    { LOADP(p); ph_gemm_out(p, l, need_ctx, bid, nb, lds); } xcd_barrier(bar);
    if (l == 0) {
        { LOADP(p); ph_norm<false>(p, l, 1, NROW, bid, nb); } xcd_barrier(bar);
        { LOADP(p); ph_ffn1(p, need_ctx, bid, nb, lds); } xcd_barrier(bar);
        { LOADP(p); ph_ffn2(p, l, need_ctx, bid, nb, lds); } xcd_barrier(bar);
    } else {
        { LOADP(p); ph_norm<true>(p, l, 1, NLAT, bid, nb); } xcd_barrier(bar);
        { LOADP(p); ph_moe_scatter(p, bid, nb, lds); } xcd_barrier(bar);
        { LOADP(p); ph_moe1(p, 0, bid, nb, lds); } xcd_barrier(bar);
        { LOADP(p); ph_moe2(p, l, 0, bid, nb, lds); } xcd_barrier(bar);
        { LOADP(p); ph_moe1(p, 1, bid, nb, lds); } xcd_barrier(bar);
        { LOADP(p); ph_moe2(p, l, 1, bid, nb, lds); } xcd_barrier(bar);
    }
}

__global__ void __launch_bounds__(512, 2) fwd(Params p_in) {
    extern __shared__ __attribute__((aligned(16))) float lds[];
    volatile LAS unsigned* st = (volatile LAS unsigned*)(lds + LDS_FLOATS);
    if (threadIdx.x == 0) { st[0] = 0u; st[1] = 0u; st[2] = 0u; st[3] = 0u; }
    if (threadIdx.x < (int)(sizeof(Params) / 8)) { const kargp_t q = (kargp_t)__builtin_amdgcn_kernarg_segment_ptr(); ((LAS unsigned long long*)(lds + LDS_FLOATS + 4))[threadIdx.x] = q[threadIdx.x]; }
    __syncthreads();
    XcdBarrier bar;
    { LOADP(p); bar = xcd_barrier_post((unsigned*)p.ws, st); }
    const int bid = blockIdx.x, nb = gridDim.x;
    { LOADP(p); ph_prologue(p, bid, nb, lds); } xcd_barrier(bar);
    run_layer<0>(bar, bid, nb, lds);
    run_layer<1>(bar, bid, nb, lds);
    { LOADP(p); ph_final(p, bid, nb); }
}

extern "C" void kernel_launch(void* const* d_in, const int* in_sizes, int n_in, void* d_out, int out_size, void* d_ws, size_t ws_size, hipStream_t stream) {
    static int grid = 0;
    if (grid == 0) {
        if (n_in < 30 || ws_size < WS_NEED) { fprintf(stderr, "kernel_launch: bad args n_in=%d ws=%zu need=%zu\n", n_in, ws_size, (size_t)WS_NEED); grid = -1; return; }
        int dev = 0, cus = 0, per_cu = 0;
        if (hipGetDevice(&dev) != hipSuccess || hipDeviceGetAttribute(&cus, hipDeviceAttributeMultiprocessorCount, dev) != hipSuccess) { grid = -1; return; }
        if (hipFuncSetAttribute((const void*)fwd, hipFuncAttributeMaxDynamicSharedMemorySize, LDS_BYTES) != hipSuccess) { fprintf(stderr, "kernel_launch: hipFuncSetAttribute failed\n"); grid = -1; return; }
        if (hipOccupancyMaxActiveBlocksPerMultiprocessor(&per_cu, (const void*)fwd, 512, LDS_BYTES) != hipSuccess || per_cu < 1) { fprintf(stderr, "kernel_launch: occupancy query says %d\n", per_cu); per_cu = 1; }
        (void)hipGetLastError();
        grid = cus;
    }
    if (grid < 0) return;
    Params p{};
    const float** f = (const float**)&p;
    for (int i = 0; i < 30; ++i) f[i] = (const float*)d_in[i];
    p.out = (float*)d_out; p.ws = (char*)d_ws;
    (void)hipMemsetAsync(d_ws, 0, 65536, stream);
    hipLaunchKernelGGL(fwd, dim3(grid), dim3(512), LDS_BYTES, stream, p);
}
```

```cpp
#include <hip/hip_runtime.h>
#include <cstdio>
#include <cstdint>

typedef unsigned short bf16_t;
typedef short bf16x8 __attribute__((ext_vector_type(8)));
typedef float f32x4 __attribute__((ext_vector_type(4)));
typedef unsigned u32x4 __attribute__((ext_vector_type(4)));
#define LAS __attribute__((address_space(3)))

constexpr int NB = 2, NSEQ = 16384, NCTX = 256, DM = 1024;
constexpr int NLAT = NB * NSEQ;
constexpr int NCR = NB * NCTX;
constexpr int NROW = NLAT + NCR;
constexpr int DIN = 2816, DFF = 2816, DFE = 3584, NE = 8;
constexpr int NCI = 130;
constexpr int C_AQ = 0, C_AK = 256, C_AV = 384, C_RQ = 512, C_RK = 768, C_RV = 1024, C_RG = 1280, C_DQ = 1536, C_DK = 1792, C_DV = 2048, C_LX = 2304, C_LY = 2560;
constexpr int GRP_ROWS = 34816;

constexpr size_t al256(size_t x) { return (x + 255) & ~(size_t)255; }
constexpr size_t OFF_CTRL = 0;
constexpr size_t OFF_MOD = 65536;
constexpr size_t OFF_ROPE_RET = al256(OFF_MOD + 2 * 3 * 6144 * 4);
constexpr size_t OFF_ROPE_AX = al256(OFF_ROPE_RET + 2 * 16384 * 32 * 4);
constexpr size_t OFF_XC = al256(OFF_ROPE_AX + (2 * 256 * 16 + 2 * 64 * 16 + 2 * 256 * 8 + 2 * 64 * 8) * 4);
constexpr size_t OFF_ROUTE = al256(OFF_XC + (size_t)NCR * DM * 4);
constexpr size_t OFF_TOK = al256(OFF_ROUTE + (size_t)NLAT * 16);
constexpr size_t OFF_WGT = al256(OFF_TOK + (size_t)2 * GRP_ROWS * 4);
constexpr size_t OFF_LRU = al256(OFF_WGT + (size_t)2 * GRP_ROWS * 4);
constexpr size_t OFF_WM13 = al256(OFF_LRU + (size_t)3 * 2 * 2 * NCI * 256 * 4);
constexpr size_t OFF_WM2 = al256(OFF_WM13 + (size_t)NE * 2 * DFE * DM * 2);
constexpr size_t OFF_R = al256(OFF_WM2 + (size_t)NE * DM * DFE * 2);
constexpr size_t OFF_P = OFF_R;
constexpr size_t OFF_ACT = al256(OFF_P + (size_t)NROW * DIN * 2);
constexpr size_t OFF_RET = al256(OFF_ACT + (size_t)NROW * DM * 2);
constexpr size_t OFF_WIN = al256(OFF_RET + (size_t)2 * 2 * NCI * 4 * 4096 * 4);
constexpr size_t OFF_WOUT = al256(OFF_WIN + (size_t)2 * DIN * DM * 2);
constexpr size_t OFF_WF13 = al256(OFF_WOUT + (size_t)2 * DM * DM * 2);
constexpr size_t OFF_WF2 = al256(OFF_WF13 + (size_t)2 * DFF * DM * 2);
constexpr size_t OFF_R_END1 = al256(OFF_WF2 + (size_t)DM * DFF * 2);
constexpr size_t OFF_ASORT = OFF_R;
constexpr size_t OFF_UMOE = al256(OFF_ASORT + (size_t)2 * GRP_ROWS * DM * 2);
constexpr size_t OFF_R_END2 = al256(OFF_UMOE + (size_t)GRP_ROWS * DFE * 2);
constexpr size_t WS_NEED = OFF_R_END1 > OFF_R_END2 ? OFF_R_END1 : OFF_R_END2;
static_assert(OFF_ACT >= OFF_UMOE, "H2 must not overlap A_sorted");
constexpr int CW_CNT = 4096;
constexpr int CW_CUR = 4160;

struct Params {
    const float *x, *c, *ctx, *c_ctx, *w_ada, *b_ada, *g1, *g2, *w_in, *w_out, *sink, *ret_logit, *ret_gn, *diff_lam, *diff_gn,
        *conv_w, *conv_b, *lru_wa, *lru_ba, *lru_wx, *lru_bx, *lru_lam, *ffn_w1, *ffn_w3, *ffn_w2, *moe_router, *moe_w1, *moe_w3, *moe_w2, *final_norm;
    float* out; char* ws;
};

__device__ __forceinline__ int ltid_() { int t = threadIdx.x; asm volatile("" : "+v"(t)); return t; }
#define TIDX ltid_()
__device__ __forceinline__ float bf2f(bf16_t h) { return __uint_as_float(((unsigned)h) << 16); }
__device__ __forceinline__ bf16_t f2bf(float f) { unsigned u = __float_as_uint(f); u += 0x7fffu + ((u >> 16) & 1u); return (bf16_t)(u >> 16); }
__device__ __forceinline__ unsigned pack2(float lo, float hi) { return (unsigned)f2bf(lo) | ((unsigned)f2bf(hi) << 16); }
__device__ __forceinline__ float wave_sum(float v) {
#pragma unroll
    for (int o = 32; o >= 1; o >>= 1) v += __shfl_xor(v, o);
    return v;
}
__device__ __forceinline__ float sigmoidf_(float x) { return 1.0f / (1.0f + __expf(-x)); }
__device__ __forceinline__ float siluf_(float x) { return x / (1.0f + __expf(-x)); }
__device__ __forceinline__ float softplusf_(float x) { return x > 20.f ? x : log1pf(expf(x)); }
__device__ __forceinline__ float gelu_tanh(float x) { const float u = 0.7978845608028654f * (x + 0.044715f * x * x * x); return 0.5f * x * (1.0f + tanhf(u)); }
__device__ __forceinline__ int row_base(int b, int ci) { return ci < 2 ? NLAT + b * NCTX + ci * 128 : b * NSEQ + (ci - 2) * 128; }
__device__ __forceinline__ int mod_class(int row) { return row < NSEQ ? 0 : (row < NLAT ? 1 : 2); }

__device__ __forceinline__ void convert_tile(const float* src, int K, int N, bf16_t* dst, int tile, int mode, float* lds) {
    const int tpn = N / 64, tk = tile / tpn, tn = tile % tpn, t = TIDX;
    {   const int kk = t >> 3, nc = (t & 7) * 8;
        const float4 a = *(const float4*)(src + (size_t)(tk * 64 + kk) * N + tn * 64 + nc);
        const float4 b = *(const float4*)(src + (size_t)(tk * 64 + kk) * N + tn * 64 + nc + 4);
        float* d = lds + kk * 65 + nc; d[0] = a.x; d[1] = a.y; d[2] = a.z; d[3] = a.w; d[4] = b.x; d[5] = b.y; d[6] = b.z; d[7] = b.w; }
    __syncthreads();
    {   const int n = t >> 3, kc = (t & 7) * 8, ng = tn * 64 + n;
        const int nrow = mode == 0 ? ng : ((ng >> 7) * 256 + (mode == 2 ? 128 : 0) + (ng & 127));
        uint4 w; w.x = pack2(lds[(kc + 0) * 65 + n], lds[(kc + 1) * 65 + n]); w.y = pack2(lds[(kc + 2) * 65 + n], lds[(kc + 3) * 65 + n]);
        w.z = pack2(lds[(kc + 4) * 65 + n], lds[(kc + 5) * 65 + n]); w.w = pack2(lds[(kc + 6) * 65 + n], lds[(kc + 7) * 65 + n]);
        *(uint4*)(dst + (size_t)nrow * K + tk * 64 + kc) = w; }
    __syncthreads();
}

__device__ __forceinline__ void ph_prologue(const Params& p, int bid, int nb, float* lds) {
    char* ws = p.ws; const int t = TIDX;
    {
        struct Job { const float* src; bf16_t* dst; int K, N, mode, base; };
        Job* jobs = (Job*)(lds + 64 * 65 + 3);
        const int T_IN = 16 * 44, T_OUT = 16 * 16, T_F13 = 16 * 44, T_F2 = 44 * 16, T_M13 = 16 * 56, T_M2 = 56 * 16;
        const int total = 2 * T_IN + 2 * T_OUT + 2 * T_F13 + T_F2 + 16 * T_M13 + 8 * T_M2;
        if (t < 32) {
            Job jb; jb.src = nullptr; jb.dst = nullptr; jb.K = DM; jb.N = DM; jb.mode = 0; jb.base = total;
            if (t < 2) { jb.src = p.w_in + (size_t)t * DM * DIN; jb.dst = (bf16_t*)(ws + OFF_WIN) + (size_t)t * DIN * DM; jb.N = DIN; jb.base = t * T_IN; }
            else if (t < 4) { jb.src = p.w_out + (size_t)(t - 2) * DM * DM; jb.dst = (bf16_t*)(ws + OFF_WOUT) + (size_t)(t - 2) * DM * DM; jb.base = 2 * T_IN + (t - 2) * T_OUT; }
            else if (t < 6) { jb.src = t == 4 ? p.ffn_w1 : p.ffn_w3; jb.dst = (bf16_t*)(ws + OFF_WF13); jb.N = DFF; jb.mode = t - 3; jb.base = 2 * T_IN + 2 * T_OUT + (t - 4) * T_F13; }
            else if (t == 6) { jb.src = p.ffn_w2; jb.dst = (bf16_t*)(ws + OFF_WF2); jb.K = DFF; jb.base = 2 * T_IN + 2 * T_OUT + 2 * T_F13; }
            else if (t < 23) { const int q = t - 7, e = q & 7, w3 = q >> 3; jb.src = (w3 ? p.moe_w3 : p.moe_w1) + (size_t)e * DM * DFE; jb.dst = (bf16_t*)(ws + OFF_WM13) + (size_t)e * 2 * DFE * DM; jb.N = DFE; jb.mode = 1 + w3;
                jb.base = 2 * T_IN + 2 * T_OUT + 2 * T_F13 + T_F2 + q * T_M13; }
            else if (t < 31) { const int e = t - 23; jb.src = p.moe_w2 + (size_t)e * DFE * DM; jb.dst = (bf16_t*)(ws + OFF_WM2) + (size_t)e * DM * DFE; jb.K = DFE;
                jb.base = 2 * T_IN + 2 * T_OUT + 2 * T_F13 + T_F2 + 16 * T_M13 + e * T_M2; }
            jobs[t] = jb;
        }
        __syncthreads();
        int j = 0;
        for (int u = bid; u < total; u += nb) {
            while (u >= jobs[j + 1].base) ++j;
            const Job jb = jobs[j];
            convert_tile(jb.src, jb.K, jb.N, jb.dst, u - jb.base, jb.mode, lds);
        }
        __syncthreads();
    }
    {
        float* sv = lds;
        float* red = lds + 3072;
        for (int i = t; i < 3072; i += 512) { const int v = i >> 10, k = i & 1023; const float cv = v < 2 ? p.c[v * DM + k] : p.c_ctx[k]; sv[i] = siluf_(cv); }
        __syncthreads();
        float* mod = (float*)(ws + OFF_MOD);
        for (int u = bid; u < 2 * 96; u += nb) {
            const int l = u / 96, j0 = (u % 96) * 64, j = t & 63, kg = t >> 6;
            float a0 = 0.f, a1 = 0.f, a2 = 0.f;
            const float* w = p.w_ada + (size_t)l * DM * 6144 + j0 + j;
            for (int k = kg * 128; k < kg * 128 + 128; ++k) { const float wv = w[(size_t)k * 6144]; a0 += sv[k] * wv; a1 += sv[1024 + k] * wv; a2 += sv[2048 + k] * wv; }
            red[(kg * 3 + 0) * 64 + j] = a0; red[(kg * 3 + 1) * 64 + j] = a1; red[(kg * 3 + 2) * 64 + j] = a2;
            __syncthreads();
            if (t < 192) { const int v = t >> 6; float s = 0.f;
                for (int g = 0; g < 8; ++g) s += red[(g * 3 + v) * 64 + j];
                mod[((size_t)l * 3 + v) * 6144 + j0 + j] = s + p.b_ada[l * 6144 + j0 + j]; }
            __syncthreads();
        }
    }
    {
        float* rr = (float*)(ws + OFF_ROPE_RET);
        const int gt = bid * 512 + t, gs = nb * 512;
        for (int i = gt; i < 16384 * 32; i += gs) { const int n = i >> 5, j = i & 31;
            const float inv = (float)pow(10000.0, -(double)j / 32.0); const float ang = (float)n * inv;
            rr[i] = (float)cos((double)ang); rr[16384 * 32 + i] = (float)sin((double)ang); }
        float* ax = (float*)(ws + OFF_ROPE_AX);
        for (int i = gt; i < 256 * 16; i += gs) { const int n = i >> 4, j = i & 15; const float inv = (float)pow(10000.0, -(double)j / 16.0); const float ang = (float)n * inv;
            ax[i] = (float)cos((double)ang); ax[4096 + i] = (float)sin((double)ang);
            if (n < 64) { ax[8192 + i] = (float)cos((double)ang); ax[9216 + i] = (float)sin((double)ang); } }
        for (int i = gt; i < 256 * 8; i += gs) { const int n = i >> 3, j = i & 7; const float inv = (float)pow(10000.0, -(double)j / 8.0); const float ang = (float)n * inv;
            ax[10240 + i] = (float)cos((double)ang); ax[12288 + i] = (float)sin((double)ang);
            if (n < 64) { ax[14336 + i] = (float)cos((double)ang); ax[14848 + i] = (float)sin((double)ang); } }
        float* xc = (float*)(ws + OFF_XC);
        for (int i = gt; i < NCR * DM / 4; i += gs) ((float4*)xc)[i] = ((const float4*)p.ctx)[i];
        int* tok = (int*)(ws + OFF_TOK);
        for (int i = gt; i < 2 * GRP_ROWS; i += gs) tok[i] = -1;
    }
}

template <bool ROUTE>
__device__ __forceinline__ void ph_norm(const Params& p, int l, int which  , int nrows, int bid, int nb) {
    char* ws = p.ws; const int lane = TIDX & 63, wv = TIDX >> 6;
    const float* mod = (const float*)(ws + OFF_MOD) + (size_t)l * 3 * 6144;
    const float* g = (which == 0 ? p.g1 : p.g2) + l * DM;
    bf16_t* H = (bf16_t*)(ws + OFF_ACT);
    const float* xl = (which == 0 && l == 0) ? p.x : p.out;
    const float* xc = (const float*)(ws + OFF_XC);
    for (int r = bid * 8 + wv; r < nrows; r += nb * 8) {
        const float* xr = r < NLAT ? xl + (size_t)r * DM : xc + (size_t)(r - NLAT) * DM;
        const float* mv = mod + (size_t)mod_class(r) * 6144 + (which == 0 ? 0 : 3072);
        float4 v[4]; float ss = 0.f;
#pragma unroll
        for (int i = 0; i < 4; ++i) { v[i] = *(const float4*)(xr + i * 256 + lane * 4); ss += v[i].x * v[i].x + v[i].y * v[i].y + v[i].z * v[i].z + v[i].w * v[i].w; }
        ss = wave_sum(ss);
        const float rn = rsqrtf(ss * (1.0f / 1024.0f) + 1e-6f);
        float lg[8];
        if (ROUTE) {
#pragma unroll
            for (int e = 0; e < 8; ++e) lg[e] = 0.f;
        }
#pragma unroll
        for (int i = 0; i < 4; ++i) {
            const int c = i * 256 + lane * 4;
            const float4 gg = *(const float4*)(g + c), sh = *(const float4*)(mv + c), sc = *(const float4*)(mv + 1024 + c);
            float h0 = v[i].x * rn * gg.x * (1.f + sc.x) + sh.x, h1 = v[i].y * rn * gg.y * (1.f + sc.y) + sh.y;
            float h2 = v[i].z * rn * gg.z * (1.f + sc.z) + sh.z, h3 = v[i].w * rn * gg.w * (1.f + sc.w) + sh.w;
            uint2 w; w.x = pack2(h0, h1); w.y = pack2(h2, h3);
            *(uint2*)(H + (size_t)r * DM + c) = w;
            if (ROUTE) {
                const float* rt = p.moe_router + (size_t)c * 8;
#pragma unroll
                for (int e = 0; e < 8; ++e) lg[e] += h0 * rt[e] + h1 * rt[8 + e] + h2 * rt[16 + e] + h3 * rt[24 + e];
            }
        }
        if (ROUTE) {
#pragma unroll
            for (int e = 0; e < 8; ++e) lg[e] = wave_sum(lg[e]);
            if (lane == 0 && r < NLAT) {
                int e0 = 0; float v0 = lg[0];
#pragma unroll
                for (int e = 1; e < 8; ++e) if (lg[e] > v0) { v0 = lg[e]; e0 = e; }
                int e1 = -1; float v1 = -3.0e38f;
#pragma unroll
                for (int e = 0; e < 8; ++e) if (e != e0 && lg[e] > v1) { v1 = lg[e]; e1 = e; }
                const float ex = __expf(v1 - v0), w0 = 1.0f / (1.0f + ex), w1 = ex / (1.0f + ex);
                int4 rec; rec.x = e0; rec.y = e1; rec.z = __float_as_int(w0); rec.w = __float_as_int(w1);
                *(int4*)(ws + OFF_ROUTE + (size_t)r * 16) = rec;
                unsigned* cw = (unsigned*)ws;
                atomicAdd(cw + CW_CNT + e0, 1u); atomicAdd(cw + CW_CNT + 8 + e1, 1u);
            }
        }
    }
}

namespace pg8 {
#define PG8_LAS __attribute__((address_space(3)))
typedef unsigned short bf16_t;
typedef short bf16x8 __attribute__((ext_vector_type(8)));
typedef float f32x4 __attribute__((ext_vector_type(4)));
typedef unsigned u32x4 __attribute__((ext_vector_type(4)));
constexpr int BM = 256, BK = 64, HALF = 128, HTB = HALF * BK * 2  , STAGE_BYTES = 8 * HTB, NXCD = 8, WGM = 8;

__host__ __device__ __forceinline__ int lds_byte(int r, int c) { const int st = (r >> 4) * 2 + (c >> 5), rr = r & 15, cc = c & 31, ob = rr * 64 + cc * 2; return st * 1024 + (ob ^ (((ob >> 9) & 1) << 5)); }
__host__ __device__ __forceinline__ void stage_rc(int b, int& R, int& C) { const int st = b / 1024, sb = b % 1024, swz = sb ^ (((sb >> 9) & 1) << 5); R = (st >> 1) * 16 + swz / 64; C = (st & 1) * 32 + (swz % 64) / 2; }
__host__ __device__ __forceinline__ int perm32(int rho) { const int n = rho >> 4, i = rho & 15; return 8 * (i >> 2) + 4 * n + (i & 3); }

struct Unit { int pm, pn; };
struct Gemm { const bf16_t* A; const bf16_t* Bt; int M, N, K; };

struct StaticOrder {
    int nM, nN, nwg, G, c;
    __host__ __device__ void init(int M, int N, int G_, int c_) { nM = M / BM; nN = N / BM; nwg = nM * nN; G = G_; c = c_; }
    __host__ __device__ bool next(int i, Unit& u) const {
        const long L = (long)i * G + c; if (L >= nwg) return false;
        int wgid = (int)L; { const int q = nwg / NXCD, r = nwg % NXCD, xcd = wgid % NXCD, off = wgid / NXCD; wgid = (xcd < r ? xcd * (q + 1) : r * (q + 1) + (xcd - r) * q) + off; }
        const int nig = WGM * nN, gid = wgid / nig, fm = gid * WGM, gsz = (nM - fm) < WGM ? (nM - fm) : WGM;
        u.pm = fm + ((wgid % nig) % gsz); u.pn = (wgid % nig) / gsz; return true;
    }
    __device__ __forceinline__ void a_ready(const Unit&) const {}
    __device__ __forceinline__ void done(const Unit&) const {}
};
__device__ __forceinline__ unsigned cvt_pk_bf16(float lo, float hi) { unsigned r; asm volatile("v_cvt_pk_bf16_f32 %0, %1, %2" : "=v"(r) : "v"(lo), "v"(hi)); return r; }
typedef float f32x2 __attribute__((ext_vector_type(2)));
template <class Epi, class Sched, bool ALIGN_EPI = false, bool SP2 = false>
__device__ __forceinline__ void gemm_phase(PG8_LAS unsigned char* lds, const Gemm g, const Sched& S, const Epi& E) {
    int tid_ = threadIdx.x; asm volatile("" : "+v"(tid_));
    const int tid = tid_, wid = __builtin_amdgcn_readfirstlane(tid >> 6), lane = tid & 63, wr = wid >> 2, wc = wid & 3, fr = lane & 15, fq = lane >> 4;
    const int K = g.K, nt = K / BK;
    unsigned voffA[2], voffB[2];
#pragma unroll
    for (int i = 0; i < 2; ++i) { int R, C; stage_rc(tid * 16 + i * 8192, R, C); const int Rb = Epi::PERM ? ((R & ~31) + perm32(R & 31)) : R;
        voffA[i] = (unsigned)(R * K + C) * 2u; voffB[i] = (unsigned)(Rb * K + C) * 2u; }
    const size_t kstep = (size_t)(BK * 2);
    const size_t hstep = (size_t)HALF * K * 2;
    const size_t tstep = 2 * hstep;
    const unsigned ldsw = (unsigned)wid * 1024u;
    const int aoff = lds_byte(wr * 64 + fr, fq * 8), boff = lds_byte(wc * 32 + fr, fq * 8);
#define PG8_SA(b, h) (((b) * 2 + (h)) * HTB)
#define PG8_SB(b, h) ((4 + (b) * 2 + (h)) * HTB)
#define PG8_STAGE(bufoff, gbase, voff) do { _Pragma("unroll") for (int _i = 0; _i < 2; ++_i) \
        __builtin_amdgcn_global_load_lds((const unsigned*)((const char*)(gbase) + (voff)[_i]), (PG8_LAS unsigned*)(lds + (bufoff) + ldsw + _i * 8192), 16, 0, 0); } while (0)
#define PG8_LDA(dst, b, h) do { _Pragma("unroll") for (int m = 0; m < 4; ++m) _Pragma("unroll") for (int k = 0; k < 2; ++k) dst[m][k] = *(const PG8_LAS bf16x8*)(lds + PG8_SA(b, h) + aoff + m * 2048 + k * 1024); } while (0)
#define PG8_LDB(dst, b, h) do { _Pragma("unroll") for (int n = 0; n < 2; ++n) _Pragma("unroll") for (int k = 0; k < 2; ++k) dst[n][k] = *(const PG8_LAS bf16x8*)(lds + PG8_SB(b, h) + boff + n * 2048 + k * 1024); } while (0)
#define PG8_MMA(ai, bj, At, Bt) do { __builtin_amdgcn_s_setprio(1); _Pragma("unroll") for (int m = 0; m < 4; ++m) _Pragma("unroll") for (int n = 0; n < 2; ++n) _Pragma("unroll") for (int k = 0; k < 2; ++k) \
        acc[ai][bj][m][n] = __builtin_amdgcn_mfma_f32_16x16x32_bf16(Bt[n][k], At[m][k], acc[ai][bj][m][n], 0, 0, 0); __builtin_amdgcn_s_setprio(0); } while (0)
#define PG8_WAIT_V(n) asm volatile("s_waitcnt vmcnt(" #n ")" ::: "memory")
#define PG8_WAIT_L(n) asm volatile("s_waitcnt lgkmcnt(" #n ")" ::: "memory")
#define PG8_BAR __builtin_amdgcn_s_barrier()
#define PG8_SCHED __builtin_amdgcn_sched_barrier(0)
    Unit cur, nxt; int ui = 0;
    if (!S.next(0, cur)) return;
    f32x4 acc[2][2][4][2];
#pragma unroll
    for (int a = 0; a < 2; ++a)
#pragma unroll
        for (int b = 0; b < 2; ++b)
#pragma unroll
            for (int m = 0; m < 4; ++m)
#pragma unroll
                for (int n = 0; n < 2; ++n) acc[a][b][m][n] = (f32x4){0.f, 0.f, 0.f, 0.f};
    bf16x8 At[4][2], B0[2][2], B1[2][2];
    const char* cA = (const char*)g.A + (size_t)cur.pm * tstep; const char* cB = (const char*)g.Bt + (size_t)cur.pn * tstep;
    S.a_ready(cur);
    if constexpr (SP2) {
        PG8_STAGE(PG8_SB(0, 0), cB, voffB); PG8_STAGE(PG8_SB(0, 1), cB + hstep, voffB); PG8_STAGE(PG8_SA(0, 0), cA, voffA); PG8_STAGE(PG8_SA(0, 1), cA + hstep, voffA);
        if (wr == 1) PG8_BAR;
        PG8_WAIT_V(2); PG8_BAR;
        PG8_STAGE(PG8_SB(1, 0), cB + kstep, voffB); PG8_STAGE(PG8_SA(1, 0), cA + kstep, voffA); PG8_STAGE(PG8_SB(1, 1), cB + hstep + kstep, voffB);
        PG8_WAIT_V(6); PG8_BAR;
    } else {
        PG8_STAGE(PG8_SB(0, 0), cB, voffB); PG8_STAGE(PG8_SA(0, 0), cA, voffA); PG8_STAGE(PG8_SB(0, 1), cB + hstep, voffB); PG8_STAGE(PG8_SA(0, 1), cA + hstep, voffA);
        if (wr == 1) PG8_BAR;
        PG8_WAIT_V(4); PG8_BAR;
        PG8_STAGE(PG8_SB(1, 0), cB + kstep, voffB); PG8_STAGE(PG8_SA(1, 0), cA + kstep, voffA); PG8_STAGE(PG8_SB(1, 1), cB + hstep + kstep, voffB);
        PG8_WAIT_V(6); PG8_BAR;
    }
    for (;;) {
        const bool has_next = S.next(ui + 1, nxt);
        const char* nA = has_next ? (const char*)g.A + (size_t)nxt.pm * tstep : cA; const char* nB = has_next ? (const char*)g.Bt + (size_t)nxt.pn * tstep : cB;
        for (int t = 0; t < nt; t += 2) {
            const bool last = (t == nt - 2);
            const char* a1 = cA + (size_t)(t + 1) * kstep;
            const char* a2 = last ? nA : cA + (size_t)(t + 2) * kstep; const char* b2 = last ? nB : cB + (size_t)(t + 2) * kstep;
            const char* a3 = a2 + kstep; const char* b3 = b2 + kstep;
            if (last && has_next) S.a_ready(nxt);
            if constexpr (SP2) {
            PG8_LDB(B0, 0, 0); PG8_LDB(B1, 0, 1); PG8_SCHED; PG8_LDA(At, 0, 0); PG8_STAGE(PG8_SA(1, 1), a1 + hstep, voffA);
            PG8_WAIT_V(8); PG8_WAIT_L(0); PG8_BAR; PG8_MMA(0, 0, At, B0); PG8_MMA(0, 1, At, B1); PG8_BAR; PG8_SCHED;
            PG8_LDA(At, 0, 1); PG8_STAGE(PG8_SB(0, 0), b2, voffB); PG8_STAGE(PG8_SB(0, 1), b2 + hstep, voffB); PG8_STAGE(PG8_SA(0, 0), a2, voffA);
            PG8_WAIT_V(8); PG8_WAIT_L(0); PG8_BAR; PG8_MMA(1, 0, At, B0); PG8_MMA(1, 1, At, B1); PG8_BAR; PG8_SCHED;
            PG8_LDB(B0, 1, 0); PG8_LDB(B1, 1, 1); PG8_SCHED; PG8_LDA(At, 1, 0); PG8_STAGE(PG8_SA(0, 1), a2 + hstep, voffA);
            PG8_WAIT_V(8); PG8_WAIT_L(0); PG8_BAR; PG8_MMA(0, 0, At, B0); PG8_MMA(0, 1, At, B1); PG8_BAR; PG8_SCHED;
            PG8_LDA(At, 1, 1); PG8_STAGE(PG8_SB(1, 0), b3, voffB); PG8_STAGE(PG8_SB(1, 1), b3 + hstep, voffB); PG8_STAGE(PG8_SA(1, 0), a3, voffA);
            PG8_WAIT_V(8); PG8_WAIT_L(0); PG8_BAR; PG8_MMA(1, 0, At, B0); PG8_MMA(1, 1, At, B1); PG8_BAR; PG8_SCHED;
            } else {
            PG8_LDB(B0, 0, 0); PG8_SCHED; PG8_LDA(At, 0, 0); PG8_STAGE(PG8_SA(1, 1), a1 + hstep, voffA);
            PG8_WAIT_L(8); PG8_BAR; PG8_WAIT_L(0); PG8_MMA(0, 0, At, B0); PG8_BAR; PG8_SCHED;
            PG8_LDB(B1, 0, 1); PG8_STAGE(PG8_SB(0, 0), b2, voffB);
            PG8_BAR; PG8_WAIT_L(0); PG8_MMA(0, 1, At, B1); PG8_BAR;
            PG8_LDA(At, 0, 1); PG8_STAGE(PG8_SA(0, 0), a2, voffA);
            PG8_BAR; PG8_WAIT_L(0); PG8_MMA(1, 0, At, B0); PG8_BAR; PG8_SCHED;
            PG8_STAGE(PG8_SB(0, 1), b2 + hstep, voffB);
            PG8_WAIT_V(6); PG8_BAR; PG8_MMA(1, 1, At, B1); PG8_BAR;
            PG8_LDB(B0, 1, 0); PG8_SCHED; PG8_LDA(At, 1, 0); PG8_STAGE(PG8_SA(0, 1), a2 + hstep, voffA);
            PG8_WAIT_L(8); PG8_BAR; PG8_WAIT_L(0); PG8_MMA(0, 0, At, B0); PG8_BAR; PG8_SCHED;
            PG8_LDB(B1, 1, 1); PG8_STAGE(PG8_SB(1, 0), b3, voffB);
            PG8_BAR; PG8_WAIT_L(0); PG8_MMA(0, 1, At, B1); PG8_BAR;
            PG8_LDA(At, 1, 1); PG8_STAGE(PG8_SA(1, 0), a3, voffA);
            PG8_BAR; PG8_WAIT_L(0); PG8_MMA(1, 0, At, B0); PG8_BAR; PG8_SCHED;
            PG8_STAGE(PG8_SB(1, 1), b3 + hstep, voffB);
            PG8_WAIT_V(6); PG8_BAR; PG8_MMA(1, 1, At, B1); PG8_BAR;
            }
        }
        if constexpr (ALIGN_EPI) { if (wr == 0) PG8_BAR; }
        if constexpr (!Epi::AFTER_DRAIN) { E(acc, cur, wr, wc, fr, fq); S.done(cur); }
        if (!has_next) break;
#pragma unroll
        for (int a = 0; a < 2; ++a)
#pragma unroll
            for (int b = 0; b < 2; ++b)
#pragma unroll
                for (int m = 0; m < 4; ++m)
#pragma unroll
                    for (int n = 0; n < 2; ++n) acc[a][b][m][n] = (f32x4){0.f, 0.f, 0.f, 0.f};
        cur = nxt; cA = nA; cB = nB; ++ui;
        if constexpr (ALIGN_EPI) { if (wr == 1) PG8_BAR; }
    }
    PG8_WAIT_V(0);
    if constexpr (!ALIGN_EPI) { if (wr == 0) PG8_BAR; }
    PG8_BAR;
    if constexpr (Epi::AFTER_DRAIN) { E.fused(acc, cur, wr, wc, fr, fq, lds, wid, lane); S.done(cur); }
#undef PG8_SA
#undef PG8_SB
#undef PG8_STAGE
#undef PG8_LDA
#undef PG8_LDB
#undef PG8_MMA
#undef PG8_WAIT_V
#undef PG8_WAIT_L
#undef PG8_BAR
#undef PG8_SCHED
}
}

__device__ __forceinline__ void ph_rope(const Params& p, int bid, int nb) {
    char* ws = p.ws; const int lane = TIDX & 63, wv = TIDX >> 6;
    bf16_t* P = (bf16_t*)(ws + OFF_P);
    const float* rr = (const float*)(ws + OFF_ROPE_RET); const float* ax = (const float*)(ws + OFF_ROPE_AX);
    for (int r = bid * 8 + wv; r < NROW; r += nb * 8) {
        const bool lat = r < NLAT; const int n = r & (NSEQ - 1), gr = n >> 6, gc = n & 63;
        bf16_t* pr = P + (size_t)r * DIN;
        for (int it = 0; it < 11; ++it) {
            const int pi = it * 64 + lane;
            int c1, c2; float cs = 1.f, sn = 0.f, scale = 1.f;
            if (pi < 192) {
                const int hd = pi >> 5, j = pi & 31; c1 = (pi < 128 ? C_AQ : C_AK - 256) + hd * 64 + j; c2 = c1 + 32;
                if (pi < 128) scale = 0.125f * 1.4426950408889634f;
                if (lat) { if (j < 16) { cs = ax[gr * 16 + j]; sn = ax[4096 + gr * 16 + j]; } else { cs = ax[8192 + gc * 16 + j - 16]; sn = ax[9216 + gc * 16 + j - 16]; } }
            } else if (pi < 448) {
                const int q = pi - 192, hd = q >> 5, j = q & 31; c1 = C_RQ + hd * 64 + j; c2 = c1 + 32;
                if (q >= 128) scale = 0.125f;
                if (lat) { cs = rr[n * 32 + j]; sn = rr[16384 * 32 + n * 32 + j]; }
            } else {
                const int q = pi - 448, blk = q >> 4, j = q & 15; c1 = C_DQ + blk * 32 + j; c2 = c1 + 16;
                if (q < 128) scale = 0.17677669529663687f * 1.4426950408889634f;
                if (lat) { if (j < 8) { cs = ax[10240 + gr * 8 + j]; sn = ax[12288 + gr * 8 + j]; } else { cs = ax[14336 + gc * 8 + j - 8]; sn = ax[14848 + gc * 8 + j - 8]; } }
            }
            const float x1 = bf2f(pr[c1]), x2 = bf2f(pr[c2]);
            pr[c1] = f2bf((x1 * cs - x2 * sn) * scale); pr[c2] = f2bf((x2 * cs + x1 * sn) * scale);
        }
    }
}

__device__ __forceinline__ float ret_lg(const Params& p, int l, int dir, int h) { return -softplusf_(-p.ret_logit[(l * 2 + dir) * 4 + h]); }
__device__ __forceinline__ void ph_ret_summ(const Params& p, int l, int bid, int nb, float* lds) {
    char* ws = p.ws; const int t = TIDX;
    const bf16_t* P = (const bf16_t*)(ws + OFF_P); float* RET = (float*)(ws + OFF_RET);
    float* ks = lds; float* vs = lds + 128 * 64; float* zf = vs + 128 * 64; float* zb = zf + 128;
    for (int u = bid; u < 2 * NCI * 4; u += nb) {
        const int h = u & 3, ci = (u >> 2) % NCI, b = u / (4 * NCI), rb = row_base(b, ci);
        const float lgf = ret_lg(p, l, 0, h), lgb = ret_lg(p, l, 1, h);
        __syncthreads();
        for (int i = t; i < 128 * 64; i += 512) { const int m = i >> 6, d = i & 63; ks[i] = bf2f(P[(size_t)(rb + m) * DIN + C_RK + h * 64 + d]); vs[i] = bf2f(P[(size_t)(rb + m) * DIN + C_RV + h * 64 + d]); }
        if (t < 128) { zf[t] = expf(lgf * (float)(127 - t)); zb[t] = expf(lgb * (float)t); }
        __syncthreads();
        const int d = t >> 3, e0 = (t & 7) * 8;
        float af[8], ab[8];
#pragma unroll
        for (int j = 0; j < 8; ++j) { af[j] = 0.f; ab[j] = 0.f; }
        for (int m = 0; m < 128; ++m) { const float kv = ks[m * 64 + d], kf = kv * zf[m], kb = kv * zb[m];
#pragma unroll
            for (int j = 0; j < 8; ++j) { const float vv = vs[m * 64 + e0 + j]; af[j] += kf * vv; ab[j] += kb * vv; } }
        float* of = RET + ((((size_t)0 * 2 + b) * NCI + ci) * 4 + h) * 4096 + d * 64 + e0;
        float* ob = RET + ((((size_t)1 * 2 + b) * NCI + ci) * 4 + h) * 4096 + d * 64 + e0;
#pragma unroll
        for (int j = 0; j < 8; ++j) { of[j] = af[j]; ob[j] = ab[j]; }
    }
}

template <int MODE>
__device__ __forceinline__ void ph_lru_chunk(const Params& p, int l, int bid, int nb, float* lds, int ci_lo) {
    char* ws = p.ws; const int t = TIDX;
    const bf16_t* P = (const bf16_t*)(ws + OFF_P);
    float* LA = (float*)(ws + OFF_LRU); float* LB = LA + 2 * 2 * NCI * 256; float* LC = LB + 2 * 2 * NCI * 256;
    bf16_t* O = (bf16_t*)(ws + OFF_ACT);
    float* us = lds;
    float* as_ = lds + 8192;
    float* bs_ = lds + 16384;
    float* hs = lds + 24576;
    const int nci = NCI - ci_lo;
    for (int u = bid; u < 2 * nci * 4; u += nb) {
        const int hb = u & 3, ci = ci_lo + (u >> 2) % nci, b = u / (4 * nci), rb = row_base(b, ci);
        const int seg_lo = ci < 2 ? NLAT + b * NCTX : b * NSEQ, seg_hi = ci < 2 ? seg_lo + NCTX : seg_lo + NSEQ;
        __syncthreads();
        for (int i = t; i < 128 * 64; i += 512) { const int tt = i >> 6, j = i & 63, ch = hb * 64 + j; float acc = p.conv_b[l * 256 + ch];
#pragma unroll
            for (int k = 0; k < 4; ++k) { const int rr = rb + tt - 1 + k; if (rr >= seg_lo && rr < seg_hi) acc += p.conv_w[(l * 4 + k) * 256 + ch] * bf2f(P[(size_t)rr * DIN + C_LX + ch]); }
            us[i] = acc; }
        __syncthreads();
        for (int dir = 0; dir < 2; ++dir) {
            const int j = t & 63, tg = t >> 6, ch = hb * 64 + j;
            const float* wa = p.lru_wa + (((size_t)(l * 2 + dir) * 4 + hb) * 64) * 64 + j;
            const float* wx = p.lru_wx + (((size_t)(l * 2 + dir) * 4 + hb) * 64) * 64 + j;
            const float ba = p.lru_ba[(l * 2 + dir) * 256 + ch], bx = p.lru_bx[(l * 2 + dir) * 256 + ch];
            const float spl = softplusf_(-p.lru_lam[(l * 2 + dir) * 256 + ch]);
            float ra[16], rx[16];
#pragma unroll
            for (int k = 0; k < 16; ++k) { ra[k] = ba; rx[k] = bx; }
            for (int i = 0; i < 64; ++i) { const float wav = wa[i * 64], wxv = wx[i * 64];
#pragma unroll
                for (int k = 0; k < 16; ++k) { const float uv = us[(tg * 16 + k) * 64 + i]; ra[k] += uv * wav; rx[k] += uv * wxv; } }
#pragma unroll
            for (int k = 0; k < 16; ++k) { const int tt = tg * 16 + k; const float r = sigmoidf_(ra[k]), ig = sigmoidf_(rx[k]);
                const float la = -8.0f * r * spl, a = expf(la), bb = sqrtf(-expm1f(2.0f * la)) * (ig * us[tt * 64 + j]);
                as_[tt * 64 + j] = a; bs_[tt * 64 + j] = bb; }
            __syncthreads();
            if (t < 64) {
                const size_t cidx = (((size_t)dir * 2 + b) * NCI + ci) * 256 + hb * 64 + t;
                float h = MODE == 3 ? LC[cidx] : 0.f, ap = 1.f;
                if (dir == 0) { for (int tt = 0; tt < 128; ++tt) { const float a = as_[tt * 64 + t]; h = a * h + bs_[tt * 64 + t]; ap *= a; if (MODE == 3) hs[tt * 64 + t] = h; } }
                else { for (int tt = 127; tt >= 0; --tt) { const float a = as_[tt * 64 + t]; h = a * h + bs_[tt * 64 + t]; ap *= a; if (MODE == 3) hs[tt * 64 + t] += h; } }
                if (MODE == 1) { LA[cidx] = ap; LB[cidx] = h; }
            }
            __syncthreads();
        }
        if (MODE == 3) {
            for (int i = t; i < 128 * 64; i += 512) { const int tt = i >> 6, j = i & 63, ch = hb * 64 + j;
                const float y = bf2f(P[(size_t)(rb + tt) * DIN + C_LY + ch]);
                O[(size_t)(rb + tt) * DM + 768 + ch] = f2bf(hs[i] * gelu_tanh(y)); }
        }
    }
}

__device__ __forceinline__ int scan_ci(int dir, int s) { return dir == 0 ? s : (s == 0 ? 1 : (s == 1 ? 0 : NCI + 1 - s)); }
__device__ __forceinline__ void ph_scan2(const Params& p, int l, int bid, int nb) {
    char* ws = p.ws; const int gt = bid * 512 + TIDX, gs = nb * 512;
    float* RET = (float*)(ws + OFF_RET);
    for (int i = gt; i < 2 * 2 * 4 * 4096; i += gs) {
        const int de = i & 4095, h = (i >> 12) & 3, b = (i >> 14) & 1, dir = i >> 15;
        const float decay = expf(ret_lg(p, l, dir, h) * 128.0f); float S = 0.f;
        for (int s = 0; s < NCI; ++s) { const int ci = scan_ci(dir, s); float* q = RET + ((((size_t)dir * 2 + b) * NCI + ci) * 4 + h) * 4096 + de; const float U = *q; *q = S; S = decay * S + U; }
    }
    float* LA = (float*)(ws + OFF_LRU); float* LB = LA + 2 * 2 * NCI * 256; float* LC = LB + 2 * 2 * NCI * 256;
    for (int i = gt; i < 2 * 2 * 256; i += gs) {
        const int ch = i & 255, b = (i >> 8) & 1, dir = i >> 9; float h = 0.f;
        for (int s = 0; s < NCI; ++s) { const int ci = scan_ci(dir, s); const size_t idx = (((size_t)dir * 2 + b) * NCI + ci) * 256 + ch; LC[idx] = h; h = LA[idx] * h + LB[idx]; }
    }
}

__device__ __forceinline__ void ph_ret_out(const Params& p, int l, int bid, int nb, float* lds, int ci_lo) {
    char* ws = p.ws; const int t = TIDX;
    const bf16_t* P = (const bf16_t*)(ws + OFF_P); const float* RET = (const float*)(ws + OFF_RET); bf16_t* O = (bf16_t*)(ws + OFF_ACT);
    float* qs = lds;
    float* ks = qs + 128 * 65;
    float* vs = ks + 128 * 65;
    float* sf = vs + 128 * 64;
    float* sb = sf + 4096;
    float* pf = sb + 4096;
    float* pb = pf + 132;
    const int nci = NCI - ci_lo;
    for (int u = bid; u < 2 * nci * 4; u += nb) {
        const int h = u & 3, ci = ci_lo + (u >> 2) % nci, b = u / (4 * nci), rb = row_base(b, ci);
        const float lgf = ret_lg(p, l, 0, h), lgb = ret_lg(p, l, 1, h);
        __syncthreads();
        for (int i = t; i < 128 * 64; i += 512) { const int m = i >> 6, d = i & 63; const bf16_t* pr = P + (size_t)(rb + m) * DIN + h * 64 + d;
            qs[m * 65 + d] = bf2f(pr[C_RQ]); ks[m * 65 + d] = bf2f(pr[C_RK]); vs[i] = bf2f(pr[C_RV]); }
        for (int i = t; i < 4096; i += 512) { sf[i] = RET[((((size_t)0 * 2 + b) * NCI + ci) * 4 + h) * 4096 + i]; sb[i] = RET[((((size_t)1 * 2 + b) * NCI + ci) * 4 + h) * 4096 + i]; }
        if (t < 129) { pf[t] = expf(lgf * (float)t); pb[t] = expf(lgb * (float)t); }
        __syncthreads();
        const int n = t >> 2, e0 = (t & 3) * 16;
        float y[16];
#pragma unroll
        for (int j = 0; j < 16; ++j) y[j] = 0.f;
        for (int m = 0; m < 128; ++m) {
            float s = 0.f;
#pragma unroll 16
            for (int d = 0; d < 64; ++d) s += qs[n * 65 + d] * ks[m * 65 + d];
            float w = 0.f; if (m <= n) w += pf[n - m]; if (m >= n) w += pb[m - n];
            s *= w;
#pragma unroll
            for (int j = 0; j < 16; ++j) y[j] += s * vs[m * 64 + e0 + j];
        }
        const float xf = pf[n + 1], xb = pb[128 - n];
        for (int d = 0; d < 64; ++d) { const float qv = qs[n * 65 + d], qf = qv * xf, qb = qv * xb;
#pragma unroll
            for (int j = 0; j < 16; ++j) y[j] += qf * sf[d * 64 + e0 + j] + qb * sb[d * 64 + e0 + j]; }
        float ss = 0.f;
#pragma unroll
        for (int j = 0; j < 16; ++j) ss += y[j] * y[j];
        ss += __shfl_xor(ss, 1); ss += __shfl_xor(ss, 2);
        const float rn = rsqrtf(ss * (1.0f / 64.0f) + 1e-6f);
#pragma unroll
        for (int j = 0; j < 16; ++j) { const int c = h * 64 + e0 + j; const float g = bf2f(P[(size_t)(rb + n) * DIN + C_RG + c]);
            O[(size_t)(rb + n) * DM + 256 + c] = f2bf(y[j] * rn * p.ret_gn[l * 256 + c] * siluf_(g)); }
    }
}

__device__ __forceinline__ float diff_lambda_val(const Params& p, int l, float lam_init) {
    const float* lv = p.diff_lam + l * 128; float s1 = 0.f, s2 = 0.f;
    for (int i = 0; i < 32; ++i) { s1 += lv[i] * lv[32 + i]; s2 += lv[64 + i] * lv[96 + i]; }
    return expf(s1) - expf(s2) + lam_init;
}
typedef float f32x16 __attribute__((ext_vector_type(16)));
typedef short s16x4 __attribute__((ext_vector_type(4)));
typedef short v4i16_t __attribute__((ext_vector_type(4)));
typedef float f32x2_t __attribute__((ext_vector_type(2)));
typedef __bf16 bf16x2_t __attribute__((ext_vector_type(2)));
__device__ __forceinline__ unsigned cvtpk_s(float lo, float hi) { f32x2_t v = {lo, hi}; bf16x2_t bb = __builtin_convertvector(v, bf16x2_t); return __builtin_bit_cast(unsigned, bb); }
__device__ __forceinline__ int crow(int r, int hi) { return (r & 3) + 8 * (r >> 2) + 4 * hi; }
__device__ __forceinline__ float xhalf_max(float m) { auto rr = __builtin_amdgcn_permlane32_swap(__float_as_uint(m), __float_as_uint(m), false, false); return fmaxf(__uint_as_float(rr[0]), __uint_as_float(rr[1])); }
__device__ __forceinline__ float xhalf_sum(float m) { auto rr = __builtin_amdgcn_permlane32_swap(__float_as_uint(m), __float_as_uint(m), false, false); return __uint_as_float(rr[0]) + __uint_as_float(rr[1]); }
__device__ __forceinline__ s16x4 vtr(const LAS char* p) { return __builtin_bit_cast(s16x4, __builtin_amdgcn_ds_read_tr16_b64_v4i16((LAS v4i16_t*)p)); }

constexpr int DF_K = 0, DF_V = 16384, DF_WS = 32768, DF_ST = 34816;
__device__ __forceinline__ void ph_diff(const Params& p, int l, bool need_ctx, float lam_init, int bid, int nb, float* lds) {
    char* ws = p.ws; const int tid = TIDX, lane = tid & 63, r32 = lane & 31, hi = lane >> 5, wid = __builtin_amdgcn_readfirstlane(tid >> 6);
    const bf16_t* P = (const bf16_t*)(ws + OFF_P); bf16_t* O = (bf16_t*)(ws + OFF_ACT);
    LAS char* sm = (LAS char*)lds;
    LAS float* wsf = (LAS float*)(sm + DF_WS) + wid * 64;
    const float lam = diff_lambda_val(p, l, lam_init);
    const int nun = 512 + (need_ctx ? 8 : 0);
    for (int u = bid; u < nun; u += nb) {
        int b, h, qrow0, t_lo;
        if (u < 512) { b = u >> 8; h = (u >> 6) & 3; qrow0 = b * NSEQ + (u & 63) * 256; t_lo = 0; }
        else { const int v = u - 512; b = v >> 2; h = v & 3; qrow0 = NLAT + b * NCTX; t_lo = 256; }
        const int t_hi = 260;
        const bf16_t* kcol = P + C_DK + h * 64 + wid * 8;
        const bf16_t* vcol = P + C_DV + h * 64 + (wid >> 2) * 32 + (lane & 3) * 8;
        const int krow_in = lane, vrow_in = 16 * (wid & 3) + (lane >> 2);
#define TILE_ROW0(t) ((t) < 256 ? b * NSEQ + (t) * 64 : NLAT + b * NCTX + ((t) - 256) * 64)
        bf16x8 qr[4];
        { const bf16_t* qp = P + (size_t)(qrow0 + wid * 32 + r32) * DIN + C_DQ + h * 64 + hi * 8;
#pragma unroll
          for (int d0 = 0; d0 < 4; ++d0) qr[d0] = *(const bf16x8*)(qp + d0 * 16); }
        f32x16 o[2][2]; float mhat[2], lsum[2];
#pragma unroll
        for (int m = 0; m < 2; ++m) { mhat[m] = 0.f; lsum[m] = 0.f;
#pragma unroll
            for (int r = 0; r < 16; ++r) { o[m][0][r] = 0.f; o[m][1][r] = 0.f; } }
        u32x4 kst, vst;
        { const int r0 = TILE_ROW0(t_lo); kst = *(const u32x4*)(kcol + (size_t)(r0 + krow_in) * DIN); vst = *(const u32x4*)(vcol + (size_t)(r0 + vrow_in) * DIN); }
        __syncthreads();
        *(LAS u32x4*)(sm + DF_K + tid * 16) = kst; *(LAS u32x4*)(sm + DF_V + tid * 16) = vst;
        __syncthreads();
        bool first = true;
        for (int t = t_lo; t < t_hi; ++t) {
            const int cur = (t - t_lo) & 1;
            if (t + 1 < t_hi) { const int r0 = TILE_ROW0(t + 1); kst = *(const u32x4*)(kcol + (size_t)(r0 + krow_in) * DIN); vst = *(const u32x4*)(vcol + (size_t)(r0 + vrow_in) * DIN); }
            const LAS char* kb = sm + DF_K + cur * 8192 + hi * 1024 + r32 * 16;
            const LAS char* vb = sm + DF_V + cur * 8192 + ((lane >> 4) & 1) * 32 + (lane & 3) * 8 + (4 * hi + ((lane & 15) >> 2)) * 64;
            bf16x8 kf[8];
#pragma unroll
            for (int j = 0; j < 4; ++j) { kf[2 * j] = *(const LAS bf16x8*)(kb + j * 2048); kf[2 * j + 1] = *(const LAS bf16x8*)(kb + j * 2048 + 512); }
            bf16x8 vf[8];
#pragma unroll
            for (int i = 0; i < 8; ++i) { const s16x4 lo = vtr(vb + (i >> 2) * 4096 + (i & 3) * 1024), hh = vtr(vb + (i >> 2) * 4096 + (i & 3) * 1024 + 512);
                vf[i] = (bf16x8){lo[0], lo[1], lo[2], lo[3], hh[0], hh[1], hh[2], hh[3]}; }
#pragma unroll
            for (int m = 0; m < 2; ++m) {
                float nm = -mhat[m]; asm volatile("" : "+v"(nm));
                f32x16 negm;
#pragma unroll
                for (int r = 0; r < 16; ++r) negm[r] = nm;
                f32x16 c0 = __builtin_amdgcn_mfma_f32_32x32x16_bf16(kf[4 * m + 0], qr[2 * m], negm, 0, 0, 0);
                f32x16 c1 = __builtin_amdgcn_mfma_f32_32x32x16_bf16(kf[4 * m + 1], qr[2 * m], negm, 0, 0, 0);
                c0 = __builtin_amdgcn_mfma_f32_32x32x16_bf16(kf[4 * m + 2], qr[2 * m + 1], c0, 0, 0, 0);
                c1 = __builtin_amdgcn_mfma_f32_32x32x16_bf16(kf[4 * m + 3], qr[2 * m + 1], c1, 0, 0, 0);
                float rm = fmaxf(c0[0], c1[0]);
#pragma unroll
                for (int r = 1; r < 16; ++r) rm = fmaxf(rm, fmaxf(c0[r], c1[r]));
                rm = xhalf_max(rm);
                if (first || __any(rm > 8.0f)) {
                    const float dl = first ? rm : fmaxf(rm, 0.f);
                    mhat[m] += dl;
#pragma unroll
                    for (int r = 0; r < 16; ++r) { c0[r] -= dl; c1[r] -= dl; }
                    if (!first) {
                        const float f = __builtin_amdgcn_exp2f(-dl); lsum[m] *= f;
                        if (hi == 0) wsf[r32] = f;
#pragma unroll
                        for (int r = 0; r < 16; ++r) { const float fr_ = wsf[crow(r, hi)]; o[m][0][r] *= fr_; o[m][1][r] *= fr_; }
                    }
                }
                float sacc = 0.f;
#pragma unroll
                for (int r = 0; r < 16; ++r) { c0[r] = __builtin_amdgcn_exp2f(c0[r]); c1[r] = __builtin_amdgcn_exp2f(c1[r]); sacc += c0[r] + c1[r]; }
                lsum[m] += sacc;
                u32x4 pw[4];
#pragma unroll
                for (int k = 0; k < 2; ++k) {
                    pw[k] = (u32x4){cvtpk_s(c0[8 * k + 0], c0[8 * k + 1]), cvtpk_s(c0[8 * k + 2], c0[8 * k + 3]), cvtpk_s(c0[8 * k + 4], c0[8 * k + 5]), cvtpk_s(c0[8 * k + 6], c0[8 * k + 7])};
                    pw[2 + k] = (u32x4){cvtpk_s(c1[8 * k + 0], c1[8 * k + 1]), cvtpk_s(c1[8 * k + 2], c1[8 * k + 3]), cvtpk_s(c1[8 * k + 4], c1[8 * k + 5]), cvtpk_s(c1[8 * k + 6], c1[8 * k + 7])}; }
#pragma unroll
                for (int k = 0; k < 4; ++k) {
                    o[m][0] = __builtin_amdgcn_mfma_f32_32x32x16_bf16(__builtin_bit_cast(bf16x8, pw[k]), vf[k], o[m][0], 0, 0, 0);
                    o[m][1] = __builtin_amdgcn_mfma_f32_32x32x16_bf16(__builtin_bit_cast(bf16x8, pw[k]), vf[4 + k], o[m][1], 0, 0, 0); }
            }
            first = false;
            if (t + 1 < t_hi) { *(LAS u32x4*)(sm + DF_K + (cur ^ 1) * 8192 + tid * 16) = kst; *(LAS u32x4*)(sm + DF_V + (cur ^ 1) * 8192 + tid * 16) = vst; }
            __syncthreads();
        }
#undef TILE_ROW0
        const float inv0 = 1.0f / xhalf_sum(lsum[0]), inv1 = lam / xhalf_sum(lsum[1]);
        int lane_e = TIDX & 63; asm volatile("" : "+v"(lane_e));
        { const int r32e = lane_e & 31, hie = lane_e >> 5;
        LAS float* wse = (LAS float*)(sm + DF_WS) + wid * 64; LAS float* stge = (LAS float*)(sm + DF_ST) + wid * 2048;
        if (hie == 0) { wse[r32e] = inv0; wse[32 + r32e] = inv1; }
#pragma unroll
        for (int r = 0; r < 16; ++r) { const int q = crow(r, hie); const float i0 = wse[q], i1 = wse[32 + q];
            stge[q * 64 + r32e] = o[0][0][r] * i0 - o[1][0][r] * i1; stge[q * 64 + 32 + r32e] = o[0][1][r] * i0 - o[1][1][r] * i1; } }
        const int lane = lane_e; LAS float* stg = (LAS float*)(sm + DF_ST) + wid * 2048;
        const float* gn = p.diff_gn + l * 256 + h * 64 + (lane & 7) * 8;
        const f32x4 g0 = *(const f32x4*)gn, g1 = *(const f32x4*)(gn + 4);
#pragma unroll
        for (int i = 0; i < 4; ++i) { const int row = i * 8 + (lane >> 3), ch = lane & 7;
            const f32x4 v0 = *(const LAS f32x4*)(stg + row * 64 + ch * 8), v1 = *(const LAS f32x4*)(stg + row * 64 + ch * 8 + 4);
            float ss = v0[0] * v0[0] + v0[1] * v0[1] + v0[2] * v0[2] + v0[3] * v0[3] + v1[0] * v1[0] + v1[1] * v1[1] + v1[2] * v1[2] + v1[3] * v1[3];
            ss += __shfl_xor(ss, 1); ss += __shfl_xor(ss, 2); ss += __shfl_xor(ss, 4);
            const float rn = rsqrtf(ss * (1.0f / 64.0f) + 1e-6f) * (1.0f - lam_init);
            u32x4 w; w.x = cvtpk_s(v0[0] * rn * g0[0], v0[1] * rn * g0[1]); w.y = cvtpk_s(v0[2] * rn * g0[2], v0[3] * rn * g0[3]);
            w.z = cvtpk_s(v1[0] * rn * g1[0], v1[1] * rn * g1[1]); w.w = cvtpk_s(v1[2] * rn * g1[2], v1[3] * rn * g1[3]);
            *(u32x4*)(O + (size_t)(qrow0 + wid * 32 + row) * DM + 512 + h * 64 + ch * 8) = w; }
    }
}

__device__ __forceinline__ void ph_swa(const Params& p, int l, bool need_ctx, int bid, int nb, float* lds) {
    char* ws = p.ws; const int tid = TIDX, lane = tid & 63, r32 = lane & 31, hi = lane >> 5, wid = __builtin_amdgcn_readfirstlane(tid >> 6);
    const bf16_t* P = (const bf16_t*)(ws + OFF_P); bf16_t* O = (bf16_t*)(ws + OFF_ACT);
    LAS char* sm = (LAS char*)lds;
    LAS float* wsf = (LAS float*)(sm + DF_WS) + wid * 64;
    const int nun = 512 + (need_ctx ? 8 : 0);
    for (int u = bid; u < nun; u += nb) {
        int b, h, qrow0, q0, tw_lo, nwin;
        if (u < 512) { b = u >> 8; h = (u >> 6) & 3; q0 = (u & 63) * 256; qrow0 = b * NSEQ + q0; const int lo = q0 - 128 < 0 ? 0 : q0 - 128, hi_ = q0 + 384 > NSEQ ? NSEQ : q0 + 384; tw_lo = lo >> 6; nwin = (hi_ - lo) >> 6; }
        else { const int v = u - 512; b = v >> 2; h = v & 3; q0 = 0; qrow0 = NLAT + b * NCTX; tw_lo = 0; nwin = 0; }
        const int g = h >> 1, nt = nwin + 4;
        const bf16_t* kcol = P + C_AK + g * 64 + wid * 8;
        const bf16_t* vcol = P + C_AV + g * 64 + (wid >> 2) * 32 + (lane & 3) * 8;
        const int krow_in = lane, vrow_in = 16 * (wid & 3) + (lane >> 2);
#define SWA_ROW0(i) ((i) < nwin ? b * NSEQ + (tw_lo + (i)) * 64 : NLAT + b * NCTX + ((i) - nwin) * 64)
        bf16x8 qr[4];
        { const bf16_t* qp = P + (size_t)(qrow0 + wid * 32 + r32) * DIN + C_AQ + h * 64 + hi * 8;
#pragma unroll
          for (int d0 = 0; d0 < 4; ++d0) qr[d0] = *(const bf16x8*)(qp + d0 * 16); }
        f32x16 o[2]; float mhat = p.sink[l * 4 + h] * 1.4426950408889634f, lsum = hi == 0 ? 1.0f : 0.0f;
#pragma unroll
        for (int r = 0; r < 16; ++r) { o[0][r] = 0.f; o[1][r] = 0.f; }
        const int qw = q0 + wid * 32, qpos = qw + r32;
        u32x4 kst, vst;
        { const int r0 = SWA_ROW0(0); kst = *(const u32x4*)(kcol + (size_t)(r0 + krow_in) * DIN); vst = *(const u32x4*)(vcol + (size_t)(r0 + vrow_in) * DIN); }
        __syncthreads();
        *(LAS u32x4*)(sm + DF_K + tid * 16) = kst; *(LAS u32x4*)(sm + DF_V + tid * 16) = vst;
        __syncthreads();
        for (int i = 0; i < nt; ++i) {
            const int cur = i & 1;
            if (i + 1 < nt) { const int r0 = SWA_ROW0(i + 1); kst = *(const u32x4*)(kcol + (size_t)(r0 + krow_in) * DIN); vst = *(const u32x4*)(vcol + (size_t)(r0 + vrow_in) * DIN); }
            const bool win = i < nwin; const int T = (tw_lo + i) * 64;
            const bool skip = win && (T > qw + 31 + 128 || T + 63 < qw - 128);
            if (!skip) {
                const LAS char* kb = sm + DF_K + cur * 8192 + hi * 1024 + r32 * 16;
                const LAS char* vb = sm + DF_V + cur * 8192 + ((lane >> 4) & 1) * 32 + (lane & 3) * 8 + (4 * hi + ((lane & 15) >> 2)) * 64;
                float nm = -mhat; asm volatile("" : "+v"(nm));
                f32x16 c0, c1;
#pragma unroll
                for (int r = 0; r < 16; ++r) { c0[r] = nm; c1[r] = nm; }
#pragma unroll
                for (int j = 0; j < 4; ++j) {
                    c0 = __builtin_amdgcn_mfma_f32_32x32x16_bf16(*(const LAS bf16x8*)(kb + j * 2048), qr[j], c0, 0, 0, 0);
                    c1 = __builtin_amdgcn_mfma_f32_32x32x16_bf16(*(const LAS bf16x8*)(kb + j * 2048 + 512), qr[j], c1, 0, 0, 0); }
                if (win && (T < qw + 31 - 128 || T + 63 > qw + 128)) {
#pragma unroll
                    for (int r = 0; r < 16; ++r) { const int kp = T + crow(r, hi); const int d0_ = qpos - kp, d1_ = d0_ - 32;
                        if (d0_ > 128 || d0_ < -128) c0[r] = -1.0e30f;
                        if (d1_ > 128 || d1_ < -128) c1[r] = -1.0e30f; }
                }
                float rm = fmaxf(c0[0], c1[0]);
#pragma unroll
                for (int r = 1; r < 16; ++r) rm = fmaxf(rm, fmaxf(c0[r], c1[r]));
                rm = xhalf_max(rm);
                if (__any(rm > 8.0f)) {
                    const float dl = fmaxf(rm, 0.f); mhat += dl;
#pragma unroll
                    for (int r = 0; r < 16; ++r) { c0[r] -= dl; c1[r] -= dl; }
                    const float f = __builtin_amdgcn_exp2f(-dl); lsum *= f;
                    if (hi == 0) wsf[r32] = f;
#pragma unroll
                    for (int r = 0; r < 16; ++r) { const float fr_ = wsf[crow(r, hi)]; o[0][r] *= fr_; o[1][r] *= fr_; }
                }
                float sacc = 0.f;
#pragma unroll
                for (int r = 0; r < 16; ++r) { c0[r] = __builtin_amdgcn_exp2f(c0[r]); c1[r] = __builtin_amdgcn_exp2f(c1[r]); sacc += c0[r] + c1[r]; }
                lsum += sacc;
                u32x4 pw[4];
#pragma unroll
                for (int k = 0; k < 2; ++k) {
                    pw[k] = (u32x4){cvtpk_s(c0[8 * k + 0], c0[8 * k + 1]), cvtpk_s(c0[8 * k + 2], c0[8 * k + 3]), cvtpk_s(c0[8 * k + 4], c0[8 * k + 5]), cvtpk_s(c0[8 * k + 6], c0[8 * k + 7])};
                    pw[2 + k] = (u32x4){cvtpk_s(c1[8 * k + 0], c1[8 * k + 1]), cvtpk_s(c1[8 * k + 2], c1[8 * k + 3]), cvtpk_s(c1[8 * k + 4], c1[8 * k + 5]), cvtpk_s(c1[8 * k + 6], c1[8 * k + 7])}; }
#pragma unroll
                for (int k = 0; k < 4; ++k) {
                    const s16x4 lo0 = vtr(vb + k * 1024), hi0 = vtr(vb + k * 1024 + 512), lo1 = vtr(vb + 4096 + k * 1024), hi1 = vtr(vb + 4096 + k * 1024 + 512);
                    o[0] = __builtin_amdgcn_mfma_f32_32x32x16_bf16(__builtin_bit_cast(bf16x8, pw[k]), (bf16x8){lo0[0], lo0[1], lo0[2], lo0[3], hi0[0], hi0[1], hi0[2], hi0[3]}, o[0], 0, 0, 0);
                    o[1] = __builtin_amdgcn_mfma_f32_32x32x16_bf16(__builtin_bit_cast(bf16x8, pw[k]), (bf16x8){lo1[0], lo1[1], lo1[2], lo1[3], hi1[0], hi1[1], hi1[2], hi1[3]}, o[1], 0, 0, 0); }
            }
            if (i + 1 < nt) { *(LAS u32x4*)(sm + DF_K + (cur ^ 1) * 8192 + tid * 16) = kst; *(LAS u32x4*)(sm + DF_V + (cur ^ 1) * 8192 + tid * 16) = vst; }
            __syncthreads();
        }
#undef SWA_ROW0
        const float inv = 1.0f / xhalf_sum(lsum);
        int lane_e = TIDX & 63;
        { const int r32e = lane_e & 31, hie = lane_e >> 5;
        LAS float* wse = (LAS float*)(sm + DF_WS) + wid * 64; LAS float* stge = (LAS float*)(sm + DF_ST) + wid * 2048;
        if (hie == 0) wse[r32e] = inv;
#pragma unroll
        for (int r = 0; r < 16; ++r) { const int q = crow(r, hie); const float i0 = wse[q]; stge[q * 64 + r32e] = o[0][r] * i0; stge[q * 64 + 32 + r32e] = o[1][r] * i0; } }
        LAS float* stg = (LAS float*)(sm + DF_ST) + wid * 2048;
#pragma unroll
        for (int i = 0; i < 4; ++i) { const int row = i * 8 + (lane_e >> 3), ch = lane_e & 7;
            const f32x4 v0 = *(const LAS f32x4*)(stg + row * 64 + ch * 8), v1 = *(const LAS f32x4*)(stg + row * 64 + ch * 8 + 4);
            u32x4 w; w.x = cvtpk_s(v0[0], v0[1]); w.y = cvtpk_s(v0[2], v0[3]); w.z = cvtpk_s(v1[0], v1[1]); w.w = cvtpk_s(v1[2], v1[3]);
            *(u32x4*)(O + (size_t)(qrow0 + wid * 32 + row) * DM + h * 64 + ch * 8) = w; }
    }
}

__device__ __forceinline__ void moe_offsets(const Params& p, int* offs  ) {
    if (TIDX < 2) { const unsigned* cw = (const unsigned*)p.ws + CW_CNT + TIDX * 8; int o = 0;
        for (int e = 0; e < 8; ++e) { offs[TIDX * 9 + e] = o; o += ((int)__hip_atomic_load(cw + e, __ATOMIC_RELAXED, __HIP_MEMORY_SCOPE_AGENT) + 255) & ~255; }
        offs[TIDX * 9 + 8] = o; }
    __syncthreads();
}
__device__ __forceinline__ void ph_moe_scatter(const Params& p, int bid, int nb, float* lds) {
    char* ws = p.ws; int* offs = (int*)lds; moe_offsets(p, offs);
    const int lane = TIDX & 63, wv = TIDX >> 6;
    const bf16_t* H = (const bf16_t*)(ws + OFF_ACT); bf16_t* AS = (bf16_t*)(ws + OFF_ASORT);
    int* tok = (int*)(ws + OFF_TOK); float* wgt = (float*)(ws + OFF_WGT); unsigned* cw = (unsigned*)ws;
    for (int r = bid * 8 + wv; r < NLAT; r += nb * 8) {
        const int4 rec = *(const int4*)(ws + OFF_ROUTE + (size_t)r * 16);
        for (int g = 0; g < 2; ++g) {
            const int e = g == 0 ? rec.x : rec.y; int pos = 0;
            if (lane == 0) { pos = offs[g * 9 + e] + (int)atomicAdd(cw + CW_CUR + g * 8 + e, 1u); tok[g * GRP_ROWS + pos] = r; wgt[g * GRP_ROWS + pos] = __int_as_float(g == 0 ? rec.z : rec.w); }
            pos = __shfl(pos, 0);
            const uint4* src = (const uint4*)(H + (size_t)r * DM); uint4* dst = (uint4*)(AS + ((size_t)g * GRP_ROWS + pos) * DM);
            dst[lane] = src[lane]; dst[64 + lane] = src[64 + lane];
        }
    }
}

__device__ __forceinline__ void ph_final(const Params& p, int bid, int nb) {
    const int lane = TIDX & 63, wv = TIDX >> 6;
    for (int r = bid * 8 + wv; r < NLAT; r += nb * 8) {
        float* xr = p.out + (size_t)r * DM; float4 v[4]; float ss = 0.f;
#pragma unroll
        for (int i = 0; i < 4; ++i) { v[i] = *(const float4*)(xr + i * 256 + lane * 4); ss += v[i].x * v[i].x + v[i].y * v[i].y + v[i].z * v[i].z + v[i].w * v[i].w; }
        ss = wave_sum(ss); const float rn = rsqrtf(ss * (1.0f / 1024.0f) + 1e-6f);
#pragma unroll
        for (int i = 0; i < 4; ++i) { const float4 g = *(const float4*)(p.final_norm + i * 256 + lane * 4);
            float4 o; o.x = v[i].x * rn * g.x; o.y = v[i].y * rn * g.y; o.z = v[i].z * rn * g.z; o.w = v[i].w * rn * g.w; *(float4*)(xr + i * 256 + lane * 4) = o; }
    }
}

__device__ __forceinline__ float fast_silu(float v) { return v * __builtin_amdgcn_rcpf(1.0f + __expf(-v)); }
struct EpiStoreBf16 {
    static constexpr bool PERM = true, AFTER_DRAIN = false; bf16_t* O; int ldc;
    __device__ __forceinline__ void operator()(const f32x4 (&acc)[2][2][4][2], const pg8::Unit& u, int wr, int wc, int fr, int fq) const {
        bf16_t* base = O + (size_t)(u.pm * 256 + wr * 64 + fr) * ldc + u.pn * 256 + wc * 32 + 8 * fq;
#pragma unroll
        for (int ai = 0; ai < 2; ++ai)
#pragma unroll
            for (int m = 0; m < 4; ++m) { bf16_t* rowp = base + (size_t)(ai * 128 + m * 16) * ldc;
#pragma unroll
                for (int bj = 0; bj < 2; ++bj) { const f32x4 v0 = acc[ai][bj][m][0], v1 = acc[ai][bj][m][1]; u32x4 w;
                    w.x = pg8::cvt_pk_bf16(v0[0], v0[1]); w.y = pg8::cvt_pk_bf16(v0[2], v0[3]); w.z = pg8::cvt_pk_bf16(v1[0], v1[1]); w.w = pg8::cvt_pk_bf16(v1[2], v1[3]);
                    *(u32x4*)(rowp + bj * 128) = w; } }
    }
};
struct EpiSwiglu {
    static constexpr bool PERM = true, AFTER_DRAIN = false; bf16_t* U; int ldu, npe;
    __device__ __forceinline__ void operator()(const f32x4 (&acc)[2][2][4][2], const pg8::Unit& u, int wr, int wc, int fr, int fq) const {
        bf16_t* base = U + (size_t)(u.pm * 256 + wr * 64 + fr) * ldu + (u.pn % npe) * 128 + wc * 32 + 8 * fq;
#pragma unroll
        for (int ai = 0; ai < 2; ++ai)
#pragma unroll
            for (int m = 0; m < 4; ++m) { float o[8];
#pragma unroll
                for (int n = 0; n < 2; ++n)
#pragma unroll
                    for (int i = 0; i < 4; ++i) o[n * 4 + i] = fast_silu(acc[ai][0][m][n][i]) * acc[ai][1][m][n][i];
                u32x4 w; w.x = pg8::cvt_pk_bf16(o[0], o[1]); w.y = pg8::cvt_pk_bf16(o[2], o[3]); w.z = pg8::cvt_pk_bf16(o[4], o[5]); w.w = pg8::cvt_pk_bf16(o[6], o[7]);
                *(u32x4*)(base + (size_t)(ai * 128 + m * 16) * ldu) = w; }
    }
};
struct EpiResidual {
    static constexpr bool PERM = false, AFTER_DRAIN = false; const float* xin; float* xout; float* xc; const float* gate;
    __device__ __forceinline__ void operator()(const f32x4 (&acc)[2][2][4][2], const pg8::Unit& u, int wr, int wc, int fr, int fq) const {
        const int cls = u.pm < 64 ? 0 : (u.pm < 128 ? 1 : 2), col0 = u.pn * 256 + wc * 32 + 4 * fq;
        const float* gv = gate + (size_t)cls * 6144 + col0;
        const float* bi = u.pm < 128 ? xin + (size_t)u.pm * 256 * DM : xc + (size_t)(u.pm - 128) * 256 * DM;
        float* bo = u.pm < 128 ? xout + (size_t)u.pm * 256 * DM : xc + (size_t)(u.pm - 128) * 256 * DM;
        f32x4 g4[2][2];
#pragma unroll
        for (int bj = 0; bj < 2; ++bj)
#pragma unroll
            for (int n = 0; n < 2; ++n) g4[bj][n] = *(const f32x4*)(gv + bj * 128 + n * 16);
#pragma unroll
        for (int ai = 0; ai < 2; ++ai)
#pragma unroll
            for (int m = 0; m < 4; ++m) { const size_t off = (size_t)(ai * 128 + wr * 64 + m * 16 + fr) * DM + col0;
#pragma unroll
                for (int bj = 0; bj < 2; ++bj)
#pragma unroll
                    for (int n = 0; n < 2; ++n) { const f32x4 xi = *(const f32x4*)(bi + off + bj * 128 + n * 16); *(f32x4*)(bo + off + bj * 128 + n * 16) = xi + g4[bj][n] * acc[ai][bj][m][n]; } }
    }
};
struct EpiMoeScatter {
    static constexpr bool PERM = false, AFTER_DRAIN = false; float* x; const float* gate; const int* tok; const float* wgt; int npe;
    __device__ __forceinline__ void operator()(const f32x4 (&acc)[2][2][4][2], const pg8::Unit& u, int wr, int wc, int fr, int fq) const {
        const int col0 = (u.pn % npe) * 256 + wc * 32 + 4 * fq;
#pragma unroll
        for (int ai = 0; ai < 2; ++ai)
#pragma unroll
            for (int m = 0; m < 4; ++m) { const int r = u.pm * 256 + ai * 128 + wr * 64 + m * 16 + fr; const int tk = tok[r];
                if (tk >= 0) { const float wv = wgt[r]; const float* gv = gate + (size_t)mod_class(tk) * 6144 + col0; float* xr = x + (size_t)tk * DM + col0;
#pragma unroll
                    for (int bj = 0; bj < 2; ++bj)
#pragma unroll
                        for (int n = 0; n < 2; ++n) { const f32x4 g4 = *(const f32x4*)(gv + bj * 128 + n * 16); f32x4* q = (f32x4*)(xr + bj * 128 + n * 16); *q = *q + g4 * wv * acc[ai][bj][m][n]; } } }
    }
};
struct MoeOrder : pg8::StaticOrder {
    int o1, o2, o3, o4, o5, o6, o7, npe;
    __device__ __forceinline__ bool next(int i, pg8::Unit& u) const {
        if (!pg8::StaticOrder::next(i, u)) return false;
        const int r = u.pm * 256; const int e = (r >= o1) + (r >= o2) + (r >= o3) + (r >= o4) + (r >= o5) + (r >= o6) + (r >= o7);
        u.pn += e * npe; return true;
    }
};
#define GEMM_LDS ((PG8_LAS unsigned char*)lds)
__device__ __forceinline__ void ph_gemm_in(const Params& p, int l, int bid, int nb, float* lds) {
    char* ws = p.ws; pg8::Gemm g{(const bf16_t*)(ws + OFF_ACT), (const bf16_t*)(ws + OFF_WIN) + (size_t)l * DIN * DM, NROW, DIN, DM};
    pg8::StaticOrder S; S.init(NROW, DIN, nb, bid);
    EpiStoreBf16 E{(bf16_t*)(ws + OFF_P), DIN};
    pg8::gemm_phase<EpiStoreBf16, pg8::StaticOrder, true, true>(GEMM_LDS, g, S, E);
}
__device__ __forceinline__ void ph_gemm_out(const Params& p, int l, bool need_ctx, int bid, int nb, float* lds) {
    char* ws = p.ws; const int M = need_ctx ? NROW : NLAT;
    pg8::Gemm g{(const bf16_t*)(ws + OFF_ACT), (const bf16_t*)(ws + OFF_WOUT) + (size_t)l * DM * DM, M, DM, DM};
    pg8::StaticOrder S; S.init(M, DM, nb, bid);
    EpiResidual E{l == 0 ? p.x : p.out, p.out, (float*)(ws + OFF_XC), (const float*)(ws + OFF_MOD) + (size_t)l * 3 * 6144 + 2048};
    pg8::gemm_phase<EpiResidual, pg8::StaticOrder, true, true>(GEMM_LDS, g, S, E);
}
__device__ __forceinline__ void ph_ffn1(const Params& p, bool need_ctx, int bid, int nb, float* lds) {
    char* ws = p.ws; const int M = need_ctx ? NROW : NLAT;
    pg8::Gemm g{(const bf16_t*)(ws + OFF_ACT), (const bf16_t*)(ws + OFF_WF13), M, 2 * DFF, DM};
    pg8::StaticOrder S; S.init(M, 2 * DFF, nb, bid);
    EpiSwiglu E{(bf16_t*)(ws + OFF_P), DFF, 2 * DFF / 256};
    pg8::gemm_phase<EpiSwiglu, pg8::StaticOrder, true, true>(GEMM_LDS, g, S, E);
}
__device__ __forceinline__ void ph_ffn2(const Params& p, int l, bool need_ctx, int bid, int nb, float* lds) {
    char* ws = p.ws; const int M = need_ctx ? NROW : NLAT;
    pg8::Gemm g{(const bf16_t*)(ws + OFF_P), (const bf16_t*)(ws + OFF_WF2), M, DM, DFF};
    pg8::StaticOrder S; S.init(M, DM, nb, bid);
    EpiResidual E{p.out, p.out, (float*)(ws + OFF_XC), (const float*)(ws + OFF_MOD) + (size_t)l * 3 * 6144 + 5120};
    pg8::gemm_phase<EpiResidual, pg8::StaticOrder, true, true>(GEMM_LDS, g, S, E);
}
__device__ __forceinline__ MoeOrder moe_order(const int* og, int npe, int nb, int bid) {
    MoeOrder S; S.init(og[8], npe * 256, nb, bid); S.o1 = og[1]; S.o2 = og[2]; S.o3 = og[3]; S.o4 = og[4]; S.o5 = og[5]; S.o6 = og[6]; S.o7 = og[7]; S.npe = npe; return S;
}
__device__ __forceinline__ void ph_moe1(const Params& p, int g, int bid, int nb, float* lds) {
    char* ws = p.ws; int* offs = (int*)(lds + 32768); __syncthreads(); moe_offsets(p, offs);
    const MoeOrder S = moe_order(offs + g * 9, 2 * DFE / 256, nb, bid);
    pg8::Gemm gm{(const bf16_t*)(ws + OFF_ASORT) + (size_t)g * GRP_ROWS * DM, (const bf16_t*)(ws + OFF_WM13), 0, 0, DM};
    EpiSwiglu E{(bf16_t*)(ws + OFF_UMOE), DFE, 2 * DFE / 256};
    pg8::gemm_phase<EpiSwiglu, MoeOrder, true, true>(GEMM_LDS, gm, S, E);
}
__device__ __forceinline__ void ph_moe2(const Params& p, int l, int g, int bid, int nb, float* lds) {
    char* ws = p.ws; int* offs = (int*)(lds + 32768); __syncthreads(); moe_offsets(p, offs);
    const MoeOrder S = moe_order(offs + g * 9, DM / 256, nb, bid);
    pg8::Gemm gm{(const bf16_t*)(ws + OFF_UMOE), (const bf16_t*)(ws + OFF_WM2), 0, 0, DFE};
    EpiMoeScatter E{p.out, (const float*)(ws + OFF_MOD) + (size_t)l * 3 * 6144 + 5120, (const int*)(ws + OFF_TOK) + g * GRP_ROWS, (const float*)(ws + OFF_WGT) + g * GRP_ROWS, DM / 256};
    pg8::gemm_phase<EpiMoeScatter, MoeOrder, true, true>(GEMM_LDS, gm, S, E);
}

#define XB_TMO      128
#define XB_XCNT(j)  (256  + 64 * (j))
#define XB_XSUB(j)  (1280 + 64 * (j))
#define XB_XGEN(j)  (2304 + 64 * (j))
#define XB_TOP      3328
#define XB_TOPGEN   3392
#define XCD_BAR_WORDS 3456
#define XB_SPIN_CAP (1u << 22)

__device__ __forceinline__ unsigned xb_ld(unsigned* p)              { return __hip_atomic_load(p, __ATOMIC_RELAXED, __HIP_MEMORY_SCOPE_AGENT); }
__device__ __forceinline__ unsigned xb_add(unsigned* p, unsigned v) { return __hip_atomic_fetch_add(p, v, __ATOMIC_RELAXED, __HIP_MEMORY_SCOPE_AGENT); }
__device__ __forceinline__ unsigned xb_xcc_id() { return (unsigned)__builtin_amdgcn_s_getreg((3 << 11) | 20) & 0xFu; }
#define XB_SPIN(cond, bar) do { unsigned _sp = 0; while (cond) { __builtin_amdgcn_s_sleep(1); \
    if ((++_sp & 255u) == 0u) { if (xb_ld(&(bar)[XB_TMO])) break; if (_sp > XB_SPIN_CAP) { atomicAdd(&(bar)[XB_TMO], 1u); break; } } } } while (0)

struct XcdBarrier {
    unsigned* bar; unsigned x;
    volatile LAS unsigned* st;
};

__device__ __forceinline__ XcdBarrier xcd_barrier_post(unsigned* bar, volatile LAS unsigned* st) {
    XcdBarrier b; b.bar = bar; b.x = xb_xcc_id(); b.st = st;
    if (threadIdx.x == 0) (void)xb_add(&bar[XB_XCNT(b.x)], 1u);
    return b;
}
__device__ __forceinline__ void xcd_barrier_complete(unsigned* bar, unsigned x, unsigned& nloc, unsigned& nx) {
    const unsigned G = gridDim.x * gridDim.y * gridDim.z;
    unsigned sum, cnt, mine, sp = 0u;
    for (;;) {
        sum = 0u; cnt = 0u; mine = 0u;
#pragma unroll
        for (unsigned j = 0; j < 16; ++j) { const unsigned c = xb_ld(&bar[XB_XCNT(j)]); sum += c; cnt += (c > 0u) ? 1u : 0u; mine = (j == x) ? c : mine; }
        if (sum == G) break;
        __builtin_amdgcn_s_sleep(1);
        if ((++sp & 255u) == 0u) { if (xb_ld(&bar[XB_TMO])) break; if (sp > XB_SPIN_CAP) { atomicAdd(&bar[XB_TMO], 1u); break; } }
    }
    nloc = mine > 0u ? mine : 1u; nx = cnt > 0u ? cnt : 1u;
}

__device__ __forceinline__ void xcd_barrier(const XcdBarrier& b) {
    asm volatile("s_waitcnt vmcnt(0)" ::: "memory");
    __syncthreads();
    if (threadIdx.x == 0) {
        unsigned* bar = b.bar;
        __builtin_amdgcn_s_waitcnt(0);
        unsigned nloc = b.st[0], nx = b.st[1];
        if (nloc == 0u) { xcd_barrier_complete(bar, b.x, nloc, nx); b.st[0] = nloc; b.st[1] = nx; }
        const unsigned old = xb_add(&bar[XB_XSUB(b.x)], 1u);
        const unsigned gen = old / nloc;
        if (old + 1u == (gen + 1u) * nloc) {
            __builtin_amdgcn_fence(__ATOMIC_RELEASE, "agent");
            asm volatile("s_waitcnt vmcnt(0)" ::: "memory");
            const unsigned og = xb_add(&bar[XB_TOP], 1u);
            const unsigned tg = og / nx;
            if (og + 1u == (tg + 1u) * nx) xb_add(&bar[XB_TOPGEN], 1u);
            else XB_SPIN(xb_ld(&bar[XB_TOPGEN]) == tg, bar);
            __builtin_amdgcn_fence(__ATOMIC_ACQUIRE, "agent");
            xb_add(&bar[XB_XGEN(b.x)], 1u);
            asm volatile("s_waitcnt vmcnt(0)" ::: "memory");
        } else {
            XB_SPIN(xb_ld(&bar[XB_XGEN(b.x)]) == gen, bar);
            __builtin_amdgcn_fence(__ATOMIC_ACQUIRE, "agent");
            asm volatile("s_waitcnt vmcnt(0)" ::: "memory");
        }
    }
    __syncthreads();
}


constexpr int LDS_FLOATS = 33792;
constexpr int LDS_BYTES = LDS_FLOATS * 4 + 16 + 256;

typedef const __attribute__((address_space(4))) unsigned long long* kargp_t;
typedef __attribute__((address_space(1))) const float* gcf_t;
__device__ __forceinline__ Params load_params(const float* lds) {
    const LAS unsigned* tbl = (const LAS unsigned*)(lds + LDS_FLOATS + 4);
    Params p; const float** f = (const float**)&p;
#pragma unroll
    for (int i = 0; i < (int)(sizeof(Params) / 8); ++i) {
        const unsigned lo = __builtin_amdgcn_readfirstlane(tbl[2 * i]), hi = __builtin_amdgcn_readfirstlane(tbl[2 * i + 1]);
        f[i] = (const float*)(gcf_t)(((unsigned long long)hi << 32) | lo); }
    return p;
}
#define LOADP(name) const Params name = load_params(lds)

template <int l>
__device__ __forceinline__ void run_layer(const XcdBarrier& bar, int bid, int nb, float* lds) {
    constexpr bool need_ctx = l == 0;
    constexpr float lam_init = l == 0 ? 0.2f : 0.35550906759509393f;
    { LOADP(p); ph_norm<false>(p, l, 0, NROW, bid, nb); } xcd_barrier(bar);
    { LOADP(p); ph_gemm_in(p, l, bid, nb, lds); } xcd_barrier(bar);
    { LOADP(p); ph_rope(p, bid, nb); } xcd_barrier(bar);
    { LOADP(p); ph_ret_summ(p, l, bid, nb, lds); } { LOADP(p); ph_lru_chunk<1>(p, l, bid, nb, lds, 0); } xcd_barrier(bar);
    { LOADP(p); ph_scan2(p, l, bid, nb); } xcd_barrier(bar);
    { LOADP(p); ph_diff(p, l, need_ctx, lam_init, bid, nb, lds); }
    { LOADP(p); ph_swa(p, l, need_ctx, bid, nb, lds); }
    { LOADP(p); ph_ret_out(p, l, bid, nb, lds, need_ctx ? 0 : 2); }
    { LOADP(p); ph_lru_chunk<3>(p, l, bid, nb, lds, need_ctx ? 0 : 2); } xcd_barrier(bar);
    { LOADP(p); ph_gemm_out(p, l, need_ctx, bid, nb, lds); } xcd_barrier(bar);
    if (l == 0) {
        { LOADP(p); ph_norm<false>(p, l, 1, NROW, bid, nb); } xcd_barrier(bar);
        { LOADP(p); ph_ffn1(p, need_ctx, bid, nb, lds); } xcd_barrier(bar);
        { LOADP(p); ph_ffn2(p, l, need_ctx, bid, nb, lds); } xcd_barrier(bar);
    } else {
        { LOADP(p); ph_norm<true>(p, l, 1, NLAT, bid, nb); } xcd_barrier(bar);
        { LOADP(p); ph_moe_scatter(p, bid, nb, lds); } xcd_barrier(bar);
        { LOADP(p); ph_moe1(p, 0, bid, nb, lds); } xcd_barrier(bar);
        { LOADP(p); ph_moe2(p, l, 0, bid, nb, lds); } xcd_barrier(bar);
        { LOADP(p); ph_moe1(p, 1, bid, nb, lds); } xcd_barrier(bar);
        { LOADP(p); ph_moe2(p, l, 1, bid, nb, lds); } xcd_barrier(bar);
    }
}

__global__ void __launch_bounds__(512, 2) fwd(Params p_in) {
    extern __shared__ __attribute__((aligned(16))) float lds[];
    volatile LAS unsigned* st = (volatile LAS unsigned*)(lds + LDS_FLOATS);
    if (threadIdx.x == 0) { st[0] = 0u; st[1] = 0u; st[2] = 0u; st[3] = 0u; }
    if (threadIdx.x < (int)(sizeof(Params) / 8)) { const kargp_t q = (kargp_t)__builtin_amdgcn_kernarg_segment_ptr(); ((LAS unsigned long long*)(lds + LDS_FLOATS + 4))[threadIdx.x] = q[threadIdx.x]; }
    __syncthreads();
    XcdBarrier bar;
    { LOADP(p); bar = xcd_barrier_post((unsigned*)p.ws, st); }
    const int bid = blockIdx.x, nb = gridDim.x;
    { LOADP(p); ph_prologue(p, bid, nb, lds); } xcd_barrier(bar);
    run_layer<0>(bar, bid, nb, lds);
    run_layer<1>(bar, bid, nb, lds);
    { LOADP(p); ph_final(p, bid, nb); }
}

extern "C" void kernel_launch(void* const* d_in, const int* in_sizes, int n_in, void* d_out, int out_size, void* d_ws, size_t ws_size, hipStream_t stream) {
    static int grid = 0;
    if (grid == 0) {
        if (n_in < 30 || ws_size < WS_NEED) { fprintf(stderr, "kernel_launch: bad args n_in=%d ws=%zu need=%zu\n", n_in, ws_size, (size_t)WS_NEED); grid = -1; return; }
        int dev = 0, cus = 0, per_cu = 0;
        if (hipGetDevice(&dev) != hipSuccess || hipDeviceGetAttribute(&cus, hipDeviceAttributeMultiprocessorCount, dev) != hipSuccess) { grid = -1; return; }
        if (hipFuncSetAttribute((const void*)fwd, hipFuncAttributeMaxDynamicSharedMemorySize, LDS_BYTES) != hipSuccess) { fprintf(stderr, "kernel_launch: hipFuncSetAttribute failed\n"); grid = -1; return; }
        if (hipOccupancyMaxActiveBlocksPerMultiprocessor(&per_cu, (const void*)fwd, 512, LDS_BYTES) != hipSuccess || per_cu < 1) { fprintf(stderr, "kernel_launch: occupancy query says %d\n", per_cu); per_cu = 1; }
        (void)hipGetLastError();
        grid = cus;
    }
    if (grid < 0) return;
    Params p{};
    const float** f = (const float**)&p;
    for (int i = 0; i < 30; ++i) f[i] = (const float*)d_in[i];
    p.out = (float*)d_out; p.ws = (char*)d_ws;
    (void)hipMemsetAsync(d_ws, 0, 65536, stream);
    hipLaunchKernelGGL(fwd, dim3(grid), dim3(512), LDS_BYTES, stream, p);
}
```

```cpp
#include <hip/hip_runtime.h>
#include <cstdio>
#include <cstdint>

typedef unsigned short bf16_t;
typedef short bf16x8 __attribute__((ext_vector_type(8)));
typedef float f32x4 __attribute__((ext_vector_type(4)));
typedef unsigned u32x4 __attribute__((ext_vector_type(4)));
#define LAS __attribute__((address_space(3)))

constexpr int NB = 2, NSEQ = 16384, NCTX = 256, DM = 1024;
constexpr int NLAT = NB * NSEQ;
constexpr int NCR = NB * NCTX;
constexpr int NROW = NLAT + NCR;
constexpr int DIN = 2816, DFF = 2816, DFE = 3584, NE = 8;
constexpr int NCI = 130;
constexpr int C_AQ = 0, C_AK = 256, C_AV = 384, C_RQ = 512, C_RK = 768, C_RV = 1024, C_RG = 1280, C_DQ = 1536, C_DK = 1792, C_DV = 2048, C_LX = 2304, C_LY = 2560;
constexpr int GRP_ROWS = 34816;

constexpr size_t al256(size_t x) { return (x + 255) & ~(size_t)255; }
constexpr size_t OFF_CTRL = 0;
constexpr size_t OFF_MOD = 65536;
constexpr size_t OFF_ROPE_RET = al256(OFF_MOD + 2 * 3 * 6144 * 4);
constexpr size_t OFF_ROPE_AX = al256(OFF_ROPE_RET + 2 * 16384 * 32 * 4);
constexpr size_t OFF_XC = al256(OFF_ROPE_AX + (2 * 256 * 16 + 2 * 64 * 16 + 2 * 256 * 8 + 2 * 64 * 8) * 4);
constexpr size_t OFF_ROUTE = al256(OFF_XC + (size_t)NCR * DM * 4);
constexpr size_t OFF_TOK = al256(OFF_ROUTE + (size_t)NLAT * 16);
constexpr size_t OFF_WGT = al256(OFF_TOK + (size_t)2 * GRP_ROWS * 4);
constexpr size_t OFF_LRU = al256(OFF_WGT + (size_t)2 * GRP_ROWS * 4);
constexpr size_t OFF_WM13 = al256(OFF_LRU + (size_t)3 * 2 * 2 * NCI * 256 * 4);
constexpr size_t OFF_WM2 = al256(OFF_WM13 + (size_t)NE * 2 * DFE * DM * 2);
constexpr size_t OFF_R = al256(OFF_WM2 + (size_t)NE * DM * DFE * 2);
constexpr size_t OFF_P = OFF_R;
constexpr size_t OFF_ACT = al256(OFF_P + (size_t)NROW * DIN * 2);
constexpr size_t OFF_RET = al256(OFF_ACT + (size_t)NROW * DM * 2);
constexpr size_t OFF_WIN = al256(OFF_RET + (size_t)2 * 2 * NCI * 4 * 4096 * 4);
constexpr size_t OFF_WOUT = al256(OFF_WIN + (size_t)2 * DIN * DM * 2);
constexpr size_t OFF_WF13 = al256(OFF_WOUT + (size_t)2 * DM * DM * 2);
constexpr size_t OFF_WF2 = al256(OFF_WF13 + (size_t)2 * DFF * DM * 2);
constexpr size_t OFF_R_END1 = al256(OFF_WF2 + (size_t)DM * DFF * 2);
constexpr size_t OFF_ASORT = OFF_R;
constexpr size_t OFF_UMOE = al256(OFF_ASORT + (size_t)2 * GRP_ROWS * DM * 2);
constexpr size_t OFF_R_END2 = al256(OFF_UMOE + (size_t)GRP_ROWS * DFE * 2);
constexpr size_t WS_NEED = OFF_R_END1 > OFF_R_END2 ? OFF_R_END1 : OFF_R_END2;
static_assert(OFF_ACT >= OFF_UMOE, "H2 must not overlap A_sorted");
constexpr int CW_CNT = 4096;
constexpr int CW_CUR = 4160;

struct Params {
    const float *x, *c, *ctx, *c_ctx, *w_ada, *b_ada, *g1, *g2, *w_in, *w_out, *sink, *ret_logit, *ret_gn, *diff_lam, *diff_gn,
        *conv_w, *conv_b, *lru_wa, *lru_ba, *lru_wx, *lru_bx, *lru_lam, *ffn_w1, *ffn_w3, *ffn_w2, *moe_router, *moe_w1, *moe_w3, *moe_w2, *final_norm;
    float* out; char* ws;
};

__device__ __forceinline__ int ltid_() { int t = threadIdx.x; asm volatile("" : "+v"(t)); return t; }
#define TIDX ltid_()
__device__ __forceinline__ float bf2f(bf16_t h) { return __uint_as_float(((unsigned)h) << 16); }
__device__ __forceinline__ bf16_t f2bf(float f) { unsigned u = __float_as_uint(f); u += 0x7fffu + ((u >> 16) & 1u); return (bf16_t)(u >> 16); }
__device__ __forceinline__ unsigned pack2(float lo, float hi) { return (unsigned)f2bf(lo) | ((unsigned)f2bf(hi) << 16); }
__device__ __forceinline__ float wave_sum(float v) {
#pragma unroll
    for (int o = 32; o >= 1; o >>= 1) v += __shfl_xor(v, o);
    return v;
}
__device__ __forceinline__ float sigmoidf_(float x) { return 1.0f / (1.0f + __expf(-x)); }
__device__ __forceinline__ float siluf_(float x) { return x / (1.0f + __expf(-x)); }
__device__ __forceinline__ float fast_silu(float v) { return v * __builtin_amdgcn_rcpf(1.0f + __expf(-v)); }
__device__ __forceinline__ float softplusf_(float x) { return x > 20.f ? x : log1pf(expf(x)); }
__device__ __forceinline__ float gelu_tanh(float x) { const float u = 0.7978845608028654f * (x + 0.044715f * x * x * x); return x * __builtin_amdgcn_rcpf(1.0f + __expf(-2.0f * u)); }
__device__ __forceinline__ int row_base(int b, int ci) { return ci < 2 ? NLAT + b * NCTX + ci * 128 : b * NSEQ + (ci - 2) * 128; }
__device__ __forceinline__ int mod_class(int row) { return row < NSEQ ? 0 : (row < NLAT ? 1 : 2); }

typedef float f32x16 __attribute__((ext_vector_type(16)));
typedef short s16x4 __attribute__((ext_vector_type(4)));
typedef short v4i16_t __attribute__((ext_vector_type(4)));
typedef float f32x2_t __attribute__((ext_vector_type(2)));
typedef __bf16 bf16x2_t __attribute__((ext_vector_type(2)));
__device__ __forceinline__ unsigned cvtpk_s(float lo, float hi) { f32x2_t v = {lo, hi}; bf16x2_t bb = __builtin_convertvector(v, bf16x2_t); return __builtin_bit_cast(unsigned, bb); }
__device__ __forceinline__ int crow(int r, int hi) { return (r & 3) + 8 * (r >> 2) + 4 * hi; }
__device__ __forceinline__ s16x4 vtr(const LAS char* p) { return __builtin_bit_cast(s16x4, __builtin_amdgcn_ds_read_tr16_b64_v4i16((LAS v4i16_t*)p)); }
__device__ __forceinline__ float bfs(short s) { return __uint_as_float(((unsigned)(unsigned short)s) << 16); }

__device__ __forceinline__ void convert_tile(const float* src, int K, int N, bf16_t* dst, int tile, int mode, float* lds) {
    const int tpn = N / 64, tk = tile / tpn, tn = tile % tpn, t = TIDX;
    {   const int kk = t >> 3, nc = (t & 7) * 8;
        const float4 a = *(const float4*)(src + (size_t)(tk * 64 + kk) * N + tn * 64 + nc);
        const float4 b = *(const float4*)(src + (size_t)(tk * 64 + kk) * N + tn * 64 + nc + 4);
        float* d = lds + kk * 65 + nc; d[0] = a.x; d[1] = a.y; d[2] = a.z; d[3] = a.w; d[4] = b.x; d[5] = b.y; d[6] = b.z; d[7] = b.w; }
    __syncthreads();
    {   const int n = t >> 3, kc = (t & 7) * 8, ng = tn * 64 + n;
        const int nrow = mode == 0 ? ng : ((ng >> 7) * 256 + (mode == 2 ? 128 : 0) + (ng & 127));
        uint4 w; w.x = pack2(lds[(kc + 0) * 65 + n], lds[(kc + 1) * 65 + n]); w.y = pack2(lds[(kc + 2) * 65 + n], lds[(kc + 3) * 65 + n]);
        w.z = pack2(lds[(kc + 4) * 65 + n], lds[(kc + 5) * 65 + n]); w.w = pack2(lds[(kc + 6) * 65 + n], lds[(kc + 7) * 65 + n]);
        *(uint4*)(dst + (size_t)nrow * K + tk * 64 + kc) = w; }
    __syncthreads();
}

__device__ __forceinline__ void ph_prologue(const Params& p, int bid, int nb, float* lds) {
    char* ws = p.ws; const int t = TIDX;
    {
        struct Job { const float* src; bf16_t* dst; int K, N, mode, base; };
        Job* jobs = (Job*)(lds + 64 * 65 + 3);
        const int T_IN = 16 * 44, T_OUT = 16 * 16, T_F13 = 16 * 44, T_F2 = 44 * 16, T_M13 = 16 * 56, T_M2 = 56 * 16;
        const int total = 2 * T_IN + 2 * T_OUT + 2 * T_F13 + T_F2 + 16 * T_M13 + 8 * T_M2;
        if (t < 32) {
            Job jb; jb.src = nullptr; jb.dst = nullptr; jb.K = DM; jb.N = DM; jb.mode = 0; jb.base = total;
            if (t < 2) { jb.src = p.w_in + (size_t)t * DM * DIN; jb.dst = (bf16_t*)(ws + OFF_WIN) + (size_t)t * DIN * DM; jb.N = DIN; jb.base = t * T_IN; }
            else if (t < 4) { jb.src = p.w_out + (size_t)(t - 2) * DM * DM; jb.dst = (bf16_t*)(ws + OFF_WOUT) + (size_t)(t - 2) * DM * DM; jb.base = 2 * T_IN + (t - 2) * T_OUT; }
            else if (t < 6) { jb.src = t == 4 ? p.ffn_w1 : p.ffn_w3; jb.dst = (bf16_t*)(ws + OFF_WF13); jb.N = DFF; jb.mode = t - 3; jb.base = 2 * T_IN + 2 * T_OUT + (t - 4) * T_F13; }
            else if (t == 6) { jb.src = p.ffn_w2; jb.dst = (bf16_t*)(ws + OFF_WF2); jb.K = DFF; jb.base = 2 * T_IN + 2 * T_OUT + 2 * T_F13; }
            else if (t < 23) { const int q = t - 7, e = q & 7, w3 = q >> 3; jb.src = (w3 ? p.moe_w3 : p.moe_w1) + (size_t)e * DM * DFE; jb.dst = (bf16_t*)(ws + OFF_WM13) + (size_t)e * 2 * DFE * DM; jb.N = DFE; jb.mode = 1 + w3;
                jb.base = 2 * T_IN + 2 * T_OUT + 2 * T_F13 + T_F2 + q * T_M13; }
            else if (t < 31) { const int e = t - 23; jb.src = p.moe_w2 + (size_t)e * DFE * DM; jb.dst = (bf16_t*)(ws + OFF_WM2) + (size_t)e * DM * DFE; jb.K = DFE;
                jb.base = 2 * T_IN + 2 * T_OUT + 2 * T_F13 + T_F2 + 16 * T_M13 + e * T_M2; }
            jobs[t] = jb;
        }
        __syncthreads();
        int j = 0;
        for (int u = bid; u < total; u += nb) {
            while (u >= jobs[j + 1].base) ++j;
            const Job jb = jobs[j];
            convert_tile(jb.src, jb.K, jb.N, jb.dst, u - jb.base, jb.mode, lds);
        }
        __syncthreads();
    }
    {
        float* sv = lds;
        float* red = lds + 3072;
        for (int i = t; i < 3072; i += 512) { const int v = i >> 10, k = i & 1023; const float cv = v < 2 ? p.c[v * DM + k] : p.c_ctx[k]; sv[i] = siluf_(cv); }
        __syncthreads();
        float* mod = (float*)(ws + OFF_MOD);
        for (int u = bid; u < 2 * 96; u += nb) {
            const int l = u / 96, j0 = (u % 96) * 64, j = t & 63, kg = t >> 6;
            float a0 = 0.f, a1 = 0.f, a2 = 0.f;
            const float* w = p.w_ada + (size_t)l * DM * 6144 + j0 + j;
            for (int k = kg * 128; k < kg * 128 + 128; ++k) { const float wv = w[(size_t)k * 6144]; a0 += sv[k] * wv; a1 += sv[1024 + k] * wv; a2 += sv[2048 + k] * wv; }
            red[(kg * 3 + 0) * 64 + j] = a0; red[(kg * 3 + 1) * 64 + j] = a1; red[(kg * 3 + 2) * 64 + j] = a2;
            __syncthreads();
            if (t < 192) { const int v = t >> 6; float s = 0.f;
                for (int g = 0; g < 8; ++g) s += red[(g * 3 + v) * 64 + j];
                mod[((size_t)l * 3 + v) * 6144 + j0 + j] = s + p.b_ada[l * 6144 + j0 + j]; }
            __syncthreads();
        }
    }
    {
        float* rr = (float*)(ws + OFF_ROPE_RET);
        const int gt = bid * 512 + t, gs = nb * 512;
        for (int i = gt; i < 16384 * 32; i += gs) { const int n = i >> 5, j = i & 31;
            const float inv = (float)pow(10000.0, -(double)j / 32.0); const float ang = (float)n * inv;
            rr[i] = (float)cos((double)ang); rr[16384 * 32 + i] = (float)sin((double)ang); }
        float* ax = (float*)(ws + OFF_ROPE_AX);
        for (int i = gt; i < 256 * 16; i += gs) { const int n = i >> 4, j = i & 15; const float inv = (float)pow(10000.0, -(double)j / 16.0); const float ang = (float)n * inv;
            ax[i] = (float)cos((double)ang); ax[4096 + i] = (float)sin((double)ang);
            if (n < 64) { ax[8192 + i] = (float)cos((double)ang); ax[9216 + i] = (float)sin((double)ang); } }
        for (int i = gt; i < 256 * 8; i += gs) { const int n = i >> 3, j = i & 7; const float inv = (float)pow(10000.0, -(double)j / 8.0); const float ang = (float)n * inv;
            ax[10240 + i] = (float)cos((double)ang); ax[12288 + i] = (float)sin((double)ang);
            if (n < 64) { ax[14336 + i] = (float)cos((double)ang); ax[14848 + i] = (float)sin((double)ang); } }
        float* xc = (float*)(ws + OFF_XC);
        for (int i = gt; i < NCR * DM / 4; i += gs) ((float4*)xc)[i] = ((const float4*)p.ctx)[i];
        int* tok = (int*)(ws + OFF_TOK);
        for (int i = gt; i < 2 * GRP_ROWS; i += gs) tok[i] = -1;
    }
}

template <bool ROUTE>
__device__ __forceinline__ void ph_norm(const Params& p, int l, int which  , int nrows, int bid, int nb) {
    char* ws = p.ws; const int lane = TIDX & 63, wv = TIDX >> 6;
    const float* mod = (const float*)(ws + OFF_MOD) + (size_t)l * 3 * 6144;
    const float* g = (which == 0 ? p.g1 : p.g2) + l * DM;
    bf16_t* H = (bf16_t*)(ws + OFF_ACT);
    const float* xl = (which == 0 && l == 0) ? p.x : p.out;
    const float* xc = (const float*)(ws + OFF_XC);
    for (int r = bid * 8 + wv; r < nrows; r += nb * 8) {
        const float* xr = r < NLAT ? xl + (size_t)r * DM : xc + (size_t)(r - NLAT) * DM;
        const float* mv = mod + (size_t)mod_class(r) * 6144 + (which == 0 ? 0 : 3072);
        float4 v[4]; float ss = 0.f;
#pragma unroll
        for (int i = 0; i < 4; ++i) { v[i] = *(const float4*)(xr + i * 256 + lane * 4); ss += v[i].x * v[i].x + v[i].y * v[i].y + v[i].z * v[i].z + v[i].w * v[i].w; }
        ss = wave_sum(ss);
        const float rn = rsqrtf(ss * (1.0f / 1024.0f) + 1e-6f);
        float lg[8];
        if (ROUTE) {
#pragma unroll
            for (int e = 0; e < 8; ++e) lg[e] = 0.f;
        }
#pragma unroll
        for (int i = 0; i < 4; ++i) {
            const int c = i * 256 + lane * 4;
            const float4 gg = *(const float4*)(g + c), sh = *(const float4*)(mv + c), sc = *(const float4*)(mv + 1024 + c);
            float h0 = v[i].x * rn * gg.x * (1.f + sc.x) + sh.x, h1 = v[i].y * rn * gg.y * (1.f + sc.y) + sh.y;
            float h2 = v[i].z * rn * gg.z * (1.f + sc.z) + sh.z, h3 = v[i].w * rn * gg.w * (1.f + sc.w) + sh.w;
            uint2 w; w.x = pack2(h0, h1); w.y = pack2(h2, h3);
            *(uint2*)(H + (size_t)r * DM + c) = w;
            if (ROUTE) {
                const float* rt = p.moe_router + (size_t)c * 8;
#pragma unroll
                for (int e = 0; e < 8; ++e) lg[e] += h0 * rt[e] + h1 * rt[8 + e] + h2 * rt[16 + e] + h3 * rt[24 + e];
            }
        }
        if (ROUTE) {
#pragma unroll
            for (int e = 0; e < 8; ++e) lg[e] = wave_sum(lg[e]);
            if (lane == 0 && r < NLAT) {
                int e0 = 0; float v0 = lg[0];
#pragma unroll
                for (int e = 1; e < 8; ++e) if (lg[e] > v0) { v0 = lg[e]; e0 = e; }
                int e1 = -1; float v1 = -3.0e38f;
#pragma unroll
                for (int e = 0; e < 8; ++e) if (e != e0 && lg[e] > v1) { v1 = lg[e]; e1 = e; }
                const float ex = __expf(v1 - v0), w0 = 1.0f / (1.0f + ex), w1 = ex / (1.0f + ex);
                int4 rec; rec.x = e0; rec.y = e1; rec.z = __float_as_int(w0); rec.w = __float_as_int(w1);
                *(int4*)(ws + OFF_ROUTE + (size_t)r * 16) = rec;
                unsigned* cw = (unsigned*)ws;
                atomicAdd(cw + CW_CNT + e0, 1u); atomicAdd(cw + CW_CNT + 8 + e1, 1u);
            }
        }
    }
}

namespace pg8 {
#define PG8_LAS __attribute__((address_space(3)))
typedef unsigned short bf16_t;
typedef short bf16x8 __attribute__((ext_vector_type(8)));
typedef float f32x4 __attribute__((ext_vector_type(4)));
typedef unsigned u32x4 __attribute__((ext_vector_type(4)));
constexpr int BM = 256, BK = 64, HALF = 128, HTB = HALF * BK * 2  , STAGE_BYTES = 8 * HTB, NXCD = 8, WGM = 8;

__host__ __device__ __forceinline__ int lds_byte(int r, int c) { const int st = (r >> 4) * 2 + (c >> 5), rr = r & 15, cc = c & 31, ob = rr * 64 + cc * 2; return st * 1024 + (ob ^ (((ob >> 9) & 1) << 5)); }
__host__ __device__ __forceinline__ void stage_rc(int b, int& R, int& C) { const int st = b / 1024, sb = b % 1024, swz = sb ^ (((sb >> 9) & 1) << 5); R = (st >> 1) * 16 + swz / 64; C = (st & 1) * 32 + (swz % 64) / 2; }
__host__ __device__ __forceinline__ int perm32(int rho) { const int n = rho >> 4, i = rho & 15; return 8 * (i >> 2) + 4 * n + (i & 3); }

struct Unit { int pm, pn; };
struct Gemm { const bf16_t* A; const bf16_t* Bt; int M, N, K; };

struct StaticOrder {
    int nM, nN, nwg, G, c;
    __host__ __device__ void init(int M, int N, int G_, int c_) { nM = M / BM; nN = N / BM; nwg = nM * nN; G = G_; c = c_; }
    __host__ __device__ bool next(int i, Unit& u) const {
        const long L = (long)i * G + c; if (L >= nwg) return false;
        int wgid = (int)L; { const int q = nwg / NXCD, r = nwg % NXCD, xcd = wgid % NXCD, off = wgid / NXCD; wgid = (xcd < r ? xcd * (q + 1) : r * (q + 1) + (xcd - r) * q) + off; }
        const int nig = WGM * nN, gid = wgid / nig, fm = gid * WGM, gsz = (nM - fm) < WGM ? (nM - fm) : WGM;
        u.pm = fm + ((wgid % nig) % gsz); u.pn = (wgid % nig) / gsz; return true;
    }
    __device__ __forceinline__ void a_ready(const Unit&) const {}
    __device__ __forceinline__ void done(const Unit&) const {}
};
__device__ __forceinline__ unsigned cvt_pk_bf16(float lo, float hi) { unsigned r; asm volatile("v_cvt_pk_bf16_f32 %0, %1, %2" : "=v"(r) : "v"(lo), "v"(hi)); return r; }
typedef float f32x2 __attribute__((ext_vector_type(2)));
template <class Epi, class Sched, bool ALIGN_EPI = false, bool SP2 = false>
__device__ __forceinline__ void gemm_phase(PG8_LAS unsigned char* lds, const Gemm g, const Sched& S, const Epi& E) {
    int tid_ = threadIdx.x; asm volatile("" : "+v"(tid_));
    const int tid = tid_, wid = __builtin_amdgcn_readfirstlane(tid >> 6), lane = tid & 63, wr = wid >> 2, wc = wid & 3, fr = lane & 15, fq = lane >> 4;
    const int K = g.K, nt = K / BK;
    unsigned voffA[2], voffB[2];
#pragma unroll
    for (int i = 0; i < 2; ++i) { int R, C; stage_rc(tid * 16 + i * 8192, R, C); const int Rb = Epi::PERM ? ((R & ~31) + perm32(R & 31)) : R;
        voffA[i] = (unsigned)(R * K + C) * 2u; voffB[i] = (unsigned)(Rb * K + C) * 2u; }
    const size_t kstep = (size_t)(BK * 2);
    const size_t hstep = (size_t)HALF * K * 2;
    const size_t tstep = 2 * hstep;
    const unsigned ldsw = (unsigned)wid * 1024u;
    const int aoff = lds_byte(wr * 64 + fr, fq * 8), boff = lds_byte(wc * 32 + fr, fq * 8);
#define PG8_SA(b, h) (((b) * 2 + (h)) * HTB)
#define PG8_SB(b, h) ((4 + (b) * 2 + (h)) * HTB)
#define PG8_STAGE(bufoff, gbase, voff) do { _Pragma("unroll") for (int _i = 0; _i < 2; ++_i) \
        __builtin_amdgcn_global_load_lds((const unsigned*)((const char*)(gbase) + (voff)[_i]), (PG8_LAS unsigned*)(lds + (bufoff) + ldsw + _i * 8192), 16, 0, 0); } while (0)
#define PG8_LDA(dst, b, h) do { _Pragma("unroll") for (int m = 0; m < 4; ++m) _Pragma("unroll") for (int k = 0; k < 2; ++k) dst[m][k] = *(const PG8_LAS bf16x8*)(lds + PG8_SA(b, h) + aoff + m * 2048 + k * 1024); } while (0)
#define PG8_LDB(dst, b, h) do { _Pragma("unroll") for (int n = 0; n < 2; ++n) _Pragma("unroll") for (int k = 0; k < 2; ++k) dst[n][k] = *(const PG8_LAS bf16x8*)(lds + PG8_SB(b, h) + boff + n * 2048 + k * 1024); } while (0)
#define PG8_MMA(ai, bj, At, Bt) do { __builtin_amdgcn_s_setprio(1); _Pragma("unroll") for (int m = 0; m < 4; ++m) _Pragma("unroll") for (int n = 0; n < 2; ++n) _Pragma("unroll") for (int k = 0; k < 2; ++k) \
        acc[ai][bj][m][n] = __builtin_amdgcn_mfma_f32_16x16x32_bf16(Bt[n][k], At[m][k], acc[ai][bj][m][n], 0, 0, 0); __builtin_amdgcn_s_setprio(0); } while (0)
#define PG8_WAIT_V(n) asm volatile("s_waitcnt vmcnt(" #n ")" ::: "memory")
#define PG8_WAIT_L(n) asm volatile("s_waitcnt lgkmcnt(" #n ")" ::: "memory")
#define PG8_BAR __builtin_amdgcn_s_barrier()
#define PG8_SCHED __builtin_amdgcn_sched_barrier(0)
    Unit cur, nxt; int ui = 0;
    if (!S.next(0, cur)) return;
    f32x4 acc[2][2][4][2];
#pragma unroll
    for (int a = 0; a < 2; ++a)
#pragma unroll
        for (int b = 0; b < 2; ++b)
#pragma unroll
            for (int m = 0; m < 4; ++m)
#pragma unroll
                for (int n = 0; n < 2; ++n) acc[a][b][m][n] = (f32x4){0.f, 0.f, 0.f, 0.f};
    bf16x8 At[4][2], B0[2][2], B1[2][2];
    const char* cA = (const char*)g.A + (size_t)cur.pm * tstep; const char* cB = (const char*)g.Bt + (size_t)cur.pn * tstep;
    S.a_ready(cur);
    if constexpr (SP2) {
        PG8_STAGE(PG8_SB(0, 0), cB, voffB); PG8_STAGE(PG8_SB(0, 1), cB + hstep, voffB); PG8_STAGE(PG8_SA(0, 0), cA, voffA); PG8_STAGE(PG8_SA(0, 1), cA + hstep, voffA);
        if (wr == 1) PG8_BAR;
        PG8_WAIT_V(2); PG8_BAR;
        PG8_STAGE(PG8_SB(1, 0), cB + kstep, voffB); PG8_STAGE(PG8_SA(1, 0), cA + kstep, voffA); PG8_STAGE(PG8_SB(1, 1), cB + hstep + kstep, voffB);
        PG8_WAIT_V(6); PG8_BAR;
    } else {
        PG8_STAGE(PG8_SB(0, 0), cB, voffB); PG8_STAGE(PG8_SA(0, 0), cA, voffA); PG8_STAGE(PG8_SB(0, 1), cB + hstep, voffB); PG8_STAGE(PG8_SA(0, 1), cA + hstep, voffA);
        if (wr == 1) PG8_BAR;
        PG8_WAIT_V(4); PG8_BAR;
        PG8_STAGE(PG8_SB(1, 0), cB + kstep, voffB); PG8_STAGE(PG8_SA(1, 0), cA + kstep, voffA); PG8_STAGE(PG8_SB(1, 1), cB + hstep + kstep, voffB);
        PG8_WAIT_V(6); PG8_BAR;
    }
    for (;;) {
        const bool has_next = S.next(ui + 1, nxt);
        const char* nA = has_next ? (const char*)g.A + (size_t)nxt.pm * tstep : cA; const char* nB = has_next ? (const char*)g.Bt + (size_t)nxt.pn * tstep : cB;
        for (int t = 0; t < nt; t += 2) {
            const bool last = (t == nt - 2);
            const char* a1 = cA + (size_t)(t + 1) * kstep;
            const char* a2 = last ? nA : cA + (size_t)(t + 2) * kstep; const char* b2 = last ? nB : cB + (size_t)(t + 2) * kstep;
            const char* a3 = a2 + kstep; const char* b3 = b2 + kstep;
            if (last && has_next) S.a_ready(nxt);
            if constexpr (SP2) {
            PG8_LDB(B0, 0, 0); PG8_LDB(B1, 0, 1); PG8_SCHED; PG8_LDA(At, 0, 0); PG8_STAGE(PG8_SA(1, 1), a1 + hstep, voffA);
            PG8_WAIT_V(8); PG8_WAIT_L(0); PG8_BAR; PG8_MMA(0, 0, At, B0); PG8_MMA(0, 1, At, B1); PG8_BAR; PG8_SCHED;
            PG8_LDA(At, 0, 1); PG8_STAGE(PG8_SB(0, 0), b2, voffB); PG8_STAGE(PG8_SB(0, 1), b2 + hstep, voffB); PG8_STAGE(PG8_SA(0, 0), a2, voffA);
            PG8_WAIT_V(8); PG8_WAIT_L(0); PG8_BAR; PG8_MMA(1, 0, At, B0); PG8_MMA(1, 1, At, B1); PG8_BAR; PG8_SCHED;
            PG8_LDB(B0, 1, 0); PG8_LDB(B1, 1, 1); PG8_SCHED; PG8_LDA(At, 1, 0); PG8_STAGE(PG8_SA(0, 1), a2 + hstep, voffA);
            PG8_WAIT_V(8); PG8_WAIT_L(0); PG8_BAR; PG8_MMA(0, 0, At, B0); PG8_MMA(0, 1, At, B1); PG8_BAR; PG8_SCHED;
            PG8_LDA(At, 1, 1); PG8_STAGE(PG8_SB(1, 0), b3, voffB); PG8_STAGE(PG8_SB(1, 1), b3 + hstep, voffB); PG8_STAGE(PG8_SA(1, 0), a3, voffA);
            PG8_WAIT_V(8); PG8_WAIT_L(0); PG8_BAR; PG8_MMA(1, 0, At, B0); PG8_MMA(1, 1, At, B1); PG8_BAR; PG8_SCHED;
            } else {
            PG8_LDB(B0, 0, 0); PG8_SCHED; PG8_LDA(At, 0, 0); PG8_STAGE(PG8_SA(1, 1), a1 + hstep, voffA);
            PG8_WAIT_L(8); PG8_BAR; PG8_WAIT_L(0); PG8_MMA(0, 0, At, B0); PG8_BAR; PG8_SCHED;
            PG8_LDB(B1, 0, 1); PG8_STAGE(PG8_SB(0, 0), b2, voffB);
            PG8_BAR; PG8_WAIT_L(0); PG8_MMA(0, 1, At, B1); PG8_BAR;
            PG8_LDA(At, 0, 1); PG8_STAGE(PG8_SA(0, 0), a2, voffA);
            PG8_BAR; PG8_WAIT_L(0); PG8_MMA(1, 0, At, B0); PG8_BAR; PG8_SCHED;
            PG8_STAGE(PG8_SB(0, 1), b2 + hstep, voffB);
            PG8_WAIT_V(6); PG8_BAR; PG8_MMA(1, 1, At, B1); PG8_BAR;
            PG8_LDB(B0, 1, 0); PG8_SCHED; PG8_LDA(At, 1, 0); PG8_STAGE(PG8_SA(0, 1), a2 + hstep, voffA);
            PG8_WAIT_L(8); PG8_BAR; PG8_WAIT_L(0); PG8_MMA(0, 0, At, B0); PG8_BAR; PG8_SCHED;
            PG8_LDB(B1, 1, 1); PG8_STAGE(PG8_SB(1, 0), b3, voffB);
            PG8_BAR; PG8_WAIT_L(0); PG8_MMA(0, 1, At, B1); PG8_BAR;
            PG8_LDA(At, 1, 1); PG8_STAGE(PG8_SA(1, 0), a3, voffA);
            PG8_BAR; PG8_WAIT_L(0); PG8_MMA(1, 0, At, B0); PG8_BAR; PG8_SCHED;
            PG8_STAGE(PG8_SB(1, 1), b3 + hstep, voffB);
            PG8_WAIT_V(6); PG8_BAR; PG8_MMA(1, 1, At, B1); PG8_BAR;
            }
        }
        if constexpr (ALIGN_EPI) { if (wr == 0) PG8_BAR; }
        if constexpr (!Epi::AFTER_DRAIN) { E(acc, cur, wr, wc, fr, fq); S.done(cur); }
        if (!has_next) break;
#pragma unroll
        for (int a = 0; a < 2; ++a)
#pragma unroll
            for (int b = 0; b < 2; ++b)
#pragma unroll
                for (int m = 0; m < 4; ++m)
#pragma unroll
                    for (int n = 0; n < 2; ++n) acc[a][b][m][n] = (f32x4){0.f, 0.f, 0.f, 0.f};
        cur = nxt; cA = nA; cB = nB; ++ui;
        if constexpr (ALIGN_EPI) { if (wr == 1) PG8_BAR; }
    }
    PG8_WAIT_V(0);
    if constexpr (!ALIGN_EPI) { if (wr == 0) PG8_BAR; }
    PG8_BAR;
    if constexpr (Epi::AFTER_DRAIN) { E.fused(acc, cur, wr, wc, fr, fq, lds, wid, lane); S.done(cur); }
#undef PG8_SA
#undef PG8_SB
#undef PG8_STAGE
#undef PG8_LDA
#undef PG8_LDB
#undef PG8_MMA
#undef PG8_WAIT_V
#undef PG8_WAIT_L
#undef PG8_BAR
#undef PG8_SCHED
}
}

__device__ __forceinline__ void ph_rope(const Params& p, int bid, int nb) {
    char* ws = p.ws; const int lane = TIDX & 63, wv = TIDX >> 6;
    bf16_t* P = (bf16_t*)(ws + OFF_P);
    const float* rr = (const float*)(ws + OFF_ROPE_RET); const float* ax = (const float*)(ws + OFF_ROPE_AX);
    for (int r = bid * 8 + wv; r < NROW; r += nb * 8) {
        const bool lat = r < NLAT; const int n = r & (NSEQ - 1), gr = n >> 6, gc = n & 63;
        bf16_t* pr = P + (size_t)r * DIN;
        for (int it = 0; it < 11; ++it) {
            const int pi = it * 64 + lane;
            int c1, c2; float cs = 1.f, sn = 0.f, scale = 1.f;
            if (pi < 192) {
                const int hd = pi >> 5, j = pi & 31; c1 = (pi < 128 ? C_AQ : C_AK - 256) + hd * 64 + j; c2 = c1 + 32;
                if (pi < 128) scale = 0.125f * 1.4426950408889634f;
                if (lat) { if (j < 16) { cs = ax[gr * 16 + j]; sn = ax[4096 + gr * 16 + j]; } else { cs = ax[8192 + gc * 16 + j - 16]; sn = ax[9216 + gc * 16 + j - 16]; } }
            } else if (pi < 448) {
                const int q = pi - 192, hd = q >> 5, j = q & 31; c1 = C_RQ + hd * 64 + j; c2 = c1 + 32;
                if (q >= 128) scale = 0.125f;
                if (lat) { cs = rr[n * 32 + j]; sn = rr[16384 * 32 + n * 32 + j]; }
            } else {
                const int q = pi - 448, blk = q >> 4, j = q & 15; c1 = C_DQ + blk * 32 + j; c2 = c1 + 16;
                if (q < 128) scale = 0.17677669529663687f * 1.4426950408889634f;
                if (lat) { if (j < 8) { cs = ax[10240 + gr * 8 + j]; sn = ax[12288 + gr * 8 + j]; } else { cs = ax[14336 + gc * 8 + j - 8]; sn = ax[14848 + gc * 8 + j - 8]; } }
            }
            const float x1 = bf2f(pr[c1]), x2 = bf2f(pr[c2]);
            pr[c1] = f2bf((x1 * cs - x2 * sn) * scale); pr[c2] = f2bf((x2 * cs + x1 * sn) * scale);
        }
    }
}

constexpr int RT_K = 0, RT_V = 32768, RT_ST = 65536;
template <bool KV> __device__ __forceinline__ void ret_stage(const bf16_t* P, int rb, int hp, LAS char* sm, int tid, int wid, int lane) {
    const int vrow = 16 * (wid & 3) + (lane >> 2), vc = (wid >> 2) * 32 + (lane & 3) * 8;
    u32x4 kk[4], vv[4];
#pragma unroll
    for (int i = 0; i < 4; ++i) { const int hh = i >> 1, tt = i & 1, h = 2 * hp + hh, r0 = rb + tt * 64;
        vv[i] = *(const u32x4*)(P + (size_t)(r0 + vrow) * DIN + C_RV + h * 64 + vc);
        kk[i] = KV ? *(const u32x4*)(P + (size_t)(r0 + vrow) * DIN + C_RK + h * 64 + vc) : *(const u32x4*)(P + (size_t)(r0 + lane) * DIN + C_RK + h * 64 + wid * 8); }
#pragma unroll
    for (int i = 0; i < 4; ++i) { *(LAS u32x4*)(sm + RT_K + i * 8192 + tid * 16) = kk[i]; *(LAS u32x4*)(sm + RT_V + i * 8192 + tid * 16) = vv[i]; }
}
__device__ __forceinline__ float ret_lg(const Params& p, int l, int dir, int h) { return -softplusf_(-p.ret_logit[(l * 2 + dir) * 4 + h]); }
__device__ __forceinline__ void ph_ret_summ(const Params& p, int l, int bid, int nb, float* lds) {
    char* ws = p.ws; const int tid = TIDX, lane = tid & 63, r32 = lane & 31, hi = lane >> 5, wid = __builtin_amdgcn_readfirstlane(tid >> 6);
    const bf16_t* P = (const bf16_t*)(ws + OFF_P); float* RET = (float*)(ws + OFF_RET);
    LAS char* sm = (LAS char*)lds;
    for (int u = bid; u < 2 * NCI * 2; u += nb) {
        const int hp = u & 1, ci = (u >> 1) % NCI, b = (u >> 1) / NCI, rb = row_base(b, ci);
        __syncthreads();
        ret_stage<true>(P, rb, hp, sm, tid, wid, lane);
        __syncthreads();
        const int hh = wid >> 2, dh = (wid >> 1) & 1, eh = wid & 1, h = 2 * hp + hh;
        const float lg2f = ret_lg(p, l, 0, h) * 1.4426950408889634f, lg2b = ret_lg(p, l, 1, h) * 1.4426950408889634f;
        const int voff = ((lane >> 4) & 1) * 32 + (lane & 3) * 8 + (4 * hi + ((lane & 15) >> 2)) * 64;
        const LAS char* Kb = sm + RT_K + hh * 16384 + dh * 4096 + voff; const LAS char* Vb = sm + RT_V + hh * 16384 + eh * 4096 + voff;
        f32x16 a0, a1;
#pragma unroll
        for (int r = 0; r < 16; ++r) { a0[r] = 0.f; a1[r] = 0.f; }
#pragma unroll
        for (int k8 = 0; k8 < 8; ++k8) { const int tt = k8 >> 2, sl = k8 & 3;
            const s16x4 klo = vtr(Kb + tt * 8192 + sl * 1024), khi = vtr(Kb + tt * 8192 + sl * 1024 + 512), vlo = vtr(Vb + tt * 8192 + sl * 1024), vhi = vtr(Vb + tt * 8192 + sl * 1024 + 512);
            const int mb = tt * 64 + sl * 16 + 4 * hi; float kf_[8], kb_[8];
#pragma unroll
            for (int j = 0; j < 8; ++j) { const int m = mb + (j < 4 ? j : j + 4); const float kv = bfs(j < 4 ? klo[j] : khi[j - 4]);
                kf_[j] = kv * __builtin_amdgcn_exp2f(lg2f * (float)(127 - m)); kb_[j] = kv * __builtin_amdgcn_exp2f(lg2b * (float)m); }
            const u32x4 af = {cvtpk_s(kf_[0], kf_[1]), cvtpk_s(kf_[2], kf_[3]), cvtpk_s(kf_[4], kf_[5]), cvtpk_s(kf_[6], kf_[7])};
            const u32x4 ab = {cvtpk_s(kb_[0], kb_[1]), cvtpk_s(kb_[2], kb_[3]), cvtpk_s(kb_[4], kb_[5]), cvtpk_s(kb_[6], kb_[7])};
            const bf16x8 vfr = {vlo[0], vlo[1], vlo[2], vlo[3], vhi[0], vhi[1], vhi[2], vhi[3]};
            a0 = __builtin_amdgcn_mfma_f32_32x32x16_bf16(__builtin_bit_cast(bf16x8, af), vfr, a0, 0, 0, 0);
            a1 = __builtin_amdgcn_mfma_f32_32x32x16_bf16(__builtin_bit_cast(bf16x8, ab), vfr, a1, 0, 0, 0); }
        float* of = RET + ((((size_t)0 * 2 + b) * NCI + ci) * 4 + h) * 4096 + eh * 32 + r32;
        float* ob = RET + ((((size_t)1 * 2 + b) * NCI + ci) * 4 + h) * 4096 + eh * 32 + r32;
#pragma unroll
        for (int r = 0; r < 16; ++r) { const int d = dh * 32 + crow(r, hi); of[d * 64] = a0[r]; ob[d * 64] = a1[r]; }
    }
}

constexpr int LR_UB = 0, LR_A = 18432, LR_B = 51200, LR_H = 83968;
template <int MODE>
__device__ __forceinline__ void ph_lru_chunk(const Params& p, int l, int bid, int nb, float* lds, int ci_lo) {
    char* ws = p.ws; const int tid = TIDX, lane = tid & 63, r32 = lane & 31, hi = lane >> 5, wid = __builtin_amdgcn_readfirstlane(tid >> 6);
    const bf16_t* P = (const bf16_t*)(ws + OFF_P);
    float* LA = (float*)(ws + OFF_LRU); float* LB = LA + 2 * 2 * NCI * 256; float* LC = LB + 2 * 2 * NCI * 256;
    bf16_t* O = (bf16_t*)(ws + OFF_ACT);
    LAS char* sm = (LAS char*)lds;
    const int hb = bid & 3, tt = wid >> 1, jt = wid & 1, jcol = jt * 32 + r32, ch = hb * 64 + jcol;
    bf16x8 wfr[2][2][4]; float bia[2][2], spl[2];
#pragma unroll
    for (int dir = 0; dir < 2; ++dir) {
#pragma unroll
        for (int gt = 0; gt < 2; ++gt) { const float* W = (gt == 0 ? p.lru_wa : p.lru_wx) + (((size_t)(l * 2 + dir) * 4 + hb) * 64) * 64 + jcol;
#pragma unroll
            for (int ks = 0; ks < 4; ++ks) { const float* wp = W + (16 * ks + 8 * hi) * 64;
                const u32x4 w4 = {cvtpk_s(wp[0], wp[64]), cvtpk_s(wp[128], wp[192]), cvtpk_s(wp[256], wp[320]), cvtpk_s(wp[384], wp[448])};
                wfr[dir][gt][ks] = __builtin_bit_cast(bf16x8, w4); }
            bia[dir][gt] = (gt == 0 ? p.lru_ba : p.lru_bx)[(l * 2 + dir) * 256 + ch]; }
        spl[dir] = -8.0f * softplusf_(-p.lru_lam[(l * 2 + dir) * 256 + ch]); }
    const int nci = NCI - ci_lo, npair = 2 * nci;
    for (int pi = bid >> 2; pi < npair; pi += nb >> 2) {
        const int ci = ci_lo + pi % nci, b = pi / nci, rb = row_base(b, ci);
        const int seg_lo = ci < 2 ? NLAT + b * NCTX : b * NSEQ, seg_hi = ci < 2 ? seg_lo + NCTX : seg_lo + NSEQ;
        __syncthreads();
#pragma unroll
        for (int it = 0; it < 2; ++it) { const int item = it * 512 + tid, t = item >> 3, c8 = (item & 7) * 8, c0 = hb * 64 + c8;
            float acc[8];
            { const f32x4 b0 = *(const f32x4*)(p.conv_b + l * 256 + c0), b1 = *(const f32x4*)(p.conv_b + l * 256 + c0 + 4);
              acc[0] = b0[0]; acc[1] = b0[1]; acc[2] = b0[2]; acc[3] = b0[3]; acc[4] = b1[0]; acc[5] = b1[1]; acc[6] = b1[2]; acc[7] = b1[3]; }
#pragma unroll
            for (int k = 0; k < 4; ++k) { const int rr = rb + t - 1 + k;
                if (rr >= seg_lo && rr < seg_hi) { const bf16x8 xv = *(const bf16x8*)(P + (size_t)rr * DIN + C_LX + c0);
                    const f32x4 w0 = *(const f32x4*)(p.conv_w + (l * 4 + k) * 256 + c0), w1 = *(const f32x4*)(p.conv_w + (l * 4 + k) * 256 + c0 + 4);
                    acc[0] += w0[0] * bfs(xv[0]); acc[1] += w0[1] * bfs(xv[1]); acc[2] += w0[2] * bfs(xv[2]); acc[3] += w0[3] * bfs(xv[3]);
                    acc[4] += w1[0] * bfs(xv[4]); acc[5] += w1[1] * bfs(xv[5]); acc[6] += w1[2] * bfs(xv[6]); acc[7] += w1[3] * bfs(xv[7]); } }
            const u32x4 w = {cvtpk_s(acc[0], acc[1]), cvtpk_s(acc[2], acc[3]), cvtpk_s(acc[4], acc[5]), cvtpk_s(acc[6], acc[7])};
            *(LAS u32x4*)(sm + LR_UB + t * 144 + c8 * 2) = w; }
        __syncthreads();
        bf16x8 ua[4];
#pragma unroll
        for (int ks = 0; ks < 4; ++ks) ua[ks] = *(const LAS bf16x8*)(sm + LR_UB + (tt * 32 + r32) * 144 + (16 * ks + 8 * hi) * 2);
#pragma unroll
        for (int dir = 0; dir < 2; ++dir) {
            f32x16 ga, gx;
#pragma unroll
            for (int r = 0; r < 16; ++r) { ga[r] = bia[dir][0]; gx[r] = bia[dir][1]; }
#pragma unroll
            for (int ks = 0; ks < 4; ++ks) { ga = __builtin_amdgcn_mfma_f32_32x32x16_bf16(ua[ks], wfr[dir][0][ks], ga, 0, 0, 0); gx = __builtin_amdgcn_mfma_f32_32x32x16_bf16(ua[ks], wfr[dir][1][ks], gx, 0, 0, 0); }
#pragma unroll
            for (int r = 0; r < 16; ++r) { const int t = tt * 32 + crow(r, hi);
                const float rg = __builtin_amdgcn_rcpf(1.0f + __expf(-ga[r])), ig = __builtin_amdgcn_rcpf(1.0f + __expf(-gx[r]));
                const float a = __expf(spl[dir] * rg);
                const float uu = __uint_as_float(((unsigned)*(const LAS unsigned short*)(sm + LR_UB + t * 144 + jcol * 2)) << 16);
                *(LAS float*)(sm + LR_A + (t * 64 + jcol) * 4) = a;
                *(LAS float*)(sm + LR_B + (t * 64 + jcol) * 4) = sqrtf(fmaxf(1.0f - a * a, 0.f)) * (ig * uu); }
            __syncthreads();
            if (wid == 0) {
                const size_t cidx = (((size_t)dir * 2 + b) * NCI + ci) * 256 + hb * 64 + lane;
                float h = MODE == 3 ? LC[cidx] : 0.f, ap = 1.f;
                const LAS float* as_ = (const LAS float*)(sm + LR_A) + lane; const LAS float* bs_ = (const LAS float*)(sm + LR_B) + lane; LAS float* hs = (LAS float*)(sm + LR_H) + lane;
#pragma unroll 1
                for (int t0 = 0; t0 < 128; t0 += 16) {
                    float av[16], bv[16], hv[16];
#pragma unroll
                    for (int k = 0; k < 16; ++k) { const int t = dir == 0 ? t0 + k : 127 - t0 - k; av[k] = as_[t * 64]; bv[k] = bs_[t * 64]; if (MODE == 3 && dir == 1) hv[k] = hs[t * 64]; }
#pragma unroll
                    for (int k = 0; k < 16; ++k) { const int t = dir == 0 ? t0 + k : 127 - t0 - k; h = av[k] * h + bv[k]; ap *= av[k];
                        if (MODE == 3) hs[t * 64] = dir == 0 ? h : hv[k] + h; }
                }
                if (MODE == 1) { LA[cidx] = ap; LB[cidx] = h; }
            }
            __syncthreads();
        }
        if (MODE == 3) {
#pragma unroll
            for (int it = 0; it < 2; ++it) { const int item = it * 512 + tid, t = item >> 3, c8 = (item & 7) * 8, c0 = hb * 64 + c8;
                const f32x4 h0 = *(const LAS f32x4*)(sm + LR_H + (t * 64 + c8) * 4), h1 = *(const LAS f32x4*)(sm + LR_H + (t * 64 + c8 + 4) * 4);
                const bf16x8 yv = *(const bf16x8*)(P + (size_t)(rb + t) * DIN + C_LY + c0);
                const u32x4 w = {cvtpk_s(h0[0] * gelu_tanh(bfs(yv[0])), h0[1] * gelu_tanh(bfs(yv[1]))), cvtpk_s(h0[2] * gelu_tanh(bfs(yv[2])), h0[3] * gelu_tanh(bfs(yv[3]))),
                                 cvtpk_s(h1[0] * gelu_tanh(bfs(yv[4])), h1[1] * gelu_tanh(bfs(yv[5]))), cvtpk_s(h1[2] * gelu_tanh(bfs(yv[6])), h1[3] * gelu_tanh(bfs(yv[7])))};
                *(u32x4*)(O + (size_t)(rb + t) * DM + 768 + c0) = w; }
        }
    }
}

__device__ __forceinline__ int scan_ci(int dir, int s) { return dir == 0 ? s : (s == 0 ? 1 : (s == 1 ? 0 : NCI + 1 - s)); }
__device__ __forceinline__ void ph_scan2(const Params& p, int l, int bid, int nb) {
    char* ws = p.ws; const int gt = bid * 512 + TIDX, gs = nb * 512;
    float* RET = (float*)(ws + OFF_RET);
    for (int i = gt; i < 2 * 2 * 4 * 4096; i += gs) {
        const int de = i & 4095, h = (i >> 12) & 3, b = (i >> 14) & 1, dir = i >> 15;
        const float decay = expf(ret_lg(p, l, dir, h) * 128.0f); float S = 0.f;
        float* base = RET + (((size_t)dir * 2 + b) * NCI * 4 + h) * 4096 + de;
        for (int s0 = 0; s0 < NCI; s0 += 13) {
            float uu[13];
#pragma unroll
            for (int j = 0; j < 13; ++j) uu[j] = base[(size_t)scan_ci(dir, s0 + j) * 4 * 4096];
#pragma unroll
            for (int j = 0; j < 13; ++j) { base[(size_t)scan_ci(dir, s0 + j) * 4 * 4096] = S; S = decay * S + uu[j]; }
        }
    }
    float* LA = (float*)(ws + OFF_LRU); float* LB = LA + 2 * 2 * NCI * 256; float* LC = LB + 2 * 2 * NCI * 256;
    for (int i = gt; i < 2 * 2 * 256; i += gs) {
        const int ch = i & 255, b = (i >> 8) & 1, dir = i >> 9; float h = 0.f;
        const size_t base = ((size_t)dir * 2 + b) * NCI * 256 + ch;
        for (int s0 = 0; s0 < NCI; s0 += 13) {
            float aa[13], bb[13];
#pragma unroll
            for (int j = 0; j < 13; ++j) { const size_t idx = base + (size_t)scan_ci(dir, s0 + j) * 256; aa[j] = LA[idx]; bb[j] = LB[idx]; }
#pragma unroll
            for (int j = 0; j < 13; ++j) { LC[base + (size_t)scan_ci(dir, s0 + j) * 256] = h; h = aa[j] * h + bb[j]; }
        }
    }
}

__device__ __forceinline__ bf16x8 scale_frag(bf16x8 q, float s) {
    u32x4 w;
#pragma unroll
    for (int i = 0; i < 4; ++i) w[i] = cvtpk_s(bfs(q[2 * i]) * s, bfs(q[2 * i + 1]) * s);
    return __builtin_bit_cast(bf16x8, w);
}
__device__ __forceinline__ void ph_ret_out(const Params& p, int l, int bid, int nb, float* lds, int ci_lo) {
    char* ws = p.ws; const int tid = TIDX, lane = tid & 63, r32 = lane & 31, hi = lane >> 5, wid = __builtin_amdgcn_readfirstlane(tid >> 6);
    const bf16_t* P = (const bf16_t*)(ws + OFF_P); const float* RET = (const float*)(ws + OFF_RET); bf16_t* O = (bf16_t*)(ws + OFF_ACT);
    LAS char* sm = (LAS char*)lds;
    const int nci = NCI - ci_lo;
    for (int u = bid; u < 2 * nci * 2; u += nb) {
        const int hp = u & 1, ci = ci_lo + (u >> 1) % nci, b = (u >> 1) / nci, rb = row_base(b, ci);
        __syncthreads();
        ret_stage<false>(P, rb, hp, sm, tid, wid, lane);
        __syncthreads();
        const int hh = wid >> 2, qt = wid & 3, h = 2 * hp + hh; int n = qt * 32 + r32;
        asm volatile("" : "+v"(n));
        const float lg2f = ret_lg(p, l, 0, h) * 1.4426950408889634f, lg2b = ret_lg(p, l, 1, h) * 1.4426950408889634f;
        bf16x8 qr[4];
        { const bf16_t* qp = P + (size_t)(rb + n) * DIN + C_RQ + h * 64 + hi * 8;
#pragma unroll
          for (int ks = 0; ks < 4; ++ks) qr[ks] = *(const bf16x8*)(qp + ks * 16); }
        f32x16 o[2];
#pragma unroll
        for (int r = 0; r < 16; ++r) { o[0][r] = 0.f; o[1][r] = 0.f; }
#pragma unroll
        for (int dir = 0; dir < 2; ++dir) {
            const float xi = dir == 0 ? __builtin_amdgcn_exp2f(lg2f * (float)(n + 1)) : __builtin_amdgcn_exp2f(lg2b * (float)(128 - n));
            const float* Sb = RET + ((((size_t)dir * 2 + b) * NCI + ci) * 4 + h) * 4096 + hi * 8 * 64 + r32;
#pragma unroll
            for (int ks = 0; ks < 4; ++ks) { const bf16x8 qx = scale_frag(qr[ks], xi);
#pragma unroll
                for (int eh = 0; eh < 2; ++eh) { const float* sp = Sb + ks * 16 * 64 + eh * 32;
                    const u32x4 sw = {cvtpk_s(sp[0], sp[64]), cvtpk_s(sp[128], sp[192]), cvtpk_s(sp[256], sp[320]), cvtpk_s(sp[384], sp[448])};
                    o[eh] = __builtin_amdgcn_mfma_f32_32x32x16_bf16(qx, __builtin_bit_cast(bf16x8, sw), o[eh], 0, 0, 0); } }
        }
        const LAS char* Kb = sm + RT_K + hh * 16384 + hi * 1024 + r32 * 16;
        const LAS char* Vb = sm + RT_V + hh * 16384 + ((lane >> 4) & 1) * 32 + (lane & 3) * 8 + (4 * hi + ((lane & 15) >> 2)) * 64;
        u32x4 pw[8];
#pragma unroll
        for (int kb = 0; kb < 4; ++kb) { const int tt = kb >> 1, kbl = kb & 1;
            f32x16 c;
#pragma unroll
            for (int r = 0; r < 16; ++r) c[r] = 0.f;
#pragma unroll
            for (int ks = 0; ks < 4; ++ks) c = __builtin_amdgcn_mfma_f32_32x32x16_bf16(*(const LAS bf16x8*)(Kb + tt * 8192 + ks * 2048 + kbl * 512), qr[ks], c, 0, 0, 0);
#pragma unroll
            for (int r = 0; r < 16; ++r) { const int dlt = n - (kb * 32 + crow(r, hi)); const float fd = (float)dlt;
                const float w = __builtin_amdgcn_exp2f(fd * (dlt > 0 ? lg2f : -lg2b));
                c[r] *= dlt == 0 ? 2.0f : w; }
            pw[2 * kb] = (u32x4){cvtpk_s(c[0], c[1]), cvtpk_s(c[2], c[3]), cvtpk_s(c[4], c[5]), cvtpk_s(c[6], c[7])};
            pw[2 * kb + 1] = (u32x4){cvtpk_s(c[8], c[9]), cvtpk_s(c[10], c[11]), cvtpk_s(c[12], c[13]), cvtpk_s(c[14], c[15])}; }
#pragma unroll
        for (int k8 = 0; k8 < 8; ++k8) { const int tt = k8 >> 2, sl = k8 & 3;
#pragma unroll
            for (int eh = 0; eh < 2; ++eh) { const s16x4 vlo = vtr(Vb + tt * 8192 + eh * 4096 + sl * 1024), vhi = vtr(Vb + tt * 8192 + eh * 4096 + sl * 1024 + 512);
                o[eh] = __builtin_amdgcn_mfma_f32_32x32x16_bf16(__builtin_bit_cast(bf16x8, pw[k8]), (bf16x8){vlo[0], vlo[1], vlo[2], vlo[3], vhi[0], vhi[1], vhi[2], vhi[3]}, o[eh], 0, 0, 0); } }
        LAS float* stg = (LAS float*)(sm + RT_ST) + wid * 2048;
#pragma unroll
        for (int r = 0; r < 16; ++r) { const int q = crow(r, hi); stg[q * 64 + r32] = o[0][r]; stg[q * 64 + 32 + r32] = o[1][r]; }
        const float* gn = p.ret_gn + l * 256 + h * 64 + (lane & 7) * 8;
        const f32x4 g0 = *(const f32x4*)gn, g1 = *(const f32x4*)(gn + 4);
#pragma unroll
        for (int i = 0; i < 4; ++i) { const int row = i * 8 + (lane >> 3), ch = lane & 7;
            const f32x4 v0 = *(const LAS f32x4*)(stg + row * 64 + ch * 8), v1 = *(const LAS f32x4*)(stg + row * 64 + ch * 8 + 4);
            float ss = v0[0] * v0[0] + v0[1] * v0[1] + v0[2] * v0[2] + v0[3] * v0[3] + v1[0] * v1[0] + v1[1] * v1[1] + v1[2] * v1[2] + v1[3] * v1[3];
            ss += __shfl_xor(ss, 1); ss += __shfl_xor(ss, 2); ss += __shfl_xor(ss, 4);
            const float rn = rsqrtf(ss * (1.0f / 64.0f) + 1e-6f);
            const size_t grow = (size_t)(rb + qt * 32 + row);
            const bf16x8 gg = *(const bf16x8*)(P + grow * DIN + C_RG + h * 64 + ch * 8);
            u32x4 w; w.x = cvtpk_s(v0[0] * rn * g0[0] * fast_silu(bfs(gg[0])), v0[1] * rn * g0[1] * fast_silu(bfs(gg[1]))); w.y = cvtpk_s(v0[2] * rn * g0[2] * fast_silu(bfs(gg[2])), v0[3] * rn * g0[3] * fast_silu(bfs(gg[3])));
            w.z = cvtpk_s(v1[0] * rn * g1[0] * fast_silu(bfs(gg[4])), v1[1] * rn * g1[1] * fast_silu(bfs(gg[5]))); w.w = cvtpk_s(v1[2] * rn * g1[2] * fast_silu(bfs(gg[6])), v1[3] * rn * g1[3] * fast_silu(bfs(gg[7])));
            *(u32x4*)(O + grow * DM + 256 + h * 64 + ch * 8) = w; }
    }
}

__device__ __forceinline__ float diff_lambda_val(const Params& p, int l, float lam_init) {
    const float* lv = p.diff_lam + l * 128; float s1 = 0.f, s2 = 0.f;
    for (int i = 0; i < 32; ++i) { s1 += lv[i] * lv[32 + i]; s2 += lv[64 + i] * lv[96 + i]; }
    return expf(s1) - expf(s2) + lam_init;
}
__device__ __forceinline__ float xhalf_max(float m) { auto rr = __builtin_amdgcn_permlane32_swap(__float_as_uint(m), __float_as_uint(m), false, false); return fmaxf(__uint_as_float(rr[0]), __uint_as_float(rr[1])); }
__device__ __forceinline__ float xhalf_sum(float m) { auto rr = __builtin_amdgcn_permlane32_swap(__float_as_uint(m), __float_as_uint(m), false, false); return __uint_as_float(rr[0]) + __uint_as_float(rr[1]); }

constexpr int DF_K = 0, DF_V = 16384, DF_WS = 32768, DF_ST = 34816;
__device__ __forceinline__ void ph_diff(const Params& p, int l, bool need_ctx, float lam_init, int bid, int nb, float* lds) {
    char* ws = p.ws; const int tid = TIDX, lane = tid & 63, r32 = lane & 31, hi = lane >> 5, wid = __builtin_amdgcn_readfirstlane(tid >> 6);
    const bf16_t* P = (const bf16_t*)(ws + OFF_P); bf16_t* O = (bf16_t*)(ws + OFF_ACT);
    LAS char* sm = (LAS char*)lds;
    LAS float* wsf = (LAS float*)(sm + DF_WS) + wid * 64;
    const float lam = diff_lambda_val(p, l, lam_init);
    const int nun = 512 + (need_ctx ? 8 : 0);
    for (int u = bid; u < nun; u += nb) {
        int b, h, qrow0, t_lo;
        if (u < 512) { b = u >> 8; h = (u >> 6) & 3; qrow0 = b * NSEQ + (u & 63) * 256; t_lo = 0; }
        else { const int v = u - 512; b = v >> 2; h = v & 3; qrow0 = NLAT + b * NCTX; t_lo = 256; }
        const int t_hi = 260;
        const bf16_t* kcol = P + C_DK + h * 64 + wid * 8;
        const bf16_t* vcol = P + C_DV + h * 64 + (wid >> 2) * 32 + (lane & 3) * 8;
        const int krow_in = lane, vrow_in = 16 * (wid & 3) + (lane >> 2);
#define TILE_ROW0(t) ((t) < 256 ? b * NSEQ + (t) * 64 : NLAT + b * NCTX + ((t) - 256) * 64)
        bf16x8 qr[4];
        { const bf16_t* qp = P + (size_t)(qrow0 + wid * 32 + r32) * DIN + C_DQ + h * 64 + hi * 8;
#pragma unroll
          for (int d0 = 0; d0 < 4; ++d0) qr[d0] = *(const bf16x8*)(qp + d0 * 16); }
        f32x16 o[2][2]; float mhat[2], lsum[2];
#pragma unroll
        for (int m = 0; m < 2; ++m) { mhat[m] = 0.f; lsum[m] = 0.f;
#pragma unroll
            for (int r = 0; r < 16; ++r) { o[m][0][r] = 0.f; o[m][1][r] = 0.f; } }
        u32x4 kst, vst;
        { const int r0 = TILE_ROW0(t_lo); kst = *(const u32x4*)(kcol + (size_t)(r0 + krow_in) * DIN); vst = *(const u32x4*)(vcol + (size_t)(r0 + vrow_in) * DIN); }
        __syncthreads();
        *(LAS u32x4*)(sm + DF_K + tid * 16) = kst; *(LAS u32x4*)(sm + DF_V + tid * 16) = vst;
        __syncthreads();
        bool first = true;
        for (int t = t_lo; t < t_hi; ++t) {
            const int cur = (t - t_lo) & 1;
            if (t + 1 < t_hi) { const int r0 = TILE_ROW0(t + 1); kst = *(const u32x4*)(kcol + (size_t)(r0 + krow_in) * DIN); vst = *(const u32x4*)(vcol + (size_t)(r0 + vrow_in) * DIN); }
            const LAS char* kb = sm + DF_K + cur * 8192 + hi * 1024 + r32 * 16;
            const LAS char* vb = sm + DF_V + cur * 8192 + ((lane >> 4) & 1) * 32 + (lane & 3) * 8 + (4 * hi + ((lane & 15) >> 2)) * 64;
            bf16x8 kf[8];
#pragma unroll
            for (int j = 0; j < 4; ++j) { kf[2 * j] = *(const LAS bf16x8*)(kb + j * 2048); kf[2 * j + 1] = *(const LAS bf16x8*)(kb + j * 2048 + 512); }
            bf16x8 vf[8];
#pragma unroll
            for (int i = 0; i < 8; ++i) { const s16x4 lo = vtr(vb + (i >> 2) * 4096 + (i & 3) * 1024), hh = vtr(vb + (i >> 2) * 4096 + (i & 3) * 1024 + 512);
                vf[i] = (bf16x8){lo[0], lo[1], lo[2], lo[3], hh[0], hh[1], hh[2], hh[3]}; }
#pragma unroll
            for (int m = 0; m < 2; ++m) {
                float nm = -mhat[m]; asm volatile("" : "+v"(nm));
                f32x16 negm;
#pragma unroll
                for (int r = 0; r < 16; ++r) negm[r] = nm;
                f32x16 c0 = __builtin_amdgcn_mfma_f32_32x32x16_bf16(kf[4 * m + 0], qr[2 * m], negm, 0, 0, 0);
                f32x16 c1 = __builtin_amdgcn_mfma_f32_32x32x16_bf16(kf[4 * m + 1], qr[2 * m], negm, 0, 0, 0);
                c0 = __builtin_amdgcn_mfma_f32_32x32x16_bf16(kf[4 * m + 2], qr[2 * m + 1], c0, 0, 0, 0);
                c1 = __builtin_amdgcn_mfma_f32_32x32x16_bf16(kf[4 * m + 3], qr[2 * m + 1], c1, 0, 0, 0);
                float rm = fmaxf(c0[0], c1[0]);
#pragma unroll
                for (int r = 1; r < 16; ++r) rm = fmaxf(rm, fmaxf(c0[r], c1[r]));
                rm = xhalf_max(rm);
                if (first || __any(rm > 8.0f)) {
                    const float dl = first ? rm : fmaxf(rm, 0.f);
                    mhat[m] += dl;
#pragma unroll
                    for (int r = 0; r < 16; ++r) { c0[r] -= dl; c1[r] -= dl; }
                    if (!first) {
                        const float f = __builtin_amdgcn_exp2f(-dl); lsum[m] *= f;
                        if (hi == 0) wsf[r32] = f;
#pragma unroll
                        for (int r = 0; r < 16; ++r) { const float fr_ = wsf[crow(r, hi)]; o[m][0][r] *= fr_; o[m][1][r] *= fr_; }
                    }
                }
                float sacc = 0.f;
#pragma unroll
                for (int r = 0; r < 16; ++r) { c0[r] = __builtin_amdgcn_exp2f(c0[r]); c1[r] = __builtin_amdgcn_exp2f(c1[r]); sacc += c0[r] + c1[r]; }
                lsum[m] += sacc;
                u32x4 pw[4];
#pragma unroll
                for (int k = 0; k < 2; ++k) {
                    pw[k] = (u32x4){cvtpk_s(c0[8 * k + 0], c0[8 * k + 1]), cvtpk_s(c0[8 * k + 2], c0[8 * k + 3]), cvtpk_s(c0[8 * k + 4], c0[8 * k + 5]), cvtpk_s(c0[8 * k + 6], c0[8 * k + 7])};
                    pw[2 + k] = (u32x4){cvtpk_s(c1[8 * k + 0], c1[8 * k + 1]), cvtpk_s(c1[8 * k + 2], c1[8 * k + 3]), cvtpk_s(c1[8 * k + 4], c1[8 * k + 5]), cvtpk_s(c1[8 * k + 6], c1[8 * k + 7])}; }
#pragma unroll
                for (int k = 0; k < 4; ++k) {
                    o[m][0] = __builtin_amdgcn_mfma_f32_32x32x16_bf16(__builtin_bit_cast(bf16x8, pw[k]), vf[k], o[m][0], 0, 0, 0);
                    o[m][1] = __builtin_amdgcn_mfma_f32_32x32x16_bf16(__builtin_bit_cast(bf16x8, pw[k]), vf[4 + k], o[m][1], 0, 0, 0); }
            }
            first = false;
            if (t + 1 < t_hi) { *(LAS u32x4*)(sm + DF_K + (cur ^ 1) * 8192 + tid * 16) = kst; *(LAS u32x4*)(sm + DF_V + (cur ^ 1) * 8192 + tid * 16) = vst; }
            __syncthreads();
        }
#undef TILE_ROW0
        const float inv0 = 1.0f / xhalf_sum(lsum[0]), inv1 = lam / xhalf_sum(lsum[1]);
        int lane_e = TIDX & 63; asm volatile("" : "+v"(lane_e));
        { const int r32e = lane_e & 31, hie = lane_e >> 5;
        LAS float* wse = (LAS float*)(sm + DF_WS) + wid * 64; LAS float* stge = (LAS float*)(sm + DF_ST) + wid * 2048;
        if (hie == 0) { wse[r32e] = inv0; wse[32 + r32e] = inv1; }
#pragma unroll
        for (int r = 0; r < 16; ++r) { const int q = crow(r, hie); const float i0 = wse[q], i1 = wse[32 + q];
            stge[q * 64 + r32e] = o[0][0][r] * i0 - o[1][0][r] * i1; stge[q * 64 + 32 + r32e] = o[0][1][r] * i0 - o[1][1][r] * i1; } }
        const int lane = lane_e; LAS float* stg = (LAS float*)(sm + DF_ST) + wid * 2048;
        const float* gn = p.diff_gn + l * 256 + h * 64 + (lane & 7) * 8;
        const f32x4 g0 = *(const f32x4*)gn, g1 = *(const f32x4*)(gn + 4);
#pragma unroll
        for (int i = 0; i < 4; ++i) { const int row = i * 8 + (lane >> 3), ch = lane & 7;
            const f32x4 v0 = *(const LAS f32x4*)(stg + row * 64 + ch * 8), v1 = *(const LAS f32x4*)(stg + row * 64 + ch * 8 + 4);
            float ss = v0[0] * v0[0] + v0[1] * v0[1] + v0[2] * v0[2] + v0[3] * v0[3] + v1[0] * v1[0] + v1[1] * v1[1] + v1[2] * v1[2] + v1[3] * v1[3];
            ss += __shfl_xor(ss, 1); ss += __shfl_xor(ss, 2); ss += __shfl_xor(ss, 4);
            const float rn = rsqrtf(ss * (1.0f / 64.0f) + 1e-6f) * (1.0f - lam_init);
            u32x4 w; w.x = cvtpk_s(v0[0] * rn * g0[0], v0[1] * rn * g0[1]); w.y = cvtpk_s(v0[2] * rn * g0[2], v0[3] * rn * g0[3]);
            w.z = cvtpk_s(v1[0] * rn * g1[0], v1[1] * rn * g1[1]); w.w = cvtpk_s(v1[2] * rn * g1[2], v1[3] * rn * g1[3]);
            *(u32x4*)(O + (size_t)(qrow0 + wid * 32 + row) * DM + 512 + h * 64 + ch * 8) = w; }
    }
}

__device__ __forceinline__ void ph_swa(const Params& p, int l, bool need_ctx, int bid, int nb, float* lds) {
    char* ws = p.ws; const int tid = TIDX, lane = tid & 63, r32 = lane & 31, hi = lane >> 5, wid = __builtin_amdgcn_readfirstlane(tid >> 6);
    const bf16_t* P = (const bf16_t*)(ws + OFF_P); bf16_t* O = (bf16_t*)(ws + OFF_ACT);
    LAS char* sm = (LAS char*)lds;
    LAS float* wsf = (LAS float*)(sm + DF_WS) + wid * 64;
    const int nun = 512 + (need_ctx ? 8 : 0);
    for (int u = bid; u < nun; u += nb) {
        int b, h, qrow0, q0, tw_lo, nwin;
        if (u < 512) { b = u >> 8; h = (u >> 6) & 3; q0 = (u & 63) * 256; qrow0 = b * NSEQ + q0; const int lo = q0 - 128 < 0 ? 0 : q0 - 128, hi_ = q0 + 384 > NSEQ ? NSEQ : q0 + 384; tw_lo = lo >> 6; nwin = (hi_ - lo) >> 6; }
        else { const int v = u - 512; b = v >> 2; h = v & 3; q0 = 0; qrow0 = NLAT + b * NCTX; tw_lo = 0; nwin = 0; }
        const int g = h >> 1, nt = nwin + 4;
        const bf16_t* kcol = P + C_AK + g * 64 + wid * 8;
        const bf16_t* vcol = P + C_AV + g * 64 + (wid >> 2) * 32 + (lane & 3) * 8;
        const int krow_in = lane, vrow_in = 16 * (wid & 3) + (lane >> 2);
#define SWA_ROW0(i) ((i) < nwin ? b * NSEQ + (tw_lo + (i)) * 64 : NLAT + b * NCTX + ((i) - nwin) * 64)
        bf16x8 qr[4];
        { const bf16_t* qp = P + (size_t)(qrow0 + wid * 32 + r32) * DIN + C_AQ + h * 64 + hi * 8;
#pragma unroll
          for (int d0 = 0; d0 < 4; ++d0) qr[d0] = *(const bf16x8*)(qp + d0 * 16); }
        f32x16 o[2]; float mhat = p.sink[l * 4 + h] * 1.4426950408889634f, lsum = hi == 0 ? 1.0f : 0.0f;
#pragma unroll
        for (int r = 0; r < 16; ++r) { o[0][r] = 0.f; o[1][r] = 0.f; }
        const int qw = q0 + wid * 32, qpos = qw + r32;
        u32x4 kst, vst;
        { const int r0 = SWA_ROW0(0); kst = *(const u32x4*)(kcol + (size_t)(r0 + krow_in) * DIN); vst = *(const u32x4*)(vcol + (size_t)(r0 + vrow_in) * DIN); }
        __syncthreads();
        *(LAS u32x4*)(sm + DF_K + tid * 16) = kst; *(LAS u32x4*)(sm + DF_V + tid * 16) = vst;
        __syncthreads();
        for (int i = 0; i < nt; ++i) {
            const int cur = i & 1;
            if (i + 1 < nt) { const int r0 = SWA_ROW0(i + 1); kst = *(const u32x4*)(kcol + (size_t)(r0 + krow_in) * DIN); vst = *(const u32x4*)(vcol + (size_t)(r0 + vrow_in) * DIN); }
            const bool win = i < nwin; const int T = (tw_lo + i) * 64;
            const bool skip = win && (T > qw + 31 + 128 || T + 63 < qw - 128);
            if (!skip) {
                const LAS char* kb = sm + DF_K + cur * 8192 + hi * 1024 + r32 * 16;
                const LAS char* vb = sm + DF_V + cur * 8192 + ((lane >> 4) & 1) * 32 + (lane & 3) * 8 + (4 * hi + ((lane & 15) >> 2)) * 64;
                float nm = -mhat; asm volatile("" : "+v"(nm));
                f32x16 c0, c1;
#pragma unroll
                for (int r = 0; r < 16; ++r) { c0[r] = nm; c1[r] = nm; }
#pragma unroll
                for (int j = 0; j < 4; ++j) {
                    c0 = __builtin_amdgcn_mfma_f32_32x32x16_bf16(*(const LAS bf16x8*)(kb + j * 2048), qr[j], c0, 0, 0, 0);
                    c1 = __builtin_amdgcn_mfma_f32_32x32x16_bf16(*(const LAS bf16x8*)(kb + j * 2048 + 512), qr[j], c1, 0, 0, 0); }
                if (win && (T < qw + 31 - 128 || T + 63 > qw + 128)) {
#pragma unroll
                    for (int r = 0; r < 16; ++r) { const int kp = T + crow(r, hi); const int d0_ = qpos - kp, d1_ = d0_ - 32;
                        if (d0_ > 128 || d0_ < -128) c0[r] = -1.0e30f;
                        if (d1_ > 128 || d1_ < -128) c1[r] = -1.0e30f; }
                }
                float rm = fmaxf(c0[0], c1[0]);
#pragma unroll
                for (int r = 1; r < 16; ++r) rm = fmaxf(rm, fmaxf(c0[r], c1[r]));
                rm = xhalf_max(rm);
                if (__any(rm > 8.0f)) {
                    const float dl = fmaxf(rm, 0.f); mhat += dl;
#pragma unroll
                    for (int r = 0; r < 16; ++r) { c0[r] -= dl; c1[r] -= dl; }
                    const float f = __builtin_amdgcn_exp2f(-dl); lsum *= f;
                    if (hi == 0) wsf[r32] = f;
#pragma unroll
                    for (int r = 0; r < 16; ++r) { const float fr_ = wsf[crow(r, hi)]; o[0][r] *= fr_; o[1][r] *= fr_; }
                }
                float sacc = 0.f;
#pragma unroll
                for (int r = 0; r < 16; ++r) { c0[r] = __builtin_amdgcn_exp2f(c0[r]); c1[r] = __builtin_amdgcn_exp2f(c1[r]); sacc += c0[r] + c1[r]; }
                lsum += sacc;
                u32x4 pw[4];
#pragma unroll
                for (int k = 0; k < 2; ++k) {
                    pw[k] = (u32x4){cvtpk_s(c0[8 * k + 0], c0[8 * k + 1]), cvtpk_s(c0[8 * k + 2], c0[8 * k + 3]), cvtpk_s(c0[8 * k + 4], c0[8 * k + 5]), cvtpk_s(c0[8 * k + 6], c0[8 * k + 7])};
                    pw[2 + k] = (u32x4){cvtpk_s(c1[8 * k + 0], c1[8 * k + 1]), cvtpk_s(c1[8 * k + 2], c1[8 * k + 3]), cvtpk_s(c1[8 * k + 4], c1[8 * k + 5]), cvtpk_s(c1[8 * k + 6], c1[8 * k + 7])}; }
#pragma unroll
                for (int k = 0; k < 4; ++k) {
                    const s16x4 lo0 = vtr(vb + k * 1024), hi0 = vtr(vb + k * 1024 + 512), lo1 = vtr(vb + 4096 + k * 1024), hi1 = vtr(vb + 4096 + k * 1024 + 512);
                    o[0] = __builtin_amdgcn_mfma_f32_32x32x16_bf16(__builtin_bit_cast(bf16x8, pw[k]), (bf16x8){lo0[0], lo0[1], lo0[2], lo0[3], hi0[0], hi0[1], hi0[2], hi0[3]}, o[0], 0, 0, 0);
                    o[1] = __builtin_amdgcn_mfma_f32_32x32x16_bf16(__builtin_bit_cast(bf16x8, pw[k]), (bf16x8){lo1[0], lo1[1], lo1[2], lo1[3], hi1[0], hi1[1], hi1[2], hi1[3]}, o[1], 0, 0, 0); }
            }
            if (i + 1 < nt) { *(LAS u32x4*)(sm + DF_K + (cur ^ 1) * 8192 + tid * 16) = kst; *(LAS u32x4*)(sm + DF_V + (cur ^ 1) * 8192 + tid * 16) = vst; }
            __syncthreads();
        }
#undef SWA_ROW0
        const float inv = 1.0f / xhalf_sum(lsum);
        int lane_e = TIDX & 63;
        { const int r32e = lane_e & 31, hie = lane_e >> 5;
        LAS float* wse = (LAS float*)(sm + DF_WS) + wid * 64; LAS float* stge = (LAS float*)(sm + DF_ST) + wid * 2048;
        if (hie == 0) wse[r32e] = inv;
#pragma unroll
        for (int r = 0; r < 16; ++r) { const int q = crow(r, hie); const float i0 = wse[q]; stge[q * 64 + r32e] = o[0][r] * i0; stge[q * 64 + 32 + r32e] = o[1][r] * i0; } }
        LAS float* stg = (LAS float*)(sm + DF_ST) + wid * 2048;
#pragma unroll
        for (int i = 0; i < 4; ++i) { const int row = i * 8 + (lane_e >> 3), ch = lane_e & 7;
            const f32x4 v0 = *(const LAS f32x4*)(stg + row * 64 + ch * 8), v1 = *(const LAS f32x4*)(stg + row * 64 + ch * 8 + 4);
            u32x4 w; w.x = cvtpk_s(v0[0], v0[1]); w.y = cvtpk_s(v0[2], v0[3]); w.z = cvtpk_s(v1[0], v1[1]); w.w = cvtpk_s(v1[2], v1[3]);
            *(u32x4*)(O + (size_t)(qrow0 + wid * 32 + row) * DM + h * 64 + ch * 8) = w; }
    }
}

__device__ __forceinline__ void moe_offsets(const Params& p, int* offs  ) {
    if (TIDX < 2) { const unsigned* cw = (const unsigned*)p.ws + CW_CNT + TIDX * 8; int o = 0;
        for (int e = 0; e < 8; ++e) { offs[TIDX * 9 + e] = o; o += ((int)__hip_atomic_load(cw + e, __ATOMIC_RELAXED, __HIP_MEMORY_SCOPE_AGENT) + 255) & ~255; }
        offs[TIDX * 9 + 8] = o; }
    __syncthreads();
}
__device__ __forceinline__ void ph_moe_scatter(const Params& p, int bid, int nb, float* lds) {
    char* ws = p.ws; int* offs = (int*)lds; moe_offsets(p, offs);
    const int lane = TIDX & 63, wv = TIDX >> 6;
    const bf16_t* H = (const bf16_t*)(ws + OFF_ACT); bf16_t* AS = (bf16_t*)(ws + OFF_ASORT);
    int* tok = (int*)(ws + OFF_TOK); float* wgt = (float*)(ws + OFF_WGT); unsigned* cw = (unsigned*)ws;
    for (int r = bid * 8 + wv; r < NLAT; r += nb * 8) {
        const int4 rec = *(const int4*)(ws + OFF_ROUTE + (size_t)r * 16);
        for (int g = 0; g < 2; ++g) {
            const int e = g == 0 ? rec.x : rec.y; int pos = 0;
            if (lane == 0) { pos = offs[g * 9 + e] + (int)atomicAdd(cw + CW_CUR + g * 8 + e, 1u); tok[g * GRP_ROWS + pos] = r; wgt[g * GRP_ROWS + pos] = __int_as_float(g == 0 ? rec.z : rec.w); }
            pos = __shfl(pos, 0);
            const uint4* src = (const uint4*)(H + (size_t)r * DM); uint4* dst = (uint4*)(AS + ((size_t)g * GRP_ROWS + pos) * DM);
            dst[lane] = src[lane]; dst[64 + lane] = src[64 + lane];
        }
    }
}

__device__ __forceinline__ void ph_final(const Params& p, int bid, int nb) {
    const int lane = TIDX & 63, wv = TIDX >> 6;
    for (int r = bid * 8 + wv; r < NLAT; r += nb * 8) {
        float* xr = p.out + (size_t)r * DM; float4 v[4]; float ss = 0.f;
#pragma unroll
        for (int i = 0; i < 4; ++i) { v[i] = *(const float4*)(xr + i * 256 + lane * 4); ss += v[i].x * v[i].x + v[i].y * v[i].y + v[i].z * v[i].z + v[i].w * v[i].w; }
        ss = wave_sum(ss); const float rn = rsqrtf(ss * (1.0f / 1024.0f) + 1e-6f);
#pragma unroll
        for (int i = 0; i < 4; ++i) { const float4 g = *(const float4*)(p.final_norm + i * 256 + lane * 4);
            float4 o; o.x = v[i].x * rn * g.x; o.y = v[i].y * rn * g.y; o.z = v[i].z * rn * g.z; o.w = v[i].w * rn * g.w; *(float4*)(xr + i * 256 + lane * 4) = o; }
    }
}

struct EpiStoreBf16 {
    static constexpr bool PERM = true, AFTER_DRAIN = false; bf16_t* O; int ldc;
    __device__ __forceinline__ void operator()(const f32x4 (&acc)[2][2][4][2], const pg8::Unit& u, int wr, int wc, int fr, int fq) const {
        bf16_t* base = O + (size_t)(u.pm * 256 + wr * 64 + fr) * ldc + u.pn * 256 + wc * 32 + 8 * fq;
#pragma unroll
        for (int ai = 0; ai < 2; ++ai)
#pragma unroll
            for (int m = 0; m < 4; ++m) { bf16_t* rowp = base + (size_t)(ai * 128 + m * 16) * ldc;
#pragma unroll
                for (int bj = 0; bj < 2; ++bj) { const f32x4 v0 = acc[ai][bj][m][0], v1 = acc[ai][bj][m][1]; u32x4 w;
                    w.x = pg8::cvt_pk_bf16(v0[0], v0[1]); w.y = pg8::cvt_pk_bf16(v0[2], v0[3]); w.z = pg8::cvt_pk_bf16(v1[0], v1[1]); w.w = pg8::cvt_pk_bf16(v1[2], v1[3]);
                    *(u32x4*)(rowp + bj * 128) = w; } }
    }
};
struct EpiSwiglu {
    static constexpr bool PERM = true, AFTER_DRAIN = false; bf16_t* U; int ldu, npe;
    __device__ __forceinline__ void operator()(const f32x4 (&acc)[2][2][4][2], const pg8::Unit& u, int wr, int wc, int fr, int fq) const {
        bf16_t* base = U + (size_t)(u.pm * 256 + wr * 64 + fr) * ldu + (u.pn % npe) * 128 + wc * 32 + 8 * fq;
#pragma unroll
        for (int ai = 0; ai < 2; ++ai)
#pragma unroll
            for (int m = 0; m < 4; ++m) { float o[8];
#pragma unroll
                for (int n = 0; n < 2; ++n)
#pragma unroll
                    for (int i = 0; i < 4; ++i) o[n * 4 + i] = fast_silu(acc[ai][0][m][n][i]) * acc[ai][1][m][n][i];
                u32x4 w; w.x = pg8::cvt_pk_bf16(o[0], o[1]); w.y = pg8::cvt_pk_bf16(o[2], o[3]); w.z = pg8::cvt_pk_bf16(o[4], o[5]); w.w = pg8::cvt_pk_bf16(o[6], o[7]);
                *(u32x4*)(base + (size_t)(ai * 128 + m * 16) * ldu) = w; }
    }
};
struct EpiResidual {
    static constexpr bool PERM = false, AFTER_DRAIN = false; const float* xin; float* xout; float* xc; const float* gate;
    __device__ __forceinline__ void operator()(const f32x4 (&acc)[2][2][4][2], const pg8::Unit& u, int wr, int wc, int fr, int fq) const {
        const int cls = u.pm < 64 ? 0 : (u.pm < 128 ? 1 : 2), col0 = u.pn * 256 + wc * 32 + 4 * fq;
        const float* gv = gate + (size_t)cls * 6144 + col0;
        const float* bi = u.pm < 128 ? xin + (size_t)u.pm * 256 * DM : xc + (size_t)(u.pm - 128) * 256 * DM;
        float* bo = u.pm < 128 ? xout + (size_t)u.pm * 256 * DM : xc + (size_t)(u.pm - 128) * 256 * DM;
        f32x4 g4[2][2];
#pragma unroll
        for (int bj = 0; bj < 2; ++bj)
#pragma unroll
            for (int n = 0; n < 2; ++n) g4[bj][n] = *(const f32x4*)(gv + bj * 128 + n * 16);
#pragma unroll
        for (int ai = 0; ai < 2; ++ai)
#pragma unroll
            for (int m = 0; m < 4; ++m) { const size_t off = (size_t)(ai * 128 + wr * 64 + m * 16 + fr) * DM + col0;
#pragma unroll
                for (int bj = 0; bj < 2; ++bj)
#pragma unroll
                    for (int n = 0; n < 2; ++n) { const f32x4 xi = *(const f32x4*)(bi + off + bj * 128 + n * 16); *(f32x4*)(bo + off + bj * 128 + n * 16) = xi + g4[bj][n] * acc[ai][bj][m][n]; } }
    }
};
struct EpiMoeScatter {
    static constexpr bool PERM = false, AFTER_DRAIN = false; float* x; const float* gate; const int* tok; const float* wgt; int npe;
    __device__ __forceinline__ void operator()(const f32x4 (&acc)[2][2][4][2], const pg8::Unit& u, int wr, int wc, int fr, int fq) const {
        const int col0 = (u.pn % npe) * 256 + wc * 32 + 4 * fq;
#pragma unroll
        for (int ai = 0; ai < 2; ++ai)
#pragma unroll
            for (int m = 0; m < 4; ++m) { const int r = u.pm * 256 + ai * 128 + wr * 64 + m * 16 + fr; const int tk = tok[r];
                if (tk >= 0) { const float wv = wgt[r]; const float* gv = gate + (size_t)mod_class(tk) * 6144 + col0; float* xr = x + (size_t)tk * DM + col0;
#pragma unroll
                    for (int bj = 0; bj < 2; ++bj)
#pragma unroll
                        for (int n = 0; n < 2; ++n) { const f32x4 g4 = *(const f32x4*)(gv + bj * 128 + n * 16); f32x4* q = (f32x4*)(xr + bj * 128 + n * 16); *q = *q + g4 * wv * acc[ai][bj][m][n]; } } }
    }
};
struct MoeOrder : pg8::StaticOrder {
    int o1, o2, o3, o4, o5, o6, o7, npe;
    __device__ __forceinline__ bool next(int i, pg8::Unit& u) const {
        if (!pg8::StaticOrder::next(i, u)) return false;
        const int r = u.pm * 256; const int e = (r >= o1) + (r >= o2) + (r >= o3) + (r >= o4) + (r >= o5) + (r >= o6) + (r >= o7);
        u.pn += e * npe; return true;
    }
};
#define GEMM_LDS ((PG8_LAS unsigned char*)lds)
__device__ __forceinline__ void ph_gemm_in(const Params& p, int l, int bid, int nb, float* lds) {
    char* ws = p.ws; pg8::Gemm g{(const bf16_t*)(ws + OFF_ACT), (const bf16_t*)(ws + OFF_WIN) + (size_t)l * DIN * DM, NROW, DIN, DM};
    pg8::StaticOrder S; S.init(NROW, DIN, nb, bid);
    EpiStoreBf16 E{(bf16_t*)(ws + OFF_P), DIN};
    pg8::gemm_phase<EpiStoreBf16, pg8::StaticOrder, true, true>(GEMM_LDS, g, S, E);
}
__device__ __forceinline__ void ph_gemm_out(const Params& p, int l, bool need_ctx, int bid, int nb, float* lds) {
    char* ws = p.ws; const int M = need_ctx ? NROW : NLAT;
    pg8::Gemm g{(const bf16_t*)(ws + OFF_ACT), (const bf16_t*)(ws + OFF_WOUT) + (size_t)l * DM * DM, M, DM, DM};
    pg8::StaticOrder S; S.init(M, DM, nb, bid);
    EpiResidual E{l == 0 ? p.x : p.out, p.out, (float*)(ws + OFF_XC), (const float*)(ws + OFF_MOD) + (size_t)l * 3 * 6144 + 2048};
    pg8::gemm_phase<EpiResidual, pg8::StaticOrder, true, true>(GEMM_LDS, g, S, E);
}
__device__ __forceinline__ void ph_ffn1(const Params& p, bool need_ctx, int bid, int nb, float* lds) {
    char* ws = p.ws; const int M = need_ctx ? NROW : NLAT;
    pg8::Gemm g{(const bf16_t*)(ws + OFF_ACT), (const bf16_t*)(ws + OFF_WF13), M, 2 * DFF, DM};
    pg8::StaticOrder S; S.init(M, 2 * DFF, nb, bid);
    EpiSwiglu E{(bf16_t*)(ws + OFF_P), DFF, 2 * DFF / 256};
    pg8::gemm_phase<EpiSwiglu, pg8::StaticOrder, true, true>(GEMM_LDS, g, S, E);
}
__device__ __forceinline__ void ph_ffn2(const Params& p, int l, bool need_ctx, int bid, int nb, float* lds) {
    char* ws = p.ws; const int M = need_ctx ? NROW : NLAT;
    pg8::Gemm g{(const bf16_t*)(ws + OFF_P), (const bf16_t*)(ws + OFF_WF2), M, DM, DFF};
    pg8::StaticOrder S; S.init(M, DM, nb, bid);
    EpiResidual E{p.out, p.out, (float*)(ws + OFF_XC), (const float*)(ws + OFF_MOD) + (size_t)l * 3 * 6144 + 5120};
    pg8::gemm_phase<EpiResidual, pg8::StaticOrder, true, true>(GEMM_LDS, g, S, E);
}
__device__ __forceinline__ MoeOrder moe_order(const int* og, int npe, int nb, int bid) {
    MoeOrder S; S.init(og[8], npe * 256, nb, bid); S.o1 = og[1]; S.o2 = og[2]; S.o3 = og[3]; S.o4 = og[4]; S.o5 = og[5]; S.o6 = og[6]; S.o7 = og[7]; S.npe = npe; return S;
}
__device__ __forceinline__ void ph_moe1(const Params& p, int g, int bid, int nb, float* lds) {
    char* ws = p.ws; int* offs = (int*)(lds + 32768); __syncthreads(); moe_offsets(p, offs);
    const MoeOrder S = moe_order(offs + g * 9, 2 * DFE / 256, nb, bid);
    pg8::Gemm gm{(const bf16_t*)(ws + OFF_ASORT) + (size_t)g * GRP_ROWS * DM, (const bf16_t*)(ws + OFF_WM13), 0, 0, DM};
    EpiSwiglu E{(bf16_t*)(ws + OFF_UMOE), DFE, 2 * DFE / 256};
    pg8::gemm_phase<EpiSwiglu, MoeOrder, true, true>(GEMM_LDS, gm, S, E);
}
__device__ __forceinline__ void ph_moe2(const Params& p, int l, int g, int bid, int nb, float* lds) {
    char* ws = p.ws; int* offs = (int*)(lds + 32768); __syncthreads(); moe_offsets(p, offs);
    const MoeOrder S = moe_order(offs + g * 9, DM / 256, nb, bid);
    pg8::Gemm gm{(const bf16_t*)(ws + OFF_UMOE), (const bf16_t*)(ws + OFF_WM2), 0, 0, DFE};
    EpiMoeScatter E{p.out, (const float*)(ws + OFF_MOD) + (size_t)l * 3 * 6144 + 5120, (const int*)(ws + OFF_TOK) + g * GRP_ROWS, (const float*)(ws + OFF_WGT) + g * GRP_ROWS, DM / 256};
    pg8::gemm_phase<EpiMoeScatter, MoeOrder, true, true>(GEMM_LDS, gm, S, E);
}

#define XB_TMO      128
#define XB_XCNT(j)  (256  + 64 * (j))
#define XB_XSUB(j)  (1280 + 64 * (j))
#define XB_XGEN(j)  (2304 + 64 * (j))
#define XB_TOP      3328
#define XB_TOPGEN   3392
#define XCD_BAR_WORDS 3456
#define XB_SPIN_CAP (1u << 22)

__device__ __forceinline__ unsigned xb_ld(unsigned* p)              { return __hip_atomic_load(p, __ATOMIC_RELAXED, __HIP_MEMORY_SCOPE_AGENT); }
__device__ __forceinline__ unsigned xb_add(unsigned* p, unsigned v) { return __hip_atomic_fetch_add(p, v, __ATOMIC_RELAXED, __HIP_MEMORY_SCOPE_AGENT); }
__device__ __forceinline__ unsigned xb_xcc_id() { return (unsigned)__builtin_amdgcn_s_getreg((3 << 11) | 20) & 0xFu; }
#define XB_SPIN(cond, bar) do { unsigned _sp = 0; while (cond) { __builtin_amdgcn_s_sleep(1); \
    if ((++_sp & 255u) == 0u) { if (xb_ld(&(bar)[XB_TMO])) break; if (_sp > XB_SPIN_CAP) { atomicAdd(&(bar)[XB_TMO], 1u); break; } } } } while (0)

struct XcdBarrier {
    unsigned* bar; unsigned x;
    volatile LAS unsigned* st;
};

__device__ __forceinline__ XcdBarrier xcd_barrier_post(unsigned* bar, volatile LAS unsigned* st) {
    XcdBarrier b; b.bar = bar; b.x = xb_xcc_id(); b.st = st;
    if (threadIdx.x == 0) (void)xb_add(&bar[XB_XCNT(b.x)], 1u);
    return b;
}
__device__ __forceinline__ void xcd_barrier_complete(unsigned* bar, unsigned x, unsigned& nloc, unsigned& nx) {
    const unsigned G = gridDim.x * gridDim.y * gridDim.z;
    unsigned sum, cnt, mine, sp = 0u;
    for (;;) {
        sum = 0u; cnt = 0u; mine = 0u;
#pragma unroll
        for (unsigned j = 0; j < 16; ++j) { const unsigned c = xb_ld(&bar[XB_XCNT(j)]); sum += c; cnt += (c > 0u) ? 1u : 0u; mine = (j == x) ? c : mine; }
        if (sum == G) break;
        __builtin_amdgcn_s_sleep(1);
        if ((++sp & 255u) == 0u) { if (xb_ld(&bar[XB_TMO])) break; if (sp > XB_SPIN_CAP) { atomicAdd(&bar[XB_TMO], 1u); break; } }
    }
    nloc = mine > 0u ? mine : 1u; nx = cnt > 0u ? cnt : 1u;
}

__device__ __forceinline__ void xcd_barrier(const XcdBarrier& b) {
    asm volatile("s_waitcnt vmcnt(0)" ::: "memory");
    __syncthreads();
    if (threadIdx.x == 0) {
        unsigned* bar = b.bar;
        __builtin_amdgcn_s_waitcnt(0);
        unsigned nloc = b.st[0], nx = b.st[1];
        if (nloc == 0u) { xcd_barrier_complete(bar, b.x, nloc, nx); b.st[0] = nloc; b.st[1] = nx; }
        const unsigned old = xb_add(&bar[XB_XSUB(b.x)], 1u);
        const unsigned gen = old / nloc;
        if (old + 1u == (gen + 1u) * nloc) {
            __builtin_amdgcn_fence(__ATOMIC_RELEASE, "agent");
            asm volatile("s_waitcnt vmcnt(0)" ::: "memory");
            const unsigned og = xb_add(&bar[XB_TOP], 1u);
            const unsigned tg = og / nx;
            if (og + 1u == (tg + 1u) * nx) xb_add(&bar[XB_TOPGEN], 1u);
            else XB_SPIN(xb_ld(&bar[XB_TOPGEN]) == tg, bar);
            __builtin_amdgcn_fence(__ATOMIC_ACQUIRE, "agent");
            xb_add(&bar[XB_XGEN(b.x)], 1u);
            asm volatile("s_waitcnt vmcnt(0)" ::: "memory");
        } else {
            XB_SPIN(xb_ld(&bar[XB_XGEN(b.x)]) == gen, bar);
            __builtin_amdgcn_fence(__ATOMIC_ACQUIRE, "agent");
            asm volatile("s_waitcnt vmcnt(0)" ::: "memory");
        }
    }
    __syncthreads();
}


constexpr int LDS_FLOATS = 33792;
constexpr int LDS_BYTES = LDS_FLOATS * 4 + 16 + 256;

typedef const __attribute__((address_space(4))) unsigned long long* kargp_t;
typedef __attribute__((address_space(1))) const float* gcf_t;
__device__ __forceinline__ Params load_params(const float* lds) {
    const LAS unsigned* tbl = (const LAS unsigned*)(lds + LDS_FLOATS + 4);
    Params p; const float** f = (const float**)&p;
#pragma unroll
    for (int i = 0; i < (int)(sizeof(Params) / 8); ++i) {
        const unsigned lo = __builtin_amdgcn_readfirstlane(tbl[2 * i]), hi = __builtin_amdgcn_readfirstlane(tbl[2 * i + 1]);
        f[i] = (const float*)(gcf_t)(((unsigned long long)hi << 32) | lo); }
    return p;
}
#define LOADP(name) const Params name = load_params(lds)

template <int l>
__device__ __forceinline__ void run_layer(const XcdBarrier& bar, int bid, int nb, float* lds) {
    constexpr bool need_ctx = l == 0;
    constexpr float lam_init = l == 0 ? 0.2f : 0.35550906759509393f;
    { LOADP(p); ph_norm<false>(p, l, 0, NROW, bid, nb); } xcd_barrier(bar);
    { LOADP(p); ph_gemm_in(p, l, bid, nb, lds); } xcd_barrier(bar);
    { LOADP(p); ph_rope(p, bid, nb); } xcd_barrier(bar);
    { LOADP(p); ph_ret_summ(p, l, bid, nb, lds); } { LOADP(p); ph_lru_chunk<1>(p, l, bid, nb, lds, 0); } xcd_barrier(bar);
    { LOADP(p); ph_scan2(p, l, bid, nb); } xcd_barrier(bar);
    { LOADP(p); ph_diff(p, l, need_ctx, lam_init, bid, nb, lds); }
    { LOADP(p); ph_swa(p, l, need_ctx, bid, nb, lds); }
    { LOADP(p); ph_ret_out(p, l, bid, nb, lds, need_ctx ? 0 : 2); }
    { LOADP(p); ph_lru_chunk<3>(p, l, bid, nb, lds, need_ctx ? 0 : 2); } xcd_barrier(bar);
    { LOADP(p); ph_gemm_out(p, l, need_ctx, bid, nb, lds); } xcd_barrier(bar);
    if (l == 0) {
        { LOADP(p); ph_norm<false>(p, l, 1, NROW, bid, nb); } xcd_barrier(bar);
        { LOADP(p); ph_ffn1(p, need_ctx, bid, nb, lds); } xcd_barrier(bar);
        { LOADP(p); ph_ffn2(p, l, need_ctx, bid, nb, lds); } xcd_barrier(bar);
    } else {
        { LOADP(p); ph_norm<true>(p, l, 1, NLAT, bid, nb); } xcd_barrier(bar);
        { LOADP(p); ph_moe_scatter(p, bid, nb, lds); } xcd_barrier(bar);
        { LOADP(p); ph_moe1(p, 0, bid, nb, lds); } xcd_barrier(bar);
        { LOADP(p); ph_moe2(p, l, 0, bid, nb, lds); } xcd_barrier(bar);
        { LOADP(p); ph_moe1(p, 1, bid, nb, lds); } xcd_barrier(bar);
        { LOADP(p); ph_moe2(p, l, 1, bid, nb, lds); } xcd_barrier(bar);
    }
}

__global__ void __launch_bounds__(512, 2) fwd(Params p_in) {
    extern __shared__ __attribute__((aligned(16))) float lds[];
    volatile LAS unsigned* st = (volatile LAS unsigned*)(lds + LDS_FLOATS);
    if (threadIdx.x == 0) { st[0] = 0u; st[1] = 0u; st[2] = 0u; st[3] = 0u; }
    if (threadIdx.x < (int)(sizeof(Params) / 8)) { const kargp_t q = (kargp_t)__builtin_amdgcn_kernarg_segment_ptr(); ((LAS unsigned long long*)(lds + LDS_FLOATS + 4))[threadIdx.x] = q[threadIdx.x]; }
    __syncthreads();
    XcdBarrier bar;
    { LOADP(p); bar = xcd_barrier_post((unsigned*)p.ws, st); }
    const int bid = blockIdx.x, nb = gridDim.x;
    { LOADP(p); ph_prologue(p, bid, nb, lds); } xcd_barrier(bar);
    run_layer<0>(bar, bid, nb, lds);
    run_layer<1>(bar, bid, nb, lds);
    { LOADP(p); ph_final(p, bid, nb); }
}

extern "C" void kernel_launch(void* const* d_in, const int* in_sizes, int n_in, void* d_out, int out_size, void* d_ws, size_t ws_size, hipStream_t stream) {
    static int grid = 0;
    if (grid == 0) {
        if (n_in < 30 || ws_size < WS_NEED) { fprintf(stderr, "kernel_launch: bad args n_in=%d ws=%zu need=%zu\n", n_in, ws_size, (size_t)WS_NEED); grid = -1; return; }
        int dev = 0, cus = 0, per_cu = 0;
        if (hipGetDevice(&dev) != hipSuccess || hipDeviceGetAttribute(&cus, hipDeviceAttributeMultiprocessorCount, dev) != hipSuccess) { grid = -1; return; }
        if (hipFuncSetAttribute((const void*)fwd, hipFuncAttributeMaxDynamicSharedMemorySize, LDS_BYTES) != hipSuccess) { fprintf(stderr, "kernel_launch: hipFuncSetAttribute failed\n"); grid = -1; return; }
        if (hipOccupancyMaxActiveBlocksPerMultiprocessor(&per_cu, (const void*)fwd, 512, LDS_BYTES) != hipSuccess || per_cu < 1) { fprintf(stderr, "kernel_launch: occupancy query says %d\n", per_cu); per_cu = 1; }
        (void)hipGetLastError();
        grid = cus;
    }
    if (grid < 0) return;
    Params p{};
    const float** f = (const float**)&p;
    for (int i = 0; i < 30; ++i) f[i] = (const float*)d_in[i];
    p.out = (float*)d_out; p.ws = (char*)d_ws;
    (void)hipMemsetAsync(d_ws, 0, 65536, stream);
    hipLaunchKernelGGL(fwd, dim3(grid), dim3(512), LDS_BYTES, stream, p);
}
```

```cpp
#include <hip/hip_runtime.h>
#include <cstdio>
#include <cstdint>

typedef unsigned short bf16_t;
typedef short bf16x8 __attribute__((ext_vector_type(8)));
typedef float f32x4 __attribute__((ext_vector_type(4)));
typedef unsigned u32x4 __attribute__((ext_vector_type(4)));
#define LAS __attribute__((address_space(3)))

constexpr int NB = 2, NSEQ = 16384, NCTX = 256, DM = 1024;
constexpr int NLAT = NB * NSEQ;
constexpr int NCR = NB * NCTX;
constexpr int NROW = NLAT + NCR;
constexpr int DIN = 2816, DFF = 2816, DFE = 3584, NE = 8;
constexpr int NCI = 130;
constexpr int C_AQ = 0, C_AK = 256, C_AV = 384, C_RQ = 512, C_RK = 768, C_RV = 1024, C_RG = 1280, C_DQ = 1536, C_DK = 1792, C_DV = 2048, C_LX = 2304, C_LY = 2560;
constexpr int GRP_ROWS = 34816;

constexpr size_t al256(size_t x) { return (x + 255) & ~(size_t)255; }
constexpr size_t OFF_CTRL = 0;
constexpr size_t OFF_MOD = 65536;
constexpr size_t OFF_TAB = al256(OFF_MOD + 2 * 3 * 6144 * 4);
constexpr size_t TAB_ATTN = 0, TAB_RET = 4u << 20, TAB_DIFF = 8u << 20;
constexpr size_t OFF_XC = al256(OFF_TAB + (10u << 20));
constexpr size_t OFF_ROUTE = al256(OFF_XC + (size_t)NCR * DM * 4);
constexpr size_t OFF_TOK = al256(OFF_ROUTE + (size_t)NLAT * 16);
constexpr size_t OFF_WGT = al256(OFF_TOK + (size_t)2 * GRP_ROWS * 4);
constexpr size_t OFF_LRU = al256(OFF_WGT + (size_t)2 * GRP_ROWS * 4);
constexpr size_t OFF_WM13 = al256(OFF_LRU + (size_t)3 * 2 * 2 * NCI * 256 * 4);
constexpr size_t OFF_WM2 = al256(OFF_WM13 + (size_t)NE * 2 * DFE * DM * 2);
constexpr size_t OFF_R = al256(OFF_WM2 + (size_t)NE * DM * DFE * 2);
constexpr size_t OFF_P = OFF_R;
constexpr size_t OFF_ACT = al256(OFF_P + (size_t)NROW * DIN * 2);
constexpr size_t OFF_RET = al256(OFF_ACT + (size_t)NROW * DM * 2);
constexpr size_t OFF_WIN = al256(OFF_RET + (size_t)2 * 2 * NCI * 4 * 4096 * 4);
constexpr size_t OFF_WOUT = al256(OFF_WIN + (size_t)2 * DIN * DM * 2);
constexpr size_t OFF_WF13 = al256(OFF_WOUT + (size_t)2 * DM * DM * 2);
constexpr size_t OFF_WF2 = al256(OFF_WF13 + (size_t)2 * DFF * DM * 2);
constexpr size_t OFF_R_END1 = al256(OFF_WF2 + (size_t)DM * DFF * 2);
constexpr size_t OFF_ASORT = OFF_R;
constexpr size_t OFF_UMOE = al256(OFF_ASORT + (size_t)2 * GRP_ROWS * DM * 2);
constexpr size_t OFF_R_END2 = al256(OFF_UMOE + (size_t)GRP_ROWS * DFE * 2);
constexpr size_t WS_NEED = OFF_R_END1 > OFF_R_END2 ? OFF_R_END1 : OFF_R_END2;
static_assert(OFF_ACT >= OFF_UMOE, "H2 must not overlap A_sorted");
constexpr int CW_CNT = 4096;
constexpr int CW_CUR = 4160;

struct Params {
    const float *x, *c, *ctx, *c_ctx, *w_ada, *b_ada, *g1, *g2, *w_in, *w_out, *sink, *ret_logit, *ret_gn, *diff_lam, *diff_gn,
        *conv_w, *conv_b, *lru_wa, *lru_ba, *lru_wx, *lru_bx, *lru_lam, *ffn_w1, *ffn_w3, *ffn_w2, *moe_router, *moe_w1, *moe_w3, *moe_w2, *final_norm;
    float* out; char* ws;
};

__device__ __forceinline__ int ltid_() { int t = threadIdx.x; asm volatile("" : "+v"(t)); return t; }
#define TIDX ltid_()
__device__ __forceinline__ float bf2f(bf16_t h) { return __uint_as_float(((unsigned)h) << 16); }
__device__ __forceinline__ bf16_t f2bf(float f) { unsigned u = __float_as_uint(f); u += 0x7fffu + ((u >> 16) & 1u); return (bf16_t)(u >> 16); }
__device__ __forceinline__ unsigned pack2(float lo, float hi) { return (unsigned)f2bf(lo) | ((unsigned)f2bf(hi) << 16); }
__device__ __forceinline__ float wave_sum(float v) {
#pragma unroll
    for (int o = 32; o >= 1; o >>= 1) v += __shfl_xor(v, o);
    return v;
}
__device__ __forceinline__ float sigmoidf_(float x) { return 1.0f / (1.0f + __expf(-x)); }
__device__ __forceinline__ float siluf_(float x) { return x / (1.0f + __expf(-x)); }
__device__ __forceinline__ float fast_silu(float v) { return v * __builtin_amdgcn_rcpf(1.0f + __expf(-v)); }
__device__ __forceinline__ float softplusf_(float x) { return x > 20.f ? x : log1pf(expf(x)); }
__device__ __forceinline__ float gelu_tanh(float x) { const float u = 0.7978845608028654f * (x + 0.044715f * x * x * x); return x * __builtin_amdgcn_rcpf(1.0f + __expf(-2.0f * u)); }
__device__ __forceinline__ int row_base(int b, int ci) { return ci < 2 ? NLAT + b * NCTX + ci * 128 : b * NSEQ + (ci - 2) * 128; }
__device__ __forceinline__ int mod_class(int row) { return row < NSEQ ? 0 : (row < NLAT ? 1 : 2); }

typedef float f32x16 __attribute__((ext_vector_type(16)));
typedef short s16x4 __attribute__((ext_vector_type(4)));
typedef short v4i16_t __attribute__((ext_vector_type(4)));
typedef float f32x2_t __attribute__((ext_vector_type(2)));
typedef __bf16 bf16x2_t __attribute__((ext_vector_type(2)));
__device__ __forceinline__ unsigned cvtpk_s(float lo, float hi) { f32x2_t v = {lo, hi}; bf16x2_t bb = __builtin_convertvector(v, bf16x2_t); return __builtin_bit_cast(unsigned, bb); }
__device__ __forceinline__ int crow(int r, int hi) { return (r & 3) + 8 * (r >> 2) + 4 * hi; }
__device__ __forceinline__ s16x4 vtr(const LAS char* p) { return __builtin_bit_cast(s16x4, __builtin_amdgcn_ds_read_tr16_b64_v4i16((LAS v4i16_t*)p)); }
__device__ __forceinline__ float bfs(short s) { return __uint_as_float(((unsigned)(unsigned short)s) << 16); }

__device__ __forceinline__ void convert_tile(const float* src, int K, int N, bf16_t* dst, int tile, int mode, float* lds) {
    const int tpn = N / 64, tk = tile / tpn, tn = tile % tpn, t = TIDX;
    {   const int kk = t >> 3, nc = (t & 7) * 8;
        const float4 a = *(const float4*)(src + (size_t)(tk * 64 + kk) * N + tn * 64 + nc);
        const float4 b = *(const float4*)(src + (size_t)(tk * 64 + kk) * N + tn * 64 + nc + 4);
        float* d = lds + kk * 65 + nc; d[0] = a.x; d[1] = a.y; d[2] = a.z; d[3] = a.w; d[4] = b.x; d[5] = b.y; d[6] = b.z; d[7] = b.w; }
    __syncthreads();
    {   const int n = t >> 3, kc = (t & 7) * 8, ng = tn * 64 + n;
        int nrow;
        if (mode == 3) {
            const int s = ng >> 7; const bool r64 = s <= 2 || (s >= 4 && s <= 7), r32 = s >= 12 && s <= 15;
            if (r64) { const int d = ng & 63; nrow = (ng & ~63) + 8 * ((d & 31) >> 2) + 4 * (d >> 5) + (d & 3); }
            else if (r32) { const int d = ng & 31; nrow = (ng & ~31) + 8 * ((d & 15) >> 2) + 4 * (d >> 4) + (d & 3); }
            else nrow = ng;
        } else nrow = mode == 0 ? ng : ((ng >> 7) * 256 + (mode == 2 ? 128 : 0) + (ng & 127));
        uint4 w; w.x = pack2(lds[(kc + 0) * 65 + n], lds[(kc + 1) * 65 + n]); w.y = pack2(lds[(kc + 2) * 65 + n], lds[(kc + 3) * 65 + n]);
        w.z = pack2(lds[(kc + 4) * 65 + n], lds[(kc + 5) * 65 + n]); w.w = pack2(lds[(kc + 6) * 65 + n], lds[(kc + 7) * 65 + n]);
        *(uint4*)(dst + (size_t)nrow * K + tk * 64 + kc) = w; }
    __syncthreads();
}

__device__ __forceinline__ void ph_prologue(const Params& p, int bid, int nb, float* lds) {
    char* ws = p.ws; const int t = TIDX;
    {
        struct Job { const float* src; bf16_t* dst; int K, N, mode, base; };
        Job* jobs = (Job*)(lds + 64 * 65 + 3);
        const int T_IN = 16 * 44, T_OUT = 16 * 16, T_F13 = 16 * 44, T_F2 = 44 * 16, T_M13 = 16 * 56, T_M2 = 56 * 16;
        const int total = 2 * T_IN + 2 * T_OUT + 2 * T_F13 + T_F2 + 16 * T_M13 + 8 * T_M2;
        if (t < 32) {
            Job jb; jb.src = nullptr; jb.dst = nullptr; jb.K = DM; jb.N = DM; jb.mode = 0; jb.base = total;
            if (t < 2) { jb.src = p.w_in + (size_t)t * DM * DIN; jb.dst = (bf16_t*)(ws + OFF_WIN) + (size_t)t * DIN * DM; jb.N = DIN; jb.mode = 3; jb.base = t * T_IN; }
            else if (t < 4) { jb.src = p.w_out + (size_t)(t - 2) * DM * DM; jb.dst = (bf16_t*)(ws + OFF_WOUT) + (size_t)(t - 2) * DM * DM; jb.base = 2 * T_IN + (t - 2) * T_OUT; }
            else if (t < 6) { jb.src = t == 4 ? p.ffn_w1 : p.ffn_w3; jb.dst = (bf16_t*)(ws + OFF_WF13); jb.N = DFF; jb.mode = t - 3; jb.base = 2 * T_IN + 2 * T_OUT + (t - 4) * T_F13; }
            else if (t == 6) { jb.src = p.ffn_w2; jb.dst = (bf16_t*)(ws + OFF_WF2); jb.K = DFF; jb.base = 2 * T_IN + 2 * T_OUT + 2 * T_F13; }
            else if (t < 23) { const int q = t - 7, e = q & 7, w3 = q >> 3; jb.src = (w3 ? p.moe_w3 : p.moe_w1) + (size_t)e * DM * DFE; jb.dst = (bf16_t*)(ws + OFF_WM13) + (size_t)e * 2 * DFE * DM; jb.N = DFE; jb.mode = 1 + w3;
                jb.base = 2 * T_IN + 2 * T_OUT + 2 * T_F13 + T_F2 + q * T_M13; }
            else if (t < 31) { const int e = t - 23; jb.src = p.moe_w2 + (size_t)e * DFE * DM; jb.dst = (bf16_t*)(ws + OFF_WM2) + (size_t)e * DM * DFE; jb.K = DFE;
                jb.base = 2 * T_IN + 2 * T_OUT + 2 * T_F13 + T_F2 + 16 * T_M13 + e * T_M2; }
            jobs[t] = jb;
        }
        __syncthreads();
        int j = 0;
        for (int u = bid; u < total; u += nb) {
            while (u >= jobs[j + 1].base) ++j;
            const Job jb = jobs[j];
            convert_tile(jb.src, jb.K, jb.N, jb.dst, u - jb.base, jb.mode, lds);
        }
        __syncthreads();
    }
    {
        float* sv = lds;
        float* red = lds + 3072;
        for (int i = t; i < 3072; i += 512) { const int v = i >> 10, k = i & 1023; const float cv = v < 2 ? p.c[v * DM + k] : p.c_ctx[k]; sv[i] = siluf_(cv); }
        __syncthreads();
        float* mod = (float*)(ws + OFF_MOD);
        for (int u = bid; u < 2 * 96; u += nb) {
            const int l = u / 96, j0 = (u % 96) * 64, j = t & 63, kg = t >> 6;
            float a0 = 0.f, a1 = 0.f, a2 = 0.f;
            const float* w = p.w_ada + (size_t)l * DM * 6144 + j0 + j;
            for (int k = kg * 128; k < kg * 128 + 128; ++k) { const float wv = w[(size_t)k * 6144]; a0 += sv[k] * wv; a1 += sv[1024 + k] * wv; a2 += sv[2048 + k] * wv; }
            red[(kg * 3 + 0) * 64 + j] = a0; red[(kg * 3 + 1) * 64 + j] = a1; red[(kg * 3 + 2) * 64 + j] = a2;
            __syncthreads();
            if (t < 192) { const int v = t >> 6; float s = 0.f;
                for (int g = 0; g < 8; ++g) s += red[(g * 3 + v) * 64 + j];
                mod[((size_t)l * 3 + v) * 6144 + j0 + j] = s + p.b_ada[l * 6144 + j0 + j]; }
            __syncthreads();
        }
    }
    {
        const int gt = bid * 512 + t, gs = nb * 512;
        float* ta = (float*)(ws + OFF_TAB + TAB_ATTN); float* tr = (float*)(ws + OFF_TAB + TAB_RET); float* td = (float*)(ws + OFF_TAB + TAB_DIFF);
        for (int i = gt; i < 16384 * 32; i += gs) { const int n = i >> 5, j = i & 31;
            { const float inv = (float)pow(10000.0, -(double)j / 32.0); const float ang = (float)n * inv; tr[i] = (float)cos((double)ang); tr[16384 * 32 + i] = (float)sin((double)ang); }
            { const float inv = (float)pow(10000.0, -(double)(j & 15) / 16.0); const float ang = (float)(j < 16 ? (n >> 6) : (n & 63)) * inv; ta[i] = (float)cos((double)ang); ta[16384 * 32 + i] = (float)sin((double)ang); }
            if (j < 16) { const float inv = (float)pow(10000.0, -(double)(j & 7) / 8.0); const float ang = (float)(j < 8 ? (n >> 6) : (n & 63)) * inv; td[n * 16 + j] = (float)cos((double)ang); td[16384 * 16 + n * 16 + j] = (float)sin((double)ang); } }
        float* xc = (float*)(ws + OFF_XC);
        for (int i = gt; i < NCR * DM / 4; i += gs) ((float4*)xc)[i] = ((const float4*)p.ctx)[i];
        int* tok = (int*)(ws + OFF_TOK);
        for (int i = gt; i < 2 * GRP_ROWS; i += gs) tok[i] = -1;
    }
}

template <bool ROUTE>
__device__ __forceinline__ void ph_norm(const Params& p, int l, int which  , int nrows, int bid, int nb) {
    char* ws = p.ws; const int lane = TIDX & 63, wv = TIDX >> 6;
    const float* mod = (const float*)(ws + OFF_MOD) + (size_t)l * 3 * 6144;
    const float* g = (which == 0 ? p.g1 : p.g2) + l * DM;
    bf16_t* H = (bf16_t*)(ws + OFF_ACT);
    const float* xl = (which == 0 && l == 0) ? p.x : p.out;
    const float* xc = (const float*)(ws + OFF_XC);
    for (int r = bid * 8 + wv; r < nrows; r += nb * 8) {
        const float* xr = r < NLAT ? xl + (size_t)r * DM : xc + (size_t)(r - NLAT) * DM;
        const float* mv = mod + (size_t)mod_class(r) * 6144 + (which == 0 ? 0 : 3072);
        float4 v[4]; float ss = 0.f;
#pragma unroll
        for (int i = 0; i < 4; ++i) { v[i] = *(const float4*)(xr + i * 256 + lane * 4); ss += v[i].x * v[i].x + v[i].y * v[i].y + v[i].z * v[i].z + v[i].w * v[i].w; }
        ss = wave_sum(ss);
        const float rn = rsqrtf(ss * (1.0f / 1024.0f) + 1e-6f);
        float lg[8];
        if (ROUTE) {
#pragma unroll
            for (int e = 0; e < 8; ++e) lg[e] = 0.f;
        }
#pragma unroll
        for (int i = 0; i < 4; ++i) {
            const int c = i * 256 + lane * 4;
            const float4 gg = *(const float4*)(g + c), sh = *(const float4*)(mv + c), sc = *(const float4*)(mv + 1024 + c);
            float h0 = v[i].x * rn * gg.x * (1.f + sc.x) + sh.x, h1 = v[i].y * rn * gg.y * (1.f + sc.y) + sh.y;
            float h2 = v[i].z * rn * gg.z * (1.f + sc.z) + sh.z, h3 = v[i].w * rn * gg.w * (1.f + sc.w) + sh.w;
            uint2 w; w.x = pack2(h0, h1); w.y = pack2(h2, h3);
            *(uint2*)(H + (size_t)r * DM + c) = w;
            if (ROUTE) {
                const float* rt = p.moe_router + (size_t)c * 8;
#pragma unroll
                for (int e = 0; e < 8; ++e) lg[e] += h0 * rt[e] + h1 * rt[8 + e] + h2 * rt[16 + e] + h3 * rt[24 + e];
            }
        }
        if (ROUTE) {
#pragma unroll
            for (int e = 0; e < 8; ++e) lg[e] = wave_sum(lg[e]);
            if (lane == 0 && r < NLAT) {
                int e0 = 0; float v0 = lg[0];
#pragma unroll
                for (int e = 1; e < 8; ++e) if (lg[e] > v0) { v0 = lg[e]; e0 = e; }
                int e1 = -1; float v1 = -3.0e38f;
#pragma unroll
                for (int e = 0; e < 8; ++e) if (e != e0 && lg[e] > v1) { v1 = lg[e]; e1 = e; }
                const float ex = __expf(v1 - v0), w0 = 1.0f / (1.0f + ex), w1 = ex / (1.0f + ex);
                int4 rec; rec.x = e0; rec.y = e1; rec.z = __float_as_int(w0); rec.w = __float_as_int(w1);
                *(int4*)(ws + OFF_ROUTE + (size_t)r * 16) = rec;
                unsigned* cw = (unsigned*)ws;
                atomicAdd(cw + CW_CNT + e0, 1u); atomicAdd(cw + CW_CNT + 8 + e1, 1u);
            }
        }
    }
}

namespace pg8 {
#define PG8_LAS __attribute__((address_space(3)))
typedef unsigned short bf16_t;
typedef short bf16x8 __attribute__((ext_vector_type(8)));
typedef float f32x4 __attribute__((ext_vector_type(4)));
typedef unsigned u32x4 __attribute__((ext_vector_type(4)));
constexpr int BM = 256, BK = 64, HALF = 128, HTB = HALF * BK * 2  , STAGE_BYTES = 8 * HTB, NXCD = 8, WGM = 8;

__host__ __device__ __forceinline__ int lds_byte(int r, int c) { const int st = (r >> 4) * 2 + (c >> 5), rr = r & 15, cc = c & 31, ob = rr * 64 + cc * 2; return st * 1024 + (ob ^ (((ob >> 9) & 1) << 5)); }
__host__ __device__ __forceinline__ void stage_rc(int b, int& R, int& C) { const int st = b / 1024, sb = b % 1024, swz = sb ^ (((sb >> 9) & 1) << 5); R = (st >> 1) * 16 + swz / 64; C = (st & 1) * 32 + (swz % 64) / 2; }
__host__ __device__ __forceinline__ int perm32(int rho) { const int n = rho >> 4, i = rho & 15; return 8 * (i >> 2) + 4 * n + (i & 3); }

struct Unit { int pm, pn; };
struct Gemm { const bf16_t* A; const bf16_t* Bt; int M, N, K; };

struct StaticOrder {
    int nM, nN, nwg, G, c;
    __host__ __device__ void init(int M, int N, int G_, int c_) { nM = M / BM; nN = N / BM; nwg = nM * nN; G = G_; c = c_; }
    __host__ __device__ bool next(int i, Unit& u) const {
        const long L = (long)i * G + c; if (L >= nwg) return false;
        int wgid = (int)L; { const int q = nwg / NXCD, r = nwg % NXCD, xcd = wgid % NXCD, off = wgid / NXCD; wgid = (xcd < r ? xcd * (q + 1) : r * (q + 1) + (xcd - r) * q) + off; }
        const int nig = WGM * nN, gid = wgid / nig, fm = gid * WGM, gsz = (nM - fm) < WGM ? (nM - fm) : WGM;
        u.pm = fm + ((wgid % nig) % gsz); u.pn = (wgid % nig) / gsz; return true;
    }
    __device__ __forceinline__ void a_ready(const Unit&) const {}
    __device__ __forceinline__ void done(const Unit&) const {}
};
__device__ __forceinline__ unsigned cvt_pk_bf16(float lo, float hi) { unsigned r; asm volatile("v_cvt_pk_bf16_f32 %0, %1, %2" : "=v"(r) : "v"(lo), "v"(hi)); return r; }
typedef float f32x2 __attribute__((ext_vector_type(2)));
template <class Epi, class Sched, bool ALIGN_EPI = false, bool SP2 = false>
__device__ __forceinline__ void gemm_phase(PG8_LAS unsigned char* lds, const Gemm g, const Sched& S, const Epi& E) {
    int tid_ = threadIdx.x; asm volatile("" : "+v"(tid_));
    const int tid = tid_, wid = __builtin_amdgcn_readfirstlane(tid >> 6), lane = tid & 63, wr = wid >> 2, wc = wid & 3, fr = lane & 15, fq = lane >> 4;
    const int K = g.K, nt = K / BK;
    unsigned voffA[2], voffB[2];
#pragma unroll
    for (int i = 0; i < 2; ++i) { int R, C; stage_rc(tid * 16 + i * 8192, R, C); const int Rb = Epi::PERM ? ((R & ~31) + perm32(R & 31)) : R;
        voffA[i] = (unsigned)(R * K + C) * 2u; voffB[i] = (unsigned)(Rb * K + C) * 2u; }
    const size_t kstep = (size_t)(BK * 2);
    const size_t hstep = (size_t)HALF * K * 2;
    const size_t tstep = 2 * hstep;
    const unsigned ldsw = (unsigned)wid * 1024u;
    const int aoff = lds_byte(wr * 64 + fr, fq * 8), boff = lds_byte(wc * 32 + fr, fq * 8);
#define PG8_SA(b, h) (((b) * 2 + (h)) * HTB)
#define PG8_SB(b, h) ((4 + (b) * 2 + (h)) * HTB)
#define PG8_STAGE(bufoff, gbase, voff) do { _Pragma("unroll") for (int _i = 0; _i < 2; ++_i) \
        __builtin_amdgcn_global_load_lds((const unsigned*)((const char*)(gbase) + (voff)[_i]), (PG8_LAS unsigned*)(lds + (bufoff) + ldsw + _i * 8192), 16, 0, 0); } while (0)
#define PG8_LDA(dst, b, h) do { _Pragma("unroll") for (int m = 0; m < 4; ++m) _Pragma("unroll") for (int k = 0; k < 2; ++k) dst[m][k] = *(const PG8_LAS bf16x8*)(lds + PG8_SA(b, h) + aoff + m * 2048 + k * 1024); } while (0)
#define PG8_LDB(dst, b, h) do { _Pragma("unroll") for (int n = 0; n < 2; ++n) _Pragma("unroll") for (int k = 0; k < 2; ++k) dst[n][k] = *(const PG8_LAS bf16x8*)(lds + PG8_SB(b, h) + boff + n * 2048 + k * 1024); } while (0)
#define PG8_MMA(ai, bj, At, Bt) do { __builtin_amdgcn_s_setprio(1); _Pragma("unroll") for (int m = 0; m < 4; ++m) _Pragma("unroll") for (int n = 0; n < 2; ++n) _Pragma("unroll") for (int k = 0; k < 2; ++k) \
        acc[ai][bj][m][n] = __builtin_amdgcn_mfma_f32_16x16x32_bf16(Bt[n][k], At[m][k], acc[ai][bj][m][n], 0, 0, 0); __builtin_amdgcn_s_setprio(0); } while (0)
#define PG8_WAIT_V(n) asm volatile("s_waitcnt vmcnt(" #n ")" ::: "memory")
#define PG8_WAIT_L(n) asm volatile("s_waitcnt lgkmcnt(" #n ")" ::: "memory")
#define PG8_BAR __builtin_amdgcn_s_barrier()
#define PG8_SCHED __builtin_amdgcn_sched_barrier(0)
    Unit cur, nxt; int ui = 0;
    if (!S.next(0, cur)) return;
    f32x4 acc[2][2][4][2];
#pragma unroll
    for (int a = 0; a < 2; ++a)
#pragma unroll
        for (int b = 0; b < 2; ++b)
#pragma unroll
            for (int m = 0; m < 4; ++m)
#pragma unroll
                for (int n = 0; n < 2; ++n) acc[a][b][m][n] = (f32x4){0.f, 0.f, 0.f, 0.f};
    bf16x8 At[4][2], B0[2][2], B1[2][2];
    const char* cA = (const char*)g.A + (size_t)cur.pm * tstep; const char* cB = (const char*)g.Bt + (size_t)cur.pn * tstep;
    S.a_ready(cur);
    if constexpr (SP2) {
        PG8_STAGE(PG8_SB(0, 0), cB, voffB); PG8_STAGE(PG8_SB(0, 1), cB + hstep, voffB); PG8_STAGE(PG8_SA(0, 0), cA, voffA); PG8_STAGE(PG8_SA(0, 1), cA + hstep, voffA);
        if (wr == 1) PG8_BAR;
        PG8_WAIT_V(2); PG8_BAR;
        PG8_STAGE(PG8_SB(1, 0), cB + kstep, voffB); PG8_STAGE(PG8_SA(1, 0), cA + kstep, voffA); PG8_STAGE(PG8_SB(1, 1), cB + hstep + kstep, voffB);
        PG8_WAIT_V(6); PG8_BAR;
    } else {
        PG8_STAGE(PG8_SB(0, 0), cB, voffB); PG8_STAGE(PG8_SA(0, 0), cA, voffA); PG8_STAGE(PG8_SB(0, 1), cB + hstep, voffB); PG8_STAGE(PG8_SA(0, 1), cA + hstep, voffA);
        if (wr == 1) PG8_BAR;
        PG8_WAIT_V(4); PG8_BAR;
        PG8_STAGE(PG8_SB(1, 0), cB + kstep, voffB); PG8_STAGE(PG8_SA(1, 0), cA + kstep, voffA); PG8_STAGE(PG8_SB(1, 1), cB + hstep + kstep, voffB);
        PG8_WAIT_V(6); PG8_BAR;
    }
    for (;;) {
        const bool has_next = S.next(ui + 1, nxt);
        const char* nA = has_next ? (const char*)g.A + (size_t)nxt.pm * tstep : cA; const char* nB = has_next ? (const char*)g.Bt + (size_t)nxt.pn * tstep : cB;
        for (int t = 0; t < nt; t += 2) {
            const bool last = (t == nt - 2);
            const char* a1 = cA + (size_t)(t + 1) * kstep;
            const char* a2 = last ? nA : cA + (size_t)(t + 2) * kstep; const char* b2 = last ? nB : cB + (size_t)(t + 2) * kstep;
            const char* a3 = a2 + kstep; const char* b3 = b2 + kstep;
            if (last && has_next) S.a_ready(nxt);
            if constexpr (SP2) {
            PG8_LDB(B0, 0, 0); PG8_LDB(B1, 0, 1); PG8_SCHED; PG8_LDA(At, 0, 0); PG8_STAGE(PG8_SA(1, 1), a1 + hstep, voffA);
            PG8_WAIT_V(8); PG8_WAIT_L(0); PG8_BAR; PG8_MMA(0, 0, At, B0); PG8_MMA(0, 1, At, B1); PG8_BAR; PG8_SCHED;
            PG8_LDA(At, 0, 1); PG8_STAGE(PG8_SB(0, 0), b2, voffB); PG8_STAGE(PG8_SB(0, 1), b2 + hstep, voffB); PG8_STAGE(PG8_SA(0, 0), a2, voffA);
            PG8_WAIT_V(8); PG8_WAIT_L(0); PG8_BAR; PG8_MMA(1, 0, At, B0); PG8_MMA(1, 1, At, B1); PG8_BAR; PG8_SCHED;
            PG8_LDB(B0, 1, 0); PG8_LDB(B1, 1, 1); PG8_SCHED; PG8_LDA(At, 1, 0); PG8_STAGE(PG8_SA(0, 1), a2 + hstep, voffA);
            PG8_WAIT_V(8); PG8_WAIT_L(0); PG8_BAR; PG8_MMA(0, 0, At, B0); PG8_MMA(0, 1, At, B1); PG8_BAR; PG8_SCHED;
            PG8_LDA(At, 1, 1); PG8_STAGE(PG8_SB(1, 0), b3, voffB); PG8_STAGE(PG8_SB(1, 1), b3 + hstep, voffB); PG8_STAGE(PG8_SA(1, 0), a3, voffA);
            PG8_WAIT_V(8); PG8_WAIT_L(0); PG8_BAR; PG8_MMA(1, 0, At, B0); PG8_MMA(1, 1, At, B1); PG8_BAR; PG8_SCHED;
            } else {
            PG8_LDB(B0, 0, 0); PG8_SCHED; PG8_LDA(At, 0, 0); PG8_STAGE(PG8_SA(1, 1), a1 + hstep, voffA);
            PG8_WAIT_L(8); PG8_BAR; PG8_WAIT_L(0); PG8_MMA(0, 0, At, B0); PG8_BAR; PG8_SCHED;
            PG8_LDB(B1, 0, 1); PG8_STAGE(PG8_SB(0, 0), b2, voffB);
            PG8_BAR; PG8_WAIT_L(0); PG8_MMA(0, 1, At, B1); PG8_BAR;
            PG8_LDA(At, 0, 1); PG8_STAGE(PG8_SA(0, 0), a2, voffA);
            PG8_BAR; PG8_WAIT_L(0); PG8_MMA(1, 0, At, B0); PG8_BAR; PG8_SCHED;
            PG8_STAGE(PG8_SB(0, 1), b2 + hstep, voffB);
            PG8_WAIT_V(6); PG8_BAR; PG8_MMA(1, 1, At, B1); PG8_BAR;
            PG8_LDB(B0, 1, 0); PG8_SCHED; PG8_LDA(At, 1, 0); PG8_STAGE(PG8_SA(0, 1), a2 + hstep, voffA);
            PG8_WAIT_L(8); PG8_BAR; PG8_WAIT_L(0); PG8_MMA(0, 0, At, B0); PG8_BAR; PG8_SCHED;
            PG8_LDB(B1, 1, 1); PG8_STAGE(PG8_SB(1, 0), b3, voffB);
            PG8_BAR; PG8_WAIT_L(0); PG8_MMA(0, 1, At, B1); PG8_BAR;
            PG8_LDA(At, 1, 1); PG8_STAGE(PG8_SA(1, 0), a3, voffA);
            PG8_BAR; PG8_WAIT_L(0); PG8_MMA(1, 0, At, B0); PG8_BAR; PG8_SCHED;
            PG8_STAGE(PG8_SB(1, 1), b3 + hstep, voffB);
            PG8_WAIT_V(6); PG8_BAR; PG8_MMA(1, 1, At, B1); PG8_BAR;
            }
        }
        if constexpr (ALIGN_EPI) { if (wr == 0) PG8_BAR; }
        if constexpr (!Epi::AFTER_DRAIN) { E(acc, cur, wr, wc, fr, fq); S.done(cur); }
        if (!has_next) break;
#pragma unroll
        for (int a = 0; a < 2; ++a)
#pragma unroll
            for (int b = 0; b < 2; ++b)
#pragma unroll
                for (int m = 0; m < 4; ++m)
#pragma unroll
                    for (int n = 0; n < 2; ++n) acc[a][b][m][n] = (f32x4){0.f, 0.f, 0.f, 0.f};
        cur = nxt; cA = nA; cB = nB; ++ui;
        if constexpr (ALIGN_EPI) { if (wr == 1) PG8_BAR; }
    }
    PG8_WAIT_V(0);
    if constexpr (!ALIGN_EPI) { if (wr == 0) PG8_BAR; }
    PG8_BAR;
    if constexpr (Epi::AFTER_DRAIN) { E.fused(acc, cur, wr, wc, fr, fq, lds, wid, lane); S.done(cur); }
#undef PG8_SA
#undef PG8_SB
#undef PG8_STAGE
#undef PG8_LDA
#undef PG8_LDB
#undef PG8_MMA
#undef PG8_WAIT_V
#undef PG8_WAIT_L
#undef PG8_BAR
#undef PG8_SCHED
}
}

constexpr int RT_K = 0, RT_V = 32768, RT_ST = 65536;
template <bool KV> __device__ __forceinline__ void ret_stage(const bf16_t* P, int rb, int hp, LAS char* sm, int tid, int wid, int lane) {
    const int vrow = 16 * (wid & 3) + (lane >> 2), vc = (wid >> 2) * 32 + (lane & 3) * 8;
    u32x4 kk[4], vv[4];
#pragma unroll
    for (int i = 0; i < 4; ++i) { const int hh = i >> 1, tt = i & 1, h = 2 * hp + hh, r0 = rb + tt * 64;
        vv[i] = *(const u32x4*)(P + (size_t)(r0 + vrow) * DIN + C_RV + h * 64 + vc);
        kk[i] = KV ? *(const u32x4*)(P + (size_t)(r0 + vrow) * DIN + C_RK + h * 64 + vc) : *(const u32x4*)(P + (size_t)(r0 + lane) * DIN + C_RK + h * 64 + wid * 8); }
#pragma unroll
    for (int i = 0; i < 4; ++i) { *(LAS u32x4*)(sm + RT_K + i * 8192 + tid * 16) = kk[i]; *(LAS u32x4*)(sm + RT_V + i * 8192 + tid * 16) = vv[i]; }
}
__device__ __forceinline__ float ret_lg(const Params& p, int l, int dir, int h) { return -softplusf_(-p.ret_logit[(l * 2 + dir) * 4 + h]); }
__device__ __forceinline__ void ph_ret_summ(const Params& p, int l, int bid, int nb, float* lds) {
    char* ws = p.ws; const int tid = TIDX, lane = tid & 63, r32 = lane & 31, hi = lane >> 5, wid = __builtin_amdgcn_readfirstlane(tid >> 6);
    const bf16_t* P = (const bf16_t*)(ws + OFF_P); float* RET = (float*)(ws + OFF_RET);
    LAS char* sm = (LAS char*)lds;
    for (int u = bid; u < 2 * NCI * 2; u += nb) {
        const int hp = u & 1, ci = (u >> 1) % NCI, b = (u >> 1) / NCI, rb = row_base(b, ci);
        __syncthreads();
        ret_stage<true>(P, rb, hp, sm, tid, wid, lane);
        __syncthreads();
        const int hh = wid >> 2, dh = (wid >> 1) & 1, eh = wid & 1, h = 2 * hp + hh;
        const float lg2f = ret_lg(p, l, 0, h) * 1.4426950408889634f, lg2b = ret_lg(p, l, 1, h) * 1.4426950408889634f;
        const int voff = ((lane >> 4) & 1) * 32 + (lane & 3) * 8 + (4 * hi + ((lane & 15) >> 2)) * 64;
        const LAS char* Kb = sm + RT_K + hh * 16384 + dh * 4096 + voff; const LAS char* Vb = sm + RT_V + hh * 16384 + eh * 4096 + voff;
        f32x16 a0, a1;
#pragma unroll
        for (int r = 0; r < 16; ++r) { a0[r] = 0.f; a1[r] = 0.f; }
#pragma unroll
        for (int k8 = 0; k8 < 8; ++k8) { const int tt = k8 >> 2, sl = k8 & 3;
            const s16x4 klo = vtr(Kb + tt * 8192 + sl * 1024), khi = vtr(Kb + tt * 8192 + sl * 1024 + 512), vlo = vtr(Vb + tt * 8192 + sl * 1024), vhi = vtr(Vb + tt * 8192 + sl * 1024 + 512);
            const int mb = tt * 64 + sl * 16 + 4 * hi; float kf_[8], kb_[8];
#pragma unroll
            for (int j = 0; j < 8; ++j) { const int m = mb + (j < 4 ? j : j + 4); const float kv = bfs(j < 4 ? klo[j] : khi[j - 4]);
                kf_[j] = kv * __builtin_amdgcn_exp2f(lg2f * (float)(127 - m)); kb_[j] = kv * __builtin_amdgcn_exp2f(lg2b * (float)m); }
            const u32x4 af = {cvtpk_s(kf_[0], kf_[1]), cvtpk_s(kf_[2], kf_[3]), cvtpk_s(kf_[4], kf_[5]), cvtpk_s(kf_[6], kf_[7])};
            const u32x4 ab = {cvtpk_s(kb_[0], kb_[1]), cvtpk_s(kb_[2], kb_[3]), cvtpk_s(kb_[4], kb_[5]), cvtpk_s(kb_[6], kb_[7])};
            const bf16x8 vfr = {vlo[0], vlo[1], vlo[2], vlo[3], vhi[0], vhi[1], vhi[2], vhi[3]};
            a0 = __builtin_amdgcn_mfma_f32_32x32x16_bf16(__builtin_bit_cast(bf16x8, af), vfr, a0, 0, 0, 0);
            a1 = __builtin_amdgcn_mfma_f32_32x32x16_bf16(__builtin_bit_cast(bf16x8, ab), vfr, a1, 0, 0, 0); }
        float* of = RET + ((((size_t)0 * 2 + b) * NCI + ci) * 4 + h) * 4096 + eh * 32 + r32;
        float* ob = RET + ((((size_t)1 * 2 + b) * NCI + ci) * 4 + h) * 4096 + eh * 32 + r32;
#pragma unroll
        for (int r = 0; r < 16; ++r) { const int d = dh * 32 + crow(r, hi); of[d * 64] = a0[r]; ob[d * 64] = a1[r]; }
    }
}

constexpr int LR_UB = 0, LR_A = 18432, LR_B = 51200, LR_H = 83968;
template <int MODE>
__device__ __forceinline__ void ph_lru_chunk(const Params& p, int l, int bid, int nb, float* lds, int ci_lo) {
    char* ws = p.ws; const int tid = TIDX, lane = tid & 63, r32 = lane & 31, hi = lane >> 5, wid = __builtin_amdgcn_readfirstlane(tid >> 6);
    const bf16_t* P = (const bf16_t*)(ws + OFF_P);
    float* LA = (float*)(ws + OFF_LRU); float* LB = LA + 2 * 2 * NCI * 256; float* LC = LB + 2 * 2 * NCI * 256;
    bf16_t* O = (bf16_t*)(ws + OFF_ACT);
    LAS char* sm = (LAS char*)lds;
    const int hb = bid & 3, tt = wid >> 1, jt = wid & 1, jcol = jt * 32 + r32, ch = hb * 64 + jcol;
    bf16x8 wfr[2][2][4]; float bia[2][2], spl[2];
#pragma unroll
    for (int dir = 0; dir < 2; ++dir) {
#pragma unroll
        for (int gt = 0; gt < 2; ++gt) { const float* W = (gt == 0 ? p.lru_wa : p.lru_wx) + (((size_t)(l * 2 + dir) * 4 + hb) * 64) * 64 + jcol;
#pragma unroll
            for (int ks = 0; ks < 4; ++ks) { const float* wp = W + (16 * ks + 8 * hi) * 64;
                const u32x4 w4 = {cvtpk_s(wp[0], wp[64]), cvtpk_s(wp[128], wp[192]), cvtpk_s(wp[256], wp[320]), cvtpk_s(wp[384], wp[448])};
                wfr[dir][gt][ks] = __builtin_bit_cast(bf16x8, w4); }
            bia[dir][gt] = (gt == 0 ? p.lru_ba : p.lru_bx)[(l * 2 + dir) * 256 + ch]; }
        spl[dir] = -8.0f * softplusf_(-p.lru_lam[(l * 2 + dir) * 256 + ch]); }
    const int nci = NCI - ci_lo, npair = 2 * nci;
    for (int pi = bid >> 2; pi < npair; pi += nb >> 2) {
        const int ci = ci_lo + pi % nci, b = pi / nci, rb = row_base(b, ci);
        const int seg_lo = ci < 2 ? NLAT + b * NCTX : b * NSEQ, seg_hi = ci < 2 ? seg_lo + NCTX : seg_lo + NSEQ;
        __syncthreads();
#pragma unroll
        for (int it = 0; it < 2; ++it) { const int item = it * 512 + tid, t = item >> 3, c8 = (item & 7) * 8, c0 = hb * 64 + c8;
            float acc[8];
            { const f32x4 b0 = *(const f32x4*)(p.conv_b + l * 256 + c0), b1 = *(const f32x4*)(p.conv_b + l * 256 + c0 + 4);
              acc[0] = b0[0]; acc[1] = b0[1]; acc[2] = b0[2]; acc[3] = b0[3]; acc[4] = b1[0]; acc[5] = b1[1]; acc[6] = b1[2]; acc[7] = b1[3]; }
#pragma unroll
            for (int k = 0; k < 4; ++k) { const int rr = rb + t - 1 + k;
                if (rr >= seg_lo && rr < seg_hi) { const bf16x8 xv = *(const bf16x8*)(P + (size_t)rr * DIN + C_LX + c0);
                    const f32x4 w0 = *(const f32x4*)(p.conv_w + (l * 4 + k) * 256 + c0), w1 = *(const f32x4*)(p.conv_w + (l * 4 + k) * 256 + c0 + 4);
                    acc[0] += w0[0] * bfs(xv[0]); acc[1] += w0[1] * bfs(xv[1]); acc[2] += w0[2] * bfs(xv[2]); acc[3] += w0[3] * bfs(xv[3]);
                    acc[4] += w1[0] * bfs(xv[4]); acc[5] += w1[1] * bfs(xv[5]); acc[6] += w1[2] * bfs(xv[6]); acc[7] += w1[3] * bfs(xv[7]); } }
            const u32x4 w = {cvtpk_s(acc[0], acc[1]), cvtpk_s(acc[2], acc[3]), cvtpk_s(acc[4], acc[5]), cvtpk_s(acc[6], acc[7])};
            *(LAS u32x4*)(sm + LR_UB + t * 144 + c8 * 2) = w; }
        __syncthreads();
        bf16x8 ua[4];
#pragma unroll
        for (int ks = 0; ks < 4; ++ks) ua[ks] = *(const LAS bf16x8*)(sm + LR_UB + (tt * 32 + r32) * 144 + (16 * ks + 8 * hi) * 2);
#pragma unroll
        for (int dir = 0; dir < 2; ++dir) {
            f32x16 ga, gx;
#pragma unroll
            for (int r = 0; r < 16; ++r) { ga[r] = bia[dir][0]; gx[r] = bia[dir][1]; }
#pragma unroll
            for (int ks = 0; ks < 4; ++ks) { ga = __builtin_amdgcn_mfma_f32_32x32x16_bf16(ua[ks], wfr[dir][0][ks], ga, 0, 0, 0); gx = __builtin_amdgcn_mfma_f32_32x32x16_bf16(ua[ks], wfr[dir][1][ks], gx, 0, 0, 0); }
#pragma unroll
            for (int r = 0; r < 16; ++r) { const int t = tt * 32 + crow(r, hi);
                const float rg = __builtin_amdgcn_rcpf(1.0f + __expf(-ga[r])), ig = __builtin_amdgcn_rcpf(1.0f + __expf(-gx[r]));
                const float a = __expf(spl[dir] * rg);
                const float uu = __uint_as_float(((unsigned)*(const LAS unsigned short*)(sm + LR_UB + t * 144 + jcol * 2)) << 16);
                *(LAS float*)(sm + LR_A + (t * 64 + jcol) * 4) = a;
                *(LAS float*)(sm + LR_B + (t * 64 + jcol) * 4) = sqrtf(fmaxf(1.0f - a * a, 0.f)) * (ig * uu); }
            __syncthreads();
            if (wid == 0) {
                const size_t cidx = (((size_t)dir * 2 + b) * NCI + ci) * 256 + hb * 64 + lane;
                float h = MODE == 3 ? LC[cidx] : 0.f, ap = 1.f;
                const LAS float* as_ = (const LAS float*)(sm + LR_A) + lane; const LAS float* bs_ = (const LAS float*)(sm + LR_B) + lane; LAS float* hs = (LAS float*)(sm + LR_H) + lane;
#pragma unroll 1
                for (int t0 = 0; t0 < 128; t0 += 16) {
                    float av[16], bv[16], hv[16];
#pragma unroll
                    for (int k = 0; k < 16; ++k) { const int t = dir == 0 ? t0 + k : 127 - t0 - k; av[k] = as_[t * 64]; bv[k] = bs_[t * 64]; if (MODE == 3 && dir == 1) hv[k] = hs[t * 64]; }
#pragma unroll
                    for (int k = 0; k < 16; ++k) { const int t = dir == 0 ? t0 + k : 127 - t0 - k; h = av[k] * h + bv[k]; ap *= av[k];
                        if (MODE == 3) hs[t * 64] = dir == 0 ? h : hv[k] + h; }
                }
                if (MODE == 1) { LA[cidx] = ap; LB[cidx] = h; }
            }
            __syncthreads();
        }
        if (MODE == 3) {
#pragma unroll
            for (int it = 0; it < 2; ++it) { const int item = it * 512 + tid, t = item >> 3, c8 = (item & 7) * 8, c0 = hb * 64 + c8;
                const f32x4 h0 = *(const LAS f32x4*)(sm + LR_H + (t * 64 + c8) * 4), h1 = *(const LAS f32x4*)(sm + LR_H + (t * 64 + c8 + 4) * 4);
                const bf16x8 yv = *(const bf16x8*)(P + (size_t)(rb + t) * DIN + C_LY + c0);
                const u32x4 w = {cvtpk_s(h0[0] * gelu_tanh(bfs(yv[0])), h0[1] * gelu_tanh(bfs(yv[1]))), cvtpk_s(h0[2] * gelu_tanh(bfs(yv[2])), h0[3] * gelu_tanh(bfs(yv[3]))),
                                 cvtpk_s(h1[0] * gelu_tanh(bfs(yv[4])), h1[1] * gelu_tanh(bfs(yv[5]))), cvtpk_s(h1[2] * gelu_tanh(bfs(yv[6])), h1[3] * gelu_tanh(bfs(yv[7])))};
                *(u32x4*)(O + (size_t)(rb + t) * DM + 768 + c0) = w; }
        }
    }
}

__device__ __forceinline__ int scan_ci(int dir, int s) { return dir == 0 ? s : (s == 0 ? 1 : (s == 1 ? 0 : NCI + 1 - s)); }
__device__ __forceinline__ void ph_scan2(const Params& p, int l, int bid, int nb) {
    char* ws = p.ws; const int gt = bid * 512 + TIDX, gs = nb * 512;
    float* RET = (float*)(ws + OFF_RET);
    for (int i = gt; i < 2 * 2 * 4 * 4096; i += gs) {
        const int de = i & 4095, h = (i >> 12) & 3, b = (i >> 14) & 1, dir = i >> 15;
        const float decay = expf(ret_lg(p, l, dir, h) * 128.0f); float S = 0.f;
        float* base = RET + (((size_t)dir * 2 + b) * NCI * 4 + h) * 4096 + de;
        for (int s0 = 0; s0 < NCI; s0 += 13) {
            float uu[13];
#pragma unroll
            for (int j = 0; j < 13; ++j) uu[j] = base[(size_t)scan_ci(dir, s0 + j) * 4 * 4096];
#pragma unroll
            for (int j = 0; j < 13; ++j) { base[(size_t)scan_ci(dir, s0 + j) * 4 * 4096] = S; S = decay * S + uu[j]; }
        }
    }
    float* LA = (float*)(ws + OFF_LRU); float* LB = LA + 2 * 2 * NCI * 256; float* LC = LB + 2 * 2 * NCI * 256;
    for (int i = gt; i < 2 * 2 * 256; i += gs) {
        const int ch = i & 255, b = (i >> 8) & 1, dir = i >> 9; float h = 0.f;
        const size_t base = ((size_t)dir * 2 + b) * NCI * 256 + ch;
        for (int s0 = 0; s0 < NCI; s0 += 13) {
            float aa[13], bb[13];
#pragma unroll
            for (int j = 0; j < 13; ++j) { const size_t idx = base + (size_t)scan_ci(dir, s0 + j) * 256; aa[j] = LA[idx]; bb[j] = LB[idx]; }
#pragma unroll
            for (int j = 0; j < 13; ++j) { LC[base + (size_t)scan_ci(dir, s0 + j) * 256] = h; h = aa[j] * h + bb[j]; }
        }
    }
}

__device__ __forceinline__ bf16x8 scale_frag(bf16x8 q, float s) {
    u32x4 w;
#pragma unroll
    for (int i = 0; i < 4; ++i) w[i] = cvtpk_s(bfs(q[2 * i]) * s, bfs(q[2 * i + 1]) * s);
    return __builtin_bit_cast(bf16x8, w);
}
__device__ __forceinline__ void ph_ret_out(const Params& p, int l, int bid, int nb, float* lds, int ci_lo) {
    char* ws = p.ws; const int tid = TIDX, lane = tid & 63, r32 = lane & 31, hi = lane >> 5, wid = __builtin_amdgcn_readfirstlane(tid >> 6);
    const bf16_t* P = (const bf16_t*)(ws + OFF_P); const float* RET = (const float*)(ws + OFF_RET); bf16_t* O = (bf16_t*)(ws + OFF_ACT);
    LAS char* sm = (LAS char*)lds;
    const int nci = NCI - ci_lo;
    for (int u = bid; u < 2 * nci * 2; u += nb) {
        const int hp = u & 1, ci = ci_lo + (u >> 1) % nci, b = (u >> 1) / nci, rb = row_base(b, ci);
        __syncthreads();
        ret_stage<false>(P, rb, hp, sm, tid, wid, lane);
        __syncthreads();
        const int hh = wid >> 2, qt = wid & 3, h = 2 * hp + hh; int n = qt * 32 + r32;
        asm volatile("" : "+v"(n));
        const float lg2f = ret_lg(p, l, 0, h) * 1.4426950408889634f, lg2b = ret_lg(p, l, 1, h) * 1.4426950408889634f;
        bf16x8 qr[4];
        { const bf16_t* qp = P + (size_t)(rb + n) * DIN + C_RQ + h * 64 + hi * 8;
#pragma unroll
          for (int ks = 0; ks < 4; ++ks) qr[ks] = *(const bf16x8*)(qp + ks * 16); }
        f32x16 o[2];
#pragma unroll
        for (int r = 0; r < 16; ++r) { o[0][r] = 0.f; o[1][r] = 0.f; }
#pragma unroll
        for (int dir = 0; dir < 2; ++dir) {
            const float xi = dir == 0 ? __builtin_amdgcn_exp2f(lg2f * (float)(n + 1)) : __builtin_amdgcn_exp2f(lg2b * (float)(128 - n));
            const float* Sb = RET + ((((size_t)dir * 2 + b) * NCI + ci) * 4 + h) * 4096 + hi * 8 * 64 + r32;
#pragma unroll
            for (int ks = 0; ks < 4; ++ks) { const bf16x8 qx = scale_frag(qr[ks], xi);
#pragma unroll
                for (int eh = 0; eh < 2; ++eh) { const float* sp = Sb + ks * 16 * 64 + eh * 32;
                    const u32x4 sw = {cvtpk_s(sp[0], sp[64]), cvtpk_s(sp[128], sp[192]), cvtpk_s(sp[256], sp[320]), cvtpk_s(sp[384], sp[448])};
                    o[eh] = __builtin_amdgcn_mfma_f32_32x32x16_bf16(qx, __builtin_bit_cast(bf16x8, sw), o[eh], 0, 0, 0); } }
        }
        const LAS char* Kb = sm + RT_K + hh * 16384 + hi * 1024 + r32 * 16;
        const LAS char* Vb = sm + RT_V + hh * 16384 + ((lane >> 4) & 1) * 32 + (lane & 3) * 8 + (4 * hi + ((lane & 15) >> 2)) * 64;
        u32x4 pw[8];
#pragma unroll
        for (int kb = 0; kb < 4; ++kb) { const int tt = kb >> 1, kbl = kb & 1;
            f32x16 c;
#pragma unroll
            for (int r = 0; r < 16; ++r) c[r] = 0.f;
#pragma unroll
            for (int ks = 0; ks < 4; ++ks) c = __builtin_amdgcn_mfma_f32_32x32x16_bf16(*(const LAS bf16x8*)(Kb + tt * 8192 + ks * 2048 + kbl * 512), qr[ks], c, 0, 0, 0);
#pragma unroll
            for (int r = 0; r < 16; ++r) { const int dlt = n - (kb * 32 + crow(r, hi)); const float fd = (float)dlt;
                const float w = __builtin_amdgcn_exp2f(fd * (dlt > 0 ? lg2f : -lg2b));
                c[r] *= dlt == 0 ? 2.0f : w; }
            pw[2 * kb] = (u32x4){cvtpk_s(c[0], c[1]), cvtpk_s(c[2], c[3]), cvtpk_s(c[4], c[5]), cvtpk_s(c[6], c[7])};
            pw[2 * kb + 1] = (u32x4){cvtpk_s(c[8], c[9]), cvtpk_s(c[10], c[11]), cvtpk_s(c[12], c[13]), cvtpk_s(c[14], c[15])}; }
#pragma unroll
        for (int k8 = 0; k8 < 8; ++k8) { const int tt = k8 >> 2, sl = k8 & 3;
#pragma unroll
            for (int eh = 0; eh < 2; ++eh) { const s16x4 vlo = vtr(Vb + tt * 8192 + eh * 4096 + sl * 1024), vhi = vtr(Vb + tt * 8192 + eh * 4096 + sl * 1024 + 512);
                o[eh] = __builtin_amdgcn_mfma_f32_32x32x16_bf16(__builtin_bit_cast(bf16x8, pw[k8]), (bf16x8){vlo[0], vlo[1], vlo[2], vlo[3], vhi[0], vhi[1], vhi[2], vhi[3]}, o[eh], 0, 0, 0); } }
        LAS float* stg = (LAS float*)(sm + RT_ST) + wid * 2048;
#pragma unroll
        for (int r = 0; r < 16; ++r) { const int q = crow(r, hi); stg[q * 64 + r32] = o[0][r]; stg[q * 64 + 32 + r32] = o[1][r]; }
        const float* gn = p.ret_gn + l * 256 + h * 64 + (lane & 7) * 8;
        const f32x4 g0 = *(const f32x4*)gn, g1 = *(const f32x4*)(gn + 4);
#pragma unroll
        for (int i = 0; i < 4; ++i) { const int row = i * 8 + (lane >> 3), ch = lane & 7;
            const f32x4 v0 = *(const LAS f32x4*)(stg + row * 64 + ch * 8), v1 = *(const LAS f32x4*)(stg + row * 64 + ch * 8 + 4);
            float ss = v0[0] * v0[0] + v0[1] * v0[1] + v0[2] * v0[2] + v0[3] * v0[3] + v1[0] * v1[0] + v1[1] * v1[1] + v1[2] * v1[2] + v1[3] * v1[3];
            ss += __shfl_xor(ss, 1); ss += __shfl_xor(ss, 2); ss += __shfl_xor(ss, 4);
            const float rn = rsqrtf(ss * (1.0f / 64.0f) + 1e-6f);
            const size_t grow = (size_t)(rb + qt * 32 + row);
            const bf16x8 gg = *(const bf16x8*)(P + grow * DIN + C_RG + h * 64 + ch * 8);
            u32x4 w; w.x = cvtpk_s(v0[0] * rn * g0[0] * fast_silu(bfs(gg[0])), v0[1] * rn * g0[1] * fast_silu(bfs(gg[1]))); w.y = cvtpk_s(v0[2] * rn * g0[2] * fast_silu(bfs(gg[2])), v0[3] * rn * g0[3] * fast_silu(bfs(gg[3])));
            w.z = cvtpk_s(v1[0] * rn * g1[0] * fast_silu(bfs(gg[4])), v1[1] * rn * g1[1] * fast_silu(bfs(gg[5]))); w.w = cvtpk_s(v1[2] * rn * g1[2] * fast_silu(bfs(gg[6])), v1[3] * rn * g1[3] * fast_silu(bfs(gg[7])));
            *(u32x4*)(O + grow * DM + 256 + h * 64 + ch * 8) = w; }
    }
}

__device__ __forceinline__ float diff_lambda_val(const Params& p, int l, float lam_init) {
    const float* lv = p.diff_lam + l * 128; float s1 = 0.f, s2 = 0.f;
    for (int i = 0; i < 32; ++i) { s1 += lv[i] * lv[32 + i]; s2 += lv[64 + i] * lv[96 + i]; }
    return expf(s1) - expf(s2) + lam_init;
}
__device__ __forceinline__ float xhalf_max(float m) { auto rr = __builtin_amdgcn_permlane32_swap(__float_as_uint(m), __float_as_uint(m), false, false); return fmaxf(__uint_as_float(rr[0]), __uint_as_float(rr[1])); }
__device__ __forceinline__ float xhalf_sum(float m) { auto rr = __builtin_amdgcn_permlane32_swap(__float_as_uint(m), __float_as_uint(m), false, false); return __uint_as_float(rr[0]) + __uint_as_float(rr[1]); }

constexpr int DF_K = 0, DF_V = 16384, DF_WS = 32768, DF_ST = 34816;
__device__ __forceinline__ void ph_diff(const Params& p, int l, bool need_ctx, float lam_init, int bid, int nb, float* lds) {
    char* ws = p.ws; const int tid = TIDX, lane = tid & 63, r32 = lane & 31, hi = lane >> 5, wid = __builtin_amdgcn_readfirstlane(tid >> 6);
    const bf16_t* P = (const bf16_t*)(ws + OFF_P); bf16_t* O = (bf16_t*)(ws + OFF_ACT);
    LAS char* sm = (LAS char*)lds;
    LAS float* wsf = (LAS float*)(sm + DF_WS) + wid * 64;
    const float lam = diff_lambda_val(p, l, lam_init);
    const int nun = 512 + (need_ctx ? 8 : 0);
    for (int u = bid; u < nun; u += nb) {
        int b, h, qrow0, t_lo;
        if (u < 512) { b = u >> 8; h = (u >> 6) & 3; qrow0 = b * NSEQ + (u & 63) * 256; t_lo = 0; }
        else { const int v = u - 512; b = v >> 2; h = v & 3; qrow0 = NLAT + b * NCTX; t_lo = 256; }
        const int t_hi = 260;
        const bf16_t* kcol = P + C_DK + h * 64 + wid * 8;
        const bf16_t* vcol = P + C_DV + h * 64 + (wid >> 2) * 32 + (lane & 3) * 8;
        const int krow_in = lane, vrow_in = 16 * (wid & 3) + (lane >> 2);
#define TILE_ROW0(t) ((t) < 256 ? b * NSEQ + (t) * 64 : NLAT + b * NCTX + ((t) - 256) * 64)
        bf16x8 qr[4];
        { const bf16_t* qp = P + (size_t)(qrow0 + wid * 32 + r32) * DIN + C_DQ + h * 64 + hi * 8;
#pragma unroll
          for (int d0 = 0; d0 < 4; ++d0) qr[d0] = *(const bf16x8*)(qp + d0 * 16); }
        f32x16 o[2][2]; float mhat[2], lsum[2];
#pragma unroll
        for (int m = 0; m < 2; ++m) { mhat[m] = 0.f; lsum[m] = 0.f;
#pragma unroll
            for (int r = 0; r < 16; ++r) { o[m][0][r] = 0.f; o[m][1][r] = 0.f; } }
        u32x4 kst, vst;
        { const int r0 = TILE_ROW0(t_lo); kst = *(const u32x4*)(kcol + (size_t)(r0 + krow_in) * DIN); vst = *(const u32x4*)(vcol + (size_t)(r0 + vrow_in) * DIN); }
        __syncthreads();
        *(LAS u32x4*)(sm + DF_K + tid * 16) = kst; *(LAS u32x4*)(sm + DF_V + tid * 16) = vst;
        __syncthreads();
        bool first = true;
        for (int t = t_lo; t < t_hi; ++t) {
            const int cur = (t - t_lo) & 1;
            if (t + 1 < t_hi) { const int r0 = TILE_ROW0(t + 1); kst = *(const u32x4*)(kcol + (size_t)(r0 + krow_in) * DIN); vst = *(const u32x4*)(vcol + (size_t)(r0 + vrow_in) * DIN); }
            const LAS char* kb = sm + DF_K + cur * 8192 + hi * 1024 + r32 * 16;
            const LAS char* vb = sm + DF_V + cur * 8192 + ((lane >> 4) & 1) * 32 + (lane & 3) * 8 + (4 * hi + ((lane & 15) >> 2)) * 64;
            bf16x8 kf[8];
#pragma unroll
            for (int j = 0; j < 4; ++j) { kf[2 * j] = *(const LAS bf16x8*)(kb + j * 2048); kf[2 * j + 1] = *(const LAS bf16x8*)(kb + j * 2048 + 512); }
            bf16x8 vf[8];
#pragma unroll
            for (int i = 0; i < 8; ++i) { const s16x4 lo = vtr(vb + (i >> 2) * 4096 + (i & 3) * 1024), hh = vtr(vb + (i >> 2) * 4096 + (i & 3) * 1024 + 512);
                vf[i] = (bf16x8){lo[0], lo[1], lo[2], lo[3], hh[0], hh[1], hh[2], hh[3]}; }
#pragma unroll
            for (int m = 0; m < 2; ++m) {
                float nm = -mhat[m]; asm volatile("" : "+v"(nm));
                f32x16 negm;
#pragma unroll
                for (int r = 0; r < 16; ++r) negm[r] = nm;
                f32x16 c0 = __builtin_amdgcn_mfma_f32_32x32x16_bf16(kf[4 * m + 0], qr[2 * m], negm, 0, 0, 0);
                f32x16 c1 = __builtin_amdgcn_mfma_f32_32x32x16_bf16(kf[4 * m + 1], qr[2 * m], negm, 0, 0, 0);
                c0 = __builtin_amdgcn_mfma_f32_32x32x16_bf16(kf[4 * m + 2], qr[2 * m + 1], c0, 0, 0, 0);
                c1 = __builtin_amdgcn_mfma_f32_32x32x16_bf16(kf[4 * m + 3], qr[2 * m + 1], c1, 0, 0, 0);
                float rm = fmaxf(c0[0], c1[0]);
#pragma unroll
                for (int r = 1; r < 16; ++r) rm = fmaxf(rm, fmaxf(c0[r], c1[r]));
                rm = xhalf_max(rm);
                if (first || __any(rm > 8.0f)) {
                    const float dl = first ? rm : fmaxf(rm, 0.f);
                    mhat[m] += dl;
#pragma unroll
                    for (int r = 0; r < 16; ++r) { c0[r] -= dl; c1[r] -= dl; }
                    if (!first) {
                        const float f = __builtin_amdgcn_exp2f(-dl); lsum[m] *= f;
                        if (hi == 0) wsf[r32] = f;
#pragma unroll
                        for (int r = 0; r < 16; ++r) { const float fr_ = wsf[crow(r, hi)]; o[m][0][r] *= fr_; o[m][1][r] *= fr_; }
                    }
                }
                float sacc = 0.f;
#pragma unroll
                for (int r = 0; r < 16; ++r) { c0[r] = __builtin_amdgcn_exp2f(c0[r]); c1[r] = __builtin_amdgcn_exp2f(c1[r]); sacc += c0[r] + c1[r]; }
                lsum[m] += sacc;
                u32x4 pw[4];
#pragma unroll
                for (int k = 0; k < 2; ++k) {
                    pw[k] = (u32x4){cvtpk_s(c0[8 * k + 0], c0[8 * k + 1]), cvtpk_s(c0[8 * k + 2], c0[8 * k + 3]), cvtpk_s(c0[8 * k + 4], c0[8 * k + 5]), cvtpk_s(c0[8 * k + 6], c0[8 * k + 7])};
                    pw[2 + k] = (u32x4){cvtpk_s(c1[8 * k + 0], c1[8 * k + 1]), cvtpk_s(c1[8 * k + 2], c1[8 * k + 3]), cvtpk_s(c1[8 * k + 4], c1[8 * k + 5]), cvtpk_s(c1[8 * k + 6], c1[8 * k + 7])}; }
#pragma unroll
                for (int k = 0; k < 4; ++k) {
                    o[m][0] = __builtin_amdgcn_mfma_f32_32x32x16_bf16(__builtin_bit_cast(bf16x8, pw[k]), vf[k], o[m][0], 0, 0, 0);
                    o[m][1] = __builtin_amdgcn_mfma_f32_32x32x16_bf16(__builtin_bit_cast(bf16x8, pw[k]), vf[4 + k], o[m][1], 0, 0, 0); }
            }
            first = false;
            if (t + 1 < t_hi) { *(LAS u32x4*)(sm + DF_K + (cur ^ 1) * 8192 + tid * 16) = kst; *(LAS u32x4*)(sm + DF_V + (cur ^ 1) * 8192 + tid * 16) = vst; }
            __syncthreads();
        }
#undef TILE_ROW0
        const float inv0 = 1.0f / xhalf_sum(lsum[0]), inv1 = lam / xhalf_sum(lsum[1]);
        int lane_e = TIDX & 63; asm volatile("" : "+v"(lane_e));
        { const int r32e = lane_e & 31, hie = lane_e >> 5;
        LAS float* wse = (LAS float*)(sm + DF_WS) + wid * 64; LAS float* stge = (LAS float*)(sm + DF_ST) + wid * 2048;
        if (hie == 0) { wse[r32e] = inv0; wse[32 + r32e] = inv1; }
#pragma unroll
        for (int r = 0; r < 16; ++r) { const int q = crow(r, hie); const float i0 = wse[q], i1 = wse[32 + q];
            stge[q * 64 + r32e] = o[0][0][r] * i0 - o[1][0][r] * i1; stge[q * 64 + 32 + r32e] = o[0][1][r] * i0 - o[1][1][r] * i1; } }
        const int lane = lane_e; LAS float* stg = (LAS float*)(sm + DF_ST) + wid * 2048;
        const float* gn = p.diff_gn + l * 256 + h * 64 + (lane & 7) * 8;
        const f32x4 g0 = *(const f32x4*)gn, g1 = *(const f32x4*)(gn + 4);
#pragma unroll
        for (int i = 0; i < 4; ++i) { const int row = i * 8 + (lane >> 3), ch = lane & 7;
            const f32x4 v0 = *(const LAS f32x4*)(stg + row * 64 + ch * 8), v1 = *(const LAS f32x4*)(stg + row * 64 + ch * 8 + 4);
            float ss = v0[0] * v0[0] + v0[1] * v0[1] + v0[2] * v0[2] + v0[3] * v0[3] + v1[0] * v1[0] + v1[1] * v1[1] + v1[2] * v1[2] + v1[3] * v1[3];
            ss += __shfl_xor(ss, 1); ss += __shfl_xor(ss, 2); ss += __shfl_xor(ss, 4);
            const float rn = rsqrtf(ss * (1.0f / 64.0f) + 1e-6f) * (1.0f - lam_init);
            u32x4 w; w.x = cvtpk_s(v0[0] * rn * g0[0], v0[1] * rn * g0[1]); w.y = cvtpk_s(v0[2] * rn * g0[2], v0[3] * rn * g0[3]);
            w.z = cvtpk_s(v1[0] * rn * g1[0], v1[1] * rn * g1[1]); w.w = cvtpk_s(v1[2] * rn * g1[2], v1[3] * rn * g1[3]);
            *(u32x4*)(O + (size_t)(qrow0 + wid * 32 + row) * DM + 512 + h * 64 + ch * 8) = w; }
    }
}

__device__ __forceinline__ void ph_swa(const Params& p, int l, bool need_ctx, int bid, int nb, float* lds) {
    char* ws = p.ws; const int tid = TIDX, lane = tid & 63, r32 = lane & 31, hi = lane >> 5, wid = __builtin_amdgcn_readfirstlane(tid >> 6);
    const bf16_t* P = (const bf16_t*)(ws + OFF_P); bf16_t* O = (bf16_t*)(ws + OFF_ACT);
    LAS char* sm = (LAS char*)lds;
    LAS float* wsf = (LAS float*)(sm + DF_WS) + wid * 64;
    const int nun = 512 + (need_ctx ? 8 : 0);
    for (int u = bid; u < nun; u += nb) {
        int b, h, qrow0, q0, tw_lo, nwin;
        if (u < 512) { b = u >> 8; h = (u >> 6) & 3; q0 = (u & 63) * 256; qrow0 = b * NSEQ + q0; const int lo = q0 - 128 < 0 ? 0 : q0 - 128, hi_ = q0 + 384 > NSEQ ? NSEQ : q0 + 384; tw_lo = lo >> 6; nwin = (hi_ - lo) >> 6; }
        else { const int v = u - 512; b = v >> 2; h = v & 3; q0 = 0; qrow0 = NLAT + b * NCTX; tw_lo = 0; nwin = 0; }
        const int g = h >> 1, nt = nwin + 4;
        const bf16_t* kcol = P + C_AK + g * 64 + wid * 8;
        const bf16_t* vcol = P + C_AV + g * 64 + (wid >> 2) * 32 + (lane & 3) * 8;
        const int krow_in = lane, vrow_in = 16 * (wid & 3) + (lane >> 2);
#define SWA_ROW0(i) ((i) < nwin ? b * NSEQ + (tw_lo + (i)) * 64 : NLAT + b * NCTX + ((i) - nwin) * 64)
        bf16x8 qr[4];
        { const bf16_t* qp = P + (size_t)(qrow0 + wid * 32 + r32) * DIN + C_AQ + h * 64 + hi * 8;
#pragma unroll
          for (int d0 = 0; d0 < 4; ++d0) qr[d0] = *(const bf16x8*)(qp + d0 * 16); }
        f32x16 o[2]; float mhat = p.sink[l * 4 + h] * 1.4426950408889634f, lsum = hi == 0 ? 1.0f : 0.0f;
#pragma unroll
        for (int r = 0; r < 16; ++r) { o[0][r] = 0.f; o[1][r] = 0.f; }
        const int qw = q0 + wid * 32, qpos = qw + r32;
        u32x4 kst, vst;
        { const int r0 = SWA_ROW0(0); kst = *(const u32x4*)(kcol + (size_t)(r0 + krow_in) * DIN); vst = *(const u32x4*)(vcol + (size_t)(r0 + vrow_in) * DIN); }
        __syncthreads();
        *(LAS u32x4*)(sm + DF_K + tid * 16) = kst; *(LAS u32x4*)(sm + DF_V + tid * 16) = vst;
        __syncthreads();
        for (int i = 0; i < nt; ++i) {
            const int cur = i & 1;
            if (i + 1 < nt) { const int r0 = SWA_ROW0(i + 1); kst = *(const u32x4*)(kcol + (size_t)(r0 + krow_in) * DIN); vst = *(const u32x4*)(vcol + (size_t)(r0 + vrow_in) * DIN); }
            const bool win = i < nwin; const int T = (tw_lo + i) * 64;
            const bool skip = win && (T > qw + 31 + 128 || T + 63 < qw - 128);
            if (!skip) {
                const LAS char* kb = sm + DF_K + cur * 8192 + hi * 1024 + r32 * 16;
                const LAS char* vb = sm + DF_V + cur * 8192 + ((lane >> 4) & 1) * 32 + (lane & 3) * 8 + (4 * hi + ((lane & 15) >> 2)) * 64;
                float nm = -mhat; asm volatile("" : "+v"(nm));
                f32x16 c0, c1;
#pragma unroll
                for (int r = 0; r < 16; ++r) { c0[r] = nm; c1[r] = nm; }
#pragma unroll
                for (int j = 0; j < 4; ++j) {
                    c0 = __builtin_amdgcn_mfma_f32_32x32x16_bf16(*(const LAS bf16x8*)(kb + j * 2048), qr[j], c0, 0, 0, 0);
                    c1 = __builtin_amdgcn_mfma_f32_32x32x16_bf16(*(const LAS bf16x8*)(kb + j * 2048 + 512), qr[j], c1, 0, 0, 0); }
                if (win && (T < qw + 31 - 128 || T + 63 > qw + 128)) {
#pragma unroll
                    for (int r = 0; r < 16; ++r) { const int kp = T + crow(r, hi); const int d0_ = qpos - kp, d1_ = d0_ - 32;
                        if (d0_ > 128 || d0_ < -128) c0[r] = -1.0e30f;
                        if (d1_ > 128 || d1_ < -128) c1[r] = -1.0e30f; }
                }
                float rm = fmaxf(c0[0], c1[0]);
#pragma unroll
                for (int r = 1; r < 16; ++r) rm = fmaxf(rm, fmaxf(c0[r], c1[r]));
                rm = xhalf_max(rm);
                if (__any(rm > 8.0f)) {
                    const float dl = fmaxf(rm, 0.f); mhat += dl;
#pragma unroll
                    for (int r = 0; r < 16; ++r) { c0[r] -= dl; c1[r] -= dl; }
                    const float f = __builtin_amdgcn_exp2f(-dl); lsum *= f;
                    if (hi == 0) wsf[r32] = f;
#pragma unroll
                    for (int r = 0; r < 16; ++r) { const float fr_ = wsf[crow(r, hi)]; o[0][r] *= fr_; o[1][r] *= fr_; }
                }
                float sacc = 0.f;
#pragma unroll
                for (int r = 0; r < 16; ++r) { c0[r] = __builtin_amdgcn_exp2f(c0[r]); c1[r] = __builtin_amdgcn_exp2f(c1[r]); sacc += c0[r] + c1[r]; }
                lsum += sacc;
                u32x4 pw[4];
#pragma unroll
                for (int k = 0; k < 2; ++k) {
                    pw[k] = (u32x4){cvtpk_s(c0[8 * k + 0], c0[8 * k + 1]), cvtpk_s(c0[8 * k + 2], c0[8 * k + 3]), cvtpk_s(c0[8 * k + 4], c0[8 * k + 5]), cvtpk_s(c0[8 * k + 6], c0[8 * k + 7])};
                    pw[2 + k] = (u32x4){cvtpk_s(c1[8 * k + 0], c1[8 * k + 1]), cvtpk_s(c1[8 * k + 2], c1[8 * k + 3]), cvtpk_s(c1[8 * k + 4], c1[8 * k + 5]), cvtpk_s(c1[8 * k + 6], c1[8 * k + 7])}; }
#pragma unroll
                for (int k = 0; k < 4; ++k) {
                    const s16x4 lo0 = vtr(vb + k * 1024), hi0 = vtr(vb + k * 1024 + 512), lo1 = vtr(vb + 4096 + k * 1024), hi1 = vtr(vb + 4096 + k * 1024 + 512);
                    o[0] = __builtin_amdgcn_mfma_f32_32x32x16_bf16(__builtin_bit_cast(bf16x8, pw[k]), (bf16x8){lo0[0], lo0[1], lo0[2], lo0[3], hi0[0], hi0[1], hi0[2], hi0[3]}, o[0], 0, 0, 0);
                    o[1] = __builtin_amdgcn_mfma_f32_32x32x16_bf16(__builtin_bit_cast(bf16x8, pw[k]), (bf16x8){lo1[0], lo1[1], lo1[2], lo1[3], hi1[0], hi1[1], hi1[2], hi1[3]}, o[1], 0, 0, 0); }
            }
            if (i + 1 < nt) { *(LAS u32x4*)(sm + DF_K + (cur ^ 1) * 8192 + tid * 16) = kst; *(LAS u32x4*)(sm + DF_V + (cur ^ 1) * 8192 + tid * 16) = vst; }
            __syncthreads();
        }
#undef SWA_ROW0
        const float inv = 1.0f / xhalf_sum(lsum);
        int lane_e = TIDX & 63;
        { const int r32e = lane_e & 31, hie = lane_e >> 5;
        LAS float* wse = (LAS float*)(sm + DF_WS) + wid * 64; LAS float* stge = (LAS float*)(sm + DF_ST) + wid * 2048;
        if (hie == 0) wse[r32e] = inv;
#pragma unroll
        for (int r = 0; r < 16; ++r) { const int q = crow(r, hie); const float i0 = wse[q]; stge[q * 64 + r32e] = o[0][r] * i0; stge[q * 64 + 32 + r32e] = o[1][r] * i0; } }
        LAS float* stg = (LAS float*)(sm + DF_ST) + wid * 2048;
#pragma unroll
        for (int i = 0; i < 4; ++i) { const int row = i * 8 + (lane_e >> 3), ch = lane_e & 7;
            const f32x4 v0 = *(const LAS f32x4*)(stg + row * 64 + ch * 8), v1 = *(const LAS f32x4*)(stg + row * 64 + ch * 8 + 4);
            u32x4 w; w.x = cvtpk_s(v0[0], v0[1]); w.y = cvtpk_s(v0[2], v0[3]); w.z = cvtpk_s(v1[0], v1[1]); w.w = cvtpk_s(v1[2], v1[3]);
            *(u32x4*)(O + (size_t)(qrow0 + wid * 32 + row) * DM + h * 64 + ch * 8) = w; }
    }
}

__device__ __forceinline__ void moe_offsets(const Params& p, int* offs  ) {
    if (TIDX < 2) { const unsigned* cw = (const unsigned*)p.ws + CW_CNT + TIDX * 8; int o = 0;
        for (int e = 0; e < 8; ++e) { offs[TIDX * 9 + e] = o; o += ((int)__hip_atomic_load(cw + e, __ATOMIC_RELAXED, __HIP_MEMORY_SCOPE_AGENT) + 255) & ~255; }
        offs[TIDX * 9 + 8] = o; }
    __syncthreads();
}
__device__ __forceinline__ void ph_moe_scatter(const Params& p, int bid, int nb, float* lds) {
    char* ws = p.ws; int* offs = (int*)lds; moe_offsets(p, offs);
    const int lane = TIDX & 63, wv = TIDX >> 6;
    const bf16_t* H = (const bf16_t*)(ws + OFF_ACT); bf16_t* AS = (bf16_t*)(ws + OFF_ASORT);
    int* tok = (int*)(ws + OFF_TOK); float* wgt = (float*)(ws + OFF_WGT); unsigned* cw = (unsigned*)ws;
    for (int r = bid * 8 + wv; r < NLAT; r += nb * 8) {
        const int4 rec = *(const int4*)(ws + OFF_ROUTE + (size_t)r * 16);
        for (int g = 0; g < 2; ++g) {
            const int e = g == 0 ? rec.x : rec.y; int pos = 0;
            if (lane == 0) { pos = offs[g * 9 + e] + (int)atomicAdd(cw + CW_CUR + g * 8 + e, 1u); tok[g * GRP_ROWS + pos] = r; wgt[g * GRP_ROWS + pos] = __int_as_float(g == 0 ? rec.z : rec.w); }
            pos = __shfl(pos, 0);
            const uint4* src = (const uint4*)(H + (size_t)r * DM); uint4* dst = (uint4*)(AS + ((size_t)g * GRP_ROWS + pos) * DM);
            dst[lane] = src[lane]; dst[64 + lane] = src[64 + lane];
        }
    }
}

__device__ __forceinline__ void ph_final(const Params& p, int bid, int nb) {
    const int lane = TIDX & 63, wv = TIDX >> 6;
    for (int r = bid * 8 + wv; r < NLAT; r += nb * 8) {
        float* xr = p.out + (size_t)r * DM; float4 v[4]; float ss = 0.f;
#pragma unroll
        for (int i = 0; i < 4; ++i) { v[i] = *(const float4*)(xr + i * 256 + lane * 4); ss += v[i].x * v[i].x + v[i].y * v[i].y + v[i].z * v[i].z + v[i].w * v[i].w; }
        ss = wave_sum(ss); const float rn = rsqrtf(ss * (1.0f / 1024.0f) + 1e-6f);
#pragma unroll
        for (int i = 0; i < 4; ++i) { const float4 g = *(const float4*)(p.final_norm + i * 256 + lane * 4);
            float4 o; o.x = v[i].x * rn * g.x; o.y = v[i].y * rn * g.y; o.z = v[i].z * rn * g.z; o.w = v[i].w * rn * g.w; *(float4*)(xr + i * 256 + lane * 4) = o; }
    }
}

struct EpiStoreBf16 {
    static constexpr bool PERM = true, AFTER_DRAIN = false; bf16_t* O; int ldc;
    __device__ __forceinline__ void operator()(const f32x4 (&acc)[2][2][4][2], const pg8::Unit& u, int wr, int wc, int fr, int fq) const {
        bf16_t* base = O + (size_t)(u.pm * 256 + wr * 64 + fr) * ldc + u.pn * 256 + wc * 32 + 8 * fq;
#pragma unroll
        for (int ai = 0; ai < 2; ++ai)
#pragma unroll
            for (int m = 0; m < 4; ++m) { bf16_t* rowp = base + (size_t)(ai * 128 + m * 16) * ldc;
#pragma unroll
                for (int bj = 0; bj < 2; ++bj) { const f32x4 v0 = acc[ai][bj][m][0], v1 = acc[ai][bj][m][1]; u32x4 w;
                    w.x = pg8::cvt_pk_bf16(v0[0], v0[1]); w.y = pg8::cvt_pk_bf16(v0[2], v0[3]); w.z = pg8::cvt_pk_bf16(v1[0], v1[1]); w.w = pg8::cvt_pk_bf16(v1[2], v1[3]);
                    *(u32x4*)(rowp + bj * 128) = w; } }
    }
};
struct EpiSwiglu {
    static constexpr bool PERM = true, AFTER_DRAIN = false; bf16_t* U; int ldu, npe;
    __device__ __forceinline__ void operator()(const f32x4 (&acc)[2][2][4][2], const pg8::Unit& u, int wr, int wc, int fr, int fq) const {
        bf16_t* base = U + (size_t)(u.pm * 256 + wr * 64 + fr) * ldu + (u.pn % npe) * 128 + wc * 32 + 8 * fq;
#pragma unroll
        for (int ai = 0; ai < 2; ++ai)
#pragma unroll
            for (int m = 0; m < 4; ++m) { float o[8];
#pragma unroll
                for (int n = 0; n < 2; ++n)
#pragma unroll
                    for (int i = 0; i < 4; ++i) o[n * 4 + i] = fast_silu(acc[ai][0][m][n][i]) * acc[ai][1][m][n][i];
                u32x4 w; w.x = pg8::cvt_pk_bf16(o[0], o[1]); w.y = pg8::cvt_pk_bf16(o[2], o[3]); w.z = pg8::cvt_pk_bf16(o[4], o[5]); w.w = pg8::cvt_pk_bf16(o[6], o[7]);
                *(u32x4*)(base + (size_t)(ai * 128 + m * 16) * ldu) = w; }
    }
};
struct EpiResidual {
    static constexpr bool PERM = false, AFTER_DRAIN = false; const float* xin; float* xout; float* xc; const float* gate;
    __device__ __forceinline__ void operator()(const f32x4 (&acc)[2][2][4][2], const pg8::Unit& u, int wr, int wc, int fr, int fq) const {
        const int cls = u.pm < 64 ? 0 : (u.pm < 128 ? 1 : 2), col0 = u.pn * 256 + wc * 32 + 4 * fq;
        const float* gv = gate + (size_t)cls * 6144 + col0;
        const float* bi = u.pm < 128 ? xin + (size_t)u.pm * 256 * DM : xc + (size_t)(u.pm - 128) * 256 * DM;
        float* bo = u.pm < 128 ? xout + (size_t)u.pm * 256 * DM : xc + (size_t)(u.pm - 128) * 256 * DM;
        f32x4 g4[2][2];
#pragma unroll
        for (int bj = 0; bj < 2; ++bj)
#pragma unroll
            for (int n = 0; n < 2; ++n) g4[bj][n] = *(const f32x4*)(gv + bj * 128 + n * 16);
#pragma unroll
        for (int ai = 0; ai < 2; ++ai)
#pragma unroll
            for (int m = 0; m < 4; ++m) { const size_t off = (size_t)(ai * 128 + wr * 64 + m * 16 + fr) * DM + col0;
#pragma unroll
                for (int bj = 0; bj < 2; ++bj)
#pragma unroll
                    for (int n = 0; n < 2; ++n) { const f32x4 xi = *(const f32x4*)(bi + off + bj * 128 + n * 16); *(f32x4*)(bo + off + bj * 128 + n * 16) = xi + g4[bj][n] * acc[ai][bj][m][n]; } }
    }
};
struct EpiMoeScatter {
    static constexpr bool PERM = false, AFTER_DRAIN = false; float* x; const float* gate; const int* tok; const float* wgt; int npe;
    __device__ __forceinline__ void operator()(const f32x4 (&acc)[2][2][4][2], const pg8::Unit& u, int wr, int wc, int fr, int fq) const {
        const int col0 = (u.pn % npe) * 256 + wc * 32 + 4 * fq;
#pragma unroll
        for (int ai = 0; ai < 2; ++ai)
#pragma unroll
            for (int m = 0; m < 4; ++m) { const int r = u.pm * 256 + ai * 128 + wr * 64 + m * 16 + fr; const int tk = tok[r];
                if (tk >= 0) { const float wv = wgt[r]; const float* gv = gate + (size_t)mod_class(tk) * 6144 + col0; float* xr = x + (size_t)tk * DM + col0;
#pragma unroll
                    for (int bj = 0; bj < 2; ++bj)
#pragma unroll
                        for (int n = 0; n < 2; ++n) { const f32x4 g4 = *(const f32x4*)(gv + bj * 128 + n * 16); f32x4* q = (f32x4*)(xr + bj * 128 + n * 16); *q = *q + g4 * wv * acc[ai][bj][m][n]; } } }
    }
};
struct MoeOrder : pg8::StaticOrder {
    int o1, o2, o3, o4, o5, o6, o7, npe;
    __device__ __forceinline__ bool next(int i, pg8::Unit& u) const {
        if (!pg8::StaticOrder::next(i, u)) return false;
        const int r = u.pm * 256; const int e = (r >= o1) + (r >= o2) + (r >= o3) + (r >= o4) + (r >= o5) + (r >= o6) + (r >= o7);
        u.pn += e * npe; return true;
    }
};
#define GEMM_LDS ((PG8_LAS unsigned char*)lds)
struct EpiInProj {
    static constexpr bool PERM = true, AFTER_DRAIN = false; bf16_t* O; const char* tab;
    __device__ __forceinline__ void operator()(const f32x4 (&acc)[2][2][4][2], const pg8::Unit& u, int wr, int wc, int fr, int fq) const {
        const int row0 = u.pm * 256 + wr * 64 + fr; const bool lat = u.pm < 128;
#pragma unroll
        for (int bj = 0; bj < 2; ++bj) {
            const int s = u.pn * 2 + bj;
            int mode = 0; float scale = 1.0f;
            if (s <= 1) { mode = 1; scale = 0.125f * 1.4426950408889634f; } else if (s == 2) mode = 1;
            else if (s == 4 || s == 5) mode = 2; else if (s == 6 || s == 7) { mode = 2; scale = 0.125f; }
            else if (s == 12 || s == 13) { mode = 3; scale = 0.17677669529663687f * 1.4426950408889634f; } else if (s == 14 || s == 15) mode = 3;
            if (mode == 0) {
                bf16_t* base = O + (size_t)row0 * DIN + s * 128 + wc * 32 + 8 * fq;
#pragma unroll
                for (int ai = 0; ai < 2; ++ai)
#pragma unroll
                    for (int m = 0; m < 4; ++m) { const f32x4 v0 = acc[ai][bj][m][0], v1 = acc[ai][bj][m][1]; u32x4 w;
                        w.x = pg8::cvt_pk_bf16(v0[0], v0[1]); w.y = pg8::cvt_pk_bf16(v0[2], v0[3]); w.z = pg8::cvt_pk_bf16(v1[0], v1[1]); w.w = pg8::cvt_pk_bf16(v1[2], v1[3]);
                        *(u32x4*)(base + (size_t)(ai * 128 + m * 16) * DIN) = w; }
            } else {
                const bool wide = mode != 3; const int half = wide ? 32 : 16, g = wide ? 4 * (wc & 1) + fq : fq;
                const int cbase = s * 128 + (wide ? 64 * (wc >> 1) : 32 * wc) + 4 * g;
                const float* ct = (const float*)(tab + (mode == 1 ? TAB_ATTN : (mode == 2 ? TAB_RET : TAB_DIFF))) + 4 * g; const int tstride = half, tsin = 16384 * half;
#pragma unroll
                for (int ai = 0; ai < 2; ++ai)
#pragma unroll
                    for (int m = 0; m < 4; ++m) { const int row = row0 + ai * 128 + m * 16; const f32x4 v0 = acc[ai][bj][m][0], v1 = acc[ai][bj][m][1];
                        f32x4 cs = {1.f, 1.f, 1.f, 1.f}, sn = {0.f, 0.f, 0.f, 0.f};
                        if (lat) { const float* tp = ct + (size_t)(row & (NSEQ - 1)) * tstride; cs = *(const f32x4*)tp; sn = *(const f32x4*)(tp + tsin); }
                        const f32x4 o1 = (v0 * cs - v1 * sn) * scale, o2 = (v1 * cs + v0 * sn) * scale;
                        bf16_t* op = O + (size_t)row * DIN + cbase;
                        uint2 w1, w2; w1.x = pg8::cvt_pk_bf16(o1[0], o1[1]); w1.y = pg8::cvt_pk_bf16(o1[2], o1[3]); w2.x = pg8::cvt_pk_bf16(o2[0], o2[1]); w2.y = pg8::cvt_pk_bf16(o2[2], o2[3]);
                        *(uint2*)op = w1; *(uint2*)(op + half) = w2; }
            }
        }
    }
};
__device__ __forceinline__ void ph_gemm_in(const Params& p, int l, int bid, int nb, float* lds) {
    char* ws = p.ws; pg8::Gemm g{(const bf16_t*)(ws + OFF_ACT), (const bf16_t*)(ws + OFF_WIN) + (size_t)l * DIN * DM, NROW, DIN, DM};
    pg8::StaticOrder S; S.init(NROW, DIN, nb, bid);
    EpiInProj E{(bf16_t*)(ws + OFF_P), ws + OFF_TAB};
    pg8::gemm_phase<EpiInProj, pg8::StaticOrder, true, true>(GEMM_LDS, g, S, E);
}
__device__ __forceinline__ void ph_gemm_out(const Params& p, int l, bool need_ctx, int bid, int nb, float* lds) {
    char* ws = p.ws; const int M = need_ctx ? NROW : NLAT;
    pg8::Gemm g{(const bf16_t*)(ws + OFF_ACT), (const bf16_t*)(ws + OFF_WOUT) + (size_t)l * DM * DM, M, DM, DM};
    pg8::StaticOrder S; S.init(M, DM, nb, bid);
    EpiResidual E{l == 0 ? p.x : p.out, p.out, (float*)(ws + OFF_XC), (const float*)(ws + OFF_MOD) + (size_t)l * 3 * 6144 + 2048};
    pg8::gemm_phase<EpiResidual, pg8::StaticOrder, true, true>(GEMM_LDS, g, S, E);
}
__device__ __forceinline__ void ph_ffn1(const Params& p, bool need_ctx, int bid, int nb, float* lds) {
    char* ws = p.ws; const int M = need_ctx ? NROW : NLAT;
    pg8::Gemm g{(const bf16_t*)(ws + OFF_ACT), (const bf16_t*)(ws + OFF_WF13), M, 2 * DFF, DM};
    pg8::StaticOrder S; S.init(M, 2 * DFF, nb, bid);
    EpiSwiglu E{(bf16_t*)(ws + OFF_P), DFF, 2 * DFF / 256};
    pg8::gemm_phase<EpiSwiglu, pg8::StaticOrder, true, true>(GEMM_LDS, g, S, E);
}
__device__ __forceinline__ void ph_ffn2(const Params& p, int l, bool need_ctx, int bid, int nb, float* lds) {
    char* ws = p.ws; const int M = need_ctx ? NROW : NLAT;
    pg8::Gemm g{(const bf16_t*)(ws + OFF_P), (const bf16_t*)(ws + OFF_WF2), M, DM, DFF};
    pg8::StaticOrder S; S.init(M, DM, nb, bid);
    EpiResidual E{p.out, p.out, (float*)(ws + OFF_XC), (const float*)(ws + OFF_MOD) + (size_t)l * 3 * 6144 + 5120};
    pg8::gemm_phase<EpiResidual, pg8::StaticOrder, true, true>(GEMM_LDS, g, S, E);
}
__device__ __forceinline__ MoeOrder moe_order(const int* og, int npe, int nb, int bid) {
    MoeOrder S; S.init(og[8], npe * 256, nb, bid); S.o1 = og[1]; S.o2 = og[2]; S.o3 = og[3]; S.o4 = og[4]; S.o5 = og[5]; S.o6 = og[6]; S.o7 = og[7]; S.npe = npe; return S;
}
__device__ __forceinline__ void ph_moe1(const Params& p, int g, int bid, int nb, float* lds) {
    char* ws = p.ws; int* offs = (int*)(lds + 32768); __syncthreads(); moe_offsets(p, offs);
    const MoeOrder S = moe_order(offs + g * 9, 2 * DFE / 256, nb, bid);
    pg8::Gemm gm{(const bf16_t*)(ws + OFF_ASORT) + (size_t)g * GRP_ROWS * DM, (const bf16_t*)(ws + OFF_WM13), 0, 0, DM};
    EpiSwiglu E{(bf16_t*)(ws + OFF_UMOE), DFE, 2 * DFE / 256};
    pg8::gemm_phase<EpiSwiglu, MoeOrder, true, true>(GEMM_LDS, gm, S, E);
}
__device__ __forceinline__ void ph_moe2(const Params& p, int l, int g, int bid, int nb, float* lds) {
    char* ws = p.ws; int* offs = (int*)(lds + 32768); __syncthreads(); moe_offsets(p, offs);
    const MoeOrder S = moe_order(offs + g * 9, DM / 256, nb, bid);
    pg8::Gemm gm{(const bf16_t*)(ws + OFF_UMOE), (const bf16_t*)(ws + OFF_WM2), 0, 0, DFE};
    EpiMoeScatter E{p.out, (const float*)(ws + OFF_MOD) + (size_t)l * 3 * 6144 + 5120, (const int*)(ws + OFF_TOK) + g * GRP_ROWS, (const float*)(ws + OFF_WGT) + g * GRP_ROWS, DM / 256};
    pg8::gemm_phase<EpiMoeScatter, MoeOrder, true, true>(GEMM_LDS, gm, S, E);
}

#define XB_TMO      128
#define XB_XCNT(j)  (256  + 64 * (j))
#define XB_XSUB(j)  (1280 + 64 * (j))
#define XB_XGEN(j)  (2304 + 64 * (j))
#define XB_TOP      3328
#define XB_TOPGEN   3392
#define XCD_BAR_WORDS 3456
#define XB_SPIN_CAP (1u << 22)

__device__ __forceinline__ unsigned xb_ld(unsigned* p)              { return __hip_atomic_load(p, __ATOMIC_RELAXED, __HIP_MEMORY_SCOPE_AGENT); }
__device__ __forceinline__ unsigned xb_add(unsigned* p, unsigned v) { return __hip_atomic_fetch_add(p, v, __ATOMIC_RELAXED, __HIP_MEMORY_SCOPE_AGENT); }
__device__ __forceinline__ unsigned xb_xcc_id() { return (unsigned)__builtin_amdgcn_s_getreg((3 << 11) | 20) & 0xFu; }
#define XB_SPIN(cond, bar) do { unsigned _sp = 0; while (cond) { __builtin_amdgcn_s_sleep(1); \
    if ((++_sp & 255u) == 0u) { if (xb_ld(&(bar)[XB_TMO])) break; if (_sp > XB_SPIN_CAP) { atomicAdd(&(bar)[XB_TMO], 1u); break; } } } } while (0)

struct XcdBarrier {
    unsigned* bar; unsigned x;
    volatile LAS unsigned* st;
};

__device__ __forceinline__ XcdBarrier xcd_barrier_post(unsigned* bar, volatile LAS unsigned* st) {
    XcdBarrier b; b.bar = bar; b.x = xb_xcc_id(); b.st = st;
    if (threadIdx.x == 0) (void)xb_add(&bar[XB_XCNT(b.x)], 1u);
    return b;
}
__device__ __forceinline__ void xcd_barrier_complete(unsigned* bar, unsigned x, unsigned& nloc, unsigned& nx) {
    const unsigned G = gridDim.x * gridDim.y * gridDim.z;
    unsigned sum, cnt, mine, sp = 0u;
    for (;;) {
        sum = 0u; cnt = 0u; mine = 0u;
#pragma unroll
        for (unsigned j = 0; j < 16; ++j) { const unsigned c = xb_ld(&bar[XB_XCNT(j)]); sum += c; cnt += (c > 0u) ? 1u : 0u; mine = (j == x) ? c : mine; }
        if (sum == G) break;
        __builtin_amdgcn_s_sleep(1);
        if ((++sp & 255u) == 0u) { if (xb_ld(&bar[XB_TMO])) break; if (sp > XB_SPIN_CAP) { atomicAdd(&bar[XB_TMO], 1u); break; } }
    }
    nloc = mine > 0u ? mine : 1u; nx = cnt > 0u ? cnt : 1u;
}

__device__ __forceinline__ void xcd_barrier(const XcdBarrier& b) {
    asm volatile("s_waitcnt vmcnt(0)" ::: "memory");
    __syncthreads();
    if (threadIdx.x == 0) {
        unsigned* bar = b.bar;
        __builtin_amdgcn_s_waitcnt(0);
        unsigned nloc = b.st[0], nx = b.st[1];
        if (nloc == 0u) { xcd_barrier_complete(bar, b.x, nloc, nx); b.st[0] = nloc; b.st[1] = nx; }
        const unsigned old = xb_add(&bar[XB_XSUB(b.x)], 1u);
        const unsigned gen = old / nloc;
        if (old + 1u == (gen + 1u) * nloc) {
            __builtin_amdgcn_fence(__ATOMIC_RELEASE, "agent");
            asm volatile("s_waitcnt vmcnt(0)" ::: "memory");
            const unsigned og = xb_add(&bar[XB_TOP], 1u);
            const unsigned tg = og / nx;
            if (og + 1u == (tg + 1u) * nx) xb_add(&bar[XB_TOPGEN], 1u);
            else XB_SPIN(xb_ld(&bar[XB_TOPGEN]) == tg, bar);
            __builtin_amdgcn_fence(__ATOMIC_ACQUIRE, "agent");
            xb_add(&bar[XB_XGEN(b.x)], 1u);
            asm volatile("s_waitcnt vmcnt(0)" ::: "memory");
        } else {
            XB_SPIN(xb_ld(&bar[XB_XGEN(b.x)]) == gen, bar);
            __builtin_amdgcn_fence(__ATOMIC_ACQUIRE, "agent");
            asm volatile("s_waitcnt vmcnt(0)" ::: "memory");
        }
    }
    __syncthreads();
}


constexpr int LDS_FLOATS = 33792;
constexpr int LDS_BYTES = LDS_FLOATS * 4 + 16 + 256;

typedef const __attribute__((address_space(4))) unsigned long long* kargp_t;
typedef __attribute__((address_space(1))) const float* gcf_t;
__device__ __forceinline__ Params load_params(const float* lds) {
    const LAS unsigned* tbl = (const LAS unsigned*)(lds + LDS_FLOATS + 4);
    Params p; const float** f = (const float**)&p;
#pragma unroll
    for (int i = 0; i < (int)(sizeof(Params) / 8); ++i) {
        const unsigned lo = __builtin_amdgcn_readfirstlane(tbl[2 * i]), hi = __builtin_amdgcn_readfirstlane(tbl[2 * i + 1]);
        f[i] = (const float*)(gcf_t)(((unsigned long long)hi << 32) | lo); }
    return p;
}
#define LOADP(name) const Params name = load_params(lds)

template <int l>
__device__ __forceinline__ void run_layer(const XcdBarrier& bar, int bid, int nb, float* lds) {
    constexpr bool need_ctx = l == 0;
    constexpr float lam_init = l == 0 ? 0.2f : 0.35550906759509393f;
    { LOADP(p); ph_norm<false>(p, l, 0, NROW, bid, nb); } xcd_barrier(bar);
    { LOADP(p); ph_gemm_in(p, l, bid, nb, lds); } xcd_barrier(bar);
    { LOADP(p); ph_ret_summ(p, l, bid, nb, lds); } { LOADP(p); ph_lru_chunk<1>(p, l, bid, nb, lds, 0); } xcd_barrier(bar);
    { LOADP(p); ph_scan2(p, l, bid, nb); } xcd_barrier(bar);
    { LOADP(p); ph_diff(p, l, need_ctx, lam_init, bid, nb, lds); }
    { LOADP(p); ph_swa(p, l, need_ctx, bid, nb, lds); }
    { LOADP(p); ph_ret_out(p, l, bid, nb, lds, need_ctx ? 0 : 2); }
    { LOADP(p); ph_lru_chunk<3>(p, l, bid, nb, lds, need_ctx ? 0 : 2); } xcd_barrier(bar);
    { LOADP(p); ph_gemm_out(p, l, need_ctx, bid, nb, lds); } xcd_barrier(bar);
    if (l == 0) {
        { LOADP(p); ph_norm<false>(p, l, 1, NROW, bid, nb); } xcd_barrier(bar);
        { LOADP(p); ph_ffn1(p, need_ctx, bid, nb, lds); } xcd_barrier(bar);
        { LOADP(p); ph_ffn2(p, l, need_ctx, bid, nb, lds); } xcd_barrier(bar);
    } else {
        { LOADP(p); ph_norm<true>(p, l, 1, NLAT, bid, nb); } xcd_barrier(bar);
        { LOADP(p); ph_moe_scatter(p, bid, nb, lds); } xcd_barrier(bar);
        { LOADP(p); ph_moe1(p, 0, bid, nb, lds); } xcd_barrier(bar);
        { LOADP(p); ph_moe2(p, l, 0, bid, nb, lds); } xcd_barrier(bar);
        { LOADP(p); ph_moe1(p, 1, bid, nb, lds); } xcd_barrier(bar);
        { LOADP(p); ph_moe2(p, l, 1, bid, nb, lds); } xcd_barrier(bar);
    }
}

__global__ void __launch_bounds__(512, 2) fwd(Params p_in) {
    extern __shared__ __attribute__((aligned(16))) float lds[];
    volatile LAS unsigned* st = (volatile LAS unsigned*)(lds + LDS_FLOATS);
    if (threadIdx.x == 0) { st[0] = 0u; st[1] = 0u; st[2] = 0u; st[3] = 0u; }
    if (threadIdx.x < (int)(sizeof(Params) / 8)) { const kargp_t q = (kargp_t)__builtin_amdgcn_kernarg_segment_ptr(); ((LAS unsigned long long*)(lds + LDS_FLOATS + 4))[threadIdx.x] = q[threadIdx.x]; }
    __syncthreads();
    XcdBarrier bar;
    { LOADP(p); bar = xcd_barrier_post((unsigned*)p.ws, st); }
    const int bid = blockIdx.x, nb = gridDim.x;
    { LOADP(p); ph_prologue(p, bid, nb, lds); } xcd_barrier(bar);
    run_layer<0>(bar, bid, nb, lds);
    run_layer<1>(bar, bid, nb, lds);
    { LOADP(p); ph_final(p, bid, nb); }
}

extern "C" void kernel_launch(void* const* d_in, const int* in_sizes, int n_in, void* d_out, int out_size, void* d_ws, size_t ws_size, hipStream_t stream) {
    static int grid = 0;
    if (grid == 0) {
        if (n_in < 30 || ws_size < WS_NEED) { fprintf(stderr, "kernel_launch: bad args n_in=%d ws=%zu need=%zu\n", n_in, ws_size, (size_t)WS_NEED); grid = -1; return; }
        int dev = 0, cus = 0, per_cu = 0;
        if (hipGetDevice(&dev) != hipSuccess || hipDeviceGetAttribute(&cus, hipDeviceAttributeMultiprocessorCount, dev) != hipSuccess) { grid = -1; return; }
        if (hipFuncSetAttribute((const void*)fwd, hipFuncAttributeMaxDynamicSharedMemorySize, LDS_BYTES) != hipSuccess) { fprintf(stderr, "kernel_launch: hipFuncSetAttribute failed\n"); grid = -1; return; }
        if (hipOccupancyMaxActiveBlocksPerMultiprocessor(&per_cu, (const void*)fwd, 512, LDS_BYTES) != hipSuccess || per_cu < 1) { fprintf(stderr, "kernel_launch: occupancy query says %d\n", per_cu); per_cu = 1; }
        (void)hipGetLastError();
        grid = cus;
    }
    if (grid < 0) return;
    Params p{};
    const float** f = (const float**)&p;
    for (int i = 0; i < 30; ++i) f[i] = (const float*)d_in[i];
    p.out = (float*)d_out; p.ws = (char*)d_ws;
    (void)hipMemsetAsync(d_ws, 0, 65536, stream);
    hipLaunchKernelGGL(fwd, dim3(grid), dim3(512), LDS_BYTES, stream, p);
}
```

```cpp
#include <hip/hip_runtime.h>
#include <cstdio>
#include <cstdint>

typedef unsigned short bf16_t;
typedef short bf16x8 __attribute__((ext_vector_type(8)));
typedef float f32x4 __attribute__((ext_vector_type(4)));
typedef unsigned u32x4 __attribute__((ext_vector_type(4)));
#define LAS __attribute__((address_space(3)))

constexpr int NB = 2, NSEQ = 16384, NCTX = 256, DM = 1024;
constexpr int NLAT = NB * NSEQ;
constexpr int NCR = NB * NCTX;
constexpr int NROW = NLAT + NCR;
constexpr int DIN = 2816, DFF = 2816, DFE = 3584, NE = 8;
constexpr int NCI = 130;
constexpr int C_AQ = 0, C_AK = 256, C_AV = 384, C_RQ = 512, C_RK = 768, C_RV = 1024, C_RG = 1280, C_DQ = 1536, C_DK = 1792, C_DV = 2048, C_LX = 2304, C_LY = 2560;
constexpr int GRP_ROWS = 34816;

constexpr size_t al256(size_t x) { return (x + 255) & ~(size_t)255; }
constexpr size_t OFF_CTRL = 0;
constexpr size_t OFF_MOD = 65536;
constexpr size_t OFF_TAB = al256(OFF_MOD + 2 * 3 * 6144 * 4);
constexpr size_t TAB_ATTN = 0, TAB_RET = 4u << 20, TAB_DIFF = 8u << 20;
constexpr size_t OFF_XC = al256(OFF_TAB + (10u << 20));
constexpr size_t OFF_ROUTE = al256(OFF_XC + (size_t)NCR * DM * 4);
constexpr size_t OFF_TOK = al256(OFF_ROUTE + (size_t)NLAT * 16);
constexpr size_t OFF_WGT = al256(OFF_TOK + (size_t)2 * GRP_ROWS * 4);
constexpr size_t OFF_LRU = al256(OFF_WGT + (size_t)2 * GRP_ROWS * 4);
constexpr size_t OFF_WM13 = al256(OFF_LRU + (size_t)3 * 2 * 2 * NCI * 256 * 4);
constexpr size_t OFF_WM2 = al256(OFF_WM13 + (size_t)NE * 2 * DFE * DM * 2);
constexpr size_t OFF_R = al256(OFF_WM2 + (size_t)NE * DM * DFE * 2);
constexpr size_t OFF_P = OFF_R;
constexpr size_t OFF_ACT = al256(OFF_P + (size_t)NROW * DIN * 2);
constexpr size_t OFF_RET = al256(OFF_ACT + (size_t)NROW * DM * 2);
constexpr size_t OFF_WIN = al256(OFF_RET + (size_t)2 * 2 * NCI * 4 * 4096 * 4);
constexpr size_t OFF_WOUT = al256(OFF_WIN + (size_t)2 * DIN * DM * 2);
constexpr size_t OFF_WF13 = al256(OFF_WOUT + (size_t)2 * DM * DM * 2);
constexpr size_t OFF_WF2 = al256(OFF_WF13 + (size_t)2 * DFF * DM * 2);
constexpr size_t OFF_R_END1 = al256(OFF_WF2 + (size_t)DM * DFF * 2);
constexpr size_t OFF_ASORT = OFF_R;
constexpr size_t OFF_UMOE = al256(OFF_ASORT + (size_t)2 * GRP_ROWS * DM * 2);
constexpr size_t OFF_R_END2 = al256(OFF_UMOE + (size_t)GRP_ROWS * DFE * 2);
constexpr size_t WS_NEED = OFF_R_END1 > OFF_R_END2 ? OFF_R_END1 : OFF_R_END2;
static_assert(OFF_ACT >= OFF_UMOE, "H2 must not overlap A_sorted");
constexpr int CW_CNT = 4096;
constexpr int CW_BLK = 8192;

struct Params {
    const float *x, *c, *ctx, *c_ctx, *w_ada, *b_ada, *g1, *g2, *w_in, *w_out, *sink, *ret_logit, *ret_gn, *diff_lam, *diff_gn,
        *conv_w, *conv_b, *lru_wa, *lru_ba, *lru_wx, *lru_bx, *lru_lam, *ffn_w1, *ffn_w3, *ffn_w2, *moe_router, *moe_w1, *moe_w3, *moe_w2, *final_norm;
    float* out; char* ws;
};

__device__ __forceinline__ int ltid_() { int t = threadIdx.x; asm volatile("" : "+v"(t)); return t; }
#define TIDX ltid_()
__device__ __forceinline__ float bf2f(bf16_t h) { return __uint_as_float(((unsigned)h) << 16); }
__device__ __forceinline__ bf16_t f2bf(float f) { unsigned u = __float_as_uint(f); u += 0x7fffu + ((u >> 16) & 1u); return (bf16_t)(u >> 16); }
__device__ __forceinline__ unsigned pack2(float lo, float hi) { return (unsigned)f2bf(lo) | ((unsigned)f2bf(hi) << 16); }
__device__ __forceinline__ float wave_sum(float v) {
#pragma unroll
    for (int o = 32; o >= 1; o >>= 1) v += __shfl_xor(v, o);
    return v;
}
__device__ __forceinline__ float sigmoidf_(float x) { return 1.0f / (1.0f + __expf(-x)); }
__device__ __forceinline__ float siluf_(float x) { return x / (1.0f + __expf(-x)); }
__device__ __forceinline__ float fast_silu(float v) { return v * __builtin_amdgcn_rcpf(1.0f + __expf(-v)); }
__device__ __forceinline__ float softplusf_(float x) { return x > 20.f ? x : log1pf(expf(x)); }
__device__ __forceinline__ float gelu_tanh(float x) { const float u = 0.7978845608028654f * (x + 0.044715f * x * x * x); return x * __builtin_amdgcn_rcpf(1.0f + __expf(-2.0f * u)); }
__device__ __forceinline__ int row_base(int b, int ci) { return ci < 2 ? NLAT + b * NCTX + ci * 128 : b * NSEQ + (ci - 2) * 128; }
__device__ __forceinline__ int mod_class(int row) { return row < NSEQ ? 0 : (row < NLAT ? 1 : 2); }

typedef float f32x16 __attribute__((ext_vector_type(16)));
typedef short s16x4 __attribute__((ext_vector_type(4)));
typedef short v4i16_t __attribute__((ext_vector_type(4)));
typedef float f32x2_t __attribute__((ext_vector_type(2)));
typedef __bf16 bf16x2_t __attribute__((ext_vector_type(2)));
__device__ __forceinline__ unsigned cvtpk_s(float lo, float hi) { f32x2_t v = {lo, hi}; bf16x2_t bb = __builtin_convertvector(v, bf16x2_t); return __builtin_bit_cast(unsigned, bb); }
__device__ __forceinline__ int crow(int r, int hi) { return (r & 3) + 8 * (r >> 2) + 4 * hi; }
__device__ __forceinline__ s16x4 vtr(const LAS char* p) { return __builtin_bit_cast(s16x4, __builtin_amdgcn_ds_read_tr16_b64_v4i16((LAS v4i16_t*)p)); }
__device__ __forceinline__ float bfs(short s) { return __uint_as_float(((unsigned)(unsigned short)s) << 16); }

__device__ __forceinline__ void convert_tile(const float* src, int K, int N, bf16_t* dst, int tile, int mode, float* lds) {
    const int tpn = N / 64, tk = tile / tpn, tn = tile % tpn, t = TIDX;
    {   const int kk = t >> 3, nc = (t & 7) * 8;
        const float4 a = *(const float4*)(src + (size_t)(tk * 64 + kk) * N + tn * 64 + nc);
        const float4 b = *(const float4*)(src + (size_t)(tk * 64 + kk) * N + tn * 64 + nc + 4);
        float* d = lds + kk * 65 + nc; d[0] = a.x; d[1] = a.y; d[2] = a.z; d[3] = a.w; d[4] = b.x; d[5] = b.y; d[6] = b.z; d[7] = b.w; }
    __syncthreads();
    {   const int n = t >> 3, kc = (t & 7) * 8, ng = tn * 64 + n;
        int nrow;
        if (mode == 3) {
            const int s = ng >> 7; const bool r64 = s <= 2 || (s >= 4 && s <= 7), r32 = s >= 12 && s <= 15;
            if (r64) { const int d = ng & 63; nrow = (ng & ~63) + 8 * ((d & 31) >> 2) + 4 * (d >> 5) + (d & 3); }
            else if (r32) { const int d = ng & 31; nrow = (ng & ~31) + 8 * ((d & 15) >> 2) + 4 * (d >> 4) + (d & 3); }
            else nrow = ng;
        } else nrow = mode == 0 ? ng : ((ng >> 7) * 256 + (mode == 2 ? 128 : 0) + (ng & 127));
        uint4 w; w.x = pack2(lds[(kc + 0) * 65 + n], lds[(kc + 1) * 65 + n]); w.y = pack2(lds[(kc + 2) * 65 + n], lds[(kc + 3) * 65 + n]);
        w.z = pack2(lds[(kc + 4) * 65 + n], lds[(kc + 5) * 65 + n]); w.w = pack2(lds[(kc + 6) * 65 + n], lds[(kc + 7) * 65 + n]);
        *(uint4*)(dst + (size_t)nrow * K + tk * 64 + kc) = w; }
    __syncthreads();
}

__device__ __forceinline__ void ph_prologue(const Params& p, int bid, int nb, float* lds) {
    char* ws = p.ws; const int t = TIDX;
    {
        struct Job { const float* src; bf16_t* dst; int K, N, mode, base; };
        Job* jobs = (Job*)(lds + 64 * 65 + 3);
        const int T_IN = 16 * 44, T_OUT = 16 * 16, T_F13 = 16 * 44, T_F2 = 44 * 16, T_M13 = 16 * 56, T_M2 = 56 * 16;
        const int total = 2 * T_IN + 2 * T_OUT + 2 * T_F13 + T_F2 + 16 * T_M13 + 8 * T_M2;
        if (t < 32) {
            Job jb; jb.src = nullptr; jb.dst = nullptr; jb.K = DM; jb.N = DM; jb.mode = 0; jb.base = total;
            if (t < 2) { jb.src = p.w_in + (size_t)t * DM * DIN; jb.dst = (bf16_t*)(ws + OFF_WIN) + (size_t)t * DIN * DM; jb.N = DIN; jb.mode = 3; jb.base = t * T_IN; }
            else if (t < 4) { jb.src = p.w_out + (size_t)(t - 2) * DM * DM; jb.dst = (bf16_t*)(ws + OFF_WOUT) + (size_t)(t - 2) * DM * DM; jb.base = 2 * T_IN + (t - 2) * T_OUT; }
            else if (t < 6) { jb.src = t == 4 ? p.ffn_w1 : p.ffn_w3; jb.dst = (bf16_t*)(ws + OFF_WF13); jb.N = DFF; jb.mode = t - 3; jb.base = 2 * T_IN + 2 * T_OUT + (t - 4) * T_F13; }
            else if (t == 6) { jb.src = p.ffn_w2; jb.dst = (bf16_t*)(ws + OFF_WF2); jb.K = DFF; jb.base = 2 * T_IN + 2 * T_OUT + 2 * T_F13; }
            else if (t < 23) { const int q = t - 7, e = q & 7, w3 = q >> 3; jb.src = (w3 ? p.moe_w3 : p.moe_w1) + (size_t)e * DM * DFE; jb.dst = (bf16_t*)(ws + OFF_WM13) + (size_t)e * 2 * DFE * DM; jb.N = DFE; jb.mode = 1 + w3;
                jb.base = 2 * T_IN + 2 * T_OUT + 2 * T_F13 + T_F2 + q * T_M13; }
            else if (t < 31) { const int e = t - 23; jb.src = p.moe_w2 + (size_t)e * DFE * DM; jb.dst = (bf16_t*)(ws + OFF_WM2) + (size_t)e * DM * DFE; jb.K = DFE;
                jb.base = 2 * T_IN + 2 * T_OUT + 2 * T_F13 + T_F2 + 16 * T_M13 + e * T_M2; }
            jobs[t] = jb;
        }
        __syncthreads();
        int j = 0;
        for (int u = bid; u < total; u += nb) {
            while (u >= jobs[j + 1].base) ++j;
            const Job jb = jobs[j];
            convert_tile(jb.src, jb.K, jb.N, jb.dst, u - jb.base, jb.mode, lds);
        }
        __syncthreads();
    }
    {
        float* sv = lds;
        float* red = lds + 3072;
        for (int i = t; i < 3072; i += 512) { const int v = i >> 10, k = i & 1023; const float cv = v < 2 ? p.c[v * DM + k] : p.c_ctx[k]; sv[i] = siluf_(cv); }
        __syncthreads();
        float* mod = (float*)(ws + OFF_MOD);
        for (int u = bid; u < 2 * 96; u += nb) {
            const int l = u / 96, j0 = (u % 96) * 64, j = t & 63, kg = t >> 6;
            float a0 = 0.f, a1 = 0.f, a2 = 0.f;
            const float* w = p.w_ada + (size_t)l * DM * 6144 + j0 + j;
            for (int k = kg * 128; k < kg * 128 + 128; ++k) { const float wv = w[(size_t)k * 6144]; a0 += sv[k] * wv; a1 += sv[1024 + k] * wv; a2 += sv[2048 + k] * wv; }
            red[(kg * 3 + 0) * 64 + j] = a0; red[(kg * 3 + 1) * 64 + j] = a1; red[(kg * 3 + 2) * 64 + j] = a2;
            __syncthreads();
            if (t < 192) { const int v = t >> 6; float s = 0.f;
                for (int g = 0; g < 8; ++g) s += red[(g * 3 + v) * 64 + j];
                mod[((size_t)l * 3 + v) * 6144 + j0 + j] = s + p.b_ada[l * 6144 + j0 + j]; }
            __syncthreads();
        }
    }
    {
        const int gt = bid * 512 + t, gs = nb * 512;
        float* ta = (float*)(ws + OFF_TAB + TAB_ATTN); float* tr = (float*)(ws + OFF_TAB + TAB_RET); float* td = (float*)(ws + OFF_TAB + TAB_DIFF);
        for (int i = gt; i < 16384 * 32; i += gs) { const int n = i >> 5, j = i & 31;
            { const float inv = (float)pow(10000.0, -(double)j / 32.0); const float ang = (float)n * inv; tr[i] = (float)cos((double)ang); tr[16384 * 32 + i] = (float)sin((double)ang); }
            { const float inv = (float)pow(10000.0, -(double)(j & 15) / 16.0); const float ang = (float)(j < 16 ? (n >> 6) : (n & 63)) * inv; ta[i] = (float)cos((double)ang); ta[16384 * 32 + i] = (float)sin((double)ang); }
            if (j < 16) { const float inv = (float)pow(10000.0, -(double)(j & 7) / 8.0); const float ang = (float)(j < 8 ? (n >> 6) : (n & 63)) * inv; td[n * 16 + j] = (float)cos((double)ang); td[16384 * 16 + n * 16 + j] = (float)sin((double)ang); } }
        float* xc = (float*)(ws + OFF_XC);
        for (int i = gt; i < NCR * DM / 4; i += gs) ((float4*)xc)[i] = ((const float4*)p.ctx)[i];
        int* tok = (int*)(ws + OFF_TOK);
        for (int i = gt; i < 2 * GRP_ROWS; i += gs) tok[i] = -1;
    }
}

template <bool ROUTE>
__device__ __forceinline__ void ph_norm(const Params& p, int l, int which  , int nrows, int bid, int nb, float* lds) {
    char* ws = p.ws; const int lane = TIDX & 63, wv = TIDX >> 6;
    LAS unsigned* lcnt = (LAS unsigned*)lds;
    if (ROUTE) { __syncthreads(); if (TIDX < 16) lcnt[TIDX] = 0u; __syncthreads(); }
    const float* mod = (const float*)(ws + OFF_MOD) + (size_t)l * 3 * 6144;
    const float* g = (which == 0 ? p.g1 : p.g2) + l * DM;
    bf16_t* H = (bf16_t*)(ws + OFF_ACT);
    const float* xl = (which == 0 && l == 0) ? p.x : p.out;
    const float* xc = (const float*)(ws + OFF_XC);
    for (int r = bid * 8 + wv; r < nrows; r += nb * 8) {
        const float* xr = r < NLAT ? xl + (size_t)r * DM : xc + (size_t)(r - NLAT) * DM;
        const float* mv = mod + (size_t)mod_class(r) * 6144 + (which == 0 ? 0 : 3072);
        float4 v[4]; float ss = 0.f;
#pragma unroll
        for (int i = 0; i < 4; ++i) { v[i] = *(const float4*)(xr + i * 256 + lane * 4); ss += v[i].x * v[i].x + v[i].y * v[i].y + v[i].z * v[i].z + v[i].w * v[i].w; }
        ss = wave_sum(ss);
        const float rn = rsqrtf(ss * (1.0f / 1024.0f) + 1e-6f);
        float lg[8];
        if (ROUTE) {
#pragma unroll
            for (int e = 0; e < 8; ++e) lg[e] = 0.f;
        }
#pragma unroll
        for (int i = 0; i < 4; ++i) {
            const int c = i * 256 + lane * 4;
            const float4 gg = *(const float4*)(g + c), sh = *(const float4*)(mv + c), sc = *(const float4*)(mv + 1024 + c);
            float h0 = v[i].x * rn * gg.x * (1.f + sc.x) + sh.x, h1 = v[i].y * rn * gg.y * (1.f + sc.y) + sh.y;
            float h2 = v[i].z * rn * gg.z * (1.f + sc.z) + sh.z, h3 = v[i].w * rn * gg.w * (1.f + sc.w) + sh.w;
            uint2 w; w.x = pack2(h0, h1); w.y = pack2(h2, h3);
            *(uint2*)(H + (size_t)r * DM + c) = w;
            if (ROUTE) {
                const float* rt = p.moe_router + (size_t)c * 8;
#pragma unroll
                for (int e = 0; e < 8; ++e) lg[e] += h0 * rt[e] + h1 * rt[8 + e] + h2 * rt[16 + e] + h3 * rt[24 + e];
            }
        }
        if (ROUTE) {
#pragma unroll
            for (int e = 0; e < 8; ++e) lg[e] = wave_sum(lg[e]);
            if (lane == 0 && r < NLAT) {
                int e0 = 0; float v0 = lg[0];
#pragma unroll
                for (int e = 1; e < 8; ++e) if (lg[e] > v0) { v0 = lg[e]; e0 = e; }
                int e1 = -1; float v1 = -3.0e38f;
#pragma unroll
                for (int e = 0; e < 8; ++e) if (e != e0 && lg[e] > v1) { v1 = lg[e]; e1 = e; }
                const float ex = __expf(v1 - v0), w0 = 1.0f / (1.0f + ex), w1 = ex / (1.0f + ex);
                const unsigned li0 = __hip_atomic_fetch_add(lcnt + e0, 1u, __ATOMIC_RELAXED, __HIP_MEMORY_SCOPE_WORKGROUP), li1 = __hip_atomic_fetch_add(lcnt + 8 + e1, 1u, __ATOMIC_RELAXED, __HIP_MEMORY_SCOPE_WORKGROUP);
                int4 rec; rec.x = e0 | (int)(li0 << 4); rec.y = e1 | (int)(li1 << 4); rec.z = __float_as_int(w0); rec.w = __float_as_int(w1);
                *(int4*)(ws + OFF_ROUTE + (size_t)r * 16) = rec;
            }
        }
    }
    if (ROUTE) {
        __syncthreads();
        if (TIDX < 16) { unsigned* cw = (unsigned*)ws; const int t = TIDX; cw[CW_BLK + bid * 16 + t] = atomicAdd(cw + CW_CNT + t, lcnt[t]); }
    }
}

namespace pg8 {
#define PG8_LAS __attribute__((address_space(3)))
typedef unsigned short bf16_t;
typedef short bf16x8 __attribute__((ext_vector_type(8)));
typedef float f32x4 __attribute__((ext_vector_type(4)));
typedef unsigned u32x4 __attribute__((ext_vector_type(4)));
constexpr int BM = 256, BK = 64, HALF = 128, HTB = HALF * BK * 2  , STAGE_BYTES = 8 * HTB, NXCD = 8, WGM = 8;

__host__ __device__ __forceinline__ int lds_byte(int r, int c) { const int st = (r >> 4) * 2 + (c >> 5), rr = r & 15, cc = c & 31, ob = rr * 64 + cc * 2; return st * 1024 + (ob ^ (((ob >> 9) & 1) << 5)); }
__host__ __device__ __forceinline__ void stage_rc(int b, int& R, int& C) { const int st = b / 1024, sb = b % 1024, swz = sb ^ (((sb >> 9) & 1) << 5); R = (st >> 1) * 16 + swz / 64; C = (st & 1) * 32 + (swz % 64) / 2; }
__host__ __device__ __forceinline__ int perm32(int rho) { const int n = rho >> 4, i = rho & 15; return 8 * (i >> 2) + 4 * n + (i & 3); }

struct Unit { int pm, pn; };
struct Gemm { const bf16_t* A; const bf16_t* Bt; int M, N, K; };

struct StaticOrder {
    int nM, nN, nwg, G, c;
    __host__ __device__ void init(int M, int N, int G_, int c_) { nM = M / BM; nN = N / BM; nwg = nM * nN; G = G_; c = c_; }
    __host__ __device__ bool next(int i, Unit& u) const {
        const long L = (long)i * G + c; if (L >= nwg) return false;
        int wgid = (int)L; { const int q = nwg / NXCD, r = nwg % NXCD, xcd = wgid % NXCD, off = wgid / NXCD; wgid = (xcd < r ? xcd * (q + 1) : r * (q + 1) + (xcd - r) * q) + off; }
        const int nig = WGM * nN, gid = wgid / nig, fm = gid * WGM, gsz = (nM - fm) < WGM ? (nM - fm) : WGM;
        u.pm = fm + ((wgid % nig) % gsz); u.pn = (wgid % nig) / gsz; return true;
    }
    __device__ __forceinline__ void a_ready(const Unit&) const {}
    __device__ __forceinline__ void done(const Unit&) const {}
};
__device__ __forceinline__ unsigned cvt_pk_bf16(float lo, float hi) { unsigned r; asm volatile("v_cvt_pk_bf16_f32 %0, %1, %2" : "=v"(r) : "v"(lo), "v"(hi)); return r; }
typedef float f32x2 __attribute__((ext_vector_type(2)));
template <class Epi, class Sched, bool ALIGN_EPI = false, bool SP2 = false>
__device__ __forceinline__ void gemm_phase(PG8_LAS unsigned char* lds, const Gemm g, const Sched& S, const Epi& E) {
    int tid_ = threadIdx.x; asm volatile("" : "+v"(tid_));
    const int tid = tid_, wid = __builtin_amdgcn_readfirstlane(tid >> 6), lane = tid & 63, wr = wid >> 2, wc = wid & 3, fr = lane & 15, fq = lane >> 4;
    const int K = g.K, nt = K / BK;
    unsigned voffA[2], voffB[2];
#pragma unroll
    for (int i = 0; i < 2; ++i) { int R, C; stage_rc(tid * 16 + i * 8192, R, C); const int Rb = Epi::PERM ? ((R & ~31) + perm32(R & 31)) : R;
        voffA[i] = (unsigned)(R * K + C) * 2u; voffB[i] = (unsigned)(Rb * K + C) * 2u; }
    const size_t kstep = (size_t)(BK * 2);
    const size_t hstep = (size_t)HALF * K * 2;
    const size_t tstep = 2 * hstep;
    const unsigned ldsw = (unsigned)wid * 1024u;
    const int aoff = lds_byte(wr * 64 + fr, fq * 8), boff = lds_byte(wc * 32 + fr, fq * 8);
#define PG8_SA(b, h) (((b) * 2 + (h)) * HTB)
#define PG8_SB(b, h) ((4 + (b) * 2 + (h)) * HTB)
#define PG8_STAGE(bufoff, gbase, voff) do { _Pragma("unroll") for (int _i = 0; _i < 2; ++_i) \
        __builtin_amdgcn_global_load_lds((const unsigned*)((const char*)(gbase) + (voff)[_i]), (PG8_LAS unsigned*)(lds + (bufoff) + ldsw + _i * 8192), 16, 0, 0); } while (0)
#define PG8_LDA(dst, b, h) do { _Pragma("unroll") for (int m = 0; m < 4; ++m) _Pragma("unroll") for (int k = 0; k < 2; ++k) dst[m][k] = *(const PG8_LAS bf16x8*)(lds + PG8_SA(b, h) + aoff + m * 2048 + k * 1024); } while (0)
#define PG8_LDB(dst, b, h) do { _Pragma("unroll") for (int n = 0; n < 2; ++n) _Pragma("unroll") for (int k = 0; k < 2; ++k) dst[n][k] = *(const PG8_LAS bf16x8*)(lds + PG8_SB(b, h) + boff + n * 2048 + k * 1024); } while (0)
#define PG8_MMA(ai, bj, At, Bt) do { __builtin_amdgcn_s_setprio(1); _Pragma("unroll") for (int m = 0; m < 4; ++m) _Pragma("unroll") for (int n = 0; n < 2; ++n) _Pragma("unroll") for (int k = 0; k < 2; ++k) \
        acc[ai][bj][m][n] = __builtin_amdgcn_mfma_f32_16x16x32_bf16(Bt[n][k], At[m][k], acc[ai][bj][m][n], 0, 0, 0); __builtin_amdgcn_s_setprio(0); } while (0)
#define PG8_WAIT_V(n) asm volatile("s_waitcnt vmcnt(" #n ")" ::: "memory")
#define PG8_WAIT_L(n) asm volatile("s_waitcnt lgkmcnt(" #n ")" ::: "memory")
#define PG8_BAR __builtin_amdgcn_s_barrier()
#define PG8_SCHED __builtin_amdgcn_sched_barrier(0)
    Unit cur, nxt; int ui = 0;
    if (!S.next(0, cur)) return;
    f32x4 acc[2][2][4][2];
#pragma unroll
    for (int a = 0; a < 2; ++a)
#pragma unroll
        for (int b = 0; b < 2; ++b)
#pragma unroll
            for (int m = 0; m < 4; ++m)
#pragma unroll
                for (int n = 0; n < 2; ++n) acc[a][b][m][n] = (f32x4){0.f, 0.f, 0.f, 0.f};
    bf16x8 At[4][2], B0[2][2], B1[2][2];
    const char* cA = (const char*)g.A + (size_t)cur.pm * tstep; const char* cB = (const char*)g.Bt + (size_t)cur.pn * tstep;
    S.a_ready(cur);
    if constexpr (SP2) {
        PG8_STAGE(PG8_SB(0, 0), cB, voffB); PG8_STAGE(PG8_SB(0, 1), cB + hstep, voffB); PG8_STAGE(PG8_SA(0, 0), cA, voffA); PG8_STAGE(PG8_SA(0, 1), cA + hstep, voffA);
        if (wr == 1) PG8_BAR;
        PG8_WAIT_V(2); PG8_BAR;
        PG8_STAGE(PG8_SB(1, 0), cB + kstep, voffB); PG8_STAGE(PG8_SA(1, 0), cA + kstep, voffA); PG8_STAGE(PG8_SB(1, 1), cB + hstep + kstep, voffB);
        PG8_WAIT_V(6); PG8_BAR;
    } else {
        PG8_STAGE(PG8_SB(0, 0), cB, voffB); PG8_STAGE(PG8_SA(0, 0), cA, voffA); PG8_STAGE(PG8_SB(0, 1), cB + hstep, voffB); PG8_STAGE(PG8_SA(0, 1), cA + hstep, voffA);
        if (wr == 1) PG8_BAR;
        PG8_WAIT_V(4); PG8_BAR;
        PG8_STAGE(PG8_SB(1, 0), cB + kstep, voffB); PG8_STAGE(PG8_SA(1, 0), cA + kstep, voffA); PG8_STAGE(PG8_SB(1, 1), cB + hstep + kstep, voffB);
        PG8_WAIT_V(6); PG8_BAR;
    }
    for (;;) {
        const bool has_next = S.next(ui + 1, nxt);
        const char* nA = has_next ? (const char*)g.A + (size_t)nxt.pm * tstep : cA; const char* nB = has_next ? (const char*)g.Bt + (size_t)nxt.pn * tstep : cB;
        for (int t = 0; t < nt; t += 2) {
            const bool last = (t == nt - 2);
            const char* a1 = cA + (size_t)(t + 1) * kstep;
            const char* a2 = last ? nA : cA + (size_t)(t + 2) * kstep; const char* b2 = last ? nB : cB + (size_t)(t + 2) * kstep;
            const char* a3 = a2 + kstep; const char* b3 = b2 + kstep;
            if (last && has_next) S.a_ready(nxt);
            if constexpr (SP2) {
            PG8_LDB(B0, 0, 0); PG8_LDB(B1, 0, 1); PG8_SCHED; PG8_LDA(At, 0, 0); PG8_STAGE(PG8_SA(1, 1), a1 + hstep, voffA);
            PG8_WAIT_V(8); PG8_WAIT_L(0); PG8_BAR; PG8_MMA(0, 0, At, B0); PG8_MMA(0, 1, At, B1); PG8_BAR; PG8_SCHED;
            PG8_LDA(At, 0, 1); PG8_STAGE(PG8_SB(0, 0), b2, voffB); PG8_STAGE(PG8_SB(0, 1), b2 + hstep, voffB); PG8_STAGE(PG8_SA(0, 0), a2, voffA);
            PG8_WAIT_V(8); PG8_WAIT_L(0); PG8_BAR; PG8_MMA(1, 0, At, B0); PG8_MMA(1, 1, At, B1); PG8_BAR; PG8_SCHED;
            PG8_LDB(B0, 1, 0); PG8_LDB(B1, 1, 1); PG8_SCHED; PG8_LDA(At, 1, 0); PG8_STAGE(PG8_SA(0, 1), a2 + hstep, voffA);
            PG8_WAIT_V(8); PG8_WAIT_L(0); PG8_BAR; PG8_MMA(0, 0, At, B0); PG8_MMA(0, 1, At, B1); PG8_BAR; PG8_SCHED;
            PG8_LDA(At, 1, 1); PG8_STAGE(PG8_SB(1, 0), b3, voffB); PG8_STAGE(PG8_SB(1, 1), b3 + hstep, voffB); PG8_STAGE(PG8_SA(1, 0), a3, voffA);
            PG8_WAIT_V(8); PG8_WAIT_L(0); PG8_BAR; PG8_MMA(1, 0, At, B0); PG8_MMA(1, 1, At, B1); PG8_BAR; PG8_SCHED;
            } else {
            PG8_LDB(B0, 0, 0); PG8_SCHED; PG8_LDA(At, 0, 0); PG8_STAGE(PG8_SA(1, 1), a1 + hstep, voffA);
            PG8_WAIT_L(8); PG8_BAR; PG8_WAIT_L(0); PG8_MMA(0, 0, At, B0); PG8_BAR; PG8_SCHED;
            PG8_LDB(B1, 0, 1); PG8_STAGE(PG8_SB(0, 0), b2, voffB);
            PG8_BAR; PG8_WAIT_L(0); PG8_MMA(0, 1, At, B1); PG8_BAR;
            PG8_LDA(At, 0, 1); PG8_STAGE(PG8_SA(0, 0), a2, voffA);
            PG8_BAR; PG8_WAIT_L(0); PG8_MMA(1, 0, At, B0); PG8_BAR; PG8_SCHED;
            PG8_STAGE(PG8_SB(0, 1), b2 + hstep, voffB);
            PG8_WAIT_V(6); PG8_BAR; PG8_MMA(1, 1, At, B1); PG8_BAR;
            PG8_LDB(B0, 1, 0); PG8_SCHED; PG8_LDA(At, 1, 0); PG8_STAGE(PG8_SA(0, 1), a2 + hstep, voffA);
            PG8_WAIT_L(8); PG8_BAR; PG8_WAIT_L(0); PG8_MMA(0, 0, At, B0); PG8_BAR; PG8_SCHED;
            PG8_LDB(B1, 1, 1); PG8_STAGE(PG8_SB(1, 0), b3, voffB);
            PG8_BAR; PG8_WAIT_L(0); PG8_MMA(0, 1, At, B1); PG8_BAR;
            PG8_LDA(At, 1, 1); PG8_STAGE(PG8_SA(1, 0), a3, voffA);
            PG8_BAR; PG8_WAIT_L(0); PG8_MMA(1, 0, At, B0); PG8_BAR; PG8_SCHED;
            PG8_STAGE(PG8_SB(1, 1), b3 + hstep, voffB);
            PG8_WAIT_V(6); PG8_BAR; PG8_MMA(1, 1, At, B1); PG8_BAR;
            }
        }
        if constexpr (ALIGN_EPI) { if (wr == 0) PG8_BAR; }
        if constexpr (!Epi::AFTER_DRAIN) { E(acc, cur, wr, wc, fr, fq); S.done(cur); }
        if (!has_next) break;
#pragma unroll
        for (int a = 0; a < 2; ++a)
#pragma unroll
            for (int b = 0; b < 2; ++b)
#pragma unroll
                for (int m = 0; m < 4; ++m)
#pragma unroll
                    for (int n = 0; n < 2; ++n) acc[a][b][m][n] = (f32x4){0.f, 0.f, 0.f, 0.f};
        cur = nxt; cA = nA; cB = nB; ++ui;
        if constexpr (ALIGN_EPI) { if (wr == 1) PG8_BAR; }
    }
    PG8_WAIT_V(0);
    if constexpr (!ALIGN_EPI) { if (wr == 0) PG8_BAR; }
    PG8_BAR;
    if constexpr (Epi::AFTER_DRAIN) { E.fused(acc, cur, wr, wc, fr, fq, lds, wid, lane); S.done(cur); }
#undef PG8_SA
#undef PG8_SB
#undef PG8_STAGE
#undef PG8_LDA
#undef PG8_LDB
#undef PG8_MMA
#undef PG8_WAIT_V
#undef PG8_WAIT_L
#undef PG8_BAR
#undef PG8_SCHED
}
}

constexpr int RT_K = 0, RT_V = 32768, RT_ST = 65536;
template <bool KV> __device__ __forceinline__ void ret_stage(const bf16_t* P, int rb, int hp, LAS char* sm, int tid, int wid, int lane) {
    const int vrow = 16 * (wid & 3) + (lane >> 2), vc = (wid >> 2) * 32 + (lane & 3) * 8;
    u32x4 kk[4], vv[4];
#pragma unroll
    for (int i = 0; i < 4; ++i) { const int hh = i >> 1, tt = i & 1, h = 2 * hp + hh, r0 = rb + tt * 64;
        vv[i] = *(const u32x4*)(P + (size_t)(r0 + vrow) * DIN + C_RV + h * 64 + vc);
        kk[i] = KV ? *(const u32x4*)(P + (size_t)(r0 + vrow) * DIN + C_RK + h * 64 + vc) : *(const u32x4*)(P + (size_t)(r0 + lane) * DIN + C_RK + h * 64 + wid * 8); }
#pragma unroll
    for (int i = 0; i < 4; ++i) { *(LAS u32x4*)(sm + RT_K + i * 8192 + tid * 16) = kk[i]; *(LAS u32x4*)(sm + RT_V + i * 8192 + tid * 16) = vv[i]; }
}
__device__ __forceinline__ float ret_lg(const Params& p, int l, int dir, int h) { return -softplusf_(-p.ret_logit[(l * 2 + dir) * 4 + h]); }
__device__ __forceinline__ void ph_ret_summ(const Params& p, int l, int bid, int nb, float* lds) {
    char* ws = p.ws; const int tid = TIDX, lane = tid & 63, r32 = lane & 31, hi = lane >> 5, wid = __builtin_amdgcn_readfirstlane(tid >> 6);
    const bf16_t* P = (const bf16_t*)(ws + OFF_P); float* RET = (float*)(ws + OFF_RET);
    LAS char* sm = (LAS char*)lds;
    for (int u = bid; u < 2 * NCI * 2; u += nb) {
        const int hp = u & 1, ci = (u >> 1) % NCI, b = (u >> 1) / NCI, rb = row_base(b, ci);
        __syncthreads();
        ret_stage<true>(P, rb, hp, sm, tid, wid, lane);
        __syncthreads();
        const int hh = wid >> 2, dh = (wid >> 1) & 1, eh = wid & 1, h = 2 * hp + hh;
        const float lg2f = ret_lg(p, l, 0, h) * 1.4426950408889634f, lg2b = ret_lg(p, l, 1, h) * 1.4426950408889634f;
        const int voff = ((lane >> 4) & 1) * 32 + (lane & 3) * 8 + (4 * hi + ((lane & 15) >> 2)) * 64;
        const LAS char* Kb = sm + RT_K + hh * 16384 + dh * 4096 + voff; const LAS char* Vb = sm + RT_V + hh * 16384 + eh * 4096 + voff;
        f32x16 a0, a1;
#pragma unroll
        for (int r = 0; r < 16; ++r) { a0[r] = 0.f; a1[r] = 0.f; }
#pragma unroll
        for (int k8 = 0; k8 < 8; ++k8) { const int tt = k8 >> 2, sl = k8 & 3;
            const s16x4 klo = vtr(Kb + tt * 8192 + sl * 1024), khi = vtr(Kb + tt * 8192 + sl * 1024 + 512), vlo = vtr(Vb + tt * 8192 + sl * 1024), vhi = vtr(Vb + tt * 8192 + sl * 1024 + 512);
            const int mb = tt * 64 + sl * 16 + 4 * hi; float kf_[8], kb_[8];
#pragma unroll
            for (int j = 0; j < 8; ++j) { const int m = mb + (j < 4 ? j : j + 4); const float kv = bfs(j < 4 ? klo[j] : khi[j - 4]);
                kf_[j] = kv * __builtin_amdgcn_exp2f(lg2f * (float)(127 - m)); kb_[j] = kv * __builtin_amdgcn_exp2f(lg2b * (float)m); }
            const u32x4 af = {cvtpk_s(kf_[0], kf_[1]), cvtpk_s(kf_[2], kf_[3]), cvtpk_s(kf_[4], kf_[5]), cvtpk_s(kf_[6], kf_[7])};
            const u32x4 ab = {cvtpk_s(kb_[0], kb_[1]), cvtpk_s(kb_[2], kb_[3]), cvtpk_s(kb_[4], kb_[5]), cvtpk_s(kb_[6], kb_[7])};
            const bf16x8 vfr = {vlo[0], vlo[1], vlo[2], vlo[3], vhi[0], vhi[1], vhi[2], vhi[3]};
            a0 = __builtin_amdgcn_mfma_f32_32x32x16_bf16(__builtin_bit_cast(bf16x8, af), vfr, a0, 0, 0, 0);
            a1 = __builtin_amdgcn_mfma_f32_32x32x16_bf16(__builtin_bit_cast(bf16x8, ab), vfr, a1, 0, 0, 0); }
        float* of = RET + ((((size_t)0 * 2 + b) * NCI + ci) * 4 + h) * 4096 + eh * 32 + r32;
        float* ob = RET + ((((size_t)1 * 2 + b) * NCI + ci) * 4 + h) * 4096 + eh * 32 + r32;
#pragma unroll
        for (int r = 0; r < 16; ++r) { const int d = dh * 32 + crow(r, hi); of[d * 64] = a0[r]; ob[d * 64] = a1[r]; }
    }
}

constexpr int LR_UB = 0, LR_A = 18432, LR_B = 51200, LR_H = 83968;
template <int MODE>
__device__ __forceinline__ void ph_lru_chunk(const Params& p, int l, int bid, int nb, float* lds, int ci_lo) {
    char* ws = p.ws; const int tid = TIDX, lane = tid & 63, r32 = lane & 31, hi = lane >> 5, wid = __builtin_amdgcn_readfirstlane(tid >> 6);
    const bf16_t* P = (const bf16_t*)(ws + OFF_P);
    float* LA = (float*)(ws + OFF_LRU); float* LB = LA + 2 * 2 * NCI * 256; float* LC = LB + 2 * 2 * NCI * 256;
    bf16_t* O = (bf16_t*)(ws + OFF_ACT);
    LAS char* sm = (LAS char*)lds;
    const int hb = bid & 3, tt = wid >> 1, jt = wid & 1, jcol = jt * 32 + r32, ch = hb * 64 + jcol;
    bf16x8 wfr[2][2][4]; float bia[2][2], spl[2];
#pragma unroll
    for (int dir = 0; dir < 2; ++dir) {
#pragma unroll
        for (int gt = 0; gt < 2; ++gt) { const float* W = (gt == 0 ? p.lru_wa : p.lru_wx) + (((size_t)(l * 2 + dir) * 4 + hb) * 64) * 64 + jcol;
#pragma unroll
            for (int ks = 0; ks < 4; ++ks) { const float* wp = W + (16 * ks + 8 * hi) * 64;
                const u32x4 w4 = {cvtpk_s(wp[0], wp[64]), cvtpk_s(wp[128], wp[192]), cvtpk_s(wp[256], wp[320]), cvtpk_s(wp[384], wp[448])};
                wfr[dir][gt][ks] = __builtin_bit_cast(bf16x8, w4); }
            bia[dir][gt] = (gt == 0 ? p.lru_ba : p.lru_bx)[(l * 2 + dir) * 256 + ch]; }
        spl[dir] = -8.0f * softplusf_(-p.lru_lam[(l * 2 + dir) * 256 + ch]); }
    const int nci = NCI - ci_lo, npair = 2 * nci;
    for (int pi = bid >> 2; pi < npair; pi += nb >> 2) {
        const int ci = ci_lo + pi % nci, b = pi / nci, rb = row_base(b, ci);
        const int seg_lo = ci < 2 ? NLAT + b * NCTX : b * NSEQ, seg_hi = ci < 2 ? seg_lo + NCTX : seg_lo + NSEQ;
        __syncthreads();
#pragma unroll
        for (int it = 0; it < 2; ++it) { const int item = it * 512 + tid, t = item >> 3, c8 = (item & 7) * 8, c0 = hb * 64 + c8;
            float acc[8];
            { const f32x4 b0 = *(const f32x4*)(p.conv_b + l * 256 + c0), b1 = *(const f32x4*)(p.conv_b + l * 256 + c0 + 4);
              acc[0] = b0[0]; acc[1] = b0[1]; acc[2] = b0[2]; acc[3] = b0[3]; acc[4] = b1[0]; acc[5] = b1[1]; acc[6] = b1[2]; acc[7] = b1[3]; }
#pragma unroll
            for (int k = 0; k < 4; ++k) { const int rr = rb + t - 1 + k;
                if (rr >= seg_lo && rr < seg_hi) { const bf16x8 xv = *(const bf16x8*)(P + (size_t)rr * DIN + C_LX + c0);
                    const f32x4 w0 = *(const f32x4*)(p.conv_w + (l * 4 + k) * 256 + c0), w1 = *(const f32x4*)(p.conv_w + (l * 4 + k) * 256 + c0 + 4);
                    acc[0] += w0[0] * bfs(xv[0]); acc[1] += w0[1] * bfs(xv[1]); acc[2] += w0[2] * bfs(xv[2]); acc[3] += w0[3] * bfs(xv[3]);
                    acc[4] += w1[0] * bfs(xv[4]); acc[5] += w1[1] * bfs(xv[5]); acc[6] += w1[2] * bfs(xv[6]); acc[7] += w1[3] * bfs(xv[7]); } }
            const u32x4 w = {cvtpk_s(acc[0], acc[1]), cvtpk_s(acc[2], acc[3]), cvtpk_s(acc[4], acc[5]), cvtpk_s(acc[6], acc[7])};
            *(LAS u32x4*)(sm + LR_UB + t * 144 + c8 * 2) = w; }
        __syncthreads();
        bf16x8 ua[4];
#pragma unroll
        for (int ks = 0; ks < 4; ++ks) ua[ks] = *(const LAS bf16x8*)(sm + LR_UB + (tt * 32 + r32) * 144 + (16 * ks + 8 * hi) * 2);
#pragma unroll
        for (int dir = 0; dir < 2; ++dir) {
            f32x16 ga, gx;
#pragma unroll
            for (int r = 0; r < 16; ++r) { ga[r] = bia[dir][0]; gx[r] = bia[dir][1]; }
#pragma unroll
            for (int ks = 0; ks < 4; ++ks) { ga = __builtin_amdgcn_mfma_f32_32x32x16_bf16(ua[ks], wfr[dir][0][ks], ga, 0, 0, 0); gx = __builtin_amdgcn_mfma_f32_32x32x16_bf16(ua[ks], wfr[dir][1][ks], gx, 0, 0, 0); }
#pragma unroll
            for (int r = 0; r < 16; ++r) { const int t = tt * 32 + crow(r, hi);
                const float rg = __builtin_amdgcn_rcpf(1.0f + __expf(-ga[r])), ig = __builtin_amdgcn_rcpf(1.0f + __expf(-gx[r]));
                const float a = __expf(spl[dir] * rg);
                const float uu = __uint_as_float(((unsigned)*(const LAS unsigned short*)(sm + LR_UB + t * 144 + jcol * 2)) << 16);
                *(LAS float*)(sm + LR_A + (t * 64 + jcol) * 4) = a;
                *(LAS float*)(sm + LR_B + (t * 64 + jcol) * 4) = sqrtf(fmaxf(1.0f - a * a, 0.f)) * (ig * uu); }
            __syncthreads();
            if (wid == 0) {
                const size_t cidx = (((size_t)dir * 2 + b) * NCI + ci) * 256 + hb * 64 + lane;
                float h = MODE == 3 ? LC[cidx] : 0.f, ap = 1.f;
                const LAS float* as_ = (const LAS float*)(sm + LR_A) + lane; const LAS float* bs_ = (const LAS float*)(sm + LR_B) + lane; LAS float* hs = (LAS float*)(sm + LR_H) + lane;
#pragma unroll 1
                for (int t0 = 0; t0 < 128; t0 += 16) {
                    float av[16], bv[16], hv[16];
#pragma unroll
                    for (int k = 0; k < 16; ++k) { const int t = dir == 0 ? t0 + k : 127 - t0 - k; av[k] = as_[t * 64]; bv[k] = bs_[t * 64]; if (MODE == 3 && dir == 1) hv[k] = hs[t * 64]; }
#pragma unroll
                    for (int k = 0; k < 16; ++k) { const int t = dir == 0 ? t0 + k : 127 - t0 - k; h = av[k] * h + bv[k]; ap *= av[k];
                        if (MODE == 3) hs[t * 64] = dir == 0 ? h : hv[k] + h; }
                }
                if (MODE == 1) { LA[cidx] = ap; LB[cidx] = h; }
            }
            __syncthreads();
        }
        if (MODE == 3) {
#pragma unroll
            for (int it = 0; it < 2; ++it) { const int item = it * 512 + tid, t = item >> 3, c8 = (item & 7) * 8, c0 = hb * 64 + c8;
                const f32x4 h0 = *(const LAS f32x4*)(sm + LR_H + (t * 64 + c8) * 4), h1 = *(const LAS f32x4*)(sm + LR_H + (t * 64 + c8 + 4) * 4);
                const bf16x8 yv = *(const bf16x8*)(P + (size_t)(rb + t) * DIN + C_LY + c0);
                const u32x4 w = {cvtpk_s(h0[0] * gelu_tanh(bfs(yv[0])), h0[1] * gelu_tanh(bfs(yv[1]))), cvtpk_s(h0[2] * gelu_tanh(bfs(yv[2])), h0[3] * gelu_tanh(bfs(yv[3]))),
                                 cvtpk_s(h1[0] * gelu_tanh(bfs(yv[4])), h1[1] * gelu_tanh(bfs(yv[5]))), cvtpk_s(h1[2] * gelu_tanh(bfs(yv[6])), h1[3] * gelu_tanh(bfs(yv[7])))};
                *(u32x4*)(O + (size_t)(rb + t) * DM + 768 + c0) = w; }
        }
    }
}

__device__ __forceinline__ int scan_ci(int dir, int s) { return dir == 0 ? s : (s == 0 ? 1 : (s == 1 ? 0 : NCI + 1 - s)); }
__device__ __forceinline__ void ph_scan2(const Params& p, int l, int bid, int nb) {
    char* ws = p.ws; const int gt = bid * 512 + TIDX, gs = nb * 512;
    float* RET = (float*)(ws + OFF_RET);
    for (int i = gt; i < 2 * 2 * 4 * 4096; i += gs) {
        const int de = i & 4095, h = (i >> 12) & 3, b = (i >> 14) & 1, dir = i >> 15;
        const float decay = expf(ret_lg(p, l, dir, h) * 128.0f); float S = 0.f;
        float* base = RET + (((size_t)dir * 2 + b) * NCI * 4 + h) * 4096 + de;
        for (int s0 = 0; s0 < NCI; s0 += 13) {
            float uu[13];
#pragma unroll
            for (int j = 0; j < 13; ++j) uu[j] = base[(size_t)scan_ci(dir, s0 + j) * 4 * 4096];
#pragma unroll
            for (int j = 0; j < 13; ++j) { base[(size_t)scan_ci(dir, s0 + j) * 4 * 4096] = S; S = decay * S + uu[j]; }
        }
    }
    float* LA = (float*)(ws + OFF_LRU); float* LB = LA + 2 * 2 * NCI * 256; float* LC = LB + 2 * 2 * NCI * 256;
    for (int i = gt; i < 2 * 2 * 256; i += gs) {
        const int ch = i & 255, b = (i >> 8) & 1, dir = i >> 9; float h = 0.f;
        const size_t base = ((size_t)dir * 2 + b) * NCI * 256 + ch;
        for (int s0 = 0; s0 < NCI; s0 += 13) {
            float aa[13], bb[13];
#pragma unroll
            for (int j = 0; j < 13; ++j) { const size_t idx = base + (size_t)scan_ci(dir, s0 + j) * 256; aa[j] = LA[idx]; bb[j] = LB[idx]; }
#pragma unroll
            for (int j = 0; j < 13; ++j) { LC[base + (size_t)scan_ci(dir, s0 + j) * 256] = h; h = aa[j] * h + bb[j]; }
        }
    }
}

__device__ __forceinline__ bf16x8 scale_frag(bf16x8 q, float s) {
    u32x4 w;
#pragma unroll
    for (int i = 0; i < 4; ++i) w[i] = cvtpk_s(bfs(q[2 * i]) * s, bfs(q[2 * i + 1]) * s);
    return __builtin_bit_cast(bf16x8, w);
}
__device__ __forceinline__ void ph_ret_out(const Params& p, int l, int bid, int nb, float* lds, int ci_lo) {
    char* ws = p.ws; const int tid = TIDX, lane = tid & 63, r32 = lane & 31, hi = lane >> 5, wid = __builtin_amdgcn_readfirstlane(tid >> 6);
    const bf16_t* P = (const bf16_t*)(ws + OFF_P); const float* RET = (const float*)(ws + OFF_RET); bf16_t* O = (bf16_t*)(ws + OFF_ACT);
    LAS char* sm = (LAS char*)lds;
    const int nci = NCI - ci_lo;
    for (int u = bid; u < 2 * nci * 2; u += nb) {
        const int hp = u & 1, ci = ci_lo + (u >> 1) % nci, b = (u >> 1) / nci, rb = row_base(b, ci);
        __syncthreads();
        ret_stage<false>(P, rb, hp, sm, tid, wid, lane);
        __syncthreads();
        const int hh = wid >> 2, qt = wid & 3, h = 2 * hp + hh; int n = qt * 32 + r32;
        asm volatile("" : "+v"(n));
        const float lg2f = ret_lg(p, l, 0, h) * 1.4426950408889634f, lg2b = ret_lg(p, l, 1, h) * 1.4426950408889634f;
        bf16x8 qr[4];
        { const bf16_t* qp = P + (size_t)(rb + n) * DIN + C_RQ + h * 64 + hi * 8;
#pragma unroll
          for (int ks = 0; ks < 4; ++ks) qr[ks] = *(const bf16x8*)(qp + ks * 16); }
        f32x16 o[2];
#pragma unroll
        for (int r = 0; r < 16; ++r) { o[0][r] = 0.f; o[1][r] = 0.f; }
#pragma unroll
        for (int dir = 0; dir < 2; ++dir) {
            const float xi = dir == 0 ? __builtin_amdgcn_exp2f(lg2f * (float)(n + 1)) : __builtin_amdgcn_exp2f(lg2b * (float)(128 - n));
            const float* Sb = RET + ((((size_t)dir * 2 + b) * NCI + ci) * 4 + h) * 4096 + hi * 8 * 64 + r32;
#pragma unroll
            for (int ks = 0; ks < 4; ++ks) { const bf16x8 qx = scale_frag(qr[ks], xi);
#pragma unroll
                for (int eh = 0; eh < 2; ++eh) { const float* sp = Sb + ks * 16 * 64 + eh * 32;
                    const u32x4 sw = {cvtpk_s(sp[0], sp[64]), cvtpk_s(sp[128], sp[192]), cvtpk_s(sp[256], sp[320]), cvtpk_s(sp[384], sp[448])};
                    o[eh] = __builtin_amdgcn_mfma_f32_32x32x16_bf16(qx, __builtin_bit_cast(bf16x8, sw), o[eh], 0, 0, 0); } }
        }
        const LAS char* Kb = sm + RT_K + hh * 16384 + hi * 1024 + r32 * 16;
        const LAS char* Vb = sm + RT_V + hh * 16384 + ((lane >> 4) & 1) * 32 + (lane & 3) * 8 + (4 * hi + ((lane & 15) >> 2)) * 64;
        u32x4 pw[8];
#pragma unroll
        for (int kb = 0; kb < 4; ++kb) { const int tt = kb >> 1, kbl = kb & 1;
            f32x16 c;
#pragma unroll
            for (int r = 0; r < 16; ++r) c[r] = 0.f;
#pragma unroll
            for (int ks = 0; ks < 4; ++ks) c = __builtin_amdgcn_mfma_f32_32x32x16_bf16(*(const LAS bf16x8*)(Kb + tt * 8192 + ks * 2048 + kbl * 512), qr[ks], c, 0, 0, 0);
#pragma unroll
            for (int r = 0; r < 16; ++r) { const int dlt = n - (kb * 32 + crow(r, hi)); const float fd = (float)dlt;
                const float w = __builtin_amdgcn_exp2f(fd * (dlt > 0 ? lg2f : -lg2b));
                c[r] *= dlt == 0 ? 2.0f : w; }
            pw[2 * kb] = (u32x4){cvtpk_s(c[0], c[1]), cvtpk_s(c[2], c[3]), cvtpk_s(c[4], c[5]), cvtpk_s(c[6], c[7])};
            pw[2 * kb + 1] = (u32x4){cvtpk_s(c[8], c[9]), cvtpk_s(c[10], c[11]), cvtpk_s(c[12], c[13]), cvtpk_s(c[14], c[15])}; }
#pragma unroll
        for (int k8 = 0; k8 < 8; ++k8) { const int tt = k8 >> 2, sl = k8 & 3;
#pragma unroll
            for (int eh = 0; eh < 2; ++eh) { const s16x4 vlo = vtr(Vb + tt * 8192 + eh * 4096 + sl * 1024), vhi = vtr(Vb + tt * 8192 + eh * 4096 + sl * 1024 + 512);
                o[eh] = __builtin_amdgcn_mfma_f32_32x32x16_bf16(__builtin_bit_cast(bf16x8, pw[k8]), (bf16x8){vlo[0], vlo[1], vlo[2], vlo[3], vhi[0], vhi[1], vhi[2], vhi[3]}, o[eh], 0, 0, 0); } }
        LAS float* stg = (LAS float*)(sm + RT_ST) + wid * 2048;
#pragma unroll
        for (int r = 0; r < 16; ++r) { const int q = crow(r, hi); stg[q * 64 + r32] = o[0][r]; stg[q * 64 + 32 + r32] = o[1][r]; }
        const float* gn = p.ret_gn + l * 256 + h * 64 + (lane & 7) * 8;
        const f32x4 g0 = *(const f32x4*)gn, g1 = *(const f32x4*)(gn + 4);
#pragma unroll
        for (int i = 0; i < 4; ++i) { const int row = i * 8 + (lane >> 3), ch = lane & 7;
            const f32x4 v0 = *(const LAS f32x4*)(stg + row * 64 + ch * 8), v1 = *(const LAS f32x4*)(stg + row * 64 + ch * 8 + 4);
            float ss = v0[0] * v0[0] + v0[1] * v0[1] + v0[2] * v0[2] + v0[3] * v0[3] + v1[0] * v1[0] + v1[1] * v1[1] + v1[2] * v1[2] + v1[3] * v1[3];
            ss += __shfl_xor(ss, 1); ss += __shfl_xor(ss, 2); ss += __shfl_xor(ss, 4);
            const float rn = rsqrtf(ss * (1.0f / 64.0f) + 1e-6f);
            const size_t grow = (size_t)(rb + qt * 32 + row);
            const bf16x8 gg = *(const bf16x8*)(P + grow * DIN + C_RG + h * 64 + ch * 8);
            u32x4 w; w.x = cvtpk_s(v0[0] * rn * g0[0] * fast_silu(bfs(gg[0])), v0[1] * rn * g0[1] * fast_silu(bfs(gg[1]))); w.y = cvtpk_s(v0[2] * rn * g0[2] * fast_silu(bfs(gg[2])), v0[3] * rn * g0[3] * fast_silu(bfs(gg[3])));
            w.z = cvtpk_s(v1[0] * rn * g1[0] * fast_silu(bfs(gg[4])), v1[1] * rn * g1[1] * fast_silu(bfs(gg[5]))); w.w = cvtpk_s(v1[2] * rn * g1[2] * fast_silu(bfs(gg[6])), v1[3] * rn * g1[3] * fast_silu(bfs(gg[7])));
            *(u32x4*)(O + grow * DM + 256 + h * 64 + ch * 8) = w; }
    }
}

__device__ __forceinline__ float diff_lambda_val(const Params& p, int l, float lam_init) {
    const float* lv = p.diff_lam + l * 128; float s1 = 0.f, s2 = 0.f;
    for (int i = 0; i < 32; ++i) { s1 += lv[i] * lv[32 + i]; s2 += lv[64 + i] * lv[96 + i]; }
    return expf(s1) - expf(s2) + lam_init;
}
__device__ __forceinline__ float max3f(float a, float b, float c) { return __builtin_fmaxf(__builtin_fmaxf(a, b), c); }
__device__ __forceinline__ float xhalf_max(float m) { auto rr = __builtin_amdgcn_permlane32_swap(__float_as_uint(m), __float_as_uint(m), false, false); return fmaxf(__uint_as_float(rr[0]), __uint_as_float(rr[1])); }
__device__ __forceinline__ float xhalf_sum(float m) { auto rr = __builtin_amdgcn_permlane32_swap(__float_as_uint(m), __float_as_uint(m), false, false); return __uint_as_float(rr[0]) + __uint_as_float(rr[1]); }

constexpr int DF_K = 0, DF_V = 16384, DF_WS = 32768, DF_ST = 34816;
constexpr int DD_K = 0, DD_V = 32768, DD_WS = 65536, DD_ST = 67584;
__device__ __forceinline__ void glds16(const void* gsrc, unsigned lds_dst) { unsigned keep;
    asm volatile("s_mov_b32 %0, m0\n\ts_mov_b32 m0, %2\n\ts_nop 0\n\tglobal_load_lds_dwordx4 %1, off\n\ts_mov_b32 m0, %0" : "=&s"(keep) : "v"(gsrc), "s"(lds_dst) : "memory"); }
__device__ __forceinline__ void ph_diff(const Params& p, int l, bool need_ctx, float lam_init, int bid, int nb, float* lds) {
    char* ws = p.ws; const int tid = TIDX, lane = tid & 63, r32 = lane & 31, hi = lane >> 5, wid = __builtin_amdgcn_readfirstlane(tid >> 6);
    const bf16_t* P = (const bf16_t*)(ws + OFF_P); bf16_t* O = (bf16_t*)(ws + OFF_ACT);
    LAS char* sm = (LAS char*)lds;
    LAS float* wsf = (LAS float*)(sm + DD_WS) + wid * 64;
    const float lam = diff_lambda_val(p, l, lam_init);
    const int nun = 512 + (need_ctx ? 8 : 0);
    for (int u = bid; u < nun; u += nb) {
        int b, h, qrow0, t_lo;
        if (u < 512) { b = u >> 8; h = (u >> 6) & 3; qrow0 = b * NSEQ + (u & 63) * 256; t_lo = 0; }
        else { const int v = u - 512; b = v >> 2; h = v & 3; qrow0 = NLAT + b * NCTX; t_lo = 256; }
        const int t_hi = 260;
        const bf16_t* kcol = P + C_DK + h * 64 + wid * 8;
        const bf16_t* vcol = P + C_DV + h * 64 + (wid >> 2) * 32 + (lane & 3) * 8;
        const int krow_in = lane, vrow_in = 16 * (wid & 3) + (lane >> 2);
#define TILE_ROW0(t) ((t) < 256 ? b * NSEQ + (t) * 64 : NLAT + b * NCTX + ((t) - 256) * 64)
        bf16x8 qr[4];
        { const bf16_t* qp = P + (size_t)(qrow0 + wid * 32 + r32) * DIN + C_DQ + h * 64 + hi * 8;
#pragma unroll
          for (int d0 = 0; d0 < 4; ++d0) qr[d0] = *(const bf16x8*)(qp + d0 * 16); }
        f32x16 o[2][2]; float mhat[2], lsum[2];
#pragma unroll
        for (int m = 0; m < 2; ++m) { mhat[m] = 0.f; lsum[m] = 0.f;
#pragma unroll
            for (int r = 0; r < 16; ++r) { o[m][0][r] = 0.f; o[m][1][r] = 0.f; } }
        const unsigned lds0 = (unsigned)(size_t)sm + (unsigned)wid * 1024u;
#define DMA_TILE(t) do { const int r0_ = TILE_ROW0(t); const unsigned sl_ = (unsigned)(((t) - t_lo) & 3) * 8192u; \
        glds16(kcol + (size_t)(r0_ + krow_in) * DIN, (unsigned)__builtin_amdgcn_readfirstlane(lds0 + DD_K + sl_)); glds16(vcol + (size_t)(r0_ + vrow_in) * DIN, (unsigned)__builtin_amdgcn_readfirstlane(lds0 + DD_V + sl_)); } while (0)
        asm volatile("s_waitcnt lgkmcnt(0)\n\ts_barrier" ::: "memory");
        DMA_TILE(t_lo); DMA_TILE(t_lo + 1); DMA_TILE(t_lo + 2);
        bool first = true;
        for (int t = t_lo; t < t_hi; ++t) {
            const int cur = (t - t_lo) & 3;
            if (t + 2 < t_hi) asm volatile("s_waitcnt vmcnt(4)\n\ts_barrier" ::: "memory");
            else if (t + 1 < t_hi) asm volatile("s_waitcnt vmcnt(2)\n\ts_barrier" ::: "memory");
            else asm volatile("s_waitcnt vmcnt(0)\n\ts_barrier" ::: "memory");
            if (t + 3 < t_hi) DMA_TILE(t + 3);
            const LAS char* kb = sm + DD_K + cur * 8192 + hi * 1024 + r32 * 16;
            const LAS char* vb = sm + DD_V + cur * 8192 + ((lane >> 4) & 1) * 32 + (lane & 3) * 8 + (4 * hi + ((lane & 15) >> 2)) * 64;
            bf16x8 kf[8];
#pragma unroll
            for (int j = 0; j < 4; ++j) { kf[2 * j] = *(const LAS bf16x8*)(kb + j * 2048); kf[2 * j + 1] = *(const LAS bf16x8*)(kb + j * 2048 + 512); }
            bf16x8 vf[8];
#pragma unroll
            for (int i = 0; i < 8; ++i) { const s16x4 lo = vtr(vb + (i >> 2) * 4096 + (i & 3) * 1024), hh = vtr(vb + (i >> 2) * 4096 + (i & 3) * 1024 + 512);
                vf[i] = (bf16x8){lo[0], lo[1], lo[2], lo[3], hh[0], hh[1], hh[2], hh[3]}; }
#pragma unroll
            for (int m = 0; m < 2; ++m) {
                float nm = -mhat[m]; asm volatile("" : "+v"(nm));
                f32x16 negm;
#pragma unroll
                for (int r = 0; r < 16; ++r) negm[r] = nm;
                f32x16 c0 = __builtin_amdgcn_mfma_f32_32x32x16_bf16(kf[4 * m + 0], qr[2 * m], negm, 0, 0, 0);
                f32x16 c1 = __builtin_amdgcn_mfma_f32_32x32x16_bf16(kf[4 * m + 1], qr[2 * m], negm, 0, 0, 0);
                c0 = __builtin_amdgcn_mfma_f32_32x32x16_bf16(kf[4 * m + 2], qr[2 * m + 1], c0, 0, 0, 0);
                c1 = __builtin_amdgcn_mfma_f32_32x32x16_bf16(kf[4 * m + 3], qr[2 * m + 1], c1, 0, 0, 0);
                float ra = max3f(c0[0], c0[1], c1[0]), rb = max3f(c0[2], c0[3], c1[1]); ra = max3f(ra, c1[2], c1[3]);
#pragma unroll
                for (int r = 4; r < 16; r += 4) { ra = max3f(ra, c0[r], c0[r + 1]); rb = max3f(rb, c0[r + 2], c0[r + 3]); ra = max3f(ra, c1[r], c1[r + 1]); rb = max3f(rb, c1[r + 2], c1[r + 3]); }
                const float rm = xhalf_max(max3f(ra, rb, rb));
                if (__builtin_expect(first || __any(rm > 8.0f), 0)) {
                    float dl = first ? rm : fmaxf(rm, 0.f); asm volatile("; rebase" : "+v"(dl));
                    mhat[m] += dl;
#pragma unroll
                    for (int r = 0; r < 16; ++r) { c0[r] -= dl; c1[r] -= dl; }
                    asm volatile("" : "+v"(c0), "+v"(c1));
                    if (!first) {
                        const float f = __builtin_amdgcn_exp2f(-dl); lsum[m] *= f;
                        if (hi == 0) wsf[r32] = f;
#pragma unroll
                        for (int r = 0; r < 16; ++r) { const float fr_ = wsf[crow(r, hi)]; o[m][0][r] *= fr_; o[m][1][r] *= fr_; }
                    }
                }
                float sacc = 0.f;
#pragma unroll
                for (int r = 0; r < 16; ++r) { c0[r] = __builtin_amdgcn_exp2f(c0[r]); c1[r] = __builtin_amdgcn_exp2f(c1[r]); sacc += c0[r] + c1[r]; }
                lsum[m] += sacc;
                u32x4 pw[4];
#pragma unroll
                for (int k = 0; k < 2; ++k) {
                    pw[k] = (u32x4){cvtpk_s(c0[8 * k + 0], c0[8 * k + 1]), cvtpk_s(c0[8 * k + 2], c0[8 * k + 3]), cvtpk_s(c0[8 * k + 4], c0[8 * k + 5]), cvtpk_s(c0[8 * k + 6], c0[8 * k + 7])};
                    pw[2 + k] = (u32x4){cvtpk_s(c1[8 * k + 0], c1[8 * k + 1]), cvtpk_s(c1[8 * k + 2], c1[8 * k + 3]), cvtpk_s(c1[8 * k + 4], c1[8 * k + 5]), cvtpk_s(c1[8 * k + 6], c1[8 * k + 7])}; }
#pragma unroll
                for (int k = 0; k < 4; ++k) {
                    o[m][0] = __builtin_amdgcn_mfma_f32_32x32x16_bf16(__builtin_bit_cast(bf16x8, pw[k]), vf[k], o[m][0], 0, 0, 0);
                    o[m][1] = __builtin_amdgcn_mfma_f32_32x32x16_bf16(__builtin_bit_cast(bf16x8, pw[k]), vf[4 + k], o[m][1], 0, 0, 0); }
            }
            first = false;
            asm volatile("s_waitcnt lgkmcnt(0)" ::: "memory");
        }
#undef TILE_ROW0
#undef DMA_TILE
        const float inv0 = 1.0f / xhalf_sum(lsum[0]), inv1 = lam / xhalf_sum(lsum[1]);
        int lane_e = TIDX & 63; asm volatile("" : "+v"(lane_e));
        { const int r32e = lane_e & 31, hie = lane_e >> 5;
        LAS float* wse = (LAS float*)(sm + DD_WS) + wid * 64; LAS float* stge = (LAS float*)(sm + DD_ST) + wid * 2048;
        if (hie == 0) { wse[r32e] = inv0; wse[32 + r32e] = inv1; }
#pragma unroll
        for (int r = 0; r < 16; ++r) { const int q = crow(r, hie); const float i0 = wse[q], i1 = wse[32 + q];
            stge[q * 64 + r32e] = o[0][0][r] * i0 - o[1][0][r] * i1; stge[q * 64 + 32 + r32e] = o[0][1][r] * i0 - o[1][1][r] * i1; } }
        const int lane = lane_e; LAS float* stg = (LAS float*)(sm + DD_ST) + wid * 2048;
        const float* gn = p.diff_gn + l * 256 + h * 64 + (lane & 7) * 8;
        const f32x4 g0 = *(const f32x4*)gn, g1 = *(const f32x4*)(gn + 4);
#pragma unroll
        for (int i = 0; i < 4; ++i) { const int row = i * 8 + (lane >> 3), ch = lane & 7;
            const f32x4 v0 = *(const LAS f32x4*)(stg + row * 64 + ch * 8), v1 = *(const LAS f32x4*)(stg + row * 64 + ch * 8 + 4);
            float ss = v0[0] * v0[0] + v0[1] * v0[1] + v0[2] * v0[2] + v0[3] * v0[3] + v1[0] * v1[0] + v1[1] * v1[1] + v1[2] * v1[2] + v1[3] * v1[3];
            ss += __shfl_xor(ss, 1); ss += __shfl_xor(ss, 2); ss += __shfl_xor(ss, 4);
            const float rn = rsqrtf(ss * (1.0f / 64.0f) + 1e-6f) * (1.0f - lam_init);
            u32x4 w; w.x = cvtpk_s(v0[0] * rn * g0[0], v0[1] * rn * g0[1]); w.y = cvtpk_s(v0[2] * rn * g0[2], v0[3] * rn * g0[3]);
            w.z = cvtpk_s(v1[0] * rn * g1[0], v1[1] * rn * g1[1]); w.w = cvtpk_s(v1[2] * rn * g1[2], v1[3] * rn * g1[3]);
            *(u32x4*)(O + (size_t)(qrow0 + wid * 32 + row) * DM + 512 + h * 64 + ch * 8) = w; }
    }
}

__device__ __forceinline__ void ph_swa(const Params& p, int l, bool need_ctx, int bid, int nb, float* lds) {
    char* ws = p.ws; const int tid = TIDX, lane = tid & 63, r32 = lane & 31, hi = lane >> 5, wid = __builtin_amdgcn_readfirstlane(tid >> 6);
    const bf16_t* P = (const bf16_t*)(ws + OFF_P); bf16_t* O = (bf16_t*)(ws + OFF_ACT);
    LAS char* sm = (LAS char*)lds;
    LAS float* wsf = (LAS float*)(sm + DF_WS) + wid * 64;
    const int nun = 512 + (need_ctx ? 8 : 0);
    for (int u = bid; u < nun; u += nb) {
        int b, h, qrow0, q0, tw_lo, nwin;
        if (u < 512) { b = u >> 8; h = (u >> 6) & 3; q0 = (u & 63) * 256; qrow0 = b * NSEQ + q0; const int lo = q0 - 128 < 0 ? 0 : q0 - 128, hi_ = q0 + 384 > NSEQ ? NSEQ : q0 + 384; tw_lo = lo >> 6; nwin = (hi_ - lo) >> 6; }
        else { const int v = u - 512; b = v >> 2; h = v & 3; q0 = 0; qrow0 = NLAT + b * NCTX; tw_lo = 0; nwin = 0; }
        const int g = h >> 1, nt = nwin + 4;
        const bf16_t* kcol = P + C_AK + g * 64 + wid * 8;
        const bf16_t* vcol = P + C_AV + g * 64 + (wid >> 2) * 32 + (lane & 3) * 8;
        const int krow_in = lane, vrow_in = 16 * (wid & 3) + (lane >> 2);
#define SWA_ROW0(i) ((i) < nwin ? b * NSEQ + (tw_lo + (i)) * 64 : NLAT + b * NCTX + ((i) - nwin) * 64)
        bf16x8 qr[4];
        { const bf16_t* qp = P + (size_t)(qrow0 + wid * 32 + r32) * DIN + C_AQ + h * 64 + hi * 8;
#pragma unroll
          for (int d0 = 0; d0 < 4; ++d0) qr[d0] = *(const bf16x8*)(qp + d0 * 16); }
        f32x16 o[2]; float mhat = p.sink[l * 4 + h] * 1.4426950408889634f, lsum = hi == 0 ? 1.0f : 0.0f;
#pragma unroll
        for (int r = 0; r < 16; ++r) { o[0][r] = 0.f; o[1][r] = 0.f; }
        const int qw = q0 + wid * 32, qpos = qw + r32;
        u32x4 kst, vst;
        { const int r0 = SWA_ROW0(0); kst = *(const u32x4*)(kcol + (size_t)(r0 + krow_in) * DIN); vst = *(const u32x4*)(vcol + (size_t)(r0 + vrow_in) * DIN); }
        __syncthreads();
        *(LAS u32x4*)(sm + DF_K + tid * 16) = kst; *(LAS u32x4*)(sm + DF_V + tid * 16) = vst;
        __syncthreads();
        for (int i = 0; i < nt; ++i) {
            const int cur = i & 1;
            if (i + 1 < nt) { const int r0 = SWA_ROW0(i + 1); kst = *(const u32x4*)(kcol + (size_t)(r0 + krow_in) * DIN); vst = *(const u32x4*)(vcol + (size_t)(r0 + vrow_in) * DIN); }
            const bool win = i < nwin; const int T = (tw_lo + i) * 64;
            const bool skip = win && (T > qw + 31 + 128 || T + 63 < qw - 128);
            if (!skip) {
                const LAS char* kb = sm + DF_K + cur * 8192 + hi * 1024 + r32 * 16;
                const LAS char* vb = sm + DF_V + cur * 8192 + ((lane >> 4) & 1) * 32 + (lane & 3) * 8 + (4 * hi + ((lane & 15) >> 2)) * 64;
                float nm = -mhat; asm volatile("" : "+v"(nm));
                f32x16 c0, c1;
#pragma unroll
                for (int r = 0; r < 16; ++r) { c0[r] = nm; c1[r] = nm; }
#pragma unroll
                for (int j = 0; j < 4; ++j) {
                    c0 = __builtin_amdgcn_mfma_f32_32x32x16_bf16(*(const LAS bf16x8*)(kb + j * 2048), qr[j], c0, 0, 0, 0);
                    c1 = __builtin_amdgcn_mfma_f32_32x32x16_bf16(*(const LAS bf16x8*)(kb + j * 2048 + 512), qr[j], c1, 0, 0, 0); }
                if (win && (T < qw + 31 - 128 || T + 63 > qw + 128)) {
#pragma unroll
                    for (int r = 0; r < 16; ++r) { const int kp = T + crow(r, hi); const int d0_ = qpos - kp, d1_ = d0_ - 32;
                        if (d0_ > 128 || d0_ < -128) c0[r] = -1.0e30f;
                        if (d1_ > 128 || d1_ < -128) c1[r] = -1.0e30f; }
                }
                float rm = fmaxf(c0[0], c1[0]);
#pragma unroll
                for (int r = 1; r < 16; ++r) rm = fmaxf(rm, fmaxf(c0[r], c1[r]));
                rm = xhalf_max(rm);
                if (__any(rm > 8.0f)) {
                    const float dl = fmaxf(rm, 0.f); mhat += dl;
#pragma unroll
                    for (int r = 0; r < 16; ++r) { c0[r] -= dl; c1[r] -= dl; }
                    const float f = __builtin_amdgcn_exp2f(-dl); lsum *= f;
                    if (hi == 0) wsf[r32] = f;
#pragma unroll
                    for (int r = 0; r < 16; ++r) { const float fr_ = wsf[crow(r, hi)]; o[0][r] *= fr_; o[1][r] *= fr_; }
                }
                float sacc = 0.f;
#pragma unroll
                for (int r = 0; r < 16; ++r) { c0[r] = __builtin_amdgcn_exp2f(c0[r]); c1[r] = __builtin_amdgcn_exp2f(c1[r]); sacc += c0[r] + c1[r]; }
                lsum += sacc;
                u32x4 pw[4];
#pragma unroll
                for (int k = 0; k < 2; ++k) {
                    pw[k] = (u32x4){cvtpk_s(c0[8 * k + 0], c0[8 * k + 1]), cvtpk_s(c0[8 * k + 2], c0[8 * k + 3]), cvtpk_s(c0[8 * k + 4], c0[8 * k + 5]), cvtpk_s(c0[8 * k + 6], c0[8 * k + 7])};
                    pw[2 + k] = (u32x4){cvtpk_s(c1[8 * k + 0], c1[8 * k + 1]), cvtpk_s(c1[8 * k + 2], c1[8 * k + 3]), cvtpk_s(c1[8 * k + 4], c1[8 * k + 5]), cvtpk_s(c1[8 * k + 6], c1[8 * k + 7])}; }
#pragma unroll
                for (int k = 0; k < 4; ++k) {
                    const s16x4 lo0 = vtr(vb + k * 1024), hi0 = vtr(vb + k * 1024 + 512), lo1 = vtr(vb + 4096 + k * 1024), hi1 = vtr(vb + 4096 + k * 1024 + 512);
                    o[0] = __builtin_amdgcn_mfma_f32_32x32x16_bf16(__builtin_bit_cast(bf16x8, pw[k]), (bf16x8){lo0[0], lo0[1], lo0[2], lo0[3], hi0[0], hi0[1], hi0[2], hi0[3]}, o[0], 0, 0, 0);
                    o[1] = __builtin_amdgcn_mfma_f32_32x32x16_bf16(__builtin_bit_cast(bf16x8, pw[k]), (bf16x8){lo1[0], lo1[1], lo1[2], lo1[3], hi1[0], hi1[1], hi1[2], hi1[3]}, o[1], 0, 0, 0); }
            }
            if (i + 1 < nt) { *(LAS u32x4*)(sm + DF_K + (cur ^ 1) * 8192 + tid * 16) = kst; *(LAS u32x4*)(sm + DF_V + (cur ^ 1) * 8192 + tid * 16) = vst; }
            __syncthreads();
        }
#undef SWA_ROW0
        const float inv = 1.0f / xhalf_sum(lsum);
        int lane_e = TIDX & 63;
        { const int r32e = lane_e & 31, hie = lane_e >> 5;
        LAS float* wse = (LAS float*)(sm + DF_WS) + wid * 64; LAS float* stge = (LAS float*)(sm + DF_ST) + wid * 2048;
        if (hie == 0) wse[r32e] = inv;
#pragma unroll
        for (int r = 0; r < 16; ++r) { const int q = crow(r, hie); const float i0 = wse[q]; stge[q * 64 + r32e] = o[0][r] * i0; stge[q * 64 + 32 + r32e] = o[1][r] * i0; } }
        LAS float* stg = (LAS float*)(sm + DF_ST) + wid * 2048;
#pragma unroll
        for (int i = 0; i < 4; ++i) { const int row = i * 8 + (lane_e >> 3), ch = lane_e & 7;
            const f32x4 v0 = *(const LAS f32x4*)(stg + row * 64 + ch * 8), v1 = *(const LAS f32x4*)(stg + row * 64 + ch * 8 + 4);
            u32x4 w; w.x = cvtpk_s(v0[0], v0[1]); w.y = cvtpk_s(v0[2], v0[3]); w.z = cvtpk_s(v1[0], v1[1]); w.w = cvtpk_s(v1[2], v1[3]);
            *(u32x4*)(O + (size_t)(qrow0 + wid * 32 + row) * DM + h * 64 + ch * 8) = w; }
    }
}

__device__ __forceinline__ void moe_offsets(const Params& p, int* offs  ) {
    if (TIDX < 2) { const unsigned* cw = (const unsigned*)p.ws + CW_CNT + TIDX * 8; int o = 0;
        for (int e = 0; e < 8; ++e) { offs[TIDX * 9 + e] = o; o += ((int)__hip_atomic_load(cw + e, __ATOMIC_RELAXED, __HIP_MEMORY_SCOPE_AGENT) + 255) & ~255; }
        offs[TIDX * 9 + 8] = o; }
    __syncthreads();
}
__device__ __forceinline__ void ph_moe_scatter(const Params& p, int bid, int nb, float* lds) {
    char* ws = p.ws; int* offs = (int*)lds; moe_offsets(p, offs);
    const int lane = TIDX & 63, wv = TIDX >> 6;
    const bf16_t* H = (const bf16_t*)(ws + OFF_ACT); bf16_t* AS = (bf16_t*)(ws + OFF_ASORT);
    int* tok = (int*)(ws + OFF_TOK); float* wgt = (float*)(ws + OFF_WGT); const unsigned* cw = (const unsigned*)ws;
    for (int r0 = (bid * 8 + wv) * 4; r0 < NLAT; r0 += nb * 8 * 4) {
        int4 rec[4]; u32x4 d0[4], d1[4]; int pos[4][2];
#pragma unroll
        for (int k = 0; k < 4; ++k) { rec[k] = *(const int4*)(ws + OFF_ROUTE + (size_t)(r0 + k) * 16); const u32x4* src = (const u32x4*)(H + (size_t)(r0 + k) * DM); d0[k] = src[lane]; d1[k] = src[64 + lane]; }
#pragma unroll
        for (int k = 0; k < 4; ++k) { const int blk = ((r0 + k) >> 3) % nb;
#pragma unroll
            for (int g = 0; g < 2; ++g) { const int e = (g == 0 ? rec[k].x : rec[k].y) & 15, li = (g == 0 ? rec[k].x : rec[k].y) >> 4;
                pos[k][g] = offs[g * 9 + e] + (int)cw[CW_BLK + blk * 16 + g * 8 + e] + li; } }
#pragma unroll
        for (int k = 0; k < 4; ++k)
#pragma unroll
            for (int g = 0; g < 2; ++g) { const int ps = pos[k][g];
                if (lane == 0) { tok[g * GRP_ROWS + ps] = r0 + k; wgt[g * GRP_ROWS + ps] = __int_as_float(g == 0 ? rec[k].z : rec[k].w); }
                u32x4* dst = (u32x4*)(AS + ((size_t)g * GRP_ROWS + ps) * DM); dst[lane] = d0[k]; dst[64 + lane] = d1[k]; }
    }
}

__device__ __forceinline__ void ph_final(const Params& p, int bid, int nb) {
    const int lane = TIDX & 63, wv = TIDX >> 6;
    for (int r = bid * 8 + wv; r < NLAT; r += nb * 8) {
        float* xr = p.out + (size_t)r * DM; float4 v[4]; float ss = 0.f;
#pragma unroll
        for (int i = 0; i < 4; ++i) { v[i] = *(const float4*)(xr + i * 256 + lane * 4); ss += v[i].x * v[i].x + v[i].y * v[i].y + v[i].z * v[i].z + v[i].w * v[i].w; }
        ss = wave_sum(ss); const float rn = rsqrtf(ss * (1.0f / 1024.0f) + 1e-6f);
#pragma unroll
        for (int i = 0; i < 4; ++i) { const float4 g = *(const float4*)(p.final_norm + i * 256 + lane * 4);
            float4 o; o.x = v[i].x * rn * g.x; o.y = v[i].y * rn * g.y; o.z = v[i].z * rn * g.z; o.w = v[i].w * rn * g.w; *(float4*)(xr + i * 256 + lane * 4) = o; }
    }
}

struct EpiStoreBf16 {
    static constexpr bool PERM = true, AFTER_DRAIN = false; bf16_t* O; int ldc;
    __device__ __forceinline__ void operator()(const f32x4 (&acc)[2][2][4][2], const pg8::Unit& u, int wr, int wc, int fr, int fq) const {
        bf16_t* base = O + (size_t)(u.pm * 256 + wr * 64 + fr) * ldc + u.pn * 256 + wc * 32 + 8 * fq;
#pragma unroll
        for (int ai = 0; ai < 2; ++ai)
#pragma unroll
            for (int m = 0; m < 4; ++m) { bf16_t* rowp = base + (size_t)(ai * 128 + m * 16) * ldc;
#pragma unroll
                for (int bj = 0; bj < 2; ++bj) { const f32x4 v0 = acc[ai][bj][m][0], v1 = acc[ai][bj][m][1]; u32x4 w;
                    w.x = pg8::cvt_pk_bf16(v0[0], v0[1]); w.y = pg8::cvt_pk_bf16(v0[2], v0[3]); w.z = pg8::cvt_pk_bf16(v1[0], v1[1]); w.w = pg8::cvt_pk_bf16(v1[2], v1[3]);
                    *(u32x4*)(rowp + bj * 128) = w; } }
    }
};
struct EpiSwiglu {
    static constexpr bool PERM = true, AFTER_DRAIN = false; bf16_t* U; int ldu, npe;
    __device__ __forceinline__ void operator()(const f32x4 (&acc)[2][2][4][2], const pg8::Unit& u, int wr, int wc, int fr, int fq) const {
        bf16_t* base = U + (size_t)(u.pm * 256 + wr * 64 + fr) * ldu + (u.pn % npe) * 128 + wc * 32 + 8 * fq;
#pragma unroll
        for (int ai = 0; ai < 2; ++ai)
#pragma unroll
            for (int m = 0; m < 4; ++m) { float o[8];
#pragma unroll
                for (int n = 0; n < 2; ++n)
#pragma unroll
                    for (int i = 0; i < 4; ++i) o[n * 4 + i] = fast_silu(acc[ai][0][m][n][i]) * acc[ai][1][m][n][i];
                u32x4 w; w.x = pg8::cvt_pk_bf16(o[0], o[1]); w.y = pg8::cvt_pk_bf16(o[2], o[3]); w.z = pg8::cvt_pk_bf16(o[4], o[5]); w.w = pg8::cvt_pk_bf16(o[6], o[7]);
                *(u32x4*)(base + (size_t)(ai * 128 + m * 16) * ldu) = w; }
    }
};
struct EpiResidual {
    static constexpr bool PERM = false, AFTER_DRAIN = false; const float* xin; float* xout; float* xc; const float* gate;
    __device__ __forceinline__ void operator()(const f32x4 (&acc)[2][2][4][2], const pg8::Unit& u, int wr, int wc, int fr, int fq) const {
        const int cls = u.pm < 64 ? 0 : (u.pm < 128 ? 1 : 2), col0 = u.pn * 256 + wc * 32 + 4 * fq;
        const float* gv = gate + (size_t)cls * 6144 + col0;
        const float* bi = u.pm < 128 ? xin + (size_t)u.pm * 256 * DM : xc + (size_t)(u.pm - 128) * 256 * DM;
        float* bo = u.pm < 128 ? xout + (size_t)u.pm * 256 * DM : xc + (size_t)(u.pm - 128) * 256 * DM;
        f32x4 g4[2][2];
#pragma unroll
        for (int bj = 0; bj < 2; ++bj)
#pragma unroll
            for (int n = 0; n < 2; ++n) g4[bj][n] = *(const f32x4*)(gv + bj * 128 + n * 16);
#pragma unroll
        for (int ai = 0; ai < 2; ++ai)
#pragma unroll
            for (int m = 0; m < 4; ++m) { const size_t off = (size_t)(ai * 128 + wr * 64 + m * 16 + fr) * DM + col0;
#pragma unroll
                for (int bj = 0; bj < 2; ++bj)
#pragma unroll
                    for (int n = 0; n < 2; ++n) { const f32x4 xi = *(const f32x4*)(bi + off + bj * 128 + n * 16); *(f32x4*)(bo + off + bj * 128 + n * 16) = xi + g4[bj][n] * acc[ai][bj][m][n]; } }
    }
};
struct EpiMoeScatter {
    static constexpr bool PERM = false, AFTER_DRAIN = false; float* x; const float* gate; const int* tok; const float* wgt; int npe;
    __device__ __forceinline__ void operator()(const f32x4 (&acc)[2][2][4][2], const pg8::Unit& u, int wr, int wc, int fr, int fq) const {
        const int col0 = (u.pn % npe) * 256 + wc * 32 + 4 * fq;
#pragma unroll
        for (int ai = 0; ai < 2; ++ai)
#pragma unroll
            for (int m = 0; m < 4; ++m) { const int r = u.pm * 256 + ai * 128 + wr * 64 + m * 16 + fr; const int tk = tok[r];
                if (tk >= 0) { const float wv = wgt[r]; const float* gv = gate + (size_t)mod_class(tk) * 6144 + col0; float* xr = x + (size_t)tk * DM + col0;
#pragma unroll
                    for (int bj = 0; bj < 2; ++bj)
#pragma unroll
                        for (int n = 0; n < 2; ++n) { const f32x4 g4 = *(const f32x4*)(gv + bj * 128 + n * 16); f32x4* q = (f32x4*)(xr + bj * 128 + n * 16); *q = *q + g4 * wv * acc[ai][bj][m][n]; } } }
    }
};
struct MoeOrder : pg8::StaticOrder {
    int o1, o2, o3, o4, o5, o6, o7, npe;
    __device__ __forceinline__ bool next(int i, pg8::Unit& u) const {
        if (!pg8::StaticOrder::next(i, u)) return false;
        const int r = u.pm * 256; const int e = (r >= o1) + (r >= o2) + (r >= o3) + (r >= o4) + (r >= o5) + (r >= o6) + (r >= o7);
        u.pn += e * npe; return true;
    }
};
#define GEMM_LDS ((PG8_LAS unsigned char*)lds)
struct EpiInProj {
    static constexpr bool PERM = true, AFTER_DRAIN = false; bf16_t* O; const char* tab;
    __device__ __forceinline__ void operator()(const f32x4 (&acc)[2][2][4][2], const pg8::Unit& u, int wr, int wc, int fr, int fq) const {
        const int row0 = u.pm * 256 + wr * 64 + fr; const bool lat = u.pm < 128;
#pragma unroll
        for (int bj = 0; bj < 2; ++bj) {
            const int s = u.pn * 2 + bj;
            int mode = 0; float scale = 1.0f;
            if (s <= 1) { mode = 1; scale = 0.125f * 1.4426950408889634f; } else if (s == 2) mode = 1;
            else if (s == 4 || s == 5) mode = 2; else if (s == 6 || s == 7) { mode = 2; scale = 0.125f; }
            else if (s == 12 || s == 13) { mode = 3; scale = 0.17677669529663687f * 1.4426950408889634f; } else if (s == 14 || s == 15) mode = 3;
            if (mode == 0) {
                bf16_t* base = O + (size_t)row0 * DIN + s * 128 + wc * 32 + 8 * fq;
#pragma unroll
                for (int ai = 0; ai < 2; ++ai)
#pragma unroll
                    for (int m = 0; m < 4; ++m) { const f32x4 v0 = acc[ai][bj][m][0], v1 = acc[ai][bj][m][1]; u32x4 w;
                        w.x = pg8::cvt_pk_bf16(v0[0], v0[1]); w.y = pg8::cvt_pk_bf16(v0[2], v0[3]); w.z = pg8::cvt_pk_bf16(v1[0], v1[1]); w.w = pg8::cvt_pk_bf16(v1[2], v1[3]);
                        *(u32x4*)(base + (size_t)(ai * 128 + m * 16) * DIN) = w; }
            } else {
                const bool wide = mode != 3; const int half = wide ? 32 : 16, g = wide ? 4 * (wc & 1) + fq : fq;
                const int cbase = s * 128 + (wide ? 64 * (wc >> 1) : 32 * wc) + 4 * g;
                const float* ct = (const float*)(tab + (mode == 1 ? TAB_ATTN : (mode == 2 ? TAB_RET : TAB_DIFF))) + 4 * g; const int tstride = half, tsin = 16384 * half;
#pragma unroll
                for (int ai = 0; ai < 2; ++ai)
#pragma unroll
                    for (int m = 0; m < 4; ++m) { const int row = row0 + ai * 128 + m * 16; const f32x4 v0 = acc[ai][bj][m][0], v1 = acc[ai][bj][m][1];
                        f32x4 cs = {1.f, 1.f, 1.f, 1.f}, sn = {0.f, 0.f, 0.f, 0.f};
                        if (lat) { const float* tp = ct + (size_t)(row & (NSEQ - 1)) * tstride; cs = *(const f32x4*)tp; sn = *(const f32x4*)(tp + tsin); }
                        const f32x4 o1 = (v0 * cs - v1 * sn) * scale, o2 = (v1 * cs + v0 * sn) * scale;
                        bf16_t* op = O + (size_t)row * DIN + cbase;
                        uint2 w1, w2; w1.x = pg8::cvt_pk_bf16(o1[0], o1[1]); w1.y = pg8::cvt_pk_bf16(o1[2], o1[3]); w2.x = pg8::cvt_pk_bf16(o2[0], o2[1]); w2.y = pg8::cvt_pk_bf16(o2[2], o2[3]);
                        *(uint2*)op = w1; *(uint2*)(op + half) = w2; }
            }
        }
    }
};
__device__ __forceinline__ void ph_gemm_in(const Params& p, int l, int bid, int nb, float* lds) {
    char* ws = p.ws; pg8::Gemm g{(const bf16_t*)(ws + OFF_ACT), (const bf16_t*)(ws + OFF_WIN) + (size_t)l * DIN * DM, NROW, DIN, DM};
    pg8::StaticOrder S; S.init(NROW, DIN, nb, bid);
    EpiInProj E{(bf16_t*)(ws + OFF_P), ws + OFF_TAB};
    pg8::gemm_phase<EpiInProj, pg8::StaticOrder, true, true>(GEMM_LDS, g, S, E);
}
__device__ __forceinline__ void ph_gemm_out(const Params& p, int l, bool need_ctx, int bid, int nb, float* lds) {
    char* ws = p.ws; const int M = need_ctx ? NROW : NLAT;
    pg8::Gemm g{(const bf16_t*)(ws + OFF_ACT), (const bf16_t*)(ws + OFF_WOUT) + (size_t)l * DM * DM, M, DM, DM};
    pg8::StaticOrder S; S.init(M, DM, nb, bid);
    EpiResidual E{l == 0 ? p.x : p.out, p.out, (float*)(ws + OFF_XC), (const float*)(ws + OFF_MOD) + (size_t)l * 3 * 6144 + 2048};
    pg8::gemm_phase<EpiResidual, pg8::StaticOrder, true, true>(GEMM_LDS, g, S, E);
}
__device__ __forceinline__ void ph_ffn1(const Params& p, bool need_ctx, int bid, int nb, float* lds) {
    char* ws = p.ws; const int M = need_ctx ? NROW : NLAT;
    pg8::Gemm g{(const bf16_t*)(ws + OFF_ACT), (const bf16_t*)(ws + OFF_WF13), M, 2 * DFF, DM};
    pg8::StaticOrder S; S.init(M, 2 * DFF, nb, bid);
    EpiSwiglu E{(bf16_t*)(ws + OFF_P), DFF, 2 * DFF / 256};
    pg8::gemm_phase<EpiSwiglu, pg8::StaticOrder, true, true>(GEMM_LDS, g, S, E);
}
__device__ __forceinline__ void ph_ffn2(const Params& p, int l, bool need_ctx, int bid, int nb, float* lds) {
    char* ws = p.ws; const int M = need_ctx ? NROW : NLAT;
    pg8::Gemm g{(const bf16_t*)(ws + OFF_P), (const bf16_t*)(ws + OFF_WF2), M, DM, DFF};
    pg8::StaticOrder S; S.init(M, DM, nb, bid);
    EpiResidual E{p.out, p.out, (float*)(ws + OFF_XC), (const float*)(ws + OFF_MOD) + (size_t)l * 3 * 6144 + 5120};
    pg8::gemm_phase<EpiResidual, pg8::StaticOrder, true, true>(GEMM_LDS, g, S, E);
}
__device__ __forceinline__ MoeOrder moe_order(const int* og, int npe, int nb, int bid) {
    MoeOrder S; S.init(og[8], npe * 256, nb, bid); S.o1 = og[1]; S.o2 = og[2]; S.o3 = og[3]; S.o4 = og[4]; S.o5 = og[5]; S.o6 = og[6]; S.o7 = og[7]; S.npe = npe; return S;
}
__device__ __forceinline__ void ph_moe1(const Params& p, int g, int bid, int nb, float* lds) {
    char* ws = p.ws; int* offs = (int*)(lds + 32768); __syncthreads(); moe_offsets(p, offs);
    const MoeOrder S = moe_order(offs + g * 9, 2 * DFE / 256, nb, bid);
    pg8::Gemm gm{(const bf16_t*)(ws + OFF_ASORT) + (size_t)g * GRP_ROWS * DM, (const bf16_t*)(ws + OFF_WM13), 0, 0, DM};
    EpiSwiglu E{(bf16_t*)(ws + OFF_UMOE), DFE, 2 * DFE / 256};
    pg8::gemm_phase<EpiSwiglu, MoeOrder, true, true>(GEMM_LDS, gm, S, E);
}
__device__ __forceinline__ void ph_moe2(const Params& p, int l, int g, int bid, int nb, float* lds) {
    char* ws = p.ws; int* offs = (int*)(lds + 32768); __syncthreads(); moe_offsets(p, offs);
    const MoeOrder S = moe_order(offs + g * 9, DM / 256, nb, bid);
    pg8::Gemm gm{(const bf16_t*)(ws + OFF_UMOE), (const bf16_t*)(ws + OFF_WM2), 0, 0, DFE};
    EpiMoeScatter E{p.out, (const float*)(ws + OFF_MOD) + (size_t)l * 3 * 6144 + 5120, (const int*)(ws + OFF_TOK) + g * GRP_ROWS, (const float*)(ws + OFF_WGT) + g * GRP_ROWS, DM / 256};
    pg8::gemm_phase<EpiMoeScatter, MoeOrder, true, true>(GEMM_LDS, gm, S, E);
}

#define XB_TMO      128
#define XB_XCNT(j)  (256  + 64 * (j))
#define XB_XSUB(j)  (1280 + 64 * (j))
#define XB_XGEN(j)  (2304 + 64 * (j))
#define XB_TOP      3328
#define XB_TOPGEN   3392
#define XCD_BAR_WORDS 3456
#define XB_SPIN_CAP (1u << 22)

__device__ __forceinline__ unsigned xb_ld(unsigned* p)              { return __hip_atomic_load(p, __ATOMIC_RELAXED, __HIP_MEMORY_SCOPE_AGENT); }
__device__ __forceinline__ unsigned xb_add(unsigned* p, unsigned v) { return __hip_atomic_fetch_add(p, v, __ATOMIC_RELAXED, __HIP_MEMORY_SCOPE_AGENT); }
__device__ __forceinline__ unsigned xb_xcc_id() { return (unsigned)__builtin_amdgcn_s_getreg((3 << 11) | 20) & 0xFu; }
#define XB_SPIN(cond, bar) do { unsigned _sp = 0; while (cond) { __builtin_amdgcn_s_sleep(1); \
    if ((++_sp & 255u) == 0u) { if (xb_ld(&(bar)[XB_TMO])) break; if (_sp > XB_SPIN_CAP) { atomicAdd(&(bar)[XB_TMO], 1u); break; } } } } while (0)

struct XcdBarrier {
    unsigned* bar; unsigned x;
    volatile LAS unsigned* st;
};

__device__ __forceinline__ XcdBarrier xcd_barrier_post(unsigned* bar, volatile LAS unsigned* st) {
    XcdBarrier b; b.bar = bar; b.x = xb_xcc_id(); b.st = st;
    if (threadIdx.x == 0) (void)xb_add(&bar[XB_XCNT(b.x)], 1u);
    return b;
}
__device__ __forceinline__ void xcd_barrier_complete(unsigned* bar, unsigned x, unsigned& nloc, unsigned& nx) {
    const unsigned G = gridDim.x * gridDim.y * gridDim.z;
    unsigned sum, cnt, mine, sp = 0u;
    for (;;) {
        sum = 0u; cnt = 0u; mine = 0u;
#pragma unroll
        for (unsigned j = 0; j < 16; ++j) { const unsigned c = xb_ld(&bar[XB_XCNT(j)]); sum += c; cnt += (c > 0u) ? 1u : 0u; mine = (j == x) ? c : mine; }
        if (sum == G) break;
        __builtin_amdgcn_s_sleep(1);
        if ((++sp & 255u) == 0u) { if (xb_ld(&bar[XB_TMO])) break; if (sp > XB_SPIN_CAP) { atomicAdd(&bar[XB_TMO], 1u); break; } }
    }
    nloc = mine > 0u ? mine : 1u; nx = cnt > 0u ? cnt : 1u;
}

__device__ __forceinline__ void xcd_barrier(const XcdBarrier& b) {
    asm volatile("s_waitcnt vmcnt(0)" ::: "memory");
    __syncthreads();
    if (threadIdx.x == 0) {
        unsigned* bar = b.bar;
        __builtin_amdgcn_s_waitcnt(0);
        unsigned nloc = b.st[0], nx = b.st[1];
        if (nloc == 0u) { xcd_barrier_complete(bar, b.x, nloc, nx); b.st[0] = nloc; b.st[1] = nx; }
        const unsigned old = xb_add(&bar[XB_XSUB(b.x)], 1u);
        const unsigned gen = old / nloc;
        if (old + 1u == (gen + 1u) * nloc) {
            __builtin_amdgcn_fence(__ATOMIC_RELEASE, "agent");
            asm volatile("s_waitcnt vmcnt(0)" ::: "memory");
            const unsigned og = xb_add(&bar[XB_TOP], 1u);
            const unsigned tg = og / nx;
            if (og + 1u == (tg + 1u) * nx) xb_add(&bar[XB_TOPGEN], 1u);
            else XB_SPIN(xb_ld(&bar[XB_TOPGEN]) == tg, bar);
            __builtin_amdgcn_fence(__ATOMIC_ACQUIRE, "agent");
            xb_add(&bar[XB_XGEN(b.x)], 1u);
            asm volatile("s_waitcnt vmcnt(0)" ::: "memory");
        } else {
            XB_SPIN(xb_ld(&bar[XB_XGEN(b.x)]) == gen, bar);
            __builtin_amdgcn_fence(__ATOMIC_ACQUIRE, "agent");
            asm volatile("s_waitcnt vmcnt(0)" ::: "memory");
        }
    }
    __syncthreads();
}


constexpr int LDS_FLOATS = 33792;
constexpr int LDS_BYTES = LDS_FLOATS * 4 + 16 + 256;

typedef const __attribute__((address_space(4))) unsigned long long* kargp_t;
typedef __attribute__((address_space(1))) const float* gcf_t;
__device__ __forceinline__ Params load_params(const float* lds) {
    const LAS unsigned* tbl = (const LAS unsigned*)(lds + LDS_FLOATS + 4);
    Params p; const float** f = (const float**)&p;
#pragma unroll
    for (int i = 0; i < (int)(sizeof(Params) / 8); ++i) {
        const unsigned lo = __builtin_amdgcn_readfirstlane(tbl[2 * i]), hi = __builtin_amdgcn_readfirstlane(tbl[2 * i + 1]);
        f[i] = (const float*)(gcf_t)(((unsigned long long)hi << 32) | lo); }
    return p;
}
#define LOADP(name) const Params name = load_params(lds)

template <int l>
__device__ __forceinline__ void run_layer(const XcdBarrier& bar, int bid, int nb, float* lds) {
    constexpr bool need_ctx = l == 0;
    constexpr float lam_init = l == 0 ? 0.2f : 0.35550906759509393f;
    { LOADP(p); ph_norm<false>(p, l, 0, NROW, bid, nb, lds); } xcd_barrier(bar);
    { LOADP(p); ph_gemm_in(p, l, bid, nb, lds); } xcd_barrier(bar);
    { LOADP(p); ph_ret_summ(p, l, bid, nb, lds); } { LOADP(p); ph_lru_chunk<1>(p, l, bid, nb, lds, 0); } xcd_barrier(bar);
    { LOADP(p); ph_scan2(p, l, bid, nb); } xcd_barrier(bar);
    { LOADP(p); ph_diff(p, l, need_ctx, lam_init, bid, nb, lds); }
    { LOADP(p); ph_swa(p, l, need_ctx, bid, nb, lds); }
    { LOADP(p); ph_ret_out(p, l, bid, nb, lds, need_ctx ? 0 : 2); }
    { LOADP(p); ph_lru_chunk<3>(p, l, bid, nb, lds, need_ctx ? 0 : 2); } xcd_barrier(bar);
    { LOADP(p); ph_gemm_out(p, l, need_ctx, bid, nb, lds); } xcd_barrier(bar);
    if (l == 0) {
        { LOADP(p); ph_norm<false>(p, l, 1, NROW, bid, nb, lds); } xcd_barrier(bar);
        { LOADP(p); ph_ffn1(p, need_ctx, bid, nb, lds); } xcd_barrier(bar);
        { LOADP(p); ph_ffn2(p, l, need_ctx, bid, nb, lds); } xcd_barrier(bar);
    } else {
        { LOADP(p); ph_norm<true>(p, l, 1, NLAT, bid, nb, lds); } xcd_barrier(bar);
        { LOADP(p); ph_moe_scatter(p, bid, nb, lds); } xcd_barrier(bar);
        { LOADP(p); ph_moe1(p, 0, bid, nb, lds); } xcd_barrier(bar);
        { LOADP(p); ph_moe2(p, l, 0, bid, nb, lds); } xcd_barrier(bar);
        { LOADP(p); ph_moe1(p, 1, bid, nb, lds); } xcd_barrier(bar);
        { LOADP(p); ph_moe2(p, l, 1, bid, nb, lds); } xcd_barrier(bar);
    }
}

__global__ void __launch_bounds__(512, 2) fwd(Params p_in) {
    extern __shared__ __attribute__((aligned(16))) float lds[];
    volatile LAS unsigned* st = (volatile LAS unsigned*)(lds + LDS_FLOATS);
    if (threadIdx.x == 0) { st[0] = 0u; st[1] = 0u; st[2] = 0u; st[3] = 0u; }
    if (threadIdx.x < (int)(sizeof(Params) / 8)) { const kargp_t q = (kargp_t)__builtin_amdgcn_kernarg_segment_ptr(); ((LAS unsigned long long*)(lds + LDS_FLOATS + 4))[threadIdx.x] = q[threadIdx.x]; }
    __syncthreads();
    XcdBarrier bar;
    { LOADP(p); bar = xcd_barrier_post((unsigned*)p.ws, st); }
    const int bid = blockIdx.x, nb = gridDim.x;
    { LOADP(p); ph_prologue(p, bid, nb, lds); } xcd_barrier(bar);
    run_layer<0>(bar, bid, nb, lds);
    run_layer<1>(bar, bid, nb, lds);
    { LOADP(p); ph_final(p, bid, nb); }
}

extern "C" void kernel_launch(void* const* d_in, const int* in_sizes, int n_in, void* d_out, int out_size, void* d_ws, size_t ws_size, hipStream_t stream) {
    static int grid = 0;
    if (grid == 0) {
        if (n_in < 30 || ws_size < WS_NEED) { fprintf(stderr, "kernel_launch: bad args n_in=%d ws=%zu need=%zu\n", n_in, ws_size, (size_t)WS_NEED); grid = -1; return; }
        int dev = 0, cus = 0, per_cu = 0;
        if (hipGetDevice(&dev) != hipSuccess || hipDeviceGetAttribute(&cus, hipDeviceAttributeMultiprocessorCount, dev) != hipSuccess) { grid = -1; return; }
        if (hipFuncSetAttribute((const void*)fwd, hipFuncAttributeMaxDynamicSharedMemorySize, LDS_BYTES) != hipSuccess) { fprintf(stderr, "kernel_launch: hipFuncSetAttribute failed\n"); grid = -1; return; }
        if (hipOccupancyMaxActiveBlocksPerMultiprocessor(&per_cu, (const void*)fwd, 512, LDS_BYTES) != hipSuccess || per_cu < 1) { fprintf(stderr, "kernel_launch: occupancy query says %d\n", per_cu); per_cu = 1; }
        (void)hipGetLastError();
        grid = cus;
    }
    if (grid < 0) return;
    Params p{};
    const float** f = (const float**)&p;
    for (int i = 0; i < 30; ++i) f[i] = (const float*)d_in[i];
    p.out = (float*)d_out; p.ws = (char*)d_ws;
    (void)hipMemsetAsync(d_ws, 0, 65536, stream);
    hipLaunchKernelGGL(fwd, dim3(grid), dim3(512), LDS_BYTES, stream, p);
}
```

```cpp
#include <hip/hip_runtime.h>
#include <cstdio>
#include <cstdint>

typedef unsigned short bf16_t;
typedef short bf16x8 __attribute__((ext_vector_type(8)));
typedef float f32x4 __attribute__((ext_vector_type(4)));
typedef unsigned u32x4 __attribute__((ext_vector_type(4)));
#define LAS __attribute__((address_space(3)))

constexpr int NB = 2, NSEQ = 16384, NCTX = 256, DM = 1024;
constexpr int NLAT = NB * NSEQ;
constexpr int NCR = NB * NCTX;
constexpr int NROW = NLAT + NCR;
constexpr int DIN = 2816, DFF = 2816, DFE = 3584, NE = 8;
constexpr int NCI = 130;
constexpr int C_AQ = 0, C_AK = 256, C_AV = 384, C_RQ = 512, C_RK = 768, C_RV = 1024, C_RG = 1280, C_DQ = 1536, C_DK = 1792, C_DV = 2048, C_LX = 2304, C_LY = 2560;
constexpr int GRP_ROWS = 34816;

constexpr size_t al256(size_t x) { return (x + 255) & ~(size_t)255; }
constexpr size_t OFF_CTRL = 0;
constexpr size_t OFF_MOD = 65536;
constexpr size_t OFF_TAB = al256(OFF_MOD + 2 * 3 * 6144 * 4);
constexpr size_t TAB_ATTN = 0, TAB_RET = 4u << 20, TAB_DIFF = 8u << 20;
constexpr size_t OFF_XC = al256(OFF_TAB + (10u << 20));
constexpr size_t OFF_ROUTE = al256(OFF_XC + (size_t)NCR * DM * 4);
constexpr size_t OFF_TOK = al256(OFF_ROUTE + (size_t)NLAT * 16);
constexpr size_t OFF_WGT = al256(OFF_TOK + (size_t)2 * GRP_ROWS * 4);
constexpr size_t OFF_LRU = al256(OFF_WGT + (size_t)2 * GRP_ROWS * 4);
constexpr size_t OFF_WM13 = al256(OFF_LRU + (size_t)3 * 2 * 2 * NCI * 256 * 4);
constexpr size_t OFF_WM2 = al256(OFF_WM13 + (size_t)NE * 2 * DFE * DM * 2);
constexpr size_t OFF_R = al256(OFF_WM2 + (size_t)NE * DM * DFE * 2);
constexpr size_t OFF_P = OFF_R;
constexpr size_t OFF_ACT = al256(OFF_P + (size_t)NROW * DIN * 2);
constexpr size_t OFF_RET = al256(OFF_ACT + (size_t)NROW * DM * 2);
constexpr size_t OFF_WIN = al256(OFF_RET + (size_t)2 * 2 * NCI * 4 * 4096 * 4);
constexpr size_t OFF_WOUT = al256(OFF_WIN + (size_t)2 * DIN * DM * 2);
constexpr size_t OFF_WF13 = al256(OFF_WOUT + (size_t)2 * DM * DM * 2);
constexpr size_t OFF_WF2 = al256(OFF_WF13 + (size_t)2 * DFF * DM * 2);
constexpr size_t OFF_R_END1 = al256(OFF_WF2 + (size_t)DM * DFF * 2);
constexpr size_t OFF_ASORT = OFF_R;
constexpr size_t OFF_UMOE = al256(OFF_ASORT + (size_t)2 * GRP_ROWS * DM * 2);
constexpr size_t OFF_R_END2 = al256(OFF_UMOE + (size_t)GRP_ROWS * DFE * 2);
constexpr size_t WS_NEED = OFF_R_END1 > OFF_R_END2 ? OFF_R_END1 : OFF_R_END2;
static_assert(OFF_ACT >= OFF_UMOE, "H2 must not overlap A_sorted");
constexpr int CW_CNT = 4096;
constexpr int CW_BLK = 8192;

struct Params {
    const float *x, *c, *ctx, *c_ctx, *w_ada, *b_ada, *g1, *g2, *w_in, *w_out, *sink, *ret_logit, *ret_gn, *diff_lam, *diff_gn,
        *conv_w, *conv_b, *lru_wa, *lru_ba, *lru_wx, *lru_bx, *lru_lam, *ffn_w1, *ffn_w3, *ffn_w2, *moe_router, *moe_w1, *moe_w3, *moe_w2, *final_norm;
    float* out; char* ws;
};

__device__ __forceinline__ int ltid_() { int t = threadIdx.x; asm volatile("" : "+v"(t)); return t; }
#define TIDX ltid_()
__device__ __forceinline__ float bf2f(bf16_t h) { return __uint_as_float(((unsigned)h) << 16); }
__device__ __forceinline__ bf16_t f2bf(float f) { unsigned u = __float_as_uint(f); u += 0x7fffu + ((u >> 16) & 1u); return (bf16_t)(u >> 16); }
__device__ __forceinline__ unsigned pack2(float lo, float hi) { return (unsigned)f2bf(lo) | ((unsigned)f2bf(hi) << 16); }
__device__ __forceinline__ float wave_sum(float v) {
#pragma unroll
    for (int o = 32; o >= 1; o >>= 1) v += __shfl_xor(v, o);
    return v;
}
__device__ __forceinline__ float sigmoidf_(float x) { return 1.0f / (1.0f + __expf(-x)); }
__device__ __forceinline__ float siluf_(float x) { return x / (1.0f + __expf(-x)); }
__device__ __forceinline__ float fast_silu(float v) { return v * __builtin_amdgcn_rcpf(1.0f + __expf(-v)); }
__device__ __forceinline__ float softplusf_(float x) { return x > 20.f ? x : log1pf(expf(x)); }
__device__ __forceinline__ float gelu_tanh(float x) { const float u = 0.7978845608028654f * (x + 0.044715f * x * x * x); return x * __builtin_amdgcn_rcpf(1.0f + __expf(-2.0f * u)); }
__device__ __forceinline__ int row_base(int b, int ci) { return ci < 2 ? NLAT + b * NCTX + ci * 128 : b * NSEQ + (ci - 2) * 128; }
__device__ __forceinline__ int mod_class(int row) { return row < NSEQ ? 0 : (row < NLAT ? 1 : 2); }

typedef float f32x16 __attribute__((ext_vector_type(16)));
typedef short s16x4 __attribute__((ext_vector_type(4)));
typedef short v4i16_t __attribute__((ext_vector_type(4)));
typedef float f32x2_t __attribute__((ext_vector_type(2)));
typedef __bf16 bf16x2_t __attribute__((ext_vector_type(2)));
__device__ __forceinline__ unsigned cvtpk_s(float lo, float hi) { f32x2_t v = {lo, hi}; bf16x2_t bb = __builtin_convertvector(v, bf16x2_t); return __builtin_bit_cast(unsigned, bb); }
__device__ __forceinline__ int crow(int r, int hi) { return (r & 3) + 8 * (r >> 2) + 4 * hi; }
__device__ __forceinline__ s16x4 vtr(const LAS char* p) { return __builtin_bit_cast(s16x4, __builtin_amdgcn_ds_read_tr16_b64_v4i16((LAS v4i16_t*)p)); }
__device__ __forceinline__ float bfs(short s) { return __uint_as_float(((unsigned)(unsigned short)s) << 16); }

__device__ __forceinline__ void convert_tile(const float* src, int K, int N, bf16_t* dst, int tile, int mode, float* lds) {
    const int tpn = N / 64, tk = tile / tpn, tn = tile % tpn, t = TIDX;
    {   const int kk = t >> 3, nc = (t & 7) * 8;
        const float4 a = *(const float4*)(src + (size_t)(tk * 64 + kk) * N + tn * 64 + nc);
        const float4 b = *(const float4*)(src + (size_t)(tk * 64 + kk) * N + tn * 64 + nc + 4);
        float* d = lds + kk * 65 + nc; d[0] = a.x; d[1] = a.y; d[2] = a.z; d[3] = a.w; d[4] = b.x; d[5] = b.y; d[6] = b.z; d[7] = b.w; }
    __syncthreads();
    {   const int n = t >> 3, kc = (t & 7) * 8, ng = tn * 64 + n;
        int nrow;
        if (mode == 3) {
            const int s = ng >> 7; const bool r64 = s <= 2 || (s >= 4 && s <= 7), r32 = s >= 12 && s <= 15;
            if (r64) { const int d = ng & 63; nrow = (ng & ~63) + 8 * ((d & 31) >> 2) + 4 * (d >> 5) + (d & 3); }
            else if (r32) { const int d = ng & 31; nrow = (ng & ~31) + 8 * ((d & 15) >> 2) + 4 * (d >> 4) + (d & 3); }
            else nrow = ng;
        } else nrow = mode == 0 ? ng : ((ng >> 7) * 256 + (mode == 2 ? 128 : 0) + (ng & 127));
        uint4 w; w.x = pack2(lds[(kc + 0) * 65 + n], lds[(kc + 1) * 65 + n]); w.y = pack2(lds[(kc + 2) * 65 + n], lds[(kc + 3) * 65 + n]);
        w.z = pack2(lds[(kc + 4) * 65 + n], lds[(kc + 5) * 65 + n]); w.w = pack2(lds[(kc + 6) * 65 + n], lds[(kc + 7) * 65 + n]);
        *(uint4*)(dst + (size_t)nrow * K + tk * 64 + kc) = w; }
    __syncthreads();
}

__device__ __forceinline__ void ph_prologue(const Params& p, int bid, int nb, float* lds) {
    char* ws = p.ws; const int t = TIDX;
    {
        struct Job { const float* src; bf16_t* dst; int K, N, mode, base; };
        Job* jobs = (Job*)(lds + 64 * 65 + 3);
        const int T_IN = 16 * 44, T_OUT = 16 * 16, T_F13 = 16 * 44, T_F2 = 44 * 16, T_M13 = 16 * 56, T_M2 = 56 * 16;
        const int total = 2 * T_IN + 2 * T_OUT + 2 * T_F13 + T_F2 + 16 * T_M13 + 8 * T_M2;
        if (t < 32) {
            Job jb; jb.src = nullptr; jb.dst = nullptr; jb.K = DM; jb.N = DM; jb.mode = 0; jb.base = total;
            if (t < 2) { jb.src = p.w_in + (size_t)t * DM * DIN; jb.dst = (bf16_t*)(ws + OFF_WIN) + (size_t)t * DIN * DM; jb.N = DIN; jb.mode = 3; jb.base = t * T_IN; }
            else if (t < 4) { jb.src = p.w_out + (size_t)(t - 2) * DM * DM; jb.dst = (bf16_t*)(ws + OFF_WOUT) + (size_t)(t - 2) * DM * DM; jb.base = 2 * T_IN + (t - 2) * T_OUT; }
            else if (t < 6) { jb.src = t == 4 ? p.ffn_w1 : p.ffn_w3; jb.dst = (bf16_t*)(ws + OFF_WF13); jb.N = DFF; jb.mode = t - 3; jb.base = 2 * T_IN + 2 * T_OUT + (t - 4) * T_F13; }
            else if (t == 6) { jb.src = p.ffn_w2; jb.dst = (bf16_t*)(ws + OFF_WF2); jb.K = DFF; jb.base = 2 * T_IN + 2 * T_OUT + 2 * T_F13; }
            else if (t < 23) { const int q = t - 7, e = q & 7, w3 = q >> 3; jb.src = (w3 ? p.moe_w3 : p.moe_w1) + (size_t)e * DM * DFE; jb.dst = (bf16_t*)(ws + OFF_WM13) + (size_t)e * 2 * DFE * DM; jb.N = DFE; jb.mode = 1 + w3;
                jb.base = 2 * T_IN + 2 * T_OUT + 2 * T_F13 + T_F2 + q * T_M13; }
            else if (t < 31) { const int e = t - 23; jb.src = p.moe_w2 + (size_t)e * DFE * DM; jb.dst = (bf16_t*)(ws + OFF_WM2) + (size_t)e * DM * DFE; jb.K = DFE;
                jb.base = 2 * T_IN + 2 * T_OUT + 2 * T_F13 + T_F2 + 16 * T_M13 + e * T_M2; }
            jobs[t] = jb;
        }
        __syncthreads();
        int j = 0;
        for (int u = bid; u < total; u += nb) {
            while (u >= jobs[j + 1].base) ++j;
            const Job jb = jobs[j];
            convert_tile(jb.src, jb.K, jb.N, jb.dst, u - jb.base, jb.mode, lds);
        }
        __syncthreads();
    }
    {
        float* sv = lds;
        float* red = lds + 3072;
        for (int i = t; i < 3072; i += 512) { const int v = i >> 10, k = i & 1023; const float cv = v < 2 ? p.c[v * DM + k] : p.c_ctx[k]; sv[i] = siluf_(cv); }
        __syncthreads();
        float* mod = (float*)(ws + OFF_MOD);
        for (int u = bid; u < 2 * 96; u += nb) {
            const int l = u / 96, j0 = (u % 96) * 64, j = t & 63, kg = t >> 6;
            float a0 = 0.f, a1 = 0.f, a2 = 0.f;
            const float* w = p.w_ada + (size_t)l * DM * 6144 + j0 + j;
            for (int k = kg * 128; k < kg * 128 + 128; ++k) { const float wv = w[(size_t)k * 6144]; a0 += sv[k] * wv; a1 += sv[1024 + k] * wv; a2 += sv[2048 + k] * wv; }
            red[(kg * 3 + 0) * 64 + j] = a0; red[(kg * 3 + 1) * 64 + j] = a1; red[(kg * 3 + 2) * 64 + j] = a2;
            __syncthreads();
            if (t < 192) { const int v = t >> 6; float s = 0.f;
                for (int g = 0; g < 8; ++g) s += red[(g * 3 + v) * 64 + j];
                mod[((size_t)l * 3 + v) * 6144 + j0 + j] = s + p.b_ada[l * 6144 + j0 + j]; }
            __syncthreads();
        }
    }
    {
        const int gt = bid * 512 + t, gs = nb * 512;
        float* ta = (float*)(ws + OFF_TAB + TAB_ATTN); float* tr = (float*)(ws + OFF_TAB + TAB_RET); float* td = (float*)(ws + OFF_TAB + TAB_DIFF);
        for (int i = gt; i < 16384 * 32; i += gs) { const int n = i >> 5, j = i & 31;
            { const float inv = (float)pow(10000.0, -(double)j / 32.0); const float ang = (float)n * inv; tr[i] = (float)cos((double)ang); tr[16384 * 32 + i] = (float)sin((double)ang); }
            { const float inv = (float)pow(10000.0, -(double)(j & 15) / 16.0); const float ang = (float)(j < 16 ? (n >> 6) : (n & 63)) * inv; ta[i] = (float)cos((double)ang); ta[16384 * 32 + i] = (float)sin((double)ang); }
            if (j < 16) { const float inv = (float)pow(10000.0, -(double)(j & 7) / 8.0); const float ang = (float)(j < 8 ? (n >> 6) : (n & 63)) * inv; td[n * 16 + j] = (float)cos((double)ang); td[16384 * 16 + n * 16 + j] = (float)sin((double)ang); } }
        float* xc = (float*)(ws + OFF_XC);
        for (int i = gt; i < NCR * DM / 4; i += gs) ((float4*)xc)[i] = ((const float4*)p.ctx)[i];
        int* tok = (int*)(ws + OFF_TOK);
        for (int i = gt; i < 2 * GRP_ROWS; i += gs) tok[i] = -1;
    }
}

template <bool ROUTE>
__device__ __forceinline__ void ph_norm(const Params& p, int l, int which  , int nrows, int bid, int nb, float* lds) {
    char* ws = p.ws; const int lane = TIDX & 63, wv = TIDX >> 6;
    LAS unsigned* lcnt = (LAS unsigned*)lds;
    if (ROUTE) { __syncthreads(); if (TIDX < 16) lcnt[TIDX] = 0u; __syncthreads(); }
    const float* mod = (const float*)(ws + OFF_MOD) + (size_t)l * 3 * 6144;
    const float* g = (which == 0 ? p.g1 : p.g2) + l * DM;
    bf16_t* H = (bf16_t*)(ws + OFF_ACT);
    const float* xl = (which == 0 && l == 0) ? p.x : p.out;
    const float* xc = (const float*)(ws + OFF_XC);
    const int stride = nb * 8;
    for (int r0 = bid * 8 + wv; r0 < nrows; r0 += 2 * stride) {
        float4 v[2][4]; float ss[2]; const bool has1 = r0 + stride < nrows;
#pragma unroll
        for (int q = 0; q < 2; ++q) { const int r = (q == 0 || has1) ? r0 + q * stride : r0;
            const float* xr = r < NLAT ? xl + (size_t)r * DM : xc + (size_t)(r - NLAT) * DM;
#pragma unroll
            for (int i = 0; i < 4; ++i) v[q][i] = *(const float4*)(xr + i * 256 + lane * 4); }
#pragma unroll
        for (int q = 0; q < 2; ++q) { float s = 0.f;
#pragma unroll
            for (int i = 0; i < 4; ++i) s += v[q][i].x * v[q][i].x + v[q][i].y * v[q][i].y + v[q][i].z * v[q][i].z + v[q][i].w * v[q][i].w;
            ss[q] = wave_sum(s); }
#pragma unroll
        for (int q = 0; q < 2; ++q) {
            if (q == 1 && !has1) break;
            const int r = r0 + q * stride;
            const float* mv = mod + (size_t)mod_class(r) * 6144 + (which == 0 ? 0 : 3072);
            const float rn = rsqrtf(ss[q] * (1.0f / 1024.0f) + 1e-6f);
            float lg[8];
            if (ROUTE) {
#pragma unroll
                for (int e = 0; e < 8; ++e) lg[e] = 0.f;
            }
#pragma unroll
            for (int i = 0; i < 4; ++i) {
                const int c = i * 256 + lane * 4;
                const float4 gg = *(const float4*)(g + c), sh = *(const float4*)(mv + c), sc = *(const float4*)(mv + 1024 + c);
                float h0 = v[q][i].x * rn * gg.x * (1.f + sc.x) + sh.x, h1 = v[q][i].y * rn * gg.y * (1.f + sc.y) + sh.y;
                float h2 = v[q][i].z * rn * gg.z * (1.f + sc.z) + sh.z, h3 = v[q][i].w * rn * gg.w * (1.f + sc.w) + sh.w;
                uint2 w; w.x = pack2(h0, h1); w.y = pack2(h2, h3);
                *(uint2*)(H + (size_t)r * DM + c) = w;
                if (ROUTE) {
                    const float* rt = p.moe_router + (size_t)c * 8;
#pragma unroll
                    for (int e = 0; e < 8; ++e) lg[e] += h0 * rt[e] + h1 * rt[8 + e] + h2 * rt[16 + e] + h3 * rt[24 + e];
                }
            }
            if (ROUTE) {
#pragma unroll
                for (int e = 0; e < 8; ++e) lg[e] = wave_sum(lg[e]);
                if (lane == 0 && r < NLAT) {
                    int e0 = 0; float v0 = lg[0];
#pragma unroll
                    for (int e = 1; e < 8; ++e) if (lg[e] > v0) { v0 = lg[e]; e0 = e; }
                    int e1 = -1; float v1 = -3.0e38f;
#pragma unroll
                    for (int e = 0; e < 8; ++e) if (e != e0 && lg[e] > v1) { v1 = lg[e]; e1 = e; }
                    const float ex = __expf(v1 - v0), w0 = 1.0f / (1.0f + ex), w1 = ex / (1.0f + ex);
                    const unsigned li0 = __hip_atomic_fetch_add(lcnt + e0, 1u, __ATOMIC_RELAXED, __HIP_MEMORY_SCOPE_WORKGROUP), li1 = __hip_atomic_fetch_add(lcnt + 8 + e1, 1u, __ATOMIC_RELAXED, __HIP_MEMORY_SCOPE_WORKGROUP);
                    int4 rec; rec.x = e0 | (int)(li0 << 4); rec.y = e1 | (int)(li1 << 4); rec.z = __float_as_int(w0); rec.w = __float_as_int(w1);
                    *(int4*)(ws + OFF_ROUTE + (size_t)r * 16) = rec;
                }
            }
        }
    }
    if (ROUTE) {
        __syncthreads();
        if (TIDX < 16) { unsigned* cw = (unsigned*)ws; const int t = TIDX; cw[CW_BLK + bid * 16 + t] = atomicAdd(cw + CW_CNT + t, lcnt[t]); }
    }
}

namespace pg8 {
#define PG8_LAS __attribute__((address_space(3)))
typedef unsigned short bf16_t;
typedef short bf16x8 __attribute__((ext_vector_type(8)));
typedef float f32x4 __attribute__((ext_vector_type(4)));
typedef unsigned u32x4 __attribute__((ext_vector_type(4)));
constexpr int BM = 256, BK = 64, HALF = 128, HTB = HALF * BK * 2  , STAGE_BYTES = 8 * HTB, NXCD = 8, WGM = 8;

__host__ __device__ __forceinline__ int lds_byte(int r, int c) { const int st = (r >> 4) * 2 + (c >> 5), rr = r & 15, cc = c & 31, ob = rr * 64 + cc * 2; return st * 1024 + (ob ^ (((ob >> 9) & 1) << 5)); }
__host__ __device__ __forceinline__ void stage_rc(int b, int& R, int& C) { const int st = b / 1024, sb = b % 1024, swz = sb ^ (((sb >> 9) & 1) << 5); R = (st >> 1) * 16 + swz / 64; C = (st & 1) * 32 + (swz % 64) / 2; }
__host__ __device__ __forceinline__ int perm32(int rho) { const int n = rho >> 4, i = rho & 15; return 8 * (i >> 2) + 4 * n + (i & 3); }

struct Unit { int pm, pn; };
struct Gemm { const bf16_t* A; const bf16_t* Bt; int M, N, K; };

struct StaticOrder {
    int nM, nN, nwg, G, c;
    __host__ __device__ void init(int M, int N, int G_, int c_) { nM = M / BM; nN = N / BM; nwg = nM * nN; G = G_; c = c_; }
    __host__ __device__ bool next(int i, Unit& u) const {
        const long L = (long)i * G + c; if (L >= nwg) return false;
        int wgid = (int)L; { const int q = nwg / NXCD, r = nwg % NXCD, xcd = wgid % NXCD, off = wgid / NXCD; wgid = (xcd < r ? xcd * (q + 1) : r * (q + 1) + (xcd - r) * q) + off; }
        const int nig = WGM * nN, gid = wgid / nig, fm = gid * WGM, gsz = (nM - fm) < WGM ? (nM - fm) : WGM;
        u.pm = fm + ((wgid % nig) % gsz); u.pn = (wgid % nig) / gsz; return true;
    }
    __device__ __forceinline__ void a_ready(const Unit&) const {}
    __device__ __forceinline__ void done(const Unit&) const {}
};
__device__ __forceinline__ unsigned cvt_pk_bf16(float lo, float hi) { unsigned r; asm volatile("v_cvt_pk_bf16_f32 %0, %1, %2" : "=v"(r) : "v"(lo), "v"(hi)); return r; }
typedef float f32x2 __attribute__((ext_vector_type(2)));
template <class Epi, class Sched, bool ALIGN_EPI = false, bool SP2 = false>
__device__ __forceinline__ void gemm_phase(PG8_LAS unsigned char* lds, const Gemm g, const Sched& S, const Epi& E) {
    int tid_ = threadIdx.x; asm volatile("" : "+v"(tid_));
    const int tid = tid_, wid = __builtin_amdgcn_readfirstlane(tid >> 6), lane = tid & 63, wr = wid >> 2, wc = wid & 3, fr = lane & 15, fq = lane >> 4;
    const int K = g.K, nt = K / BK;
    unsigned voffA[2], voffB[2];
#pragma unroll
    for (int i = 0; i < 2; ++i) { int R, C; stage_rc(tid * 16 + i * 8192, R, C); const int Rb = Epi::PERM ? ((R & ~31) + perm32(R & 31)) : R;
        voffA[i] = (unsigned)(R * K + C) * 2u; voffB[i] = (unsigned)(Rb * K + C) * 2u; }
    const size_t kstep = (size_t)(BK * 2);
    const size_t hstep = (size_t)HALF * K * 2;
    const size_t tstep = 2 * hstep;
    const unsigned ldsw = (unsigned)wid * 1024u;
    const int aoff = lds_byte(wr * 64 + fr, fq * 8), boff = lds_byte(wc * 32 + fr, fq * 8);
#define PG8_SA(b, h) (((b) * 2 + (h)) * HTB)
#define PG8_SB(b, h) ((4 + (b) * 2 + (h)) * HTB)
#define PG8_STAGE(bufoff, gbase, voff) do { _Pragma("unroll") for (int _i = 0; _i < 2; ++_i) \
        __builtin_amdgcn_global_load_lds((const unsigned*)((const char*)(gbase) + (voff)[_i]), (PG8_LAS unsigned*)(lds + (bufoff) + ldsw + _i * 8192), 16, 0, 0); } while (0)
#define PG8_LDA(dst, b, h) do { _Pragma("unroll") for (int m = 0; m < 4; ++m) _Pragma("unroll") for (int k = 0; k < 2; ++k) dst[m][k] = *(const PG8_LAS bf16x8*)(lds + PG8_SA(b, h) + aoff + m * 2048 + k * 1024); } while (0)
#define PG8_LDB(dst, b, h) do { _Pragma("unroll") for (int n = 0; n < 2; ++n) _Pragma("unroll") for (int k = 0; k < 2; ++k) dst[n][k] = *(const PG8_LAS bf16x8*)(lds + PG8_SB(b, h) + boff + n * 2048 + k * 1024); } while (0)
#define PG8_MMA(ai, bj, At, Bt) do { __builtin_amdgcn_s_setprio(1); _Pragma("unroll") for (int m = 0; m < 4; ++m) _Pragma("unroll") for (int n = 0; n < 2; ++n) _Pragma("unroll") for (int k = 0; k < 2; ++k) \
        acc[ai][bj][m][n] = __builtin_amdgcn_mfma_f32_16x16x32_bf16(Bt[n][k], At[m][k], acc[ai][bj][m][n], 0, 0, 0); __builtin_amdgcn_s_setprio(0); } while (0)
#define PG8_WAIT_V(n) asm volatile("s_waitcnt vmcnt(" #n ")" ::: "memory")
#define PG8_WAIT_L(n) asm volatile("s_waitcnt lgkmcnt(" #n ")" ::: "memory")
#define PG8_BAR __builtin_amdgcn_s_barrier()
#define PG8_SCHED __builtin_amdgcn_sched_barrier(0)
    Unit cur, nxt; int ui = 0;
    if (!S.next(0, cur)) return;
    f32x4 acc[2][2][4][2];
#pragma unroll
    for (int a = 0; a < 2; ++a)
#pragma unroll
        for (int b = 0; b < 2; ++b)
#pragma unroll
            for (int m = 0; m < 4; ++m)
#pragma unroll
                for (int n = 0; n < 2; ++n) acc[a][b][m][n] = (f32x4){0.f, 0.f, 0.f, 0.f};
    bf16x8 At[4][2], B0[2][2], B1[2][2];
    const char* cA = (const char*)g.A + (size_t)cur.pm * tstep; const char* cB = (const char*)g.Bt + (size_t)cur.pn * tstep;
    S.a_ready(cur);
    if constexpr (SP2) {
        PG8_STAGE(PG8_SB(0, 0), cB, voffB); PG8_STAGE(PG8_SB(0, 1), cB + hstep, voffB); PG8_STAGE(PG8_SA(0, 0), cA, voffA); PG8_STAGE(PG8_SA(0, 1), cA + hstep, voffA);
        if (wr == 1) PG8_BAR;
        PG8_WAIT_V(2); PG8_BAR;
        PG8_STAGE(PG8_SB(1, 0), cB + kstep, voffB); PG8_STAGE(PG8_SA(1, 0), cA + kstep, voffA); PG8_STAGE(PG8_SB(1, 1), cB + hstep + kstep, voffB);
        PG8_WAIT_V(6); PG8_BAR;
    } else {
        PG8_STAGE(PG8_SB(0, 0), cB, voffB); PG8_STAGE(PG8_SA(0, 0), cA, voffA); PG8_STAGE(PG8_SB(0, 1), cB + hstep, voffB); PG8_STAGE(PG8_SA(0, 1), cA + hstep, voffA);
        if (wr == 1) PG8_BAR;
        PG8_WAIT_V(4); PG8_BAR;
        PG8_STAGE(PG8_SB(1, 0), cB + kstep, voffB); PG8_STAGE(PG8_SA(1, 0), cA + kstep, voffA); PG8_STAGE(PG8_SB(1, 1), cB + hstep + kstep, voffB);
        PG8_WAIT_V(6); PG8_BAR;
    }
    for (;;) {
        const bool has_next = S.next(ui + 1, nxt);
        const char* nA = has_next ? (const char*)g.A + (size_t)nxt.pm * tstep : cA; const char* nB = has_next ? (const char*)g.Bt + (size_t)nxt.pn * tstep : cB;
        for (int t = 0; t < nt; t += 2) {
            const bool last = (t == nt - 2);
            const char* a1 = cA + (size_t)(t + 1) * kstep;
            const char* a2 = last ? nA : cA + (size_t)(t + 2) * kstep; const char* b2 = last ? nB : cB + (size_t)(t + 2) * kstep;
            const char* a3 = a2 + kstep; const char* b3 = b2 + kstep;
            if (last && has_next) S.a_ready(nxt);
            if constexpr (SP2) {
            PG8_LDB(B0, 0, 0); PG8_LDB(B1, 0, 1); PG8_SCHED; PG8_LDA(At, 0, 0); PG8_STAGE(PG8_SA(1, 1), a1 + hstep, voffA);
            PG8_WAIT_V(8); PG8_WAIT_L(0); PG8_BAR; PG8_MMA(0, 0, At, B0); PG8_MMA(0, 1, At, B1); PG8_BAR; PG8_SCHED;
            PG8_LDA(At, 0, 1); PG8_STAGE(PG8_SB(0, 0), b2, voffB); PG8_STAGE(PG8_SB(0, 1), b2 + hstep, voffB); PG8_STAGE(PG8_SA(0, 0), a2, voffA);
            PG8_WAIT_V(8); PG8_WAIT_L(0); PG8_BAR; PG8_MMA(1, 0, At, B0); PG8_MMA(1, 1, At, B1); PG8_BAR; PG8_SCHED;
            PG8_LDB(B0, 1, 0); PG8_LDB(B1, 1, 1); PG8_SCHED; PG8_LDA(At, 1, 0); PG8_STAGE(PG8_SA(0, 1), a2 + hstep, voffA);
            PG8_WAIT_V(8); PG8_WAIT_L(0); PG8_BAR; PG8_MMA(0, 0, At, B0); PG8_MMA(0, 1, At, B1); PG8_BAR; PG8_SCHED;
            PG8_LDA(At, 1, 1); PG8_STAGE(PG8_SB(1, 0), b3, voffB); PG8_STAGE(PG8_SB(1, 1), b3 + hstep, voffB); PG8_STAGE(PG8_SA(1, 0), a3, voffA);
            PG8_WAIT_V(8); PG8_WAIT_L(0); PG8_BAR; PG8_MMA(1, 0, At, B0); PG8_MMA(1, 1, At, B1); PG8_BAR; PG8_SCHED;
            } else {
            PG8_LDB(B0, 0, 0); PG8_SCHED; PG8_LDA(At, 0, 0); PG8_STAGE(PG8_SA(1, 1), a1 + hstep, voffA);
            PG8_WAIT_L(8); PG8_BAR; PG8_WAIT_L(0); PG8_MMA(0, 0, At, B0); PG8_BAR; PG8_SCHED;
            PG8_LDB(B1, 0, 1); PG8_STAGE(PG8_SB(0, 0), b2, voffB);
            PG8_BAR; PG8_WAIT_L(0); PG8_MMA(0, 1, At, B1); PG8_BAR;
            PG8_LDA(At, 0, 1); PG8_STAGE(PG8_SA(0, 0), a2, voffA);
            PG8_BAR; PG8_WAIT_L(0); PG8_MMA(1, 0, At, B0); PG8_BAR; PG8_SCHED;
            PG8_STAGE(PG8_SB(0, 1), b2 + hstep, voffB);
            PG8_WAIT_V(6); PG8_BAR; PG8_MMA(1, 1, At, B1); PG8_BAR;
            PG8_LDB(B0, 1, 0); PG8_SCHED; PG8_LDA(At, 1, 0); PG8_STAGE(PG8_SA(0, 1), a2 + hstep, voffA);
            PG8_WAIT_L(8); PG8_BAR; PG8_WAIT_L(0); PG8_MMA(0, 0, At, B0); PG8_BAR; PG8_SCHED;
            PG8_LDB(B1, 1, 1); PG8_STAGE(PG8_SB(1, 0), b3, voffB);
            PG8_BAR; PG8_WAIT_L(0); PG8_MMA(0, 1, At, B1); PG8_BAR;
            PG8_LDA(At, 1, 1); PG8_STAGE(PG8_SA(1, 0), a3, voffA);
            PG8_BAR; PG8_WAIT_L(0); PG8_MMA(1, 0, At, B0); PG8_BAR; PG8_SCHED;
            PG8_STAGE(PG8_SB(1, 1), b3 + hstep, voffB);
            PG8_WAIT_V(6); PG8_BAR; PG8_MMA(1, 1, At, B1); PG8_BAR;
            }
        }
        if constexpr (ALIGN_EPI) { if (wr == 0) PG8_BAR; }
        if constexpr (!Epi::AFTER_DRAIN) { E(acc, cur, wr, wc, fr, fq); S.done(cur); }
        if (!has_next) break;
#pragma unroll
        for (int a = 0; a < 2; ++a)
#pragma unroll
            for (int b = 0; b < 2; ++b)
#pragma unroll
                for (int m = 0; m < 4; ++m)
#pragma unroll
                    for (int n = 0; n < 2; ++n) acc[a][b][m][n] = (f32x4){0.f, 0.f, 0.f, 0.f};
        cur = nxt; cA = nA; cB = nB; ++ui;
        if constexpr (ALIGN_EPI) { if (wr == 1) PG8_BAR; }
    }
    PG8_WAIT_V(0);
    if constexpr (!ALIGN_EPI) { if (wr == 0) PG8_BAR; }
    PG8_BAR;
    if constexpr (Epi::AFTER_DRAIN) { E.fused(acc, cur, wr, wc, fr, fq, lds, wid, lane); S.done(cur); }
#undef PG8_SA
#undef PG8_SB
#undef PG8_STAGE
#undef PG8_LDA
#undef PG8_LDB
#undef PG8_MMA
#undef PG8_WAIT_V
#undef PG8_WAIT_L
#undef PG8_BAR
#undef PG8_SCHED
}
}

constexpr int RT_K = 0, RT_V = 32768, RT_ST = 65536;
template <bool KV> __device__ __forceinline__ void ret_stage(const bf16_t* P, int rb, int hp, LAS char* sm, int tid, int wid, int lane) {
    const int vrow = 16 * (wid & 3) + (lane >> 2), vc = (wid >> 2) * 32 + (lane & 3) * 8;
    u32x4 kk[4], vv[4];
#pragma unroll
    for (int i = 0; i < 4; ++i) { const int hh = i >> 1, tt = i & 1, h = 2 * hp + hh, r0 = rb + tt * 64;
        vv[i] = *(const u32x4*)(P + (size_t)(r0 + vrow) * DIN + C_RV + h * 64 + vc);
        kk[i] = KV ? *(const u32x4*)(P + (size_t)(r0 + vrow) * DIN + C_RK + h * 64 + vc) : *(const u32x4*)(P + (size_t)(r0 + lane) * DIN + C_RK + h * 64 + wid * 8); }
#pragma unroll
    for (int i = 0; i < 4; ++i) { *(LAS u32x4*)(sm + RT_K + i * 8192 + tid * 16) = kk[i]; *(LAS u32x4*)(sm + RT_V + i * 8192 + tid * 16) = vv[i]; }
}
__device__ __forceinline__ float ret_lg(const Params& p, int l, int dir, int h) { return -softplusf_(-p.ret_logit[(l * 2 + dir) * 4 + h]); }
__device__ __forceinline__ void ph_ret_summ(const Params& p, int l, int bid, int nb, float* lds) {
    char* ws = p.ws; const int tid = TIDX, lane = tid & 63, r32 = lane & 31, hi = lane >> 5, wid = __builtin_amdgcn_readfirstlane(tid >> 6);
    const bf16_t* P = (const bf16_t*)(ws + OFF_P); float* RET = (float*)(ws + OFF_RET);
    LAS char* sm = (LAS char*)lds;
    for (int u = bid; u < 2 * NCI * 2; u += nb) {
        const int hp = u & 1, ci = (u >> 1) % NCI, b = (u >> 1) / NCI, rb = row_base(b, ci);
        __syncthreads();
        ret_stage<true>(P, rb, hp, sm, tid, wid, lane);
        __syncthreads();
        const int hh = wid >> 2, dh = (wid >> 1) & 1, eh = wid & 1, h = 2 * hp + hh;
        const float lg2f = ret_lg(p, l, 0, h) * 1.4426950408889634f, lg2b = ret_lg(p, l, 1, h) * 1.4426950408889634f;
        const int voff = ((lane >> 4) & 1) * 32 + (lane & 3) * 8 + (4 * hi + ((lane & 15) >> 2)) * 64;
        const LAS char* Kb = sm + RT_K + hh * 16384 + dh * 4096 + voff; const LAS char* Vb = sm + RT_V + hh * 16384 + eh * 4096 + voff;
        f32x16 a0, a1;
#pragma unroll
        for (int r = 0; r < 16; ++r) { a0[r] = 0.f; a1[r] = 0.f; }
#pragma unroll
        for (int k8 = 0; k8 < 8; ++k8) { const int tt = k8 >> 2, sl = k8 & 3;
            const s16x4 klo = vtr(Kb + tt * 8192 + sl * 1024), khi = vtr(Kb + tt * 8192 + sl * 1024 + 512), vlo = vtr(Vb + tt * 8192 + sl * 1024), vhi = vtr(Vb + tt * 8192 + sl * 1024 + 512);
            const int mb = tt * 64 + sl * 16 + 4 * hi; float kf_[8], kb_[8];
#pragma unroll
            for (int j = 0; j < 8; ++j) { const int m = mb + (j < 4 ? j : j + 4); const float kv = bfs(j < 4 ? klo[j] : khi[j - 4]);
                kf_[j] = kv * __builtin_amdgcn_exp2f(lg2f * (float)(127 - m)); kb_[j] = kv * __builtin_amdgcn_exp2f(lg2b * (float)m); }
            const u32x4 af = {cvtpk_s(kf_[0], kf_[1]), cvtpk_s(kf_[2], kf_[3]), cvtpk_s(kf_[4], kf_[5]), cvtpk_s(kf_[6], kf_[7])};
            const u32x4 ab = {cvtpk_s(kb_[0], kb_[1]), cvtpk_s(kb_[2], kb_[3]), cvtpk_s(kb_[4], kb_[5]), cvtpk_s(kb_[6], kb_[7])};
            const bf16x8 vfr = {vlo[0], vlo[1], vlo[2], vlo[3], vhi[0], vhi[1], vhi[2], vhi[3]};
            a0 = __builtin_amdgcn_mfma_f32_32x32x16_bf16(__builtin_bit_cast(bf16x8, af), vfr, a0, 0, 0, 0);
            a1 = __builtin_amdgcn_mfma_f32_32x32x16_bf16(__builtin_bit_cast(bf16x8, ab), vfr, a1, 0, 0, 0); }
        float* of = RET + ((((size_t)0 * 2 + b) * NCI + ci) * 4 + h) * 4096 + eh * 32 + r32;
        float* ob = RET + ((((size_t)1 * 2 + b) * NCI + ci) * 4 + h) * 4096 + eh * 32 + r32;
#pragma unroll
        for (int r = 0; r < 16; ++r) { const int d = dh * 32 + crow(r, hi); of[d * 64] = a0[r]; ob[d * 64] = a1[r]; }
    }
}

constexpr int LR_UB = 0, LR_A = 18432, LR_B = 51200, LR_H = 83968;
template <int MODE>
__device__ __forceinline__ void ph_lru_chunk(const Params& p, int l, int bid, int nb, float* lds, int ci_lo) {
    char* ws = p.ws; const int tid = TIDX, lane = tid & 63, r32 = lane & 31, hi = lane >> 5, wid = __builtin_amdgcn_readfirstlane(tid >> 6);
    const bf16_t* P = (const bf16_t*)(ws + OFF_P);
    float* LA = (float*)(ws + OFF_LRU); float* LB = LA + 2 * 2 * NCI * 256; float* LC = LB + 2 * 2 * NCI * 256;
    bf16_t* O = (bf16_t*)(ws + OFF_ACT);
    LAS char* sm = (LAS char*)lds;
    const int hb = bid & 3, tt = wid >> 1, jt = wid & 1, jcol = jt * 32 + r32, ch = hb * 64 + jcol;
    bf16x8 wfr[2][2][4]; float bia[2][2], spl[2];
#pragma unroll
    for (int dir = 0; dir < 2; ++dir) {
#pragma unroll
        for (int gt = 0; gt < 2; ++gt) { const float* W = (gt == 0 ? p.lru_wa : p.lru_wx) + (((size_t)(l * 2 + dir) * 4 + hb) * 64) * 64 + jcol;
#pragma unroll
            for (int ks = 0; ks < 4; ++ks) { const float* wp = W + (16 * ks + 8 * hi) * 64;
                const u32x4 w4 = {cvtpk_s(wp[0], wp[64]), cvtpk_s(wp[128], wp[192]), cvtpk_s(wp[256], wp[320]), cvtpk_s(wp[384], wp[448])};
                wfr[dir][gt][ks] = __builtin_bit_cast(bf16x8, w4); }
            bia[dir][gt] = (gt == 0 ? p.lru_ba : p.lru_bx)[(l * 2 + dir) * 256 + ch]; }
        spl[dir] = -8.0f * softplusf_(-p.lru_lam[(l * 2 + dir) * 256 + ch]); }
    const int nci = NCI - ci_lo, npair = 2 * nci;
    for (int pi = bid >> 2; pi < npair; pi += nb >> 2) {
        const int ci = ci_lo + pi % nci, b = pi / nci, rb = row_base(b, ci);
        const int seg_lo = ci < 2 ? NLAT + b * NCTX : b * NSEQ, seg_hi = ci < 2 ? seg_lo + NCTX : seg_lo + NSEQ;
        __syncthreads();
#pragma unroll
        for (int it = 0; it < 2; ++it) { const int item = it * 512 + tid, t = item >> 3, c8 = (item & 7) * 8, c0 = hb * 64 + c8;
            float acc[8];
            { const f32x4 b0 = *(const f32x4*)(p.conv_b + l * 256 + c0), b1 = *(const f32x4*)(p.conv_b + l * 256 + c0 + 4);
              acc[0] = b0[0]; acc[1] = b0[1]; acc[2] = b0[2]; acc[3] = b0[3]; acc[4] = b1[0]; acc[5] = b1[1]; acc[6] = b1[2]; acc[7] = b1[3]; }
#pragma unroll
            for (int k = 0; k < 4; ++k) { const int rr = rb + t - 1 + k;
                if (rr >= seg_lo && rr < seg_hi) { const bf16x8 xv = *(const bf16x8*)(P + (size_t)rr * DIN + C_LX + c0);
                    const f32x4 w0 = *(const f32x4*)(p.conv_w + (l * 4 + k) * 256 + c0), w1 = *(const f32x4*)(p.conv_w + (l * 4 + k) * 256 + c0 + 4);
                    acc[0] += w0[0] * bfs(xv[0]); acc[1] += w0[1] * bfs(xv[1]); acc[2] += w0[2] * bfs(xv[2]); acc[3] += w0[3] * bfs(xv[3]);
                    acc[4] += w1[0] * bfs(xv[4]); acc[5] += w1[1] * bfs(xv[5]); acc[6] += w1[2] * bfs(xv[6]); acc[7] += w1[3] * bfs(xv[7]); } }
            const u32x4 w = {cvtpk_s(acc[0], acc[1]), cvtpk_s(acc[2], acc[3]), cvtpk_s(acc[4], acc[5]), cvtpk_s(acc[6], acc[7])};
            *(LAS u32x4*)(sm + LR_UB + t * 144 + c8 * 2) = w; }
        __syncthreads();
        bf16x8 ua[4];
#pragma unroll
        for (int ks = 0; ks < 4; ++ks) ua[ks] = *(const LAS bf16x8*)(sm + LR_UB + (tt * 32 + r32) * 144 + (16 * ks + 8 * hi) * 2);
#pragma unroll
        for (int dir = 0; dir < 2; ++dir) {
            f32x16 ga, gx;
#pragma unroll
            for (int r = 0; r < 16; ++r) { ga[r] = bia[dir][0]; gx[r] = bia[dir][1]; }
#pragma unroll
            for (int ks = 0; ks < 4; ++ks) { ga = __builtin_amdgcn_mfma_f32_32x32x16_bf16(ua[ks], wfr[dir][0][ks], ga, 0, 0, 0); gx = __builtin_amdgcn_mfma_f32_32x32x16_bf16(ua[ks], wfr[dir][1][ks], gx, 0, 0, 0); }
#pragma unroll
            for (int r = 0; r < 16; ++r) { const int t = tt * 32 + crow(r, hi);
                const float rg = __builtin_amdgcn_rcpf(1.0f + __expf(-ga[r])), ig = __builtin_amdgcn_rcpf(1.0f + __expf(-gx[r]));
                const float a = __expf(spl[dir] * rg);
                const float uu = __uint_as_float(((unsigned)*(const LAS unsigned short*)(sm + LR_UB + t * 144 + jcol * 2)) << 16);
                *(LAS float*)(sm + LR_A + (t * 64 + jcol) * 4) = a;
                *(LAS float*)(sm + LR_B + (t * 64 + jcol) * 4) = sqrtf(fmaxf(1.0f - a * a, 0.f)) * (ig * uu); }
            __syncthreads();
            if (wid == 0) {
                const size_t cidx = (((size_t)dir * 2 + b) * NCI + ci) * 256 + hb * 64 + lane;
                float h = MODE == 3 ? LC[cidx] : 0.f, ap = 1.f;
                const LAS float* as_ = (const LAS float*)(sm + LR_A) + lane; const LAS float* bs_ = (const LAS float*)(sm + LR_B) + lane; LAS float* hs = (LAS float*)(sm + LR_H) + lane;
#pragma unroll 1
                for (int t0 = 0; t0 < 128; t0 += 16) {
                    float av[16], bv[16], hv[16];
#pragma unroll
                    for (int k = 0; k < 16; ++k) { const int t = dir == 0 ? t0 + k : 127 - t0 - k; av[k] = as_[t * 64]; bv[k] = bs_[t * 64]; if (MODE == 3 && dir == 1) hv[k] = hs[t * 64]; }
#pragma unroll
                    for (int k = 0; k < 16; ++k) { const int t = dir == 0 ? t0 + k : 127 - t0 - k; h = av[k] * h + bv[k]; ap *= av[k];
                        if (MODE == 3) hs[t * 64] = dir == 0 ? h : hv[k] + h; }
                }
                if (MODE == 1) { LA[cidx] = ap; LB[cidx] = h; }
            }
            __syncthreads();
        }
        if (MODE == 3) {
#pragma unroll
            for (int it = 0; it < 2; ++it) { const int item = it * 512 + tid, t = item >> 3, c8 = (item & 7) * 8, c0 = hb * 64 + c8;
                const f32x4 h0 = *(const LAS f32x4*)(sm + LR_H + (t * 64 + c8) * 4), h1 = *(const LAS f32x4*)(sm + LR_H + (t * 64 + c8 + 4) * 4);
                const bf16x8 yv = *(const bf16x8*)(P + (size_t)(rb + t) * DIN + C_LY + c0);
                const u32x4 w = {cvtpk_s(h0[0] * gelu_tanh(bfs(yv[0])), h0[1] * gelu_tanh(bfs(yv[1]))), cvtpk_s(h0[2] * gelu_tanh(bfs(yv[2])), h0[3] * gelu_tanh(bfs(yv[3]))),
                                 cvtpk_s(h1[0] * gelu_tanh(bfs(yv[4])), h1[1] * gelu_tanh(bfs(yv[5]))), cvtpk_s(h1[2] * gelu_tanh(bfs(yv[6])), h1[3] * gelu_tanh(bfs(yv[7])))};
                *(u32x4*)(O + (size_t)(rb + t) * DM + 768 + c0) = w; }
        }
    }
}

__device__ __forceinline__ int scan_ci(int dir, int s) { return dir == 0 ? s : (s == 0 ? 1 : (s == 1 ? 0 : NCI + 1 - s)); }
__device__ __forceinline__ void ph_scan2(const Params& p, int l, int bid, int nb) {
    char* ws = p.ws; const int gt = bid * 512 + TIDX, gs = nb * 512;
    float* RET = (float*)(ws + OFF_RET);
    for (int i = gt; i < 2 * 2 * 4 * 4096; i += gs) {
        const int de = i & 4095, h = (i >> 12) & 3, b = (i >> 14) & 1, dir = i >> 15;
        const float decay = expf(ret_lg(p, l, dir, h) * 128.0f); float S = 0.f;
        float* base = RET + (((size_t)dir * 2 + b) * NCI * 4 + h) * 4096 + de;
        for (int s0 = 0; s0 < NCI; s0 += 13) {
            float uu[13];
#pragma unroll
            for (int j = 0; j < 13; ++j) uu[j] = base[(size_t)scan_ci(dir, s0 + j) * 4 * 4096];
#pragma unroll
            for (int j = 0; j < 13; ++j) { base[(size_t)scan_ci(dir, s0 + j) * 4 * 4096] = S; S = decay * S + uu[j]; }
        }
    }
    float* LA = (float*)(ws + OFF_LRU); float* LB = LA + 2 * 2 * NCI * 256; float* LC = LB + 2 * 2 * NCI * 256;
    for (int i = gt; i < 2 * 2 * 256; i += gs) {
        const int ch = i & 255, b = (i >> 8) & 1, dir = i >> 9; float h = 0.f;
        const size_t base = ((size_t)dir * 2 + b) * NCI * 256 + ch;
        for (int s0 = 0; s0 < NCI; s0 += 13) {
            float aa[13], bb[13];
#pragma unroll
            for (int j = 0; j < 13; ++j) { const size_t idx = base + (size_t)scan_ci(dir, s0 + j) * 256; aa[j] = LA[idx]; bb[j] = LB[idx]; }
#pragma unroll
            for (int j = 0; j < 13; ++j) { LC[base + (size_t)scan_ci(dir, s0 + j) * 256] = h; h = aa[j] * h + bb[j]; }
        }
    }
}

__device__ __forceinline__ bf16x8 scale_frag(bf16x8 q, float s) {
    u32x4 w;
#pragma unroll
    for (int i = 0; i < 4; ++i) w[i] = cvtpk_s(bfs(q[2 * i]) * s, bfs(q[2 * i + 1]) * s);
    return __builtin_bit_cast(bf16x8, w);
}
__device__ __forceinline__ void ph_ret_out(const Params& p, int l, int bid, int nb, float* lds, int ci_lo) {
    char* ws = p.ws; const int tid = TIDX, lane = tid & 63, r32 = lane & 31, hi = lane >> 5, wid = __builtin_amdgcn_readfirstlane(tid >> 6);
    const bf16_t* P = (const bf16_t*)(ws + OFF_P); const float* RET = (const float*)(ws + OFF_RET); bf16_t* O = (bf16_t*)(ws + OFF_ACT);
    LAS char* sm = (LAS char*)lds;
    const int nci = NCI - ci_lo;
    for (int u = bid; u < 2 * nci * 2; u += nb) {
        const int hp = u & 1, ci = ci_lo + (u >> 1) % nci, b = (u >> 1) / nci, rb = row_base(b, ci);
        __syncthreads();
        ret_stage<false>(P, rb, hp, sm, tid, wid, lane);
        __syncthreads();
        const int hh = wid >> 2, qt = wid & 3, h = 2 * hp + hh; int n = qt * 32 + r32;
        asm volatile("" : "+v"(n));
        const float lg2f = ret_lg(p, l, 0, h) * 1.4426950408889634f, lg2b = ret_lg(p, l, 1, h) * 1.4426950408889634f;
        bf16x8 qr[4];
        { const bf16_t* qp = P + (size_t)(rb + n) * DIN + C_RQ + h * 64 + hi * 8;
#pragma unroll
          for (int ks = 0; ks < 4; ++ks) qr[ks] = *(const bf16x8*)(qp + ks * 16); }
        f32x16 o[2];
#pragma unroll
        for (int r = 0; r < 16; ++r) { o[0][r] = 0.f; o[1][r] = 0.f; }
#pragma unroll
        for (int dir = 0; dir < 2; ++dir) {
            const float xi = dir == 0 ? __builtin_amdgcn_exp2f(lg2f * (float)(n + 1)) : __builtin_amdgcn_exp2f(lg2b * (float)(128 - n));
            const float* Sb = RET + ((((size_t)dir * 2 + b) * NCI + ci) * 4 + h) * 4096 + hi * 8 * 64 + r32;
#pragma unroll
            for (int ks = 0; ks < 4; ++ks) { const bf16x8 qx = scale_frag(qr[ks], xi);
#pragma unroll
                for (int eh = 0; eh < 2; ++eh) { const float* sp = Sb + ks * 16 * 64 + eh * 32;
                    const u32x4 sw = {cvtpk_s(sp[0], sp[64]), cvtpk_s(sp[128], sp[192]), cvtpk_s(sp[256], sp[320]), cvtpk_s(sp[384], sp[448])};
                    o[eh] = __builtin_amdgcn_mfma_f32_32x32x16_bf16(qx, __builtin_bit_cast(bf16x8, sw), o[eh], 0, 0, 0); } }
        }
        const LAS char* Kb = sm + RT_K + hh * 16384 + hi * 1024 + r32 * 16;
        const LAS char* Vb = sm + RT_V + hh * 16384 + ((lane >> 4) & 1) * 32 + (lane & 3) * 8 + (4 * hi + ((lane & 15) >> 2)) * 64;
        u32x4 pw[8];
#pragma unroll
        for (int kb = 0; kb < 4; ++kb) { const int tt = kb >> 1, kbl = kb & 1;
            f32x16 c;
#pragma unroll
            for (int r = 0; r < 16; ++r) c[r] = 0.f;
#pragma unroll
            for (int ks = 0; ks < 4; ++ks) c = __builtin_amdgcn_mfma_f32_32x32x16_bf16(*(const LAS bf16x8*)(Kb + tt * 8192 + ks * 2048 + kbl * 512), qr[ks], c, 0, 0, 0);
#pragma unroll
            for (int r = 0; r < 16; ++r) { const int dlt = n - (kb * 32 + crow(r, hi)); const float fd = (float)dlt;
                const float w = __builtin_amdgcn_exp2f(fd * (dlt > 0 ? lg2f : -lg2b));
                c[r] *= dlt == 0 ? 2.0f : w; }
            pw[2 * kb] = (u32x4){cvtpk_s(c[0], c[1]), cvtpk_s(c[2], c[3]), cvtpk_s(c[4], c[5]), cvtpk_s(c[6], c[7])};
            pw[2 * kb + 1] = (u32x4){cvtpk_s(c[8], c[9]), cvtpk_s(c[10], c[11]), cvtpk_s(c[12], c[13]), cvtpk_s(c[14], c[15])}; }
#pragma unroll
        for (int k8 = 0; k8 < 8; ++k8) { const int tt = k8 >> 2, sl = k8 & 3;
#pragma unroll
            for (int eh = 0; eh < 2; ++eh) { const s16x4 vlo = vtr(Vb + tt * 8192 + eh * 4096 + sl * 1024), vhi = vtr(Vb + tt * 8192 + eh * 4096 + sl * 1024 + 512);
                o[eh] = __builtin_amdgcn_mfma_f32_32x32x16_bf16(__builtin_bit_cast(bf16x8, pw[k8]), (bf16x8){vlo[0], vlo[1], vlo[2], vlo[3], vhi[0], vhi[1], vhi[2], vhi[3]}, o[eh], 0, 0, 0); } }
        LAS float* stg = (LAS float*)(sm + RT_ST) + wid * 2048;
#pragma unroll
        for (int r = 0; r < 16; ++r) { const int q = crow(r, hi); stg[q * 64 + r32] = o[0][r]; stg[q * 64 + 32 + r32] = o[1][r]; }
        const float* gn = p.ret_gn + l * 256 + h * 64 + (lane & 7) * 8;
        const f32x4 g0 = *(const f32x4*)gn, g1 = *(const f32x4*)(gn + 4);
#pragma unroll
        for (int i = 0; i < 4; ++i) { const int row = i * 8 + (lane >> 3), ch = lane & 7;
            const f32x4 v0 = *(const LAS f32x4*)(stg + row * 64 + ch * 8), v1 = *(const LAS f32x4*)(stg + row * 64 + ch * 8 + 4);
            float ss = v0[0] * v0[0] + v0[1] * v0[1] + v0[2] * v0[2] + v0[3] * v0[3] + v1[0] * v1[0] + v1[1] * v1[1] + v1[2] * v1[2] + v1[3] * v1[3];
            ss += __shfl_xor(ss, 1); ss += __shfl_xor(ss, 2); ss += __shfl_xor(ss, 4);
            const float rn = rsqrtf(ss * (1.0f / 64.0f) + 1e-6f);
            const size_t grow = (size_t)(rb + qt * 32 + row);
            const bf16x8 gg = *(const bf16x8*)(P + grow * DIN + C_RG + h * 64 + ch * 8);
            u32x4 w; w.x = cvtpk_s(v0[0] * rn * g0[0] * fast_silu(bfs(gg[0])), v0[1] * rn * g0[1] * fast_silu(bfs(gg[1]))); w.y = cvtpk_s(v0[2] * rn * g0[2] * fast_silu(bfs(gg[2])), v0[3] * rn * g0[3] * fast_silu(bfs(gg[3])));
            w.z = cvtpk_s(v1[0] * rn * g1[0] * fast_silu(bfs(gg[4])), v1[1] * rn * g1[1] * fast_silu(bfs(gg[5]))); w.w = cvtpk_s(v1[2] * rn * g1[2] * fast_silu(bfs(gg[6])), v1[3] * rn * g1[3] * fast_silu(bfs(gg[7])));
            *(u32x4*)(O + grow * DM + 256 + h * 64 + ch * 8) = w; }
    }
}

__device__ __forceinline__ float diff_lambda_val(const Params& p, int l, float lam_init) {
    const float* lv = p.diff_lam + l * 128; float s1 = 0.f, s2 = 0.f;
    for (int i = 0; i < 32; ++i) { s1 += lv[i] * lv[32 + i]; s2 += lv[64 + i] * lv[96 + i]; }
    return expf(s1) - expf(s2) + lam_init;
}
__device__ __forceinline__ float max3f(float a, float b, float c) { return __builtin_fmaxf(__builtin_fmaxf(a, b), c); }
__device__ __forceinline__ float xhalf_max(float m) { auto rr = __builtin_amdgcn_permlane32_swap(__float_as_uint(m), __float_as_uint(m), false, false); return fmaxf(__uint_as_float(rr[0]), __uint_as_float(rr[1])); }
__device__ __forceinline__ float xhalf_sum(float m) { auto rr = __builtin_amdgcn_permlane32_swap(__float_as_uint(m), __float_as_uint(m), false, false); return __uint_as_float(rr[0]) + __uint_as_float(rr[1]); }

constexpr int DF_K = 0, DF_V = 16384, DF_WS = 32768, DF_ST = 34816;
constexpr int DD_K = 0, DD_V = 32768, DD_WS = 65536, DD_ST = 67584;
__device__ __forceinline__ void glds16(const void* gsrc, unsigned lds_dst) { unsigned keep;
    asm volatile("s_mov_b32 %0, m0\n\ts_mov_b32 m0, %2\n\ts_nop 0\n\tglobal_load_lds_dwordx4 %1, off\n\ts_mov_b32 m0, %0" : "=&s"(keep) : "v"(gsrc), "s"(lds_dst) : "memory"); }
__device__ __forceinline__ void ph_diff(const Params& p, int l, bool need_ctx, float lam_init, int bid, int nb, float* lds) {
    char* ws = p.ws; const int tid = TIDX, lane = tid & 63, r32 = lane & 31, hi = lane >> 5, wid = __builtin_amdgcn_readfirstlane(tid >> 6);
    const bf16_t* P = (const bf16_t*)(ws + OFF_P); bf16_t* O = (bf16_t*)(ws + OFF_ACT);
    LAS char* sm = (LAS char*)lds;
    LAS float* wsf = (LAS float*)(sm + DD_WS) + wid * 64;
    const float lam = diff_lambda_val(p, l, lam_init);
    const int nun = 512 + (need_ctx ? 8 : 0);
    for (int u = bid; u < nun; u += nb) {
        int b, h, qrow0, t_lo;
        if (u < 512) { b = u >> 8; h = (u >> 6) & 3; qrow0 = b * NSEQ + (u & 63) * 256; t_lo = 0; }
        else { const int v = u - 512; b = v >> 2; h = v & 3; qrow0 = NLAT + b * NCTX; t_lo = 256; }
        const int t_hi = 260;
        const bf16_t* kcol = P + C_DK + h * 64 + wid * 8;
        const bf16_t* vcol = P + C_DV + h * 64 + (wid >> 2) * 32 + (lane & 3) * 8;
        const int krow_in = lane, vrow_in = 16 * (wid & 3) + (lane >> 2);
#define TILE_ROW0(t) ((t) < 256 ? b * NSEQ + (t) * 64 : NLAT + b * NCTX + ((t) - 256) * 64)
        bf16x8 qr[4];
        { const bf16_t* qp = P + (size_t)(qrow0 + wid * 32 + r32) * DIN + C_DQ + h * 64 + hi * 8;
#pragma unroll
          for (int d0 = 0; d0 < 4; ++d0) qr[d0] = *(const bf16x8*)(qp + d0 * 16); }
        f32x16 o[2][2]; float mhat[2], lsum[2];
#pragma unroll
        for (int m = 0; m < 2; ++m) { mhat[m] = 0.f; lsum[m] = 0.f;
#pragma unroll
            for (int r = 0; r < 16; ++r) { o[m][0][r] = 0.f; o[m][1][r] = 0.f; } }
        const unsigned lds0 = (unsigned)(size_t)sm + (unsigned)wid * 1024u;
#define DMA_TILE(t) do { const int r0_ = TILE_ROW0(t); const unsigned sl_ = (unsigned)(((t) - t_lo) & 3) * 8192u; \
        glds16(kcol + (size_t)(r0_ + krow_in) * DIN, (unsigned)__builtin_amdgcn_readfirstlane(lds0 + DD_K + sl_)); glds16(vcol + (size_t)(r0_ + vrow_in) * DIN, (unsigned)__builtin_amdgcn_readfirstlane(lds0 + DD_V + sl_)); } while (0)
        asm volatile("s_waitcnt lgkmcnt(0)\n\ts_barrier" ::: "memory");
        DMA_TILE(t_lo); DMA_TILE(t_lo + 1); DMA_TILE(t_lo + 2);
        bool first = true;
        for (int t = t_lo; t < t_hi; ++t) {
            const int cur = (t - t_lo) & 3;
            if (t + 2 < t_hi) asm volatile("s_waitcnt vmcnt(4)\n\ts_barrier" ::: "memory");
            else if (t + 1 < t_hi) asm volatile("s_waitcnt vmcnt(2)\n\ts_barrier" ::: "memory");
            else asm volatile("s_waitcnt vmcnt(0)\n\ts_barrier" ::: "memory");
            if (t + 3 < t_hi) DMA_TILE(t + 3);
            const LAS char* kb = sm + DD_K + cur * 8192 + hi * 1024 + r32 * 16;
            const LAS char* vb = sm + DD_V + cur * 8192 + ((lane >> 4) & 1) * 32 + (lane & 3) * 8 + (4 * hi + ((lane & 15) >> 2)) * 64;
            bf16x8 kf[8];
#pragma unroll
            for (int j = 0; j < 4; ++j) { kf[2 * j] = *(const LAS bf16x8*)(kb + j * 2048); kf[2 * j + 1] = *(const LAS bf16x8*)(kb + j * 2048 + 512); }
            bf16x8 vf[8];
#pragma unroll
            for (int i = 0; i < 8; ++i) { const s16x4 lo = vtr(vb + (i >> 2) * 4096 + (i & 3) * 1024), hh = vtr(vb + (i >> 2) * 4096 + (i & 3) * 1024 + 512);
                vf[i] = (bf16x8){lo[0], lo[1], lo[2], lo[3], hh[0], hh[1], hh[2], hh[3]}; }
#pragma unroll
            for (int m = 0; m < 2; ++m) {
                float nm = -mhat[m]; asm volatile("" : "+v"(nm));
                f32x16 negm;
#pragma unroll
                for (int r = 0; r < 16; ++r) negm[r] = nm;
                f32x16 c0 = __builtin_amdgcn_mfma_f32_32x32x16_bf16(kf[4 * m + 0], qr[2 * m], negm, 0, 0, 0);
                f32x16 c1 = __builtin_amdgcn_mfma_f32_32x32x16_bf16(kf[4 * m + 1], qr[2 * m], negm, 0, 0, 0);
                c0 = __builtin_amdgcn_mfma_f32_32x32x16_bf16(kf[4 * m + 2], qr[2 * m + 1], c0, 0, 0, 0);
                c1 = __builtin_amdgcn_mfma_f32_32x32x16_bf16(kf[4 * m + 3], qr[2 * m + 1], c1, 0, 0, 0);
                float ra = max3f(c0[0], c0[1], c1[0]), rb = max3f(c0[2], c0[3], c1[1]); ra = max3f(ra, c1[2], c1[3]);
#pragma unroll
                for (int r = 4; r < 16; r += 4) { ra = max3f(ra, c0[r], c0[r + 1]); rb = max3f(rb, c0[r + 2], c0[r + 3]); ra = max3f(ra, c1[r], c1[r + 1]); rb = max3f(rb, c1[r + 2], c1[r + 3]); }
                const float rm = xhalf_max(max3f(ra, rb, rb));
                if (__builtin_expect(first || __any(rm > 8.0f), 0)) {
                    float dl = first ? rm : fmaxf(rm, 0.f); asm volatile("; rebase" : "+v"(dl));
                    mhat[m] += dl;
#pragma unroll
                    for (int r = 0; r < 16; ++r) { c0[r] -= dl; c1[r] -= dl; }
                    asm volatile("" : "+v"(c0), "+v"(c1));
                    if (!first) {
                        const float f = __builtin_amdgcn_exp2f(-dl); lsum[m] *= f;
                        if (hi == 0) wsf[r32] = f;
#pragma unroll
                        for (int r = 0; r < 16; ++r) { const float fr_ = wsf[crow(r, hi)]; o[m][0][r] *= fr_; o[m][1][r] *= fr_; }
                    }
                }
                float sacc = 0.f;
#pragma unroll
                for (int r = 0; r < 16; ++r) { c0[r] = __builtin_amdgcn_exp2f(c0[r]); c1[r] = __builtin_amdgcn_exp2f(c1[r]); sacc += c0[r] + c1[r]; }
                lsum[m] += sacc;
                u32x4 pw[4];
#pragma unroll
                for (int k = 0; k < 2; ++k) {
                    pw[k] = (u32x4){cvtpk_s(c0[8 * k + 0], c0[8 * k + 1]), cvtpk_s(c0[8 * k + 2], c0[8 * k + 3]), cvtpk_s(c0[8 * k + 4], c0[8 * k + 5]), cvtpk_s(c0[8 * k + 6], c0[8 * k + 7])};
                    pw[2 + k] = (u32x4){cvtpk_s(c1[8 * k + 0], c1[8 * k + 1]), cvtpk_s(c1[8 * k + 2], c1[8 * k + 3]), cvtpk_s(c1[8 * k + 4], c1[8 * k + 5]), cvtpk_s(c1[8 * k + 6], c1[8 * k + 7])}; }
#pragma unroll
                for (int k = 0; k < 4; ++k) {
                    o[m][0] = __builtin_amdgcn_mfma_f32_32x32x16_bf16(__builtin_bit_cast(bf16x8, pw[k]), vf[k], o[m][0], 0, 0, 0);
                    o[m][1] = __builtin_amdgcn_mfma_f32_32x32x16_bf16(__builtin_bit_cast(bf16x8, pw[k]), vf[4 + k], o[m][1], 0, 0, 0); }
            }
            first = false;
            asm volatile("s_waitcnt lgkmcnt(0)" ::: "memory");
        }
#undef TILE_ROW0
#undef DMA_TILE
        const float inv0 = 1.0f / xhalf_sum(lsum[0]), inv1 = lam / xhalf_sum(lsum[1]);
        int lane_e = TIDX & 63; asm volatile("" : "+v"(lane_e));
        { const int r32e = lane_e & 31, hie = lane_e >> 5;
        LAS float* wse = (LAS float*)(sm + DD_WS) + wid * 64; LAS float* stge = (LAS float*)(sm + DD_ST) + wid * 2048;
        if (hie == 0) { wse[r32e] = inv0; wse[32 + r32e] = inv1; }
#pragma unroll
        for (int r = 0; r < 16; ++r) { const int q = crow(r, hie); const float i0 = wse[q], i1 = wse[32 + q];
            stge[q * 64 + r32e] = o[0][0][r] * i0 - o[1][0][r] * i1; stge[q * 64 + 32 + r32e] = o[0][1][r] * i0 - o[1][1][r] * i1; } }
        const int lane = lane_e; LAS float* stg = (LAS float*)(sm + DD_ST) + wid * 2048;
        const float* gn = p.diff_gn + l * 256 + h * 64 + (lane & 7) * 8;
        const f32x4 g0 = *(const f32x4*)gn, g1 = *(const f32x4*)(gn + 4);
#pragma unroll
        for (int i = 0; i < 4; ++i) { const int row = i * 8 + (lane >> 3), ch = lane & 7;
            const f32x4 v0 = *(const LAS f32x4*)(stg + row * 64 + ch * 8), v1 = *(const LAS f32x4*)(stg + row * 64 + ch * 8 + 4);
            float ss = v0[0] * v0[0] + v0[1] * v0[1] + v0[2] * v0[2] + v0[3] * v0[3] + v1[0] * v1[0] + v1[1] * v1[1] + v1[2] * v1[2] + v1[3] * v1[3];
            ss += __shfl_xor(ss, 1); ss += __shfl_xor(ss, 2); ss += __shfl_xor(ss, 4);
            const float rn = rsqrtf(ss * (1.0f / 64.0f) + 1e-6f) * (1.0f - lam_init);
            u32x4 w; w.x = cvtpk_s(v0[0] * rn * g0[0], v0[1] * rn * g0[1]); w.y = cvtpk_s(v0[2] * rn * g0[2], v0[3] * rn * g0[3]);
            w.z = cvtpk_s(v1[0] * rn * g1[0], v1[1] * rn * g1[1]); w.w = cvtpk_s(v1[2] * rn * g1[2], v1[3] * rn * g1[3]);
            *(u32x4*)(O + (size_t)(qrow0 + wid * 32 + row) * DM + 512 + h * 64 + ch * 8) = w; }
    }
}

__device__ __forceinline__ void ph_swa(const Params& p, int l, bool need_ctx, int bid, int nb, float* lds) {
    char* ws = p.ws; const int tid = TIDX, lane = tid & 63, r32 = lane & 31, hi = lane >> 5, wid = __builtin_amdgcn_readfirstlane(tid >> 6);
    const bf16_t* P = (const bf16_t*)(ws + OFF_P); bf16_t* O = (bf16_t*)(ws + OFF_ACT);
    LAS char* sm = (LAS char*)lds;
    LAS float* wsf = (LAS float*)(sm + DD_WS) + wid * 64;
    const int nun = 512 + (need_ctx ? 8 : 0);
    for (int u = bid; u < nun; u += nb) {
        int b, h, qrow0, q0, tw_lo, nwin;
        if (u < 512) { b = u >> 8; h = (u >> 6) & 3; q0 = (u & 63) * 256; qrow0 = b * NSEQ + q0; const int lo = q0 - 128 < 0 ? 0 : q0 - 128, hi_ = q0 + 384 > NSEQ ? NSEQ : q0 + 384; tw_lo = lo >> 6; nwin = (hi_ - lo) >> 6; }
        else { const int v = u - 512; b = v >> 2; h = v & 3; q0 = 0; qrow0 = NLAT + b * NCTX; tw_lo = 0; nwin = 0; }
        const int g = h >> 1, nt = nwin + 4;
        const bf16_t* kcol = P + C_AK + g * 64 + wid * 8;
        const bf16_t* vcol = P + C_AV + g * 64 + (wid >> 2) * 32 + (lane & 3) * 8;
        const int krow_in = lane, vrow_in = 16 * (wid & 3) + (lane >> 2);
#define SWA_ROW0(i) ((i) < nwin ? b * NSEQ + (tw_lo + (i)) * 64 : NLAT + b * NCTX + ((i) - nwin) * 64)
        bf16x8 qr[4];
        { const bf16_t* qp = P + (size_t)(qrow0 + wid * 32 + r32) * DIN + C_AQ + h * 64 + hi * 8;
#pragma unroll
          for (int d0 = 0; d0 < 4; ++d0) qr[d0] = *(const bf16x8*)(qp + d0 * 16); }
        f32x16 o[2]; float mhat = p.sink[l * 4 + h] * 1.4426950408889634f, lsum = hi == 0 ? 1.0f : 0.0f;
#pragma unroll
        for (int r = 0; r < 16; ++r) { o[0][r] = 0.f; o[1][r] = 0.f; }
        const int qw = q0 + wid * 32, qpos = qw + r32;
        const unsigned lds0 = (unsigned)(size_t)sm + (unsigned)wid * 1024u;
#define DMA_TILE(i) do { const int r0_ = SWA_ROW0(i); const unsigned sl_ = (unsigned)((i) & 3) * 8192u; \
        glds16(kcol + (size_t)(r0_ + krow_in) * DIN, (unsigned)__builtin_amdgcn_readfirstlane(lds0 + DD_K + sl_)); glds16(vcol + (size_t)(r0_ + vrow_in) * DIN, (unsigned)__builtin_amdgcn_readfirstlane(lds0 + DD_V + sl_)); } while (0)
        asm volatile("s_waitcnt lgkmcnt(0)\n\ts_barrier" ::: "memory");
        DMA_TILE(0); DMA_TILE(1); DMA_TILE(2);
        for (int i = 0; i < nt; ++i) {
            const int cur = i & 3;
            if (i + 2 < nt) asm volatile("s_waitcnt vmcnt(4)\n\ts_barrier" ::: "memory");
            else if (i + 1 < nt) asm volatile("s_waitcnt vmcnt(2)\n\ts_barrier" ::: "memory");
            else asm volatile("s_waitcnt vmcnt(0)\n\ts_barrier" ::: "memory");
            if (i + 3 < nt) DMA_TILE(i + 3);
            const bool win = i < nwin; const int T = (tw_lo + i) * 64;
            const bool skip = win && (T > qw + 31 + 128 || T + 63 < qw - 128);
            if (!skip) {
                const LAS char* kb = sm + DD_K + cur * 8192 + hi * 1024 + r32 * 16;
                const LAS char* vb = sm + DD_V + cur * 8192 + ((lane >> 4) & 1) * 32 + (lane & 3) * 8 + (4 * hi + ((lane & 15) >> 2)) * 64;
                float nm = -mhat; asm volatile("" : "+v"(nm));
                f32x16 c0, c1;
#pragma unroll
                for (int r = 0; r < 16; ++r) { c0[r] = nm; c1[r] = nm; }
#pragma unroll
                for (int j = 0; j < 4; ++j) {
                    c0 = __builtin_amdgcn_mfma_f32_32x32x16_bf16(*(const LAS bf16x8*)(kb + j * 2048), qr[j], c0, 0, 0, 0);
                    c1 = __builtin_amdgcn_mfma_f32_32x32x16_bf16(*(const LAS bf16x8*)(kb + j * 2048 + 512), qr[j], c1, 0, 0, 0); }
                if (win && (T < qw + 31 - 128 || T + 63 > qw + 128)) {
#pragma unroll
                    for (int r = 0; r < 16; ++r) { const int kp = T + crow(r, hi); const int d0_ = qpos - kp, d1_ = d0_ - 32;
                        if (d0_ > 128 || d0_ < -128) c0[r] = -1.0e30f;
                        if (d1_ > 128 || d1_ < -128) c1[r] = -1.0e30f; }
                }
                float rm = fmaxf(c0[0], c1[0]);
#pragma unroll
                for (int r = 1; r < 16; ++r) rm = fmaxf(rm, fmaxf(c0[r], c1[r]));
                rm = xhalf_max(rm);
                if (__any(rm > 8.0f)) {
                    const float dl = fmaxf(rm, 0.f); mhat += dl;
#pragma unroll
                    for (int r = 0; r < 16; ++r) { c0[r] -= dl; c1[r] -= dl; }
                    const float f = __builtin_amdgcn_exp2f(-dl); lsum *= f;
                    if (hi == 0) wsf[r32] = f;
#pragma unroll
                    for (int r = 0; r < 16; ++r) { const float fr_ = wsf[crow(r, hi)]; o[0][r] *= fr_; o[1][r] *= fr_; }
                }
                float sacc = 0.f;
#pragma unroll
                for (int r = 0; r < 16; ++r) { c0[r] = __builtin_amdgcn_exp2f(c0[r]); c1[r] = __builtin_amdgcn_exp2f(c1[r]); sacc += c0[r] + c1[r]; }
                lsum += sacc;
                u32x4 pw[4];
#pragma unroll
                for (int k = 0; k < 2; ++k) {
                    pw[k] = (u32x4){cvtpk_s(c0[8 * k + 0], c0[8 * k + 1]), cvtpk_s(c0[8 * k + 2], c0[8 * k + 3]), cvtpk_s(c0[8 * k + 4], c0[8 * k + 5]), cvtpk_s(c0[8 * k + 6], c0[8 * k + 7])};
                    pw[2 + k] = (u32x4){cvtpk_s(c1[8 * k + 0], c1[8 * k + 1]), cvtpk_s(c1[8 * k + 2], c1[8 * k + 3]), cvtpk_s(c1[8 * k + 4], c1[8 * k + 5]), cvtpk_s(c1[8 * k + 6], c1[8 * k + 7])}; }
#pragma unroll
                for (int k = 0; k < 4; ++k) {
                    const s16x4 lo0 = vtr(vb + k * 1024), hi0 = vtr(vb + k * 1024 + 512), lo1 = vtr(vb + 4096 + k * 1024), hi1 = vtr(vb + 4096 + k * 1024 + 512);
                    o[0] = __builtin_amdgcn_mfma_f32_32x32x16_bf16(__builtin_bit_cast(bf16x8, pw[k]), (bf16x8){lo0[0], lo0[1], lo0[2], lo0[3], hi0[0], hi0[1], hi0[2], hi0[3]}, o[0], 0, 0, 0);
                    o[1] = __builtin_amdgcn_mfma_f32_32x32x16_bf16(__builtin_bit_cast(bf16x8, pw[k]), (bf16x8){lo1[0], lo1[1], lo1[2], lo1[3], hi1[0], hi1[1], hi1[2], hi1[3]}, o[1], 0, 0, 0); }
            }
            asm volatile("s_waitcnt lgkmcnt(0)" ::: "memory");
        }
#undef SWA_ROW0
#undef DMA_TILE
        const float inv = 1.0f / xhalf_sum(lsum);
        int lane_e = TIDX & 63;
        { const int r32e = lane_e & 31, hie = lane_e >> 5;
        LAS float* wse = (LAS float*)(sm + DD_WS) + wid * 64; LAS float* stge = (LAS float*)(sm + DD_ST) + wid * 2048;
        if (hie == 0) wse[r32e] = inv;
#pragma unroll
        for (int r = 0; r < 16; ++r) { const int q = crow(r, hie); const float i0 = wse[q]; stge[q * 64 + r32e] = o[0][r] * i0; stge[q * 64 + 32 + r32e] = o[1][r] * i0; } }
        LAS float* stg = (LAS float*)(sm + DD_ST) + wid * 2048;
#pragma unroll
        for (int i = 0; i < 4; ++i) { const int row = i * 8 + (lane_e >> 3), ch = lane_e & 7;
            const f32x4 v0 = *(const LAS f32x4*)(stg + row * 64 + ch * 8), v1 = *(const LAS f32x4*)(stg + row * 64 + ch * 8 + 4);
            u32x4 w; w.x = cvtpk_s(v0[0], v0[1]); w.y = cvtpk_s(v0[2], v0[3]); w.z = cvtpk_s(v1[0], v1[1]); w.w = cvtpk_s(v1[2], v1[3]);
            *(u32x4*)(O + (size_t)(qrow0 + wid * 32 + row) * DM + h * 64 + ch * 8) = w; }
    }
}

__device__ __forceinline__ void moe_offsets(const Params& p, int* offs  ) {
    if (TIDX < 2) { const unsigned* cw = (const unsigned*)p.ws + CW_CNT + TIDX * 8; int o = 0;
        for (int e = 0; e < 8; ++e) { offs[TIDX * 9 + e] = o; o += ((int)__hip_atomic_load(cw + e, __ATOMIC_RELAXED, __HIP_MEMORY_SCOPE_AGENT) + 255) & ~255; }
        offs[TIDX * 9 + 8] = o; }
    __syncthreads();
}
__device__ __forceinline__ void ph_moe_scatter(const Params& p, int bid, int nb, float* lds) {
    char* ws = p.ws; int* offs = (int*)lds; moe_offsets(p, offs);
    const int lane = TIDX & 63, wv = TIDX >> 6;
    const bf16_t* H = (const bf16_t*)(ws + OFF_ACT); bf16_t* AS = (bf16_t*)(ws + OFF_ASORT);
    int* tok = (int*)(ws + OFF_TOK); float* wgt = (float*)(ws + OFF_WGT); const unsigned* cw = (const unsigned*)ws;
    for (int r0 = (bid * 8 + wv) * 4; r0 < NLAT; r0 += nb * 8 * 4) {
        int4 rec[4]; u32x4 d0[4], d1[4]; int pos[4][2];
#pragma unroll
        for (int k = 0; k < 4; ++k) { rec[k] = *(const int4*)(ws + OFF_ROUTE + (size_t)(r0 + k) * 16); const u32x4* src = (const u32x4*)(H + (size_t)(r0 + k) * DM); d0[k] = src[lane]; d1[k] = src[64 + lane]; }
#pragma unroll
        for (int k = 0; k < 4; ++k) { const int blk = ((r0 + k) >> 3) % nb;
#pragma unroll
            for (int g = 0; g < 2; ++g) { const int e = (g == 0 ? rec[k].x : rec[k].y) & 15, li = (g == 0 ? rec[k].x : rec[k].y) >> 4;
                pos[k][g] = offs[g * 9 + e] + (int)cw[CW_BLK + blk * 16 + g * 8 + e] + li; } }
#pragma unroll
        for (int k = 0; k < 4; ++k)
#pragma unroll
            for (int g = 0; g < 2; ++g) { const int ps = pos[k][g];
                if (lane == 0) { tok[g * GRP_ROWS + ps] = r0 + k; wgt[g * GRP_ROWS + ps] = __int_as_float(g == 0 ? rec[k].z : rec[k].w); }
                u32x4* dst = (u32x4*)(AS + ((size_t)g * GRP_ROWS + ps) * DM); dst[lane] = d0[k]; dst[64 + lane] = d1[k]; }
    }
}

__device__ __forceinline__ void ph_final(const Params& p, int bid, int nb) {
    const int lane = TIDX & 63, wv = TIDX >> 6;
    for (int r = bid * 8 + wv; r < NLAT; r += nb * 8) {
        float* xr = p.out + (size_t)r * DM; float4 v[4]; float ss = 0.f;
#pragma unroll
        for (int i = 0; i < 4; ++i) { v[i] = *(const float4*)(xr + i * 256 + lane * 4); ss += v[i].x * v[i].x + v[i].y * v[i].y + v[i].z * v[i].z + v[i].w * v[i].w; }
        ss = wave_sum(ss); const float rn = rsqrtf(ss * (1.0f / 1024.0f) + 1e-6f);
#pragma unroll
        for (int i = 0; i < 4; ++i) { const float4 g = *(const float4*)(p.final_norm + i * 256 + lane * 4);
            float4 o; o.x = v[i].x * rn * g.x; o.y = v[i].y * rn * g.y; o.z = v[i].z * rn * g.z; o.w = v[i].w * rn * g.w; *(float4*)(xr + i * 256 + lane * 4) = o; }
    }
}

struct EpiStoreBf16 {
    static constexpr bool PERM = true, AFTER_DRAIN = false; bf16_t* O; int ldc;
    __device__ __forceinline__ void operator()(const f32x4 (&acc)[2][2][4][2], const pg8::Unit& u, int wr, int wc, int fr, int fq) const {
        bf16_t* base = O + (size_t)(u.pm * 256 + wr * 64 + fr) * ldc + u.pn * 256 + wc * 32 + 8 * fq;
#pragma unroll
        for (int ai = 0; ai < 2; ++ai)
#pragma unroll
            for (int m = 0; m < 4; ++m) { bf16_t* rowp = base + (size_t)(ai * 128 + m * 16) * ldc;
#pragma unroll
                for (int bj = 0; bj < 2; ++bj) { const f32x4 v0 = acc[ai][bj][m][0], v1 = acc[ai][bj][m][1]; u32x4 w;
                    w.x = pg8::cvt_pk_bf16(v0[0], v0[1]); w.y = pg8::cvt_pk_bf16(v0[2], v0[3]); w.z = pg8::cvt_pk_bf16(v1[0], v1[1]); w.w = pg8::cvt_pk_bf16(v1[2], v1[3]);
                    *(u32x4*)(rowp + bj * 128) = w; } }
    }
};
struct EpiSwiglu {
    static constexpr bool PERM = true, AFTER_DRAIN = false; bf16_t* U; int ldu, npe;
    __device__ __forceinline__ void operator()(const f32x4 (&acc)[2][2][4][2], const pg8::Unit& u, int wr, int wc, int fr, int fq) const {
        bf16_t* base = U + (size_t)(u.pm * 256 + wr * 64 + fr) * ldu + (u.pn % npe) * 128 + wc * 32 + 8 * fq;
#pragma unroll
        for (int ai = 0; ai < 2; ++ai)
#pragma unroll
            for (int m = 0; m < 4; ++m) { float o[8];
#pragma unroll
                for (int n = 0; n < 2; ++n)
#pragma unroll
                    for (int i = 0; i < 4; ++i) o[n * 4 + i] = fast_silu(acc[ai][0][m][n][i]) * acc[ai][1][m][n][i];
                u32x4 w; w.x = pg8::cvt_pk_bf16(o[0], o[1]); w.y = pg8::cvt_pk_bf16(o[2], o[3]); w.z = pg8::cvt_pk_bf16(o[4], o[5]); w.w = pg8::cvt_pk_bf16(o[6], o[7]);
                *(u32x4*)(base + (size_t)(ai * 128 + m * 16) * ldu) = w; }
    }
};
struct EpiResidual {
    static constexpr bool PERM = false, AFTER_DRAIN = false; const float* xin; float* xout; float* xc; const float* gate;
    __device__ __forceinline__ void operator()(const f32x4 (&acc)[2][2][4][2], const pg8::Unit& u, int wr, int wc, int fr, int fq) const {
        const int cls = u.pm < 64 ? 0 : (u.pm < 128 ? 1 : 2), col0 = u.pn * 256 + wc * 32 + 4 * fq;
        const float* gv = gate + (size_t)cls * 6144 + col0;
        const float* bi = u.pm < 128 ? xin + (size_t)u.pm * 256 * DM : xc + (size_t)(u.pm - 128) * 256 * DM;
        float* bo = u.pm < 128 ? xout + (size_t)u.pm * 256 * DM : xc + (size_t)(u.pm - 128) * 256 * DM;
        f32x4 g4[2][2];
#pragma unroll
        for (int bj = 0; bj < 2; ++bj)
#pragma unroll
            for (int n = 0; n < 2; ++n) g4[bj][n] = *(const f32x4*)(gv + bj * 128 + n * 16);
#pragma unroll
        for (int ai = 0; ai < 2; ++ai)
#pragma unroll
            for (int m = 0; m < 4; ++m) { const size_t off = (size_t)(ai * 128 + wr * 64 + m * 16 + fr) * DM + col0;
#pragma unroll
                for (int bj = 0; bj < 2; ++bj)
#pragma unroll
                    for (int n = 0; n < 2; ++n) { const f32x4 xi = *(const f32x4*)(bi + off + bj * 128 + n * 16); *(f32x4*)(bo + off + bj * 128 + n * 16) = xi + g4[bj][n] * acc[ai][bj][m][n]; } }
    }
};
struct EpiMoeScatter {
    static constexpr bool PERM = false, AFTER_DRAIN = false; float* x; const float* gate; const int* tok; const float* wgt; int npe;
    __device__ __forceinline__ void operator()(const f32x4 (&acc)[2][2][4][2], const pg8::Unit& u, int wr, int wc, int fr, int fq) const {
        const int col0 = (u.pn % npe) * 256 + wc * 32 + 4 * fq;
#pragma unroll
        for (int ai = 0; ai < 2; ++ai)
#pragma unroll
            for (int m = 0; m < 4; ++m) { const int r = u.pm * 256 + ai * 128 + wr * 64 + m * 16 + fr; const int tk = tok[r];
                if (tk >= 0) { const float wv = wgt[r]; const float* gv = gate + (size_t)mod_class(tk) * 6144 + col0; float* xr = x + (size_t)tk * DM + col0;
#pragma unroll
                    for (int bj = 0; bj < 2; ++bj)
#pragma unroll
                        for (int n = 0; n < 2; ++n) { const f32x4 g4 = *(const f32x4*)(gv + bj * 128 + n * 16); f32x4* q = (f32x4*)(xr + bj * 128 + n * 16); *q = *q + g4 * wv * acc[ai][bj][m][n]; } } }
    }
};
struct MoeOrder : pg8::StaticOrder {
    int o1, o2, o3, o4, o5, o6, o7, npe;
    __device__ __forceinline__ bool next(int i, pg8::Unit& u) const {
        if (!pg8::StaticOrder::next(i, u)) return false;
        const int r = u.pm * 256; const int e = (r >= o1) + (r >= o2) + (r >= o3) + (r >= o4) + (r >= o5) + (r >= o6) + (r >= o7);
        u.pn += e * npe; return true;
    }
};
#define GEMM_LDS ((PG8_LAS unsigned char*)lds)
struct EpiInProj {
    static constexpr bool PERM = true, AFTER_DRAIN = false; bf16_t* O; const char* tab;
    __device__ __forceinline__ void operator()(const f32x4 (&acc)[2][2][4][2], const pg8::Unit& u, int wr, int wc, int fr, int fq) const {
        const int row0 = u.pm * 256 + wr * 64 + fr; const bool lat = u.pm < 128;
#pragma unroll
        for (int bj = 0; bj < 2; ++bj) {
            const int s = u.pn * 2 + bj;
            int mode = 0; float scale = 1.0f;
            if (s <= 1) { mode = 1; scale = 0.125f * 1.4426950408889634f; } else if (s == 2) mode = 1;
            else if (s == 4 || s == 5) mode = 2; else if (s == 6 || s == 7) { mode = 2; scale = 0.125f; }
            else if (s == 12 || s == 13) { mode = 3; scale = 0.17677669529663687f * 1.4426950408889634f; } else if (s == 14 || s == 15) mode = 3;
            if (mode == 0) {
                bf16_t* base = O + (size_t)row0 * DIN + s * 128 + wc * 32 + 8 * fq;
#pragma unroll
                for (int ai = 0; ai < 2; ++ai)
#pragma unroll
                    for (int m = 0; m < 4; ++m) { const f32x4 v0 = acc[ai][bj][m][0], v1 = acc[ai][bj][m][1]; u32x4 w;
                        w.x = pg8::cvt_pk_bf16(v0[0], v0[1]); w.y = pg8::cvt_pk_bf16(v0[2], v0[3]); w.z = pg8::cvt_pk_bf16(v1[0], v1[1]); w.w = pg8::cvt_pk_bf16(v1[2], v1[3]);
                        *(u32x4*)(base + (size_t)(ai * 128 + m * 16) * DIN) = w; }
            } else {
                const bool wide = mode != 3; const int half = wide ? 32 : 16, g = wide ? 4 * (wc & 1) + fq : fq;
                const int cbase = s * 128 + (wide ? 64 * (wc >> 1) : 32 * wc) + 4 * g;
                const float* ct = (const float*)(tab + (mode == 1 ? TAB_ATTN : (mode == 2 ? TAB_RET : TAB_DIFF))) + 4 * g; const int tstride = half, tsin = 16384 * half;
#pragma unroll
                for (int ai = 0; ai < 2; ++ai)
#pragma unroll
                    for (int m = 0; m < 4; ++m) { const int row = row0 + ai * 128 + m * 16; const f32x4 v0 = acc[ai][bj][m][0], v1 = acc[ai][bj][m][1];
                        f32x4 cs = {1.f, 1.f, 1.f, 1.f}, sn = {0.f, 0.f, 0.f, 0.f};
                        if (lat) { const float* tp = ct + (size_t)(row & (NSEQ - 1)) * tstride; cs = *(const f32x4*)tp; sn = *(const f32x4*)(tp + tsin); }
                        const f32x4 o1 = (v0 * cs - v1 * sn) * scale, o2 = (v1 * cs + v0 * sn) * scale;
                        bf16_t* op = O + (size_t)row * DIN + cbase;
                        uint2 w1, w2; w1.x = pg8::cvt_pk_bf16(o1[0], o1[1]); w1.y = pg8::cvt_pk_bf16(o1[2], o1[3]); w2.x = pg8::cvt_pk_bf16(o2[0], o2[1]); w2.y = pg8::cvt_pk_bf16(o2[2], o2[3]);
                        *(uint2*)op = w1; *(uint2*)(op + half) = w2; }
            }
        }
    }
};
__device__ __forceinline__ void ph_gemm_in(const Params& p, int l, int bid, int nb, float* lds) {
    char* ws = p.ws; pg8::Gemm g{(const bf16_t*)(ws + OFF_ACT), (const bf16_t*)(ws + OFF_WIN) + (size_t)l * DIN * DM, NROW, DIN, DM};
    pg8::StaticOrder S; S.init(NROW, DIN, nb, bid);
    EpiInProj E{(bf16_t*)(ws + OFF_P), ws + OFF_TAB};
    pg8::gemm_phase<EpiInProj, pg8::StaticOrder, true, true>(GEMM_LDS, g, S, E);
}
__device__ __forceinline__ void ph_gemm_out(const Params& p, int l, bool need_ctx, int bid, int nb, float* lds) {
    char* ws = p.ws; const int M = need_ctx ? NROW : NLAT;
    pg8::Gemm g{(const bf16_t*)(ws + OFF_ACT), (const bf16_t*)(ws + OFF_WOUT) + (size_t)l * DM * DM, M, DM, DM};
    pg8::StaticOrder S; S.init(M, DM, nb, bid);
    EpiResidual E{l == 0 ? p.x : p.out, p.out, (float*)(ws + OFF_XC), (const float*)(ws + OFF_MOD) + (size_t)l * 3 * 6144 + 2048};
    pg8::gemm_phase<EpiResidual, pg8::StaticOrder, true, true>(GEMM_LDS, g, S, E);
}
__device__ __forceinline__ void ph_ffn1(const Params& p, bool need_ctx, int bid, int nb, float* lds) {
    char* ws = p.ws; const int M = need_ctx ? NROW : NLAT;
    pg8::Gemm g{(const bf16_t*)(ws + OFF_ACT), (const bf16_t*)(ws + OFF_WF13), M, 2 * DFF, DM};
    pg8::StaticOrder S; S.init(M, 2 * DFF, nb, bid);
    EpiSwiglu E{(bf16_t*)(ws + OFF_P), DFF, 2 * DFF / 256};
    pg8::gemm_phase<EpiSwiglu, pg8::StaticOrder, true, true>(GEMM_LDS, g, S, E);
}
__device__ __forceinline__ void ph_ffn2(const Params& p, int l, bool need_ctx, int bid, int nb, float* lds) {
    char* ws = p.ws; const int M = need_ctx ? NROW : NLAT;
    pg8::Gemm g{(const bf16_t*)(ws + OFF_P), (const bf16_t*)(ws + OFF_WF2), M, DM, DFF};
    pg8::StaticOrder S; S.init(M, DM, nb, bid);
    EpiResidual E{p.out, p.out, (float*)(ws + OFF_XC), (const float*)(ws + OFF_MOD) + (size_t)l * 3 * 6144 + 5120};
    pg8::gemm_phase<EpiResidual, pg8::StaticOrder, true, true>(GEMM_LDS, g, S, E);
}
__device__ __forceinline__ MoeOrder moe_order(const int* og, int npe, int nb, int bid) {
    MoeOrder S; S.init(og[8], npe * 256, nb, bid); S.o1 = og[1]; S.o2 = og[2]; S.o3 = og[3]; S.o4 = og[4]; S.o5 = og[5]; S.o6 = og[6]; S.o7 = og[7]; S.npe = npe; return S;
}
__device__ __forceinline__ void ph_moe1(const Params& p, int g, int bid, int nb, float* lds) {
    char* ws = p.ws; int* offs = (int*)(lds + 32768); __syncthreads(); moe_offsets(p, offs);
    const MoeOrder S = moe_order(offs + g * 9, 2 * DFE / 256, nb, bid);
    pg8::Gemm gm{(const bf16_t*)(ws + OFF_ASORT) + (size_t)g * GRP_ROWS * DM, (const bf16_t*)(ws + OFF_WM13), 0, 0, DM};
    EpiSwiglu E{(bf16_t*)(ws + OFF_UMOE), DFE, 2 * DFE / 256};
    pg8::gemm_phase<EpiSwiglu, MoeOrder, true, true>(GEMM_LDS, gm, S, E);
}
__device__ __forceinline__ void ph_moe2(const Params& p, int l, int g, int bid, int nb, float* lds) {
    char* ws = p.ws; int* offs = (int*)(lds + 32768); __syncthreads(); moe_offsets(p, offs);
    const MoeOrder S = moe_order(offs + g * 9, DM / 256, nb, bid);
    pg8::Gemm gm{(const bf16_t*)(ws + OFF_UMOE), (const bf16_t*)(ws + OFF_WM2), 0, 0, DFE};
    EpiMoeScatter E{p.out, (const float*)(ws + OFF_MOD) + (size_t)l * 3 * 6144 + 5120, (const int*)(ws + OFF_TOK) + g * GRP_ROWS, (const float*)(ws + OFF_WGT) + g * GRP_ROWS, DM / 256};
    pg8::gemm_phase<EpiMoeScatter, MoeOrder, true, true>(GEMM_LDS, gm, S, E);
}

#define XB_TMO      128
#define XB_XCNT(j)  (256  + 64 * (j))
#define XB_XSUB(j)  (1280 + 64 * (j))
#define XB_XGEN(j)  (2304 + 64 * (j))
#define XB_TOP      3328
#define XB_TOPGEN   3392
#define XCD_BAR_WORDS 3456
#define XB_SPIN_CAP (1u << 22)

__device__ __forceinline__ unsigned xb_ld(unsigned* p)              { return __hip_atomic_load(p, __ATOMIC_RELAXED, __HIP_MEMORY_SCOPE_AGENT); }
__device__ __forceinline__ unsigned xb_add(unsigned* p, unsigned v) { return __hip_atomic_fetch_add(p, v, __ATOMIC_RELAXED, __HIP_MEMORY_SCOPE_AGENT); }
__device__ __forceinline__ unsigned xb_xcc_id() { return (unsigned)__builtin_amdgcn_s_getreg((3 << 11) | 20) & 0xFu; }
#define XB_SPIN(cond, bar) do { unsigned _sp = 0; while (cond) { __builtin_amdgcn_s_sleep(1); \
    if ((++_sp & 255u) == 0u) { if (xb_ld(&(bar)[XB_TMO])) break; if (_sp > XB_SPIN_CAP) { atomicAdd(&(bar)[XB_TMO], 1u); break; } } } } while (0)

struct XcdBarrier {
    unsigned* bar; unsigned x;
    volatile LAS unsigned* st;
};

__device__ __forceinline__ XcdBarrier xcd_barrier_post(unsigned* bar, volatile LAS unsigned* st) {
    XcdBarrier b; b.bar = bar; b.x = xb_xcc_id(); b.st = st;
    if (threadIdx.x == 0) (void)xb_add(&bar[XB_XCNT(b.x)], 1u);
    return b;
}
__device__ __forceinline__ void xcd_barrier_complete(unsigned* bar, unsigned x, unsigned& nloc, unsigned& nx) {
    const unsigned G = gridDim.x * gridDim.y * gridDim.z;
    unsigned sum, cnt, mine, sp = 0u;
    for (;;) {
        sum = 0u; cnt = 0u; mine = 0u;
#pragma unroll
        for (unsigned j = 0; j < 16; ++j) { const unsigned c = xb_ld(&bar[XB_XCNT(j)]); sum += c; cnt += (c > 0u) ? 1u : 0u; mine = (j == x) ? c : mine; }
        if (sum == G) break;
        __builtin_amdgcn_s_sleep(1);
        if ((++sp & 255u) == 0u) { if (xb_ld(&bar[XB_TMO])) break; if (sp > XB_SPIN_CAP) { atomicAdd(&bar[XB_TMO], 1u); break; } }
    }
    nloc = mine > 0u ? mine : 1u; nx = cnt > 0u ? cnt : 1u;
}

__device__ __forceinline__ void xcd_barrier(const XcdBarrier& b) {
    asm volatile("s_waitcnt vmcnt(0)" ::: "memory");
    __syncthreads();
    if (threadIdx.x == 0) {
        unsigned* bar = b.bar;
        __builtin_amdgcn_s_waitcnt(0);
        unsigned nloc = b.st[0], nx = b.st[1];
        if (nloc == 0u) { xcd_barrier_complete(bar, b.x, nloc, nx); b.st[0] = nloc; b.st[1] = nx; }
        const unsigned old = xb_add(&bar[XB_XSUB(b.x)], 1u);
        const unsigned gen = old / nloc;
        if (old + 1u == (gen + 1u) * nloc) {
            __builtin_amdgcn_fence(__ATOMIC_RELEASE, "agent");
            asm volatile("s_waitcnt vmcnt(0)" ::: "memory");
            const unsigned og = xb_add(&bar[XB_TOP], 1u);
            const unsigned tg = og / nx;
            if (og + 1u == (tg + 1u) * nx) xb_add(&bar[XB_TOPGEN], 1u);
            else XB_SPIN(xb_ld(&bar[XB_TOPGEN]) == tg, bar);
            __builtin_amdgcn_fence(__ATOMIC_ACQUIRE, "agent");
            xb_add(&bar[XB_XGEN(b.x)], 1u);
            asm volatile("s_waitcnt vmcnt(0)" ::: "memory");
        } else {
            XB_SPIN(xb_ld(&bar[XB_XGEN(b.x)]) == gen, bar);
            __builtin_amdgcn_fence(__ATOMIC_ACQUIRE, "agent");
            asm volatile("s_waitcnt vmcnt(0)" ::: "memory");
        }
    }
    __syncthreads();
}


constexpr int LDS_FLOATS = 33792;
constexpr int LDS_BYTES = LDS_FLOATS * 4 + 16 + 256;

typedef const __attribute__((address_space(4))) unsigned long long* kargp_t;
typedef __attribute__((address_space(1))) const float* gcf_t;
__device__ __forceinline__ Params load_params(const float* lds) {
    const LAS unsigned* tbl = (const LAS unsigned*)(lds + LDS_FLOATS + 4);
    Params p; const float** f = (const float**)&p;
#pragma unroll
    for (int i = 0; i < (int)(sizeof(Params) / 8); ++i) {
        const unsigned lo = __builtin_amdgcn_readfirstlane(tbl[2 * i]), hi = __builtin_amdgcn_readfirstlane(tbl[2 * i + 1]);
        f[i] = (const float*)(gcf_t)(((unsigned long long)hi << 32) | lo); }
    return p;
}
#define LOADP(name) const Params name = load_params(lds)

template <int l>
__device__ __forceinline__ void run_layer(const XcdBarrier& bar, int bid, int nb, float* lds) {
    constexpr bool need_ctx = l == 0;
    constexpr float lam_init = l == 0 ? 0.2f : 0.35550906759509393f;
    { LOADP(p); ph_norm<false>(p, l, 0, NROW, bid, nb, lds); } xcd_barrier(bar);
    { LOADP(p); ph_gemm_in(p, l, bid, nb, lds); } xcd_barrier(bar);
    { LOADP(p); ph_ret_summ(p, l, bid, nb, lds); } { LOADP(p); ph_lru_chunk<1>(p, l, bid, nb, lds, 0); } xcd_barrier(bar);
    { LOADP(p); ph_scan2(p, l, bid, nb); } xcd_barrier(bar);
    { LOADP(p); ph_diff(p, l, need_ctx, lam_init, bid, nb, lds); }
    { LOADP(p); ph_swa(p, l, need_ctx, bid, nb, lds); }
    { LOADP(p); ph_ret_out(p, l, bid, nb, lds, need_ctx ? 0 : 2); }
    { LOADP(p); ph_lru_chunk<3>(p, l, bid, nb, lds, need_ctx ? 0 : 2); } xcd_barrier(bar);
    { LOADP(p); ph_gemm_out(p, l, need_ctx, bid, nb, lds); } xcd_barrier(bar);
    if (l == 0) {
        { LOADP(p); ph_norm<false>(p, l, 1, NROW, bid, nb, lds); } xcd_barrier(bar);
        { LOADP(p); ph_ffn1(p, need_ctx, bid, nb, lds); } xcd_barrier(bar);
        { LOADP(p); ph_ffn2(p, l, need_ctx, bid, nb, lds); } xcd_barrier(bar);
    } else {
        { LOADP(p); ph_norm<true>(p, l, 1, NLAT, bid, nb, lds); } xcd_barrier(bar);
        { LOADP(p); ph_moe_scatter(p, bid, nb, lds); } xcd_barrier(bar);
        { LOADP(p); ph_moe1(p, 0, bid, nb, lds); } xcd_barrier(bar);
        { LOADP(p); ph_moe2(p, l, 0, bid, nb, lds); } xcd_barrier(bar);
        { LOADP(p); ph_moe1(p, 1, bid, nb, lds); } xcd_barrier(bar);
        { LOADP(p); ph_moe2(p, l, 1, bid, nb, lds); } xcd_barrier(bar);
    }
}

__global__ void __launch_bounds__(512, 2) fwd(Params p_in) {
    extern __shared__ __attribute__((aligned(16))) float lds[];
    volatile LAS unsigned* st = (volatile LAS unsigned*)(lds + LDS_FLOATS);
    if (threadIdx.x == 0) { st[0] = 0u; st[1] = 0u; st[2] = 0u; st[3] = 0u; }
    if (threadIdx.x < (int)(sizeof(Params) / 8)) { const kargp_t q = (kargp_t)__builtin_amdgcn_kernarg_segment_ptr(); ((LAS unsigned long long*)(lds + LDS_FLOATS + 4))[threadIdx.x] = q[threadIdx.x]; }
    __syncthreads();
    XcdBarrier bar;
    { LOADP(p); bar = xcd_barrier_post((unsigned*)p.ws, st); }
    const int bid = blockIdx.x, nb = gridDim.x;
    { LOADP(p); ph_prologue(p, bid, nb, lds); } xcd_barrier(bar);
    run_layer<0>(bar, bid, nb, lds);
    run_layer<1>(bar, bid, nb, lds);
    { LOADP(p); ph_final(p, bid, nb); }
}

extern "C" void kernel_launch(void* const* d_in, const int* in_sizes, int n_in, void* d_out, int out_size, void* d_ws, size_t ws_size, hipStream_t stream) {
    static int grid = 0;
    if (grid == 0) {
        if (n_in < 30 || ws_size < WS_NEED) { fprintf(stderr, "kernel_launch: bad args n_in=%d ws=%zu need=%zu\n", n_in, ws_size, (size_t)WS_NEED); grid = -1; return; }
        int dev = 0, cus = 0, per_cu = 0;
        if (hipGetDevice(&dev) != hipSuccess || hipDeviceGetAttribute(&cus, hipDeviceAttributeMultiprocessorCount, dev) != hipSuccess) { grid = -1; return; }
        if (hipFuncSetAttribute((const void*)fwd, hipFuncAttributeMaxDynamicSharedMemorySize, LDS_BYTES) != hipSuccess) { fprintf(stderr, "kernel_launch: hipFuncSetAttribute failed\n"); grid = -1; return; }
        if (hipOccupancyMaxActiveBlocksPerMultiprocessor(&per_cu, (const void*)fwd, 512, LDS_BYTES) != hipSuccess || per_cu < 1) { fprintf(stderr, "kernel_launch: occupancy query says %d\n", per_cu); per_cu = 1; }
        (void)hipGetLastError();
        grid = cus;
    }
    if (grid < 0) return;
    Params p{};
    const float** f = (const float**)&p;
    for (int i = 0; i < 30; ++i) f[i] = (const float*)d_in[i];
    p.out = (float*)d_out; p.ws = (char*)d_ws;
    (void)hipMemsetAsync(d_ws, 0, 65536, stream);
    hipLaunchKernelGGL(fwd, dim3(grid), dim3(512), LDS_BYTES, stream, p);
}
```

```cpp
#include <hip/hip_runtime.h>
#include <cstdio>
#include <cstdint>

typedef unsigned short bf16_t;
typedef short bf16x8 __attribute__((ext_vector_type(8)));
typedef float f32x4 __attribute__((ext_vector_type(4)));
typedef unsigned u32x4 __attribute__((ext_vector_type(4)));
#define LAS __attribute__((address_space(3)))

constexpr int NB = 2, NSEQ = 16384, NCTX = 256, DM = 1024;
constexpr int NLAT = NB * NSEQ;
constexpr int NCR = NB * NCTX;
constexpr int NROW = NLAT + NCR;
constexpr int DIN = 2816, DFF = 2816, DFE = 3584, NE = 8;
constexpr int NCI = 130;
constexpr int C_AQ = 0, C_AK = 256, C_AV = 384, C_RQ = 512, C_RK = 768, C_RV = 1024, C_RG = 1280, C_DQ = 1536, C_DK = 1792, C_DV = 2048, C_LX = 2304, C_LY = 2560;
constexpr int GRP_ROWS = 34816;

constexpr size_t al256(size_t x) { return (x + 255) & ~(size_t)255; }
constexpr size_t OFF_CTRL = 0;
constexpr size_t OFF_MOD = 65536;
constexpr size_t OFF_TAB = al256(OFF_MOD + 2 * 3 * 6144 * 4);
constexpr size_t TAB_ATTN = 0, TAB_RET = 4u << 20, TAB_DIFF = 8u << 20;
constexpr size_t OFF_XC = al256(OFF_TAB + (10u << 20));
constexpr size_t OFF_ROUTE = al256(OFF_XC + (size_t)NCR * DM * 4);
constexpr size_t OFF_TOK = al256(OFF_ROUTE + (size_t)NLAT * 16);
constexpr size_t OFF_WGT = al256(OFF_TOK + (size_t)2 * GRP_ROWS * 4);
constexpr size_t OFF_LRU = al256(OFF_WGT + (size_t)2 * GRP_ROWS * 4);
constexpr size_t OFF_WM13 = al256(OFF_LRU + (size_t)3 * 2 * 2 * NCI * 256 * 4);
constexpr size_t OFF_WM2 = al256(OFF_WM13 + (size_t)NE * 2 * DFE * DM * 2);
constexpr size_t OFF_R = al256(OFF_WM2 + (size_t)NE * DM * DFE * 2);
constexpr size_t OFF_P = OFF_R;
constexpr size_t OFF_ACT = al256(OFF_P + (size_t)NROW * DIN * 2);
constexpr size_t OFF_RET = al256(OFF_ACT + (size_t)NROW * DM * 2);
constexpr size_t OFF_WIN = al256(OFF_RET + (size_t)2 * 2 * NCI * 4 * 4096 * 4);
constexpr size_t OFF_WOUT = al256(OFF_WIN + (size_t)2 * DIN * DM * 2);
constexpr size_t OFF_WF13 = al256(OFF_WOUT + (size_t)2 * DM * DM * 2);
constexpr size_t OFF_WF2 = al256(OFF_WF13 + (size_t)2 * DFF * DM * 2);
constexpr size_t OFF_R_END1 = al256(OFF_WF2 + (size_t)DM * DFF * 2);
constexpr size_t OFF_ASORT = OFF_R;
constexpr size_t OFF_UMOE = al256(OFF_ASORT + (size_t)2 * GRP_ROWS * DM * 2);
constexpr size_t OFF_R_END2 = al256(OFF_UMOE + (size_t)GRP_ROWS * DFE * 2);
constexpr size_t WS_NEED = OFF_R_END1 > OFF_R_END2 ? OFF_R_END1 : OFF_R_END2;
static_assert(OFF_ACT >= OFF_UMOE, "H2 must not overlap A_sorted");
constexpr int CW_CNT = 4096;
constexpr int CW_BLK = 8192;

struct Params {
    const float *x, *c, *ctx, *c_ctx, *w_ada, *b_ada, *g1, *g2, *w_in, *w_out, *sink, *ret_logit, *ret_gn, *diff_lam, *diff_gn,
        *conv_w, *conv_b, *lru_wa, *lru_ba, *lru_wx, *lru_bx, *lru_lam, *ffn_w1, *ffn_w3, *ffn_w2, *moe_router, *moe_w1, *moe_w3, *moe_w2, *final_norm;
    float* out; char* ws;
};

__device__ __forceinline__ int ltid_() { int t = threadIdx.x; asm volatile("" : "+v"(t)); return t; }
#define TIDX ltid_()
__device__ __forceinline__ float bf2f(bf16_t h) { return __uint_as_float(((unsigned)h) << 16); }
__device__ __forceinline__ bf16_t f2bf(float f) { unsigned u = __float_as_uint(f); u += 0x7fffu + ((u >> 16) & 1u); return (bf16_t)(u >> 16); }
__device__ __forceinline__ unsigned pack2(float lo, float hi) { return (unsigned)f2bf(lo) | ((unsigned)f2bf(hi) << 16); }
__device__ __forceinline__ float wave_sum(float v) {
#pragma unroll
    for (int o = 32; o >= 1; o >>= 1) v += __shfl_xor(v, o);
    return v;
}
__device__ __forceinline__ float sigmoidf_(float x) { return 1.0f / (1.0f + __expf(-x)); }
__device__ __forceinline__ float siluf_(float x) { return x / (1.0f + __expf(-x)); }
__device__ __forceinline__ float fast_silu(float v) { return v * __builtin_amdgcn_rcpf(1.0f + __expf(-v)); }
__device__ __forceinline__ float softplusf_(float x) { return x > 20.f ? x : log1pf(expf(x)); }
__device__ __forceinline__ float gelu_tanh(float x) { const float u = 0.7978845608028654f * (x + 0.044715f * x * x * x); return x * __builtin_amdgcn_rcpf(1.0f + __expf(-2.0f * u)); }
__device__ __forceinline__ int row_base(int b, int ci) { return ci < 2 ? NLAT + b * NCTX + ci * 128 : b * NSEQ + (ci - 2) * 128; }
__device__ __forceinline__ int mod_class(int row) { return row < NSEQ ? 0 : (row < NLAT ? 1 : 2); }

typedef float f32x16 __attribute__((ext_vector_type(16)));
typedef short s16x4 __attribute__((ext_vector_type(4)));
typedef short v4i16_t __attribute__((ext_vector_type(4)));
typedef float f32x2_t __attribute__((ext_vector_type(2)));
typedef __bf16 bf16x2_t __attribute__((ext_vector_type(2)));
__device__ __forceinline__ unsigned cvtpk_s(float lo, float hi) { f32x2_t v = {lo, hi}; bf16x2_t bb = __builtin_convertvector(v, bf16x2_t); return __builtin_bit_cast(unsigned, bb); }
__device__ __forceinline__ int crow(int r, int hi) { return (r & 3) + 8 * (r >> 2) + 4 * hi; }
__device__ __forceinline__ s16x4 vtr(const LAS char* p) { return __builtin_bit_cast(s16x4, __builtin_amdgcn_ds_read_tr16_b64_v4i16((LAS v4i16_t*)p)); }
__device__ __forceinline__ float bfs(short s) { return __uint_as_float(((unsigned)(unsigned short)s) << 16); }

__device__ __forceinline__ void convert_tile4(const float* src, int K, int N, bf16_t* dst, int unit, int mode, float* lds) {
    const int upn = N / 256, tk = unit / upn, tn4 = unit % upn, t = TIDX;
    {   const int kk = t >> 3, nc = (t & 7) * 8; float4 a[4], b[4];
#pragma unroll
        for (int q = 0; q < 4; ++q) { const float* sp = src + (size_t)(tk * 64 + kk) * N + tn4 * 256 + q * 64 + nc; a[q] = *(const float4*)sp; b[q] = *(const float4*)(sp + 4); }
#pragma unroll
        for (int q = 0; q < 4; ++q) { float* d = lds + q * (64 * 65) + kk * 65 + nc; d[0] = a[q].x; d[1] = a[q].y; d[2] = a[q].z; d[3] = a[q].w; d[4] = b[q].x; d[5] = b[q].y; d[6] = b[q].z; d[7] = b[q].w; } }
    __syncthreads();
    {   const int n = t >> 3, kc = (t & 7) * 8;
#pragma unroll
        for (int q = 0; q < 4; ++q) { const int ng = tn4 * 256 + q * 64 + n; const float* L = lds + q * (64 * 65);
            int nrow;
            if (mode == 3) {
                const int s = ng >> 7; const bool r64 = s <= 2 || (s >= 4 && s <= 7), r32 = s >= 12 && s <= 15;
                if (r64) { const int d = ng & 63; nrow = (ng & ~63) + 8 * ((d & 31) >> 2) + 4 * (d >> 5) + (d & 3); }
                else if (r32) { const int d = ng & 31; nrow = (ng & ~31) + 8 * ((d & 15) >> 2) + 4 * (d >> 4) + (d & 3); }
                else nrow = ng;
            } else nrow = mode == 0 ? ng : ((ng >> 7) * 256 + (mode == 2 ? 128 : 0) + (ng & 127));
            uint4 w; w.x = pack2(L[(kc + 0) * 65 + n], L[(kc + 1) * 65 + n]); w.y = pack2(L[(kc + 2) * 65 + n], L[(kc + 3) * 65 + n]);
            w.z = pack2(L[(kc + 4) * 65 + n], L[(kc + 5) * 65 + n]); w.w = pack2(L[(kc + 6) * 65 + n], L[(kc + 7) * 65 + n]);
            *(uint4*)(dst + (size_t)nrow * K + tk * 64 + kc) = w; } }
    __syncthreads();
}

__device__ __forceinline__ void ph_prologue(const Params& p, int bid, int nb, float* lds) {
    char* ws = p.ws; const int t = TIDX;
    {
        struct Job { const float* src; bf16_t* dst; int K, N, mode, base; };
        Job* jobs = (Job*)(lds + 4 * 64 * 65);
        const int T_IN = 16 * 11, T_OUT = 16 * 4, T_F13 = 16 * 11, T_F2 = 44 * 4, T_M13 = 16 * 14, T_M2 = 56 * 4;
        const int total = 2 * T_IN + 2 * T_OUT + 2 * T_F13 + T_F2 + 16 * T_M13 + 8 * T_M2;
        if (t < 32) {
            Job jb; jb.src = nullptr; jb.dst = nullptr; jb.K = DM; jb.N = DM; jb.mode = 0; jb.base = total;
            if (t < 2) { jb.src = p.w_in + (size_t)t * DM * DIN; jb.dst = (bf16_t*)(ws + OFF_WIN) + (size_t)t * DIN * DM; jb.N = DIN; jb.mode = 3; jb.base = t * T_IN; }
            else if (t < 4) { jb.src = p.w_out + (size_t)(t - 2) * DM * DM; jb.dst = (bf16_t*)(ws + OFF_WOUT) + (size_t)(t - 2) * DM * DM; jb.base = 2 * T_IN + (t - 2) * T_OUT; }
            else if (t < 6) { jb.src = t == 4 ? p.ffn_w1 : p.ffn_w3; jb.dst = (bf16_t*)(ws + OFF_WF13); jb.N = DFF; jb.mode = t - 3; jb.base = 2 * T_IN + 2 * T_OUT + (t - 4) * T_F13; }
            else if (t == 6) { jb.src = p.ffn_w2; jb.dst = (bf16_t*)(ws + OFF_WF2); jb.K = DFF; jb.base = 2 * T_IN + 2 * T_OUT + 2 * T_F13; }
            else if (t < 23) { const int q = t - 7, e = q & 7, w3 = q >> 3; jb.src = (w3 ? p.moe_w3 : p.moe_w1) + (size_t)e * DM * DFE; jb.dst = (bf16_t*)(ws + OFF_WM13) + (size_t)e * 2 * DFE * DM; jb.N = DFE; jb.mode = 1 + w3;
                jb.base = 2 * T_IN + 2 * T_OUT + 2 * T_F13 + T_F2 + q * T_M13; }
            else if (t < 31) { const int e = t - 23; jb.src = p.moe_w2 + (size_t)e * DFE * DM; jb.dst = (bf16_t*)(ws + OFF_WM2) + (size_t)e * DM * DFE; jb.K = DFE;
                jb.base = 2 * T_IN + 2 * T_OUT + 2 * T_F13 + T_F2 + 16 * T_M13 + e * T_M2; }
            jobs[t] = jb;
        }
        __syncthreads();
        int j = 0;
        for (int u = bid; u < total; u += nb) {
            while (u >= jobs[j + 1].base) ++j;
            const Job jb = jobs[j];
            convert_tile4(jb.src, jb.K, jb.N, jb.dst, u - jb.base, jb.mode, lds);
        }
        __syncthreads();
    }
    {
        float* sv = lds;
        float* red = lds + 3072;
        for (int i = t; i < 3072; i += 512) { const int v = i >> 10, k = i & 1023; const float cv = v < 2 ? p.c[v * DM + k] : p.c_ctx[k]; sv[i] = siluf_(cv); }
        __syncthreads();
        float* mod = (float*)(ws + OFF_MOD);
        for (int u = bid; u < 2 * 96; u += nb) {
            const int l = u / 96, j0 = (u % 96) * 64, j = t & 63, kg = t >> 6;
            float a0 = 0.f, a1 = 0.f, a2 = 0.f;
            const float* w = p.w_ada + (size_t)l * DM * 6144 + j0 + j;
            for (int k = kg * 128; k < kg * 128 + 128; ++k) { const float wv = w[(size_t)k * 6144]; a0 += sv[k] * wv; a1 += sv[1024 + k] * wv; a2 += sv[2048 + k] * wv; }
            red[(kg * 3 + 0) * 64 + j] = a0; red[(kg * 3 + 1) * 64 + j] = a1; red[(kg * 3 + 2) * 64 + j] = a2;
            __syncthreads();
            if (t < 192) { const int v = t >> 6; float s = 0.f;
                for (int g = 0; g < 8; ++g) s += red[(g * 3 + v) * 64 + j];
                mod[((size_t)l * 3 + v) * 6144 + j0 + j] = s + p.b_ada[l * 6144 + j0 + j]; }
            __syncthreads();
        }
    }
    {
        const int gt = bid * 512 + t, gs = nb * 512;
        float* ta = (float*)(ws + OFF_TAB + TAB_ATTN); float* tr = (float*)(ws + OFF_TAB + TAB_RET); float* td = (float*)(ws + OFF_TAB + TAB_DIFF);
        for (int i = gt; i < 16384 * 32; i += gs) { const int n = i >> 5, j = i & 31;
            { const float inv = (float)pow(10000.0, -(double)j / 32.0); const float ang = (float)n * inv; tr[i] = (float)cos((double)ang); tr[16384 * 32 + i] = (float)sin((double)ang); }
            { const float inv = (float)pow(10000.0, -(double)(j & 15) / 16.0); const float ang = (float)(j < 16 ? (n >> 6) : (n & 63)) * inv; ta[i] = (float)cos((double)ang); ta[16384 * 32 + i] = (float)sin((double)ang); }
            if (j < 16) { const float inv = (float)pow(10000.0, -(double)(j & 7) / 8.0); const float ang = (float)(j < 8 ? (n >> 6) : (n & 63)) * inv; td[n * 16 + j] = (float)cos((double)ang); td[16384 * 16 + n * 16 + j] = (float)sin((double)ang); } }
        float* xc = (float*)(ws + OFF_XC);
        for (int i = gt; i < NCR * DM / 4; i += gs) ((float4*)xc)[i] = ((const float4*)p.ctx)[i];
        int* tok = (int*)(ws + OFF_TOK);
        for (int i = gt; i < 2 * GRP_ROWS; i += gs) tok[i] = -1;
    }
}

template <bool ROUTE>
__device__ __forceinline__ void ph_norm(const Params& p, int l, int which  , int nrows, int bid, int nb, float* lds) {
    char* ws = p.ws; const int lane = TIDX & 63, wv = TIDX >> 6;
    LAS unsigned* lcnt = (LAS unsigned*)lds;
    if (ROUTE) { __syncthreads(); if (TIDX < 16) lcnt[TIDX] = 0u; __syncthreads(); }
    const float* mod = (const float*)(ws + OFF_MOD) + (size_t)l * 3 * 6144;
    const float* g = (which == 0 ? p.g1 : p.g2) + l * DM;
    bf16_t* H = (bf16_t*)(ws + OFF_ACT);
    const float* xl = (which == 0 && l == 0) ? p.x : p.out;
    const float* xc = (const float*)(ws + OFF_XC);
    const int stride = nb * 8;
    for (int r0 = bid * 8 + wv; r0 < nrows; r0 += 2 * stride) {
        float4 v[2][4]; float ss[2]; const bool has1 = r0 + stride < nrows;
#pragma unroll
        for (int q = 0; q < 2; ++q) { const int r = (q == 0 || has1) ? r0 + q * stride : r0;
            const float* xr = r < NLAT ? xl + (size_t)r * DM : xc + (size_t)(r - NLAT) * DM;
#pragma unroll
            for (int i = 0; i < 4; ++i) v[q][i] = *(const float4*)(xr + i * 256 + lane * 4); }
#pragma unroll
        for (int q = 0; q < 2; ++q) { float s = 0.f;
#pragma unroll
            for (int i = 0; i < 4; ++i) s += v[q][i].x * v[q][i].x + v[q][i].y * v[q][i].y + v[q][i].z * v[q][i].z + v[q][i].w * v[q][i].w;
            ss[q] = wave_sum(s); }
#pragma unroll
        for (int q = 0; q < 2; ++q) {
            if (q == 1 && !has1) break;
            const int r = r0 + q * stride;
            const float* mv = mod + (size_t)mod_class(r) * 6144 + (which == 0 ? 0 : 3072);
            const float rn = rsqrtf(ss[q] * (1.0f / 1024.0f) + 1e-6f);
            float lg[8];
            if (ROUTE) {
#pragma unroll
                for (int e = 0; e < 8; ++e) lg[e] = 0.f;
            }
#pragma unroll
            for (int i = 0; i < 4; ++i) {
                const int c = i * 256 + lane * 4;
                const float4 gg = *(const float4*)(g + c), sh = *(const float4*)(mv + c), sc = *(const float4*)(mv + 1024 + c);
                float h0 = v[q][i].x * rn * gg.x * (1.f + sc.x) + sh.x, h1 = v[q][i].y * rn * gg.y * (1.f + sc.y) + sh.y;
                float h2 = v[q][i].z * rn * gg.z * (1.f + sc.z) + sh.z, h3 = v[q][i].w * rn * gg.w * (1.f + sc.w) + sh.w;
                uint2 w; w.x = pack2(h0, h1); w.y = pack2(h2, h3);
                *(uint2*)(H + (size_t)r * DM + c) = w;
                if (ROUTE) {
                    const float* rt = p.moe_router + (size_t)c * 8;
#pragma unroll
                    for (int e = 0; e < 8; ++e) lg[e] += h0 * rt[e] + h1 * rt[8 + e] + h2 * rt[16 + e] + h3 * rt[24 + e];
                }
            }
            if (ROUTE) {
#pragma unroll
                for (int e = 0; e < 8; ++e) lg[e] = wave_sum(lg[e]);
                if (lane == 0 && r < NLAT) {
                    int e0 = 0; float v0 = lg[0];
#pragma unroll
                    for (int e = 1; e < 8; ++e) if (lg[e] > v0) { v0 = lg[e]; e0 = e; }
                    int e1 = -1; float v1 = -3.0e38f;
#pragma unroll
                    for (int e = 0; e < 8; ++e) if (e != e0 && lg[e] > v1) { v1 = lg[e]; e1 = e; }
                    const float ex = __expf(v1 - v0), w0 = 1.0f / (1.0f + ex), w1 = ex / (1.0f + ex);
                    const unsigned li0 = __hip_atomic_fetch_add(lcnt + e0, 1u, __ATOMIC_RELAXED, __HIP_MEMORY_SCOPE_WORKGROUP), li1 = __hip_atomic_fetch_add(lcnt + 8 + e1, 1u, __ATOMIC_RELAXED, __HIP_MEMORY_SCOPE_WORKGROUP);
                    int4 rec; rec.x = e0 | (int)(li0 << 4); rec.y = e1 | (int)(li1 << 4); rec.z = __float_as_int(w0); rec.w = __float_as_int(w1);
                    *(int4*)(ws + OFF_ROUTE + (size_t)r * 16) = rec;
                }
            }
        }
    }
    if (ROUTE) {
        __syncthreads();
        if (TIDX < 16) { unsigned* cw = (unsigned*)ws; const int t = TIDX; cw[CW_BLK + bid * 16 + t] = atomicAdd(cw + CW_CNT + t, lcnt[t]); }
    }
}

namespace pg8 {
#define PG8_LAS __attribute__((address_space(3)))
typedef unsigned short bf16_t;
typedef short bf16x8 __attribute__((ext_vector_type(8)));
typedef float f32x4 __attribute__((ext_vector_type(4)));
typedef unsigned u32x4 __attribute__((ext_vector_type(4)));
constexpr int BM = 256, BK = 64, HALF = 128, HTB = HALF * BK * 2  , STAGE_BYTES = 8 * HTB, NXCD = 8, WGM = 8;

__host__ __device__ __forceinline__ int lds_byte(int r, int c) { const int st = (r >> 4) * 2 + (c >> 5), rr = r & 15, cc = c & 31, ob = rr * 64 + cc * 2; return st * 1024 + (ob ^ (((ob >> 9) & 1) << 5)); }
__host__ __device__ __forceinline__ void stage_rc(int b, int& R, int& C) { const int st = b / 1024, sb = b % 1024, swz = sb ^ (((sb >> 9) & 1) << 5); R = (st >> 1) * 16 + swz / 64; C = (st & 1) * 32 + (swz % 64) / 2; }
__host__ __device__ __forceinline__ int perm32(int rho) { const int n = rho >> 4, i = rho & 15; return 8 * (i >> 2) + 4 * n + (i & 3); }

struct Unit { int pm, pn; };
struct Gemm { const bf16_t* A; const bf16_t* Bt; int M, N, K; };

struct StaticOrder {
    int nM, nN, nwg, G, c;
    __host__ __device__ void init(int M, int N, int G_, int c_) { nM = M / BM; nN = N / BM; nwg = nM * nN; G = G_; c = c_; }
    __host__ __device__ bool next(int i, Unit& u) const {
        const long L = (long)i * G + c; if (L >= nwg) return false;
        int wgid = (int)L; { const int q = nwg / NXCD, r = nwg % NXCD, xcd = wgid % NXCD, off = wgid / NXCD; wgid = (xcd < r ? xcd * (q + 1) : r * (q + 1) + (xcd - r) * q) + off; }
        const int nig = WGM * nN, gid = wgid / nig, fm = gid * WGM, gsz = (nM - fm) < WGM ? (nM - fm) : WGM;
        u.pm = fm + ((wgid % nig) % gsz); u.pn = (wgid % nig) / gsz; return true;
    }
    __device__ __forceinline__ void a_ready(const Unit&) const {}
    __device__ __forceinline__ void done(const Unit&) const {}
};
__device__ __forceinline__ unsigned cvt_pk_bf16(float lo, float hi) { unsigned r; asm volatile("v_cvt_pk_bf16_f32 %0, %1, %2" : "=v"(r) : "v"(lo), "v"(hi)); return r; }
typedef float f32x2 __attribute__((ext_vector_type(2)));
template <class Epi, class Sched, bool ALIGN_EPI = false, bool SP2 = false>
__device__ __forceinline__ void gemm_phase(PG8_LAS unsigned char* lds, const Gemm g, const Sched& S, const Epi& E) {
    int tid_ = threadIdx.x; asm volatile("" : "+v"(tid_));
    const int tid = tid_, wid = __builtin_amdgcn_readfirstlane(tid >> 6), lane = tid & 63, wr = wid >> 2, wc = wid & 3, fr = lane & 15, fq = lane >> 4;
    const int K = g.K, nt = K / BK;
    unsigned voffA[2], voffB[2];
#pragma unroll
    for (int i = 0; i < 2; ++i) { int R, C; stage_rc(tid * 16 + i * 8192, R, C); const int Rb = Epi::PERM ? ((R & ~31) + perm32(R & 31)) : R;
        voffA[i] = (unsigned)(R * K + C) * 2u; voffB[i] = (unsigned)(Rb * K + C) * 2u; }
    const size_t kstep = (size_t)(BK * 2);
    const size_t hstep = (size_t)HALF * K * 2;
    const size_t tstep = 2 * hstep;
    const unsigned ldsw = (unsigned)wid * 1024u;
    const int aoff = lds_byte(wr * 64 + fr, fq * 8), boff = lds_byte(wc * 32 + fr, fq * 8);
#define PG8_SA(b, h) (((b) * 2 + (h)) * HTB)
#define PG8_SB(b, h) ((4 + (b) * 2 + (h)) * HTB)
#define PG8_STAGE(bufoff, gbase, voff) do { _Pragma("unroll") for (int _i = 0; _i < 2; ++_i) \
        __builtin_amdgcn_global_load_lds((const unsigned*)((const char*)(gbase) + (voff)[_i]), (PG8_LAS unsigned*)(lds + (bufoff) + ldsw + _i * 8192), 16, 0, 0); } while (0)
#define PG8_LDA(dst, b, h) do { _Pragma("unroll") for (int m = 0; m < 4; ++m) _Pragma("unroll") for (int k = 0; k < 2; ++k) dst[m][k] = *(const PG8_LAS bf16x8*)(lds + PG8_SA(b, h) + aoff + m * 2048 + k * 1024); } while (0)
#define PG8_LDB(dst, b, h) do { _Pragma("unroll") for (int n = 0; n < 2; ++n) _Pragma("unroll") for (int k = 0; k < 2; ++k) dst[n][k] = *(const PG8_LAS bf16x8*)(lds + PG8_SB(b, h) + boff + n * 2048 + k * 1024); } while (0)
#define PG8_MMA(ai, bj, At, Bt) do { __builtin_amdgcn_s_setprio(1); _Pragma("unroll") for (int m = 0; m < 4; ++m) _Pragma("unroll") for (int n = 0; n < 2; ++n) _Pragma("unroll") for (int k = 0; k < 2; ++k) \
        acc[ai][bj][m][n] = __builtin_amdgcn_mfma_f32_16x16x32_bf16(Bt[n][k], At[m][k], acc[ai][bj][m][n], 0, 0, 0); __builtin_amdgcn_s_setprio(0); } while (0)
#define PG8_WAIT_V(n) asm volatile("s_waitcnt vmcnt(" #n ")" ::: "memory")
#define PG8_WAIT_L(n) asm volatile("s_waitcnt lgkmcnt(" #n ")" ::: "memory")
#define PG8_BAR __builtin_amdgcn_s_barrier()
#define PG8_SCHED __builtin_amdgcn_sched_barrier(0)
    Unit cur, nxt; int ui = 0;
    if (!S.next(0, cur)) return;
    f32x4 acc[2][2][4][2];
#pragma unroll
    for (int a = 0; a < 2; ++a)
#pragma unroll
        for (int b = 0; b < 2; ++b)
#pragma unroll
            for (int m = 0; m < 4; ++m)
#pragma unroll
                for (int n = 0; n < 2; ++n) acc[a][b][m][n] = (f32x4){0.f, 0.f, 0.f, 0.f};
    bf16x8 At[4][2], B0[2][2], B1[2][2];
    const char* cA = (const char*)g.A + (size_t)cur.pm * tstep; const char* cB = (const char*)g.Bt + (size_t)cur.pn * tstep;
    S.a_ready(cur);
    if constexpr (SP2) {
        PG8_STAGE(PG8_SB(0, 0), cB, voffB); PG8_STAGE(PG8_SB(0, 1), cB + hstep, voffB); PG8_STAGE(PG8_SA(0, 0), cA, voffA); PG8_STAGE(PG8_SA(0, 1), cA + hstep, voffA);
        if (wr == 1) PG8_BAR;
        PG8_WAIT_V(2); PG8_BAR;
        PG8_STAGE(PG8_SB(1, 0), cB + kstep, voffB); PG8_STAGE(PG8_SA(1, 0), cA + kstep, voffA); PG8_STAGE(PG8_SB(1, 1), cB + hstep + kstep, voffB);
        PG8_WAIT_V(6); PG8_BAR;
    } else {
        PG8_STAGE(PG8_SB(0, 0), cB, voffB); PG8_STAGE(PG8_SA(0, 0), cA, voffA); PG8_STAGE(PG8_SB(0, 1), cB + hstep, voffB); PG8_STAGE(PG8_SA(0, 1), cA + hstep, voffA);
        if (wr == 1) PG8_BAR;
        PG8_WAIT_V(4); PG8_BAR;
        PG8_STAGE(PG8_SB(1, 0), cB + kstep, voffB); PG8_STAGE(PG8_SA(1, 0), cA + kstep, voffA); PG8_STAGE(PG8_SB(1, 1), cB + hstep + kstep, voffB);
        PG8_WAIT_V(6); PG8_BAR;
    }
    for (;;) {
        const bool has_next = S.next(ui + 1, nxt);
        const char* nA = has_next ? (const char*)g.A + (size_t)nxt.pm * tstep : cA; const char* nB = has_next ? (const char*)g.Bt + (size_t)nxt.pn * tstep : cB;
        for (int t = 0; t < nt; t += 2) {
            const bool last = (t == nt - 2);
            const char* a1 = cA + (size_t)(t + 1) * kstep;
            const char* a2 = last ? nA : cA + (size_t)(t + 2) * kstep; const char* b2 = last ? nB : cB + (size_t)(t + 2) * kstep;
            const char* a3 = a2 + kstep; const char* b3 = b2 + kstep;
            if (last && has_next) S.a_ready(nxt);
            if constexpr (SP2) {
            PG8_LDB(B0, 0, 0); PG8_LDB(B1, 0, 1); PG8_SCHED; PG8_LDA(At, 0, 0); PG8_STAGE(PG8_SA(1, 1), a1 + hstep, voffA);
            PG8_WAIT_V(8); PG8_WAIT_L(0); PG8_BAR; PG8_MMA(0, 0, At, B0); PG8_MMA(0, 1, At, B1); PG8_BAR; PG8_SCHED;
            PG8_LDA(At, 0, 1); PG8_STAGE(PG8_SB(0, 0), b2, voffB); PG8_STAGE(PG8_SB(0, 1), b2 + hstep, voffB); PG8_STAGE(PG8_SA(0, 0), a2, voffA);
            PG8_WAIT_V(8); PG8_WAIT_L(0); PG8_BAR; PG8_MMA(1, 0, At, B0); PG8_MMA(1, 1, At, B1); PG8_BAR; PG8_SCHED;
            PG8_LDB(B0, 1, 0); PG8_LDB(B1, 1, 1); PG8_SCHED; PG8_LDA(At, 1, 0); PG8_STAGE(PG8_SA(0, 1), a2 + hstep, voffA);
            PG8_WAIT_V(8); PG8_WAIT_L(0); PG8_BAR; PG8_MMA(0, 0, At, B0); PG8_MMA(0, 1, At, B1); PG8_BAR; PG8_SCHED;
            PG8_LDA(At, 1, 1); PG8_STAGE(PG8_SB(1, 0), b3, voffB); PG8_STAGE(PG8_SB(1, 1), b3 + hstep, voffB); PG8_STAGE(PG8_SA(1, 0), a3, voffA);
            PG8_WAIT_V(8); PG8_WAIT_L(0); PG8_BAR; PG8_MMA(1, 0, At, B0); PG8_MMA(1, 1, At, B1); PG8_BAR; PG8_SCHED;
            } else {
            PG8_LDB(B0, 0, 0); PG8_SCHED; PG8_LDA(At, 0, 0); PG8_STAGE(PG8_SA(1, 1), a1 + hstep, voffA);
            PG8_WAIT_L(8); PG8_BAR; PG8_WAIT_L(0); PG8_MMA(0, 0, At, B0); PG8_BAR; PG8_SCHED;
            PG8_LDB(B1, 0, 1); PG8_STAGE(PG8_SB(0, 0), b2, voffB);
            PG8_BAR; PG8_WAIT_L(0); PG8_MMA(0, 1, At, B1); PG8_BAR;
            PG8_LDA(At, 0, 1); PG8_STAGE(PG8_SA(0, 0), a2, voffA);
            PG8_BAR; PG8_WAIT_L(0); PG8_MMA(1, 0, At, B0); PG8_BAR; PG8_SCHED;
            PG8_STAGE(PG8_SB(0, 1), b2 + hstep, voffB);
            PG8_WAIT_V(6); PG8_BAR; PG8_MMA(1, 1, At, B1); PG8_BAR;
            PG8_LDB(B0, 1, 0); PG8_SCHED; PG8_LDA(At, 1, 0); PG8_STAGE(PG8_SA(0, 1), a2 + hstep, voffA);
            PG8_WAIT_L(8); PG8_BAR; PG8_WAIT_L(0); PG8_MMA(0, 0, At, B0); PG8_BAR; PG8_SCHED;
            PG8_LDB(B1, 1, 1); PG8_STAGE(PG8_SB(1, 0), b3, voffB);
            PG8_BAR; PG8_WAIT_L(0); PG8_MMA(0, 1, At, B1); PG8_BAR;
            PG8_LDA(At, 1, 1); PG8_STAGE(PG8_SA(1, 0), a3, voffA);
            PG8_BAR; PG8_WAIT_L(0); PG8_MMA(1, 0, At, B0); PG8_BAR; PG8_SCHED;
            PG8_STAGE(PG8_SB(1, 1), b3 + hstep, voffB);
            PG8_WAIT_V(6); PG8_BAR; PG8_MMA(1, 1, At, B1); PG8_BAR;
            }
        }
        if constexpr (ALIGN_EPI) { if (wr == 0) PG8_BAR; }
        if constexpr (!Epi::AFTER_DRAIN) { E(acc, cur, wr, wc, fr, fq); S.done(cur); }
        if (!has_next) break;
#pragma unroll
        for (int a = 0; a < 2; ++a)
#pragma unroll
            for (int b = 0; b < 2; ++b)
#pragma unroll
                for (int m = 0; m < 4; ++m)
#pragma unroll
                    for (int n = 0; n < 2; ++n) acc[a][b][m][n] = (f32x4){0.f, 0.f, 0.f, 0.f};
        cur = nxt; cA = nA; cB = nB; ++ui;
        if constexpr (ALIGN_EPI) { if (wr == 1) PG8_BAR; }
    }
    PG8_WAIT_V(0);
    if constexpr (!ALIGN_EPI) { if (wr == 0) PG8_BAR; }
    PG8_BAR;
    if constexpr (Epi::AFTER_DRAIN) { E.fused(acc, cur, wr, wc, fr, fq, lds, wid, lane); S.done(cur); }
#undef PG8_SA
#undef PG8_SB
#undef PG8_STAGE
#undef PG8_LDA
#undef PG8_LDB
#undef PG8_MMA
#undef PG8_WAIT_V
#undef PG8_WAIT_L
#undef PG8_BAR
#undef PG8_SCHED
}
}

constexpr int RT_K = 0, RT_V = 32768, RT_ST = 65536;
template <bool KV> __device__ __forceinline__ void ret_stage(const bf16_t* P, int rb, int hp, LAS char* sm, int tid, int wid, int lane) {
    const int vrow = 16 * (wid & 3) + (lane >> 2), vc = (wid >> 2) * 32 + (lane & 3) * 8;
    u32x4 kk[4], vv[4];
#pragma unroll
    for (int i = 0; i < 4; ++i) { const int hh = i >> 1, tt = i & 1, h = 2 * hp + hh, r0 = rb + tt * 64;
        vv[i] = *(const u32x4*)(P + (size_t)(r0 + vrow) * DIN + C_RV + h * 64 + vc);
        kk[i] = KV ? *(const u32x4*)(P + (size_t)(r0 + vrow) * DIN + C_RK + h * 64 + vc) : *(const u32x4*)(P + (size_t)(r0 + lane) * DIN + C_RK + h * 64 + wid * 8); }
#pragma unroll
    for (int i = 0; i < 4; ++i) { *(LAS u32x4*)(sm + RT_K + i * 8192 + tid * 16) = kk[i]; *(LAS u32x4*)(sm + RT_V + i * 8192 + tid * 16) = vv[i]; }
}
__device__ __forceinline__ float ret_lg(const Params& p, int l, int dir, int h) { return -softplusf_(-p.ret_logit[(l * 2 + dir) * 4 + h]); }
__device__ __forceinline__ void ph_ret_summ(const Params& p, int l, int bid, int nb, float* lds) {
    char* ws = p.ws; const int tid = TIDX, lane = tid & 63, r32 = lane & 31, hi = lane >> 5, wid = __builtin_amdgcn_readfirstlane(tid >> 6);
    const bf16_t* P = (const bf16_t*)(ws + OFF_P); float* RET = (float*)(ws + OFF_RET);
    LAS char* sm = (LAS char*)lds;
    for (int u = bid; u < 2 * NCI * 2; u += nb) {
        const int hp = u & 1, ci = (u >> 1) % NCI, b = (u >> 1) / NCI, rb = row_base(b, ci);
        __syncthreads();
        ret_stage<true>(P, rb, hp, sm, tid, wid, lane);
        __syncthreads();
        const int hh = wid >> 2, dh = (wid >> 1) & 1, eh = wid & 1, h = 2 * hp + hh;
        const float lg2f = ret_lg(p, l, 0, h) * 1.4426950408889634f, lg2b = ret_lg(p, l, 1, h) * 1.4426950408889634f;
        const int voff = ((lane >> 4) & 1) * 32 + (lane & 3) * 8 + (4 * hi + ((lane & 15) >> 2)) * 64;
        const LAS char* Kb = sm + RT_K + hh * 16384 + dh * 4096 + voff; const LAS char* Vb = sm + RT_V + hh * 16384 + eh * 4096 + voff;
        f32x16 a0, a1;
#pragma unroll
        for (int r = 0; r < 16; ++r) { a0[r] = 0.f; a1[r] = 0.f; }
#pragma unroll
        for (int k8 = 0; k8 < 8; ++k8) { const int tt = k8 >> 2, sl = k8 & 3;
            const s16x4 klo = vtr(Kb + tt * 8192 + sl * 1024), khi = vtr(Kb + tt * 8192 + sl * 1024 + 512), vlo = vtr(Vb + tt * 8192 + sl * 1024), vhi = vtr(Vb + tt * 8192 + sl * 1024 + 512);
            const int mb = tt * 64 + sl * 16 + 4 * hi; float kf_[8], kb_[8];
#pragma unroll
            for (int j = 0; j < 8; ++j) { const int m = mb + (j < 4 ? j : j + 4); const float kv = bfs(j < 4 ? klo[j] : khi[j - 4]);
                kf_[j] = kv * __builtin_amdgcn_exp2f(lg2f * (float)(127 - m)); kb_[j] = kv * __builtin_amdgcn_exp2f(lg2b * (float)m); }
            const u32x4 af = {cvtpk_s(kf_[0], kf_[1]), cvtpk_s(kf_[2], kf_[3]), cvtpk_s(kf_[4], kf_[5]), cvtpk_s(kf_[6], kf_[7])};
            const u32x4 ab = {cvtpk_s(kb_[0], kb_[1]), cvtpk_s(kb_[2], kb_[3]), cvtpk_s(kb_[4], kb_[5]), cvtpk_s(kb_[6], kb_[7])};
            const bf16x8 vfr = {vlo[0], vlo[1], vlo[2], vlo[3], vhi[0], vhi[1], vhi[2], vhi[3]};
            a0 = __builtin_amdgcn_mfma_f32_32x32x16_bf16(__builtin_bit_cast(bf16x8, af), vfr, a0, 0, 0, 0);
            a1 = __builtin_amdgcn_mfma_f32_32x32x16_bf16(__builtin_bit_cast(bf16x8, ab), vfr, a1, 0, 0, 0); }
        float* of = RET + ((((size_t)0 * 2 + b) * NCI + ci) * 4 + h) * 4096 + eh * 32 + r32;
        float* ob = RET + ((((size_t)1 * 2 + b) * NCI + ci) * 4 + h) * 4096 + eh * 32 + r32;
#pragma unroll
        for (int r = 0; r < 16; ++r) { const int d = dh * 32 + crow(r, hi); of[d * 64] = a0[r]; ob[d * 64] = a1[r]; }
    }
}

constexpr int LR_UB = 0, LR_A = 18432, LR_B = 51200, LR_H = 83968;
template <int MODE>
__device__ __forceinline__ void ph_lru_chunk(const Params& p, int l, int bid, int nb, float* lds, int ci_lo) {
    char* ws = p.ws; const int tid = TIDX, lane = tid & 63, r32 = lane & 31, hi = lane >> 5, wid = __builtin_amdgcn_readfirstlane(tid >> 6);
    const bf16_t* P = (const bf16_t*)(ws + OFF_P);
    float* LA = (float*)(ws + OFF_LRU); float* LB = LA + 2 * 2 * NCI * 256; float* LC = LB + 2 * 2 * NCI * 256;
    bf16_t* O = (bf16_t*)(ws + OFF_ACT);
    LAS char* sm = (LAS char*)lds;
    const int hb = bid & 3, tt = wid >> 1, jt = wid & 1, jcol = jt * 32 + r32, ch = hb * 64 + jcol;
    bf16x8 wfr[2][2][4]; float bia[2][2], spl[2];
#pragma unroll
    for (int dir = 0; dir < 2; ++dir) {
#pragma unroll
        for (int gt = 0; gt < 2; ++gt) { const float* W = (gt == 0 ? p.lru_wa : p.lru_wx) + (((size_t)(l * 2 + dir) * 4 + hb) * 64) * 64 + jcol;
#pragma unroll
            for (int ks = 0; ks < 4; ++ks) { const float* wp = W + (16 * ks + 8 * hi) * 64;
                const u32x4 w4 = {cvtpk_s(wp[0], wp[64]), cvtpk_s(wp[128], wp[192]), cvtpk_s(wp[256], wp[320]), cvtpk_s(wp[384], wp[448])};
                wfr[dir][gt][ks] = __builtin_bit_cast(bf16x8, w4); }
            bia[dir][gt] = (gt == 0 ? p.lru_ba : p.lru_bx)[(l * 2 + dir) * 256 + ch]; }
        spl[dir] = -8.0f * softplusf_(-p.lru_lam[(l * 2 + dir) * 256 + ch]); }
    const int nci = NCI - ci_lo, npair = 2 * nci;
    for (int pi = bid >> 2; pi < npair; pi += nb >> 2) {
        const int ci = ci_lo + pi % nci, b = pi / nci, rb = row_base(b, ci);
        const int seg_lo = ci < 2 ? NLAT + b * NCTX : b * NSEQ, seg_hi = ci < 2 ? seg_lo + NCTX : seg_lo + NSEQ;
        __syncthreads();
#pragma unroll
        for (int it = 0; it < 2; ++it) { const int item = it * 512 + tid, t = item >> 3, c8 = (item & 7) * 8, c0 = hb * 64 + c8;
            float acc[8];
            { const f32x4 b0 = *(const f32x4*)(p.conv_b + l * 256 + c0), b1 = *(const f32x4*)(p.conv_b + l * 256 + c0 + 4);
              acc[0] = b0[0]; acc[1] = b0[1]; acc[2] = b0[2]; acc[3] = b0[3]; acc[4] = b1[0]; acc[5] = b1[1]; acc[6] = b1[2]; acc[7] = b1[3]; }
#pragma unroll
            for (int k = 0; k < 4; ++k) { const int rr = rb + t - 1 + k;
                if (rr >= seg_lo && rr < seg_hi) { const bf16x8 xv = *(const bf16x8*)(P + (size_t)rr * DIN + C_LX + c0);
                    const f32x4 w0 = *(const f32x4*)(p.conv_w + (l * 4 + k) * 256 + c0), w1 = *(const f32x4*)(p.conv_w + (l * 4 + k) * 256 + c0 + 4);
                    acc[0] += w0[0] * bfs(xv[0]); acc[1] += w0[1] * bfs(xv[1]); acc[2] += w0[2] * bfs(xv[2]); acc[3] += w0[3] * bfs(xv[3]);
                    acc[4] += w1[0] * bfs(xv[4]); acc[5] += w1[1] * bfs(xv[5]); acc[6] += w1[2] * bfs(xv[6]); acc[7] += w1[3] * bfs(xv[7]); } }
            const u32x4 w = {cvtpk_s(acc[0], acc[1]), cvtpk_s(acc[2], acc[3]), cvtpk_s(acc[4], acc[5]), cvtpk_s(acc[6], acc[7])};
            *(LAS u32x4*)(sm + LR_UB + t * 144 + c8 * 2) = w; }
        __syncthreads();
        bf16x8 ua[4];
#pragma unroll
        for (int ks = 0; ks < 4; ++ks) ua[ks] = *(const LAS bf16x8*)(sm + LR_UB + (tt * 32 + r32) * 144 + (16 * ks + 8 * hi) * 2);
#pragma unroll
        for (int dir = 0; dir < 2; ++dir) {
            f32x16 ga, gx;
#pragma unroll
            for (int r = 0; r < 16; ++r) { ga[r] = bia[dir][0]; gx[r] = bia[dir][1]; }
#pragma unroll
            for (int ks = 0; ks < 4; ++ks) { ga = __builtin_amdgcn_mfma_f32_32x32x16_bf16(ua[ks], wfr[dir][0][ks], ga, 0, 0, 0); gx = __builtin_amdgcn_mfma_f32_32x32x16_bf16(ua[ks], wfr[dir][1][ks], gx, 0, 0, 0); }
#pragma unroll
            for (int r = 0; r < 16; ++r) { const int t = tt * 32 + crow(r, hi);
                const float rg = __builtin_amdgcn_rcpf(1.0f + __expf(-ga[r])), ig = __builtin_amdgcn_rcpf(1.0f + __expf(-gx[r]));
                const float a = __expf(spl[dir] * rg);
                const float uu = __uint_as_float(((unsigned)*(const LAS unsigned short*)(sm + LR_UB + t * 144 + jcol * 2)) << 16);
                *(LAS float*)(sm + LR_A + (t * 64 + jcol) * 4) = a;
                *(LAS float*)(sm + LR_B + (t * 64 + jcol) * 4) = sqrtf(fmaxf(1.0f - a * a, 0.f)) * (ig * uu); }
            __syncthreads();
            if (wid == 0) {
                const size_t cidx = (((size_t)dir * 2 + b) * NCI + ci) * 256 + hb * 64 + lane;
                float h = MODE == 3 ? LC[cidx] : 0.f, ap = 1.f;
                const LAS float* as_ = (const LAS float*)(sm + LR_A) + lane; const LAS float* bs_ = (const LAS float*)(sm + LR_B) + lane; LAS float* hs = (LAS float*)(sm + LR_H) + lane;
#pragma unroll 1
                for (int t0 = 0; t0 < 128; t0 += 16) {
                    float av[16], bv[16], hv[16];
#pragma unroll
                    for (int k = 0; k < 16; ++k) { const int t = dir == 0 ? t0 + k : 127 - t0 - k; av[k] = as_[t * 64]; bv[k] = bs_[t * 64]; if (MODE == 3 && dir == 1) hv[k] = hs[t * 64]; }
#pragma unroll
                    for (int k = 0; k < 16; ++k) { const int t = dir == 0 ? t0 + k : 127 - t0 - k; h = av[k] * h + bv[k]; ap *= av[k];
                        if (MODE == 3) hs[t * 64] = dir == 0 ? h : hv[k] + h; }
                }
                if (MODE == 1) { LA[cidx] = ap; LB[cidx] = h; }
            }
            __syncthreads();
        }
        if (MODE == 3) {
#pragma unroll
            for (int it = 0; it < 2; ++it) { const int item = it * 512 + tid, t = item >> 3, c8 = (item & 7) * 8, c0 = hb * 64 + c8;
                const f32x4 h0 = *(const LAS f32x4*)(sm + LR_H + (t * 64 + c8) * 4), h1 = *(const LAS f32x4*)(sm + LR_H + (t * 64 + c8 + 4) * 4);
                const bf16x8 yv = *(const bf16x8*)(P + (size_t)(rb + t) * DIN + C_LY + c0);
                const u32x4 w = {cvtpk_s(h0[0] * gelu_tanh(bfs(yv[0])), h0[1] * gelu_tanh(bfs(yv[1]))), cvtpk_s(h0[2] * gelu_tanh(bfs(yv[2])), h0[3] * gelu_tanh(bfs(yv[3]))),
                                 cvtpk_s(h1[0] * gelu_tanh(bfs(yv[4])), h1[1] * gelu_tanh(bfs(yv[5]))), cvtpk_s(h1[2] * gelu_tanh(bfs(yv[6])), h1[3] * gelu_tanh(bfs(yv[7])))};
                *(u32x4*)(O + (size_t)(rb + t) * DM + 768 + c0) = w; }
        }
    }
}

__device__ __forceinline__ int scan_ci(int dir, int s) { return dir == 0 ? s : (s == 0 ? 1 : (s == 1 ? 0 : NCI + 1 - s)); }
__device__ __forceinline__ void ph_scan2(const Params& p, int l, int bid, int nb) {
    char* ws = p.ws; const int gt = bid * 512 + TIDX, gs = nb * 512;
    float* RET = (float*)(ws + OFF_RET);
    for (int i = gt; i < 2 * 2 * 4 * 4096; i += gs) {
        const int de = i & 4095, h = (i >> 12) & 3, b = (i >> 14) & 1, dir = i >> 15;
        const float decay = expf(ret_lg(p, l, dir, h) * 128.0f); float S = 0.f;
        float* base = RET + (((size_t)dir * 2 + b) * NCI * 4 + h) * 4096 + de;
        for (int s0 = 0; s0 < NCI; s0 += 13) {
            float uu[13];
#pragma unroll
            for (int j = 0; j < 13; ++j) uu[j] = base[(size_t)scan_ci(dir, s0 + j) * 4 * 4096];
#pragma unroll
            for (int j = 0; j < 13; ++j) { base[(size_t)scan_ci(dir, s0 + j) * 4 * 4096] = S; S = decay * S + uu[j]; }
        }
    }
    float* LA = (float*)(ws + OFF_LRU); float* LB = LA + 2 * 2 * NCI * 256; float* LC = LB + 2 * 2 * NCI * 256;
    for (int i = gt; i < 2 * 2 * 256; i += gs) {
        const int ch = i & 255, b = (i >> 8) & 1, dir = i >> 9; float h = 0.f;
        const size_t base = ((size_t)dir * 2 + b) * NCI * 256 + ch;
        for (int s0 = 0; s0 < NCI; s0 += 13) {
            float aa[13], bb[13];
#pragma unroll
            for (int j = 0; j < 13; ++j) { const size_t idx = base + (size_t)scan_ci(dir, s0 + j) * 256; aa[j] = LA[idx]; bb[j] = LB[idx]; }
#pragma unroll
            for (int j = 0; j < 13; ++j) { LC[base + (size_t)scan_ci(dir, s0 + j) * 256] = h; h = aa[j] * h + bb[j]; }
        }
    }
}

__device__ __forceinline__ bf16x8 scale_frag(bf16x8 q, float s) {
    u32x4 w;
#pragma unroll
    for (int i = 0; i < 4; ++i) w[i] = cvtpk_s(bfs(q[2 * i]) * s, bfs(q[2 * i + 1]) * s);
    return __builtin_bit_cast(bf16x8, w);
}
__device__ __forceinline__ void ph_ret_out(const Params& p, int l, int bid, int nb, float* lds, int ci_lo) {
    char* ws = p.ws; const int tid = TIDX, lane = tid & 63, r32 = lane & 31, hi = lane >> 5, wid = __builtin_amdgcn_readfirstlane(tid >> 6);
    const bf16_t* P = (const bf16_t*)(ws + OFF_P); const float* RET = (const float*)(ws + OFF_RET); bf16_t* O = (bf16_t*)(ws + OFF_ACT);
    LAS char* sm = (LAS char*)lds;
    const int nci = NCI - ci_lo;
    for (int u = bid; u < 2 * nci * 2; u += nb) {
        const int hp = u & 1, ci = ci_lo + (u >> 1) % nci, b = (u >> 1) / nci, rb = row_base(b, ci);
        __syncthreads();
        ret_stage<false>(P, rb, hp, sm, tid, wid, lane);
        __syncthreads();
        const int hh = wid >> 2, qt = wid & 3, h = 2 * hp + hh; int n = qt * 32 + r32;
        asm volatile("" : "+v"(n));
        const float lg2f = ret_lg(p, l, 0, h) * 1.4426950408889634f, lg2b = ret_lg(p, l, 1, h) * 1.4426950408889634f;
        bf16x8 qr[4];
        { const bf16_t* qp = P + (size_t)(rb + n) * DIN + C_RQ + h * 64 + hi * 8;
#pragma unroll
          for (int ks = 0; ks < 4; ++ks) qr[ks] = *(const bf16x8*)(qp + ks * 16); }
        f32x16 o[2];
#pragma unroll
        for (int r = 0; r < 16; ++r) { o[0][r] = 0.f; o[1][r] = 0.f; }
#pragma unroll
        for (int dir = 0; dir < 2; ++dir) {
            const float xi = dir == 0 ? __builtin_amdgcn_exp2f(lg2f * (float)(n + 1)) : __builtin_amdgcn_exp2f(lg2b * (float)(128 - n));
            const float* Sb = RET + ((((size_t)dir * 2 + b) * NCI + ci) * 4 + h) * 4096 + hi * 8 * 64 + r32;
#pragma unroll
            for (int ks = 0; ks < 4; ++ks) { const bf16x8 qx = scale_frag(qr[ks], xi);
#pragma unroll
                for (int eh = 0; eh < 2; ++eh) { const float* sp = Sb + ks * 16 * 64 + eh * 32;
                    const u32x4 sw = {cvtpk_s(sp[0], sp[64]), cvtpk_s(sp[128], sp[192]), cvtpk_s(sp[256], sp[320]), cvtpk_s(sp[384], sp[448])};
                    o[eh] = __builtin_amdgcn_mfma_f32_32x32x16_bf16(qx, __builtin_bit_cast(bf16x8, sw), o[eh], 0, 0, 0); } }
        }
        const LAS char* Kb = sm + RT_K + hh * 16384 + hi * 1024 + r32 * 16;
        const LAS char* Vb = sm + RT_V + hh * 16384 + ((lane >> 4) & 1) * 32 + (lane & 3) * 8 + (4 * hi + ((lane & 15) >> 2)) * 64;
        u32x4 pw[8];
#pragma unroll
        for (int kb = 0; kb < 4; ++kb) { const int tt = kb >> 1, kbl = kb & 1;
            f32x16 c;
#pragma unroll
            for (int r = 0; r < 16; ++r) c[r] = 0.f;
#pragma unroll
            for (int ks = 0; ks < 4; ++ks) c = __builtin_amdgcn_mfma_f32_32x32x16_bf16(*(const LAS bf16x8*)(Kb + tt * 8192 + ks * 2048 + kbl * 512), qr[ks], c, 0, 0, 0);
#pragma unroll
            for (int r = 0; r < 16; ++r) { const int dlt = n - (kb * 32 + crow(r, hi)); const float fd = (float)dlt;
                const float w = __builtin_amdgcn_exp2f(fd * (dlt > 0 ? lg2f : -lg2b));
                c[r] *= dlt == 0 ? 2.0f : w; }
            pw[2 * kb] = (u32x4){cvtpk_s(c[0], c[1]), cvtpk_s(c[2], c[3]), cvtpk_s(c[4], c[5]), cvtpk_s(c[6], c[7])};
            pw[2 * kb + 1] = (u32x4){cvtpk_s(c[8], c[9]), cvtpk_s(c[10], c[11]), cvtpk_s(c[12], c[13]), cvtpk_s(c[14], c[15])}; }
#pragma unroll
        for (int k8 = 0; k8 < 8; ++k8) { const int tt = k8 >> 2, sl = k8 & 3;
#pragma unroll
            for (int eh = 0; eh < 2; ++eh) { const s16x4 vlo = vtr(Vb + tt * 8192 + eh * 4096 + sl * 1024), vhi = vtr(Vb + tt * 8192 + eh * 4096 + sl * 1024 + 512);
                o[eh] = __builtin_amdgcn_mfma_f32_32x32x16_bf16(__builtin_bit_cast(bf16x8, pw[k8]), (bf16x8){vlo[0], vlo[1], vlo[2], vlo[3], vhi[0], vhi[1], vhi[2], vhi[3]}, o[eh], 0, 0, 0); } }
        LAS float* stg = (LAS float*)(sm + RT_ST) + wid * 2048;
#pragma unroll
        for (int r = 0; r < 16; ++r) { const int q = crow(r, hi); stg[q * 64 + r32] = o[0][r]; stg[q * 64 + 32 + r32] = o[1][r]; }
        const float* gn = p.ret_gn + l * 256 + h * 64 + (lane & 7) * 8;
        const f32x4 g0 = *(const f32x4*)gn, g1 = *(const f32x4*)(gn + 4);
#pragma unroll
        for (int i = 0; i < 4; ++i) { const int row = i * 8 + (lane >> 3), ch = lane & 7;
            const f32x4 v0 = *(const LAS f32x4*)(stg + row * 64 + ch * 8), v1 = *(const LAS f32x4*)(stg + row * 64 + ch * 8 + 4);
            float ss = v0[0] * v0[0] + v0[1] * v0[1] + v0[2] * v0[2] + v0[3] * v0[3] + v1[0] * v1[0] + v1[1] * v1[1] + v1[2] * v1[2] + v1[3] * v1[3];
            ss += __shfl_xor(ss, 1); ss += __shfl_xor(ss, 2); ss += __shfl_xor(ss, 4);
            const float rn = rsqrtf(ss * (1.0f / 64.0f) + 1e-6f);
            const size_t grow = (size_t)(rb + qt * 32 + row);
            const bf16x8 gg = *(const bf16x8*)(P + grow * DIN + C_RG + h * 64 + ch * 8);
            u32x4 w; w.x = cvtpk_s(v0[0] * rn * g0[0] * fast_silu(bfs(gg[0])), v0[1] * rn * g0[1] * fast_silu(bfs(gg[1]))); w.y = cvtpk_s(v0[2] * rn * g0[2] * fast_silu(bfs(gg[2])), v0[3] * rn * g0[3] * fast_silu(bfs(gg[3])));
            w.z = cvtpk_s(v1[0] * rn * g1[0] * fast_silu(bfs(gg[4])), v1[1] * rn * g1[1] * fast_silu(bfs(gg[5]))); w.w = cvtpk_s(v1[2] * rn * g1[2] * fast_silu(bfs(gg[6])), v1[3] * rn * g1[3] * fast_silu(bfs(gg[7])));
            *(u32x4*)(O + grow * DM + 256 + h * 64 + ch * 8) = w; }
    }
}

__device__ __forceinline__ float diff_lambda_val(const Params& p, int l, float lam_init) {
    const float* lv = p.diff_lam + l * 128; float s1 = 0.f, s2 = 0.f;
    for (int i = 0; i < 32; ++i) { s1 += lv[i] * lv[32 + i]; s2 += lv[64 + i] * lv[96 + i]; }
    return expf(s1) - expf(s2) + lam_init;
}
__device__ __forceinline__ float max3f(float a, float b, float c) { return __builtin_fmaxf(__builtin_fmaxf(a, b), c); }
__device__ __forceinline__ float xhalf_max(float m) { auto rr = __builtin_amdgcn_permlane32_swap(__float_as_uint(m), __float_as_uint(m), false, false); return fmaxf(__uint_as_float(rr[0]), __uint_as_float(rr[1])); }
__device__ __forceinline__ float xhalf_sum(float m) { auto rr = __builtin_amdgcn_permlane32_swap(__float_as_uint(m), __float_as_uint(m), false, false); return __uint_as_float(rr[0]) + __uint_as_float(rr[1]); }

constexpr int DF_K = 0, DF_V = 16384, DF_WS = 32768, DF_ST = 34816;
constexpr int DD_K = 0, DD_V = 32768, DD_WS = 65536, DD_ST = 67584;
__device__ __forceinline__ void glds16(const void* gsrc, unsigned lds_dst) { unsigned keep;
    asm volatile("s_mov_b32 %0, m0\n\ts_mov_b32 m0, %2\n\ts_nop 0\n\tglobal_load_lds_dwordx4 %1, off\n\ts_mov_b32 m0, %0" : "=&s"(keep) : "v"(gsrc), "s"(lds_dst) : "memory"); }
__device__ __forceinline__ void ph_diff(const Params& p, int l, bool need_ctx, float lam_init, int bid, int nb, float* lds) {
    char* ws = p.ws; const int tid = TIDX, lane = tid & 63, r32 = lane & 31, hi = lane >> 5, wid = __builtin_amdgcn_readfirstlane(tid >> 6);
    const bf16_t* P = (const bf16_t*)(ws + OFF_P); bf16_t* O = (bf16_t*)(ws + OFF_ACT);
    LAS char* sm = (LAS char*)lds;
    LAS float* wsf = (LAS float*)(sm + DD_WS) + wid * 64;
    const float lam = diff_lambda_val(p, l, lam_init);
    const int nun = 512 + (need_ctx ? 8 : 0);
    for (int u = bid; u < nun; u += nb) {
        int b, h, qrow0, t_lo;
        if (u < 512) { b = u >> 8; h = (u >> 6) & 3; qrow0 = b * NSEQ + (u & 63) * 256; t_lo = 0; }
        else { const int v = u - 512; b = v >> 2; h = v & 3; qrow0 = NLAT + b * NCTX; t_lo = 256; }
        const int t_hi = 260;
        const bf16_t* kcol = P + C_DK + h * 64 + wid * 8;
        const bf16_t* vcol = P + C_DV + h * 64 + (wid >> 2) * 32 + (lane & 3) * 8;
        const int krow_in = lane, vrow_in = 16 * (wid & 3) + (lane >> 2);
#define TILE_ROW0(t) ((t) < 256 ? b * NSEQ + (t) * 64 : NLAT + b * NCTX + ((t) - 256) * 64)
        bf16x8 qr[4];
        { const bf16_t* qp = P + (size_t)(qrow0 + wid * 32 + r32) * DIN + C_DQ + h * 64 + hi * 8;
#pragma unroll
          for (int d0 = 0; d0 < 4; ++d0) qr[d0] = *(const bf16x8*)(qp + d0 * 16); }
        f32x16 o[2][2]; float mhat[2], lsum[2];
#pragma unroll
        for (int m = 0; m < 2; ++m) { mhat[m] = 0.f; lsum[m] = 0.f;
#pragma unroll
            for (int r = 0; r < 16; ++r) { o[m][0][r] = 0.f; o[m][1][r] = 0.f; } }
        const unsigned lds0 = (unsigned)(size_t)sm + (unsigned)wid * 1024u;
#define DMA_TILE(t) do { const int r0_ = TILE_ROW0(t); const unsigned sl_ = (unsigned)(((t) - t_lo) & 3) * 8192u; \
        glds16(kcol + (size_t)(r0_ + krow_in) * DIN, (unsigned)__builtin_amdgcn_readfirstlane(lds0 + DD_K + sl_)); glds16(vcol + (size_t)(r0_ + vrow_in) * DIN, (unsigned)__builtin_amdgcn_readfirstlane(lds0 + DD_V + sl_)); } while (0)
        asm volatile("s_waitcnt lgkmcnt(0)\n\ts_barrier" ::: "memory");
        DMA_TILE(t_lo); DMA_TILE(t_lo + 1); DMA_TILE(t_lo + 2);
        bool first = true;
        for (int t = t_lo; t < t_hi; ++t) {
            const int cur = (t - t_lo) & 3;
            if (t + 2 < t_hi) asm volatile("s_waitcnt vmcnt(4)\n\ts_barrier" ::: "memory");
            else if (t + 1 < t_hi) asm volatile("s_waitcnt vmcnt(2)\n\ts_barrier" ::: "memory");
            else asm volatile("s_waitcnt vmcnt(0)\n\ts_barrier" ::: "memory");
            if (t + 3 < t_hi) DMA_TILE(t + 3);
            const LAS char* kb = sm + DD_K + cur * 8192 + hi * 1024 + r32 * 16;
            const LAS char* vb = sm + DD_V + cur * 8192 + ((lane >> 4) & 1) * 32 + (lane & 3) * 8 + (4 * hi + ((lane & 15) >> 2)) * 64;
            bf16x8 kf[8];
#pragma unroll
            for (int j = 0; j < 4; ++j) { kf[2 * j] = *(const LAS bf16x8*)(kb + j * 2048); kf[2 * j + 1] = *(const LAS bf16x8*)(kb + j * 2048 + 512); }
            bf16x8 vf[8];
#pragma unroll
            for (int i = 0; i < 8; ++i) { const s16x4 lo = vtr(vb + (i >> 2) * 4096 + (i & 3) * 1024), hh = vtr(vb + (i >> 2) * 4096 + (i & 3) * 1024 + 512);
                vf[i] = (bf16x8){lo[0], lo[1], lo[2], lo[3], hh[0], hh[1], hh[2], hh[3]}; }
#pragma unroll
            for (int m = 0; m < 2; ++m) {
                float nm = -mhat[m]; asm volatile("" : "+v"(nm));
                f32x16 negm;
#pragma unroll
                for (int r = 0; r < 16; ++r) negm[r] = nm;
                f32x16 c0 = __builtin_amdgcn_mfma_f32_32x32x16_bf16(kf[4 * m + 0], qr[2 * m], negm, 0, 0, 0);
                f32x16 c1 = __builtin_amdgcn_mfma_f32_32x32x16_bf16(kf[4 * m + 1], qr[2 * m], negm, 0, 0, 0);
                c0 = __builtin_amdgcn_mfma_f32_32x32x16_bf16(kf[4 * m + 2], qr[2 * m + 1], c0, 0, 0, 0);
                c1 = __builtin_amdgcn_mfma_f32_32x32x16_bf16(kf[4 * m + 3], qr[2 * m + 1], c1, 0, 0, 0);
                float ra = max3f(c0[0], c0[1], c1[0]), rb = max3f(c0[2], c0[3], c1[1]); ra = max3f(ra, c1[2], c1[3]);
#pragma unroll
                for (int r = 4; r < 16; r += 4) { ra = max3f(ra, c0[r], c0[r + 1]); rb = max3f(rb, c0[r + 2], c0[r + 3]); ra = max3f(ra, c1[r], c1[r + 1]); rb = max3f(rb, c1[r + 2], c1[r + 3]); }
                const float rm = xhalf_max(max3f(ra, rb, rb));
                if (__builtin_expect(first || __any(rm > 8.0f), 0)) {
                    float dl = first ? rm : fmaxf(rm, 0.f); asm volatile("; rebase" : "+v"(dl));
                    mhat[m] += dl;
#pragma unroll
                    for (int r = 0; r < 16; ++r) { c0[r] -= dl; c1[r] -= dl; }
                    asm volatile("" : "+v"(c0), "+v"(c1));
                    if (!first) {
                        const float f = __builtin_amdgcn_exp2f(-dl); lsum[m] *= f;
                        if (hi == 0) wsf[r32] = f;
#pragma unroll
                        for (int r = 0; r < 16; ++r) { const float fr_ = wsf[crow(r, hi)]; o[m][0][r] *= fr_; o[m][1][r] *= fr_; }
                    }
                }
                float sacc = 0.f;
#pragma unroll
                for (int r = 0; r < 16; ++r) { c0[r] = __builtin_amdgcn_exp2f(c0[r]); c1[r] = __builtin_amdgcn_exp2f(c1[r]); sacc += c0[r] + c1[r]; }
                lsum[m] += sacc;
                u32x4 pw[4];
#pragma unroll
                for (int k = 0; k < 2; ++k) {
                    pw[k] = (u32x4){cvtpk_s(c0[8 * k + 0], c0[8 * k + 1]), cvtpk_s(c0[8 * k + 2], c0[8 * k + 3]), cvtpk_s(c0[8 * k + 4], c0[8 * k + 5]), cvtpk_s(c0[8 * k + 6], c0[8 * k + 7])};
                    pw[2 + k] = (u32x4){cvtpk_s(c1[8 * k + 0], c1[8 * k + 1]), cvtpk_s(c1[8 * k + 2], c1[8 * k + 3]), cvtpk_s(c1[8 * k + 4], c1[8 * k + 5]), cvtpk_s(c1[8 * k + 6], c1[8 * k + 7])}; }
#pragma unroll
                for (int k = 0; k < 4; ++k) {
                    o[m][0] = __builtin_amdgcn_mfma_f32_32x32x16_bf16(__builtin_bit_cast(bf16x8, pw[k]), vf[k], o[m][0], 0, 0, 0);
                    o[m][1] = __builtin_amdgcn_mfma_f32_32x32x16_bf16(__builtin_bit_cast(bf16x8, pw[k]), vf[4 + k], o[m][1], 0, 0, 0); }
            }
            first = false;
            asm volatile("s_waitcnt lgkmcnt(0)" ::: "memory");
        }
#undef TILE_ROW0
#undef DMA_TILE
        const float inv0 = 1.0f / xhalf_sum(lsum[0]), inv1 = lam / xhalf_sum(lsum[1]);
        int lane_e = TIDX & 63; asm volatile("" : "+v"(lane_e));
        { const int r32e = lane_e & 31, hie = lane_e >> 5;
        LAS float* wse = (LAS float*)(sm + DD_WS) + wid * 64; LAS float* stge = (LAS float*)(sm + DD_ST) + wid * 2048;
        if (hie == 0) { wse[r32e] = inv0; wse[32 + r32e] = inv1; }
#pragma unroll
        for (int r = 0; r < 16; ++r) { const int q = crow(r, hie); const float i0 = wse[q], i1 = wse[32 + q];
            stge[q * 64 + r32e] = o[0][0][r] * i0 - o[1][0][r] * i1; stge[q * 64 + 32 + r32e] = o[0][1][r] * i0 - o[1][1][r] * i1; } }
        const int lane = lane_e; LAS float* stg = (LAS float*)(sm + DD_ST) + wid * 2048;
        const float* gn = p.diff_gn + l * 256 + h * 64 + (lane & 7) * 8;
        const f32x4 g0 = *(const f32x4*)gn, g1 = *(const f32x4*)(gn + 4);
#pragma unroll
        for (int i = 0; i < 4; ++i) { const int row = i * 8 + (lane >> 3), ch = lane & 7;
            const f32x4 v0 = *(const LAS f32x4*)(stg + row * 64 + ch * 8), v1 = *(const LAS f32x4*)(stg + row * 64 + ch * 8 + 4);
            float ss = v0[0] * v0[0] + v0[1] * v0[1] + v0[2] * v0[2] + v0[3] * v0[3] + v1[0] * v1[0] + v1[1] * v1[1] + v1[2] * v1[2] + v1[3] * v1[3];
            ss += __shfl_xor(ss, 1); ss += __shfl_xor(ss, 2); ss += __shfl_xor(ss, 4);
            const float rn = rsqrtf(ss * (1.0f / 64.0f) + 1e-6f) * (1.0f - lam_init);
            u32x4 w; w.x = cvtpk_s(v0[0] * rn * g0[0], v0[1] * rn * g0[1]); w.y = cvtpk_s(v0[2] * rn * g0[2], v0[3] * rn * g0[3]);
            w.z = cvtpk_s(v1[0] * rn * g1[0], v1[1] * rn * g1[1]); w.w = cvtpk_s(v1[2] * rn * g1[2], v1[3] * rn * g1[3]);
            *(u32x4*)(O + (size_t)(qrow0 + wid * 32 + row) * DM + 512 + h * 64 + ch * 8) = w; }
    }
}

__device__ __forceinline__ void ph_swa(const Params& p, int l, bool need_ctx, int bid, int nb, float* lds) {
    char* ws = p.ws; const int tid = TIDX, lane = tid & 63, r32 = lane & 31, hi = lane >> 5, wid = __builtin_amdgcn_readfirstlane(tid >> 6);
    const bf16_t* P = (const bf16_t*)(ws + OFF_P); bf16_t* O = (bf16_t*)(ws + OFF_ACT);
    LAS char* sm = (LAS char*)lds;
    LAS float* wsf = (LAS float*)(sm + DD_WS) + wid * 64;
    const int nun = 512 + (need_ctx ? 8 : 0);
    for (int u = bid; u < nun; u += nb) {
        int b, h, qrow0, q0, tw_lo, nwin;
        if (u < 512) { b = u >> 8; h = (u >> 6) & 3; q0 = (u & 63) * 256; qrow0 = b * NSEQ + q0; const int lo = q0 - 128 < 0 ? 0 : q0 - 128, hi_ = q0 + 384 > NSEQ ? NSEQ : q0 + 384; tw_lo = lo >> 6; nwin = (hi_ - lo) >> 6; }
        else { const int v = u - 512; b = v >> 2; h = v & 3; q0 = 0; qrow0 = NLAT + b * NCTX; tw_lo = 0; nwin = 0; }
        const int g = h >> 1, nt = nwin + 4;
        const bf16_t* kcol = P + C_AK + g * 64 + wid * 8;
        const bf16_t* vcol = P + C_AV + g * 64 + (wid >> 2) * 32 + (lane & 3) * 8;
        const int krow_in = lane, vrow_in = 16 * (wid & 3) + (lane >> 2);
#define SWA_ROW0(i) ((i) < nwin ? b * NSEQ + (tw_lo + (i)) * 64 : NLAT + b * NCTX + ((i) - nwin) * 64)
        bf16x8 qr[4];
        { const bf16_t* qp = P + (size_t)(qrow0 + wid * 32 + r32) * DIN + C_AQ + h * 64 + hi * 8;
#pragma unroll
          for (int d0 = 0; d0 < 4; ++d0) qr[d0] = *(const bf16x8*)(qp + d0 * 16); }
        f32x16 o[2]; float mhat = p.sink[l * 4 + h] * 1.4426950408889634f, lsum = hi == 0 ? 1.0f : 0.0f;
#pragma unroll
        for (int r = 0; r < 16; ++r) { o[0][r] = 0.f; o[1][r] = 0.f; }
        const int qw = q0 + wid * 32, qpos = qw + r32;
        const unsigned lds0 = (unsigned)(size_t)sm + (unsigned)wid * 1024u;
#define DMA_TILE(i) do { const int r0_ = SWA_ROW0(i); const unsigned sl_ = (unsigned)((i) & 3) * 8192u; \
        glds16(kcol + (size_t)(r0_ + krow_in) * DIN, (unsigned)__builtin_amdgcn_readfirstlane(lds0 + DD_K + sl_)); glds16(vcol + (size_t)(r0_ + vrow_in) * DIN, (unsigned)__builtin_amdgcn_readfirstlane(lds0 + DD_V + sl_)); } while (0)
        asm volatile("s_waitcnt lgkmcnt(0)\n\ts_barrier" ::: "memory");
        DMA_TILE(0); DMA_TILE(1); DMA_TILE(2);
        for (int i = 0; i < nt; ++i) {
            const int cur = i & 3;
            if (i + 2 < nt) asm volatile("s_waitcnt vmcnt(4)\n\ts_barrier" ::: "memory");
            else if (i + 1 < nt) asm volatile("s_waitcnt vmcnt(2)\n\ts_barrier" ::: "memory");
            else asm volatile("s_waitcnt vmcnt(0)\n\ts_barrier" ::: "memory");
            if (i + 3 < nt) DMA_TILE(i + 3);
            const bool win = i < nwin; const int T = (tw_lo + i) * 64;
            const bool skip = win && (T > qw + 31 + 128 || T + 63 < qw - 128);
            if (!skip) {
                const LAS char* kb = sm + DD_K + cur * 8192 + hi * 1024 + r32 * 16;
                const LAS char* vb = sm + DD_V + cur * 8192 + ((lane >> 4) & 1) * 32 + (lane & 3) * 8 + (4 * hi + ((lane & 15) >> 2)) * 64;
                float nm = -mhat; asm volatile("" : "+v"(nm));
                f32x16 c0, c1;
#pragma unroll
                for (int r = 0; r < 16; ++r) { c0[r] = nm; c1[r] = nm; }
#pragma unroll
                for (int j = 0; j < 4; ++j) {
                    c0 = __builtin_amdgcn_mfma_f32_32x32x16_bf16(*(const LAS bf16x8*)(kb + j * 2048), qr[j], c0, 0, 0, 0);
                    c1 = __builtin_amdgcn_mfma_f32_32x32x16_bf16(*(const LAS bf16x8*)(kb + j * 2048 + 512), qr[j], c1, 0, 0, 0); }
                if (win && (T < qw + 31 - 128 || T + 63 > qw + 128)) {
#pragma unroll
                    for (int r = 0; r < 16; ++r) { const int kp = T + crow(r, hi); const int d0_ = qpos - kp, d1_ = d0_ - 32;
                        if (d0_ > 128 || d0_ < -128) c0[r] = -1.0e30f;
                        if (d1_ > 128 || d1_ < -128) c1[r] = -1.0e30f; }
                }
                float rm = fmaxf(c0[0], c1[0]);
#pragma unroll
                for (int r = 1; r < 16; ++r) rm = fmaxf(rm, fmaxf(c0[r], c1[r]));
                rm = xhalf_max(rm);
                if (__any(rm > 8.0f)) {
                    const float dl = fmaxf(rm, 0.f); mhat += dl;
#pragma unroll
                    for (int r = 0; r < 16; ++r) { c0[r] -= dl; c1[r] -= dl; }
                    const float f = __builtin_amdgcn_exp2f(-dl); lsum *= f;
                    if (hi == 0) wsf[r32] = f;
#pragma unroll
                    for (int r = 0; r < 16; ++r) { const float fr_ = wsf[crow(r, hi)]; o[0][r] *= fr_; o[1][r] *= fr_; }
                }
                float sacc = 0.f;
#pragma unroll
                for (int r = 0; r < 16; ++r) { c0[r] = __builtin_amdgcn_exp2f(c0[r]); c1[r] = __builtin_amdgcn_exp2f(c1[r]); sacc += c0[r] + c1[r]; }
                lsum += sacc;
                u32x4 pw[4];
#pragma unroll
                for (int k = 0; k < 2; ++k) {
                    pw[k] = (u32x4){cvtpk_s(c0[8 * k + 0], c0[8 * k + 1]), cvtpk_s(c0[8 * k + 2], c0[8 * k + 3]), cvtpk_s(c0[8 * k + 4], c0[8 * k + 5]), cvtpk_s(c0[8 * k + 6], c0[8 * k + 7])};
                    pw[2 + k] = (u32x4){cvtpk_s(c1[8 * k + 0], c1[8 * k + 1]), cvtpk_s(c1[8 * k + 2], c1[8 * k + 3]), cvtpk_s(c1[8 * k + 4], c1[8 * k + 5]), cvtpk_s(c1[8 * k + 6], c1[8 * k + 7])}; }
#pragma unroll
                for (int k = 0; k < 4; ++k) {
                    const s16x4 lo0 = vtr(vb + k * 1024), hi0 = vtr(vb + k * 1024 + 512), lo1 = vtr(vb + 4096 + k * 1024), hi1 = vtr(vb + 4096 + k * 1024 + 512);
                    o[0] = __builtin_amdgcn_mfma_f32_32x32x16_bf16(__builtin_bit_cast(bf16x8, pw[k]), (bf16x8){lo0[0], lo0[1], lo0[2], lo0[3], hi0[0], hi0[1], hi0[2], hi0[3]}, o[0], 0, 0, 0);
                    o[1] = __builtin_amdgcn_mfma_f32_32x32x16_bf16(__builtin_bit_cast(bf16x8, pw[k]), (bf16x8){lo1[0], lo1[1], lo1[2], lo1[3], hi1[0], hi1[1], hi1[2], hi1[3]}, o[1], 0, 0, 0); }
            }
            asm volatile("s_waitcnt lgkmcnt(0)" ::: "memory");
        }
#undef SWA_ROW0
#undef DMA_TILE
        const float inv = 1.0f / xhalf_sum(lsum);
        int lane_e = TIDX & 63;
        { const int r32e = lane_e & 31, hie = lane_e >> 5;
        LAS float* wse = (LAS float*)(sm + DD_WS) + wid * 64; LAS float* stge = (LAS float*)(sm + DD_ST) + wid * 2048;
        if (hie == 0) wse[r32e] = inv;
#pragma unroll
        for (int r = 0; r < 16; ++r) { const int q = crow(r, hie); const float i0 = wse[q]; stge[q * 64 + r32e] = o[0][r] * i0; stge[q * 64 + 32 + r32e] = o[1][r] * i0; } }
        LAS float* stg = (LAS float*)(sm + DD_ST) + wid * 2048;
#pragma unroll
        for (int i = 0; i < 4; ++i) { const int row = i * 8 + (lane_e >> 3), ch = lane_e & 7;
            const f32x4 v0 = *(const LAS f32x4*)(stg + row * 64 + ch * 8), v1 = *(const LAS f32x4*)(stg + row * 64 + ch * 8 + 4);
            u32x4 w; w.x = cvtpk_s(v0[0], v0[1]); w.y = cvtpk_s(v0[2], v0[3]); w.z = cvtpk_s(v1[0], v1[1]); w.w = cvtpk_s(v1[2], v1[3]);
            *(u32x4*)(O + (size_t)(qrow0 + wid * 32 + row) * DM + h * 64 + ch * 8) = w; }
    }
}

__device__ __forceinline__ void moe_offsets(const Params& p, int* offs  ) {
    if (TIDX < 2) { const unsigned* cw = (const unsigned*)p.ws + CW_CNT + TIDX * 8; int o = 0;
        for (int e = 0; e < 8; ++e) { offs[TIDX * 9 + e] = o; o += ((int)__hip_atomic_load(cw + e, __ATOMIC_RELAXED, __HIP_MEMORY_SCOPE_AGENT) + 255) & ~255; }
        offs[TIDX * 9 + 8] = o; }
    __syncthreads();
}
__device__ __forceinline__ void ph_moe_scatter(const Params& p, int bid, int nb, float* lds) {
    char* ws = p.ws; int* offs = (int*)lds; moe_offsets(p, offs);
    const int lane = TIDX & 63, wv = TIDX >> 6;
    const bf16_t* H = (const bf16_t*)(ws + OFF_ACT); bf16_t* AS = (bf16_t*)(ws + OFF_ASORT);
    int* tok = (int*)(ws + OFF_TOK); float* wgt = (float*)(ws + OFF_WGT); const unsigned* cw = (const unsigned*)ws;
    for (int r0 = (bid * 8 + wv) * 4; r0 < NLAT; r0 += nb * 8 * 4) {
        int4 rec[4]; u32x4 d0[4], d1[4]; int pos[4][2];
#pragma unroll
        for (int k = 0; k < 4; ++k) { rec[k] = *(const int4*)(ws + OFF_ROUTE + (size_t)(r0 + k) * 16); const u32x4* src = (const u32x4*)(H + (size_t)(r0 + k) * DM); d0[k] = src[lane]; d1[k] = src[64 + lane]; }
#pragma unroll
        for (int k = 0; k < 4; ++k) { const int blk = ((r0 + k) >> 3) % nb;
#pragma unroll
            for (int g = 0; g < 2; ++g) { const int e = (g == 0 ? rec[k].x : rec[k].y) & 15, li = (g == 0 ? rec[k].x : rec[k].y) >> 4;
                pos[k][g] = offs[g * 9 + e] + (int)cw[CW_BLK + blk * 16 + g * 8 + e] + li; } }
#pragma unroll
        for (int k = 0; k < 4; ++k)
#pragma unroll
            for (int g = 0; g < 2; ++g) { const int ps = pos[k][g];
                if (lane == 0) { tok[g * GRP_ROWS + ps] = r0 + k; wgt[g * GRP_ROWS + ps] = __int_as_float(g == 0 ? rec[k].z : rec[k].w); }
                u32x4* dst = (u32x4*)(AS + ((size_t)g * GRP_ROWS + ps) * DM); dst[lane] = d0[k]; dst[64 + lane] = d1[k]; }
    }
}

__device__ __forceinline__ void ph_final(const Params& p, int bid, int nb) {
    const int lane = TIDX & 63, wv = TIDX >> 6;
    for (int r = bid * 8 + wv; r < NLAT; r += nb * 8) {
        float* xr = p.out + (size_t)r * DM; float4 v[4]; float ss = 0.f;
#pragma unroll
        for (int i = 0; i < 4; ++i) { v[i] = *(const float4*)(xr + i * 256 + lane * 4); ss += v[i].x * v[i].x + v[i].y * v[i].y + v[i].z * v[i].z + v[i].w * v[i].w; }
        ss = wave_sum(ss); const float rn = rsqrtf(ss * (1.0f / 1024.0f) + 1e-6f);
#pragma unroll
        for (int i = 0; i < 4; ++i) { const float4 g = *(const float4*)(p.final_norm + i * 256 + lane * 4);
            float4 o; o.x = v[i].x * rn * g.x; o.y = v[i].y * rn * g.y; o.z = v[i].z * rn * g.z; o.w = v[i].w * rn * g.w; *(float4*)(xr + i * 256 + lane * 4) = o; }
    }
}

struct EpiStoreBf16 {
    static constexpr bool PERM = true, AFTER_DRAIN = false; bf16_t* O; int ldc;
    __device__ __forceinline__ void operator()(const f32x4 (&acc)[2][2][4][2], const pg8::Unit& u, int wr, int wc, int fr, int fq) const {
        bf16_t* base = O + (size_t)(u.pm * 256 + wr * 64 + fr) * ldc + u.pn * 256 + wc * 32 + 8 * fq;
#pragma unroll
        for (int ai = 0; ai < 2; ++ai)
#pragma unroll
            for (int m = 0; m < 4; ++m) { bf16_t* rowp = base + (size_t)(ai * 128 + m * 16) * ldc;
#pragma unroll
                for (int bj = 0; bj < 2; ++bj) { const f32x4 v0 = acc[ai][bj][m][0], v1 = acc[ai][bj][m][1]; u32x4 w;
                    w.x = pg8::cvt_pk_bf16(v0[0], v0[1]); w.y = pg8::cvt_pk_bf16(v0[2], v0[3]); w.z = pg8::cvt_pk_bf16(v1[0], v1[1]); w.w = pg8::cvt_pk_bf16(v1[2], v1[3]);
                    *(u32x4*)(rowp + bj * 128) = w; } }
    }
};
struct EpiSwiglu {
    static constexpr bool PERM = true, AFTER_DRAIN = false; bf16_t* U; int ldu, npe;
    __device__ __forceinline__ void operator()(const f32x4 (&acc)[2][2][4][2], const pg8::Unit& u, int wr, int wc, int fr, int fq) const {
        bf16_t* base = U + (size_t)(u.pm * 256 + wr * 64 + fr) * ldu + (u.pn % npe) * 128 + wc * 32 + 8 * fq;
#pragma unroll
        for (int ai = 0; ai < 2; ++ai)
#pragma unroll
            for (int m = 0; m < 4; ++m) { float o[8];
#pragma unroll
                for (int n = 0; n < 2; ++n)
#pragma unroll
                    for (int i = 0; i < 4; ++i) o[n * 4 + i] = fast_silu(acc[ai][0][m][n][i]) * acc[ai][1][m][n][i];
                u32x4 w; w.x = pg8::cvt_pk_bf16(o[0], o[1]); w.y = pg8::cvt_pk_bf16(o[2], o[3]); w.z = pg8::cvt_pk_bf16(o[4], o[5]); w.w = pg8::cvt_pk_bf16(o[6], o[7]);
                *(u32x4*)(base + (size_t)(ai * 128 + m * 16) * ldu) = w; }
    }
};
struct EpiResidual {
    static constexpr bool PERM = false, AFTER_DRAIN = false; const float* xin; float* xout; float* xc; const float* gate;
    __device__ __forceinline__ void operator()(const f32x4 (&acc)[2][2][4][2], const pg8::Unit& u, int wr, int wc, int fr, int fq) const {
        const int cls = u.pm < 64 ? 0 : (u.pm < 128 ? 1 : 2), col0 = u.pn * 256 + wc * 32 + 4 * fq;
        const float* gv = gate + (size_t)cls * 6144 + col0;
        const float* bi = u.pm < 128 ? xin + (size_t)u.pm * 256 * DM : xc + (size_t)(u.pm - 128) * 256 * DM;
        float* bo = u.pm < 128 ? xout + (size_t)u.pm * 256 * DM : xc + (size_t)(u.pm - 128) * 256 * DM;
        f32x4 g4[2][2];
#pragma unroll
        for (int bj = 0; bj < 2; ++bj)
#pragma unroll
            for (int n = 0; n < 2; ++n) g4[bj][n] = *(const f32x4*)(gv + bj * 128 + n * 16);
#pragma unroll
        for (int ai = 0; ai < 2; ++ai)
#pragma unroll
            for (int m = 0; m < 4; ++m) { const size_t off = (size_t)(ai * 128 + wr * 64 + m * 16 + fr) * DM + col0;
#pragma unroll
                for (int bj = 0; bj < 2; ++bj)
#pragma unroll
                    for (int n = 0; n < 2; ++n) { const f32x4 xi = *(const f32x4*)(bi + off + bj * 128 + n * 16); *(f32x4*)(bo + off + bj * 128 + n * 16) = xi + g4[bj][n] * acc[ai][bj][m][n]; } }
    }
};
struct EpiMoeScatter {
    static constexpr bool PERM = false, AFTER_DRAIN = false; float* x; const float* gate; const int* tok; const float* wgt; int npe;
    __device__ __forceinline__ void operator()(const f32x4 (&acc)[2][2][4][2], const pg8::Unit& u, int wr, int wc, int fr, int fq) const {
        const int col0 = (u.pn % npe) * 256 + wc * 32 + 4 * fq;
#pragma unroll
        for (int ai = 0; ai < 2; ++ai)
#pragma unroll
            for (int m = 0; m < 4; ++m) { const int r = u.pm * 256 + ai * 128 + wr * 64 + m * 16 + fr; const int tk = tok[r];
                if (tk >= 0) { const float wv = wgt[r]; const float* gv = gate + (size_t)mod_class(tk) * 6144 + col0; float* xr = x + (size_t)tk * DM + col0;
#pragma unroll
                    for (int bj = 0; bj < 2; ++bj)
#pragma unroll
                        for (int n = 0; n < 2; ++n) { const f32x4 g4 = *(const f32x4*)(gv + bj * 128 + n * 16); f32x4* q = (f32x4*)(xr + bj * 128 + n * 16); *q = *q + g4 * wv * acc[ai][bj][m][n]; } } }
    }
};
struct MoeOrder : pg8::StaticOrder {
    int o1, o2, o3, o4, o5, o6, o7, npe;
    __device__ __forceinline__ bool next(int i, pg8::Unit& u) const {
        if (!pg8::StaticOrder::next(i, u)) return false;
        const int r = u.pm * 256; const int e = (r >= o1) + (r >= o2) + (r >= o3) + (r >= o4) + (r >= o5) + (r >= o6) + (r >= o7);
        u.pn += e * npe; return true;
    }
};
#define GEMM_LDS ((PG8_LAS unsigned char*)lds)
struct EpiInProj {
    static constexpr bool PERM = true, AFTER_DRAIN = false; bf16_t* O; const char* tab;
    __device__ __forceinline__ void operator()(const f32x4 (&acc)[2][2][4][2], const pg8::Unit& u, int wr, int wc, int fr, int fq) const {
        const int row0 = u.pm * 256 + wr * 64 + fr; const bool lat = u.pm < 128;
#pragma unroll
        for (int bj = 0; bj < 2; ++bj) {
            const int s = u.pn * 2 + bj;
            int mode = 0; float scale = 1.0f;
            if (s <= 1) { mode = 1; scale = 0.125f * 1.4426950408889634f; } else if (s == 2) mode = 1;
            else if (s == 4 || s == 5) mode = 2; else if (s == 6 || s == 7) { mode = 2; scale = 0.125f; }
            else if (s == 12 || s == 13) { mode = 3; scale = 0.17677669529663687f * 1.4426950408889634f; } else if (s == 14 || s == 15) mode = 3;
            if (mode == 0) {
                bf16_t* base = O + (size_t)row0 * DIN + s * 128 + wc * 32 + 8 * fq;
#pragma unroll
                for (int ai = 0; ai < 2; ++ai)
#pragma unroll
                    for (int m = 0; m < 4; ++m) { const f32x4 v0 = acc[ai][bj][m][0], v1 = acc[ai][bj][m][1]; u32x4 w;
                        w.x = pg8::cvt_pk_bf16(v0[0], v0[1]); w.y = pg8::cvt_pk_bf16(v0[2], v0[3]); w.z = pg8::cvt_pk_bf16(v1[0], v1[1]); w.w = pg8::cvt_pk_bf16(v1[2], v1[3]);
                        *(u32x4*)(base + (size_t)(ai * 128 + m * 16) * DIN) = w; }
            } else {
                const bool wide = mode != 3; const int half = wide ? 32 : 16, g = wide ? 4 * (wc & 1) + fq : fq;
                const int cbase = s * 128 + (wide ? 64 * (wc >> 1) : 32 * wc) + 4 * g;
                const float* ct = (const float*)(tab + (mode == 1 ? TAB_ATTN : (mode == 2 ? TAB_RET : TAB_DIFF))) + 4 * g; const int tstride = half, tsin = 16384 * half;
#pragma unroll
                for (int ai = 0; ai < 2; ++ai)
#pragma unroll
                    for (int m = 0; m < 4; ++m) { const int row = row0 + ai * 128 + m * 16; const f32x4 v0 = acc[ai][bj][m][0], v1 = acc[ai][bj][m][1];
                        f32x4 cs = {1.f, 1.f, 1.f, 1.f}, sn = {0.f, 0.f, 0.f, 0.f};
                        if (lat) { const float* tp = ct + (size_t)(row & (NSEQ - 1)) * tstride; cs = *(const f32x4*)tp; sn = *(const f32x4*)(tp + tsin); }
                        const f32x4 o1 = (v0 * cs - v1 * sn) * scale, o2 = (v1 * cs + v0 * sn) * scale;
                        bf16_t* op = O + (size_t)row * DIN + cbase;
                        uint2 w1, w2; w1.x = pg8::cvt_pk_bf16(o1[0], o1[1]); w1.y = pg8::cvt_pk_bf16(o1[2], o1[3]); w2.x = pg8::cvt_pk_bf16(o2[0], o2[1]); w2.y = pg8::cvt_pk_bf16(o2[2], o2[3]);
                        *(uint2*)op = w1; *(uint2*)(op + half) = w2; }
            }
        }
    }
};
__device__ __forceinline__ void ph_gemm_in(const Params& p, int l, int bid, int nb, float* lds) {
    char* ws = p.ws; pg8::Gemm g{(const bf16_t*)(ws + OFF_ACT), (const bf16_t*)(ws + OFF_WIN) + (size_t)l * DIN * DM, NROW, DIN, DM};
    pg8::StaticOrder S; S.init(NROW, DIN, nb, bid);
    EpiInProj E{(bf16_t*)(ws + OFF_P), ws + OFF_TAB};
    pg8::gemm_phase<EpiInProj, pg8::StaticOrder, true, true>(GEMM_LDS, g, S, E);
}
__device__ __forceinline__ void ph_gemm_out(const Params& p, int l, bool need_ctx, int bid, int nb, float* lds) {
    char* ws = p.ws; const int M = need_ctx ? NROW : NLAT;
    pg8::Gemm g{(const bf16_t*)(ws + OFF_ACT), (const bf16_t*)(ws + OFF_WOUT) + (size_t)l * DM * DM, M, DM, DM};
    pg8::StaticOrder S; S.init(M, DM, nb, bid);
    EpiResidual E{l == 0 ? p.x : p.out, p.out, (float*)(ws + OFF_XC), (const float*)(ws + OFF_MOD) + (size_t)l * 3 * 6144 + 2048};
    pg8::gemm_phase<EpiResidual, pg8::StaticOrder, true, true>(GEMM_LDS, g, S, E);
}
__device__ __forceinline__ void ph_ffn1(const Params& p, bool need_ctx, int bid, int nb, float* lds) {
    char* ws = p.ws; const int M = need_ctx ? NROW : NLAT;
    pg8::Gemm g{(const bf16_t*)(ws + OFF_ACT), (const bf16_t*)(ws + OFF_WF13), M, 2 * DFF, DM};
    pg8::StaticOrder S; S.init(M, 2 * DFF, nb, bid);
    EpiSwiglu E{(bf16_t*)(ws + OFF_P), DFF, 2 * DFF / 256};
    pg8::gemm_phase<EpiSwiglu, pg8::StaticOrder, true, true>(GEMM_LDS, g, S, E);
}
__device__ __forceinline__ void ph_ffn2(const Params& p, int l, bool need_ctx, int bid, int nb, float* lds) {
    char* ws = p.ws; const int M = need_ctx ? NROW : NLAT;
    pg8::Gemm g{(const bf16_t*)(ws + OFF_P), (const bf16_t*)(ws + OFF_WF2), M, DM, DFF};
    pg8::StaticOrder S; S.init(M, DM, nb, bid);
    EpiResidual E{p.out, p.out, (float*)(ws + OFF_XC), (const float*)(ws + OFF_MOD) + (size_t)l * 3 * 6144 + 5120};
    pg8::gemm_phase<EpiResidual, pg8::StaticOrder, true, true>(GEMM_LDS, g, S, E);
}
__device__ __forceinline__ MoeOrder moe_order(const int* og, int npe, int nb, int bid) {
    MoeOrder S; S.init(og[8], npe * 256, nb, bid); S.o1 = og[1]; S.o2 = og[2]; S.o3 = og[3]; S.o4 = og[4]; S.o5 = og[5]; S.o6 = og[6]; S.o7 = og[7]; S.npe = npe; return S;
}
__device__ __forceinline__ void ph_moe1(const Params& p, int g, int bid, int nb, float* lds) {
    char* ws = p.ws; int* offs = (int*)(lds + 32768); __syncthreads(); moe_offsets(p, offs);
    const MoeOrder S = moe_order(offs + g * 9, 2 * DFE / 256, nb, bid);
    pg8::Gemm gm{(const bf16_t*)(ws + OFF_ASORT) + (size_t)g * GRP_ROWS * DM, (const bf16_t*)(ws + OFF_WM13), 0, 0, DM};
    EpiSwiglu E{(bf16_t*)(ws + OFF_UMOE), DFE, 2 * DFE / 256};
    pg8::gemm_phase<EpiSwiglu, MoeOrder, true, true>(GEMM_LDS, gm, S, E);
}
__device__ __forceinline__ void ph_moe2(const Params& p, int l, int g, int bid, int nb, float* lds) {
    char* ws = p.ws; int* offs = (int*)(lds + 32768); __syncthreads(); moe_offsets(p, offs);
    const MoeOrder S = moe_order(offs + g * 9, DM / 256, nb, bid);
    pg8::Gemm gm{(const bf16_t*)(ws + OFF_UMOE), (const bf16_t*)(ws + OFF_WM2), 0, 0, DFE};
    EpiMoeScatter E{p.out, (const float*)(ws + OFF_MOD) + (size_t)l * 3 * 6144 + 5120, (const int*)(ws + OFF_TOK) + g * GRP_ROWS, (const float*)(ws + OFF_WGT) + g * GRP_ROWS, DM / 256};
    pg8::gemm_phase<EpiMoeScatter, MoeOrder, true, true>(GEMM_LDS, gm, S, E);
}

#define XB_TMO      128
#define XB_XCNT(j)  (256  + 64 * (j))
#define XB_XSUB(j)  (1280 + 64 * (j))
#define XB_XGEN(j)  (2304 + 64 * (j))
#define XB_TOP      3328
#define XB_TOPGEN   3392
#define XCD_BAR_WORDS 3456
#define XB_SPIN_CAP (1u << 22)

__device__ __forceinline__ unsigned xb_ld(unsigned* p)              { return __hip_atomic_load(p, __ATOMIC_RELAXED, __HIP_MEMORY_SCOPE_AGENT); }
__device__ __forceinline__ unsigned xb_add(unsigned* p, unsigned v) { return __hip_atomic_fetch_add(p, v, __ATOMIC_RELAXED, __HIP_MEMORY_SCOPE_AGENT); }
__device__ __forceinline__ unsigned xb_xcc_id() { return (unsigned)__builtin_amdgcn_s_getreg((3 << 11) | 20) & 0xFu; }
#define XB_SPIN(cond, bar) do { unsigned _sp = 0; while (cond) { __builtin_amdgcn_s_sleep(1); \
    if ((++_sp & 255u) == 0u) { if (xb_ld(&(bar)[XB_TMO])) break; if (_sp > XB_SPIN_CAP) { atomicAdd(&(bar)[XB_TMO], 1u); break; } } } } while (0)

struct XcdBarrier {
    unsigned* bar; unsigned x;
    volatile LAS unsigned* st;
};

__device__ __forceinline__ XcdBarrier xcd_barrier_post(unsigned* bar, volatile LAS unsigned* st) {
    XcdBarrier b; b.bar = bar; b.x = xb_xcc_id(); b.st = st;
    if (threadIdx.x == 0) (void)xb_add(&bar[XB_XCNT(b.x)], 1u);
    return b;
}
__device__ __forceinline__ void xcd_barrier_complete(unsigned* bar, unsigned x, unsigned& nloc, unsigned& nx) {
    const unsigned G = gridDim.x * gridDim.y * gridDim.z;
    unsigned sum, cnt, mine, sp = 0u;
    for (;;) {
        sum = 0u; cnt = 0u; mine = 0u;
#pragma unroll
        for (unsigned j = 0; j < 16; ++j) { const unsigned c = xb_ld(&bar[XB_XCNT(j)]); sum += c; cnt += (c > 0u) ? 1u : 0u; mine = (j == x) ? c : mine; }
        if (sum == G) break;
        __builtin_amdgcn_s_sleep(1);
        if ((++sp & 255u) == 0u) { if (xb_ld(&bar[XB_TMO])) break; if (sp > XB_SPIN_CAP) { atomicAdd(&bar[XB_TMO], 1u); break; } }
    }
    nloc = mine > 0u ? mine : 1u; nx = cnt > 0u ? cnt : 1u;
}

__device__ __forceinline__ void xcd_barrier(const XcdBarrier& b) {
    asm volatile("s_waitcnt vmcnt(0)" ::: "memory");
    __syncthreads();
    if (threadIdx.x == 0) {
        unsigned* bar = b.bar;
        __builtin_amdgcn_s_waitcnt(0);
        unsigned nloc = b.st[0], nx = b.st[1];
        if (nloc == 0u) { xcd_barrier_complete(bar, b.x, nloc, nx); b.st[0] = nloc; b.st[1] = nx; }
        const unsigned old = xb_add(&bar[XB_XSUB(b.x)], 1u);
        const unsigned gen = old / nloc;
        if (old + 1u == (gen + 1u) * nloc) {
            __builtin_amdgcn_fence(__ATOMIC_RELEASE, "agent");
            asm volatile("s_waitcnt vmcnt(0)" ::: "memory");
            const unsigned og = xb_add(&bar[XB_TOP], 1u);
            const unsigned tg = og / nx;
            if (og + 1u == (tg + 1u) * nx) xb_add(&bar[XB_TOPGEN], 1u);
            else XB_SPIN(xb_ld(&bar[XB_TOPGEN]) == tg, bar);
            __builtin_amdgcn_fence(__ATOMIC_ACQUIRE, "agent");
            xb_add(&bar[XB_XGEN(b.x)], 1u);
            asm volatile("s_waitcnt vmcnt(0)" ::: "memory");
        } else {
            XB_SPIN(xb_ld(&bar[XB_XGEN(b.x)]) == gen, bar);
            __builtin_amdgcn_fence(__ATOMIC_ACQUIRE, "agent");
            asm volatile("s_waitcnt vmcnt(0)" ::: "memory");
        }
    }
    __syncthreads();
}


constexpr int LDS_FLOATS = 33792;
constexpr int LDS_BYTES = LDS_FLOATS * 4 + 16 + 256;

typedef const __attribute__((address_space(4))) unsigned long long* kargp_t;
typedef __attribute__((address_space(1))) const float* gcf_t;
__device__ __forceinline__ Params load_params(const float* lds) {
    const LAS unsigned* tbl = (const LAS unsigned*)(lds + LDS_FLOATS + 4);
    Params p; const float** f = (const float**)&p;
#pragma unroll
    for (int i = 0; i < (int)(sizeof(Params) / 8); ++i) {
        const unsigned lo = __builtin_amdgcn_readfirstlane(tbl[2 * i]), hi = __builtin_amdgcn_readfirstlane(tbl[2 * i + 1]);
        f[i] = (const float*)(gcf_t)(((unsigned long long)hi << 32) | lo); }
    return p;
}
#define LOADP(name) const Params name = load_params(lds)

template <int l>
__device__ __forceinline__ void run_layer(const XcdBarrier& bar, int bid, int nb, float* lds) {
    constexpr bool need_ctx = l == 0;
    constexpr float lam_init = l == 0 ? 0.2f : 0.35550906759509393f;
    { LOADP(p); ph_norm<false>(p, l, 0, NROW, bid, nb, lds); } xcd_barrier(bar);
    { LOADP(p); ph_gemm_in(p, l, bid, nb, lds); } xcd_barrier(bar);
    { LOADP(p); ph_ret_summ(p, l, bid, nb, lds); } { LOADP(p); ph_lru_chunk<1>(p, l, bid, nb, lds, 0); } xcd_barrier(bar);
    { LOADP(p); ph_scan2(p, l, bid, nb); } xcd_barrier(bar);
    { LOADP(p); ph_diff(p, l, need_ctx, lam_init, bid, nb, lds); }
    { LOADP(p); ph_swa(p, l, need_ctx, bid, nb, lds); }
    { LOADP(p); ph_ret_out(p, l, bid, nb, lds, need_ctx ? 0 : 2); }
    { LOADP(p); ph_lru_chunk<3>(p, l, bid, nb, lds, need_ctx ? 0 : 2); } xcd_barrier(bar);
    { LOADP(p); ph_gemm_out(p, l, need_ctx, bid, nb, lds); } xcd_barrier(bar);
    if (l == 0) {
        { LOADP(p); ph_norm<false>(p, l, 1, NROW, bid, nb, lds); } xcd_barrier(bar);
        { LOADP(p); ph_ffn1(p, need_ctx, bid, nb, lds); } xcd_barrier(bar);
        { LOADP(p); ph_ffn2(p, l, need_ctx, bid, nb, lds); } xcd_barrier(bar);
    } else {
        { LOADP(p); ph_norm<true>(p, l, 1, NLAT, bid, nb, lds); } xcd_barrier(bar);
        { LOADP(p); ph_moe_scatter(p, bid, nb, lds); } xcd_barrier(bar);
        { LOADP(p); ph_moe1(p, 0, bid, nb, lds); } xcd_barrier(bar);
        { LOADP(p); ph_moe2(p, l, 0, bid, nb, lds); } xcd_barrier(bar);
        { LOADP(p); ph_moe1(p, 1, bid, nb, lds); } xcd_barrier(bar);
        { LOADP(p); ph_moe2(p, l, 1, bid, nb, lds); } xcd_barrier(bar);
    }
}

__global__ void __launch_bounds__(512, 2) fwd(Params p_in) {
    extern __shared__ __attribute__((aligned(16))) float lds[];
    volatile LAS unsigned* st = (volatile LAS unsigned*)(lds + LDS_FLOATS);
    if (threadIdx.x == 0) { st[0] = 0u; st[1] = 0u; st[2] = 0u; st[3] = 0u; }
    if (threadIdx.x < (int)(sizeof(Params) / 8)) { const kargp_t q = (kargp_t)__builtin_amdgcn_kernarg_segment_ptr(); ((LAS unsigned long long*)(lds + LDS_FLOATS + 4))[threadIdx.x] = q[threadIdx.x]; }
    __syncthreads();
    XcdBarrier bar;
    { LOADP(p); bar = xcd_barrier_post((unsigned*)p.ws, st); }
    const int bid = blockIdx.x, nb = gridDim.x;
    { LOADP(p); ph_prologue(p, bid, nb, lds); } xcd_barrier(bar);
    run_layer<0>(bar, bid, nb, lds);
    run_layer<1>(bar, bid, nb, lds);
    { LOADP(p); ph_final(p, bid, nb); }
}

extern "C" void kernel_launch(void* const* d_in, const int* in_sizes, int n_in, void* d_out, int out_size, void* d_ws, size_t ws_size, hipStream_t stream) {
    static int grid = 0;
    if (grid == 0) {
        if (n_in < 30 || ws_size < WS_NEED) { fprintf(stderr, "kernel_launch: bad args n_in=%d ws=%zu need=%zu\n", n_in, ws_size, (size_t)WS_NEED); grid = -1; return; }
        int dev = 0, cus = 0, per_cu = 0;
        if (hipGetDevice(&dev) != hipSuccess || hipDeviceGetAttribute(&cus, hipDeviceAttributeMultiprocessorCount, dev) != hipSuccess) { grid = -1; return; }
        if (hipFuncSetAttribute((const void*)fwd, hipFuncAttributeMaxDynamicSharedMemorySize, LDS_BYTES) != hipSuccess) { fprintf(stderr, "kernel_launch: hipFuncSetAttribute failed\n"); grid = -1; return; }
        if (hipOccupancyMaxActiveBlocksPerMultiprocessor(&per_cu, (const void*)fwd, 512, LDS_BYTES) != hipSuccess || per_cu < 1) { fprintf(stderr, "kernel_launch: occupancy query says %d\n", per_cu); per_cu = 1; }
        (void)hipGetLastError();
        grid = cus;
    }
    if (grid < 0) return;
    Params p{};
    const float** f = (const float**)&p;
    for (int i = 0; i < 30; ++i) f[i] = (const float*)d_in[i];
    p.out = (float*)d_out; p.ws = (char*)d_ws;
    (void)hipMemsetAsync(d_ws, 0, 65536, stream);
    hipLaunchKernelGGL(fwd, dim3(grid), dim3(512), LDS_BYTES, stream, p);
}
```

```cpp
#include <hip/hip_runtime.h>
#include <cstdio>
#include <cstdint>

typedef unsigned short bf16_t;
typedef short bf16x8 __attribute__((ext_vector_type(8)));
typedef float f32x4 __attribute__((ext_vector_type(4)));
typedef unsigned u32x4 __attribute__((ext_vector_type(4)));
#define LAS __attribute__((address_space(3)))

constexpr int NB = 2, NSEQ = 16384, NCTX = 256, DM = 1024;
constexpr int NLAT = NB * NSEQ;
constexpr int NCR = NB * NCTX;
constexpr int NROW = NLAT + NCR;
constexpr int DIN = 2816, DFF = 2816, DFE = 3584, NE = 8;
constexpr int NCI = 130;
constexpr int C_AQ = 0, C_AK = 256, C_AV = 384, C_RQ = 512, C_RK = 768, C_RV = 1024, C_RG = 1280, C_DQ = 1536, C_DK = 1792, C_DV = 2048, C_LX = 2304, C_LY = 2560;
constexpr int GRP_ROWS = 34816;

constexpr size_t al256(size_t x) { return (x + 255) & ~(size_t)255; }
constexpr size_t OFF_CTRL = 0;
constexpr size_t OFF_MOD = 65536;
constexpr size_t OFF_TAB = al256(OFF_MOD + 2 * 3 * 6144 * 4);
constexpr size_t TAB_ATTN = 0, TAB_RET = 4u << 20, TAB_DIFF = 8u << 20;
constexpr size_t OFF_XC = al256(OFF_TAB + (10u << 20));
constexpr size_t OFF_ROUTE = al256(OFF_XC + (size_t)NCR * DM * 4);
constexpr size_t OFF_TOK = al256(OFF_ROUTE + (size_t)NLAT * 16);
constexpr size_t OFF_WGT = al256(OFF_TOK + (size_t)2 * GRP_ROWS * 4);
constexpr size_t OFF_LRU = al256(OFF_WGT + (size_t)2 * GRP_ROWS * 4);
constexpr size_t OFF_WM13 = al256(OFF_LRU + (size_t)3 * 2 * 2 * NCI * 256 * 4);
constexpr size_t OFF_WM2 = al256(OFF_WM13 + (size_t)NE * 2 * DFE * DM * 2);
constexpr size_t OFF_R = al256(OFF_WM2 + (size_t)NE * DM * DFE * 2);
constexpr size_t OFF_P = OFF_R;
constexpr size_t OFF_ACT = al256(OFF_P + (size_t)NROW * DIN * 2);
constexpr size_t OFF_RET = al256(OFF_ACT + (size_t)NROW * DM * 2);
constexpr size_t OFF_WIN = al256(OFF_RET + (size_t)2 * 2 * NCI * 4 * 4096 * 4);
constexpr size_t OFF_WOUT = al256(OFF_WIN + (size_t)2 * DIN * DM * 2);
constexpr size_t OFF_WF13 = al256(OFF_WOUT + (size_t)2 * DM * DM * 2);
constexpr size_t OFF_WF2 = al256(OFF_WF13 + (size_t)2 * DFF * DM * 2);
constexpr size_t OFF_R_END1 = al256(OFF_WF2 + (size_t)DM * DFF * 2);
constexpr size_t OFF_ASORT = OFF_R;
constexpr size_t OFF_UMOE = al256(OFF_ASORT + (size_t)2 * GRP_ROWS * DM * 2);
constexpr size_t OFF_R_END2 = al256(OFF_UMOE + (size_t)GRP_ROWS * DFE * 2);
constexpr size_t WS_NEED = OFF_R_END1 > OFF_R_END2 ? OFF_R_END1 : OFF_R_END2;
static_assert(OFF_ACT >= OFF_UMOE, "H2 must not overlap A_sorted");
constexpr int CW_CNT = 4096;
constexpr int CW_BLK = 8192;

struct Params {
    const float *x, *c, *ctx, *c_ctx, *w_ada, *b_ada, *g1, *g2, *w_in, *w_out, *sink, *ret_logit, *ret_gn, *diff_lam, *diff_gn,
        *conv_w, *conv_b, *lru_wa, *lru_ba, *lru_wx, *lru_bx, *lru_lam, *ffn_w1, *ffn_w3, *ffn_w2, *moe_router, *moe_w1, *moe_w3, *moe_w2, *final_norm;
    float* out; char* ws;
};

__device__ __forceinline__ int ltid_() { int t = threadIdx.x; asm volatile("" : "+v"(t)); return t; }
#define TIDX ltid_()
__device__ __forceinline__ float bf2f(bf16_t h) { return __uint_as_float(((unsigned)h) << 16); }
__device__ __forceinline__ bf16_t f2bf(float f) { unsigned u = __float_as_uint(f); u += 0x7fffu + ((u >> 16) & 1u); return (bf16_t)(u >> 16); }
__device__ __forceinline__ unsigned pack2(float lo, float hi) { return (unsigned)f2bf(lo) | ((unsigned)f2bf(hi) << 16); }
__device__ __forceinline__ float wave_sum(float v) {
#pragma unroll
    for (int o = 32; o >= 1; o >>= 1) v += __shfl_xor(v, o);
    return v;
}
__device__ __forceinline__ float sigmoidf_(float x) { return 1.0f / (1.0f + __expf(-x)); }
__device__ __forceinline__ float siluf_(float x) { return x / (1.0f + __expf(-x)); }
__device__ __forceinline__ float fast_silu(float v) { return v * __builtin_amdgcn_rcpf(1.0f + __expf(-v)); }
__device__ __forceinline__ float softplusf_(float x) { return x > 20.f ? x : log1pf(expf(x)); }
__device__ __forceinline__ float gelu_tanh(float x) { const float u = 0.7978845608028654f * (x + 0.044715f * x * x * x); return x * __builtin_amdgcn_rcpf(1.0f + __expf(-2.0f * u)); }
__device__ __forceinline__ int row_base(int b, int ci) { return ci < 2 ? NLAT + b * NCTX + ci * 128 : b * NSEQ + (ci - 2) * 128; }
__device__ __forceinline__ int mod_class(int row) { return row < NSEQ ? 0 : (row < NLAT ? 1 : 2); }

typedef float f32x16 __attribute__((ext_vector_type(16)));
typedef short s16x4 __attribute__((ext_vector_type(4)));
typedef short v4i16_t __attribute__((ext_vector_type(4)));
typedef float f32x2_t __attribute__((ext_vector_type(2)));
typedef __bf16 bf16x2_t __attribute__((ext_vector_type(2)));
__device__ __forceinline__ unsigned cvtpk_s(float lo, float hi) { f32x2_t v = {lo, hi}; bf16x2_t bb = __builtin_convertvector(v, bf16x2_t); return __builtin_bit_cast(unsigned, bb); }
__device__ __forceinline__ int crow(int r, int hi) { return (r & 3) + 8 * (r >> 2) + 4 * hi; }
__device__ __forceinline__ s16x4 vtr(const LAS char* p) { return __builtin_bit_cast(s16x4, __builtin_amdgcn_ds_read_tr16_b64_v4i16((LAS v4i16_t*)p)); }
__device__ __forceinline__ float bfs(short s) { return __uint_as_float(((unsigned)(unsigned short)s) << 16); }

__device__ __forceinline__ void convert_tile4(const float* src, int K, int N, bf16_t* dst, int unit, int mode, float* lds) {
    const int upn = N / 256, tk = unit / upn, tn4 = unit % upn, t = TIDX;
    {   const int kk = t >> 3, nc = (t & 7) * 8; float4 a[4], b[4];
#pragma unroll
        for (int q = 0; q < 4; ++q) { const float* sp = src + (size_t)(tk * 64 + kk) * N + tn4 * 256 + q * 64 + nc; a[q] = *(const float4*)sp; b[q] = *(const float4*)(sp + 4); }
#pragma unroll
        for (int q = 0; q < 4; ++q) { float* d = lds + q * (64 * 65) + kk * 65 + nc; d[0] = a[q].x; d[1] = a[q].y; d[2] = a[q].z; d[3] = a[q].w; d[4] = b[q].x; d[5] = b[q].y; d[6] = b[q].z; d[7] = b[q].w; } }
    __syncthreads();
    {   const int n = t >> 3, kc = (t & 7) * 8;
#pragma unroll
        for (int q = 0; q < 4; ++q) { const int ng = tn4 * 256 + q * 64 + n; const float* L = lds + q * (64 * 65);
            int nrow;
            if (mode == 3) {
                const int s = ng >> 7; const bool r64 = s <= 2 || (s >= 4 && s <= 7), r32 = s >= 12 && s <= 15;
                if (r64) { const int d = ng & 63; nrow = (ng & ~63) + 8 * ((d & 31) >> 2) + 4 * (d >> 5) + (d & 3); }
                else if (r32) { const int d = ng & 31; nrow = (ng & ~31) + 8 * ((d & 15) >> 2) + 4 * (d >> 4) + (d & 3); }
                else nrow = ng;
            } else nrow = mode == 0 ? ng : ((ng >> 7) * 256 + (mode == 2 ? 128 : 0) + (ng & 127));
            uint4 w; w.x = pack2(L[(kc + 0) * 65 + n], L[(kc + 1) * 65 + n]); w.y = pack2(L[(kc + 2) * 65 + n], L[(kc + 3) * 65 + n]);
            w.z = pack2(L[(kc + 4) * 65 + n], L[(kc + 5) * 65 + n]); w.w = pack2(L[(kc + 6) * 65 + n], L[(kc + 7) * 65 + n]);
            *(uint4*)(dst + (size_t)nrow * K + tk * 64 + kc) = w; } }
    __syncthreads();
}

__device__ __forceinline__ void ph_prologue(const Params& p, int bid, int nb, float* lds) {
    char* ws = p.ws; const int t = TIDX;
    {
        struct Job { const float* src; bf16_t* dst; int K, N, mode, base; };
        Job* jobs = (Job*)(lds + 4 * 64 * 65);
        const int T_IN = 16 * 11, T_OUT = 16 * 4, T_F13 = 16 * 11, T_F2 = 44 * 4, T_M13 = 16 * 14, T_M2 = 56 * 4;
        const int total = 2 * T_IN + 2 * T_OUT + 2 * T_F13 + T_F2 + 16 * T_M13 + 8 * T_M2;
        if (t < 32) {
            Job jb; jb.src = nullptr; jb.dst = nullptr; jb.K = DM; jb.N = DM; jb.mode = 0; jb.base = total;
            if (t < 2) { jb.src = p.w_in + (size_t)t * DM * DIN; jb.dst = (bf16_t*)(ws + OFF_WIN) + (size_t)t * DIN * DM; jb.N = DIN; jb.mode = 3; jb.base = t * T_IN; }
            else if (t < 4) { jb.src = p.w_out + (size_t)(t - 2) * DM * DM; jb.dst = (bf16_t*)(ws + OFF_WOUT) + (size_t)(t - 2) * DM * DM; jb.base = 2 * T_IN + (t - 2) * T_OUT; }
            else if (t < 6) { jb.src = t == 4 ? p.ffn_w1 : p.ffn_w3; jb.dst = (bf16_t*)(ws + OFF_WF13); jb.N = DFF; jb.mode = t - 3; jb.base = 2 * T_IN + 2 * T_OUT + (t - 4) * T_F13; }
            else if (t == 6) { jb.src = p.ffn_w2; jb.dst = (bf16_t*)(ws + OFF_WF2); jb.K = DFF; jb.base = 2 * T_IN + 2 * T_OUT + 2 * T_F13; }
            else if (t < 23) { const int q = t - 7, e = q & 7, w3 = q >> 3; jb.src = (w3 ? p.moe_w3 : p.moe_w1) + (size_t)e * DM * DFE; jb.dst = (bf16_t*)(ws + OFF_WM13) + (size_t)e * 2 * DFE * DM; jb.N = DFE; jb.mode = 1 + w3;
                jb.base = 2 * T_IN + 2 * T_OUT + 2 * T_F13 + T_F2 + q * T_M13; }
            else if (t < 31) { const int e = t - 23; jb.src = p.moe_w2 + (size_t)e * DFE * DM; jb.dst = (bf16_t*)(ws + OFF_WM2) + (size_t)e * DM * DFE; jb.K = DFE;
                jb.base = 2 * T_IN + 2 * T_OUT + 2 * T_F13 + T_F2 + 16 * T_M13 + e * T_M2; }
            jobs[t] = jb;
        }
        __syncthreads();
        int j = 0;
        for (int u = bid; u < total; u += nb) {
            while (u >= jobs[j + 1].base) ++j;
            const Job jb = jobs[j];
            convert_tile4(jb.src, jb.K, jb.N, jb.dst, u - jb.base, jb.mode, lds);
        }
        __syncthreads();
    }
    {
        float* sv = lds;
        float* red = lds + 3072;
        for (int i = t; i < 3072; i += 512) { const int v = i >> 10, k = i & 1023; const float cv = v < 2 ? p.c[v * DM + k] : p.c_ctx[k]; sv[i] = siluf_(cv); }
        __syncthreads();
        float* mod = (float*)(ws + OFF_MOD);
        for (int u = bid; u < 2 * 96; u += nb) {
            const int l = u / 96, j0 = (u % 96) * 64, j = t & 63, kg = t >> 6;
            float a0 = 0.f, a1 = 0.f, a2 = 0.f;
            const float* w = p.w_ada + (size_t)l * DM * 6144 + j0 + j;
            for (int k = kg * 128; k < kg * 128 + 128; ++k) { const float wv = w[(size_t)k * 6144]; a0 += sv[k] * wv; a1 += sv[1024 + k] * wv; a2 += sv[2048 + k] * wv; }
            red[(kg * 3 + 0) * 64 + j] = a0; red[(kg * 3 + 1) * 64 + j] = a1; red[(kg * 3 + 2) * 64 + j] = a2;
            __syncthreads();
            if (t < 192) { const int v = t >> 6; float s = 0.f;
                for (int g = 0; g < 8; ++g) s += red[(g * 3 + v) * 64 + j];
                mod[((size_t)l * 3 + v) * 6144 + j0 + j] = s + p.b_ada[l * 6144 + j0 + j]; }
            __syncthreads();
        }
    }
    {
        const int gt = bid * 512 + t, gs = nb * 512;
        float* ta = (float*)(ws + OFF_TAB + TAB_ATTN); float* tr = (float*)(ws + OFF_TAB + TAB_RET); float* td = (float*)(ws + OFF_TAB + TAB_DIFF);
        for (int i = gt; i < 16384 * 32; i += gs) { const int n = i >> 5, j = i & 31;
            { const float inv = (float)pow(10000.0, -(double)j / 32.0); const float ang = (float)n * inv; tr[i] = (float)cos((double)ang); tr[16384 * 32 + i] = (float)sin((double)ang); }
            { const float inv = (float)pow(10000.0, -(double)(j & 15) / 16.0); const float ang = (float)(j < 16 ? (n >> 6) : (n & 63)) * inv; ta[i] = (float)cos((double)ang); ta[16384 * 32 + i] = (float)sin((double)ang); }
            if (j < 16) { const float inv = (float)pow(10000.0, -(double)(j & 7) / 8.0); const float ang = (float)(j < 8 ? (n >> 6) : (n & 63)) * inv; td[n * 16 + j] = (float)cos((double)ang); td[16384 * 16 + n * 16 + j] = (float)sin((double)ang); } }
        float* xc = (float*)(ws + OFF_XC);
        for (int i = gt; i < NCR * DM / 4; i += gs) ((float4*)xc)[i] = ((const float4*)p.ctx)[i];
        int* tok = (int*)(ws + OFF_TOK);
        for (int i = gt; i < 2 * GRP_ROWS; i += gs) tok[i] = -1;
    }
}

template <bool ROUTE>
__device__ __forceinline__ void ph_norm(const Params& p, int l, int which  , int nrows, int bid, int nb, float* lds) {
    char* ws = p.ws; const int lane = TIDX & 63, wv = TIDX >> 6;
    LAS unsigned* lcnt = (LAS unsigned*)lds;
    if (ROUTE) { __syncthreads(); if (TIDX < 16) lcnt[TIDX] = 0u; __syncthreads(); }
    const float* mod = (const float*)(ws + OFF_MOD) + (size_t)l * 3 * 6144;
    const float* g = (which == 0 ? p.g1 : p.g2) + l * DM;
    bf16_t* H = (bf16_t*)(ws + OFF_ACT);
    const float* xl = (which == 0 && l == 0) ? p.x : p.out;
    const float* xc = (const float*)(ws + OFF_XC);
    const int stride = nb * 8;
    for (int r0 = bid * 8 + wv; r0 < nrows; r0 += 2 * stride) {
        float4 v[2][4]; float ss[2]; const bool has1 = r0 + stride < nrows;
#pragma unroll
        for (int q = 0; q < 2; ++q) { const int r = (q == 0 || has1) ? r0 + q * stride : r0;
            const float* xr = r < NLAT ? xl + (size_t)r * DM : xc + (size_t)(r - NLAT) * DM;
#pragma unroll
            for (int i = 0; i < 4; ++i) v[q][i] = *(const float4*)(xr + i * 256 + lane * 4); }
#pragma unroll
        for (int q = 0; q < 2; ++q) { float s = 0.f;
#pragma unroll
            for (int i = 0; i < 4; ++i) s += v[q][i].x * v[q][i].x + v[q][i].y * v[q][i].y + v[q][i].z * v[q][i].z + v[q][i].w * v[q][i].w;
            ss[q] = wave_sum(s); }
#pragma unroll
        for (int q = 0; q < 2; ++q) {
            if (q == 1 && !has1) break;
            const int r = r0 + q * stride;
            const float* mv = mod + (size_t)mod_class(r) * 6144 + (which == 0 ? 0 : 3072);
            const float rn = rsqrtf(ss[q] * (1.0f / 1024.0f) + 1e-6f);
            float lg[8];
            if (ROUTE) {
#pragma unroll
                for (int e = 0; e < 8; ++e) lg[e] = 0.f;
            }
#pragma unroll
            for (int i = 0; i < 4; ++i) {
                const int c = i * 256 + lane * 4;
                const float4 gg = *(const float4*)(g + c), sh = *(const float4*)(mv + c), sc = *(const float4*)(mv + 1024 + c);
                float h0 = v[q][i].x * rn * gg.x * (1.f + sc.x) + sh.x, h1 = v[q][i].y * rn * gg.y * (1.f + sc.y) + sh.y;
                float h2 = v[q][i].z * rn * gg.z * (1.f + sc.z) + sh.z, h3 = v[q][i].w * rn * gg.w * (1.f + sc.w) + sh.w;
                uint2 w; w.x = pack2(h0, h1); w.y = pack2(h2, h3);
                *(uint2*)(H + (size_t)r * DM + c) = w;
                if (ROUTE) {
                    const float* rt = p.moe_router + (size_t)c * 8;
#pragma unroll
                    for (int e = 0; e < 8; ++e) lg[e] += h0 * rt[e] + h1 * rt[8 + e] + h2 * rt[16 + e] + h3 * rt[24 + e];
                }
            }
            if (ROUTE) {
#pragma unroll
                for (int e = 0; e < 8; ++e) lg[e] = wave_sum(lg[e]);
                if (lane == 0 && r < NLAT) {
                    int e0 = 0; float v0 = lg[0];
#pragma unroll
                    for (int e = 1; e < 8; ++e) if (lg[e] > v0) { v0 = lg[e]; e0 = e; }
                    int e1 = -1; float v1 = -3.0e38f;
#pragma unroll
                    for (int e = 0; e < 8; ++e) if (e != e0 && lg[e] > v1) { v1 = lg[e]; e1 = e; }
                    const float ex = __expf(v1 - v0), w0 = 1.0f / (1.0f + ex), w1 = ex / (1.0f + ex);
                    const unsigned li0 = __hip_atomic_fetch_add(lcnt + e0, 1u, __ATOMIC_RELAXED, __HIP_MEMORY_SCOPE_WORKGROUP), li1 = __hip_atomic_fetch_add(lcnt + 8 + e1, 1u, __ATOMIC_RELAXED, __HIP_MEMORY_SCOPE_WORKGROUP);
                    int4 rec; rec.x = e0 | (int)(li0 << 4); rec.y = e1 | (int)(li1 << 4); rec.z = __float_as_int(w0); rec.w = __float_as_int(w1);
                    *(int4*)(ws + OFF_ROUTE + (size_t)r * 16) = rec;
                }
            }
        }
    }
    if (ROUTE) {
        __syncthreads();
        if (TIDX < 16) { unsigned* cw = (unsigned*)ws; const int t = TIDX; cw[CW_BLK + bid * 16 + t] = atomicAdd(cw + CW_CNT + t, lcnt[t]); }
    }
}

namespace pg8 {
#define PG8_LAS __attribute__((address_space(3)))
typedef unsigned short bf16_t;
typedef short bf16x8 __attribute__((ext_vector_type(8)));
typedef float f32x4 __attribute__((ext_vector_type(4)));
typedef unsigned u32x4 __attribute__((ext_vector_type(4)));
constexpr int BM = 256, BK = 64, HALF = 128, HTB = HALF * BK * 2  , STAGE_BYTES = 8 * HTB, NXCD = 8, WGM = 8;

__host__ __device__ __forceinline__ int lds_byte(int r, int c) { const int st = (r >> 4) * 2 + (c >> 5), rr = r & 15, cc = c & 31, ob = rr * 64 + cc * 2; return st * 1024 + (ob ^ (((ob >> 9) & 1) << 5)); }
__host__ __device__ __forceinline__ void stage_rc(int b, int& R, int& C) { const int st = b / 1024, sb = b % 1024, swz = sb ^ (((sb >> 9) & 1) << 5); R = (st >> 1) * 16 + swz / 64; C = (st & 1) * 32 + (swz % 64) / 2; }
__host__ __device__ __forceinline__ int perm32(int rho) { const int n = rho >> 4, i = rho & 15; return 8 * (i >> 2) + 4 * n + (i & 3); }

struct Unit { int pm, pn; };
struct Gemm { const bf16_t* A; const bf16_t* Bt; int M, N, K; };

struct StaticOrder {
    int nM, nN, nwg, G, c;
    __host__ __device__ void init(int M, int N, int G_, int c_) { nM = M / BM; nN = N / BM; nwg = nM * nN; G = G_; c = c_; }
    __host__ __device__ bool next(int i, Unit& u) const {
        const long L = (long)i * G + c; if (L >= nwg) return false;
        int wgid = (int)L; { const int q = nwg / NXCD, r = nwg % NXCD, xcd = wgid % NXCD, off = wgid / NXCD; wgid = (xcd < r ? xcd * (q + 1) : r * (q + 1) + (xcd - r) * q) + off; }
        const int nig = WGM * nN, gid = wgid / nig, fm = gid * WGM, gsz = (nM - fm) < WGM ? (nM - fm) : WGM;
        u.pm = fm + ((wgid % nig) % gsz); u.pn = (wgid % nig) / gsz; return true;
    }
    __device__ __forceinline__ void a_ready(const Unit&) const {}
    __device__ __forceinline__ void done(const Unit&) const {}
};
__device__ __forceinline__ unsigned cvt_pk_bf16(float lo, float hi) { unsigned r; asm volatile("v_cvt_pk_bf16_f32 %0, %1, %2" : "=v"(r) : "v"(lo), "v"(hi)); return r; }
typedef float f32x2 __attribute__((ext_vector_type(2)));
template <class Epi, class Sched, bool ALIGN_EPI = false, bool SP2 = false>
__device__ __forceinline__ void gemm_phase(PG8_LAS unsigned char* lds, const Gemm g, const Sched& S, const Epi& E) {
    int tid_ = threadIdx.x; asm volatile("" : "+v"(tid_));
    const int tid = tid_, wid = __builtin_amdgcn_readfirstlane(tid >> 6), lane = tid & 63, wr = wid >> 2, wc = wid & 3, fr = lane & 15, fq = lane >> 4;
    const int K = g.K, nt = K / BK;
    unsigned voffA[2], voffB[2];
#pragma unroll
    for (int i = 0; i < 2; ++i) { int R, C; stage_rc(tid * 16 + i * 8192, R, C); const int Rb = Epi::PERM ? ((R & ~31) + perm32(R & 31)) : R;
        voffA[i] = (unsigned)(R * K + C) * 2u; voffB[i] = (unsigned)(Rb * K + C) * 2u; }
    const size_t kstep = (size_t)(BK * 2);
    const size_t hstep = (size_t)HALF * K * 2;
    const size_t tstep = 2 * hstep;
    const unsigned ldsw = (unsigned)wid * 1024u;
    const int aoff = lds_byte(wr * 64 + fr, fq * 8), boff = lds_byte(wc * 32 + fr, fq * 8);
#define PG8_SA(b, h) (((b) * 2 + (h)) * HTB)
#define PG8_SB(b, h) ((4 + (b) * 2 + (h)) * HTB)
#define PG8_STAGE(bufoff, gbase, voff) do { _Pragma("unroll") for (int _i = 0; _i < 2; ++_i) \
        __builtin_amdgcn_global_load_lds((const unsigned*)((const char*)(gbase) + (voff)[_i]), (PG8_LAS unsigned*)(lds + (bufoff) + ldsw + _i * 8192), 16, 0, 0); } while (0)
#define PG8_LDA(dst, b, h) do { _Pragma("unroll") for (int m = 0; m < 4; ++m) _Pragma("unroll") for (int k = 0; k < 2; ++k) dst[m][k] = *(const PG8_LAS bf16x8*)(lds + PG8_SA(b, h) + aoff + m * 2048 + k * 1024); } while (0)
#define PG8_LDB(dst, b, h) do { _Pragma("unroll") for (int n = 0; n < 2; ++n) _Pragma("unroll") for (int k = 0; k < 2; ++k) dst[n][k] = *(const PG8_LAS bf16x8*)(lds + PG8_SB(b, h) + boff + n * 2048 + k * 1024); } while (0)
#define PG8_MMA(ai, bj, At, Bt) do { __builtin_amdgcn_s_setprio(1); _Pragma("unroll") for (int m = 0; m < 4; ++m) _Pragma("unroll") for (int n = 0; n < 2; ++n) _Pragma("unroll") for (int k = 0; k < 2; ++k) \
        acc[ai][bj][m][n] = __builtin_amdgcn_mfma_f32_16x16x32_bf16(Bt[n][k], At[m][k], acc[ai][bj][m][n], 0, 0, 0); __builtin_amdgcn_s_setprio(0); } while (0)
#define PG8_WAIT_V(n) asm volatile("s_waitcnt vmcnt(" #n ")" ::: "memory")
#define PG8_WAIT_L(n) asm volatile("s_waitcnt lgkmcnt(" #n ")" ::: "memory")
#define PG8_BAR __builtin_amdgcn_s_barrier()
#define PG8_SCHED __builtin_amdgcn_sched_barrier(0)
    Unit cur, nxt; int ui = 0;
    if (!S.next(0, cur)) return;
    f32x4 acc[2][2][4][2];
#pragma unroll
    for (int a = 0; a < 2; ++a)
#pragma unroll
        for (int b = 0; b < 2; ++b)
#pragma unroll
            for (int m = 0; m < 4; ++m)
#pragma unroll
                for (int n = 0; n < 2; ++n) acc[a][b][m][n] = (f32x4){0.f, 0.f, 0.f, 0.f};
    bf16x8 At[4][2], B0[2][2], B1[2][2];
    const char* cA = (const char*)g.A + (size_t)cur.pm * tstep; const char* cB = (const char*)g.Bt + (size_t)cur.pn * tstep;
    S.a_ready(cur);
    if constexpr (SP2) {
        PG8_STAGE(PG8_SB(0, 0), cB, voffB); PG8_STAGE(PG8_SB(0, 1), cB + hstep, voffB); PG8_STAGE(PG8_SA(0, 0), cA, voffA); PG8_STAGE(PG8_SA(0, 1), cA + hstep, voffA);
        if (wr == 1) PG8_BAR;
        PG8_WAIT_V(2); PG8_BAR;
        PG8_STAGE(PG8_SB(1, 0), cB + kstep, voffB); PG8_STAGE(PG8_SA(1, 0), cA + kstep, voffA); PG8_STAGE(PG8_SB(1, 1), cB + hstep + kstep, voffB);
        PG8_WAIT_V(6); PG8_BAR;
    } else {
        PG8_STAGE(PG8_SB(0, 0), cB, voffB); PG8_STAGE(PG8_SA(0, 0), cA, voffA); PG8_STAGE(PG8_SB(0, 1), cB + hstep, voffB); PG8_STAGE(PG8_SA(0, 1), cA + hstep, voffA);
        if (wr == 1) PG8_BAR;
        PG8_WAIT_V(4); PG8_BAR;
        PG8_STAGE(PG8_SB(1, 0), cB + kstep, voffB); PG8_STAGE(PG8_SA(1, 0), cA + kstep, voffA); PG8_STAGE(PG8_SB(1, 1), cB + hstep + kstep, voffB);
        PG8_WAIT_V(6); PG8_BAR;
    }
    for (;;) {
        const bool has_next = S.next(ui + 1, nxt);
        const char* nA = has_next ? (const char*)g.A + (size_t)nxt.pm * tstep : cA; const char* nB = has_next ? (const char*)g.Bt + (size_t)nxt.pn * tstep : cB;
        for (int t = 0; t < nt; t += 2) {
            const bool last = (t == nt - 2);
            const char* a1 = cA + (size_t)(t + 1) * kstep;
            const char* a2 = last ? nA : cA + (size_t)(t + 2) * kstep; const char* b2 = last ? nB : cB + (size_t)(t + 2) * kstep;
            const char* a3 = a2 + kstep; const char* b3 = b2 + kstep;
            if (last && has_next) S.a_ready(nxt);
            if constexpr (SP2) {
            PG8_LDB(B0, 0, 0); PG8_LDB(B1, 0, 1); PG8_SCHED; PG8_LDA(At, 0, 0); PG8_STAGE(PG8_SA(1, 1), a1 + hstep, voffA);
            PG8_WAIT_V(8); PG8_WAIT_L(0); PG8_BAR; PG8_MMA(0, 0, At, B0); PG8_MMA(0, 1, At, B1); PG8_BAR; PG8_SCHED;
            PG8_LDA(At, 0, 1); PG8_STAGE(PG8_SB(0, 0), b2, voffB); PG8_STAGE(PG8_SB(0, 1), b2 + hstep, voffB); PG8_STAGE(PG8_SA(0, 0), a2, voffA);
            PG8_WAIT_V(8); PG8_WAIT_L(0); PG8_BAR; PG8_MMA(1, 0, At, B0); PG8_MMA(1, 1, At, B1); PG8_BAR; PG8_SCHED;
            PG8_LDB(B0, 1, 0); PG8_LDB(B1, 1, 1); PG8_SCHED; PG8_LDA(At, 1, 0); PG8_STAGE(PG8_SA(0, 1), a2 + hstep, voffA);
            PG8_WAIT_V(8); PG8_WAIT_L(0); PG8_BAR; PG8_MMA(0, 0, At, B0); PG8_MMA(0, 1, At, B1); PG8_BAR; PG8_SCHED;
            PG8_LDA(At, 1, 1); PG8_STAGE(PG8_SB(1, 0), b3, voffB); PG8_STAGE(PG8_SB(1, 1), b3 + hstep, voffB); PG8_STAGE(PG8_SA(1, 0), a3, voffA);
            PG8_WAIT_V(8); PG8_WAIT_L(0); PG8_BAR; PG8_MMA(1, 0, At, B0); PG8_MMA(1, 1, At, B1); PG8_BAR; PG8_SCHED;
            } else {
            PG8_LDB(B0, 0, 0); PG8_SCHED; PG8_LDA(At, 0, 0); PG8_STAGE(PG8_SA(1, 1), a1 + hstep, voffA);
            PG8_WAIT_L(8); PG8_BAR; PG8_WAIT_L(0); PG8_MMA(0, 0, At, B0); PG8_BAR; PG8_SCHED;
            PG8_LDB(B1, 0, 1); PG8_STAGE(PG8_SB(0, 0), b2, voffB);
            PG8_BAR; PG8_WAIT_L(0); PG8_MMA(0, 1, At, B1); PG8_BAR;
            PG8_LDA(At, 0, 1); PG8_STAGE(PG8_SA(0, 0), a2, voffA);
            PG8_BAR; PG8_WAIT_L(0); PG8_MMA(1, 0, At, B0); PG8_BAR; PG8_SCHED;
            PG8_STAGE(PG8_SB(0, 1), b2 + hstep, voffB);
            PG8_WAIT_V(6); PG8_BAR; PG8_MMA(1, 1, At, B1); PG8_BAR;
            PG8_LDB(B0, 1, 0); PG8_SCHED; PG8_LDA(At, 1, 0); PG8_STAGE(PG8_SA(0, 1), a2 + hstep, voffA);
            PG8_WAIT_L(8); PG8_BAR; PG8_WAIT_L(0); PG8_MMA(0, 0, At, B0); PG8_BAR; PG8_SCHED;
            PG8_LDB(B1, 1, 1); PG8_STAGE(PG8_SB(1, 0), b3, voffB);
            PG8_BAR; PG8_WAIT_L(0); PG8_MMA(0, 1, At, B1); PG8_BAR;
            PG8_LDA(At, 1, 1); PG8_STAGE(PG8_SA(1, 0), a3, voffA);
            PG8_BAR; PG8_WAIT_L(0); PG8_MMA(1, 0, At, B0); PG8_BAR; PG8_SCHED;
            PG8_STAGE(PG8_SB(1, 1), b3 + hstep, voffB);
            PG8_WAIT_V(6); PG8_BAR; PG8_MMA(1, 1, At, B1); PG8_BAR;
            }
        }
        if constexpr (ALIGN_EPI) { if (wr == 0) PG8_BAR; }
        if constexpr (!Epi::AFTER_DRAIN) { E(acc, cur, wr, wc, fr, fq); S.done(cur); }
        if (!has_next) break;
#pragma unroll
        for (int a = 0; a < 2; ++a)
#pragma unroll
            for (int b = 0; b < 2; ++b)
#pragma unroll
                for (int m = 0; m < 4; ++m)
#pragma unroll
                    for (int n = 0; n < 2; ++n) acc[a][b][m][n] = (f32x4){0.f, 0.f, 0.f, 0.f};
        cur = nxt; cA = nA; cB = nB; ++ui;
        if constexpr (ALIGN_EPI) { if (wr == 1) PG8_BAR; }
    }
    PG8_WAIT_V(0);
    if constexpr (!ALIGN_EPI) { if (wr == 0) PG8_BAR; }
    PG8_BAR;
    if constexpr (Epi::AFTER_DRAIN) { E.fused(acc, cur, wr, wc, fr, fq, lds, wid, lane); S.done(cur); }
#undef PG8_SA
#undef PG8_SB
#undef PG8_STAGE
#undef PG8_LDA
#undef PG8_LDB
#undef PG8_MMA
#undef PG8_WAIT_V
#undef PG8_WAIT_L
#undef PG8_BAR
#undef PG8_SCHED
}
}

constexpr int RT_K = 0, RT_V = 32768, RT_ST = 65536;
template <bool KV> __device__ __forceinline__ void ret_stage(const bf16_t* P, int rb, int hp, LAS char* sm, int tid, int wid, int lane) {
    const int vrow = 16 * (wid & 3) + (lane >> 2), vc = (wid >> 2) * 32 + (lane & 3) * 8;
    u32x4 kk[4], vv[4];
#pragma unroll
    for (int i = 0; i < 4; ++i) { const int hh = i >> 1, tt = i & 1, h = 2 * hp + hh, r0 = rb + tt * 64;
        vv[i] = *(const u32x4*)(P + (size_t)(r0 + vrow) * DIN + C_RV + h * 64 + vc);
        kk[i] = KV ? *(const u32x4*)(P + (size_t)(r0 + vrow) * DIN + C_RK + h * 64 + vc) : *(const u32x4*)(P + (size_t)(r0 + lane) * DIN + C_RK + h * 64 + wid * 8); }
#pragma unroll
    for (int i = 0; i < 4; ++i) { *(LAS u32x4*)(sm + RT_K + i * 8192 + tid * 16) = kk[i]; *(LAS u32x4*)(sm + RT_V + i * 8192 + tid * 16) = vv[i]; }
}
__device__ __forceinline__ float ret_lg(const Params& p, int l, int dir, int h) { return -softplusf_(-p.ret_logit[(l * 2 + dir) * 4 + h]); }
__device__ __forceinline__ void ph_ret_summ(const Params& p, int l, int bid, int nb, float* lds) {
    char* ws = p.ws; const int tid = TIDX, lane = tid & 63, r32 = lane & 31, hi = lane >> 5, wid = __builtin_amdgcn_readfirstlane(tid >> 6);
    const bf16_t* P = (const bf16_t*)(ws + OFF_P); float* RET = (float*)(ws + OFF_RET);
    LAS char* sm = (LAS char*)lds;
    for (int u = bid; u < 2 * NCI * 2; u += nb) {
        const int hp = u & 1, ci = (u >> 1) % NCI, b = (u >> 1) / NCI, rb = row_base(b, ci);
        __syncthreads();
        ret_stage<true>(P, rb, hp, sm, tid, wid, lane);
        __syncthreads();
        const int hh = wid >> 2, dh = (wid >> 1) & 1, eh = wid & 1, h = 2 * hp + hh;
        const float lg2f = ret_lg(p, l, 0, h) * 1.4426950408889634f, lg2b = ret_lg(p, l, 1, h) * 1.4426950408889634f;
        const int voff = ((lane >> 4) & 1) * 32 + (lane & 3) * 8 + (4 * hi + ((lane & 15) >> 2)) * 64;
        const LAS char* Kb = sm + RT_K + hh * 16384 + dh * 4096 + voff; const LAS char* Vb = sm + RT_V + hh * 16384 + eh * 4096 + voff;
        f32x16 a0, a1;
#pragma unroll
        for (int r = 0; r < 16; ++r) { a0[r] = 0.f; a1[r] = 0.f; }
#pragma unroll
        for (int k8 = 0; k8 < 8; ++k8) { const int tt = k8 >> 2, sl = k8 & 3;
            const s16x4 klo = vtr(Kb + tt * 8192 + sl * 1024), khi = vtr(Kb + tt * 8192 + sl * 1024 + 512), vlo = vtr(Vb + tt * 8192 + sl * 1024), vhi = vtr(Vb + tt * 8192 + sl * 1024 + 512);
            const int mb = tt * 64 + sl * 16 + 4 * hi; float kf_[8], kb_[8];
#pragma unroll
            for (int j = 0; j < 8; ++j) { const int m = mb + (j < 4 ? j : j + 4); const float kv = bfs(j < 4 ? klo[j] : khi[j - 4]);
                kf_[j] = kv * __builtin_amdgcn_exp2f(lg2f * (float)(127 - m)); kb_[j] = kv * __builtin_amdgcn_exp2f(lg2b * (float)m); }
            const u32x4 af = {cvtpk_s(kf_[0], kf_[1]), cvtpk_s(kf_[2], kf_[3]), cvtpk_s(kf_[4], kf_[5]), cvtpk_s(kf_[6], kf_[7])};
            const u32x4 ab = {cvtpk_s(kb_[0], kb_[1]), cvtpk_s(kb_[2], kb_[3]), cvtpk_s(kb_[4], kb_[5]), cvtpk_s(kb_[6], kb_[7])};
            const bf16x8 vfr = {vlo[0], vlo[1], vlo[2], vlo[3], vhi[0], vhi[1], vhi[2], vhi[3]};
            a0 = __builtin_amdgcn_mfma_f32_32x32x16_bf16(__builtin_bit_cast(bf16x8, af), vfr, a0, 0, 0, 0);
            a1 = __builtin_amdgcn_mfma_f32_32x32x16_bf16(__builtin_bit_cast(bf16x8, ab), vfr, a1, 0, 0, 0); }
        float* of = RET + ((((size_t)0 * 2 + b) * NCI + ci) * 4 + h) * 4096 + eh * 32 + r32;
        float* ob = RET + ((((size_t)1 * 2 + b) * NCI + ci) * 4 + h) * 4096 + eh * 32 + r32;
#pragma unroll
        for (int r = 0; r < 16; ++r) { const int d = dh * 32 + crow(r, hi); of[d * 64] = a0[r]; ob[d * 64] = a1[r]; }
    }
}

constexpr int LR_UB = 0, LR_A = 18432, LR_B = 51200, LR_H = 83968;
template <int MODE>
__device__ __forceinline__ void ph_lru_chunk(const Params& p, int l, int bid, int nb, float* lds, int ci_lo) {
    char* ws = p.ws; const int tid = TIDX, lane = tid & 63, r32 = lane & 31, hi = lane >> 5, wid = __builtin_amdgcn_readfirstlane(tid >> 6);
    const bf16_t* P = (const bf16_t*)(ws + OFF_P);
    float* LA = (float*)(ws + OFF_LRU); float* LB = LA + 2 * 2 * NCI * 256; float* LC = LB + 2 * 2 * NCI * 256;
    bf16_t* O = (bf16_t*)(ws + OFF_ACT);
    LAS char* sm = (LAS char*)lds;
    const int hb = bid & 3, tt = wid >> 1, jt = wid & 1, jcol = jt * 32 + r32, ch = hb * 64 + jcol;
    bf16x8 wfr[2][2][4]; float bia[2][2], spl[2];
#pragma unroll
    for (int dir = 0; dir < 2; ++dir) {
#pragma unroll
        for (int gt = 0; gt < 2; ++gt) { const float* W = (gt == 0 ? p.lru_wa : p.lru_wx) + (((size_t)(l * 2 + dir) * 4 + hb) * 64) * 64 + jcol;
#pragma unroll
            for (int ks = 0; ks < 4; ++ks) { const float* wp = W + (16 * ks + 8 * hi) * 64;
                const u32x4 w4 = {cvtpk_s(wp[0], wp[64]), cvtpk_s(wp[128], wp[192]), cvtpk_s(wp[256], wp[320]), cvtpk_s(wp[384], wp[448])};
                wfr[dir][gt][ks] = __builtin_bit_cast(bf16x8, w4); }
            bia[dir][gt] = (gt == 0 ? p.lru_ba : p.lru_bx)[(l * 2 + dir) * 256 + ch]; }
        spl[dir] = -8.0f * softplusf_(-p.lru_lam[(l * 2 + dir) * 256 + ch]); }
    const int nci = NCI - ci_lo, npair = 2 * nci;
    for (int pi = bid >> 2; pi < npair; pi += nb >> 2) {
        const int ci = ci_lo + pi % nci, b = pi / nci, rb = row_base(b, ci);
        const int seg_lo = ci < 2 ? NLAT + b * NCTX : b * NSEQ, seg_hi = ci < 2 ? seg_lo + NCTX : seg_lo + NSEQ;
        __syncthreads();
#pragma unroll
        for (int it = 0; it < 2; ++it) { const int item = it * 512 + tid, t = item >> 3, c8 = (item & 7) * 8, c0 = hb * 64 + c8;
            float acc[8];
            { const f32x4 b0 = *(const f32x4*)(p.conv_b + l * 256 + c0), b1 = *(const f32x4*)(p.conv_b + l * 256 + c0 + 4);
              acc[0] = b0[0]; acc[1] = b0[1]; acc[2] = b0[2]; acc[3] = b0[3]; acc[4] = b1[0]; acc[5] = b1[1]; acc[6] = b1[2]; acc[7] = b1[3]; }
#pragma unroll
            for (int k = 0; k < 4; ++k) { const int rr = rb + t - 1 + k;
                if (rr >= seg_lo && rr < seg_hi) { const bf16x8 xv = *(const bf16x8*)(P + (size_t)rr * DIN + C_LX + c0);
                    const f32x4 w0 = *(const f32x4*)(p.conv_w + (l * 4 + k) * 256 + c0), w1 = *(const f32x4*)(p.conv_w + (l * 4 + k) * 256 + c0 + 4);
                    acc[0] += w0[0] * bfs(xv[0]); acc[1] += w0[1] * bfs(xv[1]); acc[2] += w0[2] * bfs(xv[2]); acc[3] += w0[3] * bfs(xv[3]);
                    acc[4] += w1[0] * bfs(xv[4]); acc[5] += w1[1] * bfs(xv[5]); acc[6] += w1[2] * bfs(xv[6]); acc[7] += w1[3] * bfs(xv[7]); } }
            const u32x4 w = {cvtpk_s(acc[0], acc[1]), cvtpk_s(acc[2], acc[3]), cvtpk_s(acc[4], acc[5]), cvtpk_s(acc[6], acc[7])};
            *(LAS u32x4*)(sm + LR_UB + t * 144 + c8 * 2) = w; }
        __syncthreads();
        bf16x8 ua[4];
#pragma unroll
        for (int ks = 0; ks < 4; ++ks) ua[ks] = *(const LAS bf16x8*)(sm + LR_UB + (tt * 32 + r32) * 144 + (16 * ks + 8 * hi) * 2);
#pragma unroll
        for (int dir = 0; dir < 2; ++dir) {
            f32x16 ga, gx;
#pragma unroll
            for (int r = 0; r < 16; ++r) { ga[r] = bia[dir][0]; gx[r] = bia[dir][1]; }
#pragma unroll
            for (int ks = 0; ks < 4; ++ks) { ga = __builtin_amdgcn_mfma_f32_32x32x16_bf16(ua[ks], wfr[dir][0][ks], ga, 0, 0, 0); gx = __builtin_amdgcn_mfma_f32_32x32x16_bf16(ua[ks], wfr[dir][1][ks], gx, 0, 0, 0); }
#pragma unroll
            for (int r = 0; r < 16; ++r) { const int t = tt * 32 + crow(r, hi);
                const float rg = __builtin_amdgcn_rcpf(1.0f + __expf(-ga[r])), ig = __builtin_amdgcn_rcpf(1.0f + __expf(-gx[r]));
                const float a = __expf(spl[dir] * rg);
                const float uu = __uint_as_float(((unsigned)*(const LAS unsigned short*)(sm + LR_UB + t * 144 + jcol * 2)) << 16);
                *(LAS float*)(sm + LR_A + (t * 64 + jcol) * 4) = a;
                *(LAS float*)(sm + LR_B + (t * 64 + jcol) * 4) = sqrtf(fmaxf(1.0f - a * a, 0.f)) * (ig * uu); }
            __syncthreads();
            if (wid == 0) {
                const size_t cidx = (((size_t)dir * 2 + b) * NCI + ci) * 256 + hb * 64 + lane;
                float h = MODE == 3 ? LC[cidx] : 0.f, ap = 1.f;
                const LAS float* as_ = (const LAS float*)(sm + LR_A) + lane; const LAS float* bs_ = (const LAS float*)(sm + LR_B) + lane; LAS float* hs = (LAS float*)(sm + LR_H) + lane;
#pragma unroll 1
                for (int t0 = 0; t0 < 128; t0 += 16) {
                    float av[16], bv[16], hv[16];
#pragma unroll
                    for (int k = 0; k < 16; ++k) { const int t = dir == 0 ? t0 + k : 127 - t0 - k; av[k] = as_[t * 64]; bv[k] = bs_[t * 64]; if (MODE == 3 && dir == 1) hv[k] = hs[t * 64]; }
#pragma unroll
                    for (int k = 0; k < 16; ++k) { const int t = dir == 0 ? t0 + k : 127 - t0 - k; h = av[k] * h + bv[k]; ap *= av[k];
                        if (MODE == 3) hs[t * 64] = dir == 0 ? h : hv[k] + h; }
                }
                if (MODE == 1) { LA[cidx] = ap; LB[cidx] = h; }
            }
            __syncthreads();
        }
        if (MODE == 3) {
#pragma unroll
            for (int it = 0; it < 2; ++it) { const int item = it * 512 + tid, t = item >> 3, c8 = (item & 7) * 8, c0 = hb * 64 + c8;
                const f32x4 h0 = *(const LAS f32x4*)(sm + LR_H + (t * 64 + c8) * 4), h1 = *(const LAS f32x4*)(sm + LR_H + (t * 64 + c8 + 4) * 4);
                const bf16x8 yv = *(const bf16x8*)(P + (size_t)(rb + t) * DIN + C_LY + c0);
                const u32x4 w = {cvtpk_s(h0[0] * gelu_tanh(bfs(yv[0])), h0[1] * gelu_tanh(bfs(yv[1]))), cvtpk_s(h0[2] * gelu_tanh(bfs(yv[2])), h0[3] * gelu_tanh(bfs(yv[3]))),
                                 cvtpk_s(h1[0] * gelu_tanh(bfs(yv[4])), h1[1] * gelu_tanh(bfs(yv[5]))), cvtpk_s(h1[2] * gelu_tanh(bfs(yv[6])), h1[3] * gelu_tanh(bfs(yv[7])))};
                *(u32x4*)(O + (size_t)(rb + t) * DM + 768 + c0) = w; }
        }
    }
}

__device__ __forceinline__ int scan_ci(int dir, int s) { return dir == 0 ? s : (s == 0 ? 1 : (s == 1 ? 0 : NCI + 1 - s)); }
__device__ __forceinline__ void ph_scan2(const Params& p, int l, int bid, int nb) {
    char* ws = p.ws; const int gt = bid * 512 + TIDX, gs = nb * 512;
    float* RET = (float*)(ws + OFF_RET);
    for (int i = gt; i < 2 * 2 * 4 * 4096; i += gs) {
        const int de = i & 4095, h = (i >> 12) & 3, b = (i >> 14) & 1, dir = i >> 15;
        const float decay = expf(ret_lg(p, l, dir, h) * 128.0f); float S = 0.f;
        float* base = RET + (((size_t)dir * 2 + b) * NCI * 4 + h) * 4096 + de;
        for (int s0 = 0; s0 < NCI; s0 += 13) {
            float uu[13];
#pragma unroll
            for (int j = 0; j < 13; ++j) uu[j] = base[(size_t)scan_ci(dir, s0 + j) * 4 * 4096];
#pragma unroll
            for (int j = 0; j < 13; ++j) { base[(size_t)scan_ci(dir, s0 + j) * 4 * 4096] = S; S = decay * S + uu[j]; }
        }
    }
    float* LA = (float*)(ws + OFF_LRU); float* LB = LA + 2 * 2 * NCI * 256; float* LC = LB + 2 * 2 * NCI * 256;
    for (int i = gt; i < 2 * 2 * 256; i += gs) {
        const int ch = i & 255, b = (i >> 8) & 1, dir = i >> 9; float h = 0.f;
        const size_t base = ((size_t)dir * 2 + b) * NCI * 256 + ch;
        for (int s0 = 0; s0 < NCI; s0 += 13) {
            float aa[13], bb[13];
#pragma unroll
            for (int j = 0; j < 13; ++j) { const size_t idx = base + (size_t)scan_ci(dir, s0 + j) * 256; aa[j] = LA[idx]; bb[j] = LB[idx]; }
#pragma unroll
            for (int j = 0; j < 13; ++j) { LC[base + (size_t)scan_ci(dir, s0 + j) * 256] = h; h = aa[j] * h + bb[j]; }
        }
    }
}

__device__ __forceinline__ bf16x8 scale_frag(bf16x8 q, float s) {
    u32x4 w;
#pragma unroll
    for (int i = 0; i < 4; ++i) w[i] = cvtpk_s(bfs(q[2 * i]) * s, bfs(q[2 * i + 1]) * s);
    return __builtin_bit_cast(bf16x8, w);
}
__device__ __forceinline__ void ph_ret_out(const Params& p, int l, int bid, int nb, float* lds, int ci_lo) {
    char* ws = p.ws; const int tid = TIDX, lane = tid & 63, r32 = lane & 31, hi = lane >> 5, wid = __builtin_amdgcn_readfirstlane(tid >> 6);
    const bf16_t* P = (const bf16_t*)(ws + OFF_P); const float* RET = (const float*)(ws + OFF_RET); bf16_t* O = (bf16_t*)(ws + OFF_ACT);
    LAS char* sm = (LAS char*)lds;
    const int nci = NCI - ci_lo;
    for (int u = bid; u < 2 * nci * 2; u += nb) {
        const int hp = u & 1, ci = ci_lo + (u >> 1) % nci, b = (u >> 1) / nci, rb = row_base(b, ci);
        __syncthreads();
        ret_stage<false>(P, rb, hp, sm, tid, wid, lane);
        __syncthreads();
        const int hh = wid >> 2, qt = wid & 3, h = 2 * hp + hh; int n = qt * 32 + r32;
        asm volatile("" : "+v"(n));
        const float lg2f = ret_lg(p, l, 0, h) * 1.4426950408889634f, lg2b = ret_lg(p, l, 1, h) * 1.4426950408889634f;
        bf16x8 qr[4];
        { const bf16_t* qp = P + (size_t)(rb + n) * DIN + C_RQ + h * 64 + hi * 8;
#pragma unroll
          for (int ks = 0; ks < 4; ++ks) qr[ks] = *(const bf16x8*)(qp + ks * 16); }
        f32x16 o[2];
#pragma unroll
        for (int r = 0; r < 16; ++r) { o[0][r] = 0.f; o[1][r] = 0.f; }
#pragma unroll
        for (int dir = 0; dir < 2; ++dir) {
            const float xi = dir == 0 ? __builtin_amdgcn_exp2f(lg2f * (float)(n + 1)) : __builtin_amdgcn_exp2f(lg2b * (float)(128 - n));
            const float* Sb = RET + ((((size_t)dir * 2 + b) * NCI + ci) * 4 + h) * 4096 + hi * 8 * 64 + r32;
#pragma unroll
            for (int ks = 0; ks < 4; ++ks) { const bf16x8 qx = scale_frag(qr[ks], xi);
#pragma unroll
                for (int eh = 0; eh < 2; ++eh) { const float* sp = Sb + ks * 16 * 64 + eh * 32;
                    const u32x4 sw = {cvtpk_s(sp[0], sp[64]), cvtpk_s(sp[128], sp[192]), cvtpk_s(sp[256], sp[320]), cvtpk_s(sp[384], sp[448])};
                    o[eh] = __builtin_amdgcn_mfma_f32_32x32x16_bf16(qx, __builtin_bit_cast(bf16x8, sw), o[eh], 0, 0, 0); } }
        }
        const LAS char* Kb = sm + RT_K + hh * 16384 + hi * 1024 + r32 * 16;
        const LAS char* Vb = sm + RT_V + hh * 16384 + ((lane >> 4) & 1) * 32 + (lane & 3) * 8 + (4 * hi + ((lane & 15) >> 2)) * 64;
        u32x4 pw[8];
#pragma unroll
        for (int kb = 0; kb < 4; ++kb) { const int tt = kb >> 1, kbl = kb & 1;
            f32x16 c;
#pragma unroll
            for (int r = 0; r < 16; ++r) c[r] = 0.f;
#pragma unroll
            for (int ks = 0; ks < 4; ++ks) c = __builtin_amdgcn_mfma_f32_32x32x16_bf16(*(const LAS bf16x8*)(Kb + tt * 8192 + ks * 2048 + kbl * 512), qr[ks], c, 0, 0, 0);
#pragma unroll
            for (int r = 0; r < 16; ++r) { const int dlt = n - (kb * 32 + crow(r, hi)); const float fd = (float)dlt;
                const float w = __builtin_amdgcn_exp2f(fd * (dlt > 0 ? lg2f : -lg2b));
                c[r] *= dlt == 0 ? 2.0f : w; }
            pw[2 * kb] = (u32x4){cvtpk_s(c[0], c[1]), cvtpk_s(c[2], c[3]), cvtpk_s(c[4], c[5]), cvtpk_s(c[6], c[7])};
            pw[2 * kb + 1] = (u32x4){cvtpk_s(c[8], c[9]), cvtpk_s(c[10], c[11]), cvtpk_s(c[12], c[13]), cvtpk_s(c[14], c[15])}; }
#pragma unroll
        for (int k8 = 0; k8 < 8; ++k8) { const int tt = k8 >> 2, sl = k8 & 3;
#pragma unroll
            for (int eh = 0; eh < 2; ++eh) { const s16x4 vlo = vtr(Vb + tt * 8192 + eh * 4096 + sl * 1024), vhi = vtr(Vb + tt * 8192 + eh * 4096 + sl * 1024 + 512);
                o[eh] = __builtin_amdgcn_mfma_f32_32x32x16_bf16(__builtin_bit_cast(bf16x8, pw[k8]), (bf16x8){vlo[0], vlo[1], vlo[2], vlo[3], vhi[0], vhi[1], vhi[2], vhi[3]}, o[eh], 0, 0, 0); } }
        LAS float* stg = (LAS float*)(sm + RT_ST) + wid * 2048;
#pragma unroll
        for (int r = 0; r < 16; ++r) { const int q = crow(r, hi); stg[q * 64 + r32] = o[0][r]; stg[q * 64 + 32 + r32] = o[1][r]; }
        const float* gn = p.ret_gn + l * 256 + h * 64 + (lane & 7) * 8;
        const f32x4 g0 = *(const f32x4*)gn, g1 = *(const f32x4*)(gn + 4);
#pragma unroll
        for (int i = 0; i < 4; ++i) { const int row = i * 8 + (lane >> 3), ch = lane & 7;
            const f32x4 v0 = *(const LAS f32x4*)(stg + row * 64 + ch * 8), v1 = *(const LAS f32x4*)(stg + row * 64 + ch * 8 + 4);
            float ss = v0[0] * v0[0] + v0[1] * v0[1] + v0[2] * v0[2] + v0[3] * v0[3] + v1[0] * v1[0] + v1[1] * v1[1] + v1[2] * v1[2] + v1[3] * v1[3];
            ss += __shfl_xor(ss, 1); ss += __shfl_xor(ss, 2); ss += __shfl_xor(ss, 4);
            const float rn = rsqrtf(ss * (1.0f / 64.0f) + 1e-6f);
            const size_t grow = (size_t)(rb + qt * 32 + row);
            const bf16x8 gg = *(const bf16x8*)(P + grow * DIN + C_RG + h * 64 + ch * 8);
            u32x4 w; w.x = cvtpk_s(v0[0] * rn * g0[0] * fast_silu(bfs(gg[0])), v0[1] * rn * g0[1] * fast_silu(bfs(gg[1]))); w.y = cvtpk_s(v0[2] * rn * g0[2] * fast_silu(bfs(gg[2])), v0[3] * rn * g0[3] * fast_silu(bfs(gg[3])));
            w.z = cvtpk_s(v1[0] * rn * g1[0] * fast_silu(bfs(gg[4])), v1[1] * rn * g1[1] * fast_silu(bfs(gg[5]))); w.w = cvtpk_s(v1[2] * rn * g1[2] * fast_silu(bfs(gg[6])), v1[3] * rn * g1[3] * fast_silu(bfs(gg[7])));
            *(u32x4*)(O + grow * DM + 256 + h * 64 + ch * 8) = w; }
    }
}

__device__ __forceinline__ float diff_lambda_val(const Params& p, int l, float lam_init) {
    const float* lv = p.diff_lam + l * 128; float s1 = 0.f, s2 = 0.f;
    for (int i = 0; i < 32; ++i) { s1 += lv[i] * lv[32 + i]; s2 += lv[64 + i] * lv[96 + i]; }
    return expf(s1) - expf(s2) + lam_init;
}
__device__ __forceinline__ float max3f(float a, float b, float c) { return __builtin_fmaxf(__builtin_fmaxf(a, b), c); }
__device__ __forceinline__ float xhalf_max(float m) { auto rr = __builtin_amdgcn_permlane32_swap(__float_as_uint(m), __float_as_uint(m), false, false); return fmaxf(__uint_as_float(rr[0]), __uint_as_float(rr[1])); }
__device__ __forceinline__ float xhalf_sum(float m) { auto rr = __builtin_amdgcn_permlane32_swap(__float_as_uint(m), __float_as_uint(m), false, false); return __uint_as_float(rr[0]) + __uint_as_float(rr[1]); }

constexpr int DF_K = 0, DF_V = 16384, DF_WS = 32768, DF_ST = 34816;
constexpr int DD_K = 0, DD_V = 32768, DD_WS = 65536, DD_ST = 67584;
__device__ __forceinline__ void glds16(const void* gsrc, unsigned lds_dst) { unsigned keep;
    asm volatile("s_mov_b32 %0, m0\n\ts_mov_b32 m0, %2\n\ts_nop 0\n\tglobal_load_lds_dwordx4 %1, off\n\ts_mov_b32 m0, %0" : "=&s"(keep) : "v"(gsrc), "s"(lds_dst) : "memory"); }
template <bool SAFE>
__device__ __forceinline__ void diff_tiles(const bf16_t* P, int b, int h, int t_lo, LAS char* sm, int tid, int wid, int lane, const bf16x8 (&qr)[4], f32x16 (&o)[2][2], float (&lsum)[2]) {
    const int r32 = lane & 31, hi = lane >> 5, t_hi = 260;
    LAS float* wsf = (LAS float*)(sm + DD_WS) + wid * 64;
    const bf16_t* kcol = P + C_DK + h * 64 + wid * 8;
    const bf16_t* vcol = P + C_DV + h * 64 + (wid >> 2) * 32 + (lane & 3) * 8;
    const int krow_in = lane, vrow_in = 16 * (wid & 3) + (lane >> 2);
#define TILE_ROW0(t) ((t) < 256 ? b * NSEQ + (t) * 64 : NLAT + b * NCTX + ((t) - 256) * 64)
    float mhat[2];
#pragma unroll
    for (int m = 0; m < 2; ++m) { mhat[m] = 0.f; lsum[m] = 0.f;
#pragma unroll
        for (int r = 0; r < 16; ++r) { o[m][0][r] = 0.f; o[m][1][r] = 0.f; } }
    const unsigned lds0 = (unsigned)(size_t)sm + (unsigned)wid * 1024u;
#define DMA_TILE(t) do { const int r0_ = TILE_ROW0(t); const unsigned sl_ = (unsigned)(((t) - t_lo) & 3) * 8192u; \
    glds16(kcol + (size_t)(r0_ + krow_in) * DIN, (unsigned)__builtin_amdgcn_readfirstlane(lds0 + DD_K + sl_)); glds16(vcol + (size_t)(r0_ + vrow_in) * DIN, (unsigned)__builtin_amdgcn_readfirstlane(lds0 + DD_V + sl_)); } while (0)
    asm volatile("s_waitcnt lgkmcnt(0)\n\ts_barrier" ::: "memory");
    DMA_TILE(t_lo); DMA_TILE(t_lo + 1); DMA_TILE(t_lo + 2);
    bool first = true;
    for (int t = t_lo; t < t_hi; ++t) {
        const int cur = (t - t_lo) & 3;
        if (t + 2 < t_hi) asm volatile("s_waitcnt vmcnt(4)\n\ts_barrier" ::: "memory");
        else if (t + 1 < t_hi) asm volatile("s_waitcnt vmcnt(2)\n\ts_barrier" ::: "memory");
        else asm volatile("s_waitcnt vmcnt(0)\n\ts_barrier" ::: "memory");
        if (t + 3 < t_hi) DMA_TILE(t + 3);
        const LAS char* kb = sm + DD_K + cur * 8192 + hi * 1024 + r32 * 16;
        const LAS char* vb = sm + DD_V + cur * 8192 + ((lane >> 4) & 1) * 32 + (lane & 3) * 8 + (4 * hi + ((lane & 15) >> 2)) * 64;
#pragma unroll
        for (int m = 0; m < 2; ++m) {
            bf16x8 kf[8];
#pragma unroll
            for (int j = 2 * m; j < 2 * m + 2; ++j) { kf[2 * j] = *(const LAS bf16x8*)(kb + j * 2048); kf[2 * j + 1] = *(const LAS bf16x8*)(kb + j * 2048 + 512); }
            f32x16 c0, c1;
            if (SAFE) { float nm = -mhat[m]; asm volatile("" : "+v"(nm));
#pragma unroll
                for (int r = 0; r < 16; ++r) { c0[r] = nm; c1[r] = nm; } }
            else {
#pragma unroll
                for (int r = 0; r < 16; ++r) { c0[r] = 0.f; c1[r] = 0.f; } }
            c0 = __builtin_amdgcn_mfma_f32_32x32x16_bf16(kf[4 * m + 0], qr[2 * m], c0, 0, 0, 0);
            c1 = __builtin_amdgcn_mfma_f32_32x32x16_bf16(kf[4 * m + 1], qr[2 * m], c1, 0, 0, 0);
            c0 = __builtin_amdgcn_mfma_f32_32x32x16_bf16(kf[4 * m + 2], qr[2 * m + 1], c0, 0, 0, 0);
            c1 = __builtin_amdgcn_mfma_f32_32x32x16_bf16(kf[4 * m + 3], qr[2 * m + 1], c1, 0, 0, 0);
            if (SAFE) {
                float ra = max3f(c0[0], c0[1], c1[0]), rb = max3f(c0[2], c0[3], c1[1]); ra = max3f(ra, c1[2], c1[3]);
#pragma unroll
                for (int r = 4; r < 16; r += 4) { ra = max3f(ra, c0[r], c0[r + 1]); rb = max3f(rb, c0[r + 2], c0[r + 3]); ra = max3f(ra, c1[r], c1[r + 1]); rb = max3f(rb, c1[r + 2], c1[r + 3]); }
                const float rm = xhalf_max(max3f(ra, rb, rb));
                if (__builtin_expect(first || __any(rm > 8.0f), 0)) {
                    float dl = first ? rm : fmaxf(rm, 0.f); asm volatile("; rebase" : "+v"(dl));
                    mhat[m] += dl;
#pragma unroll
                    for (int r = 0; r < 16; ++r) { c0[r] -= dl; c1[r] -= dl; }
                    asm volatile("" : "+v"(c0), "+v"(c1));
                    if (!first) {
                        const float f = __builtin_amdgcn_exp2f(-dl); lsum[m] *= f;
                        if (hi == 0) wsf[r32] = f;
#pragma unroll
                        for (int r = 0; r < 16; ++r) { const float fr_ = wsf[crow(r, hi)]; o[m][0][r] *= fr_; o[m][1][r] *= fr_; }
                    }
                }
            }
            float sacc = 0.f;
#pragma unroll
            for (int r = 0; r < 16; ++r) { c0[r] = __builtin_amdgcn_exp2f(c0[r]); c1[r] = __builtin_amdgcn_exp2f(c1[r]); sacc += c0[r] + c1[r]; }
            lsum[m] += sacc;
            u32x4 pw[4];
#pragma unroll
            for (int k = 0; k < 2; ++k) {
                pw[k] = (u32x4){cvtpk_s(c0[8 * k + 0], c0[8 * k + 1]), cvtpk_s(c0[8 * k + 2], c0[8 * k + 3]), cvtpk_s(c0[8 * k + 4], c0[8 * k + 5]), cvtpk_s(c0[8 * k + 6], c0[8 * k + 7])};
                pw[2 + k] = (u32x4){cvtpk_s(c1[8 * k + 0], c1[8 * k + 1]), cvtpk_s(c1[8 * k + 2], c1[8 * k + 3]), cvtpk_s(c1[8 * k + 4], c1[8 * k + 5]), cvtpk_s(c1[8 * k + 6], c1[8 * k + 7])}; }
            if (!SAFE) __builtin_amdgcn_sched_barrier(0);
#pragma unroll
            for (int dh = 0; dh < 2; ++dh) {
#pragma unroll
                for (int k = 0; k < 4; ++k) { const s16x4 lo = vtr(vb + dh * 4096 + k * 1024), hh = vtr(vb + dh * 4096 + k * 1024 + 512);
                    o[m][dh] = __builtin_amdgcn_mfma_f32_32x32x16_bf16(__builtin_bit_cast(bf16x8, pw[k]), (bf16x8){lo[0], lo[1], lo[2], lo[3], hh[0], hh[1], hh[2], hh[3]}, o[m][dh], 0, 0, 0); } }
            if (!SAFE) __builtin_amdgcn_sched_barrier(0);
        }
        first = false;
        asm volatile("s_waitcnt lgkmcnt(0)" ::: "memory");
    }
#undef TILE_ROW0
#undef DMA_TILE
}

constexpr int DQ_K = 0, DQ_V = 40960, DQ_WS = 81920, DQ_ST = 0;
__device__ __forceinline__ void diff_tiles_fast(const bf16_t* P, int b, int h, int t_lo, LAS char* sm, int tid, int wid, int lane, const bf16x8 (&qr)[4], f32x16 (&o)[2][2], float (&lsum)[2]) {
    const int r32 = lane & 31, hi = lane >> 5, NT = 260 - t_lo;
    const bf16_t* kcol = P + C_DK + h * 64 + wid * 8;
    const bf16_t* vcol = P + C_DV + h * 64 + (wid >> 2) * 32 + (lane & 3) * 8;
    const int krow_in = lane, vrow_in = 16 * (wid & 3) + (lane >> 2);
    const unsigned lds0 = (unsigned)(size_t)sm + (unsigned)wid * 1024u;
#define TILE_ROW0(i) ((t_lo + (i)) < 256 ? b * NSEQ + (t_lo + (i)) * 64 : NLAT + b * NCTX + (t_lo + (i) - 256) * 64)
#define DMA_TILE(i, slot) do { const int r0_ = TILE_ROW0(i); const unsigned sl_ = (unsigned)(slot) * 8192u; \
    glds16(kcol + (size_t)(r0_ + krow_in) * DIN, (unsigned)__builtin_amdgcn_readfirstlane(lds0 + DQ_K + sl_)); glds16(vcol + (size_t)(r0_ + vrow_in) * DIN, (unsigned)__builtin_amdgcn_readfirstlane(lds0 + DQ_V + sl_)); } while (0)
#pragma unroll
    for (int m = 0; m < 2; ++m) { lsum[m] = 0.f;
#pragma unroll
        for (int r = 0; r < 16; ++r) { o[m][0][r] = 0.f; o[m][1][r] = 0.f; } }
    asm volatile("s_waitcnt lgkmcnt(0)\n\ts_barrier" ::: "memory");
    DMA_TILE(0, 0); DMA_TILE(1, 1); DMA_TILE(2, 2);
    asm volatile("s_waitcnt vmcnt(2)\n\ts_barrier" ::: "memory");
    const int kfo = hi * 1024 + r32 * 16, vfo = ((lane >> 4) & 1) * 32 + (lane & 3) * 8 + (4 * hi + ((lane & 15) >> 2)) * 64;
    f32x16 cA0, cA1, cB0, cB1; u32x4 pwp[4], pwq[4];
#pragma unroll
    for (int k = 0; k < 4; ++k) pwp[k] = (u32x4){0u, 0u, 0u, 0u};
    {   const LAS char* kb_ = sm + DQ_K + kfo;
#pragma unroll
        for (int r = 0; r < 16; ++r) { cA0[r] = 0.f; cA1[r] = 0.f; }
#pragma unroll
        for (int j = 0; j < 2; ++j) { cA0 = __builtin_amdgcn_mfma_f32_32x32x16_bf16(*(const LAS bf16x8*)(kb_ + j * 2048), qr[j], cA0, 0, 0, 0);
                                      cA1 = __builtin_amdgcn_mfma_f32_32x32x16_bf16(*(const LAS bf16x8*)(kb_ + j * 2048 + 512), qr[j], cA1, 0, 0, 0); } }
#define STEPF(CC0, CC1, PWC, MCUR, PWP, MPREV, VS, CN0, CN1, KS, MNEXT) do { \
    const LAS char* kb_ = sm + DQ_K + (KS) * 8192 + kfo + (MNEXT) * 4096; const LAS char* vb_ = sm + DQ_V + (VS) * 8192 + vfo; \
    const bf16x8 kq0_ = *(const LAS bf16x8*)(kb_), kq1_ = *(const LAS bf16x8*)(kb_ + 512), kq2_ = *(const LAS bf16x8*)(kb_ + 2048), kq3_ = *(const LAS bf16x8*)(kb_ + 2560); \
    float sacc_ = 0.f; \
    _Pragma("unroll") for (int r_ = 0; r_ < 16; ++r_) { CN0[r_] = 0.f; CN1[r_] = 0.f; } \
    bf16x8 vq_[8]; \
    _Pragma("unroll") for (int g_ = 0; g_ < 4; ++g_) { const s16x4 l0_ = vtr(vb_ + g_ * 1024), h0_ = vtr(vb_ + g_ * 1024 + 512), l1_ = vtr(vb_ + 4096 + g_ * 1024), h1_ = vtr(vb_ + 4096 + g_ * 1024 + 512); \
        vq_[g_] = (bf16x8){l0_[0], l0_[1], l0_[2], l0_[3], h0_[0], h0_[1], h0_[2], h0_[3]}; vq_[4 + g_] = (bf16x8){l1_[0], l1_[1], l1_[2], l1_[3], h1_[0], h1_[1], h1_[2], h1_[3]}; } \
    asm volatile("s_waitcnt lgkmcnt(0)" ::: "memory"); __builtin_amdgcn_sched_barrier(0);        \
    _Pragma("unroll") for (int g_ = 0; g_ < 4; ++g_) { \
        o[MPREV][0] = __builtin_amdgcn_mfma_f32_32x32x16_bf16(__builtin_bit_cast(bf16x8, PWP[g_]), vq_[g_], o[MPREV][0], 0, 0, 0); \
        o[MPREV][1] = __builtin_amdgcn_mfma_f32_32x32x16_bf16(__builtin_bit_cast(bf16x8, PWP[g_]), vq_[4 + g_], o[MPREV][1], 0, 0, 0); \
        if (g_ == 0) CN0 = __builtin_amdgcn_mfma_f32_32x32x16_bf16(kq0_, qr[2 * (MNEXT)], CN0, 0, 0, 0); \
        if (g_ == 1) CN1 = __builtin_amdgcn_mfma_f32_32x32x16_bf16(kq1_, qr[2 * (MNEXT)], CN1, 0, 0, 0); \
        if (g_ == 2) CN0 = __builtin_amdgcn_mfma_f32_32x32x16_bf16(kq2_, qr[2 * (MNEXT) + 1], CN0, 0, 0, 0); \
        if (g_ == 3) CN1 = __builtin_amdgcn_mfma_f32_32x32x16_bf16(kq3_, qr[2 * (MNEXT) + 1], CN1, 0, 0, 0); \
        _Pragma("unroll") for (int r_ = 4 * g_; r_ < 4 * g_ + 4; ++r_) { CC0[r_] = __builtin_amdgcn_exp2f(CC0[r_]); CC1[r_] = __builtin_amdgcn_exp2f(CC1[r_]); sacc_ += CC0[r_] + CC1[r_]; } \
        if (g_ == 1) { PWC[0] = (u32x4){cvtpk_s(CC0[0], CC0[1]), cvtpk_s(CC0[2], CC0[3]), cvtpk_s(CC0[4], CC0[5]), cvtpk_s(CC0[6], CC0[7])}; \
                       PWC[2] = (u32x4){cvtpk_s(CC1[0], CC1[1]), cvtpk_s(CC1[2], CC1[3]), cvtpk_s(CC1[4], CC1[5]), cvtpk_s(CC1[6], CC1[7])}; } \
        if (g_ == 3) { PWC[1] = (u32x4){cvtpk_s(CC0[8], CC0[9]), cvtpk_s(CC0[10], CC0[11]), cvtpk_s(CC0[12], CC0[13]), cvtpk_s(CC0[14], CC0[15])}; \
                       PWC[3] = (u32x4){cvtpk_s(CC1[8], CC1[9]), cvtpk_s(CC1[10], CC1[11]), cvtpk_s(CC1[12], CC1[13]), cvtpk_s(CC1[14], CC1[15])}; } } \
    lsum[MCUR] += sacc_; \
    _Pragma("unroll") for (int g_ = 0; g_ < 4; ++g_) { \
        __builtin_amdgcn_sched_group_barrier(0x008, 1, 0); __builtin_amdgcn_sched_group_barrier(0x400, 3, 0); \
        __builtin_amdgcn_sched_group_barrier(0x008, 1, 0); __builtin_amdgcn_sched_group_barrier(0x400, 3, 0); \
        __builtin_amdgcn_sched_group_barrier(0x008, 1, 0); __builtin_amdgcn_sched_group_barrier(0x400, 2, 0); } \
    __builtin_amdgcn_sched_barrier(0); } while (0)
    int s0 = 0, s1 = 1, s3 = 3, sp = 0;
    for (int t = 0; t < NT; ++t) {
        if (t + 2 < NT) asm volatile("s_waitcnt vmcnt(2)\n\ts_barrier" ::: "memory"); else asm volatile("s_waitcnt vmcnt(0)\n\ts_barrier" ::: "memory");
        if (t + 3 < NT) DMA_TILE(t + 3, s3);
        STEPF(cA0, cA1, pwq, 0, pwp, 1, sp, cB0, cB1, s0, 1);
        STEPF(cB0, cB1, pwp, 1, pwq, 0, s0, cA0, cA1, s1, 0);
        asm volatile("s_waitcnt lgkmcnt(0)" ::: "memory");
        sp = s0; s0 = s1; s1 = (s1 == 4) ? 0 : s1 + 1; s3 = (s3 == 4) ? 0 : s3 + 1;
    }
    {   const LAS char* vb_ = sm + DQ_V + sp * 8192 + vfo;
#pragma unroll
        for (int g_ = 0; g_ < 4; ++g_) { const s16x4 l0_ = vtr(vb_ + g_ * 1024), h0_ = vtr(vb_ + g_ * 1024 + 512), l1_ = vtr(vb_ + 4096 + g_ * 1024), h1_ = vtr(vb_ + 4096 + g_ * 1024 + 512);
            o[1][0] = __builtin_amdgcn_mfma_f32_32x32x16_bf16(__builtin_bit_cast(bf16x8, pwp[g_]), (bf16x8){l0_[0], l0_[1], l0_[2], l0_[3], h0_[0], h0_[1], h0_[2], h0_[3]}, o[1][0], 0, 0, 0);
            o[1][1] = __builtin_amdgcn_mfma_f32_32x32x16_bf16(__builtin_bit_cast(bf16x8, pwp[g_]), (bf16x8){l1_[0], l1_[1], l1_[2], l1_[3], h1_[0], h1_[1], h1_[2], h1_[3]}, o[1][1], 0, 0, 0); } }
    asm volatile("s_waitcnt lgkmcnt(0)" ::: "memory");
#undef TILE_ROW0
#undef DMA_TILE
#undef STEPF
}

template <bool SAFE>
__device__ __forceinline__ bool diff_unit(const Params& p, int l, float lam_init, float lam, int u, float* lds) {
    char* ws = p.ws; const int tid = TIDX, lane = tid & 63, r32 = lane & 31, hi = lane >> 5, wid = __builtin_amdgcn_readfirstlane(tid >> 6);
    const bf16_t* P = (const bf16_t*)(ws + OFF_P); bf16_t* O = (bf16_t*)(ws + OFF_ACT);
    LAS char* sm = (LAS char*)lds;
    int b, h, qrow0, t_lo;
    if (u < 512) { b = u >> 8; h = (u >> 6) & 3; qrow0 = b * NSEQ + (u & 63) * 256; t_lo = 0; }
    else { const int v = u - 512; b = v >> 2; h = v & 3; qrow0 = NLAT + b * NCTX; t_lo = 256; }
    bf16x8 qr[4];
    { const bf16_t* qp = P + (size_t)(qrow0 + wid * 32 + r32) * DIN + C_DQ + h * 64 + hi * 8;
#pragma unroll
      for (int d0 = 0; d0 < 4; ++d0) qr[d0] = *(const bf16x8*)(qp + d0 * 16); }
    f32x16 o[2][2]; float lsum[2];
    if (SAFE) diff_tiles<true>(P, b, h, t_lo, sm, tid, wid, lane, qr, o, lsum); else diff_tiles_fast(P, b, h, t_lo, sm, tid, wid, lane, qr, o, lsum);
    constexpr int WS_OFF = SAFE ? DD_WS : DQ_WS, ST_OFF = SAFE ? DD_ST : DQ_ST;
    const float l0 = xhalf_sum(lsum[0]), l1 = xhalf_sum(lsum[1]);
    if (!SAFE) {
        const bool bad = !(l0 > 7.9e-31f && l0 < 1.2e30f && l1 > 7.9e-31f && l1 < 1.2e30f);
        LAS unsigned* flg = (LAS unsigned*)(sm + WS_OFF + 2048);
        const unsigned anyb = __any(bad) ? 1u : 0u;
        if (lane == 0) flg[wid] = anyb;
        asm volatile("s_waitcnt lgkmcnt(0)\n\ts_barrier" ::: "memory");
        const unsigned allb = flg[0] | flg[1] | flg[2] | flg[3] | flg[4] | flg[5] | flg[6] | flg[7];
        if (__builtin_expect(allb != 0u, 0)) return true;
    }
    const float inv0 = 1.0f / l0, inv1 = lam / l1;
    int lane_e = TIDX & 63;
    { const int r32e = lane_e & 31, hie = lane_e >> 5;
    LAS float* wse = (LAS float*)(sm + WS_OFF) + wid * 64; LAS float* stge = (LAS float*)(sm + ST_OFF) + wid * 2048;
    if (hie == 0) { wse[r32e] = inv0; wse[32 + r32e] = inv1; }
#pragma unroll
    for (int r = 0; r < 16; ++r) { const int q = crow(r, hie); const float i0 = wse[q], i1 = wse[32 + q];
        stge[q * 64 + r32e] = o[0][0][r] * i0 - o[1][0][r] * i1; stge[q * 64 + 32 + r32e] = o[0][1][r] * i0 - o[1][1][r] * i1; } }
    LAS float* stg = (LAS float*)(sm + ST_OFF) + wid * 2048;
    const float* gn = p.diff_gn + l * 256 + h * 64 + (lane_e & 7) * 8;
    const f32x4 g0 = *(const f32x4*)gn, g1 = *(const f32x4*)(gn + 4);
#pragma unroll
    for (int i = 0; i < 4; ++i) { const int row = i * 8 + (lane_e >> 3), ch = lane_e & 7;
        const f32x4 v0 = *(const LAS f32x4*)(stg + row * 64 + ch * 8), v1 = *(const LAS f32x4*)(stg + row * 64 + ch * 8 + 4);
        float ss = v0[0] * v0[0] + v0[1] * v0[1] + v0[2] * v0[2] + v0[3] * v0[3] + v1[0] * v1[0] + v1[1] * v1[1] + v1[2] * v1[2] + v1[3] * v1[3];
        ss += __shfl_xor(ss, 1); ss += __shfl_xor(ss, 2); ss += __shfl_xor(ss, 4);
        const float rn = rsqrtf(ss * (1.0f / 64.0f) + 1e-6f) * (1.0f - lam_init);
        u32x4 w; w.x = cvtpk_s(v0[0] * rn * g0[0], v0[1] * rn * g0[1]); w.y = cvtpk_s(v0[2] * rn * g0[2], v0[3] * rn * g0[3]);
        w.z = cvtpk_s(v1[0] * rn * g1[0], v1[1] * rn * g1[1]); w.w = cvtpk_s(v1[2] * rn * g1[2], v1[3] * rn * g1[3]);
        *(u32x4*)(O + (size_t)(qrow0 + wid * 32 + row) * DM + 512 + h * 64 + ch * 8) = w; }
    return false;
}
__device__ __forceinline__ void ph_diff(const Params& p, int l, bool need_ctx, float lam_init, int bid, int nb, float* lds) {
    const float lam = __int_as_float(__builtin_amdgcn_readfirstlane(__float_as_int(diff_lambda_val(p, l, lam_init))));
    const int nun = 512 + (need_ctx ? 8 : 0);
    unsigned redo = 0u; int idx = 0;
    for (int u = bid; u < nun; u += nb, ++idx) if (diff_unit<false>(p, l, lam_init, lam, u, lds)) redo |= 1u << idx;
    idx = 0;
    if (__builtin_expect(redo != 0u, 0))
        for (int u = bid; u < nun; u += nb, ++idx) if ((redo >> idx) & 1u) (void)diff_unit<true>(p, l, lam_init, lam, u, lds);
}

__device__ __forceinline__ void ph_swa(const Params& p, int l, bool need_ctx, int bid, int nb, float* lds) {
    char* ws = p.ws; const int tid = TIDX, lane = tid & 63, r32 = lane & 31, hi = lane >> 5, wid = __builtin_amdgcn_readfirstlane(tid >> 6);
    const bf16_t* P = (const bf16_t*)(ws + OFF_P); bf16_t* O = (bf16_t*)(ws + OFF_ACT);
    LAS char* sm = (LAS char*)lds;
    LAS float* wsf = (LAS float*)(sm + DD_WS) + wid * 64;
    const int nun = 512 + (need_ctx ? 8 : 0);
    for (int u = bid; u < nun; u += nb) {
        int b, h, qrow0, q0, tw_lo, nwin;
        if (u < 512) { b = u >> 8; h = (u >> 6) & 3; q0 = (u & 63) * 256; qrow0 = b * NSEQ + q0; const int lo = q0 - 128 < 0 ? 0 : q0 - 128, hi_ = q0 + 384 > NSEQ ? NSEQ : q0 + 384; tw_lo = lo >> 6; nwin = (hi_ - lo) >> 6; }
        else { const int v = u - 512; b = v >> 2; h = v & 3; q0 = 0; qrow0 = NLAT + b * NCTX; tw_lo = 0; nwin = 0; }
        const int g = h >> 1, nt = nwin + 4;
        const bf16_t* kcol = P + C_AK + g * 64 + wid * 8;
        const bf16_t* vcol = P + C_AV + g * 64 + (wid >> 2) * 32 + (lane & 3) * 8;
        const int krow_in = lane, vrow_in = 16 * (wid & 3) + (lane >> 2);
#define SWA_ROW0(i) ((i) < nwin ? b * NSEQ + (tw_lo + (i)) * 64 : NLAT + b * NCTX + ((i) - nwin) * 64)
        bf16x8 qr[4];
        { const bf16_t* qp = P + (size_t)(qrow0 + wid * 32 + r32) * DIN + C_AQ + h * 64 + hi * 8;
#pragma unroll
          for (int d0 = 0; d0 < 4; ++d0) qr[d0] = *(const bf16x8*)(qp + d0 * 16); }
        f32x16 o[2]; float mhat = p.sink[l * 4 + h] * 1.4426950408889634f, lsum = hi == 0 ? 1.0f : 0.0f;
#pragma unroll
        for (int r = 0; r < 16; ++r) { o[0][r] = 0.f; o[1][r] = 0.f; }
        const int qw = q0 + wid * 32, qpos = qw + r32;
        const unsigned lds0 = (unsigned)(size_t)sm + (unsigned)wid * 1024u;
#define DMA_TILE(i) do { const int r0_ = SWA_ROW0(i); const unsigned sl_ = (unsigned)((i) & 3) * 8192u; \
        glds16(kcol + (size_t)(r0_ + krow_in) * DIN, (unsigned)__builtin_amdgcn_readfirstlane(lds0 + DD_K + sl_)); glds16(vcol + (size_t)(r0_ + vrow_in) * DIN, (unsigned)__builtin_amdgcn_readfirstlane(lds0 + DD_V + sl_)); } while (0)
        asm volatile("s_waitcnt lgkmcnt(0)\n\ts_barrier" ::: "memory");
        DMA_TILE(0); DMA_TILE(1); DMA_TILE(2);
        for (int i = 0; i < nt; ++i) {
            const int cur = i & 3;
            if (i + 2 < nt) asm volatile("s_waitcnt vmcnt(4)\n\ts_barrier" ::: "memory");
            else if (i + 1 < nt) asm volatile("s_waitcnt vmcnt(2)\n\ts_barrier" ::: "memory");
            else asm volatile("s_waitcnt vmcnt(0)\n\ts_barrier" ::: "memory");
            if (i + 3 < nt) DMA_TILE(i + 3);
            const bool win = i < nwin; const int T = (tw_lo + i) * 64;
            const bool skip = win && (T > qw + 31 + 128 || T + 63 < qw - 128);
            if (!skip) {
                const LAS char* kb = sm + DD_K + cur * 8192 + hi * 1024 + r32 * 16;
                const LAS char* vb = sm + DD_V + cur * 8192 + ((lane >> 4) & 1) * 32 + (lane & 3) * 8 + (4 * hi + ((lane & 15) >> 2)) * 64;
                float nm = -mhat; asm volatile("" : "+v"(nm));
                f32x16 c0, c1;
#pragma unroll
                for (int r = 0; r < 16; ++r) { c0[r] = nm; c1[r] = nm; }
#pragma unroll
                for (int j = 0; j < 4; ++j) {
                    c0 = __builtin_amdgcn_mfma_f32_32x32x16_bf16(*(const LAS bf16x8*)(kb + j * 2048), qr[j], c0, 0, 0, 0);
                    c1 = __builtin_amdgcn_mfma_f32_32x32x16_bf16(*(const LAS bf16x8*)(kb + j * 2048 + 512), qr[j], c1, 0, 0, 0); }
                if (win && (T < qw + 31 - 128 || T + 63 > qw + 128)) {
#pragma unroll
                    for (int r = 0; r < 16; ++r) { const int kp = T + crow(r, hi); const int d0_ = qpos - kp, d1_ = d0_ - 32;
                        if (d0_ > 128 || d0_ < -128) c0[r] = -1.0e30f;
                        if (d1_ > 128 || d1_ < -128) c1[r] = -1.0e30f; }
                }
                float rm = fmaxf(c0[0], c1[0]);
#pragma unroll
                for (int r = 1; r < 16; ++r) rm = fmaxf(rm, fmaxf(c0[r], c1[r]));
                rm = xhalf_max(rm);
                if (__any(rm > 8.0f)) {
                    const float dl = fmaxf(rm, 0.f); mhat += dl;
#pragma unroll
                    for (int r = 0; r < 16; ++r) { c0[r] -= dl; c1[r] -= dl; }
                    const float f = __builtin_amdgcn_exp2f(-dl); lsum *= f;
                    if (hi == 0) wsf[r32] = f;
#pragma unroll
                    for (int r = 0; r < 16; ++r) { const float fr_ = wsf[crow(r, hi)]; o[0][r] *= fr_; o[1][r] *= fr_; }
                }
                float sacc = 0.f;
#pragma unroll
                for (int r = 0; r < 16; ++r) { c0[r] = __builtin_amdgcn_exp2f(c0[r]); c1[r] = __builtin_amdgcn_exp2f(c1[r]); sacc += c0[r] + c1[r]; }
                lsum += sacc;
                u32x4 pw[4];
#pragma unroll
                for (int k = 0; k < 2; ++k) {
                    pw[k] = (u32x4){cvtpk_s(c0[8 * k + 0], c0[8 * k + 1]), cvtpk_s(c0[8 * k + 2], c0[8 * k + 3]), cvtpk_s(c0[8 * k + 4], c0[8 * k + 5]), cvtpk_s(c0[8 * k + 6], c0[8 * k + 7])};
                    pw[2 + k] = (u32x4){cvtpk_s(c1[8 * k + 0], c1[8 * k + 1]), cvtpk_s(c1[8 * k + 2], c1[8 * k + 3]), cvtpk_s(c1[8 * k + 4], c1[8 * k + 5]), cvtpk_s(c1[8 * k + 6], c1[8 * k + 7])}; }
#pragma unroll
                for (int k = 0; k < 4; ++k) {
                    const s16x4 lo0 = vtr(vb + k * 1024), hi0 = vtr(vb + k * 1024 + 512), lo1 = vtr(vb + 4096 + k * 1024), hi1 = vtr(vb + 4096 + k * 1024 + 512);
                    o[0] = __builtin_amdgcn_mfma_f32_32x32x16_bf16(__builtin_bit_cast(bf16x8, pw[k]), (bf16x8){lo0[0], lo0[1], lo0[2], lo0[3], hi0[0], hi0[1], hi0[2], hi0[3]}, o[0], 0, 0, 0);
                    o[1] = __builtin_amdgcn_mfma_f32_32x32x16_bf16(__builtin_bit_cast(bf16x8, pw[k]), (bf16x8){lo1[0], lo1[1], lo1[2], lo1[3], hi1[0], hi1[1], hi1[2], hi1[3]}, o[1], 0, 0, 0); }
            }
            asm volatile("s_waitcnt lgkmcnt(0)" ::: "memory");
        }
#undef SWA_ROW0
#undef DMA_TILE
        const float inv = 1.0f / xhalf_sum(lsum);
        int lane_e = TIDX & 63;
        { const int r32e = lane_e & 31, hie = lane_e >> 5;
        LAS float* wse = (LAS float*)(sm + DD_WS) + wid * 64; LAS float* stge = (LAS float*)(sm + DD_ST) + wid * 2048;
        if (hie == 0) wse[r32e] = inv;
#pragma unroll
        for (int r = 0; r < 16; ++r) { const int q = crow(r, hie); const float i0 = wse[q]; stge[q * 64 + r32e] = o[0][r] * i0; stge[q * 64 + 32 + r32e] = o[1][r] * i0; } }
        LAS float* stg = (LAS float*)(sm + DD_ST) + wid * 2048;
#pragma unroll
        for (int i = 0; i < 4; ++i) { const int row = i * 8 + (lane_e >> 3), ch = lane_e & 7;
            const f32x4 v0 = *(const LAS f32x4*)(stg + row * 64 + ch * 8), v1 = *(const LAS f32x4*)(stg + row * 64 + ch * 8 + 4);
            u32x4 w; w.x = cvtpk_s(v0[0], v0[1]); w.y = cvtpk_s(v0[2], v0[3]); w.z = cvtpk_s(v1[0], v1[1]); w.w = cvtpk_s(v1[2], v1[3]);
            *(u32x4*)(O + (size_t)(qrow0 + wid * 32 + row) * DM + h * 64 + ch * 8) = w; }
    }
}

__device__ __forceinline__ void moe_offsets(const Params& p, int* offs  ) {
    if (TIDX < 2) { const unsigned* cw = (const unsigned*)p.ws + CW_CNT + TIDX * 8; int o = 0;
        for (int e = 0; e < 8; ++e) { offs[TIDX * 9 + e] = o; o += ((int)__hip_atomic_load(cw + e, __ATOMIC_RELAXED, __HIP_MEMORY_SCOPE_AGENT) + 255) & ~255; }
        offs[TIDX * 9 + 8] = o; }
    __syncthreads();
}
__device__ __forceinline__ void ph_moe_scatter(const Params& p, int bid, int nb, float* lds) {
    char* ws = p.ws; int* offs = (int*)lds; moe_offsets(p, offs);
    const int lane = TIDX & 63, wv = TIDX >> 6;
    const bf16_t* H = (const bf16_t*)(ws + OFF_ACT); bf16_t* AS = (bf16_t*)(ws + OFF_ASORT);
    int* tok = (int*)(ws + OFF_TOK); float* wgt = (float*)(ws + OFF_WGT); const unsigned* cw = (const unsigned*)ws;
    for (int r0 = (bid * 8 + wv) * 4; r0 < NLAT; r0 += nb * 8 * 4) {
        int4 rec[4]; u32x4 d0[4], d1[4]; int pos[4][2];
#pragma unroll
        for (int k = 0; k < 4; ++k) { rec[k] = *(const int4*)(ws + OFF_ROUTE + (size_t)(r0 + k) * 16); const u32x4* src = (const u32x4*)(H + (size_t)(r0 + k) * DM); d0[k] = src[lane]; d1[k] = src[64 + lane]; }
#pragma unroll
        for (int k = 0; k < 4; ++k) { const int blk = ((r0 + k) >> 3) % nb;
#pragma unroll
            for (int g = 0; g < 2; ++g) { const int e = (g == 0 ? rec[k].x : rec[k].y) & 15, li = (g == 0 ? rec[k].x : rec[k].y) >> 4;
                pos[k][g] = offs[g * 9 + e] + (int)cw[CW_BLK + blk * 16 + g * 8 + e] + li; } }
#pragma unroll
        for (int k = 0; k < 4; ++k)
#pragma unroll
            for (int g = 0; g < 2; ++g) { const int ps = pos[k][g];
                if (lane == 0) { tok[g * GRP_ROWS + ps] = r0 + k; wgt[g * GRP_ROWS + ps] = __int_as_float(g == 0 ? rec[k].z : rec[k].w); }
                u32x4* dst = (u32x4*)(AS + ((size_t)g * GRP_ROWS + ps) * DM); dst[lane] = d0[k]; dst[64 + lane] = d1[k]; }
    }
}

__device__ __forceinline__ void ph_final(const Params& p, int bid, int nb) {
    const int lane = TIDX & 63, wv = TIDX >> 6;
    for (int r = bid * 8 + wv; r < NLAT; r += nb * 8) {
        float* xr = p.out + (size_t)r * DM; float4 v[4]; float ss = 0.f;
#pragma unroll
        for (int i = 0; i < 4; ++i) { v[i] = *(const float4*)(xr + i * 256 + lane * 4); ss += v[i].x * v[i].x + v[i].y * v[i].y + v[i].z * v[i].z + v[i].w * v[i].w; }
        ss = wave_sum(ss); const float rn = rsqrtf(ss * (1.0f / 1024.0f) + 1e-6f);
#pragma unroll
        for (int i = 0; i < 4; ++i) { const float4 g = *(const float4*)(p.final_norm + i * 256 + lane * 4);
            float4 o; o.x = v[i].x * rn * g.x; o.y = v[i].y * rn * g.y; o.z = v[i].z * rn * g.z; o.w = v[i].w * rn * g.w; *(float4*)(xr + i * 256 + lane * 4) = o; }
    }
}

struct EpiStoreBf16 {
    static constexpr bool PERM = true, AFTER_DRAIN = false; bf16_t* O; int ldc;
    __device__ __forceinline__ void operator()(const f32x4 (&acc)[2][2][4][2], const pg8::Unit& u, int wr, int wc, int fr, int fq) const {
        bf16_t* base = O + (size_t)(u.pm * 256 + wr * 64 + fr) * ldc + u.pn * 256 + wc * 32 + 8 * fq;
#pragma unroll
        for (int ai = 0; ai < 2; ++ai)
#pragma unroll
            for (int m = 0; m < 4; ++m) { bf16_t* rowp = base + (size_t)(ai * 128 + m * 16) * ldc;
#pragma unroll
                for (int bj = 0; bj < 2; ++bj) { const f32x4 v0 = acc[ai][bj][m][0], v1 = acc[ai][bj][m][1]; u32x4 w;
                    w.x = pg8::cvt_pk_bf16(v0[0], v0[1]); w.y = pg8::cvt_pk_bf16(v0[2], v0[3]); w.z = pg8::cvt_pk_bf16(v1[0], v1[1]); w.w = pg8::cvt_pk_bf16(v1[2], v1[3]);
                    *(u32x4*)(rowp + bj * 128) = w; } }
    }
};
struct EpiSwiglu {
    static constexpr bool PERM = true, AFTER_DRAIN = false; bf16_t* U; int ldu, npe;
    __device__ __forceinline__ void operator()(const f32x4 (&acc)[2][2][4][2], const pg8::Unit& u, int wr, int wc, int fr, int fq) const {
        bf16_t* base = U + (size_t)(u.pm * 256 + wr * 64 + fr) * ldu + (u.pn % npe) * 128 + wc * 32 + 8 * fq;
#pragma unroll
        for (int ai = 0; ai < 2; ++ai)
#pragma unroll
            for (int m = 0; m < 4; ++m) { float o[8];
#pragma unroll
                for (int n = 0; n < 2; ++n)
#pragma unroll
                    for (int i = 0; i < 4; ++i) o[n * 4 + i] = fast_silu(acc[ai][0][m][n][i]) * acc[ai][1][m][n][i];
                u32x4 w; w.x = pg8::cvt_pk_bf16(o[0], o[1]); w.y = pg8::cvt_pk_bf16(o[2], o[3]); w.z = pg8::cvt_pk_bf16(o[4], o[5]); w.w = pg8::cvt_pk_bf16(o[6], o[7]);
                *(u32x4*)(base + (size_t)(ai * 128 + m * 16) * ldu) = w; }
    }
};
struct EpiResidual {
    static constexpr bool PERM = false, AFTER_DRAIN = false; const float* xin; float* xout; float* xc; const float* gate;
    __device__ __forceinline__ void operator()(const f32x4 (&acc)[2][2][4][2], const pg8::Unit& u, int wr, int wc, int fr, int fq) const {
        const int cls = u.pm < 64 ? 0 : (u.pm < 128 ? 1 : 2), col0 = u.pn * 256 + wc * 32 + 4 * fq;
        const float* gv = gate + (size_t)cls * 6144 + col0;
        const float* bi = u.pm < 128 ? xin + (size_t)u.pm * 256 * DM : xc + (size_t)(u.pm - 128) * 256 * DM;
        float* bo = u.pm < 128 ? xout + (size_t)u.pm * 256 * DM : xc + (size_t)(u.pm - 128) * 256 * DM;
        f32x4 g4[2][2];
#pragma unroll
        for (int bj = 0; bj < 2; ++bj)
#pragma unroll
            for (int n = 0; n < 2; ++n) g4[bj][n] = *(const f32x4*)(gv + bj * 128 + n * 16);
#pragma unroll
        for (int ai = 0; ai < 2; ++ai)
#pragma unroll
            for (int m = 0; m < 4; ++m) { const size_t off = (size_t)(ai * 128 + wr * 64 + m * 16 + fr) * DM + col0;
#pragma unroll
                for (int bj = 0; bj < 2; ++bj)
#pragma unroll
                    for (int n = 0; n < 2; ++n) { const f32x4 xi = *(const f32x4*)(bi + off + bj * 128 + n * 16); *(f32x4*)(bo + off + bj * 128 + n * 16) = xi + g4[bj][n] * acc[ai][bj][m][n]; } }
    }
};
struct EpiMoeScatter {
    static constexpr bool PERM = false, AFTER_DRAIN = false; float* x; const float* gate; const int* tok; const float* wgt; int npe;
    __device__ __forceinline__ void operator()(const f32x4 (&acc)[2][2][4][2], const pg8::Unit& u, int wr, int wc, int fr, int fq) const {
        const int col0 = (u.pn % npe) * 256 + wc * 32 + 4 * fq;
#pragma unroll
        for (int ai = 0; ai < 2; ++ai)
#pragma unroll
            for (int m = 0; m < 4; ++m) { const int r = u.pm * 256 + ai * 128 + wr * 64 + m * 16 + fr; const int tk = tok[r];
                if (tk >= 0) { const float wv = wgt[r]; const float* gv = gate + (size_t)mod_class(tk) * 6144 + col0; float* xr = x + (size_t)tk * DM + col0;
#pragma unroll
                    for (int bj = 0; bj < 2; ++bj)
#pragma unroll
                        for (int n = 0; n < 2; ++n) { const f32x4 g4 = *(const f32x4*)(gv + bj * 128 + n * 16); f32x4* q = (f32x4*)(xr + bj * 128 + n * 16); *q = *q + g4 * wv * acc[ai][bj][m][n]; } } }
    }
};
struct MoeOrder : pg8::StaticOrder {
    int o1, o2, o3, o4, o5, o6, o7, npe;
    __device__ __forceinline__ bool next(int i, pg8::Unit& u) const {
        if (!pg8::StaticOrder::next(i, u)) return false;
        const int r = u.pm * 256; const int e = (r >= o1) + (r >= o2) + (r >= o3) + (r >= o4) + (r >= o5) + (r >= o6) + (r >= o7);
        u.pn += e * npe; return true;
    }
};
#define GEMM_LDS ((PG8_LAS unsigned char*)lds)
struct EpiInProj {
    static constexpr bool PERM = true, AFTER_DRAIN = false; bf16_t* O; const char* tab;
    __device__ __forceinline__ void operator()(const f32x4 (&acc)[2][2][4][2], const pg8::Unit& u, int wr, int wc, int fr, int fq) const {
        const int row0 = u.pm * 256 + wr * 64 + fr; const bool lat = u.pm < 128;
#pragma unroll
        for (int bj = 0; bj < 2; ++bj) {
            const int s = u.pn * 2 + bj;
            int mode = 0; float scale = 1.0f;
            if (s <= 1) { mode = 1; scale = 0.125f * 1.4426950408889634f; } else if (s == 2) mode = 1;
            else if (s == 4 || s == 5) mode = 2; else if (s == 6 || s == 7) { mode = 2; scale = 0.125f; }
            else if (s == 12 || s == 13) { mode = 3; scale = 0.17677669529663687f * 1.4426950408889634f; } else if (s == 14 || s == 15) mode = 3;
            if (mode == 0) {
                bf16_t* base = O + (size_t)row0 * DIN + s * 128 + wc * 32 + 8 * fq;
#pragma unroll
                for (int ai = 0; ai < 2; ++ai)
#pragma unroll
                    for (int m = 0; m < 4; ++m) { const f32x4 v0 = acc[ai][bj][m][0], v1 = acc[ai][bj][m][1]; u32x4 w;
                        w.x = pg8::cvt_pk_bf16(v0[0], v0[1]); w.y = pg8::cvt_pk_bf16(v0[2], v0[3]); w.z = pg8::cvt_pk_bf16(v1[0], v1[1]); w.w = pg8::cvt_pk_bf16(v1[2], v1[3]);
                        *(u32x4*)(base + (size_t)(ai * 128 + m * 16) * DIN) = w; }
            } else {
                const bool wide = mode != 3; const int half = wide ? 32 : 16, g = wide ? 4 * (wc & 1) + fq : fq;
                const int cbase = s * 128 + (wide ? 64 * (wc >> 1) : 32 * wc) + 4 * g;
                const float* ct = (const float*)(tab + (mode == 1 ? TAB_ATTN : (mode == 2 ? TAB_RET : TAB_DIFF))) + 4 * g; const int tstride = half, tsin = 16384 * half;
#pragma unroll
                for (int ai = 0; ai < 2; ++ai)
#pragma unroll
                    for (int m = 0; m < 4; ++m) { const int row = row0 + ai * 128 + m * 16; const f32x4 v0 = acc[ai][bj][m][0], v1 = acc[ai][bj][m][1];
                        f32x4 cs = {1.f, 1.f, 1.f, 1.f}, sn = {0.f, 0.f, 0.f, 0.f};
                        if (lat) { const float* tp = ct + (size_t)(row & (NSEQ - 1)) * tstride; cs = *(const f32x4*)tp; sn = *(const f32x4*)(tp + tsin); }
                        const f32x4 o1 = (v0 * cs - v1 * sn) * scale, o2 = (v1 * cs + v0 * sn) * scale;
                        bf16_t* op = O + (size_t)row * DIN + cbase;
                        uint2 w1, w2; w1.x = pg8::cvt_pk_bf16(o1[0], o1[1]); w1.y = pg8::cvt_pk_bf16(o1[2], o1[3]); w2.x = pg8::cvt_pk_bf16(o2[0], o2[1]); w2.y = pg8::cvt_pk_bf16(o2[2], o2[3]);
                        *(uint2*)op = w1; *(uint2*)(op + half) = w2; }
            }
        }
    }
};
__device__ __forceinline__ void ph_gemm_in(const Params& p, int l, int bid, int nb, float* lds) {
    char* ws = p.ws; pg8::Gemm g{(const bf16_t*)(ws + OFF_ACT), (const bf16_t*)(ws + OFF_WIN) + (size_t)l * DIN * DM, NROW, DIN, DM};
    pg8::StaticOrder S; S.init(NROW, DIN, nb, bid);
    EpiInProj E{(bf16_t*)(ws + OFF_P), ws + OFF_TAB};
    pg8::gemm_phase<EpiInProj, pg8::StaticOrder, true, true>(GEMM_LDS, g, S, E);
}
__device__ __forceinline__ void ph_gemm_out(const Params& p, int l, bool need_ctx, int bid, int nb, float* lds) {
    char* ws = p.ws; const int M = need_ctx ? NROW : NLAT;
    pg8::Gemm g{(const bf16_t*)(ws + OFF_ACT), (const bf16_t*)(ws + OFF_WOUT) + (size_t)l * DM * DM, M, DM, DM};
    pg8::StaticOrder S; S.init(M, DM, nb, bid);
    EpiResidual E{l == 0 ? p.x : p.out, p.out, (float*)(ws + OFF_XC), (const float*)(ws + OFF_MOD) + (size_t)l * 3 * 6144 + 2048};
    pg8::gemm_phase<EpiResidual, pg8::StaticOrder, true, true>(GEMM_LDS, g, S, E);
}
__device__ __forceinline__ void ph_ffn1(const Params& p, bool need_ctx, int bid, int nb, float* lds) {
    char* ws = p.ws; const int M = need_ctx ? NROW : NLAT;
    pg8::Gemm g{(const bf16_t*)(ws + OFF_ACT), (const bf16_t*)(ws + OFF_WF13), M, 2 * DFF, DM};
    pg8::StaticOrder S; S.init(M, 2 * DFF, nb, bid);
    EpiSwiglu E{(bf16_t*)(ws + OFF_P), DFF, 2 * DFF / 256};
    pg8::gemm_phase<EpiSwiglu, pg8::StaticOrder, true, true>(GEMM_LDS, g, S, E);
}
__device__ __forceinline__ void ph_ffn2(const Params& p, int l, bool need_ctx, int bid, int nb, float* lds) {
    char* ws = p.ws; const int M = need_ctx ? NROW : NLAT;
    pg8::Gemm g{(const bf16_t*)(ws + OFF_P), (const bf16_t*)(ws + OFF_WF2), M, DM, DFF};
    pg8::StaticOrder S; S.init(M, DM, nb, bid);
    EpiResidual E{p.out, p.out, (float*)(ws + OFF_XC), (const float*)(ws + OFF_MOD) + (size_t)l * 3 * 6144 + 5120};
    pg8::gemm_phase<EpiResidual, pg8::StaticOrder, true, true>(GEMM_LDS, g, S, E);
}
__device__ __forceinline__ MoeOrder moe_order(const int* og, int npe, int nb, int bid) {
    MoeOrder S; S.init(og[8], npe * 256, nb, bid); S.o1 = og[1]; S.o2 = og[2]; S.o3 = og[3]; S.o4 = og[4]; S.o5 = og[5]; S.o6 = og[6]; S.o7 = og[7]; S.npe = npe; return S;
}
__device__ __forceinline__ void ph_moe1(const Params& p, int g, int bid, int nb, float* lds) {
    char* ws = p.ws; int* offs = (int*)(lds + 32768); __syncthreads(); moe_offsets(p, offs);
    const MoeOrder S = moe_order(offs + g * 9, 2 * DFE / 256, nb, bid);
    pg8::Gemm gm{(const bf16_t*)(ws + OFF_ASORT) + (size_t)g * GRP_ROWS * DM, (const bf16_t*)(ws + OFF_WM13), 0, 0, DM};
    EpiSwiglu E{(bf16_t*)(ws + OFF_UMOE), DFE, 2 * DFE / 256};
    pg8::gemm_phase<EpiSwiglu, MoeOrder, true, true>(GEMM_LDS, gm, S, E);
}
__device__ __forceinline__ void ph_moe2(const Params& p, int l, int g, int bid, int nb, float* lds) {
    char* ws = p.ws; int* offs = (int*)(lds + 32768); __syncthreads(); moe_offsets(p, offs);
    const MoeOrder S = moe_order(offs + g * 9, DM / 256, nb, bid);
    pg8::Gemm gm{(const bf16_t*)(ws + OFF_UMOE), (const bf16_t*)(ws + OFF_WM2), 0, 0, DFE};
    EpiMoeScatter E{p.out, (const float*)(ws + OFF_MOD) + (size_t)l * 3 * 6144 + 5120, (const int*)(ws + OFF_TOK) + g * GRP_ROWS, (const float*)(ws + OFF_WGT) + g * GRP_ROWS, DM / 256};
    pg8::gemm_phase<EpiMoeScatter, MoeOrder, true, true>(GEMM_LDS, gm, S, E);
}

#define XB_TMO      128
#define XB_XCNT(j)  (256  + 64 * (j))
#define XB_XSUB(j)  (1280 + 64 * (j))
#define XB_XGEN(j)  (2304 + 64 * (j))
#define XB_TOP      3328
#define XB_TOPGEN   3392
#define XCD_BAR_WORDS 3456
#define XB_SPIN_CAP (1u << 22)

__device__ __forceinline__ unsigned xb_ld(unsigned* p)              { return __hip_atomic_load(p, __ATOMIC_RELAXED, __HIP_MEMORY_SCOPE_AGENT); }
__device__ __forceinline__ unsigned xb_add(unsigned* p, unsigned v) { return __hip_atomic_fetch_add(p, v, __ATOMIC_RELAXED, __HIP_MEMORY_SCOPE_AGENT); }
__device__ __forceinline__ unsigned xb_xcc_id() { return (unsigned)__builtin_amdgcn_s_getreg((3 << 11) | 20) & 0xFu; }
#define XB_SPIN(cond, bar) do { unsigned _sp = 0; while (cond) { __builtin_amdgcn_s_sleep(1); \
    if ((++_sp & 255u) == 0u) { if (xb_ld(&(bar)[XB_TMO])) break; if (_sp > XB_SPIN_CAP) { atomicAdd(&(bar)[XB_TMO], 1u); break; } } } } while (0)

struct XcdBarrier {
    unsigned* bar; unsigned x;
    volatile LAS unsigned* st;
};

__device__ __forceinline__ XcdBarrier xcd_barrier_post(unsigned* bar, volatile LAS unsigned* st) {
    XcdBarrier b; b.bar = bar; b.x = xb_xcc_id(); b.st = st;
    if (threadIdx.x == 0) (void)xb_add(&bar[XB_XCNT(b.x)], 1u);
    return b;
}
__device__ __forceinline__ void xcd_barrier_complete(unsigned* bar, unsigned x, unsigned& nloc, unsigned& nx) {
    const unsigned G = gridDim.x * gridDim.y * gridDim.z;
    unsigned sum, cnt, mine, sp = 0u;
    for (;;) {
        sum = 0u; cnt = 0u; mine = 0u;
#pragma unroll
        for (unsigned j = 0; j < 16; ++j) { const unsigned c = xb_ld(&bar[XB_XCNT(j)]); sum += c; cnt += (c > 0u) ? 1u : 0u; mine = (j == x) ? c : mine; }
        if (sum == G) break;
        __builtin_amdgcn_s_sleep(1);
        if ((++sp & 255u) == 0u) { if (xb_ld(&bar[XB_TMO])) break; if (sp > XB_SPIN_CAP) { atomicAdd(&bar[XB_TMO], 1u); break; } }
    }
    nloc = mine > 0u ? mine : 1u; nx = cnt > 0u ? cnt : 1u;
}

__device__ __forceinline__ void xcd_barrier(const XcdBarrier& b) {
    asm volatile("s_waitcnt vmcnt(0)" ::: "memory");
    __syncthreads();
    if (threadIdx.x == 0) {
        unsigned* bar = b.bar;
        __builtin_amdgcn_s_waitcnt(0);
        unsigned nloc = b.st[0], nx = b.st[1];
        if (nloc == 0u) { xcd_barrier_complete(bar, b.x, nloc, nx); b.st[0] = nloc; b.st[1] = nx; }
        const unsigned old = xb_add(&bar[XB_XSUB(b.x)], 1u);
        const unsigned gen = old / nloc;
        if (old + 1u == (gen + 1u) * nloc) {
            __builtin_amdgcn_fence(__ATOMIC_RELEASE, "agent");
            asm volatile("s_waitcnt vmcnt(0)" ::: "memory");
            const unsigned og = xb_add(&bar[XB_TOP], 1u);
            const unsigned tg = og / nx;
            if (og + 1u == (tg + 1u) * nx) xb_add(&bar[XB_TOPGEN], 1u);
            else XB_SPIN(xb_ld(&bar[XB_TOPGEN]) == tg, bar);
            __builtin_amdgcn_fence(__ATOMIC_ACQUIRE, "agent");
            xb_add(&bar[XB_XGEN(b.x)], 1u);
            asm volatile("s_waitcnt vmcnt(0)" ::: "memory");
        } else {
            XB_SPIN(xb_ld(&bar[XB_XGEN(b.x)]) == gen, bar);
            __builtin_amdgcn_fence(__ATOMIC_ACQUIRE, "agent");
            asm volatile("s_waitcnt vmcnt(0)" ::: "memory");
        }
    }
    __syncthreads();
}


constexpr int LDS_FLOATS = 33792;
constexpr int LDS_BYTES = LDS_FLOATS * 4 + 16 + 256;

typedef const __attribute__((address_space(4))) unsigned long long* kargp_t;
typedef __attribute__((address_space(1))) const float* gcf_t;
__device__ __forceinline__ Params load_params(const float* lds) {
    const LAS unsigned* tbl = (const LAS unsigned*)(lds + LDS_FLOATS + 4);
    Params p; const float** f = (const float**)&p;
#pragma unroll
    for (int i = 0; i < (int)(sizeof(Params) / 8); ++i) {
        const unsigned lo = __builtin_amdgcn_readfirstlane(tbl[2 * i]), hi = __builtin_amdgcn_readfirstlane(tbl[2 * i + 1]);
        f[i] = (const float*)(gcf_t)(((unsigned long long)hi << 32) | lo); }
    return p;
}
#define LOADP(name) const Params name = load_params(lds)

template <int l>
__device__ __forceinline__ void run_layer(const XcdBarrier& bar, int bid, int nb, float* lds) {
    constexpr bool need_ctx = l == 0;
    constexpr float lam_init = l == 0 ? 0.2f : 0.35550906759509393f;
    { LOADP(p); ph_norm<false>(p, l, 0, NROW, bid, nb, lds); } xcd_barrier(bar);
    { LOADP(p); ph_gemm_in(p, l, bid, nb, lds); } xcd_barrier(bar);
    { LOADP(p); ph_ret_summ(p, l, bid, nb, lds); } { LOADP(p); ph_lru_chunk<1>(p, l, bid, nb, lds, 0); } xcd_barrier(bar);
    { LOADP(p); ph_scan2(p, l, bid, nb); } xcd_barrier(bar);
    { LOADP(p); ph_diff(p, l, need_ctx, lam_init, bid, nb, lds); }
    { LOADP(p); ph_swa(p, l, need_ctx, bid, nb, lds); }
    { LOADP(p); ph_ret_out(p, l, bid, nb, lds, need_ctx ? 0 : 2); }
    { LOADP(p); ph_lru_chunk<3>(p, l, bid, nb, lds, need_ctx ? 0 : 2); } xcd_barrier(bar);
    { LOADP(p); ph_gemm_out(p, l, need_ctx, bid, nb, lds); } xcd_barrier(bar);
    if (l == 0) {
        { LOADP(p); ph_norm<false>(p, l, 1, NROW, bid, nb, lds); } xcd_barrier(bar);
        { LOADP(p); ph_ffn1(p, need_ctx, bid, nb, lds); } xcd_barrier(bar);
        { LOADP(p); ph_ffn2(p, l, need_ctx, bid, nb, lds); } xcd_barrier(bar);
    } else {
        { LOADP(p); ph_norm<true>(p, l, 1, NLAT, bid, nb, lds); } xcd_barrier(bar);
        { LOADP(p); ph_moe_scatter(p, bid, nb, lds); } xcd_barrier(bar);
        { LOADP(p); ph_moe1(p, 0, bid, nb, lds); } xcd_barrier(bar);
        { LOADP(p); ph_moe2(p, l, 0, bid, nb, lds); } xcd_barrier(bar);
        { LOADP(p); ph_moe1(p, 1, bid, nb, lds); } xcd_barrier(bar);
        { LOADP(p); ph_moe2(p, l, 1, bid, nb, lds); } xcd_barrier(bar);
    }
}

__global__ void __launch_bounds__(512, 2) fwd(Params p_in) {
    extern __shared__ __attribute__((aligned(16))) float lds[];
    volatile LAS unsigned* st = (volatile LAS unsigned*)(lds + LDS_FLOATS);
    if (threadIdx.x == 0) { st[0] = 0u; st[1] = 0u; st[2] = 0u; st[3] = 0u; }
    if (threadIdx.x < (int)(sizeof(Params) / 8)) { const kargp_t q = (kargp_t)__builtin_amdgcn_kernarg_segment_ptr(); ((LAS unsigned long long*)(lds + LDS_FLOATS + 4))[threadIdx.x] = q[threadIdx.x]; }
    __syncthreads();
    XcdBarrier bar;
    { LOADP(p); bar = xcd_barrier_post((unsigned*)p.ws, st); }
    const int bid = blockIdx.x, nb = gridDim.x;
    { LOADP(p); ph_prologue(p, bid, nb, lds); } xcd_barrier(bar);
    run_layer<0>(bar, bid, nb, lds);
    run_layer<1>(bar, bid, nb, lds);
    { LOADP(p); ph_final(p, bid, nb); }
}

extern "C" void kernel_launch(void* const* d_in, const int* in_sizes, int n_in, void* d_out, int out_size, void* d_ws, size_t ws_size, hipStream_t stream) {
    static int grid = 0;
    if (grid == 0) {
        if (n_in < 30 || ws_size < WS_NEED) { fprintf(stderr, "kernel_launch: bad args n_in=%d ws=%zu need=%zu\n", n_in, ws_size, (size_t)WS_NEED); grid = -1; return; }
        int dev = 0, cus = 0, per_cu = 0;
        if (hipGetDevice(&dev) != hipSuccess || hipDeviceGetAttribute(&cus, hipDeviceAttributeMultiprocessorCount, dev) != hipSuccess) { grid = -1; return; }
        if (hipFuncSetAttribute((const void*)fwd, hipFuncAttributeMaxDynamicSharedMemorySize, LDS_BYTES) != hipSuccess) { fprintf(stderr, "kernel_launch: hipFuncSetAttribute failed\n"); grid = -1; return; }
        if (hipOccupancyMaxActiveBlocksPerMultiprocessor(&per_cu, (const void*)fwd, 512, LDS_BYTES) != hipSuccess || per_cu < 1) { fprintf(stderr, "kernel_launch: occupancy query says %d\n", per_cu); per_cu = 1; }
        (void)hipGetLastError();
        grid = cus;
    }
    if (grid < 0) return;
    Params p{};
    const float** f = (const float**)&p;
    for (int i = 0; i < 30; ++i) f[i] = (const float*)d_in[i];
    p.out = (float*)d_out; p.ws = (char*)d_ws;
    (void)hipMemsetAsync(d_ws, 0, 65536, stream);
    hipLaunchKernelGGL(fwd, dim3(grid), dim3(512), LDS_BYTES, stream, p);
}
```

```cpp
#include <hip/hip_runtime.h>
#include <cstdio>
#include <cstdint>

typedef unsigned short bf16_t;
typedef short bf16x8 __attribute__((ext_vector_type(8)));
typedef float f32x4 __attribute__((ext_vector_type(4)));
typedef unsigned u32x4 __attribute__((ext_vector_type(4)));
#define LAS __attribute__((address_space(3)))

constexpr int NB = 2, NSEQ = 16384, NCTX = 256, DM = 1024;
constexpr int NLAT = NB * NSEQ;
constexpr int NCR = NB * NCTX;
constexpr int NROW = NLAT + NCR;
constexpr int DIN = 2816, DFF = 2816, DFE = 3584, NE = 8;
constexpr int NCI = 130;
constexpr int C_AQ = 0, C_AK = 256, C_AV = 384, C_RQ = 512, C_RK = 768, C_RV = 1024, C_RG = 1280, C_DQ = 1536, C_DK = 1792, C_DV = 2048, C_LX = 2304, C_LY = 2560;
constexpr int GRP_ROWS = 34816;

constexpr size_t al256(size_t x) { return (x + 255) & ~(size_t)255; }
constexpr size_t OFF_CTRL = 0;
constexpr size_t OFF_MOD = 65536;
constexpr size_t OFF_TAB = al256(OFF_MOD + 2 * 3 * 6144 * 4);
constexpr size_t TAB_ATTN = 0, TAB_RET = 4u << 20, TAB_DIFF = 8u << 20;
constexpr size_t OFF_XC = al256(OFF_TAB + (10u << 20));
constexpr size_t OFF_ROUTE = al256(OFF_XC + (size_t)NCR * DM * 4);
constexpr size_t OFF_TOK = al256(OFF_ROUTE + (size_t)NLAT * 16);
constexpr size_t OFF_WGT = al256(OFF_TOK + (size_t)2 * GRP_ROWS * 4);
constexpr size_t OFF_LRU = al256(OFF_WGT + (size_t)2 * GRP_ROWS * 4);
constexpr size_t OFF_WM13 = al256(OFF_LRU + (size_t)3 * 2 * 2 * NCI * 256 * 4);
constexpr size_t OFF_WM2 = al256(OFF_WM13 + (size_t)NE * 2 * DFE * DM);
constexpr size_t OFF_XB = al256(OFF_WM2 + (size_t)NE * DM * DFE);
constexpr size_t OFF_R = al256(OFF_XB + (size_t)NLAT * DM * 2);
constexpr size_t OFF_P = OFF_R;
constexpr size_t OFF_ACT = al256(OFF_P + (size_t)NROW * DIN * 2);
constexpr size_t OFF_RET = al256(OFF_ACT + (size_t)NROW * DM * 2);
constexpr size_t OFF_WIN = al256(OFF_RET + (size_t)2 * 2 * NCI * 4 * 4096 * 4);
constexpr size_t OFF_WOUT = al256(OFF_WIN + (size_t)2 * DIN * DM * 2);
constexpr size_t OFF_WF13 = al256(OFF_WOUT + (size_t)2 * DM * DM * 2);
constexpr size_t OFF_WF2 = al256(OFF_WF13 + (size_t)2 * DFF * DM * 2);
constexpr size_t OFF_R_END1 = al256(OFF_WF2 + (size_t)DM * DFF * 2);
constexpr size_t OFF_ASORT = OFF_R;
constexpr size_t OFF_YMOE = OFF_ASORT;
constexpr size_t OFF_UMOE = al256(OFF_ASORT + (size_t)2 * GRP_ROWS * DM * 2);
constexpr size_t OFF_R_END2 = al256(OFF_UMOE + (size_t)GRP_ROWS * DFE * 2);
constexpr size_t WS_NEED = OFF_R_END1 > OFF_R_END2 ? OFF_R_END1 : OFF_R_END2;
static_assert(OFF_ACT >= OFF_UMOE, "H2 must not overlap A_sorted");
constexpr int CW_CNT = 4096;
constexpr int CW_BLK = 8192;

struct Params {
    const float *x, *c, *ctx, *c_ctx, *w_ada, *b_ada, *g1, *g2, *w_in, *w_out, *sink, *ret_logit, *ret_gn, *diff_lam, *diff_gn,
        *conv_w, *conv_b, *lru_wa, *lru_ba, *lru_wx, *lru_bx, *lru_lam, *ffn_w1, *ffn_w3, *ffn_w2, *moe_router, *moe_w1, *moe_w3, *moe_w2, *final_norm;
    float* out; char* ws;
};

__device__ __forceinline__ int ltid_() { int t = threadIdx.x; asm volatile("" : "+v"(t)); return t; }
#define TIDX ltid_()
__device__ __forceinline__ float bf2f(bf16_t h) { return __uint_as_float(((unsigned)h) << 16); }
__device__ __forceinline__ bf16_t f2bf(float f) { unsigned u = __float_as_uint(f); u += 0x7fffu + ((u >> 16) & 1u); return (bf16_t)(u >> 16); }
__device__ __forceinline__ unsigned pack2(float lo, float hi) { return (unsigned)f2bf(lo) | ((unsigned)f2bf(hi) << 16); }
__device__ __forceinline__ unsigned pack4_fp8(float a, float b, float c, float d) {
    a = fminf(fmaxf(a, -440.f), 440.f); b = fminf(fmaxf(b, -440.f), 440.f); c = fminf(fmaxf(c, -440.f), 440.f); d = fminf(fmaxf(d, -440.f), 440.f);
    unsigned w = 0u; w = __builtin_amdgcn_cvt_pk_fp8_f32(a, b, w, false); w = __builtin_amdgcn_cvt_pk_fp8_f32(c, d, w, true); return w;
}
constexpr float F8_WSCALE = 128.0f, F8_ASCALE = 8.0f;
constexpr int F8_WE8M0 = 127 - 7, F8_AE8M0 = 127 - 3, F8_SCALES = F8_WE8M0 | (F8_AE8M0 << 8);
#define BFLO(w) __uint_as_float((w) << 16)
#define BFHI(w) __uint_as_float((w) & 0xffff0000u)
__device__ __forceinline__ float wave_sum(float v) {
#pragma unroll
    for (int o = 32; o >= 1; o >>= 1) v += __shfl_xor(v, o);
    return v;
}
__device__ __forceinline__ float sigmoidf_(float x) { return 1.0f / (1.0f + __expf(-x)); }
__device__ __forceinline__ float siluf_(float x) { return x / (1.0f + __expf(-x)); }
__device__ __forceinline__ float fast_silu(float v) { return v * __builtin_amdgcn_rcpf(1.0f + __expf(-v)); }
__device__ __forceinline__ float softplusf_(float x) { return x > 20.f ? x : log1pf(expf(x)); }
__device__ __forceinline__ float gelu_tanh(float x) { const float u = 0.7978845608028654f * (x + 0.044715f * x * x * x); return x * __builtin_amdgcn_rcpf(1.0f + __expf(-2.0f * u)); }
__device__ __forceinline__ int row_base(int b, int ci) { return ci < 2 ? NLAT + b * NCTX + ci * 128 : b * NSEQ + (ci - 2) * 128; }
__device__ __forceinline__ int mod_class(int row) { return row < NSEQ ? 0 : (row < NLAT ? 1 : 2); }

typedef float f32x16 __attribute__((ext_vector_type(16)));
typedef short s16x4 __attribute__((ext_vector_type(4)));
typedef short v4i16_t __attribute__((ext_vector_type(4)));
typedef float f32x2_t __attribute__((ext_vector_type(2)));
typedef __bf16 bf16x2_t __attribute__((ext_vector_type(2)));
__device__ __forceinline__ unsigned cvtpk_s(float lo, float hi) { f32x2_t v = {lo, hi}; bf16x2_t bb = __builtin_convertvector(v, bf16x2_t); return __builtin_bit_cast(unsigned, bb); }
__device__ __forceinline__ int crow(int r, int hi) { return (r & 3) + 8 * (r >> 2) + 4 * hi; }
__device__ __forceinline__ s16x4 vtr(const LAS char* p) { return __builtin_bit_cast(s16x4, __builtin_amdgcn_ds_read_tr16_b64_v4i16((LAS v4i16_t*)p)); }
__device__ __forceinline__ float bfs(short s) { return __uint_as_float(((unsigned)(unsigned short)s) << 16); }

struct Ct4Regs { float4 a[4], b[4]; };
__device__ __forceinline__ void ct4_load(const float* src, int N, int unit, Ct4Regs& r) {
    const int upn = N / 256, tk = unit / upn, tn4 = unit % upn, t = TIDX, kk = t >> 3, nc = (t & 7) * 8;
#pragma unroll
    for (int q = 0; q < 4; ++q) { const float* sp = src + (size_t)(tk * 64 + kk) * N + tn4 * 256 + q * 64 + nc; r.a[q] = *(const float4*)sp; r.b[q] = *(const float4*)(sp + 4); }
}
__device__ __forceinline__ void ct4_store(const Ct4Regs& r, int K, int N, bf16_t* dst, int unit, int mode_, float* lds) {
    const int upn = N / 256, tk = unit / upn, tn4 = unit % upn, t = TIDX; const bool f8 = (mode_ & 8) != 0; const int mode = mode_ & 7;
    {   const int kk = t >> 3, nc = (t & 7) * 8;
#pragma unroll
        for (int q = 0; q < 4; ++q) { float* d = lds + q * (64 * 65) + kk * 65 + nc; d[0] = r.a[q].x; d[1] = r.a[q].y; d[2] = r.a[q].z; d[3] = r.a[q].w; d[4] = r.b[q].x; d[5] = r.b[q].y; d[6] = r.b[q].z; d[7] = r.b[q].w; } }
    __syncthreads();
    {   const int n = t >> 3, kc = (t & 7) * 8;
#pragma unroll
        for (int q = 0; q < 4; ++q) { const int ng = tn4 * 256 + q * 64 + n; const float* L = lds + q * (64 * 65);
            int nrow;
            if (mode == 3) {
                const int s = ng >> 7; const bool r64 = s <= 2 || (s >= 4 && s <= 7), r32 = s >= 12 && s <= 15;
                if (r64) { const int d = ng & 63; nrow = (ng & ~63) + 8 * ((d & 31) >> 2) + 4 * (d >> 5) + (d & 3); }
                else if (r32) { const int d = ng & 31; nrow = (ng & ~31) + 8 * ((d & 15) >> 2) + 4 * (d >> 4) + (d & 3); }
                else nrow = ng;
            } else nrow = mode == 0 ? ng : ((ng >> 7) * 256 + (mode == 2 ? 128 : 0) + (ng & 127));
            if (f8) { uint2 w; w.x = pack4_fp8(L[(kc + 0) * 65 + n] * F8_WSCALE, L[(kc + 1) * 65 + n] * F8_WSCALE, L[(kc + 2) * 65 + n] * F8_WSCALE, L[(kc + 3) * 65 + n] * F8_WSCALE);
                w.y = pack4_fp8(L[(kc + 4) * 65 + n] * F8_WSCALE, L[(kc + 5) * 65 + n] * F8_WSCALE, L[(kc + 6) * 65 + n] * F8_WSCALE, L[(kc + 7) * 65 + n] * F8_WSCALE);
                *(uint2*)((unsigned char*)dst + (size_t)nrow * K + tk * 64 + kc) = w; }
            else { uint4 w; w.x = pack2(L[(kc + 0) * 65 + n], L[(kc + 1) * 65 + n]); w.y = pack2(L[(kc + 2) * 65 + n], L[(kc + 3) * 65 + n]);
                w.z = pack2(L[(kc + 4) * 65 + n], L[(kc + 5) * 65 + n]); w.w = pack2(L[(kc + 6) * 65 + n], L[(kc + 7) * 65 + n]);
                *(uint4*)(dst + (size_t)nrow * K + tk * 64 + kc) = w; } } }
    __syncthreads();
}

constexpr int CV_T_IN = 16 * 11, CV_T_OUT = 16 * 4, CV_T_F13 = 16 * 11, CV_T_F2 = 44 * 4, CV_T_M13 = 16 * 14, CV_T_M2 = 56 * 4;
constexpr int CV_MOE0 = 2 * CV_T_IN + 2 * CV_T_OUT + 2 * CV_T_F13 + CV_T_F2, CV_TOTAL = CV_MOE0 + 16 * CV_T_M13 + 8 * CV_T_M2, CV_TA = 12 * 106, CV_TB = 4 * 212, CV_TAILS = 2 * CV_TA + CV_TB;
static_assert(CV_MOE0 + CV_TAILS <= CV_TOTAL, "conversion tails");
__device__ __forceinline__ void convert_units(const Params& p, float* lds, int v0, int vstep, int vend, int split, int skip) {
    char* ws = p.ws; const int t = TIDX;
    {
        struct Job { const float* src; bf16_t* dst; int K, N, mode, base; };
        Job* jobs = (Job*)(lds + 4 * 64 * 65);
        const int T_IN = CV_T_IN, T_OUT = CV_T_OUT, T_F13 = CV_T_F13, T_F2 = CV_T_F2, T_M13 = CV_T_M13, T_M2 = CV_T_M2;
        const int total = CV_TOTAL;
        if (t < 32) {
            Job jb; jb.src = nullptr; jb.dst = nullptr; jb.K = DM; jb.N = DM; jb.mode = 0; jb.base = total;
            if (t < 2) { jb.src = p.w_in + (size_t)t * DM * DIN; jb.dst = (bf16_t*)(ws + OFF_WIN) + (size_t)t * DIN * DM; jb.N = DIN; jb.mode = 3; jb.base = t * T_IN; }
            else if (t < 4) { jb.src = p.w_out + (size_t)(t - 2) * DM * DM; jb.dst = (bf16_t*)(ws + OFF_WOUT) + (size_t)(t - 2) * DM * DM; jb.base = 2 * T_IN + (t - 2) * T_OUT; }
            else if (t < 6) { jb.src = t == 4 ? p.ffn_w1 : p.ffn_w3; jb.dst = (bf16_t*)(ws + OFF_WF13); jb.N = DFF; jb.mode = 8 | (t - 3); jb.base = 2 * T_IN + 2 * T_OUT + (t - 4) * T_F13; }
            else if (t == 6) { jb.src = p.ffn_w2; jb.dst = (bf16_t*)(ws + OFF_WF2); jb.K = DFF; jb.base = 2 * T_IN + 2 * T_OUT + 2 * T_F13; }
            else if (t < 23) { const int q = t - 7, e = q & 7, w3 = q >> 3; jb.src = (w3 ? p.moe_w3 : p.moe_w1) + (size_t)e * DM * DFE; jb.dst = (bf16_t*)(ws + OFF_WM13 + (size_t)e * 2 * DFE * DM); jb.N = DFE; jb.mode = 8 | (1 + w3);
                jb.base = 2 * T_IN + 2 * T_OUT + 2 * T_F13 + T_F2 + q * T_M13; }
            else if (t < 31) { const int e = t - 23; jb.src = p.moe_w2 + (size_t)e * DFE * DM; jb.dst = (bf16_t*)(ws + OFF_WM2 + (size_t)e * DM * DFE); jb.K = DFE; jb.mode = 8;
                jb.base = 2 * T_IN + 2 * T_OUT + 2 * T_F13 + T_F2 + 16 * T_M13 + e * T_M2; }
            jobs[t] = jb;
        }
        __syncthreads();
#define JOB_SRC(jj) ((const float*)(__attribute__((address_space(1))) const float*)(unsigned long long)jobs[jj].src)
#define JOB_DST(jj) ((bf16_t*)(__attribute__((address_space(1))) bf16_t*)(unsigned long long)jobs[jj].dst)
#define CV_U(v) ((v) < split ? (v) : (v) + skip)
        int j = 0; Ct4Regs cur, nxt;
        if (v0 < vend) { const int u0 = CV_U(v0); while (u0 >= jobs[j + 1].base) ++j; ct4_load(JOB_SRC(j), jobs[j].N, u0 - jobs[j].base, cur); }
        for (int v = v0; v < vend; v += vstep) {
            const int u = CV_U(v), vn = v + vstep < vend ? v + vstep : v, un = CV_U(vn); int jn = j;
            while (un >= jobs[jn + 1].base) ++jn;
            ct4_load(JOB_SRC(jn), jobs[jn].N, un - jobs[jn].base, nxt);
            ct4_store(cur, jobs[j].K, jobs[j].N, JOB_DST(j), u - jobs[j].base, jobs[j].mode, lds);
            cur = nxt; j = jn;
        }
#undef JOB_SRC
#undef JOB_DST
#undef CV_U
        __syncthreads();
    }
}

__device__ __forceinline__ void ph_prologue(const Params& p, int bid, int nb, float* lds) {
    char* ws = p.ws; const int t = TIDX;
    { const bool tails = nb == 256; convert_units(p, lds, bid, nb, tails ? CV_TOTAL - CV_TAILS : CV_TOTAL, CV_MOE0, tails ? CV_TAILS : 0); }
    {
        float* sv = lds;
        float* red = lds + 3072;
        for (int i = t; i < 3072; i += 512) { const int v = i >> 10, k = i & 1023; const float cv = v < 2 ? p.c[v * DM + k] : p.c_ctx[k]; sv[i] = siluf_(cv); }
        __syncthreads();
        float* mod = (float*)(ws + OFF_MOD);
        for (int u = bid; u < 2 * 96; u += nb) {
            const int l = u / 96, j0 = (u % 96) * 64, j = t & 63, kg = t >> 6;
            float a0 = 0.f, a1 = 0.f, a2 = 0.f;
            const float* w = p.w_ada + (size_t)l * DM * 6144 + j0 + j;
            for (int k = kg * 128; k < kg * 128 + 128; ++k) { const float wv = w[(size_t)k * 6144]; a0 += sv[k] * wv; a1 += sv[1024 + k] * wv; a2 += sv[2048 + k] * wv; }
            red[(kg * 3 + 0) * 64 + j] = a0; red[(kg * 3 + 1) * 64 + j] = a1; red[(kg * 3 + 2) * 64 + j] = a2;
            __syncthreads();
            if (t < 192) { const int v = t >> 6; float s = 0.f;
                for (int g = 0; g < 8; ++g) s += red[(g * 3 + v) * 64 + j];
                mod[((size_t)l * 3 + v) * 6144 + j0 + j] = s + p.b_ada[l * 6144 + j0 + j]; }
            __syncthreads();
        }
    }
    {
        const int gt = bid * 512 + t, gs = nb * 512;
        float* ta = (float*)(ws + OFF_TAB + TAB_ATTN); float* tr = (float*)(ws + OFF_TAB + TAB_RET); float* td = (float*)(ws + OFF_TAB + TAB_DIFF);
        const int j = gt & 31;
        const float inv_r = (float)pow(10000.0, -(double)j / 32.0), inv_a = (float)pow(10000.0, -(double)(j & 15) / 16.0), inv_d = (float)pow(10000.0, -(double)(j & 7) / 8.0);
        for (int i = gt; i < 16384 * 32; i += gs) { const int n = i >> 5; double sv, cv;
            { const float ang = (float)n * inv_r; sincos((double)ang, &sv, &cv); tr[i] = (float)cv; tr[16384 * 32 + i] = (float)sv; }
            { const float ang = (float)(j < 16 ? (n >> 6) : (n & 63)) * inv_a; sincos((double)ang, &sv, &cv); ta[i] = (float)cv; ta[16384 * 32 + i] = (float)sv; }
            if (j < 16) { const float ang = (float)(j < 8 ? (n >> 6) : (n & 63)) * inv_d; sincos((double)ang, &sv, &cv); td[n * 16 + j] = (float)cv; td[16384 * 16 + n * 16 + j] = (float)sv; } }
        float* xc = (float*)(ws + OFF_XC);
        for (int i = gt; i < NCR * DM / 4; i += gs) ((float4*)xc)[i] = ((const float4*)p.ctx)[i];
    }
}

template <bool ROUTE>
__device__ __forceinline__ void ph_norm(const Params& p, int l, int which  , int nrows, int bid, int nb, float* lds) {
    char* ws = p.ws; const int lane = TIDX & 63, wv = TIDX >> 6;
    LAS unsigned* lcnt = (LAS unsigned*)lds;
    if (ROUTE) { __syncthreads(); if (TIDX < 16) lcnt[TIDX] = 0u; __syncthreads(); }
    const float* mod = (const float*)(ws + OFF_MOD) + (size_t)l * 3 * 6144;
    const float* g = (which == 0 ? p.g1 : p.g2) + l * DM;
    bf16_t* H = (bf16_t*)(ws + OFF_ACT);
    const bool xin32 = which == 0 && l == 0;
    const float* xl = p.x; const bf16_t* xb = (const bf16_t*)(ws + OFF_XB);
    const float* xc = (const float*)(ws + OFF_XC);
    const int stride = nb * 8;
    float rw[ROUTE ? 4 : 1][4][8];
    if (ROUTE) {
#pragma unroll
        for (int i = 0; i < 4; ++i) { const float* rt = p.moe_router + (size_t)(i * 256 + lane * 4) * 8;
#pragma unroll
            for (int k = 0; k < 4; ++k) { const float4 a = *(const float4*)(rt + k * 8), b = *(const float4*)(rt + k * 8 + 4);
                rw[i][k][0] = a.x; rw[i][k][1] = a.y; rw[i][k][2] = a.z; rw[i][k][3] = a.w; rw[i][k][4] = b.x; rw[i][k][5] = b.y; rw[i][k][6] = b.z; rw[i][k][7] = b.w; } } }
    float4 ma[4], mb[4]; int ccls = -1;
    constexpr int NQ = ROUTE ? 1 : 2;
    for (int r0 = bid * 8 + wv; r0 < nrows; r0 += NQ * stride) {
        float4 v[NQ][4]; float ss[NQ]; const bool has1 = NQ == 2 && r0 + stride < nrows;
#pragma unroll
        for (int q = 0; q < NQ; ++q) { const int r = (q == 0 || has1) ? r0 + q * stride : r0;
            if (xin32 || r >= NLAT) { const float* xr = r < NLAT ? xl + (size_t)r * DM : xc + (size_t)(r - NLAT) * DM;
#pragma unroll
                for (int i = 0; i < 4; ++i) v[q][i] = *(const float4*)(xr + i * 256 + lane * 4); }
            else { const bf16_t* xr = xb + (size_t)r * DM;
#pragma unroll
                for (int i = 0; i < 4; ++i) { const uint2 w = *(const uint2*)(xr + i * 256 + lane * 4); v[q][i] = make_float4(BFLO(w.x), BFHI(w.x), BFLO(w.y), BFHI(w.y)); } } }
#pragma unroll
        for (int q = 0; q < NQ; ++q) { float s = 0.f;
#pragma unroll
            for (int i = 0; i < 4; ++i) s += v[q][i].x * v[q][i].x + v[q][i].y * v[q][i].y + v[q][i].z * v[q][i].z + v[q][i].w * v[q][i].w;
            ss[q] = wave_sum(s); }
#pragma unroll
        for (int q = 0; q < NQ; ++q) {
            if (q == 1 && !has1) break;
            const int r = r0 + q * stride;
            const int cls = __builtin_amdgcn_readfirstlane(mod_class(r));
            if (cls != ccls) { const float* mv = mod + (size_t)cls * 6144 + (which == 0 ? 0 : 3072); ccls = cls;
#pragma unroll
                for (int i = 0; i < 4; ++i) { const int c = i * 256 + lane * 4; const float4 gg = *(const float4*)(g + c), sh = *(const float4*)(mv + c), sc = *(const float4*)(mv + 1024 + c);
                    ma[i] = make_float4(gg.x * (1.f + sc.x), gg.y * (1.f + sc.y), gg.z * (1.f + sc.z), gg.w * (1.f + sc.w)); mb[i] = sh; } }
            const float rn = rsqrtf(ss[q] * (1.0f / 1024.0f) + 1e-6f);
            float lg[8];
            if (ROUTE) {
#pragma unroll
                for (int e = 0; e < 8; ++e) lg[e] = 0.f;
            }
#pragma unroll
            for (int i = 0; i < 4; ++i) {
                const int c = i * 256 + lane * 4;
                float h0 = v[q][i].x * rn * ma[i].x + mb[i].x, h1 = v[q][i].y * rn * ma[i].y + mb[i].y;
                float h2 = v[q][i].z * rn * ma[i].z + mb[i].z, h3 = v[q][i].w * rn * ma[i].w + mb[i].w;
                if (which == 1) *(unsigned*)((unsigned char*)H + (size_t)r * DM + c) = pack4_fp8(h0 * F8_ASCALE, h1 * F8_ASCALE, h2 * F8_ASCALE, h3 * F8_ASCALE);
                else { uint2 w; w.x = pack2(h0, h1); w.y = pack2(h2, h3); *(uint2*)(H + (size_t)r * DM + c) = w; }
                if (ROUTE) {
#pragma unroll
                    for (int e = 0; e < 8; ++e) lg[e] += h0 * rw[ROUTE ? i : 0][0][e] + h1 * rw[ROUTE ? i : 0][1][e] + h2 * rw[ROUTE ? i : 0][2][e] + h3 * rw[ROUTE ? i : 0][3][e];
                }
            }
            if (ROUTE) {
#pragma unroll
                for (int e = 0; e < 8; ++e) lg[e] = wave_sum(lg[e]);
                if (lane == 0 && r < NLAT) {
                    int e0 = 0; float v0 = lg[0];
#pragma unroll
                    for (int e = 1; e < 8; ++e) if (lg[e] > v0) { v0 = lg[e]; e0 = e; }
                    int e1 = -1; float v1 = -3.0e38f;
#pragma unroll
                    for (int e = 0; e < 8; ++e) if (e != e0 && lg[e] > v1) { v1 = lg[e]; e1 = e; }
                    const float ex = __expf(v1 - v0), w0 = 1.0f / (1.0f + ex), w1 = ex / (1.0f + ex);
                    const unsigned li0 = __hip_atomic_fetch_add(lcnt + e0, 1u, __ATOMIC_RELAXED, __HIP_MEMORY_SCOPE_WORKGROUP), li1 = __hip_atomic_fetch_add(lcnt + 8 + e1, 1u, __ATOMIC_RELAXED, __HIP_MEMORY_SCOPE_WORKGROUP);
                    int4 rec; rec.x = e0 | (int)(li0 << 4); rec.y = e1 | (int)(li1 << 4); rec.z = __float_as_int(w0); rec.w = __float_as_int(w1);
                    *(int4*)(ws + OFF_ROUTE + (size_t)r * 16) = rec;
                }
            }
        }
    }
    if (ROUTE) {
        __syncthreads();
        if (TIDX < 16) { unsigned* cw = (unsigned*)ws; const int t = TIDX; cw[CW_BLK + bid * 16 + t] = atomicAdd(cw + CW_CNT + t, lcnt[t]); }
    }
}

namespace pg8 {
#define PG8_LAS __attribute__((address_space(3)))
typedef unsigned short bf16_t;
typedef short bf16x8 __attribute__((ext_vector_type(8)));
typedef float f32x4 __attribute__((ext_vector_type(4)));
typedef unsigned u32x4 __attribute__((ext_vector_type(4)));
constexpr int BM = 256, BK = 64, HALF = 128, HTB = HALF * BK * 2  , STAGE_BYTES = 8 * HTB, NXCD = 8, WGM = 8;

__host__ __device__ __forceinline__ int lds_byte(int r, int c) { const int st = (r >> 4) * 2 + (c >> 5), rr = r & 15, cc = c & 31, ob = rr * 64 + cc * 2; return st * 1024 + (ob ^ (((ob >> 9) & 1) << 5)); }
__host__ __device__ __forceinline__ void stage_rc(int b, int& R, int& C) { const int st = b / 1024, sb = b % 1024, swz = sb ^ (((sb >> 9) & 1) << 5); R = (st >> 1) * 16 + swz / 64; C = (st & 1) * 32 + (swz % 64) / 2; }
__host__ __device__ __forceinline__ int perm32(int rho) { const int n = rho >> 4, i = rho & 15; return 8 * (i >> 2) + 4 * n + (i & 3); }

struct Unit { int pm, pn; };
struct Gemm { const bf16_t* A; const bf16_t* Bt; int M, N, K; };

struct StaticOrder {
    int nM, nN, nwg, G, c;
    __host__ __device__ void init(int M, int N, int G_, int c_) { nM = M / BM; nN = N / BM; nwg = nM * nN; G = G_; c = c_; }
    __host__ __device__ bool next(int i, Unit& u) const {
        const long L = (long)i * G + c; if (L >= nwg) return false;
        int wgid = (int)L; { const int q = nwg / NXCD, r = nwg % NXCD, xcd = wgid % NXCD, off = wgid / NXCD; wgid = (xcd < r ? xcd * (q + 1) : r * (q + 1) + (xcd - r) * q) + off; }
        const int nig = WGM * nN, gid = wgid / nig, fm = gid * WGM, gsz = (nM - fm) < WGM ? (nM - fm) : WGM;
        u.pm = fm + ((wgid % nig) % gsz); u.pn = (wgid % nig) / gsz; return true;
    }
    __device__ __forceinline__ void a_ready(const Unit&) const {}
    __device__ __forceinline__ void done(const Unit&) const {}
};
__device__ __forceinline__ unsigned cvt_pk_bf16(float lo, float hi) { unsigned r; asm volatile("v_cvt_pk_bf16_f32 %0, %1, %2" : "=v"(r) : "v"(lo), "v"(hi)); return r; }
typedef float f32x2 __attribute__((ext_vector_type(2)));
typedef int i32x4_t __attribute__((ext_vector_type(4)));
typedef int i32x8_t __attribute__((ext_vector_type(8)));
__device__ __forceinline__ i32x8_t cat8(bf16x8 lo, bf16x8 hi) { const i32x4_t a = __builtin_bit_cast(i32x4_t, lo), b = __builtin_bit_cast(i32x4_t, hi); return __builtin_shufflevector(a, b, 0, 1, 2, 3, 4, 5, 6, 7); }
template <class Epi, class Sched, bool ALIGN_EPI = false, bool SP2 = false, bool F8 = false>
__device__ __forceinline__ void gemm_phase(PG8_LAS unsigned char* lds, const Gemm g, const Sched& S, const Epi& E) {
    int tid_ = threadIdx.x; asm volatile("" : "+v"(tid_));
    const int tid = tid_, wid = __builtin_amdgcn_readfirstlane(tid >> 6), lane = tid & 63, wr = wid >> 2, wc = wid & 3, fr = lane & 15, fq = lane >> 4;
    const int K = g.K, nt = K / BK;
    unsigned voffA[1], voffB[1];
    { int R, C; stage_rc(tid * 16, R, C); const int Rb = Epi::PERM ? ((R & ~31) + perm32(R & 31)) : R;
        voffA[0] = (unsigned)(R * K + C) * 2u; voffB[0] = (unsigned)(Rb * K + C) * 2u; }
    const size_t pstep = (size_t)64 * K * 2;
    const size_t kstep = (size_t)(BK * 2);
    const size_t hstep = (size_t)HALF * K * 2;
    const size_t tstep = 2 * hstep;
    const unsigned ldsw = (unsigned)wid * 1024u;
    const int aoff = lds_byte(wr * 64 + fr, fq * (F8 ? 16 : 8)), boff = lds_byte(wc * 32 + fr, fq * (F8 ? 16 : 8));
#define PG8_SA(b, h) (((b) * 2 + (h)) * HTB)
#define PG8_SB(b, h) ((4 + (b) * 2 + (h)) * HTB)
#define PG8_STAGE(bufoff, gbase, voff) do { _Pragma("unroll") for (int _i = 0; _i < 2; ++_i) { unsigned vo_ = (voff)[0]; asm volatile("" : "+v"(vo_));   \
        __builtin_amdgcn_global_load_lds((const unsigned*)((const char*)(gbase) + _i * pstep + vo_), (PG8_LAS unsigned*)(lds + (bufoff) + ldsw + _i * 8192), 16, 0, 0); } } while (0)
#define PG8_LDA(dst, b, h) do { _Pragma("unroll") for (int m = 0; m < 4; ++m) { \
        if constexpr (F8) dst##8[m] = cat8(*(const PG8_LAS bf16x8*)(lds + PG8_SA(b, h) + aoff + m * 2048), *(const PG8_LAS bf16x8*)(lds + PG8_SA(b, h) + aoff + m * 2048 + 16)); \
        else { _Pragma("unroll") for (int k = 0; k < 2; ++k) dst[m][k] = *(const PG8_LAS bf16x8*)(lds + PG8_SA(b, h) + aoff + m * 2048 + k * 1024); } } } while (0)
#define PG8_LDB(dst, b, h) do { _Pragma("unroll") for (int n = 0; n < 2; ++n) { \
        if constexpr (F8) dst##8[n] = cat8(*(const PG8_LAS bf16x8*)(lds + PG8_SB(b, h) + boff + n * 2048), *(const PG8_LAS bf16x8*)(lds + PG8_SB(b, h) + boff + n * 2048 + 16)); \
        else { _Pragma("unroll") for (int k = 0; k < 2; ++k) dst[n][k] = *(const PG8_LAS bf16x8*)(lds + PG8_SB(b, h) + boff + n * 2048 + k * 1024); } } } while (0)
#define PG8_MMA(ai, bj, At, Bt) do { __builtin_amdgcn_s_setprio(1); _Pragma("unroll") for (int m = 0; m < 4; ++m) _Pragma("unroll") for (int n = 0; n < 2; ++n) { \
        if constexpr (F8) acc[ai][bj][m][n] = __builtin_amdgcn_mfma_scale_f32_16x16x128_f8f6f4(Bt##8[n], At##8[m], acc[ai][bj][m][n], 0, 0, 0, F8_SCALES, 1, F8_SCALES); \
        else { _Pragma("unroll") for (int k = 0; k < 2; ++k) acc[ai][bj][m][n] = __builtin_amdgcn_mfma_f32_16x16x32_bf16(Bt[n][k], At[m][k], acc[ai][bj][m][n], 0, 0, 0); } } \
        __builtin_amdgcn_s_setprio(0); } while (0)
#define PG8_WAIT_V(n) asm volatile("s_waitcnt vmcnt(" #n ")" ::: "memory")
#define PG8_WAIT_L(n) asm volatile("s_waitcnt lgkmcnt(" #n ")" ::: "memory")
#define PG8_BAR __builtin_amdgcn_s_barrier()
#define PG8_SCHED __builtin_amdgcn_sched_barrier(0)
    Unit cur, nxt; int ui = 0;
    if (!S.next(0, cur)) return;
    f32x4 acc[2][2][4][2];
#pragma unroll
    for (int a = 0; a < 2; ++a)
#pragma unroll
        for (int b = 0; b < 2; ++b)
#pragma unroll
            for (int m = 0; m < 4; ++m)
#pragma unroll
                for (int n = 0; n < 2; ++n) acc[a][b][m][n] = (f32x4){0.f, 0.f, 0.f, 0.f};
    bf16x8 At[4][2], B0[2][2], B1[2][2]; i32x8_t At8[4], B08[2], B18[2];
    const char* cA = (const char*)g.A + (size_t)cur.pm * tstep; const char* cB = (const char*)g.Bt + (size_t)cur.pn * tstep;
    S.a_ready(cur);
    if constexpr (SP2) {
        PG8_STAGE(PG8_SB(0, 0), cB, voffB); PG8_STAGE(PG8_SB(0, 1), cB + hstep, voffB); PG8_STAGE(PG8_SA(0, 0), cA, voffA); PG8_STAGE(PG8_SA(0, 1), cA + hstep, voffA);
        if (wr == 1) PG8_BAR;
        PG8_WAIT_V(2); PG8_BAR;
        PG8_STAGE(PG8_SB(1, 0), cB + kstep, voffB); PG8_STAGE(PG8_SA(1, 0), cA + kstep, voffA); PG8_STAGE(PG8_SB(1, 1), cB + hstep + kstep, voffB);
        PG8_WAIT_V(6); PG8_BAR;
    } else {
        PG8_STAGE(PG8_SB(0, 0), cB, voffB); PG8_STAGE(PG8_SA(0, 0), cA, voffA); PG8_STAGE(PG8_SB(0, 1), cB + hstep, voffB); PG8_STAGE(PG8_SA(0, 1), cA + hstep, voffA);
        if (wr == 1) PG8_BAR;
        PG8_WAIT_V(4); PG8_BAR;
        PG8_STAGE(PG8_SB(1, 0), cB + kstep, voffB); PG8_STAGE(PG8_SA(1, 0), cA + kstep, voffA); PG8_STAGE(PG8_SB(1, 1), cB + hstep + kstep, voffB);
        PG8_WAIT_V(6); PG8_BAR;
    }
    for (;;) {
        const bool has_next = S.next(ui + 1, nxt);
        const char* nA = has_next ? (const char*)g.A + (size_t)nxt.pm * tstep : cA; const char* nB = has_next ? (const char*)g.Bt + (size_t)nxt.pn * tstep : cB;
#pragma unroll 1
        for (int t = 0; t < nt; t += 2) {
            const bool last = (t == nt - 2);
            const char* a1 = cA + (size_t)(t + 1) * kstep;
            const char* a2 = last ? nA : cA + (size_t)(t + 2) * kstep; const char* b2 = last ? nB : cB + (size_t)(t + 2) * kstep;
            const char* a3 = a2 + kstep; const char* b3 = b2 + kstep;
            if (last && has_next) S.a_ready(nxt);
            if constexpr (SP2) {
            PG8_LDB(B0, 0, 0); PG8_LDB(B1, 0, 1); PG8_SCHED; PG8_LDA(At, 0, 0); PG8_STAGE(PG8_SA(1, 1), a1 + hstep, voffA);
            PG8_WAIT_V(8); PG8_WAIT_L(0); PG8_BAR; PG8_MMA(0, 0, At, B0); PG8_MMA(0, 1, At, B1); PG8_BAR; PG8_SCHED;
            PG8_LDA(At, 0, 1); PG8_STAGE(PG8_SB(0, 0), b2, voffB); PG8_STAGE(PG8_SB(0, 1), b2 + hstep, voffB); PG8_STAGE(PG8_SA(0, 0), a2, voffA);
            PG8_WAIT_V(8); PG8_WAIT_L(0); PG8_BAR; PG8_MMA(1, 0, At, B0); PG8_MMA(1, 1, At, B1); PG8_BAR; PG8_SCHED;
            PG8_LDB(B0, 1, 0); PG8_LDB(B1, 1, 1); PG8_SCHED; PG8_LDA(At, 1, 0); PG8_STAGE(PG8_SA(0, 1), a2 + hstep, voffA);
            PG8_WAIT_V(8); PG8_WAIT_L(0); PG8_BAR; PG8_MMA(0, 0, At, B0); PG8_MMA(0, 1, At, B1); PG8_BAR; PG8_SCHED;
            PG8_LDA(At, 1, 1); PG8_STAGE(PG8_SB(1, 0), b3, voffB); PG8_STAGE(PG8_SB(1, 1), b3 + hstep, voffB); PG8_STAGE(PG8_SA(1, 0), a3, voffA);
            PG8_WAIT_V(8); PG8_WAIT_L(0); PG8_BAR; PG8_MMA(1, 0, At, B0); PG8_MMA(1, 1, At, B1); PG8_BAR; PG8_SCHED;
            } else {
            PG8_LDB(B0, 0, 0); PG8_SCHED; PG8_LDA(At, 0, 0); PG8_STAGE(PG8_SA(1, 1), a1 + hstep, voffA);
            PG8_WAIT_L(8); PG8_BAR; PG8_WAIT_L(0); PG8_MMA(0, 0, At, B0); PG8_BAR; PG8_SCHED;
            PG8_LDB(B1, 0, 1); PG8_STAGE(PG8_SB(0, 0), b2, voffB);
            PG8_BAR; PG8_WAIT_L(0); PG8_MMA(0, 1, At, B1); PG8_BAR;
            PG8_LDA(At, 0, 1); PG8_STAGE(PG8_SA(0, 0), a2, voffA);
            PG8_BAR; PG8_WAIT_L(0); PG8_MMA(1, 0, At, B0); PG8_BAR; PG8_SCHED;
            PG8_STAGE(PG8_SB(0, 1), b2 + hstep, voffB);
            PG8_WAIT_V(6); PG8_BAR; PG8_MMA(1, 1, At, B1); PG8_BAR;
            PG8_LDB(B0, 1, 0); PG8_SCHED; PG8_LDA(At, 1, 0); PG8_STAGE(PG8_SA(0, 1), a2 + hstep, voffA);
            PG8_WAIT_L(8); PG8_BAR; PG8_WAIT_L(0); PG8_MMA(0, 0, At, B0); PG8_BAR; PG8_SCHED;
            PG8_LDB(B1, 1, 1); PG8_STAGE(PG8_SB(1, 0), b3, voffB);
            PG8_BAR; PG8_WAIT_L(0); PG8_MMA(0, 1, At, B1); PG8_BAR;
            PG8_LDA(At, 1, 1); PG8_STAGE(PG8_SA(1, 0), a3, voffA);
            PG8_BAR; PG8_WAIT_L(0); PG8_MMA(1, 0, At, B0); PG8_BAR; PG8_SCHED;
            PG8_STAGE(PG8_SB(1, 1), b3 + hstep, voffB);
            PG8_WAIT_V(6); PG8_BAR; PG8_MMA(1, 1, At, B1); PG8_BAR;
            }
        }
        if constexpr (ALIGN_EPI) { if (wr == 0) PG8_BAR; }
        if constexpr (!Epi::AFTER_DRAIN) { E(acc, cur, wr, wc, fr, fq); S.done(cur); }
        if (!has_next) break;
#pragma unroll
        for (int a = 0; a < 2; ++a)
#pragma unroll
            for (int b = 0; b < 2; ++b)
#pragma unroll
                for (int m = 0; m < 4; ++m)
#pragma unroll
                    for (int n = 0; n < 2; ++n) acc[a][b][m][n] = (f32x4){0.f, 0.f, 0.f, 0.f};
        cur = nxt; cA = nA; cB = nB; ++ui;
        if constexpr (ALIGN_EPI) { if (wr == 1) PG8_BAR; }
    }
    PG8_WAIT_V(0);
    if constexpr (!ALIGN_EPI) { if (wr == 0) PG8_BAR; }
    PG8_BAR;
    if constexpr (Epi::AFTER_DRAIN) { E.fused(acc, cur, wr, wc, fr, fq, lds, wid, lane); S.done(cur); }
#undef PG8_SA
#undef PG8_SB
#undef PG8_STAGE
#undef PG8_LDA
#undef PG8_LDB
#undef PG8_MMA
#undef PG8_WAIT_V
#undef PG8_WAIT_L
#undef PG8_BAR
#undef PG8_SCHED
}
}

constexpr int RT_K = 0, RT_V = 32768, RT_ST = 65536;
template <bool KV> __device__ __forceinline__ void ret_stage(const bf16_t* P, int rb, int hp, LAS char* sm, int tid, int wid, int lane) {
    const int vrow = 16 * (wid & 3) + (lane >> 2), vc = (wid >> 2) * 32 + (lane & 3) * 8;
    u32x4 kk[4], vv[4];
#pragma unroll
    for (int i = 0; i < 4; ++i) { const int hh = i >> 1, tt = i & 1, h = 2 * hp + hh, r0 = rb + tt * 64;
        vv[i] = *(const u32x4*)(P + (size_t)(r0 + vrow) * DIN + C_RV + h * 64 + vc);
        kk[i] = KV ? *(const u32x4*)(P + (size_t)(r0 + vrow) * DIN + C_RK + h * 64 + vc) : *(const u32x4*)(P + (size_t)(r0 + lane) * DIN + C_RK + h * 64 + wid * 8); }
#pragma unroll
    for (int i = 0; i < 4; ++i) { *(LAS u32x4*)(sm + RT_K + i * 8192 + tid * 16) = kk[i]; *(LAS u32x4*)(sm + RT_V + i * 8192 + tid * 16) = vv[i]; }
}
constexpr int CW_QUE = 6016;
constexpr int QUE_LDS_WORD = 33792 + 4 + 64;
struct UnitQ { unsigned* ctr; int pend; };
__device__ __forceinline__ void q_prefetch(UnitQ& q) { if (TIDX == 0) q.pend = (int)atomicAdd(q.ctr, 1u); }
__device__ __forceinline__ int q_take(UnitQ& q, float* lds) {
    LAS int* slot = (LAS int*)lds + QUE_LDS_WORD;
    __syncthreads();
    if (TIDX == 0) *slot = q.pend;
    __syncthreads();
    return __builtin_amdgcn_readfirstlane(*slot);
}
__device__ __forceinline__ float ret_lg(const Params& p, int l, int dir, int h) { return -softplusf_(-p.ret_logit[(l * 2 + dir) * 4 + h]); }
__device__ __forceinline__ void ph_ret_summ(const Params& p, int l, int bid, int nb, float* lds) {
    char* ws = p.ws; const int tid = TIDX, lane = tid & 63, r32 = lane & 31, hi = lane >> 5, wid = __builtin_amdgcn_readfirstlane(tid >> 6);
    const bf16_t* P = (const bf16_t*)(ws + OFF_P); float* RET = (float*)(ws + OFF_RET);
    LAS char* sm = (LAS char*)lds;
    UnitQ uq{(unsigned*)ws + CW_QUE + l * 16 + 2, 0}; q_prefetch(uq);
    for (int u = q_take(uq, lds); u < 2 * NCI * 2; u = q_take(uq, lds)) {
        q_prefetch(uq);
        const int hp = u & 1, ci = (u >> 1) % NCI, b = (u >> 1) / NCI, rb = row_base(b, ci);
        __syncthreads();
        ret_stage<true>(P, rb, hp, sm, tid, wid, lane);
        __syncthreads();
        const int hh = wid >> 2, dh = (wid >> 1) & 1, eh = wid & 1, h = 2 * hp + hh;
        const float lg2f = ret_lg(p, l, 0, h) * 1.4426950408889634f, lg2b = ret_lg(p, l, 1, h) * 1.4426950408889634f;
        const int voff = ((lane >> 4) & 1) * 32 + (lane & 3) * 8 + (4 * hi + ((lane & 15) >> 2)) * 64;
        const LAS char* Kb = sm + RT_K + hh * 16384 + dh * 4096 + voff; const LAS char* Vb = sm + RT_V + hh * 16384 + eh * 4096 + voff;
        f32x16 a0, a1;
#pragma unroll
        for (int r = 0; r < 16; ++r) { a0[r] = 0.f; a1[r] = 0.f; }
#pragma unroll
        for (int k8 = 0; k8 < 8; ++k8) { const int tt = k8 >> 2, sl = k8 & 3;
            const s16x4 klo = vtr(Kb + tt * 8192 + sl * 1024), khi = vtr(Kb + tt * 8192 + sl * 1024 + 512), vlo = vtr(Vb + tt * 8192 + sl * 1024), vhi = vtr(Vb + tt * 8192 + sl * 1024 + 512);
            const int mb = tt * 64 + sl * 16 + 4 * hi; float kf_[8], kb_[8];
#pragma unroll
            for (int j = 0; j < 8; ++j) { const int m = mb + (j < 4 ? j : j + 4); const float kv = bfs(j < 4 ? klo[j] : khi[j - 4]);
                kf_[j] = kv * __builtin_amdgcn_exp2f(lg2f * (float)(127 - m)); kb_[j] = kv * __builtin_amdgcn_exp2f(lg2b * (float)m); }
            const u32x4 af = {cvtpk_s(kf_[0], kf_[1]), cvtpk_s(kf_[2], kf_[3]), cvtpk_s(kf_[4], kf_[5]), cvtpk_s(kf_[6], kf_[7])};
            const u32x4 ab = {cvtpk_s(kb_[0], kb_[1]), cvtpk_s(kb_[2], kb_[3]), cvtpk_s(kb_[4], kb_[5]), cvtpk_s(kb_[6], kb_[7])};
            const bf16x8 vfr = {vlo[0], vlo[1], vlo[2], vlo[3], vhi[0], vhi[1], vhi[2], vhi[3]};
            a0 = __builtin_amdgcn_mfma_f32_32x32x16_bf16(__builtin_bit_cast(bf16x8, af), vfr, a0, 0, 0, 0);
            a1 = __builtin_amdgcn_mfma_f32_32x32x16_bf16(__builtin_bit_cast(bf16x8, ab), vfr, a1, 0, 0, 0); }
        float* of = RET + ((((size_t)0 * 2 + b) * NCI + ci) * 4 + h) * 4096 + eh * 32 + r32;
        float* ob = RET + ((((size_t)1 * 2 + b) * NCI + ci) * 4 + h) * 4096 + eh * 32 + r32;
#pragma unroll
        for (int r = 0; r < 16; ++r) { const int d = dh * 32 + crow(r, hi); of[d * 64] = a0[r]; ob[d * 64] = a1[r]; }
    }
}

constexpr int LR_UB = 0, LR_A = 18432, LR_B = 51200, LR_H = 83968, LR_SEG = 116736, LR_CW = 120832;
template <int MODE>
__device__ __forceinline__ void ph_lru_chunk(const Params& p, int l, int bid, int nb, float* lds, int ci_lo) {
    char* ws = p.ws; const int tid = TIDX, lane = tid & 63, r32 = lane & 31, hi = lane >> 5, wid = __builtin_amdgcn_readfirstlane(tid >> 6);
    const bf16_t* P = (const bf16_t*)(ws + OFF_P);
    float* LA = (float*)(ws + OFF_LRU); float* LB = LA + 2 * 2 * NCI * 256; float* LC = LB + 2 * 2 * NCI * 256;
    bf16_t* O = (bf16_t*)(ws + OFF_ACT);
    LAS char* sm = (LAS char*)lds;
    const int hb = bid & 3, tt = wid >> 1, jt = wid & 1, jcol = jt * 32 + r32, ch = hb * 64 + jcol;
    bf16x8 wfr[2][2][4]; float bia[2][2], spl[2];
#pragma unroll
    for (int dir = 0; dir < 2; ++dir) {
#pragma unroll
        for (int gt = 0; gt < 2; ++gt) { const float* W = (gt == 0 ? p.lru_wa : p.lru_wx) + (((size_t)(l * 2 + dir) * 4 + hb) * 64) * 64 + jcol;
#pragma unroll
            for (int ks = 0; ks < 4; ++ks) { const float* wp = W + (16 * ks + 8 * hi) * 64;
                const u32x4 w4 = {cvtpk_s(wp[0], wp[64]), cvtpk_s(wp[128], wp[192]), cvtpk_s(wp[256], wp[320]), cvtpk_s(wp[384], wp[448])};
                wfr[dir][gt][ks] = __builtin_bit_cast(bf16x8, w4); }
            bia[dir][gt] = (gt == 0 ? p.lru_ba : p.lru_bx)[(l * 2 + dir) * 256 + ch]; }
        spl[dir] = -8.0f * softplusf_(-p.lru_lam[(l * 2 + dir) * 256 + ch]); }
    const int nci = NCI - ci_lo, npair = 2 * nci;
    LAS float* cwl = (LAS float*)(sm + LR_CW);
    __syncthreads();
    if (tid < 320) cwl[tid] = tid < 256 ? p.conv_w[(l * 4 + (tid >> 6)) * 256 + hb * 64 + (tid & 63)] : p.conv_b[l * 256 + hb * 64 + (tid - 256)];
    UnitQ uq{(unsigned*)ws + CW_QUE + l * 16 + (MODE == 3 ? 4 : 8) + hb, 0}; q_prefetch(uq);
    for (int pi = q_take(uq, lds); pi < npair; pi = q_take(uq, lds)) {
        q_prefetch(uq);
        const int ci = ci_lo + pi % nci, b = pi / nci, rb = row_base(b, ci);
        const int seg_lo = ci < 2 ? NLAT + b * NCTX : b * NSEQ, seg_hi = ci < 2 ? seg_lo + NCTX : seg_lo + NSEQ;
        __syncthreads();
#pragma unroll
        for (int it = 0; it < 2; ++it) { const int item = it * 512 + tid, t = item >> 3, c8 = (item & 7) * 8, c0 = hb * 64 + c8;
            float acc[8];
            { const f32x4 b0 = *(const LAS f32x4*)(cwl + 256 + c8), b1 = *(const LAS f32x4*)(cwl + 256 + c8 + 4);
              acc[0] = b0[0]; acc[1] = b0[1]; acc[2] = b0[2]; acc[3] = b0[3]; acc[4] = b1[0]; acc[5] = b1[1]; acc[6] = b1[2]; acc[7] = b1[3]; }
#pragma unroll
            for (int k = 0; k < 4; ++k) { const int rr = rb + t - 1 + k;
                if (rr >= seg_lo && rr < seg_hi) { const bf16x8 xv = *(const bf16x8*)(P + (size_t)rr * DIN + C_LX + c0);
                    const f32x4 w0 = *(const LAS f32x4*)(cwl + k * 64 + c8), w1 = *(const LAS f32x4*)(cwl + k * 64 + c8 + 4);
                    acc[0] += w0[0] * bfs(xv[0]); acc[1] += w0[1] * bfs(xv[1]); acc[2] += w0[2] * bfs(xv[2]); acc[3] += w0[3] * bfs(xv[3]);
                    acc[4] += w1[0] * bfs(xv[4]); acc[5] += w1[1] * bfs(xv[5]); acc[6] += w1[2] * bfs(xv[6]); acc[7] += w1[3] * bfs(xv[7]); } }
            const u32x4 w = {cvtpk_s(acc[0], acc[1]), cvtpk_s(acc[2], acc[3]), cvtpk_s(acc[4], acc[5]), cvtpk_s(acc[6], acc[7])};
            *(LAS u32x4*)(sm + LR_UB + t * 144 + c8 * 2) = w; }
        __syncthreads();
        bf16x8 ua[4];
#pragma unroll
        for (int ks = 0; ks < 4; ++ks) ua[ks] = *(const LAS bf16x8*)(sm + LR_UB + (tt * 32 + r32) * 144 + (16 * ks + 8 * hi) * 2);
#pragma unroll
        for (int dir = 0; dir < 2; ++dir) {
            f32x16 ga, gx;
#pragma unroll
            for (int r = 0; r < 16; ++r) { ga[r] = bia[dir][0]; gx[r] = bia[dir][1]; }
#pragma unroll
            for (int ks = 0; ks < 4; ++ks) { ga = __builtin_amdgcn_mfma_f32_32x32x16_bf16(ua[ks], wfr[dir][0][ks], ga, 0, 0, 0); gx = __builtin_amdgcn_mfma_f32_32x32x16_bf16(ua[ks], wfr[dir][1][ks], gx, 0, 0, 0); }
#pragma unroll
            for (int r = 0; r < 16; ++r) { const int t = tt * 32 + crow(r, hi);
                const float rg = __builtin_amdgcn_rcpf(1.0f + __expf(-ga[r])), ig = __builtin_amdgcn_rcpf(1.0f + __expf(-gx[r]));
                const float a = __expf(spl[dir] * rg);
                const float uu = __uint_as_float(((unsigned)*(const LAS unsigned short*)(sm + LR_UB + t * 144 + jcol * 2)) << 16);
                *(LAS float*)(sm + LR_A + (t * 64 + jcol) * 4) = a;
                *(LAS float*)(sm + LR_B + (t * 64 + jcol) * 4) = sqrtf(fmaxf(1.0f - a * a, 0.f)) * (ig * uu); }
            __syncthreads();
            {
                const size_t cidx = (((size_t)dir * 2 + b) * NCI + ci) * 256 + hb * 64 + lane;
                float cin = MODE == 3 ? LC[cidx] : 0.f;
                LAS float* as_ = (LAS float*)(sm + LR_A) + lane; LAS float* bs_ = (LAS float*)(sm + LR_B) + lane; LAS float* hs = (LAS float*)(sm + LR_H) + lane;
                LAS float* sg = (LAS float*)(sm + LR_SEG) + lane;
                {   float h = 0.f, c = 1.f;
#pragma unroll 1
                    for (int k0 = 0; k0 < 16; k0 += 8) { float cl[8], hl[8];
#pragma unroll
                        for (int k = 0; k < 8; ++k) { const int s = wid * 16 + k0 + k, t = dir == 0 ? s : 127 - s; cl[k] = as_[t * 64]; hl[k] = bs_[t * 64]; }
#pragma unroll
                        for (int k = 0; k < 8; ++k) { const int s = wid * 16 + k0 + k, t = dir == 0 ? s : 127 - s; h = cl[k] * h + hl[k]; c *= cl[k]; as_[t * 64] = c; bs_[t * 64] = h; } }
                    sg[wid * 64] = c; sg[(8 + wid) * 64] = h; }
                __syncthreads();
                float pa = 1.f;
                for (int v = 0; v < wid; ++v) { const float sa = sg[v * 64]; cin = sa * cin + sg[(8 + v) * 64]; pa *= sa; }
                if (MODE == 1) { if (wid == 7) { const float c7 = sg[7 * 64], h7 = sg[15 * 64]; LA[cidx] = pa * c7; LB[cidx] = c7 * cin + h7; } }
                else {
#pragma unroll 1
                    for (int k0 = 0; k0 < 16; k0 += 8) {
#pragma unroll
                        for (int k = 0; k < 8; ++k) { const int s = wid * 16 + k0 + k, t = dir == 0 ? s : 127 - s; const float val = bs_[t * 64] + as_[t * 64] * cin;
                            if (dir == 0) hs[t * 64] = val; else hs[t * 64] += val; } }
                }
            }
            __syncthreads();
        }
        if (MODE == 3) {
            bf16x8 yv2[2];
#pragma unroll
            for (int it = 0; it < 2; ++it) { const int item = it * 512 + tid, t = item >> 3, c8 = (item & 7) * 8, c0 = hb * 64 + c8; yv2[it] = *(const bf16x8*)(P + (size_t)(rb + t) * DIN + C_LY + c0); }
#pragma unroll
            for (int it = 0; it < 2; ++it) { const int item = it * 512 + tid, t = item >> 3, c8 = (item & 7) * 8, c0 = hb * 64 + c8;
                const f32x4 h0 = *(const LAS f32x4*)(sm + LR_H + (t * 64 + c8) * 4), h1 = *(const LAS f32x4*)(sm + LR_H + (t * 64 + c8 + 4) * 4);
                const bf16x8 yv = yv2[it];
                const u32x4 w = {cvtpk_s(h0[0] * gelu_tanh(bfs(yv[0])), h0[1] * gelu_tanh(bfs(yv[1]))), cvtpk_s(h0[2] * gelu_tanh(bfs(yv[2])), h0[3] * gelu_tanh(bfs(yv[3]))),
                                 cvtpk_s(h1[0] * gelu_tanh(bfs(yv[4])), h1[1] * gelu_tanh(bfs(yv[5]))), cvtpk_s(h1[2] * gelu_tanh(bfs(yv[6])), h1[3] * gelu_tanh(bfs(yv[7])))};
                *(u32x4*)(O + (size_t)(rb + t) * DM + 768 + c0) = w; }
        }
    }
}

__device__ __forceinline__ int scan_ci(int dir, int s) { return dir == 0 ? s : (s == 0 ? 1 : (s == 1 ? 0 : NCI + 1 - s)); }
__device__ __forceinline__ void ph_scan2(const Params& p, int l, int bid, int nb) {
    char* ws = p.ws; const int gt = bid * 512 + TIDX, gs = nb * 512;
    float* RET = (float*)(ws + OFF_RET);
    for (int i = gt; i < 2 * 2 * 4 * 4096; i += gs) {
        const int de = i & 4095, h = (i >> 12) & 3, b = (i >> 14) & 1, dir = i >> 15;
        const float decay = expf(ret_lg(p, l, dir, h) * 128.0f); float S = 0.f;
        float* base = RET + (((size_t)dir * 2 + b) * NCI * 4 + h) * 4096 + de;
        float ua[13], ub[13];
#pragma unroll
        for (int j = 0; j < 13; ++j) ua[j] = base[(size_t)scan_ci(dir, j) * 4 * 4096];
#pragma unroll 1
        for (int s0 = 0; s0 < NCI; s0 += 26) {
#pragma unroll
            for (int j = 0; j < 13; ++j) ub[j] = base[(size_t)scan_ci(dir, s0 + 13 + j) * 4 * 4096];
#pragma unroll
            for (int j = 0; j < 13; ++j) { base[(size_t)scan_ci(dir, s0 + j) * 4 * 4096] = S; S = decay * S + ua[j]; }
            const int s1 = s0 + 26 < NCI ? s0 + 26 : s0;
#pragma unroll
            for (int j = 0; j < 13; ++j) ua[j] = base[(size_t)scan_ci(dir, s1 + j) * 4 * 4096];
#pragma unroll
            for (int j = 0; j < 13; ++j) { base[(size_t)scan_ci(dir, s0 + 13 + j) * 4 * 4096] = S; S = decay * S + ub[j]; }
        }
    }
    float* LA = (float*)(ws + OFF_LRU); float* LB = LA + 2 * 2 * NCI * 256; float* LC = LB + 2 * 2 * NCI * 256;
    const int lo = nb >= 192 ? 128 * 512 : 0;
    for (int i = gt - lo; i < 2 * 2 * 256; i += gs) {
        if (i < 0) continue;
        const int ch = i & 255, b = (i >> 8) & 1, dir = i >> 9; float h = 0.f;
        const size_t base = ((size_t)dir * 2 + b) * NCI * 256 + ch;
        float aa[13], bb[13], ac[13], bc[13];
#pragma unroll
        for (int j = 0; j < 13; ++j) { const size_t idx = base + (size_t)scan_ci(dir, j) * 256; aa[j] = LA[idx]; bb[j] = LB[idx]; }
#pragma unroll 1
        for (int s0 = 0; s0 < NCI; s0 += 26) {
#pragma unroll
            for (int j = 0; j < 13; ++j) { const size_t idx = base + (size_t)scan_ci(dir, s0 + 13 + j) * 256; ac[j] = LA[idx]; bc[j] = LB[idx]; }
#pragma unroll
            for (int j = 0; j < 13; ++j) { LC[base + (size_t)scan_ci(dir, s0 + j) * 256] = h; h = aa[j] * h + bb[j]; }
            const int s1 = s0 + 26 < NCI ? s0 + 26 : s0;
#pragma unroll
            for (int j = 0; j < 13; ++j) { const size_t idx = base + (size_t)scan_ci(dir, s1 + j) * 256; aa[j] = LA[idx]; bb[j] = LB[idx]; }
#pragma unroll
            for (int j = 0; j < 13; ++j) { LC[base + (size_t)scan_ci(dir, s0 + 13 + j) * 256] = h; h = ac[j] * h + bc[j]; }
        }
    }
}

__device__ __forceinline__ bf16x8 scale_frag(bf16x8 q, float s) {
    u32x4 w;
#pragma unroll
    for (int i = 0; i < 4; ++i) w[i] = cvtpk_s(bfs(q[2 * i]) * s, bfs(q[2 * i + 1]) * s);
    return __builtin_bit_cast(bf16x8, w);
}
__device__ __forceinline__ void ph_ret_out(const Params& p, int l, int bid, int nb, float* lds, int ci_lo) {
    char* ws = p.ws; const int tid = TIDX, lane = tid & 63, r32 = lane & 31, hi = lane >> 5, wid = __builtin_amdgcn_readfirstlane(tid >> 6);
    const bf16_t* P = (const bf16_t*)(ws + OFF_P); const float* RET = (const float*)(ws + OFF_RET); bf16_t* O = (bf16_t*)(ws + OFF_ACT);
    LAS char* sm = (LAS char*)lds;
    const int nci = NCI - ci_lo;
    UnitQ uq{(unsigned*)ws + CW_QUE + l * 16 + 1, 0}; q_prefetch(uq);
    for (int u = q_take(uq, lds); u < 2 * nci * 2; u = q_take(uq, lds)) {
        q_prefetch(uq);
        const int hp = u & 1, ci = ci_lo + (u >> 1) % nci, b = (u >> 1) / nci, rb = row_base(b, ci);
        __syncthreads();
        ret_stage<false>(P, rb, hp, sm, tid, wid, lane);
        __syncthreads();
        const int hh = wid >> 2, qt = wid & 3, h = 2 * hp + hh; int n = qt * 32 + r32;
        asm volatile("" : "+v"(n));
        const float lg2f = ret_lg(p, l, 0, h) * 1.4426950408889634f, lg2b = ret_lg(p, l, 1, h) * 1.4426950408889634f;
        bf16x8 qr[4];
        { const bf16_t* qp = P + (size_t)(rb + n) * DIN + C_RQ + h * 64 + hi * 8;
#pragma unroll
          for (int ks = 0; ks < 4; ++ks) qr[ks] = *(const bf16x8*)(qp + ks * 16); }
        f32x16 o[2];
#pragma unroll
        for (int r = 0; r < 16; ++r) { o[0][r] = 0.f; o[1][r] = 0.f; }
#pragma unroll
        for (int dir = 0; dir < 2; ++dir) {
            const float xi = dir == 0 ? __builtin_amdgcn_exp2f(lg2f * (float)(n + 1)) : __builtin_amdgcn_exp2f(lg2b * (float)(128 - n));
            const float* Sb = RET + ((((size_t)dir * 2 + b) * NCI + ci) * 4 + h) * 4096 + hi * 8 * 64 + r32;
#pragma unroll
            for (int ks = 0; ks < 4; ++ks) { const bf16x8 qx = scale_frag(qr[ks], xi);
#pragma unroll
                for (int eh = 0; eh < 2; ++eh) { const float* sp = Sb + ks * 16 * 64 + eh * 32;
                    const u32x4 sw = {cvtpk_s(sp[0], sp[64]), cvtpk_s(sp[128], sp[192]), cvtpk_s(sp[256], sp[320]), cvtpk_s(sp[384], sp[448])};
                    o[eh] = __builtin_amdgcn_mfma_f32_32x32x16_bf16(qx, __builtin_bit_cast(bf16x8, sw), o[eh], 0, 0, 0); } }
        }
        const LAS char* Kb = sm + RT_K + hh * 16384 + hi * 1024 + r32 * 16;
        const LAS char* Vb = sm + RT_V + hh * 16384 + ((lane >> 4) & 1) * 32 + (lane & 3) * 8 + (4 * hi + ((lane & 15) >> 2)) * 64;
        u32x4 pw[8];
#pragma unroll
        for (int kb = 0; kb < 4; ++kb) { const int tt = kb >> 1, kbl = kb & 1;
            f32x16 c;
#pragma unroll
            for (int r = 0; r < 16; ++r) c[r] = 0.f;
#pragma unroll
            for (int ks = 0; ks < 4; ++ks) c = __builtin_amdgcn_mfma_f32_32x32x16_bf16(*(const LAS bf16x8*)(Kb + tt * 8192 + ks * 2048 + kbl * 512), qr[ks], c, 0, 0, 0);
#pragma unroll
            for (int r = 0; r < 16; ++r) { const int dlt = n - (kb * 32 + crow(r, hi)); const float fd = (float)dlt;
                const float w = __builtin_amdgcn_exp2f(fd * (dlt > 0 ? lg2f : -lg2b));
                c[r] *= dlt == 0 ? 2.0f : w; }
            pw[2 * kb] = (u32x4){cvtpk_s(c[0], c[1]), cvtpk_s(c[2], c[3]), cvtpk_s(c[4], c[5]), cvtpk_s(c[6], c[7])};
            pw[2 * kb + 1] = (u32x4){cvtpk_s(c[8], c[9]), cvtpk_s(c[10], c[11]), cvtpk_s(c[12], c[13]), cvtpk_s(c[14], c[15])}; }
#pragma unroll
        for (int k8 = 0; k8 < 8; ++k8) { const int tt = k8 >> 2, sl = k8 & 3;
#pragma unroll
            for (int eh = 0; eh < 2; ++eh) { const s16x4 vlo = vtr(Vb + tt * 8192 + eh * 4096 + sl * 1024), vhi = vtr(Vb + tt * 8192 + eh * 4096 + sl * 1024 + 512);
                o[eh] = __builtin_amdgcn_mfma_f32_32x32x16_bf16(__builtin_bit_cast(bf16x8, pw[k8]), (bf16x8){vlo[0], vlo[1], vlo[2], vlo[3], vhi[0], vhi[1], vhi[2], vhi[3]}, o[eh], 0, 0, 0); } }
        LAS float* stg = (LAS float*)(sm + RT_ST) + wid * 2048;
#pragma unroll
        for (int r = 0; r < 16; ++r) { const int q = crow(r, hi); stg[q * 64 + r32] = o[0][r]; stg[q * 64 + 32 + r32] = o[1][r]; }
        const float* gn = p.ret_gn + l * 256 + h * 64 + (lane & 7) * 8;
        const f32x4 g0 = *(const f32x4*)gn, g1 = *(const f32x4*)(gn + 4);
        bf16x8 ggv[4];
#pragma unroll
        for (int i = 0; i < 4; ++i) ggv[i] = *(const bf16x8*)(P + (size_t)(rb + qt * 32 + i * 8 + (lane >> 3)) * DIN + C_RG + h * 64 + (lane & 7) * 8);
#pragma unroll
        for (int i = 0; i < 4; ++i) { const int row = i * 8 + (lane >> 3), ch = lane & 7;
            const f32x4 v0 = *(const LAS f32x4*)(stg + row * 64 + ch * 8), v1 = *(const LAS f32x4*)(stg + row * 64 + ch * 8 + 4);
            float ss = v0[0] * v0[0] + v0[1] * v0[1] + v0[2] * v0[2] + v0[3] * v0[3] + v1[0] * v1[0] + v1[1] * v1[1] + v1[2] * v1[2] + v1[3] * v1[3];
            ss += __shfl_xor(ss, 1); ss += __shfl_xor(ss, 2); ss += __shfl_xor(ss, 4);
            const float rn = rsqrtf(ss * (1.0f / 64.0f) + 1e-6f);
            const size_t grow = (size_t)(rb + qt * 32 + row);
            const bf16x8 gg = ggv[i];
            u32x4 w; w.x = cvtpk_s(v0[0] * rn * g0[0] * fast_silu(bfs(gg[0])), v0[1] * rn * g0[1] * fast_silu(bfs(gg[1]))); w.y = cvtpk_s(v0[2] * rn * g0[2] * fast_silu(bfs(gg[2])), v0[3] * rn * g0[3] * fast_silu(bfs(gg[3])));
            w.z = cvtpk_s(v1[0] * rn * g1[0] * fast_silu(bfs(gg[4])), v1[1] * rn * g1[1] * fast_silu(bfs(gg[5]))); w.w = cvtpk_s(v1[2] * rn * g1[2] * fast_silu(bfs(gg[6])), v1[3] * rn * g1[3] * fast_silu(bfs(gg[7])));
            *(u32x4*)(O + grow * DM + 256 + h * 64 + ch * 8) = w; }
    }
}

__device__ __forceinline__ float diff_lambda_val(const Params& p, int l, float lam_init) {
    const float* lv = p.diff_lam + l * 128; float s1 = 0.f, s2 = 0.f;
    for (int i = 0; i < 32; ++i) { s1 += lv[i] * lv[32 + i]; s2 += lv[64 + i] * lv[96 + i]; }
    return expf(s1) - expf(s2) + lam_init;
}
__device__ __forceinline__ float max3f(float a, float b, float c) { return __builtin_fmaxf(__builtin_fmaxf(a, b), c); }
__device__ __forceinline__ float xhalf_max(float m) { auto rr = __builtin_amdgcn_permlane32_swap(__float_as_uint(m), __float_as_uint(m), false, false); return fmaxf(__uint_as_float(rr[0]), __uint_as_float(rr[1])); }
__device__ __forceinline__ float xhalf_sum(float m) { auto rr = __builtin_amdgcn_permlane32_swap(__float_as_uint(m), __float_as_uint(m), false, false); return __uint_as_float(rr[0]) + __uint_as_float(rr[1]); }

constexpr int DF_K = 0, DF_V = 16384, DF_WS = 32768, DF_ST = 34816;
constexpr int DD_K = 0, DD_V = 32768, DD_WS = 65536, DD_ST = 67584;
__device__ __forceinline__ void glds16(const void* gsrc, unsigned lds_dst) { unsigned keep;
    asm volatile("s_mov_b32 %0, m0\n\ts_mov_b32 m0, %2\n\ts_nop 0\n\tglobal_load_lds_dwordx4 %1, off\n\ts_mov_b32 m0, %0" : "=&s"(keep) : "v"(gsrc), "s"(lds_dst) : "memory"); }
template <bool SAFE>
__device__ __forceinline__ void diff_tiles(const bf16_t* P, int b, int h, int t_lo, LAS char* sm, int tid, int wid, int lane, const bf16x8 (&qr)[4], f32x16 (&o)[2][2], float (&lsum)[2]) {
    const int r32 = lane & 31, hi = lane >> 5, t_hi = 260;
    LAS float* wsf = (LAS float*)(sm + DD_WS) + wid * 64;
    const bf16_t* kcol = P + C_DK + h * 64 + wid * 8;
    const bf16_t* vcol = P + C_DV + h * 64 + (wid >> 2) * 32 + (lane & 3) * 8;
    const int krow_in = lane, vrow_in = 16 * (wid & 3) + (lane >> 2);
#define TILE_ROW0(t) ((t) < 256 ? b * NSEQ + (t) * 64 : NLAT + b * NCTX + ((t) - 256) * 64)
    float mhat[2];
#pragma unroll
    for (int m = 0; m < 2; ++m) { mhat[m] = 0.f; lsum[m] = 0.f;
#pragma unroll
        for (int r = 0; r < 16; ++r) { o[m][0][r] = 0.f; o[m][1][r] = 0.f; } }
    const unsigned lds0 = (unsigned)(size_t)sm + (unsigned)wid * 1024u;
#define DMA_TILE(t) do { const int r0_ = TILE_ROW0(t); const unsigned sl_ = (unsigned)(((t) - t_lo) & 3) * 8192u; \
    glds16(kcol + (size_t)(r0_ + krow_in) * DIN, (unsigned)__builtin_amdgcn_readfirstlane(lds0 + DD_K + sl_)); glds16(vcol + (size_t)(r0_ + vrow_in) * DIN, (unsigned)__builtin_amdgcn_readfirstlane(lds0 + DD_V + sl_)); } while (0)
    asm volatile("s_waitcnt lgkmcnt(0)\n\ts_barrier" ::: "memory");
    DMA_TILE(t_lo); DMA_TILE(t_lo + 1); DMA_TILE(t_lo + 2);
    bool first = true;
    for (int t = t_lo; t < t_hi; ++t) {
        const int cur = (t - t_lo) & 3;
        if (t + 2 < t_hi) asm volatile("s_waitcnt vmcnt(4)\n\ts_barrier" ::: "memory");
        else if (t + 1 < t_hi) asm volatile("s_waitcnt vmcnt(2)\n\ts_barrier" ::: "memory");
        else asm volatile("s_waitcnt vmcnt(0)\n\ts_barrier" ::: "memory");
        if (t + 3 < t_hi) DMA_TILE(t + 3);
        const LAS char* kb = sm + DD_K + cur * 8192 + hi * 1024 + r32 * 16;
        const LAS char* vb = sm + DD_V + cur * 8192 + ((lane >> 4) & 1) * 32 + (lane & 3) * 8 + (4 * hi + ((lane & 15) >> 2)) * 64;
#pragma unroll
        for (int m = 0; m < 2; ++m) {
            bf16x8 kf[8];
#pragma unroll
            for (int j = 2 * m; j < 2 * m + 2; ++j) { kf[2 * j] = *(const LAS bf16x8*)(kb + j * 2048); kf[2 * j + 1] = *(const LAS bf16x8*)(kb + j * 2048 + 512); }
            f32x16 c0, c1;
            if (SAFE) { float nm = -mhat[m]; asm volatile("" : "+v"(nm));
#pragma unroll
                for (int r = 0; r < 16; ++r) { c0[r] = nm; c1[r] = nm; } }
            else {
#pragma unroll
                for (int r = 0; r < 16; ++r) { c0[r] = 0.f; c1[r] = 0.f; } }
            c0 = __builtin_amdgcn_mfma_f32_32x32x16_bf16(kf[4 * m + 0], qr[2 * m], c0, 0, 0, 0);
            c1 = __builtin_amdgcn_mfma_f32_32x32x16_bf16(kf[4 * m + 1], qr[2 * m], c1, 0, 0, 0);
            c0 = __builtin_amdgcn_mfma_f32_32x32x16_bf16(kf[4 * m + 2], qr[2 * m + 1], c0, 0, 0, 0);
            c1 = __builtin_amdgcn_mfma_f32_32x32x16_bf16(kf[4 * m + 3], qr[2 * m + 1], c1, 0, 0, 0);
            if (SAFE) {
                float ra = max3f(c0[0], c0[1], c1[0]), rb = max3f(c0[2], c0[3], c1[1]); ra = max3f(ra, c1[2], c1[3]);
#pragma unroll
                for (int r = 4; r < 16; r += 4) { ra = max3f(ra, c0[r], c0[r + 1]); rb = max3f(rb, c0[r + 2], c0[r + 3]); ra = max3f(ra, c1[r], c1[r + 1]); rb = max3f(rb, c1[r + 2], c1[r + 3]); }
                const float rm = xhalf_max(max3f(ra, rb, rb));
                if (__builtin_expect(first || __any(rm > 8.0f), 0)) {
                    float dl = first ? rm : fmaxf(rm, 0.f); asm volatile("; rebase" : "+v"(dl));
                    mhat[m] += dl;
#pragma unroll
                    for (int r = 0; r < 16; ++r) { c0[r] -= dl; c1[r] -= dl; }
                    asm volatile("" : "+v"(c0), "+v"(c1));
                    if (!first) {
                        const float f = __builtin_amdgcn_exp2f(-dl); lsum[m] *= f;
                        if (hi == 0) wsf[r32] = f;
#pragma unroll
                        for (int r = 0; r < 16; ++r) { const float fr_ = wsf[crow(r, hi)]; o[m][0][r] *= fr_; o[m][1][r] *= fr_; }
                    }
                }
            }
            float sacc = 0.f;
#pragma unroll
            for (int r = 0; r < 16; ++r) { c0[r] = __builtin_amdgcn_exp2f(c0[r]); c1[r] = __builtin_amdgcn_exp2f(c1[r]); sacc += c0[r] + c1[r]; }
            lsum[m] += sacc;
            u32x4 pw[4];
#pragma unroll
            for (int k = 0; k < 2; ++k) {
                pw[k] = (u32x4){cvtpk_s(c0[8 * k + 0], c0[8 * k + 1]), cvtpk_s(c0[8 * k + 2], c0[8 * k + 3]), cvtpk_s(c0[8 * k + 4], c0[8 * k + 5]), cvtpk_s(c0[8 * k + 6], c0[8 * k + 7])};
                pw[2 + k] = (u32x4){cvtpk_s(c1[8 * k + 0], c1[8 * k + 1]), cvtpk_s(c1[8 * k + 2], c1[8 * k + 3]), cvtpk_s(c1[8 * k + 4], c1[8 * k + 5]), cvtpk_s(c1[8 * k + 6], c1[8 * k + 7])}; }
            if (!SAFE) __builtin_amdgcn_sched_barrier(0);
#pragma unroll
            for (int dh = 0; dh < 2; ++dh) {
#pragma unroll
                for (int k = 0; k < 4; ++k) { const s16x4 lo = vtr(vb + dh * 4096 + k * 1024), hh = vtr(vb + dh * 4096 + k * 1024 + 512);
                    o[m][dh] = __builtin_amdgcn_mfma_f32_32x32x16_bf16(__builtin_bit_cast(bf16x8, pw[k]), (bf16x8){lo[0], lo[1], lo[2], lo[3], hh[0], hh[1], hh[2], hh[3]}, o[m][dh], 0, 0, 0); } }
            if (!SAFE) __builtin_amdgcn_sched_barrier(0);
        }
        first = false;
        asm volatile("s_waitcnt lgkmcnt(0)" ::: "memory");
    }
#undef TILE_ROW0
#undef DMA_TILE
}

constexpr int DQ_K = 0, DQ_V = 40960, DQ_WS = 81920, DQ_ST = 0;
__device__ __forceinline__ void diff_tiles_fast(const bf16_t* P, int b, int h, int t_lo, LAS char* sm, int tid, int wid, int lane, const bf16x8 (&qr)[4], f32x16 (&o)[2][2], f32x4 (&ls)[2]) {
    const int r32 = lane & 31, hi = lane >> 5, NT = 260 - t_lo;
    const bf16_t* kcol = P + C_DK + h * 64 + wid * 8;
    const bf16_t* vcol = P + C_DV + h * 64 + (wid >> 2) * 32 + (lane & 3) * 8;
    const int krow_in = lane, vrow_in = 16 * (wid & 3) + (lane >> 2);
    const unsigned lds0 = (unsigned)(size_t)sm + (unsigned)wid * 1024u;
#define TILE_ROW0(i) ((t_lo + (i)) < 256 ? b * NSEQ + (t_lo + (i)) * 64 : NLAT + b * NCTX + (t_lo + (i) - 256) * 64)
#define DMA_TILE(i, slot) do { const int r0_ = TILE_ROW0(i); const unsigned sl_ = (unsigned)(slot) * 8192u; \
    glds16(kcol + (size_t)(r0_ + krow_in) * DIN, (unsigned)__builtin_amdgcn_readfirstlane(lds0 + DQ_K + sl_)); glds16(vcol + (size_t)(r0_ + vrow_in) * DIN, (unsigned)__builtin_amdgcn_readfirstlane(lds0 + DQ_V + sl_)); } while (0)
#pragma unroll
    for (int m = 0; m < 2; ++m) { ls[m] = (f32x4){0.f, 0.f, 0.f, 0.f};
#pragma unroll
        for (int r = 0; r < 16; ++r) { o[m][0][r] = 0.f; o[m][1][r] = 0.f; } }
    const unsigned onev = (((lane >> 4) ^ (lane >> 3)) & 1) ? 0u : 0x3F803F80u;
    const bf16x8 onesB = __builtin_bit_cast(bf16x8, ((u32x4){onev, onev, onev, onev}));
    asm volatile("s_waitcnt lgkmcnt(0)\n\ts_barrier" ::: "memory");
    DMA_TILE(0, 0); DMA_TILE(1, 1); DMA_TILE(2, 2); DMA_TILE(3, 3);
    asm volatile("s_waitcnt vmcnt(4)\n\ts_barrier" ::: "memory");
    const int kfo = hi * 1024 + r32 * 16, vfo = ((lane >> 4) & 1) * 32 + (lane & 3) * 8 + (4 * hi + ((lane & 15) >> 2)) * 64;
    f32x16 cA0, cA1, cB0, cB1; u32x4 pwp[4], pwq[4]; bf16x8 vq[8], kq[4];
#define KOFF(g) ((((g) & 1) * 512) + (((g) >> 1) * 2048))
#define LDK(g, base) kq[g] = *(const LAS bf16x8*)((base) + KOFF(g))
#define LDV(g, base) do { const s16x4 l0_ = vtr((base) + (g) * 1024), h0_ = vtr((base) + (g) * 1024 + 512), l1_ = vtr((base) + 4096 + (g) * 1024), h1_ = vtr((base) + 4096 + (g) * 1024 + 512); \
        vq[g] = (bf16x8){l0_[0], l0_[1], l0_[2], l0_[3], h0_[0], h0_[1], h0_[2], h0_[3]}; vq[4 + (g)] = (bf16x8){l1_[0], l1_[1], l1_[2], l1_[3], h1_[0], h1_[1], h1_[2], h1_[3]}; } while (0)
    {
        const LAS char* kb_ = sm + DQ_K + kfo;
#pragma unroll
        for (int r = 0; r < 16; ++r) { cA0[r] = 0.f; cA1[r] = 0.f; cB0[r] = 0.f; cB1[r] = 0.f; }
#pragma unroll
        for (int j = 0; j < 2; ++j) { cA0 = __builtin_amdgcn_mfma_f32_32x32x16_bf16(*(const LAS bf16x8*)(kb_ + j * 2048), qr[j], cA0, 0, 0, 0);
                                      cA1 = __builtin_amdgcn_mfma_f32_32x32x16_bf16(*(const LAS bf16x8*)(kb_ + j * 2048 + 512), qr[j], cA1, 0, 0, 0);
                                      cB0 = __builtin_amdgcn_mfma_f32_32x32x16_bf16(*(const LAS bf16x8*)(kb_ + 4096 + j * 2048), qr[2 + j], cB0, 0, 0, 0);
                                      cB1 = __builtin_amdgcn_mfma_f32_32x32x16_bf16(*(const LAS bf16x8*)(kb_ + 4096 + j * 2048 + 512), qr[2 + j], cB1, 0, 0, 0); }
#pragma unroll
        for (int r = 0; r < 16; ++r) { cA0[r] = __builtin_amdgcn_exp2f(cA0[r]); cA1[r] = __builtin_amdgcn_exp2f(cA1[r]); }
#pragma unroll
        for (int k = 0; k < 2; ++k) {
            pwq[k] = (u32x4){cvtpk_s(cA0[8 * k + 0], cA0[8 * k + 1]), cvtpk_s(cA0[8 * k + 2], cA0[8 * k + 3]), cvtpk_s(cA0[8 * k + 4], cA0[8 * k + 5]), cvtpk_s(cA0[8 * k + 6], cA0[8 * k + 7])};
            pwq[2 + k] = (u32x4){cvtpk_s(cA1[8 * k + 0], cA1[8 * k + 1]), cvtpk_s(cA1[8 * k + 2], cA1[8 * k + 3]), cvtpk_s(cA1[8 * k + 4], cA1[8 * k + 5]), cvtpk_s(cA1[8 * k + 6], cA1[8 * k + 7])}; }
        const LAS char* v0_ = sm + DQ_V + vfo; const LAS char* k1_ = sm + DQ_K + 8192 + kfo;
#pragma unroll
        for (int g = 0; g < 4; ++g) { LDV(g, v0_); LDK(g, k1_); }
        __builtin_amdgcn_sched_barrier(0);
    }
#define STEPF(CC0, CC1, PWC, PWP, MPREV, CN0, CN1, MNEXT, RELOAD, NREAD) do { \
    _Pragma("unroll") for (int r_ = 0; r_ < 16; ++r_) { CN0[r_] = 0.f; CN1[r_] = 0.f; } \
    _Pragma("unroll") for (int g_ = 0; g_ < 4; ++g_) { \
        o[MPREV][0] = __builtin_amdgcn_mfma_f32_32x32x16_bf16(__builtin_bit_cast(bf16x8, PWP[g_]), vq[g_], o[MPREV][0], 0, 0, 0); \
        o[MPREV][1] = __builtin_amdgcn_mfma_f32_32x32x16_bf16(__builtin_bit_cast(bf16x8, PWP[g_]), vq[4 + g_], o[MPREV][1], 0, 0, 0); \
        ls[MPREV] = __builtin_amdgcn_mfma_f32_16x16x32_bf16(__builtin_bit_cast(bf16x8, PWP[g_]), onesB, ls[MPREV], 0, 0, 0); \
        if ((g_ & 1) == 0) CN0 = __builtin_amdgcn_mfma_f32_32x32x16_bf16(kq[g_], qr[2 * (MNEXT) + (g_ >> 1)], CN0, 0, 0, 0); \
        else               CN1 = __builtin_amdgcn_mfma_f32_32x32x16_bf16(kq[g_], qr[2 * (MNEXT) + (g_ >> 1)], CN1, 0, 0, 0); \
        _Pragma("unroll") for (int r_ = 4 * g_; r_ < 4 * g_ + 4; ++r_) { CC0[r_] = __builtin_amdgcn_exp2f(CC0[r_]); CC1[r_] = __builtin_amdgcn_exp2f(CC1[r_]); } \
        if (g_ == 1) { PWC[0] = (u32x4){cvtpk_s(CC0[0], CC0[1]), cvtpk_s(CC0[2], CC0[3]), cvtpk_s(CC0[4], CC0[5]), cvtpk_s(CC0[6], CC0[7])}; \
                       PWC[2] = (u32x4){cvtpk_s(CC1[0], CC1[1]), cvtpk_s(CC1[2], CC1[3]), cvtpk_s(CC1[4], CC1[5]), cvtpk_s(CC1[6], CC1[7])}; } \
        if (g_ == 3) { PWC[1] = (u32x4){cvtpk_s(CC0[8], CC0[9]), cvtpk_s(CC0[10], CC0[11]), cvtpk_s(CC0[12], CC0[13]), cvtpk_s(CC0[14], CC0[15])}; \
                       PWC[3] = (u32x4){cvtpk_s(CC1[8], CC1[9]), cvtpk_s(CC1[10], CC1[11]), cvtpk_s(CC1[12], CC1[13]), cvtpk_s(CC1[14], CC1[15])}; } \
        RELOAD(g_); } \
    _Pragma("unroll") for (int g_ = 0; g_ < 4; ++g_) { \
        _Pragma("unroll") for (int i_ = 0; i_ < 4; ++i_) { __builtin_amdgcn_sched_group_barrier(0x008, 1, 0); __builtin_amdgcn_sched_group_barrier(0x400, 2, 0); } \
        __builtin_amdgcn_sched_group_barrier(0x100, NREAD, 0); }        \
    __builtin_amdgcn_sched_barrier(0); } while (0)
#define RELOAD_A(g) LDK(g, k1_ + 4096)
#define RELOAD_B(g) do { LDK(g, k2_); LDV(g, v1_); } while (0)
    int s1 = 1, s2 = 2, s4 = 4;
    for (int t = 0; t < NT; ++t) {
        if (t + 3 < NT) asm volatile("s_waitcnt vmcnt(2)\n\ts_barrier" ::: "memory"); else asm volatile("s_waitcnt vmcnt(0)\n\ts_barrier" ::: "memory");
        if (t + 4 < NT) DMA_TILE(t + 4, s4);
        const LAS char* k1_ = sm + DQ_K + s1 * 8192 + kfo; const LAS char* k2_ = sm + DQ_K + s2 * 8192 + kfo; const LAS char* v1_ = sm + DQ_V + s1 * 8192 + vfo;
        __builtin_amdgcn_sched_barrier(0);
        STEPF(cB0, cB1, pwp, pwq, 0, cA0, cA1, 0, RELOAD_A, 1);
        STEPF(cA0, cA1, pwq, pwp, 1, cB0, cB1, 1, RELOAD_B, 5);
        s1 = s2; s2 = (s2 == 4) ? 0 : s2 + 1; s4 = (s4 == 4) ? 0 : s4 + 1;
    }
#undef TILE_ROW0
#undef DMA_TILE
#undef STEPF
#undef RELOAD_A
#undef RELOAD_B
#undef LDK
#undef LDV
#undef KOFF
}

template <bool SAFE>
__device__ __forceinline__ bool diff_unit(const Params& p, int l, float lam_init, float lam, int u, float* lds) {
    char* ws = p.ws; const int tid = TIDX, lane = tid & 63, r32 = lane & 31, hi = lane >> 5, wid = __builtin_amdgcn_readfirstlane(tid >> 6);
    const bf16_t* P = (const bf16_t*)(ws + OFF_P); bf16_t* O = (bf16_t*)(ws + OFF_ACT);
    LAS char* sm = (LAS char*)lds;
    int b, h, qrow0, t_lo;
    if (u < 512) { b = u >> 8; h = (u >> 6) & 3; qrow0 = b * NSEQ + (u & 63) * 256; t_lo = 0; }
    else { const int v = u - 512; b = v >> 2; h = v & 3; qrow0 = NLAT + b * NCTX; t_lo = 256; }
    bf16x8 qr[4];
    { const bf16_t* qp = P + (size_t)(qrow0 + wid * 32 + r32) * DIN + C_DQ + h * 64 + hi * 8;
#pragma unroll
      for (int d0 = 0; d0 < 4; ++d0) qr[d0] = *(const bf16x8*)(qp + d0 * 16); }
        asm volatile("" :: "v"(qr[0]), "v"(qr[1]), "v"(qr[2]), "v"(qr[3]));
    f32x16 o[2][2]; float lsum[2] = {1.f, 1.f}; f32x4 ls[2];
    if (SAFE) diff_tiles<true>(P, b, h, t_lo, sm, tid, wid, lane, qr, o, lsum); else diff_tiles_fast(P, b, h, t_lo, sm, tid, wid, lane, qr, o, ls);
    constexpr int WS_OFF = SAFE ? DD_WS : DQ_WS, ST_OFF = SAFE ? DD_ST : DQ_ST;
    if (!SAFE) {
        bool bad = false;
#pragma unroll
        for (int i = 0; i < 4; ++i) bad |= !(ls[0][i] > 7.9e-31f && ls[0][i] < 1.2e30f && ls[1][i] > 7.9e-31f && ls[1][i] < 1.2e30f);
        LAS unsigned* flg = (LAS unsigned*)(sm + WS_OFF + 2048);
        const unsigned anyb = __any(bad) ? 1u : 0u;
        if (lane == 0) flg[wid] = anyb;
        asm volatile("s_waitcnt lgkmcnt(0)\n\ts_barrier" ::: "memory");
        const unsigned allb = flg[0] | flg[1] | flg[2] | flg[3] | flg[4] | flg[5] | flg[6] | flg[7];
        if (__builtin_expect(allb != 0u, 0)) return true;
    }
    int lane_e = TIDX & 63;
    { const int r32e = lane_e & 31, hie = lane_e >> 5;
    LAS float* wse = (LAS float*)(sm + WS_OFF) + wid * 64; LAS float* stge = (LAS float*)(sm + ST_OFF) + wid * 2048;
    if (SAFE) { const float l0 = xhalf_sum(lsum[0]), l1 = xhalf_sum(lsum[1]); if (hie == 0) { wse[r32e] = 1.0f / l0; wse[32 + r32e] = lam / l1; } }
    else if ((lane_e & 7) == 0) { const int qb = ((lane_e >> 3) & 1) * 16 + (lane_e >> 4) * 4;
#pragma unroll
        for (int i = 0; i < 4; ++i) { wse[qb + i] = 1.0f / ls[0][i]; wse[32 + qb + i] = lam / ls[1][i]; } }
#pragma unroll
    for (int r = 0; r < 16; ++r) { const int q = crow(r, hie); const float i0 = wse[q], i1 = wse[32 + q];
        stge[q * 64 + r32e] = o[0][0][r] * i0 - o[1][0][r] * i1; stge[q * 64 + 32 + r32e] = o[0][1][r] * i0 - o[1][1][r] * i1; } }
    LAS float* stg = (LAS float*)(sm + ST_OFF) + wid * 2048;
    const float* gn = p.diff_gn + l * 256 + h * 64 + (lane_e & 7) * 8;
    const f32x4 g0 = *(const f32x4*)gn, g1 = *(const f32x4*)(gn + 4);
#pragma unroll
    for (int i = 0; i < 4; ++i) { const int row = i * 8 + (lane_e >> 3), ch = lane_e & 7;
        const f32x4 v0 = *(const LAS f32x4*)(stg + row * 64 + ch * 8), v1 = *(const LAS f32x4*)(stg + row * 64 + ch * 8 + 4);
        float ss = v0[0] * v0[0] + v0[1] * v0[1] + v0[2] * v0[2] + v0[3] * v0[3] + v1[0] * v1[0] + v1[1] * v1[1] + v1[2] * v1[2] + v1[3] * v1[3];
        ss += __shfl_xor(ss, 1); ss += __shfl_xor(ss, 2); ss += __shfl_xor(ss, 4);
        const float rn = rsqrtf(ss * (1.0f / 64.0f) + 1e-6f) * (1.0f - lam_init);
        u32x4 w; w.x = cvtpk_s(v0[0] * rn * g0[0], v0[1] * rn * g0[1]); w.y = cvtpk_s(v0[2] * rn * g0[2], v0[3] * rn * g0[3]);
        w.z = cvtpk_s(v1[0] * rn * g1[0], v1[1] * rn * g1[1]); w.w = cvtpk_s(v1[2] * rn * g1[2], v1[3] * rn * g1[3]);
        *(u32x4*)(O + (size_t)(qrow0 + wid * 32 + row) * DM + 512 + h * 64 + ch * 8) = w; }
    return false;
}
__device__ __forceinline__ void ph_diff(const Params& p, int l, bool need_ctx, float lam_init, int bid, int nb, float* lds) {
    const float lam = __int_as_float(__builtin_amdgcn_readfirstlane(__float_as_int(diff_lambda_val(p, l, lam_init))));
    const int nun = 512 + (need_ctx ? 8 : 0);
    unsigned redo = 0u; int idx = 0;
    for (int u = (bid + 160) % nb; u < nun; u += nb, ++idx) if (diff_unit<false>(p, l, lam_init, lam, u, lds)) redo |= 1u << idx;
    idx = 0;
    if (__builtin_expect(redo != 0u, 0))
        for (int u = (bid + 160) % nb; u < nun; u += nb, ++idx) if ((redo >> idx) & 1u) (void)diff_unit<true>(p, l, lam_init, lam, u, lds);
}

__device__ __forceinline__ void ph_swa(const Params& p, int l, bool need_ctx, int bid, int nb, float* lds) {
    char* ws = p.ws; const int tid = TIDX, lane = tid & 63, r32 = lane & 31, hi = lane >> 5, wid = __builtin_amdgcn_readfirstlane(tid >> 6);
    const bf16_t* P = (const bf16_t*)(ws + OFF_P); bf16_t* O = (bf16_t*)(ws + OFF_ACT);
    LAS char* sm = (LAS char*)lds;
    LAS float* wsf = (LAS float*)(sm + DD_WS) + wid * 64;
    const int nun = 512 + (need_ctx ? 8 : 0);
    UnitQ uq{(unsigned*)ws + CW_QUE + l * 16 + 0, 0}; q_prefetch(uq);
    for (int u = q_take(uq, lds); u < nun; u = q_take(uq, lds)) {
        q_prefetch(uq);
        int b, h, qrow0, q0, tw_lo, nwin;
        if (u < 512) { b = u >> 8; h = (u >> 6) & 3; q0 = (u & 63) * 256; qrow0 = b * NSEQ + q0; const int lo = q0 - 128 < 0 ? 0 : q0 - 128, hi_ = q0 + 384 > NSEQ ? NSEQ : q0 + 384; tw_lo = lo >> 6; nwin = (hi_ - lo) >> 6; }
        else { const int v = u - 512; b = v >> 2; h = v & 3; q0 = 0; qrow0 = NLAT + b * NCTX; tw_lo = 0; nwin = 0; }
        const int g = h >> 1, nt = nwin + 4;
        const bf16_t* kcol = P + C_AK + g * 64 + wid * 8;
        const bf16_t* vcol = P + C_AV + g * 64 + (wid >> 2) * 32 + (lane & 3) * 8;
        const int krow_in = lane, vrow_in = 16 * (wid & 3) + (lane >> 2);
#define SWA_ROW0(i) ((i) < nwin ? b * NSEQ + (tw_lo + (i)) * 64 : NLAT + b * NCTX + ((i) - nwin) * 64)
        bf16x8 qr[4];
        { const bf16_t* qp = P + (size_t)(qrow0 + wid * 32 + r32) * DIN + C_AQ + h * 64 + hi * 8;
#pragma unroll
          for (int d0 = 0; d0 < 4; ++d0) qr[d0] = *(const bf16x8*)(qp + d0 * 16); }
        asm volatile("" :: "v"(qr[0]), "v"(qr[1]), "v"(qr[2]), "v"(qr[3]));
        f32x16 o[2]; float mhat = p.sink[l * 4 + h] * 1.4426950408889634f, lsum = hi == 0 ? 1.0f : 0.0f;
#pragma unroll
        for (int r = 0; r < 16; ++r) { o[0][r] = 0.f; o[1][r] = 0.f; }
        const int qw = q0 + wid * 32, qpos = qw + r32;
        const unsigned lds0 = (unsigned)(size_t)sm + (unsigned)wid * 1024u;
#define DMA_TILE(i) do { const int r0_ = SWA_ROW0(i); const unsigned sl_ = (unsigned)((i) & 3) * 8192u; \
        glds16(kcol + (size_t)(r0_ + krow_in) * DIN, (unsigned)__builtin_amdgcn_readfirstlane(lds0 + DD_K + sl_)); glds16(vcol + (size_t)(r0_ + vrow_in) * DIN, (unsigned)__builtin_amdgcn_readfirstlane(lds0 + DD_V + sl_)); } while (0)
        asm volatile("s_waitcnt lgkmcnt(0)\n\ts_barrier" ::: "memory");
        DMA_TILE(0); DMA_TILE(1); DMA_TILE(2);
        for (int i = 0; i < nt; ++i) {
            const int cur = i & 3;
            if (i + 2 < nt) asm volatile("s_waitcnt vmcnt(4)\n\ts_barrier" ::: "memory");
            else if (i + 1 < nt) asm volatile("s_waitcnt vmcnt(2)\n\ts_barrier" ::: "memory");
            else asm volatile("s_waitcnt vmcnt(0)\n\ts_barrier" ::: "memory");
            if (i + 3 < nt) DMA_TILE(i + 3);
            const bool win = i < nwin; const int T = (tw_lo + i) * 64;
            const bool skip = win && (T > qw + 31 + 128 || T + 63 < qw - 128);
            if (!skip) {
                const LAS char* kb = sm + DD_K + cur * 8192 + hi * 1024 + r32 * 16;
                const LAS char* vb = sm + DD_V + cur * 8192 + ((lane >> 4) & 1) * 32 + (lane & 3) * 8 + (4 * hi + ((lane & 15) >> 2)) * 64;
                float nm = -mhat; asm volatile("" : "+v"(nm));
                f32x16 c0, c1;
#pragma unroll
                for (int r = 0; r < 16; ++r) { c0[r] = nm; c1[r] = nm; }
#pragma unroll
                for (int j = 0; j < 4; ++j) {
                    c0 = __builtin_amdgcn_mfma_f32_32x32x16_bf16(*(const LAS bf16x8*)(kb + j * 2048), qr[j], c0, 0, 0, 0);
                    c1 = __builtin_amdgcn_mfma_f32_32x32x16_bf16(*(const LAS bf16x8*)(kb + j * 2048 + 512), qr[j], c1, 0, 0, 0); }
                if (win && (T < qw + 31 - 128 || T + 63 > qw + 128)) {
#pragma unroll
                    for (int r = 0; r < 16; ++r) { const int kp = T + crow(r, hi); const int d0_ = qpos - kp, d1_ = d0_ - 32;
                        if (d0_ > 128 || d0_ < -128) c0[r] = -1.0e30f;
                        if (d1_ > 128 || d1_ < -128) c1[r] = -1.0e30f; }
                }
                float rm = fmaxf(c0[0], c1[0]);
#pragma unroll
                for (int r = 1; r < 16; ++r) rm = fmaxf(rm, fmaxf(c0[r], c1[r]));
                rm = xhalf_max(rm);
                if (__any(rm > 8.0f)) {
                    const float dl = fmaxf(rm, 0.f); mhat += dl;
#pragma unroll
                    for (int r = 0; r < 16; ++r) { c0[r] -= dl; c1[r] -= dl; }
                    const float f = __builtin_amdgcn_exp2f(-dl); lsum *= f;
                    if (hi == 0) wsf[r32] = f;
#pragma unroll
                    for (int r = 0; r < 16; ++r) { const float fr_ = wsf[crow(r, hi)]; o[0][r] *= fr_; o[1][r] *= fr_; }
                }
                float sacc = 0.f;
#pragma unroll
                for (int r = 0; r < 16; ++r) { c0[r] = __builtin_amdgcn_exp2f(c0[r]); c1[r] = __builtin_amdgcn_exp2f(c1[r]); sacc += c0[r] + c1[r]; }
                lsum += sacc;
                u32x4 pw[4];
#pragma unroll
                for (int k = 0; k < 2; ++k) {
                    pw[k] = (u32x4){cvtpk_s(c0[8 * k + 0], c0[8 * k + 1]), cvtpk_s(c0[8 * k + 2], c0[8 * k + 3]), cvtpk_s(c0[8 * k + 4], c0[8 * k + 5]), cvtpk_s(c0[8 * k + 6], c0[8 * k + 7])};
                    pw[2 + k] = (u32x4){cvtpk_s(c1[8 * k + 0], c1[8 * k + 1]), cvtpk_s(c1[8 * k + 2], c1[8 * k + 3]), cvtpk_s(c1[8 * k + 4], c1[8 * k + 5]), cvtpk_s(c1[8 * k + 6], c1[8 * k + 7])}; }
#pragma unroll
                for (int k = 0; k < 4; ++k) {
                    const s16x4 lo0 = vtr(vb + k * 1024), hi0 = vtr(vb + k * 1024 + 512), lo1 = vtr(vb + 4096 + k * 1024), hi1 = vtr(vb + 4096 + k * 1024 + 512);
                    o[0] = __builtin_amdgcn_mfma_f32_32x32x16_bf16(__builtin_bit_cast(bf16x8, pw[k]), (bf16x8){lo0[0], lo0[1], lo0[2], lo0[3], hi0[0], hi0[1], hi0[2], hi0[3]}, o[0], 0, 0, 0);
                    o[1] = __builtin_amdgcn_mfma_f32_32x32x16_bf16(__builtin_bit_cast(bf16x8, pw[k]), (bf16x8){lo1[0], lo1[1], lo1[2], lo1[3], hi1[0], hi1[1], hi1[2], hi1[3]}, o[1], 0, 0, 0); }
            }
            asm volatile("s_waitcnt lgkmcnt(0)" ::: "memory");
        }
#undef SWA_ROW0
#undef DMA_TILE
        const float inv = 1.0f / xhalf_sum(lsum);
        int lane_e = TIDX & 63;
        { const int r32e = lane_e & 31, hie = lane_e >> 5;
        LAS float* wse = (LAS float*)(sm + DD_WS) + wid * 64; LAS float* stge = (LAS float*)(sm + DD_ST) + wid * 2048;
        if (hie == 0) wse[r32e] = inv;
#pragma unroll
        for (int r = 0; r < 16; ++r) { const int q = crow(r, hie); const float i0 = wse[q]; stge[q * 64 + r32e] = o[0][r] * i0; stge[q * 64 + 32 + r32e] = o[1][r] * i0; } }
        LAS float* stg = (LAS float*)(sm + DD_ST) + wid * 2048;
#pragma unroll
        for (int i = 0; i < 4; ++i) { const int row = i * 8 + (lane_e >> 3), ch = lane_e & 7;
            const f32x4 v0 = *(const LAS f32x4*)(stg + row * 64 + ch * 8), v1 = *(const LAS f32x4*)(stg + row * 64 + ch * 8 + 4);
            u32x4 w; w.x = cvtpk_s(v0[0], v0[1]); w.y = cvtpk_s(v0[2], v0[3]); w.z = cvtpk_s(v1[0], v1[1]); w.w = cvtpk_s(v1[2], v1[3]);
            *(u32x4*)(O + (size_t)(qrow0 + wid * 32 + row) * DM + h * 64 + ch * 8) = w; }
    }
}

__device__ __forceinline__ void moe_offsets(const Params& p, int* offs  ) {
    if (TIDX < 2) { const unsigned* cw = (const unsigned*)p.ws + CW_CNT + TIDX * 8; int o = 0;
        for (int e = 0; e < 8; ++e) { offs[TIDX * 9 + e] = o; o += ((int)__hip_atomic_load(cw + e, __ATOMIC_RELAXED, __HIP_MEMORY_SCOPE_AGENT) + 255) & ~255; }
        offs[TIDX * 9 + 8] = o; }
    __syncthreads();
}
__device__ __forceinline__ void ph_moe_scatter(const Params& p, int bid, int nb, float* lds) {
    char* ws = p.ws; int* offs = (int*)lds; moe_offsets(p, offs);
    const int lane = TIDX & 63, wv = TIDX >> 6;
    const bf16_t* H = (const bf16_t*)(ws + OFF_ACT); bf16_t* AS = (bf16_t*)(ws + OFF_ASORT);
    int* tok = (int*)(ws + OFF_TOK); float* wgt = (float*)(ws + OFF_WGT); const unsigned* cw = (const unsigned*)ws;
    const int step = nb * 8 * 4; int r0 = (bid * 8 + wv) * 4;
    int4 rec[4]; u32x4 d8[4];
#define SC_LOAD(rc, dd, rbase) do { _Pragma("unroll") for (int k = 0; k < 4; ++k) { rc[k] = *(const int4*)(ws + OFF_ROUTE + (size_t)((rbase) + k) * 16); dd[k] = ((const u32x4*)((const unsigned char*)H + (size_t)((rbase) + k) * DM))[lane]; } } while (0)
    if (r0 < NLAT) SC_LOAD(rec, d8, r0);
    for (; r0 < NLAT; r0 += step) {
        int pos[4][2];
#pragma unroll
        for (int k = 0; k < 4; ++k) { const int blk = ((r0 + k) >> 3) % nb;
#pragma unroll
            for (int g = 0; g < 2; ++g) { const int e = (g == 0 ? rec[k].x : rec[k].y) & 15, li = (g == 0 ? rec[k].x : rec[k].y) >> 4;
                pos[k][g] = offs[g * 9 + e] + (int)cw[CW_BLK + blk * 16 + g * 8 + e] + li; } }
        const int rn = r0 + step < NLAT ? r0 + step : r0;
        int4 recn[4]; u32x4 d8n[4];
        SC_LOAD(recn, d8n, rn);
#pragma unroll
        for (int k = 0; k < 4; ++k)
#pragma unroll
            for (int g = 0; g < 2; ++g) { const int ps = pos[k][g];
                u32x4* dst = (u32x4*)((unsigned char*)AS + ((size_t)g * GRP_ROWS + ps) * DM); dst[lane] = d8[k]; }
#pragma unroll
        for (int k = 0; k < 4; ++k) { rec[k] = recn[k]; d8[k] = d8n[k]; }
    }
#undef SC_LOAD
}

__device__ __forceinline__ void ph_final(const Params& p, int bid, int nb, float* lds) {
    char* ws = p.ws; int* offs = (int*)lds; __syncthreads(); moe_offsets(p, offs);
    const int lane = TIDX & 63, wv = TIDX >> 6;
    const bf16_t* Y = (const bf16_t*)(ws + OFF_YMOE); const unsigned* cw = (const unsigned*)ws;
    const float* gt2 = (const float*)(ws + OFF_MOD) + (size_t)3 * 6144 + 5120;
    const int stride = nb * 8;
    int4 rec[2]; int pos[2][2];
#define FIN_REC(dst, rbase) do { _Pragma("unroll") for (int q = 0; q < 2; ++q) { const int r_ = ((rbase) + q * stride < NLAT) ? (rbase) + q * stride : (rbase); dst[q] = *(const int4*)(ws + OFF_ROUTE + (size_t)r_ * 16); } } while (0)
#define FIN_POS(dst, src_, rbase) do { _Pragma("unroll") for (int q = 0; q < 2; ++q) { const int r_ = ((rbase) + q * stride < NLAT) ? (rbase) + q * stride : (rbase); const int blk_ = (r_ >> 3) % nb; \
        const int e0_ = src_[q].x & 15, e1_ = src_[q].y & 15; \
        dst[q][0] = offs[e0_] + (int)cw[CW_BLK + blk_ * 16 + e0_] + (src_[q].x >> 4); dst[q][1] = offs[9 + e1_] + (int)cw[CW_BLK + blk_ * 16 + 8 + e1_] + (src_[q].y >> 4); } } while (0)
    int r0 = bid * 8 + wv;
    float4 fg[4];
#pragma unroll
    for (int i = 0; i < 4; ++i) fg[i] = *(const float4*)(p.final_norm + i * 256 + lane * 4);
    float4 gq[2][4]; int gcls[2] = {-1, -1};
    if (r0 < NLAT) { FIN_REC(rec, r0); FIN_POS(pos, rec, r0); }
    for (; r0 < NLAT; r0 += 2 * stride) {
        const bool has1 = r0 + stride < NLAT; const int rn = r0 + 2 * stride; const bool more = rn < NLAT;
        const int rnc = more ? rn : r0;
        int4 recn[2]; int posn[2][2];
        FIN_REC(recn, rnc);
        float4 v[2][4]; uint2 ya[2][4], yb[2][4];
#pragma unroll
        for (int q = 0; q < 2; ++q) { const int r = (q == 0 || has1) ? r0 + q * stride : r0;
            { const int cls = __builtin_amdgcn_readfirstlane(mod_class(r));
              if (cls != gcls[q]) { gcls[q] = cls;
#pragma unroll
                  for (int i = 0; i < 4; ++i) gq[q][i] = *(const float4*)(gt2 + (size_t)cls * 6144 + i * 256 + lane * 4); } }
            const bf16_t* y0 = Y + (size_t)pos[q][0] * DM; const bf16_t* y1 = Y + ((size_t)GRP_ROWS + pos[q][1]) * DM; const bf16_t* xr = (const bf16_t*)(ws + OFF_XB) + (size_t)r * DM;
#pragma unroll
            for (int i = 0; i < 4; ++i) { const int c = i * 256 + lane * 4; { const uint2 w = *(const uint2*)(xr + c); v[q][i] = make_float4(BFLO(w.x), BFHI(w.x), BFLO(w.y), BFHI(w.y)); } ya[q][i] = *(const uint2*)(y0 + c); yb[q][i] = *(const uint2*)(y1 + c); } }
        FIN_POS(posn, recn, rnc);
        float ss[2];
#pragma unroll
        for (int q = 0; q < 2; ++q) { const float w0 = __int_as_float(rec[q].z), w1 = __int_as_float(rec[q].w); float s = 0.f;
#pragma unroll
            for (int i = 0; i < 4; ++i) { const uint2 a = ya[q][i], b = yb[q][i]; const float4 g = gq[q][i];
                v[q][i].x += g.x * (w0 * BFLO(a.x) + w1 * BFLO(b.x)); v[q][i].y += g.y * (w0 * BFHI(a.x) + w1 * BFHI(b.x)); v[q][i].z += g.z * (w0 * BFLO(a.y) + w1 * BFLO(b.y)); v[q][i].w += g.w * (w0 * BFHI(a.y) + w1 * BFHI(b.y));
                s += v[q][i].x * v[q][i].x + v[q][i].y * v[q][i].y + v[q][i].z * v[q][i].z + v[q][i].w * v[q][i].w; }
            ss[q] = wave_sum(s); }
#pragma unroll
        for (int q = 0; q < 2; ++q) { if (q == 1 && !has1) break;
            float* xr = p.out + (size_t)(r0 + q * stride) * DM; const float rn_ = rsqrtf(ss[q] * (1.0f / 1024.0f) + 1e-6f);
#pragma unroll
            for (int i = 0; i < 4; ++i) { const float4 g = fg[i];
                float4 o; o.x = v[q][i].x * rn_ * g.x; o.y = v[q][i].y * rn_ * g.y; o.z = v[q][i].z * rn_ * g.z; o.w = v[q][i].w * rn_ * g.w; *(float4*)(xr + i * 256 + lane * 4) = o; } }
#pragma unroll
        for (int q = 0; q < 2; ++q) { rec[q] = recn[q]; pos[q][0] = posn[q][0]; pos[q][1] = posn[q][1]; }
    }
#undef FIN_REC
#undef FIN_POS
}

struct EpiStoreBf16 {
    static constexpr bool PERM = true, AFTER_DRAIN = false; bf16_t* O; int ldc;
    __device__ __forceinline__ void operator()(const f32x4 (&acc)[2][2][4][2], const pg8::Unit& u, int wr, int wc, int fr, int fq) const {
        bf16_t* base = O + (size_t)(u.pm * 256 + wr * 64 + fr) * ldc + u.pn * 256 + wc * 32 + 8 * fq;
#pragma unroll
        for (int ai = 0; ai < 2; ++ai)
#pragma unroll
            for (int m = 0; m < 4; ++m) { bf16_t* rowp = base + (size_t)(ai * 128 + m * 16) * ldc;
#pragma unroll
                for (int bj = 0; bj < 2; ++bj) { const f32x4 v0 = acc[ai][bj][m][0], v1 = acc[ai][bj][m][1]; u32x4 w;
                    w.x = pg8::cvt_pk_bf16(v0[0], v0[1]); w.y = pg8::cvt_pk_bf16(v0[2], v0[3]); w.z = pg8::cvt_pk_bf16(v1[0], v1[1]); w.w = pg8::cvt_pk_bf16(v1[2], v1[3]);
                    *(u32x4*)(rowp + bj * 128) = w; } }
    }
};
template <bool F8OUT>
struct EpiSwiglu {
    static constexpr bool PERM = true, AFTER_DRAIN = false; void* U; int ldu, npe;
    __device__ __forceinline__ void operator()(const f32x4 (&acc)[2][2][4][2], const pg8::Unit& u, int wr, int wc, int fr, int fq) const {
        { const int ln_ = (int)__builtin_amdgcn_mbcnt_hi(~0u, __builtin_amdgcn_mbcnt_lo(~0u, 0u)); fr = ln_ & 15; fq = ln_ >> 4; }
        const size_t e0 = (size_t)(u.pm * 256 + wr * 64 + fr) * ldu + (u.pn % npe) * 128 + wc * 32 + 8 * fq;
#pragma unroll
        for (int ai = 0; ai < 2; ++ai)
#pragma unroll
            for (int m = 0; m < 4; ++m) { float o[8];
#pragma unroll
                for (int n = 0; n < 2; ++n)
#pragma unroll
                    for (int i = 0; i < 4; i += 2) { const f32x2_t a2 = {acc[ai][0][m][n][i], acc[ai][0][m][n][i + 1]}, b2 = {acc[ai][1][m][n][i], acc[ai][1][m][n][i + 1]};
                        const f32x2_t t2 = a2 * -1.4426950408889634f; constexpr float s_ = F8OUT ? 1.0f / F8_ASCALE : 1.0f;
                        const f32x2_t e2 = {__builtin_amdgcn_exp2f(t2[0]), __builtin_amdgcn_exp2f(t2[1])}, d2 = e2 * s_ + s_;
                        const f32x2_t r2 = {__builtin_amdgcn_rcpf(d2[0]), __builtin_amdgcn_rcpf(d2[1])}, o2 = (a2 * b2) * r2;
                        o[n * 4 + i] = o2[0]; o[n * 4 + i + 1] = o2[1]; }
                const size_t e = e0 + (size_t)(ai * 128 + m * 16) * ldu;
                if (F8OUT) { uint2 w; w.x = pack4_fp8(o[0], o[1], o[2], o[3]); w.y = pack4_fp8(o[4], o[5], o[6], o[7]);
                    *(uint2*)((unsigned char*)U + e) = w; }
                else { u32x4 w; w.x = pg8::cvt_pk_bf16(o[0], o[1]); w.y = pg8::cvt_pk_bf16(o[2], o[3]); w.z = pg8::cvt_pk_bf16(o[4], o[5]); w.w = pg8::cvt_pk_bf16(o[6], o[7]);
                    *(u32x4*)((bf16_t*)U + e) = w; } }
    }
};
template <bool IN_F32>
struct EpiResidual {
    static constexpr bool PERM = true, AFTER_DRAIN = false; const float* xin; bf16_t* xb; const float* gate;
    __device__ __forceinline__ void operator()(const f32x4 (&acc)[2][2][4][2], const pg8::Unit& u, int wr, int wc, int fr, int fq) const {
        { const int ln_ = (int)__builtin_amdgcn_mbcnt_hi(~0u, __builtin_amdgcn_mbcnt_lo(~0u, 0u)); fr = ln_ & 15; fq = ln_ >> 4; }
        const int cls = u.pm < 64 ? 0 : 1, col0 = u.pn * 256 + wc * 32 + 8 * fq;
        const float* gv = gate + (size_t)cls * 6144 + col0;
        f32x4 g4[2][2];
#pragma unroll
        for (int bj = 0; bj < 2; ++bj)
#pragma unroll
            for (int n = 0; n < 2; ++n) g4[bj][n] = *(const f32x4*)(gv + bj * 128 + n * 4);
        const size_t row0 = (size_t)u.pm * 256 + wr * 64 + fr;
        f32x4 xv[8][2][2]; u32x4 xw[8][2];
#define ER_LD(i) do { const size_t off_ = (row0 + ((i) >> 2) * 128 + ((i) & 3) * 16) * DM + col0; \
            _Pragma("unroll") for (int bj = 0; bj < 2; ++bj) { if (IN_F32) { xv[i][bj][0] = *(const f32x4*)(xin + off_ + bj * 128); xv[i][bj][1] = *(const f32x4*)(xin + off_ + bj * 128 + 4); } \
                                                                else xw[i][bj] = *(const u32x4*)(xb + off_ + bj * 128); } } while (0)
#define ER_ST(i) do { const size_t off_ = (row0 + ((i) >> 2) * 128 + ((i) & 3) * 16) * DM + col0; \
            _Pragma("unroll") for (int bj = 0; bj < 2; ++bj) { f32x4 x0_, x1_; \
                if (IN_F32) { x0_ = xv[i][bj][0]; x1_ = xv[i][bj][1]; } \
                else { const u32x4 w_ = xw[i][bj]; x0_ = (f32x4){BFLO(w_.x), BFHI(w_.x), BFLO(w_.y), BFHI(w_.y)}; x1_ = (f32x4){BFLO(w_.z), BFHI(w_.z), BFLO(w_.w), BFHI(w_.w)}; } \
                const f32x4 o0_ = x0_ + g4[bj][0] * acc[(i) >> 2][bj][(i) & 3][0], o1_ = x1_ + g4[bj][1] * acc[(i) >> 2][bj][(i) & 3][1]; \
                u32x4 ow_; ow_.x = pg8::cvt_pk_bf16(o0_[0], o0_[1]); ow_.y = pg8::cvt_pk_bf16(o0_[2], o0_[3]); ow_.z = pg8::cvt_pk_bf16(o1_[0], o1_[1]); ow_.w = pg8::cvt_pk_bf16(o1_[2], o1_[3]); \
                *(u32x4*)(xb + off_ + bj * 128) = ow_; } } while (0)
        ER_LD(0); ER_LD(1); ER_LD(2);
#pragma unroll
        for (int i = 0; i < 8; ++i) { ER_ST(i); if (i + 3 < 8) ER_LD(i + 3); }
#undef ER_LD
#undef ER_ST
    }
};
struct MoeOrder : pg8::StaticOrder {
    int goff, npe, np0;
    __device__ __forceinline__ bool next(int i, pg8::Unit& u) const {
        int pl, pn;
        if (G == 256) {
            const int xcd = c & 7, slot = c >> 3, sb = i * 8 + xcd, NG = nN >> 2, pg = sb / NG, ng = sb - pg * NG;
            pl = pg * 8 + (slot >> 2); pn = ng * 4 + (slot & 3);
            if (pl >= nM) return false;
        } else { const int L = i * G + c; if (L >= nwg) return false; pl = L / nN; pn = L - pl * nN; }
        const int g = pl >= np0 ? 1 : 0, pm = pl - g * np0; u.pn = pn;
        const LAS int* og = (const LAS int*)(size_t)(unsigned)goff + g * 9;
        const int r = pm * 256; int e = 0;
#pragma unroll
        for (int k = 1; k < 8; ++k) e += (r >= og[k]) ? 1 : 0;
        u.pm = g * (GRP_ROWS / 256) + pm; u.pn += __builtin_amdgcn_readfirstlane(e) * npe; return true;
    }
};
#define GEMM_LDS ((PG8_LAS unsigned char*)lds)
struct EpiInProj {
    static constexpr bool PERM = true, AFTER_DRAIN = false; bf16_t* O; const char* tab;
    __device__ __forceinline__ void operator()(const f32x4 (&acc)[2][2][4][2], const pg8::Unit& u, int wr, int wc, int fr, int fq) const {
        const int row0 = u.pm * 256 + wr * 64 + fr; const bool lat = u.pm < 128;
#pragma unroll
        for (int bj = 0; bj < 2; ++bj) {
            const int s = u.pn * 2 + bj;
            int mode = 0; float scale = 1.0f;
            if (s <= 1) { mode = 1; scale = 0.125f * 1.4426950408889634f; } else if (s == 2) mode = 1;
            else if (s == 4 || s == 5) mode = 2; else if (s == 6 || s == 7) { mode = 2; scale = 0.125f; }
            else if (s == 12 || s == 13) { mode = 3; scale = 0.17677669529663687f * 1.4426950408889634f; } else if (s == 14 || s == 15) mode = 3;
            if (mode == 0) {
                bf16_t* base = O + (size_t)row0 * DIN + s * 128 + wc * 32 + 8 * fq;
#pragma unroll
                for (int ai = 0; ai < 2; ++ai)
#pragma unroll
                    for (int m = 0; m < 4; ++m) { const f32x4 v0 = acc[ai][bj][m][0], v1 = acc[ai][bj][m][1]; u32x4 w;
                        w.x = pg8::cvt_pk_bf16(v0[0], v0[1]); w.y = pg8::cvt_pk_bf16(v0[2], v0[3]); w.z = pg8::cvt_pk_bf16(v1[0], v1[1]); w.w = pg8::cvt_pk_bf16(v1[2], v1[3]);
                        *(u32x4*)(base + (size_t)(ai * 128 + m * 16) * DIN) = w; }
            } else {
                const bool wide = mode != 3; const int half = wide ? 32 : 16, g = wide ? 4 * (wc & 1) + fq : fq;
                const int cbase = s * 128 + (wide ? 64 * (wc >> 1) : 32 * wc) + 4 * g;
                const float* ct = (const float*)(tab + (mode == 1 ? TAB_ATTN : (mode == 2 ? TAB_RET : TAB_DIFF))) + 4 * g; const int tstride = half, tsin = 16384 * half;
                f32x4 csv[8], snv[8];
#pragma unroll
                for (int i = 0; i < 8; ++i) { const int row = row0 + (i >> 2) * 128 + (i & 3) * 16; const float* tp = ct + (size_t)(row & (NSEQ - 1)) * tstride;
                    csv[i] = *(const f32x4*)tp; snv[i] = *(const f32x4*)(tp + tsin); }
                asm volatile("" :: "v"(csv[0]), "v"(csv[1]), "v"(csv[2]), "v"(csv[3]), "v"(csv[4]), "v"(csv[5]), "v"(csv[6]), "v"(csv[7]), "v"(snv[0]), "v"(snv[1]), "v"(snv[2]), "v"(snv[3]), "v"(snv[4]), "v"(snv[5]), "v"(snv[6]), "v"(snv[7]));
#pragma unroll
                for (int ai = 0; ai < 2; ++ai)
#pragma unroll
                    for (int m = 0; m < 4; ++m) { const int row = row0 + ai * 128 + m * 16; const f32x4 v0 = acc[ai][bj][m][0], v1 = acc[ai][bj][m][1];
                        f32x4 cs = {1.f, 1.f, 1.f, 1.f}, sn = {0.f, 0.f, 0.f, 0.f};
                        if (lat) { cs = csv[ai * 4 + m]; sn = snv[ai * 4 + m]; }
                        const f32x4 o1 = (v0 * cs - v1 * sn) * scale, o2 = (v1 * cs + v0 * sn) * scale;
                        bf16_t* op = O + (size_t)row * DIN + cbase;
                        uint2 w1, w2; w1.x = pg8::cvt_pk_bf16(o1[0], o1[1]); w1.y = pg8::cvt_pk_bf16(o1[2], o1[3]); w2.x = pg8::cvt_pk_bf16(o2[0], o2[1]); w2.y = pg8::cvt_pk_bf16(o2[2], o2[3]);
                        *(uint2*)op = w1; *(uint2*)(op + half) = w2; }
            }
        }
    }
};
template <int K>
__device__ __forceinline__ void ctx_gemm_residual(const bf16_t* A, const bf16_t* W, float* xc, const float* gate, int bid, int nb, float* lds) {
    const int tid = TIDX, lane = tid & 63, wid = __builtin_amdgcn_readfirstlane(tid >> 6);
    constexpr int KW = K / 8, NS = KW / 16, CH = (NS % 11 == 0) ? 11 : 8;
    static_assert(K % 128 == 0 && NS % CH == 0, "ctx_gemm_residual: K split");
    LAS float* red = (LAS float*)lds;
    for (int tile = bid; tile < 256; tile += nb) {
        const int row0 = (tile >> 4) * 32, col0 = (tile & 15) * 64;
        const bf16_t* ap = A + (size_t)(row0 + (lane & 31)) * K + wid * KW + (lane >> 5) * 8;
        const bf16_t* bp = W + (size_t)(col0 + (lane & 31)) * K + wid * KW + (lane >> 5) * 8;
        f32x16 c0, c1;
#pragma unroll
        for (int r = 0; r < 16; ++r) { c0[r] = 0.f; c1[r] = 0.f; }
#pragma unroll 1
        for (int s0 = 0; s0 < NS; s0 += CH) {
            bf16x8 af[CH], b0[CH], b1[CH];
#pragma unroll
            for (int i = 0; i < CH; ++i) { af[i] = *(const bf16x8*)(ap + (s0 + i) * 16); b0[i] = *(const bf16x8*)(bp + (s0 + i) * 16); b1[i] = *(const bf16x8*)(bp + (size_t)32 * K + (s0 + i) * 16); }
#pragma unroll
            for (int i = 0; i < CH; ++i) { c0 = __builtin_amdgcn_mfma_f32_32x32x16_bf16(af[i], b0[i], c0, 0, 0, 0); c1 = __builtin_amdgcn_mfma_f32_32x32x16_bf16(af[i], b1[i], c1, 0, 0, 0); }
        }
        __syncthreads();
#pragma unroll
        for (int r = 0; r < 16; ++r) { red[((wid * 2 + 0) * 16 + r) * 64 + lane] = c0[r]; red[((wid * 2 + 1) * 16 + r) * 64 + lane] = c1[r]; }
        __syncthreads();
#pragma unroll
        for (int j = 0; j < 4; ++j) { const int o = tid + 512 * j; float s = 0.f;
#pragma unroll
            for (int w = 0; w < 8; ++w) s += red[w * 2048 + o];
            const int blk = o >> 10, r = (o >> 6) & 15, ln = o & 63, row = crow(r, ln >> 5), col = col0 + blk * 32 + (ln & 31);
            float* x = xc + (size_t)(row0 + row) * DM + col; *x = *x + gate[col] * s; }
    }
    __syncthreads();
}
__device__ __forceinline__ void ph_gemm_in(const Params& p, int l, int bid, int nb, float* lds) {
    char* ws = p.ws; pg8::Gemm g{(const bf16_t*)(ws + OFF_ACT), (const bf16_t*)(ws + OFF_WIN) + (size_t)l * DIN * DM, NROW, DIN, DM};
    pg8::StaticOrder S; S.init(NROW, DIN, nb, bid);
    EpiInProj E{(bf16_t*)(ws + OFF_P), ws + OFF_TAB};
    pg8::gemm_phase<EpiInProj, pg8::StaticOrder, true, true>(GEMM_LDS, g, S, E);
    if (nb == 256 && bid >= 150) { const int v = CV_MOE0 + (l == 0 ? 0 : CV_TA + CV_TB); convert_units(p, lds, v + bid - 150, 106, v + CV_TA, 0, 0); }
}
__device__ __forceinline__ void ph_gemm_out(const Params& p, int l, bool need_ctx, int bid, int nb, float* lds) {
    char* ws = p.ws; const int M = NLAT;
    if (need_ctx) ctx_gemm_residual<DM>((const bf16_t*)(ws + OFF_ACT) + (size_t)NLAT * DM, (const bf16_t*)(ws + OFF_WOUT) + (size_t)l * DM * DM, (float*)(ws + OFF_XC),
                                        (const float*)(ws + OFF_MOD) + (size_t)l * 3 * 6144 + 2048 + 2 * 6144, bid, nb, lds);
    pg8::Gemm g{(const bf16_t*)(ws + OFF_ACT), (const bf16_t*)(ws + OFF_WOUT) + (size_t)l * DM * DM, M, DM, DM};
    pg8::StaticOrder S; S.init(M, DM, nb, bid);
    const float* gate = (const float*)(ws + OFF_MOD) + (size_t)l * 3 * 6144 + 2048; bf16_t* xb = (bf16_t*)(ws + OFF_XB);
    if (l == 0) { EpiResidual<true> E{p.x, xb, gate}; pg8::gemm_phase<EpiResidual<true>, pg8::StaticOrder, true, true>(GEMM_LDS, g, S, E); }
    else { EpiResidual<false> E{nullptr, xb, gate}; pg8::gemm_phase<EpiResidual<false>, pg8::StaticOrder, true, true>(GEMM_LDS, g, S, E); }
}
__device__ __forceinline__ void ph_ffn1(const Params& p, bool need_ctx, int bid, int nb, float* lds) {
    char* ws = p.ws; const int M = need_ctx ? NROW : NLAT;
    pg8::Gemm g{(const bf16_t*)(ws + OFF_ACT), (const bf16_t*)(ws + OFF_WF13), M, 2 * DFF, DM / 2};
    pg8::StaticOrder S; S.init(M, 2 * DFF, nb, bid);
    EpiSwiglu<false> E{(void*)(ws + OFF_P), DFF, 2 * DFF / 256};
    pg8::gemm_phase<EpiSwiglu<false>, pg8::StaticOrder, true, true, true>(GEMM_LDS, g, S, E);
    if (nb == 256 && need_ctx && bid >= 44) { const int v = CV_MOE0 + CV_TA; convert_units(p, lds, v + bid - 44, 212, v + CV_TB, 0, 0); }
}
__device__ __forceinline__ void ph_ffn2(const Params& p, int l, bool need_ctx, int bid, int nb, float* lds) {
    char* ws = p.ws; const int M = NLAT;
    if (need_ctx) ctx_gemm_residual<DFF>((const bf16_t*)(ws + OFF_P) + (size_t)NLAT * DFF, (const bf16_t*)(ws + OFF_WF2), (float*)(ws + OFF_XC),
                                         (const float*)(ws + OFF_MOD) + (size_t)l * 3 * 6144 + 5120 + 2 * 6144, bid, nb, lds);
    pg8::Gemm g{(const bf16_t*)(ws + OFF_P), (const bf16_t*)(ws + OFF_WF2), M, DM, DFF};
    pg8::StaticOrder S; S.init(M, DM, nb, bid);
    EpiResidual<false> E{nullptr, (bf16_t*)(ws + OFF_XB), (const float*)(ws + OFF_MOD) + (size_t)l * 3 * 6144 + 5120};
    pg8::gemm_phase<EpiResidual<false>, pg8::StaticOrder, true, true>(GEMM_LDS, g, S, E);
}
__device__ __forceinline__ MoeOrder moe_order(const int* offs, int npe, int nb, int bid) {
    MoeOrder S; const int r0 = __builtin_amdgcn_readfirstlane(offs[8]), r1 = __builtin_amdgcn_readfirstlane(offs[17]);
    S.init(r0 + r1, npe * 256, nb, bid); S.goff = (int)(unsigned)(size_t)(const LAS int*)offs; S.npe = npe; S.np0 = r0 >> 8; return S;
}
__device__ __forceinline__ void ph_moe1(const Params& p, int bid, int nb, float* lds) {
    char* ws = p.ws; int* offs = (int*)(lds + 32768); __syncthreads(); moe_offsets(p, offs);
    const MoeOrder S = moe_order(offs, 2 * DFE / 256, nb, bid);
    pg8::Gemm gm{(const bf16_t*)(ws + OFF_ASORT), (const bf16_t*)(ws + OFF_WM13), 0, 0, DM / 2};
    EpiSwiglu<true> E{(void*)(ws + OFF_UMOE), DFE, 2 * DFE / 256};
    pg8::gemm_phase<EpiSwiglu<true>, MoeOrder, true, true, true>(GEMM_LDS, gm, S, E);
}
struct EpiMoeOut {
    static constexpr bool PERM = true, AFTER_DRAIN = false; bf16_t* Y; int npe;
    __device__ __forceinline__ void operator()(const f32x4 (&acc)[2][2][4][2], const pg8::Unit& u, int wr, int wc, int fr, int fq) const {
        { const int ln_ = (int)__builtin_amdgcn_mbcnt_hi(~0u, __builtin_amdgcn_mbcnt_lo(~0u, 0u)); fr = ln_ & 15; fq = ln_ >> 4; }
        bf16_t* base = Y + (size_t)(u.pm * 256 + wr * 64 + fr) * DM + (u.pn % npe) * 256 + wc * 32 + 8 * fq;
#pragma unroll
        for (int ai = 0; ai < 2; ++ai)
#pragma unroll
            for (int m = 0; m < 4; ++m) { bf16_t* rowp = base + (size_t)(ai * 128 + m * 16) * DM;
#pragma unroll
                for (int bj = 0; bj < 2; ++bj) { const f32x4 v0 = acc[ai][bj][m][0], v1 = acc[ai][bj][m][1]; u32x4 w;
                    w.x = pg8::cvt_pk_bf16(v0[0], v0[1]); w.y = pg8::cvt_pk_bf16(v0[2], v0[3]); w.z = pg8::cvt_pk_bf16(v1[0], v1[1]); w.w = pg8::cvt_pk_bf16(v1[2], v1[3]);
                    *(u32x4*)(rowp + bj * 128) = w; } }
    }
};
__device__ __forceinline__ void ph_moe2(const Params& p, int bid, int nb, float* lds) {
    char* ws = p.ws; int* offs = (int*)(lds + 32768); __syncthreads(); moe_offsets(p, offs);
    const MoeOrder S = moe_order(offs, DM / 256, nb, bid);
    pg8::Gemm gm{(const bf16_t*)(ws + OFF_UMOE), (const bf16_t*)(ws + OFF_WM2), 0, 0, DFE / 2};
    EpiMoeOut E{(bf16_t*)(ws + OFF_YMOE), DM / 256};
    pg8::gemm_phase<EpiMoeOut, MoeOrder, true, true, true>(GEMM_LDS, gm, S, E);
}

#define XB_TMO      128
#define XB_XCNT(j)  (256  + 64 * (j))
#define XB_XSUB(j)  (1280 + 64 * (j))
#define XB_XGEN(j)  (2304 + 64 * (j))
#define XB_TOP      3328
#define XB_TOPGEN   3392
#define XCD_BAR_WORDS 3456
#define XB_SPIN_CAP (1u << 22)

__device__ __forceinline__ unsigned xb_ld(unsigned* p)              { return __hip_atomic_load(p, __ATOMIC_RELAXED, __HIP_MEMORY_SCOPE_AGENT); }
__device__ __forceinline__ unsigned xb_add(unsigned* p, unsigned v) { return __hip_atomic_fetch_add(p, v, __ATOMIC_RELAXED, __HIP_MEMORY_SCOPE_AGENT); }
__device__ __forceinline__ unsigned xb_xcc_id() { return (unsigned)__builtin_amdgcn_s_getreg((3 << 11) | 20) & 0xFu; }
#define XB_SPIN(cond, bar) do { unsigned _sp = 0; while (cond) { __builtin_amdgcn_s_sleep(1); \
    if ((++_sp & 255u) == 0u) { if (xb_ld(&(bar)[XB_TMO])) break; if (_sp > XB_SPIN_CAP) { atomicAdd(&(bar)[XB_TMO], 1u); break; } } } } while (0)

struct XcdBarrier {
    unsigned* bar; unsigned x;
    volatile LAS unsigned* st;
};

__device__ __forceinline__ XcdBarrier xcd_barrier_post(unsigned* bar, volatile LAS unsigned* st) {
    XcdBarrier b; b.bar = bar; b.x = xb_xcc_id(); b.st = st;
    if (threadIdx.x == 0) (void)xb_add(&bar[XB_XCNT(b.x)], 1u);
    return b;
}
__device__ __forceinline__ void xcd_barrier_complete(unsigned* bar, unsigned x, unsigned& nloc, unsigned& nx) {
    const unsigned G = gridDim.x * gridDim.y * gridDim.z;
    unsigned sum, cnt, mine, sp = 0u;
    for (;;) {
        sum = 0u; cnt = 0u; mine = 0u;
#pragma unroll
        for (unsigned j = 0; j < 16; ++j) { const unsigned c = xb_ld(&bar[XB_XCNT(j)]); sum += c; cnt += (c > 0u) ? 1u : 0u; mine = (j == x) ? c : mine; }
        if (sum == G) break;
        __builtin_amdgcn_s_sleep(1);
        if ((++sp & 255u) == 0u) { if (xb_ld(&bar[XB_TMO])) break; if (sp > XB_SPIN_CAP) { atomicAdd(&bar[XB_TMO], 1u); break; } }
    }
    nloc = mine > 0u ? mine : 1u; nx = cnt > 0u ? cnt : 1u;
}

__device__ __forceinline__ void xcd_barrier(const XcdBarrier& b) {
    asm volatile("s_waitcnt vmcnt(0)" ::: "memory");
    __syncthreads();
    if (threadIdx.x == 0) {
        unsigned* bar = b.bar;
        __builtin_amdgcn_s_waitcnt(0);
        unsigned nloc = b.st[0], nx = b.st[1];
        if (nloc == 0u) { xcd_barrier_complete(bar, b.x, nloc, nx); b.st[0] = nloc; b.st[1] = nx; }
        const unsigned old = xb_add(&bar[XB_XSUB(b.x)], 1u);
        const unsigned gen = old / nloc;
        if (old + 1u == (gen + 1u) * nloc) {
            __builtin_amdgcn_fence(__ATOMIC_RELEASE, "agent");
            asm volatile("s_waitcnt vmcnt(0)" ::: "memory");
            const unsigned og = xb_add(&bar[XB_TOP], 1u);
            const unsigned tg = og / nx;
            if (og + 1u == (tg + 1u) * nx) xb_add(&bar[XB_TOPGEN], 1u);
            else XB_SPIN(xb_ld(&bar[XB_TOPGEN]) == tg, bar);
            __builtin_amdgcn_fence(__ATOMIC_ACQUIRE, "agent");
            xb_add(&bar[XB_XGEN(b.x)], 1u);
            asm volatile("s_waitcnt vmcnt(0)" ::: "memory");
        } else {
            XB_SPIN(xb_ld(&bar[XB_XGEN(b.x)]) == gen, bar);
            __builtin_amdgcn_fence(__ATOMIC_ACQUIRE, "agent");
            asm volatile("s_waitcnt vmcnt(0)" ::: "memory");
        }
    }
    __syncthreads();
}


constexpr int LDS_FLOATS = 33792;
constexpr int LDS_BYTES = LDS_FLOATS * 4 + 16 + 256 + 16;

typedef const __attribute__((address_space(4))) unsigned long long* kargp_t;
typedef __attribute__((address_space(1))) const float* gcf_t;
__device__ __forceinline__ Params load_params(const float* lds) {
    const LAS unsigned* tbl = (const LAS unsigned*)(lds + LDS_FLOATS + 4);
    Params p; const float** f = (const float**)&p;
#pragma unroll
    for (int i = 0; i < (int)(sizeof(Params) / 8); ++i) {
        const unsigned lo = __builtin_amdgcn_readfirstlane(tbl[2 * i]), hi = __builtin_amdgcn_readfirstlane(tbl[2 * i + 1]);
        f[i] = (const float*)(gcf_t)(((unsigned long long)hi << 32) | lo); }
    return p;
}
#define LOADP(name) const Params name = load_params(lds)

template <int l>
__device__ __forceinline__ void run_layer(const XcdBarrier& bar, int bid, int nb, float* lds) {
    constexpr bool need_ctx = l == 0;
    constexpr float lam_init = l == 0 ? 0.2f : 0.35550906759509393f;
    { LOADP(p); ph_norm<false>(p, l, 0, NROW, bid, nb, lds); } xcd_barrier(bar);
    { LOADP(p); ph_gemm_in(p, l, bid, nb, lds); } xcd_barrier(bar);
    { LOADP(p); ph_ret_summ(p, l, bid, nb, lds); } { LOADP(p); ph_lru_chunk<1>(p, l, bid, nb, lds, 0); } xcd_barrier(bar);
    { LOADP(p); ph_scan2(p, l, bid, nb); }
    { LOADP(p); ph_diff(p, l, need_ctx, lam_init, bid, nb, lds); }
    { LOADP(p); ph_swa(p, l, need_ctx, bid, nb, lds); } xcd_barrier(bar);
    { LOADP(p); ph_ret_out(p, l, bid, nb, lds, need_ctx ? 0 : 2); }
    { LOADP(p); ph_lru_chunk<3>(p, l, bid, nb, lds, need_ctx ? 0 : 2); } xcd_barrier(bar);
    { LOADP(p); ph_gemm_out(p, l, need_ctx, bid, nb, lds); } xcd_barrier(bar);
    if (l == 0) {
        { LOADP(p); ph_norm<false>(p, l, 1, NROW, bid, nb, lds); } xcd_barrier(bar);
        { LOADP(p); ph_ffn1(p, need_ctx, bid, nb, lds); } xcd_barrier(bar);
        { LOADP(p); ph_ffn2(p, l, need_ctx, bid, nb, lds); } xcd_barrier(bar);
    } else {
        { LOADP(p); ph_norm<true>(p, l, 1, NLAT, bid, nb, lds); } xcd_barrier(bar);
        { LOADP(p); ph_moe_scatter(p, bid, nb, lds); } xcd_barrier(bar);
        { LOADP(p); ph_moe1(p, bid, nb, lds); } xcd_barrier(bar);
        { LOADP(p); ph_moe2(p, bid, nb, lds); } xcd_barrier(bar);
    }
}

__global__ void __launch_bounds__(512, 2) fwd(Params p_in) {
    extern __shared__ __attribute__((aligned(16))) float lds[];
    volatile LAS unsigned* st = (volatile LAS unsigned*)(lds + LDS_FLOATS);
    if (threadIdx.x == 0) { st[0] = 0u; st[1] = 0u; st[2] = 0u; st[3] = 0u; }
    if (threadIdx.x < (int)(sizeof(Params) / 8)) { const kargp_t q = (kargp_t)__builtin_amdgcn_kernarg_segment_ptr(); ((LAS unsigned long long*)(lds + LDS_FLOATS + 4))[threadIdx.x] = q[threadIdx.x]; }
    __syncthreads();
    XcdBarrier bar;
    { LOADP(p); bar = xcd_barrier_post((unsigned*)p.ws, st); }
    const int bid = blockIdx.x, nb = gridDim.x;
    { LOADP(p); ph_prologue(p, bid, nb, lds); } xcd_barrier(bar);
    run_layer<0>(bar, bid, nb, lds);
    run_layer<1>(bar, bid, nb, lds);
    { LOADP(p); ph_final(p, bid, nb, lds); }
}

extern "C" void kernel_launch(void* const* d_in, const int* in_sizes, int n_in, void* d_out, int out_size, void* d_ws, size_t ws_size, hipStream_t stream) {
    static int grid = 0;
    if (grid == 0) {
        if (n_in < 30 || ws_size < WS_NEED) { fprintf(stderr, "kernel_launch: bad args n_in=%d ws=%zu need=%zu\n", n_in, ws_size, (size_t)WS_NEED); grid = -1; return; }
        int dev = 0, cus = 0, per_cu = 0;
        if (hipGetDevice(&dev) != hipSuccess || hipDeviceGetAttribute(&cus, hipDeviceAttributeMultiprocessorCount, dev) != hipSuccess) { grid = -1; return; }
        if (hipFuncSetAttribute((const void*)fwd, hipFuncAttributeMaxDynamicSharedMemorySize, LDS_BYTES) != hipSuccess) { fprintf(stderr, "kernel_launch: hipFuncSetAttribute failed\n"); grid = -1; return; }
        if (hipOccupancyMaxActiveBlocksPerMultiprocessor(&per_cu, (const void*)fwd, 512, LDS_BYTES) != hipSuccess || per_cu < 1) { fprintf(stderr, "kernel_launch: occupancy query says %d\n", per_cu); per_cu = 1; }
        (void)hipGetLastError();
        grid = cus;
    }
    if (grid < 0) return;
    Params p{};
    const float** f = (const float**)&p;
    for (int i = 0; i < 30; ++i) f[i] = (const float*)d_in[i];
    p.out = (float*)d_out; p.ws = (char*)d_ws;
    (void)hipMemsetAsync(d_ws, 0, 65536, stream);
    hipLaunchKernelGGL(fwd, dim3(grid), dim3(512), LDS_BYTES, stream, p);
}
```

```cpp
#include <hip/hip_runtime.h>
#include <cstdio>
#include <cstdint>

typedef unsigned short bf16_t;
typedef short bf16x8 __attribute__((ext_vector_type(8)));
typedef float f32x4 __attribute__((ext_vector_type(4)));
typedef unsigned u32x4 __attribute__((ext_vector_type(4)));
#define LAS __attribute__((address_space(3)))

constexpr int NB = 2, NSEQ = 16384, NCTX = 256, DM = 1024;
constexpr int NLAT = NB * NSEQ;
constexpr int NCR = NB * NCTX;
constexpr int NROW = NLAT + NCR;
constexpr int DIN = 2816, DFF = 2816, DFE = 3584, NE = 8;
constexpr int NCI = 130;
constexpr int C_AQ = 0, C_AK = 256, C_AV = 384, C_RQ = 512, C_RK = 768, C_RV = 1024, C_RG = 1280, C_DQ = 1536, C_DK = 1792, C_DV = 2048, C_LX = 2304, C_LY = 2560;
constexpr int GRP_ROWS = 34816;

constexpr size_t al256(size_t x) { return (x + 255) & ~(size_t)255; }
constexpr size_t OFF_CTRL = 0;
constexpr size_t OFF_MOD = 65536;
constexpr size_t OFF_TAB = al256(OFF_MOD + 2 * 3 * 6144 * 4);
constexpr size_t TAB_ATTN = 0, TAB_RET = 4u << 20, TAB_DIFF = 8u << 20;
constexpr size_t OFF_XC = al256(OFF_TAB + (10u << 20));
constexpr size_t OFF_ROUTE = al256(OFF_XC + (size_t)NCR * DM * 4);
constexpr size_t OFF_TOK = al256(OFF_ROUTE + (size_t)NLAT * 16);
constexpr size_t OFF_WGT = al256(OFF_TOK + (size_t)2 * GRP_ROWS * 4);
constexpr size_t OFF_LRU = al256(OFF_WGT + (size_t)2 * GRP_ROWS * 4);
constexpr size_t OFF_WM13 = al256(OFF_LRU + (size_t)3 * 2 * 2 * NCI * 256 * 4);
constexpr size_t OFF_WM2 = al256(OFF_WM13 + (size_t)NE * 2 * DFE * DM);
constexpr size_t OFF_XB = al256(OFF_WM2 + (size_t)NE * DM * DFE);
constexpr size_t OFF_R = al256(OFF_XB + (size_t)NLAT * DM * 2);
constexpr size_t OFF_P = OFF_R;
constexpr size_t OFF_ACT = al256(OFF_P + (size_t)NROW * DIN * 2);
constexpr size_t OFF_RET = al256(OFF_ACT + (size_t)NROW * DM * 2);
constexpr size_t OFF_WIN = al256(OFF_RET + (size_t)2 * 2 * NCI * 4 * 4096 * 4);
constexpr size_t OFF_WOUT = al256(OFF_WIN + (size_t)2 * DIN * DM * 2);
constexpr size_t OFF_WF13 = al256(OFF_WOUT + (size_t)2 * DM * DM * 2);
constexpr size_t OFF_WF2 = al256(OFF_WF13 + (size_t)2 * DFF * DM * 2);
constexpr size_t OFF_R_END1 = al256(OFF_WF2 + (size_t)DM * DFF * 2);
constexpr size_t OFF_ASORT = OFF_R;
constexpr size_t OFF_YMOE = OFF_ASORT;
constexpr size_t OFF_UMOE = al256(OFF_ASORT + (size_t)2 * GRP_ROWS * DM * 2);
constexpr size_t OFF_R_END2 = al256(OFF_UMOE + (size_t)GRP_ROWS * DFE * 2);
constexpr size_t WS_NEED = OFF_R_END1 > OFF_R_END2 ? OFF_R_END1 : OFF_R_END2;
static_assert(OFF_ACT >= OFF_UMOE, "H2 must not overlap A_sorted");
constexpr int CW_CNT = 4096;
constexpr int CW_BLK = 8192;

struct Params {
    const float *x, *c, *ctx, *c_ctx, *w_ada, *b_ada, *g1, *g2, *w_in, *w_out, *sink, *ret_logit, *ret_gn, *diff_lam, *diff_gn,
        *conv_w, *conv_b, *lru_wa, *lru_ba, *lru_wx, *lru_bx, *lru_lam, *ffn_w1, *ffn_w3, *ffn_w2, *moe_router, *moe_w1, *moe_w3, *moe_w2, *final_norm;
    float* out; char* ws;
};

__device__ __forceinline__ int ltid_() { int t = threadIdx.x; asm volatile("" : "+v"(t)); return t; }
#define TIDX ltid_()
__device__ __forceinline__ float bf2f(bf16_t h) { return __uint_as_float(((unsigned)h) << 16); }
__device__ __forceinline__ bf16_t f2bf(float f) { unsigned u = __float_as_uint(f); u += 0x7fffu + ((u >> 16) & 1u); return (bf16_t)(u >> 16); }
__device__ __forceinline__ unsigned pack2(float lo, float hi) { return (unsigned)f2bf(lo) | ((unsigned)f2bf(hi) << 16); }
__device__ __forceinline__ unsigned pack4_fp8(float a, float b, float c, float d) {
    a = fminf(fmaxf(a, -440.f), 440.f); b = fminf(fmaxf(b, -440.f), 440.f); c = fminf(fmaxf(c, -440.f), 440.f); d = fminf(fmaxf(d, -440.f), 440.f);
    unsigned w = 0u; w = __builtin_amdgcn_cvt_pk_fp8_f32(a, b, w, false); w = __builtin_amdgcn_cvt_pk_fp8_f32(c, d, w, true); return w;
}
constexpr float F8_WSCALE = 128.0f, F8_ASCALE = 8.0f;
constexpr int F8_WE8M0 = 127 - 7, F8_AE8M0 = 127 - 3, F8_SCALES = F8_WE8M0 | (F8_AE8M0 << 8);
#define BFLO(w) __uint_as_float((w) << 16)
#define BFHI(w) __uint_as_float((w) & 0xffff0000u)
__device__ __forceinline__ float wave_sum(float v) {
#pragma unroll
    for (int o = 32; o >= 1; o >>= 1) v += __shfl_xor(v, o);
    return v;
}
__device__ __forceinline__ float sigmoidf_(float x) { return 1.0f / (1.0f + __expf(-x)); }
__device__ __forceinline__ float siluf_(float x) { return x / (1.0f + __expf(-x)); }
__device__ __forceinline__ float fast_silu(float v) { return v * __builtin_amdgcn_rcpf(1.0f + __expf(-v)); }
__device__ __forceinline__ float softplusf_(float x) { return x > 20.f ? x : log1pf(expf(x)); }
__device__ __forceinline__ float gelu_tanh(float x) { const float u = 0.7978845608028654f * (x + 0.044715f * x * x * x); return x * __builtin_amdgcn_rcpf(1.0f + __expf(-2.0f * u)); }
__device__ __forceinline__ int row_base(int b, int ci) { return ci < 2 ? NLAT + b * NCTX + ci * 128 : b * NSEQ + (ci - 2) * 128; }
__device__ __forceinline__ int mod_class(int row) { return row < NSEQ ? 0 : (row < NLAT ? 1 : 2); }

typedef float f32x16 __attribute__((ext_vector_type(16)));
typedef short s16x4 __attribute__((ext_vector_type(4)));
typedef short v4i16_t __attribute__((ext_vector_type(4)));
typedef float f32x2_t __attribute__((ext_vector_type(2)));
typedef __bf16 bf16x2_t __attribute__((ext_vector_type(2)));
__device__ __forceinline__ unsigned cvtpk_s(float lo, float hi) { f32x2_t v = {lo, hi}; bf16x2_t bb = __builtin_convertvector(v, bf16x2_t); return __builtin_bit_cast(unsigned, bb); }
__device__ __forceinline__ int crow(int r, int hi) { return (r & 3) + 8 * (r >> 2) + 4 * hi; }
__device__ __forceinline__ s16x4 vtr(const LAS char* p) { return __builtin_bit_cast(s16x4, __builtin_amdgcn_ds_read_tr16_b64_v4i16((LAS v4i16_t*)p)); }
__device__ __forceinline__ float bfs(short s) { return __uint_as_float(((unsigned)(unsigned short)s) << 16); }

struct Ct4Regs { float4 a[4], b[4]; };
__device__ __forceinline__ void ct4_load(const float* src, int N, int unit, Ct4Regs& r) {
    const int upn = N / 256, tk = unit / upn, tn4 = unit % upn, t = TIDX, kk = t >> 3, nc = (t & 7) * 8;
#pragma unroll
    for (int q = 0; q < 4; ++q) { const float* sp = src + (size_t)(tk * 64 + kk) * N + tn4 * 256 + q * 64 + nc; r.a[q] = *(const float4*)sp; r.b[q] = *(const float4*)(sp + 4); }
}
__device__ __forceinline__ void ct4_store(const Ct4Regs& r, int K, int N, bf16_t* dst, int unit, int mode_, float* lds) {
    const int upn = N / 256, tk = unit / upn, tn4 = unit % upn, t = TIDX; const bool f8 = (mode_ & 8) != 0; const int mode = mode_ & 7;
    {   const int kk = t >> 3, nc = (t & 7) * 8;
#pragma unroll
        for (int q = 0; q < 4; ++q) { float* d = lds + q * (64 * 65) + kk * 65 + nc; d[0] = r.a[q].x; d[1] = r.a[q].y; d[2] = r.a[q].z; d[3] = r.a[q].w; d[4] = r.b[q].x; d[5] = r.b[q].y; d[6] = r.b[q].z; d[7] = r.b[q].w; } }
    __syncthreads();
    {   const int n = t >> 3, kc = (t & 7) * 8;
#pragma unroll
        for (int q = 0; q < 4; ++q) { const int ng = tn4 * 256 + q * 64 + n; const float* L = lds + q * (64 * 65);
            int nrow;
            if (mode == 3) {
                const int s = ng >> 7; const bool r64 = s <= 2 || (s >= 4 && s <= 7), r32 = s >= 12 && s <= 15;
                if (r64) { const int d = ng & 63; nrow = (ng & ~63) + 8 * ((d & 31) >> 2) + 4 * (d >> 5) + (d & 3); }
                else if (r32) { const int d = ng & 31; nrow = (ng & ~31) + 8 * ((d & 15) >> 2) + 4 * (d >> 4) + (d & 3); }
                else nrow = ng;
            } else nrow = mode == 0 ? ng : ((ng >> 7) * 256 + (mode == 2 ? 128 : 0) + (ng & 127));
            if (f8) { uint2 w; w.x = pack4_fp8(L[(kc + 0) * 65 + n] * F8_WSCALE, L[(kc + 1) * 65 + n] * F8_WSCALE, L[(kc + 2) * 65 + n] * F8_WSCALE, L[(kc + 3) * 65 + n] * F8_WSCALE);
                w.y = pack4_fp8(L[(kc + 4) * 65 + n] * F8_WSCALE, L[(kc + 5) * 65 + n] * F8_WSCALE, L[(kc + 6) * 65 + n] * F8_WSCALE, L[(kc + 7) * 65 + n] * F8_WSCALE);
                *(uint2*)((unsigned char*)dst + (size_t)nrow * K + tk * 64 + kc) = w; }
            else { uint4 w; w.x = pack2(L[(kc + 0) * 65 + n], L[(kc + 1) * 65 + n]); w.y = pack2(L[(kc + 2) * 65 + n], L[(kc + 3) * 65 + n]);
                w.z = pack2(L[(kc + 4) * 65 + n], L[(kc + 5) * 65 + n]); w.w = pack2(L[(kc + 6) * 65 + n], L[(kc + 7) * 65 + n]);
                *(uint4*)(dst + (size_t)nrow * K + tk * 64 + kc) = w; } } }
    __syncthreads();
}

constexpr int CV_T_IN = 16 * 11, CV_T_OUT = 16 * 4, CV_T_F13 = 16 * 11, CV_T_F2 = 44 * 4, CV_T_M13 = 16 * 14, CV_T_M2 = 56 * 4;
constexpr int CV_MOE0 = 2 * CV_T_IN + 2 * CV_T_OUT + 2 * CV_T_F13 + CV_T_F2, CV_TOTAL = CV_MOE0 + 16 * CV_T_M13 + 8 * CV_T_M2, CV_TA = 12 * 106, CV_TB = 4 * 212, CV_TAILS = 2 * CV_TA + CV_TB;
static_assert(CV_MOE0 + CV_TAILS <= CV_TOTAL, "conversion tails");
__device__ __forceinline__ void convert_units(const Params& p, float* lds, int v0, int vstep, int vend, int split, int skip) {
    char* ws = p.ws; const int t = TIDX;
    {
        struct Job { const float* src; bf16_t* dst; int K, N, mode, base; };
        Job* jobs = (Job*)(lds + 4 * 64 * 65);
        const int T_IN = CV_T_IN, T_OUT = CV_T_OUT, T_F13 = CV_T_F13, T_F2 = CV_T_F2, T_M13 = CV_T_M13, T_M2 = CV_T_M2;
        const int total = CV_TOTAL;
        if (t < 32) {
            Job jb; jb.src = nullptr; jb.dst = nullptr; jb.K = DM; jb.N = DM; jb.mode = 0; jb.base = total;
            if (t < 2) { jb.src = p.w_in + (size_t)t * DM * DIN; jb.dst = (bf16_t*)(ws + OFF_WIN) + (size_t)t * DIN * DM; jb.N = DIN; jb.mode = 3; jb.base = t * T_IN; }
            else if (t < 4) { jb.src = p.w_out + (size_t)(t - 2) * DM * DM; jb.dst = (bf16_t*)(ws + OFF_WOUT) + (size_t)(t - 2) * DM * DM; jb.base = 2 * T_IN + (t - 2) * T_OUT; }
            else if (t < 6) { jb.src = t == 4 ? p.ffn_w1 : p.ffn_w3; jb.dst = (bf16_t*)(ws + OFF_WF13); jb.N = DFF; jb.mode = 8 | (t - 3); jb.base = 2 * T_IN + 2 * T_OUT + (t - 4) * T_F13; }
            else if (t == 6) { jb.src = p.ffn_w2; jb.dst = (bf16_t*)(ws + OFF_WF2); jb.K = DFF; jb.base = 2 * T_IN + 2 * T_OUT + 2 * T_F13; }
            else if (t < 23) { const int q = t - 7, e = q & 7, w3 = q >> 3; jb.src = (w3 ? p.moe_w3 : p.moe_w1) + (size_t)e * DM * DFE; jb.dst = (bf16_t*)(ws + OFF_WM13 + (size_t)e * 2 * DFE * DM); jb.N = DFE; jb.mode = 8 | (1 + w3);
                jb.base = 2 * T_IN + 2 * T_OUT + 2 * T_F13 + T_F2 + q * T_M13; }
            else if (t < 31) { const int e = t - 23; jb.src = p.moe_w2 + (size_t)e * DFE * DM; jb.dst = (bf16_t*)(ws + OFF_WM2 + (size_t)e * DM * DFE); jb.K = DFE; jb.mode = 8;
                jb.base = 2 * T_IN + 2 * T_OUT + 2 * T_F13 + T_F2 + 16 * T_M13 + e * T_M2; }
            jobs[t] = jb;
        }
        __syncthreads();
#define JOB_SRC(jj) ((const float*)(__attribute__((address_space(1))) const float*)(unsigned long long)jobs[jj].src)
#define JOB_DST(jj) ((bf16_t*)(__attribute__((address_space(1))) bf16_t*)(unsigned long long)jobs[jj].dst)
#define CV_U(v) ((v) < split ? (v) : (v) + skip)
        int j = 0; Ct4Regs cur, nxt;
        if (v0 < vend) { const int u0 = CV_U(v0); while (u0 >= jobs[j + 1].base) ++j; ct4_load(JOB_SRC(j), jobs[j].N, u0 - jobs[j].base, cur); }
        for (int v = v0; v < vend; v += vstep) {
            const int u = CV_U(v), vn = v + vstep < vend ? v + vstep : v, un = CV_U(vn); int jn = j;
            while (un >= jobs[jn + 1].base) ++jn;
            ct4_load(JOB_SRC(jn), jobs[jn].N, un - jobs[jn].base, nxt);
            ct4_store(cur, jobs[j].K, jobs[j].N, JOB_DST(j), u - jobs[j].base, jobs[j].mode, lds);
            cur = nxt; j = jn;
        }
#undef JOB_SRC
#undef JOB_DST
#undef CV_U
        __syncthreads();
    }
}

__device__ __forceinline__ void ph_prologue(const Params& p, int bid, int nb, float* lds) {
    char* ws = p.ws; const int t = TIDX;
    { const bool tails = nb == 256; convert_units(p, lds, bid, nb, tails ? CV_TOTAL - CV_TAILS : CV_TOTAL, CV_MOE0, tails ? CV_TAILS : 0); }
    {
        float* sv = lds;
        float* red = lds + 3072;
        for (int i = t; i < 3072; i += 512) { const int v = i >> 10, k = i & 1023; const float cv = v < 2 ? p.c[v * DM + k] : p.c_ctx[k]; sv[i] = siluf_(cv); }
        __syncthreads();
        float* mod = (float*)(ws + OFF_MOD);
        for (int u = bid; u < 2 * 96; u += nb) {
            const int l = u / 96, j0 = (u % 96) * 64, j = t & 63, kg = t >> 6;
            float a0 = 0.f, a1 = 0.f, a2 = 0.f;
            const float* w = p.w_ada + (size_t)l * DM * 6144 + j0 + j;
            for (int k = kg * 128; k < kg * 128 + 128; ++k) { const float wv = w[(size_t)k * 6144]; a0 += sv[k] * wv; a1 += sv[1024 + k] * wv; a2 += sv[2048 + k] * wv; }
            red[(kg * 3 + 0) * 64 + j] = a0; red[(kg * 3 + 1) * 64 + j] = a1; red[(kg * 3 + 2) * 64 + j] = a2;
            __syncthreads();
            if (t < 192) { const int v = t >> 6; float s = 0.f;
                for (int g = 0; g < 8; ++g) s += red[(g * 3 + v) * 64 + j];
                mod[((size_t)l * 3 + v) * 6144 + j0 + j] = s + p.b_ada[l * 6144 + j0 + j]; }
            __syncthreads();
        }
    }
    {
        const int gt = bid * 512 + t, gs = nb * 512;
        float* ta = (float*)(ws + OFF_TAB + TAB_ATTN); float* tr = (float*)(ws + OFF_TAB + TAB_RET); float* td = (float*)(ws + OFF_TAB + TAB_DIFF);
        const int j = gt & 31;
        const float inv_r = (float)pow(10000.0, -(double)j / 32.0), inv_a = (float)pow(10000.0, -(double)(j & 15) / 16.0), inv_d = (float)pow(10000.0, -(double)(j & 7) / 8.0);
        for (int i = gt; i < 16384 * 32; i += gs) { const int n = i >> 5; double sv, cv;
            { const float ang = (float)n * inv_r; sincos((double)ang, &sv, &cv); tr[i] = (float)cv; tr[16384 * 32 + i] = (float)sv; }
            { const float ang = (float)(j < 16 ? (n >> 6) : (n & 63)) * inv_a; sincos((double)ang, &sv, &cv); ta[i] = (float)cv; ta[16384 * 32 + i] = (float)sv; }
            if (j < 16) { const float ang = (float)(j < 8 ? (n >> 6) : (n & 63)) * inv_d; sincos((double)ang, &sv, &cv); td[n * 16 + j] = (float)cv; td[16384 * 16 + n * 16 + j] = (float)sv; } }
        float* xc = (float*)(ws + OFF_XC);
        for (int i = gt; i < NCR * DM / 4; i += gs) ((float4*)xc)[i] = ((const float4*)p.ctx)[i];
    }
}

template <bool ROUTE>
__device__ __forceinline__ void ph_norm(const Params& p, int l, int which  , int nrows, int bid, int nb, float* lds) {
    char* ws = p.ws; const int lane = TIDX & 63, wv = TIDX >> 6;
    LAS unsigned* lcnt = (LAS unsigned*)lds;
    if (ROUTE) { __syncthreads(); if (TIDX < 16) lcnt[TIDX] = 0u; __syncthreads(); }
    const float* mod = (const float*)(ws + OFF_MOD) + (size_t)l * 3 * 6144;
    const float* g = (which == 0 ? p.g1 : p.g2) + l * DM;
    bf16_t* H = (bf16_t*)(ws + OFF_ACT);
    const bool xin32 = which == 0 && l == 0;
    const float* xl = p.x; const bf16_t* xb = (const bf16_t*)(ws + OFF_XB);
    const float* xc = (const float*)(ws + OFF_XC);
    const int stride = nb * 8;
    float rw[ROUTE ? 4 : 1][4][8];
    if (ROUTE) {
#pragma unroll
        for (int i = 0; i < 4; ++i) { const float* rt = p.moe_router + (size_t)(i * 256 + lane * 4) * 8;
#pragma unroll
            for (int k = 0; k < 4; ++k) { const float4 a = *(const float4*)(rt + k * 8), b = *(const float4*)(rt + k * 8 + 4);
                rw[i][k][0] = a.x; rw[i][k][1] = a.y; rw[i][k][2] = a.z; rw[i][k][3] = a.w; rw[i][k][4] = b.x; rw[i][k][5] = b.y; rw[i][k][6] = b.z; rw[i][k][7] = b.w; } } }
    float4 ma[4], mb[4]; int ccls = -1;
    constexpr int NQ = ROUTE ? 1 : 2;
    for (int r0 = bid * 8 + wv; r0 < nrows; r0 += NQ * stride) {
        float4 v[NQ][4]; float ss[NQ]; const bool has1 = NQ == 2 && r0 + stride < nrows;
#pragma unroll
        for (int q = 0; q < NQ; ++q) { const int r = (q == 0 || has1) ? r0 + q * stride : r0;
            if (xin32 || r >= NLAT) { const float* xr = r < NLAT ? xl + (size_t)r * DM : xc + (size_t)(r - NLAT) * DM;
#pragma unroll
                for (int i = 0; i < 4; ++i) v[q][i] = *(const float4*)(xr + i * 256 + lane * 4); }
            else { const bf16_t* xr = xb + (size_t)r * DM;
#pragma unroll
                for (int i = 0; i < 4; ++i) { const uint2 w = *(const uint2*)(xr + i * 256 + lane * 4); v[q][i] = make_float4(BFLO(w.x), BFHI(w.x), BFLO(w.y), BFHI(w.y)); } } }
#pragma unroll
        for (int q = 0; q < NQ; ++q) { float s = 0.f;
#pragma unroll
            for (int i = 0; i < 4; ++i) s += v[q][i].x * v[q][i].x + v[q][i].y * v[q][i].y + v[q][i].z * v[q][i].z + v[q][i].w * v[q][i].w;
            ss[q] = wave_sum(s); }
#pragma unroll
        for (int q = 0; q < NQ; ++q) {
            if (q == 1 && !has1) break;
            const int r = r0 + q * stride;
            const int cls = __builtin_amdgcn_readfirstlane(mod_class(r));
            if (cls != ccls) { const float* mv = mod + (size_t)cls * 6144 + (which == 0 ? 0 : 3072); ccls = cls;
#pragma unroll
                for (int i = 0; i < 4; ++i) { const int c = i * 256 + lane * 4; const float4 gg = *(const float4*)(g + c), sh = *(const float4*)(mv + c), sc = *(const float4*)(mv + 1024 + c);
                    ma[i] = make_float4(gg.x * (1.f + sc.x), gg.y * (1.f + sc.y), gg.z * (1.f + sc.z), gg.w * (1.f + sc.w)); mb[i] = sh; } }
            const float rn = rsqrtf(ss[q] * (1.0f / 1024.0f) + 1e-6f);
            float lg[8];
            if (ROUTE) {
#pragma unroll
                for (int e = 0; e < 8; ++e) lg[e] = 0.f;
            }
#pragma unroll
            for (int i = 0; i < 4; ++i) {
                const int c = i * 256 + lane * 4;
                float h0 = v[q][i].x * rn * ma[i].x + mb[i].x, h1 = v[q][i].y * rn * ma[i].y + mb[i].y;
                float h2 = v[q][i].z * rn * ma[i].z + mb[i].z, h3 = v[q][i].w * rn * ma[i].w + mb[i].w;
                if (which == 1) *(unsigned*)((unsigned char*)H + (size_t)r * DM + c) = pack4_fp8(h0 * F8_ASCALE, h1 * F8_ASCALE, h2 * F8_ASCALE, h3 * F8_ASCALE);
                else { uint2 w; w.x = pack2(h0, h1); w.y = pack2(h2, h3); *(uint2*)(H + (size_t)r * DM + c) = w; }
                if (ROUTE) {
#pragma unroll
                    for (int e = 0; e < 8; ++e) lg[e] += h0 * rw[ROUTE ? i : 0][0][e] + h1 * rw[ROUTE ? i : 0][1][e] + h2 * rw[ROUTE ? i : 0][2][e] + h3 * rw[ROUTE ? i : 0][3][e];
                }
            }
            if (ROUTE) {
#pragma unroll
                for (int e = 0; e < 8; ++e) lg[e] = wave_sum(lg[e]);
                if (lane == 0 && r < NLAT) {
                    int e0 = 0; float v0 = lg[0];
#pragma unroll
                    for (int e = 1; e < 8; ++e) if (lg[e] > v0) { v0 = lg[e]; e0 = e; }
                    int e1 = -1; float v1 = -3.0e38f;
#pragma unroll
                    for (int e = 0; e < 8; ++e) if (e != e0 && lg[e] > v1) { v1 = lg[e]; e1 = e; }
                    const float ex = __expf(v1 - v0), w0 = 1.0f / (1.0f + ex), w1 = ex / (1.0f + ex);
                    const unsigned li0 = __hip_atomic_fetch_add(lcnt + e0, 1u, __ATOMIC_RELAXED, __HIP_MEMORY_SCOPE_WORKGROUP), li1 = __hip_atomic_fetch_add(lcnt + 8 + e1, 1u, __ATOMIC_RELAXED, __HIP_MEMORY_SCOPE_WORKGROUP);
                    int4 rec; rec.x = e0 | (int)(li0 << 4); rec.y = e1 | (int)(li1 << 4); rec.z = __float_as_int(w0); rec.w = __float_as_int(w1);
                    *(int4*)(ws + OFF_ROUTE + (size_t)r * 16) = rec;
                }
            }
        }
    }
    if (ROUTE) {
        __syncthreads();
        if (TIDX < 16) { unsigned* cw = (unsigned*)ws; const int t = TIDX; cw[CW_BLK + bid * 16 + t] = atomicAdd(cw + CW_CNT + t, lcnt[t]); }
    }
}

namespace pg8 {
#define PG8_LAS __attribute__((address_space(3)))
typedef unsigned short bf16_t;
typedef short bf16x8 __attribute__((ext_vector_type(8)));
typedef float f32x4 __attribute__((ext_vector_type(4)));
typedef unsigned u32x4 __attribute__((ext_vector_type(4)));
constexpr int BM = 256, BK = 64, HALF = 128, HTB = HALF * BK * 2  , STAGE_BYTES = 8 * HTB, NXCD = 8, WGM = 8;

__host__ __device__ __forceinline__ int lds_byte(int r, int c) { const int st = (r >> 4) * 2 + (c >> 5), rr = r & 15, cc = c & 31, ob = rr * 64 + cc * 2; return st * 1024 + (ob ^ (((ob >> 9) & 1) << 5)); }
__host__ __device__ __forceinline__ void stage_rc(int b, int& R, int& C) { const int st = b / 1024, sb = b % 1024, swz = sb ^ (((sb >> 9) & 1) << 5); R = (st >> 1) * 16 + swz / 64; C = (st & 1) * 32 + (swz % 64) / 2; }
__host__ __device__ __forceinline__ int perm32(int rho) { const int n = rho >> 4, i = rho & 15; return 8 * (i >> 2) + 4 * n + (i & 3); }

struct Unit { int pm, pn; };
struct Gemm { const bf16_t* A; const bf16_t* Bt; int M, N, K; };

struct StaticOrder {
    int nM, nN, nwg, G, c;
    __host__ __device__ void init(int M, int N, int G_, int c_) { nM = M / BM; nN = N / BM; nwg = nM * nN; G = G_; c = c_; }
    __host__ __device__ bool next(int i, Unit& u) const {
        const long L = (long)i * G + c; if (L >= nwg) return false;
        int wgid = (int)L; { const int q = nwg / NXCD, r = nwg % NXCD, xcd = wgid % NXCD, off = wgid / NXCD; wgid = (xcd < r ? xcd * (q + 1) : r * (q + 1) + (xcd - r) * q) + off; }
        const int nig = WGM * nN, gid = wgid / nig, fm = gid * WGM, gsz = (nM - fm) < WGM ? (nM - fm) : WGM;
        u.pm = fm + ((wgid % nig) % gsz); u.pn = (wgid % nig) / gsz; return true;
    }
    __device__ __forceinline__ void a_ready(const Unit&) const {}
    __device__ __forceinline__ void done(const Unit&) const {}
};
__device__ __forceinline__ unsigned cvt_pk_bf16(float lo, float hi) { unsigned r; asm volatile("v_cvt_pk_bf16_f32 %0, %1, %2" : "=v"(r) : "v"(lo), "v"(hi)); return r; }
typedef float f32x2 __attribute__((ext_vector_type(2)));
typedef int i32x4_t __attribute__((ext_vector_type(4)));
typedef int i32x8_t __attribute__((ext_vector_type(8)));
__device__ __forceinline__ i32x8_t cat8(bf16x8 lo, bf16x8 hi) { const i32x4_t a = __builtin_bit_cast(i32x4_t, lo), b = __builtin_bit_cast(i32x4_t, hi); return __builtin_shufflevector(a, b, 0, 1, 2, 3, 4, 5, 6, 7); }
template <class Epi, class Sched, bool ALIGN_EPI = false, bool SP2 = false, bool F8 = false>
__device__ __forceinline__ void gemm_phase(PG8_LAS unsigned char* lds, const Gemm g, const Sched& S, const Epi& E) {
    int tid_ = threadIdx.x; asm volatile("" : "+v"(tid_));
    const int tid = tid_, wid = __builtin_amdgcn_readfirstlane(tid >> 6), lane = tid & 63, wr = wid >> 2, wc = wid & 3, fr = lane & 15, fq = lane >> 4;
    const int K = g.K, nt = K / BK;
    unsigned voffA[1], voffB[1];
    { int R, C; stage_rc(tid * 16, R, C); const int Rb = Epi::PERM ? ((R & ~31) + perm32(R & 31)) : R;
        voffA[0] = (unsigned)(R * K + C) * 2u; voffB[0] = (unsigned)(Rb * K + C) * 2u; }
    const size_t pstep = (size_t)64 * K * 2;
    const size_t kstep = (size_t)(BK * 2);
    const size_t hstep = (size_t)HALF * K * 2;
    const size_t tstep = 2 * hstep;
    const unsigned ldsw = (unsigned)wid * 1024u;
    const int aoff = lds_byte(wr * 64 + fr, fq * (F8 ? 16 : 8)), boff = lds_byte(wc * 32 + fr, fq * (F8 ? 16 : 8));
#define PG8_SA(b, h) (((b) * 2 + (h)) * HTB)
#define PG8_SB(b, h) ((4 + (b) * 2 + (h)) * HTB)
#define PG8_STAGE(bufoff, gbase, voff) do { _Pragma("unroll") for (int _i = 0; _i < 2; ++_i) { unsigned vo_ = (voff)[0]; asm volatile("" : "+v"(vo_));   \
        __builtin_amdgcn_global_load_lds((const unsigned*)((const char*)(gbase) + _i * pstep + vo_), (PG8_LAS unsigned*)(lds + (bufoff) + ldsw + _i * 8192), 16, 0, 0); } } while (0)
#define PG8_LDA(dst, b, h) do { _Pragma("unroll") for (int m = 0; m < 4; ++m) { \
        if constexpr (F8) dst##8[m] = cat8(*(const PG8_LAS bf16x8*)(lds + PG8_SA(b, h) + aoff + m * 2048), *(const PG8_LAS bf16x8*)(lds + PG8_SA(b, h) + aoff + m * 2048 + 16)); \
        else { _Pragma("unroll") for (int k = 0; k < 2; ++k) dst[m][k] = *(const PG8_LAS bf16x8*)(lds + PG8_SA(b, h) + aoff + m * 2048 + k * 1024); } } } while (0)
#define PG8_LDB(dst, b, h) do { _Pragma("unroll") for (int n = 0; n < 2; ++n) { \
        if constexpr (F8) dst##8[n] = cat8(*(const PG8_LAS bf16x8*)(lds + PG8_SB(b, h) + boff + n * 2048), *(const PG8_LAS bf16x8*)(lds + PG8_SB(b, h) + boff + n * 2048 + 16)); \
        else { _Pragma("unroll") for (int k = 0; k < 2; ++k) dst[n][k] = *(const PG8_LAS bf16x8*)(lds + PG8_SB(b, h) + boff + n * 2048 + k * 1024); } } } while (0)
#define PG8_MMA(ai, bj, At, Bt) do { __builtin_amdgcn_s_setprio(1); _Pragma("unroll") for (int m = 0; m < 4; ++m) _Pragma("unroll") for (int n = 0; n < 2; ++n) { \
        if constexpr (F8) acc[ai][bj][m][n] = __builtin_amdgcn_mfma_scale_f32_16x16x128_f8f6f4(Bt##8[n], At##8[m], acc[ai][bj][m][n], 0, 0, 0, F8_SCALES, 1, F8_SCALES); \
        else { _Pragma("unroll") for (int k = 0; k < 2; ++k) acc[ai][bj][m][n] = __builtin_amdgcn_mfma_f32_16x16x32_bf16(Bt[n][k], At[m][k], acc[ai][bj][m][n], 0, 0, 0); } } \
        __builtin_amdgcn_s_setprio(0); } while (0)
#define PG8_WAIT_V(n) asm volatile("s_waitcnt vmcnt(" #n ")" ::: "memory")
#define PG8_WAIT_L(n) asm volatile("s_waitcnt lgkmcnt(" #n ")" ::: "memory")
#define PG8_BAR __builtin_amdgcn_s_barrier()
#define PG8_SCHED __builtin_amdgcn_sched_barrier(0)
    Unit cur, nxt; int ui = 0;
    if (!S.next(0, cur)) return;
    f32x4 acc[2][2][4][2];
#pragma unroll
    for (int a = 0; a < 2; ++a)
#pragma unroll
        for (int b = 0; b < 2; ++b)
#pragma unroll
            for (int m = 0; m < 4; ++m)
#pragma unroll
                for (int n = 0; n < 2; ++n) acc[a][b][m][n] = (f32x4){0.f, 0.f, 0.f, 0.f};
    bf16x8 At[4][2], B0[2][2], B1[2][2]; i32x8_t At8[4], B08[2], B18[2];
    const char* cA = (const char*)g.A + (size_t)cur.pm * tstep; const char* cB = (const char*)g.Bt + (size_t)cur.pn * tstep;
    S.a_ready(cur);
    if constexpr (SP2) {
        PG8_STAGE(PG8_SB(0, 0), cB, voffB); PG8_STAGE(PG8_SB(0, 1), cB + hstep, voffB); PG8_STAGE(PG8_SA(0, 0), cA, voffA); PG8_STAGE(PG8_SA(0, 1), cA + hstep, voffA);
        if (wr == 1) PG8_BAR;
        PG8_WAIT_V(2); PG8_BAR;
        PG8_STAGE(PG8_SB(1, 0), cB + kstep, voffB); PG8_STAGE(PG8_SA(1, 0), cA + kstep, voffA); PG8_STAGE(PG8_SB(1, 1), cB + hstep + kstep, voffB);
        PG8_WAIT_V(6); PG8_BAR;
    } else {
        PG8_STAGE(PG8_SB(0, 0), cB, voffB); PG8_STAGE(PG8_SA(0, 0), cA, voffA); PG8_STAGE(PG8_SB(0, 1), cB + hstep, voffB); PG8_STAGE(PG8_SA(0, 1), cA + hstep, voffA);
        if (wr == 1) PG8_BAR;
        PG8_WAIT_V(4); PG8_BAR;
        PG8_STAGE(PG8_SB(1, 0), cB + kstep, voffB); PG8_STAGE(PG8_SA(1, 0), cA + kstep, voffA); PG8_STAGE(PG8_SB(1, 1), cB + hstep + kstep, voffB);
        PG8_WAIT_V(6); PG8_BAR;
    }
    for (;;) {
        const bool has_next = S.next(ui + 1, nxt);
        const char* nA = has_next ? (const char*)g.A + (size_t)nxt.pm * tstep : cA; const char* nB = has_next ? (const char*)g.Bt + (size_t)nxt.pn * tstep : cB;
#pragma unroll 1
        for (int t = 0; t < nt; t += 2) {
            const bool last = (t == nt - 2);
            const char* a1 = cA + (size_t)(t + 1) * kstep;
            const char* a2 = last ? nA : cA + (size_t)(t + 2) * kstep; const char* b2 = last ? nB : cB + (size_t)(t + 2) * kstep;
            const char* a3 = a2 + kstep; const char* b3 = b2 + kstep;
            if (last && has_next) S.a_ready(nxt);
            if constexpr (SP2) {
            PG8_LDB(B0, 0, 0); PG8_LDB(B1, 0, 1); PG8_SCHED; PG8_LDA(At, 0, 0); PG8_STAGE(PG8_SA(1, 1), a1 + hstep, voffA);
            PG8_WAIT_V(8); PG8_WAIT_L(0); PG8_BAR; PG8_MMA(0, 0, At, B0); PG8_MMA(0, 1, At, B1); PG8_BAR; PG8_SCHED;
            PG8_LDA(At, 0, 1); PG8_STAGE(PG8_SB(0, 0), b2, voffB); PG8_STAGE(PG8_SB(0, 1), b2 + hstep, voffB); PG8_STAGE(PG8_SA(0, 0), a2, voffA);
            PG8_WAIT_V(8); PG8_WAIT_L(0); PG8_BAR; PG8_MMA(1, 0, At, B0); PG8_MMA(1, 1, At, B1); PG8_BAR; PG8_SCHED;
            PG8_LDB(B0, 1, 0); PG8_LDB(B1, 1, 1); PG8_SCHED; PG8_LDA(At, 1, 0); PG8_STAGE(PG8_SA(0, 1), a2 + hstep, voffA);
            PG8_WAIT_V(8); PG8_WAIT_L(0); PG8_BAR; PG8_MMA(0, 0, At, B0); PG8_MMA(0, 1, At, B1); PG8_BAR; PG8_SCHED;
            PG8_LDA(At, 1, 1); PG8_STAGE(PG8_SB(1, 0), b3, voffB); PG8_STAGE(PG8_SB(1, 1), b3 + hstep, voffB); PG8_STAGE(PG8_SA(1, 0), a3, voffA);
            PG8_WAIT_V(8); PG8_WAIT_L(0); PG8_BAR; PG8_MMA(1, 0, At, B0); PG8_MMA(1, 1, At, B1); PG8_BAR; PG8_SCHED;
            } else {
            PG8_LDB(B0, 0, 0); PG8_SCHED; PG8_LDA(At, 0, 0); PG8_STAGE(PG8_SA(1, 1), a1 + hstep, voffA);
            PG8_WAIT_L(8); PG8_BAR; PG8_WAIT_L(0); PG8_MMA(0, 0, At, B0); PG8_BAR; PG8_SCHED;
            PG8_LDB(B1, 0, 1); PG8_STAGE(PG8_SB(0, 0), b2, voffB);
            PG8_BAR; PG8_WAIT_L(0); PG8_MMA(0, 1, At, B1); PG8_BAR;
            PG8_LDA(At, 0, 1); PG8_STAGE(PG8_SA(0, 0), a2, voffA);
            PG8_BAR; PG8_WAIT_L(0); PG8_MMA(1, 0, At, B0); PG8_BAR; PG8_SCHED;
            PG8_STAGE(PG8_SB(0, 1), b2 + hstep, voffB);
            PG8_WAIT_V(6); PG8_BAR; PG8_MMA(1, 1, At, B1); PG8_BAR;
            PG8_LDB(B0, 1, 0); PG8_SCHED; PG8_LDA(At, 1, 0); PG8_STAGE(PG8_SA(0, 1), a2 + hstep, voffA);
            PG8_WAIT_L(8); PG8_BAR; PG8_WAIT_L(0); PG8_MMA(0, 0, At, B0); PG8_BAR; PG8_SCHED;
            PG8_LDB(B1, 1, 1); PG8_STAGE(PG8_SB(1, 0), b3, voffB);
            PG8_BAR; PG8_WAIT_L(0); PG8_MMA(0, 1, At, B1); PG8_BAR;
            PG8_LDA(At, 1, 1); PG8_STAGE(PG8_SA(1, 0), a3, voffA);
            PG8_BAR; PG8_WAIT_L(0); PG8_MMA(1, 0, At, B0); PG8_BAR; PG8_SCHED;
            PG8_STAGE(PG8_SB(1, 1), b3 + hstep, voffB);
            PG8_WAIT_V(6); PG8_BAR; PG8_MMA(1, 1, At, B1); PG8_BAR;
            }
        }
        if constexpr (ALIGN_EPI) { if (wr == 0) PG8_BAR; }
        if constexpr (!Epi::AFTER_DRAIN) { E(acc, cur, wr, wc, fr, fq); S.done(cur); }
        if (!has_next) break;
#pragma unroll
        for (int a = 0; a < 2; ++a)
#pragma unroll
            for (int b = 0; b < 2; ++b)
#pragma unroll
                for (int m = 0; m < 4; ++m)
#pragma unroll
                    for (int n = 0; n < 2; ++n) acc[a][b][m][n] = (f32x4){0.f, 0.f, 0.f, 0.f};
        cur = nxt; cA = nA; cB = nB; ++ui;
        if constexpr (ALIGN_EPI) { if (wr == 1) PG8_BAR; }
    }
    PG8_WAIT_V(0);
    if constexpr (!ALIGN_EPI) { if (wr == 0) PG8_BAR; }
    PG8_BAR;
    if constexpr (Epi::AFTER_DRAIN) { E.fused(acc, cur, wr, wc, fr, fq, lds, wid, lane); S.done(cur); }
#undef PG8_SA
#undef PG8_SB
#undef PG8_STAGE
#undef PG8_LDA
#undef PG8_LDB
#undef PG8_MMA
#undef PG8_WAIT_V
#undef PG8_WAIT_L
#undef PG8_BAR
#undef PG8_SCHED
}
}

constexpr int RT_K = 0, RT_V = 32768, RT_ST = 65536;
template <bool KV> __device__ __forceinline__ void ret_stage(const bf16_t* P, int rb, int hp, LAS char* sm, int tid, int wid, int lane) {
    const int vrow = 16 * (wid & 3) + (lane >> 2), vc = (wid >> 2) * 32 + (lane & 3) * 8;
    u32x4 kk[4], vv[4];
#pragma unroll
    for (int i = 0; i < 4; ++i) { const int hh = i >> 1, tt = i & 1, h = 2 * hp + hh, r0 = rb + tt * 64;
        vv[i] = *(const u32x4*)(P + (size_t)(r0 + vrow) * DIN + C_RV + h * 64 + vc);
        kk[i] = KV ? *(const u32x4*)(P + (size_t)(r0 + vrow) * DIN + C_RK + h * 64 + vc) : *(const u32x4*)(P + (size_t)(r0 + lane) * DIN + C_RK + h * 64 + wid * 8); }
#pragma unroll
    for (int i = 0; i < 4; ++i) { *(LAS u32x4*)(sm + RT_K + i * 8192 + tid * 16) = kk[i]; *(LAS u32x4*)(sm + RT_V + i * 8192 + tid * 16) = vv[i]; }
}
constexpr int CW_QUE = 6016;
constexpr int QUE_LDS_WORD = 33792 + 4 + 64;
struct UnitQ { unsigned* ctr; int pend; };
__device__ __forceinline__ void q_prefetch(UnitQ& q) { if (TIDX == 0) q.pend = (int)atomicAdd(q.ctr, 1u); }
__device__ __forceinline__ int q_take(UnitQ& q, float* lds) {
    LAS int* slot = (LAS int*)lds + QUE_LDS_WORD;
    __syncthreads();
    if (TIDX == 0) *slot = q.pend;
    __syncthreads();
    return __builtin_amdgcn_readfirstlane(*slot);
}
__device__ __forceinline__ float ret_lg(const Params& p, int l, int dir, int h) { return -softplusf_(-p.ret_logit[(l * 2 + dir) * 4 + h]); }
__device__ __forceinline__ void ph_ret_summ(const Params& p, int l, int bid, int nb, float* lds) {
    char* ws = p.ws; const int tid = TIDX, lane = tid & 63, r32 = lane & 31, hi = lane >> 5, wid = __builtin_amdgcn_readfirstlane(tid >> 6);
    const bf16_t* P = (const bf16_t*)(ws + OFF_P); float* RET = (float*)(ws + OFF_RET);
    LAS char* sm = (LAS char*)lds;
    UnitQ uq{(unsigned*)ws + CW_QUE + l * 16 + 2, 0}; q_prefetch(uq);
    for (int u = q_take(uq, lds); u < 2 * NCI * 2; u = q_take(uq, lds)) {
        q_prefetch(uq);
        const int hp = u & 1, ci = (u >> 1) % NCI, b = (u >> 1) / NCI, rb = row_base(b, ci);
        __syncthreads();
        ret_stage<true>(P, rb, hp, sm, tid, wid, lane);
        __syncthreads();
        const int hh = wid >> 2, dh = (wid >> 1) & 1, eh = wid & 1, h = 2 * hp + hh;
        const float lg2f = ret_lg(p, l, 0, h) * 1.4426950408889634f, lg2b = ret_lg(p, l, 1, h) * 1.4426950408889634f;
        const int voff = ((lane >> 4) & 1) * 32 + (lane & 3) * 8 + (4 * hi + ((lane & 15) >> 2)) * 64;
        const LAS char* Kb = sm + RT_K + hh * 16384 + dh * 4096 + voff; const LAS char* Vb = sm + RT_V + hh * 16384 + eh * 4096 + voff;
        f32x16 a0, a1;
#pragma unroll
        for (int r = 0; r < 16; ++r) { a0[r] = 0.f; a1[r] = 0.f; }
#pragma unroll
        for (int k8 = 0; k8 < 8; ++k8) { const int tt = k8 >> 2, sl = k8 & 3;
            const s16x4 klo = vtr(Kb + tt * 8192 + sl * 1024), khi = vtr(Kb + tt * 8192 + sl * 1024 + 512), vlo = vtr(Vb + tt * 8192 + sl * 1024), vhi = vtr(Vb + tt * 8192 + sl * 1024 + 512);
            const int mb = tt * 64 + sl * 16 + 4 * hi; float kf_[8], kb_[8];
#pragma unroll
            for (int j = 0; j < 8; ++j) { const int m = mb + (j < 4 ? j : j + 4); const float kv = bfs(j < 4 ? klo[j] : khi[j - 4]);
                kf_[j] = kv * __builtin_amdgcn_exp2f(lg2f * (float)(127 - m)); kb_[j] = kv * __builtin_amdgcn_exp2f(lg2b * (float)m); }
            const u32x4 af = {cvtpk_s(kf_[0], kf_[1]), cvtpk_s(kf_[2], kf_[3]), cvtpk_s(kf_[4], kf_[5]), cvtpk_s(kf_[6], kf_[7])};
            const u32x4 ab = {cvtpk_s(kb_[0], kb_[1]), cvtpk_s(kb_[2], kb_[3]), cvtpk_s(kb_[4], kb_[5]), cvtpk_s(kb_[6], kb_[7])};
            const bf16x8 vfr = {vlo[0], vlo[1], vlo[2], vlo[3], vhi[0], vhi[1], vhi[2], vhi[3]};
            a0 = __builtin_amdgcn_mfma_f32_32x32x16_bf16(__builtin_bit_cast(bf16x8, af), vfr, a0, 0, 0, 0);
            a1 = __builtin_amdgcn_mfma_f32_32x32x16_bf16(__builtin_bit_cast(bf16x8, ab), vfr, a1, 0, 0, 0); }
        float* of = RET + ((((size_t)0 * 2 + b) * NCI + ci) * 4 + h) * 4096 + eh * 32 + r32;
        float* ob = RET + ((((size_t)1 * 2 + b) * NCI + ci) * 4 + h) * 4096 + eh * 32 + r32;
#pragma unroll
        for (int r = 0; r < 16; ++r) { const int d = dh * 32 + crow(r, hi); of[d * 64] = a0[r]; ob[d * 64] = a1[r]; }
    }
}

constexpr int LR_UB = 0, LR_A = 18432, LR_B = 51200, LR_H = 83968, LR_SEG = 116736, LR_CW = 120832;
template <int MODE>
__device__ __forceinline__ void ph_lru_chunk(const Params& p, int l, int bid, int nb, float* lds, int ci_lo) {
    char* ws = p.ws; const int tid = TIDX, lane = tid & 63, r32 = lane & 31, hi = lane >> 5, wid = __builtin_amdgcn_readfirstlane(tid >> 6);
    const bf16_t* P = (const bf16_t*)(ws + OFF_P);
    float* LA = (float*)(ws + OFF_LRU); float* LB = LA + 2 * 2 * NCI * 256; float* LC = LB + 2 * 2 * NCI * 256;
    bf16_t* O = (bf16_t*)(ws + OFF_ACT);
    LAS char* sm = (LAS char*)lds;
    const int hb = bid & 3, tt = wid >> 1, jt = wid & 1, jcol = jt * 32 + r32, ch = hb * 64 + jcol;
    bf16x8 wfr[2][2][4]; float bia[2][2], spl[2];
#pragma unroll
    for (int dir = 0; dir < 2; ++dir) {
#pragma unroll
        for (int gt = 0; gt < 2; ++gt) { const float* W = (gt == 0 ? p.lru_wa : p.lru_wx) + (((size_t)(l * 2 + dir) * 4 + hb) * 64) * 64 + jcol;
#pragma unroll
            for (int ks = 0; ks < 4; ++ks) { const float* wp = W + (16 * ks + 8 * hi) * 64;
                const u32x4 w4 = {cvtpk_s(wp[0], wp[64]), cvtpk_s(wp[128], wp[192]), cvtpk_s(wp[256], wp[320]), cvtpk_s(wp[384], wp[448])};
                wfr[dir][gt][ks] = __builtin_bit_cast(bf16x8, w4); }
            bia[dir][gt] = (gt == 0 ? p.lru_ba : p.lru_bx)[(l * 2 + dir) * 256 + ch]; }
        spl[dir] = -8.0f * softplusf_(-p.lru_lam[(l * 2 + dir) * 256 + ch]); }
    const int nci = NCI - ci_lo, npair = 2 * nci;
    LAS float* cwl = (LAS float*)(sm + LR_CW);
    __syncthreads();
    if (tid < 320) cwl[tid] = tid < 256 ? p.conv_w[(l * 4 + (tid >> 6)) * 256 + hb * 64 + (tid & 63)] : p.conv_b[l * 256 + hb * 64 + (tid - 256)];
    UnitQ uq{(unsigned*)ws + CW_QUE + l * 16 + (MODE == 3 ? 4 : 8) + hb, 0}; q_prefetch(uq);
    for (int pi = q_take(uq, lds); pi < npair; pi = q_take(uq, lds)) {
        q_prefetch(uq);
        const int ci = ci_lo + pi % nci, b = pi / nci, rb = row_base(b, ci);
        const int seg_lo = ci < 2 ? NLAT + b * NCTX : b * NSEQ, seg_hi = ci < 2 ? seg_lo + NCTX : seg_lo + NSEQ;
        __syncthreads();
#pragma unroll
        for (int it = 0; it < 2; ++it) { const int item = it * 512 + tid, t = item >> 3, c8 = (item & 7) * 8, c0 = hb * 64 + c8;
            float acc[8];
            { const f32x4 b0 = *(const LAS f32x4*)(cwl + 256 + c8), b1 = *(const LAS f32x4*)(cwl + 256 + c8 + 4);
              acc[0] = b0[0]; acc[1] = b0[1]; acc[2] = b0[2]; acc[3] = b0[3]; acc[4] = b1[0]; acc[5] = b1[1]; acc[6] = b1[2]; acc[7] = b1[3]; }
#pragma unroll
            for (int k = 0; k < 4; ++k) { const int rr = rb + t - 1 + k;
                if (rr >= seg_lo && rr < seg_hi) { const bf16x8 xv = *(const bf16x8*)(P + (size_t)rr * DIN + C_LX + c0);
                    const f32x4 w0 = *(const LAS f32x4*)(cwl + k * 64 + c8), w1 = *(const LAS f32x4*)(cwl + k * 64 + c8 + 4);
                    acc[0] += w0[0] * bfs(xv[0]); acc[1] += w0[1] * bfs(xv[1]); acc[2] += w0[2] * bfs(xv[2]); acc[3] += w0[3] * bfs(xv[3]);
                    acc[4] += w1[0] * bfs(xv[4]); acc[5] += w1[1] * bfs(xv[5]); acc[6] += w1[2] * bfs(xv[6]); acc[7] += w1[3] * bfs(xv[7]); } }
            const u32x4 w = {cvtpk_s(acc[0], acc[1]), cvtpk_s(acc[2], acc[3]), cvtpk_s(acc[4], acc[5]), cvtpk_s(acc[6], acc[7])};
            *(LAS u32x4*)(sm + LR_UB + t * 144 + c8 * 2) = w; }
        __syncthreads();
        bf16x8 ua[4];
#pragma unroll
        for (int ks = 0; ks < 4; ++ks) ua[ks] = *(const LAS bf16x8*)(sm + LR_UB + (tt * 32 + r32) * 144 + (16 * ks + 8 * hi) * 2);
#pragma unroll
        for (int dir = 0; dir < 2; ++dir) {
            f32x16 ga, gx;
#pragma unroll
            for (int r = 0; r < 16; ++r) { ga[r] = bia[dir][0]; gx[r] = bia[dir][1]; }
#pragma unroll
            for (int ks = 0; ks < 4; ++ks) { ga = __builtin_amdgcn_mfma_f32_32x32x16_bf16(ua[ks], wfr[dir][0][ks], ga, 0, 0, 0); gx = __builtin_amdgcn_mfma_f32_32x32x16_bf16(ua[ks], wfr[dir][1][ks], gx, 0, 0, 0); }
#pragma unroll
            for (int r = 0; r < 16; ++r) { const int t = tt * 32 + crow(r, hi);
                const float rg = __builtin_amdgcn_rcpf(1.0f + __expf(-ga[r])), ig = __builtin_amdgcn_rcpf(1.0f + __expf(-gx[r]));
                const float a = __expf(spl[dir] * rg);
                const float uu = __uint_as_float(((unsigned)*(const LAS unsigned short*)(sm + LR_UB + t * 144 + jcol * 2)) << 16);
                *(LAS float*)(sm + LR_A + (t * 64 + jcol) * 4) = a;
                *(LAS float*)(sm + LR_B + (t * 64 + jcol) * 4) = sqrtf(fmaxf(1.0f - a * a, 0.f)) * (ig * uu); }
            __syncthreads();
            {
                const size_t cidx = (((size_t)dir * 2 + b) * NCI + ci) * 256 + hb * 64 + lane;
                float cin = MODE == 3 ? LC[cidx] : 0.f;
                LAS float* as_ = (LAS float*)(sm + LR_A) + lane; LAS float* bs_ = (LAS float*)(sm + LR_B) + lane; LAS float* hs = (LAS float*)(sm + LR_H) + lane;
                LAS float* sg = (LAS float*)(sm + LR_SEG) + lane;
                {   float h = 0.f, c = 1.f;
#pragma unroll 1
                    for (int k0 = 0; k0 < 16; k0 += 8) { float cl[8], hl[8];
#pragma unroll
                        for (int k = 0; k < 8; ++k) { const int s = wid * 16 + k0 + k, t = dir == 0 ? s : 127 - s; cl[k] = as_[t * 64]; hl[k] = bs_[t * 64]; }
#pragma unroll
                        for (int k = 0; k < 8; ++k) { const int s = wid * 16 + k0 + k, t = dir == 0 ? s : 127 - s; h = cl[k] * h + hl[k]; c *= cl[k]; as_[t * 64] = c; bs_[t * 64] = h; } }
                    sg[wid * 64] = c; sg[(8 + wid) * 64] = h; }
                __syncthreads();
                float pa = 1.f;
                for (int v = 0; v < wid; ++v) { const float sa = sg[v * 64]; cin = sa * cin + sg[(8 + v) * 64]; pa *= sa; }
                if (MODE == 1) { if (wid == 7) { const float c7 = sg[7 * 64], h7 = sg[15 * 64]; LA[cidx] = pa * c7; LB[cidx] = c7 * cin + h7; } }
                else {
#pragma unroll 1
                    for (int k0 = 0; k0 < 16; k0 += 8) {
#pragma unroll
                        for (int k = 0; k < 8; ++k) { const int s = wid * 16 + k0 + k, t = dir == 0 ? s : 127 - s; const float val = bs_[t * 64] + as_[t * 64] * cin;
                            if (dir == 0) hs[t * 64] = val; else hs[t * 64] += val; } }
                }
            }
            __syncthreads();
        }
        if (MODE == 3) {
            bf16x8 yv2[2];
#pragma unroll
            for (int it = 0; it < 2; ++it) { const int item = it * 512 + tid, t = item >> 3, c8 = (item & 7) * 8, c0 = hb * 64 + c8; yv2[it] = *(const bf16x8*)(P + (size_t)(rb + t) * DIN + C_LY + c0); }
#pragma unroll
            for (int it = 0; it < 2; ++it) { const int item = it * 512 + tid, t = item >> 3, c8 = (item & 7) * 8, c0 = hb * 64 + c8;
                const f32x4 h0 = *(const LAS f32x4*)(sm + LR_H + (t * 64 + c8) * 4), h1 = *(const LAS f32x4*)(sm + LR_H + (t * 64 + c8 + 4) * 4);
                const bf16x8 yv = yv2[it];
                const u32x4 w = {cvtpk_s(h0[0] * gelu_tanh(bfs(yv[0])), h0[1] * gelu_tanh(bfs(yv[1]))), cvtpk_s(h0[2] * gelu_tanh(bfs(yv[2])), h0[3] * gelu_tanh(bfs(yv[3]))),
                                 cvtpk_s(h1[0] * gelu_tanh(bfs(yv[4])), h1[1] * gelu_tanh(bfs(yv[5]))), cvtpk_s(h1[2] * gelu_tanh(bfs(yv[6])), h1[3] * gelu_tanh(bfs(yv[7])))};
                *(u32x4*)(O + (size_t)(rb + t) * DM + 768 + c0) = w; }
        }
    }
}

__device__ __forceinline__ int scan_ci(int dir, int s) { return dir == 0 ? s : (s == 0 ? 1 : (s == 1 ? 0 : NCI + 1 - s)); }
__device__ __forceinline__ void ph_scan2(const Params& p, int l, int bid, int nb) {
    char* ws = p.ws; const int gt = bid * 512 + TIDX, gs = nb * 512;
    float* RET = (float*)(ws + OFF_RET);
    for (int i = gt; i < 2 * 2 * 4 * 4096; i += gs) {
        const int de = i & 4095, h = (i >> 12) & 3, b = (i >> 14) & 1, dir = i >> 15;
        const float decay = expf(ret_lg(p, l, dir, h) * 128.0f); float S = 0.f;
        float* base = RET + (((size_t)dir * 2 + b) * NCI * 4 + h) * 4096 + de;
        float ua[13], ub[13];
#pragma unroll
        for (int j = 0; j < 13; ++j) ua[j] = base[(size_t)scan_ci(dir, j) * 4 * 4096];
#pragma unroll 1
        for (int s0 = 0; s0 < NCI; s0 += 26) {
#pragma unroll
            for (int j = 0; j < 13; ++j) ub[j] = base[(size_t)scan_ci(dir, s0 + 13 + j) * 4 * 4096];
#pragma unroll
            for (int j = 0; j < 13; ++j) { base[(size_t)scan_ci(dir, s0 + j) * 4 * 4096] = S; S = decay * S + ua[j]; }
            const int s1 = s0 + 26 < NCI ? s0 + 26 : s0;
#pragma unroll
            for (int j = 0; j < 13; ++j) ua[j] = base[(size_t)scan_ci(dir, s1 + j) * 4 * 4096];
#pragma unroll
            for (int j = 0; j < 13; ++j) { base[(size_t)scan_ci(dir, s0 + 13 + j) * 4 * 4096] = S; S = decay * S + ub[j]; }
        }
    }
    float* LA = (float*)(ws + OFF_LRU); float* LB = LA + 2 * 2 * NCI * 256; float* LC = LB + 2 * 2 * NCI * 256;
    const int lo = nb >= 192 ? 128 * 512 : 0;
    for (int i = gt - lo; i < 2 * 2 * 256; i += gs) {
        if (i < 0) continue;
        const int ch = i & 255, b = (i >> 8) & 1, dir = i >> 9; float h = 0.f;
        const size_t base = ((size_t)dir * 2 + b) * NCI * 256 + ch;
        float aa[13], bb[13], ac[13], bc[13];
#pragma unroll
        for (int j = 0; j < 13; ++j) { const size_t idx = base + (size_t)scan_ci(dir, j) * 256; aa[j] = LA[idx]; bb[j] = LB[idx]; }
#pragma unroll 1
        for (int s0 = 0; s0 < NCI; s0 += 26) {
#pragma unroll
            for (int j = 0; j < 13; ++j) { const size_t idx = base + (size_t)scan_ci(dir, s0 + 13 + j) * 256; ac[j] = LA[idx]; bc[j] = LB[idx]; }
#pragma unroll
            for (int j = 0; j < 13; ++j) { LC[base + (size_t)scan_ci(dir, s0 + j) * 256] = h; h = aa[j] * h + bb[j]; }
            const int s1 = s0 + 26 < NCI ? s0 + 26 : s0;
#pragma unroll
            for (int j = 0; j < 13; ++j) { const size_t idx = base + (size_t)scan_ci(dir, s1 + j) * 256; aa[j] = LA[idx]; bb[j] = LB[idx]; }
#pragma unroll
            for (int j = 0; j < 13; ++j) { LC[base + (size_t)scan_ci(dir, s0 + 13 + j) * 256] = h; h = ac[j] * h + bc[j]; }
        }
    }
}

__device__ __forceinline__ bf16x8 scale_frag(bf16x8 q, float s) {
    u32x4 w;
#pragma unroll
    for (int i = 0; i < 4; ++i) w[i] = cvtpk_s(bfs(q[2 * i]) * s, bfs(q[2 * i + 1]) * s);
    return __builtin_bit_cast(bf16x8, w);
}
__device__ __forceinline__ void ph_ret_out(const Params& p, int l, int bid, int nb, float* lds, int ci_lo) {
    char* ws = p.ws; const int tid = TIDX, lane = tid & 63, r32 = lane & 31, hi = lane >> 5, wid = __builtin_amdgcn_readfirstlane(tid >> 6);
    const bf16_t* P = (const bf16_t*)(ws + OFF_P); const float* RET = (const float*)(ws + OFF_RET); bf16_t* O = (bf16_t*)(ws + OFF_ACT);
    LAS char* sm = (LAS char*)lds;
    const int nci = NCI - ci_lo;
    UnitQ uq{(unsigned*)ws + CW_QUE + l * 16 + 1, 0}; q_prefetch(uq);
    for (int u = q_take(uq, lds); u < 2 * nci * 2; u = q_take(uq, lds)) {
        q_prefetch(uq);
        const int hp = u & 1, ci = ci_lo + (u >> 1) % nci, b = (u >> 1) / nci, rb = row_base(b, ci);
        __syncthreads();
        ret_stage<false>(P, rb, hp, sm, tid, wid, lane);
        __syncthreads();
        const int hh = wid >> 2, qt = wid & 3, h = 2 * hp + hh; int n = qt * 32 + r32;
        asm volatile("" : "+v"(n));
        const float lg2f = ret_lg(p, l, 0, h) * 1.4426950408889634f, lg2b = ret_lg(p, l, 1, h) * 1.4426950408889634f;
        bf16x8 qr[4];
        { const bf16_t* qp = P + (size_t)(rb + n) * DIN + C_RQ + h * 64 + hi * 8;
#pragma unroll
          for (int ks = 0; ks < 4; ++ks) qr[ks] = *(const bf16x8*)(qp + ks * 16); }
        f32x16 o[2];
#pragma unroll
        for (int r = 0; r < 16; ++r) { o[0][r] = 0.f; o[1][r] = 0.f; }
#pragma unroll
        for (int dir = 0; dir < 2; ++dir) {
            const float xi = dir == 0 ? __builtin_amdgcn_exp2f(lg2f * (float)(n + 1)) : __builtin_amdgcn_exp2f(lg2b * (float)(128 - n));
            const float* Sb = RET + ((((size_t)dir * 2 + b) * NCI + ci) * 4 + h) * 4096 + hi * 8 * 64 + r32;
#pragma unroll
            for (int ks = 0; ks < 4; ++ks) { const bf16x8 qx = scale_frag(qr[ks], xi);
#pragma unroll
                for (int eh = 0; eh < 2; ++eh) { const float* sp = Sb + ks * 16 * 64 + eh * 32;
                    const u32x4 sw = {cvtpk_s(sp[0], sp[64]), cvtpk_s(sp[128], sp[192]), cvtpk_s(sp[256], sp[320]), cvtpk_s(sp[384], sp[448])};
                    o[eh] = __builtin_amdgcn_mfma_f32_32x32x16_bf16(qx, __builtin_bit_cast(bf16x8, sw), o[eh], 0, 0, 0); } }
        }
        const LAS char* Kb = sm + RT_K + hh * 16384 + hi * 1024 + r32 * 16;
        const LAS char* Vb = sm + RT_V + hh * 16384 + ((lane >> 4) & 1) * 32 + (lane & 3) * 8 + (4 * hi + ((lane & 15) >> 2)) * 64;
        u32x4 pw[8];
#pragma unroll
        for (int kb = 0; kb < 4; ++kb) { const int tt = kb >> 1, kbl = kb & 1;
            f32x16 c;
#pragma unroll
            for (int r = 0; r < 16; ++r) c[r] = 0.f;
#pragma unroll
            for (int ks = 0; ks < 4; ++ks) c = __builtin_amdgcn_mfma_f32_32x32x16_bf16(*(const LAS bf16x8*)(Kb + tt * 8192 + ks * 2048 + kbl * 512), qr[ks], c, 0, 0, 0);
#pragma unroll
            for (int r = 0; r < 16; ++r) { const int dlt = n - (kb * 32 + crow(r, hi)); const float fd = (float)dlt;
                const float w = __builtin_amdgcn_exp2f(fd * (dlt > 0 ? lg2f : -lg2b));
                c[r] *= dlt == 0 ? 2.0f : w; }
            pw[2 * kb] = (u32x4){cvtpk_s(c[0], c[1]), cvtpk_s(c[2], c[3]), cvtpk_s(c[4], c[5]), cvtpk_s(c[6], c[7])};
            pw[2 * kb + 1] = (u32x4){cvtpk_s(c[8], c[9]), cvtpk_s(c[10], c[11]), cvtpk_s(c[12], c[13]), cvtpk_s(c[14], c[15])}; }
#pragma unroll
        for (int k8 = 0; k8 < 8; ++k8) { const int tt = k8 >> 2, sl = k8 & 3;
#pragma unroll
            for (int eh = 0; eh < 2; ++eh) { const s16x4 vlo = vtr(Vb + tt * 8192 + eh * 4096 + sl * 1024), vhi = vtr(Vb + tt * 8192 + eh * 4096 + sl * 1024 + 512);
                o[eh] = __builtin_amdgcn_mfma_f32_32x32x16_bf16(__builtin_bit_cast(bf16x8, pw[k8]), (bf16x8){vlo[0], vlo[1], vlo[2], vlo[3], vhi[0], vhi[1], vhi[2], vhi[3]}, o[eh], 0, 0, 0); } }
        LAS float* stg = (LAS float*)(sm + RT_ST) + wid * 2048;
#pragma unroll
        for (int r = 0; r < 16; ++r) { const int q = crow(r, hi); stg[q * 64 + r32] = o[0][r]; stg[q * 64 + 32 + r32] = o[1][r]; }
        const float* gn = p.ret_gn + l * 256 + h * 64 + (lane & 7) * 8;
        const f32x4 g0 = *(const f32x4*)gn, g1 = *(const f32x4*)(gn + 4);
        bf16x8 ggv[4];
#pragma unroll
        for (int i = 0; i < 4; ++i) ggv[i] = *(const bf16x8*)(P + (size_t)(rb + qt * 32 + i * 8 + (lane >> 3)) * DIN + C_RG + h * 64 + (lane & 7) * 8);
#pragma unroll
        for (int i = 0; i < 4; ++i) { const int row = i * 8 + (lane >> 3), ch = lane & 7;
            const f32x4 v0 = *(const LAS f32x4*)(stg + row * 64 + ch * 8), v1 = *(const LAS f32x4*)(stg + row * 64 + ch * 8 + 4);
            float ss = v0[0] * v0[0] + v0[1] * v0[1] + v0[2] * v0[2] + v0[3] * v0[3] + v1[0] * v1[0] + v1[1] * v1[1] + v1[2] * v1[2] + v1[3] * v1[3];
            ss += __shfl_xor(ss, 1); ss += __shfl_xor(ss, 2); ss += __shfl_xor(ss, 4);
            const float rn = rsqrtf(ss * (1.0f / 64.0f) + 1e-6f);
            const size_t grow = (size_t)(rb + qt * 32 + row);
            const bf16x8 gg = ggv[i];
            u32x4 w; w.x = cvtpk_s(v0[0] * rn * g0[0] * fast_silu(bfs(gg[0])), v0[1] * rn * g0[1] * fast_silu(bfs(gg[1]))); w.y = cvtpk_s(v0[2] * rn * g0[2] * fast_silu(bfs(gg[2])), v0[3] * rn * g0[3] * fast_silu(bfs(gg[3])));
            w.z = cvtpk_s(v1[0] * rn * g1[0] * fast_silu(bfs(gg[4])), v1[1] * rn * g1[1] * fast_silu(bfs(gg[5]))); w.w = cvtpk_s(v1[2] * rn * g1[2] * fast_silu(bfs(gg[6])), v1[3] * rn * g1[3] * fast_silu(bfs(gg[7])));
            *(u32x4*)(O + grow * DM + 256 + h * 64 + ch * 8) = w; }
    }
}

__device__ __forceinline__ float diff_lambda_val(const Params& p, int l, float lam_init) {
    const float* lv = p.diff_lam + l * 128; float s1 = 0.f, s2 = 0.f;
    for (int i = 0; i < 32; ++i) { s1 += lv[i] * lv[32 + i]; s2 += lv[64 + i] * lv[96 + i]; }
    return expf(s1) - expf(s2) + lam_init;
}
__device__ __forceinline__ float max3f(float a, float b, float c) { return __builtin_fmaxf(__builtin_fmaxf(a, b), c); }
__device__ __forceinline__ float xhalf_max(float m) { auto rr = __builtin_amdgcn_permlane32_swap(__float_as_uint(m), __float_as_uint(m), false, false); return fmaxf(__uint_as_float(rr[0]), __uint_as_float(rr[1])); }
__device__ __forceinline__ float xhalf_sum(float m) { auto rr = __builtin_amdgcn_permlane32_swap(__float_as_uint(m), __float_as_uint(m), false, false); return __uint_as_float(rr[0]) + __uint_as_float(rr[1]); }

constexpr int DF_K = 0, DF_V = 16384, DF_WS = 32768, DF_ST = 34816;
constexpr int DD_K = 0, DD_V = 32768, DD_WS = 65536, DD_ST = 67584;
__device__ __forceinline__ void glds16(const void* gsrc, unsigned lds_dst) { unsigned keep;
    asm volatile("s_mov_b32 %0, m0\n\ts_mov_b32 m0, %2\n\ts_nop 0\n\tglobal_load_lds_dwordx4 %1, off\n\ts_mov_b32 m0, %0" : "=&s"(keep) : "v"(gsrc), "s"(lds_dst) : "memory"); }
template <bool SAFE>
__device__ __forceinline__ void diff_tiles(const bf16_t* P, int b, int h, int t_lo, LAS char* sm, int tid, int wid, int lane, const bf16x8 (&qr)[4], f32x16 (&o)[2][2], float (&lsum)[2]) {
    const int r32 = lane & 31, hi = lane >> 5, t_hi = 260;
    LAS float* wsf = (LAS float*)(sm + DD_WS) + wid * 64;
    const bf16_t* kcol = P + C_DK + h * 64 + wid * 8;
    const bf16_t* vcol = P + C_DV + h * 64 + (wid >> 2) * 32 + (lane & 3) * 8;
    const int krow_in = lane, vrow_in = 16 * (wid & 3) + (lane >> 2);
#define TILE_ROW0(t) ((t) < 256 ? b * NSEQ + (t) * 64 : NLAT + b * NCTX + ((t) - 256) * 64)
    float mhat[2];
#pragma unroll
    for (int m = 0; m < 2; ++m) { mhat[m] = 0.f; lsum[m] = 0.f;
#pragma unroll
        for (int r = 0; r < 16; ++r) { o[m][0][r] = 0.f; o[m][1][r] = 0.f; } }
    const unsigned lds0 = (unsigned)(size_t)sm + (unsigned)wid * 1024u;
#define DMA_TILE(t) do { const int r0_ = TILE_ROW0(t); const unsigned sl_ = (unsigned)(((t) - t_lo) & 3) * 8192u; \
    glds16(kcol + (size_t)(r0_ + krow_in) * DIN, (unsigned)__builtin_amdgcn_readfirstlane(lds0 + DD_K + sl_)); glds16(vcol + (size_t)(r0_ + vrow_in) * DIN, (unsigned)__builtin_amdgcn_readfirstlane(lds0 + DD_V + sl_)); } while (0)
    asm volatile("s_waitcnt lgkmcnt(0)\n\ts_barrier" ::: "memory");
    DMA_TILE(t_lo); DMA_TILE(t_lo + 1); DMA_TILE(t_lo + 2);
    bool first = true;
    for (int t = t_lo; t < t_hi; ++t) {
        const int cur = (t - t_lo) & 3;
        if (t + 2 < t_hi) asm volatile("s_waitcnt vmcnt(4)\n\ts_barrier" ::: "memory");
        else if (t + 1 < t_hi) asm volatile("s_waitcnt vmcnt(2)\n\ts_barrier" ::: "memory");
        else asm volatile("s_waitcnt vmcnt(0)\n\ts_barrier" ::: "memory");
        if (t + 3 < t_hi) DMA_TILE(t + 3);
        const LAS char* kb = sm + DD_K + cur * 8192 + hi * 1024 + r32 * 16;
        const LAS char* vb = sm + DD_V + cur * 8192 + ((lane >> 4) & 1) * 32 + (lane & 3) * 8 + (4 * hi + ((lane & 15) >> 2)) * 64;
#pragma unroll
        for (int m = 0; m < 2; ++m) {
            bf16x8 kf[8];
#pragma unroll
            for (int j = 2 * m; j < 2 * m + 2; ++j) { kf[2 * j] = *(const LAS bf16x8*)(kb + j * 2048); kf[2 * j + 1] = *(const LAS bf16x8*)(kb + j * 2048 + 512); }
            f32x16 c0, c1;
            if (SAFE) { float nm = -mhat[m]; asm volatile("" : "+v"(nm));
#pragma unroll
                for (int r = 0; r < 16; ++r) { c0[r] = nm; c1[r] = nm; } }
            else {
#pragma unroll
                for (int r = 0; r < 16; ++r) { c0[r] = 0.f; c1[r] = 0.f; } }
            c0 = __builtin_amdgcn_mfma_f32_32x32x16_bf16(kf[4 * m + 0], qr[2 * m], c0, 0, 0, 0);
            c1 = __builtin_amdgcn_mfma_f32_32x32x16_bf16(kf[4 * m + 1], qr[2 * m], c1, 0, 0, 0);
            c0 = __builtin_amdgcn_mfma_f32_32x32x16_bf16(kf[4 * m + 2], qr[2 * m + 1], c0, 0, 0, 0);
            c1 = __builtin_amdgcn_mfma_f32_32x32x16_bf16(kf[4 * m + 3], qr[2 * m + 1], c1, 0, 0, 0);
            if (SAFE) {
                float ra = max3f(c0[0], c0[1], c1[0]), rb = max3f(c0[2], c0[3], c1[1]); ra = max3f(ra, c1[2], c1[3]);
#pragma unroll
                for (int r = 4; r < 16; r += 4) { ra = max3f(ra, c0[r], c0[r + 1]); rb = max3f(rb, c0[r + 2], c0[r + 3]); ra = max3f(ra, c1[r], c1[r + 1]); rb = max3f(rb, c1[r + 2], c1[r + 3]); }
                const float rm = xhalf_max(max3f(ra, rb, rb));
                if (__builtin_expect(first || __any(rm > 8.0f), 0)) {
                    float dl = first ? rm : fmaxf(rm, 0.f); asm volatile("; rebase" : "+v"(dl));
                    mhat[m] += dl;
#pragma unroll
                    for (int r = 0; r < 16; ++r) { c0[r] -= dl; c1[r] -= dl; }
                    asm volatile("" : "+v"(c0), "+v"(c1));
                    if (!first) {
                        const float f = __builtin_amdgcn_exp2f(-dl); lsum[m] *= f;
                        if (hi == 0) wsf[r32] = f;
#pragma unroll
                        for (int r = 0; r < 16; ++r) { const float fr_ = wsf[crow(r, hi)]; o[m][0][r] *= fr_; o[m][1][r] *= fr_; }
                    }
                }
            }
            float sacc = 0.f;
#pragma unroll
            for (int r = 0; r < 16; ++r) { c0[r] = __builtin_amdgcn_exp2f(c0[r]); c1[r] = __builtin_amdgcn_exp2f(c1[r]); sacc += c0[r] + c1[r]; }
            lsum[m] += sacc;
            u32x4 pw[4];
#pragma unroll
            for (int k = 0; k < 2; ++k) {
                pw[k] = (u32x4){cvtpk_s(c0[8 * k + 0], c0[8 * k + 1]), cvtpk_s(c0[8 * k + 2], c0[8 * k + 3]), cvtpk_s(c0[8 * k + 4], c0[8 * k + 5]), cvtpk_s(c0[8 * k + 6], c0[8 * k + 7])};
                pw[2 + k] = (u32x4){cvtpk_s(c1[8 * k + 0], c1[8 * k + 1]), cvtpk_s(c1[8 * k + 2], c1[8 * k + 3]), cvtpk_s(c1[8 * k + 4], c1[8 * k + 5]), cvtpk_s(c1[8 * k + 6], c1[8 * k + 7])}; }
            if (!SAFE) __builtin_amdgcn_sched_barrier(0);
#pragma unroll
            for (int dh = 0; dh < 2; ++dh) {
#pragma unroll
                for (int k = 0; k < 4; ++k) { const s16x4 lo = vtr(vb + dh * 4096 + k * 1024), hh = vtr(vb + dh * 4096 + k * 1024 + 512);
                    o[m][dh] = __builtin_amdgcn_mfma_f32_32x32x16_bf16(__builtin_bit_cast(bf16x8, pw[k]), (bf16x8){lo[0], lo[1], lo[2], lo[3], hh[0], hh[1], hh[2], hh[3]}, o[m][dh], 0, 0, 0); } }
            if (!SAFE) __builtin_amdgcn_sched_barrier(0);
        }
        first = false;
        asm volatile("s_waitcnt lgkmcnt(0)" ::: "memory");
    }
#undef TILE_ROW0
#undef DMA_TILE
}

constexpr int DQ_K = 0, DQ_V = 40960, DQ_WS = 81920, DQ_ST = 0;
__device__ __forceinline__ void diff_tiles_fast(const bf16_t* P, int b, int h, int t_lo, LAS char* sm, int tid, int wid, int lane, const bf16x8 (&qr)[4], f32x16 (&o)[2][2], f32x4 (&ls)[2]) {
    const int r32 = lane & 31, hi = lane >> 5, NT = 260 - t_lo;
    const bf16_t* kcol = P + C_DK + h * 64 + wid * 8;
    const bf16_t* vcol = P + C_DV + h * 64 + (wid >> 2) * 32 + (lane & 3) * 8;
    const int krow_in = lane, vrow_in = 16 * (wid & 3) + (lane >> 2);
    const unsigned lds0 = (unsigned)(size_t)sm + (unsigned)wid * 1024u;
#define TILE_ROW0(i) ((t_lo + (i)) < 256 ? b * NSEQ + (t_lo + (i)) * 64 : NLAT + b * NCTX + (t_lo + (i) - 256) * 64)
#define DMA_TILE(i, slot) do { const int r0_ = TILE_ROW0(i); const unsigned sl_ = (unsigned)(slot) * 8192u; \
    glds16(kcol + (size_t)(r0_ + krow_in) * DIN, (unsigned)__builtin_amdgcn_readfirstlane(lds0 + DQ_K + sl_)); glds16(vcol + (size_t)(r0_ + vrow_in) * DIN, (unsigned)__builtin_amdgcn_readfirstlane(lds0 + DQ_V + sl_)); } while (0)
#pragma unroll
    for (int m = 0; m < 2; ++m) { ls[m] = (f32x4){0.f, 0.f, 0.f, 0.f};
#pragma unroll
        for (int r = 0; r < 16; ++r) { o[m][0][r] = 0.f; o[m][1][r] = 0.f; } }
    const unsigned onev = (((lane >> 4) ^ (lane >> 3)) & 1) ? 0u : 0x3F803F80u;
    const bf16x8 onesB = __builtin_bit_cast(bf16x8, ((u32x4){onev, onev, onev, onev}));
    asm volatile("s_waitcnt lgkmcnt(0)\n\ts_barrier" ::: "memory");
    DMA_TILE(0, 0); DMA_TILE(1, 1); DMA_TILE(2, 2); DMA_TILE(3, 3);
    asm volatile("s_waitcnt vmcnt(4)\n\ts_barrier" ::: "memory");
    const int kfo = hi * 1024 + r32 * 16, vfo = ((lane >> 4) & 1) * 32 + (lane & 3) * 8 + (4 * hi + ((lane & 15) >> 2)) * 64;
    f32x16 cA0, cA1, cB0, cB1; u32x4 pwp[4], pwq[4]; bf16x8 vq[8], kq[4];
#define KOFF(g) ((((g) & 1) * 512) + (((g) >> 1) * 2048))
#define LDK(g, base) kq[g] = *(const LAS bf16x8*)((base) + KOFF(g))
#define LDV(g, base) do { const s16x4 l0_ = vtr((base) + (g) * 1024), h0_ = vtr((base) + (g) * 1024 + 512), l1_ = vtr((base) + 4096 + (g) * 1024), h1_ = vtr((base) + 4096 + (g) * 1024 + 512); \
        vq[g] = (bf16x8){l0_[0], l0_[1], l0_[2], l0_[3], h0_[0], h0_[1], h0_[2], h0_[3]}; vq[4 + (g)] = (bf16x8){l1_[0], l1_[1], l1_[2], l1_[3], h1_[0], h1_[1], h1_[2], h1_[3]}; } while (0)
    {
        const LAS char* kb_ = sm + DQ_K + kfo;
#pragma unroll
        for (int r = 0; r < 16; ++r) { cA0[r] = 0.f; cA1[r] = 0.f; cB0[r] = 0.f; cB1[r] = 0.f; }
#pragma unroll
        for (int j = 0; j < 2; ++j) { cA0 = __builtin_amdgcn_mfma_f32_32x32x16_bf16(*(const LAS bf16x8*)(kb_ + j * 2048), qr[j], cA0, 0, 0, 0);
                                      cA1 = __builtin_amdgcn_mfma_f32_32x32x16_bf16(*(const LAS bf16x8*)(kb_ + j * 2048 + 512), qr[j], cA1, 0, 0, 0);
                                      cB0 = __builtin_amdgcn_mfma_f32_32x32x16_bf16(*(const LAS bf16x8*)(kb_ + 4096 + j * 2048), qr[2 + j], cB0, 0, 0, 0);
                                      cB1 = __builtin_amdgcn_mfma_f32_32x32x16_bf16(*(const LAS bf16x8*)(kb_ + 4096 + j * 2048 + 512), qr[2 + j], cB1, 0, 0, 0); }
#pragma unroll
        for (int r = 0; r < 16; ++r) { cA0[r] = __builtin_amdgcn_exp2f(cA0[r]); cA1[r] = __builtin_amdgcn_exp2f(cA1[r]); }
#pragma unroll
        for (int k = 0; k < 2; ++k) {
            pwq[k] = (u32x4){cvtpk_s(cA0[8 * k + 0], cA0[8 * k + 1]), cvtpk_s(cA0[8 * k + 2], cA0[8 * k + 3]), cvtpk_s(cA0[8 * k + 4], cA0[8 * k + 5]), cvtpk_s(cA0[8 * k + 6], cA0[8 * k + 7])};
            pwq[2 + k] = (u32x4){cvtpk_s(cA1[8 * k + 0], cA1[8 * k + 1]), cvtpk_s(cA1[8 * k + 2], cA1[8 * k + 3]), cvtpk_s(cA1[8 * k + 4], cA1[8 * k + 5]), cvtpk_s(cA1[8 * k + 6], cA1[8 * k + 7])}; }
        const LAS char* v0_ = sm + DQ_V + vfo; const LAS char* k1_ = sm + DQ_K + 8192 + kfo;
#pragma unroll
        for (int g = 0; g < 4; ++g) { LDV(g, v0_); LDK(g, k1_); }
        __builtin_amdgcn_sched_barrier(0);
    }
#define STEPF(CC0, CC1, PWC, PWP, MPREV, CN0, CN1, MNEXT, RELOAD, NREAD) do { \
    _Pragma("unroll") for (int r_ = 0; r_ < 16; ++r_) { CN0[r_] = 0.f; CN1[r_] = 0.f; } \
    _Pragma("unroll") for (int g_ = 0; g_ < 4; ++g_) { \
        o[MPREV][0] = __builtin_amdgcn_mfma_f32_32x32x16_bf16(__builtin_bit_cast(bf16x8, PWP[g_]), vq[g_], o[MPREV][0], 0, 0, 0); \
        o[MPREV][1] = __builtin_amdgcn_mfma_f32_32x32x16_bf16(__builtin_bit_cast(bf16x8, PWP[g_]), vq[4 + g_], o[MPREV][1], 0, 0, 0); \
        ls[MPREV] = __builtin_amdgcn_mfma_f32_16x16x32_bf16(__builtin_bit_cast(bf16x8, PWP[g_]), onesB, ls[MPREV], 0, 0, 0); \
        if ((g_ & 1) == 0) CN0 = __builtin_amdgcn_mfma_f32_32x32x16_bf16(kq[g_], qr[2 * (MNEXT) + (g_ >> 1)], CN0, 0, 0, 0); \
        else               CN1 = __builtin_amdgcn_mfma_f32_32x32x16_bf16(kq[g_], qr[2 * (MNEXT) + (g_ >> 1)], CN1, 0, 0, 0); \
        _Pragma("unroll") for (int r_ = 4 * g_; r_ < 4 * g_ + 4; ++r_) { CC0[r_] = __builtin_amdgcn_exp2f(CC0[r_]); CC1[r_] = __builtin_amdgcn_exp2f(CC1[r_]); } \
        if (g_ == 1) { PWC[0] = (u32x4){cvtpk_s(CC0[0], CC0[1]), cvtpk_s(CC0[2], CC0[3]), cvtpk_s(CC0[4], CC0[5]), cvtpk_s(CC0[6], CC0[7])}; \
                       PWC[2] = (u32x4){cvtpk_s(CC1[0], CC1[1]), cvtpk_s(CC1[2], CC1[3]), cvtpk_s(CC1[4], CC1[5]), cvtpk_s(CC1[6], CC1[7])}; } \
        if (g_ == 3) { PWC[1] = (u32x4){cvtpk_s(CC0[8], CC0[9]), cvtpk_s(CC0[10], CC0[11]), cvtpk_s(CC0[12], CC0[13]), cvtpk_s(CC0[14], CC0[15])}; \
                       PWC[3] = (u32x4){cvtpk_s(CC1[8], CC1[9]), cvtpk_s(CC1[10], CC1[11]), cvtpk_s(CC1[12], CC1[13]), cvtpk_s(CC1[14], CC1[15])}; } \
        RELOAD(g_); } \
    _Pragma("unroll") for (int g_ = 0; g_ < 4; ++g_) { \
        _Pragma("unroll") for (int i_ = 0; i_ < 4; ++i_) { __builtin_amdgcn_sched_group_barrier(0x008, 1, 0); __builtin_amdgcn_sched_group_barrier(0x400, 2, 0); } \
        __builtin_amdgcn_sched_group_barrier(0x100, NREAD, 0); }        \
    __builtin_amdgcn_sched_barrier(0); } while (0)
#define RELOAD_A(g) LDK(g, k1_ + 4096)
#define RELOAD_B(g) do { LDK(g, k2_); LDV(g, v1_); } while (0)
    int s1 = 1, s2 = 2, s4 = 4;
    for (int t = 0; t < NT; ++t) {
        if (t + 3 < NT) asm volatile("s_waitcnt vmcnt(2)\n\ts_barrier" ::: "memory"); else asm volatile("s_waitcnt vmcnt(0)\n\ts_barrier" ::: "memory");
        if (t + 4 < NT) DMA_TILE(t + 4, s4);
        const LAS char* k1_ = sm + DQ_K + s1 * 8192 + kfo; const LAS char* k2_ = sm + DQ_K + s2 * 8192 + kfo; const LAS char* v1_ = sm + DQ_V + s1 * 8192 + vfo;
        __builtin_amdgcn_sched_barrier(0);
        STEPF(cB0, cB1, pwp, pwq, 0, cA0, cA1, 0, RELOAD_A, 1);
        STEPF(cA0, cA1, pwq, pwp, 1, cB0, cB1, 1, RELOAD_B, 5);
        s1 = s2; s2 = (s2 == 4) ? 0 : s2 + 1; s4 = (s4 == 4) ? 0 : s4 + 1;
    }
#undef TILE_ROW0
#undef DMA_TILE
#undef STEPF
#undef RELOAD_A
#undef RELOAD_B
#undef LDK
#undef LDV
#undef KOFF
}

template <bool SAFE>
__device__ __forceinline__ bool diff_unit(const Params& p, int l, float lam_init, float lam, int u, float* lds) {
    char* ws = p.ws; const int tid = TIDX, lane = tid & 63, r32 = lane & 31, hi = lane >> 5, wid = __builtin_amdgcn_readfirstlane(tid >> 6);
    const bf16_t* P = (const bf16_t*)(ws + OFF_P); bf16_t* O = (bf16_t*)(ws + OFF_ACT);
    LAS char* sm = (LAS char*)lds;
    int b, h, qrow0, t_lo;
    if (u < 512) { b = u >> 8; h = (u >> 6) & 3; qrow0 = b * NSEQ + (u & 63) * 256; t_lo = 0; }
    else { const int v = u - 512; b = v >> 2; h = v & 3; qrow0 = NLAT + b * NCTX; t_lo = 256; }
    bf16x8 qr[4];
    { const bf16_t* qp = P + (size_t)(qrow0 + wid * 32 + r32) * DIN + C_DQ + h * 64 + hi * 8;
#pragma unroll
      for (int d0 = 0; d0 < 4; ++d0) qr[d0] = *(const bf16x8*)(qp + d0 * 16); }
        asm volatile("" :: "v"(qr[0]), "v"(qr[1]), "v"(qr[2]), "v"(qr[3]));
    f32x16 o[2][2]; float lsum[2] = {1.f, 1.f}; f32x4 ls[2];
    if (SAFE) diff_tiles<true>(P, b, h, t_lo, sm, tid, wid, lane, qr, o, lsum); else diff_tiles_fast(P, b, h, t_lo, sm, tid, wid, lane, qr, o, ls);
    constexpr int WS_OFF = SAFE ? DD_WS : DQ_WS, ST_OFF = SAFE ? DD_ST : DQ_ST;
    if (!SAFE) {
        bool bad = false;
#pragma unroll
        for (int i = 0; i < 4; ++i) bad |= !(ls[0][i] > 7.9e-31f && ls[0][i] < 1.2e30f && ls[1][i] > 7.9e-31f && ls[1][i] < 1.2e30f);
        LAS unsigned* flg = (LAS unsigned*)(sm + WS_OFF + 2048);
        const unsigned anyb = __any(bad) ? 1u : 0u;
        if (lane == 0) flg[wid] = anyb;
        asm volatile("s_waitcnt lgkmcnt(0)\n\ts_barrier" ::: "memory");
        const unsigned allb = flg[0] | flg[1] | flg[2] | flg[3] | flg[4] | flg[5] | flg[6] | flg[7];
        if (__builtin_expect(allb != 0u, 0)) return true;
    }
    int lane_e = TIDX & 63;
    { const int r32e = lane_e & 31, hie = lane_e >> 5;
    LAS float* wse = (LAS float*)(sm + WS_OFF) + wid * 64; LAS float* stge = (LAS float*)(sm + ST_OFF) + wid * 2048;
    if (SAFE) { const float l0 = xhalf_sum(lsum[0]), l1 = xhalf_sum(lsum[1]); if (hie == 0) { wse[r32e] = 1.0f / l0; wse[32 + r32e] = lam / l1; } }
    else if ((lane_e & 7) == 0) { const int qb = ((lane_e >> 3) & 1) * 16 + (lane_e >> 4) * 4;
#pragma unroll
        for (int i = 0; i < 4; ++i) { wse[qb + i] = 1.0f / ls[0][i]; wse[32 + qb + i] = lam / ls[1][i]; } }
#pragma unroll
    for (int r = 0; r < 16; ++r) { const int q = crow(r, hie); const float i0 = wse[q], i1 = wse[32 + q];
        stge[q * 64 + r32e] = o[0][0][r] * i0 - o[1][0][r] * i1; stge[q * 64 + 32 + r32e] = o[0][1][r] * i0 - o[1][1][r] * i1; } }
    LAS float* stg = (LAS float*)(sm + ST_OFF) + wid * 2048;
    const float* gn = p.diff_gn + l * 256 + h * 64 + (lane_e & 7) * 8;
    const f32x4 g0 = *(const f32x4*)gn, g1 = *(const f32x4*)(gn + 4);
#pragma unroll
    for (int i = 0; i < 4; ++i) { const int row = i * 8 + (lane_e >> 3), ch = lane_e & 7;
        const f32x4 v0 = *(const LAS f32x4*)(stg + row * 64 + ch * 8), v1 = *(const LAS f32x4*)(stg + row * 64 + ch * 8 + 4);
        float ss = v0[0] * v0[0] + v0[1] * v0[1] + v0[2] * v0[2] + v0[3] * v0[3] + v1[0] * v1[0] + v1[1] * v1[1] + v1[2] * v1[2] + v1[3] * v1[3];
        ss += __shfl_xor(ss, 1); ss += __shfl_xor(ss, 2); ss += __shfl_xor(ss, 4);
        const float rn = rsqrtf(ss * (1.0f / 64.0f) + 1e-6f) * (1.0f - lam_init);
        u32x4 w; w.x = cvtpk_s(v0[0] * rn * g0[0], v0[1] * rn * g0[1]); w.y = cvtpk_s(v0[2] * rn * g0[2], v0[3] * rn * g0[3]);
        w.z = cvtpk_s(v1[0] * rn * g1[0], v1[1] * rn * g1[1]); w.w = cvtpk_s(v1[2] * rn * g1[2], v1[3] * rn * g1[3]);
        *(u32x4*)(O + (size_t)(qrow0 + wid * 32 + row) * DM + 512 + h * 64 + ch * 8) = w; }
    return false;
}
__device__ __forceinline__ void ph_diff(const Params& p, int l, bool need_ctx, float lam_init, int bid, int nb, float* lds) {
    const float lam = __int_as_float(__builtin_amdgcn_readfirstlane(__float_as_int(diff_lambda_val(p, l, lam_init))));
    const int nun = 512 + (need_ctx ? 8 : 0);
    unsigned redo = 0u; int idx = 0;
    for (int u = (bid + 160) % nb; u < nun; u += nb, ++idx) if (diff_unit<false>(p, l, lam_init, lam, u, lds)) redo |= 1u << idx;
    idx = 0;
    if (__builtin_expect(redo != 0u, 0))
        for (int u = (bid + 160) % nb; u < nun; u += nb, ++idx) if ((redo >> idx) & 1u) (void)diff_unit<true>(p, l, lam_init, lam, u, lds);
}

__device__ __forceinline__ void ph_swa(const Params& p, int l, bool need_ctx, int bid, int nb, float* lds) {
    char* ws = p.ws; const int tid = TIDX, lane = tid & 63, r32 = lane & 31, hi = lane >> 5, wid = __builtin_amdgcn_readfirstlane(tid >> 6);
    const bf16_t* P = (const bf16_t*)(ws + OFF_P); bf16_t* O = (bf16_t*)(ws + OFF_ACT);
    LAS char* sm = (LAS char*)lds;
    LAS float* wsf = (LAS float*)(sm + DD_WS) + wid * 64;
    const int nun = 512 + (need_ctx ? 8 : 0);
    UnitQ uq{(unsigned*)ws + CW_QUE + l * 16 + 0, 0}; q_prefetch(uq);
    for (int u = q_take(uq, lds); u < nun; u = q_take(uq, lds)) {
        q_prefetch(uq);
        int b, h, qrow0, q0, tw_lo, nwin;
        if (u < 512) { b = u >> 8; h = (u >> 6) & 3; q0 = (u & 63) * 256; qrow0 = b * NSEQ + q0; const int lo = q0 - 128 < 0 ? 0 : q0 - 128, hi_ = q0 + 384 > NSEQ ? NSEQ : q0 + 384; tw_lo = lo >> 6; nwin = (hi_ - lo) >> 6; }
        else { const int v = u - 512; b = v >> 2; h = v & 3; q0 = 0; qrow0 = NLAT + b * NCTX; tw_lo = 0; nwin = 0; }
        const int g = h >> 1, nt = nwin + 4;
        const bf16_t* kcol = P + C_AK + g * 64 + wid * 8;
        const bf16_t* vcol = P + C_AV + g * 64 + (wid >> 2) * 32 + (lane & 3) * 8;
        const int krow_in = lane, vrow_in = 16 * (wid & 3) + (lane >> 2);
#define SWA_ROW0(i) ((i) < nwin ? b * NSEQ + (tw_lo + (i)) * 64 : NLAT + b * NCTX + ((i) - nwin) * 64)
        bf16x8 qr[4];
        { const bf16_t* qp = P + (size_t)(qrow0 + wid * 32 + r32) * DIN + C_AQ + h * 64 + hi * 8;
#pragma unroll
          for (int d0 = 0; d0 < 4; ++d0) qr[d0] = *(const bf16x8*)(qp + d0 * 16); }
        asm volatile("" :: "v"(qr[0]), "v"(qr[1]), "v"(qr[2]), "v"(qr[3]));
        f32x16 o[2]; float mhat = p.sink[l * 4 + h] * 1.4426950408889634f, lsum = hi == 0 ? 1.0f : 0.0f;
#pragma unroll
        for (int r = 0; r < 16; ++r) { o[0][r] = 0.f; o[1][r] = 0.f; }
        const int qw = q0 + wid * 32, qpos = qw + r32;
        const unsigned lds0 = (unsigned)(size_t)sm + (unsigned)wid * 1024u;
#define DMA_TILE(i) do { const int r0_ = SWA_ROW0(i); const unsigned sl_ = (unsigned)((i) & 3) * 8192u; \
        glds16(kcol + (size_t)(r0_ + krow_in) * DIN, (unsigned)__builtin_amdgcn_readfirstlane(lds0 + DD_K + sl_)); glds16(vcol + (size_t)(r0_ + vrow_in) * DIN, (unsigned)__builtin_amdgcn_readfirstlane(lds0 + DD_V + sl_)); } while (0)
        asm volatile("s_waitcnt lgkmcnt(0)\n\ts_barrier" ::: "memory");
        DMA_TILE(0); DMA_TILE(1); DMA_TILE(2);
        for (int i = 0; i < nt; ++i) {
            const int cur = i & 3;
            if (i + 2 < nt) asm volatile("s_waitcnt vmcnt(4)\n\ts_barrier" ::: "memory");
            else if (i + 1 < nt) asm volatile("s_waitcnt vmcnt(2)\n\ts_barrier" ::: "memory");
            else asm volatile("s_waitcnt vmcnt(0)\n\ts_barrier" ::: "memory");
            if (i + 3 < nt) DMA_TILE(i + 3);
            const bool win = i < nwin; const int T = (tw_lo + i) * 64;
            const bool skip = win && (T > qw + 31 + 128 || T + 63 < qw - 128);
            if (!skip) {
                const LAS char* kb = sm + DD_K + cur * 8192 + hi * 1024 + r32 * 16;
                const LAS char* vb = sm + DD_V + cur * 8192 + ((lane >> 4) & 1) * 32 + (lane & 3) * 8 + (4 * hi + ((lane & 15) >> 2)) * 64;
                float nm = -mhat; asm volatile("" : "+v"(nm));
                f32x16 c0, c1;
#pragma unroll
                for (int r = 0; r < 16; ++r) { c0[r] = nm; c1[r] = nm; }
#pragma unroll
                for (int j = 0; j < 4; ++j) {
                    c0 = __builtin_amdgcn_mfma_f32_32x32x16_bf16(*(const LAS bf16x8*)(kb + j * 2048), qr[j], c0, 0, 0, 0);
                    c1 = __builtin_amdgcn_mfma_f32_32x32x16_bf16(*(const LAS bf16x8*)(kb + j * 2048 + 512), qr[j], c1, 0, 0, 0); }
                if (win && (T < qw + 31 - 128 || T + 63 > qw + 128)) {
#pragma unroll
                    for (int r = 0; r < 16; ++r) { const int kp = T + crow(r, hi); const int d0_ = qpos - kp, d1_ = d0_ - 32;
                        if (d0_ > 128 || d0_ < -128) c0[r] = -1.0e30f;
                        if (d1_ > 128 || d1_ < -128) c1[r] = -1.0e30f; }
                }
                float rm = fmaxf(c0[0], c1[0]);
#pragma unroll
                for (int r = 1; r < 16; ++r) rm = fmaxf(rm, fmaxf(c0[r], c1[r]));
                rm = xhalf_max(rm);
                if (__any(rm > 8.0f)) {
                    const float dl = fmaxf(rm, 0.f); mhat += dl;
#pragma unroll
                    for (int r = 0; r < 16; ++r) { c0[r] -= dl; c1[r] -= dl; }
                    const float f = __builtin_amdgcn_exp2f(-dl); lsum *= f;
                    if (hi == 0) wsf[r32] = f;
#pragma unroll
                    for (int r = 0; r < 16; ++r) { const float fr_ = wsf[crow(r, hi)]; o[0][r] *= fr_; o[1][r] *= fr_; }
                }
                float sacc = 0.f;
#pragma unroll
                for (int r = 0; r < 16; ++r) { c0[r] = __builtin_amdgcn_exp2f(c0[r]); c1[r] = __builtin_amdgcn_exp2f(c1[r]); sacc += c0[r] + c1[r]; }
                lsum += sacc;
                u32x4 pw[4];
#pragma unroll
                for (int k = 0; k < 2; ++k) {
                    pw[k] = (u32x4){cvtpk_s(c0[8 * k + 0], c0[8 * k + 1]), cvtpk_s(c0[8 * k + 2], c0[8 * k + 3]), cvtpk_s(c0[8 * k + 4], c0[8 * k + 5]), cvtpk_s(c0[8 * k + 6], c0[8 * k + 7])};
                    pw[2 + k] = (u32x4){cvtpk_s(c1[8 * k + 0], c1[8 * k + 1]), cvtpk_s(c1[8 * k + 2], c1[8 * k + 3]), cvtpk_s(c1[8 * k + 4], c1[8 * k + 5]), cvtpk_s(c1[8 * k + 6], c1[8 * k + 7])}; }
#pragma unroll
                for (int k = 0; k < 4; ++k) {
                    const s16x4 lo0 = vtr(vb + k * 1024), hi0 = vtr(vb + k * 1024 + 512), lo1 = vtr(vb + 4096 + k * 1024), hi1 = vtr(vb + 4096 + k * 1024 + 512);
                    o[0] = __builtin_amdgcn_mfma_f32_32x32x16_bf16(__builtin_bit_cast(bf16x8, pw[k]), (bf16x8){lo0[0], lo0[1], lo0[2], lo0[3], hi0[0], hi0[1], hi0[2], hi0[3]}, o[0], 0, 0, 0);
                    o[1] = __builtin_amdgcn_mfma_f32_32x32x16_bf16(__builtin_bit_cast(bf16x8, pw[k]), (bf16x8){lo1[0], lo1[1], lo1[2], lo1[3], hi1[0], hi1[1], hi1[2], hi1[3]}, o[1], 0, 0, 0); }
            }
            asm volatile("s_waitcnt lgkmcnt(0)" ::: "memory");
        }
#undef SWA_ROW0
#undef DMA_TILE
        const float inv = 1.0f / xhalf_sum(lsum);
        int lane_e = TIDX & 63;
        { const int r32e = lane_e & 31, hie = lane_e >> 5;
        LAS float* wse = (LAS float*)(sm + DD_WS) + wid * 64; LAS float* stge = (LAS float*)(sm + DD_ST) + wid * 2048;
        if (hie == 0) wse[r32e] = inv;
#pragma unroll
        for (int r = 0; r < 16; ++r) { const int q = crow(r, hie); const float i0 = wse[q]; stge[q * 64 + r32e] = o[0][r] * i0; stge[q * 64 + 32 + r32e] = o[1][r] * i0; } }
        LAS float* stg = (LAS float*)(sm + DD_ST) + wid * 2048;
#pragma unroll
        for (int i = 0; i < 4; ++i) { const int row = i * 8 + (lane_e >> 3), ch = lane_e & 7;
            const f32x4 v0 = *(const LAS f32x4*)(stg + row * 64 + ch * 8), v1 = *(const LAS f32x4*)(stg + row * 64 + ch * 8 + 4);
            u32x4 w; w.x = cvtpk_s(v0[0], v0[1]); w.y = cvtpk_s(v0[2], v0[3]); w.z = cvtpk_s(v1[0], v1[1]); w.w = cvtpk_s(v1[2], v1[3]);
            *(u32x4*)(O + (size_t)(qrow0 + wid * 32 + row) * DM + h * 64 + ch * 8) = w; }
    }
}

__device__ __forceinline__ void moe_offsets(const Params& p, int* offs  ) {
    if (TIDX < 2) { const unsigned* cw = (const unsigned*)p.ws + CW_CNT + TIDX * 8; int o = 0;
        for (int e = 0; e < 8; ++e) { offs[TIDX * 9 + e] = o; o += ((int)__hip_atomic_load(cw + e, __ATOMIC_RELAXED, __HIP_MEMORY_SCOPE_AGENT) + 255) & ~255; }
        offs[TIDX * 9 + 8] = o; }
    __syncthreads();
}
__device__ __forceinline__ void ph_moe_scatter(const Params& p, int bid, int nb, float* lds) {
    char* ws = p.ws; int* offs = (int*)lds; moe_offsets(p, offs);
    const int lane = TIDX & 63, wv = TIDX >> 6;
    const bf16_t* H = (const bf16_t*)(ws + OFF_ACT); bf16_t* AS = (bf16_t*)(ws + OFF_ASORT);
    int* tok = (int*)(ws + OFF_TOK); float* wgt = (float*)(ws + OFF_WGT); const unsigned* cw = (const unsigned*)ws;
    const int step = nb * 8 * 4; int r0 = (bid * 8 + wv) * 4;
    int4 rec[4]; u32x4 d8[4];
#define SC_LOAD(rc, dd, rbase) do { _Pragma("unroll") for (int k = 0; k < 4; ++k) { rc[k] = *(const int4*)(ws + OFF_ROUTE + (size_t)((rbase) + k) * 16); dd[k] = ((const u32x4*)((const unsigned char*)H + (size_t)((rbase) + k) * DM))[lane]; } } while (0)
    if (r0 < NLAT) SC_LOAD(rec, d8, r0);
    for (; r0 < NLAT; r0 += step) {
        int pos[4][2];
#pragma unroll
        for (int k = 0; k < 4; ++k) { const int blk = ((r0 + k) >> 3) % nb;
#pragma unroll
            for (int g = 0; g < 2; ++g) { const int e = (g == 0 ? rec[k].x : rec[k].y) & 15, li = (g == 0 ? rec[k].x : rec[k].y) >> 4;
                pos[k][g] = offs[g * 9 + e] + (int)cw[CW_BLK + blk * 16 + g * 8 + e] + li; } }
        const int rn = r0 + step < NLAT ? r0 + step : r0;
        int4 recn[4]; u32x4 d8n[4];
        SC_LOAD(recn, d8n, rn);
#pragma unroll
        for (int k = 0; k < 4; ++k)
#pragma unroll
            for (int g = 0; g < 2; ++g) { const int ps = pos[k][g];
                u32x4* dst = (u32x4*)((unsigned char*)AS + ((size_t)g * GRP_ROWS + ps) * DM); dst[lane] = d8[k]; }
#pragma unroll
        for (int k = 0; k < 4; ++k) { rec[k] = recn[k]; d8[k] = d8n[k]; }
    }
#undef SC_LOAD
}

__device__ __forceinline__ void ph_final(const Params& p, int bid, int nb, float* lds) {
    char* ws = p.ws; int* offs = (int*)lds; __syncthreads(); moe_offsets(p, offs);
    const int lane = TIDX & 63, wv = TIDX >> 6;
    const bf16_t* Y = (const bf16_t*)(ws + OFF_YMOE); const unsigned* cw = (const unsigned*)ws;
    const float* gt2 = (const float*)(ws + OFF_MOD) + (size_t)3 * 6144 + 5120;
    const int stride = nb * 8;
    int4 rec[2]; int pos[2][2];
#define FIN_REC(dst, rbase) do { _Pragma("unroll") for (int q = 0; q < 2; ++q) { const int r_ = ((rbase) + q * stride < NLAT) ? (rbase) + q * stride : (rbase); dst[q] = *(const int4*)(ws + OFF_ROUTE + (size_t)r_ * 16); } } while (0)
#define FIN_POS(dst, src_, rbase) do { _Pragma("unroll") for (int q = 0; q < 2; ++q) { const int r_ = ((rbase) + q * stride < NLAT) ? (rbase) + q * stride : (rbase); const int blk_ = (r_ >> 3) % nb; \
        const int e0_ = src_[q].x & 15, e1_ = src_[q].y & 15; \
        dst[q][0] = offs[e0_] + (int)cw[CW_BLK + blk_ * 16 + e0_] + (src_[q].x >> 4); dst[q][1] = offs[9 + e1_] + (int)cw[CW_BLK + blk_ * 16 + 8 + e1_] + (src_[q].y >> 4); } } while (0)
    int r0 = bid * 8 + wv;
    float4 fg[4];
#pragma unroll
    for (int i = 0; i < 4; ++i) fg[i] = *(const float4*)(p.final_norm + i * 256 + lane * 4);
    float4 gq[2][4]; int gcls[2] = {-1, -1};
    if (r0 < NLAT) { FIN_REC(rec, r0); FIN_POS(pos, rec, r0); }
    for (; r0 < NLAT; r0 += 2 * stride) {
        const bool has1 = r0 + stride < NLAT; const int rn = r0 + 2 * stride; const bool more = rn < NLAT;
        const int rnc = more ? rn : r0;
        int4 recn[2]; int posn[2][2];
        FIN_REC(recn, rnc);
        float4 v[2][4]; uint2 ya[2][4], yb[2][4];
#pragma unroll
        for (int q = 0; q < 2; ++q) { const int r = (q == 0 || has1) ? r0 + q * stride : r0;
            { const int cls = __builtin_amdgcn_readfirstlane(mod_class(r));
              if (cls != gcls[q]) { gcls[q] = cls;
#pragma unroll
                  for (int i = 0; i < 4; ++i) gq[q][i] = *(const float4*)(gt2 + (size_t)cls * 6144 + i * 256 + lane * 4); } }
            const bf16_t* y0 = Y + (size_t)pos[q][0] * DM; const bf16_t* y1 = Y + ((size_t)GRP_ROWS + pos[q][1]) * DM; const bf16_t* xr = (const bf16_t*)(ws + OFF_XB) + (size_t)r * DM;
#pragma unroll
            for (int i = 0; i < 4; ++i) { const int c = i * 256 + lane * 4; { const uint2 w = *(const uint2*)(xr + c); v[q][i] = make_float4(BFLO(w.x), BFHI(w.x), BFLO(w.y), BFHI(w.y)); } ya[q][i] = *(const uint2*)(y0 + c); yb[q][i] = *(const uint2*)(y1 + c); } }
        FIN_POS(posn, recn, rnc);
        float ss[2];
#pragma unroll
        for (int q = 0; q < 2; ++q) { const float w0 = __int_as_float(rec[q].z), w1 = __int_as_float(rec[q].w); float s = 0.f;
#pragma unroll
            for (int i = 0; i < 4; ++i) { const uint2 a = ya[q][i], b = yb[q][i]; const float4 g = gq[q][i];
                v[q][i].x += g.x * (w0 * BFLO(a.x) + w1 * BFLO(b.x)); v[q][i].y += g.y * (w0 * BFHI(a.x) + w1 * BFHI(b.x)); v[q][i].z += g.z * (w0 * BFLO(a.y) + w1 * BFLO(b.y)); v[q][i].w += g.w * (w0 * BFHI(a.y) + w1 * BFHI(b.y));
                s += v[q][i].x * v[q][i].x + v[q][i].y * v[q][i].y + v[q][i].z * v[q][i].z + v[q][i].w * v[q][i].w; }
            ss[q] = wave_sum(s); }
#pragma unroll
        for (int q = 0; q < 2; ++q) { if (q == 1 && !has1) break;
            float* xr = p.out + (size_t)(r0 + q * stride) * DM; const float rn_ = rsqrtf(ss[q] * (1.0f / 1024.0f) + 1e-6f);
#pragma unroll
            for (int i = 0; i < 4; ++i) { const float4 g = fg[i];
                float4 o; o.x = v[q][i].x * rn_ * g.x; o.y = v[q][i].y * rn_ * g.y; o.z = v[q][i].z * rn_ * g.z; o.w = v[q][i].w * rn_ * g.w; *(float4*)(xr + i * 256 + lane * 4) = o; } }
#pragma unroll
        for (int q = 0; q < 2; ++q) { rec[q] = recn[q]; pos[q][0] = posn[q][0]; pos[q][1] = posn[q][1]; }
    }
#undef FIN_REC
#undef FIN_POS
}

struct EpiStoreBf16 {
    static constexpr bool PERM = true, AFTER_DRAIN = false; bf16_t* O; int ldc;
    __device__ __forceinline__ void operator()(const f32x4 (&acc)[2][2][4][2], const pg8::Unit& u, int wr, int wc, int fr, int fq) const {
        bf16_t* base = O + (size_t)(u.pm * 256 + wr * 64 + fr) * ldc + u.pn * 256 + wc * 32 + 8 * fq;
#pragma unroll
        for (int ai = 0; ai < 2; ++ai)
#pragma unroll
            for (int m = 0; m < 4; ++m) { bf16_t* rowp = base + (size_t)(ai * 128 + m * 16) * ldc;
#pragma unroll
                for (int bj = 0; bj < 2; ++bj) { const f32x4 v0 = acc[ai][bj][m][0], v1 = acc[ai][bj][m][1]; u32x4 w;
                    w.x = pg8::cvt_pk_bf16(v0[0], v0[1]); w.y = pg8::cvt_pk_bf16(v0[2], v0[3]); w.z = pg8::cvt_pk_bf16(v1[0], v1[1]); w.w = pg8::cvt_pk_bf16(v1[2], v1[3]);
                    *(u32x4*)(rowp + bj * 128) = w; } }
    }
};
template <bool F8OUT>
struct EpiSwiglu {
    static constexpr bool PERM = true, AFTER_DRAIN = false; void* U; int ldu, npe;
    __device__ __forceinline__ void operator()(const f32x4 (&acc)[2][2][4][2], const pg8::Unit& u, int wr, int wc, int fr, int fq) const {
        { const int ln_ = (int)__builtin_amdgcn_mbcnt_hi(~0u, __builtin_amdgcn_mbcnt_lo(~0u, 0u)); fr = ln_ & 15; fq = ln_ >> 4; }
        const size_t e0 = (size_t)(u.pm * 256 + wr * 64 + fr) * ldu + (u.pn % npe) * 128 + wc * 32 + 8 * fq;
#pragma unroll
        for (int ai = 0; ai < 2; ++ai)
#pragma unroll
            for (int m = 0; m < 4; ++m) { float o[8];
#pragma unroll
                for (int n = 0; n < 2; ++n)
#pragma unroll
                    for (int i = 0; i < 4; i += 2) { const f32x2_t a2 = {acc[ai][0][m][n][i], acc[ai][0][m][n][i + 1]}, b2 = {acc[ai][1][m][n][i], acc[ai][1][m][n][i + 1]};
                        const f32x2_t t2 = a2 * -1.4426950408889634f; constexpr float s_ = F8OUT ? 1.0f / F8_ASCALE : 1.0f;
                        const f32x2_t e2 = {__builtin_amdgcn_exp2f(t2[0]), __builtin_amdgcn_exp2f(t2[1])}, d2 = e2 * s_ + s_;
                        const f32x2_t r2 = {__builtin_amdgcn_rcpf(d2[0]), __builtin_amdgcn_rcpf(d2[1])}, o2 = (a2 * b2) * r2;
                        o[n * 4 + i] = o2[0]; o[n * 4 + i + 1] = o2[1]; }
                const size_t e = e0 + (size_t)(ai * 128 + m * 16) * ldu;
                if (F8OUT) { uint2 w; w.x = pack4_fp8(o[0], o[1], o[2], o[3]); w.y = pack4_fp8(o[4], o[5], o[6], o[7]);
                    *(uint2*)((unsigned char*)U + e) = w; }
                else { u32x4 w; w.x = pg8::cvt_pk_bf16(o[0], o[1]); w.y = pg8::cvt_pk_bf16(o[2], o[3]); w.z = pg8::cvt_pk_bf16(o[4], o[5]); w.w = pg8::cvt_pk_bf16(o[6], o[7]);
                    *(u32x4*)((bf16_t*)U + e) = w; } }
    }
};
template <bool IN_F32>
struct EpiResidual {
    static constexpr bool PERM = true, AFTER_DRAIN = false; const float* xin; bf16_t* xb; const float* gate;
    __device__ __forceinline__ void operator()(const f32x4 (&acc)[2][2][4][2], const pg8::Unit& u, int wr, int wc, int fr, int fq) const {
        { const int ln_ = (int)__builtin_amdgcn_mbcnt_hi(~0u, __builtin_amdgcn_mbcnt_lo(~0u, 0u)); fr = ln_ & 15; fq = ln_ >> 4; }
        const int cls = u.pm < 64 ? 0 : 1, col0 = u.pn * 256 + wc * 32 + 8 * fq;
        const float* gv = gate + (size_t)cls * 6144 + col0;
        f32x4 g4[2][2];
#pragma unroll
        for (int bj = 0; bj < 2; ++bj)
#pragma unroll
            for (int n = 0; n < 2; ++n) g4[bj][n] = *(const f32x4*)(gv + bj * 128 + n * 4);
        const size_t row0 = (size_t)u.pm * 256 + wr * 64 + fr;
        f32x4 xv[8][2][2]; u32x4 xw[8][2];
#define ER_LD(i) do { const size_t off_ = (row0 + ((i) >> 2) * 128 + ((i) & 3) * 16) * DM + col0; \
            _Pragma("unroll") for (int bj = 0; bj < 2; ++bj) { if (IN_F32) { xv[i][bj][0] = *(const f32x4*)(xin + off_ + bj * 128); xv[i][bj][1] = *(const f32x4*)(xin + off_ + bj * 128 + 4); } \
                                                                else xw[i][bj] = *(const u32x4*)(xb + off_ + bj * 128); } } while (0)
#define ER_ST(i) do { const size_t off_ = (row0 + ((i) >> 2) * 128 + ((i) & 3) * 16) * DM + col0; \
            _Pragma("unroll") for (int bj = 0; bj < 2; ++bj) { f32x4 x0_, x1_; \
                if (IN_F32) { x0_ = xv[i][bj][0]; x1_ = xv[i][bj][1]; } \
                else { const u32x4 w_ = xw[i][bj]; x0_ = (f32x4){BFLO(w_.x), BFHI(w_.x), BFLO(w_.y), BFHI(w_.y)}; x1_ = (f32x4){BFLO(w_.z), BFHI(w_.z), BFLO(w_.w), BFHI(w_.w)}; } \
                const f32x4 o0_ = x0_ + g4[bj][0] * acc[(i) >> 2][bj][(i) & 3][0], o1_ = x1_ + g4[bj][1] * acc[(i) >> 2][bj][(i) & 3][1]; \
                u32x4 ow_; ow_.x = pg8::cvt_pk_bf16(o0_[0], o0_[1]); ow_.y = pg8::cvt_pk_bf16(o0_[2], o0_[3]); ow_.z = pg8::cvt_pk_bf16(o1_[0], o1_[1]); ow_.w = pg8::cvt_pk_bf16(o1_[2], o1_[3]); \
                *(u32x4*)(xb + off_ + bj * 128) = ow_; } } while (0)
        ER_LD(0); ER_LD(1); ER_LD(2);
#pragma unroll
        for (int i = 0; i < 8; ++i) { ER_ST(i); if (i + 3 < 8) ER_LD(i + 3); }
#undef ER_LD
#undef ER_ST
    }
};
struct MoeOrder : pg8::StaticOrder {
    int goff, npe, np0;
    __device__ __forceinline__ bool next(int i, pg8::Unit& u) const {
        int pl, pn;
        if (G == 256) {
            const int xcd = c & 7, slot = c >> 3, sb = i * 8 + xcd, NG = nN >> 2, pg = sb / NG, ng = sb - pg * NG;
            pl = pg * 8 + (slot >> 2); pn = ng * 4 + (slot & 3);
            if (pl >= nM) return false;
        } else { const int L = i * G + c; if (L >= nwg) return false; pl = L / nN; pn = L - pl * nN; }
        const int g = pl >= np0 ? 1 : 0, pm = pl - g * np0; u.pn = pn;
        const LAS int* og = (const LAS int*)(size_t)(unsigned)goff + g * 9;
        const int r = pm * 256; int e = 0;
#pragma unroll
        for (int k = 1; k < 8; ++k) e += (r >= og[k]) ? 1 : 0;
        u.pm = g * (GRP_ROWS / 256) + pm; u.pn += __builtin_amdgcn_readfirstlane(e) * npe; return true;
    }
};
#define GEMM_LDS ((PG8_LAS unsigned char*)lds)
struct EpiInProj {
    static constexpr bool PERM = true, AFTER_DRAIN = false; bf16_t* O; const char* tab;
    __device__ __forceinline__ void operator()(const f32x4 (&acc)[2][2][4][2], const pg8::Unit& u, int wr, int wc, int fr, int fq) const {
        const int row0 = u.pm * 256 + wr * 64 + fr; const bool lat = u.pm < 128;
#pragma unroll
        for (int bj = 0; bj < 2; ++bj) {
            const int s = u.pn * 2 + bj;
            int mode = 0; float scale = 1.0f;
            if (s <= 1) { mode = 1; scale = 0.125f * 1.4426950408889634f; } else if (s == 2) mode = 1;
            else if (s == 4 || s == 5) mode = 2; else if (s == 6 || s == 7) { mode = 2; scale = 0.125f; }
            else if (s == 12 || s == 13) { mode = 3; scale = 0.17677669529663687f * 1.4426950408889634f; } else if (s == 14 || s == 15) mode = 3;
            if (mode == 0) {
                bf16_t* base = O + (size_t)row0 * DIN + s * 128 + wc * 32 + 8 * fq;
#pragma unroll
                for (int ai = 0; ai < 2; ++ai)
#pragma unroll
                    for (int m = 0; m < 4; ++m) { const f32x4 v0 = acc[ai][bj][m][0], v1 = acc[ai][bj][m][1]; u32x4 w;
                        w.x = pg8::cvt_pk_bf16(v0[0], v0[1]); w.y = pg8::cvt_pk_bf16(v0[2], v0[3]); w.z = pg8::cvt_pk_bf16(v1[0], v1[1]); w.w = pg8::cvt_pk_bf16(v1[2], v1[3]);
                        *(u32x4*)(base + (size_t)(ai * 128 + m * 16) * DIN) = w; }
            } else {
                const bool wide = mode != 3; const int half = wide ? 32 : 16, g = wide ? 4 * (wc & 1) + fq : fq;
                const int cbase = s * 128 + (wide ? 64 * (wc >> 1) : 32 * wc) + 4 * g;
                const float* ct = (const float*)(tab + (mode == 1 ? TAB_ATTN : (mode == 2 ? TAB_RET : TAB_DIFF))) + 4 * g; const int tstride = half, tsin = 16384 * half;
                f32x4 csv[8], snv[8];
#pragma unroll
                for (int i = 0; i < 8; ++i) { const int row = row0 + (i >> 2) * 128 + (i & 3) * 16; const float* tp = ct + (size_t)(row & (NSEQ - 1)) * tstride;
                    csv[i] = *(const f32x4*)tp; snv[i] = *(const f32x4*)(tp + tsin); }
                asm volatile("" :: "v"(csv[0]), "v"(csv[1]), "v"(csv[2]), "v"(csv[3]), "v"(csv[4]), "v"(csv[5]), "v"(csv[6]), "v"(csv[7]), "v"(snv[0]), "v"(snv[1]), "v"(snv[2]), "v"(snv[3]), "v"(snv[4]), "v"(snv[5]), "v"(snv[6]), "v"(snv[7]));
#pragma unroll
                for (int ai = 0; ai < 2; ++ai)
#pragma unroll
                    for (int m = 0; m < 4; ++m) { const int row = row0 + ai * 128 + m * 16; const f32x4 v0 = acc[ai][bj][m][0], v1 = acc[ai][bj][m][1];
                        f32x4 cs = {1.f, 1.f, 1.f, 1.f}, sn = {0.f, 0.f, 0.f, 0.f};
                        if (lat) { cs = csv[ai * 4 + m]; sn = snv[ai * 4 + m]; }
                        const f32x4 o1 = (v0 * cs - v1 * sn) * scale, o2 = (v1 * cs + v0 * sn) * scale;
                        bf16_t* op = O + (size_t)row * DIN + cbase;
                        uint2 w1, w2; w1.x = pg8::cvt_pk_bf16(o1[0], o1[1]); w1.y = pg8::cvt_pk_bf16(o1[2], o1[3]); w2.x = pg8::cvt_pk_bf16(o2[0], o2[1]); w2.y = pg8::cvt_pk_bf16(o2[2], o2[3]);
                        *(uint2*)op = w1; *(uint2*)(op + half) = w2; }
            }
        }
    }
};
template <int K>
__device__ __forceinline__ void ctx_gemm_residual(const bf16_t* A, const bf16_t* W, float* xc, const float* gate, int bid, int nb, float* lds) {
    const int tid = TIDX, lane = tid & 63, wid = __builtin_amdgcn_readfirstlane(tid >> 6);
    constexpr int KW = K / 8, NS = KW / 16, CH = (NS % 11 == 0) ? 11 : 8;
    static_assert(K % 128 == 0 && NS % CH == 0, "ctx_gemm_residual: K split");
    LAS float* red = (LAS float*)lds;
    for (int tile = bid; tile < 256; tile += nb) {
        const int row0 = (tile >> 4) * 32, col0 = (tile & 15) * 64;
        const bf16_t* ap = A + (size_t)(row0 + (lane & 31)) * K + wid * KW + (lane >> 5) * 8;
        const bf16_t* bp = W + (size_t)(col0 + (lane & 31)) * K + wid * KW + (lane >> 5) * 8;
        f32x16 c0, c1;
#pragma unroll
        for (int r = 0; r < 16; ++r) { c0[r] = 0.f; c1[r] = 0.f; }
#pragma unroll 1
        for (int s0 = 0; s0 < NS; s0 += CH) {
            bf16x8 af[CH], b0[CH], b1[CH];
#pragma unroll
            for (int i = 0; i < CH; ++i) { af[i] = *(const bf16x8*)(ap + (s0 + i) * 16); b0[i] = *(const bf16x8*)(bp + (s0 + i) * 16); b1[i] = *(const bf16x8*)(bp + (size_t)32 * K + (s0 + i) * 16); }
#pragma unroll
            for (int i = 0; i < CH; ++i) { c0 = __builtin_amdgcn_mfma_f32_32x32x16_bf16(af[i], b0[i], c0, 0, 0, 0); c1 = __builtin_amdgcn_mfma_f32_32x32x16_bf16(af[i], b1[i], c1, 0, 0, 0); }
        }
        __syncthreads();
#pragma unroll
        for (int r = 0; r < 16; ++r) { red[((wid * 2 + 0) * 16 + r) * 64 + lane] = c0[r]; red[((wid * 2 + 1) * 16 + r) * 64 + lane] = c1[r]; }
        __syncthreads();
#pragma unroll
        for (int j = 0; j < 4; ++j) { const int o = tid + 512 * j; float s = 0.f;
#pragma unroll
            for (int w = 0; w < 8; ++w) s += red[w * 2048 + o];
            const int blk = o >> 10, r = (o >> 6) & 15, ln = o & 63, row = crow(r, ln >> 5), col = col0 + blk * 32 + (ln & 31);
            float* x = xc + (size_t)(row0 + row) * DM + col; *x = *x + gate[col] * s; }
    }
    __syncthreads();
}
__device__ __forceinline__ void ph_gemm_in(const Params& p, int l, int bid, int nb, float* lds) {
    char* ws = p.ws; pg8::Gemm g{(const bf16_t*)(ws + OFF_ACT), (const bf16_t*)(ws + OFF_WIN) + (size_t)l * DIN * DM, NROW, DIN, DM};
    pg8::StaticOrder S; S.init(NROW, DIN, nb, bid);
    EpiInProj E{(bf16_t*)(ws + OFF_P), ws + OFF_TAB};
    if (nb == 256 && bid >= 150) { const int v = CV_MOE0 + (l == 0 ? 0 : CV_TA + CV_TB); convert_units(p, lds, v + bid - 150, 106, v + CV_TA, 0, 0); }
    pg8::gemm_phase<EpiInProj, pg8::StaticOrder, true, true>(GEMM_LDS, g, S, E);
}
__device__ __forceinline__ void ph_gemm_out(const Params& p, int l, bool need_ctx, int bid, int nb, float* lds) {
    char* ws = p.ws; const int M = NLAT;
    if (need_ctx) ctx_gemm_residual<DM>((const bf16_t*)(ws + OFF_ACT) + (size_t)NLAT * DM, (const bf16_t*)(ws + OFF_WOUT) + (size_t)l * DM * DM, (float*)(ws + OFF_XC),
                                        (const float*)(ws + OFF_MOD) + (size_t)l * 3 * 6144 + 2048 + 2 * 6144, bid, nb, lds);
    pg8::Gemm g{(const bf16_t*)(ws + OFF_ACT), (const bf16_t*)(ws + OFF_WOUT) + (size_t)l * DM * DM, M, DM, DM};
    pg8::StaticOrder S; S.init(M, DM, nb, bid);
    const float* gate = (const float*)(ws + OFF_MOD) + (size_t)l * 3 * 6144 + 2048; bf16_t* xb = (bf16_t*)(ws + OFF_XB);
    if (l == 0) { EpiResidual<true> E{p.x, xb, gate}; pg8::gemm_phase<EpiResidual<true>, pg8::StaticOrder, true, true>(GEMM_LDS, g, S, E); }
    else { EpiResidual<false> E{nullptr, xb, gate}; pg8::gemm_phase<EpiResidual<false>, pg8::StaticOrder, true, true>(GEMM_LDS, g, S, E); }
}
__device__ __forceinline__ void ph_ffn1(const Params& p, bool need_ctx, int bid, int nb, float* lds) {
    char* ws = p.ws; const int M = need_ctx ? NROW : NLAT;
    pg8::Gemm g{(const bf16_t*)(ws + OFF_ACT), (const bf16_t*)(ws + OFF_WF13), M, 2 * DFF, DM / 2};
    pg8::StaticOrder S; S.init(M, 2 * DFF, nb, bid);
    EpiSwiglu<false> E{(void*)(ws + OFF_P), DFF, 2 * DFF / 256};
    if (nb == 256 && need_ctx && bid >= 44) { const int v = CV_MOE0 + CV_TA; convert_units(p, lds, v + bid - 44, 212, v + CV_TB, 0, 0); }
    pg8::gemm_phase<EpiSwiglu<false>, pg8::StaticOrder, true, true, true>(GEMM_LDS, g, S, E);
}
__device__ __forceinline__ void ph_ffn2(const Params& p, int l, bool need_ctx, int bid, int nb, float* lds) {
    char* ws = p.ws; const int M = NLAT;
    if (need_ctx) ctx_gemm_residual<DFF>((const bf16_t*)(ws + OFF_P) + (size_t)NLAT * DFF, (const bf16_t*)(ws + OFF_WF2), (float*)(ws + OFF_XC),
                                         (const float*)(ws + OFF_MOD) + (size_t)l * 3 * 6144 + 5120 + 2 * 6144, bid, nb, lds);
    pg8::Gemm g{(const bf16_t*)(ws + OFF_P), (const bf16_t*)(ws + OFF_WF2), M, DM, DFF};
    pg8::StaticOrder S; S.init(M, DM, nb, bid);
    EpiResidual<false> E{nullptr, (bf16_t*)(ws + OFF_XB), (const float*)(ws + OFF_MOD) + (size_t)l * 3 * 6144 + 5120};
    pg8::gemm_phase<EpiResidual<false>, pg8::StaticOrder, true, true>(GEMM_LDS, g, S, E);
}
__device__ __forceinline__ MoeOrder moe_order(const int* offs, int npe, int nb, int bid) {
    MoeOrder S; const int r0 = __builtin_amdgcn_readfirstlane(offs[8]), r1 = __builtin_amdgcn_readfirstlane(offs[17]);
    S.init(r0 + r1, npe * 256, nb, bid); S.goff = (int)(unsigned)(size_t)(const LAS int*)offs; S.npe = npe; S.np0 = r0 >> 8; return S;
}
__device__ __forceinline__ void ph_moe1(const Params& p, int bid, int nb, float* lds) {
    char* ws = p.ws; int* offs = (int*)(lds + 32768); __syncthreads(); moe_offsets(p, offs);
    const MoeOrder S = moe_order(offs, 2 * DFE / 256, nb, bid);
    pg8::Gemm gm{(const bf16_t*)(ws + OFF_ASORT), (const bf16_t*)(ws + OFF_WM13), 0, 0, DM / 2};
    EpiSwiglu<true> E{(void*)(ws + OFF_UMOE), DFE, 2 * DFE / 256};
    pg8::gemm_phase<EpiSwiglu<true>, MoeOrder, true, true, true>(GEMM_LDS, gm, S, E);
}
struct EpiMoeOut {
    static constexpr bool PERM = true, AFTER_DRAIN = false; bf16_t* Y; int npe;
    __device__ __forceinline__ void operator()(const f32x4 (&acc)[2][2][4][2], const pg8::Unit& u, int wr, int wc, int fr, int fq) const {
        { const int ln_ = (int)__builtin_amdgcn_mbcnt_hi(~0u, __builtin_amdgcn_mbcnt_lo(~0u, 0u)); fr = ln_ & 15; fq = ln_ >> 4; }
        bf16_t* base = Y + (size_t)(u.pm * 256 + wr * 64 + fr) * DM + (u.pn % npe) * 256 + wc * 32 + 8 * fq;
#pragma unroll
        for (int ai = 0; ai < 2; ++ai)
#pragma unroll
            for (int m = 0; m < 4; ++m) { bf16_t* rowp = base + (size_t)(ai * 128 + m * 16) * DM;
#pragma unroll
                for (int bj = 0; bj < 2; ++bj) { const f32x4 v0 = acc[ai][bj][m][0], v1 = acc[ai][bj][m][1]; u32x4 w;
                    w.x = pg8::cvt_pk_bf16(v0[0], v0[1]); w.y = pg8::cvt_pk_bf16(v0[2], v0[3]); w.z = pg8::cvt_pk_bf16(v1[0], v1[1]); w.w = pg8::cvt_pk_bf16(v1[2], v1[3]);
                    *(u32x4*)(rowp + bj * 128) = w; } }
    }
};
__device__ __forceinline__ void ph_moe2(const Params& p, int bid, int nb, float* lds) {
    char* ws = p.ws; int* offs = (int*)(lds + 32768); __syncthreads(); moe_offsets(p, offs);
    const MoeOrder S = moe_order(offs, DM / 256, nb, bid);
    pg8::Gemm gm{(const bf16_t*)(ws + OFF_UMOE), (const bf16_t*)(ws + OFF_WM2), 0, 0, DFE / 2};
    EpiMoeOut E{(bf16_t*)(ws + OFF_YMOE), DM / 256};
    pg8::gemm_phase<EpiMoeOut, MoeOrder, true, true, true>(GEMM_LDS, gm, S, E);
}

#define XB_TMO      128
#define XB_XCNT(j)  (256  + 64 * (j))
#define XB_XSUB(j)  (1280 + 64 * (j))
#define XB_XGEN(j)  (2304 + 64 * (j))
#define XB_TOP      3328
#define XB_TOPGEN   3392
#define XCD_BAR_WORDS 3456
#define XB_SPIN_CAP (1u << 22)

__device__ __forceinline__ unsigned xb_ld(unsigned* p)              { return __hip_atomic_load(p, __ATOMIC_RELAXED, __HIP_MEMORY_SCOPE_AGENT); }
__device__ __forceinline__ unsigned xb_add(unsigned* p, unsigned v) { return __hip_atomic_fetch_add(p, v, __ATOMIC_RELAXED, __HIP_MEMORY_SCOPE_AGENT); }
__device__ __forceinline__ unsigned xb_xcc_id() { return (unsigned)__builtin_amdgcn_s_getreg((3 << 11) | 20) & 0xFu; }
#define XB_SPIN(cond, bar) do { unsigned _sp = 0; while (cond) { __builtin_amdgcn_s_sleep(1); \
    if ((++_sp & 255u) == 0u) { if (xb_ld(&(bar)[XB_TMO])) break; if (_sp > XB_SPIN_CAP) { atomicAdd(&(bar)[XB_TMO], 1u); break; } } } } while (0)

struct XcdBarrier {
    unsigned* bar; unsigned x;
    volatile LAS unsigned* st;
};

__device__ __forceinline__ XcdBarrier xcd_barrier_post(unsigned* bar, volatile LAS unsigned* st) {
    XcdBarrier b; b.bar = bar; b.x = xb_xcc_id(); b.st = st;
    if (threadIdx.x == 0) (void)xb_add(&bar[XB_XCNT(b.x)], 1u);
    return b;
}
__device__ __forceinline__ void xcd_barrier_complete(unsigned* bar, unsigned x, unsigned& nloc, unsigned& nx) {
    const unsigned G = gridDim.x * gridDim.y * gridDim.z;
    unsigned sum, cnt, mine, sp = 0u;
    for (;;) {
        sum = 0u; cnt = 0u; mine = 0u;
#pragma unroll
        for (unsigned j = 0; j < 16; ++j) { const unsigned c = xb_ld(&bar[XB_XCNT(j)]); sum += c; cnt += (c > 0u) ? 1u : 0u; mine = (j == x) ? c : mine; }
        if (sum == G) break;
        __builtin_amdgcn_s_sleep(1);
        if ((++sp & 255u) == 0u) { if (xb_ld(&bar[XB_TMO])) break; if (sp > XB_SPIN_CAP) { atomicAdd(&bar[XB_TMO], 1u); break; } }
    }
    nloc = mine > 0u ? mine : 1u; nx = cnt > 0u ? cnt : 1u;
}

__device__ __forceinline__ void xcd_barrier(const XcdBarrier& b) {
    asm volatile("s_waitcnt vmcnt(0)" ::: "memory");
    __syncthreads();
    if (threadIdx.x == 0) {
        unsigned* bar = b.bar;
        __builtin_amdgcn_s_waitcnt(0);
        unsigned nloc = b.st[0], nx = b.st[1];
        if (nloc == 0u) { xcd_barrier_complete(bar, b.x, nloc, nx); b.st[0] = nloc; b.st[1] = nx; }
        const unsigned old = xb_add(&bar[XB_XSUB(b.x)], 1u);
        const unsigned gen = old / nloc;
        if (old + 1u == (gen + 1u) * nloc) {
            __builtin_amdgcn_fence(__ATOMIC_RELEASE, "agent");
            asm volatile("s_waitcnt vmcnt(0)" ::: "memory");
            const unsigned og = xb_add(&bar[XB_TOP], 1u);
            const unsigned tg = og / nx;
            if (og + 1u == (tg + 1u) * nx) xb_add(&bar[XB_TOPGEN], 1u);
            else XB_SPIN(xb_ld(&bar[XB_TOPGEN]) == tg, bar);
            __builtin_amdgcn_fence(__ATOMIC_ACQUIRE, "agent");
            xb_add(&bar[XB_XGEN(b.x)], 1u);
            asm volatile("s_waitcnt vmcnt(0)" ::: "memory");
        } else {
            XB_SPIN(xb_ld(&bar[XB_XGEN(b.x)]) == gen, bar);
            __builtin_amdgcn_fence(__ATOMIC_ACQUIRE, "agent");
            asm volatile("s_waitcnt vmcnt(0)" ::: "memory");
        }
    }
    __syncthreads();
}


constexpr int LDS_FLOATS = 33792;
constexpr int LDS_BYTES = LDS_FLOATS * 4 + 16 + 256 + 16;

typedef const __attribute__((address_space(4))) unsigned long long* kargp_t;
typedef __attribute__((address_space(1))) const float* gcf_t;
__device__ __forceinline__ Params load_params(const float* lds) {
    const LAS unsigned* tbl = (const LAS unsigned*)(lds + LDS_FLOATS + 4);
    Params p; const float** f = (const float**)&p;
#pragma unroll
    for (int i = 0; i < (int)(sizeof(Params) / 8); ++i) {
        const unsigned lo = __builtin_amdgcn_readfirstlane(tbl[2 * i]), hi = __builtin_amdgcn_readfirstlane(tbl[2 * i + 1]);
        f[i] = (const float*)(gcf_t)(((unsigned long long)hi << 32) | lo); }
    return p;
}
#define LOADP(name) const Params name = load_params(lds)

template <int l>
__device__ __forceinline__ void run_layer(const XcdBarrier& bar, int bid, int nb, float* lds) {
    constexpr bool need_ctx = l == 0;
    constexpr float lam_init = l == 0 ? 0.2f : 0.35550906759509393f;
    { LOADP(p); ph_norm<false>(p, l, 0, NROW, bid, nb, lds); } xcd_barrier(bar);
    { LOADP(p); ph_gemm_in(p, l, bid, nb, lds); } xcd_barrier(bar);
    { LOADP(p); ph_ret_summ(p, l, bid, nb, lds); } { LOADP(p); ph_lru_chunk<1>(p, l, bid, nb, lds, 0); } xcd_barrier(bar);
    { LOADP(p); ph_scan2(p, l, bid, nb); } xcd_barrier(bar);
    { LOADP(p); ph_diff(p, l, need_ctx, lam_init, bid, nb, lds); }
    { LOADP(p); ph_swa(p, l, need_ctx, bid, nb, lds); }
    { LOADP(p); ph_ret_out(p, l, bid, nb, lds, need_ctx ? 0 : 2); }
    { LOADP(p); ph_lru_chunk<3>(p, l, bid, nb, lds, need_ctx ? 0 : 2); } xcd_barrier(bar);
    { LOADP(p); ph_gemm_out(p, l, need_ctx, bid, nb, lds); } xcd_barrier(bar);
    if (l == 0) {
        { LOADP(p); ph_norm<false>(p, l, 1, NROW, bid, nb, lds); } xcd_barrier(bar);
        { LOADP(p); ph_ffn1(p, need_ctx, bid, nb, lds); } xcd_barrier(bar);
        { LOADP(p); ph_ffn2(p, l, need_ctx, bid, nb, lds); } xcd_barrier(bar);
    } else {
        { LOADP(p); ph_norm<true>(p, l, 1, NLAT, bid, nb, lds); } xcd_barrier(bar);
        { LOADP(p); ph_moe_scatter(p, bid, nb, lds); } xcd_barrier(bar);
        { LOADP(p); ph_moe1(p, bid, nb, lds); } xcd_barrier(bar);
        { LOADP(p); ph_moe2(p, bid, nb, lds); } xcd_barrier(bar);
    }
}

__global__ void __launch_bounds__(512, 2) fwd(Params p_in) {
    extern __shared__ __attribute__((aligned(16))) float lds[];
    volatile LAS unsigned* st = (volatile LAS unsigned*)(lds + LDS_FLOATS);
    if (threadIdx.x == 0) { st[0] = 0u; st[1] = 0u; st[2] = 0u; st[3] = 0u; }
    if (threadIdx.x < (int)(sizeof(Params) / 8)) { const kargp_t q = (kargp_t)__builtin_amdgcn_kernarg_segment_ptr(); ((LAS unsigned long long*)(lds + LDS_FLOATS + 4))[threadIdx.x] = q[threadIdx.x]; }
    __syncthreads();
    XcdBarrier bar;
    { LOADP(p); bar = xcd_barrier_post((unsigned*)p.ws, st); }
    const int bid = blockIdx.x, nb = gridDim.x;
    { LOADP(p); ph_prologue(p, bid, nb, lds); } xcd_barrier(bar);
    run_layer<0>(bar, bid, nb, lds);
    run_layer<1>(bar, bid, nb, lds);
    { LOADP(p); ph_final(p, bid, nb, lds); }
}

extern "C" void kernel_launch(void* const* d_in, const int* in_sizes, int n_in, void* d_out, int out_size, void* d_ws, size_t ws_size, hipStream_t stream) {
    static int grid = 0;
    if (grid == 0) {
        if (n_in < 30 || ws_size < WS_NEED) { fprintf(stderr, "kernel_launch: bad args n_in=%d ws=%zu need=%zu\n", n_in, ws_size, (size_t)WS_NEED); grid = -1; return; }
        int dev = 0, cus = 0, per_cu = 0;
        if (hipGetDevice(&dev) != hipSuccess || hipDeviceGetAttribute(&cus, hipDeviceAttributeMultiprocessorCount, dev) != hipSuccess) { grid = -1; return; }
        if (hipFuncSetAttribute((const void*)fwd, hipFuncAttributeMaxDynamicSharedMemorySize, LDS_BYTES) != hipSuccess) { fprintf(stderr, "kernel_launch: hipFuncSetAttribute failed\n"); grid = -1; return; }
        if (hipOccupancyMaxActiveBlocksPerMultiprocessor(&per_cu, (const void*)fwd, 512, LDS_BYTES) != hipSuccess || per_cu < 1) { fprintf(stderr, "kernel_launch: occupancy query says %d\n", per_cu); per_cu = 1; }
        (void)hipGetLastError();
        grid = cus;
    }
    if (grid < 0) return;
    Params p{};
    const float** f = (const float**)&p;
    for (int i = 0; i < 30; ++i) f[i] = (const float*)d_in[i];
    p.out = (float*)d_out; p.ws = (char*)d_ws;
    (void)hipMemsetAsync(d_ws, 0, 65536, stream);
    hipLaunchKernelGGL(fwd, dim3(grid), dim3(512), LDS_BYTES, stream, p);
}
```

```cpp
#include <hip/hip_runtime.h>
#include <cstdio>
#include <cstdint>

typedef unsigned short bf16_t;
typedef short bf16x8 __attribute__((ext_vector_type(8)));
typedef float f32x4 __attribute__((ext_vector_type(4)));
typedef unsigned u32x4 __attribute__((ext_vector_type(4)));
#define LAS __attribute__((address_space(3)))

constexpr int NB = 2, NSEQ = 16384, NCTX = 256, DM = 1024;
constexpr int NLAT = NB * NSEQ;
constexpr int NCR = NB * NCTX;
constexpr int NROW = NLAT + NCR;
constexpr int DIN = 2816, DFF = 2816, DFE = 3584, NE = 8;
constexpr int NCI = 130;
constexpr int C_AQ = 0, C_AK = 256, C_AV = 384, C_RQ = 512, C_RK = 768, C_RV = 1024, C_RG = 1280, C_DQ = 1536, C_DK = 1792, C_DV = 2048, C_LX = 2304, C_LY = 2560;
constexpr int GRP_ROWS = 34816;

constexpr size_t al256(size_t x) { return (x + 255) & ~(size_t)255; }
constexpr size_t OFF_CTRL = 0;
constexpr size_t OFF_MOD = 65536;
constexpr size_t OFF_TAB = al256(OFF_MOD + 2 * 3 * 6144 * 4);
constexpr size_t TAB_ATTN = 0, TAB_RET = 4u << 20, TAB_DIFF = 8u << 20;
constexpr size_t OFF_XC = al256(OFF_TAB + (10u << 20));
constexpr size_t OFF_ROUTE = al256(OFF_XC + (size_t)NCR * DM * 4);
constexpr size_t OFF_TOK = al256(OFF_ROUTE + (size_t)NLAT * 16);
constexpr size_t OFF_WGT = al256(OFF_TOK + (size_t)2 * GRP_ROWS * 4);
constexpr size_t OFF_LRU = al256(OFF_WGT + (size_t)2 * GRP_ROWS * 4);
constexpr size_t OFF_WM13 = al256(OFF_LRU + (size_t)3 * 2 * 2 * NCI * 256 * 4);
constexpr size_t OFF_WM2 = al256(OFF_WM13 + (size_t)NE * 2 * DFE * DM);
constexpr size_t OFF_XB = al256(OFF_WM2 + (size_t)NE * DM * DFE);
constexpr size_t OFF_R = al256(OFF_XB + (size_t)NLAT * DM * 2);
constexpr size_t OFF_P = OFF_R;
constexpr size_t OFF_ACT = al256(OFF_P + (size_t)NROW * DIN * 2);
constexpr size_t OFF_RET = al256(OFF_ACT + (size_t)NROW * DM * 2);
constexpr size_t OFF_WIN = al256(OFF_RET + (size_t)2 * 2 * NCI * 4 * 4096 * 4);
constexpr size_t OFF_WOUT = al256(OFF_WIN + (size_t)2 * DIN * DM * 2);
constexpr size_t OFF_WF13 = al256(OFF_WOUT + (size_t)2 * DM * DM * 2);
constexpr size_t OFF_WF2 = al256(OFF_WF13 + (size_t)2 * DFF * DM * 2);
constexpr size_t OFF_R_END1 = al256(OFF_WF2 + (size_t)DM * DFF * 2);
constexpr size_t OFF_ASORT = OFF_R;
constexpr size_t OFF_YMOE = OFF_ASORT;
constexpr size_t OFF_UMOE = al256(OFF_ASORT + (size_t)2 * GRP_ROWS * DM * 2);
constexpr size_t OFF_R_END2 = al256(OFF_UMOE + (size_t)GRP_ROWS * DFE * 2);
constexpr size_t WS_NEED = OFF_R_END1 > OFF_R_END2 ? OFF_R_END1 : OFF_R_END2;
static_assert(OFF_ACT >= OFF_UMOE, "H2 must not overlap A_sorted");
constexpr int CW_CNT = 4096;
constexpr int CW_BLK = 8192;

struct Params {
    const float *x, *c, *ctx, *c_ctx, *w_ada, *b_ada, *g1, *g2, *w_in, *w_out, *sink, *ret_logit, *ret_gn, *diff_lam, *diff_gn,
        *conv_w, *conv_b, *lru_wa, *lru_ba, *lru_wx, *lru_bx, *lru_lam, *ffn_w1, *ffn_w3, *ffn_w2, *moe_router, *moe_w1, *moe_w3, *moe_w2, *final_norm;
    float* out; char* ws;
};

__device__ __forceinline__ int ltid_() { int t = threadIdx.x; asm volatile("" : "+v"(t)); return t; }
#define TIDX ltid_()
__device__ __forceinline__ float bf2f(bf16_t h) { return __uint_as_float(((unsigned)h) << 16); }
__device__ __forceinline__ bf16_t f2bf(float f) { unsigned u = __float_as_uint(f); u += 0x7fffu + ((u >> 16) & 1u); return (bf16_t)(u >> 16); }
__device__ __forceinline__ unsigned pack2(float lo, float hi) { return (unsigned)f2bf(lo) | ((unsigned)f2bf(hi) << 16); }
__device__ __forceinline__ unsigned pack4_fp8(float a, float b, float c, float d) {
    a = fminf(fmaxf(a, -440.f), 440.f); b = fminf(fmaxf(b, -440.f), 440.f); c = fminf(fmaxf(c, -440.f), 440.f); d = fminf(fmaxf(d, -440.f), 440.f);
    unsigned w = 0u; w = __builtin_amdgcn_cvt_pk_fp8_f32(a, b, w, false); w = __builtin_amdgcn_cvt_pk_fp8_f32(c, d, w, true); return w;
}
constexpr float F8_WSCALE = 128.0f, F8_ASCALE = 8.0f;
constexpr int F8_WE8M0 = 127 - 7, F8_AE8M0 = 127 - 3, F8_SCALES = F8_WE8M0 | (F8_AE8M0 << 8);
#define BFLO(w) __uint_as_float((w) << 16)
#define BFHI(w) __uint_as_float((w) & 0xffff0000u)
__device__ __forceinline__ float wave_sum(float v) {
#pragma unroll
    for (int o = 32; o >= 1; o >>= 1) v += __shfl_xor(v, o);
    return v;
}
__device__ __forceinline__ float sigmoidf_(float x) { return 1.0f / (1.0f + __expf(-x)); }
__device__ __forceinline__ float siluf_(float x) { return x / (1.0f + __expf(-x)); }
__device__ __forceinline__ float fast_silu(float v) { return v * __builtin_amdgcn_rcpf(1.0f + __expf(-v)); }
__device__ __forceinline__ float softplusf_(float x) { return x > 20.f ? x : log1pf(expf(x)); }
__device__ __forceinline__ float gelu_tanh(float x) { const float u = 0.7978845608028654f * (x + 0.044715f * x * x * x); return x * __builtin_amdgcn_rcpf(1.0f + __expf(-2.0f * u)); }
__device__ __forceinline__ int row_base(int b, int ci) { return ci < 2 ? NLAT + b * NCTX + ci * 128 : b * NSEQ + (ci - 2) * 128; }
__device__ __forceinline__ int mod_class(int row) { return row < NSEQ ? 0 : (row < NLAT ? 1 : 2); }

typedef float f32x16 __attribute__((ext_vector_type(16)));
typedef short s16x4 __attribute__((ext_vector_type(4)));
typedef short v4i16_t __attribute__((ext_vector_type(4)));
typedef float f32x2_t __attribute__((ext_vector_type(2)));
typedef __bf16 bf16x2_t __attribute__((ext_vector_type(2)));
__device__ __forceinline__ unsigned cvtpk_s(float lo, float hi) { f32x2_t v = {lo, hi}; bf16x2_t bb = __builtin_convertvector(v, bf16x2_t); return __builtin_bit_cast(unsigned, bb); }
__device__ __forceinline__ int crow(int r, int hi) { return (r & 3) + 8 * (r >> 2) + 4 * hi; }
__device__ __forceinline__ s16x4 vtr(const LAS char* p) { return __builtin_bit_cast(s16x4, __builtin_amdgcn_ds_read_tr16_b64_v4i16((LAS v4i16_t*)p)); }
__device__ __forceinline__ float bfs(short s) { return __uint_as_float(((unsigned)(unsigned short)s) << 16); }

struct Ct4Regs { float4 a[4], b[4]; };
__device__ __forceinline__ void ct4_load(const float* src, int N, int unit, Ct4Regs& r) {
    const int upn = N / 256, tk = unit / upn, tn4 = unit % upn, t = TIDX, kk = t >> 3, nc = (t & 7) * 8;
#pragma unroll
    for (int q = 0; q < 4; ++q) { const float* sp = src + (size_t)(tk * 64 + kk) * N + tn4 * 256 + q * 64 + nc; r.a[q] = *(const float4*)sp; r.b[q] = *(const float4*)(sp + 4); }
}
__device__ __forceinline__ void ct4_store(const Ct4Regs& r, int K, int N, bf16_t* dst, int unit, int mode_, float* lds) {
    const int upn = N / 256, tk = unit / upn, tn4 = unit % upn, t = TIDX; const bool f8 = (mode_ & 8) != 0; const int mode = mode_ & 7;
    {   const int kk = t >> 3, nc = (t & 7) * 8;
#pragma unroll
        for (int q = 0; q < 4; ++q) { float* d = lds + q * (64 * 65) + kk * 65 + nc; d[0] = r.a[q].x; d[1] = r.a[q].y; d[2] = r.a[q].z; d[3] = r.a[q].w; d[4] = r.b[q].x; d[5] = r.b[q].y; d[6] = r.b[q].z; d[7] = r.b[q].w; } }
    __syncthreads();
    {   const int n = t >> 3, kc = (t & 7) * 8;
#pragma unroll
        for (int q = 0; q < 4; ++q) { const int ng = tn4 * 256 + q * 64 + n; const float* L = lds + q * (64 * 65);
            int nrow;
            if (mode == 3) {
                const int s = ng >> 7; const bool r64 = s <= 2 || (s >= 4 && s <= 7), r32 = s >= 12 && s <= 15;
                if (r64) { const int d = ng & 63; nrow = (ng & ~63) + 8 * ((d & 31) >> 2) + 4 * (d >> 5) + (d & 3); }
                else if (r32) { const int d = ng & 31; nrow = (ng & ~31) + 8 * ((d & 15) >> 2) + 4 * (d >> 4) + (d & 3); }
                else nrow = ng;
            } else nrow = mode == 0 ? ng : ((ng >> 7) * 256 + (mode == 2 ? 128 : 0) + (ng & 127));
            if (f8) { uint2 w; w.x = pack4_fp8(L[(kc + 0) * 65 + n] * F8_WSCALE, L[(kc + 1) * 65 + n] * F8_WSCALE, L[(kc + 2) * 65 + n] * F8_WSCALE, L[(kc + 3) * 65 + n] * F8_WSCALE);
                w.y = pack4_fp8(L[(kc + 4) * 65 + n] * F8_WSCALE, L[(kc + 5) * 65 + n] * F8_WSCALE, L[(kc + 6) * 65 + n] * F8_WSCALE, L[(kc + 7) * 65 + n] * F8_WSCALE);
                *(uint2*)((unsigned char*)dst + (size_t)nrow * K + tk * 64 + kc) = w; }
            else { uint4 w; w.x = pack2(L[(kc + 0) * 65 + n], L[(kc + 1) * 65 + n]); w.y = pack2(L[(kc + 2) * 65 + n], L[(kc + 3) * 65 + n]);
                w.z = pack2(L[(kc + 4) * 65 + n], L[(kc + 5) * 65 + n]); w.w = pack2(L[(kc + 6) * 65 + n], L[(kc + 7) * 65 + n]);
                *(uint4*)(dst + (size_t)nrow * K + tk * 64 + kc) = w; } } }
    __syncthreads();
}

constexpr int CV_T_IN = 16 * 11, CV_T_OUT = 16 * 4, CV_T_F13 = 16 * 11, CV_T_F2 = 44 * 4, CV_T_M13 = 16 * 14, CV_T_M2 = 56 * 4;
constexpr int CV_MOE0 = 2 * CV_T_IN + 2 * CV_T_OUT + 2 * CV_T_F13 + CV_T_F2, CV_TOTAL = CV_MOE0 + 16 * CV_T_M13 + 8 * CV_T_M2, CV_TA = 12 * 106, CV_TB = 4 * 212, CV_TAILS = 2 * CV_TA + CV_TB;
static_assert(CV_MOE0 + CV_TAILS <= CV_TOTAL, "conversion tails");
__device__ __forceinline__ void convert_units(const Params& p, float* lds, int v0, int vstep, int vend, int split, int skip) {
    char* ws = p.ws; const int t = TIDX;
    {
        struct Job { const float* src; bf16_t* dst; int K, N, mode, base; };
        Job* jobs = (Job*)(lds + 4 * 64 * 65);
        const int T_IN = CV_T_IN, T_OUT = CV_T_OUT, T_F13 = CV_T_F13, T_F2 = CV_T_F2, T_M13 = CV_T_M13, T_M2 = CV_T_M2;
        const int total = CV_TOTAL;
        if (t < 32) {
            Job jb; jb.src = nullptr; jb.dst = nullptr; jb.K = DM; jb.N = DM; jb.mode = 0; jb.base = total;
            if (t < 2) { jb.src = p.w_in + (size_t)t * DM * DIN; jb.dst = (bf16_t*)(ws + OFF_WIN) + (size_t)t * DIN * DM; jb.N = DIN; jb.mode = 3; jb.base = t * T_IN; }
            else if (t < 4) { jb.src = p.w_out + (size_t)(t - 2) * DM * DM; jb.dst = (bf16_t*)(ws + OFF_WOUT) + (size_t)(t - 2) * DM * DM; jb.base = 2 * T_IN + (t - 2) * T_OUT; }
            else if (t < 6) { jb.src = t == 4 ? p.ffn_w1 : p.ffn_w3; jb.dst = (bf16_t*)(ws + OFF_WF13); jb.N = DFF; jb.mode = 8 | (t - 3); jb.base = 2 * T_IN + 2 * T_OUT + (t - 4) * T_F13; }
            else if (t == 6) { jb.src = p.ffn_w2; jb.dst = (bf16_t*)(ws + OFF_WF2); jb.K = DFF; jb.base = 2 * T_IN + 2 * T_OUT + 2 * T_F13; }
            else if (t < 23) { const int q = t - 7, e = q & 7, w3 = q >> 3; jb.src = (w3 ? p.moe_w3 : p.moe_w1) + (size_t)e * DM * DFE; jb.dst = (bf16_t*)(ws + OFF_WM13 + (size_t)e * 2 * DFE * DM); jb.N = DFE; jb.mode = 8 | (1 + w3);
                jb.base = 2 * T_IN + 2 * T_OUT + 2 * T_F13 + T_F2 + q * T_M13; }
            else if (t < 31) { const int e = t - 23; jb.src = p.moe_w2 + (size_t)e * DFE * DM; jb.dst = (bf16_t*)(ws + OFF_WM2 + (size_t)e * DM * DFE); jb.K = DFE; jb.mode = 8;
                jb.base = 2 * T_IN + 2 * T_OUT + 2 * T_F13 + T_F2 + 16 * T_M13 + e * T_M2; }
            jobs[t] = jb;
        }
        __syncthreads();
#define JOB_SRC(jj) ((const float*)(__attribute__((address_space(1))) const float*)(unsigned long long)jobs[jj].src)
#define JOB_DST(jj) ((bf16_t*)(__attribute__((address_space(1))) bf16_t*)(unsigned long long)jobs[jj].dst)
#define CV_U(v) ((v) < split ? (v) : (v) + skip)
        int j = 0; Ct4Regs cur, nxt;
        if (v0 < vend) { const int u0 = CV_U(v0); while (u0 >= jobs[j + 1].base) ++j; ct4_load(JOB_SRC(j), jobs[j].N, u0 - jobs[j].base, cur); }
        for (int v = v0; v < vend; v += vstep) {
            const int u = CV_U(v), vn = v + vstep < vend ? v + vstep : v, un = CV_U(vn); int jn = j;
            while (un >= jobs[jn + 1].base) ++jn;
            ct4_load(JOB_SRC(jn), jobs[jn].N, un - jobs[jn].base, nxt);
            ct4_store(cur, jobs[j].K, jobs[j].N, JOB_DST(j), u - jobs[j].base, jobs[j].mode, lds);
            cur = nxt; j = jn;
        }
#undef JOB_SRC
#undef JOB_DST
#undef CV_U
        __syncthreads();
    }
}

__device__ __forceinline__ void ph_prologue(const Params& p, int bid, int nb, float* lds) {
    char* ws = p.ws; const int t = TIDX;
    { const bool tails = nb == 256; convert_units(p, lds, bid, nb, tails ? CV_TOTAL - CV_TAILS : CV_TOTAL, CV_MOE0, tails ? CV_TAILS : 0); }
    {
        float* sv = lds;
        float* red = lds + 3072;
        for (int i = t; i < 3072; i += 512) { const int v = i >> 10, k = i & 1023; const float cv = v < 2 ? p.c[v * DM + k] : p.c_ctx[k]; sv[i] = siluf_(cv); }
        __syncthreads();
        float* mod = (float*)(ws + OFF_MOD);
        for (int u = bid; u < 2 * 96; u += nb) {
            const int l = u / 96, j0 = (u % 96) * 64, j = t & 63, kg = t >> 6;
            float a0 = 0.f, a1 = 0.f, a2 = 0.f;
            const float* w = p.w_ada + (size_t)l * DM * 6144 + j0 + j;
            for (int k = kg * 128; k < kg * 128 + 128; ++k) { const float wv = w[(size_t)k * 6144]; a0 += sv[k] * wv; a1 += sv[1024 + k] * wv; a2 += sv[2048 + k] * wv; }
            red[(kg * 3 + 0) * 64 + j] = a0; red[(kg * 3 + 1) * 64 + j] = a1; red[(kg * 3 + 2) * 64 + j] = a2;
            __syncthreads();
            if (t < 192) { const int v = t >> 6; float s = 0.f;
                for (int g = 0; g < 8; ++g) s += red[(g * 3 + v) * 64 + j];
                mod[((size_t)l * 3 + v) * 6144 + j0 + j] = s + p.b_ada[l * 6144 + j0 + j]; }
            __syncthreads();
        }
    }
    {
        const int gt = bid * 512 + t, gs = nb * 512;
        float* ta = (float*)(ws + OFF_TAB + TAB_ATTN); float* tr = (float*)(ws + OFF_TAB + TAB_RET); float* td = (float*)(ws + OFF_TAB + TAB_DIFF);
        const int j = gt & 31;
        const float inv_r = (float)pow(10000.0, -(double)j / 32.0), inv_a = (float)pow(10000.0, -(double)(j & 15) / 16.0), inv_d = (float)pow(10000.0, -(double)(j & 7) / 8.0);
        for (int i = gt; i < 16384 * 32; i += gs) { const int n = i >> 5; double sv, cv;
            { const float ang = (float)n * inv_r; sincos((double)ang, &sv, &cv); tr[i] = (float)cv; tr[16384 * 32 + i] = (float)sv; }
            { const float ang = (float)(j < 16 ? (n >> 6) : (n & 63)) * inv_a; sincos((double)ang, &sv, &cv); ta[i] = (float)cv; ta[16384 * 32 + i] = (float)sv; }
            if (j < 16) { const float ang = (float)(j < 8 ? (n >> 6) : (n & 63)) * inv_d; sincos((double)ang, &sv, &cv); td[n * 16 + j] = (float)cv; td[16384 * 16 + n * 16 + j] = (float)sv; } }
        float* xc = (float*)(ws + OFF_XC);
        for (int i = gt; i < NCR * DM / 4; i += gs) ((float4*)xc)[i] = ((const float4*)p.ctx)[i];
    }
}

template <bool ROUTE>
__device__ __forceinline__ void ph_norm(const Params& p, int l, int which  , int nrows, int bid, int nb, float* lds) {
    char* ws = p.ws; const int lane = TIDX & 63, wv = TIDX >> 6;
    LAS unsigned* lcnt = (LAS unsigned*)lds;
    if (ROUTE) { __syncthreads(); if (TIDX < 16) lcnt[TIDX] = 0u; __syncthreads(); }
    const float* mod = (const float*)(ws + OFF_MOD) + (size_t)l * 3 * 6144;
    const float* g = (which == 0 ? p.g1 : p.g2) + l * DM;
    bf16_t* H = (bf16_t*)(ws + OFF_ACT);
    const bool xin32 = which == 0 && l == 0;
    const float* xl = p.x; const bf16_t* xb = (const bf16_t*)(ws + OFF_XB);
    const float* xc = (const float*)(ws + OFF_XC);
    const int stride = nb * 8;
    float rw[ROUTE ? 4 : 1][4][8];
    if (ROUTE) {
#pragma unroll
        for (int i = 0; i < 4; ++i) { const float* rt = p.moe_router + (size_t)(i * 256 + lane * 4) * 8;
#pragma unroll
            for (int k = 0; k < 4; ++k) { const float4 a = *(const float4*)(rt + k * 8), b = *(const float4*)(rt + k * 8 + 4);
                rw[i][k][0] = a.x; rw[i][k][1] = a.y; rw[i][k][2] = a.z; rw[i][k][3] = a.w; rw[i][k][4] = b.x; rw[i][k][5] = b.y; rw[i][k][6] = b.z; rw[i][k][7] = b.w; } } }
    float4 ma[4], mb[4]; int ccls = -1;
    constexpr int NQ = ROUTE ? 1 : 2;
    for (int r0 = bid * 8 + wv; r0 < nrows; r0 += NQ * stride) {
        float4 v[NQ][4]; float ss[NQ]; const bool has1 = NQ == 2 && r0 + stride < nrows;
#pragma unroll
        for (int q = 0; q < NQ; ++q) { const int r = (q == 0 || has1) ? r0 + q * stride : r0;
            if (xin32 || r >= NLAT) { const float* xr = r < NLAT ? xl + (size_t)r * DM : xc + (size_t)(r - NLAT) * DM;
#pragma unroll
                for (int i = 0; i < 4; ++i) v[q][i] = *(const float4*)(xr + i * 256 + lane * 4); }
            else { const bf16_t* xr = xb + (size_t)r * DM;
#pragma unroll
                for (int i = 0; i < 4; ++i) { const uint2 w = *(const uint2*)(xr + i * 256 + lane * 4); v[q][i] = make_float4(BFLO(w.x), BFHI(w.x), BFLO(w.y), BFHI(w.y)); } } }
#pragma unroll
        for (int q = 0; q < NQ; ++q) { float s = 0.f;
#pragma unroll
            for (int i = 0; i < 4; ++i) s += v[q][i].x * v[q][i].x + v[q][i].y * v[q][i].y + v[q][i].z * v[q][i].z + v[q][i].w * v[q][i].w;
            ss[q] = wave_sum(s); }
#pragma unroll
        for (int q = 0; q < NQ; ++q) {
            if (q == 1 && !has1) break;
            const int r = r0 + q * stride;
            const int cls = __builtin_amdgcn_readfirstlane(mod_class(r));
            if (cls != ccls) { const float* mv = mod + (size_t)cls * 6144 + (which == 0 ? 0 : 3072); ccls = cls;
#pragma unroll
                for (int i = 0; i < 4; ++i) { const int c = i * 256 + lane * 4; const float4 gg = *(const float4*)(g + c), sh = *(const float4*)(mv + c), sc = *(const float4*)(mv + 1024 + c);
                    ma[i] = make_float4(gg.x * (1.f + sc.x), gg.y * (1.f + sc.y), gg.z * (1.f + sc.z), gg.w * (1.f + sc.w)); mb[i] = sh; } }
            const float rn = rsqrtf(ss[q] * (1.0f / 1024.0f) + 1e-6f);
            float lg[8];
            if (ROUTE) {
#pragma unroll
                for (int e = 0; e < 8; ++e) lg[e] = 0.f;
            }
#pragma unroll
            for (int i = 0; i < 4; ++i) {
                const int c = i * 256 + lane * 4;
                float h0 = v[q][i].x * rn * ma[i].x + mb[i].x, h1 = v[q][i].y * rn * ma[i].y + mb[i].y;
                float h2 = v[q][i].z * rn * ma[i].z + mb[i].z, h3 = v[q][i].w * rn * ma[i].w + mb[i].w;
                if (which == 1) *(unsigned*)((unsigned char*)H + (size_t)r * DM + c) = pack4_fp8(h0 * F8_ASCALE, h1 * F8_ASCALE, h2 * F8_ASCALE, h3 * F8_ASCALE);
                else { uint2 w; w.x = pack2(h0, h1); w.y = pack2(h2, h3); *(uint2*)(H + (size_t)r * DM + c) = w; }
                if (ROUTE) {
#pragma unroll
                    for (int e = 0; e < 8; ++e) lg[e] += h0 * rw[ROUTE ? i : 0][0][e] + h1 * rw[ROUTE ? i : 0][1][e] + h2 * rw[ROUTE ? i : 0][2][e] + h3 * rw[ROUTE ? i : 0][3][e];
                }
            }
            if (ROUTE) {
#pragma unroll
                for (int e = 0; e < 8; ++e) lg[e] = wave_sum(lg[e]);
                if (lane == 0 && r < NLAT) {
                    int e0 = 0; float v0 = lg[0];
#pragma unroll
                    for (int e = 1; e < 8; ++e) if (lg[e] > v0) { v0 = lg[e]; e0 = e; }
                    int e1 = -1; float v1 = -3.0e38f;
#pragma unroll
                    for (int e = 0; e < 8; ++e) if (e != e0 && lg[e] > v1) { v1 = lg[e]; e1 = e; }
                    const float ex = __expf(v1 - v0), w0 = 1.0f / (1.0f + ex), w1 = ex / (1.0f + ex);
                    const unsigned li0 = __hip_atomic_fetch_add(lcnt + e0, 1u, __ATOMIC_RELAXED, __HIP_MEMORY_SCOPE_WORKGROUP), li1 = __hip_atomic_fetch_add(lcnt + 8 + e1, 1u, __ATOMIC_RELAXED, __HIP_MEMORY_SCOPE_WORKGROUP);
                    int4 rec; rec.x = e0 | (int)(li0 << 4); rec.y = e1 | (int)(li1 << 4); rec.z = __float_as_int(w0); rec.w = __float_as_int(w1);
                    *(int4*)(ws + OFF_ROUTE + (size_t)r * 16) = rec;
                }
            }
        }
    }
    if (ROUTE) {
        __syncthreads();
        if (TIDX < 16) { unsigned* cw = (unsigned*)ws; const int t = TIDX; cw[CW_BLK + bid * 16 + t] = atomicAdd(cw + CW_CNT + t, lcnt[t]); }
    }
}

namespace pg8 {
#define PG8_LAS __attribute__((address_space(3)))
typedef unsigned short bf16_t;
typedef short bf16x8 __attribute__((ext_vector_type(8)));
typedef float f32x4 __attribute__((ext_vector_type(4)));
typedef unsigned u32x4 __attribute__((ext_vector_type(4)));
constexpr int BM = 256, BK = 64, HALF = 128, HTB = HALF * BK * 2  , STAGE_BYTES = 8 * HTB, NXCD = 8, WGM = 8;

__host__ __device__ __forceinline__ int lds_byte(int r, int c) { const int st = (r >> 4) * 2 + (c >> 5), rr = r & 15, cc = c & 31, ob = rr * 64 + cc * 2; return st * 1024 + (ob ^ (((ob >> 9) & 1) << 5)); }
__host__ __device__ __forceinline__ void stage_rc(int b, int& R, int& C) { const int st = b / 1024, sb = b % 1024, swz = sb ^ (((sb >> 9) & 1) << 5); R = (st >> 1) * 16 + swz / 64; C = (st & 1) * 32 + (swz % 64) / 2; }
__host__ __device__ __forceinline__ int perm32(int rho) { const int n = rho >> 4, i = rho & 15; return 8 * (i >> 2) + 4 * n + (i & 3); }

struct Unit { int pm, pn; };
struct Gemm { const bf16_t* A; const bf16_t* Bt; int M, N, K; };

struct StaticOrder {
    int nM, nN, nwg, G, c;
    __host__ __device__ void init(int M, int N, int G_, int c_) { nM = M / BM; nN = N / BM; nwg = nM * nN; G = G_; c = c_; }
    __host__ __device__ bool next(int i, Unit& u) const {
        const long L = (long)i * G + c; if (L >= nwg) return false;
        int wgid = (int)L; { const int q = nwg / NXCD, r = nwg % NXCD, xcd = wgid % NXCD, off = wgid / NXCD; wgid = (xcd < r ? xcd * (q + 1) : r * (q + 1) + (xcd - r) * q) + off; }
        const int nig = WGM * nN, gid = wgid / nig, fm = gid * WGM, gsz = (nM - fm) < WGM ? (nM - fm) : WGM;
        u.pm = fm + ((wgid % nig) % gsz); u.pn = (wgid % nig) / gsz; return true;
    }
    __device__ __forceinline__ void a_ready(const Unit&) const {}
    __device__ __forceinline__ void done(const Unit&) const {}
};
__device__ __forceinline__ unsigned cvt_pk_bf16(float lo, float hi) { unsigned r; asm volatile("v_cvt_pk_bf16_f32 %0, %1, %2" : "=v"(r) : "v"(lo), "v"(hi)); return r; }
typedef float f32x2 __attribute__((ext_vector_type(2)));
typedef int i32x4_t __attribute__((ext_vector_type(4)));
typedef int i32x8_t __attribute__((ext_vector_type(8)));
__device__ __forceinline__ i32x8_t cat8(bf16x8 lo, bf16x8 hi) { const i32x4_t a = __builtin_bit_cast(i32x4_t, lo), b = __builtin_bit_cast(i32x4_t, hi); return __builtin_shufflevector(a, b, 0, 1, 2, 3, 4, 5, 6, 7); }
template <class Epi, class Sched, bool ALIGN_EPI = false, bool SP2 = false, bool F8 = false>
__device__ __forceinline__ void gemm_phase(PG8_LAS unsigned char* lds, const Gemm g, const Sched& S, const Epi& E) {
    int tid_ = threadIdx.x; asm volatile("" : "+v"(tid_));
    const int tid = tid_, wid = __builtin_amdgcn_readfirstlane(tid >> 6), lane = tid & 63, wr = wid >> 2, wc = wid & 3, fr = lane & 15, fq = lane >> 4;
    const int K = g.K, nt = K / BK;
    unsigned voffA[1], voffB[1];
    { int R, C; stage_rc(tid * 16, R, C); const int Rb = Epi::PERM ? ((R & ~31) + perm32(R & 31)) : R;
        voffA[0] = (unsigned)(R * K + C) * 2u; voffB[0] = (unsigned)(Rb * K + C) * 2u; }
    const size_t pstep = (size_t)64 * K * 2;
    const size_t kstep = (size_t)(BK * 2);
    const size_t hstep = (size_t)HALF * K * 2;
    const size_t tstep = 2 * hstep;
    const unsigned ldsw = (unsigned)wid * 1024u;
    const int aoff = lds_byte(wr * 64 + fr, fq * (F8 ? 16 : 8)), boff = lds_byte(wc * 32 + fr, fq * (F8 ? 16 : 8));
#define PG8_SA(b, h) (((b) * 2 + (h)) * HTB)
#define PG8_SB(b, h) ((4 + (b) * 2 + (h)) * HTB)
#define PG8_STAGE(bufoff, gbase, voff) do { _Pragma("unroll") for (int _i = 0; _i < 2; ++_i) { unsigned vo_ = (voff)[0]; asm volatile("" : "+v"(vo_));   \
        __builtin_amdgcn_global_load_lds((const unsigned*)((const char*)(gbase) + _i * pstep + vo_), (PG8_LAS unsigned*)(lds + (bufoff) + ldsw + _i * 8192), 16, 0, 0); } } while (0)
#define PG8_LDA(dst, b, h) do { _Pragma("unroll") for (int m = 0; m < 4; ++m) { \
        if constexpr (F8) dst##8[m] = cat8(*(const PG8_LAS bf16x8*)(lds + PG8_SA(b, h) + aoff + m * 2048), *(const PG8_LAS bf16x8*)(lds + PG8_SA(b, h) + aoff + m * 2048 + 16)); \
        else { _Pragma("unroll") for (int k = 0; k < 2; ++k) dst[m][k] = *(const PG8_LAS bf16x8*)(lds + PG8_SA(b, h) + aoff + m * 2048 + k * 1024); } } } while (0)
#define PG8_LDB(dst, b, h) do { _Pragma("unroll") for (int n = 0; n < 2; ++n) { \
        if constexpr (F8) dst##8[n] = cat8(*(const PG8_LAS bf16x8*)(lds + PG8_SB(b, h) + boff + n * 2048), *(const PG8_LAS bf16x8*)(lds + PG8_SB(b, h) + boff + n * 2048 + 16)); \
        else { _Pragma("unroll") for (int k = 0; k < 2; ++k) dst[n][k] = *(const PG8_LAS bf16x8*)(lds + PG8_SB(b, h) + boff + n * 2048 + k * 1024); } } } while (0)
#define PG8_MMA(ai, bj, At, Bt) do { __builtin_amdgcn_s_setprio(1); _Pragma("unroll") for (int m = 0; m < 4; ++m) _Pragma("unroll") for (int n = 0; n < 2; ++n) { \
        if constexpr (F8) acc[ai][bj][m][n] = __builtin_amdgcn_mfma_scale_f32_16x16x128_f8f6f4(Bt##8[n], At##8[m], acc[ai][bj][m][n], 0, 0, 0, F8_SCALES, 1, F8_SCALES); \
        else { _Pragma("unroll") for (int k = 0; k < 2; ++k) acc[ai][bj][m][n] = __builtin_amdgcn_mfma_f32_16x16x32_bf16(Bt[n][k], At[m][k], acc[ai][bj][m][n], 0, 0, 0); } } \
        __builtin_amdgcn_s_setprio(0); } while (0)
#define PG8_WAIT_V(n) asm volatile("s_waitcnt vmcnt(" #n ")" ::: "memory")
#define PG8_WAIT_L(n) asm volatile("s_waitcnt lgkmcnt(" #n ")" ::: "memory")
#define PG8_BAR __builtin_amdgcn_s_barrier()
#define PG8_SCHED __builtin_amdgcn_sched_barrier(0)
    Unit cur, nxt; int ui = 0;
    if (!S.next(0, cur)) return;
    f32x4 acc[2][2][4][2];
#pragma unroll
    for (int a = 0; a < 2; ++a)
#pragma unroll
        for (int b = 0; b < 2; ++b)
#pragma unroll
            for (int m = 0; m < 4; ++m)
#pragma unroll
                for (int n = 0; n < 2; ++n) acc[a][b][m][n] = (f32x4){0.f, 0.f, 0.f, 0.f};
    bf16x8 At[4][2], B0[2][2], B1[2][2]; i32x8_t At8[4], B08[2], B18[2];
    const char* cA = (const char*)g.A + (size_t)cur.pm * tstep; const char* cB = (const char*)g.Bt + (size_t)cur.pn * tstep;
    S.a_ready(cur);
    if constexpr (SP2) {
        PG8_STAGE(PG8_SB(0, 0), cB, voffB); PG8_STAGE(PG8_SB(0, 1), cB + hstep, voffB); PG8_STAGE(PG8_SA(0, 0), cA, voffA); PG8_STAGE(PG8_SA(0, 1), cA + hstep, voffA);
        if (wr == 1) PG8_BAR;
        PG8_WAIT_V(2); PG8_BAR;
        PG8_STAGE(PG8_SB(1, 0), cB + kstep, voffB); PG8_STAGE(PG8_SA(1, 0), cA + kstep, voffA); PG8_STAGE(PG8_SB(1, 1), cB + hstep + kstep, voffB);
        PG8_WAIT_V(6); PG8_BAR;
    } else {
        PG8_STAGE(PG8_SB(0, 0), cB, voffB); PG8_STAGE(PG8_SA(0, 0), cA, voffA); PG8_STAGE(PG8_SB(0, 1), cB + hstep, voffB); PG8_STAGE(PG8_SA(0, 1), cA + hstep, voffA);
        if (wr == 1) PG8_BAR;
        PG8_WAIT_V(4); PG8_BAR;
        PG8_STAGE(PG8_SB(1, 0), cB + kstep, voffB); PG8_STAGE(PG8_SA(1, 0), cA + kstep, voffA); PG8_STAGE(PG8_SB(1, 1), cB + hstep + kstep, voffB);
        PG8_WAIT_V(6); PG8_BAR;
    }
    for (;;) {
        const bool has_next = S.next(ui + 1, nxt);
        const char* nA = has_next ? (const char*)g.A + (size_t)nxt.pm * tstep : cA; const char* nB = has_next ? (const char*)g.Bt + (size_t)nxt.pn * tstep : cB;
#pragma unroll 1
        for (int t = 0; t < nt; t += 2) {
            const bool last = (t == nt - 2);
            const char* a1 = cA + (size_t)(t + 1) * kstep;
            const char* a2 = last ? nA : cA + (size_t)(t + 2) * kstep; const char* b2 = last ? nB : cB + (size_t)(t + 2) * kstep;
            const char* a3 = a2 + kstep; const char* b3 = b2 + kstep;
            if (last && has_next) S.a_ready(nxt);
            if constexpr (SP2) {
            PG8_LDB(B0, 0, 0); PG8_LDB(B1, 0, 1); PG8_SCHED; PG8_LDA(At, 0, 0); PG8_STAGE(PG8_SA(1, 1), a1 + hstep, voffA);
            PG8_WAIT_V(8); PG8_WAIT_L(0); PG8_BAR; PG8_MMA(0, 0, At, B0); PG8_MMA(0, 1, At, B1); PG8_BAR; PG8_SCHED;
            PG8_LDA(At, 0, 1); PG8_STAGE(PG8_SB(0, 0), b2, voffB); PG8_STAGE(PG8_SB(0, 1), b2 + hstep, voffB); PG8_STAGE(PG8_SA(0, 0), a2, voffA);
            PG8_WAIT_V(8); PG8_WAIT_L(0); PG8_BAR; PG8_MMA(1, 0, At, B0); PG8_MMA(1, 1, At, B1); PG8_BAR; PG8_SCHED;
            PG8_LDB(B0, 1, 0); PG8_LDB(B1, 1, 1); PG8_SCHED; PG8_LDA(At, 1, 0); PG8_STAGE(PG8_SA(0, 1), a2 + hstep, voffA);
            PG8_WAIT_V(8); PG8_WAIT_L(0); PG8_BAR; PG8_MMA(0, 0, At, B0); PG8_MMA(0, 1, At, B1); PG8_BAR; PG8_SCHED;
            PG8_LDA(At, 1, 1); PG8_STAGE(PG8_SB(1, 0), b3, voffB); PG8_STAGE(PG8_SB(1, 1), b3 + hstep, voffB); PG8_STAGE(PG8_SA(1, 0), a3, voffA);
            PG8_WAIT_V(8); PG8_WAIT_L(0); PG8_BAR; PG8_MMA(1, 0, At, B0); PG8_MMA(1, 1, At, B1); PG8_BAR; PG8_SCHED;
            } else {
            PG8_LDB(B0, 0, 0); PG8_SCHED; PG8_LDA(At, 0, 0); PG8_STAGE(PG8_SA(1, 1), a1 + hstep, voffA);
            PG8_WAIT_L(8); PG8_BAR; PG8_WAIT_L(0); PG8_MMA(0, 0, At, B0); PG8_BAR; PG8_SCHED;
            PG8_LDB(B1, 0, 1); PG8_STAGE(PG8_SB(0, 0), b2, voffB);
            PG8_BAR; PG8_WAIT_L(0); PG8_MMA(0, 1, At, B1); PG8_BAR;
            PG8_LDA(At, 0, 1); PG8_STAGE(PG8_SA(0, 0), a2, voffA);
            PG8_BAR; PG8_WAIT_L(0); PG8_MMA(1, 0, At, B0); PG8_BAR; PG8_SCHED;
            PG8_STAGE(PG8_SB(0, 1), b2 + hstep, voffB);
            PG8_WAIT_V(6); PG8_BAR; PG8_MMA(1, 1, At, B1); PG8_BAR;
            PG8_LDB(B0, 1, 0); PG8_SCHED; PG8_LDA(At, 1, 0); PG8_STAGE(PG8_SA(0, 1), a2 + hstep, voffA);
            PG8_WAIT_L(8); PG8_BAR; PG8_WAIT_L(0); PG8_MMA(0, 0, At, B0); PG8_BAR; PG8_SCHED;
            PG8_LDB(B1, 1, 1); PG8_STAGE(PG8_SB(1, 0), b3, voffB);
            PG8_BAR; PG8_WAIT_L(0); PG8_MMA(0, 1, At, B1); PG8_BAR;
            PG8_LDA(At, 1, 1); PG8_STAGE(PG8_SA(1, 0), a3, voffA);
            PG8_BAR; PG8_WAIT_L(0); PG8_MMA(1, 0, At, B0); PG8_BAR; PG8_SCHED;
            PG8_STAGE(PG8_SB(1, 1), b3 + hstep, voffB);
            PG8_WAIT_V(6); PG8_BAR; PG8_MMA(1, 1, At, B1); PG8_BAR;
            }
        }
        if constexpr (ALIGN_EPI) { if (wr == 0) PG8_BAR; }
        if constexpr (!Epi::AFTER_DRAIN) { E(acc, cur, wr, wc, fr, fq); S.done(cur); }
        if (!has_next) break;
#pragma unroll
        for (int a = 0; a < 2; ++a)
#pragma unroll
            for (int b = 0; b < 2; ++b)
#pragma unroll
                for (int m = 0; m < 4; ++m)
#pragma unroll
                    for (int n = 0; n < 2; ++n) acc[a][b][m][n] = (f32x4){0.f, 0.f, 0.f, 0.f};
        cur = nxt; cA = nA; cB = nB; ++ui;
        if constexpr (ALIGN_EPI) { if (wr == 1) PG8_BAR; }
    }
    PG8_WAIT_V(0);
    if constexpr (!ALIGN_EPI) { if (wr == 0) PG8_BAR; }
    PG8_BAR;
    if constexpr (Epi::AFTER_DRAIN) { E.fused(acc, cur, wr, wc, fr, fq, lds, wid, lane); S.done(cur); }
#undef PG8_SA
#undef PG8_SB
#undef PG8_STAGE
#undef PG8_LDA
#undef PG8_LDB
#undef PG8_MMA
#undef PG8_WAIT_V
#undef PG8_WAIT_L
#undef PG8_BAR
#undef PG8_SCHED
}
}

constexpr int RT_K = 0, RT_V = 32768, RT_ST = 65536;
template <bool KV> __device__ __forceinline__ void ret_stage(const bf16_t* P, int rb, int hp, LAS char* sm, int tid, int wid, int lane) {
    const int vrow = 16 * (wid & 3) + (lane >> 2), vc = (wid >> 2) * 32 + (lane & 3) * 8;
    u32x4 kk[4], vv[4];
#pragma unroll
    for (int i = 0; i < 4; ++i) { const int hh = i >> 1, tt = i & 1, h = 2 * hp + hh, r0 = rb + tt * 64;
        vv[i] = *(const u32x4*)(P + (size_t)(r0 + vrow) * DIN + C_RV + h * 64 + vc);
        kk[i] = KV ? *(const u32x4*)(P + (size_t)(r0 + vrow) * DIN + C_RK + h * 64 + vc) : *(const u32x4*)(P + (size_t)(r0 + lane) * DIN + C_RK + h * 64 + wid * 8); }
#pragma unroll
    for (int i = 0; i < 4; ++i) { *(LAS u32x4*)(sm + RT_K + i * 8192 + tid * 16) = kk[i]; *(LAS u32x4*)(sm + RT_V + i * 8192 + tid * 16) = vv[i]; }
}
constexpr int CW_QUE = 6016;
constexpr int QUE_LDS_WORD = 33792 + 4 + 64;
struct UnitQ { unsigned* ctr; int pend; };
__device__ __forceinline__ void q_prefetch(UnitQ& q) { if (TIDX == 0) q.pend = (int)atomicAdd(q.ctr, 1u); }
__device__ __forceinline__ int q_take(UnitQ& q, float* lds) {
    LAS int* slot = (LAS int*)lds + QUE_LDS_WORD;
    __syncthreads();
    if (TIDX == 0) *slot = q.pend;
    __syncthreads();
    return __builtin_amdgcn_readfirstlane(*slot);
}
__device__ __forceinline__ float ret_lg(const Params& p, int l, int dir, int h) { return -softplusf_(-p.ret_logit[(l * 2 + dir) * 4 + h]); }
__device__ __forceinline__ void ph_ret_summ(const Params& p, int l, int bid, int nb, float* lds) {
    char* ws = p.ws; const int tid = TIDX, lane = tid & 63, r32 = lane & 31, hi = lane >> 5, wid = __builtin_amdgcn_readfirstlane(tid >> 6);
    const bf16_t* P = (const bf16_t*)(ws + OFF_P); float* RET = (float*)(ws + OFF_RET);
    LAS char* sm = (LAS char*)lds;
    UnitQ uq{(unsigned*)ws + CW_QUE + l * 16 + 2, 0}; q_prefetch(uq);
    for (int u = q_take(uq, lds); u < 2 * NCI * 2; u = q_take(uq, lds)) {
        q_prefetch(uq);
        const int hp = u & 1, ci = (u >> 1) % NCI, b = (u >> 1) / NCI, rb = row_base(b, ci);
        __syncthreads();
        ret_stage<true>(P, rb, hp, sm, tid, wid, lane);
        __syncthreads();
        const int hh = wid >> 2, dh = (wid >> 1) & 1, eh = wid & 1, h = 2 * hp + hh;
        const float lg2f = ret_lg(p, l, 0, h) * 1.4426950408889634f, lg2b = ret_lg(p, l, 1, h) * 1.4426950408889634f;
        const int voff = ((lane >> 4) & 1) * 32 + (lane & 3) * 8 + (4 * hi + ((lane & 15) >> 2)) * 64;
        const LAS char* Kb = sm + RT_K + hh * 16384 + dh * 4096 + voff; const LAS char* Vb = sm + RT_V + hh * 16384 + eh * 4096 + voff;
        f32x16 a0, a1;
#pragma unroll
        for (int r = 0; r < 16; ++r) { a0[r] = 0.f; a1[r] = 0.f; }
#pragma unroll
        for (int k8 = 0; k8 < 8; ++k8) { const int tt = k8 >> 2, sl = k8 & 3;
            const s16x4 klo = vtr(Kb + tt * 8192 + sl * 1024), khi = vtr(Kb + tt * 8192 + sl * 1024 + 512), vlo = vtr(Vb + tt * 8192 + sl * 1024), vhi = vtr(Vb + tt * 8192 + sl * 1024 + 512);
            const int mb = tt * 64 + sl * 16 + 4 * hi; float kf_[8], kb_[8];
#pragma unroll
            for (int j = 0; j < 8; ++j) { const int m = mb + (j < 4 ? j : j + 4); const float kv = bfs(j < 4 ? klo[j] : khi[j - 4]);
                kf_[j] = kv * __builtin_amdgcn_exp2f(lg2f * (float)(127 - m)); kb_[j] = kv * __builtin_amdgcn_exp2f(lg2b * (float)m); }
            const u32x4 af = {cvtpk_s(kf_[0], kf_[1]), cvtpk_s(kf_[2], kf_[3]), cvtpk_s(kf_[4], kf_[5]), cvtpk_s(kf_[6], kf_[7])};
            const u32x4 ab = {cvtpk_s(kb_[0], kb_[1]), cvtpk_s(kb_[2], kb_[3]), cvtpk_s(kb_[4], kb_[5]), cvtpk_s(kb_[6], kb_[7])};
            const bf16x8 vfr = {vlo[0], vlo[1], vlo[2], vlo[3], vhi[0], vhi[1], vhi[2], vhi[3]};
            a0 = __builtin_amdgcn_mfma_f32_32x32x16_bf16(__builtin_bit_cast(bf16x8, af), vfr, a0, 0, 0, 0);
            a1 = __builtin_amdgcn_mfma_f32_32x32x16_bf16(__builtin_bit_cast(bf16x8, ab), vfr, a1, 0, 0, 0); }
        float* of = RET + ((((size_t)0 * 2 + b) * NCI + ci) * 4 + h) * 4096 + eh * 32 + r32;
        float* ob = RET + ((((size_t)1 * 2 + b) * NCI + ci) * 4 + h) * 4096 + eh * 32 + r32;
#pragma unroll
        for (int r = 0; r < 16; ++r) { const int d = dh * 32 + crow(r, hi); of[d * 64] = a0[r]; ob[d * 64] = a1[r]; }
    }
}

constexpr int LR_UB = 0, LR_A = 18432, LR_B = 51200, LR_H = 83968, LR_SEG = 116736, LR_CW = 120832;
template <int MODE>
__device__ __forceinline__ void ph_lru_chunk(const Params& p, int l, int bid, int nb, float* lds, int ci_lo) {
    char* ws = p.ws; const int tid = TIDX, lane = tid & 63, r32 = lane & 31, hi = lane >> 5, wid = __builtin_amdgcn_readfirstlane(tid >> 6);
    const bf16_t* P = (const bf16_t*)(ws + OFF_P);
    float* LA = (float*)(ws + OFF_LRU); float* LB = LA + 2 * 2 * NCI * 256; float* LC = LB + 2 * 2 * NCI * 256;
    bf16_t* O = (bf16_t*)(ws + OFF_ACT);
    LAS char* sm = (LAS char*)lds;
    const int hb = bid & 3, tt = wid >> 1, jt = wid & 1, jcol = jt * 32 + r32, ch = hb * 64 + jcol;
    bf16x8 wfr[2][2][4]; float bia[2][2], spl[2];
#pragma unroll
    for (int dir = 0; dir < 2; ++dir) {
#pragma unroll
        for (int gt = 0; gt < 2; ++gt) { const float* W = (gt == 0 ? p.lru_wa : p.lru_wx) + (((size_t)(l * 2 + dir) * 4 + hb) * 64) * 64 + jcol;
#pragma unroll
            for (int ks = 0; ks < 4; ++ks) { const float* wp = W + (16 * ks + 8 * hi) * 64;
                const u32x4 w4 = {cvtpk_s(wp[0], wp[64]), cvtpk_s(wp[128], wp[192]), cvtpk_s(wp[256], wp[320]), cvtpk_s(wp[384], wp[448])};
                wfr[dir][gt][ks] = __builtin_bit_cast(bf16x8, w4); }
            bia[dir][gt] = (gt == 0 ? p.lru_ba : p.lru_bx)[(l * 2 + dir) * 256 + ch]; }
        spl[dir] = -8.0f * softplusf_(-p.lru_lam[(l * 2 + dir) * 256 + ch]); }
    const int nci = NCI - ci_lo, npair = 2 * nci;
    LAS float* cwl = (LAS float*)(sm + LR_CW);
    __syncthreads();
    if (tid < 320) cwl[tid] = tid < 256 ? p.conv_w[(l * 4 + (tid >> 6)) * 256 + hb * 64 + (tid & 63)] : p.conv_b[l * 256 + hb * 64 + (tid - 256)];
    UnitQ uq{(unsigned*)ws + CW_QUE + l * 16 + (MODE == 3 ? 4 : 8) + hb, 0}; q_prefetch(uq);
    for (int pi = q_take(uq, lds); pi < npair; pi = q_take(uq, lds)) {
        q_prefetch(uq);
        const int ci = ci_lo + pi % nci, b = pi / nci, rb = row_base(b, ci);
        const int seg_lo = ci < 2 ? NLAT + b * NCTX : b * NSEQ, seg_hi = ci < 2 ? seg_lo + NCTX : seg_lo + NSEQ;
        __syncthreads();
#pragma unroll
        for (int it = 0; it < 2; ++it) { const int item = it * 512 + tid, t = item >> 3, c8 = (item & 7) * 8, c0 = hb * 64 + c8;
            float acc[8];
            { const f32x4 b0 = *(const LAS f32x4*)(cwl + 256 + c8), b1 = *(const LAS f32x4*)(cwl + 256 + c8 + 4);
              acc[0] = b0[0]; acc[1] = b0[1]; acc[2] = b0[2]; acc[3] = b0[3]; acc[4] = b1[0]; acc[5] = b1[1]; acc[6] = b1[2]; acc[7] = b1[3]; }
#pragma unroll
            for (int k = 0; k < 4; ++k) { const int rr = rb + t - 1 + k;
                if (rr >= seg_lo && rr < seg_hi) { const bf16x8 xv = *(const bf16x8*)(P + (size_t)rr * DIN + C_LX + c0);
                    const f32x4 w0 = *(const LAS f32x4*)(cwl + k * 64 + c8), w1 = *(const LAS f32x4*)(cwl + k * 64 + c8 + 4);
                    acc[0] += w0[0] * bfs(xv[0]); acc[1] += w0[1] * bfs(xv[1]); acc[2] += w0[2] * bfs(xv[2]); acc[3] += w0[3] * bfs(xv[3]);
                    acc[4] += w1[0] * bfs(xv[4]); acc[5] += w1[1] * bfs(xv[5]); acc[6] += w1[2] * bfs(xv[6]); acc[7] += w1[3] * bfs(xv[7]); } }
            const u32x4 w = {cvtpk_s(acc[0], acc[1]), cvtpk_s(acc[2], acc[3]), cvtpk_s(acc[4], acc[5]), cvtpk_s(acc[6], acc[7])};
            *(LAS u32x4*)(sm + LR_UB + t * 144 + c8 * 2) = w; }
        __syncthreads();
        bf16x8 ua[4];
#pragma unroll
        for (int ks = 0; ks < 4; ++ks) ua[ks] = *(const LAS bf16x8*)(sm + LR_UB + (tt * 32 + r32) * 144 + (16 * ks + 8 * hi) * 2);
#pragma unroll
        for (int dir = 0; dir < 2; ++dir) {
            f32x16 ga, gx;
#pragma unroll
            for (int r = 0; r < 16; ++r) { ga[r] = bia[dir][0]; gx[r] = bia[dir][1]; }
#pragma unroll
            for (int ks = 0; ks < 4; ++ks) { ga = __builtin_amdgcn_mfma_f32_32x32x16_bf16(ua[ks], wfr[dir][0][ks], ga, 0, 0, 0); gx = __builtin_amdgcn_mfma_f32_32x32x16_bf16(ua[ks], wfr[dir][1][ks], gx, 0, 0, 0); }
#pragma unroll
            for (int r = 0; r < 16; ++r) { const int t = tt * 32 + crow(r, hi);
                const float rg = __builtin_amdgcn_rcpf(1.0f + __expf(-ga[r])), ig = __builtin_amdgcn_rcpf(1.0f + __expf(-gx[r]));
                const float a = __expf(spl[dir] * rg);
                const float uu = __uint_as_float(((unsigned)*(const LAS unsigned short*)(sm + LR_UB + t * 144 + jcol * 2)) << 16);
                *(LAS float*)(sm + LR_A + (t * 64 + jcol) * 4) = a;
                *(LAS float*)(sm + LR_B + (t * 64 + jcol) * 4) = sqrtf(fmaxf(1.0f - a * a, 0.f)) * (ig * uu); }
            __syncthreads();
            {
                const size_t cidx = (((size_t)dir * 2 + b) * NCI + ci) * 256 + hb * 64 + lane;
                float cin = MODE == 3 ? LC[cidx] : 0.f;
                LAS float* as_ = (LAS float*)(sm + LR_A) + lane; LAS float* bs_ = (LAS float*)(sm + LR_B) + lane; LAS float* hs = (LAS float*)(sm + LR_H) + lane;
                LAS float* sg = (LAS float*)(sm + LR_SEG) + lane;
                {   float h = 0.f, c = 1.f;
#pragma unroll 1
                    for (int k0 = 0; k0 < 16; k0 += 8) { float cl[8], hl[8];
#pragma unroll
                        for (int k = 0; k < 8; ++k) { const int s = wid * 16 + k0 + k, t = dir == 0 ? s : 127 - s; cl[k] = as_[t * 64]; hl[k] = bs_[t * 64]; }
#pragma unroll
                        for (int k = 0; k < 8; ++k) { const int s = wid * 16 + k0 + k, t = dir == 0 ? s : 127 - s; h = cl[k] * h + hl[k]; c *= cl[k]; as_[t * 64] = c; bs_[t * 64] = h; } }
                    sg[wid * 64] = c; sg[(8 + wid) * 64] = h; }
                __syncthreads();
                float pa = 1.f;
                for (int v = 0; v < wid; ++v) { const float sa = sg[v * 64]; cin = sa * cin + sg[(8 + v) * 64]; pa *= sa; }
                if (MODE == 1) { if (wid == 7) { const float c7 = sg[7 * 64], h7 = sg[15 * 64]; LA[cidx] = pa * c7; LB[cidx] = c7 * cin + h7; } }
                else {
#pragma unroll 1
                    for (int k0 = 0; k0 < 16; k0 += 8) {
#pragma unroll
                        for (int k = 0; k < 8; ++k) { const int s = wid * 16 + k0 + k, t = dir == 0 ? s : 127 - s; const float val = bs_[t * 64] + as_[t * 64] * cin;
                            if (dir == 0) hs[t * 64] = val; else hs[t * 64] += val; } }
                }
            }
            __syncthreads();
        }
        if (MODE == 3) {
            bf16x8 yv2[2];
#pragma unroll
            for (int it = 0; it < 2; ++it) { const int item = it * 512 + tid, t = item >> 3, c8 = (item & 7) * 8, c0 = hb * 64 + c8; yv2[it] = *(const bf16x8*)(P + (size_t)(rb + t) * DIN + C_LY + c0); }
#pragma unroll
            for (int it = 0; it < 2; ++it) { const int item = it * 512 + tid, t = item >> 3, c8 = (item & 7) * 8, c0 = hb * 64 + c8;
                const f32x4 h0 = *(const LAS f32x4*)(sm + LR_H + (t * 64 + c8) * 4), h1 = *(const LAS f32x4*)(sm + LR_H + (t * 64 + c8 + 4) * 4);
                const bf16x8 yv = yv2[it];
                const u32x4 w = {cvtpk_s(h0[0] * gelu_tanh(bfs(yv[0])), h0[1] * gelu_tanh(bfs(yv[1]))), cvtpk_s(h0[2] * gelu_tanh(bfs(yv[2])), h0[3] * gelu_tanh(bfs(yv[3]))),
                                 cvtpk_s(h1[0] * gelu_tanh(bfs(yv[4])), h1[1] * gelu_tanh(bfs(yv[5]))), cvtpk_s(h1[2] * gelu_tanh(bfs(yv[6])), h1[3] * gelu_tanh(bfs(yv[7])))};
                *(u32x4*)(O + (size_t)(rb + t) * DM + 768 + c0) = w; }
        }
    }
}

__device__ __forceinline__ int scan_ci(int dir, int s) { return dir == 0 ? s : (s == 0 ? 1 : (s == 1 ? 0 : NCI + 1 - s)); }
__device__ __forceinline__ void ph_scan2(const Params& p, int l, int bid, int nb) {
    char* ws = p.ws; const int gt = bid * 512 + TIDX, gs = nb * 512;
    float* RET = (float*)(ws + OFF_RET);
    for (int i = gt; i < 2 * 2 * 4 * 4096; i += gs) {
        const int de = i & 4095, h = (i >> 12) & 3, b = (i >> 14) & 1, dir = i >> 15;
        const float decay = expf(ret_lg(p, l, dir, h) * 128.0f); float S = 0.f;
        float* base = RET + (((size_t)dir * 2 + b) * NCI * 4 + h) * 4096 + de;
        float ua[13], ub[13];
#pragma unroll
        for (int j = 0; j < 13; ++j) ua[j] = base[(size_t)scan_ci(dir, j) * 4 * 4096];
#pragma unroll 1
        for (int s0 = 0; s0 < NCI; s0 += 26) {
#pragma unroll
            for (int j = 0; j < 13; ++j) ub[j] = base[(size_t)scan_ci(dir, s0 + 13 + j) * 4 * 4096];
#pragma unroll
            for (int j = 0; j < 13; ++j) { base[(size_t)scan_ci(dir, s0 + j) * 4 * 4096] = S; S = decay * S + ua[j]; }
            const int s1 = s0 + 26 < NCI ? s0 + 26 : s0;
#pragma unroll
            for (int j = 0; j < 13; ++j) ua[j] = base[(size_t)scan_ci(dir, s1 + j) * 4 * 4096];
#pragma unroll
            for (int j = 0; j < 13; ++j) { base[(size_t)scan_ci(dir, s0 + 13 + j) * 4 * 4096] = S; S = decay * S + ub[j]; }
        }
    }
    float* LA = (float*)(ws + OFF_LRU); float* LB = LA + 2 * 2 * NCI * 256; float* LC = LB + 2 * 2 * NCI * 256;
    const int lo = nb >= 192 ? 128 * 512 : 0;
    for (int i = gt - lo; i < 2 * 2 * 256; i += gs) {
        if (i < 0) continue;
        const int ch = i & 255, b = (i >> 8) & 1, dir = i >> 9; float h = 0.f;
        const size_t base = ((size_t)dir * 2 + b) * NCI * 256 + ch;
        float aa[13], bb[13], ac[13], bc[13];
#pragma unroll
        for (int j = 0; j < 13; ++j) { const size_t idx = base + (size_t)scan_ci(dir, j) * 256; aa[j] = LA[idx]; bb[j] = LB[idx]; }
#pragma unroll 1
        for (int s0 = 0; s0 < NCI; s0 += 26) {
#pragma unroll
            for (int j = 0; j < 13; ++j) { const size_t idx = base + (size_t)scan_ci(dir, s0 + 13 + j) * 256; ac[j] = LA[idx]; bc[j] = LB[idx]; }
#pragma unroll
            for (int j = 0; j < 13; ++j) { LC[base + (size_t)scan_ci(dir, s0 + j) * 256] = h; h = aa[j] * h + bb[j]; }
            const int s1 = s0 + 26 < NCI ? s0 + 26 : s0;
#pragma unroll
            for (int j = 0; j < 13; ++j) { const size_t idx = base + (size_t)scan_ci(dir, s1 + j) * 256; aa[j] = LA[idx]; bb[j] = LB[idx]; }
#pragma unroll
            for (int j = 0; j < 13; ++j) { LC[base + (size_t)scan_ci(dir, s0 + 13 + j) * 256] = h; h = ac[j] * h + bc[j]; }
        }
    }
}

__device__ __forceinline__ bf16x8 scale_frag(bf16x8 q, float s) {
    u32x4 w;
#pragma unroll
    for (int i = 0; i < 4; ++i) w[i] = cvtpk_s(bfs(q[2 * i]) * s, bfs(q[2 * i + 1]) * s);
    return __builtin_bit_cast(bf16x8, w);
}
__device__ __forceinline__ void ph_ret_out(const Params& p, int l, int bid, int nb, float* lds, int ci_lo) {
    char* ws = p.ws; const int tid = TIDX, lane = tid & 63, r32 = lane & 31, hi = lane >> 5, wid = __builtin_amdgcn_readfirstlane(tid >> 6);
    const bf16_t* P = (const bf16_t*)(ws + OFF_P); const float* RET = (const float*)(ws + OFF_RET); bf16_t* O = (bf16_t*)(ws + OFF_ACT);
    LAS char* sm = (LAS char*)lds;
    const int nci = NCI - ci_lo;
    UnitQ uq{(unsigned*)ws + CW_QUE + l * 16 + 1, 0}; q_prefetch(uq);
    for (int u = q_take(uq, lds); u < 2 * nci * 2; u = q_take(uq, lds)) {
        q_prefetch(uq);
        const int hp = u & 1, ci = ci_lo + (u >> 1) % nci, b = (u >> 1) / nci, rb = row_base(b, ci);
        __syncthreads();
        ret_stage<false>(P, rb, hp, sm, tid, wid, lane);
        __syncthreads();
        const int hh = wid >> 2, qt = wid & 3, h = 2 * hp + hh; int n = qt * 32 + r32;
        asm volatile("" : "+v"(n));
        const float lg2f = ret_lg(p, l, 0, h) * 1.4426950408889634f, lg2b = ret_lg(p, l, 1, h) * 1.4426950408889634f;
        bf16x8 qr[4];
        { const bf16_t* qp = P + (size_t)(rb + n) * DIN + C_RQ + h * 64 + hi * 8;
#pragma unroll
          for (int ks = 0; ks < 4; ++ks) qr[ks] = *(const bf16x8*)(qp + ks * 16); }
        f32x16 o[2];
#pragma unroll
        for (int r = 0; r < 16; ++r) { o[0][r] = 0.f; o[1][r] = 0.f; }
#pragma unroll
        for (int dir = 0; dir < 2; ++dir) {
            const float xi = dir == 0 ? __builtin_amdgcn_exp2f(lg2f * (float)(n + 1)) : __builtin_amdgcn_exp2f(lg2b * (float)(128 - n));
            const float* Sb = RET + ((((size_t)dir * 2 + b) * NCI + ci) * 4 + h) * 4096 + hi * 8 * 64 + r32;
#pragma unroll
            for (int ks = 0; ks < 4; ++ks) { const bf16x8 qx = scale_frag(qr[ks], xi);
#pragma unroll
                for (int eh = 0; eh < 2; ++eh) { const float* sp = Sb + ks * 16 * 64 + eh * 32;
                    const u32x4 sw = {cvtpk_s(sp[0], sp[64]), cvtpk_s(sp[128], sp[192]), cvtpk_s(sp[256], sp[320]), cvtpk_s(sp[384], sp[448])};
                    o[eh] = __builtin_amdgcn_mfma_f32_32x32x16_bf16(qx, __builtin_bit_cast(bf16x8, sw), o[eh], 0, 0, 0); } }
        }
        const LAS char* Kb = sm + RT_K + hh * 16384 + hi * 1024 + r32 * 16;
        const LAS char* Vb = sm + RT_V + hh * 16384 + ((lane >> 4) & 1) * 32 + (lane & 3) * 8 + (4 * hi + ((lane & 15) >> 2)) * 64;
        u32x4 pw[8];
#pragma unroll
        for (int kb = 0; kb < 4; ++kb) { const int tt = kb >> 1, kbl = kb & 1;
            f32x16 c;
#pragma unroll
            for (int r = 0; r < 16; ++r) c[r] = 0.f;
#pragma unroll
            for (int ks = 0; ks < 4; ++ks) c = __builtin_amdgcn_mfma_f32_32x32x16_bf16(*(const LAS bf16x8*)(Kb + tt * 8192 + ks * 2048 + kbl * 512), qr[ks], c, 0, 0, 0);
#pragma unroll
            for (int r = 0; r < 16; ++r) { const int dlt = n - (kb * 32 + crow(r, hi)); const float fd = (float)dlt;
                const float w = __builtin_amdgcn_exp2f(fd * (dlt > 0 ? lg2f : -lg2b));
                c[r] *= dlt == 0 ? 2.0f : w; }
            pw[2 * kb] = (u32x4){cvtpk_s(c[0], c[1]), cvtpk_s(c[2], c[3]), cvtpk_s(c[4], c[5]), cvtpk_s(c[6], c[7])};
            pw[2 * kb + 1] = (u32x4){cvtpk_s(c[8], c[9]), cvtpk_s(c[10], c[11]), cvtpk_s(c[12], c[13]), cvtpk_s(c[14], c[15])}; }
#pragma unroll
        for (int k8 = 0; k8 < 8; ++k8) { const int tt = k8 >> 2, sl = k8 & 3;
#pragma unroll
            for (int eh = 0; eh < 2; ++eh) { const s16x4 vlo = vtr(Vb + tt * 8192 + eh * 4096 + sl * 1024), vhi = vtr(Vb + tt * 8192 + eh * 4096 + sl * 1024 + 512);
                o[eh] = __builtin_amdgcn_mfma_f32_32x32x16_bf16(__builtin_bit_cast(bf16x8, pw[k8]), (bf16x8){vlo[0], vlo[1], vlo[2], vlo[3], vhi[0], vhi[1], vhi[2], vhi[3]}, o[eh], 0, 0, 0); } }
        LAS float* stg = (LAS float*)(sm + RT_ST) + wid * 2048;
#pragma unroll
        for (int r = 0; r < 16; ++r) { const int q = crow(r, hi); stg[q * 64 + r32] = o[0][r]; stg[q * 64 + 32 + r32] = o[1][r]; }
        const float* gn = p.ret_gn + l * 256 + h * 64 + (lane & 7) * 8;
        const f32x4 g0 = *(const f32x4*)gn, g1 = *(const f32x4*)(gn + 4);
        bf16x8 ggv[4];
#pragma unroll
        for (int i = 0; i < 4; ++i) ggv[i] = *(const bf16x8*)(P + (size_t)(rb + qt * 32 + i * 8 + (lane >> 3)) * DIN + C_RG + h * 64 + (lane & 7) * 8);
#pragma unroll
        for (int i = 0; i < 4; ++i) { const int row = i * 8 + (lane >> 3), ch = lane & 7;
            const f32x4 v0 = *(const LAS f32x4*)(stg + row * 64 + ch * 8), v1 = *(const LAS f32x4*)(stg + row * 64 + ch * 8 + 4);
            float ss = v0[0] * v0[0] + v0[1] * v0[1] + v0[2] * v0[2] + v0[3] * v0[3] + v1[0] * v1[0] + v1[1] * v1[1] + v1[2] * v1[2] + v1[3] * v1[3];
            ss += __shfl_xor(ss, 1); ss += __shfl_xor(ss, 2); ss += __shfl_xor(ss, 4);
            const float rn = rsqrtf(ss * (1.0f / 64.0f) + 1e-6f);
            const size_t grow = (size_t)(rb + qt * 32 + row);
            const bf16x8 gg = ggv[i];
            u32x4 w; w.x = cvtpk_s(v0[0] * rn * g0[0] * fast_silu(bfs(gg[0])), v0[1] * rn * g0[1] * fast_silu(bfs(gg[1]))); w.y = cvtpk_s(v0[2] * rn * g0[2] * fast_silu(bfs(gg[2])), v0[3] * rn * g0[3] * fast_silu(bfs(gg[3])));
            w.z = cvtpk_s(v1[0] * rn * g1[0] * fast_silu(bfs(gg[4])), v1[1] * rn * g1[1] * fast_silu(bfs(gg[5]))); w.w = cvtpk_s(v1[2] * rn * g1[2] * fast_silu(bfs(gg[6])), v1[3] * rn * g1[3] * fast_silu(bfs(gg[7])));
            *(u32x4*)(O + grow * DM + 256 + h * 64 + ch * 8) = w; }
    }
}

__device__ __forceinline__ float diff_lambda_val(const Params& p, int l, float lam_init) {
    const float* lv = p.diff_lam + l * 128; float s1 = 0.f, s2 = 0.f;
    for (int i = 0; i < 32; ++i) { s1 += lv[i] * lv[32 + i]; s2 += lv[64 + i] * lv[96 + i]; }
    return expf(s1) - expf(s2) + lam_init;
}
__device__ __forceinline__ float max3f(float a, float b, float c) { return __builtin_fmaxf(__builtin_fmaxf(a, b), c); }
__device__ __forceinline__ float xhalf_max(float m) { auto rr = __builtin_amdgcn_permlane32_swap(__float_as_uint(m), __float_as_uint(m), false, false); return fmaxf(__uint_as_float(rr[0]), __uint_as_float(rr[1])); }
__device__ __forceinline__ float xhalf_sum(float m) { auto rr = __builtin_amdgcn_permlane32_swap(__float_as_uint(m), __float_as_uint(m), false, false); return __uint_as_float(rr[0]) + __uint_as_float(rr[1]); }

constexpr int DF_K = 0, DF_V = 16384, DF_WS = 32768, DF_ST = 34816;
constexpr int DD_K = 0, DD_V = 32768, DD_WS = 65536, DD_ST = 67584;
__device__ __forceinline__ void glds16(const void* gsrc, unsigned lds_dst) { unsigned keep;
    asm volatile("s_mov_b32 %0, m0\n\ts_mov_b32 m0, %2\n\ts_nop 0\n\tglobal_load_lds_dwordx4 %1, off\n\ts_mov_b32 m0, %0" : "=&s"(keep) : "v"(gsrc), "s"(lds_dst) : "memory"); }
template <bool SAFE>
__device__ __forceinline__ void diff_tiles(const bf16_t* P, int b, int h, int t_lo, LAS char* sm, int tid, int wid, int lane, const bf16x8 (&qr)[4], f32x16 (&o)[2][2], float (&lsum)[2]) {
    const int r32 = lane & 31, hi = lane >> 5, t_hi = 260;
    LAS float* wsf = (LAS float*)(sm + DD_WS) + wid * 64;
    const bf16_t* kcol = P + C_DK + h * 64 + wid * 8;
    const bf16_t* vcol = P + C_DV + h * 64 + (wid >> 2) * 32 + (lane & 3) * 8;
    const int krow_in = lane, vrow_in = 16 * (wid & 3) + (lane >> 2);
#define TILE_ROW0(t) ((t) < 256 ? b * NSEQ + (t) * 64 : NLAT + b * NCTX + ((t) - 256) * 64)
    float mhat[2];
#pragma unroll
    for (int m = 0; m < 2; ++m) { mhat[m] = 0.f; lsum[m] = 0.f;
#pragma unroll
        for (int r = 0; r < 16; ++r) { o[m][0][r] = 0.f; o[m][1][r] = 0.f; } }
    const unsigned lds0 = (unsigned)(size_t)sm + (unsigned)wid * 1024u;
#define DMA_TILE(t) do { const int r0_ = TILE_ROW0(t); const unsigned sl_ = (unsigned)(((t) - t_lo) & 3) * 8192u; \
    glds16(kcol + (size_t)(r0_ + krow_in) * DIN, (unsigned)__builtin_amdgcn_readfirstlane(lds0 + DD_K + sl_)); glds16(vcol + (size_t)(r0_ + vrow_in) * DIN, (unsigned)__builtin_amdgcn_readfirstlane(lds0 + DD_V + sl_)); } while (0)
    asm volatile("s_waitcnt lgkmcnt(0)\n\ts_barrier" ::: "memory");
    DMA_TILE(t_lo); DMA_TILE(t_lo + 1); DMA_TILE(t_lo + 2);
    bool first = true;
    for (int t = t_lo; t < t_hi; ++t) {
        const int cur = (t - t_lo) & 3;
        if (t + 2 < t_hi) asm volatile("s_waitcnt vmcnt(4)\n\ts_barrier" ::: "memory");
        else if (t + 1 < t_hi) asm volatile("s_waitcnt vmcnt(2)\n\ts_barrier" ::: "memory");
        else asm volatile("s_waitcnt vmcnt(0)\n\ts_barrier" ::: "memory");
        if (t + 3 < t_hi) DMA_TILE(t + 3);
        const LAS char* kb = sm + DD_K + cur * 8192 + hi * 1024 + r32 * 16;
        const LAS char* vb = sm + DD_V + cur * 8192 + ((lane >> 4) & 1) * 32 + (lane & 3) * 8 + (4 * hi + ((lane & 15) >> 2)) * 64;
#pragma unroll
        for (int m = 0; m < 2; ++m) {
            bf16x8 kf[8];
#pragma unroll
            for (int j = 2 * m; j < 2 * m + 2; ++j) { kf[2 * j] = *(const LAS bf16x8*)(kb + j * 2048); kf[2 * j + 1] = *(const LAS bf16x8*)(kb + j * 2048 + 512); }
            f32x16 c0, c1;
            if (SAFE) { float nm = -mhat[m]; asm volatile("" : "+v"(nm));
#pragma unroll
                for (int r = 0; r < 16; ++r) { c0[r] = nm; c1[r] = nm; } }
            else {
#pragma unroll
                for (int r = 0; r < 16; ++r) { c0[r] = 0.f; c1[r] = 0.f; } }
            c0 = __builtin_amdgcn_mfma_f32_32x32x16_bf16(kf[4 * m + 0], qr[2 * m], c0, 0, 0, 0);
            c1 = __builtin_amdgcn_mfma_f32_32x32x16_bf16(kf[4 * m + 1], qr[2 * m], c1, 0, 0, 0);
            c0 = __builtin_amdgcn_mfma_f32_32x32x16_bf16(kf[4 * m + 2], qr[2 * m + 1], c0, 0, 0, 0);
            c1 = __builtin_amdgcn_mfma_f32_32x32x16_bf16(kf[4 * m + 3], qr[2 * m + 1], c1, 0, 0, 0);
            if (SAFE) {
                float ra = max3f(c0[0], c0[1], c1[0]), rb = max3f(c0[2], c0[3], c1[1]); ra = max3f(ra, c1[2], c1[3]);
#pragma unroll
                for (int r = 4; r < 16; r += 4) { ra = max3f(ra, c0[r], c0[r + 1]); rb = max3f(rb, c0[r + 2], c0[r + 3]); ra = max3f(ra, c1[r], c1[r + 1]); rb = max3f(rb, c1[r + 2], c1[r + 3]); }
                const float rm = xhalf_max(max3f(ra, rb, rb));
                if (__builtin_expect(first || __any(rm > 8.0f), 0)) {
                    float dl = first ? rm : fmaxf(rm, 0.f); asm volatile("; rebase" : "+v"(dl));
                    mhat[m] += dl;
#pragma unroll
                    for (int r = 0; r < 16; ++r) { c0[r] -= dl; c1[r] -= dl; }
                    asm volatile("" : "+v"(c0), "+v"(c1));
                    if (!first) {
                        const float f = __builtin_amdgcn_exp2f(-dl); lsum[m] *= f;
                        if (hi == 0) wsf[r32] = f;
#pragma unroll
                        for (int r = 0; r < 16; ++r) { const float fr_ = wsf[crow(r, hi)]; o[m][0][r] *= fr_; o[m][1][r] *= fr_; }
                    }
                }
            }
            float sacc = 0.f;
#pragma unroll
            for (int r = 0; r < 16; ++r) { c0[r] = __builtin_amdgcn_exp2f(c0[r]); c1[r] = __builtin_amdgcn_exp2f(c1[r]); sacc += c0[r] + c1[r]; }
            lsum[m] += sacc;
            u32x4 pw[4];
#pragma unroll
            for (int k = 0; k < 2; ++k) {
                pw[k] = (u32x4){cvtpk_s(c0[8 * k + 0], c0[8 * k + 1]), cvtpk_s(c0[8 * k + 2], c0[8 * k + 3]), cvtpk_s(c0[8 * k + 4], c0[8 * k + 5]), cvtpk_s(c0[8 * k + 6], c0[8 * k + 7])};
                pw[2 + k] = (u32x4){cvtpk_s(c1[8 * k + 0], c1[8 * k + 1]), cvtpk_s(c1[8 * k + 2], c1[8 * k + 3]), cvtpk_s(c1[8 * k + 4], c1[8 * k + 5]), cvtpk_s(c1[8 * k + 6], c1[8 * k + 7])}; }
            if (!SAFE) __builtin_amdgcn_sched_barrier(0);
#pragma unroll
            for (int dh = 0; dh < 2; ++dh) {
#pragma unroll
                for (int k = 0; k < 4; ++k) { const s16x4 lo = vtr(vb + dh * 4096 + k * 1024), hh = vtr(vb + dh * 4096 + k * 1024 + 512);
                    o[m][dh] = __builtin_amdgcn_mfma_f32_32x32x16_bf16(__builtin_bit_cast(bf16x8, pw[k]), (bf16x8){lo[0], lo[1], lo[2], lo[3], hh[0], hh[1], hh[2], hh[3]}, o[m][dh], 0, 0, 0); } }
            if (!SAFE) __builtin_amdgcn_sched_barrier(0);
        }
        first = false;
        asm volatile("s_waitcnt lgkmcnt(0)" ::: "memory");
    }
#undef TILE_ROW0
#undef DMA_TILE
}

constexpr int DQ_K = 0, DQ_V = 40960, DQ_WS = 81920, DQ_ST = 0;
__device__ __forceinline__ void diff_tiles_fast(const bf16_t* P, int b, int h, int t_lo, LAS char* sm, int tid, int wid, int lane, const bf16x8 (&qr)[4], f32x16 (&o)[2][2], f32x4 (&ls)[2]) {
    const int r32 = lane & 31, hi = lane >> 5, NT = 260 - t_lo;
    const bf16_t* kcol = P + C_DK + h * 64 + wid * 8;
    const bf16_t* vcol = P + C_DV + h * 64 + (wid >> 2) * 32 + (lane & 3) * 8;
    const int krow_in = lane, vrow_in = 16 * (wid & 3) + (lane >> 2);
    const unsigned lds0 = (unsigned)(size_t)sm + (unsigned)wid * 1024u;
#define TILE_ROW0(i) ((t_lo + (i)) < 256 ? b * NSEQ + (t_lo + (i)) * 64 : NLAT + b * NCTX + (t_lo + (i) - 256) * 64)
#define DMA_TILE(i, slot) do { const int r0_ = TILE_ROW0(i); const unsigned sl_ = (unsigned)(slot) * 8192u; \
    glds16(kcol + (size_t)(r0_ + krow_in) * DIN, (unsigned)__builtin_amdgcn_readfirstlane(lds0 + DQ_K + sl_)); glds16(vcol + (size_t)(r0_ + vrow_in) * DIN, (unsigned)__builtin_amdgcn_readfirstlane(lds0 + DQ_V + sl_)); } while (0)
#pragma unroll
    for (int m = 0; m < 2; ++m) { ls[m] = (f32x4){0.f, 0.f, 0.f, 0.f};
#pragma unroll
        for (int r = 0; r < 16; ++r) { o[m][0][r] = 0.f; o[m][1][r] = 0.f; } }
    const unsigned onev = (((lane >> 4) ^ (lane >> 3)) & 1) ? 0u : 0x3F803F80u;
    const bf16x8 onesB = __builtin_bit_cast(bf16x8, ((u32x4){onev, onev, onev, onev}));
    asm volatile("s_waitcnt lgkmcnt(0)\n\ts_barrier" ::: "memory");
    DMA_TILE(0, 0); DMA_TILE(1, 1); DMA_TILE(2, 2); DMA_TILE(3, 3);
    asm volatile("s_waitcnt vmcnt(4)\n\ts_barrier" ::: "memory");
    const int kfo = hi * 1024 + r32 * 16, vfo = ((lane >> 4) & 1) * 32 + (lane & 3) * 8 + (4 * hi + ((lane & 15) >> 2)) * 64;
    f32x16 cA0, cA1, cB0, cB1; u32x4 pwp[4], pwq[4]; bf16x8 vq[8], kq[4];
#define KOFF(g) ((((g) & 1) * 512) + (((g) >> 1) * 2048))
#define LDK(g, base) kq[g] = *(const LAS bf16x8*)((base) + KOFF(g))
#define LDV(g, base) do { const s16x4 l0_ = vtr((base) + (g) * 1024), h0_ = vtr((base) + (g) * 1024 + 512), l1_ = vtr((base) + 4096 + (g) * 1024), h1_ = vtr((base) + 4096 + (g) * 1024 + 512); \
        vq[g] = (bf16x8){l0_[0], l0_[1], l0_[2], l0_[3], h0_[0], h0_[1], h0_[2], h0_[3]}; vq[4 + (g)] = (bf16x8){l1_[0], l1_[1], l1_[2], l1_[3], h1_[0], h1_[1], h1_[2], h1_[3]}; } while (0)
    {
        const LAS char* kb_ = sm + DQ_K + kfo;
#pragma unroll
        for (int r = 0; r < 16; ++r) { cA0[r] = 0.f; cA1[r] = 0.f; cB0[r] = 0.f; cB1[r] = 0.f; }
#pragma unroll
        for (int j = 0; j < 2; ++j) { cA0 = __builtin_amdgcn_mfma_f32_32x32x16_bf16(*(const LAS bf16x8*)(kb_ + j * 2048), qr[j], cA0, 0, 0, 0);
                                      cA1 = __builtin_amdgcn_mfma_f32_32x32x16_bf16(*(const LAS bf16x8*)(kb_ + j * 2048 + 512), qr[j], cA1, 0, 0, 0);
                                      cB0 = __builtin_amdgcn_mfma_f32_32x32x16_bf16(*(const LAS bf16x8*)(kb_ + 4096 + j * 2048), qr[2 + j], cB0, 0, 0, 0);
                                      cB1 = __builtin_amdgcn_mfma_f32_32x32x16_bf16(*(const LAS bf16x8*)(kb_ + 4096 + j * 2048 + 512), qr[2 + j], cB1, 0, 0, 0); }
#pragma unroll
        for (int r = 0; r < 16; ++r) { cA0[r] = __builtin_amdgcn_exp2f(cA0[r]); cA1[r] = __builtin_amdgcn_exp2f(cA1[r]); }
#pragma unroll
        for (int k = 0; k < 2; ++k) {
            pwq[k] = (u32x4){cvtpk_s(cA0[8 * k + 0], cA0[8 * k + 1]), cvtpk_s(cA0[8 * k + 2], cA0[8 * k + 3]), cvtpk_s(cA0[8 * k + 4], cA0[8 * k + 5]), cvtpk_s(cA0[8 * k + 6], cA0[8 * k + 7])};
            pwq[2 + k] = (u32x4){cvtpk_s(cA1[8 * k + 0], cA1[8 * k + 1]), cvtpk_s(cA1[8 * k + 2], cA1[8 * k + 3]), cvtpk_s(cA1[8 * k + 4], cA1[8 * k + 5]), cvtpk_s(cA1[8 * k + 6], cA1[8 * k + 7])}; }
        const LAS char* v0_ = sm + DQ_V + vfo; const LAS char* k1_ = sm + DQ_K + 8192 + kfo;
#pragma unroll
        for (int g = 0; g < 4; ++g) { LDV(g, v0_); LDK(g, k1_); }
        __builtin_amdgcn_sched_barrier(0);
    }
#define STEPF(CC0, CC1, PWC, PWP, MPREV, CN0, CN1, MNEXT, RELOAD, NREAD) do { \
    _Pragma("unroll") for (int r_ = 0; r_ < 16; ++r_) { CN0[r_] = 0.f; CN1[r_] = 0.f; } \
    _Pragma("unroll") for (int g_ = 0; g_ < 4; ++g_) { \
        o[MPREV][0] = __builtin_amdgcn_mfma_f32_32x32x16_bf16(__builtin_bit_cast(bf16x8, PWP[g_]), vq[g_], o[MPREV][0], 0, 0, 0); \
        o[MPREV][1] = __builtin_amdgcn_mfma_f32_32x32x16_bf16(__builtin_bit_cast(bf16x8, PWP[g_]), vq[4 + g_], o[MPREV][1], 0, 0, 0); \
        ls[MPREV] = __builtin_amdgcn_mfma_f32_16x16x32_bf16(__builtin_bit_cast(bf16x8, PWP[g_]), onesB, ls[MPREV], 0, 0, 0); \
        if ((g_ & 1) == 0) CN0 = __builtin_amdgcn_mfma_f32_32x32x16_bf16(kq[g_], qr[2 * (MNEXT) + (g_ >> 1)], CN0, 0, 0, 0); \
        else               CN1 = __builtin_amdgcn_mfma_f32_32x32x16_bf16(kq[g_], qr[2 * (MNEXT) + (g_ >> 1)], CN1, 0, 0, 0); \
        _Pragma("unroll") for (int r_ = 4 * g_; r_ < 4 * g_ + 4; ++r_) { CC0[r_] = __builtin_amdgcn_exp2f(CC0[r_]); CC1[r_] = __builtin_amdgcn_exp2f(CC1[r_]); } \
        if (g_ == 1) { PWC[0] = (u32x4){cvtpk_s(CC0[0], CC0[1]), cvtpk_s(CC0[2], CC0[3]), cvtpk_s(CC0[4], CC0[5]), cvtpk_s(CC0[6], CC0[7])}; \
                       PWC[2] = (u32x4){cvtpk_s(CC1[0], CC1[1]), cvtpk_s(CC1[2], CC1[3]), cvtpk_s(CC1[4], CC1[5]), cvtpk_s(CC1[6], CC1[7])}; } \
        if (g_ == 3) { PWC[1] = (u32x4){cvtpk_s(CC0[8], CC0[9]), cvtpk_s(CC0[10], CC0[11]), cvtpk_s(CC0[12], CC0[13]), cvtpk_s(CC0[14], CC0[15])}; \
                       PWC[3] = (u32x4){cvtpk_s(CC1[8], CC1[9]), cvtpk_s(CC1[10], CC1[11]), cvtpk_s(CC1[12], CC1[13]), cvtpk_s(CC1[14], CC1[15])}; } \
        RELOAD(g_); } \
    _Pragma("unroll") for (int g_ = 0; g_ < 4; ++g_) { \
        _Pragma("unroll") for (int i_ = 0; i_ < 4; ++i_) { __builtin_amdgcn_sched_group_barrier(0x008, 1, 0); __builtin_amdgcn_sched_group_barrier(0x400, 2, 0); } \
        __builtin_amdgcn_sched_group_barrier(0x100, NREAD, 0); }        \
    __builtin_amdgcn_sched_barrier(0); } while (0)
#define RELOAD_A(g) LDK(g, k1_ + 4096)
#define RELOAD_B(g) do { LDK(g, k2_); LDV(g, v1_); } while (0)
    int s1 = 1, s2 = 2, s4 = 4;
    for (int t = 0; t < NT; ++t) {
        if (t + 3 < NT) asm volatile("s_waitcnt vmcnt(2)\n\ts_barrier" ::: "memory"); else asm volatile("s_waitcnt vmcnt(0)\n\ts_barrier" ::: "memory");
        if (t + 4 < NT) DMA_TILE(t + 4, s4);
        const LAS char* k1_ = sm + DQ_K + s1 * 8192 + kfo; const LAS char* k2_ = sm + DQ_K + s2 * 8192 + kfo; const LAS char* v1_ = sm + DQ_V + s1 * 8192 + vfo;
        __builtin_amdgcn_sched_barrier(0);
        STEPF(cB0, cB1, pwp, pwq, 0, cA0, cA1, 0, RELOAD_A, 1);
        STEPF(cA0, cA1, pwq, pwp, 1, cB0, cB1, 1, RELOAD_B, 5);
        s1 = s2; s2 = (s2 == 4) ? 0 : s2 + 1; s4 = (s4 == 4) ? 0 : s4 + 1;
    }
#undef TILE_ROW0
#undef DMA_TILE
#undef STEPF
#undef RELOAD_A
#undef RELOAD_B
#undef LDK
#undef LDV
#undef KOFF
}

template <bool SAFE>
__device__ __forceinline__ bool diff_unit(const Params& p, int l, float lam_init, float lam, int u, float* lds) {
    char* ws = p.ws; const int tid = TIDX, lane = tid & 63, r32 = lane & 31, hi = lane >> 5, wid = __builtin_amdgcn_readfirstlane(tid >> 6);
    const bf16_t* P = (const bf16_t*)(ws + OFF_P); bf16_t* O = (bf16_t*)(ws + OFF_ACT);
    LAS char* sm = (LAS char*)lds;
    int b, h, qrow0, t_lo;
    if (u < 512) { b = u >> 8; h = (u >> 6) & 3; qrow0 = b * NSEQ + (u & 63) * 256; t_lo = 0; }
    else { const int v = u - 512; b = v >> 2; h = v & 3; qrow0 = NLAT + b * NCTX; t_lo = 256; }
    bf16x8 qr[4];
    { const bf16_t* qp = P + (size_t)(qrow0 + wid * 32 + r32) * DIN + C_DQ + h * 64 + hi * 8;
#pragma unroll
      for (int d0 = 0; d0 < 4; ++d0) qr[d0] = *(const bf16x8*)(qp + d0 * 16); }
        asm volatile("" :: "v"(qr[0]), "v"(qr[1]), "v"(qr[2]), "v"(qr[3]));
    f32x16 o[2][2]; float lsum[2] = {1.f, 1.f}; f32x4 ls[2];
    if (SAFE) diff_tiles<true>(P, b, h, t_lo, sm, tid, wid, lane, qr, o, lsum); else diff_tiles_fast(P, b, h, t_lo, sm, tid, wid, lane, qr, o, ls);
    constexpr int WS_OFF = SAFE ? DD_WS : DQ_WS, ST_OFF = SAFE ? DD_ST : DQ_ST;
    if (!SAFE) {
        bool bad = false;
#pragma unroll
        for (int i = 0; i < 4; ++i) bad |= !(ls[0][i] > 7.9e-31f && ls[0][i] < 1.2e30f && ls[1][i] > 7.9e-31f && ls[1][i] < 1.2e30f);
        LAS unsigned* flg = (LAS unsigned*)(sm + WS_OFF + 2048);
        const unsigned anyb = __any(bad) ? 1u : 0u;
        if (lane == 0) flg[wid] = anyb;
        asm volatile("s_waitcnt lgkmcnt(0)\n\ts_barrier" ::: "memory");
        const unsigned allb = flg[0] | flg[1] | flg[2] | flg[3] | flg[4] | flg[5] | flg[6] | flg[7];
        if (__builtin_expect(allb != 0u, 0)) return true;
    }
    int lane_e = TIDX & 63;
    { const int r32e = lane_e & 31, hie = lane_e >> 5;
    LAS float* wse = (LAS float*)(sm + WS_OFF) + wid * 64; LAS float* stge = (LAS float*)(sm + ST_OFF) + wid * 2048;
    if (SAFE) { const float l0 = xhalf_sum(lsum[0]), l1 = xhalf_sum(lsum[1]); if (hie == 0) { wse[r32e] = 1.0f / l0; wse[32 + r32e] = lam / l1; } }
    else if ((lane_e & 7) == 0) { const int qb = ((lane_e >> 3) & 1) * 16 + (lane_e >> 4) * 4;
#pragma unroll
        for (int i = 0; i < 4; ++i) { wse[qb + i] = 1.0f / ls[0][i]; wse[32 + qb + i] = lam / ls[1][i]; } }
#pragma unroll
    for (int r = 0; r < 16; ++r) { const int q = crow(r, hie); const float i0 = wse[q], i1 = wse[32 + q];
        stge[q * 64 + r32e] = o[0][0][r] * i0 - o[1][0][r] * i1; stge[q * 64 + 32 + r32e] = o[0][1][r] * i0 - o[1][1][r] * i1; } }
    LAS float* stg = (LAS float*)(sm + ST_OFF) + wid * 2048;
    const float* gn = p.diff_gn + l * 256 + h * 64 + (lane_e & 7) * 8;
    const f32x4 g0 = *(const f32x4*)gn, g1 = *(const f32x4*)(gn + 4);
#pragma unroll
    for (int i = 0; i < 4; ++i) { const int row = i * 8 + (lane_e >> 3), ch = lane_e & 7;
        const f32x4 v0 = *(const LAS f32x4*)(stg + row * 64 + ch * 8), v1 = *(const LAS f32x4*)(stg + row * 64 + ch * 8 + 4);
        float ss = v0[0] * v0[0] + v0[1] * v0[1] + v0[2] * v0[2] + v0[3] * v0[3] + v1[0] * v1[0] + v1[1] * v1[1] + v1[2] * v1[2] + v1[3] * v1[3];
        ss += __shfl_xor(ss, 1); ss += __shfl_xor(ss, 2); ss += __shfl_xor(ss, 4);
        const float rn = rsqrtf(ss * (1.0f / 64.0f) + 1e-6f) * (1.0f - lam_init);
        u32x4 w; w.x = cvtpk_s(v0[0] * rn * g0[0], v0[1] * rn * g0[1]); w.y = cvtpk_s(v0[2] * rn * g0[2], v0[3] * rn * g0[3]);
        w.z = cvtpk_s(v1[0] * rn * g1[0], v1[1] * rn * g1[1]); w.w = cvtpk_s(v1[2] * rn * g1[2], v1[3] * rn * g1[3]);
        *(u32x4*)(O + (size_t)(qrow0 + wid * 32 + row) * DM + 512 + h * 64 + ch * 8) = w; }
    return false;
}
__device__ __forceinline__ void ph_diff(const Params& p, int l, bool need_ctx, float lam_init, int bid, int nb, float* lds) {
    const float lam = __int_as_float(__builtin_amdgcn_readfirstlane(__float_as_int(diff_lambda_val(p, l, lam_init))));
    const int nun = 512 + (need_ctx ? 8 : 0);
    unsigned redo = 0u; int idx = 0;
    for (int u = (bid + 160) % nb; u < nun; u += nb, ++idx) if (diff_unit<false>(p, l, lam_init, lam, u, lds)) redo |= 1u << idx;
    idx = 0;
    if (__builtin_expect(redo != 0u, 0))
        for (int u = (bid + 160) % nb; u < nun; u += nb, ++idx) if ((redo >> idx) & 1u) (void)diff_unit<true>(p, l, lam_init, lam, u, lds);
}

__device__ __forceinline__ void ph_swa(const Params& p, int l, bool need_ctx, int bid, int nb, float* lds) {
    char* ws = p.ws; const int tid = TIDX, lane = tid & 63, r32 = lane & 31, hi = lane >> 5, wid = __builtin_amdgcn_readfirstlane(tid >> 6);
    const bf16_t* P = (const bf16_t*)(ws + OFF_P); bf16_t* O = (bf16_t*)(ws + OFF_ACT);
    LAS char* sm = (LAS char*)lds;
    LAS float* wsf = (LAS float*)(sm + DD_WS) + wid * 64;
    const int nun = 512 + (need_ctx ? 8 : 0);
    UnitQ uq{(unsigned*)ws + CW_QUE + l * 16 + 0, 0}; q_prefetch(uq);
    for (int u = q_take(uq, lds); u < nun; u = q_take(uq, lds)) {
        q_prefetch(uq);
        int b, h, qrow0, q0, tw_lo, nwin;
        if (u < 512) { b = u >> 8; h = (u >> 6) & 3; q0 = (u & 63) * 256; qrow0 = b * NSEQ + q0; const int lo = q0 - 128 < 0 ? 0 : q0 - 128, hi_ = q0 + 384 > NSEQ ? NSEQ : q0 + 384; tw_lo = lo >> 6; nwin = (hi_ - lo) >> 6; }
        else { const int v = u - 512; b = v >> 2; h = v & 3; q0 = 0; qrow0 = NLAT + b * NCTX; tw_lo = 0; nwin = 0; }
        const int g = h >> 1, nt = nwin + 4;
        const bf16_t* kcol = P + C_AK + g * 64 + wid * 8;
        const bf16_t* vcol = P + C_AV + g * 64 + (wid >> 2) * 32 + (lane & 3) * 8;
        const int krow_in = lane, vrow_in = 16 * (wid & 3) + (lane >> 2);
#define SWA_ROW0(i) ((i) < nwin ? b * NSEQ + (tw_lo + (i)) * 64 : NLAT + b * NCTX + ((i) - nwin) * 64)
        bf16x8 qr[4];
        { const bf16_t* qp = P + (size_t)(qrow0 + wid * 32 + r32) * DIN + C_AQ + h * 64 + hi * 8;
#pragma unroll
          for (int d0 = 0; d0 < 4; ++d0) qr[d0] = *(const bf16x8*)(qp + d0 * 16); }
        asm volatile("" :: "v"(qr[0]), "v"(qr[1]), "v"(qr[2]), "v"(qr[3]));
        f32x16 o[2]; float mhat = p.sink[l * 4 + h] * 1.4426950408889634f, lsum = hi == 0 ? 1.0f : 0.0f;
#pragma unroll
        for (int r = 0; r < 16; ++r) { o[0][r] = 0.f; o[1][r] = 0.f; }
        const int qw = q0 + wid * 32, qpos = qw + r32;
        const unsigned lds0 = (unsigned)(size_t)sm + (unsigned)wid * 1024u;
#define DMA_TILE(i) do { const int r0_ = SWA_ROW0(i); const unsigned sl_ = (unsigned)((i) & 3) * 8192u; \
        glds16(kcol + (size_t)(r0_ + krow_in) * DIN, (unsigned)__builtin_amdgcn_readfirstlane(lds0 + DD_K + sl_)); glds16(vcol + (size_t)(r0_ + vrow_in) * DIN, (unsigned)__builtin_amdgcn_readfirstlane(lds0 + DD_V + sl_)); } while (0)
        asm volatile("s_waitcnt lgkmcnt(0)\n\ts_barrier" ::: "memory");
        DMA_TILE(0); DMA_TILE(1); DMA_TILE(2);
        for (int i = 0; i < nt; ++i) {
            const int cur = i & 3;
            if (i + 2 < nt) asm volatile("s_waitcnt vmcnt(4)\n\ts_barrier" ::: "memory");
            else if (i + 1 < nt) asm volatile("s_waitcnt vmcnt(2)\n\ts_barrier" ::: "memory");
            else asm volatile("s_waitcnt vmcnt(0)\n\ts_barrier" ::: "memory");
            if (i + 3 < nt) DMA_TILE(i + 3);
            const bool win = i < nwin; const int T = (tw_lo + i) * 64;
            const bool skip = win && (T > qw + 31 + 128 || T + 63 < qw - 128);
            if (!skip) {
                const LAS char* kb = sm + DD_K + cur * 8192 + hi * 1024 + r32 * 16;
                const LAS char* vb = sm + DD_V + cur * 8192 + ((lane >> 4) & 1) * 32 + (lane & 3) * 8 + (4 * hi + ((lane & 15) >> 2)) * 64;
                float nm = -mhat; asm volatile("" : "+v"(nm));
                f32x16 c0, c1;
#pragma unroll
                for (int r = 0; r < 16; ++r) { c0[r] = nm; c1[r] = nm; }
#pragma unroll
                for (int j = 0; j < 4; ++j) {
                    c0 = __builtin_amdgcn_mfma_f32_32x32x16_bf16(*(const LAS bf16x8*)(kb + j * 2048), qr[j], c0, 0, 0, 0);
                    c1 = __builtin_amdgcn_mfma_f32_32x32x16_bf16(*(const LAS bf16x8*)(kb + j * 2048 + 512), qr[j], c1, 0, 0, 0); }
                if (win && (T < qw + 31 - 128 || T + 63 > qw + 128)) {
#pragma unroll
                    for (int r = 0; r < 16; ++r) { const int kp = T + crow(r, hi); const int d0_ = qpos - kp, d1_ = d0_ - 32;
                        if (d0_ > 128 || d0_ < -128) c0[r] = -1.0e30f;
                        if (d1_ > 128 || d1_ < -128) c1[r] = -1.0e30f; }
                }
                float rm = fmaxf(c0[0], c1[0]);
#pragma unroll
                for (int r = 1; r < 16; ++r) rm = fmaxf(rm, fmaxf(c0[r], c1[r]));
                rm = xhalf_max(rm);
                if (__any(rm > 8.0f)) {
                    const float dl = fmaxf(rm, 0.f); mhat += dl;
#pragma unroll
                    for (int r = 0; r < 16; ++r) { c0[r] -= dl; c1[r] -= dl; }
                    const float f = __builtin_amdgcn_exp2f(-dl); lsum *= f;
                    if (hi == 0) wsf[r32] = f;
#pragma unroll
                    for (int r = 0; r < 16; ++r) { const float fr_ = wsf[crow(r, hi)]; o[0][r] *= fr_; o[1][r] *= fr_; }
                }
                float sacc = 0.f;
#pragma unroll
                for (int r = 0; r < 16; ++r) { c0[r] = __builtin_amdgcn_exp2f(c0[r]); c1[r] = __builtin_amdgcn_exp2f(c1[r]); sacc += c0[r] + c1[r]; }
                lsum += sacc;
                u32x4 pw[4];
#pragma unroll
                for (int k = 0; k < 2; ++k) {
                    pw[k] = (u32x4){cvtpk_s(c0[8 * k + 0], c0[8 * k + 1]), cvtpk_s(c0[8 * k + 2], c0[8 * k + 3]), cvtpk_s(c0[8 * k + 4], c0[8 * k + 5]), cvtpk_s(c0[8 * k + 6], c0[8 * k + 7])};
                    pw[2 + k] = (u32x4){cvtpk_s(c1[8 * k + 0], c1[8 * k + 1]), cvtpk_s(c1[8 * k + 2], c1[8 * k + 3]), cvtpk_s(c1[8 * k + 4], c1[8 * k + 5]), cvtpk_s(c1[8 * k + 6], c1[8 * k + 7])}; }
#pragma unroll
                for (int k = 0; k < 4; ++k) {
                    const s16x4 lo0 = vtr(vb + k * 1024), hi0 = vtr(vb + k * 1024 + 512), lo1 = vtr(vb + 4096 + k * 1024), hi1 = vtr(vb + 4096 + k * 1024 + 512);
                    o[0] = __builtin_amdgcn_mfma_f32_32x32x16_bf16(__builtin_bit_cast(bf16x8, pw[k]), (bf16x8){lo0[0], lo0[1], lo0[2], lo0[3], hi0[0], hi0[1], hi0[2], hi0[3]}, o[0], 0, 0, 0);
                    o[1] = __builtin_amdgcn_mfma_f32_32x32x16_bf16(__builtin_bit_cast(bf16x8, pw[k]), (bf16x8){lo1[0], lo1[1], lo1[2], lo1[3], hi1[0], hi1[1], hi1[2], hi1[3]}, o[1], 0, 0, 0); }
            }
            asm volatile("s_waitcnt lgkmcnt(0)" ::: "memory");
        }
#undef SWA_ROW0
#undef DMA_TILE
        const float inv = 1.0f / xhalf_sum(lsum);
        int lane_e = TIDX & 63;
        { const int r32e = lane_e & 31, hie = lane_e >> 5;
        LAS float* wse = (LAS float*)(sm + DD_WS) + wid * 64; LAS float* stge = (LAS float*)(sm + DD_ST) + wid * 2048;
        if (hie == 0) wse[r32e] = inv;
#pragma unroll
        for (int r = 0; r < 16; ++r) { const int q = crow(r, hie); const float i0 = wse[q]; stge[q * 64 + r32e] = o[0][r] * i0; stge[q * 64 + 32 + r32e] = o[1][r] * i0; } }
        LAS float* stg = (LAS float*)(sm + DD_ST) + wid * 2048;
#pragma unroll
        for (int i = 0; i < 4; ++i) { const int row = i * 8 + (lane_e >> 3), ch = lane_e & 7;
            const f32x4 v0 = *(const LAS f32x4*)(stg + row * 64 + ch * 8), v1 = *(const LAS f32x4*)(stg + row * 64 + ch * 8 + 4);
            u32x4 w; w.x = cvtpk_s(v0[0], v0[1]); w.y = cvtpk_s(v0[2], v0[3]); w.z = cvtpk_s(v1[0], v1[1]); w.w = cvtpk_s(v1[2], v1[3]);
            *(u32x4*)(O + (size_t)(qrow0 + wid * 32 + row) * DM + h * 64 + ch * 8) = w; }
    }
}

__device__ __forceinline__ void moe_offsets(const Params& p, int* offs  ) {
    if (TIDX < 2) { const unsigned* cw = (const unsigned*)p.ws + CW_CNT + TIDX * 8; int o = 0;
        for (int e = 0; e < 8; ++e) { offs[TIDX * 9 + e] = o; o += ((int)__hip_atomic_load(cw + e, __ATOMIC_RELAXED, __HIP_MEMORY_SCOPE_AGENT) + 255) & ~255; }
        offs[TIDX * 9 + 8] = o; }
    __syncthreads();
}
__device__ __forceinline__ void ph_moe_scatter(const Params& p, int bid, int nb, float* lds) {
    char* ws = p.ws; int* offs = (int*)lds; moe_offsets(p, offs);
    const int lane = TIDX & 63, wv = TIDX >> 6;
    const bf16_t* H = (const bf16_t*)(ws + OFF_ACT); bf16_t* AS = (bf16_t*)(ws + OFF_ASORT);
    int* tok = (int*)(ws + OFF_TOK); float* wgt = (float*)(ws + OFF_WGT); const unsigned* cw = (const unsigned*)ws;
    const int step = nb * 8 * 4; int r0 = (bid * 8 + wv) * 4;
    int4 rec[4]; u32x4 d8[4];
#define SC_LOAD(rc, dd, rbase) do { _Pragma("unroll") for (int k = 0; k < 4; ++k) { rc[k] = *(const int4*)(ws + OFF_ROUTE + (size_t)((rbase) + k) * 16); dd[k] = ((const u32x4*)((const unsigned char*)H + (size_t)((rbase) + k) * DM))[lane]; } } while (0)
    if (r0 < NLAT) SC_LOAD(rec, d8, r0);
    for (; r0 < NLAT; r0 += step) {
        int pos[4][2];
#pragma unroll
        for (int k = 0; k < 4; ++k) { const int blk = ((r0 + k) >> 3) % nb;
#pragma unroll
            for (int g = 0; g < 2; ++g) { const int e = (g == 0 ? rec[k].x : rec[k].y) & 15, li = (g == 0 ? rec[k].x : rec[k].y) >> 4;
                pos[k][g] = offs[g * 9 + e] + (int)cw[CW_BLK + blk * 16 + g * 8 + e] + li; } }
        const int rn = r0 + step < NLAT ? r0 + step : r0;
        int4 recn[4]; u32x4 d8n[4];
        SC_LOAD(recn, d8n, rn);
#pragma unroll
        for (int k = 0; k < 4; ++k)
#pragma unroll
            for (int g = 0; g < 2; ++g) { const int ps = pos[k][g];
                u32x4* dst = (u32x4*)((unsigned char*)AS + ((size_t)g * GRP_ROWS + ps) * DM); dst[lane] = d8[k]; }
#pragma unroll
        for (int k = 0; k < 4; ++k) { rec[k] = recn[k]; d8[k] = d8n[k]; }
    }
#undef SC_LOAD
}

__device__ __forceinline__ void ph_final(const Params& p, int bid, int nb, float* lds) {
    char* ws = p.ws; int* offs = (int*)lds; __syncthreads(); moe_offsets(p, offs);
    const int lane = TIDX & 63, wv = TIDX >> 6;
    const bf16_t* Y = (const bf16_t*)(ws + OFF_YMOE); const unsigned* cw = (const unsigned*)ws;
    const float* gt2 = (const float*)(ws + OFF_MOD) + (size_t)3 * 6144 + 5120;
    const int stride = nb * 8;
    int4 rec[2]; int pos[2][2];
#define FIN_REC(dst, rbase) do { _Pragma("unroll") for (int q = 0; q < 2; ++q) { const int r_ = ((rbase) + q * stride < NLAT) ? (rbase) + q * stride : (rbase); dst[q] = *(const int4*)(ws + OFF_ROUTE + (size_t)r_ * 16); } } while (0)
#define FIN_POS(dst, src_, rbase) do { _Pragma("unroll") for (int q = 0; q < 2; ++q) { const int r_ = ((rbase) + q * stride < NLAT) ? (rbase) + q * stride : (rbase); const int blk_ = (r_ >> 3) % nb; \
        const int e0_ = src_[q].x & 15, e1_ = src_[q].y & 15; \
        dst[q][0] = offs[e0_] + (int)cw[CW_BLK + blk_ * 16 + e0_] + (src_[q].x >> 4); dst[q][1] = offs[9 + e1_] + (int)cw[CW_BLK + blk_ * 16 + 8 + e1_] + (src_[q].y >> 4); } } while (0)
    int r0 = bid * 8 + wv;
    float4 fg[4];
#pragma unroll
    for (int i = 0; i < 4; ++i) fg[i] = *(const float4*)(p.final_norm + i * 256 + lane * 4);
    float4 gq[2][4]; int gcls[2] = {-1, -1};
    if (r0 < NLAT) { FIN_REC(rec, r0); FIN_POS(pos, rec, r0); }
    for (; r0 < NLAT; r0 += 2 * stride) {
        const bool has1 = r0 + stride < NLAT; const int rn = r0 + 2 * stride; const bool more = rn < NLAT;
        const int rnc = more ? rn : r0;
        int4 recn[2]; int posn[2][2];
        FIN_REC(recn, rnc);
        float4 v[2][4]; uint2 ya[2][4], yb[2][4];
#pragma unroll
        for (int q = 0; q < 2; ++q) { const int r = (q == 0 || has1) ? r0 + q * stride : r0;
            { const int cls = __builtin_amdgcn_readfirstlane(mod_class(r));
              if (cls != gcls[q]) { gcls[q] = cls;
#pragma unroll
                  for (int i = 0; i < 4; ++i) gq[q][i] = *(const float4*)(gt2 + (size_t)cls * 6144 + i * 256 + lane * 4); } }
            const bf16_t* y0 = Y + (size_t)pos[q][0] * DM; const bf16_t* y1 = Y + ((size_t)GRP_ROWS + pos[q][1]) * DM; const bf16_t* xr = (const bf16_t*)(ws + OFF_XB) + (size_t)r * DM;
#pragma unroll
            for (int i = 0; i < 4; ++i) { const int c = i * 256 + lane * 4; { const uint2 w = *(const uint2*)(xr + c); v[q][i] = make_float4(BFLO(w.x), BFHI(w.x), BFLO(w.y), BFHI(w.y)); } ya[q][i] = *(const uint2*)(y0 + c); yb[q][i] = *(const uint2*)(y1 + c); } }
        FIN_POS(posn, recn, rnc);
        float ss[2];
#pragma unroll
        for (int q = 0; q < 2; ++q) { const float w0 = __int_as_float(rec[q].z), w1 = __int_as_float(rec[q].w); float s = 0.f;
#pragma unroll
            for (int i = 0; i < 4; ++i) { const uint2 a = ya[q][i], b = yb[q][i]; const float4 g = gq[q][i];
                v[q][i].x += g.x * (w0 * BFLO(a.x) + w1 * BFLO(b.x)); v[q][i].y += g.y * (w0 * BFHI(a.x) + w1 * BFHI(b.x)); v[q][i].z += g.z * (w0 * BFLO(a.y) + w1 * BFLO(b.y)); v[q][i].w += g.w * (w0 * BFHI(a.y) + w1 * BFHI(b.y));
                s += v[q][i].x * v[q][i].x + v[q][i].y * v[q][i].y + v[q][i].z * v[q][i].z + v[q][i].w * v[q][i].w; }
            ss[q] = wave_sum(s); }
#pragma unroll
        for (int q = 0; q < 2; ++q) { if (q == 1 && !has1) break;
            float* xr = p.out + (size_t)(r0 + q * stride) * DM; const float rn_ = rsqrtf(ss[q] * (1.0f / 1024.0f) + 1e-6f);
#pragma unroll
            for (int i = 0; i < 4; ++i) { const float4 g = fg[i];
                float4 o; o.x = v[q][i].x * rn_ * g.x; o.y = v[q][i].y * rn_ * g.y; o.z = v[q][i].z * rn_ * g.z; o.w = v[q][i].w * rn_ * g.w; *(float4*)(xr + i * 256 + lane * 4) = o; } }
#pragma unroll
        for (int q = 0; q < 2; ++q) { rec[q] = recn[q]; pos[q][0] = posn[q][0]; pos[q][1] = posn[q][1]; }
    }
#undef FIN_REC
#undef FIN_POS
}

struct EpiStoreBf16 {
    static constexpr bool PERM = true, AFTER_DRAIN = false; bf16_t* O; int ldc;
    __device__ __forceinline__ void operator()(const f32x4 (&acc)[2][2][4][2], const pg8::Unit& u, int wr, int wc, int fr, int fq) const {
        bf16_t* base = O + (size_t)(u.pm * 256 + wr * 64 + fr) * ldc + u.pn * 256 + wc * 32 + 8 * fq;
#pragma unroll
        for (int ai = 0; ai < 2; ++ai)
#pragma unroll
            for (int m = 0; m < 4; ++m) { bf16_t* rowp = base + (size_t)(ai * 128 + m * 16) * ldc;
#pragma unroll
                for (int bj = 0; bj < 2; ++bj) { const f32x4 v0 = acc[ai][bj][m][0], v1 = acc[ai][bj][m][1]; u32x4 w;
                    w.x = pg8::cvt_pk_bf16(v0[0], v0[1]); w.y = pg8::cvt_pk_bf16(v0[2], v0[3]); w.z = pg8::cvt_pk_bf16(v1[0], v1[1]); w.w = pg8::cvt_pk_bf16(v1[2], v1[3]);
                    *(u32x4*)(rowp + bj * 128) = w; } }
    }
};
template <bool F8OUT>
struct EpiSwiglu {
    static constexpr bool PERM = true, AFTER_DRAIN = false; void* U; int ldu, npe;
    __device__ __forceinline__ void operator()(const f32x4 (&acc)[2][2][4][2], const pg8::Unit& u, int wr, int wc, int fr, int fq) const {
        { const int ln_ = (int)__builtin_amdgcn_mbcnt_hi(~0u, __builtin_amdgcn_mbcnt_lo(~0u, 0u)); fr = ln_ & 15; fq = ln_ >> 4; }
        const size_t e0 = (size_t)(u.pm * 256 + wr * 64 + fr) * ldu + (u.pn % npe) * 128 + wc * 32 + 8 * fq;
#pragma unroll
        for (int ai = 0; ai < 2; ++ai)
#pragma unroll
            for (int m = 0; m < 4; ++m) { float o[8];
#pragma unroll
                for (int n = 0; n < 2; ++n)
#pragma unroll
                    for (int i = 0; i < 4; i += 2) { const f32x2_t a2 = {acc[ai][0][m][n][i], acc[ai][0][m][n][i + 1]}, b2 = {acc[ai][1][m][n][i], acc[ai][1][m][n][i + 1]};
                        const f32x2_t t2 = a2 * -1.4426950408889634f; constexpr float s_ = F8OUT ? 1.0f / F8_ASCALE : 1.0f;
                        const f32x2_t e2 = {__builtin_amdgcn_exp2f(t2[0]), __builtin_amdgcn_exp2f(t2[1])}, d2 = e2 * s_ + s_;
                        const f32x2_t r2 = {__builtin_amdgcn_rcpf(d2[0]), __builtin_amdgcn_rcpf(d2[1])}, o2 = (a2 * b2) * r2;
                        o[n * 4 + i] = o2[0]; o[n * 4 + i + 1] = o2[1]; }
                const size_t e = e0 + (size_t)(ai * 128 + m * 16) * ldu;
                if (F8OUT) { uint2 w; w.x = pack4_fp8(o[0], o[1], o[2], o[3]); w.y = pack4_fp8(o[4], o[5], o[6], o[7]);
                    *(uint2*)((unsigned char*)U + e) = w; }
                else { u32x4 w; w.x = pg8::cvt_pk_bf16(o[0], o[1]); w.y = pg8::cvt_pk_bf16(o[2], o[3]); w.z = pg8::cvt_pk_bf16(o[4], o[5]); w.w = pg8::cvt_pk_bf16(o[6], o[7]);
                    *(u32x4*)((bf16_t*)U + e) = w; } }
    }
};
template <bool IN_F32>
struct EpiResidual {
    static constexpr bool PERM = true, AFTER_DRAIN = false; const float* xin; bf16_t* xb; const float* gate;
    __device__ __forceinline__ void operator()(const f32x4 (&acc)[2][2][4][2], const pg8::Unit& u, int wr, int wc, int fr, int fq) const {
        { const int ln_ = (int)__builtin_amdgcn_mbcnt_hi(~0u, __builtin_amdgcn_mbcnt_lo(~0u, 0u)); fr = ln_ & 15; fq = ln_ >> 4; }
        const int cls = u.pm < 64 ? 0 : 1, col0 = u.pn * 256 + wc * 32 + 8 * fq;
        const float* gv = gate + (size_t)cls * 6144 + col0;
        f32x4 g4[2][2];
#pragma unroll
        for (int bj = 0; bj < 2; ++bj)
#pragma unroll
            for (int n = 0; n < 2; ++n) g4[bj][n] = *(const f32x4*)(gv + bj * 128 + n * 4);
        const size_t row0 = (size_t)u.pm * 256 + wr * 64 + fr;
        f32x4 xv[8][2][2]; u32x4 xw[8][2];
#define ER_LD(i) do { const size_t off_ = (row0 + ((i) >> 2) * 128 + ((i) & 3) * 16) * DM + col0; \
            _Pragma("unroll") for (int bj = 0; bj < 2; ++bj) { if (IN_F32) { xv[i][bj][0] = *(const f32x4*)(xin + off_ + bj * 128); xv[i][bj][1] = *(const f32x4*)(xin + off_ + bj * 128 + 4); } \
                                                                else xw[i][bj] = *(const u32x4*)(xb + off_ + bj * 128); } } while (0)
#define ER_ST(i) do { const size_t off_ = (row0 + ((i) >> 2) * 128 + ((i) & 3) * 16) * DM + col0; \
            _Pragma("unroll") for (int bj = 0; bj < 2; ++bj) { f32x4 x0_, x1_; \
                if (IN_F32) { x0_ = xv[i][bj][0]; x1_ = xv[i][bj][1]; } \
                else { const u32x4 w_ = xw[i][bj]; x0_ = (f32x4){BFLO(w_.x), BFHI(w_.x), BFLO(w_.y), BFHI(w_.y)}; x1_ = (f32x4){BFLO(w_.z), BFHI(w_.z), BFLO(w_.w), BFHI(w_.w)}; } \
                const f32x4 o0_ = x0_ + g4[bj][0] * acc[(i) >> 2][bj][(i) & 3][0], o1_ = x1_ + g4[bj][1] * acc[(i) >> 2][bj][(i) & 3][1]; \
                u32x4 ow_; ow_.x = pg8::cvt_pk_bf16(o0_[0], o0_[1]); ow_.y = pg8::cvt_pk_bf16(o0_[2], o0_[3]); ow_.z = pg8::cvt_pk_bf16(o1_[0], o1_[1]); ow_.w = pg8::cvt_pk_bf16(o1_[2], o1_[3]); \
                *(u32x4*)(xb + off_ + bj * 128) = ow_; } } while (0)
        ER_LD(0); ER_LD(1); ER_LD(2);
#pragma unroll
        for (int i = 0; i < 8; ++i) { ER_ST(i); if (i + 3 < 8) ER_LD(i + 3); }
#undef ER_LD
#undef ER_ST
    }
};
struct MoeOrder : pg8::StaticOrder {
    int goff, npe, np0;
    __device__ __forceinline__ bool next(int i, pg8::Unit& u) const {
        int pl, pn;
        if (G == 256) {
            const int xcd = c & 7, slot = c >> 3, sb = i * 8 + xcd, NG = nN >> 2, pg = sb / NG, ng = sb - pg * NG;
            pl = pg * 8 + (slot >> 2); pn = ng * 4 + (slot & 3);
            if (pl >= nM) return false;
        } else { const int L = i * G + c; if (L >= nwg) return false; pl = L / nN; pn = L - pl * nN; }
        const int g = pl >= np0 ? 1 : 0, pm = pl - g * np0; u.pn = pn;
        const LAS int* og = (const LAS int*)(size_t)(unsigned)goff + g * 9;
        const int r = pm * 256; int e = 0;
#pragma unroll
        for (int k = 1; k < 8; ++k) e += (r >= og[k]) ? 1 : 0;
        u.pm = g * (GRP_ROWS / 256) + pm; u.pn += __builtin_amdgcn_readfirstlane(e) * npe; return true;
    }
};
#define GEMM_LDS ((PG8_LAS unsigned char*)lds)
struct EpiInProj {
    static constexpr bool PERM = true, AFTER_DRAIN = false; bf16_t* O; const char* tab;
    __device__ __forceinline__ void operator()(const f32x4 (&acc)[2][2][4][2], const pg8::Unit& u, int wr, int wc, int fr, int fq) const {
        const int row0 = u.pm * 256 + wr * 64 + fr; const bool lat = u.pm < 128;
#pragma unroll
        for (int bj = 0; bj < 2; ++bj) {
            const int s = u.pn * 2 + bj;
            int mode = 0; float scale = 1.0f;
            if (s <= 1) { mode = 1; scale = 0.125f * 1.4426950408889634f; } else if (s == 2) mode = 1;
            else if (s == 4 || s == 5) mode = 2; else if (s == 6 || s == 7) { mode = 2; scale = 0.125f; }
            else if (s == 12 || s == 13) { mode = 3; scale = 0.17677669529663687f * 1.4426950408889634f; } else if (s == 14 || s == 15) mode = 3;
            if (mode == 0) {
                bf16_t* base = O + (size_t)row0 * DIN + s * 128 + wc * 32 + 8 * fq;
#pragma unroll
                for (int ai = 0; ai < 2; ++ai)
#pragma unroll
                    for (int m = 0; m < 4; ++m) { const f32x4 v0 = acc[ai][bj][m][0], v1 = acc[ai][bj][m][1]; u32x4 w;
                        w.x = pg8::cvt_pk_bf16(v0[0], v0[1]); w.y = pg8::cvt_pk_bf16(v0[2], v0[3]); w.z = pg8::cvt_pk_bf16(v1[0], v1[1]); w.w = pg8::cvt_pk_bf16(v1[2], v1[3]);
                        *(u32x4*)(base + (size_t)(ai * 128 + m * 16) * DIN) = w; }
            } else {
                const bool wide = mode != 3; const int half = wide ? 32 : 16, g = wide ? 4 * (wc & 1) + fq : fq;
                const int cbase = s * 128 + (wide ? 64 * (wc >> 1) : 32 * wc) + 4 * g;
                const float* ct = (const float*)(tab + (mode == 1 ? TAB_ATTN : (mode == 2 ? TAB_RET : TAB_DIFF))) + 4 * g; const int tstride = half, tsin = 16384 * half;
                f32x4 csv[8], snv[8];
#pragma unroll
                for (int i = 0; i < 8; ++i) { const int row = row0 + (i >> 2) * 128 + (i & 3) * 16; const float* tp = ct + (size_t)(row & (NSEQ - 1)) * tstride;
                    csv[i] = *(const f32x4*)tp; snv[i] = *(const f32x4*)(tp + tsin); }
                asm volatile("" :: "v"(csv[0]), "v"(csv[1]), "v"(csv[2]), "v"(csv[3]), "v"(csv[4]), "v"(csv[5]), "v"(csv[6]), "v"(csv[7]), "v"(snv[0]), "v"(snv[1]), "v"(snv[2]), "v"(snv[3]), "v"(snv[4]), "v"(snv[5]), "v"(snv[6]), "v"(snv[7]));
                const bool oddq = (fq & 1) != 0;
#pragma unroll
                for (int ai = 0; ai < 2; ++ai)
#pragma unroll
                    for (int mp = 0; mp < 4; mp += 2) { uint2 wa[2], wb[2];
#pragma unroll
                        for (int k = 0; k < 2; ++k) { const int m = mp + k; const f32x4 v0 = acc[ai][bj][m][0], v1 = acc[ai][bj][m][1];
                            f32x4 cs = {1.f, 1.f, 1.f, 1.f}, sn = {0.f, 0.f, 0.f, 0.f};
                            if (lat) { cs = csv[ai * 4 + m]; sn = snv[ai * 4 + m]; }
                            const f32x4 o1 = (v0 * cs - v1 * sn) * scale, o2 = (v1 * cs + v0 * sn) * scale;
                            wa[k].x = pg8::cvt_pk_bf16(o1[0], o1[1]); wa[k].y = pg8::cvt_pk_bf16(o1[2], o1[3]); wb[k].x = pg8::cvt_pk_bf16(o2[0], o2[1]); wb[k].y = pg8::cvt_pk_bf16(o2[2], o2[3]); }
                        const auto ax = __builtin_amdgcn_permlane16_swap(wa[0].x, wa[1].x, false, false), ay = __builtin_amdgcn_permlane16_swap(wa[0].y, wa[1].y, false, false);
                        const auto bx = __builtin_amdgcn_permlane16_swap(wb[0].x, wb[1].x, false, false), by = __builtin_amdgcn_permlane16_swap(wb[0].y, wb[1].y, false, false);
                        const int row = row0 + ai * 128 + (mp + (oddq ? 1 : 0)) * 16;
                        bf16_t* op = O + (size_t)row * DIN + cbase - (oddq ? 4 : 0);
                        *(u32x4*)op = (u32x4){ax[0], ay[0], ax[1], ay[1]}; *(u32x4*)(op + half) = (u32x4){bx[0], by[0], bx[1], by[1]}; }
            }
        }
    }
};
template <int K>
__device__ __forceinline__ void ctx_gemm_residual(const bf16_t* A, const bf16_t* W, float* xc, const float* gate, int bid, int nb, float* lds) {
    const int tid = TIDX, lane = tid & 63, wid = __builtin_amdgcn_readfirstlane(tid >> 6);
    constexpr int KW = K / 8, NS = KW / 16, CH = (NS % 11 == 0) ? 11 : 8;
    static_assert(K % 128 == 0 && NS % CH == 0, "ctx_gemm_residual: K split");
    LAS float* red = (LAS float*)lds;
    for (int tile = bid; tile < 256; tile += nb) {
        const int row0 = (tile >> 4) * 32, col0 = (tile & 15) * 64;
        const bf16_t* ap = A + (size_t)(row0 + (lane & 31)) * K + wid * KW + (lane >> 5) * 8;
        const bf16_t* bp = W + (size_t)(col0 + (lane & 31)) * K + wid * KW + (lane >> 5) * 8;
        f32x16 c0, c1;
#pragma unroll
        for (int r = 0; r < 16; ++r) { c0[r] = 0.f; c1[r] = 0.f; }
#pragma unroll 1
        for (int s0 = 0; s0 < NS; s0 += CH) {
            bf16x8 af[CH], b0[CH], b1[CH];
#pragma unroll
            for (int i = 0; i < CH; ++i) { af[i] = *(const bf16x8*)(ap + (s0 + i) * 16); b0[i] = *(const bf16x8*)(bp + (s0 + i) * 16); b1[i] = *(const bf16x8*)(bp + (size_t)32 * K + (s0 + i) * 16); }
#pragma unroll
            for (int i = 0; i < CH; ++i) { c0 = __builtin_amdgcn_mfma_f32_32x32x16_bf16(af[i], b0[i], c0, 0, 0, 0); c1 = __builtin_amdgcn_mfma_f32_32x32x16_bf16(af[i], b1[i], c1, 0, 0, 0); }
        }
        __syncthreads();
#pragma unroll
        for (int r = 0; r < 16; ++r) { red[((wid * 2 + 0) * 16 + r) * 64 + lane] = c0[r]; red[((wid * 2 + 1) * 16 + r) * 64 + lane] = c1[r]; }
        __syncthreads();
#pragma unroll
        for (int j = 0; j < 4; ++j) { const int o = tid + 512 * j; float s = 0.f;
#pragma unroll
            for (int w = 0; w < 8; ++w) s += red[w * 2048 + o];
            const int blk = o >> 10, r = (o >> 6) & 15, ln = o & 63, row = crow(r, ln >> 5), col = col0 + blk * 32 + (ln & 31);
            float* x = xc + (size_t)(row0 + row) * DM + col; *x = *x + gate[col] * s; }
    }
    __syncthreads();
}
__device__ __forceinline__ void ph_gemm_in(const Params& p, int l, int bid, int nb, float* lds) {
    char* ws = p.ws; pg8::Gemm g{(const bf16_t*)(ws + OFF_ACT), (const bf16_t*)(ws + OFF_WIN) + (size_t)l * DIN * DM, NROW, DIN, DM};
    pg8::StaticOrder S; S.init(NROW, DIN, nb, bid);
    EpiInProj E{(bf16_t*)(ws + OFF_P), ws + OFF_TAB};
    if (nb == 256 && bid >= 150) { const int v = CV_MOE0 + (l == 0 ? 0 : CV_TA + CV_TB); convert_units(p, lds, v + bid - 150, 106, v + CV_TA, 0, 0); }
    pg8::gemm_phase<EpiInProj, pg8::StaticOrder, true, true>(GEMM_LDS, g, S, E);
}
__device__ __forceinline__ void ph_gemm_out(const Params& p, int l, bool need_ctx, int bid, int nb, float* lds) {
    char* ws = p.ws; const int M = NLAT;
    if (need_ctx) ctx_gemm_residual<DM>((const bf16_t*)(ws + OFF_ACT) + (size_t)NLAT * DM, (const bf16_t*)(ws + OFF_WOUT) + (size_t)l * DM * DM, (float*)(ws + OFF_XC),
                                        (const float*)(ws + OFF_MOD) + (size_t)l * 3 * 6144 + 2048 + 2 * 6144, bid, nb, lds);
    pg8::Gemm g{(const bf16_t*)(ws + OFF_ACT), (const bf16_t*)(ws + OFF_WOUT) + (size_t)l * DM * DM, M, DM, DM};
    pg8::StaticOrder S; S.init(M, DM, nb, bid);
    const float* gate = (const float*)(ws + OFF_MOD) + (size_t)l * 3 * 6144 + 2048; bf16_t* xb = (bf16_t*)(ws + OFF_XB);
    if (l == 0) { EpiResidual<true> E{p.x, xb, gate}; pg8::gemm_phase<EpiResidual<true>, pg8::StaticOrder, true, true>(GEMM_LDS, g, S, E); }
    else { EpiResidual<false> E{nullptr, xb, gate}; pg8::gemm_phase<EpiResidual<false>, pg8::StaticOrder, true, true>(GEMM_LDS, g, S, E); }
}
__device__ __forceinline__ void ph_ffn1(const Params& p, bool need_ctx, int bid, int nb, float* lds) {
    char* ws = p.ws; const int M = need_ctx ? NROW : NLAT;
    pg8::Gemm g{(const bf16_t*)(ws + OFF_ACT), (const bf16_t*)(ws + OFF_WF13), M, 2 * DFF, DM / 2};
    pg8::StaticOrder S; S.init(M, 2 * DFF, nb, bid);
    EpiSwiglu<false> E{(void*)(ws + OFF_P), DFF, 2 * DFF / 256};
    if (nb == 256 && need_ctx && bid >= 44) { const int v = CV_MOE0 + CV_TA; convert_units(p, lds, v + bid - 44, 212, v + CV_TB, 0, 0); }
    pg8::gemm_phase<EpiSwiglu<false>, pg8::StaticOrder, true, true, true>(GEMM_LDS, g, S, E);
}
__device__ __forceinline__ void ph_ffn2(const Params& p, int l, bool need_ctx, int bid, int nb, float* lds) {
    char* ws = p.ws; const int M = NLAT;
    if (need_ctx) ctx_gemm_residual<DFF>((const bf16_t*)(ws + OFF_P) + (size_t)NLAT * DFF, (const bf16_t*)(ws + OFF_WF2), (float*)(ws + OFF_XC),
                                         (const float*)(ws + OFF_MOD) + (size_t)l * 3 * 6144 + 5120 + 2 * 6144, bid, nb, lds);
    pg8::Gemm g{(const bf16_t*)(ws + OFF_P), (const bf16_t*)(ws + OFF_WF2), M, DM, DFF};
    pg8::StaticOrder S; S.init(M, DM, nb, bid);
    EpiResidual<false> E{nullptr, (bf16_t*)(ws + OFF_XB), (const float*)(ws + OFF_MOD) + (size_t)l * 3 * 6144 + 5120};
    pg8::gemm_phase<EpiResidual<false>, pg8::StaticOrder, true, true>(GEMM_LDS, g, S, E);
}
__device__ __forceinline__ MoeOrder moe_order(const int* offs, int npe, int nb, int bid) {
    MoeOrder S; const int r0 = __builtin_amdgcn_readfirstlane(offs[8]), r1 = __builtin_amdgcn_readfirstlane(offs[17]);
    S.init(r0 + r1, npe * 256, nb, bid); S.goff = (int)(unsigned)(size_t)(const LAS int*)offs; S.npe = npe; S.np0 = r0 >> 8; return S;
}
__device__ __forceinline__ void ph_moe1(const Params& p, int bid, int nb, float* lds) {
    char* ws = p.ws; int* offs = (int*)(lds + 32768); __syncthreads(); moe_offsets(p, offs);
    const MoeOrder S = moe_order(offs, 2 * DFE / 256, nb, bid);
    pg8::Gemm gm{(const bf16_t*)(ws + OFF_ASORT), (const bf16_t*)(ws + OFF_WM13), 0, 0, DM / 2};
    EpiSwiglu<true> E{(void*)(ws + OFF_UMOE), DFE, 2 * DFE / 256};
    pg8::gemm_phase<EpiSwiglu<true>, MoeOrder, true, true, true>(GEMM_LDS, gm, S, E);
}
struct EpiMoeOut {
    static constexpr bool PERM = true, AFTER_DRAIN = false; bf16_t* Y; int npe;
    __device__ __forceinline__ void operator()(const f32x4 (&acc)[2][2][4][2], const pg8::Unit& u, int wr, int wc, int fr, int fq) const {
        { const int ln_ = (int)__builtin_amdgcn_mbcnt_hi(~0u, __builtin_amdgcn_mbcnt_lo(~0u, 0u)); fr = ln_ & 15; fq = ln_ >> 4; }
        bf16_t* base = Y + (size_t)(u.pm * 256 + wr * 64 + fr) * DM + (u.pn % npe) * 256 + wc * 32 + 8 * fq;
#pragma unroll
        for (int ai = 0; ai < 2; ++ai)
#pragma unroll
            for (int m = 0; m < 4; ++m) { bf16_t* rowp = base + (size_t)(ai * 128 + m * 16) * DM;
#pragma unroll
                for (int bj = 0; bj < 2; ++bj) { const f32x4 v0 = acc[ai][bj][m][0], v1 = acc[ai][bj][m][1]; u32x4 w;
                    w.x = pg8::cvt_pk_bf16(v0[0], v0[1]); w.y = pg8::cvt_pk_bf16(v0[2], v0[3]); w.z = pg8::cvt_pk_bf16(v1[0], v1[1]); w.w = pg8::cvt_pk_bf16(v1[2], v1[3]);
                    *(u32x4*)(rowp + bj * 128) = w; } }
    }
};
__device__ __forceinline__ void ph_moe2(const Params& p, int bid, int nb, float* lds) {
    char* ws = p.ws; int* offs = (int*)(lds + 32768); __syncthreads(); moe_offsets(p, offs);
    const MoeOrder S = moe_order(offs, DM / 256, nb, bid);
    pg8::Gemm gm{(const bf16_t*)(ws + OFF_UMOE), (const bf16_t*)(ws + OFF_WM2), 0, 0, DFE / 2};
    EpiMoeOut E{(bf16_t*)(ws + OFF_YMOE), DM / 256};
    pg8::gemm_phase<EpiMoeOut, MoeOrder, true, true, true>(GEMM_LDS, gm, S, E);
}

#define XB_TMO      128
#define XB_XCNT(j)  (256  + 64 * (j))
#define XB_XSUB(j)  (1280 + 64 * (j))
#define XB_XGEN(j)  (2304 + 64 * (j))
#define XB_TOP      3328
#define XB_TOPGEN   3392
#define XCD_BAR_WORDS 3456
#define XB_SPIN_CAP (1u << 22)

__device__ __forceinline__ unsigned xb_ld(unsigned* p)              { return __hip_atomic_load(p, __ATOMIC_RELAXED, __HIP_MEMORY_SCOPE_AGENT); }
__device__ __forceinline__ unsigned xb_add(unsigned* p, unsigned v) { return __hip_atomic_fetch_add(p, v, __ATOMIC_RELAXED, __HIP_MEMORY_SCOPE_AGENT); }
__device__ __forceinline__ unsigned xb_xcc_id() { return (unsigned)__builtin_amdgcn_s_getreg((3 << 11) | 20) & 0xFu; }
#define XB_SPIN(cond, bar) do { unsigned _sp = 0; while (cond) { __builtin_amdgcn_s_sleep(1); \
    if ((++_sp & 255u) == 0u) { if (xb_ld(&(bar)[XB_TMO])) break; if (_sp > XB_SPIN_CAP) { atomicAdd(&(bar)[XB_TMO], 1u); break; } } } } while (0)

struct XcdBarrier {
    unsigned* bar; unsigned x;
    volatile LAS unsigned* st;
};

__device__ __forceinline__ XcdBarrier xcd_barrier_post(unsigned* bar, volatile LAS unsigned* st) {
    XcdBarrier b; b.bar = bar; b.x = xb_xcc_id(); b.st = st;
    if (threadIdx.x == 0) (void)xb_add(&bar[XB_XCNT(b.x)], 1u);
    return b;
}
__device__ __forceinline__ void xcd_barrier_complete(unsigned* bar, unsigned x, unsigned& nloc, unsigned& nx) {
    const unsigned G = gridDim.x * gridDim.y * gridDim.z;
    unsigned sum, cnt, mine, sp = 0u;
    for (;;) {
        sum = 0u; cnt = 0u; mine = 0u;
#pragma unroll
        for (unsigned j = 0; j < 16; ++j) { const unsigned c = xb_ld(&bar[XB_XCNT(j)]); sum += c; cnt += (c > 0u) ? 1u : 0u; mine = (j == x) ? c : mine; }
        if (sum == G) break;
        __builtin_amdgcn_s_sleep(1);
        if ((++sp & 255u) == 0u) { if (xb_ld(&bar[XB_TMO])) break; if (sp > XB_SPIN_CAP) { atomicAdd(&bar[XB_TMO], 1u); break; } }
    }
    nloc = mine > 0u ? mine : 1u; nx = cnt > 0u ? cnt : 1u;
}

__device__ __forceinline__ void xcd_barrier(const XcdBarrier& b) {
    asm volatile("s_waitcnt vmcnt(0)" ::: "memory");
    __syncthreads();
    if (threadIdx.x == 0) {
        unsigned* bar = b.bar;
        __builtin_amdgcn_s_waitcnt(0);
        unsigned nloc = b.st[0], nx = b.st[1];
        if (nloc == 0u) { xcd_barrier_complete(bar, b.x, nloc, nx); b.st[0] = nloc; b.st[1] = nx; }
        const unsigned old = xb_add(&bar[XB_XSUB(b.x)], 1u);
        const unsigned gen = old / nloc;
        if (old + 1u == (gen + 1u) * nloc) {
            __builtin_amdgcn_fence(__ATOMIC_RELEASE, "agent");
            asm volatile("s_waitcnt vmcnt(0)" ::: "memory");
            const unsigned og = xb_add(&bar[XB_TOP], 1u);
            const unsigned tg = og / nx;
            if (og + 1u == (tg + 1u) * nx) xb_add(&bar[XB_TOPGEN], 1u);
            else XB_SPIN(xb_ld(&bar[XB_TOPGEN]) == tg, bar);
            __builtin_amdgcn_fence(__ATOMIC_ACQUIRE, "agent");
            xb_add(&bar[XB_XGEN(b.x)], 1u);
            asm volatile("s_waitcnt vmcnt(0)" ::: "memory");
        } else {
            XB_SPIN(xb_ld(&bar[XB_XGEN(b.x)]) == gen, bar);
            __builtin_amdgcn_fence(__ATOMIC_ACQUIRE, "agent");
            asm volatile("s_waitcnt vmcnt(0)" ::: "memory");
        }
    }
    __syncthreads();
}


constexpr int LDS_FLOATS = 33792;
constexpr int LDS_BYTES = LDS_FLOATS * 4 + 16 + 256 + 16;

typedef const __attribute__((address_space(4))) unsigned long long* kargp_t;
typedef __attribute__((address_space(1))) const float* gcf_t;
__device__ __forceinline__ Params load_params(const float* lds) {
    const LAS unsigned* tbl = (const LAS unsigned*)(lds + LDS_FLOATS + 4);
    Params p; const float** f = (const float**)&p;
#pragma unroll
    for (int i = 0; i < (int)(sizeof(Params) / 8); ++i) {
        const unsigned lo = __builtin_amdgcn_readfirstlane(tbl[2 * i]), hi = __builtin_amdgcn_readfirstlane(tbl[2 * i + 1]);
        f[i] = (const float*)(gcf_t)(((unsigned long long)hi << 32) | lo); }
    return p;
}
#define LOADP(name) const Params name = load_params(lds)

template <int l>
__device__ __forceinline__ void run_layer(const XcdBarrier& bar, int bid, int nb, float* lds) {
    constexpr bool need_ctx = l == 0;
    constexpr float lam_init = l == 0 ? 0.2f : 0.35550906759509393f;
    { LOADP(p); ph_norm<false>(p, l, 0, NROW, bid, nb, lds); } xcd_barrier(bar);
    { LOADP(p); ph_gemm_in(p, l, bid, nb, lds); } xcd_barrier(bar);
    { LOADP(p); ph_ret_summ(p, l, bid, nb, lds); } { LOADP(p); ph_lru_chunk<1>(p, l, bid, nb, lds, 0); } xcd_barrier(bar);
    { LOADP(p); ph_scan2(p, l, bid, nb); } xcd_barrier(bar);
    { LOADP(p); ph_diff(p, l, need_ctx, lam_init, bid, nb, lds); }
    { LOADP(p); ph_swa(p, l, need_ctx, bid, nb, lds); }
    { LOADP(p); ph_ret_out(p, l, bid, nb, lds, need_ctx ? 0 : 2); }
    { LOADP(p); ph_lru_chunk<3>(p, l, bid, nb, lds, need_ctx ? 0 : 2); } xcd_barrier(bar);
    { LOADP(p); ph_gemm_out(p, l, need_ctx, bid, nb, lds); } xcd_barrier(bar);
    if (l == 0) {
        { LOADP(p); ph_norm<false>(p, l, 1, NROW, bid, nb, lds); } xcd_barrier(bar);
        { LOADP(p); ph_ffn1(p, need_ctx, bid, nb, lds); } xcd_barrier(bar);
        { LOADP(p); ph_ffn2(p, l, need_ctx, bid, nb, lds); } xcd_barrier(bar);
    } else {
        { LOADP(p); ph_norm<true>(p, l, 1, NLAT, bid, nb, lds); } xcd_barrier(bar);
        { LOADP(p); ph_moe_scatter(p, bid, nb, lds); } xcd_barrier(bar);
        { LOADP(p); ph_moe1(p, bid, nb, lds); } xcd_barrier(bar);
        { LOADP(p); ph_moe2(p, bid, nb, lds); } xcd_barrier(bar);
    }
}

__global__ void __launch_bounds__(512, 2) fwd(Params p_in) {
    extern __shared__ __attribute__((aligned(16))) float lds[];
    volatile LAS unsigned* st = (volatile LAS unsigned*)(lds + LDS_FLOATS);
    if (threadIdx.x == 0) { st[0] = 0u; st[1] = 0u; st[2] = 0u; st[3] = 0u; }
    if (threadIdx.x < (int)(sizeof(Params) / 8)) { const kargp_t q = (kargp_t)__builtin_amdgcn_kernarg_segment_ptr(); ((LAS unsigned long long*)(lds + LDS_FLOATS + 4))[threadIdx.x] = q[threadIdx.x]; }
    __syncthreads();
    XcdBarrier bar;
    { LOADP(p); bar = xcd_barrier_post((unsigned*)p.ws, st); }
    const int bid = blockIdx.x, nb = gridDim.x;
    { LOADP(p); ph_prologue(p, bid, nb, lds); } xcd_barrier(bar);
    run_layer<0>(bar, bid, nb, lds);
    run_layer<1>(bar, bid, nb, lds);
    { LOADP(p); ph_final(p, bid, nb, lds); }
}

extern "C" void kernel_launch(void* const* d_in, const int* in_sizes, int n_in, void* d_out, int out_size, void* d_ws, size_t ws_size, hipStream_t stream) {
    static int grid = 0;
    if (grid == 0) {
        if (n_in < 30 || ws_size < WS_NEED) { fprintf(stderr, "kernel_launch: bad args n_in=%d ws=%zu need=%zu\n", n_in, ws_size, (size_t)WS_NEED); grid = -1; return; }
        int dev = 0, cus = 0, per_cu = 0;
        if (hipGetDevice(&dev) != hipSuccess || hipDeviceGetAttribute(&cus, hipDeviceAttributeMultiprocessorCount, dev) != hipSuccess) { grid = -1; return; }
        if (hipFuncSetAttribute((const void*)fwd, hipFuncAttributeMaxDynamicSharedMemorySize, LDS_BYTES) != hipSuccess) { fprintf(stderr, "kernel_launch: hipFuncSetAttribute failed\n"); grid = -1; return; }
        if (hipOccupancyMaxActiveBlocksPerMultiprocessor(&per_cu, (const void*)fwd, 512, LDS_BYTES) != hipSuccess || per_cu < 1) { fprintf(stderr, "kernel_launch: occupancy query says %d\n", per_cu); per_cu = 1; }
        (void)hipGetLastError();
        grid = cus;
    }
    if (grid < 0) return;
    Params p{};
    const float** f = (const float**)&p;
    for (int i = 0; i < 30; ++i) f[i] = (const float*)d_in[i];
    p.out = (float*)d_out; p.ws = (char*)d_ws;
    (void)hipMemsetAsync(d_ws, 0, 65536, stream);
    hipLaunchKernelGGL(fwd, dim3(grid), dim3(512), LDS_BYTES, stream, p);
}
```

```cpp
#include <hip/hip_runtime.h>
#include <cstdio>
#include <cstdint>

typedef unsigned short bf16_t;
typedef short bf16x8 __attribute__((ext_vector_type(8)));
typedef float f32x4 __attribute__((ext_vector_type(4)));
typedef unsigned u32x4 __attribute__((ext_vector_type(4)));
#define LAS __attribute__((address_space(3)))

constexpr int NB = 2, NSEQ = 16384, NCTX = 256, DM = 1024;
constexpr int NLAT = NB * NSEQ;
constexpr int NCR = NB * NCTX;
constexpr int NROW = NLAT + NCR;
constexpr int DIN = 2816, DFF = 2816, DFE = 3584, NE = 8;
constexpr int NCI = 130;
constexpr int C_AQ = 0, C_AK = 256, C_AV = 384, C_RQ = 512, C_RK = 768, C_RV = 1024, C_RG = 1280, C_DQ = 1536, C_DK = 1792, C_DV = 2048, C_LX = 2304, C_LY = 2560;
constexpr int GRP_ROWS = 34816;

constexpr size_t al256(size_t x) { return (x + 255) & ~(size_t)255; }
constexpr size_t OFF_CTRL = 0;
constexpr size_t OFF_MOD = 65536;
constexpr size_t OFF_TAB = al256(OFF_MOD + 2 * 3 * 6144 * 4);
constexpr size_t TAB_ATTN = 0, TAB_RET = 4u << 20, TAB_DIFF = 8u << 20;
constexpr size_t OFF_XC = al256(OFF_TAB + (10u << 20));
constexpr size_t OFF_ROUTE = al256(OFF_XC + (size_t)NCR * DM * 4);
constexpr size_t OFF_TOK = al256(OFF_ROUTE + (size_t)NLAT * 16);
constexpr size_t OFF_WGT = al256(OFF_TOK + (size_t)2 * GRP_ROWS * 4);
constexpr size_t OFF_LRU = al256(OFF_WGT + (size_t)2 * GRP_ROWS * 4);
constexpr size_t OFF_WM13 = al256(OFF_LRU + (size_t)3 * 2 * 2 * NCI * 256 * 4);
constexpr size_t OFF_WM2 = al256(OFF_WM13 + (size_t)NE * 2 * DFE * DM);
constexpr size_t OFF_XB = al256(OFF_WM2 + (size_t)NE * DM * DFE);
constexpr size_t OFF_R = al256(OFF_XB + (size_t)NLAT * DM * 2);
constexpr size_t OFF_P = OFF_R;
constexpr size_t OFF_ACT = al256(OFF_P + (size_t)NROW * DIN * 2);
constexpr size_t OFF_RET = al256(OFF_ACT + (size_t)NROW * DM * 2);
constexpr size_t OFF_WIN = al256(OFF_RET + (size_t)2 * 2 * NCI * 4 * 4096 * 4);
constexpr size_t OFF_WOUT = al256(OFF_WIN + (size_t)2 * DIN * DM * 2);
constexpr size_t OFF_WF13 = al256(OFF_WOUT + (size_t)2 * DM * DM * 2);
constexpr size_t OFF_WF2 = al256(OFF_WF13 + (size_t)2 * DFF * DM * 2);
constexpr size_t OFF_R_END1 = al256(OFF_WF2 + (size_t)DM * DFF * 2);
constexpr size_t OFF_ASORT = OFF_R;
constexpr size_t OFF_YMOE = OFF_ASORT;
constexpr size_t OFF_UMOE = al256(OFF_ASORT + (size_t)2 * GRP_ROWS * DM * 2);
constexpr size_t OFF_R_END2 = al256(OFF_UMOE + (size_t)GRP_ROWS * DFE * 2);
constexpr size_t WS_NEED = OFF_R_END1 > OFF_R_END2 ? OFF_R_END1 : OFF_R_END2;
static_assert(OFF_ACT >= OFF_UMOE, "H2 must not overlap A_sorted");
constexpr int CW_CNT = 4096;
constexpr int CW_BLK = 8192;

struct Params {
    const float *x, *c, *ctx, *c_ctx, *w_ada, *b_ada, *g1, *g2, *w_in, *w_out, *sink, *ret_logit, *ret_gn, *diff_lam, *diff_gn,
        *conv_w, *conv_b, *lru_wa, *lru_ba, *lru_wx, *lru_bx, *lru_lam, *ffn_w1, *ffn_w3, *ffn_w2, *moe_router, *moe_w1, *moe_w3, *moe_w2, *final_norm;
    float* out; char* ws;
};

__device__ __forceinline__ int ltid_() { int t = threadIdx.x; asm volatile("" : "+v"(t)); return t; }
#define TIDX ltid_()
__device__ __forceinline__ float bf2f(bf16_t h) { return __uint_as_float(((unsigned)h) << 16); }
__device__ __forceinline__ bf16_t f2bf(float f) { unsigned u = __float_as_uint(f); u += 0x7fffu + ((u >> 16) & 1u); return (bf16_t)(u >> 16); }
__device__ __forceinline__ unsigned pack2(float lo, float hi) { return (unsigned)f2bf(lo) | ((unsigned)f2bf(hi) << 16); }
__device__ __forceinline__ unsigned pack4_fp8(float a, float b, float c, float d) {
    a = fminf(fmaxf(a, -440.f), 440.f); b = fminf(fmaxf(b, -440.f), 440.f); c = fminf(fmaxf(c, -440.f), 440.f); d = fminf(fmaxf(d, -440.f), 440.f);
    unsigned w = 0u; w = __builtin_amdgcn_cvt_pk_fp8_f32(a, b, w, false); w = __builtin_amdgcn_cvt_pk_fp8_f32(c, d, w, true); return w;
}
constexpr float F8_WSCALE = 128.0f, F8_ASCALE = 8.0f;
constexpr int F8_WE8M0 = 127 - 7, F8_AE8M0 = 127 - 3, F8_SCALES = F8_WE8M0 | (F8_AE8M0 << 8);
#define BFLO(w) __uint_as_float((w) << 16)
#define BFHI(w) __uint_as_float((w) & 0xffff0000u)
__device__ __forceinline__ float wave_sum(float v) {
#pragma unroll
    for (int o = 32; o >= 1; o >>= 1) v += __shfl_xor(v, o);
    return v;
}
__device__ __forceinline__ float sigmoidf_(float x) { return 1.0f / (1.0f + __expf(-x)); }
__device__ __forceinline__ float siluf_(float x) { return x / (1.0f + __expf(-x)); }
__device__ __forceinline__ float fast_silu(float v) { return v * __builtin_amdgcn_rcpf(1.0f + __expf(-v)); }
__device__ __forceinline__ float softplusf_(float x) { return x > 20.f ? x : log1pf(expf(x)); }
__device__ __forceinline__ float gelu_tanh(float x) { const float u = 0.7978845608028654f * (x + 0.044715f * x * x * x); return x * __builtin_amdgcn_rcpf(1.0f + __expf(-2.0f * u)); }
__device__ __forceinline__ int row_base(int b, int ci) { return ci < 2 ? NLAT + b * NCTX + ci * 128 : b * NSEQ + (ci - 2) * 128; }
__device__ __forceinline__ int mod_class(int row) { return row < NSEQ ? 0 : (row < NLAT ? 1 : 2); }

typedef float f32x16 __attribute__((ext_vector_type(16)));
typedef short s16x4 __attribute__((ext_vector_type(4)));
typedef short v4i16_t __attribute__((ext_vector_type(4)));
typedef float f32x2_t __attribute__((ext_vector_type(2)));
typedef __bf16 bf16x2_t __attribute__((ext_vector_type(2)));
__device__ __forceinline__ unsigned cvtpk_s(float lo, float hi) { f32x2_t v = {lo, hi}; bf16x2_t bb = __builtin_convertvector(v, bf16x2_t); return __builtin_bit_cast(unsigned, bb); }
__device__ __forceinline__ int crow(int r, int hi) { return (r & 3) + 8 * (r >> 2) + 4 * hi; }
__device__ __forceinline__ s16x4 vtr(const LAS char* p) { return __builtin_bit_cast(s16x4, __builtin_amdgcn_ds_read_tr16_b64_v4i16((LAS v4i16_t*)p)); }
__device__ __forceinline__ float bfs(short s) { return __uint_as_float(((unsigned)(unsigned short)s) << 16); }

struct Ct4Regs { float4 a[4], b[4]; };
__device__ __forceinline__ void ct4_load(const float* src, int N, int unit, Ct4Regs& r) {
    const int upn = N / 256, tk = unit / upn, tn4 = unit % upn, t = TIDX, kk = t >> 3, nc = (t & 7) * 8;
#pragma unroll
    for (int q = 0; q < 4; ++q) { const float* sp = src + (size_t)(tk * 64 + kk) * N + tn4 * 256 + q * 64 + nc; r.a[q] = *(const float4*)sp; r.b[q] = *(const float4*)(sp + 4); }
}
__device__ __forceinline__ void ct4_store(const Ct4Regs& r, int K, int N, bf16_t* dst, int unit, int mode_, float* lds) {
    const int upn = N / 256, tk = unit / upn, tn4 = unit % upn, t = TIDX; const bool f8 = (mode_ & 8) != 0; const int mode = mode_ & 7;
    {   const int kk = t >> 3, nc = (t & 7) * 8;
#pragma unroll
        for (int q = 0; q < 4; ++q) { float* d = lds + q * (64 * 65) + kk * 65 + nc; d[0] = r.a[q].x; d[1] = r.a[q].y; d[2] = r.a[q].z; d[3] = r.a[q].w; d[4] = r.b[q].x; d[5] = r.b[q].y; d[6] = r.b[q].z; d[7] = r.b[q].w; } }
    __syncthreads();
    {   const int n = t >> 3, kc = (t & 7) * 8;
#pragma unroll
        for (int q = 0; q < 4; ++q) { const int ng = tn4 * 256 + q * 64 + n; const float* L = lds + q * (64 * 65);
            int nrow;
            if (mode == 3) {
                const int s = ng >> 7; const bool r64 = s <= 2 || (s >= 4 && s <= 7), r32 = s >= 12 && s <= 15;
                if (r64) { const int d = ng & 63; nrow = (ng & ~63) + 8 * ((d & 31) >> 2) + 4 * (d >> 5) + (d & 3); }
                else if (r32) { const int d = ng & 31; nrow = (ng & ~31) + 8 * ((d & 15) >> 2) + 4 * (d >> 4) + (d & 3); }
                else nrow = ng;
            } else nrow = mode == 0 ? ng : ((ng >> 7) * 256 + (mode == 2 ? 128 : 0) + (ng & 127));
            if (f8) { uint2 w; w.x = pack4_fp8(L[(kc + 0) * 65 + n] * F8_WSCALE, L[(kc + 1) * 65 + n] * F8_WSCALE, L[(kc + 2) * 65 + n] * F8_WSCALE, L[(kc + 3) * 65 + n] * F8_WSCALE);
                w.y = pack4_fp8(L[(kc + 4) * 65 + n] * F8_WSCALE, L[(kc + 5) * 65 + n] * F8_WSCALE, L[(kc + 6) * 65 + n] * F8_WSCALE, L[(kc + 7) * 65 + n] * F8_WSCALE);
                *(uint2*)((unsigned char*)dst + (size_t)nrow * K + tk * 64 + kc) = w; }
            else { uint4 w; w.x = pack2(L[(kc + 0) * 65 + n], L[(kc + 1) * 65 + n]); w.y = pack2(L[(kc + 2) * 65 + n], L[(kc + 3) * 65 + n]);
                w.z = pack2(L[(kc + 4) * 65 + n], L[(kc + 5) * 65 + n]); w.w = pack2(L[(kc + 6) * 65 + n], L[(kc + 7) * 65 + n]);
                *(uint4*)(dst + (size_t)nrow * K + tk * 64 + kc) = w; } } }
    __syncthreads();
}

constexpr int CV_T_IN = 16 * 11, CV_T_OUT = 16 * 4, CV_T_F13 = 16 * 11, CV_T_F2 = 44 * 4, CV_T_M13 = 16 * 14, CV_T_M2 = 56 * 4;
constexpr int CV_MOE0 = 2 * CV_T_IN + 2 * CV_T_OUT + 2 * CV_T_F13 + CV_T_F2, CV_TOTAL = CV_MOE0 + 16 * CV_T_M13 + 8 * CV_T_M2, CV_TA = 12 * 106, CV_TB = 4 * 212, CV_TAILS = 2 * CV_TA + CV_TB;
static_assert(CV_MOE0 + CV_TAILS <= CV_TOTAL, "conversion tails");
__device__ __forceinline__ void convert_units(const Params& p, float* lds, int v0, int vstep, int vend, int split, int skip) {
    char* ws = p.ws; const int t = TIDX;
    {
        struct Job { const float* src; bf16_t* dst; int K, N, mode, base; };
        Job* jobs = (Job*)(lds + 4 * 64 * 65);
        const int T_IN = CV_T_IN, T_OUT = CV_T_OUT, T_F13 = CV_T_F13, T_F2 = CV_T_F2, T_M13 = CV_T_M13, T_M2 = CV_T_M2;
        const int total = CV_TOTAL;
        if (t < 32) {
            Job jb; jb.src = nullptr; jb.dst = nullptr; jb.K = DM; jb.N = DM; jb.mode = 0; jb.base = total;
            if (t < 2) { jb.src = p.w_in + (size_t)t * DM * DIN; jb.dst = (bf16_t*)(ws + OFF_WIN) + (size_t)t * DIN * DM; jb.N = DIN; jb.mode = 3; jb.base = t * T_IN; }
            else if (t < 4) { jb.src = p.w_out + (size_t)(t - 2) * DM * DM; jb.dst = (bf16_t*)(ws + OFF_WOUT) + (size_t)(t - 2) * DM * DM; jb.base = 2 * T_IN + (t - 2) * T_OUT; }
            else if (t < 6) { jb.src = t == 4 ? p.ffn_w1 : p.ffn_w3; jb.dst = (bf16_t*)(ws + OFF_WF13); jb.N = DFF; jb.mode = 8 | (t - 3); jb.base = 2 * T_IN + 2 * T_OUT + (t - 4) * T_F13; }
            else if (t == 6) { jb.src = p.ffn_w2; jb.dst = (bf16_t*)(ws + OFF_WF2); jb.K = DFF; jb.base = 2 * T_IN + 2 * T_OUT + 2 * T_F13; }
            else if (t < 23) { const int q = t - 7, e = q & 7, w3 = q >> 3; jb.src = (w3 ? p.moe_w3 : p.moe_w1) + (size_t)e * DM * DFE; jb.dst = (bf16_t*)(ws + OFF_WM13 + (size_t)e * 2 * DFE * DM); jb.N = DFE; jb.mode = 8 | (1 + w3);
                jb.base = 2 * T_IN + 2 * T_OUT + 2 * T_F13 + T_F2 + q * T_M13; }
            else if (t < 31) { const int e = t - 23; jb.src = p.moe_w2 + (size_t)e * DFE * DM; jb.dst = (bf16_t*)(ws + OFF_WM2 + (size_t)e * DM * DFE); jb.K = DFE; jb.mode = 8;
                jb.base = 2 * T_IN + 2 * T_OUT + 2 * T_F13 + T_F2 + 16 * T_M13 + e * T_M2; }
            jobs[t] = jb;
        }
        __syncthreads();
#define JOB_SRC(jj) ((const float*)(__attribute__((address_space(1))) const float*)(unsigned long long)jobs[jj].src)
#define JOB_DST(jj) ((bf16_t*)(__attribute__((address_space(1))) bf16_t*)(unsigned long long)jobs[jj].dst)
#define CV_U(v) ((v) < split ? (v) : (v) + skip)
        int j = 0; Ct4Regs cur, nxt;
        if (v0 < vend) { const int u0 = CV_U(v0); while (u0 >= jobs[j + 1].base) ++j; ct4_load(JOB_SRC(j), jobs[j].N, u0 - jobs[j].base, cur); }
        for (int v = v0; v < vend; v += vstep) {
            const int u = CV_U(v), vn = v + vstep < vend ? v + vstep : v, un = CV_U(vn); int jn = j;
            while (un >= jobs[jn + 1].base) ++jn;
            ct4_load(JOB_SRC(jn), jobs[jn].N, un - jobs[jn].base, nxt);
            ct4_store(cur, jobs[j].K, jobs[j].N, JOB_DST(j), u - jobs[j].base, jobs[j].mode, lds);
            cur = nxt; j = jn;
        }
#undef JOB_SRC
#undef JOB_DST
#undef CV_U
        __syncthreads();
    }
}

__device__ __forceinline__ void ph_prologue(const Params& p, int bid, int nb, float* lds) {
    char* ws = p.ws; const int t = TIDX;
    { const bool tails = nb == 256; convert_units(p, lds, bid, nb, tails ? CV_TOTAL - CV_TAILS : CV_TOTAL, CV_MOE0, tails ? CV_TAILS : 0); }
    {
        float* sv = lds;
        float* red = lds + 3072;
        for (int i = t; i < 3072; i += 512) { const int v = i >> 10, k = i & 1023; const float cv = v < 2 ? p.c[v * DM + k] : p.c_ctx[k]; sv[i] = siluf_(cv); }
        __syncthreads();
        float* mod = (float*)(ws + OFF_MOD);
        for (int u = bid; u < 2 * 96; u += nb) {
            const int l = u / 96, j0 = (u % 96) * 64, j = t & 63, kg = t >> 6;
            float a0 = 0.f, a1 = 0.f, a2 = 0.f;
            const float* w = p.w_ada + (size_t)l * DM * 6144 + j0 + j;
            for (int k = kg * 128; k < kg * 128 + 128; ++k) { const float wv = w[(size_t)k * 6144]; a0 += sv[k] * wv; a1 += sv[1024 + k] * wv; a2 += sv[2048 + k] * wv; }
            red[(kg * 3 + 0) * 64 + j] = a0; red[(kg * 3 + 1) * 64 + j] = a1; red[(kg * 3 + 2) * 64 + j] = a2;
            __syncthreads();
            if (t < 192) { const int v = t >> 6; float s = 0.f;
                for (int g = 0; g < 8; ++g) s += red[(g * 3 + v) * 64 + j];
                mod[((size_t)l * 3 + v) * 6144 + j0 + j] = s + p.b_ada[l * 6144 + j0 + j]; }
            __syncthreads();
        }
    }
    {
        const int gt = bid * 512 + t, gs = nb * 512;
        float* ta = (float*)(ws + OFF_TAB + TAB_ATTN); float* tr = (float*)(ws + OFF_TAB + TAB_RET); float* td = (float*)(ws + OFF_TAB + TAB_DIFF);
        const int j = gt & 31;
        const float inv_r = (float)pow(10000.0, -(double)j / 32.0), inv_a = (float)pow(10000.0, -(double)(j & 15) / 16.0), inv_d = (float)pow(10000.0, -(double)(j & 7) / 8.0);
        for (int i = gt; i < 16384 * 32; i += gs) { const int n = i >> 5; double sv, cv;
            { const float ang = (float)n * inv_r; sincos((double)ang, &sv, &cv); tr[i] = (float)cv; tr[16384 * 32 + i] = (float)sv; }
            { const float ang = (float)(j < 16 ? (n >> 6) : (n & 63)) * inv_a; sincos((double)ang, &sv, &cv); ta[i] = (float)cv; ta[16384 * 32 + i] = (float)sv; }
            if (j < 16) { const float ang = (float)(j < 8 ? (n >> 6) : (n & 63)) * inv_d; sincos((double)ang, &sv, &cv); td[n * 16 + j] = (float)cv; td[16384 * 16 + n * 16 + j] = (float)sv; } }
        float* xc = (float*)(ws + OFF_XC);
        for (int i = gt; i < NCR * DM / 4; i += gs) ((float4*)xc)[i] = ((const float4*)p.ctx)[i];
    }
}

template <bool ROUTE>
__device__ __forceinline__ void ph_norm(const Params& p, int l, int which  , int nrows, int bid, int nb, float* lds) {
    char* ws = p.ws; const int lane = TIDX & 63, wv = TIDX >> 6;
    LAS unsigned* lcnt = (LAS unsigned*)lds;
    if (ROUTE) { __syncthreads(); if (TIDX < 16) lcnt[TIDX] = 0u; __syncthreads(); }
    const float* mod = (const float*)(ws + OFF_MOD) + (size_t)l * 3 * 6144;
    const float* g = (which == 0 ? p.g1 : p.g2) + l * DM;
    bf16_t* H = (bf16_t*)(ws + OFF_ACT);
    const bool xin32 = which == 0 && l == 0;
    const float* xl = p.x; const bf16_t* xb = (const bf16_t*)(ws + OFF_XB);
    const float* xc = (const float*)(ws + OFF_XC);
    const int stride = nb * 8;
    float rw[ROUTE ? 4 : 1][4][8];
    if (ROUTE) {
#pragma unroll
        for (int i = 0; i < 4; ++i) { const float* rt = p.moe_router + (size_t)(i * 256 + lane * 4) * 8;
#pragma unroll
            for (int k = 0; k < 4; ++k) { const float4 a = *(const float4*)(rt + k * 8), b = *(const float4*)(rt + k * 8 + 4);
                rw[i][k][0] = a.x; rw[i][k][1] = a.y; rw[i][k][2] = a.z; rw[i][k][3] = a.w; rw[i][k][4] = b.x; rw[i][k][5] = b.y; rw[i][k][6] = b.z; rw[i][k][7] = b.w; } } }
    float4 ma[4], mb[4]; int ccls = -1;
    constexpr int NQ = ROUTE ? 1 : 2;
    for (int r0 = bid * 8 + wv; r0 < nrows; r0 += NQ * stride) {
        float4 v[NQ][4]; float ss[NQ]; const bool has1 = NQ == 2 && r0 + stride < nrows;
#pragma unroll
        for (int q = 0; q < NQ; ++q) { const int r = (q == 0 || has1) ? r0 + q * stride : r0;
            if (xin32 || r >= NLAT) { const float* xr = r < NLAT ? xl + (size_t)r * DM : xc + (size_t)(r - NLAT) * DM;
#pragma unroll
                for (int i = 0; i < 4; ++i) v[q][i] = *(const float4*)(xr + i * 256 + lane * 4); }
            else { const bf16_t* xr = xb + (size_t)r * DM;
#pragma unroll
                for (int i = 0; i < 4; ++i) { const uint2 w = *(const uint2*)(xr + i * 256 + lane * 4); v[q][i] = make_float4(BFLO(w.x), BFHI(w.x), BFLO(w.y), BFHI(w.y)); } } }
#pragma unroll
        for (int q = 0; q < NQ; ++q) { float s = 0.f;
#pragma unroll
            for (int i = 0; i < 4; ++i) s += v[q][i].x * v[q][i].x + v[q][i].y * v[q][i].y + v[q][i].z * v[q][i].z + v[q][i].w * v[q][i].w;
            ss[q] = wave_sum(s); }
#pragma unroll
        for (int q = 0; q < NQ; ++q) {
            if (q == 1 && !has1) break;
            const int r = r0 + q * stride;
            const int cls = __builtin_amdgcn_readfirstlane(mod_class(r));
            if (cls != ccls) { const float* mv = mod + (size_t)cls * 6144 + (which == 0 ? 0 : 3072); ccls = cls;
#pragma unroll
                for (int i = 0; i < 4; ++i) { const int c = i * 256 + lane * 4; const float4 gg = *(const float4*)(g + c), sh = *(const float4*)(mv + c), sc = *(const float4*)(mv + 1024 + c);
                    ma[i] = make_float4(gg.x * (1.f + sc.x), gg.y * (1.f + sc.y), gg.z * (1.f + sc.z), gg.w * (1.f + sc.w)); mb[i] = sh; } }
            const float rn = rsqrtf(ss[q] * (1.0f / 1024.0f) + 1e-6f);
            float lg[8];
            if (ROUTE) {
#pragma unroll
                for (int e = 0; e < 8; ++e) lg[e] = 0.f;
            }
#pragma unroll
            for (int i = 0; i < 4; ++i) {
                const int c = i * 256 + lane * 4;
                float h0 = v[q][i].x * rn * ma[i].x + mb[i].x, h1 = v[q][i].y * rn * ma[i].y + mb[i].y;
                float h2 = v[q][i].z * rn * ma[i].z + mb[i].z, h3 = v[q][i].w * rn * ma[i].w + mb[i].w;
                if (which == 1) *(unsigned*)((unsigned char*)H + (size_t)r * DM + c) = pack4_fp8(h0 * F8_ASCALE, h1 * F8_ASCALE, h2 * F8_ASCALE, h3 * F8_ASCALE);
                else { uint2 w; w.x = pack2(h0, h1); w.y = pack2(h2, h3); *(uint2*)(H + (size_t)r * DM + c) = w; }
                if (ROUTE) {
#pragma unroll
                    for (int e = 0; e < 8; ++e) lg[e] += h0 * rw[ROUTE ? i : 0][0][e] + h1 * rw[ROUTE ? i : 0][1][e] + h2 * rw[ROUTE ? i : 0][2][e] + h3 * rw[ROUTE ? i : 0][3][e];
                }
            }
            if (ROUTE) {
#pragma unroll
                for (int e = 0; e < 8; ++e) lg[e] = wave_sum(lg[e]);
                if (lane == 0 && r < NLAT) {
                    int e0 = 0; float v0 = lg[0];
#pragma unroll
                    for (int e = 1; e < 8; ++e) if (lg[e] > v0) { v0 = lg[e]; e0 = e; }
                    int e1 = -1; float v1 = -3.0e38f;
#pragma unroll
                    for (int e = 0; e < 8; ++e) if (e != e0 && lg[e] > v1) { v1 = lg[e]; e1 = e; }
                    const float ex = __expf(v1 - v0), w0 = 1.0f / (1.0f + ex), w1 = ex / (1.0f + ex);
                    const unsigned li0 = __hip_atomic_fetch_add(lcnt + e0, 1u, __ATOMIC_RELAXED, __HIP_MEMORY_SCOPE_WORKGROUP), li1 = __hip_atomic_fetch_add(lcnt + 8 + e1, 1u, __ATOMIC_RELAXED, __HIP_MEMORY_SCOPE_WORKGROUP);
                    int4 rec; rec.x = e0 | (int)(li0 << 4); rec.y = e1 | (int)(li1 << 4); rec.z = __float_as_int(w0); rec.w = __float_as_int(w1);
                    *(int4*)(ws + OFF_ROUTE + (size_t)r * 16) = rec;
                }
            }
        }
    }
    if (ROUTE) {
        __syncthreads();
        if (TIDX < 16) { unsigned* cw = (unsigned*)ws; const int t = TIDX; cw[CW_BLK + bid * 16 + t] = atomicAdd(cw + CW_CNT + t, lcnt[t]); }
    }
}

namespace pg8 {
#define PG8_LAS __attribute__((address_space(3)))
typedef unsigned short bf16_t;
typedef short bf16x8 __attribute__((ext_vector_type(8)));
typedef float f32x4 __attribute__((ext_vector_type(4)));
typedef unsigned u32x4 __attribute__((ext_vector_type(4)));
constexpr int BM = 256, BK = 64, HALF = 128, HTB = HALF * BK * 2  , STAGE_BYTES = 8 * HTB, NXCD = 8, WGM = 8;

__host__ __device__ __forceinline__ int lds_byte(int r, int c) { const int st = (r >> 4) * 2 + (c >> 5), rr = r & 15, cc = c & 31, ob = rr * 64 + cc * 2; return st * 1024 + (ob ^ (((ob >> 9) & 1) << 5)); }
__host__ __device__ __forceinline__ void stage_rc(int b, int& R, int& C) { const int st = b / 1024, sb = b % 1024, swz = sb ^ (((sb >> 9) & 1) << 5); R = (st >> 1) * 16 + swz / 64; C = (st & 1) * 32 + (swz % 64) / 2; }
__host__ __device__ __forceinline__ int perm32(int rho) { const int n = rho >> 4, i = rho & 15; return 8 * (i >> 2) + 4 * n + (i & 3); }

struct Unit { int pm, pn; };
struct Gemm { const bf16_t* A; const bf16_t* Bt; int M, N, K; };

struct StaticOrder {
    int nM, nN, nwg, G, c;
    __host__ __device__ void init(int M, int N, int G_, int c_) { nM = M / BM; nN = N / BM; nwg = nM * nN; G = G_; c = c_; }
    __host__ __device__ bool next(int i, Unit& u) const {
        const long L = (long)i * G + c; if (L >= nwg) return false;
        int wgid = (int)L; { const int q = nwg / NXCD, r = nwg % NXCD, xcd = wgid % NXCD, off = wgid / NXCD; wgid = (xcd < r ? xcd * (q + 1) : r * (q + 1) + (xcd - r) * q) + off; }
        const int nig = WGM * nN, gid = wgid / nig, fm = gid * WGM, gsz = (nM - fm) < WGM ? (nM - fm) : WGM;
        u.pm = fm + ((wgid % nig) % gsz); u.pn = (wgid % nig) / gsz; return true;
    }
    __device__ __forceinline__ void a_ready(const Unit&) const {}
    __device__ __forceinline__ void done(const Unit&) const {}
};
__device__ __forceinline__ unsigned cvt_pk_bf16(float lo, float hi) { unsigned r; asm volatile("v_cvt_pk_bf16_f32 %0, %1, %2" : "=v"(r) : "v"(lo), "v"(hi)); return r; }
typedef float f32x2 __attribute__((ext_vector_type(2)));
typedef int i32x4_t __attribute__((ext_vector_type(4)));
typedef int i32x8_t __attribute__((ext_vector_type(8)));
__device__ __forceinline__ i32x8_t cat8(bf16x8 lo, bf16x8 hi) { const i32x4_t a = __builtin_bit_cast(i32x4_t, lo), b = __builtin_bit_cast(i32x4_t, hi); return __builtin_shufflevector(a, b, 0, 1, 2, 3, 4, 5, 6, 7); }
template <class Epi, class Sched, bool ALIGN_EPI = false, bool SP2 = false, bool F8 = false>
__device__ __forceinline__ void gemm_phase(PG8_LAS unsigned char* lds, const Gemm g, const Sched& S, const Epi& E) {
    int tid_ = threadIdx.x; asm volatile("" : "+v"(tid_));
    const int tid = tid_, wid = __builtin_amdgcn_readfirstlane(tid >> 6), lane = tid & 63, wr = wid >> 2, wc = wid & 3, fr = lane & 15, fq = lane >> 4;
    const int K = g.K, nt = K / BK;
    unsigned voffA[1], voffB[1];
    { int R, C; stage_rc(tid * 16, R, C); const int Rb = Epi::PERM ? ((R & ~31) + perm32(R & 31)) : R;
        voffA[0] = (unsigned)(R * K + C) * 2u; voffB[0] = (unsigned)(Rb * K + C) * 2u; }
    const size_t pstep = (size_t)64 * K * 2;
    const size_t kstep = (size_t)(BK * 2);
    const size_t hstep = (size_t)HALF * K * 2;
    const size_t tstep = 2 * hstep;
    const unsigned ldsw = (unsigned)wid * 1024u;
    const int aoff = lds_byte(wr * 64 + fr, fq * (F8 ? 16 : 8)), boff = lds_byte(wc * 32 + fr, fq * (F8 ? 16 : 8));
#define PG8_SA(b, h) (((b) * 2 + (h)) * HTB)
#define PG8_SB(b, h) ((4 + (b) * 2 + (h)) * HTB)
#define PG8_STAGE(bufoff, gbase, voff) do { _Pragma("unroll") for (int _i = 0; _i < 2; ++_i) { unsigned vo_ = (voff)[0]; asm volatile("" : "+v"(vo_));   \
        __builtin_amdgcn_global_load_lds((const unsigned*)((const char*)(gbase) + _i * pstep + vo_), (PG8_LAS unsigned*)(lds + (bufoff) + ldsw + _i * 8192), 16, 0, 0); } } while (0)
#define PG8_LDA(dst, b, h) do { _Pragma("unroll") for (int m = 0; m < 4; ++m) { \
        if constexpr (F8) dst##8[m] = cat8(*(const PG8_LAS bf16x8*)(lds + PG8_SA(b, h) + aoff + m * 2048), *(const PG8_LAS bf16x8*)(lds + PG8_SA(b, h) + aoff + m * 2048 + 16)); \
        else { _Pragma("unroll") for (int k = 0; k < 2; ++k) dst[m][k] = *(const PG8_LAS bf16x8*)(lds + PG8_SA(b, h) + aoff + m * 2048 + k * 1024); } } } while (0)
#define PG8_LDB(dst, b, h) do { _Pragma("unroll") for (int n = 0; n < 2; ++n) { \
        if constexpr (F8) dst##8[n] = cat8(*(const PG8_LAS bf16x8*)(lds + PG8_SB(b, h) + boff + n * 2048), *(const PG8_LAS bf16x8*)(lds + PG8_SB(b, h) + boff + n * 2048 + 16)); \
        else { _Pragma("unroll") for (int k = 0; k < 2; ++k) dst[n][k] = *(const PG8_LAS bf16x8*)(lds + PG8_SB(b, h) + boff + n * 2048 + k * 1024); } } } while (0)
#define PG8_MMA(ai, bj, At, Bt) do { __builtin_amdgcn_s_setprio(1); _Pragma("unroll") for (int m = 0; m < 4; ++m) _Pragma("unroll") for (int n = 0; n < 2; ++n) { \
        if constexpr (F8) acc[ai][bj][m][n] = __builtin_amdgcn_mfma_scale_f32_16x16x128_f8f6f4(Bt##8[n], At##8[m], acc[ai][bj][m][n], 0, 0, 0, F8_SCALES, 1, F8_SCALES); \
        else { _Pragma("unroll") for (int k = 0; k < 2; ++k) acc[ai][bj][m][n] = __builtin_amdgcn_mfma_f32_16x16x32_bf16(Bt[n][k], At[m][k], acc[ai][bj][m][n], 0, 0, 0); } } \
        __builtin_amdgcn_s_setprio(0); } while (0)
#define PG8_WAIT_V(n) asm volatile("s_waitcnt vmcnt(" #n ")" ::: "memory")
#define PG8_WAIT_L(n) asm volatile("s_waitcnt lgkmcnt(" #n ")" ::: "memory")
#define PG8_BAR __builtin_amdgcn_s_barrier()
#define PG8_SCHED __builtin_amdgcn_sched_barrier(0)
    Unit cur, nxt; int ui = 0;
    if (!S.next(0, cur)) return;
    f32x4 acc[2][2][4][2];
#pragma unroll
    for (int a = 0; a < 2; ++a)
#pragma unroll
        for (int b = 0; b < 2; ++b)
#pragma unroll
            for (int m = 0; m < 4; ++m)
#pragma unroll
                for (int n = 0; n < 2; ++n) acc[a][b][m][n] = (f32x4){0.f, 0.f, 0.f, 0.f};
    bf16x8 At[4][2], B0[2][2], B1[2][2]; i32x8_t At8[4], B08[2], B18[2];
    const char* cA = (const char*)g.A + (size_t)cur.pm * tstep; const char* cB = (const char*)g.Bt + (size_t)cur.pn * tstep;
    S.a_ready(cur);
    if constexpr (SP2) {
        PG8_STAGE(PG8_SB(0, 0), cB, voffB); PG8_STAGE(PG8_SB(0, 1), cB + hstep, voffB); PG8_STAGE(PG8_SA(0, 0), cA, voffA); PG8_STAGE(PG8_SA(0, 1), cA + hstep, voffA);
        if (wr == 1) PG8_BAR;
        PG8_WAIT_V(2); PG8_BAR;
        PG8_STAGE(PG8_SB(1, 0), cB + kstep, voffB); PG8_STAGE(PG8_SA(1, 0), cA + kstep, voffA); PG8_STAGE(PG8_SB(1, 1), cB + hstep + kstep, voffB);
        PG8_WAIT_V(6); PG8_BAR;
    } else {
        PG8_STAGE(PG8_SB(0, 0), cB, voffB); PG8_STAGE(PG8_SA(0, 0), cA, voffA); PG8_STAGE(PG8_SB(0, 1), cB + hstep, voffB); PG8_STAGE(PG8_SA(0, 1), cA + hstep, voffA);
        if (wr == 1) PG8_BAR;
        PG8_WAIT_V(4); PG8_BAR;
        PG8_STAGE(PG8_SB(1, 0), cB + kstep, voffB); PG8_STAGE(PG8_SA(1, 0), cA + kstep, voffA); PG8_STAGE(PG8_SB(1, 1), cB + hstep + kstep, voffB);
        PG8_WAIT_V(6); PG8_BAR;
    }
    for (;;) {
        const bool has_next = S.next(ui + 1, nxt);
        const char* nA = has_next ? (const char*)g.A + (size_t)nxt.pm * tstep : cA; const char* nB = has_next ? (const char*)g.Bt + (size_t)nxt.pn * tstep : cB;
#pragma unroll 1
        for (int t = 0; t < nt; t += 2) {
            const bool last = (t == nt - 2);
            const char* a1 = cA + (size_t)(t + 1) * kstep;
            const char* a2 = last ? nA : cA + (size_t)(t + 2) * kstep; const char* b2 = last ? nB : cB + (size_t)(t + 2) * kstep;
            const char* a3 = a2 + kstep; const char* b3 = b2 + kstep;
            if (last && has_next) S.a_ready(nxt);
            if constexpr (SP2) {
            PG8_LDB(B0, 0, 0); PG8_LDB(B1, 0, 1); PG8_SCHED; PG8_LDA(At, 0, 0); PG8_STAGE(PG8_SA(1, 1), a1 + hstep, voffA);
            PG8_WAIT_V(8); PG8_WAIT_L(0); PG8_BAR; PG8_MMA(0, 0, At, B0); PG8_MMA(0, 1, At, B1); PG8_BAR; PG8_SCHED;
            PG8_LDA(At, 0, 1); PG8_STAGE(PG8_SB(0, 0), b2, voffB); PG8_STAGE(PG8_SB(0, 1), b2 + hstep, voffB); PG8_STAGE(PG8_SA(0, 0), a2, voffA);
            PG8_WAIT_V(8); PG8_WAIT_L(0); PG8_BAR; PG8_MMA(1, 0, At, B0); PG8_MMA(1, 1, At, B1); PG8_BAR; PG8_SCHED;
            PG8_LDB(B0, 1, 0); PG8_LDB(B1, 1, 1); PG8_SCHED; PG8_LDA(At, 1, 0); PG8_STAGE(PG8_SA(0, 1), a2 + hstep, voffA);
            PG8_WAIT_V(8); PG8_WAIT_L(0); PG8_BAR; PG8_MMA(0, 0, At, B0); PG8_MMA(0, 1, At, B1); PG8_BAR; PG8_SCHED;
            PG8_LDA(At, 1, 1); PG8_STAGE(PG8_SB(1, 0), b3, voffB); PG8_STAGE(PG8_SB(1, 1), b3 + hstep, voffB); PG8_STAGE(PG8_SA(1, 0), a3, voffA);
            PG8_WAIT_V(8); PG8_WAIT_L(0); PG8_BAR; PG8_MMA(1, 0, At, B0); PG8_MMA(1, 1, At, B1); PG8_BAR; PG8_SCHED;
            } else {
            PG8_LDB(B0, 0, 0); PG8_SCHED; PG8_LDA(At, 0, 0); PG8_STAGE(PG8_SA(1, 1), a1 + hstep, voffA);
            PG8_WAIT_L(8); PG8_BAR; PG8_WAIT_L(0); PG8_MMA(0, 0, At, B0); PG8_BAR; PG8_SCHED;
            PG8_LDB(B1, 0, 1); PG8_STAGE(PG8_SB(0, 0), b2, voffB);
            PG8_BAR; PG8_WAIT_L(0); PG8_MMA(0, 1, At, B1); PG8_BAR;
            PG8_LDA(At, 0, 1); PG8_STAGE(PG8_SA(0, 0), a2, voffA);
            PG8_BAR; PG8_WAIT_L(0); PG8_MMA(1, 0, At, B0); PG8_BAR; PG8_SCHED;
            PG8_STAGE(PG8_SB(0, 1), b2 + hstep, voffB);
            PG8_WAIT_V(6); PG8_BAR; PG8_MMA(1, 1, At, B1); PG8_BAR;
            PG8_LDB(B0, 1, 0); PG8_SCHED; PG8_LDA(At, 1, 0); PG8_STAGE(PG8_SA(0, 1), a2 + hstep, voffA);
            PG8_WAIT_L(8); PG8_BAR; PG8_WAIT_L(0); PG8_MMA(0, 0, At, B0); PG8_BAR; PG8_SCHED;
            PG8_LDB(B1, 1, 1); PG8_STAGE(PG8_SB(1, 0), b3, voffB);
            PG8_BAR; PG8_WAIT_L(0); PG8_MMA(0, 1, At, B1); PG8_BAR;
            PG8_LDA(At, 1, 1); PG8_STAGE(PG8_SA(1, 0), a3, voffA);
            PG8_BAR; PG8_WAIT_L(0); PG8_MMA(1, 0, At, B0); PG8_BAR; PG8_SCHED;
            PG8_STAGE(PG8_SB(1, 1), b3 + hstep, voffB);
            PG8_WAIT_V(6); PG8_BAR; PG8_MMA(1, 1, At, B1); PG8_BAR;
            }
        }
        if constexpr (ALIGN_EPI) { if (wr == 0) PG8_BAR; }
        if constexpr (!Epi::AFTER_DRAIN) { E(acc, cur, wr, wc, fr, fq); S.done(cur); }
        if (!has_next) break;
#pragma unroll
        for (int a = 0; a < 2; ++a)
#pragma unroll
            for (int b = 0; b < 2; ++b)
#pragma unroll
                for (int m = 0; m < 4; ++m)
#pragma unroll
                    for (int n = 0; n < 2; ++n) acc[a][b][m][n] = (f32x4){0.f, 0.f, 0.f, 0.f};
        cur = nxt; cA = nA; cB = nB; ++ui;
        if constexpr (ALIGN_EPI) { if (wr == 1) PG8_BAR; }
    }
    PG8_WAIT_V(0);
    if constexpr (!ALIGN_EPI) { if (wr == 0) PG8_BAR; }
    PG8_BAR;
    if constexpr (Epi::AFTER_DRAIN) { E.fused(acc, cur, wr, wc, fr, fq, lds, wid, lane); S.done(cur); }
#undef PG8_SA
#undef PG8_SB
#undef PG8_STAGE
#undef PG8_LDA
#undef PG8_LDB
#undef PG8_MMA
#undef PG8_WAIT_V
#undef PG8_WAIT_L
#undef PG8_BAR
#undef PG8_SCHED
}
}

constexpr int RT_K = 0, RT_V = 32768, RT_ST = 65536;
template <bool KV> __device__ __forceinline__ void ret_stage(const bf16_t* P, int rb, int hp, LAS char* sm, int tid, int wid, int lane) {
    const int vrow = 16 * (wid & 3) + (lane >> 2), vc = (wid >> 2) * 32 + (lane & 3) * 8;
    u32x4 kk[4], vv[4];
#pragma unroll
    for (int i = 0; i < 4; ++i) { const int hh = i >> 1, tt = i & 1, h = 2 * hp + hh, r0 = rb + tt * 64;
        vv[i] = *(const u32x4*)(P + (size_t)(r0 + vrow) * DIN + C_RV + h * 64 + vc);
        kk[i] = KV ? *(const u32x4*)(P + (size_t)(r0 + vrow) * DIN + C_RK + h * 64 + vc) : *(const u32x4*)(P + (size_t)(r0 + lane) * DIN + C_RK + h * 64 + wid * 8); }
#pragma unroll
    for (int i = 0; i < 4; ++i) { *(LAS u32x4*)(sm + RT_K + i * 8192 + tid * 16) = kk[i]; *(LAS u32x4*)(sm + RT_V + i * 8192 + tid * 16) = vv[i]; }
}
constexpr int CW_QUE = 6016;
constexpr int QUE_LDS_WORD = 33792 + 4 + 64;
struct UnitQ { unsigned* ctr; int pend; };
__device__ __forceinline__ void q_prefetch(UnitQ& q) { if (TIDX == 0) q.pend = (int)atomicAdd(q.ctr, 1u); }
__device__ __forceinline__ int q_take(UnitQ& q, float* lds) {
    LAS int* slot = (LAS int*)lds + QUE_LDS_WORD;
    __syncthreads();
    if (TIDX == 0) *slot = q.pend;
    __syncthreads();
    return __builtin_amdgcn_readfirstlane(*slot);
}
__device__ __forceinline__ float ret_lg(const Params& p, int l, int dir, int h) { return -softplusf_(-p.ret_logit[(l * 2 + dir) * 4 + h]); }
__device__ __forceinline__ void ph_ret_summ(const Params& p, int l, int bid, int nb, float* lds) {
    char* ws = p.ws; const int tid = TIDX, lane = tid & 63, r32 = lane & 31, hi = lane >> 5, wid = __builtin_amdgcn_readfirstlane(tid >> 6);
    const bf16_t* P = (const bf16_t*)(ws + OFF_P); float* RET = (float*)(ws + OFF_RET);
    LAS char* sm = (LAS char*)lds;
    UnitQ uq{(unsigned*)ws + CW_QUE + l * 16 + 2, 0}; q_prefetch(uq);
    for (int u = q_take(uq, lds); u < 2 * NCI * 2; u = q_take(uq, lds)) {
        q_prefetch(uq);
        const int hp = u & 1, ci = (u >> 1) % NCI, b = (u >> 1) / NCI, rb = row_base(b, ci);
        __syncthreads();
        ret_stage<true>(P, rb, hp, sm, tid, wid, lane);
        __syncthreads();
        const int hh = wid >> 2, dh = (wid >> 1) & 1, eh = wid & 1, h = 2 * hp + hh;
        const float lg2f = ret_lg(p, l, 0, h) * 1.4426950408889634f, lg2b = ret_lg(p, l, 1, h) * 1.4426950408889634f;
        const int voff = ((lane >> 4) & 1) * 32 + (lane & 3) * 8 + (4 * hi + ((lane & 15) >> 2)) * 64;
        const LAS char* Kb = sm + RT_K + hh * 16384 + dh * 4096 + voff; const LAS char* Vb = sm + RT_V + hh * 16384 + eh * 4096 + voff;
        f32x16 a0, a1;
#pragma unroll
        for (int r = 0; r < 16; ++r) { a0[r] = 0.f; a1[r] = 0.f; }
#pragma unroll
        for (int k8 = 0; k8 < 8; ++k8) { const int tt = k8 >> 2, sl = k8 & 3;
            const s16x4 klo = vtr(Kb + tt * 8192 + sl * 1024), khi = vtr(Kb + tt * 8192 + sl * 1024 + 512), vlo = vtr(Vb + tt * 8192 + sl * 1024), vhi = vtr(Vb + tt * 8192 + sl * 1024 + 512);
            const int mb = tt * 64 + sl * 16 + 4 * hi; float kf_[8], kb_[8];
#pragma unroll
            for (int j = 0; j < 8; ++j) { const int m = mb + (j < 4 ? j : j + 4); const float kv = bfs(j < 4 ? klo[j] : khi[j - 4]);
                kf_[j] = kv * __builtin_amdgcn_exp2f(lg2f * (float)(127 - m)); kb_[j] = kv * __builtin_amdgcn_exp2f(lg2b * (float)m); }
            const u32x4 af = {cvtpk_s(kf_[0], kf_[1]), cvtpk_s(kf_[2], kf_[3]), cvtpk_s(kf_[4], kf_[5]), cvtpk_s(kf_[6], kf_[7])};
            const u32x4 ab = {cvtpk_s(kb_[0], kb_[1]), cvtpk_s(kb_[2], kb_[3]), cvtpk_s(kb_[4], kb_[5]), cvtpk_s(kb_[6], kb_[7])};
            const bf16x8 vfr = {vlo[0], vlo[1], vlo[2], vlo[3], vhi[0], vhi[1], vhi[2], vhi[3]};
            a0 = __builtin_amdgcn_mfma_f32_32x32x16_bf16(__builtin_bit_cast(bf16x8, af), vfr, a0, 0, 0, 0);
            a1 = __builtin_amdgcn_mfma_f32_32x32x16_bf16(__builtin_bit_cast(bf16x8, ab), vfr, a1, 0, 0, 0); }
        float* of = RET + ((((size_t)0 * 2 + b) * NCI + ci) * 4 + h) * 4096 + eh * 32 + r32;
        float* ob = RET + ((((size_t)1 * 2 + b) * NCI + ci) * 4 + h) * 4096 + eh * 32 + r32;
#pragma unroll
        for (int r = 0; r < 16; ++r) { const int d = dh * 32 + crow(r, hi); of[d * 64] = a0[r]; ob[d * 64] = a1[r]; }
    }
}

constexpr int LR_UB = 0, LR_A = 18432, LR_B = 51200, LR_H = 83968, LR_SEG = 116736, LR_CW = 120832;
template <int MODE>
__device__ __forceinline__ void ph_lru_chunk(const Params& p, int l, int bid, int nb, float* lds, int ci_lo) {
    char* ws = p.ws; const int tid = TIDX, lane = tid & 63, r32 = lane & 31, hi = lane >> 5, wid = __builtin_amdgcn_readfirstlane(tid >> 6);
    const bf16_t* P = (const bf16_t*)(ws + OFF_P);
    float* LA = (float*)(ws + OFF_LRU); float* LB = LA + 2 * 2 * NCI * 256; float* LC = LB + 2 * 2 * NCI * 256;
    bf16_t* O = (bf16_t*)(ws + OFF_ACT);
    LAS char* sm = (LAS char*)lds;
    const int hb = bid & 3, tt = wid >> 1, jt = wid & 1, jcol = jt * 32 + r32, ch = hb * 64 + jcol;
    bf16x8 wfr[2][2][4]; float bia[2][2], spl[2];
#pragma unroll
    for (int dir = 0; dir < 2; ++dir) {
#pragma unroll
        for (int gt = 0; gt < 2; ++gt) { const float* W = (gt == 0 ? p.lru_wa : p.lru_wx) + (((size_t)(l * 2 + dir) * 4 + hb) * 64) * 64 + jcol;
#pragma unroll
            for (int ks = 0; ks < 4; ++ks) { const float* wp = W + (16 * ks + 8 * hi) * 64;
                const u32x4 w4 = {cvtpk_s(wp[0], wp[64]), cvtpk_s(wp[128], wp[192]), cvtpk_s(wp[256], wp[320]), cvtpk_s(wp[384], wp[448])};
                wfr[dir][gt][ks] = __builtin_bit_cast(bf16x8, w4); }
            bia[dir][gt] = (gt == 0 ? p.lru_ba : p.lru_bx)[(l * 2 + dir) * 256 + ch]; }
        spl[dir] = -8.0f * softplusf_(-p.lru_lam[(l * 2 + dir) * 256 + ch]); }
    const int nci = NCI - ci_lo, npair = 2 * nci;
    LAS float* cwl = (LAS float*)(sm + LR_CW);
    __syncthreads();
    if (tid < 320) cwl[tid] = tid < 256 ? p.conv_w[(l * 4 + (tid >> 6)) * 256 + hb * 64 + (tid & 63)] : p.conv_b[l * 256 + hb * 64 + (tid - 256)];
    UnitQ uq{(unsigned*)ws + CW_QUE + l * 16 + (MODE == 3 ? 4 : 8) + hb, 0}; q_prefetch(uq);
    for (int pi = q_take(uq, lds); pi < npair; pi = q_take(uq, lds)) {
        q_prefetch(uq);
        const int ci = ci_lo + pi % nci, b = pi / nci, rb = row_base(b, ci);
        const int seg_lo = ci < 2 ? NLAT + b * NCTX : b * NSEQ, seg_hi = ci < 2 ? seg_lo + NCTX : seg_lo + NSEQ;
        __syncthreads();
#pragma unroll
        for (int it = 0; it < 2; ++it) { const int item = it * 512 + tid, t = item >> 3, c8 = (item & 7) * 8, c0 = hb * 64 + c8;
            float acc[8];
            { const f32x4 b0 = *(const LAS f32x4*)(cwl + 256 + c8), b1 = *(const LAS f32x4*)(cwl + 256 + c8 + 4);
              acc[0] = b0[0]; acc[1] = b0[1]; acc[2] = b0[2]; acc[3] = b0[3]; acc[4] = b1[0]; acc[5] = b1[1]; acc[6] = b1[2]; acc[7] = b1[3]; }
#pragma unroll
            for (int k = 0; k < 4; ++k) { const int rr = rb + t - 1 + k;
                if (rr >= seg_lo && rr < seg_hi) { const bf16x8 xv = *(const bf16x8*)(P + (size_t)rr * DIN + C_LX + c0);
                    const f32x4 w0 = *(const LAS f32x4*)(cwl + k * 64 + c8), w1 = *(const LAS f32x4*)(cwl + k * 64 + c8 + 4);
                    acc[0] += w0[0] * bfs(xv[0]); acc[1] += w0[1] * bfs(xv[1]); acc[2] += w0[2] * bfs(xv[2]); acc[3] += w0[3] * bfs(xv[3]);
                    acc[4] += w1[0] * bfs(xv[4]); acc[5] += w1[1] * bfs(xv[5]); acc[6] += w1[2] * bfs(xv[6]); acc[7] += w1[3] * bfs(xv[7]); } }
            const u32x4 w = {cvtpk_s(acc[0], acc[1]), cvtpk_s(acc[2], acc[3]), cvtpk_s(acc[4], acc[5]), cvtpk_s(acc[6], acc[7])};
            *(LAS u32x4*)(sm + LR_UB + t * 144 + c8 * 2) = w; }
        __syncthreads();
        bf16x8 ua[4];
#pragma unroll
        for (int ks = 0; ks < 4; ++ks) ua[ks] = *(const LAS bf16x8*)(sm + LR_UB + (tt * 32 + r32) * 144 + (16 * ks + 8 * hi) * 2);
#pragma unroll
        for (int dir = 0; dir < 2; ++dir) {
            f32x16 ga, gx;
#pragma unroll
            for (int r = 0; r < 16; ++r) { ga[r] = bia[dir][0]; gx[r] = bia[dir][1]; }
#pragma unroll
            for (int ks = 0; ks < 4; ++ks) { ga = __builtin_amdgcn_mfma_f32_32x32x16_bf16(ua[ks], wfr[dir][0][ks], ga, 0, 0, 0); gx = __builtin_amdgcn_mfma_f32_32x32x16_bf16(ua[ks], wfr[dir][1][ks], gx, 0, 0, 0); }
#pragma unroll
            for (int r = 0; r < 16; ++r) { const int t = tt * 32 + crow(r, hi);
                const float rg = __builtin_amdgcn_rcpf(1.0f + __expf(-ga[r])), ig = __builtin_amdgcn_rcpf(1.0f + __expf(-gx[r]));
                const float a = __expf(spl[dir] * rg);
                const float uu = __uint_as_float(((unsigned)*(const LAS unsigned short*)(sm + LR_UB + t * 144 + jcol * 2)) << 16);
                *(LAS float*)(sm + LR_A + (t * 64 + jcol) * 4) = a;
                *(LAS float*)(sm + LR_B + (t * 64 + jcol) * 4) = sqrtf(fmaxf(1.0f - a * a, 0.f)) * (ig * uu); }
            __syncthreads();
            {
                const size_t cidx = (((size_t)dir * 2 + b) * NCI + ci) * 256 + hb * 64 + lane;
                float cin = MODE == 3 ? LC[cidx] : 0.f;
                LAS float* as_ = (LAS float*)(sm + LR_A) + lane; LAS float* bs_ = (LAS float*)(sm + LR_B) + lane; LAS float* hs = (LAS float*)(sm + LR_H) + lane;
                LAS float* sg = (LAS float*)(sm + LR_SEG) + lane;
                {   float h = 0.f, c = 1.f;
#pragma unroll 1
                    for (int k0 = 0; k0 < 16; k0 += 8) { float cl[8], hl[8];
#pragma unroll
                        for (int k = 0; k < 8; ++k) { const int s = wid * 16 + k0 + k, t = dir == 0 ? s : 127 - s; cl[k] = as_[t * 64]; hl[k] = bs_[t * 64]; }
#pragma unroll
                        for (int k = 0; k < 8; ++k) { const int s = wid * 16 + k0 + k, t = dir == 0 ? s : 127 - s; h = cl[k] * h + hl[k]; c *= cl[k]; as_[t * 64] = c; bs_[t * 64] = h; } }
                    sg[wid * 64] = c; sg[(8 + wid) * 64] = h; }
                __syncthreads();
                float pa = 1.f;
                for (int v = 0; v < wid; ++v) { const float sa = sg[v * 64]; cin = sa * cin + sg[(8 + v) * 64]; pa *= sa; }
                if (MODE == 1) { if (wid == 7) { const float c7 = sg[7 * 64], h7 = sg[15 * 64]; LA[cidx] = pa * c7; LB[cidx] = c7 * cin + h7; } }
                else {
#pragma unroll 1
                    for (int k0 = 0; k0 < 16; k0 += 8) {
#pragma unroll
                        for (int k = 0; k < 8; ++k) { const int s = wid * 16 + k0 + k, t = dir == 0 ? s : 127 - s; const float val = bs_[t * 64] + as_[t * 64] * cin;
                            if (dir == 0) hs[t * 64] = val; else hs[t * 64] += val; } }
                }
            }
            __syncthreads();
        }
        if (MODE == 3) {
            bf16x8 yv2[2];
#pragma unroll
            for (int it = 0; it < 2; ++it) { const int item = it * 512 + tid, t = item >> 3, c8 = (item & 7) * 8, c0 = hb * 64 + c8; yv2[it] = *(const bf16x8*)(P + (size_t)(rb + t) * DIN + C_LY + c0); }
#pragma unroll
            for (int it = 0; it < 2; ++it) { const int item = it * 512 + tid, t = item >> 3, c8 = (item & 7) * 8, c0 = hb * 64 + c8;
                const f32x4 h0 = *(const LAS f32x4*)(sm + LR_H + (t * 64 + c8) * 4), h1 = *(const LAS f32x4*)(sm + LR_H + (t * 64 + c8 + 4) * 4);
                const bf16x8 yv = yv2[it];
                const u32x4 w = {cvtpk_s(h0[0] * gelu_tanh(bfs(yv[0])), h0[1] * gelu_tanh(bfs(yv[1]))), cvtpk_s(h0[2] * gelu_tanh(bfs(yv[2])), h0[3] * gelu_tanh(bfs(yv[3]))),
                                 cvtpk_s(h1[0] * gelu_tanh(bfs(yv[4])), h1[1] * gelu_tanh(bfs(yv[5]))), cvtpk_s(h1[2] * gelu_tanh(bfs(yv[6])), h1[3] * gelu_tanh(bfs(yv[7])))};
                *(u32x4*)(O + (size_t)(rb + t) * DM + 768 + c0) = w; }
        }
    }
}

__device__ __forceinline__ int scan_ci(int dir, int s) { return dir == 0 ? s : (s == 0 ? 1 : (s == 1 ? 0 : NCI + 1 - s)); }
__device__ __forceinline__ void ph_scan2(const Params& p, int l, int bid, int nb) {
    char* ws = p.ws; const int gt = bid * 512 + TIDX, gs = nb * 512;
    float* RET = (float*)(ws + OFF_RET);
    for (int i = gt; i < 2 * 2 * 4 * 4096; i += gs) {
        const int de = i & 4095, h = (i >> 12) & 3, b = (i >> 14) & 1, dir = i >> 15;
        const float decay = expf(ret_lg(p, l, dir, h) * 128.0f); float S = 0.f;
        float* base = RET + (((size_t)dir * 2 + b) * NCI * 4 + h) * 4096 + de;
        float ua[13], ub[13];
#pragma unroll
        for (int j = 0; j < 13; ++j) ua[j] = base[(size_t)scan_ci(dir, j) * 4 * 4096];
#pragma unroll 1
        for (int s0 = 0; s0 < NCI; s0 += 26) {
#pragma unroll
            for (int j = 0; j < 13; ++j) ub[j] = base[(size_t)scan_ci(dir, s0 + 13 + j) * 4 * 4096];
#pragma unroll
            for (int j = 0; j < 13; ++j) { base[(size_t)scan_ci(dir, s0 + j) * 4 * 4096] = S; S = decay * S + ua[j]; }
            const int s1 = s0 + 26 < NCI ? s0 + 26 : s0;
#pragma unroll
            for (int j = 0; j < 13; ++j) ua[j] = base[(size_t)scan_ci(dir, s1 + j) * 4 * 4096];
#pragma unroll
            for (int j = 0; j < 13; ++j) { base[(size_t)scan_ci(dir, s0 + 13 + j) * 4 * 4096] = S; S = decay * S + ub[j]; }
        }
    }
    float* LA = (float*)(ws + OFF_LRU); float* LB = LA + 2 * 2 * NCI * 256; float* LC = LB + 2 * 2 * NCI * 256;
    const int lo = nb >= 192 ? 128 * 512 : 0;
    for (int i = gt - lo; i < 2 * 2 * 256; i += gs) {
        if (i < 0) continue;
        const int ch = i & 255, b = (i >> 8) & 1, dir = i >> 9; float h = 0.f;
        const size_t base = ((size_t)dir * 2 + b) * NCI * 256 + ch;
        float aa[13], bb[13], ac[13], bc[13];
#pragma unroll
        for (int j = 0; j < 13; ++j) { const size_t idx = base + (size_t)scan_ci(dir, j) * 256; aa[j] = LA[idx]; bb[j] = LB[idx]; }
#pragma unroll 1
        for (int s0 = 0; s0 < NCI; s0 += 26) {
#pragma unroll
            for (int j = 0; j < 13; ++j) { const size_t idx = base + (size_t)scan_ci(dir, s0 + 13 + j) * 256; ac[j] = LA[idx]; bc[j] = LB[idx]; }
#pragma unroll
            for (int j = 0; j < 13; ++j) { LC[base + (size_t)scan_ci(dir, s0 + j) * 256] = h; h = aa[j] * h + bb[j]; }
            const int s1 = s0 + 26 < NCI ? s0 + 26 : s0;
#pragma unroll
            for (int j = 0; j < 13; ++j) { const size_t idx = base + (size_t)scan_ci(dir, s1 + j) * 256; aa[j] = LA[idx]; bb[j] = LB[idx]; }
#pragma unroll
            for (int j = 0; j < 13; ++j) { LC[base + (size_t)scan_ci(dir, s0 + 13 + j) * 256] = h; h = ac[j] * h + bc[j]; }
        }
    }
}

__device__ __forceinline__ bf16x8 scale_frag(bf16x8 q, float s) {
    u32x4 w;
#pragma unroll
    for (int i = 0; i < 4; ++i) w[i] = cvtpk_s(bfs(q[2 * i]) * s, bfs(q[2 * i + 1]) * s);
    return __builtin_bit_cast(bf16x8, w);
}
__device__ __forceinline__ void ph_ret_out(const Params& p, int l, int bid, int nb, float* lds, int ci_lo) {
    char* ws = p.ws; const int tid = TIDX, lane = tid & 63, r32 = lane & 31, hi = lane >> 5, wid = __builtin_amdgcn_readfirstlane(tid >> 6);
    const bf16_t* P = (const bf16_t*)(ws + OFF_P); const float* RET = (const float*)(ws + OFF_RET); bf16_t* O = (bf16_t*)(ws + OFF_ACT);
    LAS char* sm = (LAS char*)lds;
    const int nci = NCI - ci_lo;
    UnitQ uq{(unsigned*)ws + CW_QUE + l * 16 + 1, 0}; q_prefetch(uq);
    for (int u = q_take(uq, lds); u < 2 * nci * 2; u = q_take(uq, lds)) {
        q_prefetch(uq);
        const int hp = u & 1, ci = ci_lo + (u >> 1) % nci, b = (u >> 1) / nci, rb = row_base(b, ci);
        __syncthreads();
        ret_stage<false>(P, rb, hp, sm, tid, wid, lane);
#pragma unroll
        for (int it = 0; it < 8; ++it) { const int idx = it * 512 + tid, t = idx >> 10, d = (idx >> 4) & 63, e4 = (idx & 15) * 4;
            const size_t tile_ = (((size_t)(t & 1) * 2 + b) * NCI + ci) * 4 + 2 * hp + (t >> 1);
            const f32x4 sv = *(const f32x4*)(RET + tile_ * 4096 + d * 64 + e4);
            LAS char* sd = sm + RT_ST + (((t * 4 + (d >> 4)) * 2 + (e4 >> 5)) * 1024) + (((d >> 3) & 1) * 32 + (e4 & 31)) * 16 + (d & 7) * 2;
#pragma unroll
            for (int k = 0; k < 4; ++k) *(LAS unsigned short*)(sd + k * 16) = (unsigned short)(cvtpk_s(sv[k], 0.f) & 0xffffu); }
        __syncthreads();
        const int hh = wid >> 2, qt = wid & 3, h = 2 * hp + hh; int n = qt * 32 + r32;
        asm volatile("" : "+v"(n));
        const float lg2f = ret_lg(p, l, 0, h) * 1.4426950408889634f, lg2b = ret_lg(p, l, 1, h) * 1.4426950408889634f;
        bf16x8 qr[4];
        { const bf16_t* qp = P + (size_t)(rb + n) * DIN + C_RQ + h * 64 + hi * 8;
#pragma unroll
          for (int ks = 0; ks < 4; ++ks) qr[ks] = *(const bf16x8*)(qp + ks * 16); }
        f32x16 o[2];
#pragma unroll
        for (int r = 0; r < 16; ++r) { o[0][r] = 0.f; o[1][r] = 0.f; }
#pragma unroll
        for (int dir = 0; dir < 2; ++dir) {
            const float xi = dir == 0 ? __builtin_amdgcn_exp2f(lg2f * (float)(n + 1)) : __builtin_amdgcn_exp2f(lg2b * (float)(128 - n));
            const LAS char* Sf = sm + RT_ST + (hh * 2 + dir) * 8192 + lane * 16;
#pragma unroll
            for (int ks = 0; ks < 4; ++ks) { const bf16x8 qx = scale_frag(qr[ks], xi);
#pragma unroll
                for (int eh = 0; eh < 2; ++eh) o[eh] = __builtin_amdgcn_mfma_f32_32x32x16_bf16(qx, *(const LAS bf16x8*)(Sf + (ks * 2 + eh) * 1024), o[eh], 0, 0, 0); }
        }
        const LAS char* Kb = sm + RT_K + hh * 16384 + hi * 1024 + r32 * 16;
        const LAS char* Vb = sm + RT_V + hh * 16384 + ((lane >> 4) & 1) * 32 + (lane & 3) * 8 + (4 * hi + ((lane & 15) >> 2)) * 64;
        u32x4 pw[8];
#pragma unroll
        for (int kb = 0; kb < 4; ++kb) { const int tt = kb >> 1, kbl = kb & 1;
            f32x16 c;
#pragma unroll
            for (int r = 0; r < 16; ++r) c[r] = 0.f;
#pragma unroll
            for (int ks = 0; ks < 4; ++ks) c = __builtin_amdgcn_mfma_f32_32x32x16_bf16(*(const LAS bf16x8*)(Kb + tt * 8192 + ks * 2048 + kbl * 512), qr[ks], c, 0, 0, 0);
#pragma unroll
            for (int r = 0; r < 16; ++r) { const int dlt = n - (kb * 32 + crow(r, hi)); const float fd = (float)dlt;
                const float w = __builtin_amdgcn_exp2f(fd * (dlt > 0 ? lg2f : -lg2b));
                c[r] *= dlt == 0 ? 2.0f : w; }
            pw[2 * kb] = (u32x4){cvtpk_s(c[0], c[1]), cvtpk_s(c[2], c[3]), cvtpk_s(c[4], c[5]), cvtpk_s(c[6], c[7])};
            pw[2 * kb + 1] = (u32x4){cvtpk_s(c[8], c[9]), cvtpk_s(c[10], c[11]), cvtpk_s(c[12], c[13]), cvtpk_s(c[14], c[15])}; }
#pragma unroll
        for (int k8 = 0; k8 < 8; ++k8) { const int tt = k8 >> 2, sl = k8 & 3;
#pragma unroll
            for (int eh = 0; eh < 2; ++eh) { const s16x4 vlo = vtr(Vb + tt * 8192 + eh * 4096 + sl * 1024), vhi = vtr(Vb + tt * 8192 + eh * 4096 + sl * 1024 + 512);
                o[eh] = __builtin_amdgcn_mfma_f32_32x32x16_bf16(__builtin_bit_cast(bf16x8, pw[k8]), (bf16x8){vlo[0], vlo[1], vlo[2], vlo[3], vhi[0], vhi[1], vhi[2], vhi[3]}, o[eh], 0, 0, 0); } }
        __syncthreads();
        LAS float* stg = (LAS float*)(sm + RT_ST) + wid * 2048;
#pragma unroll
        for (int r = 0; r < 16; ++r) { const int q = crow(r, hi); stg[q * 64 + r32] = o[0][r]; stg[q * 64 + 32 + r32] = o[1][r]; }
        const float* gn = p.ret_gn + l * 256 + h * 64 + (lane & 7) * 8;
        const f32x4 g0 = *(const f32x4*)gn, g1 = *(const f32x4*)(gn + 4);
        bf16x8 ggv[4];
#pragma unroll
        for (int i = 0; i < 4; ++i) ggv[i] = *(const bf16x8*)(P + (size_t)(rb + qt * 32 + i * 8 + (lane >> 3)) * DIN + C_RG + h * 64 + (lane & 7) * 8);
#pragma unroll
        for (int i = 0; i < 4; ++i) { const int row = i * 8 + (lane >> 3), ch = lane & 7;
            const f32x4 v0 = *(const LAS f32x4*)(stg + row * 64 + ch * 8), v1 = *(const LAS f32x4*)(stg + row * 64 + ch * 8 + 4);
            float ss = v0[0] * v0[0] + v0[1] * v0[1] + v0[2] * v0[2] + v0[3] * v0[3] + v1[0] * v1[0] + v1[1] * v1[1] + v1[2] * v1[2] + v1[3] * v1[3];
            ss += __shfl_xor(ss, 1); ss += __shfl_xor(ss, 2); ss += __shfl_xor(ss, 4);
            const float rn = rsqrtf(ss * (1.0f / 64.0f) + 1e-6f);
            const size_t grow = (size_t)(rb + qt * 32 + row);
            const bf16x8 gg = ggv[i];
            u32x4 w; w.x = cvtpk_s(v0[0] * rn * g0[0] * fast_silu(bfs(gg[0])), v0[1] * rn * g0[1] * fast_silu(bfs(gg[1]))); w.y = cvtpk_s(v0[2] * rn * g0[2] * fast_silu(bfs(gg[2])), v0[3] * rn * g0[3] * fast_silu(bfs(gg[3])));
            w.z = cvtpk_s(v1[0] * rn * g1[0] * fast_silu(bfs(gg[4])), v1[1] * rn * g1[1] * fast_silu(bfs(gg[5]))); w.w = cvtpk_s(v1[2] * rn * g1[2] * fast_silu(bfs(gg[6])), v1[3] * rn * g1[3] * fast_silu(bfs(gg[7])));
            *(u32x4*)(O + grow * DM + 256 + h * 64 + ch * 8) = w; }
    }
}

__device__ __forceinline__ float diff_lambda_val(const Params& p, int l, float lam_init) {
    const float* lv = p.diff_lam + l * 128; float s1 = 0.f, s2 = 0.f;
    for (int i = 0; i < 32; ++i) { s1 += lv[i] * lv[32 + i]; s2 += lv[64 + i] * lv[96 + i]; }
    return expf(s1) - expf(s2) + lam_init;
}
__device__ __forceinline__ float max3f(float a, float b, float c) { return __builtin_fmaxf(__builtin_fmaxf(a, b), c); }
__device__ __forceinline__ float xhalf_max(float m) { auto rr = __builtin_amdgcn_permlane32_swap(__float_as_uint(m), __float_as_uint(m), false, false); return fmaxf(__uint_as_float(rr[0]), __uint_as_float(rr[1])); }
__device__ __forceinline__ float xhalf_sum(float m) { auto rr = __builtin_amdgcn_permlane32_swap(__float_as_uint(m), __float_as_uint(m), false, false); return __uint_as_float(rr[0]) + __uint_as_float(rr[1]); }

constexpr int DF_K = 0, DF_V = 16384, DF_WS = 32768, DF_ST = 34816;
constexpr int DD_K = 0, DD_V = 32768, DD_WS = 65536, DD_ST = 67584;
__device__ __forceinline__ void glds16(const void* gsrc, unsigned lds_dst) { unsigned keep;
    asm volatile("s_mov_b32 %0, m0\n\ts_mov_b32 m0, %2\n\ts_nop 0\n\tglobal_load_lds_dwordx4 %1, off\n\ts_mov_b32 m0, %0" : "=&s"(keep) : "v"(gsrc), "s"(lds_dst) : "memory"); }
template <bool SAFE>
__device__ __forceinline__ void diff_tiles(const bf16_t* P, int b, int h, int t_lo, LAS char* sm, int tid, int wid, int lane, const bf16x8 (&qr)[4], f32x16 (&o)[2][2], float (&lsum)[2]) {
    const int r32 = lane & 31, hi = lane >> 5, t_hi = 260;
    LAS float* wsf = (LAS float*)(sm + DD_WS) + wid * 64;
    const bf16_t* kcol = P + C_DK + h * 64 + wid * 8;
    const bf16_t* vcol = P + C_DV + h * 64 + (wid >> 2) * 32 + (lane & 3) * 8;
    const int krow_in = lane, vrow_in = 16 * (wid & 3) + (lane >> 2);
#define TILE_ROW0(t) ((t) < 256 ? b * NSEQ + (t) * 64 : NLAT + b * NCTX + ((t) - 256) * 64)
    float mhat[2];
#pragma unroll
    for (int m = 0; m < 2; ++m) { mhat[m] = 0.f; lsum[m] = 0.f;
#pragma unroll
        for (int r = 0; r < 16; ++r) { o[m][0][r] = 0.f; o[m][1][r] = 0.f; } }
    const unsigned lds0 = (unsigned)(size_t)sm + (unsigned)wid * 1024u;
#define DMA_TILE(t) do { const int r0_ = TILE_ROW0(t); const unsigned sl_ = (unsigned)(((t) - t_lo) & 3) * 8192u; \
    glds16(kcol + (size_t)(r0_ + krow_in) * DIN, (unsigned)__builtin_amdgcn_readfirstlane(lds0 + DD_K + sl_)); glds16(vcol + (size_t)(r0_ + vrow_in) * DIN, (unsigned)__builtin_amdgcn_readfirstlane(lds0 + DD_V + sl_)); } while (0)
    asm volatile("s_waitcnt lgkmcnt(0)\n\ts_barrier" ::: "memory");
    DMA_TILE(t_lo); DMA_TILE(t_lo + 1); DMA_TILE(t_lo + 2);
    bool first = true;
    for (int t = t_lo; t < t_hi; ++t) {
        const int cur = (t - t_lo) & 3;
        if (t + 2 < t_hi) asm volatile("s_waitcnt vmcnt(4)\n\ts_barrier" ::: "memory");
        else if (t + 1 < t_hi) asm volatile("s_waitcnt vmcnt(2)\n\ts_barrier" ::: "memory");
        else asm volatile("s_waitcnt vmcnt(0)\n\ts_barrier" ::: "memory");
        if (t + 3 < t_hi) DMA_TILE(t + 3);
        const LAS char* kb = sm + DD_K + cur * 8192 + hi * 1024 + r32 * 16;
        const LAS char* vb = sm + DD_V + cur * 8192 + ((lane >> 4) & 1) * 32 + (lane & 3) * 8 + (4 * hi + ((lane & 15) >> 2)) * 64;
#pragma unroll
        for (int m = 0; m < 2; ++m) {
            bf16x8 kf[8];
#pragma unroll
            for (int j = 2 * m; j < 2 * m + 2; ++j) { kf[2 * j] = *(const LAS bf16x8*)(kb + j * 2048); kf[2 * j + 1] = *(const LAS bf16x8*)(kb + j * 2048 + 512); }
            f32x16 c0, c1;
            if (SAFE) { float nm = -mhat[m]; asm volatile("" : "+v"(nm));
#pragma unroll
                for (int r = 0; r < 16; ++r) { c0[r] = nm; c1[r] = nm; } }
            else {
#pragma unroll
                for (int r = 0; r < 16; ++r) { c0[r] = 0.f; c1[r] = 0.f; } }
            c0 = __builtin_amdgcn_mfma_f32_32x32x16_bf16(kf[4 * m + 0], qr[2 * m], c0, 0, 0, 0);
            c1 = __builtin_amdgcn_mfma_f32_32x32x16_bf16(kf[4 * m + 1], qr[2 * m], c1, 0, 0, 0);
            c0 = __builtin_amdgcn_mfma_f32_32x32x16_bf16(kf[4 * m + 2], qr[2 * m + 1], c0, 0, 0, 0);
            c1 = __builtin_amdgcn_mfma_f32_32x32x16_bf16(kf[4 * m + 3], qr[2 * m + 1], c1, 0, 0, 0);
            if (SAFE) {
                float ra = max3f(c0[0], c0[1], c1[0]), rb = max3f(c0[2], c0[3], c1[1]); ra = max3f(ra, c1[2], c1[3]);
#pragma unroll
                for (int r = 4; r < 16; r += 4) { ra = max3f(ra, c0[r], c0[r + 1]); rb = max3f(rb, c0[r + 2], c0[r + 3]); ra = max3f(ra, c1[r], c1[r + 1]); rb = max3f(rb, c1[r + 2], c1[r + 3]); }
                const float rm = xhalf_max(max3f(ra, rb, rb));
                if (__builtin_expect(first || __any(rm > 8.0f), 0)) {
                    float dl = first ? rm : fmaxf(rm, 0.f); asm volatile("; rebase" : "+v"(dl));
                    mhat[m] += dl;
#pragma unroll
                    for (int r = 0; r < 16; ++r) { c0[r] -= dl; c1[r] -= dl; }
                    asm volatile("" : "+v"(c0), "+v"(c1));
                    if (!first) {
                        const float f = __builtin_amdgcn_exp2f(-dl); lsum[m] *= f;
                        if (hi == 0) wsf[r32] = f;
#pragma unroll
                        for (int r = 0; r < 16; ++r) { const float fr_ = wsf[crow(r, hi)]; o[m][0][r] *= fr_; o[m][1][r] *= fr_; }
                    }
                }
            }
            float sacc = 0.f;
#pragma unroll
            for (int r = 0; r < 16; ++r) { c0[r] = __builtin_amdgcn_exp2f(c0[r]); c1[r] = __builtin_amdgcn_exp2f(c1[r]); sacc += c0[r] + c1[r]; }
            lsum[m] += sacc;
            u32x4 pw[4];
#pragma unroll
            for (int k = 0; k < 2; ++k) {
                pw[k] = (u32x4){cvtpk_s(c0[8 * k + 0], c0[8 * k + 1]), cvtpk_s(c0[8 * k + 2], c0[8 * k + 3]), cvtpk_s(c0[8 * k + 4], c0[8 * k + 5]), cvtpk_s(c0[8 * k + 6], c0[8 * k + 7])};
                pw[2 + k] = (u32x4){cvtpk_s(c1[8 * k + 0], c1[8 * k + 1]), cvtpk_s(c1[8 * k + 2], c1[8 * k + 3]), cvtpk_s(c1[8 * k + 4], c1[8 * k + 5]), cvtpk_s(c1[8 * k + 6], c1[8 * k + 7])}; }
            if (!SAFE) __builtin_amdgcn_sched_barrier(0);
#pragma unroll
            for (int dh = 0; dh < 2; ++dh) {
#pragma unroll
                for (int k = 0; k < 4; ++k) { const s16x4 lo = vtr(vb + dh * 4096 + k * 1024), hh = vtr(vb + dh * 4096 + k * 1024 + 512);
                    o[m][dh] = __builtin_amdgcn_mfma_f32_32x32x16_bf16(__builtin_bit_cast(bf16x8, pw[k]), (bf16x8){lo[0], lo[1], lo[2], lo[3], hh[0], hh[1], hh[2], hh[3]}, o[m][dh], 0, 0, 0); } }
            if (!SAFE) __builtin_amdgcn_sched_barrier(0);
        }
        first = false;
        asm volatile("s_waitcnt lgkmcnt(0)" ::: "memory");
    }
#undef TILE_ROW0
#undef DMA_TILE
}

constexpr int DQ_K = 0, DQ_V = 40960, DQ_WS = 81920, DQ_ST = 0;
__device__ __forceinline__ void diff_tiles_fast(const bf16_t* P, int b, int h, int t_lo, LAS char* sm, int tid, int wid, int lane, const bf16x8 (&qr)[4], f32x16 (&o)[2][2], f32x4 (&ls)[2]) {
    const int r32 = lane & 31, hi = lane >> 5, NT = 260 - t_lo;
    const bf16_t* kcol = P + C_DK + h * 64 + (((lane & 7) - 4 * wid - (lane >> 4)) & 7) * 8;
    const bf16_t* vcol = P + C_DV + h * 64 + (wid >> 2) * 32 + (lane & 3) * 8;
    const int krow_in = 8 * wid + (lane >> 3), vrow_in = 16 * (wid & 3) + (lane >> 2);
    const unsigned lds0 = (unsigned)(size_t)sm + (unsigned)wid * 1024u;
#define TILE_ROW0(i) ((t_lo + (i)) < 256 ? b * NSEQ + (t_lo + (i)) * 64 : NLAT + b * NCTX + (t_lo + (i) - 256) * 64)
#define DMA_TILE(i, slot) do { const int r0_ = TILE_ROW0(i); const unsigned sl_ = (unsigned)(slot) * 8192u; \
    glds16(kcol + (size_t)(r0_ + krow_in) * DIN, (unsigned)__builtin_amdgcn_readfirstlane(lds0 + DQ_K + sl_)); glds16(vcol + (size_t)(r0_ + vrow_in) * DIN, (unsigned)__builtin_amdgcn_readfirstlane(lds0 + DQ_V + sl_)); } while (0)
#pragma unroll
    for (int m = 0; m < 2; ++m) { ls[m] = (f32x4){0.f, 0.f, 0.f, 0.f};
#pragma unroll
        for (int r = 0; r < 16; ++r) { o[m][0][r] = 0.f; o[m][1][r] = 0.f; } }
    const unsigned onev = (((lane >> 4) ^ (lane >> 3)) & 1) ? 0u : 0x3F803F80u;
    const bf16x8 onesB = __builtin_bit_cast(bf16x8, ((u32x4){onev, onev, onev, onev}));
    asm volatile("s_waitcnt lgkmcnt(0)\n\ts_barrier" ::: "memory");
    DMA_TILE(0, 0); DMA_TILE(1, 1); DMA_TILE(2, 2); DMA_TILE(3, 3);
    asm volatile("s_waitcnt vmcnt(4)\n\ts_barrier" ::: "memory");
    int kof[4];
#pragma unroll
    for (int q = 0; q < 4; ++q) kof[q] = r32 * 128 + ((hi + (r32 >> 1) + 2 * q) & 7) * 16;
    const int vfo = ((lane >> 4) & 1) * 32 + (lane & 3) * 8 + (4 * hi + ((lane & 15) >> 2)) * 64;
    f32x16 cA0, cA1, cB0, cB1; u32x4 pwp[4], pwq[4]; bf16x8 vq[8], kq[4];
#define LDKM(g, slotbase, map) kq[g] = *(const LAS bf16x8*)((slotbase) + kof[(map) * 2 + ((g) >> 1)] + ((g) & 1) * 4096)
#define LDV(g, base) do { const s16x4 l0_ = vtr((base) + (g) * 1024), h0_ = vtr((base) + (g) * 1024 + 512), l1_ = vtr((base) + 4096 + (g) * 1024), h1_ = vtr((base) + 4096 + (g) * 1024 + 512); \
        vq[g] = (bf16x8){l0_[0], l0_[1], l0_[2], l0_[3], h0_[0], h0_[1], h0_[2], h0_[3]}; vq[4 + (g)] = (bf16x8){l1_[0], l1_[1], l1_[2], l1_[3], h1_[0], h1_[1], h1_[2], h1_[3]}; } while (0)
    {
        const LAS char* kb_ = sm + DQ_K;
#pragma unroll
        for (int r = 0; r < 16; ++r) { cA0[r] = 0.f; cA1[r] = 0.f; cB0[r] = 0.f; cB1[r] = 0.f; }
#pragma unroll
        for (int j = 0; j < 2; ++j) { cA0 = __builtin_amdgcn_mfma_f32_32x32x16_bf16(*(const LAS bf16x8*)(kb_ + kof[j]), qr[j], cA0, 0, 0, 0);
                                      cA1 = __builtin_amdgcn_mfma_f32_32x32x16_bf16(*(const LAS bf16x8*)(kb_ + kof[j] + 4096), qr[j], cA1, 0, 0, 0);
                                      cB0 = __builtin_amdgcn_mfma_f32_32x32x16_bf16(*(const LAS bf16x8*)(kb_ + kof[2 + j]), qr[2 + j], cB0, 0, 0, 0);
                                      cB1 = __builtin_amdgcn_mfma_f32_32x32x16_bf16(*(const LAS bf16x8*)(kb_ + kof[2 + j] + 4096), qr[2 + j], cB1, 0, 0, 0); }
#pragma unroll
        for (int r = 0; r < 16; ++r) { cA0[r] = __builtin_amdgcn_exp2f(cA0[r]); cA1[r] = __builtin_amdgcn_exp2f(cA1[r]); }
#pragma unroll
        for (int k = 0; k < 2; ++k) {
            pwq[k] = (u32x4){cvtpk_s(cA0[8 * k + 0], cA0[8 * k + 1]), cvtpk_s(cA0[8 * k + 2], cA0[8 * k + 3]), cvtpk_s(cA0[8 * k + 4], cA0[8 * k + 5]), cvtpk_s(cA0[8 * k + 6], cA0[8 * k + 7])};
            pwq[2 + k] = (u32x4){cvtpk_s(cA1[8 * k + 0], cA1[8 * k + 1]), cvtpk_s(cA1[8 * k + 2], cA1[8 * k + 3]), cvtpk_s(cA1[8 * k + 4], cA1[8 * k + 5]), cvtpk_s(cA1[8 * k + 6], cA1[8 * k + 7])}; }
        const LAS char* v0_ = sm + DQ_V + vfo; const LAS char* k1_ = sm + DQ_K + 8192;
#pragma unroll
        for (int g = 0; g < 4; ++g) { LDV(g, v0_); LDKM(g, k1_, 0); }
        __builtin_amdgcn_sched_barrier(0);
    }
#define STEPF(CC0, CC1, PWC, PWP, MPREV, CN0, CN1, MNEXT, RELOAD, NREAD) do { \
    _Pragma("unroll") for (int r_ = 0; r_ < 16; ++r_) { CN0[r_] = 0.f; CN1[r_] = 0.f; } \
    _Pragma("unroll") for (int g_ = 0; g_ < 4; ++g_) { \
        o[MPREV][0] = __builtin_amdgcn_mfma_f32_32x32x16_bf16(__builtin_bit_cast(bf16x8, PWP[g_]), vq[g_], o[MPREV][0], 0, 0, 0); \
        o[MPREV][1] = __builtin_amdgcn_mfma_f32_32x32x16_bf16(__builtin_bit_cast(bf16x8, PWP[g_]), vq[4 + g_], o[MPREV][1], 0, 0, 0); \
        ls[MPREV] = __builtin_amdgcn_mfma_f32_16x16x32_bf16(__builtin_bit_cast(bf16x8, PWP[g_]), onesB, ls[MPREV], 0, 0, 0); \
        if ((g_ & 1) == 0) CN0 = __builtin_amdgcn_mfma_f32_32x32x16_bf16(kq[g_], qr[2 * (MNEXT) + (g_ >> 1)], CN0, 0, 0, 0); \
        else               CN1 = __builtin_amdgcn_mfma_f32_32x32x16_bf16(kq[g_], qr[2 * (MNEXT) + (g_ >> 1)], CN1, 0, 0, 0); \
        _Pragma("unroll") for (int r_ = 4 * g_; r_ < 4 * g_ + 4; ++r_) { CC0[r_] = __builtin_amdgcn_exp2f(CC0[r_]); CC1[r_] = __builtin_amdgcn_exp2f(CC1[r_]); } \
        if (g_ == 1) { PWC[0] = (u32x4){cvtpk_s(CC0[0], CC0[1]), cvtpk_s(CC0[2], CC0[3]), cvtpk_s(CC0[4], CC0[5]), cvtpk_s(CC0[6], CC0[7])}; \
                       PWC[2] = (u32x4){cvtpk_s(CC1[0], CC1[1]), cvtpk_s(CC1[2], CC1[3]), cvtpk_s(CC1[4], CC1[5]), cvtpk_s(CC1[6], CC1[7])}; } \
        if (g_ == 3) { PWC[1] = (u32x4){cvtpk_s(CC0[8], CC0[9]), cvtpk_s(CC0[10], CC0[11]), cvtpk_s(CC0[12], CC0[13]), cvtpk_s(CC0[14], CC0[15])}; \
                       PWC[3] = (u32x4){cvtpk_s(CC1[8], CC1[9]), cvtpk_s(CC1[10], CC1[11]), cvtpk_s(CC1[12], CC1[13]), cvtpk_s(CC1[14], CC1[15])}; } \
        RELOAD(g_); } \
    _Pragma("unroll") for (int g_ = 0; g_ < 4; ++g_) { \
        _Pragma("unroll") for (int i_ = 0; i_ < 4; ++i_) { __builtin_amdgcn_sched_group_barrier(0x008, 1, 0); __builtin_amdgcn_sched_group_barrier(0x400, 2, 0); } \
        __builtin_amdgcn_sched_group_barrier(0x100, NREAD, 0); }        \
    __builtin_amdgcn_sched_barrier(0); } while (0)
#define RELOAD_A(g) LDKM(g, k1_, 1)
#define RELOAD_B(g) do { LDKM(g, k2_, 0); LDV(g, v1_); } while (0)
    int s1 = 1, s2 = 2, s4 = 4;
    for (int t = 0; t < NT; ++t) {
        if (t + 3 < NT) asm volatile("s_waitcnt vmcnt(2)\n\ts_barrier" ::: "memory"); else asm volatile("s_waitcnt vmcnt(0)\n\ts_barrier" ::: "memory");
        if (t + 4 < NT) DMA_TILE(t + 4, s4);
        const LAS char* k1_ = sm + DQ_K + s1 * 8192; const LAS char* k2_ = sm + DQ_K + s2 * 8192; const LAS char* v1_ = sm + DQ_V + s1 * 8192 + vfo;
        __builtin_amdgcn_sched_barrier(0);
        STEPF(cB0, cB1, pwp, pwq, 0, cA0, cA1, 0, RELOAD_A, 1);
        STEPF(cA0, cA1, pwq, pwp, 1, cB0, cB1, 1, RELOAD_B, 5);
        s1 = s2; s2 = (s2 == 4) ? 0 : s2 + 1; s4 = (s4 == 4) ? 0 : s4 + 1;
    }
#undef TILE_ROW0
#undef DMA_TILE
#undef STEPF
#undef RELOAD_A
#undef RELOAD_B
#undef LDKM
#undef LDV
}

template <bool SAFE>
__device__ __forceinline__ bool diff_unit(const Params& p, int l, float lam_init, float lam, int u, float* lds) {
    char* ws = p.ws; const int tid = TIDX, lane = tid & 63, r32 = lane & 31, hi = lane >> 5, wid = __builtin_amdgcn_readfirstlane(tid >> 6);
    const bf16_t* P = (const bf16_t*)(ws + OFF_P); bf16_t* O = (bf16_t*)(ws + OFF_ACT);
    LAS char* sm = (LAS char*)lds;
    int b, h, qrow0, t_lo;
    if (u < 512) { b = u >> 8; h = (u >> 6) & 3; qrow0 = b * NSEQ + (u & 63) * 256; t_lo = 0; }
    else { const int v = u - 512; b = v >> 2; h = v & 3; qrow0 = NLAT + b * NCTX; t_lo = 256; }
    bf16x8 qr[4];
    { const bf16_t* qp = P + (size_t)(qrow0 + wid * 32 + r32) * DIN + C_DQ + h * 64 + hi * 8;
#pragma unroll
      for (int d0 = 0; d0 < 4; ++d0) qr[d0] = *(const bf16x8*)(qp + d0 * 16); }
        asm volatile("" :: "v"(qr[0]), "v"(qr[1]), "v"(qr[2]), "v"(qr[3]));
    f32x16 o[2][2]; float lsum[2] = {1.f, 1.f}; f32x4 ls[2];
    if (SAFE) diff_tiles<true>(P, b, h, t_lo, sm, tid, wid, lane, qr, o, lsum); else diff_tiles_fast(P, b, h, t_lo, sm, tid, wid, lane, qr, o, ls);
    constexpr int WS_OFF = SAFE ? DD_WS : DQ_WS, ST_OFF = SAFE ? DD_ST : DQ_ST;
    if (!SAFE) {
        bool bad = false;
#pragma unroll
        for (int i = 0; i < 4; ++i) bad |= !(ls[0][i] > 7.9e-31f && ls[0][i] < 1.2e30f && ls[1][i] > 7.9e-31f && ls[1][i] < 1.2e30f);
        LAS unsigned* flg = (LAS unsigned*)(sm + WS_OFF + 2048);
        const unsigned anyb = __any(bad) ? 1u : 0u;
        if (lane == 0) flg[wid] = anyb;
        asm volatile("s_waitcnt lgkmcnt(0)\n\ts_barrier" ::: "memory");
        const unsigned allb = flg[0] | flg[1] | flg[2] | flg[3] | flg[4] | flg[5] | flg[6] | flg[7];
        if (__builtin_expect(allb != 0u, 0)) return true;
    }
    int lane_e = TIDX & 63;
    { const int r32e = lane_e & 31, hie = lane_e >> 5;
    LAS float* wse = (LAS float*)(sm + WS_OFF) + wid * 64; LAS float* stge = (LAS float*)(sm + ST_OFF) + wid * 2048;
    if (SAFE) { const float l0 = xhalf_sum(lsum[0]), l1 = xhalf_sum(lsum[1]); if (hie == 0) { wse[r32e] = 1.0f / l0; wse[32 + r32e] = lam / l1; } }
    else if ((lane_e & 7) == 0) { const int qb = ((lane_e >> 3) & 1) * 16 + (lane_e >> 4) * 4;
#pragma unroll
        for (int i = 0; i < 4; ++i) { wse[qb + i] = 1.0f / ls[0][i]; wse[32 + qb + i] = lam / ls[1][i]; } }
#pragma unroll
    for (int r = 0; r < 16; ++r) { const int q = crow(r, hie); const float i0 = wse[q], i1 = wse[32 + q];
        stge[q * 64 + r32e] = o[0][0][r] * i0 - o[1][0][r] * i1; stge[q * 64 + 32 + r32e] = o[0][1][r] * i0 - o[1][1][r] * i1; } }
    LAS float* stg = (LAS float*)(sm + ST_OFF) + wid * 2048;
    const float* gn = p.diff_gn + l * 256 + h * 64 + (lane_e & 7) * 8;
    const f32x4 g0 = *(const f32x4*)gn, g1 = *(const f32x4*)(gn + 4);
#pragma unroll
    for (int i = 0; i < 4; ++i) { const int row = i * 8 + (lane_e >> 3), ch = lane_e & 7;
        const f32x4 v0 = *(const LAS f32x4*)(stg + row * 64 + ch * 8), v1 = *(const LAS f32x4*)(stg + row * 64 + ch * 8 + 4);
        float ss = v0[0] * v0[0] + v0[1] * v0[1] + v0[2] * v0[2] + v0[3] * v0[3] + v1[0] * v1[0] + v1[1] * v1[1] + v1[2] * v1[2] + v1[3] * v1[3];
        ss += __shfl_xor(ss, 1); ss += __shfl_xor(ss, 2); ss += __shfl_xor(ss, 4);
        const float rn = rsqrtf(ss * (1.0f / 64.0f) + 1e-6f) * (1.0f - lam_init);
        u32x4 w; w.x = cvtpk_s(v0[0] * rn * g0[0], v0[1] * rn * g0[1]); w.y = cvtpk_s(v0[2] * rn * g0[2], v0[3] * rn * g0[3]);
        w.z = cvtpk_s(v1[0] * rn * g1[0], v1[1] * rn * g1[1]); w.w = cvtpk_s(v1[2] * rn * g1[2], v1[3] * rn * g1[3]);
        *(u32x4*)(O + (size_t)(qrow0 + wid * 32 + row) * DM + 512 + h * 64 + ch * 8) = w; }
    return false;
}
__device__ __forceinline__ void ph_diff(const Params& p, int l, bool need_ctx, float lam_init, int bid, int nb, float* lds) {
    const float lam = __int_as_float(__builtin_amdgcn_readfirstlane(__float_as_int(diff_lambda_val(p, l, lam_init))));
    const int nun = 512 + (need_ctx ? 8 : 0);
    unsigned redo = 0u; int idx = 0;
    for (int u = (bid + 160) % nb; u < nun; u += nb, ++idx) if (diff_unit<false>(p, l, lam_init, lam, u, lds)) redo |= 1u << idx;
    idx = 0;
    if (__builtin_expect(redo != 0u, 0))
        for (int u = (bid + 160) % nb; u < nun; u += nb, ++idx) if ((redo >> idx) & 1u) (void)diff_unit<true>(p, l, lam_init, lam, u, lds);
}

__device__ __forceinline__ void ph_swa(const Params& p, int l, bool need_ctx, int bid, int nb, float* lds) {
    char* ws = p.ws; const int tid = TIDX, lane = tid & 63, r32 = lane & 31, hi = lane >> 5, wid = __builtin_amdgcn_readfirstlane(tid >> 6);
    const bf16_t* P = (const bf16_t*)(ws + OFF_P); bf16_t* O = (bf16_t*)(ws + OFF_ACT);
    LAS char* sm = (LAS char*)lds;
    LAS float* wsf = (LAS float*)(sm + DD_WS) + wid * 64;
    const int nun = 512 + (need_ctx ? 8 : 0);
    UnitQ uq{(unsigned*)ws + CW_QUE + l * 16 + 0, 0}; q_prefetch(uq);
    for (int u = q_take(uq, lds); u < nun; u = q_take(uq, lds)) {
        q_prefetch(uq);
        int b, h, qrow0, q0, tw_lo, nwin;
        if (u < 512) { b = u >> 8; h = (u >> 6) & 3; q0 = (u & 63) * 256; qrow0 = b * NSEQ + q0; const int lo = q0 - 128 < 0 ? 0 : q0 - 128, hi_ = q0 + 384 > NSEQ ? NSEQ : q0 + 384; tw_lo = lo >> 6; nwin = (hi_ - lo) >> 6; }
        else { const int v = u - 512; b = v >> 2; h = v & 3; q0 = 0; qrow0 = NLAT + b * NCTX; tw_lo = 0; nwin = 0; }
        const int g = h >> 1, nt = nwin + 4;
        const bf16_t* kcol = P + C_AK + g * 64 + wid * 8;
        const bf16_t* vcol = P + C_AV + g * 64 + (wid >> 2) * 32 + (lane & 3) * 8;
        const int krow_in = lane, vrow_in = 16 * (wid & 3) + (lane >> 2);
#define SWA_ROW0(i) ((i) < nwin ? b * NSEQ + (tw_lo + (i)) * 64 : NLAT + b * NCTX + ((i) - nwin) * 64)
        bf16x8 qr[4];
        { const bf16_t* qp = P + (size_t)(qrow0 + wid * 32 + r32) * DIN + C_AQ + h * 64 + hi * 8;
#pragma unroll
          for (int d0 = 0; d0 < 4; ++d0) qr[d0] = *(const bf16x8*)(qp + d0 * 16); }
        asm volatile("" :: "v"(qr[0]), "v"(qr[1]), "v"(qr[2]), "v"(qr[3]));
        f32x16 o[2]; float mhat = p.sink[l * 4 + h] * 1.4426950408889634f, lsum = hi == 0 ? 1.0f : 0.0f;
#pragma unroll
        for (int r = 0; r < 16; ++r) { o[0][r] = 0.f; o[1][r] = 0.f; }
        const int qw = q0 + wid * 32, qpos = qw + r32;
        const unsigned lds0 = (unsigned)(size_t)sm + (unsigned)wid * 1024u;
#define DMA_TILE(i) do { const int r0_ = SWA_ROW0(i); const unsigned sl_ = (unsigned)((i) & 3) * 8192u; \
        glds16(kcol + (size_t)(r0_ + krow_in) * DIN, (unsigned)__builtin_amdgcn_readfirstlane(lds0 + DD_K + sl_)); glds16(vcol + (size_t)(r0_ + vrow_in) * DIN, (unsigned)__builtin_amdgcn_readfirstlane(lds0 + DD_V + sl_)); } while (0)
        asm volatile("s_waitcnt lgkmcnt(0)\n\ts_barrier" ::: "memory");
        DMA_TILE(0); DMA_TILE(1); DMA_TILE(2);
        for (int i = 0; i < nt; ++i) {
            const int cur = i & 3;
            if (i + 2 < nt) asm volatile("s_waitcnt vmcnt(4)\n\ts_barrier" ::: "memory");
            else if (i + 1 < nt) asm volatile("s_waitcnt vmcnt(2)\n\ts_barrier" ::: "memory");
            else asm volatile("s_waitcnt vmcnt(0)\n\ts_barrier" ::: "memory");
            if (i + 3 < nt) DMA_TILE(i + 3);
            const bool win = i < nwin; const int T = (tw_lo + i) * 64;
            const bool skip = win && (T > qw + 31 + 128 || T + 63 < qw - 128);
            if (!skip) {
                const LAS char* kb = sm + DD_K + cur * 8192 + hi * 1024 + r32 * 16;
                const LAS char* vb = sm + DD_V + cur * 8192 + ((lane >> 4) & 1) * 32 + (lane & 3) * 8 + (4 * hi + ((lane & 15) >> 2)) * 64;
                float nm = -mhat; asm volatile("" : "+v"(nm));
                f32x16 c0, c1;
#pragma unroll
                for (int r = 0; r < 16; ++r) { c0[r] = nm; c1[r] = nm; }
#pragma unroll
                for (int j = 0; j < 4; ++j) {
                    c0 = __builtin_amdgcn_mfma_f32_32x32x16_bf16(*(const LAS bf16x8*)(kb + j * 2048), qr[j], c0, 0, 0, 0);
                    c1 = __builtin_amdgcn_mfma_f32_32x32x16_bf16(*(const LAS bf16x8*)(kb + j * 2048 + 512), qr[j], c1, 0, 0, 0); }
                if (win && (T < qw + 31 - 128 || T + 63 > qw + 128)) {
#pragma unroll
                    for (int r = 0; r < 16; ++r) { const int kp = T + crow(r, hi); const int d0_ = qpos - kp, d1_ = d0_ - 32;
                        if (d0_ > 128 || d0_ < -128) c0[r] = -1.0e30f;
                        if (d1_ > 128 || d1_ < -128) c1[r] = -1.0e30f; }
                }
                float rm = fmaxf(c0[0], c1[0]);
#pragma unroll
                for (int r = 1; r < 16; ++r) rm = fmaxf(rm, fmaxf(c0[r], c1[r]));
                rm = xhalf_max(rm);
                if (__any(rm > 8.0f)) {
                    const float dl = fmaxf(rm, 0.f); mhat += dl;
#pragma unroll
                    for (int r = 0; r < 16; ++r) { c0[r] -= dl; c1[r] -= dl; }
                    const float f = __builtin_amdgcn_exp2f(-dl); lsum *= f;
                    if (hi == 0) wsf[r32] = f;
#pragma unroll
                    for (int r = 0; r < 16; ++r) { const float fr_ = wsf[crow(r, hi)]; o[0][r] *= fr_; o[1][r] *= fr_; }
                }
                float sacc = 0.f;
#pragma unroll
                for (int r = 0; r < 16; ++r) { c0[r] = __builtin_amdgcn_exp2f(c0[r]); c1[r] = __builtin_amdgcn_exp2f(c1[r]); sacc += c0[r] + c1[r]; }
                lsum += sacc;
                u32x4 pw[4];
#pragma unroll
                for (int k = 0; k < 2; ++k) {
                    pw[k] = (u32x4){cvtpk_s(c0[8 * k + 0], c0[8 * k + 1]), cvtpk_s(c0[8 * k + 2], c0[8 * k + 3]), cvtpk_s(c0[8 * k + 4], c0[8 * k + 5]), cvtpk_s(c0[8 * k + 6], c0[8 * k + 7])};
                    pw[2 + k] = (u32x4){cvtpk_s(c1[8 * k + 0], c1[8 * k + 1]), cvtpk_s(c1[8 * k + 2], c1[8 * k + 3]), cvtpk_s(c1[8 * k + 4], c1[8 * k + 5]), cvtpk_s(c1[8 * k + 6], c1[8 * k + 7])}; }
#pragma unroll
                for (int k = 0; k < 4; ++k) {
                    const s16x4 lo0 = vtr(vb + k * 1024), hi0 = vtr(vb + k * 1024 + 512), lo1 = vtr(vb + 4096 + k * 1024), hi1 = vtr(vb + 4096 + k * 1024 + 512);
                    o[0] = __builtin_amdgcn_mfma_f32_32x32x16_bf16(__builtin_bit_cast(bf16x8, pw[k]), (bf16x8){lo0[0], lo0[1], lo0[2], lo0[3], hi0[0], hi0[1], hi0[2], hi0[3]}, o[0], 0, 0, 0);
                    o[1] = __builtin_amdgcn_mfma_f32_32x32x16_bf16(__builtin_bit_cast(bf16x8, pw[k]), (bf16x8){lo1[0], lo1[1], lo1[2], lo1[3], hi1[0], hi1[1], hi1[2], hi1[3]}, o[1], 0, 0, 0); }
            }
            asm volatile("s_waitcnt lgkmcnt(0)" ::: "memory");
        }
#undef SWA_ROW0
#undef DMA_TILE
        const float inv = 1.0f / xhalf_sum(lsum);
        int lane_e = TIDX & 63;
        { const int r32e = lane_e & 31, hie = lane_e >> 5;
        LAS float* wse = (LAS float*)(sm + DD_WS) + wid * 64; LAS float* stge = (LAS float*)(sm + DD_ST) + wid * 2048;
        if (hie == 0) wse[r32e] = inv;
#pragma unroll
        for (int r = 0; r < 16; ++r) { const int q = crow(r, hie); const float i0 = wse[q]; stge[q * 64 + r32e] = o[0][r] * i0; stge[q * 64 + 32 + r32e] = o[1][r] * i0; } }
        LAS float* stg = (LAS float*)(sm + DD_ST) + wid * 2048;
#pragma unroll
        for (int i = 0; i < 4; ++i) { const int row = i * 8 + (lane_e >> 3), ch = lane_e & 7;
            const f32x4 v0 = *(const LAS f32x4*)(stg + row * 64 + ch * 8), v1 = *(const LAS f32x4*)(stg + row * 64 + ch * 8 + 4);
            u32x4 w; w.x = cvtpk_s(v0[0], v0[1]); w.y = cvtpk_s(v0[2], v0[3]); w.z = cvtpk_s(v1[0], v1[1]); w.w = cvtpk_s(v1[2], v1[3]);
            *(u32x4*)(O + (size_t)(qrow0 + wid * 32 + row) * DM + h * 64 + ch * 8) = w; }
    }
}

__device__ __forceinline__ void moe_offsets(const Params& p, int* offs  ) {
    if (TIDX < 2) { const unsigned* cw = (const unsigned*)p.ws + CW_CNT + TIDX * 8; int o = 0;
        for (int e = 0; e < 8; ++e) { offs[TIDX * 9 + e] = o; o += ((int)__hip_atomic_load(cw + e, __ATOMIC_RELAXED, __HIP_MEMORY_SCOPE_AGENT) + 255) & ~255; }
        offs[TIDX * 9 + 8] = o; }
    __syncthreads();
}
__device__ __forceinline__ void ph_moe_scatter(const Params& p, int bid, int nb, float* lds) {
    char* ws = p.ws; int* offs = (int*)lds; moe_offsets(p, offs);
    const int lane = TIDX & 63, wv = TIDX >> 6;
    const bf16_t* H = (const bf16_t*)(ws + OFF_ACT); bf16_t* AS = (bf16_t*)(ws + OFF_ASORT);
    int* tok = (int*)(ws + OFF_TOK); float* wgt = (float*)(ws + OFF_WGT); const unsigned* cw = (const unsigned*)ws;
    const int step = nb * 8 * 4; int r0 = (bid * 8 + wv) * 4;
    int4 rec[4]; u32x4 d8[4];
#define SC_LOAD(rc, dd, rbase) do { _Pragma("unroll") for (int k = 0; k < 4; ++k) { rc[k] = *(const int4*)(ws + OFF_ROUTE + (size_t)((rbase) + k) * 16); dd[k] = ((const u32x4*)((const unsigned char*)H + (size_t)((rbase) + k) * DM))[lane]; } } while (0)
    if (r0 < NLAT) SC_LOAD(rec, d8, r0);
    for (; r0 < NLAT; r0 += step) {
        int pos[4][2];
#pragma unroll
        for (int k = 0; k < 4; ++k) { const int blk = ((r0 + k) >> 3) % nb;
#pragma unroll
            for (int g = 0; g < 2; ++g) { const int e = (g == 0 ? rec[k].x : rec[k].y) & 15, li = (g == 0 ? rec[k].x : rec[k].y) >> 4;
                pos[k][g] = offs[g * 9 + e] + (int)cw[CW_BLK + blk * 16 + g * 8 + e] + li; } }
        const int rn = r0 + step < NLAT ? r0 + step : r0;
        int4 recn[4]; u32x4 d8n[4];
        SC_LOAD(recn, d8n, rn);
#pragma unroll
        for (int k = 0; k < 4; ++k)
#pragma unroll
            for (int g = 0; g < 2; ++g) { const int ps = pos[k][g];
                u32x4* dst = (u32x4*)((unsigned char*)AS + ((size_t)g * GRP_ROWS + ps) * DM); dst[lane] = d8[k]; }
#pragma unroll
        for (int k = 0; k < 4; ++k) { rec[k] = recn[k]; d8[k] = d8n[k]; }
    }
#undef SC_LOAD
}

__device__ __forceinline__ void ph_final(const Params& p, int bid, int nb, float* lds) {
    char* ws = p.ws; int* offs = (int*)lds; __syncthreads(); moe_offsets(p, offs);
    const int lane = TIDX & 63, wv = TIDX >> 6;
    const bf16_t* Y = (const bf16_t*)(ws + OFF_YMOE); const unsigned* cw = (const unsigned*)ws;
    const float* gt2 = (const float*)(ws + OFF_MOD) + (size_t)3 * 6144 + 5120;
    const int stride = nb * 8;
    int4 rec[2]; int pos[2][2];
#define FIN_REC(dst, rbase) do { _Pragma("unroll") for (int q = 0; q < 2; ++q) { const int r_ = ((rbase) + q * stride < NLAT) ? (rbase) + q * stride : (rbase); dst[q] = *(const int4*)(ws + OFF_ROUTE + (size_t)r_ * 16); } } while (0)
#define FIN_POS(dst, src_, rbase) do { _Pragma("unroll") for (int q = 0; q < 2; ++q) { const int r_ = ((rbase) + q * stride < NLAT) ? (rbase) + q * stride : (rbase); const int blk_ = (r_ >> 3) % nb; \
        const int e0_ = src_[q].x & 15, e1_ = src_[q].y & 15; \
        dst[q][0] = offs[e0_] + (int)cw[CW_BLK + blk_ * 16 + e0_] + (src_[q].x >> 4); dst[q][1] = offs[9 + e1_] + (int)cw[CW_BLK + blk_ * 16 + 8 + e1_] + (src_[q].y >> 4); } } while (0)
    int r0 = bid * 8 + wv;
    float4 fg[4];
#pragma unroll
    for (int i = 0; i < 4; ++i) fg[i] = *(const float4*)(p.final_norm + i * 256 + lane * 4);
    float4 gq[2][4]; int gcls[2] = {-1, -1};
    if (r0 < NLAT) { FIN_REC(rec, r0); FIN_POS(pos, rec, r0); }
    for (; r0 < NLAT; r0 += 2 * stride) {
        const bool has1 = r0 + stride < NLAT; const int rn = r0 + 2 * stride; const bool more = rn < NLAT;
        const int rnc = more ? rn : r0;
        int4 recn[2]; int posn[2][2];
        FIN_REC(recn, rnc);
        float4 v[2][4]; uint2 ya[2][4], yb[2][4];
#pragma unroll
        for (int q = 0; q < 2; ++q) { const int r = (q == 0 || has1) ? r0 + q * stride : r0;
            { const int cls = __builtin_amdgcn_readfirstlane(mod_class(r));
              if (cls != gcls[q]) { gcls[q] = cls;
#pragma unroll
                  for (int i = 0; i < 4; ++i) gq[q][i] = *(const float4*)(gt2 + (size_t)cls * 6144 + i * 256 + lane * 4); } }
            const bf16_t* y0 = Y + (size_t)pos[q][0] * DM; const bf16_t* y1 = Y + ((size_t)GRP_ROWS + pos[q][1]) * DM; const bf16_t* xr = (const bf16_t*)(ws + OFF_XB) + (size_t)r * DM;
#pragma unroll
            for (int i = 0; i < 4; ++i) { const int c = i * 256 + lane * 4; { const uint2 w = *(const uint2*)(xr + c); v[q][i] = make_float4(BFLO(w.x), BFHI(w.x), BFLO(w.y), BFHI(w.y)); } ya[q][i] = *(const uint2*)(y0 + c); yb[q][i] = *(const uint2*)(y1 + c); } }
        FIN_POS(posn, recn, rnc);
        float ss[2];
#pragma unroll
        for (int q = 0; q < 2; ++q) { const float w0 = __int_as_float(rec[q].z), w1 = __int_as_float(rec[q].w); float s = 0.f;
#pragma unroll
            for (int i = 0; i < 4; ++i) { const uint2 a = ya[q][i], b = yb[q][i]; const float4 g = gq[q][i];
                v[q][i].x += g.x * (w0 * BFLO(a.x) + w1 * BFLO(b.x)); v[q][i].y += g.y * (w0 * BFHI(a.x) + w1 * BFHI(b.x)); v[q][i].z += g.z * (w0 * BFLO(a.y) + w1 * BFLO(b.y)); v[q][i].w += g.w * (w0 * BFHI(a.y) + w1 * BFHI(b.y));
                s += v[q][i].x * v[q][i].x + v[q][i].y * v[q][i].y + v[q][i].z * v[q][i].z + v[q][i].w * v[q][i].w; }
            ss[q] = wave_sum(s); }
#pragma unroll
        for (int q = 0; q < 2; ++q) { if (q == 1 && !has1) break;
            float* xr = p.out + (size_t)(r0 + q * stride) * DM; const float rn_ = rsqrtf(ss[q] * (1.0f / 1024.0f) + 1e-6f);
#pragma unroll
            for (int i = 0; i < 4; ++i) { const float4 g = fg[i];
                float4 o; o.x = v[q][i].x * rn_ * g.x; o.y = v[q][i].y * rn_ * g.y; o.z = v[q][i].z * rn_ * g.z; o.w = v[q][i].w * rn_ * g.w; *(float4*)(xr + i * 256 + lane * 4) = o; } }
#pragma unroll
        for (int q = 0; q < 2; ++q) { rec[q] = recn[q]; pos[q][0] = posn[q][0]; pos[q][1] = posn[q][1]; }
    }
#undef FIN_REC
#undef FIN_POS
}

struct EpiStoreBf16 {
    static constexpr bool PERM = true, AFTER_DRAIN = false; bf16_t* O; int ldc;
    __device__ __forceinline__ void operator()(const f32x4 (&acc)[2][2][4][2], const pg8::Unit& u, int wr, int wc, int fr, int fq) const {
        bf16_t* base = O + (size_t)(u.pm * 256 + wr * 64 + fr) * ldc + u.pn * 256 + wc * 32 + 8 * fq;
#pragma unroll
        for (int ai = 0; ai < 2; ++ai)
#pragma unroll
            for (int m = 0; m < 4; ++m) { bf16_t* rowp = base + (size_t)(ai * 128 + m * 16) * ldc;
#pragma unroll
                for (int bj = 0; bj < 2; ++bj) { const f32x4 v0 = acc[ai][bj][m][0], v1 = acc[ai][bj][m][1]; u32x4 w;
                    w.x = pg8::cvt_pk_bf16(v0[0], v0[1]); w.y = pg8::cvt_pk_bf16(v0[2], v0[3]); w.z = pg8::cvt_pk_bf16(v1[0], v1[1]); w.w = pg8::cvt_pk_bf16(v1[2], v1[3]);
                    *(u32x4*)(rowp + bj * 128) = w; } }
    }
};
template <bool F8OUT>
struct EpiSwiglu {
    static constexpr bool PERM = true, AFTER_DRAIN = false; void* U; int ldu, npe;
    __device__ __forceinline__ void operator()(const f32x4 (&acc)[2][2][4][2], const pg8::Unit& u, int wr, int wc, int fr, int fq) const {
        { const int ln_ = (int)__builtin_amdgcn_mbcnt_hi(~0u, __builtin_amdgcn_mbcnt_lo(~0u, 0u)); fr = ln_ & 15; fq = ln_ >> 4; }
        const size_t e0 = (size_t)(u.pm * 256 + wr * 64 + fr) * ldu + (u.pn % npe) * 128 + wc * 32 + 8 * fq;
        uint2 wprev = {0u, 0u};
#pragma unroll
        for (int ai = 0; ai < 2; ++ai)
#pragma unroll
            for (int m = 0; m < 4; ++m) { float o[8];
#pragma unroll
                for (int n = 0; n < 2; ++n)
#pragma unroll
                    for (int i = 0; i < 4; i += 2) { const f32x2_t a2 = {acc[ai][0][m][n][i], acc[ai][0][m][n][i + 1]}, b2 = {acc[ai][1][m][n][i], acc[ai][1][m][n][i + 1]};
                        const f32x2_t t2 = a2 * -1.4426950408889634f; constexpr float s_ = F8OUT ? 1.0f / F8_ASCALE : 1.0f;
                        const f32x2_t e2 = {__builtin_amdgcn_exp2f(t2[0]), __builtin_amdgcn_exp2f(t2[1])}, d2 = e2 * s_ + s_;
                        const f32x2_t r2 = {__builtin_amdgcn_rcpf(d2[0]), __builtin_amdgcn_rcpf(d2[1])}, o2 = (a2 * b2) * r2;
                        o[n * 4 + i] = o2[0]; o[n * 4 + i + 1] = o2[1]; }
                const size_t e = e0 + (size_t)(ai * 128 + m * 16) * ldu;
                if (F8OUT) { uint2 w; w.x = pack4_fp8(o[0], o[1], o[2], o[3]); w.y = pack4_fp8(o[4], o[5], o[6], o[7]);
                    if ((m & 1) == 0) wprev = w;
                    else { const auto sx = __builtin_amdgcn_permlane16_swap(wprev.x, w.x, false, false), sy = __builtin_amdgcn_permlane16_swap(wprev.y, w.y, false, false);
                        const bool oddq = (fq & 1) != 0; const size_t ew = e0 + (size_t)(ai * 128 + (m - 1 + (oddq ? 1 : 0)) * 16) * ldu - (oddq ? 8 : 0);
                        *(u32x4*)((unsigned char*)U + ew) = (u32x4){sx[0], sy[0], sx[1], sy[1]}; } }
                else { u32x4 w; w.x = pg8::cvt_pk_bf16(o[0], o[1]); w.y = pg8::cvt_pk_bf16(o[2], o[3]); w.z = pg8::cvt_pk_bf16(o[4], o[5]); w.w = pg8::cvt_pk_bf16(o[6], o[7]);
                    *(u32x4*)((bf16_t*)U + e) = w; } }
    }
};
template <bool IN_F32>
struct EpiResidual {
    static constexpr bool PERM = true, AFTER_DRAIN = false; const float* xin; bf16_t* xb; const float* gate;
    __device__ __forceinline__ void operator()(const f32x4 (&acc)[2][2][4][2], const pg8::Unit& u, int wr, int wc, int fr, int fq) const {
        { const int ln_ = (int)__builtin_amdgcn_mbcnt_hi(~0u, __builtin_amdgcn_mbcnt_lo(~0u, 0u)); fr = ln_ & 15; fq = ln_ >> 4; }
        const int cls = u.pm < 64 ? 0 : 1, col0 = u.pn * 256 + wc * 32 + 8 * fq;
        const float* gv = gate + (size_t)cls * 6144 + col0;
        f32x4 g4[2][2];
#pragma unroll
        for (int bj = 0; bj < 2; ++bj)
#pragma unroll
            for (int n = 0; n < 2; ++n) g4[bj][n] = *(const f32x4*)(gv + bj * 128 + n * 4);
        const size_t row0 = (size_t)u.pm * 256 + wr * 64 + fr;
        f32x4 xv[8][2][2]; u32x4 xw[8][2];
#define ER_LD(i) do { const size_t off_ = (row0 + ((i) >> 2) * 128 + ((i) & 3) * 16) * DM + col0; \
            _Pragma("unroll") for (int bj = 0; bj < 2; ++bj) { if (IN_F32) { xv[i][bj][0] = *(const f32x4*)(xin + off_ + bj * 128); xv[i][bj][1] = *(const f32x4*)(xin + off_ + bj * 128 + 4); } \
                                                                else xw[i][bj] = *(const u32x4*)(xb + off_ + bj * 128); } } while (0)
#define ER_ST(i) do { const size_t off_ = (row0 + ((i) >> 2) * 128 + ((i) & 3) * 16) * DM + col0; \
            _Pragma("unroll") for (int bj = 0; bj < 2; ++bj) { f32x4 x0_, x1_; \
                if (IN_F32) { x0_ = xv[i][bj][0]; x1_ = xv[i][bj][1]; } \
                else { const u32x4 w_ = xw[i][bj]; x0_ = (f32x4){BFLO(w_.x), BFHI(w_.x), BFLO(w_.y), BFHI(w_.y)}; x1_ = (f32x4){BFLO(w_.z), BFHI(w_.z), BFLO(w_.w), BFHI(w_.w)}; } \
                const f32x4 o0_ = x0_ + g4[bj][0] * acc[(i) >> 2][bj][(i) & 3][0], o1_ = x1_ + g4[bj][1] * acc[(i) >> 2][bj][(i) & 3][1]; \
                u32x4 ow_; ow_.x = pg8::cvt_pk_bf16(o0_[0], o0_[1]); ow_.y = pg8::cvt_pk_bf16(o0_[2], o0_[3]); ow_.z = pg8::cvt_pk_bf16(o1_[0], o1_[1]); ow_.w = pg8::cvt_pk_bf16(o1_[2], o1_[3]); \
                *(u32x4*)(xb + off_ + bj * 128) = ow_; } } while (0)
        ER_LD(0); ER_LD(1); ER_LD(2);
#pragma unroll
        for (int i = 0; i < 8; ++i) { ER_ST(i); if (i + 3 < 8) ER_LD(i + 3); }
#undef ER_LD
#undef ER_ST
    }
};
struct MoeOrder : pg8::StaticOrder {
    int goff, npe, np0;
    __device__ __forceinline__ bool next(int i, pg8::Unit& u) const {
        int pl, pn;
        if (G == 256) {
            const int xcd = c & 7, slot = c >> 3, sb = i * 8 + xcd, NG = nN >> 2, pg = sb / NG, ng = sb - pg * NG;
            pl = pg * 8 + (slot >> 2); pn = ng * 4 + (slot & 3);
            if (pl >= nM) return false;
        } else { const int L = i * G + c; if (L >= nwg) return false; pl = L / nN; pn = L - pl * nN; }
        const int g = pl >= np0 ? 1 : 0, pm = pl - g * np0; u.pn = pn;
        const LAS int* og = (const LAS int*)(size_t)(unsigned)goff + g * 9;
        const int r = pm * 256; int e = 0;
#pragma unroll
        for (int k = 1; k < 8; ++k) e += (r >= og[k]) ? 1 : 0;
        u.pm = g * (GRP_ROWS / 256) + pm; u.pn += __builtin_amdgcn_readfirstlane(e) * npe; return true;
    }
};
#define GEMM_LDS ((PG8_LAS unsigned char*)lds)
struct EpiInProj {
    static constexpr bool PERM = true, AFTER_DRAIN = false; bf16_t* O; const char* tab;
    __device__ __forceinline__ void operator()(const f32x4 (&acc)[2][2][4][2], const pg8::Unit& u, int wr, int wc, int fr, int fq) const {
        const int row0 = u.pm * 256 + wr * 64 + fr; const bool lat = u.pm < 128;
#pragma unroll
        for (int bj = 0; bj < 2; ++bj) {
            const int s = u.pn * 2 + bj;
            int mode = 0; float scale = 1.0f;
            if (s <= 1) { mode = 1; scale = 0.125f * 1.4426950408889634f; } else if (s == 2) mode = 1;
            else if (s == 4 || s == 5) mode = 2; else if (s == 6 || s == 7) { mode = 2; scale = 0.125f; }
            else if (s == 12 || s == 13) { mode = 3; scale = 0.17677669529663687f * 1.4426950408889634f; } else if (s == 14 || s == 15) mode = 3;
            if (mode == 0) {
                bf16_t* base = O + (size_t)row0 * DIN + s * 128 + wc * 32 + 8 * fq;
#pragma unroll
                for (int ai = 0; ai < 2; ++ai)
#pragma unroll
                    for (int m = 0; m < 4; ++m) { const f32x4 v0 = acc[ai][bj][m][0], v1 = acc[ai][bj][m][1]; u32x4 w;
                        w.x = pg8::cvt_pk_bf16(v0[0], v0[1]); w.y = pg8::cvt_pk_bf16(v0[2], v0[3]); w.z = pg8::cvt_pk_bf16(v1[0], v1[1]); w.w = pg8::cvt_pk_bf16(v1[2], v1[3]);
                        *(u32x4*)(base + (size_t)(ai * 128 + m * 16) * DIN) = w; }
            } else {
                const bool wide = mode != 3; const int half = wide ? 32 : 16, g = wide ? 4 * (wc & 1) + fq : fq;
                const int cbase = s * 128 + (wide ? 64 * (wc >> 1) : 32 * wc) + 4 * g;
                const float* ct = (const float*)(tab + (mode == 1 ? TAB_ATTN : (mode == 2 ? TAB_RET : TAB_DIFF))) + 4 * g; const int tstride = half, tsin = 16384 * half;
                f32x4 csv[8], snv[8];
#pragma unroll
                for (int i = 0; i < 8; ++i) { const int row = row0 + (i >> 2) * 128 + (i & 3) * 16; const float* tp = ct + (size_t)(row & (NSEQ - 1)) * tstride;
                    csv[i] = *(const f32x4*)tp; snv[i] = *(const f32x4*)(tp + tsin); }
                asm volatile("" :: "v"(csv[0]), "v"(csv[1]), "v"(csv[2]), "v"(csv[3]), "v"(csv[4]), "v"(csv[5]), "v"(csv[6]), "v"(csv[7]), "v"(snv[0]), "v"(snv[1]), "v"(snv[2]), "v"(snv[3]), "v"(snv[4]), "v"(snv[5]), "v"(snv[6]), "v"(snv[7]));
                const bool oddq = (fq & 1) != 0;
#pragma unroll
                for (int ai = 0; ai < 2; ++ai)
#pragma unroll
                    for (int mp = 0; mp < 4; mp += 2) { uint2 wa[2], wb[2];
#pragma unroll
                        for (int k = 0; k < 2; ++k) { const int m = mp + k; const f32x4 v0 = acc[ai][bj][m][0], v1 = acc[ai][bj][m][1];
                            f32x4 cs = {1.f, 1.f, 1.f, 1.f}, sn = {0.f, 0.f, 0.f, 0.f};
                            if (lat) { cs = csv[ai * 4 + m]; sn = snv[ai * 4 + m]; }
                            const f32x4 o1 = (v0 * cs - v1 * sn) * scale, o2 = (v1 * cs + v0 * sn) * scale;
                            wa[k].x = pg8::cvt_pk_bf16(o1[0], o1[1]); wa[k].y = pg8::cvt_pk_bf16(o1[2], o1[3]); wb[k].x = pg8::cvt_pk_bf16(o2[0], o2[1]); wb[k].y = pg8::cvt_pk_bf16(o2[2], o2[3]); }
                        const auto ax = __builtin_amdgcn_permlane16_swap(wa[0].x, wa[1].x, false, false), ay = __builtin_amdgcn_permlane16_swap(wa[0].y, wa[1].y, false, false);
                        const auto bx = __builtin_amdgcn_permlane16_swap(wb[0].x, wb[1].x, false, false), by = __builtin_amdgcn_permlane16_swap(wb[0].y, wb[1].y, false, false);
                        const int row = row0 + ai * 128 + (mp + (oddq ? 1 : 0)) * 16;
                        bf16_t* op = O + (size_t)row * DIN + cbase - (oddq ? 4 : 0);
                        *(u32x4*)op = (u32x4){ax[0], ay[0], ax[1], ay[1]}; *(u32x4*)(op + half) = (u32x4){bx[0], by[0], bx[1], by[1]}; }
            }
        }
    }
};
template <int K>
__device__ __forceinline__ void ctx_gemm_residual(const bf16_t* A, const bf16_t* W, float* xc, const float* gate, int bid, int nb, float* lds) {
    const int tid = TIDX, lane = tid & 63, wid = __builtin_amdgcn_readfirstlane(tid >> 6);
    constexpr int KW = K / 8, NS = KW / 16, CH = (NS % 11 == 0) ? 11 : 8;
    static_assert(K % 128 == 0 && NS % CH == 0, "ctx_gemm_residual: K split");
    LAS float* red = (LAS float*)lds;
    for (int tile = bid; tile < 256; tile += nb) {
        const int row0 = (tile >> 4) * 32, col0 = (tile & 15) * 64;
        const bf16_t* ap = A + (size_t)(row0 + (lane & 31)) * K + wid * KW + (lane >> 5) * 8;
        const bf16_t* bp = W + (size_t)(col0 + (lane & 31)) * K + wid * KW + (lane >> 5) * 8;
        f32x16 c0, c1;
#pragma unroll
        for (int r = 0; r < 16; ++r) { c0[r] = 0.f; c1[r] = 0.f; }
#pragma unroll 1
        for (int s0 = 0; s0 < NS; s0 += CH) {
            bf16x8 af[CH], b0[CH], b1[CH];
#pragma unroll
            for (int i = 0; i < CH; ++i) { af[i] = *(const bf16x8*)(ap + (s0 + i) * 16); b0[i] = *(const bf16x8*)(bp + (s0 + i) * 16); b1[i] = *(const bf16x8*)(bp + (size_t)32 * K + (s0 + i) * 16); }
#pragma unroll
            for (int i = 0; i < CH; ++i) { c0 = __builtin_amdgcn_mfma_f32_32x32x16_bf16(af[i], b0[i], c0, 0, 0, 0); c1 = __builtin_amdgcn_mfma_f32_32x32x16_bf16(af[i], b1[i], c1, 0, 0, 0); }
        }
        __syncthreads();
#pragma unroll
        for (int r = 0; r < 16; ++r) { red[((wid * 2 + 0) * 16 + r) * 64 + lane] = c0[r]; red[((wid * 2 + 1) * 16 + r) * 64 + lane] = c1[r]; }
        __syncthreads();
#pragma unroll
        for (int j = 0; j < 4; ++j) { const int o = tid + 512 * j; float s = 0.f;
#pragma unroll
            for (int w = 0; w < 8; ++w) s += red[w * 2048 + o];
            const int blk = o >> 10, r = (o >> 6) & 15, ln = o & 63, row = crow(r, ln >> 5), col = col0 + blk * 32 + (ln & 31);
            float* x = xc + (size_t)(row0 + row) * DM + col; *x = *x + gate[col] * s; }
    }
    __syncthreads();
}
__device__ __forceinline__ void ph_gemm_in(const Params& p, int l, int bid, int nb, float* lds) {
    char* ws = p.ws; pg8::Gemm g{(const bf16_t*)(ws + OFF_ACT), (const bf16_t*)(ws + OFF_WIN) + (size_t)l * DIN * DM, NROW, DIN, DM};
    pg8::StaticOrder S; S.init(NROW, DIN, nb, bid);
    EpiInProj E{(bf16_t*)(ws + OFF_P), ws + OFF_TAB};
    if (nb == 256 && bid >= 150) { const int v = CV_MOE0 + (l == 0 ? 0 : CV_TA + CV_TB); convert_units(p, lds, v + bid - 150, 106, v + CV_TA, 0, 0); }
    pg8::gemm_phase<EpiInProj, pg8::StaticOrder, true, true>(GEMM_LDS, g, S, E);
}
__device__ __forceinline__ void ph_gemm_out(const Params& p, int l, bool need_ctx, int bid, int nb, float* lds) {
    char* ws = p.ws; const int M = NLAT;
    if (need_ctx) ctx_gemm_residual<DM>((const bf16_t*)(ws + OFF_ACT) + (size_t)NLAT * DM, (const bf16_t*)(ws + OFF_WOUT) + (size_t)l * DM * DM, (float*)(ws + OFF_XC),
                                        (const float*)(ws + OFF_MOD) + (size_t)l * 3 * 6144 + 2048 + 2 * 6144, bid, nb, lds);
    pg8::Gemm g{(const bf16_t*)(ws + OFF_ACT), (const bf16_t*)(ws + OFF_WOUT) + (size_t)l * DM * DM, M, DM, DM};
    pg8::StaticOrder S; S.init(M, DM, nb, bid);
    const float* gate = (const float*)(ws + OFF_MOD) + (size_t)l * 3 * 6144 + 2048; bf16_t* xb = (bf16_t*)(ws + OFF_XB);
    if (l == 0) { EpiResidual<true> E{p.x, xb, gate}; pg8::gemm_phase<EpiResidual<true>, pg8::StaticOrder, true, true>(GEMM_LDS, g, S, E); }
    else { EpiResidual<false> E{nullptr, xb, gate}; pg8::gemm_phase<EpiResidual<false>, pg8::StaticOrder, true, true>(GEMM_LDS, g, S, E); }
}
__device__ __forceinline__ void ph_ffn1(const Params& p, bool need_ctx, int bid, int nb, float* lds) {
    char* ws = p.ws; const int M = need_ctx ? NROW : NLAT;
    pg8::Gemm g{(const bf16_t*)(ws + OFF_ACT), (const bf16_t*)(ws + OFF_WF13), M, 2 * DFF, DM / 2};
    pg8::StaticOrder S; S.init(M, 2 * DFF, nb, bid);
    EpiSwiglu<false> E{(void*)(ws + OFF_P), DFF, 2 * DFF / 256};
    if (nb == 256 && need_ctx && bid >= 44) { const int v = CV_MOE0 + CV_TA; convert_units(p, lds, v + bid - 44, 212, v + CV_TB, 0, 0); }
    pg8::gemm_phase<EpiSwiglu<false>, pg8::StaticOrder, true, true, true>(GEMM_LDS, g, S, E);
}
__device__ __forceinline__ void ph_ffn2(const Params& p, int l, bool need_ctx, int bid, int nb, float* lds) {
    char* ws = p.ws; const int M = NLAT;
    if (need_ctx) ctx_gemm_residual<DFF>((const bf16_t*)(ws + OFF_P) + (size_t)NLAT * DFF, (const bf16_t*)(ws + OFF_WF2), (float*)(ws + OFF_XC),
                                         (const float*)(ws + OFF_MOD) + (size_t)l * 3 * 6144 + 5120 + 2 * 6144, bid, nb, lds);
    pg8::Gemm g{(const bf16_t*)(ws + OFF_P), (const bf16_t*)(ws + OFF_WF2), M, DM, DFF};
    pg8::StaticOrder S; S.init(M, DM, nb, bid);
    EpiResidual<false> E{nullptr, (bf16_t*)(ws + OFF_XB), (const float*)(ws + OFF_MOD) + (size_t)l * 3 * 6144 + 5120};
    pg8::gemm_phase<EpiResidual<false>, pg8::StaticOrder, true, true>(GEMM_LDS, g, S, E);
}
__device__ __forceinline__ MoeOrder moe_order(const int* offs, int npe, int nb, int bid) {
    MoeOrder S; const int r0 = __builtin_amdgcn_readfirstlane(offs[8]), r1 = __builtin_amdgcn_readfirstlane(offs[17]);
    S.init(r0 + r1, npe * 256, nb, bid); S.goff = (int)(unsigned)(size_t)(const LAS int*)offs; S.npe = npe; S.np0 = r0 >> 8; return S;
}
__device__ __forceinline__ void ph_moe1(const Params& p, int bid, int nb, float* lds) {
    char* ws = p.ws; int* offs = (int*)(lds + 32768); __syncthreads(); moe_offsets(p, offs);
    const MoeOrder S = moe_order(offs, 2 * DFE / 256, nb, bid);
    pg8::Gemm gm{(const bf16_t*)(ws + OFF_ASORT), (const bf16_t*)(ws + OFF_WM13), 0, 0, DM / 2};
    EpiSwiglu<true> E{(void*)(ws + OFF_UMOE), DFE, 2 * DFE / 256};
    pg8::gemm_phase<EpiSwiglu<true>, MoeOrder, true, true, true>(GEMM_LDS, gm, S, E);
}
struct EpiMoeOut {
    static constexpr bool PERM = true, AFTER_DRAIN = false; bf16_t* Y; int npe;
    __device__ __forceinline__ void operator()(const f32x4 (&acc)[2][2][4][2], const pg8::Unit& u, int wr, int wc, int fr, int fq) const {
        { const int ln_ = (int)__builtin_amdgcn_mbcnt_hi(~0u, __builtin_amdgcn_mbcnt_lo(~0u, 0u)); fr = ln_ & 15; fq = ln_ >> 4; }
        bf16_t* base = Y + (size_t)(u.pm * 256 + wr * 64 + fr) * DM + (u.pn % npe) * 256 + wc * 32 + 8 * fq;
#pragma unroll
        for (int ai = 0; ai < 2; ++ai)
#pragma unroll
            for (int m = 0; m < 4; ++m) { bf16_t* rowp = base + (size_t)(ai * 128 + m * 16) * DM;
#pragma unroll
                for (int bj = 0; bj < 2; ++bj) { const f32x4 v0 = acc[ai][bj][m][0], v1 = acc[ai][bj][m][1]; u32x4 w;
                    w.x = pg8::cvt_pk_bf16(v0[0], v0[1]); w.y = pg8::cvt_pk_bf16(v0[2], v0[3]); w.z = pg8::cvt_pk_bf16(v1[0], v1[1]); w.w = pg8::cvt_pk_bf16(v1[2], v1[3]);
                    *(u32x4*)(rowp + bj * 128) = w; } }
    }
};
__device__ __forceinline__ void ph_moe2(const Params& p, int bid, int nb, float* lds) {
    char* ws = p.ws; int* offs = (int*)(lds + 32768); __syncthreads(); moe_offsets(p, offs);
    const MoeOrder S = moe_order(offs, DM / 256, nb, bid);
    pg8::Gemm gm{(const bf16_t*)(ws + OFF_UMOE), (const bf16_t*)(ws + OFF_WM2), 0, 0, DFE / 2};
    EpiMoeOut E{(bf16_t*)(ws + OFF_YMOE), DM / 256};
    pg8::gemm_phase<EpiMoeOut, MoeOrder, true, true, true>(GEMM_LDS, gm, S, E);
}

#define XB_TMO      128
#define XB_XCNT(j)  (256  + 64 * (j))
#define XB_XSUB(j)  (1280 + 64 * (j))
#define XB_XGEN(j)  (2304 + 64 * (j))
#define XB_TOP      3328
#define XB_TOPGEN   3392
#define XCD_BAR_WORDS 3456
#define XB_SPIN_CAP (1u << 22)

__device__ __forceinline__ unsigned xb_ld(unsigned* p)              { return __hip_atomic_load(p, __ATOMIC_RELAXED, __HIP_MEMORY_SCOPE_AGENT); }
__device__ __forceinline__ unsigned xb_add(unsigned* p, unsigned v) { return __hip_atomic_fetch_add(p, v, __ATOMIC_RELAXED, __HIP_MEMORY_SCOPE_AGENT); }
__device__ __forceinline__ unsigned xb_xcc_id() { return (unsigned)__builtin_amdgcn_s_getreg((3 << 11) | 20) & 0xFu; }
#define XB_SPIN(cond, bar) do { unsigned _sp = 0; while (cond) { __builtin_amdgcn_s_sleep(1); \
    if ((++_sp & 255u) == 0u) { if (xb_ld(&(bar)[XB_TMO])) break; if (_sp > XB_SPIN_CAP) { atomicAdd(&(bar)[XB_TMO], 1u); break; } } } } while (0)

struct XcdBarrier {
    unsigned* bar; unsigned x;
    volatile LAS unsigned* st;
};

__device__ __forceinline__ XcdBarrier xcd_barrier_post(unsigned* bar, volatile LAS unsigned* st) {
    XcdBarrier b; b.bar = bar; b.x = xb_xcc_id(); b.st = st;
    if (threadIdx.x == 0) (void)xb_add(&bar[XB_XCNT(b.x)], 1u);
    return b;
}
__device__ __forceinline__ void xcd_barrier_complete(unsigned* bar, unsigned x, unsigned& nloc, unsigned& nx) {
    const unsigned G = gridDim.x * gridDim.y * gridDim.z;
    unsigned sum, cnt, mine, sp = 0u;
    for (;;) {
        sum = 0u; cnt = 0u; mine = 0u;
#pragma unroll
        for (unsigned j = 0; j < 16; ++j) { const unsigned c = xb_ld(&bar[XB_XCNT(j)]); sum += c; cnt += (c > 0u) ? 1u : 0u; mine = (j == x) ? c : mine; }
        if (sum == G) break;
        __builtin_amdgcn_s_sleep(1);
        if ((++sp & 255u) == 0u) { if (xb_ld(&bar[XB_TMO])) break; if (sp > XB_SPIN_CAP) { atomicAdd(&bar[XB_TMO], 1u); break; } }
    }
    nloc = mine > 0u ? mine : 1u; nx = cnt > 0u ? cnt : 1u;
}

__device__ __forceinline__ void xcd_barrier(const XcdBarrier& b) {
    asm volatile("s_waitcnt vmcnt(0)" ::: "memory");
    __syncthreads();
    if (threadIdx.x == 0) {
        unsigned* bar = b.bar;
        __builtin_amdgcn_s_waitcnt(0);
        unsigned nloc = b.st[0], nx = b.st[1];
        if (nloc == 0u) { xcd_barrier_complete(bar, b.x, nloc, nx); b.st[0] = nloc; b.st[1] = nx; }
        const unsigned old = xb_add(&bar[XB_XSUB(b.x)], 1u);
        const unsigned gen = old / nloc;
        if (old + 1u == (gen + 1u) * nloc) {
            __builtin_amdgcn_fence(__ATOMIC_RELEASE, "agent");
            asm volatile("s_waitcnt vmcnt(0)" ::: "memory");
            const unsigned og = xb_add(&bar[XB_TOP], 1u);
            const unsigned tg = og / nx;
            if (og + 1u == (tg + 1u) * nx) xb_add(&bar[XB_TOPGEN], 1u);
            else XB_SPIN(xb_ld(&bar[XB_TOPGEN]) == tg, bar);
            __builtin_amdgcn_fence(__ATOMIC_ACQUIRE, "agent");
            xb_add(&bar[XB_XGEN(b.x)], 1u);
            asm volatile("s_waitcnt vmcnt(0)" ::: "memory");
        } else {
            XB_SPIN(xb_ld(&bar[XB_XGEN(b.x)]) == gen, bar);
            __builtin_amdgcn_fence(__ATOMIC_ACQUIRE, "agent");
            asm volatile("s_waitcnt vmcnt(0)" ::: "memory");
        }
    }
    __syncthreads();
}


constexpr int LDS_FLOATS = 33792;
constexpr int LDS_BYTES = LDS_FLOATS * 4 + 16 + 256 + 16;

typedef const __attribute__((address_space(4))) unsigned long long* kargp_t;
typedef __attribute__((address_space(1))) const float* gcf_t;
__device__ __forceinline__ Params load_params(const float* lds) {
    const LAS unsigned* tbl = (const LAS unsigned*)(lds + LDS_FLOATS + 4);
    Params p; const float** f = (const float**)&p;
#pragma unroll
    for (int i = 0; i < (int)(sizeof(Params) / 8); ++i) {
        const unsigned lo = __builtin_amdgcn_readfirstlane(tbl[2 * i]), hi = __builtin_amdgcn_readfirstlane(tbl[2 * i + 1]);
        f[i] = (const float*)(gcf_t)(((unsigned long long)hi << 32) | lo); }
    return p;
}
#define LOADP(name) const Params name = load_params(lds)

template <int l>
__device__ __forceinline__ void run_layer(const XcdBarrier& bar, int bid, int nb, float* lds) {
    constexpr bool need_ctx = l == 0;
    constexpr float lam_init = l == 0 ? 0.2f : 0.35550906759509393f;
    { LOADP(p); ph_norm<false>(p, l, 0, NROW, bid, nb, lds); } xcd_barrier(bar);
    { LOADP(p); ph_gemm_in(p, l, bid, nb, lds); } xcd_barrier(bar);
    { LOADP(p); ph_ret_summ(p, l, bid, nb, lds); } { LOADP(p); ph_lru_chunk<1>(p, l, bid, nb, lds, 0); } xcd_barrier(bar);
    { LOADP(p); ph_scan2(p, l, bid, nb); } xcd_barrier(bar);
    { LOADP(p); ph_diff(p, l, need_ctx, lam_init, bid, nb, lds); }
    { LOADP(p); ph_swa(p, l, need_ctx, bid, nb, lds); }
    { LOADP(p); ph_ret_out(p, l, bid, nb, lds, need_ctx ? 0 : 2); }
    { LOADP(p); ph_lru_chunk<3>(p, l, bid, nb, lds, need_ctx ? 0 : 2); } xcd_barrier(bar);
    { LOADP(p); ph_gemm_out(p, l, need_ctx, bid, nb, lds); } xcd_barrier(bar);
    if (l == 0) {
        { LOADP(p); ph_norm<false>(p, l, 1, NROW, bid, nb, lds); } xcd_barrier(bar);
        { LOADP(p); ph_ffn1(p, need_ctx, bid, nb, lds); } xcd_barrier(bar);
        { LOADP(p); ph_ffn2(p, l, need_ctx, bid, nb, lds); } xcd_barrier(bar);
    } else {
        { LOADP(p); ph_norm<true>(p, l, 1, NLAT, bid, nb, lds); } xcd_barrier(bar);
        { LOADP(p); ph_moe_scatter(p, bid, nb, lds); } xcd_barrier(bar);
        { LOADP(p); ph_moe1(p, bid, nb, lds); } xcd_barrier(bar);
        { LOADP(p); ph_moe2(p, bid, nb, lds); } xcd_barrier(bar);
    }
}

__global__ void __launch_bounds__(512, 2) fwd(Params p_in) {
    extern __shared__ __attribute__((aligned(16))) float lds[];
    volatile LAS unsigned* st = (volatile LAS unsigned*)(lds + LDS_FLOATS);
    if (threadIdx.x == 0) { st[0] = 0u; st[1] = 0u; st[2] = 0u; st[3] = 0u; }
    if (threadIdx.x < (int)(sizeof(Params) / 8)) { const kargp_t q = (kargp_t)__builtin_amdgcn_kernarg_segment_ptr(); ((LAS unsigned long long*)(lds + LDS_FLOATS + 4))[threadIdx.x] = q[threadIdx.x]; }
    __syncthreads();
    XcdBarrier bar;
    { LOADP(p); bar = xcd_barrier_post((unsigned*)p.ws, st); }
    const int bid = blockIdx.x, nb = gridDim.x;
    { LOADP(p); ph_prologue(p, bid, nb, lds); } xcd_barrier(bar);
    run_layer<0>(bar, bid, nb, lds);
    run_layer<1>(bar, bid, nb, lds);
    { LOADP(p); ph_final(p, bid, nb, lds); }
}

extern "C" void kernel_launch(void* const* d_in, const int* in_sizes, int n_in, void* d_out, int out_size, void* d_ws, size_t ws_size, hipStream_t stream) {
    static int grid = 0;
    if (grid == 0) {
        if (n_in < 30 || ws_size < WS_NEED) { fprintf(stderr, "kernel_launch: bad args n_in=%d ws=%zu need=%zu\n", n_in, ws_size, (size_t)WS_NEED); grid = -1; return; }
        int dev = 0, cus = 0, per_cu = 0;
        if (hipGetDevice(&dev) != hipSuccess || hipDeviceGetAttribute(&cus, hipDeviceAttributeMultiprocessorCount, dev) != hipSuccess) { grid = -1; return; }
        if (hipFuncSetAttribute((const void*)fwd, hipFuncAttributeMaxDynamicSharedMemorySize, LDS_BYTES) != hipSuccess) { fprintf(stderr, "kernel_launch: hipFuncSetAttribute failed\n"); grid = -1; return; }
        if (hipOccupancyMaxActiveBlocksPerMultiprocessor(&per_cu, (const void*)fwd, 512, LDS_BYTES) != hipSuccess || per_cu < 1) { fprintf(stderr, "kernel_launch: occupancy query says %d\n", per_cu); per_cu = 1; }
        (void)hipGetLastError();
        grid = cus;
    }
    if (grid < 0) return;
    Params p{};
    const float** f = (const float**)&p;
    for (int i = 0; i < 30; ++i) f[i] = (const float*)d_in[i];
    p.out = (float*)d_out; p.ws = (char*)d_ws;
    (void)hipMemsetAsync(d_ws, 0, 65536, stream);
    hipLaunchKernelGGL(fwd, dim3(grid), dim3(512), LDS_BYTES, stream, p);
}
```
